# Optimizing an MI355X kernel written in HIP

```python
import functools
import jax, jax.numpy as jnp
from jax import lax
import numpy as np

D_MODEL = 1024
BATCH = 8
SEQ = 2048
DEPTH = 1
DEC_BATCH = 128
DEC_SEQ = 4
PAST_LEN = 8192
PAGE_SIZE = 128

RET_HEADS = 4
RET_DK = 128
RET_DV = 256
RET_CHUNK = 128
MLA_HEADS = 8
MLA_Q_LORA = 384
MLA_KV_LORA = 256
MLA_D_NOPE = 128
MLA_D_ROPE = 64
MLA_D_V = 128
MLA_Q_BLOCK = 128
N_MEM = 256
X_HEADS = 4
X_HD = 64
N_BRANCH = 3
D_FF = -(-8 * D_MODEL // (3 * 256)) * 256
ROPE_BASE = 10000.0
RMS_EPS = 1e-6
IN_SIZES = (RET_HEADS * RET_DK, RET_HEADS * RET_DK, RET_HEADS * RET_DV, RET_HEADS * RET_DV,
            MLA_Q_LORA, MLA_KV_LORA, MLA_D_ROPE, X_HEADS * X_HD, N_BRANCH * D_MODEL)
D_IN = (2 * RET_HEADS * RET_DK + 2 * RET_HEADS * RET_DV + MLA_Q_LORA + MLA_KV_LORA
        + MLA_D_ROPE + X_HEADS * X_HD + N_BRANCH * D_MODEL)

kernel_name = 'hybrid_retention_mla_memory_decoder_step'


def rms_norm(x, g):
    xf = x.astype(jnp.float32)
    y = xf * lax.rsqrt(jnp.mean(xf * xf, axis=-1, keepdims=True) + RMS_EPS)
    return (y * g.astype(jnp.float32)).astype(x.dtype)


def rope(x, pos):
    half = x.shape[-1] // 2
    inv = ROPE_BASE ** (-jnp.arange(half, dtype=jnp.float32) / half)
    ang = pos.astype(jnp.float32)[:, None] * inv[None, :]
    cos, sin = jnp.cos(ang)[:, None, :], jnp.sin(ang)[:, None, :]
    xf = x.astype(jnp.float32)
    x1, x2 = xf[..., :half], xf[..., half:]
    return jnp.concatenate([x1 * cos - x2 * sin, x1 * sin + x2 * cos], axis=-1).astype(x.dtype)


def split_cols(z):
    out, off = [], 0
    for n in IN_SIZES:
        out.append(z[..., off:off + n])
        off += n
    return out


def ret_log_gamma():
    return jnp.log1p(-jnp.exp2(-5.0 - jnp.arange(RET_HEADS, dtype=jnp.float32)))


def retention_chunk(q, k, v, s):
    L = q.shape[2]
    lg = ret_log_gamma()
    i = jnp.arange(L, dtype=jnp.float32)
    diff = i[:, None] - i[None, :]
    decay = jnp.where(diff[None] >= 0, jnp.exp(jnp.maximum(diff, 0.0)[None] * lg[:, None, None]), 0.0)
    q_dec = jnp.exp((i[None, :] + 1.0) * lg[:, None])
    k_dec = jnp.exp((L - 1.0 - i[None, :]) * lg[:, None])
    inner = jnp.einsum('bhid,bhjd->bhij', q, k) * decay
    o = (jnp.einsum('bhij,bhje->bhie', inner, v)
         + jnp.einsum('bhid,bhde->bhie', q * q_dec[None, :, :, None], s))
    s_new = (s * jnp.exp(L * lg)[None, :, None, None]
             + jnp.einsum('bhjd,bhje->bhde', k * k_dec[None, :, :, None], v))
    return o, s_new


def retention_prompt(q, k, v):
    b, S = q.shape[:2]
    nc = S // RET_CHUNK

    def to_chunks(t):
        return t.reshape(b, nc, RET_CHUNK, RET_HEADS, t.shape[-1]).transpose(1, 0, 3, 2, 4)

    def step(s, xs):
        qc, kc, vc = xs
        o, s = retention_chunk(qc, kc, vc, s)
        return s, o

    s0 = jnp.zeros((b, RET_HEADS, RET_DK, RET_DV), jnp.float32)
    s_fin, o = lax.scan(step, s0, (to_chunks(q), to_chunks(k), to_chunks(v)))
    o = o.transpose(1, 0, 3, 2, 4).reshape(b, S, RET_HEADS, RET_DV)
    return o, s_fin


def retention_sample(q, k, v, s0):
    tr = lambda t: t.transpose(0, 2, 1, 3)
    o, s = retention_chunk(tr(q), tr(k), tr(v), s0)
    return tr(o), s


def mla_prompt_attend(q_lat, q_pe, ckv, kpe):
    b, S = q_lat.shape[:2]
    nb = S // MLA_Q_BLOCK
    scale = (MLA_D_NOPE + MLA_D_ROPE) ** -0.5
    kpos = jnp.arange(S)

    def blk(xs):
        ql, qp, start = xs
        s = jnp.einsum('bqhl,bkl->bhqk', ql, ckv) + jnp.einsum('bqhr,bkr->bhqk', qp, kpe)
        qpos = start + jnp.arange(MLA_Q_BLOCK)
        mask = kpos[None, :] <= qpos[:, None]
        s = jnp.where(mask, s.astype(jnp.float32) * scale, -jnp.inf)
        p = jax.nn.softmax(s, axis=-1).astype(ckv.dtype)
        return jnp.einsum('bhqk,bkl->bqhl', p, ckv)

    def to_blocks(t):
        return t.reshape(b, nb, MLA_Q_BLOCK, *t.shape[2:]).swapaxes(0, 1)

    o = lax.map(blk, (to_blocks(q_lat), to_blocks(q_pe), jnp.arange(nb) * MLA_Q_BLOCK))
    return o.swapaxes(0, 1).reshape(b, S, MLA_HEADS, MLA_KV_LORA)


def mla_sample_attend(q_lat, q_pe, ckv_new, kpe_new, ckv_past, kpe_past):
    T = q_lat.shape[1]
    P = ckv_past.shape[1]
    scale = (MLA_D_NOPE + MLA_D_ROPE) ** -0.5
    s_past = (jnp.einsum('bqhl,bkl->bhqk', q_lat, ckv_past)
              + jnp.einsum('bqhr,bkr->bhqk', q_pe, kpe_past)).astype(jnp.float32) * scale
    s_new = (jnp.einsum('bqhl,bkl->bhqk', q_lat, ckv_new)
             + jnp.einsum('bqhr,bkr->bhqk', q_pe, kpe_new)).astype(jnp.float32) * scale
    causal = jnp.arange(T)[None, :] <= jnp.arange(T)[:, None]
    s_new = jnp.where(causal, s_new, -jnp.inf)
    p = jax.nn.softmax(jnp.concatenate([s_past, s_new], axis=-1), axis=-1)
    p_past = p[..., :P].astype(ckv_past.dtype)
    p_new = p[..., P:].astype(ckv_new.dtype)
    return (jnp.einsum('bhqk,bkl->bqhl', p_past, ckv_past)
            + jnp.einsum('bhqk,bkl->bqhl', p_new, ckv_new))


def mem_kv(mem, p):
    b, m, _ = mem.shape
    mn = rms_norm(mem, p['norm_mem'])
    k = (mn @ p['w_mem_k']).reshape(b, m, X_HEADS, X_HD)
    v = (mn @ p['w_mem_v']).reshape(b, m, X_HEADS, X_HD)
    return k, v


def mem_attend(q, mk, mv):
    s = jnp.einsum('bshd,bmhd->bhsm', q, mk).astype(jnp.float32) * (X_HD ** -0.5)
    p = jax.nn.softmax(s, axis=-1).astype(mv.dtype)
    return jnp.einsum('bhsm,bmhd->bshd', p, mv)


def decoder_layer(x, pos, mem_k, mem_v, p, ret_fn, mla_fn):
    b, s, _ = x.shape
    u = rms_norm(x, p['norm_mix_pre'])
    rq, rk, rv, rg, cq, ckv, kpe, xq, gates = split_cols(u @ p['w_in'])

    rq = rope(rq.reshape(b, s, RET_HEADS, RET_DK), pos).astype(jnp.float32)
    rk = rope(rk.reshape(b, s, RET_HEADS, RET_DK), pos).astype(jnp.float32) * (RET_DK ** -0.5)
    rv = rv.reshape(b, s, RET_HEADS, RET_DV).astype(jnp.float32)
    o_ret, ret_state = ret_fn(rq, rk, rv)
    o_ret = o_ret * lax.rsqrt(jnp.mean(o_ret * o_ret, axis=-1, keepdims=True) + RMS_EPS)
    o_ret = (jax.nn.silu(rg.astype(jnp.float32)) * o_ret.reshape(b, s, RET_HEADS * RET_DV)).astype(x.dtype)
    a_ret = o_ret @ p['w_ret_o']

    cq = rms_norm(cq, p['norm_q_lat'])
    q = (cq @ p['w_uq']).reshape(b, s, MLA_HEADS, MLA_D_NOPE + MLA_D_ROPE)
    q_nope, q_pe = q[..., :MLA_D_NOPE], rope(q[..., MLA_D_NOPE:], pos)
    q_lat = jnp.einsum('bshd,hld->bshl', q_nope, p['w_uk'])
    ckv = rms_norm(ckv, p['norm_kv_lat'])
    kpe = rope(kpe[:, :, None, :], pos)[:, :, 0, :]
    o_lat = mla_fn(q_lat, q_pe, ckv, kpe)
    o_mla = jnp.einsum('bshl,hld->bshd', o_lat, p['w_uv']).reshape(b, s, MLA_HEADS * MLA_D_V)
    a_mla = o_mla @ p['w_mla_o']

    o_x = mem_attend(xq.reshape(b, s, X_HEADS, X_HD), mem_k, mem_v).reshape(b, s, X_HEADS * X_HD)
    a_x = o_x @ p['w_x_o']

    g = jax.nn.sigmoid(gates.astype(jnp.float32)).reshape(b, s, N_BRANCH, D_MODEL)
    mixed = (g[:, :, 0] * a_ret + g[:, :, 1] * a_mla + g[:, :, 2] * a_x).astype(x.dtype)
    h = x + rms_norm(mixed @ p['w_out'], p['norm_mix_post'])
    f = rms_norm(h, p['norm_ffn_pre'])
    f = (jax.nn.silu(f @ p['w_ffn_gate']) * (f @ p['w_ffn_up'])) @ p['w_ffn_down']
    y = h + rms_norm(f, p['norm_ffn_post'])
    return y, ret_state, ckv, kpe


def setup_inputs(seed: int = 0) -> dict:
    key = jax.random.key(seed)
    ks = jax.random.split(key, 32)
    n_pages = PAST_LEN // PAGE_SIZE
    n_used = DEC_BATCH * n_pages
    n_pool = n_used + max(1, n_used // 4)

    def nrm(i, shape, scale=1.0):
        return jax.random.normal(ks[i], shape, jnp.float32) * scale

    def gain(i, n):
        return 1.0 + nrm(i, (DEPTH, n), 0.05)

    page_table = jax.random.permutation(ks[5], n_pool)[:n_used].reshape(DEC_BATCH, n_pages).astype(jnp.int32)
    return {
        'x_prompt': nrm(0, (BATCH, SEQ, D_MODEL)),
        'x_sample': nrm(1, (DEC_BATCH, DEC_SEQ, D_MODEL)),
        'mem_prompt': nrm(2, (BATCH, N_MEM, D_MODEL)),
        'cache_ckv': nrm(3, (DEPTH, n_pool, PAGE_SIZE, MLA_KV_LORA)),
        'cache_kpe': nrm(4, (DEPTH, n_pool, PAGE_SIZE, MLA_D_ROPE)),
        'page_table': page_table,
        'state_ret': nrm(6, (DEPTH, DEC_BATCH, RET_HEADS, RET_DK, RET_DV), 0.5),
        'cache_mem_k': nrm(7, (DEPTH, DEC_BATCH, N_MEM, X_HEADS, X_HD)),
        'cache_mem_v': nrm(8, (DEPTH, DEC_BATCH, N_MEM, X_HEADS, X_HD)),
        'norm_mix_pre': gain(9, D_MODEL),
        'norm_mix_post': gain(10, D_MODEL),
        'norm_ffn_pre': gain(11, D_MODEL),
        'norm_ffn_post': gain(12, D_MODEL),
        'norm_mem': gain(13, D_MODEL),
        'norm_q_lat': gain(14, MLA_Q_LORA),
        'norm_kv_lat': gain(15, MLA_KV_LORA),
        'w_in': nrm(16, (DEPTH, D_MODEL, D_IN), D_MODEL ** -0.5),
        'w_uq': nrm(17, (DEPTH, MLA_Q_LORA, MLA_HEADS * (MLA_D_NOPE + MLA_D_ROPE)), MLA_Q_LORA ** -0.5),
        'w_uk': nrm(18, (DEPTH, MLA_HEADS, MLA_KV_LORA, MLA_D_NOPE), MLA_KV_LORA ** -0.5),
        'w_uv': nrm(19, (DEPTH, MLA_HEADS, MLA_KV_LORA, MLA_D_V), MLA_KV_LORA ** -0.5),
        'w_mem_k': nrm(20, (DEPTH, D_MODEL, X_HEADS * X_HD), D_MODEL ** -0.5),
        'w_mem_v': nrm(21, (DEPTH, D_MODEL, X_HEADS * X_HD), D_MODEL ** -0.5),
        'w_ret_o': nrm(22, (DEPTH, RET_HEADS * RET_DV, D_MODEL), (RET_HEADS * RET_DV) ** -0.5),
        'w_mla_o': nrm(23, (DEPTH, MLA_HEADS * MLA_D_V, D_MODEL), (MLA_HEADS * MLA_D_V) ** -0.5),
        'w_x_o': nrm(24, (DEPTH, X_HEADS * X_HD, D_MODEL), (X_HEADS * X_HD) ** -0.5),
        'w_out': nrm(25, (DEPTH, D_MODEL, D_MODEL), D_MODEL ** -0.5),
        'w_ffn_gate': nrm(26, (DEPTH, D_MODEL, D_FF), D_MODEL ** -0.5),
        'w_ffn_up': nrm(27, (DEPTH, D_MODEL, D_FF), D_MODEL ** -0.5),
        'w_ffn_down': nrm(28, (DEPTH, D_FF, D_MODEL), D_FF ** -0.5),
    }


def reference(x_prompt, x_sample, mem_prompt, cache_ckv, cache_kpe, page_table, state_ret,
              cache_mem_k, cache_mem_v, norm_mix_pre, norm_mix_post, norm_ffn_pre, norm_ffn_post,
              norm_mem, norm_q_lat, norm_kv_lat, w_in, w_uq, w_uk, w_uv, w_mem_k, w_mem_v,
              w_ret_o, w_mla_o, w_x_o, w_out, w_ffn_gate, w_ffn_up, w_ffn_down):
    db = x_sample.shape[0]
    past_len = page_table.shape[1] * cache_ckv.shape[2]
    pos_p = jnp.arange(x_prompt.shape[1])
    pos_s = past_len + jnp.arange(x_sample.shape[1])

    y_prompt, y_sample = x_prompt, x_sample
    ckv_p_l, kpe_p_l, ckv_s_l, kpe_s_l = [], [], [], []
    ret_p_l, ret_s_l, mk_p_l, mv_p_l = [], [], [], []
    for l in range(DEPTH):
        p = dict(norm_mix_pre=norm_mix_pre[l], norm_mix_post=norm_mix_post[l],
                 norm_ffn_pre=norm_ffn_pre[l], norm_ffn_post=norm_ffn_post[l],
                 norm_mem=norm_mem[l], norm_q_lat=norm_q_lat[l], norm_kv_lat=norm_kv_lat[l],
                 w_in=w_in[l], w_uq=w_uq[l], w_uk=w_uk[l], w_uv=w_uv[l],
                 w_mem_k=w_mem_k[l], w_mem_v=w_mem_v[l], w_ret_o=w_ret_o[l],
                 w_mla_o=w_mla_o[l], w_x_o=w_x_o[l], w_out=w_out[l],
                 w_ffn_gate=w_ffn_gate[l], w_ffn_up=w_ffn_up[l], w_ffn_down=w_ffn_down[l])

        mk_p, mv_p = mem_kv(mem_prompt, p)
        y_prompt, ret_p, ckv_p, kpe_p = decoder_layer(
            y_prompt, pos_p, mk_p, mv_p, p, retention_prompt, mla_prompt_attend)

        ckv_past = cache_ckv[l][page_table].reshape(db, past_len, MLA_KV_LORA)
        kpe_past = cache_kpe[l][page_table].reshape(db, past_len, MLA_D_ROPE)
        ret_fn = functools.partial(retention_sample, s0=state_ret[l].astype(jnp.float32))
        mla_fn = functools.partial(mla_sample_attend, ckv_past=ckv_past, kpe_past=kpe_past)
        y_sample, ret_s, ckv_s, kpe_s = decoder_layer(
            y_sample, pos_s, cache_mem_k[l], cache_mem_v[l], p, ret_fn, mla_fn)

        ckv_p_l.append(ckv_p)
        kpe_p_l.append(kpe_p)
        ckv_s_l.append(ckv_s)
        kpe_s_l.append(kpe_s)
        ret_p_l.append(ret_p.astype(x_prompt.dtype))
        ret_s_l.append(ret_s.astype(state_ret.dtype))
        mk_p_l.append(mk_p)
        mv_p_l.append(mv_p)

    new_ckv_prompt = jnp.stack(ckv_p_l)
    new_kpe_prompt = jnp.stack(kpe_p_l)
    new_ckv_sample = jnp.stack(ckv_s_l)
    new_kpe_sample = jnp.stack(kpe_s_l)
    new_ret_prompt = jnp.stack(ret_p_l)
    new_ret_sample = jnp.stack(ret_s_l)
    new_mem_k_prompt = jnp.stack(mk_p_l)
    new_mem_v_prompt = jnp.stack(mv_p_l)
    return (y_prompt, y_sample, new_ckv_prompt, new_kpe_prompt, new_ckv_sample, new_kpe_sample,
            new_ret_prompt, new_ret_sample, new_mem_k_prompt, new_mem_v_prompt)
```

```cpp
#include <hip/hip_runtime.h>
#include <cstdio>
#include <cstdint>

#ifndef MK_ONE_LAUNCH
#define MK_ONE_LAUNCH 1
#endif

#define LAS __attribute__((address_space(3)))
#define GAS __attribute__((address_space(1)))
#define DI __device__ __forceinline__
typedef float f32x4 __attribute__((ext_vector_type(4)));

namespace {
constexpr int DM = 1024, NB = 8, SEQ = 2048, NP = NB * SEQ, DB = 128, DS = 4, NS = DB * DS, NT = NP + NS;
constexpr int PAST = 8192, PAGE = 128, NPAGES = PAST / PAGE;
constexpr int RH = 4, RDK = 128, RDV = 256;
constexpr int MH = 8, QL = 384, KVL = 256, DNOPE = 128, DROPE = 64, DVH = 128, DQH = DNOPE + DROPE;
constexpr int NMEM = 256, XH = 4, XHD = 64;
constexpr int DFF = 2816, DIN = 7104;
constexpr int C_RQ = 0, C_RK = 512, C_RV = 1024, C_RG = 2048, C_CQ = 3072, C_CKV = 3456, C_KPE = 3712, C_XQ = 3776, C_G = 4032;
constexpr float EPS = 1e-6f;
constexpr int NPOS = SEQ + DS;
constexpr int NTHREADS = 512, NWAVES = 8;
constexpr int LDS_BYTES = 147456;
constexpr int MISC_OFF = 147456 - 256;

constexpr size_t O_YP = 0, O_YS = O_YP + (size_t)NP * DM, O_CKVP = O_YS + (size_t)NS * DM, O_KPEP = O_CKVP + (size_t)NP * KVL,
                 O_CKVS = O_KPEP + (size_t)NP * DROPE, O_KPES = O_CKVS + (size_t)NS * KVL, O_RETP = O_KPES + (size_t)NS * DROPE,
                 O_RETS = O_RETP + (size_t)NB * RH * RDK * RDV, O_MKP = O_RETS + (size_t)DB * RH * RDK * RDV, O_MVP = O_MKP + (size_t)NB * NMEM * 256,
                 O_END = O_MVP + (size_t)NB * NMEM * 256;

constexpr size_t al256(size_t x) { return (x + 255) & ~(size_t)255; }
constexpr size_t WS_CTL = 0, CTL_BYTES = 1u << 20;
constexpr size_t WS_COSA = WS_CTL + CTL_BYTES;
constexpr size_t WS_SINA = WS_COSA + al256((size_t)NPOS * 64 * 4);
constexpr size_t WS_COSB = WS_SINA + al256((size_t)NPOS * 64 * 4);
constexpr size_t WS_SINB = WS_COSB + al256((size_t)NPOS * 32 * 4);
constexpr size_t WS_U = WS_SINB + al256((size_t)NPOS * 32 * 4);
constexpr size_t WS_MN = WS_U + (size_t)NT * DM * 4;
constexpr size_t WS_Z = WS_MN + (size_t)NB * NMEM * DM * 4;
constexpr size_t WS_RQ = WS_Z + (size_t)NT * DIN * 4;
constexpr size_t WS_RK = WS_RQ + (size_t)NT * 512 * 4;
constexpr size_t WS_CQN = WS_RK + (size_t)NT * 512 * 4;
constexpr size_t WS_CKVN = WS_CQN + (size_t)NT * QL * 4;
constexpr size_t WS_KPER = WS_CKVN + (size_t)NT * KVL * 4;
constexpr size_t WS_Q = WS_KPER + (size_t)NT * DROPE * 4;
constexpr size_t WS_QLAT = WS_Q + (size_t)NT * 1536 * 4;
constexpr size_t WS_QPE = WS_QLAT + (size_t)NT * 2048 * 4;
constexpr size_t WS_ORET = WS_QPE + (size_t)NT * 512 * 4;
constexpr size_t WS_OLAT = WS_ORET + (size_t)NT * 1024 * 4;
constexpr size_t WS_OX = WS_OLAT + (size_t)NT * 2048 * 4;
constexpr size_t WS_OMLA = WS_OX + (size_t)NT * 256 * 4;
constexpr size_t WS_ORETN = WS_OMLA + (size_t)NT * 1024 * 4;
constexpr size_t WS_ARET = WS_ORETN + (size_t)NT * 1024 * 4;
constexpr size_t WS_AMLA = WS_ARET + (size_t)NT * 1024 * 4;
constexpr size_t WS_AX = WS_AMLA + (size_t)NT * 1024 * 4;
constexpr size_t WS_MIX = WS_AX + (size_t)NT * 1024 * 4;
constexpr size_t WS_HP = WS_MIX + (size_t)NT * 1024 * 4;
constexpr size_t WS_H = WS_HP + (size_t)NT * 1024 * 4;
constexpr size_t WS_F = WS_H + (size_t)NT * 1024 * 4;
constexpr size_t WS_GG = WS_F + (size_t)NT * 1024 * 4;
constexpr size_t WS_UP = WS_GG + (size_t)NT * DFF * 4;
constexpr size_t WS_ACT = WS_UP + (size_t)NT * DFF * 4;
constexpr size_t WS_FO = WS_ACT + (size_t)NT * DFF * 4;
constexpr size_t WS_END = WS_FO + (size_t)NT * 1024 * 4;

constexpr int CW_BAR = 4096;

#define XB_TMO      128
#define XB_XCNT(j)  (256  + 64 * (j))
#define XB_XSUB(j)  (1280 + 64 * (j))
#define XB_XGEN(j)  (2304 + 64 * (j))
#define XB_TOP      3328
#define XB_TOPGEN   3392
#define XCD_BAR_WORDS 3456
#define XB_SPIN_CAP (1u << 25)

DI unsigned xb_ld(unsigned* p)              { return __hip_atomic_load(p, __ATOMIC_RELAXED, __HIP_MEMORY_SCOPE_AGENT); }
DI unsigned xb_add(unsigned* p, unsigned v) { return __hip_atomic_fetch_add(p, v, __ATOMIC_RELAXED, __HIP_MEMORY_SCOPE_AGENT); }
DI unsigned xb_xcc_id() { return (unsigned)__builtin_amdgcn_s_getreg((3 << 11) | 20) & 0xFu; }
#define XB_SPIN(cond, bar) do { unsigned _sp = 0; while (cond) { __builtin_amdgcn_s_sleep(1); \
    if ((++_sp & 255u) == 0u) { if (xb_ld(&(bar)[XB_TMO])) break; if (_sp > XB_SPIN_CAP) { atomicAdd(&(bar)[XB_TMO], 1u); break; } } } } while (0)

struct XcdBarrier { unsigned* bar; unsigned x; volatile LAS unsigned* st; };

DI XcdBarrier xcd_barrier_post(unsigned* bar, volatile LAS unsigned* st) {
    XcdBarrier b; b.bar = bar; b.x = xb_xcc_id(); b.st = st;
    if (threadIdx.x == 0) (void)xb_add(&bar[XB_XCNT(b.x)], 1u);
    return b;
}
DI void xcd_barrier_complete(unsigned* bar, unsigned x, unsigned& nloc, unsigned& nx) {
    const unsigned G = gridDim.x * gridDim.y * gridDim.z;
    unsigned sum, cnt, mine, sp = 0u;
    for (;;) {
        sum = 0u; cnt = 0u; mine = 0u;
#pragma unroll
        for (unsigned j = 0; j < 16; ++j) { const unsigned c = xb_ld(&bar[XB_XCNT(j)]); sum += c; cnt += (c > 0u) ? 1u : 0u; mine = (j == x) ? c : mine; }
        if (sum == G) break;
        __builtin_amdgcn_s_sleep(1);
        if ((++sp & 255u) == 0u) { if (xb_ld(&bar[XB_TMO])) break; if (sp > XB_SPIN_CAP) { atomicAdd(&bar[XB_TMO], 1u); break; } }
    }
    nloc = mine > 0u ? mine : 1u; nx = cnt > 0u ? cnt : 1u;
}
DI void xcd_barrier(const XcdBarrier& b) {
    asm volatile("s_waitcnt vmcnt(0)" ::: "memory");
    __syncthreads();
    if (threadIdx.x == 0) {
        unsigned* bar = b.bar;
        __builtin_amdgcn_s_waitcnt(0);
        unsigned nloc = b.st[0], nx = b.st[1];
        if (nloc == 0u) { xcd_barrier_complete(bar, b.x, nloc, nx); b.st[0] = nloc; b.st[1] = nx; }
        const unsigned old = xb_add(&bar[XB_XSUB(b.x)], 1u);
        const unsigned gen = old / nloc;
        if (old + 1u == (gen + 1u) * nloc) {
            __builtin_amdgcn_fence(__ATOMIC_RELEASE, "agent");
            asm volatile("s_waitcnt vmcnt(0)" ::: "memory");
            const unsigned og = xb_add(&bar[XB_TOP], 1u);
            const unsigned tg = og / nx;
            if (og + 1u == (tg + 1u) * nx) xb_add(&bar[XB_TOPGEN], 1u);
            else XB_SPIN(xb_ld(&bar[XB_TOPGEN]) == tg, bar);
            __builtin_amdgcn_fence(__ATOMIC_ACQUIRE, "agent");
            xb_add(&bar[XB_XGEN(b.x)], 1u);
            asm volatile("s_waitcnt vmcnt(0)" ::: "memory");
        } else {
            XB_SPIN(xb_ld(&bar[XB_XGEN(b.x)]) == gen, bar);
            __builtin_amdgcn_fence(__ATOMIC_ACQUIRE, "agent");
            asm volatile("s_waitcnt vmcnt(0)" ::: "memory");
        }
    }
    __syncthreads();
}

DI float wave_sum(float v) {
#pragma unroll
    for (int o = 1; o < 64; o <<= 1) v += __shfl_xor(v, o);
    return v;
}
DI float wave_max(float v) {
#pragma unroll
    for (int o = 1; o < 64; o <<= 1) v = fmaxf(v, __shfl_xor(v, o));
    return v;
}
DI float sigmoidf_(float x) { return 1.f / (1.f + expf(-x)); }
DI float siluf_(float x) { return x / (1.f + expf(-x)); }
DI int pos_index(int row) { return row < NP ? (row & (SEQ - 1)) : SEQ + ((row - NP) & (DS - 1)); }
DI float lg_gamma(int h) { return log1pf(-exp2f(-5.0f - (float)h)); }

struct Args {
    const float* in[29]; float* out; unsigned char* ws; int ph_lo, ph_hi;
};

DI void sgemm_naive(LAS float* lds, const float* __restrict__ A, int lda, const float* __restrict__ B, long sbk, long sbn,
                    float* __restrict__ C, int ldc, int M, int N, int K, int bid, int G) {
    LAS float* As = lds;
    LAS float* Bs = lds + 16 * 132;
    const int tid = threadIdx.x, tx = tid & 15, ty = tid >> 4;
    const int ntn = N / 64, ntiles = (M / 128) * ntn;
    for (int t = bid; t < ntiles; t += G) {
        const int m0 = (t / ntn) * 128, n0 = (t % ntn) * 64;
        float acc[4][4];
#pragma unroll
        for (int i = 0; i < 4; ++i)
#pragma unroll
            for (int j = 0; j < 4; ++j) acc[i][j] = 0.f;
        for (int k0 = 0; k0 < K; k0 += 16) {
            {
                const int r = tid >> 2, kq = (tid & 3) * 4;
                const float4 v = *(const float4*)(A + (size_t)(m0 + r) * lda + k0 + kq);
                As[(kq + 0) * 132 + r] = v.x; As[(kq + 1) * 132 + r] = v.y; As[(kq + 2) * 132 + r] = v.z; As[(kq + 3) * 132 + r] = v.w;
            }
#pragma unroll
            for (int i = 0; i < 2; ++i) {
                const int idx = tid + i * 512, kk = idx >> 6, nn = idx & 63;
                Bs[kk * 64 + nn] = B[(size_t)(k0 + kk) * sbk + (size_t)(n0 + nn) * sbn];
            }
            __syncthreads();
#pragma unroll
            for (int kk = 0; kk < 16; ++kk) {
                const f32x4 a = *(const LAS f32x4*)(As + kk * 132 + ty * 4);
                const f32x4 b = *(const LAS f32x4*)(Bs + kk * 64 + tx * 4);
                const float av[4] = {a.x, a.y, a.z, a.w}, bv[4] = {b.x, b.y, b.z, b.w};
#pragma unroll
                for (int i = 0; i < 4; ++i)
#pragma unroll
                    for (int j = 0; j < 4; ++j) acc[i][j] += av[i] * bv[j];
            }
            __syncthreads();
        }
#pragma unroll
        for (int i = 0; i < 4; ++i) {
            float4 o; o.x = acc[i][0]; o.y = acc[i][1]; o.z = acc[i][2]; o.w = acc[i][3];
            *(float4*)(C + (size_t)(m0 + ty * 4 + i) * ldc + n0 + tx * 4) = o;
        }
    }
}

template <int DQK, int DV, bool V_IN_K, int MODE, class KV, class QF>
DI void attn_naive(LAS float* lds, const KV& kv, int nk_loop, const QF& qf, bool active, int limit, float scale, float lg, int tq, float* optr) {
    constexpr int KS = DQK + 1;
    constexpr int VS = V_IN_K ? KS : DV;
    LAS float* Ks = lds;
    LAS float* Vs = V_IN_K ? Ks : (lds + 64 * KS);
    LAS float* qs = lds + 64 * KS + (V_IN_K ? 0 : 64 * DV);
    LAS float* ps = qs + 8 * DQK;
    static_assert((64 * KS + (V_IN_K ? 0 : 64 * DV) + 8 * DQK + 8 * 64) * 4 <= MISC_OFF, "attn_naive LDS");
    const int tid = threadIdx.x, lane = tid & 63, w = tid >> 6;
    __syncthreads();
    for (int d = lane; d < DQK; d += 64) qs[w * DQK + d] = active ? qf(d) : 0.f;
    float m = -INFINITY, l = 0.f;
    float acc[DV / 64];
#pragma unroll
    for (int c = 0; c < DV / 64; ++c) acc[c] = 0.f;
    for (int base = 0; base < nk_loop; base += 64) {
        __syncthreads();
        for (int idx = tid; idx < 64 * DQK; idx += NTHREADS) { const int j = idx / DQK, d = idx - j * DQK, key = base + j; Ks[j * KS + d] = key < nk_loop ? kv.k(key, d) : 0.f; }
        if (!V_IN_K) for (int idx = tid; idx < 64 * DV; idx += NTHREADS) { const int j = idx / DV, e = idx - j * DV, key = base + j; Vs[j * DV + e] = key < nk_loop ? kv.v(key, e) : 0.f; }
        __syncthreads();
        const int key = base + lane; const bool valid = active && key <= limit && key < nk_loop;
        float s = 0.f;
        for (int d = 0; d < DQK; ++d) s += qs[w * DQK + d] * Ks[lane * KS + d];
        float p;
        if (MODE == 0) {
            s *= scale;
            const float cm = wave_max(valid ? s : -INFINITY);
            const float mn = fmaxf(m, cm);
            const float alpha = (mn == -INFINITY) ? 1.f : expf(m - mn);
            p = valid ? expf(s - mn) : 0.f;
            l = l * alpha + wave_sum(p);
#pragma unroll
            for (int c = 0; c < DV / 64; ++c) acc[c] *= alpha;
            m = mn;
        } else {
            p = valid ? s * expf((float)(tq - key) * lg) : 0.f;
        }
        ps[w * 64 + lane] = p;
        __syncthreads();
        for (int j = 0; j < 64; ++j) { const float pj = ps[w * 64 + j];
#pragma unroll
            for (int c = 0; c < DV / 64; ++c) acc[c] += pj * Vs[j * VS + lane + 64 * c]; }
    }
    if (active) {
#pragma unroll
        for (int c = 0; c < DV / 64; ++c) optr[lane + 64 * c] = (MODE == 0) ? acc[c] / l : acc[c];
    }
}

struct KvMlaPrompt { const float* ckvn; const float* kper; int b;
    DI float k(int key, int d) const { const size_t row = (size_t)b * SEQ + key; return d < KVL ? ckvn[row * KVL + d] : kper[row * DROPE + (d - KVL)]; }
    DI float v(int, int) const { return 0.f; } };
struct KvMlaSample { const float* ckvn; const float* kper; const float* cckv; const float* ckpe; const int* pt; int b;
    DI float k(int key, int d) const {
        if (key < PAST) { const size_t r = (size_t)pt[b * NPAGES + (key >> 7)] * PAGE + (key & (PAGE - 1)); return d < KVL ? cckv[r * KVL + d] : ckpe[r * DROPE + (d - KVL)]; }
        const size_t row = (size_t)NP + b * DS + (key - PAST); return d < KVL ? ckvn[row * KVL + d] : kper[row * DROPE + (d - KVL)]; }
    DI float v(int, int) const { return 0.f; } };
struct KvRet { const float* rk; const float* z; int b, h;
    DI float k(int key, int d) const { return rk[((size_t)b * SEQ + key) * 512 + h * RDK + d]; }
    DI float v(int key, int e) const { return z[((size_t)b * SEQ + key) * DIN + C_RV + h * RDV + e]; } };
struct KvMem { const float* mk; const float* mv; int b, h;
    DI float k(int key, int d) const { return mk[(((size_t)b * NMEM + key) * XH + h) * XHD + d]; }
    DI float v(int key, int e) const { return mv[(((size_t)b * NMEM + key) * XH + h) * XHD + e]; } };

struct QPtr { const float* p; DI float operator()(int d) const { return p[d]; } };
struct QMla { const float* ql; const float* qp; DI float operator()(int d) const { return d < KVL ? ql[d] : qp[d - KVL]; } };
DI void rms_row(const float* x, const float* g, float* o, int n, int lane) {
    float s = 0.f;
    for (int i = lane; i < n; i += 64) { const float v = x[i]; s += v * v; }
    const float r = rsqrtf(wave_sum(s) / (float)n + EPS);
    for (int i = lane; i < n; i += 64) o[i] = x[i] * r * g[i];
}

__global__ void __launch_bounds__(NTHREADS, 2) fwd_kernel(Args args) {
    extern __shared__ __attribute__((aligned(16))) unsigned char lds_raw[];
    LAS unsigned char* ldsb = (LAS unsigned char*)lds_raw;
    LAS float* lds = (LAS float*)ldsb;
    volatile LAS unsigned* MISC = (volatile LAS unsigned*)(ldsb + MISC_OFF);
    const int tid = threadIdx.x, lane = tid & 63, wave = tid >> 6;
    const int G = gridDim.x, bid = blockIdx.x;
    const int gw = bid * NWAVES + wave, NGW = G * NWAVES;
    unsigned char* ws = args.ws;
    float* out = args.out;
    const int lo = args.ph_lo, hi = args.ph_hi;

    if (tid < 64) MISC[tid] = 0u;
    __syncthreads();
    XcdBarrier bar; bar.bar = (unsigned*)(ws + WS_CTL) + CW_BAR; bar.x = 0; bar.st = MISC;
    if (hi - lo > 1) bar = xcd_barrier_post((unsigned*)(ws + WS_CTL) + CW_BAR, MISC);
#define IN(k) (lo <= (k) && (k) < hi)
#define SEAM(k) do { if (IN(k) && IN((k) + 1)) xcd_barrier(bar); } while (0)

    const float* x_prompt = args.in[0]; const float* x_sample = args.in[1]; const float* mem_prompt = args.in[2];
    const float* cache_ckv = args.in[3]; const float* cache_kpe = args.in[4]; const int* page_table = (const int*)args.in[5];
    const float* state_ret = args.in[6]; const float* cache_mem_k = args.in[7]; const float* cache_mem_v = args.in[8];
    const float* g_mix_pre = args.in[9]; const float* g_mix_post = args.in[10]; const float* g_ffn_pre = args.in[11]; const float* g_ffn_post = args.in[12];
    const float* g_mem = args.in[13]; const float* g_qlat = args.in[14]; const float* g_kvlat = args.in[15];
    const float* w_in = args.in[16]; const float* w_uq = args.in[17]; const float* w_uk = args.in[18]; const float* w_uv = args.in[19];
    const float* w_mem_k = args.in[20]; const float* w_mem_v = args.in[21]; const float* w_ret_o = args.in[22]; const float* w_mla_o = args.in[23];
    const float* w_x_o = args.in[24]; const float* w_out = args.in[25]; const float* w_gate = args.in[26]; const float* w_up = args.in[27]; const float* w_down = args.in[28];
    float* COSA = (float*)(ws + WS_COSA); float* SINA = (float*)(ws + WS_SINA); float* COSB = (float*)(ws + WS_COSB); float* SINB = (float*)(ws + WS_SINB);
    float* U = (float*)(ws + WS_U); float* MN = (float*)(ws + WS_MN); float* Z = (float*)(ws + WS_Z);
    float* RQ = (float*)(ws + WS_RQ); float* RK = (float*)(ws + WS_RK); float* CQN = (float*)(ws + WS_CQN); float* CKVN = (float*)(ws + WS_CKVN); float* KPER = (float*)(ws + WS_KPER);
    float* Q = (float*)(ws + WS_Q); float* QLAT = (float*)(ws + WS_QLAT); float* QPE = (float*)(ws + WS_QPE);
    float* ORET = (float*)(ws + WS_ORET); float* OLAT = (float*)(ws + WS_OLAT); float* OX = (float*)(ws + WS_OX); float* OMLA = (float*)(ws + WS_OMLA); float* ORETN = (float*)(ws + WS_ORETN);
    float* ARET = (float*)(ws + WS_ARET); float* AMLA = (float*)(ws + WS_AMLA); float* AX = (float*)(ws + WS_AX); float* MIX = (float*)(ws + WS_MIX);
    float* HP = (float*)(ws + WS_HP); float* H = (float*)(ws + WS_H); float* F = (float*)(ws + WS_F);
    float* GG = (float*)(ws + WS_GG); float* UP = (float*)(ws + WS_UP); float* ACT = (float*)(ws + WS_ACT); float* FO = (float*)(ws + WS_FO);

    if (IN(0)) {
        for (int i = bid * NTHREADS + tid; i < NPOS * 64 + NPOS * 32; i += G * NTHREADS) {
            const bool a = i < NPOS * 64; const int j = a ? i : i - NPOS * 64; const int half = a ? 64 : 32;
            const int p = j / half, f = j % half; const int pos = p < SEQ ? p : PAST + (p - SEQ);
            const float inv = powf(10000.0f, -(float)f / (float)half);
            const float ang = (float)pos * inv;
            double rev = (double)ang * 0.15915494309189535; rev -= floor(rev);
            const float r = (float)rev;
            const float sn = __builtin_amdgcn_sinf(r), cs = __builtin_amdgcn_cosf(r);
            if (a) { COSA[j] = cs; SINA[j] = sn; } else { COSB[j] = cs; SINB[j] = sn; }
        }
        for (int row = gw; row < NT; row += NGW) {
            const float* xr = row < NP ? x_prompt + (size_t)row * DM : x_sample + (size_t)(row - NP) * DM;
            rms_row(xr, g_mix_pre, U + (size_t)row * DM, DM, lane);
        }
        for (int row = gw; row < NB * NMEM; row += NGW) rms_row(mem_prompt + (size_t)row * DM, g_mem, MN + (size_t)row * DM, DM, lane);
    }
    SEAM(0);
    if (IN(1)) {
        sgemm_naive(lds, U, DM, w_in, DIN, 1, Z, DIN, NT, DIN, DM, bid, G);
        sgemm_naive(lds, MN, DM, w_mem_k, 256, 1, out + O_MKP, 256, NB * NMEM, 256, DM, bid, G);
        sgemm_naive(lds, MN, DM, w_mem_v, 256, 1, out + O_MVP, 256, NB * NMEM, 256, DM, bid, G);
    }
    SEAM(1);
    if (IN(2)) {
        for (int row = gw; row < NT; row += NGW) {
            const float* z = Z + (size_t)row * DIN; const int p = pos_index(row);
            const float ca = COSA[p * 64 + lane], sa = SINA[p * 64 + lane];
#pragma unroll
            for (int h = 0; h < RH; ++h) {
                float x1 = z[C_RQ + h * RDK + lane], x2 = z[C_RQ + h * RDK + 64 + lane];
                RQ[(size_t)row * 512 + h * RDK + lane] = x1 * ca - x2 * sa; RQ[(size_t)row * 512 + h * RDK + 64 + lane] = x1 * sa + x2 * ca;
                x1 = z[C_RK + h * RDK + lane]; x2 = z[C_RK + h * RDK + 64 + lane];
                const float sc = 0.08838834764831845f;
                RK[(size_t)row * 512 + h * RDK + lane] = (x1 * ca - x2 * sa) * sc; RK[(size_t)row * 512 + h * RDK + 64 + lane] = (x1 * sa + x2 * ca) * sc;
            }
            rms_row(z + C_CQ, g_qlat, CQN + (size_t)row * QL, QL, lane);
            rms_row(z + C_CKV, g_kvlat, CKVN + (size_t)row * KVL, KVL, lane);
            float* ockv = row < NP ? out + O_CKVP + (size_t)row * KVL : out + O_CKVS + (size_t)(row - NP) * KVL;
            for (int i = lane; i < KVL; i += 64) ockv[i] = CKVN[(size_t)row * KVL + i];
            if (lane < 32) {
                const float cb = COSB[p * 32 + lane], sb = SINB[p * 32 + lane];
                const float x1 = z[C_KPE + lane], x2 = z[C_KPE + 32 + lane];
                const float o1 = x1 * cb - x2 * sb, o2 = x1 * sb + x2 * cb;
                KPER[(size_t)row * DROPE + lane] = o1; KPER[(size_t)row * DROPE + 32 + lane] = o2;
                float* okpe = row < NP ? out + O_KPEP + (size_t)row * DROPE : out + O_KPES + (size_t)(row - NP) * DROPE;
                okpe[lane] = o1; okpe[32 + lane] = o2;
            }
        }
    }
    SEAM(2);
    if (IN(3)) sgemm_naive(lds, CQN, QL, w_uq, 1536, 1, Q, 1536, NT, 1536, QL, bid, G);
    SEAM(3);
    if (IN(4)) {
        for (int h = 0; h < MH; ++h)
            sgemm_naive(lds, Q + h * DQH, 1536, w_uk + (size_t)h * KVL * DNOPE, 1, DNOPE, QLAT + h * KVL, MH * KVL, NT, KVL, DNOPE, bid, G);
        for (int row = gw; row < NT; row += NGW) {
            const int p = pos_index(row);
#pragma unroll
            for (int c = 0; c < 4; ++c) { const int idx = lane + 64 * c, h = idx >> 5, f = idx & 31;
                const float cb = COSB[p * 32 + f], sb = SINB[p * 32 + f];
                const float x1 = Q[(size_t)row * 1536 + h * DQH + DNOPE + f], x2 = Q[(size_t)row * 1536 + h * DQH + DNOPE + 32 + f];
                QPE[(size_t)row * 512 + h * 64 + f] = x1 * cb - x2 * sb; QPE[(size_t)row * 512 + h * 64 + 32 + f] = x1 * sb + x2 * cb; }
        }
    }
    SEAM(4);
    if (IN(5)) {
        for (int it = bid; it < NS; it += G) {
            const int b = it >> 2, t = it & 3; const size_t row = (size_t)NP + it;
            KvMlaSample kv{CKVN, KPER, cache_ckv, cache_kpe, page_table, b};
            QMla qf{QLAT + row * 2048 + wave * KVL, QPE + row * 512 + wave * 64};
            attn_naive<320, 256, true, 0>(lds, kv, PAST + t + 1, qf, true, PAST + t, 0.07216878364870322f, 0.f, 0, OLAT + row * 2048 + wave * KVL);
        }
        for (int it = bid; it < NP; it += G) {
            const int b = it >> 11, t = it & (SEQ - 1); const size_t row = (size_t)it;
            KvMlaPrompt kv{CKVN, KPER, b};
            QMla qf{QLAT + row * 2048 + wave * KVL, QPE + row * 512 + wave * 64};
            attn_naive<320, 256, true, 0>(lds, kv, t + 1, qf, true, t, 0.07216878364870322f, 0.f, 0, OLAT + row * 2048 + wave * KVL);
        }
        for (int it = bid; it < NB * RH * (SEQ / 8); it += G) {
            const int t8 = it % (SEQ / 8), bh = it / (SEQ / 8), h = bh & 3, b = bh >> 2; const int t = t8 * 8 + wave; const size_t row = (size_t)b * SEQ + t;
            KvRet kv{RK, Z, b, h};
            attn_naive<128, 256, false, 1>(lds, kv, t8 * 8 + 8, QPtr{RQ + row * 512 + h * RDK}, true, t, 1.f, lg_gamma(h), t, ORET + row * 1024 + h * RDV);
        }
        for (int it = bid; it < NB * RH * 16; it += G) {
            const int d8 = it & 15, bh = it >> 4, h = bh & 3, b = bh >> 2; const float lg = lg_gamma(h);
            const int e = tid & 255, dd = d8 * 8 + (tid >> 8) * 4;
            float a0 = 0.f, a1 = 0.f, a2 = 0.f, a3 = 0.f;
            for (int j = 0; j < SEQ; ++j) { const size_t row = (size_t)b * SEQ + j;
                const float v = Z[row * DIN + C_RV + h * RDV + e] * expf((float)(SEQ - 1 - j) * lg);
                const float* kr = RK + row * 512 + h * RDK + dd;
                a0 += kr[0] * v; a1 += kr[1] * v; a2 += kr[2] * v; a3 += kr[3] * v; }
            float* o = out + O_RETP + ((size_t)bh * RDK + dd) * RDV + e;
            o[0] = a0; o[RDV] = a1; o[2 * RDV] = a2; o[3 * RDV] = a3;
        }
        for (int it = bid; it < DB * RH; it += G) {
            const int h = it & 3, b = it >> 2; const float lg = lg_gamma(h);
            const float* s0 = state_ret + (size_t)it * RDK * RDV;
            LAS float* inner = lds;
            LAS float* qk = lds + 16;
            __syncthreads();
            for (int i = tid; i < 1024; i += NTHREADS) { const int which = i >> 9, ti = (i >> 7) & 3, d = i & 127; const size_t row = (size_t)NP + b * DS + ti;
                qk[i] = which ? RK[row * 512 + h * RDK + d] : RQ[row * 512 + h * RDK + d]; }
            __syncthreads();
            for (int pr = wave; pr < 16; pr += NWAVES) { const int i = pr >> 2, j = pr & 3;
                float s = qk[i * 128 + lane] * qk[512 + j * 128 + lane] + qk[i * 128 + 64 + lane] * qk[512 + j * 128 + 64 + lane];
                s = wave_sum(s);
                if (lane == 0) inner[pr] = (j <= i) ? s * expf((float)(i - j) * lg) : 0.f; }
            __syncthreads();
            {
                const int e = tid & 255, i0 = (tid >> 8) * 2;
                float o0 = 0.f, o1 = 0.f;
                for (int d = 0; d < RDK; ++d) { const float sv = s0[(size_t)d * RDV + e]; o0 += qk[i0 * 128 + d] * sv; o1 += qk[(i0 + 1) * 128 + d] * sv; }
                o0 *= expf((float)(i0 + 1) * lg); o1 *= expf((float)(i0 + 2) * lg);
#pragma unroll
                for (int j = 0; j < DS; ++j) { const float v = Z[((size_t)NP + b * DS + j) * DIN + C_RV + h * RDV + e]; o0 += inner[i0 * 4 + j] * v; o1 += inner[(i0 + 1) * 4 + j] * v; }
                ORET[((size_t)NP + b * DS + i0) * 1024 + h * RDV + e] = o0; ORET[((size_t)NP + b * DS + i0 + 1) * 1024 + h * RDV + e] = o1;
            }
            {
                const float g4 = expf(4.f * lg);
                float* so = out + O_RETS + (size_t)it * RDK * RDV;
                for (int i = tid; i < RDK * RDV; i += NTHREADS) { const int d = i >> 8, e = i & 255; float a = s0[i] * g4;
#pragma unroll
                    for (int j = 0; j < DS; ++j) a += expf((float)(3 - j) * lg) * qk[512 + j * 128 + d] * Z[((size_t)NP + b * DS + j) * DIN + C_RV + h * RDV + e];
                    so[i] = a; }
            }
        }
        for (int it = bid; it < (NP / 8) * XH; it += G) {
            const int h = it & 3, r8 = it >> 2; const size_t row = (size_t)r8 * 8 + wave; const int b = (int)(row >> 11);
            KvMem kv{out + O_MKP, out + O_MVP, b, h};
            attn_naive<64, 64, false, 0>(lds, kv, NMEM, QPtr{Z + row * DIN + C_XQ + h * XHD}, true, NMEM, 0.125f, 0.f, 0, OX + row * 256 + h * XHD);
        }
        for (int it = bid; it < DB * XH; it += G) {
            const int h = it & 3, b = it >> 2; const size_t row = (size_t)NP + b * DS + (wave & 3);
            KvMem kv{cache_mem_k, cache_mem_v, b, h};
            attn_naive<64, 64, false, 0>(lds, kv, NMEM, QPtr{Z + row * DIN + C_XQ + h * XHD}, wave < 4, NMEM, 0.125f, 0.f, 0, OX + row * 256 + h * XHD);
        }
    }
    SEAM(5);
    if (IN(6)) {
        for (int h = 0; h < MH; ++h)
            sgemm_naive(lds, OLAT + h * KVL, MH * KVL, w_uv + (size_t)h * KVL * DVH, DVH, 1, OMLA + h * DVH, 1024, NT, DVH, KVL, bid, G);
        for (int row = gw; row < NT; row += NGW) {
#pragma unroll
            for (int h = 0; h < RH; ++h) {
                float v[4]; float s = 0.f;
#pragma unroll
                for (int c = 0; c < 4; ++c) { v[c] = ORET[(size_t)row * 1024 + h * RDV + lane + 64 * c]; s += v[c] * v[c]; }
                const float r = rsqrtf(wave_sum(s) * (1.f / RDV) + EPS);
#pragma unroll
                for (int c = 0; c < 4; ++c) ORETN[(size_t)row * 1024 + h * RDV + lane + 64 * c] = siluf_(Z[(size_t)row * DIN + C_RG + h * RDV + lane + 64 * c]) * v[c] * r;
            }
        }
    }
    SEAM(6);
    if (IN(7)) {
        sgemm_naive(lds, ORETN, 1024, w_ret_o, 1024, 1, ARET, 1024, NT, 1024, 1024, bid, G);
        sgemm_naive(lds, OMLA, 1024, w_mla_o, 1024, 1, AMLA, 1024, NT, 1024, 1024, bid, G);
        sgemm_naive(lds, OX, 256, w_x_o, 1024, 1, AX, 1024, NT, 1024, 256, bid, G);
    }
    SEAM(7);
    if (IN(8)) {
        for (size_t i = (size_t)bid * NTHREADS + tid; i < (size_t)NT * DM; i += (size_t)G * NTHREADS) {
            const size_t row = i >> 10; const int c = (int)(i & 1023); const float* z = Z + row * DIN + C_G;
            MIX[i] = sigmoidf_(z[c]) * ARET[i] + sigmoidf_(z[1024 + c]) * AMLA[i] + sigmoidf_(z[2048 + c]) * AX[i];
        }
    }
    SEAM(8);
    if (IN(9)) sgemm_naive(lds, MIX, 1024, w_out, 1024, 1, HP, 1024, NT, 1024, 1024, bid, G);
    SEAM(9);
    if (IN(10)) {
        for (int row = gw; row < NT; row += NGW) {
            const float* xr = row < NP ? x_prompt + (size_t)row * DM : x_sample + (size_t)(row - NP) * DM;
            float v[16]; float s = 0.f;
#pragma unroll
            for (int c = 0; c < 16; ++c) { v[c] = HP[(size_t)row * DM + lane + 64 * c]; s += v[c] * v[c]; }
            float r = rsqrtf(wave_sum(s) * (1.f / DM) + EPS); s = 0.f;
#pragma unroll
            for (int c = 0; c < 16; ++c) { v[c] = xr[lane + 64 * c] + v[c] * r * g_mix_post[lane + 64 * c]; H[(size_t)row * DM + lane + 64 * c] = v[c]; s += v[c] * v[c]; }
            r = rsqrtf(wave_sum(s) * (1.f / DM) + EPS);
#pragma unroll
            for (int c = 0; c < 16; ++c) F[(size_t)row * DM + lane + 64 * c] = v[c] * r * g_ffn_pre[lane + 64 * c];
        }
    }
    SEAM(10);
    if (IN(11)) {
        sgemm_naive(lds, F, 1024, w_gate, DFF, 1, GG, DFF, NT, DFF, 1024, bid, G);
        sgemm_naive(lds, F, 1024, w_up, DFF, 1, UP, DFF, NT, DFF, 1024, bid, G);
    }
    SEAM(11);
    if (IN(12)) {
        for (size_t i = (size_t)bid * NTHREADS + tid; i < (size_t)NT * DFF; i += (size_t)G * NTHREADS) ACT[i] = siluf_(GG[i]) * UP[i];
    }
    SEAM(12);
    if (IN(13)) sgemm_naive(lds, ACT, DFF, w_down, 1024, 1, FO, 1024, NT, 1024, DFF, bid, G);
    SEAM(13);
    if (IN(14)) {
        for (int row = gw; row < NT; row += NGW) {
            float v[16]; float s = 0.f;
#pragma unroll
            for (int c = 0; c < 16; ++c) { v[c] = FO[(size_t)row * DM + lane + 64 * c]; s += v[c] * v[c]; }
            const float r = rsqrtf(wave_sum(s) * (1.f / DM) + EPS);
            float* y = row < NP ? out + O_YP + (size_t)row * DM : out + O_YS + (size_t)(row - NP) * DM;
#pragma unroll
            for (int c = 0; c < 16; ++c) y[lane + 64 * c] = H[(size_t)row * DM + lane + 64 * c] + v[c] * r * g_ffn_post[lane + 64 * c];
        }
    }
#undef IN
#undef SEAM
}
constexpr int N_PHASES = 15;
}

extern "C" void kernel_launch(void* const* d_in, const int* in_sizes, int n_in, void* d_out, int out_size, void* d_ws, size_t ws_size, hipStream_t stream) {
    static int grid = 0;
    if (grid == 0) {
        if (n_in != 29 || (size_t)out_size != O_END || ws_size < WS_END) { fprintf(stderr, "kernel_launch: unexpected shapes: n_in %d out %d ws %zu (need %zu)\n", n_in, out_size, ws_size, (size_t)WS_END); grid = -1; return; }
        int dev = 0, cus = 0, per_cu = 0;
        if (hipGetDevice(&dev) != hipSuccess || hipDeviceGetAttribute(&cus, hipDeviceAttributeMultiprocessorCount, dev) != hipSuccess) { grid = -1; return; }
        if (hipFuncSetAttribute((const void*)fwd_kernel, hipFuncAttributeMaxDynamicSharedMemorySize, LDS_BYTES) != hipSuccess) { fprintf(stderr, "kernel_launch: hipFuncSetAttribute failed\n"); grid = -1; return; }
        if (hipOccupancyMaxActiveBlocksPerMultiprocessor(&per_cu, (const void*)fwd_kernel, NTHREADS, LDS_BYTES) != hipSuccess || per_cu < 1) { fprintf(stderr, "kernel_launch: occupancy query says %d\n", per_cu); per_cu = 1; }
        (void)hipGetLastError();
        grid = cus;
    }
    if (grid < 0) return;
    (void)hipMemsetAsync((char*)d_ws + WS_CTL, 0, CTL_BYTES, stream);
    Args a{};
    for (int i = 0; i < 29; ++i) a.in[i] = (const float*)d_in[i];
    a.out = (float*)d_out; a.ws = (unsigned char*)d_ws;
#if MK_ONE_LAUNCH
    a.ph_lo = 0; a.ph_hi = N_PHASES;
    hipLaunchKernelGGL(fwd_kernel, dim3(grid), dim3(NTHREADS), LDS_BYTES, stream, a);
#else
    for (int p = 0; p < N_PHASES; ++p) { a.ph_lo = p; a.ph_hi = p + 1; hipLaunchKernelGGL(fwd_kernel, dim3(grid), dim3(NTHREADS), LDS_BYTES, stream, a); }
#endif
}
```

```cpp
#include <hip/hip_runtime.h>
#include <cstdio>
#include <cstdint>

#ifndef MK_ONE_LAUNCH
#define MK_ONE_LAUNCH 1
#endif

#define LAS __attribute__((address_space(3)))
#define GAS __attribute__((address_space(1)))
#define DI __device__ __forceinline__
typedef float f32x4 __attribute__((ext_vector_type(4)));

namespace {
constexpr int DM = 1024, NB = 8, SEQ = 2048, NP = NB * SEQ, DB = 128, DS = 4, NS = DB * DS, NT = NP + NS;
constexpr int PAST = 8192, PAGE = 128, NPAGES = PAST / PAGE;
constexpr int RH = 4, RDK = 128, RDV = 256;
constexpr int MH = 8, QL = 384, KVL = 256, DNOPE = 128, DROPE = 64, DVH = 128, DQH = DNOPE + DROPE;
constexpr int NMEM = 256, XH = 4, XHD = 64;
constexpr int DFF = 2816, DIN = 7104, ZLD = 7168;
constexpr int C_RQ = 0, C_RK = 512, C_RV = 1024, C_RG = 2048, C_CQ = 3072, C_CKV = 3456, C_KPE = 3712, C_XQ = 3776, C_G = 4032;
constexpr float EPS = 1e-6f;
constexpr int NPOS = SEQ + DS;
constexpr int NTHREADS = 512, NWAVES = 8;
constexpr int LDS_BYTES = 147456;
constexpr int MISC_OFF = 147456 - 256;

constexpr size_t O_YP = 0, O_YS = O_YP + (size_t)NP * DM, O_CKVP = O_YS + (size_t)NS * DM, O_KPEP = O_CKVP + (size_t)NP * KVL,
                 O_CKVS = O_KPEP + (size_t)NP * DROPE, O_KPES = O_CKVS + (size_t)NS * KVL, O_RETP = O_KPES + (size_t)NS * DROPE,
                 O_RETS = O_RETP + (size_t)NB * RH * RDK * RDV, O_MKP = O_RETS + (size_t)DB * RH * RDK * RDV, O_MVP = O_MKP + (size_t)NB * NMEM * 256,
                 O_END = O_MVP + (size_t)NB * NMEM * 256;

constexpr size_t al256(size_t x) { return (x + 255) & ~(size_t)255; }
constexpr size_t WS_CTL = 0, CTL_BYTES = 1u << 20;
constexpr size_t WS_COSA = WS_CTL + CTL_BYTES;
constexpr size_t WS_SINA = WS_COSA + al256((size_t)NPOS * 64 * 4);
constexpr size_t WS_COSB = WS_SINA + al256((size_t)NPOS * 64 * 4);
constexpr size_t WS_SINB = WS_COSB + al256((size_t)NPOS * 32 * 4);
constexpr size_t WS_U = WS_SINB + al256((size_t)NPOS * 32 * 4);
constexpr size_t WS_MN = WS_U + (size_t)NT * DM * 4;
constexpr size_t WS_Z = WS_MN + (size_t)NB * NMEM * DM * 4;
constexpr size_t WS_RQ = WS_Z + (size_t)NT * ZLD * 4;
constexpr size_t WS_RK = WS_RQ + (size_t)NT * 512 * 4;
constexpr size_t WS_CQN = WS_RK + (size_t)NT * 512 * 4;
constexpr size_t WS_CKVN = WS_CQN + (size_t)NT * QL * 4;
constexpr size_t WS_KPER = WS_CKVN + (size_t)NT * KVL * 4;
constexpr size_t WS_Q = WS_KPER + (size_t)NT * DROPE * 4;
constexpr size_t WS_QLAT = WS_Q + (size_t)NT * 1536 * 4;
constexpr size_t WS_QPE = WS_QLAT + (size_t)NT * 2048 * 4;
constexpr size_t WS_ORET = WS_QPE + (size_t)NT * 512 * 4;
constexpr size_t WS_OLAT = WS_ORET + (size_t)NT * 1024 * 4;
constexpr size_t WS_OX = WS_OLAT + (size_t)NT * 2048 * 4;
constexpr size_t WS_OMLA = WS_OX + (size_t)NT * 256 * 4;
constexpr size_t WS_ORETN = WS_OMLA + (size_t)NT * 1024 * 4;
constexpr size_t WS_ARET = WS_ORETN + (size_t)NT * 1024 * 4;
constexpr size_t WS_AMLA = WS_ARET + (size_t)NT * 1024 * 4;
constexpr size_t WS_AX = WS_AMLA + (size_t)NT * 1024 * 4;
constexpr size_t WS_MIX = WS_AX + (size_t)NT * 1024 * 4;
constexpr size_t WS_HP = WS_MIX + (size_t)NT * 1024 * 4;
constexpr size_t WS_H = WS_HP + (size_t)NT * 1024 * 4;
constexpr size_t WS_F = WS_H + (size_t)NT * 1024 * 4;
constexpr size_t WS_GG = WS_F + (size_t)NT * 1024 * 4;
constexpr size_t WS_UP = WS_GG + (size_t)NT * DFF * 4;
constexpr size_t WS_ACT = WS_UP + (size_t)NT * DFF * 4;
constexpr size_t WS_FO = WS_ACT + (size_t)NT * DFF * 4;
constexpr size_t WS_F32_END = WS_FO + (size_t)NT * 1024 * 4;
constexpr size_t WS_WIN_T = al256(WS_F32_END);
constexpr size_t WS_WMKV_T = WS_WIN_T + (size_t)ZLD * 1024 * 2;
constexpr size_t WS_WUQ_T = WS_WMKV_T + (size_t)512 * 1024 * 2;
constexpr size_t WS_WRO_T = WS_WUQ_T + (size_t)1536 * 384 * 2;
constexpr size_t WS_WMO_T = WS_WRO_T + (size_t)1024 * 1024 * 2;
constexpr size_t WS_WXO_T = WS_WMO_T + (size_t)1024 * 1024 * 2;
constexpr size_t WS_WO_T = WS_WXO_T + (size_t)1024 * 256 * 2;
constexpr size_t WS_WGU_T = WS_WO_T + (size_t)1024 * 1024 * 2;
constexpr size_t WS_WD_T = WS_WGU_T + (size_t)5632 * 1024 * 2;
constexpr size_t WS_UB = WS_WD_T + (size_t)1024 * 2816 * 2;
constexpr size_t WS_MNB = WS_UB + (size_t)NT * 1024 * 2;
constexpr size_t WS_CQNB = WS_MNB + (size_t)2048 * 1024 * 2;
constexpr size_t WS_ORETNB = WS_CQNB + (size_t)NT * 384 * 2;
constexpr size_t WS_OMLAB = WS_ORETNB + (size_t)NT * 1024 * 2;
constexpr size_t WS_OXB = WS_OMLAB + (size_t)NT * 1024 * 2;
constexpr size_t WS_MIXB = WS_OXB + (size_t)NT * 256 * 2;
constexpr size_t WS_FB = WS_MIXB + (size_t)NT * 1024 * 2;
constexpr size_t WS_ACTB = WS_FB + (size_t)NT * 1024 * 2;
constexpr size_t WS_END = WS_ACTB + (size_t)NT * 2816 * 2;

constexpr int CW_BAR = 4096;

#define XB_TMO      128
#define XB_XCNT(j)  (256  + 64 * (j))
#define XB_XSUB(j)  (1280 + 64 * (j))
#define XB_XGEN(j)  (2304 + 64 * (j))
#define XB_TOP      3328
#define XB_TOPGEN   3392
#define XCD_BAR_WORDS 3456
#define XB_SPIN_CAP (1u << 25)

DI unsigned xb_ld(unsigned* p)              { return __hip_atomic_load(p, __ATOMIC_RELAXED, __HIP_MEMORY_SCOPE_AGENT); }
DI unsigned xb_add(unsigned* p, unsigned v) { return __hip_atomic_fetch_add(p, v, __ATOMIC_RELAXED, __HIP_MEMORY_SCOPE_AGENT); }
DI unsigned xb_xcc_id() { return (unsigned)__builtin_amdgcn_s_getreg((3 << 11) | 20) & 0xFu; }
#define XB_SPIN(cond, bar) do { unsigned _sp = 0; while (cond) { __builtin_amdgcn_s_sleep(1); \
    if ((++_sp & 255u) == 0u) { if (xb_ld(&(bar)[XB_TMO])) break; if (_sp > XB_SPIN_CAP) { atomicAdd(&(bar)[XB_TMO], 1u); break; } } } } while (0)

struct XcdBarrier { unsigned* bar; unsigned x; volatile LAS unsigned* st; };

DI XcdBarrier xcd_barrier_post(unsigned* bar, volatile LAS unsigned* st) {
    XcdBarrier b; b.bar = bar; b.x = xb_xcc_id(); b.st = st;
    if (threadIdx.x == 0) (void)xb_add(&bar[XB_XCNT(b.x)], 1u);
    return b;
}
DI void xcd_barrier_complete(unsigned* bar, unsigned x, unsigned& nloc, unsigned& nx) {
    const unsigned G = gridDim.x * gridDim.y * gridDim.z;
    unsigned sum, cnt, mine, sp = 0u;
    for (;;) {
        sum = 0u; cnt = 0u; mine = 0u;
#pragma unroll
        for (unsigned j = 0; j < 16; ++j) { const unsigned c = xb_ld(&bar[XB_XCNT(j)]); sum += c; cnt += (c > 0u) ? 1u : 0u; mine = (j == x) ? c : mine; }
        if (sum == G) break;
        __builtin_amdgcn_s_sleep(1);
        if ((++sp & 255u) == 0u) { if (xb_ld(&bar[XB_TMO])) break; if (sp > XB_SPIN_CAP) { atomicAdd(&bar[XB_TMO], 1u); break; } }
    }
    nloc = mine > 0u ? mine : 1u; nx = cnt > 0u ? cnt : 1u;
}
DI void xcd_barrier(const XcdBarrier& b) {
    asm volatile("s_waitcnt vmcnt(0)" ::: "memory");
    __syncthreads();
    if (threadIdx.x == 0) {
        unsigned* bar = b.bar;
        __builtin_amdgcn_s_waitcnt(0);
        unsigned nloc = b.st[0], nx = b.st[1];
        if (nloc == 0u) { xcd_barrier_complete(bar, b.x, nloc, nx); b.st[0] = nloc; b.st[1] = nx; }
        const unsigned old = xb_add(&bar[XB_XSUB(b.x)], 1u);
        const unsigned gen = old / nloc;
        if (old + 1u == (gen + 1u) * nloc) {
            __builtin_amdgcn_fence(__ATOMIC_RELEASE, "agent");
            asm volatile("s_waitcnt vmcnt(0)" ::: "memory");
            const unsigned og = xb_add(&bar[XB_TOP], 1u);
            const unsigned tg = og / nx;
            if (og + 1u == (tg + 1u) * nx) xb_add(&bar[XB_TOPGEN], 1u);
            else XB_SPIN(xb_ld(&bar[XB_TOPGEN]) == tg, bar);
            __builtin_amdgcn_fence(__ATOMIC_ACQUIRE, "agent");
            xb_add(&bar[XB_XGEN(b.x)], 1u);
            asm volatile("s_waitcnt vmcnt(0)" ::: "memory");
        } else {
            XB_SPIN(xb_ld(&bar[XB_XGEN(b.x)]) == gen, bar);
            __builtin_amdgcn_fence(__ATOMIC_ACQUIRE, "agent");
            asm volatile("s_waitcnt vmcnt(0)" ::: "memory");
        }
    }
    __syncthreads();
}

DI float wave_sum(float v) {
#pragma unroll
    for (int o = 1; o < 64; o <<= 1) v += __shfl_xor(v, o);
    return v;
}
DI float wave_max(float v) {
#pragma unroll
    for (int o = 1; o < 64; o <<= 1) v = fmaxf(v, __shfl_xor(v, o));
    return v;
}
DI float sigmoidf_(float x) { return 1.f / (1.f + expf(-x)); }
DI float siluf_(float x) { return x / (1.f + expf(-x)); }
DI int pos_index(int row) { return row < NP ? (row & (SEQ - 1)) : SEQ + ((row - NP) & (DS - 1)); }
DI float lg_gamma(int h) { return log1pf(-exp2f(-5.0f - (float)h)); }


namespace pg8 {
typedef unsigned short bf16_t;
typedef short bf16x8 __attribute__((ext_vector_type(8)));
typedef unsigned u32x4 __attribute__((ext_vector_type(4)));
typedef unsigned u32x2 __attribute__((ext_vector_type(2)));
constexpr int BM = 256, BK = 64, HALF = 128, HTB = HALF * BK * 2, STAGE_BYTES = 8 * HTB, NXCD = 8, WGM = 8;
__host__ __device__ __forceinline__ int lds_byte(int r, int c) { const int st = (r >> 4) * 2 + (c >> 5), rr = r & 15, cc = c & 31, ob = rr * 64 + cc * 2; return st * 1024 + (ob ^ (((ob >> 9) & 1) << 5)); }
__host__ __device__ __forceinline__ void stage_rc(int b, int& R, int& C) { const int st = b / 1024, sb = b % 1024, swz = sb ^ (((sb >> 9) & 1) << 5); R = (st >> 1) * 16 + swz / 64; C = (st & 1) * 32 + (swz % 64) / 2; }
__host__ __device__ __forceinline__ int perm32(int rho) { const int n = rho >> 4, i = rho & 15; return 8 * (i >> 2) + 4 * n + (i & 3); }
struct Unit { int pm, pn; };
struct Gemm { const bf16_t* A; const bf16_t* Bt; int M, N, K, lda, ldb; };
struct StaticOrder {
    int nM, nN, nwg, G, c;
    __host__ __device__ void init(int M, int N, int G_, int c_) { nM = M / BM; nN = N / BM; nwg = nM * nN; G = G_; c = c_; }
    __host__ __device__ bool next(int i, Unit& u) const {
        const long L = (long)i * G + c; if (L >= nwg) return false;
        int wgid = (int)L; { const int q = nwg / NXCD, r = nwg % NXCD, xcd = wgid % NXCD, off = wgid / NXCD; wgid = (xcd < r ? xcd * (q + 1) : r * (q + 1) + (xcd - r) * q) + off; }
        const int nig = WGM * nN, gid = wgid / nig, fm = gid * WGM, gsz = (nM - fm) < WGM ? (nM - fm) : WGM;
        u.pm = fm + ((wgid % nig) % gsz); u.pn = (wgid % nig) / gsz; return true;
    }
    __device__ __forceinline__ void a_ready(const Unit&) const {}
    __device__ __forceinline__ void done(const Unit&) const {}
};
__device__ __forceinline__ unsigned cvt_pk_bf16(float lo, float hi) { unsigned r; asm volatile("v_cvt_pk_bf16_f32 %0, %1, %2" : "=v"(r) : "v"(lo), "v"(hi)); return r; }
struct EpiF32S {
    static constexpr bool PERM = false, AFTER_DRAIN = false;
    float* C; int ldc; int split_tiles; size_t split_stride;
    __device__ __forceinline__ void operator()(const f32x4 (&acc)[2][2][4][2], const Unit& u, int wr, int wc, int fr, int fq) const {
        int pn = u.pn; float* base = C; if (split_tiles) { const int t = pn / split_tiles; base += (size_t)t * split_stride; pn -= t * split_tiles; }
        const int row0 = u.pm * BM + wr * 64 + fr, col0 = pn * BM + wc * 32 + 4 * fq;
#pragma unroll
        for (int ai = 0; ai < 2; ++ai)
#pragma unroll
            for (int m = 0; m < 4; ++m) { float* rowp = base + (size_t)(row0 + ai * HALF + m * 16) * ldc + col0;
#pragma unroll
                for (int bj = 0; bj < 2; ++bj)
#pragma unroll
                    for (int n = 0; n < 2; ++n) *(f32x4*)(rowp + bj * HALF + n * 16) = acc[ai][bj][m][n]; }
    }
};
template <class Epi, class Sched, bool ALIGN_EPI = false, bool SP2 = false>
__device__ __forceinline__ void gemm_phase(LAS unsigned char* lds, const Gemm g, const Sched& S, const Epi& E) {
    const int tid = threadIdx.x, wid = __builtin_amdgcn_readfirstlane(tid >> 6), lane = tid & 63, wr = wid >> 2, wc = wid & 3, fr = lane & 15, fq = lane >> 4;
    const int K = g.K, nt = K / BK;
    unsigned voffA[2], voffB[2];
#pragma unroll
    for (int i = 0; i < 2; ++i) { int R, C; stage_rc(tid * 16 + i * 8192, R, C); const int Rb = Epi::PERM ? ((R & ~31) + perm32(R & 31)) : R;
        voffA[i] = (unsigned)(R * g.lda + C) * 2u; voffB[i] = (unsigned)(Rb * g.ldb + C) * 2u; }
    const size_t kstep = (size_t)(BK * 2);
    const size_t hstepA = (size_t)HALF * g.lda * 2, hstepB = (size_t)HALF * g.ldb * 2;
    const size_t tstepA = 2 * hstepA, tstepB = 2 * hstepB;
    const unsigned ldsw = (unsigned)wid * 1024u;
    const int aoff = lds_byte(wr * 64 + fr, fq * 8), boff = lds_byte(wc * 32 + fr, fq * 8);
#define PG8_SA(b, h) (((b) * 2 + (h)) * HTB)
#define PG8_SB(b, h) ((4 + (b) * 2 + (h)) * HTB)
#define PG8_STAGE(bufoff, gbase, voff) do { _Pragma("unroll") for (int _i = 0; _i < 2; ++_i) \
        __builtin_amdgcn_global_load_lds((const unsigned*)((const char*)(gbase) + (voff)[_i]), (LAS unsigned*)(lds + (bufoff) + ldsw + _i * 8192), 16, 0, 0); } while (0)
#define PG8_LDA(dst, b, h) do { _Pragma("unroll") for (int m = 0; m < 4; ++m) _Pragma("unroll") for (int k = 0; k < 2; ++k) dst[m][k] = *(const LAS bf16x8*)(lds + PG8_SA(b, h) + aoff + m * 2048 + k * 1024); } while (0)
#define PG8_LDB(dst, b, h) do { _Pragma("unroll") for (int n = 0; n < 2; ++n) _Pragma("unroll") for (int k = 0; k < 2; ++k) dst[n][k] = *(const LAS bf16x8*)(lds + PG8_SB(b, h) + boff + n * 2048 + k * 1024); } while (0)
#define PG8_MMA(ai, bj, At, Bt) do { __builtin_amdgcn_s_setprio(1); _Pragma("unroll") for (int m = 0; m < 4; ++m) _Pragma("unroll") for (int n = 0; n < 2; ++n) _Pragma("unroll") for (int k = 0; k < 2; ++k) \
        acc[ai][bj][m][n] = __builtin_amdgcn_mfma_f32_16x16x32_bf16(Bt[n][k], At[m][k], acc[ai][bj][m][n], 0, 0, 0); __builtin_amdgcn_s_setprio(0); } while (0)
#define PG8_WAIT_V(n) asm volatile("s_waitcnt vmcnt(" #n ")" ::: "memory")
#define PG8_WAIT_L(n) asm volatile("s_waitcnt lgkmcnt(" #n ")" ::: "memory")
#define PG8_BAR __builtin_amdgcn_s_barrier()
#define PG8_SCHED __builtin_amdgcn_sched_barrier(0)
    Unit cur, nxt; int ui = 0;
    if (!S.next(0, cur)) return;
    f32x4 acc[2][2][4][2];
#pragma unroll
    for (int a = 0; a < 2; ++a)
#pragma unroll
        for (int b = 0; b < 2; ++b)
#pragma unroll
            for (int m = 0; m < 4; ++m)
#pragma unroll
                for (int n = 0; n < 2; ++n) acc[a][b][m][n] = (f32x4){0.f, 0.f, 0.f, 0.f};
    bf16x8 At[4][2], B0[2][2], B1[2][2];
    const char* cA = (const char*)g.A + (size_t)cur.pm * tstepA; const char* cB = (const char*)g.Bt + (size_t)cur.pn * tstepB;
    S.a_ready(cur);
    if constexpr (SP2) {
        PG8_STAGE(PG8_SB(0, 0), cB, voffB); PG8_STAGE(PG8_SB(0, 1), cB + hstepB, voffB); PG8_STAGE(PG8_SA(0, 0), cA, voffA); PG8_STAGE(PG8_SA(0, 1), cA + hstepA, voffA);
        if (wr == 1) PG8_BAR;
        PG8_WAIT_V(2); PG8_BAR;
        PG8_STAGE(PG8_SB(1, 0), cB + kstep, voffB); PG8_STAGE(PG8_SA(1, 0), cA + kstep, voffA); PG8_STAGE(PG8_SB(1, 1), cB + hstepB + kstep, voffB);
        PG8_WAIT_V(6); PG8_BAR;
    } else {
        PG8_STAGE(PG8_SB(0, 0), cB, voffB); PG8_STAGE(PG8_SA(0, 0), cA, voffA); PG8_STAGE(PG8_SB(0, 1), cB + hstepB, voffB); PG8_STAGE(PG8_SA(0, 1), cA + hstepA, voffA);
        if (wr == 1) PG8_BAR;
        PG8_WAIT_V(4); PG8_BAR;
        PG8_STAGE(PG8_SB(1, 0), cB + kstep, voffB); PG8_STAGE(PG8_SA(1, 0), cA + kstep, voffA); PG8_STAGE(PG8_SB(1, 1), cB + hstepB + kstep, voffB);
        PG8_WAIT_V(6); PG8_BAR;
    }
    for (;;) {
        const bool has_next = S.next(ui + 1, nxt);
        const char* nA = has_next ? (const char*)g.A + (size_t)nxt.pm * tstepA : cA; const char* nB = has_next ? (const char*)g.Bt + (size_t)nxt.pn * tstepB : cB;
        for (int t = 0; t < nt; t += 2) {
            const bool last = (t == nt - 2);
            const char* a1 = cA + (size_t)(t + 1) * kstep;
            const char* a2 = last ? nA : cA + (size_t)(t + 2) * kstep; const char* b2 = last ? nB : cB + (size_t)(t + 2) * kstep;
            const char* a3 = a2 + kstep; const char* b3 = b2 + kstep;
            if (last && has_next) S.a_ready(nxt);
            if constexpr (SP2) {
            PG8_LDB(B0, 0, 0); PG8_LDB(B1, 0, 1); PG8_SCHED; PG8_LDA(At, 0, 0); PG8_STAGE(PG8_SA(1, 1), a1 + hstepA, voffA);
            PG8_WAIT_V(8); PG8_WAIT_L(0); PG8_BAR; PG8_MMA(0, 0, At, B0); PG8_MMA(0, 1, At, B1); PG8_BAR; PG8_SCHED;
            PG8_LDA(At, 0, 1); PG8_STAGE(PG8_SB(0, 0), b2, voffB); PG8_STAGE(PG8_SB(0, 1), b2 + hstepB, voffB); PG8_STAGE(PG8_SA(0, 0), a2, voffA);
            PG8_WAIT_V(8); PG8_WAIT_L(0); PG8_BAR; PG8_MMA(1, 0, At, B0); PG8_MMA(1, 1, At, B1); PG8_BAR; PG8_SCHED;
            PG8_LDB(B0, 1, 0); PG8_LDB(B1, 1, 1); PG8_SCHED; PG8_LDA(At, 1, 0); PG8_STAGE(PG8_SA(0, 1), a2 + hstepA, voffA);
            PG8_WAIT_V(8); PG8_WAIT_L(0); PG8_BAR; PG8_MMA(0, 0, At, B0); PG8_MMA(0, 1, At, B1); PG8_BAR; PG8_SCHED;
            PG8_LDA(At, 1, 1); PG8_STAGE(PG8_SB(1, 0), b3, voffB); PG8_STAGE(PG8_SB(1, 1), b3 + hstepB, voffB); PG8_STAGE(PG8_SA(1, 0), a3, voffA);
            PG8_WAIT_V(8); PG8_WAIT_L(0); PG8_BAR; PG8_MMA(1, 0, At, B0); PG8_MMA(1, 1, At, B1); PG8_BAR; PG8_SCHED;
            } else {
            PG8_LDB(B0, 0, 0); PG8_SCHED; PG8_LDA(At, 0, 0); PG8_STAGE(PG8_SA(1, 1), a1 + hstepA, voffA);
            PG8_WAIT_L(8); PG8_BAR; PG8_WAIT_L(0); PG8_MMA(0, 0, At, B0); PG8_BAR; PG8_SCHED;
            PG8_LDB(B1, 0, 1); PG8_STAGE(PG8_SB(0, 0), b2, voffB);
            PG8_BAR; PG8_WAIT_L(0); PG8_MMA(0, 1, At, B1); PG8_BAR;
            PG8_LDA(At, 0, 1); PG8_STAGE(PG8_SA(0, 0), a2, voffA);
            PG8_BAR; PG8_WAIT_L(0); PG8_MMA(1, 0, At, B0); PG8_BAR; PG8_SCHED;
            PG8_STAGE(PG8_SB(0, 1), b2 + hstepB, voffB);
            PG8_WAIT_V(6); PG8_BAR; PG8_MMA(1, 1, At, B1); PG8_BAR;
            PG8_LDB(B0, 1, 0); PG8_SCHED; PG8_LDA(At, 1, 0); PG8_STAGE(PG8_SA(0, 1), a2 + hstepA, voffA);
            PG8_WAIT_L(8); PG8_BAR; PG8_WAIT_L(0); PG8_MMA(0, 0, At, B0); PG8_BAR; PG8_SCHED;
            PG8_LDB(B1, 1, 1); PG8_STAGE(PG8_SB(1, 0), b3, voffB);
            PG8_BAR; PG8_WAIT_L(0); PG8_MMA(0, 1, At, B1); PG8_BAR;
            PG8_LDA(At, 1, 1); PG8_STAGE(PG8_SA(1, 0), a3, voffA);
            PG8_BAR; PG8_WAIT_L(0); PG8_MMA(1, 0, At, B0); PG8_BAR; PG8_SCHED;
            PG8_STAGE(PG8_SB(1, 1), b3 + hstepB, voffB);
            PG8_WAIT_V(6); PG8_BAR; PG8_MMA(1, 1, At, B1); PG8_BAR;
            }
        }
        if constexpr (ALIGN_EPI) { if (wr == 0) PG8_BAR; }
        if constexpr (!Epi::AFTER_DRAIN) { E(acc, cur, wr, wc, fr, fq); S.done(cur); }
        if (!has_next) break;
#pragma unroll
        for (int a = 0; a < 2; ++a)
#pragma unroll
            for (int b = 0; b < 2; ++b)
#pragma unroll
                for (int m = 0; m < 4; ++m)
#pragma unroll
                    for (int n = 0; n < 2; ++n) acc[a][b][m][n] = (f32x4){0.f, 0.f, 0.f, 0.f};
        cur = nxt; cA = nA; cB = nB; ++ui;
        if constexpr (ALIGN_EPI) { if (wr == 1) PG8_BAR; }
    }
    PG8_WAIT_V(0);
    if constexpr (!ALIGN_EPI) { if (wr == 0) PG8_BAR; }
    PG8_BAR;
    if constexpr (Epi::AFTER_DRAIN) { E.fused(acc, cur, wr, wc, fr, fq, lds, wid, lane); S.done(cur); }
#undef PG8_SA
#undef PG8_SB
#undef PG8_STAGE
#undef PG8_LDA
#undef PG8_LDB
#undef PG8_MMA
#undef PG8_WAIT_V
#undef PG8_WAIT_L
#undef PG8_BAR
#undef PG8_SCHED
}
}
typedef unsigned short bf16_t;
DI unsigned pk2(float lo, float hi) { return pg8::cvt_pk_bf16(lo, hi); }
DI bf16_t f2bf(float f) { return (bf16_t)(pg8::cvt_pk_bf16(f, 0.f) & 0xffffu); }
DI void transpose_item(const float* W, int N, bf16_t* WT, int ldt, int row_off, LAS float* scr, int item, int lane) {
    const int nblk = N / 32, kb = item / nblk, nb = item % nblk, k0 = 64 * kb, n0 = 32 * nb;
#pragma unroll 8
    for (int i = 0; i < 32; ++i) { const int kk = 2 * i + (lane >> 5); scr[kk * 33 + (lane & 31)] = W[(size_t)(k0 + kk) * N + n0 + (lane & 31)]; }
    asm volatile("s_waitcnt lgkmcnt(0)" ::: "memory");
    const int c = lane & 7;
#pragma unroll
    for (int j = 0; j < 4; ++j) { const int n = (lane >> 3) + 8 * j; const LAS float* sp = scr + (8 * c) * 33 + n;
        pg8::u32x4 o; o.x = pk2(sp[0 * 33], sp[1 * 33]); o.y = pk2(sp[2 * 33], sp[3 * 33]); o.z = pk2(sp[4 * 33], sp[5 * 33]); o.w = pk2(sp[6 * 33], sp[7 * 33]);
        *(pg8::u32x4*)(WT + (size_t)(row_off + n0 + n) * ldt + k0 + 8 * c) = o; }
    asm volatile("s_waitcnt lgkmcnt(0)" ::: "memory");
}
DI void transpose_w(const float* W, int K, int N, bf16_t* WT, int ldt, int row_off, LAS float* scr, int gw, int NGW, int lane) {
    const int nitems = (K / 64) * (N / 32);
    for (int it = gw; it < nitems; it += NGW) transpose_item(W, N, WT, ldt, row_off, scr, it, lane);
}

struct Args {
    const float* in[29]; float* out; unsigned char* ws; int ph_lo, ph_hi;
};

DI unsigned short f2bf_raw(float f) { unsigned u = __builtin_bit_cast(unsigned, f); return (unsigned short)((u + 0x7fffu + ((u >> 16) & 1u)) >> 16); }
DI void sgemm_naive(LAS float* lds, const float* __restrict__ A, int lda, const float* __restrict__ B, long sbk, long sbn,
                    float* __restrict__ C, int ldc, int M, int N, int K, int bid, int G, unsigned short* Cb = nullptr) {
    LAS float* As = lds;
    LAS float* Bs = lds + 16 * 132;
    const int tid = threadIdx.x, tx = tid & 15, ty = tid >> 4;
    const int ntn = N / 64, ntiles = (M / 128) * ntn;
    for (int t = bid; t < ntiles; t += G) {
        const int m0 = (t / ntn) * 128, n0 = (t % ntn) * 64;
        float acc[4][4];
#pragma unroll
        for (int i = 0; i < 4; ++i)
#pragma unroll
            for (int j = 0; j < 4; ++j) acc[i][j] = 0.f;
        for (int k0 = 0; k0 < K; k0 += 16) {
            {
                const int r = tid >> 2, kq = (tid & 3) * 4;
                const float4 v = *(const float4*)(A + (size_t)(m0 + r) * lda + k0 + kq);
                As[(kq + 0) * 132 + r] = v.x; As[(kq + 1) * 132 + r] = v.y; As[(kq + 2) * 132 + r] = v.z; As[(kq + 3) * 132 + r] = v.w;
            }
#pragma unroll
            for (int i = 0; i < 2; ++i) {
                const int idx = tid + i * 512, kk = idx >> 6, nn = idx & 63;
                Bs[kk * 64 + nn] = B[(size_t)(k0 + kk) * sbk + (size_t)(n0 + nn) * sbn];
            }
            __syncthreads();
#pragma unroll
            for (int kk = 0; kk < 16; ++kk) {
                const f32x4 a = *(const LAS f32x4*)(As + kk * 132 + ty * 4);
                const f32x4 b = *(const LAS f32x4*)(Bs + kk * 64 + tx * 4);
                const float av[4] = {a.x, a.y, a.z, a.w}, bv[4] = {b.x, b.y, b.z, b.w};
#pragma unroll
                for (int i = 0; i < 4; ++i)
#pragma unroll
                    for (int j = 0; j < 4; ++j) acc[i][j] += av[i] * bv[j];
            }
            __syncthreads();
        }
#pragma unroll
        for (int i = 0; i < 4; ++i) {
            float4 o; o.x = acc[i][0]; o.y = acc[i][1]; o.z = acc[i][2]; o.w = acc[i][3];
            if (Cb) { unsigned short* cb = Cb + (size_t)(m0 + ty * 4 + i) * ldc + n0 + tx * 4; cb[0] = f2bf_raw(o.x); cb[1] = f2bf_raw(o.y); cb[2] = f2bf_raw(o.z); cb[3] = f2bf_raw(o.w); }
            else *(float4*)(C + (size_t)(m0 + ty * 4 + i) * ldc + n0 + tx * 4) = o;
        }
    }
}

template <int DQK, int DV, bool V_IN_K, int MODE, class KV, class QF>
DI void attn_naive(LAS float* lds, const KV& kv, int nk_loop, const QF& qf, bool active, int limit, float scale, float lg, int tq, float* optr) {
    constexpr int KS = DQK + 1;
    constexpr int VS = V_IN_K ? KS : DV;
    LAS float* Ks = lds;
    LAS float* Vs = V_IN_K ? Ks : (lds + 64 * KS);
    LAS float* qs = lds + 64 * KS + (V_IN_K ? 0 : 64 * DV);
    LAS float* ps = qs + 8 * DQK;
    static_assert((64 * KS + (V_IN_K ? 0 : 64 * DV) + 8 * DQK + 8 * 64) * 4 <= MISC_OFF, "attn_naive LDS");
    const int tid = threadIdx.x, lane = tid & 63, w = tid >> 6;
    __syncthreads();
    for (int d = lane; d < DQK; d += 64) qs[w * DQK + d] = active ? qf(d) : 0.f;
    float m = -INFINITY, l = 0.f;
    float acc[DV / 64];
#pragma unroll
    for (int c = 0; c < DV / 64; ++c) acc[c] = 0.f;
    for (int base = 0; base < nk_loop; base += 64) {
        __syncthreads();
        for (int idx = tid; idx < 64 * DQK; idx += NTHREADS) { const int j = idx / DQK, d = idx - j * DQK, key = base + j; Ks[j * KS + d] = key < nk_loop ? kv.k(key, d) : 0.f; }
        if (!V_IN_K) for (int idx = tid; idx < 64 * DV; idx += NTHREADS) { const int j = idx / DV, e = idx - j * DV, key = base + j; Vs[j * DV + e] = key < nk_loop ? kv.v(key, e) : 0.f; }
        __syncthreads();
        const int key = base + lane; const bool valid = active && key <= limit && key < nk_loop;
        float s = 0.f;
        for (int d = 0; d < DQK; ++d) s += qs[w * DQK + d] * Ks[lane * KS + d];
        float p;
        if (MODE == 0) {
            s *= scale;
            const float cm = wave_max(valid ? s : -INFINITY);
            const float mn = fmaxf(m, cm);
            const float alpha = (mn == -INFINITY) ? 1.f : expf(m - mn);
            p = valid ? expf(s - mn) : 0.f;
            l = l * alpha + wave_sum(p);
#pragma unroll
            for (int c = 0; c < DV / 64; ++c) acc[c] *= alpha;
            m = mn;
        } else {
            p = valid ? s * expf((float)(tq - key) * lg) : 0.f;
        }
        ps[w * 64 + lane] = p;
        __syncthreads();
        for (int j = 0; j < 64; ++j) { const float pj = ps[w * 64 + j];
#pragma unroll
            for (int c = 0; c < DV / 64; ++c) acc[c] += pj * Vs[j * VS + lane + 64 * c]; }
    }
    if (active) {
#pragma unroll
        for (int c = 0; c < DV / 64; ++c) optr[lane + 64 * c] = (MODE == 0) ? acc[c] / l : acc[c];
    }
}

struct KvMlaPrompt { const float* ckvn; const float* kper; int b;
    DI float k(int key, int d) const { const size_t row = (size_t)b * SEQ + key; return d < KVL ? ckvn[row * KVL + d] : kper[row * DROPE + (d - KVL)]; }
    DI float v(int, int) const { return 0.f; } };
struct KvMlaSample { const float* ckvn; const float* kper; const float* cckv; const float* ckpe; const int* pt; int b;
    DI float k(int key, int d) const {
        if (key < PAST) { const size_t r = (size_t)pt[b * NPAGES + (key >> 7)] * PAGE + (key & (PAGE - 1)); return d < KVL ? cckv[r * KVL + d] : ckpe[r * DROPE + (d - KVL)]; }
        const size_t row = (size_t)NP + b * DS + (key - PAST); return d < KVL ? ckvn[row * KVL + d] : kper[row * DROPE + (d - KVL)]; }
    DI float v(int, int) const { return 0.f; } };
struct KvRet { const float* rk; const float* z; int b, h;
    DI float k(int key, int d) const { return rk[((size_t)b * SEQ + key) * 512 + h * RDK + d]; }
    DI float v(int key, int e) const { return z[((size_t)b * SEQ + key) * ZLD + C_RV + h * RDV + e]; } };
struct KvMem { const float* mk; const float* mv; int b, h;
    DI float k(int key, int d) const { return mk[(((size_t)b * NMEM + key) * XH + h) * XHD + d]; }
    DI float v(int key, int e) const { return mv[(((size_t)b * NMEM + key) * XH + h) * XHD + e]; } };

struct QPtr { const float* p; DI float operator()(int d) const { return p[d]; } };
struct QMla { const float* ql; const float* qp; DI float operator()(int d) const { return d < KVL ? ql[d] : qp[d - KVL]; } };
DI void rms_row(const float* x, const float* g, float* o, int n, int lane) {
    float s = 0.f;
    for (int i = lane; i < n; i += 64) { const float v = x[i]; s += v * v; }
    const float r = rsqrtf(wave_sum(s) / (float)n + EPS);
    for (int i = lane; i < n; i += 64) o[i] = x[i] * r * g[i];
}

DI void rms_row_bf16(const float* x, const float* g, bf16_t* o, int n, int lane) {
    float s = 0.f;
    for (int i = lane; i < n; i += 64) { const float v = x[i]; s += v * v; }
    const float r = rsqrtf(wave_sum(s) / (float)n + EPS);
    for (int i = lane; i < n; i += 64) o[i] = f2bf(x[i] * r * g[i]);
}
#define GEMM_PHASE(EPI, ...) pg8::gemm_phase<EPI, pg8::StaticOrder, true, true>(__VA_ARGS__)
__global__ void __launch_bounds__(NTHREADS, 2) fwd_kernel(Args args) {
    extern __shared__ __attribute__((aligned(16))) unsigned char lds_raw[];
    LAS unsigned char* ldsb = (LAS unsigned char*)lds_raw;
    LAS float* lds = (LAS float*)ldsb;
    volatile LAS unsigned* MISC = (volatile LAS unsigned*)(ldsb + MISC_OFF);
    const int tid = threadIdx.x, lane = tid & 63, wave = tid >> 6;
    const int G = gridDim.x, bid = blockIdx.x;
    const int gw = bid * NWAVES + wave, NGW = G * NWAVES;
    unsigned char* ws = args.ws;
    float* out = args.out;
    const int lo = args.ph_lo, hi = args.ph_hi;

    if (tid < 64) MISC[tid] = 0u;
    __syncthreads();
    XcdBarrier bar; bar.bar = (unsigned*)(ws + WS_CTL) + CW_BAR; bar.x = 0; bar.st = MISC;
    if (hi - lo > 1) bar = xcd_barrier_post((unsigned*)(ws + WS_CTL) + CW_BAR, MISC);
#define IN(k) (lo <= (k) && (k) < hi)
#define SEAM(k) do { if (IN(k) && IN((k) + 1)) xcd_barrier(bar); } while (0)

    const float* x_prompt = args.in[0]; const float* x_sample = args.in[1]; const float* mem_prompt = args.in[2];
    const float* cache_ckv = args.in[3]; const float* cache_kpe = args.in[4]; const int* page_table = (const int*)args.in[5];
    const float* state_ret = args.in[6]; const float* cache_mem_k = args.in[7]; const float* cache_mem_v = args.in[8];
    const float* g_mix_pre = args.in[9]; const float* g_mix_post = args.in[10]; const float* g_ffn_pre = args.in[11]; const float* g_ffn_post = args.in[12];
    const float* g_mem = args.in[13]; const float* g_qlat = args.in[14]; const float* g_kvlat = args.in[15];
    const float* w_in = args.in[16]; const float* w_uq = args.in[17]; const float* w_uk = args.in[18]; const float* w_uv = args.in[19];
    const float* w_mem_k = args.in[20]; const float* w_mem_v = args.in[21]; const float* w_ret_o = args.in[22]; const float* w_mla_o = args.in[23];
    const float* w_x_o = args.in[24]; const float* w_out = args.in[25]; const float* w_gate = args.in[26]; const float* w_up = args.in[27]; const float* w_down = args.in[28];
    float* COSA = (float*)(ws + WS_COSA); float* SINA = (float*)(ws + WS_SINA); float* COSB = (float*)(ws + WS_COSB); float* SINB = (float*)(ws + WS_SINB);
    float* U = (float*)(ws + WS_U); float* MN = (float*)(ws + WS_MN); float* Z = (float*)(ws + WS_Z);
    float* RQ = (float*)(ws + WS_RQ); float* RK = (float*)(ws + WS_RK); float* CQN = (float*)(ws + WS_CQN); float* CKVN = (float*)(ws + WS_CKVN); float* KPER = (float*)(ws + WS_KPER);
    float* Q = (float*)(ws + WS_Q); float* QLAT = (float*)(ws + WS_QLAT); float* QPE = (float*)(ws + WS_QPE);
    float* ORET = (float*)(ws + WS_ORET); float* OLAT = (float*)(ws + WS_OLAT); float* OX = (float*)(ws + WS_OX); float* OMLA = (float*)(ws + WS_OMLA); float* ORETN = (float*)(ws + WS_ORETN);
    float* ARET = (float*)(ws + WS_ARET); float* AMLA = (float*)(ws + WS_AMLA); float* AX = (float*)(ws + WS_AX); float* MIX = (float*)(ws + WS_MIX);
    float* HP = (float*)(ws + WS_HP); float* H = (float*)(ws + WS_H); float* F = (float*)(ws + WS_F);
    float* GU = (float*)(ws + WS_GG); float* FO = (float*)(ws + WS_FO);
    bf16_t* WinT = (bf16_t*)(ws + WS_WIN_T); bf16_t* WmkvT = (bf16_t*)(ws + WS_WMKV_T); bf16_t* WuqT = (bf16_t*)(ws + WS_WUQ_T); bf16_t* WroT = (bf16_t*)(ws + WS_WRO_T);
    bf16_t* WmoT = (bf16_t*)(ws + WS_WMO_T); bf16_t* WxoT = (bf16_t*)(ws + WS_WXO_T); bf16_t* WoT = (bf16_t*)(ws + WS_WO_T); bf16_t* WguT = (bf16_t*)(ws + WS_WGU_T); bf16_t* WdT = (bf16_t*)(ws + WS_WD_T);
    bf16_t* Ub = (bf16_t*)(ws + WS_UB); bf16_t* MNb = (bf16_t*)(ws + WS_MNB); bf16_t* CQNb = (bf16_t*)(ws + WS_CQNB); bf16_t* ORETNb = (bf16_t*)(ws + WS_ORETNB);
    bf16_t* OMLAb = (bf16_t*)(ws + WS_OMLAB); bf16_t* OXb = (bf16_t*)(ws + WS_OXB); bf16_t* MIXb = (bf16_t*)(ws + WS_MIXB); bf16_t* Fb = (bf16_t*)(ws + WS_FB); bf16_t* ACTb = (bf16_t*)(ws + WS_ACTB);

    if (IN(0)) {
        for (int i = bid * NTHREADS + tid; i < NPOS * 64 + NPOS * 32; i += G * NTHREADS) {
            const bool a = i < NPOS * 64; const int j = a ? i : i - NPOS * 64; const int half = a ? 64 : 32;
            const int p = j / half, f = j % half; const int pos = p < SEQ ? p : PAST + (p - SEQ);
            const float inv = powf(10000.0f, -(float)f / (float)half);
            const float ang = (float)pos * inv;
            double rev = (double)ang * 0.15915494309189535; rev -= floor(rev);
            const float r = (float)rev;
            const float sn = __builtin_amdgcn_sinf(r), cs = __builtin_amdgcn_cosf(r);
            if (a) { COSA[j] = cs; SINA[j] = sn; } else { COSB[j] = cs; SINB[j] = sn; }
        }
        for (int row = gw; row < NT; row += NGW) {
            const float* xr = row < NP ? x_prompt + (size_t)row * DM : x_sample + (size_t)(row - NP) * DM;
            rms_row_bf16(xr, g_mix_pre, Ub + (size_t)row * DM, DM, lane);
        }
        for (int row = gw; row < NB * NMEM; row += NGW) rms_row_bf16(mem_prompt + (size_t)row * DM, g_mem, MNb + (size_t)row * DM, DM, lane);
        {
            LAS float* scr = lds + wave * (64 * 33);
            transpose_w(w_in, 1024, DIN, WinT, 1024, 0, scr, gw, NGW, lane);
            for (int i = bid * NTHREADS + tid; i < (ZLD - DIN) * 1024 / 2; i += G * NTHREADS) ((unsigned*)(WinT + (size_t)DIN * 1024))[i] = 0u;
            transpose_w(w_mem_k, 1024, 256, WmkvT, 1024, 0, scr, gw, NGW, lane);
            transpose_w(w_mem_v, 1024, 256, WmkvT, 1024, 256, scr, gw, NGW, lane);
            transpose_w(w_uq, QL, 1536, WuqT, QL, 0, scr, gw, NGW, lane);
            transpose_w(w_ret_o, 1024, 1024, WroT, 1024, 0, scr, gw, NGW, lane);
            transpose_w(w_mla_o, 1024, 1024, WmoT, 1024, 0, scr, gw, NGW, lane);
            transpose_w(w_x_o, 256, 1024, WxoT, 256, 0, scr, gw, NGW, lane);
            transpose_w(w_out, 1024, 1024, WoT, 1024, 0, scr, gw, NGW, lane);
            transpose_w(w_gate, 1024, DFF, WguT, 1024, 0, scr, gw, NGW, lane);
            transpose_w(w_up, 1024, DFF, WguT, 1024, DFF, scr, gw, NGW, lane);
            transpose_w(w_down, DFF, 1024, WdT, DFF, 0, scr, gw, NGW, lane);
        }
    }
    SEAM(0);
    if (IN(1)) {
        { pg8::Gemm g{Ub, WinT, NT, ZLD, 1024, 1024, 1024}; pg8::StaticOrder S; S.init(NT, ZLD, G, bid); pg8::EpiF32S E{Z, ZLD, 0, 0};
          GEMM_PHASE(pg8::EpiF32S, ldsb, g, S, E); }
        __syncthreads();
        { pg8::Gemm g{MNb, WmkvT, NB * NMEM, 512, 1024, 1024, 1024}; pg8::StaticOrder S; S.init(NB * NMEM, 512, G, bid); pg8::EpiF32S E{out + O_MKP, 256, 1, O_MVP - O_MKP};
          GEMM_PHASE(pg8::EpiF32S, ldsb, g, S, E); }
    }
    SEAM(1);
    if (IN(2)) {
        for (int row = gw; row < NT; row += NGW) {
            const float* z = Z + (size_t)row * ZLD; const int p = pos_index(row);
            const float ca = COSA[p * 64 + lane], sa = SINA[p * 64 + lane];
#pragma unroll
            for (int h = 0; h < RH; ++h) {
                float x1 = z[C_RQ + h * RDK + lane], x2 = z[C_RQ + h * RDK + 64 + lane];
                RQ[(size_t)row * 512 + h * RDK + lane] = x1 * ca - x2 * sa; RQ[(size_t)row * 512 + h * RDK + 64 + lane] = x1 * sa + x2 * ca;
                x1 = z[C_RK + h * RDK + lane]; x2 = z[C_RK + h * RDK + 64 + lane];
                const float sc = 0.08838834764831845f;
                RK[(size_t)row * 512 + h * RDK + lane] = (x1 * ca - x2 * sa) * sc; RK[(size_t)row * 512 + h * RDK + 64 + lane] = (x1 * sa + x2 * ca) * sc;
            }
            rms_row_bf16(z + C_CQ, g_qlat, CQNb + (size_t)row * QL, QL, lane);
            rms_row(z + C_CKV, g_kvlat, CKVN + (size_t)row * KVL, KVL, lane);
            float* ockv = row < NP ? out + O_CKVP + (size_t)row * KVL : out + O_CKVS + (size_t)(row - NP) * KVL;
            for (int i = lane; i < KVL; i += 64) ockv[i] = CKVN[(size_t)row * KVL + i];
            if (lane < 32) {
                const float cb = COSB[p * 32 + lane], sb = SINB[p * 32 + lane];
                const float x1 = z[C_KPE + lane], x2 = z[C_KPE + 32 + lane];
                const float o1 = x1 * cb - x2 * sb, o2 = x1 * sb + x2 * cb;
                KPER[(size_t)row * DROPE + lane] = o1; KPER[(size_t)row * DROPE + 32 + lane] = o2;
                float* okpe = row < NP ? out + O_KPEP + (size_t)row * DROPE : out + O_KPES + (size_t)(row - NP) * DROPE;
                okpe[lane] = o1; okpe[32 + lane] = o2;
            }
        }
    }
    SEAM(2);
    if (IN(3)) { pg8::Gemm g{CQNb, WuqT, NT, 1536, QL, QL, QL}; pg8::StaticOrder S; S.init(NT, 1536, G, bid); pg8::EpiF32S E{Q, 1536, 0, 0};
        GEMM_PHASE(pg8::EpiF32S, ldsb, g, S, E); }
    SEAM(3);
    if (IN(4)) {
        for (int h = 0; h < MH; ++h)
            sgemm_naive(lds, Q + h * DQH, 1536, w_uk + (size_t)h * KVL * DNOPE, 1, DNOPE, QLAT + h * KVL, MH * KVL, NT, KVL, DNOPE, bid, G);
        for (int row = gw; row < NT; row += NGW) {
            const int p = pos_index(row);
#pragma unroll
            for (int c = 0; c < 4; ++c) { const int idx = lane + 64 * c, h = idx >> 5, f = idx & 31;
                const float cb = COSB[p * 32 + f], sb = SINB[p * 32 + f];
                const float x1 = Q[(size_t)row * 1536 + h * DQH + DNOPE + f], x2 = Q[(size_t)row * 1536 + h * DQH + DNOPE + 32 + f];
                QPE[(size_t)row * 512 + h * 64 + f] = x1 * cb - x2 * sb; QPE[(size_t)row * 512 + h * 64 + 32 + f] = x1 * sb + x2 * cb; }
        }
    }
    SEAM(4);
    if (IN(5)) {
        for (int it = bid; it < NS; it += G) {
            const int b = it >> 2, t = it & 3; const size_t row = (size_t)NP + it;
            KvMlaSample kv{CKVN, KPER, cache_ckv, cache_kpe, page_table, b};
            QMla qf{QLAT + row * 2048 + wave * KVL, QPE + row * 512 + wave * 64};
            attn_naive<320, 256, true, 0>(lds, kv, PAST + t + 1, qf, true, PAST + t, 0.07216878364870322f, 0.f, 0, OLAT + row * 2048 + wave * KVL);
        }
        for (int it = bid; it < NP; it += G) {
            const int b = it >> 11, t = it & (SEQ - 1); const size_t row = (size_t)it;
            KvMlaPrompt kv{CKVN, KPER, b};
            QMla qf{QLAT + row * 2048 + wave * KVL, QPE + row * 512 + wave * 64};
            attn_naive<320, 256, true, 0>(lds, kv, t + 1, qf, true, t, 0.07216878364870322f, 0.f, 0, OLAT + row * 2048 + wave * KVL);
        }
        for (int it = bid; it < NB * RH * (SEQ / 8); it += G) {
            const int t8 = it % (SEQ / 8), bh = it / (SEQ / 8), h = bh & 3, b = bh >> 2; const int t = t8 * 8 + wave; const size_t row = (size_t)b * SEQ + t;
            KvRet kv{RK, Z, b, h};
            attn_naive<128, 256, false, 1>(lds, kv, t8 * 8 + 8, QPtr{RQ + row * 512 + h * RDK}, true, t, 1.f, lg_gamma(h), t, ORET + row * 1024 + h * RDV);
        }
        for (int it = bid; it < NB * RH * 16; it += G) {
            const int d8 = it & 15, bh = it >> 4, h = bh & 3, b = bh >> 2; const float lg = lg_gamma(h);
            const int e = tid & 255, dd = d8 * 8 + (tid >> 8) * 4;
            float a0 = 0.f, a1 = 0.f, a2 = 0.f, a3 = 0.f;
            for (int j = 0; j < SEQ; ++j) { const size_t row = (size_t)b * SEQ + j;
                const float v = Z[row * ZLD + C_RV + h * RDV + e] * expf((float)(SEQ - 1 - j) * lg);
                const float* kr = RK + row * 512 + h * RDK + dd;
                a0 += kr[0] * v; a1 += kr[1] * v; a2 += kr[2] * v; a3 += kr[3] * v; }
            float* o = out + O_RETP + ((size_t)bh * RDK + dd) * RDV + e;
            o[0] = a0; o[RDV] = a1; o[2 * RDV] = a2; o[3 * RDV] = a3;
        }
        for (int it = bid; it < DB * RH; it += G) {
            const int h = it & 3, b = it >> 2; const float lg = lg_gamma(h);
            const float* s0 = state_ret + (size_t)it * RDK * RDV;
            LAS float* inner = lds;
            LAS float* qk = lds + 16;
            __syncthreads();
            for (int i = tid; i < 1024; i += NTHREADS) { const int which = i >> 9, ti = (i >> 7) & 3, d = i & 127; const size_t row = (size_t)NP + b * DS + ti;
                qk[i] = which ? RK[row * 512 + h * RDK + d] : RQ[row * 512 + h * RDK + d]; }
            __syncthreads();
            for (int pr = wave; pr < 16; pr += NWAVES) { const int i = pr >> 2, j = pr & 3;
                float s = qk[i * 128 + lane] * qk[512 + j * 128 + lane] + qk[i * 128 + 64 + lane] * qk[512 + j * 128 + 64 + lane];
                s = wave_sum(s);
                if (lane == 0) inner[pr] = (j <= i) ? s * expf((float)(i - j) * lg) : 0.f; }
            __syncthreads();
            {
                const int e = tid & 255, i0 = (tid >> 8) * 2;
                float o0 = 0.f, o1 = 0.f;
                for (int d = 0; d < RDK; ++d) { const float sv = s0[(size_t)d * RDV + e]; o0 += qk[i0 * 128 + d] * sv; o1 += qk[(i0 + 1) * 128 + d] * sv; }
                o0 *= expf((float)(i0 + 1) * lg); o1 *= expf((float)(i0 + 2) * lg);
#pragma unroll
                for (int j = 0; j < DS; ++j) { const float v = Z[((size_t)NP + b * DS + j) * ZLD + C_RV + h * RDV + e]; o0 += inner[i0 * 4 + j] * v; o1 += inner[(i0 + 1) * 4 + j] * v; }
                ORET[((size_t)NP + b * DS + i0) * 1024 + h * RDV + e] = o0; ORET[((size_t)NP + b * DS + i0 + 1) * 1024 + h * RDV + e] = o1;
            }
            {
                const float g4 = expf(4.f * lg);
                float* so = out + O_RETS + (size_t)it * RDK * RDV;
                for (int i = tid; i < RDK * RDV; i += NTHREADS) { const int d = i >> 8, e = i & 255; float a = s0[i] * g4;
#pragma unroll
                    for (int j = 0; j < DS; ++j) a += expf((float)(3 - j) * lg) * qk[512 + j * 128 + d] * Z[((size_t)NP + b * DS + j) * ZLD + C_RV + h * RDV + e];
                    so[i] = a; }
            }
        }
        for (int it = bid; it < (NP / 8) * XH; it += G) {
            const int h = it & 3, r8 = it >> 2; const size_t row = (size_t)r8 * 8 + wave; const int b = (int)(row >> 11);
            KvMem kv{out + O_MKP, out + O_MVP, b, h};
            attn_naive<64, 64, false, 0>(lds, kv, NMEM, QPtr{Z + row * ZLD + C_XQ + h * XHD}, true, NMEM, 0.125f, 0.f, 0, OX + row * 256 + h * XHD);
        }
        for (int it = bid; it < DB * XH; it += G) {
            const int h = it & 3, b = it >> 2; const size_t row = (size_t)NP + b * DS + (wave & 3);
            KvMem kv{cache_mem_k, cache_mem_v, b, h};
            attn_naive<64, 64, false, 0>(lds, kv, NMEM, QPtr{Z + row * ZLD + C_XQ + h * XHD}, wave < 4, NMEM, 0.125f, 0.f, 0, OX + row * 256 + h * XHD);
        }
    }
    SEAM(5);
    if (IN(6)) {
        for (int h = 0; h < MH; ++h)
            sgemm_naive(lds, OLAT + h * KVL, MH * KVL, w_uv + (size_t)h * KVL * DVH, DVH, 1, nullptr, 1024, NT, DVH, KVL, bid, G, OMLAb + h * DVH);
        for (size_t i = (size_t)bid * NTHREADS + tid; i < (size_t)NT * 256; i += (size_t)G * NTHREADS) OXb[i] = f2bf(OX[i]);
        for (int row = gw; row < NT; row += NGW) {
#pragma unroll
            for (int h = 0; h < RH; ++h) {
                float v[4]; float s = 0.f;
#pragma unroll
                for (int c = 0; c < 4; ++c) { v[c] = ORET[(size_t)row * 1024 + h * RDV + lane + 64 * c]; s += v[c] * v[c]; }
                const float r = rsqrtf(wave_sum(s) * (1.f / RDV) + EPS);
#pragma unroll
                for (int c = 0; c < 4; ++c) ORETNb[(size_t)row * 1024 + h * RDV + lane + 64 * c] = f2bf(siluf_(Z[(size_t)row * ZLD + C_RG + h * RDV + lane + 64 * c]) * v[c] * r);
            }
        }
    }
    SEAM(6);
    if (IN(7)) {
        pg8::StaticOrder S; S.init(NT, 1024, G, bid);
        { pg8::Gemm g{ORETNb, WroT, NT, 1024, 1024, 1024, 1024}; pg8::EpiF32S E{ARET, 1024, 0, 0}; GEMM_PHASE(pg8::EpiF32S, ldsb, g, S, E); }
        __syncthreads();
        { pg8::Gemm g{OMLAb, WmoT, NT, 1024, 1024, 1024, 1024}; pg8::EpiF32S E{AMLA, 1024, 0, 0}; GEMM_PHASE(pg8::EpiF32S, ldsb, g, S, E); }
        __syncthreads();
        { pg8::Gemm g{OXb, WxoT, NT, 1024, 256, 256, 256}; pg8::EpiF32S E{AX, 1024, 0, 0}; GEMM_PHASE(pg8::EpiF32S, ldsb, g, S, E); }
    }
    SEAM(7);
    if (IN(8)) {
        for (size_t i = (size_t)bid * NTHREADS + tid; i < (size_t)NT * DM; i += (size_t)G * NTHREADS) {
            const size_t row = i >> 10; const int c = (int)(i & 1023); const float* z = Z + row * ZLD + C_G;
            MIXb[i] = f2bf(sigmoidf_(z[c]) * ARET[i] + sigmoidf_(z[1024 + c]) * AMLA[i] + sigmoidf_(z[2048 + c]) * AX[i]);
        }
    }
    SEAM(8);
    if (IN(9)) { pg8::Gemm g{MIXb, WoT, NT, 1024, 1024, 1024, 1024}; pg8::StaticOrder S; S.init(NT, 1024, G, bid); pg8::EpiF32S E{HP, 1024, 0, 0};
        GEMM_PHASE(pg8::EpiF32S, ldsb, g, S, E); }
    SEAM(9);
    if (IN(10)) {
        for (int row = gw; row < NT; row += NGW) {
            const float* xr = row < NP ? x_prompt + (size_t)row * DM : x_sample + (size_t)(row - NP) * DM;
            float v[16]; float s = 0.f;
#pragma unroll
            for (int c = 0; c < 16; ++c) { v[c] = HP[(size_t)row * DM + lane + 64 * c]; s += v[c] * v[c]; }
            float r = rsqrtf(wave_sum(s) * (1.f / DM) + EPS); s = 0.f;
#pragma unroll
            for (int c = 0; c < 16; ++c) { v[c] = xr[lane + 64 * c] + v[c] * r * g_mix_post[lane + 64 * c]; H[(size_t)row * DM + lane + 64 * c] = v[c]; s += v[c] * v[c]; }
            r = rsqrtf(wave_sum(s) * (1.f / DM) + EPS);
#pragma unroll
            for (int c = 0; c < 16; ++c) Fb[(size_t)row * DM + lane + 64 * c] = f2bf(v[c] * r * g_ffn_pre[lane + 64 * c]);
        }
    }
    SEAM(10);
    if (IN(11)) {
        pg8::Gemm g{Fb, WguT, NT, 2 * DFF, 1024, 1024, 1024}; pg8::StaticOrder S; S.init(NT, 2 * DFF, G, bid); pg8::EpiF32S E{GU, 2 * DFF, 0, 0};
        GEMM_PHASE(pg8::EpiF32S, ldsb, g, S, E);
    }
    SEAM(11);
    if (IN(12)) {
        for (size_t i = (size_t)bid * NTHREADS + tid; i < (size_t)NT * DFF; i += (size_t)G * NTHREADS) { const size_t row = i / DFF; const int c = (int)(i - row * DFF); ACTb[i] = f2bf(siluf_(GU[row * (2 * DFF) + c]) * GU[row * (2 * DFF) + DFF + c]); }
    }
    SEAM(12);
    if (IN(13)) { pg8::Gemm g{ACTb, WdT, NT, 1024, DFF, DFF, DFF}; pg8::StaticOrder S; S.init(NT, 1024, G, bid); pg8::EpiF32S E{FO, 1024, 0, 0};
        GEMM_PHASE(pg8::EpiF32S, ldsb, g, S, E); }
    SEAM(13);
    if (IN(14)) {
        for (int row = gw; row < NT; row += NGW) {
            float v[16]; float s = 0.f;
#pragma unroll
            for (int c = 0; c < 16; ++c) { v[c] = FO[(size_t)row * DM + lane + 64 * c]; s += v[c] * v[c]; }
            const float r = rsqrtf(wave_sum(s) * (1.f / DM) + EPS);
            float* y = row < NP ? out + O_YP + (size_t)row * DM : out + O_YS + (size_t)(row - NP) * DM;
#pragma unroll
            for (int c = 0; c < 16; ++c) y[lane + 64 * c] = H[(size_t)row * DM + lane + 64 * c] + v[c] * r * g_ffn_post[lane + 64 * c];
        }
    }
#undef IN
#undef SEAM
}
constexpr int N_PHASES = 15;
}

extern "C" void kernel_launch(void* const* d_in, const int* in_sizes, int n_in, void* d_out, int out_size, void* d_ws, size_t ws_size, hipStream_t stream) {
    static int grid = 0;
    if (grid == 0) {
        if (n_in != 29 || (size_t)out_size != O_END || ws_size < WS_END) { fprintf(stderr, "kernel_launch: unexpected shapes: n_in %d out %d ws %zu (need %zu)\n", n_in, out_size, ws_size, (size_t)WS_END); grid = -1; return; }
        int dev = 0, cus = 0, per_cu = 0;
        if (hipGetDevice(&dev) != hipSuccess || hipDeviceGetAttribute(&cus, hipDeviceAttributeMultiprocessorCount, dev) != hipSuccess) { grid = -1; return; }
        if (hipFuncSetAttribute((const void*)fwd_kernel, hipFuncAttributeMaxDynamicSharedMemorySize, LDS_BYTES) != hipSuccess) { fprintf(stderr, "kernel_launch: hipFuncSetAttribute failed\n"); grid = -1; return; }
        if (hipOccupancyMaxActiveBlocksPerMultiprocessor(&per_cu, (const void*)fwd_kernel, NTHREADS, LDS_BYTES) != hipSuccess || per_cu < 1) { fprintf(stderr, "kernel_launch: occupancy query says %d\n", per_cu); per_cu = 1; }
        (void)hipGetLastError();
        grid = cus;
    }
    if (grid < 0) return;
    (void)hipMemsetAsync((char*)d_ws + WS_CTL, 0, CTL_BYTES, stream);
    Args a{};
    for (int i = 0; i < 29; ++i) a.in[i] = (const float*)d_in[i];
    a.out = (float*)d_out; a.ws = (unsigned char*)d_ws;
#if MK_ONE_LAUNCH
    a.ph_lo = 0; a.ph_hi = N_PHASES;
    hipLaunchKernelGGL(fwd_kernel, dim3(grid), dim3(NTHREADS), LDS_BYTES, stream, a);
#else
    for (int p = 0; p < N_PHASES; ++p) { a.ph_lo = p; a.ph_hi = p + 1; hipLaunchKernelGGL(fwd_kernel, dim3(grid), dim3(NTHREADS), LDS_BYTES, stream, a); }
#endif
}
```

```cpp
#include <hip/hip_runtime.h>
#include <cstdio>
#include <cstdint>

#ifndef MK_ONE_LAUNCH
#define MK_ONE_LAUNCH 1
#endif

#define LAS __attribute__((address_space(3)))
#define GAS __attribute__((address_space(1)))
#define DI __device__ __forceinline__
typedef float f32x4 __attribute__((ext_vector_type(4)));

namespace {
constexpr int DM = 1024, NB = 8, SEQ = 2048, NP = NB * SEQ, DB = 128, DS = 4, NS = DB * DS, NT = NP + NS;
constexpr int PAST = 8192, PAGE = 128, NPAGES = PAST / PAGE;
constexpr int RH = 4, RDK = 128, RDV = 256;
constexpr int MH = 8, QL = 384, KVL = 256, DNOPE = 128, DROPE = 64, DVH = 128, DQH = DNOPE + DROPE;
constexpr int NMEM = 256, XH = 4, XHD = 64;
constexpr int DFF = 2816, DIN = 7104, ZLD = 7168;
constexpr int C_RQ = 0, C_RK = 512, C_RV = 1024, C_RG = 2048, C_CQ = 3072, C_CKV = 3456, C_KPE = 3712, C_XQ = 3776, C_G = 4032;
constexpr float EPS = 1e-6f;
constexpr int NPOS = SEQ + DS;
constexpr int NTHREADS = 512, NWAVES = 8;
constexpr int LDS_BYTES = 147456;
constexpr int MISC_OFF = 147456 - 256;

constexpr size_t O_YP = 0, O_YS = O_YP + (size_t)NP * DM, O_CKVP = O_YS + (size_t)NS * DM, O_KPEP = O_CKVP + (size_t)NP * KVL,
                 O_CKVS = O_KPEP + (size_t)NP * DROPE, O_KPES = O_CKVS + (size_t)NS * KVL, O_RETP = O_KPES + (size_t)NS * DROPE,
                 O_RETS = O_RETP + (size_t)NB * RH * RDK * RDV, O_MKP = O_RETS + (size_t)DB * RH * RDK * RDV, O_MVP = O_MKP + (size_t)NB * NMEM * 256,
                 O_END = O_MVP + (size_t)NB * NMEM * 256;

constexpr size_t al256(size_t x) { return (x + 255) & ~(size_t)255; }
constexpr size_t WS_CTL = 0, CTL_BYTES = 1u << 20;
constexpr size_t WS_COSA = WS_CTL + CTL_BYTES;
constexpr size_t WS_SINA = WS_COSA + al256((size_t)NPOS * 64 * 4);
constexpr size_t WS_COSB = WS_SINA + al256((size_t)NPOS * 64 * 4);
constexpr size_t WS_SINB = WS_COSB + al256((size_t)NPOS * 32 * 4);
constexpr size_t WS_U = WS_SINB + al256((size_t)NPOS * 32 * 4);
constexpr size_t WS_MN = WS_U + (size_t)NT * DM * 4;
constexpr size_t WS_Z = WS_MN + (size_t)NB * NMEM * DM * 4;
constexpr size_t WS_RQ = WS_Z + (size_t)NT * ZLD * 4;
constexpr size_t WS_RK = WS_RQ + (size_t)NT * 512 * 4;
constexpr size_t WS_CQN = WS_RK + (size_t)NT * 512 * 4;
constexpr size_t WS_CKVN = WS_CQN + (size_t)NT * QL * 4;
constexpr size_t WS_KPER = WS_CKVN + (size_t)NT * KVL * 4;
constexpr size_t WS_Q = WS_KPER + (size_t)NT * DROPE * 4;
constexpr size_t WS_QLAT = WS_Q + (size_t)NT * 1536 * 4;
constexpr size_t WS_QPE = WS_QLAT + (size_t)NT * 2048 * 4;
constexpr size_t WS_ORET = WS_QPE + (size_t)NT * 512 * 4;
constexpr size_t WS_OLAT = WS_ORET + (size_t)NT * 1024 * 4;
constexpr size_t WS_OX = WS_OLAT + (size_t)NT * 2048 * 4;
constexpr size_t WS_OMLA = WS_OX + (size_t)NT * 256 * 4;
constexpr size_t WS_ORETN = WS_OMLA + (size_t)NT * 1024 * 4;
constexpr size_t WS_ARET = WS_ORETN + (size_t)NT * 1024 * 4;
constexpr size_t WS_AMLA = WS_ARET + (size_t)NT * 1024 * 4;
constexpr size_t WS_AX = WS_AMLA + (size_t)NT * 1024 * 4;
constexpr size_t WS_MIX = WS_AX + (size_t)NT * 1024 * 4;
constexpr size_t WS_HP = WS_MIX + (size_t)NT * 1024 * 4;
constexpr size_t WS_H = WS_HP + (size_t)NT * 1024 * 4;
constexpr size_t WS_F = WS_H + (size_t)NT * 1024 * 4;
constexpr size_t WS_GG = WS_F + (size_t)NT * 1024 * 4;
constexpr size_t WS_UP = WS_GG + (size_t)NT * DFF * 4;
constexpr size_t WS_ACT = WS_UP + (size_t)NT * DFF * 4;
constexpr size_t WS_FO = WS_ACT + (size_t)NT * DFF * 4;
constexpr size_t WS_F32_END = WS_FO + (size_t)NT * 1024 * 4;
constexpr size_t WS_WIN_T = al256(WS_F32_END);
constexpr size_t WS_WMKV_T = WS_WIN_T + (size_t)ZLD * 1024 * 2;
constexpr size_t WS_WUQ_T = WS_WMKV_T + (size_t)512 * 1024 * 2;
constexpr size_t WS_WRO_T = WS_WUQ_T + (size_t)1536 * 384 * 2;
constexpr size_t WS_WMO_T = WS_WRO_T + (size_t)1024 * 1024 * 2;
constexpr size_t WS_WXO_T = WS_WMO_T + (size_t)1024 * 1024 * 2;
constexpr size_t WS_WO_T = WS_WXO_T + (size_t)1024 * 256 * 2;
constexpr size_t WS_WGU_T = WS_WO_T + (size_t)1024 * 1024 * 2;
constexpr size_t WS_WD_T = WS_WGU_T + (size_t)5632 * 1024 * 2;
constexpr size_t WS_UB = WS_WD_T + (size_t)1024 * 2816 * 2;
constexpr size_t WS_MNB = WS_UB + (size_t)NT * 1024 * 2;
constexpr size_t WS_CQNB = WS_MNB + (size_t)2048 * 1024 * 2;
constexpr size_t WS_ORETNB = WS_CQNB + (size_t)NT * 384 * 2;
constexpr size_t WS_OMLAB = WS_ORETNB + (size_t)NT * 1024 * 2;
constexpr size_t WS_OXB = WS_OMLAB + (size_t)NT * 1024 * 2;
constexpr size_t WS_MIXB = WS_OXB + (size_t)NT * 256 * 2;
constexpr size_t WS_FB = WS_MIXB + (size_t)NT * 1024 * 2;
constexpr size_t WS_ACTB = WS_FB + (size_t)NT * 1024 * 2;
constexpr size_t WS_WUK_T = WS_ACTB + (size_t)NT * 2816 * 2;
constexpr size_t WS_WUV_T = WS_WUK_T + (size_t)1024 * 256 * 2;
constexpr size_t WS_CKVNB = WS_WUV_T + (size_t)1024 * 256 * 2;
constexpr size_t WS_KPERB = WS_CKVNB + (size_t)NT * 256 * 2;
constexpr size_t WS_XQB = WS_KPERB + (size_t)NT * 64 * 2;
constexpr size_t WS_MKB = WS_XQB + (size_t)NT * 256 * 2;
constexpr size_t WS_MVT = WS_MKB + (size_t)2048 * 256 * 2;
constexpr size_t WS_KN = WS_MVT + (size_t)2048 * 256 * 2;
constexpr size_t WS_VT = WS_KN + (size_t)NP * 1024 * 2;
constexpr size_t WS_QB = WS_VT + (size_t)NP * 1024 * 2;
constexpr size_t WS_END = WS_QB + (size_t)NT * 1536 * 2;

constexpr int CW_BAR = 4096;

#define XB_TMO      128
#define XB_XCNT(j)  (256  + 64 * (j))
#define XB_XSUB(j)  (1280 + 64 * (j))
#define XB_XGEN(j)  (2304 + 64 * (j))
#define XB_TOP      3328
#define XB_TOPGEN   3392
#define XCD_BAR_WORDS 3456
#define XB_SPIN_CAP (1u << 25)

DI unsigned xb_ld(unsigned* p)              { return __hip_atomic_load(p, __ATOMIC_RELAXED, __HIP_MEMORY_SCOPE_AGENT); }
DI unsigned xb_add(unsigned* p, unsigned v) { return __hip_atomic_fetch_add(p, v, __ATOMIC_RELAXED, __HIP_MEMORY_SCOPE_AGENT); }
DI unsigned xb_xcc_id() { return (unsigned)__builtin_amdgcn_s_getreg((3 << 11) | 20) & 0xFu; }
#define XB_SPIN(cond, bar) do { unsigned _sp = 0; while (cond) { __builtin_amdgcn_s_sleep(1); \
    if ((++_sp & 255u) == 0u) { if (xb_ld(&(bar)[XB_TMO])) break; if (_sp > XB_SPIN_CAP) { atomicAdd(&(bar)[XB_TMO], 1u); break; } } } } while (0)

struct XcdBarrier { unsigned* bar; unsigned x; volatile LAS unsigned* st; };

DI XcdBarrier xcd_barrier_post(unsigned* bar, volatile LAS unsigned* st) {
    XcdBarrier b; b.bar = bar; b.x = xb_xcc_id(); b.st = st;
    if (threadIdx.x == 0) (void)xb_add(&bar[XB_XCNT(b.x)], 1u);
    return b;
}
DI void xcd_barrier_complete(unsigned* bar, unsigned x, unsigned& nloc, unsigned& nx) {
    const unsigned G = gridDim.x * gridDim.y * gridDim.z;
    unsigned sum, cnt, mine, sp = 0u;
    for (;;) {
        sum = 0u; cnt = 0u; mine = 0u;
#pragma unroll
        for (unsigned j = 0; j < 16; ++j) { const unsigned c = xb_ld(&bar[XB_XCNT(j)]); sum += c; cnt += (c > 0u) ? 1u : 0u; mine = (j == x) ? c : mine; }
        if (sum == G) break;
        __builtin_amdgcn_s_sleep(1);
        if ((++sp & 255u) == 0u) { if (xb_ld(&bar[XB_TMO])) break; if (sp > XB_SPIN_CAP) { atomicAdd(&bar[XB_TMO], 1u); break; } }
    }
    nloc = mine > 0u ? mine : 1u; nx = cnt > 0u ? cnt : 1u;
}
DI void xcd_barrier(const XcdBarrier& b) {
    asm volatile("s_waitcnt vmcnt(0)" ::: "memory");
    __syncthreads();
    if (threadIdx.x == 0) {
        unsigned* bar = b.bar;
        __builtin_amdgcn_s_waitcnt(0);
        unsigned nloc = b.st[0], nx = b.st[1];
        if (nloc == 0u) { xcd_barrier_complete(bar, b.x, nloc, nx); b.st[0] = nloc; b.st[1] = nx; }
        const unsigned old = xb_add(&bar[XB_XSUB(b.x)], 1u);
        const unsigned gen = old / nloc;
        if (old + 1u == (gen + 1u) * nloc) {
            __builtin_amdgcn_fence(__ATOMIC_RELEASE, "agent");
            asm volatile("s_waitcnt vmcnt(0)" ::: "memory");
            const unsigned og = xb_add(&bar[XB_TOP], 1u);
            const unsigned tg = og / nx;
            if (og + 1u == (tg + 1u) * nx) xb_add(&bar[XB_TOPGEN], 1u);
            else XB_SPIN(xb_ld(&bar[XB_TOPGEN]) == tg, bar);
            __builtin_amdgcn_fence(__ATOMIC_ACQUIRE, "agent");
            xb_add(&bar[XB_XGEN(b.x)], 1u);
            asm volatile("s_waitcnt vmcnt(0)" ::: "memory");
        } else {
            XB_SPIN(xb_ld(&bar[XB_XGEN(b.x)]) == gen, bar);
            __builtin_amdgcn_fence(__ATOMIC_ACQUIRE, "agent");
            asm volatile("s_waitcnt vmcnt(0)" ::: "memory");
        }
    }
    __syncthreads();
}

DI float wave_sum(float v) {
#pragma unroll
    for (int o = 1; o < 64; o <<= 1) v += __shfl_xor(v, o);
    return v;
}
DI float wave_max(float v) {
#pragma unroll
    for (int o = 1; o < 64; o <<= 1) v = fmaxf(v, __shfl_xor(v, o));
    return v;
}
DI float sigmoidf_(float x) { return 1.f / (1.f + expf(-x)); }
DI float siluf_(float x) { return x / (1.f + expf(-x)); }
DI int pos_index(int row) { return row < NP ? (row & (SEQ - 1)) : SEQ + ((row - NP) & (DS - 1)); }
DI float lg_gamma(int h) { return log1pf(-exp2f(-5.0f - (float)h)); }


namespace pg8 {
typedef unsigned short bf16_t;
typedef short bf16x8 __attribute__((ext_vector_type(8)));
typedef unsigned u32x4 __attribute__((ext_vector_type(4)));
typedef unsigned u32x2 __attribute__((ext_vector_type(2)));
constexpr int BM = 256, BK = 64, HALF = 128, HTB = HALF * BK * 2, STAGE_BYTES = 8 * HTB, NXCD = 8, WGM = 8;
__host__ __device__ __forceinline__ int lds_byte(int r, int c) { const int st = (r >> 4) * 2 + (c >> 5), rr = r & 15, cc = c & 31, ob = rr * 64 + cc * 2; return st * 1024 + (ob ^ (((ob >> 9) & 1) << 5)); }
__host__ __device__ __forceinline__ void stage_rc(int b, int& R, int& C) { const int st = b / 1024, sb = b % 1024, swz = sb ^ (((sb >> 9) & 1) << 5); R = (st >> 1) * 16 + swz / 64; C = (st & 1) * 32 + (swz % 64) / 2; }
__host__ __device__ __forceinline__ int perm32(int rho) { const int n = rho >> 4, i = rho & 15; return 8 * (i >> 2) + 4 * n + (i & 3); }
struct Unit { int pm, pn; };
struct Gemm { const bf16_t* A; const bf16_t* Bt; int M, N, K, lda, ldb; };
struct StaticOrder {
    int nM, nN, nwg, G, c;
    __host__ __device__ void init(int M, int N, int G_, int c_) { nM = M / BM; nN = N / BM; nwg = nM * nN; G = G_; c = c_; }
    __host__ __device__ bool next(int i, Unit& u) const {
        const long L = (long)i * G + c; if (L >= nwg) return false;
        int wgid = (int)L; { const int q = nwg / NXCD, r = nwg % NXCD, xcd = wgid % NXCD, off = wgid / NXCD; wgid = (xcd < r ? xcd * (q + 1) : r * (q + 1) + (xcd - r) * q) + off; }
        const int nig = WGM * nN, gid = wgid / nig, fm = gid * WGM, gsz = (nM - fm) < WGM ? (nM - fm) : WGM;
        u.pm = fm + ((wgid % nig) % gsz); u.pn = (wgid % nig) / gsz; return true;
    }
    __device__ __forceinline__ void a_ready(const Unit&) const {}
    __device__ __forceinline__ void done(const Unit&) const {}
};
__device__ __forceinline__ unsigned cvt_pk_bf16(float lo, float hi) { unsigned r; asm volatile("v_cvt_pk_bf16_f32 %0, %1, %2" : "=v"(r) : "v"(lo), "v"(hi)); return r; }
struct EpiF32S {
    static constexpr bool PERM = false, AFTER_DRAIN = false;
    float* C; int ldc; int split_tiles; size_t split_stride;
    __device__ __forceinline__ void operator()(const f32x4 (&acc)[2][2][4][2], const Unit& u, int wr, int wc, int fr, int fq) const {
        int pn = u.pn; float* base = C; if (split_tiles) { const int t = pn / split_tiles; base += (size_t)t * split_stride; pn -= t * split_tiles; }
        const int row0 = u.pm * BM + wr * 64 + fr, col0 = pn * BM + wc * 32 + 4 * fq;
#pragma unroll
        for (int ai = 0; ai < 2; ++ai)
#pragma unroll
            for (int m = 0; m < 4; ++m) { float* rowp = base + (size_t)(row0 + ai * HALF + m * 16) * ldc + col0;
#pragma unroll
                for (int bj = 0; bj < 2; ++bj)
#pragma unroll
                    for (int n = 0; n < 2; ++n) *(f32x4*)(rowp + bj * HALF + n * 16) = acc[ai][bj][m][n]; }
    }
};
struct EpiBf16S {
    static constexpr bool PERM = true, AFTER_DRAIN = false;
    bf16_t* O; int ldc;
    __device__ __forceinline__ void operator()(const f32x4 (&acc)[2][2][4][2], const Unit& u, int wr, int wc, int fr, int fq) const {
        const int row0 = u.pm * BM + wr * 64 + fr, col0 = u.pn * BM + wc * 32 + 8 * fq;
#pragma unroll
        for (int ai = 0; ai < 2; ++ai)
#pragma unroll
            for (int m = 0; m < 4; ++m) { bf16_t* rowp = O + (size_t)(row0 + ai * HALF + m * 16) * ldc + col0;
#pragma unroll
                for (int bj = 0; bj < 2; ++bj) { const f32x4 v0 = acc[ai][bj][m][0], v1 = acc[ai][bj][m][1];
                    u32x4 w; w.x = cvt_pk_bf16(v0[0], v0[1]); w.y = cvt_pk_bf16(v0[2], v0[3]); w.z = cvt_pk_bf16(v1[0], v1[1]); w.w = cvt_pk_bf16(v1[2], v1[3]);
                    *(u32x4*)(rowp + bj * HALF) = w; } }
    }
};
template <class Epi, class Sched, bool ALIGN_EPI = false, bool SP2 = false>
__device__ __forceinline__ void gemm_phase(LAS unsigned char* lds, const Gemm g, const Sched& S, const Epi& E) {
    const int tid = threadIdx.x, wid = __builtin_amdgcn_readfirstlane(tid >> 6), lane = tid & 63, wr = wid >> 2, wc = wid & 3, fr = lane & 15, fq = lane >> 4;
    const int K = g.K, nt = K / BK;
    unsigned voffA[2], voffB[2];
#pragma unroll
    for (int i = 0; i < 2; ++i) { int R, C; stage_rc(tid * 16 + i * 8192, R, C); const int Rb = Epi::PERM ? ((R & ~31) + perm32(R & 31)) : R;
        voffA[i] = (unsigned)(R * g.lda + C) * 2u; voffB[i] = (unsigned)(Rb * g.ldb + C) * 2u; }
    const size_t kstep = (size_t)(BK * 2);
    const size_t hstepA = (size_t)HALF * g.lda * 2, hstepB = (size_t)HALF * g.ldb * 2;
    const size_t tstepA = 2 * hstepA, tstepB = 2 * hstepB;
    const unsigned ldsw = (unsigned)wid * 1024u;
    const int aoff = lds_byte(wr * 64 + fr, fq * 8), boff = lds_byte(wc * 32 + fr, fq * 8);
#define PG8_SA(b, h) (((b) * 2 + (h)) * HTB)
#define PG8_SB(b, h) ((4 + (b) * 2 + (h)) * HTB)
#define PG8_STAGE(bufoff, gbase, voff) do { _Pragma("unroll") for (int _i = 0; _i < 2; ++_i) \
        __builtin_amdgcn_global_load_lds((const unsigned*)((const char*)(gbase) + (voff)[_i]), (LAS unsigned*)(lds + (bufoff) + ldsw + _i * 8192), 16, 0, 0); } while (0)
#define PG8_LDA(dst, b, h) do { _Pragma("unroll") for (int m = 0; m < 4; ++m) _Pragma("unroll") for (int k = 0; k < 2; ++k) dst[m][k] = *(const LAS bf16x8*)(lds + PG8_SA(b, h) + aoff + m * 2048 + k * 1024); } while (0)
#define PG8_LDB(dst, b, h) do { _Pragma("unroll") for (int n = 0; n < 2; ++n) _Pragma("unroll") for (int k = 0; k < 2; ++k) dst[n][k] = *(const LAS bf16x8*)(lds + PG8_SB(b, h) + boff + n * 2048 + k * 1024); } while (0)
#define PG8_MMA(ai, bj, At, Bt) do { __builtin_amdgcn_s_setprio(1); _Pragma("unroll") for (int m = 0; m < 4; ++m) _Pragma("unroll") for (int n = 0; n < 2; ++n) _Pragma("unroll") for (int k = 0; k < 2; ++k) \
        acc[ai][bj][m][n] = __builtin_amdgcn_mfma_f32_16x16x32_bf16(Bt[n][k], At[m][k], acc[ai][bj][m][n], 0, 0, 0); __builtin_amdgcn_s_setprio(0); } while (0)
#define PG8_WAIT_V(n) asm volatile("s_waitcnt vmcnt(" #n ")" ::: "memory")
#define PG8_WAIT_L(n) asm volatile("s_waitcnt lgkmcnt(" #n ")" ::: "memory")
#define PG8_BAR __builtin_amdgcn_s_barrier()
#define PG8_SCHED __builtin_amdgcn_sched_barrier(0)
    Unit cur, nxt; int ui = 0;
    if (!S.next(0, cur)) return;
    f32x4 acc[2][2][4][2];
#pragma unroll
    for (int a = 0; a < 2; ++a)
#pragma unroll
        for (int b = 0; b < 2; ++b)
#pragma unroll
            for (int m = 0; m < 4; ++m)
#pragma unroll
                for (int n = 0; n < 2; ++n) acc[a][b][m][n] = (f32x4){0.f, 0.f, 0.f, 0.f};
    bf16x8 At[4][2], B0[2][2], B1[2][2];
    const char* cA = (const char*)g.A + (size_t)cur.pm * tstepA; const char* cB = (const char*)g.Bt + (size_t)cur.pn * tstepB;
    S.a_ready(cur);
    if constexpr (SP2) {
        PG8_STAGE(PG8_SB(0, 0), cB, voffB); PG8_STAGE(PG8_SB(0, 1), cB + hstepB, voffB); PG8_STAGE(PG8_SA(0, 0), cA, voffA); PG8_STAGE(PG8_SA(0, 1), cA + hstepA, voffA);
        if (wr == 1) PG8_BAR;
        PG8_WAIT_V(2); PG8_BAR;
        PG8_STAGE(PG8_SB(1, 0), cB + kstep, voffB); PG8_STAGE(PG8_SA(1, 0), cA + kstep, voffA); PG8_STAGE(PG8_SB(1, 1), cB + hstepB + kstep, voffB);
        PG8_WAIT_V(6); PG8_BAR;
    } else {
        PG8_STAGE(PG8_SB(0, 0), cB, voffB); PG8_STAGE(PG8_SA(0, 0), cA, voffA); PG8_STAGE(PG8_SB(0, 1), cB + hstepB, voffB); PG8_STAGE(PG8_SA(0, 1), cA + hstepA, voffA);
        if (wr == 1) PG8_BAR;
        PG8_WAIT_V(4); PG8_BAR;
        PG8_STAGE(PG8_SB(1, 0), cB + kstep, voffB); PG8_STAGE(PG8_SA(1, 0), cA + kstep, voffA); PG8_STAGE(PG8_SB(1, 1), cB + hstepB + kstep, voffB);
        PG8_WAIT_V(6); PG8_BAR;
    }
    for (;;) {
        const bool has_next = S.next(ui + 1, nxt);
        const char* nA = has_next ? (const char*)g.A + (size_t)nxt.pm * tstepA : cA; const char* nB = has_next ? (const char*)g.Bt + (size_t)nxt.pn * tstepB : cB;
#pragma unroll 1
        for (int t = 0; t < nt; t += 2) {
            const bool last = (t == nt - 2);
            const char* a1 = cA + (size_t)(t + 1) * kstep;
            const char* a2 = last ? nA : cA + (size_t)(t + 2) * kstep; const char* b2 = last ? nB : cB + (size_t)(t + 2) * kstep;
            const char* a3 = a2 + kstep; const char* b3 = b2 + kstep;
            if (last && has_next) S.a_ready(nxt);
            if constexpr (SP2) {
            PG8_LDB(B0, 0, 0); PG8_LDB(B1, 0, 1); PG8_SCHED; PG8_LDA(At, 0, 0); PG8_STAGE(PG8_SA(1, 1), a1 + hstepA, voffA);
            PG8_WAIT_V(8); PG8_WAIT_L(0); PG8_BAR; PG8_MMA(0, 0, At, B0); PG8_MMA(0, 1, At, B1); PG8_BAR; PG8_SCHED;
            PG8_LDA(At, 0, 1); PG8_STAGE(PG8_SB(0, 0), b2, voffB); PG8_STAGE(PG8_SB(0, 1), b2 + hstepB, voffB); PG8_STAGE(PG8_SA(0, 0), a2, voffA);
            PG8_WAIT_V(8); PG8_WAIT_L(0); PG8_BAR; PG8_MMA(1, 0, At, B0); PG8_MMA(1, 1, At, B1); PG8_BAR; PG8_SCHED;
            PG8_LDB(B0, 1, 0); PG8_LDB(B1, 1, 1); PG8_SCHED; PG8_LDA(At, 1, 0); PG8_STAGE(PG8_SA(0, 1), a2 + hstepA, voffA);
            PG8_WAIT_V(8); PG8_WAIT_L(0); PG8_BAR; PG8_MMA(0, 0, At, B0); PG8_MMA(0, 1, At, B1); PG8_BAR; PG8_SCHED;
            PG8_LDA(At, 1, 1); PG8_STAGE(PG8_SB(1, 0), b3, voffB); PG8_STAGE(PG8_SB(1, 1), b3 + hstepB, voffB); PG8_STAGE(PG8_SA(1, 0), a3, voffA);
            PG8_WAIT_V(8); PG8_WAIT_L(0); PG8_BAR; PG8_MMA(1, 0, At, B0); PG8_MMA(1, 1, At, B1); PG8_BAR; PG8_SCHED;
            } else {
            PG8_LDB(B0, 0, 0); PG8_SCHED; PG8_LDA(At, 0, 0); PG8_STAGE(PG8_SA(1, 1), a1 + hstepA, voffA);
            PG8_WAIT_L(8); PG8_BAR; PG8_WAIT_L(0); PG8_MMA(0, 0, At, B0); PG8_BAR; PG8_SCHED;
            PG8_LDB(B1, 0, 1); PG8_STAGE(PG8_SB(0, 0), b2, voffB);
            PG8_BAR; PG8_WAIT_L(0); PG8_MMA(0, 1, At, B1); PG8_BAR;
            PG8_LDA(At, 0, 1); PG8_STAGE(PG8_SA(0, 0), a2, voffA);
            PG8_BAR; PG8_WAIT_L(0); PG8_MMA(1, 0, At, B0); PG8_BAR; PG8_SCHED;
            PG8_STAGE(PG8_SB(0, 1), b2 + hstepB, voffB);
            PG8_WAIT_V(6); PG8_BAR; PG8_MMA(1, 1, At, B1); PG8_BAR;
            PG8_LDB(B0, 1, 0); PG8_SCHED; PG8_LDA(At, 1, 0); PG8_STAGE(PG8_SA(0, 1), a2 + hstepA, voffA);
            PG8_WAIT_L(8); PG8_BAR; PG8_WAIT_L(0); PG8_MMA(0, 0, At, B0); PG8_BAR; PG8_SCHED;
            PG8_LDB(B1, 1, 1); PG8_STAGE(PG8_SB(1, 0), b3, voffB);
            PG8_BAR; PG8_WAIT_L(0); PG8_MMA(0, 1, At, B1); PG8_BAR;
            PG8_LDA(At, 1, 1); PG8_STAGE(PG8_SA(1, 0), a3, voffA);
            PG8_BAR; PG8_WAIT_L(0); PG8_MMA(1, 0, At, B0); PG8_BAR; PG8_SCHED;
            PG8_STAGE(PG8_SB(1, 1), b3 + hstepB, voffB);
            PG8_WAIT_V(6); PG8_BAR; PG8_MMA(1, 1, At, B1); PG8_BAR;
            }
        }
        if constexpr (ALIGN_EPI) { if (wr == 0) PG8_BAR; }
        if constexpr (!Epi::AFTER_DRAIN) { E(acc, cur, wr, wc, fr, fq); S.done(cur); }
        if (!has_next) break;
#pragma unroll
        for (int a = 0; a < 2; ++a)
#pragma unroll
            for (int b = 0; b < 2; ++b)
#pragma unroll
                for (int m = 0; m < 4; ++m)
#pragma unroll
                    for (int n = 0; n < 2; ++n) acc[a][b][m][n] = (f32x4){0.f, 0.f, 0.f, 0.f};
        cur = nxt; cA = nA; cB = nB; ++ui;
        if constexpr (ALIGN_EPI) { if (wr == 1) PG8_BAR; }
    }
    PG8_WAIT_V(0);
    if constexpr (!ALIGN_EPI) { if (wr == 0) PG8_BAR; }
    PG8_BAR;
    if constexpr (Epi::AFTER_DRAIN) { E.fused(acc, cur, wr, wc, fr, fq, lds, wid, lane); S.done(cur); }
#undef PG8_SA
#undef PG8_SB
#undef PG8_STAGE
#undef PG8_LDA
#undef PG8_LDB
#undef PG8_MMA
#undef PG8_WAIT_V
#undef PG8_WAIT_L
#undef PG8_BAR
#undef PG8_SCHED
}
}
typedef unsigned short bf16_t;
DI unsigned pk2(float lo, float hi) { return pg8::cvt_pk_bf16(lo, hi); }
DI bf16_t f2bf(float f) { return (bf16_t)(pg8::cvt_pk_bf16(f, 0.f) & 0xffffu); }
DI void transpose_item(const float* W, int N, bf16_t* WT, int ldt, int row_off, LAS float* scr, int item, int lane) {
    const int nblk = N / 32, kb = item / nblk, nb = item % nblk, k0 = 64 * kb, n0 = 32 * nb;
#pragma unroll 8
    for (int i = 0; i < 32; ++i) { const int kk = 2 * i + (lane >> 5); scr[kk * 33 + (lane & 31)] = W[(size_t)(k0 + kk) * N + n0 + (lane & 31)]; }
    asm volatile("s_waitcnt lgkmcnt(0)" ::: "memory");
    const int c = lane & 7;
#pragma unroll
    for (int j = 0; j < 4; ++j) { const int n = (lane >> 3) + 8 * j; const LAS float* sp = scr + (8 * c) * 33 + n;
        pg8::u32x4 o; o.x = pk2(sp[0 * 33], sp[1 * 33]); o.y = pk2(sp[2 * 33], sp[3 * 33]); o.z = pk2(sp[4 * 33], sp[5 * 33]); o.w = pk2(sp[6 * 33], sp[7 * 33]);
        *(pg8::u32x4*)(WT + (size_t)(row_off + n0 + n) * ldt + k0 + 8 * c) = o; }
    asm volatile("s_waitcnt lgkmcnt(0)" ::: "memory");
}
DI void transpose_w(const float* W, int K, int N, bf16_t* WT, int ldt, int row_off, LAS float* scr, int gw, int NGW, int lane) {
    const int nitems = (K / 64) * (N / 32);
    for (int it = gw; it < nitems; it += NGW) transpose_item(W, N, WT, ldt, row_off, scr, it, lane);
}

struct Args {
    const float* in[29]; float* out; unsigned char* ws; int ph_lo, ph_hi;
};

DI unsigned short f2bf_raw(float f) { unsigned u = __builtin_bit_cast(unsigned, f); return (unsigned short)((u + 0x7fffu + ((u >> 16) & 1u)) >> 16); }
DI void sgemm_naive(LAS float* lds, const float* __restrict__ A, int lda, const float* __restrict__ B, long sbk, long sbn,
                    float* __restrict__ C, int ldc, int M, int N, int K, int bid, int G, unsigned short* Cb = nullptr) {
    LAS float* As = lds;
    LAS float* Bs = lds + 16 * 132;
    const int tid = threadIdx.x, tx = tid & 15, ty = tid >> 4;
    const int ntn = N / 64, ntiles = (M / 128) * ntn;
    for (int t = bid; t < ntiles; t += G) {
        const int m0 = (t / ntn) * 128, n0 = (t % ntn) * 64;
        float acc[4][4];
#pragma unroll
        for (int i = 0; i < 4; ++i)
#pragma unroll
            for (int j = 0; j < 4; ++j) acc[i][j] = 0.f;
        for (int k0 = 0; k0 < K; k0 += 16) {
            {
                const int r = tid >> 2, kq = (tid & 3) * 4;
                const float4 v = *(const float4*)(A + (size_t)(m0 + r) * lda + k0 + kq);
                As[(kq + 0) * 132 + r] = v.x; As[(kq + 1) * 132 + r] = v.y; As[(kq + 2) * 132 + r] = v.z; As[(kq + 3) * 132 + r] = v.w;
            }
#pragma unroll
            for (int i = 0; i < 2; ++i) {
                const int idx = tid + i * 512, kk = idx >> 6, nn = idx & 63;
                Bs[kk * 64 + nn] = B[(size_t)(k0 + kk) * sbk + (size_t)(n0 + nn) * sbn];
            }
            __syncthreads();
#pragma unroll
            for (int kk = 0; kk < 16; ++kk) {
                const f32x4 a = *(const LAS f32x4*)(As + kk * 132 + ty * 4);
                const f32x4 b = *(const LAS f32x4*)(Bs + kk * 64 + tx * 4);
                const float av[4] = {a.x, a.y, a.z, a.w}, bv[4] = {b.x, b.y, b.z, b.w};
#pragma unroll
                for (int i = 0; i < 4; ++i)
#pragma unroll
                    for (int j = 0; j < 4; ++j) acc[i][j] += av[i] * bv[j];
            }
            __syncthreads();
        }
#pragma unroll
        for (int i = 0; i < 4; ++i) {
            float4 o; o.x = acc[i][0]; o.y = acc[i][1]; o.z = acc[i][2]; o.w = acc[i][3];
            if (Cb) { unsigned short* cb = Cb + (size_t)(m0 + ty * 4 + i) * ldc + n0 + tx * 4; cb[0] = f2bf_raw(o.x); cb[1] = f2bf_raw(o.y); cb[2] = f2bf_raw(o.z); cb[3] = f2bf_raw(o.w); }
            else *(float4*)(C + (size_t)(m0 + ty * 4 + i) * ldc + n0 + tx * 4) = o;
        }
    }
}

template <int DQK, int DV, bool V_IN_K, int MODE, class KV, class QF>
DI void attn_naive(LAS float* lds, const KV& kv, int nk_loop, const QF& qf, bool active, int limit, float scale, float lg, int tq, float* optr) {
    constexpr int KS = DQK + 1;
    constexpr int VS = V_IN_K ? KS : DV;
    LAS float* Ks = lds;
    LAS float* Vs = V_IN_K ? Ks : (lds + 64 * KS);
    LAS float* qs = lds + 64 * KS + (V_IN_K ? 0 : 64 * DV);
    LAS float* ps = qs + 8 * DQK;
    static_assert((64 * KS + (V_IN_K ? 0 : 64 * DV) + 8 * DQK + 8 * 64) * 4 <= MISC_OFF, "attn_naive LDS");
    const int tid = threadIdx.x, lane = tid & 63, w = tid >> 6;
    __syncthreads();
    for (int d = lane; d < DQK; d += 64) qs[w * DQK + d] = active ? qf(d) : 0.f;
    float m = -INFINITY, l = 0.f;
    float acc[DV / 64];
#pragma unroll
    for (int c = 0; c < DV / 64; ++c) acc[c] = 0.f;
    for (int base = 0; base < nk_loop; base += 64) {
        __syncthreads();
        for (int idx = tid; idx < 64 * DQK; idx += NTHREADS) { const int j = idx / DQK, d = idx - j * DQK, key = base + j; Ks[j * KS + d] = key < nk_loop ? kv.k(key, d) : 0.f; }
        if (!V_IN_K) for (int idx = tid; idx < 64 * DV; idx += NTHREADS) { const int j = idx / DV, e = idx - j * DV, key = base + j; Vs[j * DV + e] = key < nk_loop ? kv.v(key, e) : 0.f; }
        __syncthreads();
        const int key = base + lane; const bool valid = active && key <= limit && key < nk_loop;
        float s = 0.f;
        for (int d = 0; d < DQK; ++d) s += qs[w * DQK + d] * Ks[lane * KS + d];
        float p;
        if (MODE == 0) {
            s *= scale;
            const float cm = wave_max(valid ? s : -INFINITY);
            const float mn = fmaxf(m, cm);
            const float alpha = (mn == -INFINITY) ? 1.f : expf(m - mn);
            p = valid ? expf(s - mn) : 0.f;
            l = l * alpha + wave_sum(p);
#pragma unroll
            for (int c = 0; c < DV / 64; ++c) acc[c] *= alpha;
            m = mn;
        } else {
            p = valid ? s * expf((float)(tq - key) * lg) : 0.f;
        }
        ps[w * 64 + lane] = p;
        __syncthreads();
        for (int j = 0; j < 64; ++j) { const float pj = ps[w * 64 + j];
#pragma unroll
            for (int c = 0; c < DV / 64; ++c) acc[c] += pj * Vs[j * VS + lane + 64 * c]; }
    }
    if (active) {
#pragma unroll
        for (int c = 0; c < DV / 64; ++c) optr[lane + 64 * c] = (MODE == 0) ? acc[c] / l : acc[c];
    }
}

struct KvMlaPrompt { const float* ckvn; const float* kper; int b;
    DI float k(int key, int d) const { const size_t row = (size_t)b * SEQ + key; return d < KVL ? ckvn[row * KVL + d] : kper[row * DROPE + (d - KVL)]; }
    DI float v(int, int) const { return 0.f; } };
struct KvMlaSample { const float* ckvn; const float* kper; const float* cckv; const float* ckpe; const int* pt; int b;
    DI float k(int key, int d) const {
        if (key < PAST) { const size_t r = (size_t)pt[b * NPAGES + (key >> 7)] * PAGE + (key & (PAGE - 1)); return d < KVL ? cckv[r * KVL + d] : ckpe[r * DROPE + (d - KVL)]; }
        const size_t row = (size_t)NP + b * DS + (key - PAST); return d < KVL ? ckvn[row * KVL + d] : kper[row * DROPE + (d - KVL)]; }
    DI float v(int, int) const { return 0.f; } };
struct KvRet { const float* rk; const float* z; int b, h;
    DI float k(int key, int d) const { return rk[((size_t)b * SEQ + key) * 512 + h * RDK + d]; }
    DI float v(int key, int e) const { return z[((size_t)b * SEQ + key) * ZLD + C_RV + h * RDV + e]; } };
struct KvMem { const float* mk; const float* mv; int b, h;
    DI float k(int key, int d) const { return mk[(((size_t)b * NMEM + key) * XH + h) * XHD + d]; }
    DI float v(int key, int e) const { return mv[(((size_t)b * NMEM + key) * XH + h) * XHD + e]; } };


typedef float f32x16 __attribute__((ext_vector_type(16)));
typedef short bf16x8 __attribute__((ext_vector_type(8)));
typedef short s16x4 __attribute__((ext_vector_type(4)));
typedef __bf16 bf16x2_t __attribute__((ext_vector_type(2)));
typedef float f32x2_t __attribute__((ext_vector_type(2)));
typedef unsigned u32x4_t __attribute__((ext_vector_type(4)));
typedef unsigned u32x2_t __attribute__((ext_vector_type(2)));
DI unsigned cvtpk(float lo, float hi) { f32x2_t v = {lo, hi}; bf16x2_t b = __builtin_convertvector(v, bf16x2_t); return __builtin_bit_cast(unsigned, b); }
DI int crow(int i, int h) { return (i & 3) + 8 * (i >> 2) + 4 * h; }
#define MFMA32(a, b, c) __builtin_amdgcn_mfma_f32_32x32x16_bf16((a), (b), (c), 0, 0, 0)
template <int DQK, int DV, bool CAUSAL, class Src>
DI void flash_unit(LAS unsigned char* lds, const Src& src, const bf16_t* Q, int ldq, int qpos0, int ntiles, bf16_t* O, int ldo, float c2) {
    constexpr int KP = DQK + 8, VP = 68, KS = DQK / 16, NBLK = DV / 32;
    constexpr int KBYTES = 64 * KP * 2, VBYTES = DV * VP * 2, BUF = KBYTES + VBYTES;
    constexpr int D8 = DQK / 8, NPK = (64 * D8) / NTHREADS, NPV = (DV * 8) / NTHREADS;
    static_assert((64 * D8) % NTHREADS == 0 && (DV * 8) % NTHREADS == 0 && 2 * BUF <= 131072, "flash_unit geometry");
    const int tid = threadIdx.x, lane = tid & 63, w = __builtin_amdgcn_readfirstlane(tid >> 6), l31 = lane & 31, h = lane >> 5;
    bf16x8 qf[KS];
    { const bf16_t* qrow = Q + (size_t)(32 * w + l31) * ldq + h * 8;
#pragma unroll
      for (int s_ = 0; s_ < KS; ++s_) qf[s_] = *(const bf16x8*)(qrow + 16 * s_); }
    f32x16 o[NBLK];
#pragma unroll
    for (int b = 0; b < NBLK; ++b)
#pragma unroll
        for (int i = 0; i < 16; ++i) o[b][i] = 0.f;
    float m = -INFINITY, lsum = 0.f;
    u32x4_t kreg[NPK], vreg[NPV];
#define FL_LOAD(t_) do { _Pragma("unroll") for (int i_ = 0; i_ < NPK; ++i_) { const int p_ = tid + i_ * NTHREADS; kreg[i_] = src.kpiece(64 * (t_) + p_ / D8, p_ % D8); } \
                         _Pragma("unroll") for (int i_ = 0; i_ < NPV; ++i_) { const int p_ = tid + i_ * NTHREADS; vreg[i_] = src.vpiece(p_ >> 3, 64 * (t_) + 8 * (p_ & 7)); } } while (0)
#define FL_STORE(buf_) do { _Pragma("unroll") for (int i_ = 0; i_ < NPK; ++i_) { const int p_ = tid + i_ * NTHREADS; *(LAS u32x4_t*)(lds + (buf_) * BUF + ((p_ / D8) * KP + (p_ % D8) * 8) * 2) = kreg[i_]; } \
                          _Pragma("unroll") for (int i_ = 0; i_ < NPV; ++i_) { const int p_ = tid + i_ * NTHREADS; LAS unsigned char* a_ = lds + (buf_) * BUF + KBYTES + ((p_ >> 3) * VP + (p_ & 7) * 8) * 2; \
                              *(LAS u32x2_t*)a_ = (u32x2_t){vreg[i_].x, vreg[i_].y}; *(LAS u32x2_t*)(a_ + 8) = (u32x2_t){vreg[i_].z, vreg[i_].w}; } } while (0)
    __syncthreads();
    FL_LOAD(0); FL_STORE(0);
    __syncthreads();
    const int qmine = qpos0 + 32 * w + l31, qlast = qpos0 + 32 * w + 31;
    for (int t = 0; t < ntiles; ++t) {
        const int buf = t & 1;
        if (t + 1 < ntiles) FL_LOAD(t + 1);
        if (!CAUSAL || 64 * t <= qlast) {
            const LAS unsigned char* kb_ = lds + buf * BUF; const LAS unsigned char* vb_ = kb_ + KBYTES;
            f32x16 st[2];
#pragma unroll
            for (int kb = 0; kb < 2; ++kb) {
#pragma unroll
                for (int i = 0; i < 16; ++i) st[kb][i] = 0.f;
#pragma unroll
                for (int g_ = 0; g_ < KS / 4; ++g_) { bf16x8 kf[4];
#pragma unroll
                    for (int j = 0; j < 4; ++j) kf[j] = *(const LAS bf16x8*)(kb_ + ((32 * kb + l31) * KP + 16 * (4 * g_ + j) + 8 * h) * 2);
#pragma unroll
                    for (int j = 0; j < 4; ++j) st[kb] = MFMA32(kf[j], qf[4 * g_ + j], st[kb]);
                    __builtin_amdgcn_sched_barrier(0); }
            }
            float mx = -INFINITY;
#pragma unroll
            for (int kb = 0; kb < 2; ++kb)
#pragma unroll
                for (int i = 0; i < 16; ++i) { float v = st[kb][i] * c2; if (CAUSAL) { const int key = 64 * t + 32 * kb + crow(i, h); v = key <= qmine ? v : -INFINITY; } st[kb][i] = v; mx = fmaxf(mx, v); }
            mx = fmaxf(mx, __shfl_xor(mx, 32));
            const float mn = fmaxf(m, mx);
            const float alpha = __builtin_amdgcn_exp2f(m - mn);
            m = mn;
            float ps = 0.f;
#pragma unroll
            for (int kb = 0; kb < 2; ++kb)
#pragma unroll
                for (int i = 0; i < 16; ++i) { const float p = __builtin_amdgcn_exp2f(st[kb][i] - mn); st[kb][i] = p; ps += p; }
            lsum = lsum * alpha + ps;
#pragma unroll
            for (int b = 0; b < NBLK; ++b)
#pragma unroll
                for (int i = 0; i < 16; ++i) o[b][i] *= alpha;
            bf16x8 pf[4];
#pragma unroll
            for (int ks = 0; ks < 4; ++ks) { const int kb = ks >> 1, s2 = ks & 1; u32x4_t pk;
                pk.x = cvtpk(st[kb][8 * s2 + 0], st[kb][8 * s2 + 1]); pk.y = cvtpk(st[kb][8 * s2 + 2], st[kb][8 * s2 + 3]);
                pk.z = cvtpk(st[kb][8 * s2 + 4], st[kb][8 * s2 + 5]); pk.w = cvtpk(st[kb][8 * s2 + 6], st[kb][8 * s2 + 7]); pf[ks] = __builtin_bit_cast(bf16x8, pk); }
            __builtin_amdgcn_sched_barrier(0);
#pragma unroll
            for (int b = 0; b < NBLK; ++b) { bf16x8 vf[4];
#pragma unroll
                for (int ks = 0; ks < 4; ++ks) { const LAS unsigned char* a_ = vb_ + ((32 * b + l31) * VP + 16 * ks + 4 * h) * 2;
                    const s16x4 lo = *(const LAS s16x4*)a_, hi = *(const LAS s16x4*)(a_ + 16);
                    vf[ks] = __builtin_shufflevector(lo, hi, 0, 1, 2, 3, 4, 5, 6, 7); }
#pragma unroll
                for (int ks = 0; ks < 4; ++ks) o[b] = MFMA32(vf[ks], pf[ks], o[b]);
                __builtin_amdgcn_sched_barrier(0); }
        }
        if (t + 1 < ntiles) FL_STORE(buf ^ 1);
        __syncthreads();
    }
#undef FL_LOAD
#undef FL_STORE
    lsum += __shfl_xor(lsum, 32);
    const float inv = 1.f / lsum;
    bf16_t* orow = O + (size_t)(32 * w + l31) * ldo;
#pragma unroll
    for (int b = 0; b < NBLK; ++b)
#pragma unroll
        for (int g = 0; g < 4; ++g) { u32x2_t pk; pk.x = cvtpk(o[b][4 * g + 0] * inv, o[b][4 * g + 1] * inv); pk.y = cvtpk(o[b][4 * g + 2] * inv, o[b][4 * g + 3] * inv);
            *(u32x2_t*)(orow + 32 * b + 8 * g + 4 * h) = pk; }
}
struct SrcMlaP { const bf16_t* kn; const bf16_t* kpe; const bf16_t* vt; int b, hh;
    DI u32x4_t kpiece(int key, int d8) const { const size_t row = (size_t)b * SEQ + key;
        return d8 < 16 ? *(const u32x4_t*)(kn + row * 1024 + hh * DNOPE + d8 * 8) : *(const u32x4_t*)(kpe + row * DROPE + (d8 - 16) * 8); }
    DI u32x4_t vpiece(int dv, int key0) const { return *(const u32x4_t*)(vt + (size_t)(hh * DVH + dv) * NP + (size_t)b * SEQ + key0); } };
struct SrcMemP { const bf16_t* mk; const bf16_t* mvt; int b, hh;
    DI u32x4_t kpiece(int key, int d8) const { return *(const u32x4_t*)(mk + ((size_t)b * NMEM + key) * 256 + hh * XHD + d8 * 8); }
    DI u32x4_t vpiece(int dv, int key0) const { return *(const u32x4_t*)(mvt + (size_t)(hh * XHD + dv) * (NB * NMEM) + (size_t)b * NMEM + key0); } };

struct QPtr { const float* p; DI float operator()(int d) const { return p[d]; } };
struct QMla { const float* ql; const float* qp; DI float operator()(int d) const { return d < KVL ? ql[d] : qp[d - KVL]; } };
DI void rms_row(const float* x, const float* g, float* o, int n, int lane) {
    float s = 0.f;
    for (int i = lane; i < n; i += 64) { const float v = x[i]; s += v * v; }
    const float r = rsqrtf(wave_sum(s) / (float)n + EPS);
    for (int i = lane; i < n; i += 64) o[i] = x[i] * r * g[i];
}

DI void rms_row_bf16(const float* x, const float* g, bf16_t* o, int n, int lane) {
    float s = 0.f;
    for (int i = lane; i < n; i += 64) { const float v = x[i]; s += v * v; }
    const float r = rsqrtf(wave_sum(s) / (float)n + EPS);
    for (int i = lane; i < n; i += 64) o[i] = f2bf(x[i] * r * g[i]);
}
#define GEMM_PHASE(EPI, ...) pg8::gemm_phase<EPI, pg8::StaticOrder, true, true>(__VA_ARGS__)
__global__ void __launch_bounds__(NTHREADS, 2) fwd_kernel(Args args) {
    extern __shared__ __attribute__((aligned(16))) unsigned char lds_raw[];
    LAS unsigned char* ldsb = (LAS unsigned char*)lds_raw;
    LAS float* lds = (LAS float*)ldsb;
    volatile LAS unsigned* MISC = (volatile LAS unsigned*)(ldsb + MISC_OFF);
    const int tid = threadIdx.x, lane = tid & 63, wave = tid >> 6;
    const int G = gridDim.x, bid = blockIdx.x;
    const int gw = bid * NWAVES + wave, NGW = G * NWAVES;
    unsigned char* ws = args.ws;
    float* out = args.out;
    const int lo = args.ph_lo, hi = args.ph_hi;

    if (tid < 64) MISC[tid] = 0u;
    __syncthreads();
    XcdBarrier bar; bar.bar = (unsigned*)(ws + WS_CTL) + CW_BAR; bar.x = 0; bar.st = MISC;
    if (hi - lo > 1) bar = xcd_barrier_post((unsigned*)(ws + WS_CTL) + CW_BAR, MISC);
#define IN(k) (lo <= (k) && (k) < hi)
#define SEAM(k) do { if (IN(k) && IN((k) + 1)) xcd_barrier(bar); } while (0)

    const float* x_prompt = args.in[0]; const float* x_sample = args.in[1]; const float* mem_prompt = args.in[2];
    const float* cache_ckv = args.in[3]; const float* cache_kpe = args.in[4]; const int* page_table = (const int*)args.in[5];
    const float* state_ret = args.in[6]; const float* cache_mem_k = args.in[7]; const float* cache_mem_v = args.in[8];
    const float* g_mix_pre = args.in[9]; const float* g_mix_post = args.in[10]; const float* g_ffn_pre = args.in[11]; const float* g_ffn_post = args.in[12];
    const float* g_mem = args.in[13]; const float* g_qlat = args.in[14]; const float* g_kvlat = args.in[15];
    const float* w_in = args.in[16]; const float* w_uq = args.in[17]; const float* w_uk = args.in[18]; const float* w_uv = args.in[19];
    const float* w_mem_k = args.in[20]; const float* w_mem_v = args.in[21]; const float* w_ret_o = args.in[22]; const float* w_mla_o = args.in[23];
    const float* w_x_o = args.in[24]; const float* w_out = args.in[25]; const float* w_gate = args.in[26]; const float* w_up = args.in[27]; const float* w_down = args.in[28];
    float* COSA = (float*)(ws + WS_COSA); float* SINA = (float*)(ws + WS_SINA); float* COSB = (float*)(ws + WS_COSB); float* SINB = (float*)(ws + WS_SINB);
    float* U = (float*)(ws + WS_U); float* MN = (float*)(ws + WS_MN); float* Z = (float*)(ws + WS_Z);
    float* RQ = (float*)(ws + WS_RQ); float* RK = (float*)(ws + WS_RK); float* CQN = (float*)(ws + WS_CQN); float* CKVN = (float*)(ws + WS_CKVN); float* KPER = (float*)(ws + WS_KPER);
    float* Q = (float*)(ws + WS_Q); float* QLAT = (float*)(ws + WS_QLAT); float* QPE = (float*)(ws + WS_QPE);
    float* ORET = (float*)(ws + WS_ORET); float* OLAT = (float*)(ws + WS_OLAT); float* OX = (float*)(ws + WS_OX); float* OMLA = (float*)(ws + WS_OMLA); float* ORETN = (float*)(ws + WS_ORETN);
    float* ARET = (float*)(ws + WS_ARET); float* AMLA = (float*)(ws + WS_AMLA); float* AX = (float*)(ws + WS_AX); float* MIX = (float*)(ws + WS_MIX);
    float* HP = (float*)(ws + WS_HP); float* H = (float*)(ws + WS_H); float* F = (float*)(ws + WS_F);
    float* GU = (float*)(ws + WS_GG); float* FO = (float*)(ws + WS_FO);
    bf16_t* WinT = (bf16_t*)(ws + WS_WIN_T); bf16_t* WmkvT = (bf16_t*)(ws + WS_WMKV_T); bf16_t* WuqT = (bf16_t*)(ws + WS_WUQ_T); bf16_t* WroT = (bf16_t*)(ws + WS_WRO_T);
    bf16_t* WmoT = (bf16_t*)(ws + WS_WMO_T); bf16_t* WxoT = (bf16_t*)(ws + WS_WXO_T); bf16_t* WoT = (bf16_t*)(ws + WS_WO_T); bf16_t* WguT = (bf16_t*)(ws + WS_WGU_T); bf16_t* WdT = (bf16_t*)(ws + WS_WD_T);
    bf16_t* Ub = (bf16_t*)(ws + WS_UB); bf16_t* MNb = (bf16_t*)(ws + WS_MNB); bf16_t* CQNb = (bf16_t*)(ws + WS_CQNB); bf16_t* ORETNb = (bf16_t*)(ws + WS_ORETNB);
    bf16_t* OMLAb = (bf16_t*)(ws + WS_OMLAB); bf16_t* OXb = (bf16_t*)(ws + WS_OXB); bf16_t* MIXb = (bf16_t*)(ws + WS_MIXB); bf16_t* Fb = (bf16_t*)(ws + WS_FB); bf16_t* ACTb = (bf16_t*)(ws + WS_ACTB);
    bf16_t* WukT = (bf16_t*)(ws + WS_WUK_T); bf16_t* WuvT = (bf16_t*)(ws + WS_WUV_T); bf16_t* CKVNb = (bf16_t*)(ws + WS_CKVNB); bf16_t* KPERb = (bf16_t*)(ws + WS_KPERB);
    bf16_t* XQb = (bf16_t*)(ws + WS_XQB); bf16_t* MKb = (bf16_t*)(ws + WS_MKB); bf16_t* MVT = (bf16_t*)(ws + WS_MVT); bf16_t* KN = (bf16_t*)(ws + WS_KN); bf16_t* VT = (bf16_t*)(ws + WS_VT); bf16_t* Qb = (bf16_t*)(ws + WS_QB);

    if (IN(0)) {
        for (int i = bid * NTHREADS + tid; i < NPOS * 64 + NPOS * 32; i += G * NTHREADS) {
            const bool a = i < NPOS * 64; const int j = a ? i : i - NPOS * 64; const int half = a ? 64 : 32;
            const int p = j / half, f = j % half; const int pos = p < SEQ ? p : PAST + (p - SEQ);
            const float inv = powf(10000.0f, -(float)f / (float)half);
            const float ang = (float)pos * inv;
            double rev = (double)ang * 0.15915494309189535; rev -= floor(rev);
            const float r = (float)rev;
            const float sn = __builtin_amdgcn_sinf(r), cs = __builtin_amdgcn_cosf(r);
            if (a) { COSA[j] = cs; SINA[j] = sn; } else { COSB[j] = cs; SINB[j] = sn; }
        }
        for (int row = gw; row < NT; row += NGW) {
            const float* xr = row < NP ? x_prompt + (size_t)row * DM : x_sample + (size_t)(row - NP) * DM;
            rms_row_bf16(xr, g_mix_pre, Ub + (size_t)row * DM, DM, lane);
        }
        for (int row = gw; row < NB * NMEM; row += NGW) rms_row_bf16(mem_prompt + (size_t)row * DM, g_mem, MNb + (size_t)row * DM, DM, lane);
        {
            LAS float* scr = lds + wave * (64 * 33);
            transpose_w(w_in, 1024, DIN, WinT, 1024, 0, scr, gw, NGW, lane);
            for (int i = bid * NTHREADS + tid; i < (ZLD - DIN) * 1024 / 2; i += G * NTHREADS) ((unsigned*)(WinT + (size_t)DIN * 1024))[i] = 0u;
            transpose_w(w_mem_k, 1024, 256, WmkvT, 1024, 0, scr, gw, NGW, lane);
            transpose_w(w_mem_v, 1024, 256, WmkvT, 1024, 256, scr, gw, NGW, lane);
            transpose_w(w_uq, QL, 1536, WuqT, QL, 0, scr, gw, NGW, lane);
            transpose_w(w_ret_o, 1024, 1024, WroT, 1024, 0, scr, gw, NGW, lane);
            transpose_w(w_mla_o, 1024, 1024, WmoT, 1024, 0, scr, gw, NGW, lane);
            transpose_w(w_x_o, 256, 1024, WxoT, 256, 0, scr, gw, NGW, lane);
            transpose_w(w_out, 1024, 1024, WoT, 1024, 0, scr, gw, NGW, lane);
            transpose_w(w_gate, 1024, DFF, WguT, 1024, 0, scr, gw, NGW, lane);
            transpose_w(w_up, 1024, DFF, WguT, 1024, DFF, scr, gw, NGW, lane);
            transpose_w(w_down, DFF, 1024, WdT, DFF, 0, scr, gw, NGW, lane);
            for (int hh = 0; hh < MH; ++hh) { transpose_w(w_uk + (size_t)hh * KVL * DNOPE, KVL, DNOPE, WukT, KVL, hh * DNOPE, scr, gw, NGW, lane);
                                              transpose_w(w_uv + (size_t)hh * KVL * DVH, KVL, DVH, WuvT, KVL, hh * DVH, scr, gw, NGW, lane); }
        }
    }
    SEAM(0);
    if (IN(1)) {
        { pg8::Gemm g{Ub, WinT, NT, ZLD, 1024, 1024, 1024}; pg8::StaticOrder S; S.init(NT, ZLD, G, bid); pg8::EpiF32S E{Z, ZLD, 0, 0};
          GEMM_PHASE(pg8::EpiF32S, ldsb, g, S, E); }
        __syncthreads();
        { pg8::Gemm g{MNb, WmkvT, NB * NMEM, 512, 1024, 1024, 1024}; pg8::StaticOrder S; S.init(NB * NMEM, 512, G, bid); pg8::EpiF32S E{out + O_MKP, 256, 1, O_MVP - O_MKP};
          GEMM_PHASE(pg8::EpiF32S, ldsb, g, S, E); }
    }
    SEAM(1);
    if (IN(2)) {
        for (int row = gw; row < NT; row += NGW) {
            const float* z = Z + (size_t)row * ZLD; const int p = pos_index(row);
            const float ca = COSA[p * 64 + lane], sa = SINA[p * 64 + lane];
#pragma unroll
            for (int h = 0; h < RH; ++h) {
                float x1 = z[C_RQ + h * RDK + lane], x2 = z[C_RQ + h * RDK + 64 + lane];
                RQ[(size_t)row * 512 + h * RDK + lane] = x1 * ca - x2 * sa; RQ[(size_t)row * 512 + h * RDK + 64 + lane] = x1 * sa + x2 * ca;
                x1 = z[C_RK + h * RDK + lane]; x2 = z[C_RK + h * RDK + 64 + lane];
                const float sc = 0.08838834764831845f;
                RK[(size_t)row * 512 + h * RDK + lane] = (x1 * ca - x2 * sa) * sc; RK[(size_t)row * 512 + h * RDK + 64 + lane] = (x1 * sa + x2 * ca) * sc;
            }
            rms_row_bf16(z + C_CQ, g_qlat, CQNb + (size_t)row * QL, QL, lane);
            rms_row(z + C_CKV, g_kvlat, CKVN + (size_t)row * KVL, KVL, lane);
            float* ockv = row < NP ? out + O_CKVP + (size_t)row * KVL : out + O_CKVS + (size_t)(row - NP) * KVL;
            for (int i = lane; i < KVL; i += 64) { const float v = CKVN[(size_t)row * KVL + i]; ockv[i] = v; CKVNb[(size_t)row * KVL + i] = f2bf(v); }
            for (int i = lane; i < 256; i += 64) XQb[(size_t)row * 256 + i] = f2bf(z[C_XQ + i]);
            if (lane < 32) {
                const float cb = COSB[p * 32 + lane], sb = SINB[p * 32 + lane];
                const float x1 = z[C_KPE + lane], x2 = z[C_KPE + 32 + lane];
                const float o1 = x1 * cb - x2 * sb, o2 = x1 * sb + x2 * cb;
                KPER[(size_t)row * DROPE + lane] = o1; KPER[(size_t)row * DROPE + 32 + lane] = o2;
                float* okpe = row < NP ? out + O_KPEP + (size_t)row * DROPE : out + O_KPES + (size_t)(row - NP) * DROPE;
                okpe[lane] = o1; okpe[32 + lane] = o2;
                KPERb[(size_t)row * DROPE + lane] = f2bf(o1); KPERb[(size_t)row * DROPE + 32 + lane] = f2bf(o2);
            }
        }
    }
    if (IN(2)) {
        for (int i = bid * NTHREADS + tid; i < NB * NMEM * 256; i += G * NTHREADS) { MKb[i] = f2bf(out[O_MKP + i]);
            const int f = i / (NB * NMEM), r = i - f * (NB * NMEM); MVT[i] = f2bf(out[O_MVP + (size_t)r * 256 + f]); }
    }
    SEAM(2);
    if (IN(3)) { pg8::Gemm g{CQNb, WuqT, NT, 1536, QL, QL, QL}; pg8::StaticOrder S; S.init(NT, 1536, G, bid); pg8::EpiF32S E{Q, 1536, 0, 0};
        GEMM_PHASE(pg8::EpiF32S, ldsb, g, S, E);
        __syncthreads();
        { pg8::Gemm g2{CKVNb, WukT, NP, 1024, KVL, KVL, KVL}; pg8::StaticOrder S2; S2.init(NP, 1024, G, bid); pg8::EpiBf16S E2{KN, 1024}; GEMM_PHASE(pg8::EpiBf16S, ldsb, g2, S2, E2); }
        __syncthreads();
        { pg8::Gemm g3{WuvT, CKVNb, 1024, NP, KVL, KVL, KVL}; pg8::StaticOrder S3; S3.init(1024, NP, G, bid); pg8::EpiBf16S E3{VT, NP}; GEMM_PHASE(pg8::EpiBf16S, ldsb, g3, S3, E3); } }
    SEAM(3);
    if (IN(4)) {
        for (int h = 0; h < MH; ++h)
            sgemm_naive(lds, Q + (size_t)NP * 1536 + h * DQH, 1536, w_uk + (size_t)h * KVL * DNOPE, 1, DNOPE, QLAT + (size_t)NP * 2048 + h * KVL, MH * KVL, NS, KVL, DNOPE, bid, G);
        for (int row = gw; row < NT; row += NGW) {
            const int p = pos_index(row);
            for (int i = lane; i < 1536; i += 64) { const int hh = i / DQH, d = i - hh * DQH; if (d < DNOPE) Qb[(size_t)row * 1536 + i] = f2bf(Q[(size_t)row * 1536 + i]); }
#pragma unroll
            for (int c = 0; c < 4; ++c) { const int idx = lane + 64 * c, h = idx >> 5, f = idx & 31;
                const float cb = COSB[p * 32 + f], sb = SINB[p * 32 + f];
                const float x1 = Q[(size_t)row * 1536 + h * DQH + DNOPE + f], x2 = Q[(size_t)row * 1536 + h * DQH + DNOPE + 32 + f];
                const float o1 = x1 * cb - x2 * sb, o2 = x1 * sb + x2 * cb;
                QPE[(size_t)row * 512 + h * 64 + f] = o1; QPE[(size_t)row * 512 + h * 64 + 32 + f] = o2;
                Qb[(size_t)row * 1536 + h * DQH + DNOPE + f] = f2bf(o1); Qb[(size_t)row * 1536 + h * DQH + DNOPE + 32 + f] = f2bf(o2); }
        }
    }
    SEAM(4);
    if (IN(5)) {
        for (int it = bid; it < NS; it += G) {
            const int b = it >> 2, t = it & 3; const size_t row = (size_t)NP + it;
            KvMlaSample kv{CKVN, KPER, cache_ckv, cache_kpe, page_table, b};
            QMla qf{QLAT + row * 2048 + wave * KVL, QPE + row * 512 + wave * 64};
            attn_naive<320, 256, true, 0>(lds, kv, PAST + t + 1, qf, true, PAST + t, 0.07216878364870322f, 0.f, 0, OLAT + row * 2048 + wave * KVL);
        }
        for (int it = bid; it < NB * MH * 4; it += G) {
            const int pr = __builtin_amdgcn_readfirstlane(it & 3), hh = __builtin_amdgcn_readfirstlane((it >> 2) & 7), b = __builtin_amdgcn_readfirstlane(it >> 5);
            SrcMlaP src{KN, KPERb, VT, b, hh};
#pragma unroll 1
            for (int half = 0; half < 2; ++half) { const int qb = __builtin_amdgcn_readfirstlane(half ? pr : 7 - pr); const size_t row0 = (size_t)b * SEQ + qb * 256;
                flash_unit<192, 128, true>(ldsb, src, Qb + row0 * 1536 + hh * DQH, 1536, qb * 256, 4 * (qb + 1), OMLAb + row0 * 1024 + hh * DVH, 1024, 0.07216878364870322f * 1.4426950408889634f); }
        }
        for (int it = bid; it < NB * RH * (SEQ / 8); it += G) {
            const int t8 = it % (SEQ / 8), bh = it / (SEQ / 8), h = bh & 3, b = bh >> 2; const int t = t8 * 8 + wave; const size_t row = (size_t)b * SEQ + t;
            KvRet kv{RK, Z, b, h};
            attn_naive<128, 256, false, 1>(lds, kv, t8 * 8 + 8, QPtr{RQ + row * 512 + h * RDK}, true, t, 1.f, lg_gamma(h), t, ORET + row * 1024 + h * RDV);
        }
        for (int it = bid; it < NB * RH * 16; it += G) {
            const int d8 = it & 15, bh = it >> 4, h = bh & 3, b = bh >> 2; const float lg = lg_gamma(h);
            const int e = tid & 255, dd = d8 * 8 + (tid >> 8) * 4;
            float a0 = 0.f, a1 = 0.f, a2 = 0.f, a3 = 0.f;
            for (int j = 0; j < SEQ; ++j) { const size_t row = (size_t)b * SEQ + j;
                const float v = Z[row * ZLD + C_RV + h * RDV + e] * expf((float)(SEQ - 1 - j) * lg);
                const float* kr = RK + row * 512 + h * RDK + dd;
                a0 += kr[0] * v; a1 += kr[1] * v; a2 += kr[2] * v; a3 += kr[3] * v; }
            float* o = out + O_RETP + ((size_t)bh * RDK + dd) * RDV + e;
            o[0] = a0; o[RDV] = a1; o[2 * RDV] = a2; o[3 * RDV] = a3;
        }
        for (int it = bid; it < DB * RH; it += G) {
            const int h = it & 3, b = it >> 2; const float lg = lg_gamma(h);
            const float* s0 = state_ret + (size_t)it * RDK * RDV;
            LAS float* inner = lds;
            LAS float* qk = lds + 16;
            __syncthreads();
            for (int i = tid; i < 1024; i += NTHREADS) { const int which = i >> 9, ti = (i >> 7) & 3, d = i & 127; const size_t row = (size_t)NP + b * DS + ti;
                qk[i] = which ? RK[row * 512 + h * RDK + d] : RQ[row * 512 + h * RDK + d]; }
            __syncthreads();
            for (int pr = wave; pr < 16; pr += NWAVES) { const int i = pr >> 2, j = pr & 3;
                float s = qk[i * 128 + lane] * qk[512 + j * 128 + lane] + qk[i * 128 + 64 + lane] * qk[512 + j * 128 + 64 + lane];
                s = wave_sum(s);
                if (lane == 0) inner[pr] = (j <= i) ? s * expf((float)(i - j) * lg) : 0.f; }
            __syncthreads();
            {
                const int e = tid & 255, i0 = (tid >> 8) * 2;
                float o0 = 0.f, o1 = 0.f;
                for (int d = 0; d < RDK; ++d) { const float sv = s0[(size_t)d * RDV + e]; o0 += qk[i0 * 128 + d] * sv; o1 += qk[(i0 + 1) * 128 + d] * sv; }
                o0 *= expf((float)(i0 + 1) * lg); o1 *= expf((float)(i0 + 2) * lg);
#pragma unroll
                for (int j = 0; j < DS; ++j) { const float v = Z[((size_t)NP + b * DS + j) * ZLD + C_RV + h * RDV + e]; o0 += inner[i0 * 4 + j] * v; o1 += inner[(i0 + 1) * 4 + j] * v; }
                ORET[((size_t)NP + b * DS + i0) * 1024 + h * RDV + e] = o0; ORET[((size_t)NP + b * DS + i0 + 1) * 1024 + h * RDV + e] = o1;
            }
            {
                const float g4 = expf(4.f * lg);
                float* so = out + O_RETS + (size_t)it * RDK * RDV;
                for (int i = tid; i < RDK * RDV; i += NTHREADS) { const int d = i >> 8, e = i & 255; float a = s0[i] * g4;
#pragma unroll
                    for (int j = 0; j < DS; ++j) a += expf((float)(3 - j) * lg) * qk[512 + j * 128 + d] * Z[((size_t)NP + b * DS + j) * ZLD + C_RV + h * RDV + e];
                    so[i] = a; }
            }
        }
        for (int it = bid; it < NB * XH * 8; it += G) {
            const int qb = __builtin_amdgcn_readfirstlane(it & 7), hh = __builtin_amdgcn_readfirstlane((it >> 3) & 3), b = __builtin_amdgcn_readfirstlane(it >> 5); const size_t row0 = (size_t)b * SEQ + qb * 256;
            SrcMemP src{MKb, MVT, b, hh};
            flash_unit<64, 64, false>(ldsb, src, XQb + row0 * 256 + hh * XHD, 256, 0, 4, OXb + row0 * 256 + hh * XHD, 256, 0.125f * 1.4426950408889634f);
        }
        for (int it = bid; it < DB * XH; it += G) {
            const int h = it & 3, b = it >> 2; const size_t row = (size_t)NP + b * DS + (wave & 3);
            KvMem kv{cache_mem_k, cache_mem_v, b, h};
            attn_naive<64, 64, false, 0>(lds, kv, NMEM, QPtr{Z + row * ZLD + C_XQ + h * XHD}, wave < 4, NMEM, 0.125f, 0.f, 0, OX + row * 256 + h * XHD);
        }
    }
    SEAM(5);
    if (IN(6)) {
        for (int h = 0; h < MH; ++h)
            sgemm_naive(lds, OLAT + (size_t)NP * 2048 + h * KVL, MH * KVL, w_uv + (size_t)h * KVL * DVH, DVH, 1, nullptr, 1024, NS, DVH, KVL, bid, G, OMLAb + (size_t)NP * 1024 + h * DVH);
        for (size_t i = (size_t)bid * NTHREADS + tid; i < (size_t)NS * 256; i += (size_t)G * NTHREADS) OXb[(size_t)NP * 256 + i] = f2bf(OX[(size_t)NP * 256 + i]);
        for (int row = gw; row < NT; row += NGW) {
#pragma unroll
            for (int h = 0; h < RH; ++h) {
                float v[4]; float s = 0.f;
#pragma unroll
                for (int c = 0; c < 4; ++c) { v[c] = ORET[(size_t)row * 1024 + h * RDV + lane + 64 * c]; s += v[c] * v[c]; }
                const float r = rsqrtf(wave_sum(s) * (1.f / RDV) + EPS);
#pragma unroll
                for (int c = 0; c < 4; ++c) ORETNb[(size_t)row * 1024 + h * RDV + lane + 64 * c] = f2bf(siluf_(Z[(size_t)row * ZLD + C_RG + h * RDV + lane + 64 * c]) * v[c] * r);
            }
        }
    }
    SEAM(6);
    if (IN(7)) {
        pg8::StaticOrder S; S.init(NT, 1024, G, bid);
        { pg8::Gemm g{ORETNb, WroT, NT, 1024, 1024, 1024, 1024}; pg8::EpiF32S E{ARET, 1024, 0, 0}; GEMM_PHASE(pg8::EpiF32S, ldsb, g, S, E); }
        __syncthreads();
        { pg8::Gemm g{OMLAb, WmoT, NT, 1024, 1024, 1024, 1024}; pg8::EpiF32S E{AMLA, 1024, 0, 0}; GEMM_PHASE(pg8::EpiF32S, ldsb, g, S, E); }
        __syncthreads();
        { pg8::Gemm g{OXb, WxoT, NT, 1024, 256, 256, 256}; pg8::EpiF32S E{AX, 1024, 0, 0}; GEMM_PHASE(pg8::EpiF32S, ldsb, g, S, E); }
    }
    SEAM(7);
    if (IN(8)) {
        for (size_t i = (size_t)bid * NTHREADS + tid; i < (size_t)NT * DM; i += (size_t)G * NTHREADS) {
            const size_t row = i >> 10; const int c = (int)(i & 1023); const float* z = Z + row * ZLD + C_G;
            MIXb[i] = f2bf(sigmoidf_(z[c]) * ARET[i] + sigmoidf_(z[1024 + c]) * AMLA[i] + sigmoidf_(z[2048 + c]) * AX[i]);
        }
    }
    SEAM(8);
    if (IN(9)) { pg8::Gemm g{MIXb, WoT, NT, 1024, 1024, 1024, 1024}; pg8::StaticOrder S; S.init(NT, 1024, G, bid); pg8::EpiF32S E{HP, 1024, 0, 0};
        GEMM_PHASE(pg8::EpiF32S, ldsb, g, S, E); }
    SEAM(9);
    if (IN(10)) {
        for (int row = gw; row < NT; row += NGW) {
            const float* xr = row < NP ? x_prompt + (size_t)row * DM : x_sample + (size_t)(row - NP) * DM;
            float v[16]; float s = 0.f;
#pragma unroll
            for (int c = 0; c < 16; ++c) { v[c] = HP[(size_t)row * DM + lane + 64 * c]; s += v[c] * v[c]; }
            float r = rsqrtf(wave_sum(s) * (1.f / DM) + EPS); s = 0.f;
#pragma unroll
            for (int c = 0; c < 16; ++c) { v[c] = xr[lane + 64 * c] + v[c] * r * g_mix_post[lane + 64 * c]; H[(size_t)row * DM + lane + 64 * c] = v[c]; s += v[c] * v[c]; }
            r = rsqrtf(wave_sum(s) * (1.f / DM) + EPS);
#pragma unroll
            for (int c = 0; c < 16; ++c) Fb[(size_t)row * DM + lane + 64 * c] = f2bf(v[c] * r * g_ffn_pre[lane + 64 * c]);
        }
    }
    SEAM(10);
    if (IN(11)) {
        pg8::Gemm g{Fb, WguT, NT, 2 * DFF, 1024, 1024, 1024}; pg8::StaticOrder S; S.init(NT, 2 * DFF, G, bid); pg8::EpiF32S E{GU, 2 * DFF, 0, 0};
        GEMM_PHASE(pg8::EpiF32S, ldsb, g, S, E);
    }
    SEAM(11);
    if (IN(12)) {
        for (size_t i = (size_t)bid * NTHREADS + tid; i < (size_t)NT * DFF; i += (size_t)G * NTHREADS) { const size_t row = i / DFF; const int c = (int)(i - row * DFF); ACTb[i] = f2bf(siluf_(GU[row * (2 * DFF) + c]) * GU[row * (2 * DFF) + DFF + c]); }
    }
    SEAM(12);
    if (IN(13)) { pg8::Gemm g{ACTb, WdT, NT, 1024, DFF, DFF, DFF}; pg8::StaticOrder S; S.init(NT, 1024, G, bid); pg8::EpiF32S E{FO, 1024, 0, 0};
        GEMM_PHASE(pg8::EpiF32S, ldsb, g, S, E); }
    SEAM(13);
    if (IN(14)) {
        for (int row = gw; row < NT; row += NGW) {
            float v[16]; float s = 0.f;
#pragma unroll
            for (int c = 0; c < 16; ++c) { v[c] = FO[(size_t)row * DM + lane + 64 * c]; s += v[c] * v[c]; }
            const float r = rsqrtf(wave_sum(s) * (1.f / DM) + EPS);
            float* y = row < NP ? out + O_YP + (size_t)row * DM : out + O_YS + (size_t)(row - NP) * DM;
#pragma unroll
            for (int c = 0; c < 16; ++c) y[lane + 64 * c] = H[(size_t)row * DM + lane + 64 * c] + v[c] * r * g_ffn_post[lane + 64 * c];
        }
    }
#undef IN
#undef SEAM
}
constexpr int N_PHASES = 15;
}

extern "C" void kernel_launch(void* const* d_in, const int* in_sizes, int n_in, void* d_out, int out_size, void* d_ws, size_t ws_size, hipStream_t stream) {
    static int grid = 0;
    if (grid == 0) {
        if (n_in != 29 || (size_t)out_size != O_END || ws_size < WS_END) { fprintf(stderr, "kernel_launch: unexpected shapes: n_in %d out %d ws %zu (need %zu)\n", n_in, out_size, ws_size, (size_t)WS_END); grid = -1; return; }
        int dev = 0, cus = 0, per_cu = 0;
        if (hipGetDevice(&dev) != hipSuccess || hipDeviceGetAttribute(&cus, hipDeviceAttributeMultiprocessorCount, dev) != hipSuccess) { grid = -1; return; }
        if (hipFuncSetAttribute((const void*)fwd_kernel, hipFuncAttributeMaxDynamicSharedMemorySize, LDS_BYTES) != hipSuccess) { fprintf(stderr, "kernel_launch: hipFuncSetAttribute failed\n"); grid = -1; return; }
        if (hipOccupancyMaxActiveBlocksPerMultiprocessor(&per_cu, (const void*)fwd_kernel, NTHREADS, LDS_BYTES) != hipSuccess || per_cu < 1) { fprintf(stderr, "kernel_launch: occupancy query says %d\n", per_cu); per_cu = 1; }
        (void)hipGetLastError();
        grid = cus;
    }
    if (grid < 0) return;
    (void)hipMemsetAsync((char*)d_ws + WS_CTL, 0, CTL_BYTES, stream);
    Args a{};
    for (int i = 0; i < 29; ++i) a.in[i] = (const float*)d_in[i];
    a.out = (float*)d_out; a.ws = (unsigned char*)d_ws;
#if MK_ONE_LAUNCH
    a.ph_lo = 0; a.ph_hi = N_PHASES;
    hipLaunchKernelGGL(fwd_kernel, dim3(grid), dim3(NTHREADS), LDS_BYTES, stream, a);
#else
    for (int p = 0; p < N_PHASES; ++p) { a.ph_lo = p; a.ph_hi = p + 1; hipLaunchKernelGGL(fwd_kernel, dim3(grid), dim3(NTHREADS), LDS_BYTES, stream, a); }
#endif
}
```

```cpp
#include <hip/hip_runtime.h>
#include <cstdio>
#include <cstdint>

#ifndef MK_ONE_LAUNCH
#define MK_ONE_LAUNCH 1
#endif

#define LAS __attribute__((address_space(3)))
#define GAS __attribute__((address_space(1)))
#define DI __device__ __forceinline__
typedef float f32x4 __attribute__((ext_vector_type(4)));

namespace {
constexpr int DM = 1024, NB = 8, SEQ = 2048, NP = NB * SEQ, DB = 128, DS = 4, NS = DB * DS, NT = NP + NS;
constexpr int PAST = 8192, PAGE = 128, NPAGES = PAST / PAGE;
constexpr int RH = 4, RDK = 128, RDV = 256;
constexpr int MH = 8, QL = 384, KVL = 256, DNOPE = 128, DROPE = 64, DVH = 128, DQH = DNOPE + DROPE;
constexpr int NMEM = 256, XH = 4, XHD = 64;
constexpr int DFF = 2816, DIN = 7104, ZLD = 7168;
constexpr int C_RQ = 0, C_RK = 512, C_RV = 1024, C_RG = 2048, C_CQ = 3072, C_CKV = 3456, C_KPE = 3712, C_XQ = 3776, C_G = 4032;
constexpr float EPS = 1e-6f;
constexpr int NPOS = SEQ + DS;
constexpr int NTHREADS = 512, NWAVES = 8;
constexpr int LDS_BYTES = 147456;
constexpr int MISC_OFF = 147456 - 256;

constexpr size_t O_YP = 0, O_YS = O_YP + (size_t)NP * DM, O_CKVP = O_YS + (size_t)NS * DM, O_KPEP = O_CKVP + (size_t)NP * KVL,
                 O_CKVS = O_KPEP + (size_t)NP * DROPE, O_KPES = O_CKVS + (size_t)NS * KVL, O_RETP = O_KPES + (size_t)NS * DROPE,
                 O_RETS = O_RETP + (size_t)NB * RH * RDK * RDV, O_MKP = O_RETS + (size_t)DB * RH * RDK * RDV, O_MVP = O_MKP + (size_t)NB * NMEM * 256,
                 O_END = O_MVP + (size_t)NB * NMEM * 256;

constexpr size_t al256(size_t x) { return (x + 255) & ~(size_t)255; }
constexpr size_t WS_CTL = 0, CTL_BYTES = 1u << 20;
constexpr size_t WS_COSA = WS_CTL + CTL_BYTES;
constexpr size_t WS_SINA = WS_COSA + al256((size_t)NPOS * 64 * 4);
constexpr size_t WS_COSB = WS_SINA + al256((size_t)NPOS * 64 * 4);
constexpr size_t WS_SINB = WS_COSB + al256((size_t)NPOS * 32 * 4);
constexpr size_t WS_U = WS_SINB + al256((size_t)NPOS * 32 * 4);
constexpr size_t WS_MN = WS_U + (size_t)NT * DM * 4;
constexpr size_t WS_Z = WS_MN + (size_t)NB * NMEM * DM * 4;
constexpr size_t WS_RQ = WS_Z + (size_t)NT * ZLD * 4;
constexpr size_t WS_RK = WS_RQ + (size_t)NT * 512 * 4;
constexpr size_t WS_CQN = WS_RK + (size_t)NT * 512 * 4;
constexpr size_t WS_CKVN = WS_CQN + (size_t)NT * QL * 4;
constexpr size_t WS_KPER = WS_CKVN + (size_t)NT * KVL * 4;
constexpr size_t WS_Q = WS_KPER + (size_t)NT * DROPE * 4;
constexpr size_t WS_QLAT = WS_Q + (size_t)NT * 1536 * 4;
constexpr size_t WS_QPE = WS_QLAT + (size_t)NT * 2048 * 4;
constexpr size_t WS_ORET = WS_QPE + (size_t)NT * 512 * 4;
constexpr size_t WS_OLAT = WS_ORET + (size_t)NT * 1024 * 4;
constexpr size_t WS_OX = WS_OLAT + (size_t)NT * 2048 * 4;
constexpr size_t WS_OMLA = WS_OX + (size_t)NT * 256 * 4;
constexpr size_t WS_ORETN = WS_OMLA + (size_t)NT * 1024 * 4;
constexpr size_t WS_ARET = WS_ORETN + (size_t)NT * 1024 * 4;
constexpr size_t WS_AMLA = WS_ARET + (size_t)NT * 1024 * 4;
constexpr size_t WS_AX = WS_AMLA + (size_t)NT * 1024 * 4;
constexpr size_t WS_MIX = WS_AX + (size_t)NT * 1024 * 4;
constexpr size_t WS_HP = WS_MIX + (size_t)NT * 1024 * 4;
constexpr size_t WS_H = WS_HP + (size_t)NT * 1024 * 4;
constexpr size_t WS_F = WS_H + (size_t)NT * 1024 * 4;
constexpr size_t WS_GG = WS_F + (size_t)NT * 1024 * 4;
constexpr size_t WS_UP = WS_GG + (size_t)NT * DFF * 4;
constexpr size_t WS_ACT = WS_UP + (size_t)NT * DFF * 4;
constexpr size_t WS_FO = WS_ACT + (size_t)NT * DFF * 4;
constexpr size_t WS_F32_END = WS_FO + (size_t)NT * 1024 * 4;
constexpr size_t WS_WIN_T = al256(WS_F32_END);
constexpr size_t WS_WMKV_T = WS_WIN_T + (size_t)ZLD * 1024 * 2;
constexpr size_t WS_WUQ_T = WS_WMKV_T + (size_t)512 * 1024 * 2;
constexpr size_t WS_WRO_T = WS_WUQ_T + (size_t)1536 * 384 * 2;
constexpr size_t WS_WMO_T = WS_WRO_T + (size_t)1024 * 1024 * 2;
constexpr size_t WS_WXO_T = WS_WMO_T + (size_t)1024 * 1024 * 2;
constexpr size_t WS_WO_T = WS_WXO_T + (size_t)1024 * 256 * 2;
constexpr size_t WS_WGU_T = WS_WO_T + (size_t)1024 * 1024 * 2;
constexpr size_t WS_WD_T = WS_WGU_T + (size_t)5632 * 1024 * 2;
constexpr size_t WS_UB = WS_WD_T + (size_t)1024 * 2816 * 2;
constexpr size_t WS_MNB = WS_UB + (size_t)NT * 1024 * 2;
constexpr size_t WS_CQNB = WS_MNB + (size_t)2048 * 1024 * 2;
constexpr size_t WS_ORETNB = WS_CQNB + (size_t)NT * 384 * 2;
constexpr size_t WS_OMLAB = WS_ORETNB + (size_t)NT * 1024 * 2;
constexpr size_t WS_OXB = WS_OMLAB + (size_t)NT * 1024 * 2;
constexpr size_t WS_MIXB = WS_OXB + (size_t)NT * 256 * 2;
constexpr size_t WS_FB = WS_MIXB + (size_t)NT * 1024 * 2;
constexpr size_t WS_ACTB = WS_FB + (size_t)NT * 1024 * 2;
constexpr size_t WS_WUK_T = WS_ACTB + (size_t)NT * 2816 * 2;
constexpr size_t WS_WUV_T = WS_WUK_T + (size_t)1024 * 256 * 2;
constexpr size_t WS_CKVNB = WS_WUV_T + (size_t)1024 * 256 * 2;
constexpr size_t WS_KPERB = WS_CKVNB + (size_t)NT * 256 * 2;
constexpr size_t WS_XQB = WS_KPERB + (size_t)NT * 64 * 2;
constexpr size_t WS_MKB = WS_XQB + (size_t)NT * 256 * 2;
constexpr size_t WS_MVT = WS_MKB + (size_t)2048 * 256 * 2;
constexpr size_t WS_KN = WS_MVT + (size_t)2048 * 256 * 2;
constexpr size_t WS_VT = WS_KN + (size_t)NP * 1024 * 2;
constexpr size_t WS_QB = WS_VT + (size_t)NP * 1024 * 2;
constexpr size_t WS_RQT = WS_QB + (size_t)NT * 1536 * 2;
constexpr size_t WS_RKT = WS_RQT + (size_t)NP * 512 * 2;
constexpr size_t WS_RKTT = WS_RKT + (size_t)NP * 512 * 2;
constexpr size_t WS_RVT = WS_RKTT + (size_t)NP * 512 * 2;
constexpr size_t WS_UT = WS_RVT + (size_t)NT * 1024 * 2;
constexpr size_t WS_SPT = WS_UT + (size_t)512 * 32768 * 4;
constexpr size_t WS_END = WS_SPT + (size_t)512 * 32768 * 2;

constexpr int CW_BAR = 4096;

#define XB_TMO      128
#define XB_XCNT(j)  (256  + 64 * (j))
#define XB_XSUB(j)  (1280 + 64 * (j))
#define XB_XGEN(j)  (2304 + 64 * (j))
#define XB_TOP      3328
#define XB_TOPGEN   3392
#define XCD_BAR_WORDS 3456
#define XB_SPIN_CAP (1u << 25)

DI unsigned xb_ld(unsigned* p)              { return __hip_atomic_load(p, __ATOMIC_RELAXED, __HIP_MEMORY_SCOPE_AGENT); }
DI unsigned xb_add(unsigned* p, unsigned v) { return __hip_atomic_fetch_add(p, v, __ATOMIC_RELAXED, __HIP_MEMORY_SCOPE_AGENT); }
DI unsigned xb_xcc_id() { return (unsigned)__builtin_amdgcn_s_getreg((3 << 11) | 20) & 0xFu; }
#define XB_SPIN(cond, bar) do { unsigned _sp = 0; while (cond) { __builtin_amdgcn_s_sleep(1); \
    if ((++_sp & 255u) == 0u) { if (xb_ld(&(bar)[XB_TMO])) break; if (_sp > XB_SPIN_CAP) { atomicAdd(&(bar)[XB_TMO], 1u); break; } } } } while (0)

struct XcdBarrier { unsigned* bar; unsigned x; volatile LAS unsigned* st; };

DI XcdBarrier xcd_barrier_post(unsigned* bar, volatile LAS unsigned* st) {
    XcdBarrier b; b.bar = bar; b.x = xb_xcc_id(); b.st = st;
    if (threadIdx.x == 0) (void)xb_add(&bar[XB_XCNT(b.x)], 1u);
    return b;
}
DI void xcd_barrier_complete(unsigned* bar, unsigned x, unsigned& nloc, unsigned& nx) {
    const unsigned G = gridDim.x * gridDim.y * gridDim.z;
    unsigned sum, cnt, mine, sp = 0u;
    for (;;) {
        sum = 0u; cnt = 0u; mine = 0u;
#pragma unroll
        for (unsigned j = 0; j < 16; ++j) { const unsigned c = xb_ld(&bar[XB_XCNT(j)]); sum += c; cnt += (c > 0u) ? 1u : 0u; mine = (j == x) ? c : mine; }
        if (sum == G) break;
        __builtin_amdgcn_s_sleep(1);
        if ((++sp & 255u) == 0u) { if (xb_ld(&bar[XB_TMO])) break; if (sp > XB_SPIN_CAP) { atomicAdd(&bar[XB_TMO], 1u); break; } }
    }
    nloc = mine > 0u ? mine : 1u; nx = cnt > 0u ? cnt : 1u;
}
DI void xcd_barrier(const XcdBarrier& b) {
    asm volatile("s_waitcnt vmcnt(0)" ::: "memory");
    __syncthreads();
    if (threadIdx.x == 0) {
        unsigned* bar = b.bar;
        __builtin_amdgcn_s_waitcnt(0);
        unsigned nloc = b.st[0], nx = b.st[1];
        if (nloc == 0u) { xcd_barrier_complete(bar, b.x, nloc, nx); b.st[0] = nloc; b.st[1] = nx; }
        const unsigned old = xb_add(&bar[XB_XSUB(b.x)], 1u);
        const unsigned gen = old / nloc;
        if (old + 1u == (gen + 1u) * nloc) {
            __builtin_amdgcn_fence(__ATOMIC_RELEASE, "agent");
            asm volatile("s_waitcnt vmcnt(0)" ::: "memory");
            const unsigned og = xb_add(&bar[XB_TOP], 1u);
            const unsigned tg = og / nx;
            if (og + 1u == (tg + 1u) * nx) xb_add(&bar[XB_TOPGEN], 1u);
            else XB_SPIN(xb_ld(&bar[XB_TOPGEN]) == tg, bar);
            __builtin_amdgcn_fence(__ATOMIC_ACQUIRE, "agent");
            xb_add(&bar[XB_XGEN(b.x)], 1u);
            asm volatile("s_waitcnt vmcnt(0)" ::: "memory");
        } else {
            XB_SPIN(xb_ld(&bar[XB_XGEN(b.x)]) == gen, bar);
            __builtin_amdgcn_fence(__ATOMIC_ACQUIRE, "agent");
            asm volatile("s_waitcnt vmcnt(0)" ::: "memory");
        }
    }
    __syncthreads();
}

DI float wave_sum(float v) {
#pragma unroll
    for (int o = 1; o < 64; o <<= 1) v += __shfl_xor(v, o);
    return v;
}
DI float wave_max(float v) {
#pragma unroll
    for (int o = 1; o < 64; o <<= 1) v = fmaxf(v, __shfl_xor(v, o));
    return v;
}
DI float sigmoidf_(float x) { return 1.f / (1.f + expf(-x)); }
DI float siluf_(float x) { return x / (1.f + expf(-x)); }
DI int pos_index(int row) { return row < NP ? (row & (SEQ - 1)) : SEQ + ((row - NP) & (DS - 1)); }
DI float lg_gamma(int h) { return log1pf(-exp2f(-5.0f - (float)h)); }


namespace pg8 {
typedef unsigned short bf16_t;
typedef short bf16x8 __attribute__((ext_vector_type(8)));
typedef unsigned u32x4 __attribute__((ext_vector_type(4)));
typedef unsigned u32x2 __attribute__((ext_vector_type(2)));
constexpr int BM = 256, BK = 64, HALF = 128, HTB = HALF * BK * 2, STAGE_BYTES = 8 * HTB, NXCD = 8, WGM = 8;
__host__ __device__ __forceinline__ int lds_byte(int r, int c) { const int st = (r >> 4) * 2 + (c >> 5), rr = r & 15, cc = c & 31, ob = rr * 64 + cc * 2; return st * 1024 + (ob ^ (((ob >> 9) & 1) << 5)); }
__host__ __device__ __forceinline__ void stage_rc(int b, int& R, int& C) { const int st = b / 1024, sb = b % 1024, swz = sb ^ (((sb >> 9) & 1) << 5); R = (st >> 1) * 16 + swz / 64; C = (st & 1) * 32 + (swz % 64) / 2; }
__host__ __device__ __forceinline__ int perm32(int rho) { const int n = rho >> 4, i = rho & 15; return 8 * (i >> 2) + 4 * n + (i & 3); }
struct Unit { int pm, pn; };
struct Gemm { const bf16_t* A; const bf16_t* Bt; int M, N, K, lda, ldb; };
struct StaticOrder {
    int nM, nN, nwg, G, c;
    __host__ __device__ void init(int M, int N, int G_, int c_) { nM = M / BM; nN = N / BM; nwg = nM * nN; G = G_; c = c_; }
    __host__ __device__ bool next(int i, Unit& u) const {
        const long L = (long)i * G + c; if (L >= nwg) return false;
        int wgid = (int)L; { const int q = nwg / NXCD, r = nwg % NXCD, xcd = wgid % NXCD, off = wgid / NXCD; wgid = (xcd < r ? xcd * (q + 1) : r * (q + 1) + (xcd - r) * q) + off; }
        const int nig = WGM * nN, gid = wgid / nig, fm = gid * WGM, gsz = (nM - fm) < WGM ? (nM - fm) : WGM;
        u.pm = fm + ((wgid % nig) % gsz); u.pn = (wgid % nig) / gsz; return true;
    }
    __device__ __forceinline__ void a_ready(const Unit&) const {}
    __device__ __forceinline__ void done(const Unit&) const {}
};
__device__ __forceinline__ unsigned cvt_pk_bf16(float lo, float hi) { unsigned r; asm volatile("v_cvt_pk_bf16_f32 %0, %1, %2" : "=v"(r) : "v"(lo), "v"(hi)); return r; }
struct EpiF32S {
    static constexpr bool PERM = false, AFTER_DRAIN = false;
    float* C; int ldc; int split_tiles; size_t split_stride;
    __device__ __forceinline__ void operator()(const f32x4 (&acc)[2][2][4][2], const Unit& u, int wr, int wc, int fr, int fq) const {
        int pn = u.pn; float* base = C; if (split_tiles) { const int t = pn / split_tiles; base += (size_t)t * split_stride; pn -= t * split_tiles; }
        const int row0 = u.pm * BM + wr * 64 + fr, col0 = pn * BM + wc * 32 + 4 * fq;
#pragma unroll
        for (int ai = 0; ai < 2; ++ai)
#pragma unroll
            for (int m = 0; m < 4; ++m) { float* rowp = base + (size_t)(row0 + ai * HALF + m * 16) * ldc + col0;
#pragma unroll
                for (int bj = 0; bj < 2; ++bj)
#pragma unroll
                    for (int n = 0; n < 2; ++n) *(f32x4*)(rowp + bj * HALF + n * 16) = acc[ai][bj][m][n]; }
    }
};
struct EpiBf16S {
    static constexpr bool PERM = true, AFTER_DRAIN = false;
    bf16_t* O; int ldc;
    __device__ __forceinline__ void operator()(const f32x4 (&acc)[2][2][4][2], const Unit& u, int wr, int wc, int fr, int fq) const {
        const int row0 = u.pm * BM + wr * 64 + fr, col0 = u.pn * BM + wc * 32 + 8 * fq;
#pragma unroll
        for (int ai = 0; ai < 2; ++ai)
#pragma unroll
            for (int m = 0; m < 4; ++m) { bf16_t* rowp = O + (size_t)(row0 + ai * HALF + m * 16) * ldc + col0;
#pragma unroll
                for (int bj = 0; bj < 2; ++bj) { const f32x4 v0 = acc[ai][bj][m][0], v1 = acc[ai][bj][m][1];
                    u32x4 w; w.x = cvt_pk_bf16(v0[0], v0[1]); w.y = cvt_pk_bf16(v0[2], v0[3]); w.z = cvt_pk_bf16(v1[0], v1[1]); w.w = cvt_pk_bf16(v1[2], v1[3]);
                    *(u32x4*)(rowp + bj * HALF) = w; } }
    }
};
template <class Epi, class Sched, bool ALIGN_EPI = false, bool SP2 = false>
__device__ __forceinline__ void gemm_phase(LAS unsigned char* lds, const Gemm g, const Sched& S, const Epi& E) {
    const int tid = threadIdx.x, wid = __builtin_amdgcn_readfirstlane(tid >> 6), lane = tid & 63, wr = wid >> 2, wc = wid & 3, fr = lane & 15, fq = lane >> 4;
    const int K = g.K, nt = K / BK;
    unsigned voffA[2], voffB[2];
#pragma unroll
    for (int i = 0; i < 2; ++i) { int R, C; stage_rc(tid * 16 + i * 8192, R, C); const int Rb = Epi::PERM ? ((R & ~31) + perm32(R & 31)) : R;
        voffA[i] = (unsigned)(R * g.lda + C) * 2u; voffB[i] = (unsigned)(Rb * g.ldb + C) * 2u; }
    const size_t kstep = (size_t)(BK * 2);
    const size_t hstepA = (size_t)HALF * g.lda * 2, hstepB = (size_t)HALF * g.ldb * 2;
    const size_t tstepA = 2 * hstepA, tstepB = 2 * hstepB;
    const unsigned ldsw = (unsigned)wid * 1024u;
    const int aoff = lds_byte(wr * 64 + fr, fq * 8), boff = lds_byte(wc * 32 + fr, fq * 8);
#define PG8_SA(b, h) (((b) * 2 + (h)) * HTB)
#define PG8_SB(b, h) ((4 + (b) * 2 + (h)) * HTB)
#define PG8_STAGE(bufoff, gbase, voff) do { _Pragma("unroll") for (int _i = 0; _i < 2; ++_i) \
        __builtin_amdgcn_global_load_lds((const unsigned*)((const char*)(gbase) + (voff)[_i]), (LAS unsigned*)(lds + (bufoff) + ldsw + _i * 8192), 16, 0, 0); } while (0)
#define PG8_LDA(dst, b, h) do { _Pragma("unroll") for (int m = 0; m < 4; ++m) _Pragma("unroll") for (int k = 0; k < 2; ++k) dst[m][k] = *(const LAS bf16x8*)(lds + PG8_SA(b, h) + aoff + m * 2048 + k * 1024); } while (0)
#define PG8_LDB(dst, b, h) do { _Pragma("unroll") for (int n = 0; n < 2; ++n) _Pragma("unroll") for (int k = 0; k < 2; ++k) dst[n][k] = *(const LAS bf16x8*)(lds + PG8_SB(b, h) + boff + n * 2048 + k * 1024); } while (0)
#define PG8_MMA(ai, bj, At, Bt) do { __builtin_amdgcn_s_setprio(1); _Pragma("unroll") for (int m = 0; m < 4; ++m) _Pragma("unroll") for (int n = 0; n < 2; ++n) _Pragma("unroll") for (int k = 0; k < 2; ++k) \
        acc[ai][bj][m][n] = __builtin_amdgcn_mfma_f32_16x16x32_bf16(Bt[n][k], At[m][k], acc[ai][bj][m][n], 0, 0, 0); __builtin_amdgcn_s_setprio(0); } while (0)
#define PG8_WAIT_V(n) asm volatile("s_waitcnt vmcnt(" #n ")" ::: "memory")
#define PG8_WAIT_L(n) asm volatile("s_waitcnt lgkmcnt(" #n ")" ::: "memory")
#define PG8_BAR __builtin_amdgcn_s_barrier()
#define PG8_SCHED __builtin_amdgcn_sched_barrier(0)
    Unit cur, nxt; int ui = 0;
    if (!S.next(0, cur)) return;
    f32x4 acc[2][2][4][2];
#pragma unroll
    for (int a = 0; a < 2; ++a)
#pragma unroll
        for (int b = 0; b < 2; ++b)
#pragma unroll
            for (int m = 0; m < 4; ++m)
#pragma unroll
                for (int n = 0; n < 2; ++n) acc[a][b][m][n] = (f32x4){0.f, 0.f, 0.f, 0.f};
    bf16x8 At[4][2], B0[2][2], B1[2][2];
    const char* cA = (const char*)g.A + (size_t)cur.pm * tstepA; const char* cB = (const char*)g.Bt + (size_t)cur.pn * tstepB;
    S.a_ready(cur);
    if constexpr (SP2) {
        PG8_STAGE(PG8_SB(0, 0), cB, voffB); PG8_STAGE(PG8_SB(0, 1), cB + hstepB, voffB); PG8_STAGE(PG8_SA(0, 0), cA, voffA); PG8_STAGE(PG8_SA(0, 1), cA + hstepA, voffA);
        if (wr == 1) PG8_BAR;
        PG8_WAIT_V(2); PG8_BAR;
        PG8_STAGE(PG8_SB(1, 0), cB + kstep, voffB); PG8_STAGE(PG8_SA(1, 0), cA + kstep, voffA); PG8_STAGE(PG8_SB(1, 1), cB + hstepB + kstep, voffB);
        PG8_WAIT_V(6); PG8_BAR;
    } else {
        PG8_STAGE(PG8_SB(0, 0), cB, voffB); PG8_STAGE(PG8_SA(0, 0), cA, voffA); PG8_STAGE(PG8_SB(0, 1), cB + hstepB, voffB); PG8_STAGE(PG8_SA(0, 1), cA + hstepA, voffA);
        if (wr == 1) PG8_BAR;
        PG8_WAIT_V(4); PG8_BAR;
        PG8_STAGE(PG8_SB(1, 0), cB + kstep, voffB); PG8_STAGE(PG8_SA(1, 0), cA + kstep, voffA); PG8_STAGE(PG8_SB(1, 1), cB + hstepB + kstep, voffB);
        PG8_WAIT_V(6); PG8_BAR;
    }
    for (;;) {
        const bool has_next = S.next(ui + 1, nxt);
        const char* nA = has_next ? (const char*)g.A + (size_t)nxt.pm * tstepA : cA; const char* nB = has_next ? (const char*)g.Bt + (size_t)nxt.pn * tstepB : cB;
#pragma unroll 1
        for (int t = 0; t < nt; t += 2) {
            const bool last = (t == nt - 2);
            const char* a1 = cA + (size_t)(t + 1) * kstep;
            const char* a2 = last ? nA : cA + (size_t)(t + 2) * kstep; const char* b2 = last ? nB : cB + (size_t)(t + 2) * kstep;
            const char* a3 = a2 + kstep; const char* b3 = b2 + kstep;
            if (last && has_next) S.a_ready(nxt);
            if constexpr (SP2) {
            PG8_LDB(B0, 0, 0); PG8_LDB(B1, 0, 1); PG8_SCHED; PG8_LDA(At, 0, 0); PG8_STAGE(PG8_SA(1, 1), a1 + hstepA, voffA);
            PG8_WAIT_V(8); PG8_WAIT_L(0); PG8_BAR; PG8_MMA(0, 0, At, B0); PG8_MMA(0, 1, At, B1); PG8_BAR; PG8_SCHED;
            PG8_LDA(At, 0, 1); PG8_STAGE(PG8_SB(0, 0), b2, voffB); PG8_STAGE(PG8_SB(0, 1), b2 + hstepB, voffB); PG8_STAGE(PG8_SA(0, 0), a2, voffA);
            PG8_WAIT_V(8); PG8_WAIT_L(0); PG8_BAR; PG8_MMA(1, 0, At, B0); PG8_MMA(1, 1, At, B1); PG8_BAR; PG8_SCHED;
            PG8_LDB(B0, 1, 0); PG8_LDB(B1, 1, 1); PG8_SCHED; PG8_LDA(At, 1, 0); PG8_STAGE(PG8_SA(0, 1), a2 + hstepA, voffA);
            PG8_WAIT_V(8); PG8_WAIT_L(0); PG8_BAR; PG8_MMA(0, 0, At, B0); PG8_MMA(0, 1, At, B1); PG8_BAR; PG8_SCHED;
            PG8_LDA(At, 1, 1); PG8_STAGE(PG8_SB(1, 0), b3, voffB); PG8_STAGE(PG8_SB(1, 1), b3 + hstepB, voffB); PG8_STAGE(PG8_SA(1, 0), a3, voffA);
            PG8_WAIT_V(8); PG8_WAIT_L(0); PG8_BAR; PG8_MMA(1, 0, At, B0); PG8_MMA(1, 1, At, B1); PG8_BAR; PG8_SCHED;
            } else {
            PG8_LDB(B0, 0, 0); PG8_SCHED; PG8_LDA(At, 0, 0); PG8_STAGE(PG8_SA(1, 1), a1 + hstepA, voffA);
            PG8_WAIT_L(8); PG8_BAR; PG8_WAIT_L(0); PG8_MMA(0, 0, At, B0); PG8_BAR; PG8_SCHED;
            PG8_LDB(B1, 0, 1); PG8_STAGE(PG8_SB(0, 0), b2, voffB);
            PG8_BAR; PG8_WAIT_L(0); PG8_MMA(0, 1, At, B1); PG8_BAR;
            PG8_LDA(At, 0, 1); PG8_STAGE(PG8_SA(0, 0), a2, voffA);
            PG8_BAR; PG8_WAIT_L(0); PG8_MMA(1, 0, At, B0); PG8_BAR; PG8_SCHED;
            PG8_STAGE(PG8_SB(0, 1), b2 + hstepB, voffB);
            PG8_WAIT_V(6); PG8_BAR; PG8_MMA(1, 1, At, B1); PG8_BAR;
            PG8_LDB(B0, 1, 0); PG8_SCHED; PG8_LDA(At, 1, 0); PG8_STAGE(PG8_SA(0, 1), a2 + hstepA, voffA);
            PG8_WAIT_L(8); PG8_BAR; PG8_WAIT_L(0); PG8_MMA(0, 0, At, B0); PG8_BAR; PG8_SCHED;
            PG8_LDB(B1, 1, 1); PG8_STAGE(PG8_SB(1, 0), b3, voffB);
            PG8_BAR; PG8_WAIT_L(0); PG8_MMA(0, 1, At, B1); PG8_BAR;
            PG8_LDA(At, 1, 1); PG8_STAGE(PG8_SA(1, 0), a3, voffA);
            PG8_BAR; PG8_WAIT_L(0); PG8_MMA(1, 0, At, B0); PG8_BAR; PG8_SCHED;
            PG8_STAGE(PG8_SB(1, 1), b3 + hstepB, voffB);
            PG8_WAIT_V(6); PG8_BAR; PG8_MMA(1, 1, At, B1); PG8_BAR;
            }
        }
        if constexpr (ALIGN_EPI) { if (wr == 0) PG8_BAR; }
        if constexpr (!Epi::AFTER_DRAIN) { E(acc, cur, wr, wc, fr, fq); S.done(cur); }
        if (!has_next) break;
#pragma unroll
        for (int a = 0; a < 2; ++a)
#pragma unroll
            for (int b = 0; b < 2; ++b)
#pragma unroll
                for (int m = 0; m < 4; ++m)
#pragma unroll
                    for (int n = 0; n < 2; ++n) acc[a][b][m][n] = (f32x4){0.f, 0.f, 0.f, 0.f};
        cur = nxt; cA = nA; cB = nB; ++ui;
        if constexpr (ALIGN_EPI) { if (wr == 1) PG8_BAR; }
    }
    PG8_WAIT_V(0);
    if constexpr (!ALIGN_EPI) { if (wr == 0) PG8_BAR; }
    PG8_BAR;
    if constexpr (Epi::AFTER_DRAIN) { E.fused(acc, cur, wr, wc, fr, fq, lds, wid, lane); S.done(cur); }
#undef PG8_SA
#undef PG8_SB
#undef PG8_STAGE
#undef PG8_LDA
#undef PG8_LDB
#undef PG8_MMA
#undef PG8_WAIT_V
#undef PG8_WAIT_L
#undef PG8_BAR
#undef PG8_SCHED
}
}
typedef unsigned short bf16_t;
DI unsigned pk2(float lo, float hi) { return pg8::cvt_pk_bf16(lo, hi); }
DI bf16_t f2bf(float f) { return (bf16_t)(pg8::cvt_pk_bf16(f, 0.f) & 0xffffu); }
DI void transpose_item(const float* W, int N, bf16_t* WT, int ldt, int row_off, LAS float* scr, int item, int lane) {
    const int nblk = N / 32, kb = item / nblk, nb = item % nblk, k0 = 64 * kb, n0 = 32 * nb;
#pragma unroll 8
    for (int i = 0; i < 32; ++i) { const int kk = 2 * i + (lane >> 5); scr[kk * 33 + (lane & 31)] = W[(size_t)(k0 + kk) * N + n0 + (lane & 31)]; }
    asm volatile("s_waitcnt lgkmcnt(0)" ::: "memory");
    const int c = lane & 7;
#pragma unroll
    for (int j = 0; j < 4; ++j) { const int n = (lane >> 3) + 8 * j; const LAS float* sp = scr + (8 * c) * 33 + n;
        pg8::u32x4 o; o.x = pk2(sp[0 * 33], sp[1 * 33]); o.y = pk2(sp[2 * 33], sp[3 * 33]); o.z = pk2(sp[4 * 33], sp[5 * 33]); o.w = pk2(sp[6 * 33], sp[7 * 33]);
        *(pg8::u32x4*)(WT + (size_t)(row_off + n0 + n) * ldt + k0 + 8 * c) = o; }
    asm volatile("s_waitcnt lgkmcnt(0)" ::: "memory");
}
DI void transpose_w(const float* W, int K, int N, bf16_t* WT, int ldt, int row_off, LAS float* scr, int gw, int NGW, int lane) {
    const int nitems = (K / 64) * (N / 32);
    for (int it = gw; it < nitems; it += NGW) transpose_item(W, N, WT, ldt, row_off, scr, it, lane);
}

struct Args {
    const float* in[29]; float* out; unsigned char* ws; int ph_lo, ph_hi;
};

DI unsigned short f2bf_raw(float f) { unsigned u = __builtin_bit_cast(unsigned, f); return (unsigned short)((u + 0x7fffu + ((u >> 16) & 1u)) >> 16); }
DI void sgemm_naive(LAS float* lds, const float* __restrict__ A, int lda, const float* __restrict__ B, long sbk, long sbn,
                    float* __restrict__ C, int ldc, int M, int N, int K, int bid, int G, unsigned short* Cb = nullptr) {
    LAS float* As = lds;
    LAS float* Bs = lds + 16 * 132;
    const int tid = threadIdx.x, tx = tid & 15, ty = tid >> 4;
    const int ntn = N / 64, ntiles = (M / 128) * ntn;
    for (int t = bid; t < ntiles; t += G) {
        const int m0 = (t / ntn) * 128, n0 = (t % ntn) * 64;
        float acc[4][4];
#pragma unroll
        for (int i = 0; i < 4; ++i)
#pragma unroll
            for (int j = 0; j < 4; ++j) acc[i][j] = 0.f;
        for (int k0 = 0; k0 < K; k0 += 16) {
            {
                const int r = tid >> 2, kq = (tid & 3) * 4;
                const float4 v = *(const float4*)(A + (size_t)(m0 + r) * lda + k0 + kq);
                As[(kq + 0) * 132 + r] = v.x; As[(kq + 1) * 132 + r] = v.y; As[(kq + 2) * 132 + r] = v.z; As[(kq + 3) * 132 + r] = v.w;
            }
#pragma unroll
            for (int i = 0; i < 2; ++i) {
                const int idx = tid + i * 512, kk = idx >> 6, nn = idx & 63;
                Bs[kk * 64 + nn] = B[(size_t)(k0 + kk) * sbk + (size_t)(n0 + nn) * sbn];
            }
            __syncthreads();
#pragma unroll
            for (int kk = 0; kk < 16; ++kk) {
                const f32x4 a = *(const LAS f32x4*)(As + kk * 132 + ty * 4);
                const f32x4 b = *(const LAS f32x4*)(Bs + kk * 64 + tx * 4);
                const float av[4] = {a.x, a.y, a.z, a.w}, bv[4] = {b.x, b.y, b.z, b.w};
#pragma unroll
                for (int i = 0; i < 4; ++i)
#pragma unroll
                    for (int j = 0; j < 4; ++j) acc[i][j] += av[i] * bv[j];
            }
            __syncthreads();
        }
#pragma unroll
        for (int i = 0; i < 4; ++i) {
            float4 o; o.x = acc[i][0]; o.y = acc[i][1]; o.z = acc[i][2]; o.w = acc[i][3];
            if (Cb) { unsigned short* cb = Cb + (size_t)(m0 + ty * 4 + i) * ldc + n0 + tx * 4; cb[0] = f2bf_raw(o.x); cb[1] = f2bf_raw(o.y); cb[2] = f2bf_raw(o.z); cb[3] = f2bf_raw(o.w); }
            else *(float4*)(C + (size_t)(m0 + ty * 4 + i) * ldc + n0 + tx * 4) = o;
        }
    }
}

template <int DQK, int DV, bool V_IN_K, int MODE, class KV, class QF>
DI void attn_naive(LAS float* lds, const KV& kv, int nk_loop, const QF& qf, bool active, int limit, float scale, float lg, int tq, float* optr) {
    constexpr int KS = DQK + 1;
    constexpr int VS = V_IN_K ? KS : DV;
    LAS float* Ks = lds;
    LAS float* Vs = V_IN_K ? Ks : (lds + 64 * KS);
    LAS float* qs = lds + 64 * KS + (V_IN_K ? 0 : 64 * DV);
    LAS float* ps = qs + 8 * DQK;
    static_assert((64 * KS + (V_IN_K ? 0 : 64 * DV) + 8 * DQK + 8 * 64) * 4 <= MISC_OFF, "attn_naive LDS");
    const int tid = threadIdx.x, lane = tid & 63, w = tid >> 6;
    __syncthreads();
    for (int d = lane; d < DQK; d += 64) qs[w * DQK + d] = active ? qf(d) : 0.f;
    float m = -INFINITY, l = 0.f;
    float acc[DV / 64];
#pragma unroll
    for (int c = 0; c < DV / 64; ++c) acc[c] = 0.f;
    for (int base = 0; base < nk_loop; base += 64) {
        __syncthreads();
        for (int idx = tid; idx < 64 * DQK; idx += NTHREADS) { const int j = idx / DQK, d = idx - j * DQK, key = base + j; Ks[j * KS + d] = key < nk_loop ? kv.k(key, d) : 0.f; }
        if (!V_IN_K) for (int idx = tid; idx < 64 * DV; idx += NTHREADS) { const int j = idx / DV, e = idx - j * DV, key = base + j; Vs[j * DV + e] = key < nk_loop ? kv.v(key, e) : 0.f; }
        __syncthreads();
        const int key = base + lane; const bool valid = active && key <= limit && key < nk_loop;
        float s = 0.f;
        for (int d = 0; d < DQK; ++d) s += qs[w * DQK + d] * Ks[lane * KS + d];
        float p;
        if (MODE == 0) {
            s *= scale;
            const float cm = wave_max(valid ? s : -INFINITY);
            const float mn = fmaxf(m, cm);
            const float alpha = (mn == -INFINITY) ? 1.f : expf(m - mn);
            p = valid ? expf(s - mn) : 0.f;
            l = l * alpha + wave_sum(p);
#pragma unroll
            for (int c = 0; c < DV / 64; ++c) acc[c] *= alpha;
            m = mn;
        } else {
            p = valid ? s * expf((float)(tq - key) * lg) : 0.f;
        }
        ps[w * 64 + lane] = p;
        __syncthreads();
        for (int j = 0; j < 64; ++j) { const float pj = ps[w * 64 + j];
#pragma unroll
            for (int c = 0; c < DV / 64; ++c) acc[c] += pj * Vs[j * VS + lane + 64 * c]; }
    }
    if (active) {
#pragma unroll
        for (int c = 0; c < DV / 64; ++c) optr[lane + 64 * c] = (MODE == 0) ? acc[c] / l : acc[c];
    }
}

struct KvMlaPrompt { const float* ckvn; const float* kper; int b;
    DI float k(int key, int d) const { const size_t row = (size_t)b * SEQ + key; return d < KVL ? ckvn[row * KVL + d] : kper[row * DROPE + (d - KVL)]; }
    DI float v(int, int) const { return 0.f; } };
struct KvMlaSample { const float* ckvn; const float* kper; const float* cckv; const float* ckpe; const int* pt; int b;
    DI float k(int key, int d) const {
        if (key < PAST) { const size_t r = (size_t)pt[b * NPAGES + (key >> 7)] * PAGE + (key & (PAGE - 1)); return d < KVL ? cckv[r * KVL + d] : ckpe[r * DROPE + (d - KVL)]; }
        const size_t row = (size_t)NP + b * DS + (key - PAST); return d < KVL ? ckvn[row * KVL + d] : kper[row * DROPE + (d - KVL)]; }
    DI float v(int, int) const { return 0.f; } };
struct KvRet { const float* rk; const float* z; int b, h;
    DI float k(int key, int d) const { return rk[((size_t)b * SEQ + key) * 512 + h * RDK + d]; }
    DI float v(int key, int e) const { return z[((size_t)b * SEQ + key) * ZLD + C_RV + h * RDV + e]; } };
struct KvMem { const float* mk; const float* mv; int b, h;
    DI float k(int key, int d) const { return mk[(((size_t)b * NMEM + key) * XH + h) * XHD + d]; }
    DI float v(int key, int e) const { return mv[(((size_t)b * NMEM + key) * XH + h) * XHD + e]; } };


typedef float f32x16 __attribute__((ext_vector_type(16)));
typedef short bf16x8 __attribute__((ext_vector_type(8)));
typedef short s16x4 __attribute__((ext_vector_type(4)));
typedef __bf16 bf16x2_t __attribute__((ext_vector_type(2)));
typedef float f32x2_t __attribute__((ext_vector_type(2)));
typedef unsigned u32x4_t __attribute__((ext_vector_type(4)));
typedef unsigned u32x2_t __attribute__((ext_vector_type(2)));
DI unsigned cvtpk(float lo, float hi) { f32x2_t v = {lo, hi}; bf16x2_t b = __builtin_convertvector(v, bf16x2_t); return __builtin_bit_cast(unsigned, b); }
DI int crow(int i, int h) { return (i & 3) + 8 * (i >> 2) + 4 * h; }
#define MFMA32(a, b, c) __builtin_amdgcn_mfma_f32_32x32x16_bf16((a), (b), (c), 0, 0, 0)
template <int DQK, int DV, bool CAUSAL, class Src>
DI void flash_unit(LAS unsigned char* lds, const Src& src, const bf16_t* Q, int ldq, int qpos0, int ntiles, bf16_t* O, int ldo, float c2) {
    constexpr int KP = DQK + 8, VP = 68, KS = DQK / 16, NBLK = DV / 32;
    constexpr int KBYTES = 64 * KP * 2, VBYTES = DV * VP * 2, BUF = KBYTES + VBYTES;
    constexpr int D8 = DQK / 8, NPK = (64 * D8) / NTHREADS, NPV = (DV * 8) / NTHREADS;
    static_assert((64 * D8) % NTHREADS == 0 && (DV * 8) % NTHREADS == 0 && 2 * BUF <= 131072, "flash_unit geometry");
    const int tid = threadIdx.x, lane = tid & 63, w = __builtin_amdgcn_readfirstlane(tid >> 6), l31 = lane & 31, h = lane >> 5;
    bf16x8 qf[KS];
    { const bf16_t* qrow = Q + (size_t)(32 * w + l31) * ldq + h * 8;
#pragma unroll
      for (int s_ = 0; s_ < KS; ++s_) qf[s_] = *(const bf16x8*)(qrow + 16 * s_); }
    f32x16 o[NBLK];
#pragma unroll
    for (int b = 0; b < NBLK; ++b)
#pragma unroll
        for (int i = 0; i < 16; ++i) o[b][i] = 0.f;
    float m = -INFINITY, lsum = 0.f;
    u32x4_t kreg[NPK], vreg[NPV];
#define FL_LOAD(t_) do { _Pragma("unroll") for (int i_ = 0; i_ < NPK; ++i_) { const int p_ = tid + i_ * NTHREADS; kreg[i_] = src.kpiece(64 * (t_) + p_ / D8, p_ % D8); } \
                         _Pragma("unroll") for (int i_ = 0; i_ < NPV; ++i_) { const int p_ = tid + i_ * NTHREADS; vreg[i_] = src.vpiece(p_ >> 3, 64 * (t_) + 8 * (p_ & 7)); } } while (0)
#define FL_STORE(buf_) do { _Pragma("unroll") for (int i_ = 0; i_ < NPK; ++i_) { const int p_ = tid + i_ * NTHREADS; *(LAS u32x4_t*)(lds + (buf_) * BUF + ((p_ / D8) * KP + (p_ % D8) * 8) * 2) = kreg[i_]; } \
                          _Pragma("unroll") for (int i_ = 0; i_ < NPV; ++i_) { const int p_ = tid + i_ * NTHREADS; LAS unsigned char* a_ = lds + (buf_) * BUF + KBYTES + ((p_ >> 3) * VP + (p_ & 7) * 8) * 2; \
                              *(LAS u32x2_t*)a_ = (u32x2_t){vreg[i_].x, vreg[i_].y}; *(LAS u32x2_t*)(a_ + 8) = (u32x2_t){vreg[i_].z, vreg[i_].w}; } } while (0)
    __syncthreads();
    FL_LOAD(0); FL_STORE(0);
    __syncthreads();
    const int qmine = qpos0 + 32 * w + l31, qlast = qpos0 + 32 * w + 31;
    for (int t = 0; t < ntiles; ++t) {
        const int buf = t & 1;
        if (t + 1 < ntiles) FL_LOAD(t + 1);
        if (!CAUSAL || 64 * t <= qlast) {
            const LAS unsigned char* kb_ = lds + buf * BUF; const LAS unsigned char* vb_ = kb_ + KBYTES;
            f32x16 st[2];
#pragma unroll
            for (int kb = 0; kb < 2; ++kb) {
#pragma unroll
                for (int i = 0; i < 16; ++i) st[kb][i] = 0.f;
#pragma unroll
                for (int g_ = 0; g_ < KS / 4; ++g_) { bf16x8 kf[4];
#pragma unroll
                    for (int j = 0; j < 4; ++j) kf[j] = *(const LAS bf16x8*)(kb_ + ((32 * kb + l31) * KP + 16 * (4 * g_ + j) + 8 * h) * 2);
#pragma unroll
                    for (int j = 0; j < 4; ++j) st[kb] = MFMA32(kf[j], qf[4 * g_ + j], st[kb]);
                    __builtin_amdgcn_sched_barrier(0); }
            }
            float mx = -INFINITY;
#pragma unroll
            for (int kb = 0; kb < 2; ++kb)
#pragma unroll
                for (int i = 0; i < 16; ++i) { float v = st[kb][i] * c2; if (CAUSAL) { const int key = 64 * t + 32 * kb + crow(i, h); v = key <= qmine ? v : -INFINITY; } st[kb][i] = v; mx = fmaxf(mx, v); }
            mx = fmaxf(mx, __shfl_xor(mx, 32));
            const float mn = fmaxf(m, mx);
            const float alpha = __builtin_amdgcn_exp2f(m - mn);
            m = mn;
            float ps = 0.f;
#pragma unroll
            for (int kb = 0; kb < 2; ++kb)
#pragma unroll
                for (int i = 0; i < 16; ++i) { const float p = __builtin_amdgcn_exp2f(st[kb][i] - mn); st[kb][i] = p; ps += p; }
            lsum = lsum * alpha + ps;
#pragma unroll
            for (int b = 0; b < NBLK; ++b)
#pragma unroll
                for (int i = 0; i < 16; ++i) o[b][i] *= alpha;
            bf16x8 pf[4];
#pragma unroll
            for (int ks = 0; ks < 4; ++ks) { const int kb = ks >> 1, s2 = ks & 1; u32x4_t pk;
                pk.x = cvtpk(st[kb][8 * s2 + 0], st[kb][8 * s2 + 1]); pk.y = cvtpk(st[kb][8 * s2 + 2], st[kb][8 * s2 + 3]);
                pk.z = cvtpk(st[kb][8 * s2 + 4], st[kb][8 * s2 + 5]); pk.w = cvtpk(st[kb][8 * s2 + 6], st[kb][8 * s2 + 7]); pf[ks] = __builtin_bit_cast(bf16x8, pk); }
            __builtin_amdgcn_sched_barrier(0);
#pragma unroll
            for (int b = 0; b < NBLK; ++b) { bf16x8 vf[4];
#pragma unroll
                for (int ks = 0; ks < 4; ++ks) { const LAS unsigned char* a_ = vb_ + ((32 * b + l31) * VP + 16 * ks + 4 * h) * 2;
                    const s16x4 lo = *(const LAS s16x4*)a_, hi = *(const LAS s16x4*)(a_ + 16);
                    vf[ks] = __builtin_shufflevector(lo, hi, 0, 1, 2, 3, 4, 5, 6, 7); }
#pragma unroll
                for (int ks = 0; ks < 4; ++ks) o[b] = MFMA32(vf[ks], pf[ks], o[b]);
                __builtin_amdgcn_sched_barrier(0); }
        }
        if (t + 1 < ntiles) FL_STORE(buf ^ 1);
        __syncthreads();
    }
#undef FL_LOAD
#undef FL_STORE
    lsum += __shfl_xor(lsum, 32);
    const float inv = 1.f / lsum;
    bf16_t* orow = O + (size_t)(32 * w + l31) * ldo;
#pragma unroll
    for (int b = 0; b < NBLK; ++b)
#pragma unroll
        for (int g = 0; g < 4; ++g) { u32x2_t pk; pk.x = cvtpk(o[b][4 * g + 0] * inv, o[b][4 * g + 1] * inv); pk.y = cvtpk(o[b][4 * g + 2] * inv, o[b][4 * g + 3] * inv);
            *(u32x2_t*)(orow + 32 * b + 8 * g + 4 * h) = pk; }
}
struct SrcMlaP { const bf16_t* kn; const bf16_t* kpe; const bf16_t* vt; int b, hh;
    DI u32x4_t kpiece(int key, int d8) const { const size_t row = (size_t)b * SEQ + key;
        return d8 < 16 ? *(const u32x4_t*)(kn + row * 1024 + hh * DNOPE + d8 * 8) : *(const u32x4_t*)(kpe + row * DROPE + (d8 - 16) * 8); }
    DI u32x4_t vpiece(int dv, int key0) const { return *(const u32x4_t*)(vt + (size_t)(hh * DVH + dv) * NP + (size_t)b * SEQ + key0); } };
struct SrcMemP { const bf16_t* mk; const bf16_t* mvt; int b, hh;
    DI u32x4_t kpiece(int key, int d8) const { return *(const u32x4_t*)(mk + ((size_t)b * NMEM + key) * 256 + hh * XHD + d8 * 8); }
    DI u32x4_t vpiece(int dv, int key0) const { return *(const u32x4_t*)(mvt + (size_t)(hh * XHD + dv) * (NB * NMEM) + (size_t)b * NMEM + key0); } };


DI void ret_chunk_state(const bf16_t* __restrict__ RVT, const bf16_t* __restrict__ RKtT, float* __restrict__ UT, int b, int h, int c) {
    const int tid = threadIdx.x, lane = tid & 63, w = __builtin_amdgcn_readfirstlane(tid >> 6), l31 = lane & 31, hh = lane >> 5;
    const size_t tok0 = (size_t)b * SEQ + c * 128;
    f32x16 acc[4];
#pragma unroll
    for (int kb = 0; kb < 4; ++kb)
#pragma unroll
        for (int i = 0; i < 16; ++i) acc[kb][i] = 0.f;
    const bf16_t* ap = RVT + (size_t)(h * RDV + 32 * w + l31) * NT + tok0 + 8 * hh;
    const bf16_t* bp = RKtT + (size_t)(h * RDK + l31) * NP + tok0 + 8 * hh;
#pragma unroll
    for (int s_ = 0; s_ < 8; ++s_) { const bf16x8 a = *(const bf16x8*)(ap + 16 * s_);
#pragma unroll
        for (int kb = 0; kb < 4; ++kb) { const bf16x8 bfr = *(const bf16x8*)(bp + (size_t)(32 * kb) * NP + 16 * s_); acc[kb] = MFMA32(a, bfr, acc[kb]); } }
    float* u = UT + (size_t)(((b * RH + h) * 16) + c) * 32768;
#pragma unroll
    for (int kb = 0; kb < 4; ++kb)
#pragma unroll
        for (int i = 0; i < 16; ++i) u[(32 * w + crow(i, hh)) * RDK + 32 * kb + l31] = acc[kb][i];
}
DI void ret_chunk_out(const bf16_t* __restrict__ RQt, const bf16_t* __restrict__ RKt, const bf16_t* __restrict__ RVT, const bf16_t* __restrict__ SPT, float* __restrict__ ORET, int b, int h, int c) {
    const int tid = threadIdx.x, lane = tid & 63, w = __builtin_amdgcn_readfirstlane(tid >> 6), l31 = lane & 31, hh = lane >> 5;
    const int ib = w & 3, vh = w >> 2;
    const size_t tok0 = (size_t)b * SEQ + c * 128;
    bf16x8 qf[8];
    { const bf16_t* qp = RQt + (tok0 + 32 * ib + l31) * 512 + h * RDK + 8 * hh;
#pragma unroll
      for (int s_ = 0; s_ < 8; ++s_) qf[s_] = *(const bf16x8*)(qp + 16 * s_); }
    f32x16 o[4];
#pragma unroll
    for (int blk = 0; blk < 4; ++blk)
#pragma unroll
        for (int i = 0; i < 16; ++i) o[blk][i] = 0.f;
    const bf16_t* vbase = RVT + (size_t)(h * RDV + 32 * (4 * vh) + l31) * NT + tok0 + 4 * hh;
#pragma unroll 1
    for (int jb = 0; jb <= ib; ++jb) {
        f32x16 x;
#pragma unroll
        for (int i = 0; i < 16; ++i) x[i] = 0.f;
        const bf16_t* kp = RKt + (tok0 + 32 * jb + l31) * 512 + h * RDK + 8 * hh;
#pragma unroll
        for (int s_ = 0; s_ < 8; ++s_) { const bf16x8 kf = *(const bf16x8*)(kp + 16 * s_); x = MFMA32(kf, qf[s_], x); }
        if (jb == ib) {
#pragma unroll
            for (int i = 0; i < 16; ++i) x[i] = (crow(i, hh) <= l31) ? x[i] : 0.f;
        }
#pragma unroll
        for (int s2 = 0; s2 < 2; ++s2) {
            u32x4_t pk; pk.x = cvtpk(x[8 * s2 + 0], x[8 * s2 + 1]); pk.y = cvtpk(x[8 * s2 + 2], x[8 * s2 + 3]); pk.z = cvtpk(x[8 * s2 + 4], x[8 * s2 + 5]); pk.w = cvtpk(x[8 * s2 + 6], x[8 * s2 + 7]);
            const bf16x8 pa = __builtin_bit_cast(bf16x8, pk);
#pragma unroll
            for (int blk = 0; blk < 4; ++blk) { const bf16_t* vp = vbase + (size_t)(32 * blk) * NT + 32 * jb + 16 * s2;
                const s16x4 lo = *(const s16x4*)vp, hi = *(const s16x4*)(vp + 8);
                const bf16x8 vf = __builtin_shufflevector(lo, hi, 0, 1, 2, 3, 4, 5, 6, 7);
                o[blk] = MFMA32(pa, vf, o[blk]); }
        }
    }
    const bf16_t* sp = SPT + (size_t)(((b * RH + h) * 16) + c) * 32768 + (size_t)(32 * (4 * vh) + l31) * RDK + 8 * hh;
#pragma unroll
    for (int s_ = 0; s_ < 8; ++s_)
#pragma unroll
        for (int blk = 0; blk < 4; ++blk) { const bf16x8 sf = *(const bf16x8*)(sp + (size_t)(32 * blk) * RDK + 16 * s_); o[blk] = MFMA32(qf[s_], sf, o[blk]); }
#pragma unroll
    for (int blk = 0; blk < 4; ++blk)
#pragma unroll
        for (int i = 0; i < 16; ++i) ORET[(tok0 + 32 * ib + crow(i, hh)) * 1024 + h * RDV + 32 * (4 * vh + blk) + l31] = o[blk][i];
}

struct QPtr { const float* p; DI float operator()(int d) const { return p[d]; } };
struct QMla { const float* ql; const float* qp; DI float operator()(int d) const { return d < KVL ? ql[d] : qp[d - KVL]; } };
DI void rms_row(const float* x, const float* g, float* o, int n, int lane) {
    float s = 0.f;
    for (int i = lane; i < n; i += 64) { const float v = x[i]; s += v * v; }
    const float r = rsqrtf(wave_sum(s) / (float)n + EPS);
    for (int i = lane; i < n; i += 64) o[i] = x[i] * r * g[i];
}

DI void rms_row_bf16(const float* x, const float* g, bf16_t* o, int n, int lane) {
    float s = 0.f;
    for (int i = lane; i < n; i += 64) { const float v = x[i]; s += v * v; }
    const float r = rsqrtf(wave_sum(s) / (float)n + EPS);
    for (int i = lane; i < n; i += 64) o[i] = f2bf(x[i] * r * g[i]);
}
#define GEMM_PHASE(EPI, ...) pg8::gemm_phase<EPI, pg8::StaticOrder, true, true>(__VA_ARGS__)
__global__ void __launch_bounds__(NTHREADS, 2) fwd_kernel(Args args) {
    extern __shared__ __attribute__((aligned(16))) unsigned char lds_raw[];
    LAS unsigned char* ldsb = (LAS unsigned char*)lds_raw;
    LAS float* lds = (LAS float*)ldsb;
    volatile LAS unsigned* MISC = (volatile LAS unsigned*)(ldsb + MISC_OFF);
    const int tid = threadIdx.x, lane = tid & 63, wave = tid >> 6;
    const int G = gridDim.x, bid = blockIdx.x;
    const int gw = bid * NWAVES + wave, NGW = G * NWAVES;
    unsigned char* ws = args.ws;
    float* out = args.out;
    const int lo = args.ph_lo, hi = args.ph_hi;

    if (tid < 64) MISC[tid] = 0u;
    __syncthreads();
    XcdBarrier bar; bar.bar = (unsigned*)(ws + WS_CTL) + CW_BAR; bar.x = 0; bar.st = MISC;
    if (hi - lo > 1) bar = xcd_barrier_post((unsigned*)(ws + WS_CTL) + CW_BAR, MISC);
#define IN(k) (lo <= (k) && (k) < hi)
#define SEAM(k) do { if (IN(k) && IN((k) + 1)) xcd_barrier(bar); } while (0)

    const float* x_prompt = args.in[0]; const float* x_sample = args.in[1]; const float* mem_prompt = args.in[2];
    const float* cache_ckv = args.in[3]; const float* cache_kpe = args.in[4]; const int* page_table = (const int*)args.in[5];
    const float* state_ret = args.in[6]; const float* cache_mem_k = args.in[7]; const float* cache_mem_v = args.in[8];
    const float* g_mix_pre = args.in[9]; const float* g_mix_post = args.in[10]; const float* g_ffn_pre = args.in[11]; const float* g_ffn_post = args.in[12];
    const float* g_mem = args.in[13]; const float* g_qlat = args.in[14]; const float* g_kvlat = args.in[15];
    const float* w_in = args.in[16]; const float* w_uq = args.in[17]; const float* w_uk = args.in[18]; const float* w_uv = args.in[19];
    const float* w_mem_k = args.in[20]; const float* w_mem_v = args.in[21]; const float* w_ret_o = args.in[22]; const float* w_mla_o = args.in[23];
    const float* w_x_o = args.in[24]; const float* w_out = args.in[25]; const float* w_gate = args.in[26]; const float* w_up = args.in[27]; const float* w_down = args.in[28];
    float* COSA = (float*)(ws + WS_COSA); float* SINA = (float*)(ws + WS_SINA); float* COSB = (float*)(ws + WS_COSB); float* SINB = (float*)(ws + WS_SINB);
    float* U = (float*)(ws + WS_U); float* MN = (float*)(ws + WS_MN); float* Z = (float*)(ws + WS_Z);
    float* RQ = (float*)(ws + WS_RQ); float* RK = (float*)(ws + WS_RK); float* CQN = (float*)(ws + WS_CQN); float* CKVN = (float*)(ws + WS_CKVN); float* KPER = (float*)(ws + WS_KPER);
    float* Q = (float*)(ws + WS_Q); float* QLAT = (float*)(ws + WS_QLAT); float* QPE = (float*)(ws + WS_QPE);
    float* ORET = (float*)(ws + WS_ORET); float* OLAT = (float*)(ws + WS_OLAT); float* OX = (float*)(ws + WS_OX); float* OMLA = (float*)(ws + WS_OMLA); float* ORETN = (float*)(ws + WS_ORETN);
    float* ARET = (float*)(ws + WS_ARET); float* AMLA = (float*)(ws + WS_AMLA); float* AX = (float*)(ws + WS_AX); float* MIX = (float*)(ws + WS_MIX);
    float* HP = (float*)(ws + WS_HP); float* H = (float*)(ws + WS_H); float* F = (float*)(ws + WS_F);
    float* GU = (float*)(ws + WS_GG); float* FO = (float*)(ws + WS_FO);
    bf16_t* WinT = (bf16_t*)(ws + WS_WIN_T); bf16_t* WmkvT = (bf16_t*)(ws + WS_WMKV_T); bf16_t* WuqT = (bf16_t*)(ws + WS_WUQ_T); bf16_t* WroT = (bf16_t*)(ws + WS_WRO_T);
    bf16_t* WmoT = (bf16_t*)(ws + WS_WMO_T); bf16_t* WxoT = (bf16_t*)(ws + WS_WXO_T); bf16_t* WoT = (bf16_t*)(ws + WS_WO_T); bf16_t* WguT = (bf16_t*)(ws + WS_WGU_T); bf16_t* WdT = (bf16_t*)(ws + WS_WD_T);
    bf16_t* Ub = (bf16_t*)(ws + WS_UB); bf16_t* MNb = (bf16_t*)(ws + WS_MNB); bf16_t* CQNb = (bf16_t*)(ws + WS_CQNB); bf16_t* ORETNb = (bf16_t*)(ws + WS_ORETNB);
    bf16_t* OMLAb = (bf16_t*)(ws + WS_OMLAB); bf16_t* OXb = (bf16_t*)(ws + WS_OXB); bf16_t* MIXb = (bf16_t*)(ws + WS_MIXB); bf16_t* Fb = (bf16_t*)(ws + WS_FB); bf16_t* ACTb = (bf16_t*)(ws + WS_ACTB);
    bf16_t* WukT = (bf16_t*)(ws + WS_WUK_T); bf16_t* WuvT = (bf16_t*)(ws + WS_WUV_T); bf16_t* CKVNb = (bf16_t*)(ws + WS_CKVNB); bf16_t* KPERb = (bf16_t*)(ws + WS_KPERB);
    bf16_t* XQb = (bf16_t*)(ws + WS_XQB); bf16_t* MKb = (bf16_t*)(ws + WS_MKB); bf16_t* MVT = (bf16_t*)(ws + WS_MVT); bf16_t* KN = (bf16_t*)(ws + WS_KN); bf16_t* VT = (bf16_t*)(ws + WS_VT); bf16_t* Qb = (bf16_t*)(ws + WS_QB);
    bf16_t* RQt = (bf16_t*)(ws + WS_RQT); bf16_t* RKt = (bf16_t*)(ws + WS_RKT); bf16_t* RKtT = (bf16_t*)(ws + WS_RKTT); bf16_t* RVT = (bf16_t*)(ws + WS_RVT);
    float* UT = (float*)(ws + WS_UT); bf16_t* SPT = (bf16_t*)(ws + WS_SPT);

    if (IN(0)) {
        for (int i = bid * NTHREADS + tid; i < NPOS * 64 + NPOS * 32; i += G * NTHREADS) {
            const bool a = i < NPOS * 64; const int j = a ? i : i - NPOS * 64; const int half = a ? 64 : 32;
            const int p = j / half, f = j % half; const int pos = p < SEQ ? p : PAST + (p - SEQ);
            const float inv = powf(10000.0f, -(float)f / (float)half);
            const float ang = (float)pos * inv;
            double rev = (double)ang * 0.15915494309189535; rev -= floor(rev);
            const float r = (float)rev;
            const float sn = __builtin_amdgcn_sinf(r), cs = __builtin_amdgcn_cosf(r);
            if (a) { COSA[j] = cs; SINA[j] = sn; } else { COSB[j] = cs; SINB[j] = sn; }
        }
        for (int row = gw; row < NT; row += NGW) {
            const float* xr = row < NP ? x_prompt + (size_t)row * DM : x_sample + (size_t)(row - NP) * DM;
            rms_row_bf16(xr, g_mix_pre, Ub + (size_t)row * DM, DM, lane);
        }
        for (int row = gw; row < NB * NMEM; row += NGW) rms_row_bf16(mem_prompt + (size_t)row * DM, g_mem, MNb + (size_t)row * DM, DM, lane);
        {
            LAS float* scr = lds + wave * (64 * 33);
            transpose_w(w_in, 1024, DIN, WinT, 1024, 0, scr, gw, NGW, lane);
            for (int i = bid * NTHREADS + tid; i < (ZLD - DIN) * 1024 / 2; i += G * NTHREADS) ((unsigned*)(WinT + (size_t)DIN * 1024))[i] = 0u;
            transpose_w(w_mem_k, 1024, 256, WmkvT, 1024, 0, scr, gw, NGW, lane);
            transpose_w(w_mem_v, 1024, 256, WmkvT, 1024, 256, scr, gw, NGW, lane);
            transpose_w(w_uq, QL, 1536, WuqT, QL, 0, scr, gw, NGW, lane);
            transpose_w(w_ret_o, 1024, 1024, WroT, 1024, 0, scr, gw, NGW, lane);
            transpose_w(w_mla_o, 1024, 1024, WmoT, 1024, 0, scr, gw, NGW, lane);
            transpose_w(w_x_o, 256, 1024, WxoT, 256, 0, scr, gw, NGW, lane);
            transpose_w(w_out, 1024, 1024, WoT, 1024, 0, scr, gw, NGW, lane);
            transpose_w(w_gate, 1024, DFF, WguT, 1024, 0, scr, gw, NGW, lane);
            transpose_w(w_up, 1024, DFF, WguT, 1024, DFF, scr, gw, NGW, lane);
            transpose_w(w_down, DFF, 1024, WdT, DFF, 0, scr, gw, NGW, lane);
            for (int hh = 0; hh < MH; ++hh) { transpose_w(w_uk + (size_t)hh * KVL * DNOPE, KVL, DNOPE, WukT, KVL, hh * DNOPE, scr, gw, NGW, lane);
                                              transpose_w(w_uv + (size_t)hh * KVL * DVH, KVL, DVH, WuvT, KVL, hh * DVH, scr, gw, NGW, lane); }
        }
    }
    SEAM(0);
    if (IN(1)) {
        { pg8::Gemm g{Ub, WinT, NT, ZLD, 1024, 1024, 1024}; pg8::StaticOrder S; S.init(NT, ZLD, G, bid); pg8::EpiF32S E{Z, ZLD, 0, 0};
          GEMM_PHASE(pg8::EpiF32S, ldsb, g, S, E); }
        __syncthreads();
        { pg8::Gemm g{MNb, WmkvT, NB * NMEM, 512, 1024, 1024, 1024}; pg8::StaticOrder S; S.init(NB * NMEM, 512, G, bid); pg8::EpiF32S E{out + O_MKP, 256, 1, O_MVP - O_MKP};
          GEMM_PHASE(pg8::EpiF32S, ldsb, g, S, E); }
        __syncthreads();
        { pg8::Gemm g{WinT + (size_t)C_RV * 1024, Ub, 1024, NT, 1024, 1024, 1024}; pg8::StaticOrder S; S.init(1024, NT, G, bid); pg8::EpiBf16S E{RVT, NT};
          GEMM_PHASE(pg8::EpiBf16S, ldsb, g, S, E); }
    }
    SEAM(1);
    if (IN(2)) {
        constexpr int KTP = 520;
        LAS bf16_t* Kt = (LAS bf16_t*)ldsb;
        const int ntile = NP / 64, nwork = ntile + (NS + 63) / 64;
        for (int wk = bid; wk < nwork; wk += G) {
            const bool prompt = wk < ntile; const int row_base = prompt ? wk * 64 : NP + (wk - ntile) * 64;
            __syncthreads();
            for (int r = wave; r < 64; r += NWAVES) {
                const int row = row_base + r;
                const float* z = Z + (size_t)row * ZLD; const int p = pos_index(row);
                const float ca = COSA[p * 64 + lane], sa = SINA[p * 64 + lane];
                const int il = p & 127;
#pragma unroll
                for (int h = 0; h < RH; ++h) {
                    float x1 = z[C_RQ + h * RDK + lane], x2 = z[C_RQ + h * RDK + 64 + lane];
                    const float q1 = x1 * ca - x2 * sa, q2 = x1 * sa + x2 * ca;
                    x1 = z[C_RK + h * RDK + lane]; x2 = z[C_RK + h * RDK + 64 + lane];
                    const float sc = 0.08838834764831845f;
                    const float k1 = (x1 * ca - x2 * sa) * sc, k2 = (x1 * sa + x2 * ca) * sc;
                    if (prompt) {
                        const float lg = lg_gamma(h), fq = expf((float)(il - 127) * lg), fk = expf((float)(127 - il) * lg);
                        RQt[(size_t)row * 512 + h * RDK + lane] = f2bf(q1 * fq); RQt[(size_t)row * 512 + h * RDK + 64 + lane] = f2bf(q2 * fq);
                        const bf16_t kb1 = f2bf(k1 * fk), kb2 = f2bf(k2 * fk);
                        RKt[(size_t)row * 512 + h * RDK + lane] = kb1; RKt[(size_t)row * 512 + h * RDK + 64 + lane] = kb2;
                        Kt[r * KTP + h * RDK + lane] = kb1; Kt[r * KTP + h * RDK + 64 + lane] = kb2;
                    } else {
                        RQ[(size_t)row * 512 + h * RDK + lane] = q1; RQ[(size_t)row * 512 + h * RDK + 64 + lane] = q2;
                        RK[(size_t)row * 512 + h * RDK + lane] = k1; RK[(size_t)row * 512 + h * RDK + 64 + lane] = k2;
                    }
                }
                rms_row_bf16(z + C_CQ, g_qlat, CQNb + (size_t)row * QL, QL, lane);
                rms_row(z + C_CKV, g_kvlat, CKVN + (size_t)row * KVL, KVL, lane);
                float* ockv = row < NP ? out + O_CKVP + (size_t)row * KVL : out + O_CKVS + (size_t)(row - NP) * KVL;
                for (int i = lane; i < KVL; i += 64) { const float v = CKVN[(size_t)row * KVL + i]; ockv[i] = v; CKVNb[(size_t)row * KVL + i] = f2bf(v); }
                for (int i = lane; i < 256; i += 64) XQb[(size_t)row * 256 + i] = f2bf(z[C_XQ + i]);
                if (lane < 32) {
                    const float cb = COSB[p * 32 + lane], sb = SINB[p * 32 + lane];
                    const float x1 = z[C_KPE + lane], x2 = z[C_KPE + 32 + lane];
                    const float o1 = x1 * cb - x2 * sb, o2 = x1 * sb + x2 * cb;
                    KPER[(size_t)row * DROPE + lane] = o1; KPER[(size_t)row * DROPE + 32 + lane] = o2;
                    float* okpe = row < NP ? out + O_KPEP + (size_t)row * DROPE : out + O_KPES + (size_t)(row - NP) * DROPE;
                    okpe[lane] = o1; okpe[32 + lane] = o2;
                    KPERb[(size_t)row * DROPE + lane] = f2bf(o1); KPERb[(size_t)row * DROPE + 32 + lane] = f2bf(o2);
                }
            }
            __syncthreads();
            if (prompt) {
#pragma unroll 2
                for (int i = 0; i < 8; ++i) { const int pc = tid + i * NTHREADS, f = pc >> 3, k8 = pc & 7;
                    const LAS bf16_t* c = Kt + (8 * k8) * KTP + f;
                    pg8::u32x4 o; o.x = (unsigned)c[0] | ((unsigned)c[KTP] << 16); o.y = (unsigned)c[2 * KTP] | ((unsigned)c[3 * KTP] << 16);
                    o.z = (unsigned)c[4 * KTP] | ((unsigned)c[5 * KTP] << 16); o.w = (unsigned)c[6 * KTP] | ((unsigned)c[7 * KTP] << 16);
                    *(pg8::u32x4*)(RKtT + (size_t)f * NP + row_base + 8 * k8) = o; }
            }
        }
    }
    if (IN(2)) {
        for (int i = bid * NTHREADS + tid; i < NB * NMEM * 256; i += G * NTHREADS) { MKb[i] = f2bf(out[O_MKP + i]);
            const int f = i / (NB * NMEM), r = i - f * (NB * NMEM); MVT[i] = f2bf(out[O_MVP + (size_t)r * 256 + f]); }
    }
    SEAM(2);
    if (IN(3)) { pg8::Gemm g{CQNb, WuqT, NT, 1536, QL, QL, QL}; pg8::StaticOrder S; S.init(NT, 1536, G, bid); pg8::EpiF32S E{Q, 1536, 0, 0};
        GEMM_PHASE(pg8::EpiF32S, ldsb, g, S, E);
        __syncthreads();
        { pg8::Gemm g2{CKVNb, WukT, NP, 1024, KVL, KVL, KVL}; pg8::StaticOrder S2; S2.init(NP, 1024, G, bid); pg8::EpiBf16S E2{KN, 1024}; GEMM_PHASE(pg8::EpiBf16S, ldsb, g2, S2, E2); }
        __syncthreads();
        { pg8::Gemm g3{WuvT, CKVNb, 1024, NP, KVL, KVL, KVL}; pg8::StaticOrder S3; S3.init(1024, NP, G, bid); pg8::EpiBf16S E3{VT, NP}; GEMM_PHASE(pg8::EpiBf16S, ldsb, g3, S3, E3); }
        for (int it = bid; it < NB * RH * 16; it += G) { const int c = __builtin_amdgcn_readfirstlane(it & 15), h = __builtin_amdgcn_readfirstlane((it >> 4) & 3), b = __builtin_amdgcn_readfirstlane(it >> 6);
            ret_chunk_state(RVT, RKtT, UT, b, h, c); } }
    SEAM(3);
    if (IN(4)) {
        for (int idx = bid * NTHREADS + tid; idx < NB * RH * 32768; idx += G * NTHREADS) {
            const int bh = idx >> 15, e = idx & 32767; const float g128 = expf(128.f * lg_gamma(bh & 3));
            float sp = 0.f, S = 0.f;
#pragma unroll 4
            for (int c = 0; c < 16; ++c) { const size_t o_ = (size_t)(bh * 16 + c) * 32768 + e; SPT[o_] = f2bf(sp); S = sp + UT[o_]; sp = g128 * S; }
            out[O_RETP + (size_t)bh * 32768 + (size_t)(e & 127) * RDV + (e >> 7)] = S;
        }
        for (int h = 0; h < MH; ++h)
            sgemm_naive(lds, Q + (size_t)NP * 1536 + h * DQH, 1536, w_uk + (size_t)h * KVL * DNOPE, 1, DNOPE, QLAT + (size_t)NP * 2048 + h * KVL, MH * KVL, NS, KVL, DNOPE, bid, G);
        for (int row = gw; row < NT; row += NGW) {
            const int p = pos_index(row);
            for (int i = lane; i < 1536; i += 64) { const int hh = i / DQH, d = i - hh * DQH; if (d < DNOPE) Qb[(size_t)row * 1536 + i] = f2bf(Q[(size_t)row * 1536 + i]); }
#pragma unroll
            for (int c = 0; c < 4; ++c) { const int idx = lane + 64 * c, h = idx >> 5, f = idx & 31;
                const float cb = COSB[p * 32 + f], sb = SINB[p * 32 + f];
                const float x1 = Q[(size_t)row * 1536 + h * DQH + DNOPE + f], x2 = Q[(size_t)row * 1536 + h * DQH + DNOPE + 32 + f];
                const float o1 = x1 * cb - x2 * sb, o2 = x1 * sb + x2 * cb;
                QPE[(size_t)row * 512 + h * 64 + f] = o1; QPE[(size_t)row * 512 + h * 64 + 32 + f] = o2;
                Qb[(size_t)row * 1536 + h * DQH + DNOPE + f] = f2bf(o1); Qb[(size_t)row * 1536 + h * DQH + DNOPE + 32 + f] = f2bf(o2); }
        }
    }
    SEAM(4);
    if (IN(5)) {
        for (int it = bid; it < NS; it += G) {
            const int b = it >> 2, t = it & 3; const size_t row = (size_t)NP + it;
            KvMlaSample kv{CKVN, KPER, cache_ckv, cache_kpe, page_table, b};
            QMla qf{QLAT + row * 2048 + wave * KVL, QPE + row * 512 + wave * 64};
            attn_naive<320, 256, true, 0>(lds, kv, PAST + t + 1, qf, true, PAST + t, 0.07216878364870322f, 0.f, 0, OLAT + row * 2048 + wave * KVL);
        }
        for (int it = bid; it < NB * MH * 4; it += G) {
            const int pr = __builtin_amdgcn_readfirstlane(it & 3), hh = __builtin_amdgcn_readfirstlane((it >> 2) & 7), b = __builtin_amdgcn_readfirstlane(it >> 5);
            SrcMlaP src{KN, KPERb, VT, b, hh};
#pragma unroll 1
            for (int half = 0; half < 2; ++half) { const int qb = __builtin_amdgcn_readfirstlane(half ? pr : 7 - pr); const size_t row0 = (size_t)b * SEQ + qb * 256;
                flash_unit<192, 128, true>(ldsb, src, Qb + row0 * 1536 + hh * DQH, 1536, qb * 256, 4 * (qb + 1), OMLAb + row0 * 1024 + hh * DVH, 1024, 0.07216878364870322f * 1.4426950408889634f); }
        }
        for (int it = bid; it < NB * RH * 16; it += G) { const int c = __builtin_amdgcn_readfirstlane(it & 15), h = __builtin_amdgcn_readfirstlane((it >> 4) & 3), b = __builtin_amdgcn_readfirstlane(it >> 6);
            ret_chunk_out(RQt, RKt, RVT, SPT, ORET, b, h, c); }
        for (int it = bid; it < DB * RH; it += G) {
            const int h = it & 3, b = it >> 2; const float lg = lg_gamma(h);
            const float* s0 = state_ret + (size_t)it * RDK * RDV;
            LAS float* inner = lds;
            LAS float* qk = lds + 16;
            __syncthreads();
            for (int i = tid; i < 1024; i += NTHREADS) { const int which = i >> 9, ti = (i >> 7) & 3, d = i & 127; const size_t row = (size_t)NP + b * DS + ti;
                qk[i] = which ? RK[row * 512 + h * RDK + d] : RQ[row * 512 + h * RDK + d]; }
            __syncthreads();
            for (int pr = wave; pr < 16; pr += NWAVES) { const int i = pr >> 2, j = pr & 3;
                float s = qk[i * 128 + lane] * qk[512 + j * 128 + lane] + qk[i * 128 + 64 + lane] * qk[512 + j * 128 + 64 + lane];
                s = wave_sum(s);
                if (lane == 0) inner[pr] = (j <= i) ? s * expf((float)(i - j) * lg) : 0.f; }
            __syncthreads();
            {
                const int e = tid & 255, i0 = (tid >> 8) * 2;
                float o0 = 0.f, o1 = 0.f;
                for (int d = 0; d < RDK; ++d) { const float sv = s0[(size_t)d * RDV + e]; o0 += qk[i0 * 128 + d] * sv; o1 += qk[(i0 + 1) * 128 + d] * sv; }
                o0 *= expf((float)(i0 + 1) * lg); o1 *= expf((float)(i0 + 2) * lg);
#pragma unroll
                for (int j = 0; j < DS; ++j) { const float v = Z[((size_t)NP + b * DS + j) * ZLD + C_RV + h * RDV + e]; o0 += inner[i0 * 4 + j] * v; o1 += inner[(i0 + 1) * 4 + j] * v; }
                ORET[((size_t)NP + b * DS + i0) * 1024 + h * RDV + e] = o0; ORET[((size_t)NP + b * DS + i0 + 1) * 1024 + h * RDV + e] = o1;
            }
            {
                const float g4 = expf(4.f * lg);
                float* so = out + O_RETS + (size_t)it * RDK * RDV;
                for (int i = tid; i < RDK * RDV; i += NTHREADS) { const int d = i >> 8, e = i & 255; float a = s0[i] * g4;
#pragma unroll
                    for (int j = 0; j < DS; ++j) a += expf((float)(3 - j) * lg) * qk[512 + j * 128 + d] * Z[((size_t)NP + b * DS + j) * ZLD + C_RV + h * RDV + e];
                    so[i] = a; }
            }
        }
        for (int it = bid; it < NB * XH * 8; it += G) {
            const int qb = __builtin_amdgcn_readfirstlane(it & 7), hh = __builtin_amdgcn_readfirstlane((it >> 3) & 3), b = __builtin_amdgcn_readfirstlane(it >> 5); const size_t row0 = (size_t)b * SEQ + qb * 256;
            SrcMemP src{MKb, MVT, b, hh};
            flash_unit<64, 64, false>(ldsb, src, XQb + row0 * 256 + hh * XHD, 256, 0, 4, OXb + row0 * 256 + hh * XHD, 256, 0.125f * 1.4426950408889634f);
        }
        for (int it = bid; it < DB * XH; it += G) {
            const int h = it & 3, b = it >> 2; const size_t row = (size_t)NP + b * DS + (wave & 3);
            KvMem kv{cache_mem_k, cache_mem_v, b, h};
            attn_naive<64, 64, false, 0>(lds, kv, NMEM, QPtr{Z + row * ZLD + C_XQ + h * XHD}, wave < 4, NMEM, 0.125f, 0.f, 0, OX + row * 256 + h * XHD);
        }
    }
    SEAM(5);
    if (IN(6)) {
        for (int h = 0; h < MH; ++h)
            sgemm_naive(lds, OLAT + (size_t)NP * 2048 + h * KVL, MH * KVL, w_uv + (size_t)h * KVL * DVH, DVH, 1, nullptr, 1024, NS, DVH, KVL, bid, G, OMLAb + (size_t)NP * 1024 + h * DVH);
        for (size_t i = (size_t)bid * NTHREADS + tid; i < (size_t)NS * 256; i += (size_t)G * NTHREADS) OXb[(size_t)NP * 256 + i] = f2bf(OX[(size_t)NP * 256 + i]);
        for (int row = gw; row < NT; row += NGW) {
#pragma unroll
            for (int h = 0; h < RH; ++h) {
                float v[4]; float s = 0.f;
#pragma unroll
                for (int c = 0; c < 4; ++c) { v[c] = ORET[(size_t)row * 1024 + h * RDV + lane + 64 * c]; s += v[c] * v[c]; }
                const float r = rsqrtf(wave_sum(s) * (1.f / RDV) + EPS);
#pragma unroll
                for (int c = 0; c < 4; ++c) ORETNb[(size_t)row * 1024 + h * RDV + lane + 64 * c] = f2bf(siluf_(Z[(size_t)row * ZLD + C_RG + h * RDV + lane + 64 * c]) * v[c] * r);
            }
        }
    }
    SEAM(6);
    if (IN(7)) {
        pg8::StaticOrder S; S.init(NT, 1024, G, bid);
        { pg8::Gemm g{ORETNb, WroT, NT, 1024, 1024, 1024, 1024}; pg8::EpiF32S E{ARET, 1024, 0, 0}; GEMM_PHASE(pg8::EpiF32S, ldsb, g, S, E); }
        __syncthreads();
        { pg8::Gemm g{OMLAb, WmoT, NT, 1024, 1024, 1024, 1024}; pg8::EpiF32S E{AMLA, 1024, 0, 0}; GEMM_PHASE(pg8::EpiF32S, ldsb, g, S, E); }
        __syncthreads();
        { pg8::Gemm g{OXb, WxoT, NT, 1024, 256, 256, 256}; pg8::EpiF32S E{AX, 1024, 0, 0}; GEMM_PHASE(pg8::EpiF32S, ldsb, g, S, E); }
    }
    SEAM(7);
    if (IN(8)) {
        for (size_t i = (size_t)bid * NTHREADS + tid; i < (size_t)NT * DM; i += (size_t)G * NTHREADS) {
            const size_t row = i >> 10; const int c = (int)(i & 1023); const float* z = Z + row * ZLD + C_G;
            MIXb[i] = f2bf(sigmoidf_(z[c]) * ARET[i] + sigmoidf_(z[1024 + c]) * AMLA[i] + sigmoidf_(z[2048 + c]) * AX[i]);
        }
    }
    SEAM(8);
    if (IN(9)) { pg8::Gemm g{MIXb, WoT, NT, 1024, 1024, 1024, 1024}; pg8::StaticOrder S; S.init(NT, 1024, G, bid); pg8::EpiF32S E{HP, 1024, 0, 0};
        GEMM_PHASE(pg8::EpiF32S, ldsb, g, S, E); }
    SEAM(9);
    if (IN(10)) {
        for (int row = gw; row < NT; row += NGW) {
            const float* xr = row < NP ? x_prompt + (size_t)row * DM : x_sample + (size_t)(row - NP) * DM;
            float v[16]; float s = 0.f;
#pragma unroll
            for (int c = 0; c < 16; ++c) { v[c] = HP[(size_t)row * DM + lane + 64 * c]; s += v[c] * v[c]; }
            float r = rsqrtf(wave_sum(s) * (1.f / DM) + EPS); s = 0.f;
#pragma unroll
            for (int c = 0; c < 16; ++c) { v[c] = xr[lane + 64 * c] + v[c] * r * g_mix_post[lane + 64 * c]; H[(size_t)row * DM + lane + 64 * c] = v[c]; s += v[c] * v[c]; }
            r = rsqrtf(wave_sum(s) * (1.f / DM) + EPS);
#pragma unroll
            for (int c = 0; c < 16; ++c) Fb[(size_t)row * DM + lane + 64 * c] = f2bf(v[c] * r * g_ffn_pre[lane + 64 * c]);
        }
    }
    SEAM(10);
    if (IN(11)) {
        pg8::Gemm g{Fb, WguT, NT, 2 * DFF, 1024, 1024, 1024}; pg8::StaticOrder S; S.init(NT, 2 * DFF, G, bid); pg8::EpiF32S E{GU, 2 * DFF, 0, 0};
        GEMM_PHASE(pg8::EpiF32S, ldsb, g, S, E);
    }
    SEAM(11);
    if (IN(12)) {
        for (size_t i = (size_t)bid * NTHREADS + tid; i < (size_t)NT * DFF; i += (size_t)G * NTHREADS) { const size_t row = i / DFF; const int c = (int)(i - row * DFF); ACTb[i] = f2bf(siluf_(GU[row * (2 * DFF) + c]) * GU[row * (2 * DFF) + DFF + c]); }
    }
    SEAM(12);
    if (IN(13)) { pg8::Gemm g{ACTb, WdT, NT, 1024, DFF, DFF, DFF}; pg8::StaticOrder S; S.init(NT, 1024, G, bid); pg8::EpiF32S E{FO, 1024, 0, 0};
        GEMM_PHASE(pg8::EpiF32S, ldsb, g, S, E); }
    SEAM(13);
    if (IN(14)) {
        for (int row = gw; row < NT; row += NGW) {
            float v[16]; float s = 0.f;
#pragma unroll
            for (int c = 0; c < 16; ++c) { v[c] = FO[(size_t)row * DM + lane + 64 * c]; s += v[c] * v[c]; }
            const float r = rsqrtf(wave_sum(s) * (1.f / DM) + EPS);
            float* y = row < NP ? out + O_YP + (size_t)row * DM : out + O_YS + (size_t)(row - NP) * DM;
#pragma unroll
            for (int c = 0; c < 16; ++c) y[lane + 64 * c] = H[(size_t)row * DM + lane + 64 * c] + v[c] * r * g_ffn_post[lane + 64 * c];
        }
    }
#undef IN
#undef SEAM
}
constexpr int N_PHASES = 15;
}

extern "C" void kernel_launch(void* const* d_in, const int* in_sizes, int n_in, void* d_out, int out_size, void* d_ws, size_t ws_size, hipStream_t stream) {
    static int grid = 0;
    if (grid == 0) {
        if (n_in != 29 || (size_t)out_size != O_END || ws_size < WS_END) { fprintf(stderr, "kernel_launch: unexpected shapes: n_in %d out %d ws %zu (need %zu)\n", n_in, out_size, ws_size, (size_t)WS_END); grid = -1; return; }
        int dev = 0, cus = 0, per_cu = 0;
        if (hipGetDevice(&dev) != hipSuccess || hipDeviceGetAttribute(&cus, hipDeviceAttributeMultiprocessorCount, dev) != hipSuccess) { grid = -1; return; }
        if (hipFuncSetAttribute((const void*)fwd_kernel, hipFuncAttributeMaxDynamicSharedMemorySize, LDS_BYTES) != hipSuccess) { fprintf(stderr, "kernel_launch: hipFuncSetAttribute failed\n"); grid = -1; return; }
        if (hipOccupancyMaxActiveBlocksPerMultiprocessor(&per_cu, (const void*)fwd_kernel, NTHREADS, LDS_BYTES) != hipSuccess || per_cu < 1) { fprintf(stderr, "kernel_launch: occupancy query says %d\n", per_cu); per_cu = 1; }
        (void)hipGetLastError();
        grid = cus;
    }
    if (grid < 0) return;
    (void)hipMemsetAsync((char*)d_ws + WS_CTL, 0, CTL_BYTES, stream);
    Args a{};
    for (int i = 0; i < 29; ++i) a.in[i] = (const float*)d_in[i];
    a.out = (float*)d_out; a.ws = (unsigned char*)d_ws;
#if MK_ONE_LAUNCH
    a.ph_lo = 0; a.ph_hi = N_PHASES;
    hipLaunchKernelGGL(fwd_kernel, dim3(grid), dim3(NTHREADS), LDS_BYTES, stream, a);
#else
    for (int p = 0; p < N_PHASES; ++p) { a.ph_lo = p; a.ph_hi = p + 1; hipLaunchKernelGGL(fwd_kernel, dim3(grid), dim3(NTHREADS), LDS_BYTES, stream, a); }
#endif
}
```

```cpp
#include <hip/hip_runtime.h>
#include <cstdio>
#include <cstdint>

#ifndef MK_ONE_LAUNCH
#define MK_ONE_LAUNCH 1
#endif

#define LAS __attribute__((address_space(3)))
#define GAS __attribute__((address_space(1)))
#define DI __device__ __forceinline__
typedef float f32x4 __attribute__((ext_vector_type(4)));

namespace {
constexpr int DM = 1024, NB = 8, SEQ = 2048, NP = NB * SEQ, DB = 128, DS = 4, NS = DB * DS, NT = NP + NS;
constexpr int PAST = 8192, PAGE = 128, NPAGES = PAST / PAGE;
constexpr int RH = 4, RDK = 128, RDV = 256;
constexpr int MH = 8, QL = 384, KVL = 256, DNOPE = 128, DROPE = 64, DVH = 128, DQH = DNOPE + DROPE;
constexpr int NMEM = 256, XH = 4, XHD = 64;
constexpr int DFF = 2816, DIN = 7104, ZLD = 7168;
constexpr int C_RQ = 0, C_RK = 512, C_RV = 1024, C_RG = 2048, C_CQ = 3072, C_CKV = 3456, C_KPE = 3712, C_XQ = 3776, C_G = 4032;
constexpr float EPS = 1e-6f;
constexpr int NPOS = SEQ + DS;
constexpr int NTHREADS = 512, NWAVES = 8;
constexpr int LDS_BYTES = 147456;
constexpr int MISC_OFF = 147456 - 256;

constexpr size_t O_YP = 0, O_YS = O_YP + (size_t)NP * DM, O_CKVP = O_YS + (size_t)NS * DM, O_KPEP = O_CKVP + (size_t)NP * KVL,
                 O_CKVS = O_KPEP + (size_t)NP * DROPE, O_KPES = O_CKVS + (size_t)NS * KVL, O_RETP = O_KPES + (size_t)NS * DROPE,
                 O_RETS = O_RETP + (size_t)NB * RH * RDK * RDV, O_MKP = O_RETS + (size_t)DB * RH * RDK * RDV, O_MVP = O_MKP + (size_t)NB * NMEM * 256,
                 O_END = O_MVP + (size_t)NB * NMEM * 256;

constexpr size_t al256(size_t x) { return (x + 255) & ~(size_t)255; }
constexpr size_t WS_CTL = 0, CTL_BYTES = 1u << 20;
constexpr size_t WS_COSA = WS_CTL + CTL_BYTES;
constexpr size_t WS_SINA = WS_COSA + al256((size_t)NPOS * 64 * 4);
constexpr size_t WS_COSB = WS_SINA + al256((size_t)NPOS * 64 * 4);
constexpr size_t WS_SINB = WS_COSB + al256((size_t)NPOS * 32 * 4);
constexpr size_t WS_U = WS_SINB + al256((size_t)NPOS * 32 * 4);
constexpr size_t WS_MN = WS_U + (size_t)NT * DM * 4;
constexpr size_t WS_Z = WS_MN + (size_t)NB * NMEM * DM * 4;
constexpr size_t WS_RQ = WS_Z + (size_t)NT * ZLD * 4;
constexpr size_t WS_RK = WS_RQ + (size_t)NT * 512 * 4;
constexpr size_t WS_CQN = WS_RK + (size_t)NT * 512 * 4;
constexpr size_t WS_CKVN = WS_CQN + (size_t)NT * QL * 4;
constexpr size_t WS_KPER = WS_CKVN + (size_t)NT * KVL * 4;
constexpr size_t WS_Q = WS_KPER + (size_t)NT * DROPE * 4;
constexpr size_t WS_QLAT = WS_Q + (size_t)NT * 1536 * 4;
constexpr size_t WS_QPE = WS_QLAT + (size_t)NT * 2048 * 4;
constexpr size_t WS_ORET = WS_QPE + (size_t)NT * 512 * 4;
constexpr size_t WS_OLAT = WS_ORET + (size_t)NT * 1024 * 4;
constexpr size_t WS_OX = WS_OLAT + (size_t)NT * 2048 * 4;
constexpr size_t WS_OMLA = WS_OX + (size_t)NT * 256 * 4;
constexpr size_t WS_ORETN = WS_OMLA + (size_t)NT * 1024 * 4;
constexpr size_t WS_ARET = WS_ORETN + (size_t)NT * 1024 * 4;
constexpr size_t WS_AMLA = WS_ARET + (size_t)NT * 1024 * 4;
constexpr size_t WS_AX = WS_AMLA + (size_t)NT * 1024 * 4;
constexpr size_t WS_MIX = WS_AX + (size_t)NT * 1024 * 4;
constexpr size_t WS_HP = WS_MIX + (size_t)NT * 1024 * 4;
constexpr size_t WS_H = WS_HP + (size_t)NT * 1024 * 4;
constexpr size_t WS_F = WS_H + (size_t)NT * 1024 * 4;
constexpr size_t WS_GG = WS_F + (size_t)NT * 1024 * 4;
constexpr size_t WS_UP = WS_GG + (size_t)NT * DFF * 4;
constexpr size_t WS_ACT = WS_UP + (size_t)NT * DFF * 4;
constexpr size_t WS_FO = WS_ACT + (size_t)NT * DFF * 4;
constexpr size_t WS_F32_END = WS_FO + (size_t)NT * 1024 * 4;
constexpr size_t WS_WIN_T = al256(WS_F32_END);
constexpr size_t WS_WMKV_T = WS_WIN_T + (size_t)ZLD * 1024 * 2;
constexpr size_t WS_WUQ_T = WS_WMKV_T + (size_t)512 * 1024 * 2;
constexpr size_t WS_WRO_T = WS_WUQ_T + (size_t)1536 * 384 * 2;
constexpr size_t WS_WMO_T = WS_WRO_T + (size_t)1024 * 1024 * 2;
constexpr size_t WS_WXO_T = WS_WMO_T + (size_t)1024 * 1024 * 2;
constexpr size_t WS_WO_T = WS_WXO_T + (size_t)1024 * 256 * 2;
constexpr size_t WS_WGU_T = WS_WO_T + (size_t)1024 * 1024 * 2;
constexpr size_t WS_WD_T = WS_WGU_T + (size_t)5632 * 1024 * 2;
constexpr size_t WS_UB = WS_WD_T + (size_t)1024 * 2816 * 2;
constexpr size_t WS_MNB = WS_UB + (size_t)NT * 1024 * 2;
constexpr size_t WS_CQNB = WS_MNB + (size_t)2048 * 1024 * 2;
constexpr size_t WS_ORETNB = WS_CQNB + (size_t)NT * 384 * 2;
constexpr size_t WS_OMLAB = WS_ORETNB + (size_t)NT * 1024 * 2;
constexpr size_t WS_OXB = WS_OMLAB + (size_t)NT * 1024 * 2;
constexpr size_t WS_MIXB = WS_OXB + (size_t)NT * 256 * 2;
constexpr size_t WS_FB = WS_MIXB + (size_t)NT * 1024 * 2;
constexpr size_t WS_ACTB = WS_FB + (size_t)NT * 1024 * 2;
constexpr size_t WS_WUK_T = WS_ACTB + (size_t)NT * 2816 * 2;
constexpr size_t WS_WUV_T = WS_WUK_T + (size_t)1024 * 256 * 2;
constexpr size_t WS_CKVNB = WS_WUV_T + (size_t)1024 * 256 * 2;
constexpr size_t WS_KPERB = WS_CKVNB + (size_t)NT * 256 * 2;
constexpr size_t WS_XQB = WS_KPERB + (size_t)NT * 64 * 2;
constexpr size_t WS_MKB = WS_XQB + (size_t)NT * 256 * 2;
constexpr size_t WS_MVT = WS_MKB + (size_t)2048 * 256 * 2;
constexpr size_t WS_KN = WS_MVT + (size_t)2048 * 256 * 2;
constexpr size_t WS_VT = WS_KN + (size_t)NP * 1024 * 2;
constexpr size_t WS_QB = WS_VT + (size_t)NP * 1024 * 2;
constexpr size_t WS_RQT = WS_QB + (size_t)NT * 1536 * 2;
constexpr size_t WS_RKT = WS_RQT + (size_t)NP * 512 * 2;
constexpr size_t WS_RKTT = WS_RKT + (size_t)NP * 512 * 2;
constexpr size_t WS_RVT = WS_RKTT + (size_t)NP * 512 * 2;
constexpr size_t WS_UT = WS_RVT + (size_t)NT * 1024 * 2;
constexpr size_t WS_SPT = WS_UT + (size_t)512 * 32768 * 4;
constexpr size_t WS_QLATB = WS_SPT + (size_t)512 * 32768 * 2;
constexpr size_t WS_PO = WS_QLATB + (size_t)NS * 2048 * 2;
constexpr size_t WS_PML = WS_PO + (size_t)DB * 2 * 32 * 256 * 4;
constexpr size_t WS_END = WS_PML + (size_t)DB * 2 * 32 * 2 * 4;

constexpr int CW_BAR = 4096;

#define XB_TMO      128
#define XB_XCNT(j)  (256  + 64 * (j))
#define XB_XSUB(j)  (1280 + 64 * (j))
#define XB_XGEN(j)  (2304 + 64 * (j))
#define XB_TOP      3328
#define XB_TOPGEN   3392
#define XCD_BAR_WORDS 3456
#define XB_SPIN_CAP (1u << 25)

DI unsigned xb_ld(unsigned* p)              { return __hip_atomic_load(p, __ATOMIC_RELAXED, __HIP_MEMORY_SCOPE_AGENT); }
DI unsigned xb_add(unsigned* p, unsigned v) { return __hip_atomic_fetch_add(p, v, __ATOMIC_RELAXED, __HIP_MEMORY_SCOPE_AGENT); }
DI unsigned xb_xcc_id() { return (unsigned)__builtin_amdgcn_s_getreg((3 << 11) | 20) & 0xFu; }
#define XB_SPIN(cond, bar) do { unsigned _sp = 0; while (cond) { __builtin_amdgcn_s_sleep(1); \
    if ((++_sp & 255u) == 0u) { if (xb_ld(&(bar)[XB_TMO])) break; if (_sp > XB_SPIN_CAP) { atomicAdd(&(bar)[XB_TMO], 1u); break; } } } } while (0)

struct XcdBarrier { unsigned* bar; unsigned x; volatile LAS unsigned* st; };

DI XcdBarrier xcd_barrier_post(unsigned* bar, volatile LAS unsigned* st) {
    XcdBarrier b; b.bar = bar; b.x = xb_xcc_id(); b.st = st;
    if (threadIdx.x == 0) (void)xb_add(&bar[XB_XCNT(b.x)], 1u);
    return b;
}
DI void xcd_barrier_complete(unsigned* bar, unsigned x, unsigned& nloc, unsigned& nx) {
    const unsigned G = gridDim.x * gridDim.y * gridDim.z;
    unsigned sum, cnt, mine, sp = 0u;
    for (;;) {
        sum = 0u; cnt = 0u; mine = 0u;
#pragma unroll
        for (unsigned j = 0; j < 16; ++j) { const unsigned c = xb_ld(&bar[XB_XCNT(j)]); sum += c; cnt += (c > 0u) ? 1u : 0u; mine = (j == x) ? c : mine; }
        if (sum == G) break;
        __builtin_amdgcn_s_sleep(1);
        if ((++sp & 255u) == 0u) { if (xb_ld(&bar[XB_TMO])) break; if (sp > XB_SPIN_CAP) { atomicAdd(&bar[XB_TMO], 1u); break; } }
    }
    nloc = mine > 0u ? mine : 1u; nx = cnt > 0u ? cnt : 1u;
}
DI void xcd_barrier(const XcdBarrier& b) {
    asm volatile("s_waitcnt vmcnt(0)" ::: "memory");
    __syncthreads();
    if (threadIdx.x == 0) {
        unsigned* bar = b.bar;
        __builtin_amdgcn_s_waitcnt(0);
        unsigned nloc = b.st[0], nx = b.st[1];
        if (nloc == 0u) { xcd_barrier_complete(bar, b.x, nloc, nx); b.st[0] = nloc; b.st[1] = nx; }
        const unsigned old = xb_add(&bar[XB_XSUB(b.x)], 1u);
        const unsigned gen = old / nloc;
        if (old + 1u == (gen + 1u) * nloc) {
            __builtin_amdgcn_fence(__ATOMIC_RELEASE, "agent");
            asm volatile("s_waitcnt vmcnt(0)" ::: "memory");
            const unsigned og = xb_add(&bar[XB_TOP], 1u);
            const unsigned tg = og / nx;
            if (og + 1u == (tg + 1u) * nx) xb_add(&bar[XB_TOPGEN], 1u);
            else XB_SPIN(xb_ld(&bar[XB_TOPGEN]) == tg, bar);
            __builtin_amdgcn_fence(__ATOMIC_ACQUIRE, "agent");
            xb_add(&bar[XB_XGEN(b.x)], 1u);
            asm volatile("s_waitcnt vmcnt(0)" ::: "memory");
        } else {
            XB_SPIN(xb_ld(&bar[XB_XGEN(b.x)]) == gen, bar);
            __builtin_amdgcn_fence(__ATOMIC_ACQUIRE, "agent");
            asm volatile("s_waitcnt vmcnt(0)" ::: "memory");
        }
    }
    __syncthreads();
}

DI float wave_sum(float v) {
#pragma unroll
    for (int o = 1; o < 64; o <<= 1) v += __shfl_xor(v, o);
    return v;
}
DI float wave_max(float v) {
#pragma unroll
    for (int o = 1; o < 64; o <<= 1) v = fmaxf(v, __shfl_xor(v, o));
    return v;
}
DI float sigmoidf_(float x) { return 1.f / (1.f + expf(-x)); }
DI float siluf_(float x) { return x / (1.f + expf(-x)); }
DI int pos_index(int row) { return row < NP ? (row & (SEQ - 1)) : SEQ + ((row - NP) & (DS - 1)); }
DI float lg_gamma(int h) { return log1pf(-exp2f(-5.0f - (float)h)); }


namespace pg8 {
typedef unsigned short bf16_t;
typedef short bf16x8 __attribute__((ext_vector_type(8)));
typedef unsigned u32x4 __attribute__((ext_vector_type(4)));
typedef unsigned u32x2 __attribute__((ext_vector_type(2)));
constexpr int BM = 256, BK = 64, HALF = 128, HTB = HALF * BK * 2, STAGE_BYTES = 8 * HTB, NXCD = 8, WGM = 8;
__host__ __device__ __forceinline__ int lds_byte(int r, int c) { const int st = (r >> 4) * 2 + (c >> 5), rr = r & 15, cc = c & 31, ob = rr * 64 + cc * 2; return st * 1024 + (ob ^ (((ob >> 9) & 1) << 5)); }
__host__ __device__ __forceinline__ void stage_rc(int b, int& R, int& C) { const int st = b / 1024, sb = b % 1024, swz = sb ^ (((sb >> 9) & 1) << 5); R = (st >> 1) * 16 + swz / 64; C = (st & 1) * 32 + (swz % 64) / 2; }
__host__ __device__ __forceinline__ int perm32(int rho) { const int n = rho >> 4, i = rho & 15; return 8 * (i >> 2) + 4 * n + (i & 3); }
struct Unit { int pm, pn; };
struct Gemm { const bf16_t* A; const bf16_t* Bt; int M, N, K, lda, ldb; };
struct StaticOrder {
    int nM, nN, nwg, G, c;
    __host__ __device__ void init(int M, int N, int G_, int c_) { nM = M / BM; nN = N / BM; nwg = nM * nN; G = G_; c = c_; }
    __host__ __device__ bool next(int i, Unit& u) const {
        const long L = (long)i * G + c; if (L >= nwg) return false;
        int wgid = (int)L; { const int q = nwg / NXCD, r = nwg % NXCD, xcd = wgid % NXCD, off = wgid / NXCD; wgid = (xcd < r ? xcd * (q + 1) : r * (q + 1) + (xcd - r) * q) + off; }
        const int nig = WGM * nN, gid = wgid / nig, fm = gid * WGM, gsz = (nM - fm) < WGM ? (nM - fm) : WGM;
        u.pm = fm + ((wgid % nig) % gsz); u.pn = (wgid % nig) / gsz; return true;
    }
    __device__ __forceinline__ void a_ready(const Unit&) const {}
    __device__ __forceinline__ void done(const Unit&) const {}
};
__device__ __forceinline__ unsigned cvt_pk_bf16(float lo, float hi) { unsigned r; asm volatile("v_cvt_pk_bf16_f32 %0, %1, %2" : "=v"(r) : "v"(lo), "v"(hi)); return r; }
struct EpiF32S {
    static constexpr bool PERM = false, AFTER_DRAIN = false;
    float* C; int ldc; int split_tiles; size_t split_stride;
    __device__ __forceinline__ void operator()(const f32x4 (&acc)[2][2][4][2], const Unit& u, int wr, int wc, int fr, int fq) const {
        int pn = u.pn; float* base = C; if (split_tiles) { const int t = pn / split_tiles; base += (size_t)t * split_stride; pn -= t * split_tiles; }
        const int row0 = u.pm * BM + wr * 64 + fr, col0 = pn * BM + wc * 32 + 4 * fq;
#pragma unroll
        for (int ai = 0; ai < 2; ++ai)
#pragma unroll
            for (int m = 0; m < 4; ++m) { float* rowp = base + (size_t)(row0 + ai * HALF + m * 16) * ldc + col0;
#pragma unroll
                for (int bj = 0; bj < 2; ++bj)
#pragma unroll
                    for (int n = 0; n < 2; ++n) *(f32x4*)(rowp + bj * HALF + n * 16) = acc[ai][bj][m][n]; }
    }
};
struct EpiBf16S {
    static constexpr bool PERM = true, AFTER_DRAIN = false;
    bf16_t* O; int ldc;
    __device__ __forceinline__ void operator()(const f32x4 (&acc)[2][2][4][2], const Unit& u, int wr, int wc, int fr, int fq) const {
        const int row0 = u.pm * BM + wr * 64 + fr, col0 = u.pn * BM + wc * 32 + 8 * fq;
#pragma unroll
        for (int ai = 0; ai < 2; ++ai)
#pragma unroll
            for (int m = 0; m < 4; ++m) { bf16_t* rowp = O + (size_t)(row0 + ai * HALF + m * 16) * ldc + col0;
#pragma unroll
                for (int bj = 0; bj < 2; ++bj) { const f32x4 v0 = acc[ai][bj][m][0], v1 = acc[ai][bj][m][1];
                    u32x4 w; w.x = cvt_pk_bf16(v0[0], v0[1]); w.y = cvt_pk_bf16(v0[2], v0[3]); w.z = cvt_pk_bf16(v1[0], v1[1]); w.w = cvt_pk_bf16(v1[2], v1[3]);
                    *(u32x4*)(rowp + bj * HALF) = w; } }
    }
};
template <class Epi, class Sched, bool ALIGN_EPI = false, bool SP2 = false>
__device__ __forceinline__ void gemm_phase(LAS unsigned char* lds, const Gemm g, const Sched& S, const Epi& E) {
    const int tid = threadIdx.x, wid = __builtin_amdgcn_readfirstlane(tid >> 6), lane = tid & 63, wr = wid >> 2, wc = wid & 3, fr = lane & 15, fq = lane >> 4;
    const int K = g.K, nt = K / BK;
    unsigned voffA[2], voffB[2];
#pragma unroll
    for (int i = 0; i < 2; ++i) { int R, C; stage_rc(tid * 16 + i * 8192, R, C); const int Rb = Epi::PERM ? ((R & ~31) + perm32(R & 31)) : R;
        voffA[i] = (unsigned)(R * g.lda + C) * 2u; voffB[i] = (unsigned)(Rb * g.ldb + C) * 2u; }
    const size_t kstep = (size_t)(BK * 2);
    const size_t hstepA = (size_t)HALF * g.lda * 2, hstepB = (size_t)HALF * g.ldb * 2;
    const size_t tstepA = 2 * hstepA, tstepB = 2 * hstepB;
    const unsigned ldsw = (unsigned)wid * 1024u;
    const int aoff = lds_byte(wr * 64 + fr, fq * 8), boff = lds_byte(wc * 32 + fr, fq * 8);
#define PG8_SA(b, h) (((b) * 2 + (h)) * HTB)
#define PG8_SB(b, h) ((4 + (b) * 2 + (h)) * HTB)
#define PG8_STAGE(bufoff, gbase, voff) do { _Pragma("unroll") for (int _i = 0; _i < 2; ++_i) \
        __builtin_amdgcn_global_load_lds((const unsigned*)((const char*)(gbase) + (voff)[_i]), (LAS unsigned*)(lds + (bufoff) + ldsw + _i * 8192), 16, 0, 0); } while (0)
#define PG8_LDA(dst, b, h) do { _Pragma("unroll") for (int m = 0; m < 4; ++m) _Pragma("unroll") for (int k = 0; k < 2; ++k) dst[m][k] = *(const LAS bf16x8*)(lds + PG8_SA(b, h) + aoff + m * 2048 + k * 1024); } while (0)
#define PG8_LDB(dst, b, h) do { _Pragma("unroll") for (int n = 0; n < 2; ++n) _Pragma("unroll") for (int k = 0; k < 2; ++k) dst[n][k] = *(const LAS bf16x8*)(lds + PG8_SB(b, h) + boff + n * 2048 + k * 1024); } while (0)
#define PG8_MMA(ai, bj, At, Bt) do { __builtin_amdgcn_s_setprio(1); _Pragma("unroll") for (int m = 0; m < 4; ++m) _Pragma("unroll") for (int n = 0; n < 2; ++n) _Pragma("unroll") for (int k = 0; k < 2; ++k) \
        acc[ai][bj][m][n] = __builtin_amdgcn_mfma_f32_16x16x32_bf16(Bt[n][k], At[m][k], acc[ai][bj][m][n], 0, 0, 0); __builtin_amdgcn_s_setprio(0); } while (0)
#define PG8_WAIT_V(n) asm volatile("s_waitcnt vmcnt(" #n ")" ::: "memory")
#define PG8_WAIT_L(n) asm volatile("s_waitcnt lgkmcnt(" #n ")" ::: "memory")
#define PG8_BAR __builtin_amdgcn_s_barrier()
#define PG8_SCHED __builtin_amdgcn_sched_barrier(0)
    Unit cur, nxt; int ui = 0;
    if (!S.next(0, cur)) return;
    f32x4 acc[2][2][4][2];
#pragma unroll
    for (int a = 0; a < 2; ++a)
#pragma unroll
        for (int b = 0; b < 2; ++b)
#pragma unroll
            for (int m = 0; m < 4; ++m)
#pragma unroll
                for (int n = 0; n < 2; ++n) acc[a][b][m][n] = (f32x4){0.f, 0.f, 0.f, 0.f};
    bf16x8 At[4][2], B0[2][2], B1[2][2];
    const char* cA = (const char*)g.A + (size_t)cur.pm * tstepA; const char* cB = (const char*)g.Bt + (size_t)cur.pn * tstepB;
    S.a_ready(cur);
    if constexpr (SP2) {
        PG8_STAGE(PG8_SB(0, 0), cB, voffB); PG8_STAGE(PG8_SB(0, 1), cB + hstepB, voffB); PG8_STAGE(PG8_SA(0, 0), cA, voffA); PG8_STAGE(PG8_SA(0, 1), cA + hstepA, voffA);
        if (wr == 1) PG8_BAR;
        PG8_WAIT_V(2); PG8_BAR;
        PG8_STAGE(PG8_SB(1, 0), cB + kstep, voffB); PG8_STAGE(PG8_SA(1, 0), cA + kstep, voffA); PG8_STAGE(PG8_SB(1, 1), cB + hstepB + kstep, voffB);
        PG8_WAIT_V(6); PG8_BAR;
    } else {
        PG8_STAGE(PG8_SB(0, 0), cB, voffB); PG8_STAGE(PG8_SA(0, 0), cA, voffA); PG8_STAGE(PG8_SB(0, 1), cB + hstepB, voffB); PG8_STAGE(PG8_SA(0, 1), cA + hstepA, voffA);
        if (wr == 1) PG8_BAR;
        PG8_WAIT_V(4); PG8_BAR;
        PG8_STAGE(PG8_SB(1, 0), cB + kstep, voffB); PG8_STAGE(PG8_SA(1, 0), cA + kstep, voffA); PG8_STAGE(PG8_SB(1, 1), cB + hstepB + kstep, voffB);
        PG8_WAIT_V(6); PG8_BAR;
    }
    for (;;) {
        const bool has_next = S.next(ui + 1, nxt);
        const char* nA = has_next ? (const char*)g.A + (size_t)nxt.pm * tstepA : cA; const char* nB = has_next ? (const char*)g.Bt + (size_t)nxt.pn * tstepB : cB;
#pragma unroll 1
        for (int t = 0; t < nt; t += 2) {
            const bool last = (t == nt - 2);
            const char* a1 = cA + (size_t)(t + 1) * kstep;
            const char* a2 = last ? nA : cA + (size_t)(t + 2) * kstep; const char* b2 = last ? nB : cB + (size_t)(t + 2) * kstep;
            const char* a3 = a2 + kstep; const char* b3 = b2 + kstep;
            if (last && has_next) S.a_ready(nxt);
            if constexpr (SP2) {
            PG8_LDB(B0, 0, 0); PG8_LDB(B1, 0, 1); PG8_SCHED; PG8_LDA(At, 0, 0); PG8_STAGE(PG8_SA(1, 1), a1 + hstepA, voffA);
            PG8_WAIT_V(8); PG8_WAIT_L(0); PG8_BAR; PG8_MMA(0, 0, At, B0); PG8_MMA(0, 1, At, B1); PG8_BAR; PG8_SCHED;
            PG8_LDA(At, 0, 1); PG8_STAGE(PG8_SB(0, 0), b2, voffB); PG8_STAGE(PG8_SB(0, 1), b2 + hstepB, voffB); PG8_STAGE(PG8_SA(0, 0), a2, voffA);
            PG8_WAIT_V(8); PG8_WAIT_L(0); PG8_BAR; PG8_MMA(1, 0, At, B0); PG8_MMA(1, 1, At, B1); PG8_BAR; PG8_SCHED;
            PG8_LDB(B0, 1, 0); PG8_LDB(B1, 1, 1); PG8_SCHED; PG8_LDA(At, 1, 0); PG8_STAGE(PG8_SA(0, 1), a2 + hstepA, voffA);
            PG8_WAIT_V(8); PG8_WAIT_L(0); PG8_BAR; PG8_MMA(0, 0, At, B0); PG8_MMA(0, 1, At, B1); PG8_BAR; PG8_SCHED;
            PG8_LDA(At, 1, 1); PG8_STAGE(PG8_SB(1, 0), b3, voffB); PG8_STAGE(PG8_SB(1, 1), b3 + hstepB, voffB); PG8_STAGE(PG8_SA(1, 0), a3, voffA);
            PG8_WAIT_V(8); PG8_WAIT_L(0); PG8_BAR; PG8_MMA(1, 0, At, B0); PG8_MMA(1, 1, At, B1); PG8_BAR; PG8_SCHED;
            } else {
            PG8_LDB(B0, 0, 0); PG8_SCHED; PG8_LDA(At, 0, 0); PG8_STAGE(PG8_SA(1, 1), a1 + hstepA, voffA);
            PG8_WAIT_L(8); PG8_BAR; PG8_WAIT_L(0); PG8_MMA(0, 0, At, B0); PG8_BAR; PG8_SCHED;
            PG8_LDB(B1, 0, 1); PG8_STAGE(PG8_SB(0, 0), b2, voffB);
            PG8_BAR; PG8_WAIT_L(0); PG8_MMA(0, 1, At, B1); PG8_BAR;
            PG8_LDA(At, 0, 1); PG8_STAGE(PG8_SA(0, 0), a2, voffA);
            PG8_BAR; PG8_WAIT_L(0); PG8_MMA(1, 0, At, B0); PG8_BAR; PG8_SCHED;
            PG8_STAGE(PG8_SB(0, 1), b2 + hstepB, voffB);
            PG8_WAIT_V(6); PG8_BAR; PG8_MMA(1, 1, At, B1); PG8_BAR;
            PG8_LDB(B0, 1, 0); PG8_SCHED; PG8_LDA(At, 1, 0); PG8_STAGE(PG8_SA(0, 1), a2 + hstepA, voffA);
            PG8_WAIT_L(8); PG8_BAR; PG8_WAIT_L(0); PG8_MMA(0, 0, At, B0); PG8_BAR; PG8_SCHED;
            PG8_LDB(B1, 1, 1); PG8_STAGE(PG8_SB(1, 0), b3, voffB);
            PG8_BAR; PG8_WAIT_L(0); PG8_MMA(0, 1, At, B1); PG8_BAR;
            PG8_LDA(At, 1, 1); PG8_STAGE(PG8_SA(1, 0), a3, voffA);
            PG8_BAR; PG8_WAIT_L(0); PG8_MMA(1, 0, At, B0); PG8_BAR; PG8_SCHED;
            PG8_STAGE(PG8_SB(1, 1), b3 + hstepB, voffB);
            PG8_WAIT_V(6); PG8_BAR; PG8_MMA(1, 1, At, B1); PG8_BAR;
            }
        }
        if constexpr (ALIGN_EPI) { if (wr == 0) PG8_BAR; }
        if constexpr (!Epi::AFTER_DRAIN) { E(acc, cur, wr, wc, fr, fq); S.done(cur); }
        if (!has_next) break;
#pragma unroll
        for (int a = 0; a < 2; ++a)
#pragma unroll
            for (int b = 0; b < 2; ++b)
#pragma unroll
                for (int m = 0; m < 4; ++m)
#pragma unroll
                    for (int n = 0; n < 2; ++n) acc[a][b][m][n] = (f32x4){0.f, 0.f, 0.f, 0.f};
        cur = nxt; cA = nA; cB = nB; ++ui;
        if constexpr (ALIGN_EPI) { if (wr == 1) PG8_BAR; }
    }
    PG8_WAIT_V(0);
    if constexpr (!ALIGN_EPI) { if (wr == 0) PG8_BAR; }
    PG8_BAR;
    if constexpr (Epi::AFTER_DRAIN) { E.fused(acc, cur, wr, wc, fr, fq, lds, wid, lane); S.done(cur); }
#undef PG8_SA
#undef PG8_SB
#undef PG8_STAGE
#undef PG8_LDA
#undef PG8_LDB
#undef PG8_MMA
#undef PG8_WAIT_V
#undef PG8_WAIT_L
#undef PG8_BAR
#undef PG8_SCHED
}
}
typedef unsigned short bf16_t;
DI unsigned pk2(float lo, float hi) { return pg8::cvt_pk_bf16(lo, hi); }
DI bf16_t f2bf(float f) { return (bf16_t)(pg8::cvt_pk_bf16(f, 0.f) & 0xffffu); }
DI void transpose_item(const float* W, int N, bf16_t* WT, int ldt, int row_off, LAS float* scr, int item, int lane) {
    const int nblk = N / 32, kb = item / nblk, nb = item % nblk, k0 = 64 * kb, n0 = 32 * nb;
#pragma unroll 8
    for (int i = 0; i < 32; ++i) { const int kk = 2 * i + (lane >> 5); scr[kk * 33 + (lane & 31)] = W[(size_t)(k0 + kk) * N + n0 + (lane & 31)]; }
    asm volatile("s_waitcnt lgkmcnt(0)" ::: "memory");
    const int c = lane & 7;
#pragma unroll
    for (int j = 0; j < 4; ++j) { const int n = (lane >> 3) + 8 * j; const LAS float* sp = scr + (8 * c) * 33 + n;
        pg8::u32x4 o; o.x = pk2(sp[0 * 33], sp[1 * 33]); o.y = pk2(sp[2 * 33], sp[3 * 33]); o.z = pk2(sp[4 * 33], sp[5 * 33]); o.w = pk2(sp[6 * 33], sp[7 * 33]);
        *(pg8::u32x4*)(WT + (size_t)(row_off + n0 + n) * ldt + k0 + 8 * c) = o; }
    asm volatile("s_waitcnt lgkmcnt(0)" ::: "memory");
}
DI void transpose_w(const float* W, int K, int N, bf16_t* WT, int ldt, int row_off, LAS float* scr, int gw, int NGW, int lane) {
    const int nitems = (K / 64) * (N / 32);
    for (int it = gw; it < nitems; it += NGW) transpose_item(W, N, WT, ldt, row_off, scr, it, lane);
}

struct Args {
    const float* in[29]; float* out; unsigned char* ws; int ph_lo, ph_hi;
};

DI unsigned short f2bf_raw(float f) { unsigned u = __builtin_bit_cast(unsigned, f); return (unsigned short)((u + 0x7fffu + ((u >> 16) & 1u)) >> 16); }
DI void sgemm_naive(LAS float* lds, const float* __restrict__ A, int lda, const float* __restrict__ B, long sbk, long sbn,
                    float* __restrict__ C, int ldc, int M, int N, int K, int bid, int G, unsigned short* Cb = nullptr) {
    LAS float* As = lds;
    LAS float* Bs = lds + 16 * 132;
    const int tid = threadIdx.x, tx = tid & 15, ty = tid >> 4;
    const int ntn = N / 64, ntiles = (M / 128) * ntn;
    for (int t = bid; t < ntiles; t += G) {
        const int m0 = (t / ntn) * 128, n0 = (t % ntn) * 64;
        float acc[4][4];
#pragma unroll
        for (int i = 0; i < 4; ++i)
#pragma unroll
            for (int j = 0; j < 4; ++j) acc[i][j] = 0.f;
        for (int k0 = 0; k0 < K; k0 += 16) {
            {
                const int r = tid >> 2, kq = (tid & 3) * 4;
                const float4 v = *(const float4*)(A + (size_t)(m0 + r) * lda + k0 + kq);
                As[(kq + 0) * 132 + r] = v.x; As[(kq + 1) * 132 + r] = v.y; As[(kq + 2) * 132 + r] = v.z; As[(kq + 3) * 132 + r] = v.w;
            }
#pragma unroll
            for (int i = 0; i < 2; ++i) {
                const int idx = tid + i * 512, kk = idx >> 6, nn = idx & 63;
                Bs[kk * 64 + nn] = B[(size_t)(k0 + kk) * sbk + (size_t)(n0 + nn) * sbn];
            }
            __syncthreads();
#pragma unroll
            for (int kk = 0; kk < 16; ++kk) {
                const f32x4 a = *(const LAS f32x4*)(As + kk * 132 + ty * 4);
                const f32x4 b = *(const LAS f32x4*)(Bs + kk * 64 + tx * 4);
                const float av[4] = {a.x, a.y, a.z, a.w}, bv[4] = {b.x, b.y, b.z, b.w};
#pragma unroll
                for (int i = 0; i < 4; ++i)
#pragma unroll
                    for (int j = 0; j < 4; ++j) acc[i][j] += av[i] * bv[j];
            }
            __syncthreads();
        }
#pragma unroll
        for (int i = 0; i < 4; ++i) {
            float4 o; o.x = acc[i][0]; o.y = acc[i][1]; o.z = acc[i][2]; o.w = acc[i][3];
            if (Cb) { unsigned short* cb = Cb + (size_t)(m0 + ty * 4 + i) * ldc + n0 + tx * 4; cb[0] = f2bf_raw(o.x); cb[1] = f2bf_raw(o.y); cb[2] = f2bf_raw(o.z); cb[3] = f2bf_raw(o.w); }
            else *(float4*)(C + (size_t)(m0 + ty * 4 + i) * ldc + n0 + tx * 4) = o;
        }
    }
}

template <int DQK, int DV, bool V_IN_K, int MODE, class KV, class QF>
DI void attn_naive(LAS float* lds, const KV& kv, int nk_loop, const QF& qf, bool active, int limit, float scale, float lg, int tq, float* optr) {
    constexpr int KS = DQK + 1;
    constexpr int VS = V_IN_K ? KS : DV;
    LAS float* Ks = lds;
    LAS float* Vs = V_IN_K ? Ks : (lds + 64 * KS);
    LAS float* qs = lds + 64 * KS + (V_IN_K ? 0 : 64 * DV);
    LAS float* ps = qs + 8 * DQK;
    static_assert((64 * KS + (V_IN_K ? 0 : 64 * DV) + 8 * DQK + 8 * 64) * 4 <= MISC_OFF, "attn_naive LDS");
    const int tid = threadIdx.x, lane = tid & 63, w = tid >> 6;
    __syncthreads();
    for (int d = lane; d < DQK; d += 64) qs[w * DQK + d] = active ? qf(d) : 0.f;
    float m = -INFINITY, l = 0.f;
    float acc[DV / 64];
#pragma unroll
    for (int c = 0; c < DV / 64; ++c) acc[c] = 0.f;
    for (int base = 0; base < nk_loop; base += 64) {
        __syncthreads();
        for (int idx = tid; idx < 64 * DQK; idx += NTHREADS) { const int j = idx / DQK, d = idx - j * DQK, key = base + j; Ks[j * KS + d] = key < nk_loop ? kv.k(key, d) : 0.f; }
        if (!V_IN_K) for (int idx = tid; idx < 64 * DV; idx += NTHREADS) { const int j = idx / DV, e = idx - j * DV, key = base + j; Vs[j * DV + e] = key < nk_loop ? kv.v(key, e) : 0.f; }
        __syncthreads();
        const int key = base + lane; const bool valid = active && key <= limit && key < nk_loop;
        float s = 0.f;
        for (int d = 0; d < DQK; ++d) s += qs[w * DQK + d] * Ks[lane * KS + d];
        float p;
        if (MODE == 0) {
            s *= scale;
            const float cm = wave_max(valid ? s : -INFINITY);
            const float mn = fmaxf(m, cm);
            const float alpha = (mn == -INFINITY) ? 1.f : expf(m - mn);
            p = valid ? expf(s - mn) : 0.f;
            l = l * alpha + wave_sum(p);
#pragma unroll
            for (int c = 0; c < DV / 64; ++c) acc[c] *= alpha;
            m = mn;
        } else {
            p = valid ? s * expf((float)(tq - key) * lg) : 0.f;
        }
        ps[w * 64 + lane] = p;
        __syncthreads();
        for (int j = 0; j < 64; ++j) { const float pj = ps[w * 64 + j];
#pragma unroll
            for (int c = 0; c < DV / 64; ++c) acc[c] += pj * Vs[j * VS + lane + 64 * c]; }
    }
    if (active) {
#pragma unroll
        for (int c = 0; c < DV / 64; ++c) optr[lane + 64 * c] = (MODE == 0) ? acc[c] / l : acc[c];
    }
}

struct KvMlaPrompt { const float* ckvn; const float* kper; int b;
    DI float k(int key, int d) const { const size_t row = (size_t)b * SEQ + key; return d < KVL ? ckvn[row * KVL + d] : kper[row * DROPE + (d - KVL)]; }
    DI float v(int, int) const { return 0.f; } };
struct KvMlaSample { const float* ckvn; const float* kper; const float* cckv; const float* ckpe; const int* pt; int b;
    DI float k(int key, int d) const {
        if (key < PAST) { const size_t r = (size_t)pt[b * NPAGES + (key >> 7)] * PAGE + (key & (PAGE - 1)); return d < KVL ? cckv[r * KVL + d] : ckpe[r * DROPE + (d - KVL)]; }
        const size_t row = (size_t)NP + b * DS + (key - PAST); return d < KVL ? ckvn[row * KVL + d] : kper[row * DROPE + (d - KVL)]; }
    DI float v(int, int) const { return 0.f; } };
struct KvRet { const float* rk; const float* z; int b, h;
    DI float k(int key, int d) const { return rk[((size_t)b * SEQ + key) * 512 + h * RDK + d]; }
    DI float v(int key, int e) const { return z[((size_t)b * SEQ + key) * ZLD + C_RV + h * RDV + e]; } };
struct KvMem { const float* mk; const float* mv; int b, h;
    DI float k(int key, int d) const { return mk[(((size_t)b * NMEM + key) * XH + h) * XHD + d]; }
    DI float v(int key, int e) const { return mv[(((size_t)b * NMEM + key) * XH + h) * XHD + e]; } };


typedef float f32x16 __attribute__((ext_vector_type(16)));
typedef short bf16x8 __attribute__((ext_vector_type(8)));
typedef short s16x4 __attribute__((ext_vector_type(4)));
typedef __bf16 bf16x2_t __attribute__((ext_vector_type(2)));
typedef float f32x2_t __attribute__((ext_vector_type(2)));
typedef unsigned u32x4_t __attribute__((ext_vector_type(4)));
typedef unsigned u32x2_t __attribute__((ext_vector_type(2)));
DI unsigned cvtpk(float lo, float hi) { f32x2_t v = {lo, hi}; bf16x2_t b = __builtin_convertvector(v, bf16x2_t); return __builtin_bit_cast(unsigned, b); }
DI int crow(int i, int h) { return (i & 3) + 8 * (i >> 2) + 4 * h; }
#define MFMA32(a, b, c) __builtin_amdgcn_mfma_f32_32x32x16_bf16((a), (b), (c), 0, 0, 0)
template <int DQK, int DV, bool CAUSAL, class Src>
DI void flash_unit(LAS unsigned char* lds, const Src& src, const bf16_t* Q, int ldq, int qpos0, int ntiles, bf16_t* O, int ldo, float c2) {
    constexpr int KP = DQK + 8, VP = 68, KS = DQK / 16, NBLK = DV / 32;
    constexpr int KBYTES = 64 * KP * 2, VBYTES = DV * VP * 2, BUF = KBYTES + VBYTES;
    constexpr int D8 = DQK / 8, NPK = (64 * D8) / NTHREADS, NPV = (DV * 8) / NTHREADS;
    static_assert((64 * D8) % NTHREADS == 0 && (DV * 8) % NTHREADS == 0 && 2 * BUF <= 131072, "flash_unit geometry");
    const int tid = threadIdx.x, lane = tid & 63, w = __builtin_amdgcn_readfirstlane(tid >> 6), l31 = lane & 31, h = lane >> 5;
    bf16x8 qf[KS];
    { const bf16_t* qrow = Q + (size_t)(32 * w + l31) * ldq + h * 8;
#pragma unroll
      for (int s_ = 0; s_ < KS; ++s_) qf[s_] = *(const bf16x8*)(qrow + 16 * s_); }
    f32x16 o[NBLK];
#pragma unroll
    for (int b = 0; b < NBLK; ++b)
#pragma unroll
        for (int i = 0; i < 16; ++i) o[b][i] = 0.f;
    float m = -INFINITY, lsum = 0.f;
    u32x4_t kreg[NPK], vreg[NPV];
#define FL_LOAD(t_) do { _Pragma("unroll") for (int i_ = 0; i_ < NPK; ++i_) { const int p_ = tid + i_ * NTHREADS; kreg[i_] = src.kpiece(64 * (t_) + p_ / D8, p_ % D8); } \
                         _Pragma("unroll") for (int i_ = 0; i_ < NPV; ++i_) { const int p_ = tid + i_ * NTHREADS; vreg[i_] = src.vpiece(p_ >> 3, 64 * (t_) + 8 * (p_ & 7)); } } while (0)
#define FL_STORE(buf_) do { _Pragma("unroll") for (int i_ = 0; i_ < NPK; ++i_) { const int p_ = tid + i_ * NTHREADS; *(LAS u32x4_t*)(lds + (buf_) * BUF + ((p_ / D8) * KP + (p_ % D8) * 8) * 2) = kreg[i_]; } \
                          _Pragma("unroll") for (int i_ = 0; i_ < NPV; ++i_) { const int p_ = tid + i_ * NTHREADS; LAS unsigned char* a_ = lds + (buf_) * BUF + KBYTES + ((p_ >> 3) * VP + (p_ & 7) * 8) * 2; \
                              *(LAS u32x2_t*)a_ = (u32x2_t){vreg[i_].x, vreg[i_].y}; *(LAS u32x2_t*)(a_ + 8) = (u32x2_t){vreg[i_].z, vreg[i_].w}; } } while (0)
    __syncthreads();
    FL_LOAD(0); FL_STORE(0);
    __syncthreads();
    const int qmine = qpos0 + 32 * w + l31, qlast = qpos0 + 32 * w + 31;
    for (int t = 0; t < ntiles; ++t) {
        const int buf = t & 1;
        if (t + 1 < ntiles) FL_LOAD(t + 1);
        if (!CAUSAL || 64 * t <= qlast) {
            const LAS unsigned char* kb_ = lds + buf * BUF; const LAS unsigned char* vb_ = kb_ + KBYTES;
            f32x16 st[2];
#pragma unroll
            for (int kb = 0; kb < 2; ++kb) {
#pragma unroll
                for (int i = 0; i < 16; ++i) st[kb][i] = 0.f;
#pragma unroll
                for (int g_ = 0; g_ < KS / 4; ++g_) { bf16x8 kf[4];
#pragma unroll
                    for (int j = 0; j < 4; ++j) kf[j] = *(const LAS bf16x8*)(kb_ + ((32 * kb + l31) * KP + 16 * (4 * g_ + j) + 8 * h) * 2);
#pragma unroll
                    for (int j = 0; j < 4; ++j) st[kb] = MFMA32(kf[j], qf[4 * g_ + j], st[kb]);
                    __builtin_amdgcn_sched_barrier(0); }
            }
            float mx = -INFINITY;
#pragma unroll
            for (int kb = 0; kb < 2; ++kb)
#pragma unroll
                for (int i = 0; i < 16; ++i) { float v = st[kb][i] * c2; if (CAUSAL) { const int key = 64 * t + 32 * kb + crow(i, h); v = key <= qmine ? v : -INFINITY; } st[kb][i] = v; mx = fmaxf(mx, v); }
            mx = fmaxf(mx, __shfl_xor(mx, 32));
            const float mn = fmaxf(m, mx);
            const float alpha = __builtin_amdgcn_exp2f(m - mn);
            m = mn;
            float ps = 0.f;
#pragma unroll
            for (int kb = 0; kb < 2; ++kb)
#pragma unroll
                for (int i = 0; i < 16; ++i) { const float p = __builtin_amdgcn_exp2f(st[kb][i] - mn); st[kb][i] = p; ps += p; }
            lsum = lsum * alpha + ps;
#pragma unroll
            for (int b = 0; b < NBLK; ++b)
#pragma unroll
                for (int i = 0; i < 16; ++i) o[b][i] *= alpha;
            bf16x8 pf[4];
#pragma unroll
            for (int ks = 0; ks < 4; ++ks) { const int kb = ks >> 1, s2 = ks & 1; u32x4_t pk;
                pk.x = cvtpk(st[kb][8 * s2 + 0], st[kb][8 * s2 + 1]); pk.y = cvtpk(st[kb][8 * s2 + 2], st[kb][8 * s2 + 3]);
                pk.z = cvtpk(st[kb][8 * s2 + 4], st[kb][8 * s2 + 5]); pk.w = cvtpk(st[kb][8 * s2 + 6], st[kb][8 * s2 + 7]); pf[ks] = __builtin_bit_cast(bf16x8, pk); }
            __builtin_amdgcn_sched_barrier(0);
#pragma unroll
            for (int b = 0; b < NBLK; ++b) { bf16x8 vf[4];
#pragma unroll
                for (int ks = 0; ks < 4; ++ks) { const LAS unsigned char* a_ = vb_ + ((32 * b + l31) * VP + 16 * ks + 4 * h) * 2;
                    const s16x4 lo = *(const LAS s16x4*)a_, hi = *(const LAS s16x4*)(a_ + 16);
                    vf[ks] = __builtin_shufflevector(lo, hi, 0, 1, 2, 3, 4, 5, 6, 7); }
#pragma unroll
                for (int ks = 0; ks < 4; ++ks) o[b] = MFMA32(vf[ks], pf[ks], o[b]);
                __builtin_amdgcn_sched_barrier(0); }
        }
        if (t + 1 < ntiles) FL_STORE(buf ^ 1);
        __syncthreads();
    }
#undef FL_LOAD
#undef FL_STORE
    lsum += __shfl_xor(lsum, 32);
    const float inv = 1.f / lsum;
    bf16_t* orow = O + (size_t)(32 * w + l31) * ldo;
#pragma unroll
    for (int b = 0; b < NBLK; ++b)
#pragma unroll
        for (int g = 0; g < 4; ++g) { u32x2_t pk; pk.x = cvtpk(o[b][4 * g + 0] * inv, o[b][4 * g + 1] * inv); pk.y = cvtpk(o[b][4 * g + 2] * inv, o[b][4 * g + 3] * inv);
            *(u32x2_t*)(orow + 32 * b + 8 * g + 4 * h) = pk; }
}
struct SrcMlaP { const bf16_t* kn; const bf16_t* kpe; const bf16_t* vt; int b, hh;
    DI u32x4_t kpiece(int key, int d8) const { const size_t row = (size_t)b * SEQ + key;
        return d8 < 16 ? *(const u32x4_t*)(kn + row * 1024 + hh * DNOPE + d8 * 8) : *(const u32x4_t*)(kpe + row * DROPE + (d8 - 16) * 8); }
    DI u32x4_t vpiece(int dv, int key0) const { return *(const u32x4_t*)(vt + (size_t)(hh * DVH + dv) * NP + (size_t)b * SEQ + key0); } };
struct SrcMemP { const bf16_t* mk; const bf16_t* mvt; int b, hh;
    DI u32x4_t kpiece(int key, int d8) const { return *(const u32x4_t*)(mk + ((size_t)b * NMEM + key) * 256 + hh * XHD + d8 * 8); }
    DI u32x4_t vpiece(int dv, int key0) const { return *(const u32x4_t*)(mvt + (size_t)(hh * XHD + dv) * (NB * NMEM) + (size_t)b * NMEM + key0); } };


DI void ret_chunk_state(const bf16_t* __restrict__ RVT, const bf16_t* __restrict__ RKtT, float* __restrict__ UT, int b, int h, int c) {
    const int tid = threadIdx.x, lane = tid & 63, w = __builtin_amdgcn_readfirstlane(tid >> 6), l31 = lane & 31, hh = lane >> 5;
    const size_t tok0 = (size_t)b * SEQ + c * 128;
    f32x16 acc[4];
#pragma unroll
    for (int kb = 0; kb < 4; ++kb)
#pragma unroll
        for (int i = 0; i < 16; ++i) acc[kb][i] = 0.f;
    const bf16_t* ap = RVT + (size_t)(h * RDV + 32 * w + l31) * NT + tok0 + 8 * hh;
    const bf16_t* bp = RKtT + (size_t)(h * RDK + l31) * NP + tok0 + 8 * hh;
#pragma unroll
    for (int s_ = 0; s_ < 8; ++s_) { const bf16x8 a = *(const bf16x8*)(ap + 16 * s_);
#pragma unroll
        for (int kb = 0; kb < 4; ++kb) { const bf16x8 bfr = *(const bf16x8*)(bp + (size_t)(32 * kb) * NP + 16 * s_); acc[kb] = MFMA32(a, bfr, acc[kb]); } }
    float* u = UT + (size_t)(((b * RH + h) * 16) + c) * 32768;
#pragma unroll
    for (int kb = 0; kb < 4; ++kb)
#pragma unroll
        for (int i = 0; i < 16; ++i) u[(32 * w + crow(i, hh)) * RDK + 32 * kb + l31] = acc[kb][i];
}
DI void ret_chunk_out(const bf16_t* __restrict__ RQt, const bf16_t* __restrict__ RKt, const bf16_t* __restrict__ RVT, const bf16_t* __restrict__ SPT, float* __restrict__ ORET, int b, int h, int c) {
    const int tid = threadIdx.x, lane = tid & 63, w = __builtin_amdgcn_readfirstlane(tid >> 6), l31 = lane & 31, hh = lane >> 5;
    const int ib = w & 3, vh = w >> 2;
    const size_t tok0 = (size_t)b * SEQ + c * 128;
    bf16x8 qf[8];
    { const bf16_t* qp = RQt + (tok0 + 32 * ib + l31) * 512 + h * RDK + 8 * hh;
#pragma unroll
      for (int s_ = 0; s_ < 8; ++s_) qf[s_] = *(const bf16x8*)(qp + 16 * s_); }
    f32x16 o[4];
#pragma unroll
    for (int blk = 0; blk < 4; ++blk)
#pragma unroll
        for (int i = 0; i < 16; ++i) o[blk][i] = 0.f;
    const bf16_t* vbase = RVT + (size_t)(h * RDV + 32 * (4 * vh) + l31) * NT + tok0 + 4 * hh;
#pragma unroll 1
    for (int jb = 0; jb <= ib; ++jb) {
        f32x16 x;
#pragma unroll
        for (int i = 0; i < 16; ++i) x[i] = 0.f;
        const bf16_t* kp = RKt + (tok0 + 32 * jb + l31) * 512 + h * RDK + 8 * hh;
#pragma unroll
        for (int s_ = 0; s_ < 8; ++s_) { const bf16x8 kf = *(const bf16x8*)(kp + 16 * s_); x = MFMA32(kf, qf[s_], x); }
        if (jb == ib) {
#pragma unroll
            for (int i = 0; i < 16; ++i) x[i] = (crow(i, hh) <= l31) ? x[i] : 0.f;
        }
#pragma unroll
        for (int s2 = 0; s2 < 2; ++s2) {
            u32x4_t pk; pk.x = cvtpk(x[8 * s2 + 0], x[8 * s2 + 1]); pk.y = cvtpk(x[8 * s2 + 2], x[8 * s2 + 3]); pk.z = cvtpk(x[8 * s2 + 4], x[8 * s2 + 5]); pk.w = cvtpk(x[8 * s2 + 6], x[8 * s2 + 7]);
            const bf16x8 pa = __builtin_bit_cast(bf16x8, pk);
#pragma unroll
            for (int blk = 0; blk < 4; ++blk) { const bf16_t* vp = vbase + (size_t)(32 * blk) * NT + 32 * jb + 16 * s2;
                const s16x4 lo = *(const s16x4*)vp, hi = *(const s16x4*)(vp + 8);
                const bf16x8 vf = __builtin_shufflevector(lo, hi, 0, 1, 2, 3, 4, 5, 6, 7);
                o[blk] = MFMA32(pa, vf, o[blk]); }
        }
    }
    const bf16_t* sp = SPT + (size_t)(((b * RH + h) * 16) + c) * 32768 + (size_t)(32 * (4 * vh) + l31) * RDK + 8 * hh;
#pragma unroll
    for (int s_ = 0; s_ < 8; ++s_)
#pragma unroll
        for (int blk = 0; blk < 4; ++blk) { const bf16x8 sf = *(const bf16x8*)(sp + (size_t)(32 * blk) * RDK + 16 * s_); o[blk] = MFMA32(qf[s_], sf, o[blk]); }
#pragma unroll
    for (int blk = 0; blk < 4; ++blk)
#pragma unroll
        for (int i = 0; i < 16; ++i) ORET[(tok0 + 32 * ib + crow(i, hh)) * 1024 + h * RDV + 32 * (4 * vh + blk) + l31] = o[blk][i];
}


typedef short v4i16_t __attribute__((ext_vector_type(4)));
DI s16x4 vtr(const LAS unsigned char* p) { return __builtin_bit_cast(s16x4, __builtin_amdgcn_ds_read_tr16_b64_v4i16((LAS v4i16_t*)p)); }
constexpr int MS_NSPLIT = 2, MS_KEYS = PAST / MS_NSPLIT, MS_TILES = MS_KEYS / 64;
DI void mla_sample_unit(LAS unsigned char* lds, const float* __restrict__ cckv, const float* __restrict__ ckpe, const int* __restrict__ pt,
                        const bf16_t* __restrict__ QLATb, const bf16_t* __restrict__ Qb, float* __restrict__ PO, float* __restrict__ PML, int b, int split, float c2) {
    constexpr int KP = 328, KBYTES = 64 * KP * 2;
    const int tid = threadIdx.x, lane = tid & 63, w = __builtin_amdgcn_readfirstlane(tid >> 6), l31 = lane & 31, hh = lane >> 5;
    bf16x8 qf[20];
    { const int t = l31 >> 3, head = l31 & 7;
      const bf16_t* ql = QLATb + (size_t)(b * DS + t) * 2048 + head * KVL + 8 * hh;
      const bf16_t* qp = Qb + (size_t)(NP + b * DS + t) * 1536 + head * DQH + DNOPE + 8 * hh;
#pragma unroll
      for (int s_ = 0; s_ < 16; ++s_) qf[s_] = *(const bf16x8*)(ql + 16 * s_);
#pragma unroll
      for (int s_ = 0; s_ < 4; ++s_) qf[16 + s_] = *(const bf16x8*)(qp + 16 * s_); }
    f32x16 o;
#pragma unroll
    for (int i = 0; i < 16; ++i) o[i] = 0.f;
    float m = -INFINITY, lsum = 0.f;
    f32x4 cr[8], pr[2];
#define MS_LOAD(t_) do { const int key0_ = split * MS_KEYS + 64 * (t_); const size_t rowb_ = (size_t)pt[b * NPAGES + (key0_ >> 7)] * PAGE + (key0_ & (PAGE - 1)); \
        _Pragma("unroll") for (int i_ = 0; i_ < 8; ++i_) { const int pc_ = tid + i_ * NTHREADS; cr[i_] = __builtin_nontemporal_load((const f32x4*)(cckv + (rowb_ + (pc_ >> 6)) * KVL + 4 * (pc_ & 63))); } \
        _Pragma("unroll") for (int i_ = 0; i_ < 2; ++i_) { const int pc_ = tid + i_ * NTHREADS; pr[i_] = __builtin_nontemporal_load((const f32x4*)(ckpe + (rowb_ + (pc_ >> 4)) * DROPE + 4 * (pc_ & 15))); } } while (0)
#define MS_STORE(buf_) do { \
        _Pragma("unroll") for (int i_ = 0; i_ < 8; ++i_) { const int pc_ = tid + i_ * NTHREADS; *(LAS u32x2_t*)(lds + (buf_) * KBYTES + ((pc_ >> 6) * KP + 4 * (pc_ & 63)) * 2) = (u32x2_t){cvtpk(cr[i_][0], cr[i_][1]), cvtpk(cr[i_][2], cr[i_][3])}; } \
        _Pragma("unroll") for (int i_ = 0; i_ < 2; ++i_) { const int pc_ = tid + i_ * NTHREADS; *(LAS u32x2_t*)(lds + (buf_) * KBYTES + ((pc_ >> 4) * KP + KVL + 4 * (pc_ & 15)) * 2) = (u32x2_t){cvtpk(pr[i_][0], pr[i_][1]), cvtpk(pr[i_][2], pr[i_][3])}; } } while (0)
    __syncthreads();
    MS_LOAD(0); MS_STORE(0);
    __syncthreads();
    const int q4 = (lane & 15) >> 2, p4 = lane & 3, blk = (lane >> 4) & 1;
#pragma unroll 1
    for (int t = 0; t < MS_TILES; ++t) {
        const int buf = t & 1;
        if (t + 1 < MS_TILES) MS_LOAD(t + 1);
        const LAS unsigned char* kb_ = lds + buf * KBYTES;
        f32x16 st[2];
#pragma unroll
        for (int kb = 0; kb < 2; ++kb) {
#pragma unroll
            for (int i = 0; i < 16; ++i) st[kb][i] = 0.f;
#pragma unroll
            for (int g_ = 0; g_ < 5; ++g_) { bf16x8 kf[4];
#pragma unroll
                for (int j = 0; j < 4; ++j) kf[j] = *(const LAS bf16x8*)(kb_ + ((32 * kb + l31) * KP + 16 * (4 * g_ + j) + 8 * hh) * 2);
#pragma unroll
                for (int j = 0; j < 4; ++j) st[kb] = MFMA32(kf[j], qf[4 * g_ + j], st[kb]);
                __builtin_amdgcn_sched_barrier(0); }
        }
        float mx = -INFINITY;
#pragma unroll
        for (int kb = 0; kb < 2; ++kb)
#pragma unroll
            for (int i = 0; i < 16; ++i) { const float v = st[kb][i] * c2; st[kb][i] = v; mx = fmaxf(mx, v); }
        mx = fmaxf(mx, __shfl_xor(mx, 32));
        const float mn = fmaxf(m, mx);
        const float alpha = __builtin_amdgcn_exp2f(m - mn);
        m = mn;
        float ps = 0.f;
#pragma unroll
        for (int kb = 0; kb < 2; ++kb)
#pragma unroll
            for (int i = 0; i < 16; ++i) { const float p = __builtin_amdgcn_exp2f(st[kb][i] - mn); st[kb][i] = p; ps += p; }
        lsum = lsum * alpha + ps;
#pragma unroll
        for (int i = 0; i < 16; ++i) o[i] *= alpha;
        bf16x8 vf[4];
#pragma unroll
        for (int ks = 0; ks < 4; ++ks) { const LAS unsigned char* a_ = kb_ + ((16 * ks + 4 * hh + q4) * KP + 32 * w + 16 * blk + 4 * p4) * 2;
            const s16x4 lo = vtr(a_), hi = vtr(a_ + 8 * KP * 2);
            vf[ks] = __builtin_shufflevector(lo, hi, 0, 1, 2, 3, 4, 5, 6, 7); }
#pragma unroll
        for (int ks = 0; ks < 4; ++ks) { const int kb = ks >> 1, s2 = ks & 1; u32x4_t pk;
            pk.x = cvtpk(st[kb][8 * s2 + 0], st[kb][8 * s2 + 1]); pk.y = cvtpk(st[kb][8 * s2 + 2], st[kb][8 * s2 + 3]);
            pk.z = cvtpk(st[kb][8 * s2 + 4], st[kb][8 * s2 + 5]); pk.w = cvtpk(st[kb][8 * s2 + 6], st[kb][8 * s2 + 7]);
            o = MFMA32(vf[ks], __builtin_bit_cast(bf16x8, pk), o); }
        if (t + 1 < MS_TILES) MS_STORE(buf ^ 1);
        __syncthreads();
    }
#undef MS_LOAD
#undef MS_STORE
    lsum += __shfl_xor(lsum, 32);
    const int item = b * MS_NSPLIT + split;
    if (w == 0 && lane < 32) { PML[(item * 32 + lane) * 2] = m; PML[(item * 32 + lane) * 2 + 1] = lsum; }
#pragma unroll
    for (int i = 0; i < 16; ++i) PO[((size_t)item * 32 + l31) * KVL + 32 * w + crow(i, hh)] = o[i];
}

struct QPtr { const float* p; DI float operator()(int d) const { return p[d]; } };
struct QMla { const float* ql; const float* qp; DI float operator()(int d) const { return d < KVL ? ql[d] : qp[d - KVL]; } };
DI void rms_row(const float* x, const float* g, float* o, int n, int lane) {
    float s = 0.f;
    for (int i = lane; i < n; i += 64) { const float v = x[i]; s += v * v; }
    const float r = rsqrtf(wave_sum(s) / (float)n + EPS);
    for (int i = lane; i < n; i += 64) o[i] = x[i] * r * g[i];
}

DI void rms_row_bf16(const float* x, const float* g, bf16_t* o, int n, int lane) {
    float s = 0.f;
    for (int i = lane; i < n; i += 64) { const float v = x[i]; s += v * v; }
    const float r = rsqrtf(wave_sum(s) / (float)n + EPS);
    for (int i = lane; i < n; i += 64) o[i] = f2bf(x[i] * r * g[i]);
}
#define GEMM_PHASE(EPI, ...) pg8::gemm_phase<EPI, pg8::StaticOrder, true, true>(__VA_ARGS__)
__global__ void __launch_bounds__(NTHREADS, 2) fwd_kernel(Args args) {
    extern __shared__ __attribute__((aligned(16))) unsigned char lds_raw[];
    LAS unsigned char* ldsb = (LAS unsigned char*)lds_raw;
    LAS float* lds = (LAS float*)ldsb;
    volatile LAS unsigned* MISC = (volatile LAS unsigned*)(ldsb + MISC_OFF);
    const int tid = threadIdx.x, lane = tid & 63, wave = tid >> 6;
    const int G = gridDim.x, bid = blockIdx.x;
    const int gw = bid * NWAVES + wave, NGW = G * NWAVES;
    unsigned char* ws = args.ws;
    float* out = args.out;
    const int lo = args.ph_lo, hi = args.ph_hi;

    if (tid < 64) MISC[tid] = 0u;
    __syncthreads();
    XcdBarrier bar; bar.bar = (unsigned*)(ws + WS_CTL) + CW_BAR; bar.x = 0; bar.st = MISC;
    if (hi - lo > 1) bar = xcd_barrier_post((unsigned*)(ws + WS_CTL) + CW_BAR, MISC);
#define IN(k) (lo <= (k) && (k) < hi)
#define SEAM(k) do { if (IN(k) && IN((k) + 1)) xcd_barrier(bar); } while (0)

    const float* x_prompt = args.in[0]; const float* x_sample = args.in[1]; const float* mem_prompt = args.in[2];
    const float* cache_ckv = args.in[3]; const float* cache_kpe = args.in[4]; const int* page_table = (const int*)args.in[5];
    const float* state_ret = args.in[6]; const float* cache_mem_k = args.in[7]; const float* cache_mem_v = args.in[8];
    const float* g_mix_pre = args.in[9]; const float* g_mix_post = args.in[10]; const float* g_ffn_pre = args.in[11]; const float* g_ffn_post = args.in[12];
    const float* g_mem = args.in[13]; const float* g_qlat = args.in[14]; const float* g_kvlat = args.in[15];
    const float* w_in = args.in[16]; const float* w_uq = args.in[17]; const float* w_uk = args.in[18]; const float* w_uv = args.in[19];
    const float* w_mem_k = args.in[20]; const float* w_mem_v = args.in[21]; const float* w_ret_o = args.in[22]; const float* w_mla_o = args.in[23];
    const float* w_x_o = args.in[24]; const float* w_out = args.in[25]; const float* w_gate = args.in[26]; const float* w_up = args.in[27]; const float* w_down = args.in[28];
    float* COSA = (float*)(ws + WS_COSA); float* SINA = (float*)(ws + WS_SINA); float* COSB = (float*)(ws + WS_COSB); float* SINB = (float*)(ws + WS_SINB);
    float* U = (float*)(ws + WS_U); float* MN = (float*)(ws + WS_MN); float* Z = (float*)(ws + WS_Z);
    float* RQ = (float*)(ws + WS_RQ); float* RK = (float*)(ws + WS_RK); float* CQN = (float*)(ws + WS_CQN); float* CKVN = (float*)(ws + WS_CKVN); float* KPER = (float*)(ws + WS_KPER);
    float* Q = (float*)(ws + WS_Q); float* QLAT = (float*)(ws + WS_QLAT); float* QPE = (float*)(ws + WS_QPE);
    float* ORET = (float*)(ws + WS_ORET); float* OLAT = (float*)(ws + WS_OLAT); float* OX = (float*)(ws + WS_OX); float* OMLA = (float*)(ws + WS_OMLA); float* ORETN = (float*)(ws + WS_ORETN);
    float* ARET = (float*)(ws + WS_ARET); float* AMLA = (float*)(ws + WS_AMLA); float* AX = (float*)(ws + WS_AX); float* MIX = (float*)(ws + WS_MIX);
    float* HP = (float*)(ws + WS_HP); float* H = (float*)(ws + WS_H); float* F = (float*)(ws + WS_F);
    float* GU = (float*)(ws + WS_GG); float* FO = (float*)(ws + WS_FO);
    bf16_t* WinT = (bf16_t*)(ws + WS_WIN_T); bf16_t* WmkvT = (bf16_t*)(ws + WS_WMKV_T); bf16_t* WuqT = (bf16_t*)(ws + WS_WUQ_T); bf16_t* WroT = (bf16_t*)(ws + WS_WRO_T);
    bf16_t* WmoT = (bf16_t*)(ws + WS_WMO_T); bf16_t* WxoT = (bf16_t*)(ws + WS_WXO_T); bf16_t* WoT = (bf16_t*)(ws + WS_WO_T); bf16_t* WguT = (bf16_t*)(ws + WS_WGU_T); bf16_t* WdT = (bf16_t*)(ws + WS_WD_T);
    bf16_t* Ub = (bf16_t*)(ws + WS_UB); bf16_t* MNb = (bf16_t*)(ws + WS_MNB); bf16_t* CQNb = (bf16_t*)(ws + WS_CQNB); bf16_t* ORETNb = (bf16_t*)(ws + WS_ORETNB);
    bf16_t* OMLAb = (bf16_t*)(ws + WS_OMLAB); bf16_t* OXb = (bf16_t*)(ws + WS_OXB); bf16_t* MIXb = (bf16_t*)(ws + WS_MIXB); bf16_t* Fb = (bf16_t*)(ws + WS_FB); bf16_t* ACTb = (bf16_t*)(ws + WS_ACTB);
    bf16_t* WukT = (bf16_t*)(ws + WS_WUK_T); bf16_t* WuvT = (bf16_t*)(ws + WS_WUV_T); bf16_t* CKVNb = (bf16_t*)(ws + WS_CKVNB); bf16_t* KPERb = (bf16_t*)(ws + WS_KPERB);
    bf16_t* XQb = (bf16_t*)(ws + WS_XQB); bf16_t* MKb = (bf16_t*)(ws + WS_MKB); bf16_t* MVT = (bf16_t*)(ws + WS_MVT); bf16_t* KN = (bf16_t*)(ws + WS_KN); bf16_t* VT = (bf16_t*)(ws + WS_VT); bf16_t* Qb = (bf16_t*)(ws + WS_QB);
    bf16_t* RQt = (bf16_t*)(ws + WS_RQT); bf16_t* RKt = (bf16_t*)(ws + WS_RKT); bf16_t* RKtT = (bf16_t*)(ws + WS_RKTT); bf16_t* RVT = (bf16_t*)(ws + WS_RVT);
    float* UT = (float*)(ws + WS_UT); bf16_t* SPT = (bf16_t*)(ws + WS_SPT);
    bf16_t* QLATb = (bf16_t*)(ws + WS_QLATB); float* PO = (float*)(ws + WS_PO); float* PML = (float*)(ws + WS_PML);

    if (IN(0)) {
        for (int i = bid * NTHREADS + tid; i < NPOS * 64 + NPOS * 32; i += G * NTHREADS) {
            const bool a = i < NPOS * 64; const int j = a ? i : i - NPOS * 64; const int half = a ? 64 : 32;
            const int p = j / half, f = j % half; const int pos = p < SEQ ? p : PAST + (p - SEQ);
            const float inv = powf(10000.0f, -(float)f / (float)half);
            const float ang = (float)pos * inv;
            double rev = (double)ang * 0.15915494309189535; rev -= floor(rev);
            const float r = (float)rev;
            const float sn = __builtin_amdgcn_sinf(r), cs = __builtin_amdgcn_cosf(r);
            if (a) { COSA[j] = cs; SINA[j] = sn; } else { COSB[j] = cs; SINB[j] = sn; }
        }
        for (int row = gw; row < NT; row += NGW) {
            const float* xr = row < NP ? x_prompt + (size_t)row * DM : x_sample + (size_t)(row - NP) * DM;
            rms_row_bf16(xr, g_mix_pre, Ub + (size_t)row * DM, DM, lane);
        }
        for (int row = gw; row < NB * NMEM; row += NGW) rms_row_bf16(mem_prompt + (size_t)row * DM, g_mem, MNb + (size_t)row * DM, DM, lane);
        {
            LAS float* scr = lds + wave * (64 * 33);
            transpose_w(w_in, 1024, DIN, WinT, 1024, 0, scr, gw, NGW, lane);
            for (int i = bid * NTHREADS + tid; i < (ZLD - DIN) * 1024 / 2; i += G * NTHREADS) ((unsigned*)(WinT + (size_t)DIN * 1024))[i] = 0u;
            transpose_w(w_mem_k, 1024, 256, WmkvT, 1024, 0, scr, gw, NGW, lane);
            transpose_w(w_mem_v, 1024, 256, WmkvT, 1024, 256, scr, gw, NGW, lane);
            transpose_w(w_uq, QL, 1536, WuqT, QL, 0, scr, gw, NGW, lane);
            transpose_w(w_ret_o, 1024, 1024, WroT, 1024, 0, scr, gw, NGW, lane);
            transpose_w(w_mla_o, 1024, 1024, WmoT, 1024, 0, scr, gw, NGW, lane);
            transpose_w(w_x_o, 256, 1024, WxoT, 256, 0, scr, gw, NGW, lane);
            transpose_w(w_out, 1024, 1024, WoT, 1024, 0, scr, gw, NGW, lane);
            transpose_w(w_gate, 1024, DFF, WguT, 1024, 0, scr, gw, NGW, lane);
            transpose_w(w_up, 1024, DFF, WguT, 1024, DFF, scr, gw, NGW, lane);
            transpose_w(w_down, DFF, 1024, WdT, DFF, 0, scr, gw, NGW, lane);
            for (int hh = 0; hh < MH; ++hh) { transpose_w(w_uk + (size_t)hh * KVL * DNOPE, KVL, DNOPE, WukT, KVL, hh * DNOPE, scr, gw, NGW, lane);
                                              transpose_w(w_uv + (size_t)hh * KVL * DVH, KVL, DVH, WuvT, KVL, hh * DVH, scr, gw, NGW, lane); }
        }
    }
    SEAM(0);
    if (IN(1)) {
        { pg8::Gemm g{Ub, WinT, NT, ZLD, 1024, 1024, 1024}; pg8::StaticOrder S; S.init(NT, ZLD, G, bid); pg8::EpiF32S E{Z, ZLD, 0, 0};
          GEMM_PHASE(pg8::EpiF32S, ldsb, g, S, E); }
        __syncthreads();
        { pg8::Gemm g{MNb, WmkvT, NB * NMEM, 512, 1024, 1024, 1024}; pg8::StaticOrder S; S.init(NB * NMEM, 512, G, bid); pg8::EpiF32S E{out + O_MKP, 256, 1, O_MVP - O_MKP};
          GEMM_PHASE(pg8::EpiF32S, ldsb, g, S, E); }
        __syncthreads();
        { pg8::Gemm g{WinT + (size_t)C_RV * 1024, Ub, 1024, NT, 1024, 1024, 1024}; pg8::StaticOrder S; S.init(1024, NT, G, bid); pg8::EpiBf16S E{RVT, NT};
          GEMM_PHASE(pg8::EpiBf16S, ldsb, g, S, E); }
    }
    SEAM(1);
    if (IN(2)) {
        constexpr int KTP = 520;
        LAS bf16_t* Kt = (LAS bf16_t*)ldsb;
        const int ntile = NP / 64, nwork = ntile + (NS + 63) / 64;
        for (int wk = bid; wk < nwork; wk += G) {
            const bool prompt = wk < ntile; const int row_base = prompt ? wk * 64 : NP + (wk - ntile) * 64;
            __syncthreads();
            for (int r = wave; r < 64; r += NWAVES) {
                const int row = row_base + r;
                const float* z = Z + (size_t)row * ZLD; const int p = pos_index(row);
                const float ca = COSA[p * 64 + lane], sa = SINA[p * 64 + lane];
                const int il = p & 127;
#pragma unroll
                for (int h = 0; h < RH; ++h) {
                    float x1 = z[C_RQ + h * RDK + lane], x2 = z[C_RQ + h * RDK + 64 + lane];
                    const float q1 = x1 * ca - x2 * sa, q2 = x1 * sa + x2 * ca;
                    x1 = z[C_RK + h * RDK + lane]; x2 = z[C_RK + h * RDK + 64 + lane];
                    const float sc = 0.08838834764831845f;
                    const float k1 = (x1 * ca - x2 * sa) * sc, k2 = (x1 * sa + x2 * ca) * sc;
                    if (prompt) {
                        const float lg = lg_gamma(h), fq = expf((float)(il - 127) * lg), fk = expf((float)(127 - il) * lg);
                        RQt[(size_t)row * 512 + h * RDK + lane] = f2bf(q1 * fq); RQt[(size_t)row * 512 + h * RDK + 64 + lane] = f2bf(q2 * fq);
                        const bf16_t kb1 = f2bf(k1 * fk), kb2 = f2bf(k2 * fk);
                        RKt[(size_t)row * 512 + h * RDK + lane] = kb1; RKt[(size_t)row * 512 + h * RDK + 64 + lane] = kb2;
                        Kt[r * KTP + h * RDK + lane] = kb1; Kt[r * KTP + h * RDK + 64 + lane] = kb2;
                    } else {
                        RQ[(size_t)row * 512 + h * RDK + lane] = q1; RQ[(size_t)row * 512 + h * RDK + 64 + lane] = q2;
                        RK[(size_t)row * 512 + h * RDK + lane] = k1; RK[(size_t)row * 512 + h * RDK + 64 + lane] = k2;
                    }
                }
                rms_row_bf16(z + C_CQ, g_qlat, CQNb + (size_t)row * QL, QL, lane);
                rms_row(z + C_CKV, g_kvlat, CKVN + (size_t)row * KVL, KVL, lane);
                float* ockv = row < NP ? out + O_CKVP + (size_t)row * KVL : out + O_CKVS + (size_t)(row - NP) * KVL;
                for (int i = lane; i < KVL; i += 64) { const float v = CKVN[(size_t)row * KVL + i]; ockv[i] = v; CKVNb[(size_t)row * KVL + i] = f2bf(v); }
                for (int i = lane; i < 256; i += 64) XQb[(size_t)row * 256 + i] = f2bf(z[C_XQ + i]);
                if (lane < 32) {
                    const float cb = COSB[p * 32 + lane], sb = SINB[p * 32 + lane];
                    const float x1 = z[C_KPE + lane], x2 = z[C_KPE + 32 + lane];
                    const float o1 = x1 * cb - x2 * sb, o2 = x1 * sb + x2 * cb;
                    KPER[(size_t)row * DROPE + lane] = o1; KPER[(size_t)row * DROPE + 32 + lane] = o2;
                    float* okpe = row < NP ? out + O_KPEP + (size_t)row * DROPE : out + O_KPES + (size_t)(row - NP) * DROPE;
                    okpe[lane] = o1; okpe[32 + lane] = o2;
                    KPERb[(size_t)row * DROPE + lane] = f2bf(o1); KPERb[(size_t)row * DROPE + 32 + lane] = f2bf(o2);
                }
            }
            __syncthreads();
            if (prompt) {
#pragma unroll 2
                for (int i = 0; i < 8; ++i) { const int pc = tid + i * NTHREADS, f = pc >> 3, k8 = pc & 7;
                    const LAS bf16_t* c = Kt + (8 * k8) * KTP + f;
                    pg8::u32x4 o; o.x = (unsigned)c[0] | ((unsigned)c[KTP] << 16); o.y = (unsigned)c[2 * KTP] | ((unsigned)c[3 * KTP] << 16);
                    o.z = (unsigned)c[4 * KTP] | ((unsigned)c[5 * KTP] << 16); o.w = (unsigned)c[6 * KTP] | ((unsigned)c[7 * KTP] << 16);
                    *(pg8::u32x4*)(RKtT + (size_t)f * NP + row_base + 8 * k8) = o; }
            }
        }
    }
    if (IN(2)) {
        for (int i = bid * NTHREADS + tid; i < NB * NMEM * 256; i += G * NTHREADS) { MKb[i] = f2bf(out[O_MKP + i]);
            const int f = i / (NB * NMEM), r = i - f * (NB * NMEM); MVT[i] = f2bf(out[O_MVP + (size_t)r * 256 + f]); }
    }
    SEAM(2);
    if (IN(3)) { pg8::Gemm g{CQNb, WuqT, NT, 1536, QL, QL, QL}; pg8::StaticOrder S; S.init(NT, 1536, G, bid); pg8::EpiF32S E{Q, 1536, 0, 0};
        GEMM_PHASE(pg8::EpiF32S, ldsb, g, S, E);
        __syncthreads();
        { pg8::Gemm g2{CKVNb, WukT, NP, 1024, KVL, KVL, KVL}; pg8::StaticOrder S2; S2.init(NP, 1024, G, bid); pg8::EpiBf16S E2{KN, 1024}; GEMM_PHASE(pg8::EpiBf16S, ldsb, g2, S2, E2); }
        __syncthreads();
        { pg8::Gemm g3{WuvT, CKVNb, 1024, NP, KVL, KVL, KVL}; pg8::StaticOrder S3; S3.init(1024, NP, G, bid); pg8::EpiBf16S E3{VT, NP}; GEMM_PHASE(pg8::EpiBf16S, ldsb, g3, S3, E3); }
        for (int it = bid; it < NB * RH * 16; it += G) { const int c = __builtin_amdgcn_readfirstlane(it & 15), h = __builtin_amdgcn_readfirstlane((it >> 4) & 3), b = __builtin_amdgcn_readfirstlane(it >> 6);
            ret_chunk_state(RVT, RKtT, UT, b, h, c); } }
    SEAM(3);
    if (IN(4)) {
        for (int idx = bid * NTHREADS + tid; idx < NB * RH * 32768; idx += G * NTHREADS) {
            const int bh = idx >> 15, e = idx & 32767; const float g128 = expf(128.f * lg_gamma(bh & 3));
            float sp = 0.f, S = 0.f;
#pragma unroll 4
            for (int c = 0; c < 16; ++c) { const size_t o_ = (size_t)(bh * 16 + c) * 32768 + e; SPT[o_] = f2bf(sp); S = sp + UT[o_]; sp = g128 * S; }
            out[O_RETP + (size_t)bh * 32768 + (size_t)(e & 127) * RDV + (e >> 7)] = S;
        }
        for (int h = 0; h < MH; ++h)
            sgemm_naive(lds, Q + (size_t)NP * 1536 + h * DQH, 1536, w_uk + (size_t)h * KVL * DNOPE, 1, DNOPE, nullptr, MH * KVL, NS, KVL, DNOPE, bid, G, QLATb + h * KVL);
        for (int row = gw; row < NT; row += NGW) {
            const int p = pos_index(row);
            for (int i = lane; i < 1536; i += 64) { const int hh = i / DQH, d = i - hh * DQH; if (d < DNOPE) Qb[(size_t)row * 1536 + i] = f2bf(Q[(size_t)row * 1536 + i]); }
#pragma unroll
            for (int c = 0; c < 4; ++c) { const int idx = lane + 64 * c, h = idx >> 5, f = idx & 31;
                const float cb = COSB[p * 32 + f], sb = SINB[p * 32 + f];
                const float x1 = Q[(size_t)row * 1536 + h * DQH + DNOPE + f], x2 = Q[(size_t)row * 1536 + h * DQH + DNOPE + 32 + f];
                const float o1 = x1 * cb - x2 * sb, o2 = x1 * sb + x2 * cb;
                QPE[(size_t)row * 512 + h * 64 + f] = o1; QPE[(size_t)row * 512 + h * 64 + 32 + f] = o2;
                Qb[(size_t)row * 1536 + h * DQH + DNOPE + f] = f2bf(o1); Qb[(size_t)row * 1536 + h * DQH + DNOPE + 32 + f] = f2bf(o2); }
        }
    }
    SEAM(4);
    if (IN(5)) {
        for (int it = bid; it < DB * MS_NSPLIT; it += G) { const int split = __builtin_amdgcn_readfirstlane(it % MS_NSPLIT), b = __builtin_amdgcn_readfirstlane(it / MS_NSPLIT);
            mla_sample_unit(ldsb, cache_ckv, cache_kpe, page_table, QLATb, Qb, PO, PML, b, split, 0.07216878364870322f * 1.4426950408889634f); }
        for (int it = bid; it < NB * MH * 4; it += G) {
            const int pr = __builtin_amdgcn_readfirstlane(it & 3), hh = __builtin_amdgcn_readfirstlane((it >> 2) & 7), b = __builtin_amdgcn_readfirstlane(it >> 5);
            SrcMlaP src{KN, KPERb, VT, b, hh};
#pragma unroll 1
            for (int half = 0; half < 2; ++half) { const int qb = __builtin_amdgcn_readfirstlane(half ? pr : 7 - pr); const size_t row0 = (size_t)b * SEQ + qb * 256;
                flash_unit<192, 128, true>(ldsb, src, Qb + row0 * 1536 + hh * DQH, 1536, qb * 256, 4 * (qb + 1), OMLAb + row0 * 1024 + hh * DVH, 1024, 0.07216878364870322f * 1.4426950408889634f); }
        }
        for (int it = bid; it < NB * RH * 16; it += G) { const int c = __builtin_amdgcn_readfirstlane(it & 15), h = __builtin_amdgcn_readfirstlane((it >> 4) & 3), b = __builtin_amdgcn_readfirstlane(it >> 6);
            ret_chunk_out(RQt, RKt, RVT, SPT, ORET, b, h, c); }
        for (int it = bid; it < DB * RH; it += G) {
            const int h = it & 3, b = it >> 2; const float lg = lg_gamma(h);
            const float* s0 = state_ret + (size_t)it * RDK * RDV;
            LAS float* inner = lds;
            LAS float* qk = lds + 16;
            __syncthreads();
            for (int i = tid; i < 1024; i += NTHREADS) { const int which = i >> 9, ti = (i >> 7) & 3, d = i & 127; const size_t row = (size_t)NP + b * DS + ti;
                qk[i] = which ? RK[row * 512 + h * RDK + d] : RQ[row * 512 + h * RDK + d]; }
            __syncthreads();
            for (int pr = wave; pr < 16; pr += NWAVES) { const int i = pr >> 2, j = pr & 3;
                float s = qk[i * 128 + lane] * qk[512 + j * 128 + lane] + qk[i * 128 + 64 + lane] * qk[512 + j * 128 + 64 + lane];
                s = wave_sum(s);
                if (lane == 0) inner[pr] = (j <= i) ? s * expf((float)(i - j) * lg) : 0.f; }
            __syncthreads();
            {
                const int e = tid & 255, i0 = (tid >> 8) * 2;
                float o0 = 0.f, o1 = 0.f;
                for (int d = 0; d < RDK; ++d) { const float sv = s0[(size_t)d * RDV + e]; o0 += qk[i0 * 128 + d] * sv; o1 += qk[(i0 + 1) * 128 + d] * sv; }
                o0 *= expf((float)(i0 + 1) * lg); o1 *= expf((float)(i0 + 2) * lg);
#pragma unroll
                for (int j = 0; j < DS; ++j) { const float v = Z[((size_t)NP + b * DS + j) * ZLD + C_RV + h * RDV + e]; o0 += inner[i0 * 4 + j] * v; o1 += inner[(i0 + 1) * 4 + j] * v; }
                ORET[((size_t)NP + b * DS + i0) * 1024 + h * RDV + e] = o0; ORET[((size_t)NP + b * DS + i0 + 1) * 1024 + h * RDV + e] = o1;
            }
            {
                const float g4 = expf(4.f * lg);
                float* so = out + O_RETS + (size_t)it * RDK * RDV;
                for (int i = tid; i < RDK * RDV; i += NTHREADS) { const int d = i >> 8, e = i & 255; float a = s0[i] * g4;
#pragma unroll
                    for (int j = 0; j < DS; ++j) a += expf((float)(3 - j) * lg) * qk[512 + j * 128 + d] * Z[((size_t)NP + b * DS + j) * ZLD + C_RV + h * RDV + e];
                    so[i] = a; }
            }
        }
        for (int it = bid; it < NB * XH * 8; it += G) {
            const int qb = __builtin_amdgcn_readfirstlane(it & 7), hh = __builtin_amdgcn_readfirstlane((it >> 3) & 3), b = __builtin_amdgcn_readfirstlane(it >> 5); const size_t row0 = (size_t)b * SEQ + qb * 256;
            SrcMemP src{MKb, MVT, b, hh};
            flash_unit<64, 64, false>(ldsb, src, XQb + row0 * 256 + hh * XHD, 256, 0, 4, OXb + row0 * 256 + hh * XHD, 256, 0.125f * 1.4426950408889634f);
        }
        for (int it = bid; it < DB * XH; it += G) {
            const int h = it & 3, b = it >> 2; const size_t row = (size_t)NP + b * DS + (wave & 3);
            KvMem kv{cache_mem_k, cache_mem_v, b, h};
            attn_naive<64, 64, false, 0>(lds, kv, NMEM, QPtr{Z + row * ZLD + C_XQ + h * XHD}, wave < 4, NMEM, 0.125f, 0.f, 0, OX + row * 256 + h * XHD);
        }
    }
    SEAM(5);
    if (IN(6)) {
        for (int b = bid; b < DB; b += G) {
            const int head = wave; const float c2 = 0.07216878364870322f * 1.4426950408889634f;
            LAS float* ol = lds + wave * KVL;
            for (int t = 0; t < DS; ++t) {
                const int qi = t * 8 + head; const size_t qrow = (size_t)b * DS + t;
                float qv[5];
#pragma unroll
                for (int c = 0; c < 5; ++c) { const int d = lane + 64 * c; const bf16_t raw = d < KVL ? QLATb[qrow * 2048 + head * KVL + d] : Qb[(NP + qrow) * 1536 + head * DQH + DNOPE + (d - KVL)];
                    qv[c] = __builtin_bit_cast(float, (unsigned)raw << 16); }
                float sc[DS]; float M = -INFINITY;
#pragma unroll
                for (int j = 0; j < DS; ++j) { const size_t krow = (size_t)NP + b * DS + j; float a = 0.f;
#pragma unroll
                    for (int c = 0; c < 5; ++c) { const int d = lane + 64 * c; a += qv[c] * (d < KVL ? CKVN[krow * KVL + d] : KPER[krow * DROPE + (d - KVL)]); }
                    a = wave_sum(a) * c2; sc[j] = (j <= t) ? a : -INFINITY; M = fmaxf(M, sc[j]); }
                float ms[MS_NSPLIT], ls[MS_NSPLIT];
#pragma unroll
                for (int sp = 0; sp < MS_NSPLIT; ++sp) { const int item = b * MS_NSPLIT + sp; ms[sp] = PML[(item * 32 + qi) * 2]; ls[sp] = PML[(item * 32 + qi) * 2 + 1]; M = fmaxf(M, ms[sp]); }
                float L = 0.f; float acc[4] = {0.f, 0.f, 0.f, 0.f};
#pragma unroll
                for (int sp = 0; sp < MS_NSPLIT; ++sp) { const int item = b * MS_NSPLIT + sp; const float wgt = __builtin_amdgcn_exp2f(ms[sp] - M); L += ls[sp] * wgt;
#pragma unroll
                    for (int c = 0; c < 4; ++c) acc[c] += wgt * PO[((size_t)item * 32 + qi) * KVL + lane + 64 * c]; }
#pragma unroll
                for (int j = 0; j < DS; ++j) { const float wgt = __builtin_amdgcn_exp2f(sc[j] - M); L += wgt; const size_t krow = (size_t)NP + b * DS + j;
#pragma unroll
                    for (int c = 0; c < 4; ++c) acc[c] += wgt * CKVN[krow * KVL + lane + 64 * c]; }
                const float inv = 1.f / L;
#pragma unroll
                for (int c = 0; c < 4; ++c) ol[lane + 64 * c] = acc[c] * inv;
                __syncthreads();
                float a0 = 0.f, a1 = 0.f; const float* wv = w_uv + (size_t)head * KVL * DVH;
#pragma unroll 8
                for (int l = 0; l < KVL; ++l) { const float x = ol[l]; a0 += x * wv[(size_t)l * DVH + lane]; a1 += x * wv[(size_t)l * DVH + 64 + lane]; }
                OMLAb[((size_t)NP + qrow) * 1024 + head * DVH + lane] = f2bf(a0); OMLAb[((size_t)NP + qrow) * 1024 + head * DVH + 64 + lane] = f2bf(a1);
                __syncthreads();
            }
        }
        for (size_t i = (size_t)bid * NTHREADS + tid; i < (size_t)NS * 256; i += (size_t)G * NTHREADS) OXb[(size_t)NP * 256 + i] = f2bf(OX[(size_t)NP * 256 + i]);
        for (int row = gw; row < NT; row += NGW) {
#pragma unroll
            for (int h = 0; h < RH; ++h) {
                float v[4]; float s = 0.f;
#pragma unroll
                for (int c = 0; c < 4; ++c) { v[c] = ORET[(size_t)row * 1024 + h * RDV + lane + 64 * c]; s += v[c] * v[c]; }
                const float r = rsqrtf(wave_sum(s) * (1.f / RDV) + EPS);
#pragma unroll
                for (int c = 0; c < 4; ++c) ORETNb[(size_t)row * 1024 + h * RDV + lane + 64 * c] = f2bf(siluf_(Z[(size_t)row * ZLD + C_RG + h * RDV + lane + 64 * c]) * v[c] * r);
            }
        }
    }
    SEAM(6);
    if (IN(7)) {
        pg8::StaticOrder S; S.init(NT, 1024, G, bid);
        { pg8::Gemm g{ORETNb, WroT, NT, 1024, 1024, 1024, 1024}; pg8::EpiF32S E{ARET, 1024, 0, 0}; GEMM_PHASE(pg8::EpiF32S, ldsb, g, S, E); }
        __syncthreads();
        { pg8::Gemm g{OMLAb, WmoT, NT, 1024, 1024, 1024, 1024}; pg8::EpiF32S E{AMLA, 1024, 0, 0}; GEMM_PHASE(pg8::EpiF32S, ldsb, g, S, E); }
        __syncthreads();
        { pg8::Gemm g{OXb, WxoT, NT, 1024, 256, 256, 256}; pg8::EpiF32S E{AX, 1024, 0, 0}; GEMM_PHASE(pg8::EpiF32S, ldsb, g, S, E); }
    }
    SEAM(7);
    if (IN(8)) {
        for (size_t i = (size_t)bid * NTHREADS + tid; i < (size_t)NT * DM; i += (size_t)G * NTHREADS) {
            const size_t row = i >> 10; const int c = (int)(i & 1023); const float* z = Z + row * ZLD + C_G;
            MIXb[i] = f2bf(sigmoidf_(z[c]) * ARET[i] + sigmoidf_(z[1024 + c]) * AMLA[i] + sigmoidf_(z[2048 + c]) * AX[i]);
        }
    }
    SEAM(8);
    if (IN(9)) { pg8::Gemm g{MIXb, WoT, NT, 1024, 1024, 1024, 1024}; pg8::StaticOrder S; S.init(NT, 1024, G, bid); pg8::EpiF32S E{HP, 1024, 0, 0};
        GEMM_PHASE(pg8::EpiF32S, ldsb, g, S, E); }
    SEAM(9);
    if (IN(10)) {
        for (int row = gw; row < NT; row += NGW) {
            const float* xr = row < NP ? x_prompt + (size_t)row * DM : x_sample + (size_t)(row - NP) * DM;
            float v[16]; float s = 0.f;
#pragma unroll
            for (int c = 0; c < 16; ++c) { v[c] = HP[(size_t)row * DM + lane + 64 * c]; s += v[c] * v[c]; }
            float r = rsqrtf(wave_sum(s) * (1.f / DM) + EPS); s = 0.f;
#pragma unroll
            for (int c = 0; c < 16; ++c) { v[c] = xr[lane + 64 * c] + v[c] * r * g_mix_post[lane + 64 * c]; H[(size_t)row * DM + lane + 64 * c] = v[c]; s += v[c] * v[c]; }
            r = rsqrtf(wave_sum(s) * (1.f / DM) + EPS);
#pragma unroll
            for (int c = 0; c < 16; ++c) Fb[(size_t)row * DM + lane + 64 * c] = f2bf(v[c] * r * g_ffn_pre[lane + 64 * c]);
        }
    }
    SEAM(10);
    if (IN(11)) {
        pg8::Gemm g{Fb, WguT, NT, 2 * DFF, 1024, 1024, 1024}; pg8::StaticOrder S; S.init(NT, 2 * DFF, G, bid); pg8::EpiF32S E{GU, 2 * DFF, 0, 0};
        GEMM_PHASE(pg8::EpiF32S, ldsb, g, S, E);
    }
    SEAM(11);
    if (IN(12)) {
        for (size_t i = (size_t)bid * NTHREADS + tid; i < (size_t)NT * DFF; i += (size_t)G * NTHREADS) { const size_t row = i / DFF; const int c = (int)(i - row * DFF); ACTb[i] = f2bf(siluf_(GU[row * (2 * DFF) + c]) * GU[row * (2 * DFF) + DFF + c]); }
    }
    SEAM(12);
    if (IN(13)) { pg8::Gemm g{ACTb, WdT, NT, 1024, DFF, DFF, DFF}; pg8::StaticOrder S; S.init(NT, 1024, G, bid); pg8::EpiF32S E{FO, 1024, 0, 0};
        GEMM_PHASE(pg8::EpiF32S, ldsb, g, S, E); }
    SEAM(13);
    if (IN(14)) {
        for (int row = gw; row < NT; row += NGW) {
            float v[16]; float s = 0.f;
#pragma unroll
            for (int c = 0; c < 16; ++c) { v[c] = FO[(size_t)row * DM + lane + 64 * c]; s += v[c] * v[c]; }
            const float r = rsqrtf(wave_sum(s) * (1.f / DM) + EPS);
            float* y = row < NP ? out + O_YP + (size_t)row * DM : out + O_YS + (size_t)(row - NP) * DM;
#pragma unroll
            for (int c = 0; c < 16; ++c) y[lane + 64 * c] = H[(size_t)row * DM + lane + 64 * c] + v[c] * r * g_ffn_post[lane + 64 * c];
        }
    }
#undef IN
#undef SEAM
}
constexpr int N_PHASES = 15;
}

extern "C" void kernel_launch(void* const* d_in, const int* in_sizes, int n_in, void* d_out, int out_size, void* d_ws, size_t ws_size, hipStream_t stream) {
    static int grid = 0;
    if (grid == 0) {
        if (n_in != 29 || (size_t)out_size != O_END || ws_size < WS_END) { fprintf(stderr, "kernel_launch: unexpected shapes: n_in %d out %d ws %zu (need %zu)\n", n_in, out_size, ws_size, (size_t)WS_END); grid = -1; return; }
        int dev = 0, cus = 0, per_cu = 0;
        if (hipGetDevice(&dev) != hipSuccess || hipDeviceGetAttribute(&cus, hipDeviceAttributeMultiprocessorCount, dev) != hipSuccess) { grid = -1; return; }
        if (hipFuncSetAttribute((const void*)fwd_kernel, hipFuncAttributeMaxDynamicSharedMemorySize, LDS_BYTES) != hipSuccess) { fprintf(stderr, "kernel_launch: hipFuncSetAttribute failed\n"); grid = -1; return; }
        if (hipOccupancyMaxActiveBlocksPerMultiprocessor(&per_cu, (const void*)fwd_kernel, NTHREADS, LDS_BYTES) != hipSuccess || per_cu < 1) { fprintf(stderr, "kernel_launch: occupancy query says %d\n", per_cu); per_cu = 1; }
        (void)hipGetLastError();
        grid = cus;
    }
    if (grid < 0) return;
    (void)hipMemsetAsync((char*)d_ws + WS_CTL, 0, CTL_BYTES, stream);
    Args a{};
    for (int i = 0; i < 29; ++i) a.in[i] = (const float*)d_in[i];
    a.out = (float*)d_out; a.ws = (unsigned char*)d_ws;
#if MK_ONE_LAUNCH
    a.ph_lo = 0; a.ph_hi = N_PHASES;
    hipLaunchKernelGGL(fwd_kernel, dim3(grid), dim3(NTHREADS), LDS_BYTES, stream, a);
#else
    for (int p = 0; p < N_PHASES; ++p) { a.ph_lo = p; a.ph_hi = p + 1; hipLaunchKernelGGL(fwd_kernel, dim3(grid), dim3(NTHREADS), LDS_BYTES, stream, a); }
#endif
}
```

```cpp
#include <hip/hip_runtime.h>
#include <cstdio>
#include <cstdint>

#ifndef PROBE_DUP
#define PROBE_DUP -1
#endif
#ifndef PROBE_SUB
#define PROBE_SUB 0xff
#endif
#ifndef MK_ONE_LAUNCH
#define MK_ONE_LAUNCH 1
#endif

#define LAS __attribute__((address_space(3)))
#define GAS __attribute__((address_space(1)))
#define DI __device__ __forceinline__
typedef float f32x4 __attribute__((ext_vector_type(4)));

namespace {
constexpr int DM = 1024, NB = 8, SEQ = 2048, NP = NB * SEQ, DB = 128, DS = 4, NS = DB * DS, NT = NP + NS;
constexpr int PAST = 8192, PAGE = 128, NPAGES = PAST / PAGE;
constexpr int RH = 4, RDK = 128, RDV = 256;
constexpr int MH = 8, QL = 384, KVL = 256, DNOPE = 128, DROPE = 64, DVH = 128, DQH = DNOPE + DROPE;
constexpr int NMEM = 256, XH = 4, XHD = 64;
constexpr int DFF = 2816, DIN = 7104, ZLD = 7168;
constexpr int C_RQ = 0, C_RK = 512, C_RV = 1024, C_RG = 2048, C_CQ = 3072, C_CKV = 3456, C_KPE = 3712, C_XQ = 3776, C_G = 4032;
constexpr float EPS = 1e-6f;
constexpr int NPOS = SEQ + DS;
constexpr int NTHREADS = 512, NWAVES = 8;
constexpr int LDS_BYTES = 147456;
constexpr int MISC_OFF = 147456 - 256;

constexpr size_t O_YP = 0, O_YS = O_YP + (size_t)NP * DM, O_CKVP = O_YS + (size_t)NS * DM, O_KPEP = O_CKVP + (size_t)NP * KVL,
                 O_CKVS = O_KPEP + (size_t)NP * DROPE, O_KPES = O_CKVS + (size_t)NS * KVL, O_RETP = O_KPES + (size_t)NS * DROPE,
                 O_RETS = O_RETP + (size_t)NB * RH * RDK * RDV, O_MKP = O_RETS + (size_t)DB * RH * RDK * RDV, O_MVP = O_MKP + (size_t)NB * NMEM * 256,
                 O_END = O_MVP + (size_t)NB * NMEM * 256;

constexpr size_t al256(size_t x) { return (x + 255) & ~(size_t)255; }
constexpr size_t WS_CTL = 0, CTL_BYTES = 1u << 20;
constexpr size_t WS_COSA = WS_CTL + CTL_BYTES;
constexpr size_t WS_SINA = WS_COSA + al256((size_t)NPOS * 64 * 4);
constexpr size_t WS_COSB = WS_SINA + al256((size_t)NPOS * 64 * 4);
constexpr size_t WS_SINB = WS_COSB + al256((size_t)NPOS * 32 * 4);
constexpr size_t WS_U = WS_SINB + al256((size_t)NPOS * 32 * 4);
constexpr size_t WS_MN = WS_U + (size_t)NT * DM * 4;
constexpr size_t WS_Z = WS_MN + (size_t)NB * NMEM * DM * 4;
constexpr size_t WS_RQ = WS_Z + (size_t)NT * ZLD * 4;
constexpr size_t WS_RK = WS_RQ + (size_t)NT * 512 * 4;
constexpr size_t WS_CQN = WS_RK + (size_t)NT * 512 * 4;
constexpr size_t WS_CKVN = WS_CQN + (size_t)NT * QL * 4;
constexpr size_t WS_KPER = WS_CKVN + (size_t)NT * KVL * 4;
constexpr size_t WS_Q = WS_KPER + (size_t)NT * DROPE * 4;
constexpr size_t WS_QLAT = WS_Q + (size_t)NT * 1536 * 4;
constexpr size_t WS_QPE = WS_QLAT + (size_t)NT * 2048 * 4;
constexpr size_t WS_ORET = WS_QPE + (size_t)NT * 512 * 4;
constexpr size_t WS_OLAT = WS_ORET + (size_t)NT * 1024 * 4;
constexpr size_t WS_OX = WS_OLAT + (size_t)NT * 2048 * 4;
constexpr size_t WS_OMLA = WS_OX + (size_t)NT * 256 * 4;
constexpr size_t WS_ORETN = WS_OMLA + (size_t)NT * 1024 * 4;
constexpr size_t WS_ARET = WS_ORETN + (size_t)NT * 1024 * 4;
constexpr size_t WS_AMLA = WS_ARET + (size_t)NT * 1024 * 4;
constexpr size_t WS_AX = WS_AMLA + (size_t)NT * 1024 * 4;
constexpr size_t WS_MIX = WS_AX + (size_t)NT * 1024 * 4;
constexpr size_t WS_HP = WS_MIX + (size_t)NT * 1024 * 4;
constexpr size_t WS_H = WS_HP + (size_t)NT * 1024 * 4;
constexpr size_t WS_F = WS_H + (size_t)NT * 1024 * 4;
constexpr size_t WS_GG = WS_F + (size_t)NT * 1024 * 4;
constexpr size_t WS_UP = WS_GG + (size_t)NT * DFF * 4;
constexpr size_t WS_ACT = WS_UP + (size_t)NT * DFF * 4;
constexpr size_t WS_FO = WS_ACT + (size_t)NT * DFF * 4;
constexpr size_t WS_F32_END = WS_FO + (size_t)NT * 1024 * 4;
constexpr size_t WS_WIN_T = al256(WS_F32_END);
constexpr size_t WS_WMKV_T = WS_WIN_T + (size_t)ZLD * 1024 * 2;
constexpr size_t WS_WUQ_T = WS_WMKV_T + (size_t)512 * 1024 * 2;
constexpr size_t WS_WRO_T = WS_WUQ_T + (size_t)1536 * 384 * 2;
constexpr size_t WS_WMO_T = WS_WRO_T + (size_t)1024 * 1024 * 2;
constexpr size_t WS_WXO_T = WS_WMO_T + (size_t)1024 * 1024 * 2;
constexpr size_t WS_WO_T = WS_WXO_T + (size_t)1024 * 256 * 2;
constexpr size_t WS_WGU_T = WS_WO_T + (size_t)1024 * 1024 * 2;
constexpr size_t WS_WD_T = WS_WGU_T + (size_t)5632 * 1024 * 2;
constexpr size_t WS_UB = WS_WD_T + (size_t)1024 * 2816 * 2;
constexpr size_t WS_MNB = WS_UB + (size_t)NT * 1024 * 2;
constexpr size_t WS_CQNB = WS_MNB + (size_t)2048 * 1024 * 2;
constexpr size_t WS_ORETNB = WS_CQNB + (size_t)NT * 384 * 2;
constexpr size_t WS_OMLAB = WS_ORETNB + (size_t)NT * 1024 * 2;
constexpr size_t WS_OXB = WS_OMLAB + (size_t)NT * 1024 * 2;
constexpr size_t WS_MIXB = WS_OXB + (size_t)NT * 256 * 2;
constexpr size_t WS_FB = WS_MIXB + (size_t)NT * 1024 * 2;
constexpr size_t WS_ACTB = WS_FB + (size_t)NT * 1024 * 2;
constexpr size_t WS_WUK_T = WS_ACTB + (size_t)NT * 2816 * 2;
constexpr size_t WS_WUV_T = WS_WUK_T + (size_t)1024 * 256 * 2;
constexpr size_t WS_CKVNB = WS_WUV_T + (size_t)1024 * 256 * 2;
constexpr size_t WS_KPERB = WS_CKVNB + (size_t)NT * 256 * 2;
constexpr size_t WS_XQB = WS_KPERB + (size_t)NT * 64 * 2;
constexpr size_t WS_MKB = WS_XQB + (size_t)NT * 256 * 2;
constexpr size_t WS_MVT = WS_MKB + (size_t)2048 * 256 * 2;
constexpr size_t WS_KN = WS_MVT + (size_t)2048 * 256 * 2;
constexpr size_t WS_VT = WS_KN + (size_t)NP * 1024 * 2;
constexpr size_t WS_QB = WS_VT + (size_t)NP * 1024 * 2;
constexpr size_t WS_RQT = WS_QB + (size_t)NT * 1536 * 2;
constexpr size_t WS_RKT = WS_RQT + (size_t)NP * 512 * 2;
constexpr size_t WS_RKTT = WS_RKT + (size_t)NP * 512 * 2;
constexpr size_t WS_RVT = WS_RKTT + (size_t)NP * 512 * 2;
constexpr size_t WS_UT = WS_RVT + (size_t)NT * 1024 * 2;
constexpr size_t WS_SPT = WS_UT + (size_t)512 * 32768 * 4;
constexpr size_t WS_QLATB = WS_SPT + (size_t)512 * 32768 * 2;
constexpr size_t WS_PO = WS_QLATB + (size_t)NS * 2048 * 2;
constexpr size_t WS_PML = WS_PO + (size_t)DB * 2 * 32 * 256 * 4;
constexpr size_t WS_END = WS_PML + (size_t)DB * 2 * 32 * 2 * 4;

constexpr int CW_BAR = 4096;

#define XB_TMO      128
#define XB_XCNT(j)  (256  + 64 * (j))
#define XB_XSUB(j)  (1280 + 64 * (j))
#define XB_XGEN(j)  (2304 + 64 * (j))
#define XB_TOP      3328
#define XB_TOPGEN   3392
#define XCD_BAR_WORDS 3456
#define XB_SPIN_CAP (1u << 25)

DI unsigned xb_ld(unsigned* p)              { return __hip_atomic_load(p, __ATOMIC_RELAXED, __HIP_MEMORY_SCOPE_AGENT); }
DI unsigned xb_add(unsigned* p, unsigned v) { return __hip_atomic_fetch_add(p, v, __ATOMIC_RELAXED, __HIP_MEMORY_SCOPE_AGENT); }
DI unsigned xb_xcc_id() { return (unsigned)__builtin_amdgcn_s_getreg((3 << 11) | 20) & 0xFu; }
#define XB_SPIN(cond, bar) do { unsigned _sp = 0; while (cond) { __builtin_amdgcn_s_sleep(1); \
    if ((++_sp & 255u) == 0u) { if (xb_ld(&(bar)[XB_TMO])) break; if (_sp > XB_SPIN_CAP) { atomicAdd(&(bar)[XB_TMO], 1u); break; } } } } while (0)

struct XcdBarrier { unsigned* bar; unsigned x; volatile LAS unsigned* st; };

DI XcdBarrier xcd_barrier_post(unsigned* bar, volatile LAS unsigned* st) {
    XcdBarrier b; b.bar = bar; b.x = xb_xcc_id(); b.st = st;
    if (threadIdx.x == 0) (void)xb_add(&bar[XB_XCNT(b.x)], 1u);
    return b;
}
DI void xcd_barrier_complete(unsigned* bar, unsigned x, unsigned& nloc, unsigned& nx) {
    const unsigned G = gridDim.x * gridDim.y * gridDim.z;
    unsigned sum, cnt, mine, sp = 0u;
    for (;;) {
        sum = 0u; cnt = 0u; mine = 0u;
#pragma unroll
        for (unsigned j = 0; j < 16; ++j) { const unsigned c = xb_ld(&bar[XB_XCNT(j)]); sum += c; cnt += (c > 0u) ? 1u : 0u; mine = (j == x) ? c : mine; }
        if (sum == G) break;
        __builtin_amdgcn_s_sleep(1);
        if ((++sp & 255u) == 0u) { if (xb_ld(&bar[XB_TMO])) break; if (sp > XB_SPIN_CAP) { atomicAdd(&bar[XB_TMO], 1u); break; } }
    }
    nloc = mine > 0u ? mine : 1u; nx = cnt > 0u ? cnt : 1u;
}
DI void xcd_barrier(const XcdBarrier& b) {
    asm volatile("s_waitcnt vmcnt(0)" ::: "memory");
    __syncthreads();
    if (threadIdx.x == 0) {
        unsigned* bar = b.bar;
        __builtin_amdgcn_s_waitcnt(0);
        unsigned nloc = b.st[0], nx = b.st[1];
        if (nloc == 0u) { xcd_barrier_complete(bar, b.x, nloc, nx); b.st[0] = nloc; b.st[1] = nx; }
        const unsigned old = xb_add(&bar[XB_XSUB(b.x)], 1u);
        const unsigned gen = old / nloc;
        if (old + 1u == (gen + 1u) * nloc) {
            __builtin_amdgcn_fence(__ATOMIC_RELEASE, "agent");
            asm volatile("s_waitcnt vmcnt(0)" ::: "memory");
            const unsigned og = xb_add(&bar[XB_TOP], 1u);
            const unsigned tg = og / nx;
            if (og + 1u == (tg + 1u) * nx) xb_add(&bar[XB_TOPGEN], 1u);
            else XB_SPIN(xb_ld(&bar[XB_TOPGEN]) == tg, bar);
            __builtin_amdgcn_fence(__ATOMIC_ACQUIRE, "agent");
            xb_add(&bar[XB_XGEN(b.x)], 1u);
            asm volatile("s_waitcnt vmcnt(0)" ::: "memory");
        } else {
            XB_SPIN(xb_ld(&bar[XB_XGEN(b.x)]) == gen, bar);
            __builtin_amdgcn_fence(__ATOMIC_ACQUIRE, "agent");
            asm volatile("s_waitcnt vmcnt(0)" ::: "memory");
        }
    }
    __syncthreads();
}

DI float wave_sum(float v) {
#pragma unroll
    for (int o = 1; o < 64; o <<= 1) v += __shfl_xor(v, o);
    return v;
}
DI float wave_max(float v) {
#pragma unroll
    for (int o = 1; o < 64; o <<= 1) v = fmaxf(v, __shfl_xor(v, o));
    return v;
}
DI float sigmoidf_(float x) { return 1.f / (1.f + expf(-x)); }
DI float siluf_(float x) { return x / (1.f + expf(-x)); }
DI int pos_index(int row) { return row < NP ? (row & (SEQ - 1)) : SEQ + ((row - NP) & (DS - 1)); }
DI float lg_gamma(int h) { return log1pf(-exp2f(-5.0f - (float)h)); }


namespace pg8 {
typedef unsigned short bf16_t;
typedef short bf16x8 __attribute__((ext_vector_type(8)));
typedef unsigned u32x4 __attribute__((ext_vector_type(4)));
typedef unsigned u32x2 __attribute__((ext_vector_type(2)));
constexpr int BM = 256, BK = 64, HALF = 128, HTB = HALF * BK * 2, STAGE_BYTES = 8 * HTB, NXCD = 8, WGM = 8;
__host__ __device__ __forceinline__ int lds_byte(int r, int c) { const int st = (r >> 4) * 2 + (c >> 5), rr = r & 15, cc = c & 31, ob = rr * 64 + cc * 2; return st * 1024 + (ob ^ (((ob >> 9) & 1) << 5)); }
__host__ __device__ __forceinline__ void stage_rc(int b, int& R, int& C) { const int st = b / 1024, sb = b % 1024, swz = sb ^ (((sb >> 9) & 1) << 5); R = (st >> 1) * 16 + swz / 64; C = (st & 1) * 32 + (swz % 64) / 2; }
__host__ __device__ __forceinline__ int perm32(int rho) { const int n = rho >> 4, i = rho & 15; return 8 * (i >> 2) + 4 * n + (i & 3); }
struct Unit { int pm, pn; };
struct Gemm { const bf16_t* A; const bf16_t* Bt; int M, N, K, lda, ldb; };
struct StaticOrder {
    int nM, nN, nwg, G, c;
    __host__ __device__ void init(int M, int N, int G_, int c_) { nM = M / BM; nN = N / BM; nwg = nM * nN; G = G_; c = c_; }
    __host__ __device__ bool next(int i, Unit& u) const {
        const long L = (long)i * G + c; if (L >= nwg) return false;
        int wgid = (int)L; { const int q = nwg / NXCD, r = nwg % NXCD, xcd = wgid % NXCD, off = wgid / NXCD; wgid = (xcd < r ? xcd * (q + 1) : r * (q + 1) + (xcd - r) * q) + off; }
        const int nig = WGM * nN, gid = wgid / nig, fm = gid * WGM, gsz = (nM - fm) < WGM ? (nM - fm) : WGM;
        u.pm = fm + ((wgid % nig) % gsz); u.pn = (wgid % nig) / gsz; return true;
    }
    __device__ __forceinline__ void a_ready(const Unit&) const {}
    __device__ __forceinline__ void done(const Unit&) const {}
};
__device__ __forceinline__ unsigned cvt_pk_bf16(float lo, float hi) { unsigned r; asm volatile("v_cvt_pk_bf16_f32 %0, %1, %2" : "=v"(r) : "v"(lo), "v"(hi)); return r; }
struct EpiF32S {
    static constexpr bool PERM = false, AFTER_DRAIN = false;
    float* C; int ldc; int split_tiles; size_t split_stride;
    __device__ __forceinline__ void operator()(const f32x4 (&acc)[2][2][4][2], const Unit& u, int wr, int wc, int fr, int fq) const {
        int pn = u.pn; float* base = C; if (split_tiles) { const int t = pn / split_tiles; base += (size_t)t * split_stride; pn -= t * split_tiles; }
        const int row0 = u.pm * BM + wr * 64 + fr, col0 = pn * BM + wc * 32 + 4 * fq;
#pragma unroll
        for (int ai = 0; ai < 2; ++ai)
#pragma unroll
            for (int m = 0; m < 4; ++m) { float* rowp = base + (size_t)(row0 + ai * HALF + m * 16) * ldc + col0;
#pragma unroll
                for (int bj = 0; bj < 2; ++bj)
#pragma unroll
                    for (int n = 0; n < 2; ++n) *(f32x4*)(rowp + bj * HALF + n * 16) = acc[ai][bj][m][n]; }
    }
};
struct EpiBf16S {
    static constexpr bool PERM = true, AFTER_DRAIN = false;
    bf16_t* O; int ldc;
    __device__ __forceinline__ void operator()(const f32x4 (&acc)[2][2][4][2], const Unit& u, int wr, int wc, int fr, int fq) const {
        const int row0 = u.pm * BM + wr * 64 + fr, col0 = u.pn * BM + wc * 32 + 8 * fq;
#pragma unroll
        for (int ai = 0; ai < 2; ++ai)
#pragma unroll
            for (int m = 0; m < 4; ++m) { bf16_t* rowp = O + (size_t)(row0 + ai * HALF + m * 16) * ldc + col0;
#pragma unroll
                for (int bj = 0; bj < 2; ++bj) { const f32x4 v0 = acc[ai][bj][m][0], v1 = acc[ai][bj][m][1];
                    u32x4 w; w.x = cvt_pk_bf16(v0[0], v0[1]); w.y = cvt_pk_bf16(v0[2], v0[3]); w.z = cvt_pk_bf16(v1[0], v1[1]); w.w = cvt_pk_bf16(v1[2], v1[3]);
                    *(u32x4*)(rowp + bj * HALF) = w; } }
    }
};
struct EpiSwiGLU {
    static constexpr bool PERM = true, AFTER_DRAIN = false;
    bf16_t* O; int ldc;
    __device__ __forceinline__ void operator()(const f32x4 (&acc)[2][2][4][2], const Unit& u, int wr, int wc, int fr, int fq) const {
        const int row0 = u.pm * BM + wr * 64 + fr, col0 = u.pn * (BM / 2) + wc * 16 + 4 * fq;
#pragma unroll
        for (int ai = 0; ai < 2; ++ai)
#pragma unroll
            for (int m = 0; m < 4; ++m) { bf16_t* rowp = O + (size_t)(row0 + ai * HALF + m * 16) * ldc + col0;
#pragma unroll
                for (int bj = 0; bj < 2; ++bj) { const f32x4 v0 = acc[ai][bj][m][0], v1 = acc[ai][bj][m][1];
                    const float a0 = v0[0] / (1.f + __expf(-v0[0])) * v0[1], a1 = v0[2] / (1.f + __expf(-v0[2])) * v0[3];
                    const float a2 = v1[0] / (1.f + __expf(-v1[0])) * v1[1], a3 = v1[2] / (1.f + __expf(-v1[2])) * v1[3];
                    u32x2 w; w.x = cvt_pk_bf16(a0, a1); w.y = cvt_pk_bf16(a2, a3);
                    *(u32x2*)(rowp + bj * (HALF / 2)) = w; } }
    }
};
template <int MODE  > struct EpiGate {
    static constexpr bool PERM = false, AFTER_DRAIN = false;
    const float* gate; int ldg; float* mix; bf16_t* mixb; int ldc;
    __device__ __forceinline__ void operator()(const f32x4 (&acc)[2][2][4][2], const Unit& u, int wr, int wc, int fr, int fq) const {
        const int row0 = u.pm * BM + wr * 64 + fr, col0 = u.pn * BM + wc * 32 + 4 * fq;
#pragma unroll
        for (int ai = 0; ai < 2; ++ai)
#pragma unroll
            for (int m = 0; m < 4; ++m) { const size_t r = (size_t)(row0 + ai * HALF + m * 16);
#pragma unroll
                for (int bj = 0; bj < 2; ++bj)
#pragma unroll
                    for (int n = 0; n < 2; ++n) { const int c = col0 + bj * HALF + n * 16;
                        const f32x4 gz = *(const f32x4*)(gate + r * ldg + c); f32x4 v = acc[ai][bj][m][n];
#pragma unroll
                        for (int e = 0; e < 4; ++e) v[e] = v[e] / (1.f + __expf(-gz[e]));
                        if (MODE >= 1) v += *(const f32x4*)(mix + r * ldc + c);
                        if (MODE <= 1) *(f32x4*)(mix + r * ldc + c) = v;
                        else { u32x2 w; w.x = cvt_pk_bf16(v[0], v[1]); w.y = cvt_pk_bf16(v[2], v[3]); *(u32x2*)(mixb + r * ldc + c) = w; } } }
    }
};
template <class Epi, class Sched, bool ALIGN_EPI = false, bool SP2 = false>
__device__ __forceinline__ void gemm_phase(LAS unsigned char* lds, const Gemm g, const Sched& S, const Epi& E) {
    const int tid = threadIdx.x, wid = __builtin_amdgcn_readfirstlane(tid >> 6), lane = tid & 63, wr = wid >> 2, wc = wid & 3, fr = lane & 15, fq = lane >> 4;
    const int K = g.K, nt = K / BK;
    unsigned voffA[2], voffB[2];
#pragma unroll
    for (int i = 0; i < 2; ++i) { int R, C; stage_rc(tid * 16 + i * 8192, R, C); const int Rb = Epi::PERM ? ((R & ~31) + perm32(R & 31)) : R;
        voffA[i] = (unsigned)(R * g.lda + C) * 2u; voffB[i] = (unsigned)(Rb * g.ldb + C) * 2u; }
    const size_t kstep = (size_t)(BK * 2);
    const size_t hstepA = (size_t)HALF * g.lda * 2, hstepB = (size_t)HALF * g.ldb * 2;
    const size_t tstepA = 2 * hstepA, tstepB = 2 * hstepB;
    const unsigned ldsw = (unsigned)wid * 1024u;
    const int aoff = lds_byte(wr * 64 + fr, fq * 8), boff = lds_byte(wc * 32 + fr, fq * 8);
#define PG8_SA(b, h) (((b) * 2 + (h)) * HTB)
#define PG8_SB(b, h) ((4 + (b) * 2 + (h)) * HTB)
#define PG8_STAGE(bufoff, gbase, voff) do { _Pragma("unroll") for (int _i = 0; _i < 2; ++_i) \
        __builtin_amdgcn_global_load_lds((const unsigned*)((const char*)(gbase) + (voff)[_i]), (LAS unsigned*)(lds + (bufoff) + ldsw + _i * 8192), 16, 0, 0); } while (0)
#define PG8_LDA(dst, b, h) do { _Pragma("unroll") for (int m = 0; m < 4; ++m) _Pragma("unroll") for (int k = 0; k < 2; ++k) dst[m][k] = *(const LAS bf16x8*)(lds + PG8_SA(b, h) + aoff + m * 2048 + k * 1024); } while (0)
#define PG8_LDB(dst, b, h) do { _Pragma("unroll") for (int n = 0; n < 2; ++n) _Pragma("unroll") for (int k = 0; k < 2; ++k) dst[n][k] = *(const LAS bf16x8*)(lds + PG8_SB(b, h) + boff + n * 2048 + k * 1024); } while (0)
#define PG8_MMA(ai, bj, At, Bt) do { __builtin_amdgcn_s_setprio(1); _Pragma("unroll") for (int m = 0; m < 4; ++m) _Pragma("unroll") for (int n = 0; n < 2; ++n) _Pragma("unroll") for (int k = 0; k < 2; ++k) \
        acc[ai][bj][m][n] = __builtin_amdgcn_mfma_f32_16x16x32_bf16(Bt[n][k], At[m][k], acc[ai][bj][m][n], 0, 0, 0); __builtin_amdgcn_s_setprio(0); } while (0)
#define PG8_WAIT_V(n) asm volatile("s_waitcnt vmcnt(" #n ")" ::: "memory")
#define PG8_WAIT_L(n) asm volatile("s_waitcnt lgkmcnt(" #n ")" ::: "memory")
#define PG8_BAR __builtin_amdgcn_s_barrier()
#define PG8_SCHED __builtin_amdgcn_sched_barrier(0)
    Unit cur, nxt; int ui = 0;
    if (!S.next(0, cur)) return;
    f32x4 acc[2][2][4][2];
#pragma unroll
    for (int a = 0; a < 2; ++a)
#pragma unroll
        for (int b = 0; b < 2; ++b)
#pragma unroll
            for (int m = 0; m < 4; ++m)
#pragma unroll
                for (int n = 0; n < 2; ++n) acc[a][b][m][n] = (f32x4){0.f, 0.f, 0.f, 0.f};
    bf16x8 At[4][2], B0[2][2], B1[2][2];
    const char* cA = (const char*)g.A + (size_t)cur.pm * tstepA; const char* cB = (const char*)g.Bt + (size_t)cur.pn * tstepB;
    S.a_ready(cur);
    if constexpr (SP2) {
        PG8_STAGE(PG8_SB(0, 0), cB, voffB); PG8_STAGE(PG8_SB(0, 1), cB + hstepB, voffB); PG8_STAGE(PG8_SA(0, 0), cA, voffA); PG8_STAGE(PG8_SA(0, 1), cA + hstepA, voffA);
        if (wr == 1) PG8_BAR;
        PG8_WAIT_V(2); PG8_BAR;
        PG8_STAGE(PG8_SB(1, 0), cB + kstep, voffB); PG8_STAGE(PG8_SA(1, 0), cA + kstep, voffA); PG8_STAGE(PG8_SB(1, 1), cB + hstepB + kstep, voffB);
        PG8_WAIT_V(6); PG8_BAR;
    } else {
        PG8_STAGE(PG8_SB(0, 0), cB, voffB); PG8_STAGE(PG8_SA(0, 0), cA, voffA); PG8_STAGE(PG8_SB(0, 1), cB + hstepB, voffB); PG8_STAGE(PG8_SA(0, 1), cA + hstepA, voffA);
        if (wr == 1) PG8_BAR;
        PG8_WAIT_V(4); PG8_BAR;
        PG8_STAGE(PG8_SB(1, 0), cB + kstep, voffB); PG8_STAGE(PG8_SA(1, 0), cA + kstep, voffA); PG8_STAGE(PG8_SB(1, 1), cB + hstepB + kstep, voffB);
        PG8_WAIT_V(6); PG8_BAR;
    }
    for (;;) {
        const bool has_next = S.next(ui + 1, nxt);
        const char* nA = has_next ? (const char*)g.A + (size_t)nxt.pm * tstepA : cA; const char* nB = has_next ? (const char*)g.Bt + (size_t)nxt.pn * tstepB : cB;
#pragma unroll 1
        for (int t = 0; t < nt; t += 2) {
            const bool last = (t == nt - 2);
            const char* a1 = cA + (size_t)(t + 1) * kstep;
            const char* a2 = last ? nA : cA + (size_t)(t + 2) * kstep; const char* b2 = last ? nB : cB + (size_t)(t + 2) * kstep;
            const char* a3 = a2 + kstep; const char* b3 = b2 + kstep;
            if (last && has_next) S.a_ready(nxt);
            if constexpr (SP2) {
            PG8_LDB(B0, 0, 0); PG8_LDB(B1, 0, 1); PG8_SCHED; PG8_LDA(At, 0, 0); PG8_STAGE(PG8_SA(1, 1), a1 + hstepA, voffA);
            PG8_WAIT_V(8); PG8_WAIT_L(0); PG8_BAR; PG8_MMA(0, 0, At, B0); PG8_MMA(0, 1, At, B1); PG8_BAR; PG8_SCHED;
            PG8_LDA(At, 0, 1); PG8_STAGE(PG8_SB(0, 0), b2, voffB); PG8_STAGE(PG8_SB(0, 1), b2 + hstepB, voffB); PG8_STAGE(PG8_SA(0, 0), a2, voffA);
            PG8_WAIT_V(8); PG8_WAIT_L(0); PG8_BAR; PG8_MMA(1, 0, At, B0); PG8_MMA(1, 1, At, B1); PG8_BAR; PG8_SCHED;
            PG8_LDB(B0, 1, 0); PG8_LDB(B1, 1, 1); PG8_SCHED; PG8_LDA(At, 1, 0); PG8_STAGE(PG8_SA(0, 1), a2 + hstepA, voffA);
            PG8_WAIT_V(8); PG8_WAIT_L(0); PG8_BAR; PG8_MMA(0, 0, At, B0); PG8_MMA(0, 1, At, B1); PG8_BAR; PG8_SCHED;
            PG8_LDA(At, 1, 1); PG8_STAGE(PG8_SB(1, 0), b3, voffB); PG8_STAGE(PG8_SB(1, 1), b3 + hstepB, voffB); PG8_STAGE(PG8_SA(1, 0), a3, voffA);
            PG8_WAIT_V(8); PG8_WAIT_L(0); PG8_BAR; PG8_MMA(1, 0, At, B0); PG8_MMA(1, 1, At, B1); PG8_BAR; PG8_SCHED;
            } else {
            PG8_LDB(B0, 0, 0); PG8_SCHED; PG8_LDA(At, 0, 0); PG8_STAGE(PG8_SA(1, 1), a1 + hstepA, voffA);
            PG8_WAIT_L(8); PG8_BAR; PG8_WAIT_L(0); PG8_MMA(0, 0, At, B0); PG8_BAR; PG8_SCHED;
            PG8_LDB(B1, 0, 1); PG8_STAGE(PG8_SB(0, 0), b2, voffB);
            PG8_BAR; PG8_WAIT_L(0); PG8_MMA(0, 1, At, B1); PG8_BAR;
            PG8_LDA(At, 0, 1); PG8_STAGE(PG8_SA(0, 0), a2, voffA);
            PG8_BAR; PG8_WAIT_L(0); PG8_MMA(1, 0, At, B0); PG8_BAR; PG8_SCHED;
            PG8_STAGE(PG8_SB(0, 1), b2 + hstepB, voffB);
            PG8_WAIT_V(6); PG8_BAR; PG8_MMA(1, 1, At, B1); PG8_BAR;
            PG8_LDB(B0, 1, 0); PG8_SCHED; PG8_LDA(At, 1, 0); PG8_STAGE(PG8_SA(0, 1), a2 + hstepA, voffA);
            PG8_WAIT_L(8); PG8_BAR; PG8_WAIT_L(0); PG8_MMA(0, 0, At, B0); PG8_BAR; PG8_SCHED;
            PG8_LDB(B1, 1, 1); PG8_STAGE(PG8_SB(1, 0), b3, voffB);
            PG8_BAR; PG8_WAIT_L(0); PG8_MMA(0, 1, At, B1); PG8_BAR;
            PG8_LDA(At, 1, 1); PG8_STAGE(PG8_SA(1, 0), a3, voffA);
            PG8_BAR; PG8_WAIT_L(0); PG8_MMA(1, 0, At, B0); PG8_BAR; PG8_SCHED;
            PG8_STAGE(PG8_SB(1, 1), b3 + hstepB, voffB);
            PG8_WAIT_V(6); PG8_BAR; PG8_MMA(1, 1, At, B1); PG8_BAR;
            }
        }
        if constexpr (ALIGN_EPI) { if (wr == 0) PG8_BAR; }
        if constexpr (!Epi::AFTER_DRAIN) { E(acc, cur, wr, wc, fr, fq); S.done(cur); }
        if (!has_next) break;
#pragma unroll
        for (int a = 0; a < 2; ++a)
#pragma unroll
            for (int b = 0; b < 2; ++b)
#pragma unroll
                for (int m = 0; m < 4; ++m)
#pragma unroll
                    for (int n = 0; n < 2; ++n) acc[a][b][m][n] = (f32x4){0.f, 0.f, 0.f, 0.f};
        cur = nxt; cA = nA; cB = nB; ++ui;
        if constexpr (ALIGN_EPI) { if (wr == 1) PG8_BAR; }
    }
    PG8_WAIT_V(0);
    if constexpr (!ALIGN_EPI) { if (wr == 0) PG8_BAR; }
    PG8_BAR;
    if constexpr (Epi::AFTER_DRAIN) { E.fused(acc, cur, wr, wc, fr, fq, lds, wid, lane); S.done(cur); }
#undef PG8_SA
#undef PG8_SB
#undef PG8_STAGE
#undef PG8_LDA
#undef PG8_LDB
#undef PG8_MMA
#undef PG8_WAIT_V
#undef PG8_WAIT_L
#undef PG8_BAR
#undef PG8_SCHED
}
}
typedef unsigned short bf16_t;
DI unsigned pk2(float lo, float hi) { return pg8::cvt_pk_bf16(lo, hi); }
DI bf16_t f2bf(float f) { return (bf16_t)(pg8::cvt_pk_bf16(f, 0.f) & 0xffffu); }
DI void transpose_item(const float* W, int N, bf16_t* WT, int ldt, int row_off, int rmul, LAS float* scr, int item, int lane) {
    const int nblk = N / 32, kb = item / nblk, nb = item % nblk, k0 = 64 * kb, n0 = 32 * nb;
#pragma unroll 8
    for (int i = 0; i < 32; ++i) { const int kk = 2 * i + (lane >> 5); scr[kk * 33 + (lane & 31)] = W[(size_t)(k0 + kk) * N + n0 + (lane & 31)]; }
    asm volatile("s_waitcnt lgkmcnt(0)" ::: "memory");
    const int c = lane & 7;
#pragma unroll
    for (int j = 0; j < 4; ++j) { const int n = (lane >> 3) + 8 * j; const LAS float* sp = scr + (8 * c) * 33 + n;
        pg8::u32x4 o; o.x = pk2(sp[0 * 33], sp[1 * 33]); o.y = pk2(sp[2 * 33], sp[3 * 33]); o.z = pk2(sp[4 * 33], sp[5 * 33]); o.w = pk2(sp[6 * 33], sp[7 * 33]);
        *(pg8::u32x4*)(WT + (size_t)(row_off + rmul * (n0 + n)) * ldt + k0 + 8 * c) = o; }
    asm volatile("s_waitcnt lgkmcnt(0)" ::: "memory");
}
DI void transpose_w(const float* W, int K, int N, bf16_t* WT, int ldt, int row_off, LAS float* scr, int gw, int NGW, int lane, int& rot, int rmul = 1) {
    const int nitems = (K / 64) * (N / 32);
    int first = gw - (rot % NGW); if (first < 0) first += NGW;
    for (int it = first; it < nitems; it += NGW) transpose_item(W, N, WT, ldt, row_off, rmul, scr, it, lane);
    rot += nitems;
}

struct Args {
    const float* in[29]; float* out; unsigned char* ws; int ph_lo, ph_hi, sub, pad;
};

DI unsigned short f2bf_raw(float f) { unsigned u = __builtin_bit_cast(unsigned, f); return (unsigned short)((u + 0x7fffu + ((u >> 16) & 1u)) >> 16); }
DI void sgemm_naive(LAS float* lds, const float* __restrict__ A, int lda, const float* __restrict__ B, long sbk, long sbn,
                    float* __restrict__ C, int ldc, int M, int N, int K, int bid, int G, unsigned short* Cb = nullptr) {
    LAS float* As = lds;
    LAS float* Bs = lds + 16 * 132;
    const int tid = threadIdx.x, tx = tid & 15, ty = tid >> 4;
    const int ntn = N / 64, ntiles = (M / 128) * ntn;
    for (int t = bid; t < ntiles; t += G) {
        const int m0 = (t / ntn) * 128, n0 = (t % ntn) * 64;
        float acc[4][4];
#pragma unroll
        for (int i = 0; i < 4; ++i)
#pragma unroll
            for (int j = 0; j < 4; ++j) acc[i][j] = 0.f;
        for (int k0 = 0; k0 < K; k0 += 16) {
            {
                const int r = tid >> 2, kq = (tid & 3) * 4;
                const float4 v = *(const float4*)(A + (size_t)(m0 + r) * lda + k0 + kq);
                As[(kq + 0) * 132 + r] = v.x; As[(kq + 1) * 132 + r] = v.y; As[(kq + 2) * 132 + r] = v.z; As[(kq + 3) * 132 + r] = v.w;
            }
#pragma unroll
            for (int i = 0; i < 2; ++i) {
                const int idx = tid + i * 512, kk = idx >> 6, nn = idx & 63;
                Bs[kk * 64 + nn] = B[(size_t)(k0 + kk) * sbk + (size_t)(n0 + nn) * sbn];
            }
            __syncthreads();
#pragma unroll
            for (int kk = 0; kk < 16; ++kk) {
                const f32x4 a = *(const LAS f32x4*)(As + kk * 132 + ty * 4);
                const f32x4 b = *(const LAS f32x4*)(Bs + kk * 64 + tx * 4);
                const float av[4] = {a.x, a.y, a.z, a.w}, bv[4] = {b.x, b.y, b.z, b.w};
#pragma unroll
                for (int i = 0; i < 4; ++i)
#pragma unroll
                    for (int j = 0; j < 4; ++j) acc[i][j] += av[i] * bv[j];
            }
            __syncthreads();
        }
#pragma unroll
        for (int i = 0; i < 4; ++i) {
            float4 o; o.x = acc[i][0]; o.y = acc[i][1]; o.z = acc[i][2]; o.w = acc[i][3];
            if (Cb) { unsigned short* cb = Cb + (size_t)(m0 + ty * 4 + i) * ldc + n0 + tx * 4; cb[0] = f2bf_raw(o.x); cb[1] = f2bf_raw(o.y); cb[2] = f2bf_raw(o.z); cb[3] = f2bf_raw(o.w); }
            else *(float4*)(C + (size_t)(m0 + ty * 4 + i) * ldc + n0 + tx * 4) = o;
        }
    }
}

template <int DQK, int DV, bool V_IN_K, int MODE, class KV, class QF>
DI void attn_naive(LAS float* lds, const KV& kv, int nk_loop, const QF& qf, bool active, int limit, float scale, float lg, int tq, float* optr) {
    constexpr int KS = DQK + 1;
    constexpr int VS = V_IN_K ? KS : DV;
    LAS float* Ks = lds;
    LAS float* Vs = V_IN_K ? Ks : (lds + 64 * KS);
    LAS float* qs = lds + 64 * KS + (V_IN_K ? 0 : 64 * DV);
    LAS float* ps = qs + 8 * DQK;
    static_assert((64 * KS + (V_IN_K ? 0 : 64 * DV) + 8 * DQK + 8 * 64) * 4 <= MISC_OFF, "attn_naive LDS");
    const int tid = threadIdx.x, lane = tid & 63, w = tid >> 6;
    __syncthreads();
    for (int d = lane; d < DQK; d += 64) qs[w * DQK + d] = active ? qf(d) : 0.f;
    float m = -INFINITY, l = 0.f;
    float acc[DV / 64];
#pragma unroll
    for (int c = 0; c < DV / 64; ++c) acc[c] = 0.f;
    for (int base = 0; base < nk_loop; base += 64) {
        __syncthreads();
        for (int idx = tid; idx < 64 * DQK; idx += NTHREADS) { const int j = idx / DQK, d = idx - j * DQK, key = base + j; Ks[j * KS + d] = key < nk_loop ? kv.k(key, d) : 0.f; }
        if (!V_IN_K) for (int idx = tid; idx < 64 * DV; idx += NTHREADS) { const int j = idx / DV, e = idx - j * DV, key = base + j; Vs[j * DV + e] = key < nk_loop ? kv.v(key, e) : 0.f; }
        __syncthreads();
        const int key = base + lane; const bool valid = active && key <= limit && key < nk_loop;
        float s = 0.f;
        for (int d = 0; d < DQK; ++d) s += qs[w * DQK + d] * Ks[lane * KS + d];
        float p;
        if (MODE == 0) {
            s *= scale;
            const float cm = wave_max(valid ? s : -INFINITY);
            const float mn = fmaxf(m, cm);
            const float alpha = (mn == -INFINITY) ? 1.f : expf(m - mn);
            p = valid ? expf(s - mn) : 0.f;
            l = l * alpha + wave_sum(p);
#pragma unroll
            for (int c = 0; c < DV / 64; ++c) acc[c] *= alpha;
            m = mn;
        } else {
            p = valid ? s * expf((float)(tq - key) * lg) : 0.f;
        }
        ps[w * 64 + lane] = p;
        __syncthreads();
        for (int j = 0; j < 64; ++j) { const float pj = ps[w * 64 + j];
#pragma unroll
            for (int c = 0; c < DV / 64; ++c) acc[c] += pj * Vs[j * VS + lane + 64 * c]; }
    }
    if (active) {
#pragma unroll
        for (int c = 0; c < DV / 64; ++c) optr[lane + 64 * c] = (MODE == 0) ? acc[c] / l : acc[c];
    }
}

struct KvMlaPrompt { const float* ckvn; const float* kper; int b;
    DI float k(int key, int d) const { const size_t row = (size_t)b * SEQ + key; return d < KVL ? ckvn[row * KVL + d] : kper[row * DROPE + (d - KVL)]; }
    DI float v(int, int) const { return 0.f; } };
struct KvMlaSample { const float* ckvn; const float* kper; const float* cckv; const float* ckpe; const int* pt; int b;
    DI float k(int key, int d) const {
        if (key < PAST) { const size_t r = (size_t)pt[b * NPAGES + (key >> 7)] * PAGE + (key & (PAGE - 1)); return d < KVL ? cckv[r * KVL + d] : ckpe[r * DROPE + (d - KVL)]; }
        const size_t row = (size_t)NP + b * DS + (key - PAST); return d < KVL ? ckvn[row * KVL + d] : kper[row * DROPE + (d - KVL)]; }
    DI float v(int, int) const { return 0.f; } };
struct KvRet { const float* rk; const float* z; int b, h;
    DI float k(int key, int d) const { return rk[((size_t)b * SEQ + key) * 512 + h * RDK + d]; }
    DI float v(int key, int e) const { return z[((size_t)b * SEQ + key) * ZLD + C_RV + h * RDV + e]; } };
struct KvMem { const float* mk; const float* mv; int b, h;
    DI float k(int key, int d) const { return mk[(((size_t)b * NMEM + key) * XH + h) * XHD + d]; }
    DI float v(int key, int e) const { return mv[(((size_t)b * NMEM + key) * XH + h) * XHD + e]; } };


typedef float f32x16 __attribute__((ext_vector_type(16)));
typedef short bf16x8 __attribute__((ext_vector_type(8)));
typedef short s16x4 __attribute__((ext_vector_type(4)));
typedef __bf16 bf16x2_t __attribute__((ext_vector_type(2)));
typedef float f32x2_t __attribute__((ext_vector_type(2)));
typedef unsigned u32x4_t __attribute__((ext_vector_type(4)));
typedef unsigned u32x2_t __attribute__((ext_vector_type(2)));
DI unsigned cvtpk(float lo, float hi) { f32x2_t v = {lo, hi}; bf16x2_t b = __builtin_convertvector(v, bf16x2_t); return __builtin_bit_cast(unsigned, b); }
DI int crow(int i, int h) { return (i & 3) + 8 * (i >> 2) + 4 * h; }
#define MFMA32(a, b, c) __builtin_amdgcn_mfma_f32_32x32x16_bf16((a), (b), (c), 0, 0, 0)
template <int DQK, int DV, bool CAUSAL, class Src>
DI void flash_unit(LAS unsigned char* lds, const Src& src, const bf16_t* Q, int ldq, int qpos0, int ntiles, bf16_t* O, int ldo, float c2) {
    constexpr int KP = DQK + 8, VP = 68, KS = DQK / 16, NBLK = DV / 32;
    constexpr int KBYTES = 64 * KP * 2, VBYTES = DV * VP * 2, BUF = KBYTES + VBYTES;
    constexpr int D8 = DQK / 8, NPK = (64 * D8) / NTHREADS, NPV = (DV * 8) / NTHREADS;
    static_assert((64 * D8) % NTHREADS == 0 && (DV * 8) % NTHREADS == 0 && 2 * BUF <= 131072, "flash_unit geometry");
    const int tid = threadIdx.x, lane = tid & 63, w = __builtin_amdgcn_readfirstlane(tid >> 6), l31 = lane & 31, h = lane >> 5;
    bf16x8 qf[KS];
    { const bf16_t* qrow = Q + (size_t)(32 * w + l31) * ldq + h * 8;
#pragma unroll
      for (int s_ = 0; s_ < KS; ++s_) qf[s_] = *(const bf16x8*)(qrow + 16 * s_); }
    f32x16 o[NBLK];
#pragma unroll
    for (int b = 0; b < NBLK; ++b)
#pragma unroll
        for (int i = 0; i < 16; ++i) o[b][i] = 0.f;
    float m = -INFINITY, lsum = 0.f;
    u32x4_t kreg[NPK], vreg[NPV];
#define FL_LOAD(t_) do { _Pragma("unroll") for (int i_ = 0; i_ < NPK; ++i_) { const int p_ = tid + i_ * NTHREADS; kreg[i_] = src.kpiece(64 * (t_) + p_ / D8, p_ % D8); } \
                         _Pragma("unroll") for (int i_ = 0; i_ < NPV; ++i_) { const int p_ = tid + i_ * NTHREADS; vreg[i_] = src.vpiece(p_ >> 3, 64 * (t_) + 8 * (p_ & 7)); } } while (0)
#define FL_STORE(buf_) do { _Pragma("unroll") for (int i_ = 0; i_ < NPK; ++i_) { const int p_ = tid + i_ * NTHREADS; *(LAS u32x4_t*)(lds + (buf_) * BUF + ((p_ / D8) * KP + (p_ % D8) * 8) * 2) = kreg[i_]; } \
                          _Pragma("unroll") for (int i_ = 0; i_ < NPV; ++i_) { const int p_ = tid + i_ * NTHREADS; LAS unsigned char* a_ = lds + (buf_) * BUF + KBYTES + ((p_ >> 3) * VP + (p_ & 7) * 8) * 2; \
                              *(LAS u32x2_t*)a_ = (u32x2_t){vreg[i_].x, vreg[i_].y}; *(LAS u32x2_t*)(a_ + 8) = (u32x2_t){vreg[i_].z, vreg[i_].w}; } } while (0)
    __syncthreads();
    FL_LOAD(0); FL_STORE(0);
    __syncthreads();
    const int qmine = qpos0 + 32 * w + l31, qlast = qpos0 + 32 * w + 31;
    for (int t = 0; t < ntiles; ++t) {
        const int buf = t & 1;
        if (t + 1 < ntiles) FL_LOAD(t + 1);
        if (!CAUSAL || 64 * t <= qlast) {
            const LAS unsigned char* kb_ = lds + buf * BUF; const LAS unsigned char* vb_ = kb_ + KBYTES;
            f32x16 st[2];
#pragma unroll
            for (int kb = 0; kb < 2; ++kb) {
#pragma unroll
                for (int i = 0; i < 16; ++i) st[kb][i] = 0.f;
#pragma unroll
                for (int g_ = 0; g_ < KS / 4; ++g_) { bf16x8 kf[4];
#pragma unroll
                    for (int j = 0; j < 4; ++j) kf[j] = *(const LAS bf16x8*)(kb_ + ((32 * kb + l31) * KP + 16 * (4 * g_ + j) + 8 * h) * 2);
#pragma unroll
                    for (int j = 0; j < 4; ++j) st[kb] = MFMA32(kf[j], qf[4 * g_ + j], st[kb]);
                    __builtin_amdgcn_sched_barrier(0); }
            }
            float mx = -INFINITY;
#pragma unroll
            for (int kb = 0; kb < 2; ++kb)
#pragma unroll
                for (int i = 0; i < 16; ++i) { float v = st[kb][i] * c2; if (CAUSAL) { const int key = 64 * t + 32 * kb + crow(i, h); v = key <= qmine ? v : -INFINITY; } st[kb][i] = v; mx = fmaxf(mx, v); }
            mx = fmaxf(mx, __shfl_xor(mx, 32));
            const float mn = fmaxf(m, mx);
            const float alpha = __builtin_amdgcn_exp2f(m - mn);
            m = mn;
            float ps = 0.f;
#pragma unroll
            for (int kb = 0; kb < 2; ++kb)
#pragma unroll
                for (int i = 0; i < 16; ++i) { const float p = __builtin_amdgcn_exp2f(st[kb][i] - mn); st[kb][i] = p; ps += p; }
            lsum = lsum * alpha + ps;
#pragma unroll
            for (int b = 0; b < NBLK; ++b)
#pragma unroll
                for (int i = 0; i < 16; ++i) o[b][i] *= alpha;
            bf16x8 pf[4];
#pragma unroll
            for (int ks = 0; ks < 4; ++ks) { const int kb = ks >> 1, s2 = ks & 1; u32x4_t pk;
                pk.x = cvtpk(st[kb][8 * s2 + 0], st[kb][8 * s2 + 1]); pk.y = cvtpk(st[kb][8 * s2 + 2], st[kb][8 * s2 + 3]);
                pk.z = cvtpk(st[kb][8 * s2 + 4], st[kb][8 * s2 + 5]); pk.w = cvtpk(st[kb][8 * s2 + 6], st[kb][8 * s2 + 7]); pf[ks] = __builtin_bit_cast(bf16x8, pk); }
            __builtin_amdgcn_sched_barrier(0);
#pragma unroll
            for (int b = 0; b < NBLK; ++b) { bf16x8 vf[4];
#pragma unroll
                for (int ks = 0; ks < 4; ++ks) { const LAS unsigned char* a_ = vb_ + ((32 * b + l31) * VP + 16 * ks + 4 * h) * 2;
                    const s16x4 lo = *(const LAS s16x4*)a_, hi = *(const LAS s16x4*)(a_ + 16);
                    vf[ks] = __builtin_shufflevector(lo, hi, 0, 1, 2, 3, 4, 5, 6, 7); }
#pragma unroll
                for (int ks = 0; ks < 4; ++ks) o[b] = MFMA32(vf[ks], pf[ks], o[b]);
                __builtin_amdgcn_sched_barrier(0); }
        }
        if (t + 1 < ntiles) FL_STORE(buf ^ 1);
        __syncthreads();
    }
#undef FL_LOAD
#undef FL_STORE
    lsum += __shfl_xor(lsum, 32);
    const float inv = 1.f / lsum;
    bf16_t* orow = O + (size_t)(32 * w + l31) * ldo;
#pragma unroll
    for (int b = 0; b < NBLK; ++b)
#pragma unroll
        for (int g = 0; g < 4; ++g) { u32x2_t pk; pk.x = cvtpk(o[b][4 * g + 0] * inv, o[b][4 * g + 1] * inv); pk.y = cvtpk(o[b][4 * g + 2] * inv, o[b][4 * g + 3] * inv);
            *(u32x2_t*)(orow + 32 * b + 8 * g + 4 * h) = pk; }
}
struct SrcMlaP { const bf16_t* kn; const bf16_t* kpe; const bf16_t* vt; int b, hh;
    DI u32x4_t kpiece(int key, int d8) const { const size_t row = (size_t)b * SEQ + key;
        return d8 < 16 ? *(const u32x4_t*)(kn + row * 1024 + hh * DNOPE + d8 * 8) : *(const u32x4_t*)(kpe + row * DROPE + (d8 - 16) * 8); }
    DI u32x4_t vpiece(int dv, int key0) const { return *(const u32x4_t*)(vt + (size_t)(hh * DVH + dv) * NP + (size_t)b * SEQ + key0); } };
struct SrcMemP { const bf16_t* mk; const bf16_t* mvt; int b, hh;
    DI u32x4_t kpiece(int key, int d8) const { return *(const u32x4_t*)(mk + ((size_t)b * NMEM + key) * 256 + hh * XHD + d8 * 8); }
    DI u32x4_t vpiece(int dv, int key0) const { return *(const u32x4_t*)(mvt + (size_t)(hh * XHD + dv) * (NB * NMEM) + (size_t)b * NMEM + key0); } };


DI void ret_chunk_state(const bf16_t* __restrict__ RVT, const bf16_t* __restrict__ RKtT, float* __restrict__ UT, int b, int h, int c) {
    const int tid = threadIdx.x, lane = tid & 63, w = __builtin_amdgcn_readfirstlane(tid >> 6), l31 = lane & 31, hh = lane >> 5;
    const size_t tok0 = (size_t)b * SEQ + c * 128;
    f32x16 acc[4];
#pragma unroll
    for (int kb = 0; kb < 4; ++kb)
#pragma unroll
        for (int i = 0; i < 16; ++i) acc[kb][i] = 0.f;
    const bf16_t* ap = RVT + (size_t)(h * RDV + 32 * w + l31) * NT + tok0 + 8 * hh;
    const bf16_t* bp = RKtT + (size_t)(h * RDK + l31) * NP + tok0 + 8 * hh;
#pragma unroll
    for (int s_ = 0; s_ < 8; ++s_) { const bf16x8 a = *(const bf16x8*)(ap + 16 * s_);
#pragma unroll
        for (int kb = 0; kb < 4; ++kb) { const bf16x8 bfr = *(const bf16x8*)(bp + (size_t)(32 * kb) * NP + 16 * s_); acc[kb] = MFMA32(a, bfr, acc[kb]); } }
    float* u = UT + (size_t)(((b * RH + h) * 16) + c) * 32768;
#pragma unroll
    for (int kb = 0; kb < 4; ++kb)
#pragma unroll
        for (int i = 0; i < 16; ++i) u[(32 * w + crow(i, hh)) * RDK + 32 * kb + l31] = acc[kb][i];
}
DI void ret_chunk_out(const bf16_t* __restrict__ RQt, const bf16_t* __restrict__ RKt, const bf16_t* __restrict__ RVT, const bf16_t* __restrict__ SPT, float* __restrict__ ORET, int b, int h, int c) {
    const int tid = threadIdx.x, lane = tid & 63, w = __builtin_amdgcn_readfirstlane(tid >> 6), l31 = lane & 31, hh = lane >> 5;
    const int ib = w & 3, vh = w >> 2;
    const size_t tok0 = (size_t)b * SEQ + c * 128;
    bf16x8 qf[8];
    { const bf16_t* qp = RQt + (tok0 + 32 * ib + l31) * 512 + h * RDK + 8 * hh;
#pragma unroll
      for (int s_ = 0; s_ < 8; ++s_) qf[s_] = *(const bf16x8*)(qp + 16 * s_); }
    f32x16 o[4];
#pragma unroll
    for (int blk = 0; blk < 4; ++blk)
#pragma unroll
        for (int i = 0; i < 16; ++i) o[blk][i] = 0.f;
    const bf16_t* vbase = RVT + (size_t)(h * RDV + 32 * (4 * vh) + l31) * NT + tok0 + 4 * hh;
#pragma unroll 1
    for (int jb = 0; jb <= ib; ++jb) {
        f32x16 x;
#pragma unroll
        for (int i = 0; i < 16; ++i) x[i] = 0.f;
        const bf16_t* kp = RKt + (tok0 + 32 * jb + l31) * 512 + h * RDK + 8 * hh;
#pragma unroll
        for (int s_ = 0; s_ < 8; ++s_) { const bf16x8 kf = *(const bf16x8*)(kp + 16 * s_); x = MFMA32(kf, qf[s_], x); }
        if (jb == ib) {
#pragma unroll
            for (int i = 0; i < 16; ++i) x[i] = (crow(i, hh) <= l31) ? x[i] : 0.f;
        }
#pragma unroll
        for (int s2 = 0; s2 < 2; ++s2) {
            u32x4_t pk; pk.x = cvtpk(x[8 * s2 + 0], x[8 * s2 + 1]); pk.y = cvtpk(x[8 * s2 + 2], x[8 * s2 + 3]); pk.z = cvtpk(x[8 * s2 + 4], x[8 * s2 + 5]); pk.w = cvtpk(x[8 * s2 + 6], x[8 * s2 + 7]);
            const bf16x8 pa = __builtin_bit_cast(bf16x8, pk);
#pragma unroll
            for (int blk = 0; blk < 4; ++blk) { const bf16_t* vp = vbase + (size_t)(32 * blk) * NT + 32 * jb + 16 * s2;
                const s16x4 lo = *(const s16x4*)vp, hi = *(const s16x4*)(vp + 8);
                const bf16x8 vf = __builtin_shufflevector(lo, hi, 0, 1, 2, 3, 4, 5, 6, 7);
                o[blk] = MFMA32(pa, vf, o[blk]); }
        }
    }
    const bf16_t* sp = SPT + (size_t)(((b * RH + h) * 16) + c) * 32768 + (size_t)(32 * (4 * vh) + l31) * RDK + 8 * hh;
#pragma unroll
    for (int s_ = 0; s_ < 8; ++s_)
#pragma unroll
        for (int blk = 0; blk < 4; ++blk) { const bf16x8 sf = *(const bf16x8*)(sp + (size_t)(32 * blk) * RDK + 16 * s_); o[blk] = MFMA32(qf[s_], sf, o[blk]); }
#pragma unroll
    for (int blk = 0; blk < 4; ++blk)
#pragma unroll
        for (int i = 0; i < 16; ++i) ORET[(tok0 + 32 * ib + crow(i, hh)) * 1024 + h * RDV + 32 * (4 * vh + blk) + l31] = o[blk][i];
}


typedef short v4i16_t __attribute__((ext_vector_type(4)));
DI s16x4 vtr(const LAS unsigned char* p) { return __builtin_bit_cast(s16x4, __builtin_amdgcn_ds_read_tr16_b64_v4i16((LAS v4i16_t*)p)); }
constexpr int MS_NSPLIT = 2, MS_KEYS = PAST / MS_NSPLIT, MS_TILES = MS_KEYS / 64;
DI void mla_sample_unit(LAS unsigned char* lds, const float* __restrict__ cckv, const float* __restrict__ ckpe, const int* __restrict__ pt,
                        const bf16_t* __restrict__ QLATb, const bf16_t* __restrict__ Qb, float* __restrict__ PO, float* __restrict__ PML, int b, int split, float c2) {
    constexpr int KP = 328, KBYTES = 64 * KP * 2;
    const int tid = threadIdx.x, lane = tid & 63, w = __builtin_amdgcn_readfirstlane(tid >> 6), l31 = lane & 31, hh = lane >> 5;
    bf16x8 qf[20];
    { const int t = l31 >> 3, head = l31 & 7;
      const bf16_t* ql = QLATb + (size_t)(b * DS + t) * 2048 + head * KVL + 8 * hh;
      const bf16_t* qp = Qb + (size_t)(NP + b * DS + t) * 1536 + head * DQH + DNOPE + 8 * hh;
#pragma unroll
      for (int s_ = 0; s_ < 16; ++s_) qf[s_] = *(const bf16x8*)(ql + 16 * s_);
#pragma unroll
      for (int s_ = 0; s_ < 4; ++s_) qf[16 + s_] = *(const bf16x8*)(qp + 16 * s_); }
    f32x16 o;
#pragma unroll
    for (int i = 0; i < 16; ++i) o[i] = 0.f;
    float m = -INFINITY, lsum = 0.f;
    f32x4 cr[8], pr[2];
#define MS_LOAD(t_) do { const int key0_ = split * MS_KEYS + 64 * (t_); const size_t rowb_ = (size_t)pt[b * NPAGES + (key0_ >> 7)] * PAGE + (key0_ & (PAGE - 1)); \
        _Pragma("unroll") for (int i_ = 0; i_ < 8; ++i_) { const int pc_ = tid + i_ * NTHREADS; cr[i_] = __builtin_nontemporal_load((const f32x4*)(cckv + (rowb_ + (pc_ >> 6)) * KVL + 4 * (pc_ & 63))); } \
        _Pragma("unroll") for (int i_ = 0; i_ < 2; ++i_) { const int pc_ = tid + i_ * NTHREADS; pr[i_] = __builtin_nontemporal_load((const f32x4*)(ckpe + (rowb_ + (pc_ >> 4)) * DROPE + 4 * (pc_ & 15))); } } while (0)
#define MS_STORE(buf_) do { \
        _Pragma("unroll") for (int i_ = 0; i_ < 8; ++i_) { const int pc_ = tid + i_ * NTHREADS; *(LAS u32x2_t*)(lds + (buf_) * KBYTES + ((pc_ >> 6) * KP + 4 * (pc_ & 63)) * 2) = (u32x2_t){cvtpk(cr[i_][0], cr[i_][1]), cvtpk(cr[i_][2], cr[i_][3])}; } \
        _Pragma("unroll") for (int i_ = 0; i_ < 2; ++i_) { const int pc_ = tid + i_ * NTHREADS; *(LAS u32x2_t*)(lds + (buf_) * KBYTES + ((pc_ >> 4) * KP + KVL + 4 * (pc_ & 15)) * 2) = (u32x2_t){cvtpk(pr[i_][0], pr[i_][1]), cvtpk(pr[i_][2], pr[i_][3])}; } } while (0)
    __syncthreads();
    MS_LOAD(0); MS_STORE(0);
    __syncthreads();
    const int q4 = (lane & 15) >> 2, p4 = lane & 3, blk = (lane >> 4) & 1;
#pragma unroll 1
    for (int t = 0; t < MS_TILES; ++t) {
        const int buf = t & 1;
        if (t + 1 < MS_TILES) MS_LOAD(t + 1);
        const LAS unsigned char* kb_ = lds + buf * KBYTES;
        f32x16 st[2];
#pragma unroll
        for (int kb = 0; kb < 2; ++kb) {
#pragma unroll
            for (int i = 0; i < 16; ++i) st[kb][i] = 0.f;
#pragma unroll
            for (int g_ = 0; g_ < 5; ++g_) { bf16x8 kf[4];
#pragma unroll
                for (int j = 0; j < 4; ++j) kf[j] = *(const LAS bf16x8*)(kb_ + ((32 * kb + l31) * KP + 16 * (4 * g_ + j) + 8 * hh) * 2);
#pragma unroll
                for (int j = 0; j < 4; ++j) st[kb] = MFMA32(kf[j], qf[4 * g_ + j], st[kb]);
                __builtin_amdgcn_sched_barrier(0); }
        }
        float mx = -INFINITY;
#pragma unroll
        for (int kb = 0; kb < 2; ++kb)
#pragma unroll
            for (int i = 0; i < 16; ++i) { const float v = st[kb][i] * c2; st[kb][i] = v; mx = fmaxf(mx, v); }
        mx = fmaxf(mx, __shfl_xor(mx, 32));
        const float mn = fmaxf(m, mx);
        const float alpha = __builtin_amdgcn_exp2f(m - mn);
        m = mn;
        float ps = 0.f;
#pragma unroll
        for (int kb = 0; kb < 2; ++kb)
#pragma unroll
            for (int i = 0; i < 16; ++i) { const float p = __builtin_amdgcn_exp2f(st[kb][i] - mn); st[kb][i] = p; ps += p; }
        lsum = lsum * alpha + ps;
#pragma unroll
        for (int i = 0; i < 16; ++i) o[i] *= alpha;
        bf16x8 vf[4];
#pragma unroll
        for (int ks = 0; ks < 4; ++ks) { const LAS unsigned char* a_ = kb_ + ((16 * ks + 4 * hh + q4) * KP + 32 * w + 16 * blk + 4 * p4) * 2;
            const s16x4 lo = vtr(a_), hi = vtr(a_ + 8 * KP * 2);
            vf[ks] = __builtin_shufflevector(lo, hi, 0, 1, 2, 3, 4, 5, 6, 7); }
#pragma unroll
        for (int ks = 0; ks < 4; ++ks) { const int kb = ks >> 1, s2 = ks & 1; u32x4_t pk;
            pk.x = cvtpk(st[kb][8 * s2 + 0], st[kb][8 * s2 + 1]); pk.y = cvtpk(st[kb][8 * s2 + 2], st[kb][8 * s2 + 3]);
            pk.z = cvtpk(st[kb][8 * s2 + 4], st[kb][8 * s2 + 5]); pk.w = cvtpk(st[kb][8 * s2 + 6], st[kb][8 * s2 + 7]);
            o = MFMA32(vf[ks], __builtin_bit_cast(bf16x8, pk), o); }
        if (t + 1 < MS_TILES) MS_STORE(buf ^ 1);
        __syncthreads();
    }
#undef MS_LOAD
#undef MS_STORE
    lsum += __shfl_xor(lsum, 32);
    const int item = b * MS_NSPLIT + split;
    if (w == 0 && lane < 32) { PML[(item * 32 + lane) * 2] = m; PML[(item * 32 + lane) * 2 + 1] = lsum; }
#pragma unroll
    for (int i = 0; i < 16; ++i) PO[((size_t)item * 32 + l31) * KVL + 32 * w + crow(i, hh)] = o[i];
}

struct QPtr { const float* p; DI float operator()(int d) const { return p[d]; } };
struct QMla { const float* ql; const float* qp; DI float operator()(int d) const { return d < KVL ? ql[d] : qp[d - KVL]; } };
DI void rms_row(const float* x, const float* g, float* o, int n, int lane) {
    float s = 0.f;
    for (int i = lane; i < n; i += 64) { const float v = x[i]; s += v * v; }
    const float r = rsqrtf(wave_sum(s) / (float)n + EPS);
    for (int i = lane; i < n; i += 64) o[i] = x[i] * r * g[i];
}

DI void rms_row_bf16(const float* x, const float* g, bf16_t* o, int n, int lane) {
    float s = 0.f;
    for (int i = lane; i < n; i += 64) { const float v = x[i]; s += v * v; }
    const float r = rsqrtf(wave_sum(s) / (float)n + EPS);
    for (int i = lane; i < n; i += 64) o[i] = f2bf(x[i] * r * g[i]);
}
#define GEMM_PHASE(EPI, ...) pg8::gemm_phase<EPI, pg8::StaticOrder, true, true>(__VA_ARGS__)
__global__ void __launch_bounds__(NTHREADS, 2) fwd_kernel(Args args) {
    extern __shared__ __attribute__((aligned(16))) unsigned char lds_raw[];
    LAS unsigned char* ldsb = (LAS unsigned char*)lds_raw;
    LAS float* lds = (LAS float*)ldsb;
    volatile LAS unsigned* MISC = (volatile LAS unsigned*)(ldsb + MISC_OFF);
    const int tid = threadIdx.x, lane = tid & 63, wave = tid >> 6;
    const int G = gridDim.x, bid = blockIdx.x;
    const int gw = bid * NWAVES + wave, NGW = G * NWAVES;
    unsigned char* ws = args.ws;
    float* out = args.out;
    const int lo = args.ph_lo, hi = args.ph_hi;

    if (tid < 64) MISC[tid] = 0u;
    __syncthreads();
    XcdBarrier bar; bar.bar = (unsigned*)(ws + WS_CTL) + CW_BAR; bar.x = 0; bar.st = MISC;
    if (hi - lo > 1) bar = xcd_barrier_post((unsigned*)(ws + WS_CTL) + CW_BAR, MISC);
#define IN(k) (lo <= (k) && (k) < hi)
#define SEAM(k) do { if (IN(k) && IN((k) + 1)) xcd_barrier(bar); } while (0)

    const float* x_prompt = args.in[0]; const float* x_sample = args.in[1]; const float* mem_prompt = args.in[2];
    const float* cache_ckv = args.in[3]; const float* cache_kpe = args.in[4]; const int* page_table = (const int*)args.in[5];
    const float* state_ret = args.in[6]; const float* cache_mem_k = args.in[7]; const float* cache_mem_v = args.in[8];
    const float* g_mix_pre = args.in[9]; const float* g_mix_post = args.in[10]; const float* g_ffn_pre = args.in[11]; const float* g_ffn_post = args.in[12];
    const float* g_mem = args.in[13]; const float* g_qlat = args.in[14]; const float* g_kvlat = args.in[15];
    const float* w_in = args.in[16]; const float* w_uq = args.in[17]; const float* w_uk = args.in[18]; const float* w_uv = args.in[19];
    const float* w_mem_k = args.in[20]; const float* w_mem_v = args.in[21]; const float* w_ret_o = args.in[22]; const float* w_mla_o = args.in[23];
    const float* w_x_o = args.in[24]; const float* w_out = args.in[25]; const float* w_gate = args.in[26]; const float* w_up = args.in[27]; const float* w_down = args.in[28];
    float* COSA = (float*)(ws + WS_COSA); float* SINA = (float*)(ws + WS_SINA); float* COSB = (float*)(ws + WS_COSB); float* SINB = (float*)(ws + WS_SINB);
    float* U = (float*)(ws + WS_U); float* MN = (float*)(ws + WS_MN); float* Z = (float*)(ws + WS_Z);
    float* RQ = (float*)(ws + WS_RQ); float* RK = (float*)(ws + WS_RK); float* CQN = (float*)(ws + WS_CQN); float* CKVN = (float*)(ws + WS_CKVN); float* KPER = (float*)(ws + WS_KPER);
    float* Q = (float*)(ws + WS_Q); float* QLAT = (float*)(ws + WS_QLAT); float* QPE = (float*)(ws + WS_QPE);
    float* ORET = (float*)(ws + WS_ORET); float* OLAT = (float*)(ws + WS_OLAT); float* OX = (float*)(ws + WS_OX); float* OMLA = (float*)(ws + WS_OMLA); float* ORETN = (float*)(ws + WS_ORETN);
    float* ARET = (float*)(ws + WS_ARET); float* AMLA = (float*)(ws + WS_AMLA); float* AX = (float*)(ws + WS_AX); float* MIX = (float*)(ws + WS_MIX);
    float* HP = (float*)(ws + WS_HP); float* H = (float*)(ws + WS_H); float* F = (float*)(ws + WS_F);
    float* GU = (float*)(ws + WS_GG); float* FO = (float*)(ws + WS_FO);
    bf16_t* WinT = (bf16_t*)(ws + WS_WIN_T); bf16_t* WmkvT = (bf16_t*)(ws + WS_WMKV_T); bf16_t* WuqT = (bf16_t*)(ws + WS_WUQ_T); bf16_t* WroT = (bf16_t*)(ws + WS_WRO_T);
    bf16_t* WmoT = (bf16_t*)(ws + WS_WMO_T); bf16_t* WxoT = (bf16_t*)(ws + WS_WXO_T); bf16_t* WoT = (bf16_t*)(ws + WS_WO_T); bf16_t* WguT = (bf16_t*)(ws + WS_WGU_T); bf16_t* WdT = (bf16_t*)(ws + WS_WD_T);
    bf16_t* Ub = (bf16_t*)(ws + WS_UB); bf16_t* MNb = (bf16_t*)(ws + WS_MNB); bf16_t* CQNb = (bf16_t*)(ws + WS_CQNB); bf16_t* ORETNb = (bf16_t*)(ws + WS_ORETNB);
    bf16_t* OMLAb = (bf16_t*)(ws + WS_OMLAB); bf16_t* OXb = (bf16_t*)(ws + WS_OXB); bf16_t* MIXb = (bf16_t*)(ws + WS_MIXB); bf16_t* Fb = (bf16_t*)(ws + WS_FB); bf16_t* ACTb = (bf16_t*)(ws + WS_ACTB);
    bf16_t* WukT = (bf16_t*)(ws + WS_WUK_T); bf16_t* WuvT = (bf16_t*)(ws + WS_WUV_T); bf16_t* CKVNb = (bf16_t*)(ws + WS_CKVNB); bf16_t* KPERb = (bf16_t*)(ws + WS_KPERB);
    bf16_t* XQb = (bf16_t*)(ws + WS_XQB); bf16_t* MKb = (bf16_t*)(ws + WS_MKB); bf16_t* MVT = (bf16_t*)(ws + WS_MVT); bf16_t* KN = (bf16_t*)(ws + WS_KN); bf16_t* VT = (bf16_t*)(ws + WS_VT); bf16_t* Qb = (bf16_t*)(ws + WS_QB);
    bf16_t* RQt = (bf16_t*)(ws + WS_RQT); bf16_t* RKt = (bf16_t*)(ws + WS_RKT); bf16_t* RKtT = (bf16_t*)(ws + WS_RKTT); bf16_t* RVT = (bf16_t*)(ws + WS_RVT);
    float* UT = (float*)(ws + WS_UT); bf16_t* SPT = (bf16_t*)(ws + WS_SPT);
    bf16_t* QLATb = (bf16_t*)(ws + WS_QLATB); float* PO = (float*)(ws + WS_PO); float* PML = (float*)(ws + WS_PML);

    if (IN(0)) {
        for (int i = bid * NTHREADS + tid; i < NPOS * 64 + NPOS * 32; i += G * NTHREADS) {
            const bool a = i < NPOS * 64; const int j = a ? i : i - NPOS * 64; const int half = a ? 64 : 32;
            const int p = j / half, f = j % half; const int pos = p < SEQ ? p : PAST + (p - SEQ);
            const float inv = powf(10000.0f, -(float)f / (float)half);
            const float ang = (float)pos * inv;
            double rev = (double)ang * 0.15915494309189535; rev -= floor(rev);
            const float r = (float)rev;
            const float sn = __builtin_amdgcn_sinf(r), cs = __builtin_amdgcn_cosf(r);
            if (a) { COSA[j] = cs; SINA[j] = sn; } else { COSB[j] = cs; SINB[j] = sn; }
        }
        for (int row = gw; row < NT; row += NGW) {
            const float* xr = row < NP ? x_prompt + (size_t)row * DM : x_sample + (size_t)(row - NP) * DM;
            rms_row_bf16(xr, g_mix_pre, Ub + (size_t)row * DM, DM, lane);
        }
        for (int row = gw; row < NB * NMEM; row += NGW) rms_row_bf16(mem_prompt + (size_t)row * DM, g_mem, MNb + (size_t)row * DM, DM, lane);
        {
            LAS float* scr = lds + wave * (64 * 33);
            int rot = 0;
            transpose_w(w_in, 1024, DIN, WinT, 1024, 0, scr, gw, NGW, lane, rot);
            for (int i = bid * NTHREADS + tid; i < (ZLD - DIN) * 1024 / 2; i += G * NTHREADS) ((unsigned*)(WinT + (size_t)DIN * 1024))[i] = 0u;
            transpose_w(w_mem_k, 1024, 256, WmkvT, 1024, 0, scr, gw, NGW, lane, rot);
            transpose_w(w_mem_v, 1024, 256, WmkvT, 1024, 256, scr, gw, NGW, lane, rot);
            transpose_w(w_uq, QL, 1536, WuqT, QL, 0, scr, gw, NGW, lane, rot);
            transpose_w(w_ret_o, 1024, 1024, WroT, 1024, 0, scr, gw, NGW, lane, rot);
            transpose_w(w_mla_o, 1024, 1024, WmoT, 1024, 0, scr, gw, NGW, lane, rot);
            transpose_w(w_x_o, 256, 1024, WxoT, 256, 0, scr, gw, NGW, lane, rot);
            transpose_w(w_out, 1024, 1024, WoT, 1024, 0, scr, gw, NGW, lane, rot);
            transpose_w(w_gate, 1024, DFF, WguT, 1024, 0, scr, gw, NGW, lane, rot, 2);
            transpose_w(w_up, 1024, DFF, WguT, 1024, 1, scr, gw, NGW, lane, rot, 2);
            transpose_w(w_down, DFF, 1024, WdT, DFF, 0, scr, gw, NGW, lane, rot);
            for (int hh = 0; hh < MH; ++hh) { transpose_w(w_uk + (size_t)hh * KVL * DNOPE, KVL, DNOPE, WukT, KVL, hh * DNOPE, scr, gw, NGW, lane, rot);
                                              transpose_w(w_uv + (size_t)hh * KVL * DVH, KVL, DVH, WuvT, KVL, hh * DVH, scr, gw, NGW, lane, rot); }
        }
    }
    SEAM(0);
    if (IN(1)) {
        { pg8::Gemm g{Ub, WinT, NT, ZLD, 1024, 1024, 1024}; pg8::StaticOrder S; S.init(NT, ZLD, G, bid); pg8::EpiF32S E{Z, ZLD, 0, 0};
          GEMM_PHASE(pg8::EpiF32S, ldsb, g, S, E); }
        __syncthreads();
        { pg8::Gemm g{MNb, WmkvT, NB * NMEM, 512, 1024, 1024, 1024}; pg8::StaticOrder S; S.init(NB * NMEM, 512, G, bid); pg8::EpiF32S E{out + O_MKP, 256, 1, O_MVP - O_MKP};
          GEMM_PHASE(pg8::EpiF32S, ldsb, g, S, E); }
        __syncthreads();
        { pg8::Gemm g{WinT + (size_t)C_RV * 1024, Ub, 1024, NT, 1024, 1024, 1024}; pg8::StaticOrder S; S.init(1024, NT, G, bid); pg8::EpiBf16S E{RVT, NT};
          GEMM_PHASE(pg8::EpiBf16S, ldsb, g, S, E); }
    }
    SEAM(1);
    if (IN(2)) {
        constexpr int KTP = 520;
        LAS bf16_t* Kt = (LAS bf16_t*)ldsb;
        const int ntile = NP / 64, nwork = ntile + (NS + 63) / 64;
        for (int wk = bid; wk < nwork; wk += G) {
            const bool prompt = wk < ntile; const int row_base = prompt ? wk * 64 : NP + (wk - ntile) * 64;
            __syncthreads();
            for (int r = wave; r < 64; r += NWAVES) {
                const int row = row_base + r;
                const float* z = Z + (size_t)row * ZLD; const int p = pos_index(row);
                const float ca = COSA[p * 64 + lane], sa = SINA[p * 64 + lane];
                const int il = p & 127;
#pragma unroll
                for (int h = 0; h < RH; ++h) {
                    float x1 = z[C_RQ + h * RDK + lane], x2 = z[C_RQ + h * RDK + 64 + lane];
                    const float q1 = x1 * ca - x2 * sa, q2 = x1 * sa + x2 * ca;
                    x1 = z[C_RK + h * RDK + lane]; x2 = z[C_RK + h * RDK + 64 + lane];
                    const float sc = 0.08838834764831845f;
                    const float k1 = (x1 * ca - x2 * sa) * sc, k2 = (x1 * sa + x2 * ca) * sc;
                    if (prompt) {
                        const float lg = lg_gamma(h), fq = expf((float)(il - 127) * lg), fk = expf((float)(127 - il) * lg);
                        RQt[(size_t)row * 512 + h * RDK + lane] = f2bf(q1 * fq); RQt[(size_t)row * 512 + h * RDK + 64 + lane] = f2bf(q2 * fq);
                        const bf16_t kb1 = f2bf(k1 * fk), kb2 = f2bf(k2 * fk);
                        RKt[(size_t)row * 512 + h * RDK + lane] = kb1; RKt[(size_t)row * 512 + h * RDK + 64 + lane] = kb2;
                        Kt[r * KTP + h * RDK + lane] = kb1; Kt[r * KTP + h * RDK + 64 + lane] = kb2;
                    } else {
                        RQ[(size_t)row * 512 + h * RDK + lane] = q1; RQ[(size_t)row * 512 + h * RDK + 64 + lane] = q2;
                        RK[(size_t)row * 512 + h * RDK + lane] = k1; RK[(size_t)row * 512 + h * RDK + 64 + lane] = k2;
                    }
                }
                rms_row_bf16(z + C_CQ, g_qlat, CQNb + (size_t)row * QL, QL, lane);
                rms_row(z + C_CKV, g_kvlat, CKVN + (size_t)row * KVL, KVL, lane);
                float* ockv = row < NP ? out + O_CKVP + (size_t)row * KVL : out + O_CKVS + (size_t)(row - NP) * KVL;
                for (int i = lane; i < KVL; i += 64) { const float v = CKVN[(size_t)row * KVL + i]; ockv[i] = v; CKVNb[(size_t)row * KVL + i] = f2bf(v); }
                for (int i = lane; i < 256; i += 64) XQb[(size_t)row * 256 + i] = f2bf(z[C_XQ + i]);
                if (lane < 32) {
                    const float cb = COSB[p * 32 + lane], sb = SINB[p * 32 + lane];
                    const float x1 = z[C_KPE + lane], x2 = z[C_KPE + 32 + lane];
                    const float o1 = x1 * cb - x2 * sb, o2 = x1 * sb + x2 * cb;
                    KPER[(size_t)row * DROPE + lane] = o1; KPER[(size_t)row * DROPE + 32 + lane] = o2;
                    float* okpe = row < NP ? out + O_KPEP + (size_t)row * DROPE : out + O_KPES + (size_t)(row - NP) * DROPE;
                    okpe[lane] = o1; okpe[32 + lane] = o2;
                    KPERb[(size_t)row * DROPE + lane] = f2bf(o1); KPERb[(size_t)row * DROPE + 32 + lane] = f2bf(o2);
                }
            }
            __syncthreads();
            if (prompt) {
#pragma unroll 2
                for (int i = 0; i < 8; ++i) { const int pc = tid + i * NTHREADS, f = pc >> 3, k8 = pc & 7;
                    const LAS bf16_t* c = Kt + (8 * k8) * KTP + f;
                    pg8::u32x4 o; o.x = (unsigned)c[0] | ((unsigned)c[KTP] << 16); o.y = (unsigned)c[2 * KTP] | ((unsigned)c[3 * KTP] << 16);
                    o.z = (unsigned)c[4 * KTP] | ((unsigned)c[5 * KTP] << 16); o.w = (unsigned)c[6 * KTP] | ((unsigned)c[7 * KTP] << 16);
                    *(pg8::u32x4*)(RKtT + (size_t)f * NP + row_base + 8 * k8) = o; }
            }
        }
    }
    if (IN(2)) {
        for (int i = bid * NTHREADS + tid; i < NB * NMEM * 256; i += G * NTHREADS) { MKb[i] = f2bf(out[O_MKP + i]);
            const int f = i / (NB * NMEM), r = i - f * (NB * NMEM); MVT[i] = f2bf(out[O_MVP + (size_t)r * 256 + f]); }
    }
    SEAM(2);
    if (IN(3)) { pg8::Gemm g{CQNb, WuqT, NT, 1536, QL, QL, QL}; pg8::StaticOrder S; S.init(NT, 1536, G, bid); pg8::EpiF32S E{Q, 1536, 0, 0};
        GEMM_PHASE(pg8::EpiF32S, ldsb, g, S, E);
        __syncthreads();
        { pg8::Gemm g2{CKVNb, WukT, NP, 1024, KVL, KVL, KVL}; pg8::StaticOrder S2; S2.init(NP, 1024, G, bid); pg8::EpiBf16S E2{KN, 1024}; GEMM_PHASE(pg8::EpiBf16S, ldsb, g2, S2, E2); }
        __syncthreads();
        { pg8::Gemm g3{WuvT, CKVNb, 1024, NP, KVL, KVL, KVL}; pg8::StaticOrder S3; S3.init(1024, NP, G, bid); pg8::EpiBf16S E3{VT, NP}; GEMM_PHASE(pg8::EpiBf16S, ldsb, g3, S3, E3); }
        for (int it = bid; it < NB * RH * 16; it += G) { const int c = __builtin_amdgcn_readfirstlane(it & 15), h = __builtin_amdgcn_readfirstlane((it >> 4) & 3), b = __builtin_amdgcn_readfirstlane(it >> 6);
            ret_chunk_state(RVT, RKtT, UT, b, h, c); } }
    SEAM(3);
    if (IN(4)) {
        for (int idx = bid * NTHREADS + tid; idx < NB * RH * 32768; idx += G * NTHREADS) {
            const int bh = idx >> 15, e = idx & 32767; const float g128 = expf(128.f * lg_gamma(bh & 3));
            float sp = 0.f, S = 0.f;
#pragma unroll 4
            for (int c = 0; c < 16; ++c) { const size_t o_ = (size_t)(bh * 16 + c) * 32768 + e; SPT[o_] = f2bf(sp); S = sp + UT[o_]; sp = g128 * S; }
            out[O_RETP + (size_t)bh * 32768 + (size_t)(e & 127) * RDV + (e >> 7)] = S;
        }
        for (int h = 0; h < MH; ++h)
            sgemm_naive(lds, Q + (size_t)NP * 1536 + h * DQH, 1536, w_uk + (size_t)h * KVL * DNOPE, 1, DNOPE, nullptr, MH * KVL, NS, KVL, DNOPE, bid, G, QLATb + h * KVL);
        for (int row = gw; row < NT; row += NGW) {
            const int p = pos_index(row);
            for (int i = lane; i < 1536; i += 64) { const int hh = i / DQH, d = i - hh * DQH; if (d < DNOPE) Qb[(size_t)row * 1536 + i] = f2bf(Q[(size_t)row * 1536 + i]); }
#pragma unroll
            for (int c = 0; c < 4; ++c) { const int idx = lane + 64 * c, h = idx >> 5, f = idx & 31;
                const float cb = COSB[p * 32 + f], sb = SINB[p * 32 + f];
                const float x1 = Q[(size_t)row * 1536 + h * DQH + DNOPE + f], x2 = Q[(size_t)row * 1536 + h * DQH + DNOPE + 32 + f];
                const float o1 = x1 * cb - x2 * sb, o2 = x1 * sb + x2 * cb;
                QPE[(size_t)row * 512 + h * 64 + f] = o1; QPE[(size_t)row * 512 + h * 64 + 32 + f] = o2;
                Qb[(size_t)row * 1536 + h * DQH + DNOPE + f] = f2bf(o1); Qb[(size_t)row * 1536 + h * DQH + DNOPE + 32 + f] = f2bf(o2); }
        }
    }
    SEAM(4);
    if (IN(5)) {
        if (args.sub & 1) for (int it = bid; it < DB * MS_NSPLIT; it += G) { const int split = __builtin_amdgcn_readfirstlane(it % MS_NSPLIT), b = __builtin_amdgcn_readfirstlane(it / MS_NSPLIT);
            mla_sample_unit(ldsb, cache_ckv, cache_kpe, page_table, QLATb, Qb, PO, PML, b, split, 0.07216878364870322f * 1.4426950408889634f); }
        if (args.sub & 2) for (int it = bid; it < NB * MH * 4; it += G) {
            const int pr = __builtin_amdgcn_readfirstlane(it & 3), hh = __builtin_amdgcn_readfirstlane((it >> 2) & 7), b = __builtin_amdgcn_readfirstlane(it >> 5);
            SrcMlaP src{KN, KPERb, VT, b, hh};
#pragma unroll 1
            for (int half = 0; half < 2; ++half) { const int qb = __builtin_amdgcn_readfirstlane(half ? pr : 7 - pr); const size_t row0 = (size_t)b * SEQ + qb * 256;
                flash_unit<192, 128, true>(ldsb, src, Qb + row0 * 1536 + hh * DQH, 1536, qb * 256, 4 * (qb + 1), OMLAb + row0 * 1024 + hh * DVH, 1024, 0.07216878364870322f * 1.4426950408889634f); }
        }
        if (args.sub & 4) for (int it = bid; it < NB * RH * 16; it += G) { const int c = __builtin_amdgcn_readfirstlane(it & 15), h = __builtin_amdgcn_readfirstlane((it >> 4) & 3), b = __builtin_amdgcn_readfirstlane(it >> 6);
            ret_chunk_out(RQt, RKt, RVT, SPT, ORET, b, h, c); }
        if (args.sub & 8) for (int it = bid; it < DB * RH; it += G) {
            const int h = it & 3, b = it >> 2; const float lg = lg_gamma(h);
            const float* s0 = state_ret + (size_t)it * RDK * RDV;
            LAS float* inner = lds;
            LAS float* qk = lds + 16;
            __syncthreads();
            for (int i = tid; i < 1024; i += NTHREADS) { const int which = i >> 9, ti = (i >> 7) & 3, d = i & 127; const size_t row = (size_t)NP + b * DS + ti;
                qk[i] = which ? RK[row * 512 + h * RDK + d] : RQ[row * 512 + h * RDK + d]; }
            __syncthreads();
            for (int pr = wave; pr < 16; pr += NWAVES) { const int i = pr >> 2, j = pr & 3;
                float s = qk[i * 128 + lane] * qk[512 + j * 128 + lane] + qk[i * 128 + 64 + lane] * qk[512 + j * 128 + 64 + lane];
                s = wave_sum(s);
                if (lane == 0) inner[pr] = (j <= i) ? s * expf((float)(i - j) * lg) : 0.f; }
            __syncthreads();
            {
                const int e = tid & 255, i0 = (tid >> 8) * 2;
                float o0 = 0.f, o1 = 0.f;
                for (int d = 0; d < RDK; ++d) { const float sv = s0[(size_t)d * RDV + e]; o0 += qk[i0 * 128 + d] * sv; o1 += qk[(i0 + 1) * 128 + d] * sv; }
                o0 *= expf((float)(i0 + 1) * lg); o1 *= expf((float)(i0 + 2) * lg);
#pragma unroll
                for (int j = 0; j < DS; ++j) { const float v = Z[((size_t)NP + b * DS + j) * ZLD + C_RV + h * RDV + e]; o0 += inner[i0 * 4 + j] * v; o1 += inner[(i0 + 1) * 4 + j] * v; }
                ORET[((size_t)NP + b * DS + i0) * 1024 + h * RDV + e] = o0; ORET[((size_t)NP + b * DS + i0 + 1) * 1024 + h * RDV + e] = o1;
            }
            {
                const float g4 = expf(4.f * lg);
                float* so = out + O_RETS + (size_t)it * RDK * RDV;
                for (int i = tid; i < RDK * RDV; i += NTHREADS) { const int d = i >> 8, e = i & 255; float a = s0[i] * g4;
#pragma unroll
                    for (int j = 0; j < DS; ++j) a += expf((float)(3 - j) * lg) * qk[512 + j * 128 + d] * Z[((size_t)NP + b * DS + j) * ZLD + C_RV + h * RDV + e];
                    so[i] = a; }
            }
        }
        if (args.sub & 16) for (int it = bid; it < NB * XH * 8; it += G) {
            const int qb = __builtin_amdgcn_readfirstlane(it & 7), hh = __builtin_amdgcn_readfirstlane((it >> 3) & 3), b = __builtin_amdgcn_readfirstlane(it >> 5); const size_t row0 = (size_t)b * SEQ + qb * 256;
            SrcMemP src{MKb, MVT, b, hh};
            flash_unit<64, 64, false>(ldsb, src, XQb + row0 * 256 + hh * XHD, 256, 0, 4, OXb + row0 * 256 + hh * XHD, 256, 0.125f * 1.4426950408889634f);
        }
        if (args.sub & 32) for (int it = bid; it < DB * XH; it += G) {
            const int h = it & 3, b = it >> 2; const size_t row = (size_t)NP + b * DS + (wave & 3);
            KvMem kv{cache_mem_k, cache_mem_v, b, h};
            attn_naive<64, 64, false, 0>(lds, kv, NMEM, QPtr{Z + row * ZLD + C_XQ + h * XHD}, wave < 4, NMEM, 0.125f, 0.f, 0, OX + row * 256 + h * XHD);
        }
    }
    SEAM(5);
    if (IN(6)) {
        for (int b = bid; b < DB; b += G) {
            const int head = wave; const float c2 = 0.07216878364870322f * 1.4426950408889634f;
            LAS float* ol = lds + wave * KVL;
            for (int t = 0; t < DS; ++t) {
                const int qi = t * 8 + head; const size_t qrow = (size_t)b * DS + t;
                float qv[5];
#pragma unroll
                for (int c = 0; c < 5; ++c) { const int d = lane + 64 * c; const bf16_t raw = d < KVL ? QLATb[qrow * 2048 + head * KVL + d] : Qb[(NP + qrow) * 1536 + head * DQH + DNOPE + (d - KVL)];
                    qv[c] = __builtin_bit_cast(float, (unsigned)raw << 16); }
                float sc[DS]; float M = -INFINITY;
#pragma unroll
                for (int j = 0; j < DS; ++j) { const size_t krow = (size_t)NP + b * DS + j; float a = 0.f;
#pragma unroll
                    for (int c = 0; c < 5; ++c) { const int d = lane + 64 * c; a += qv[c] * (d < KVL ? CKVN[krow * KVL + d] : KPER[krow * DROPE + (d - KVL)]); }
                    a = wave_sum(a) * c2; sc[j] = (j <= t) ? a : -INFINITY; M = fmaxf(M, sc[j]); }
                float ms[MS_NSPLIT], ls[MS_NSPLIT];
#pragma unroll
                for (int sp = 0; sp < MS_NSPLIT; ++sp) { const int item = b * MS_NSPLIT + sp; ms[sp] = PML[(item * 32 + qi) * 2]; ls[sp] = PML[(item * 32 + qi) * 2 + 1]; M = fmaxf(M, ms[sp]); }
                float L = 0.f; float acc[4] = {0.f, 0.f, 0.f, 0.f};
#pragma unroll
                for (int sp = 0; sp < MS_NSPLIT; ++sp) { const int item = b * MS_NSPLIT + sp; const float wgt = __builtin_amdgcn_exp2f(ms[sp] - M); L += ls[sp] * wgt;
#pragma unroll
                    for (int c = 0; c < 4; ++c) acc[c] += wgt * PO[((size_t)item * 32 + qi) * KVL + lane + 64 * c]; }
#pragma unroll
                for (int j = 0; j < DS; ++j) { const float wgt = __builtin_amdgcn_exp2f(sc[j] - M); L += wgt; const size_t krow = (size_t)NP + b * DS + j;
#pragma unroll
                    for (int c = 0; c < 4; ++c) acc[c] += wgt * CKVN[krow * KVL + lane + 64 * c]; }
                const float inv = 1.f / L;
#pragma unroll
                for (int c = 0; c < 4; ++c) ol[lane + 64 * c] = acc[c] * inv;
                __syncthreads();
                float a0 = 0.f, a1 = 0.f; const float* wv = w_uv + (size_t)head * KVL * DVH;
#pragma unroll 8
                for (int l = 0; l < KVL; ++l) { const float x = ol[l]; a0 += x * wv[(size_t)l * DVH + lane]; a1 += x * wv[(size_t)l * DVH + 64 + lane]; }
                OMLAb[((size_t)NP + qrow) * 1024 + head * DVH + lane] = f2bf(a0); OMLAb[((size_t)NP + qrow) * 1024 + head * DVH + 64 + lane] = f2bf(a1);
                __syncthreads();
            }
        }
        for (size_t i = (size_t)bid * NTHREADS + tid; i < (size_t)NS * 256; i += (size_t)G * NTHREADS) OXb[(size_t)NP * 256 + i] = f2bf(OX[(size_t)NP * 256 + i]);
        {
            f32x4 a[4], gz[4];
#define P6_LOAD(r_, A_, B_) do { _Pragma("unroll") for (int j_ = 0; j_ < 4; ++j_) { A_[j_] = *(const f32x4*)(ORET + (size_t)(r_) * 1024 + 4 * lane + 256 * j_); \
                                                                              B_[j_] = *(const f32x4*)(Z + (size_t)(r_) * ZLD + C_RG + 4 * lane + 256 * j_); } } while (0)
            int row = gw;
            if (row < NT) P6_LOAD(row, a, gz);
            for (; row < NT; row += NGW) {
                f32x4 an[4], gn[4]; const int nr = row + NGW;
                if (nr < NT) P6_LOAD(nr, an, gn);
#pragma unroll
                for (int j = 0; j < 4; ++j) {
                    const float ss = wave_sum(a[j][0] * a[j][0] + a[j][1] * a[j][1] + a[j][2] * a[j][2] + a[j][3] * a[j][3]);
                    const float r = rsqrtf(ss * (1.f / RDV) + EPS);
                    float o_[4];
#pragma unroll
                    for (int e = 0; e < 4; ++e) o_[e] = gz[j][e] / (1.f + __expf(-gz[j][e])) * a[j][e] * r;
                    *(u32x2_t*)(ORETNb + (size_t)row * 1024 + 4 * lane + 256 * j) = (u32x2_t){cvtpk(o_[0], o_[1]), cvtpk(o_[2], o_[3])};
                }
#pragma unroll
                for (int j = 0; j < 4; ++j) { a[j] = an[j]; gz[j] = gn[j]; }
            }
#undef P6_LOAD
        }
    }
    SEAM(6);
    if (IN(7)) {
        pg8::StaticOrder S; S.init(NT, 1024, G, bid);
        { pg8::Gemm g{ORETNb, WroT, NT, 1024, 1024, 1024, 1024}; pg8::EpiGate<0> E{Z + C_G, ZLD, ARET, MIXb, 1024}; GEMM_PHASE(pg8::EpiGate<0>, ldsb, g, S, E); }
        __syncthreads();
        { pg8::Gemm g{OMLAb, WmoT, NT, 1024, 1024, 1024, 1024}; pg8::EpiGate<1> E{Z + C_G + 1024, ZLD, ARET, MIXb, 1024}; GEMM_PHASE(pg8::EpiGate<1>, ldsb, g, S, E); }
        __syncthreads();
        { pg8::Gemm g{OXb, WxoT, NT, 1024, 256, 256, 256}; pg8::EpiGate<2> E{Z + C_G + 2048, ZLD, ARET, MIXb, 1024}; GEMM_PHASE(pg8::EpiGate<2>, ldsb, g, S, E); }
    }
    SEAM(7);
    SEAM(8);
    if (IN(9)) { pg8::Gemm g{MIXb, WoT, NT, 1024, 1024, 1024, 1024}; pg8::StaticOrder S; S.init(NT, 1024, G, bid); pg8::EpiF32S E{HP, 1024, 0, 0};
        GEMM_PHASE(pg8::EpiF32S, ldsb, g, S, E); }
    SEAM(9);
    if (IN(10)) {
        f32x4 gp[4], gf[4], a[4], b[4];
#pragma unroll
        for (int j = 0; j < 4; ++j) { gp[j] = *(const f32x4*)(g_mix_post + 4 * lane + 256 * j); gf[j] = *(const f32x4*)(g_ffn_pre + 4 * lane + 256 * j); }
#define P10_LOAD(r_, A_, B_) do { const float* xr_ = (r_) < NP ? x_prompt + (size_t)(r_) * DM : x_sample + (size_t)((r_) - NP) * DM; \
        _Pragma("unroll") for (int j_ = 0; j_ < 4; ++j_) { A_[j_] = *(const f32x4*)(HP + (size_t)(r_) * DM + 4 * lane + 256 * j_); B_[j_] = *(const f32x4*)(xr_ + 4 * lane + 256 * j_); } } while (0)
        int row = gw;
        if (row < NT) P10_LOAD(row, a, b);
        for (; row < NT; row += NGW) {
            f32x4 an[4], bn[4]; const int nr = row + NGW;
            if (nr < NT) P10_LOAD(nr, an, bn);
            float ss = 0.f;
#pragma unroll
            for (int j = 0; j < 4; ++j) ss += a[j][0] * a[j][0] + a[j][1] * a[j][1] + a[j][2] * a[j][2] + a[j][3] * a[j][3];
            float r = rsqrtf(wave_sum(ss) * (1.f / DM) + EPS); ss = 0.f;
#pragma unroll
            for (int j = 0; j < 4; ++j) { a[j] = b[j] + a[j] * r * gp[j]; *(f32x4*)(H + (size_t)row * DM + 4 * lane + 256 * j) = a[j];
                ss += a[j][0] * a[j][0] + a[j][1] * a[j][1] + a[j][2] * a[j][2] + a[j][3] * a[j][3]; }
            r = rsqrtf(wave_sum(ss) * (1.f / DM) + EPS);
#pragma unroll
            for (int j = 0; j < 4; ++j) { const f32x4 f_ = a[j] * r * gf[j]; *(u32x2_t*)(Fb + (size_t)row * DM + 4 * lane + 256 * j) = (u32x2_t){cvtpk(f_[0], f_[1]), cvtpk(f_[2], f_[3])}; }
#pragma unroll
            for (int j = 0; j < 4; ++j) { a[j] = an[j]; b[j] = bn[j]; }
        }
#undef P10_LOAD
    }
    SEAM(10);
    if (IN(11)) {
        pg8::Gemm g{Fb, WguT, NT, 2 * DFF, 1024, 1024, 1024}; pg8::StaticOrder S; S.init(NT, 2 * DFF, G, bid); pg8::EpiSwiGLU E{ACTb, DFF};
        GEMM_PHASE(pg8::EpiSwiGLU, ldsb, g, S, E);
    }
    SEAM(11);
    SEAM(12);
    if (IN(13)) { pg8::Gemm g{ACTb, WdT, NT, 1024, DFF, DFF, DFF}; pg8::StaticOrder S; S.init(NT, 1024, G, bid); pg8::EpiF32S E{FO, 1024, 0, 0};
        GEMM_PHASE(pg8::EpiF32S, ldsb, g, S, E); }
    SEAM(13);
    if (IN(14)) {
        f32x4 gp[4], a[4], b[4];
#pragma unroll
        for (int j = 0; j < 4; ++j) gp[j] = *(const f32x4*)(g_ffn_post + 4 * lane + 256 * j);
#define P14_LOAD(r_, A_, B_) do { _Pragma("unroll") for (int j_ = 0; j_ < 4; ++j_) { A_[j_] = *(const f32x4*)(FO + (size_t)(r_) * DM + 4 * lane + 256 * j_); B_[j_] = *(const f32x4*)(H + (size_t)(r_) * DM + 4 * lane + 256 * j_); } } while (0)
        int row = gw;
        if (row < NT) P14_LOAD(row, a, b);
        for (; row < NT; row += NGW) {
            f32x4 an[4], bn[4]; const int nr = row + NGW;
            if (nr < NT) P14_LOAD(nr, an, bn);
            float ss = 0.f;
#pragma unroll
            for (int j = 0; j < 4; ++j) ss += a[j][0] * a[j][0] + a[j][1] * a[j][1] + a[j][2] * a[j][2] + a[j][3] * a[j][3];
            const float r = rsqrtf(wave_sum(ss) * (1.f / DM) + EPS);
            float* y = row < NP ? out + O_YP + (size_t)row * DM : out + O_YS + (size_t)(row - NP) * DM;
#pragma unroll
            for (int j = 0; j < 4; ++j) *(f32x4*)(y + 4 * lane + 256 * j) = b[j] + a[j] * r * gp[j];
#pragma unroll
            for (int j = 0; j < 4; ++j) { a[j] = an[j]; b[j] = bn[j]; }
        }
#undef P14_LOAD
    }
#undef IN
#undef SEAM
}
constexpr int N_PHASES = 15;
}

extern "C" void kernel_launch(void* const* d_in, const int* in_sizes, int n_in, void* d_out, int out_size, void* d_ws, size_t ws_size, hipStream_t stream) {
    static int grid = 0;
    if (grid == 0) {
        if (n_in != 29 || (size_t)out_size != O_END || ws_size < WS_END) { fprintf(stderr, "kernel_launch: unexpected shapes: n_in %d out %d ws %zu (need %zu)\n", n_in, out_size, ws_size, (size_t)WS_END); grid = -1; return; }
        int dev = 0, cus = 0, per_cu = 0;
        if (hipGetDevice(&dev) != hipSuccess || hipDeviceGetAttribute(&cus, hipDeviceAttributeMultiprocessorCount, dev) != hipSuccess) { grid = -1; return; }
        if (hipFuncSetAttribute((const void*)fwd_kernel, hipFuncAttributeMaxDynamicSharedMemorySize, LDS_BYTES) != hipSuccess) { fprintf(stderr, "kernel_launch: hipFuncSetAttribute failed\n"); grid = -1; return; }
        if (hipOccupancyMaxActiveBlocksPerMultiprocessor(&per_cu, (const void*)fwd_kernel, NTHREADS, LDS_BYTES) != hipSuccess || per_cu < 1) { fprintf(stderr, "kernel_launch: occupancy query says %d\n", per_cu); per_cu = 1; }
        (void)hipGetLastError();
        grid = cus;
    }
    if (grid < 0) return;
    (void)hipMemsetAsync((char*)d_ws + WS_CTL, 0, CTL_BYTES, stream);
    Args a{};
    for (int i = 0; i < 29; ++i) a.in[i] = (const float*)d_in[i];
    a.out = (float*)d_out; a.ws = (unsigned char*)d_ws;
#if MK_ONE_LAUNCH
    a.ph_lo = 0; a.ph_hi = N_PHASES; a.sub = 0xff;
    hipLaunchKernelGGL(fwd_kernel, dim3(grid), dim3(NTHREADS), LDS_BYTES, stream, a);
#if PROBE_DUP >= 0
    a.ph_lo = PROBE_DUP; a.ph_hi = PROBE_DUP + 1; a.sub = PROBE_SUB;
    hipLaunchKernelGGL(fwd_kernel, dim3(grid), dim3(NTHREADS), LDS_BYTES, stream, a);
#endif
#else
    a.sub = 0xff; for (int p = 0; p < N_PHASES; ++p) { a.ph_lo = p; a.ph_hi = p + 1; hipLaunchKernelGGL(fwd_kernel, dim3(grid), dim3(NTHREADS), LDS_BYTES, stream, a); }
#endif
}
```

```cpp
#include <hip/hip_runtime.h>
#include <cstdio>
#include <cstdint>

#ifndef PROBE_DUP
#define PROBE_DUP -1
#endif
#ifndef PROBE_SUB
#define PROBE_SUB 0xff
#endif
#ifndef MK_ONE_LAUNCH
#define MK_ONE_LAUNCH 1
#endif

#define LAS __attribute__((address_space(3)))
#define GAS __attribute__((address_space(1)))
#define DI __device__ __forceinline__
typedef float f32x4 __attribute__((ext_vector_type(4)));
typedef __bf16 bf16x2_t __attribute__((ext_vector_type(2)));
typedef float f32x2_t __attribute__((ext_vector_type(2)));
DI unsigned cvtpk(float lo, float hi) { f32x2_t v = {lo, hi}; bf16x2_t b = __builtin_convertvector(v, bf16x2_t); return __builtin_bit_cast(unsigned, b); }

namespace {
constexpr int DM = 1024, NB = 8, SEQ = 2048, NP = NB * SEQ, DB = 128, DS = 4, NS = DB * DS, NT = NP + NS;
constexpr int PAST = 8192, PAGE = 128, NPAGES = PAST / PAGE;
constexpr int RH = 4, RDK = 128, RDV = 256;
constexpr int MH = 8, QL = 384, KVL = 256, DNOPE = 128, DROPE = 64, DVH = 128, DQH = DNOPE + DROPE;
constexpr int NMEM = 256, XH = 4, XHD = 64;
constexpr int DFF = 2816, DIN = 7104, ZLD = 7168;
constexpr int C_RQ = 0, C_RK = 512, C_RV = 1024, C_RG = 2048, C_CQ = 3072, C_CKV = 3456, C_KPE = 3712, C_XQ = 3776, C_G = 4032;
constexpr float EPS = 1e-6f;
constexpr int NPOS = SEQ + DS;
constexpr int NTHREADS = 512, NWAVES = 8;
constexpr int LDS_BYTES = 147456;
constexpr int MISC_OFF = 147456 - 256;

constexpr size_t O_YP = 0, O_YS = O_YP + (size_t)NP * DM, O_CKVP = O_YS + (size_t)NS * DM, O_KPEP = O_CKVP + (size_t)NP * KVL,
                 O_CKVS = O_KPEP + (size_t)NP * DROPE, O_KPES = O_CKVS + (size_t)NS * KVL, O_RETP = O_KPES + (size_t)NS * DROPE,
                 O_RETS = O_RETP + (size_t)NB * RH * RDK * RDV, O_MKP = O_RETS + (size_t)DB * RH * RDK * RDV, O_MVP = O_MKP + (size_t)NB * NMEM * 256,
                 O_END = O_MVP + (size_t)NB * NMEM * 256;

constexpr size_t al256(size_t x) { return (x + 255) & ~(size_t)255; }
constexpr size_t WS_CTL = 0, CTL_BYTES = 1u << 20;
constexpr size_t WS_COSA = WS_CTL + CTL_BYTES;
constexpr size_t WS_SINA = WS_COSA + al256((size_t)NPOS * 64 * 4);
constexpr size_t WS_COSB = WS_SINA + al256((size_t)NPOS * 64 * 4);
constexpr size_t WS_SINB = WS_COSB + al256((size_t)NPOS * 32 * 4);
constexpr size_t WS_U = WS_SINB + al256((size_t)NPOS * 32 * 4);
constexpr size_t WS_MN = WS_U + (size_t)NT * DM * 4;
constexpr size_t WS_Z = WS_MN + (size_t)NB * NMEM * DM * 4;
constexpr size_t WS_RQ = WS_Z + (size_t)NT * ZLD * 4;
constexpr size_t WS_RK = WS_RQ + (size_t)NT * 512 * 4;
constexpr size_t WS_CQN = WS_RK + (size_t)NT * 512 * 4;
constexpr size_t WS_CKVN = WS_CQN + (size_t)NT * QL * 4;
constexpr size_t WS_KPER = WS_CKVN + (size_t)NT * KVL * 4;
constexpr size_t WS_Q = WS_KPER + (size_t)NT * DROPE * 4;
constexpr size_t WS_QLAT = WS_Q + (size_t)NT * 1536 * 4;
constexpr size_t WS_QPE = WS_QLAT + (size_t)NT * 2048 * 4;
constexpr size_t WS_ORET = WS_QPE + (size_t)NT * 512 * 4;
constexpr size_t WS_OLAT = WS_ORET + (size_t)NT * 1024 * 4;
constexpr size_t WS_OX = WS_OLAT + (size_t)NT * 2048 * 4;
constexpr size_t WS_OMLA = WS_OX + (size_t)NT * 256 * 4;
constexpr size_t WS_ORETN = WS_OMLA + (size_t)NT * 1024 * 4;
constexpr size_t WS_ARET = WS_ORETN + (size_t)NT * 1024 * 4;
constexpr size_t WS_AMLA = WS_ARET + (size_t)NT * 1024 * 4;
constexpr size_t WS_AX = WS_AMLA + (size_t)NT * 1024 * 4;
constexpr size_t WS_MIX = WS_AX + (size_t)NT * 1024 * 4;
constexpr size_t WS_HP = WS_MIX + (size_t)NT * 1024 * 4;
constexpr size_t WS_H = WS_HP + (size_t)NT * 1024 * 4;
constexpr size_t WS_F = WS_H + (size_t)NT * 1024 * 4;
constexpr size_t WS_GG = WS_F + (size_t)NT * 1024 * 4;
constexpr size_t WS_UP = WS_GG + (size_t)NT * DFF * 4;
constexpr size_t WS_ACT = WS_UP + (size_t)NT * DFF * 4;
constexpr size_t WS_FO = WS_ACT + (size_t)NT * DFF * 4;
constexpr size_t WS_F32_END = WS_FO + (size_t)NT * 1024 * 4;
constexpr size_t WS_WIN_T = al256(WS_F32_END);
constexpr size_t WS_WMKV_T = WS_WIN_T + (size_t)ZLD * 1024 * 2;
constexpr size_t WS_WUQ_T = WS_WMKV_T + (size_t)512 * 1024 * 2;
constexpr size_t WS_WRO_T = WS_WUQ_T + (size_t)1536 * 384 * 2;
constexpr size_t WS_WMO_T = WS_WRO_T + (size_t)1024 * 1024 * 2;
constexpr size_t WS_WXO_T = WS_WMO_T + (size_t)1024 * 1024 * 2;
constexpr size_t WS_WO_T = WS_WXO_T + (size_t)1024 * 256 * 2;
constexpr size_t WS_WGU_T = WS_WO_T + (size_t)1024 * 1024 * 2;
constexpr size_t WS_WD_T = WS_WGU_T + (size_t)5632 * 1024 * 2;
constexpr size_t WS_UB = WS_WD_T + (size_t)1024 * 2816 * 2;
constexpr size_t WS_MNB = WS_UB + (size_t)NT * 1024 * 2;
constexpr size_t WS_CQNB = WS_MNB + (size_t)2048 * 1024 * 2;
constexpr size_t WS_ORETNB = WS_CQNB + (size_t)NT * 384 * 2;
constexpr size_t WS_OMLAB = WS_ORETNB + (size_t)NT * 1024 * 2;
constexpr size_t WS_OXB = WS_OMLAB + (size_t)NT * 1024 * 2;
constexpr size_t WS_MIXB = WS_OXB + (size_t)NT * 256 * 2;
constexpr size_t WS_FB = WS_MIXB + (size_t)NT * 1024 * 2;
constexpr size_t WS_ACTB = WS_FB + (size_t)NT * 1024 * 2;
constexpr size_t WS_WUK_T = WS_ACTB + (size_t)NT * 2816 * 2;
constexpr size_t WS_WUV_T = WS_WUK_T + (size_t)1024 * 256 * 2;
constexpr size_t WS_CKVNB = WS_WUV_T + (size_t)1024 * 256 * 2;
constexpr size_t WS_KPERB = WS_CKVNB + (size_t)NT * 256 * 2;
constexpr size_t WS_XQB = WS_KPERB + (size_t)NT * 64 * 2;
constexpr size_t WS_MKB = WS_XQB + (size_t)NT * 256 * 2;
constexpr size_t WS_MVT = WS_MKB + (size_t)2048 * 256 * 2;
constexpr size_t WS_KN = WS_MVT + (size_t)2048 * 256 * 2;
constexpr size_t WS_VT = WS_KN + (size_t)NP * 1024 * 2;
constexpr size_t WS_QB = WS_VT + (size_t)NP * 1024 * 2;
constexpr size_t WS_RQT = WS_QB + (size_t)NT * 1536 * 2;
constexpr size_t WS_RKT = WS_RQT + (size_t)NP * 512 * 2;
constexpr size_t WS_RKTT = WS_RKT + (size_t)NP * 512 * 2;
constexpr size_t WS_RVT = WS_RKTT + (size_t)NP * 512 * 2;
constexpr size_t WS_UT = WS_RVT + (size_t)NT * 1024 * 2;
constexpr size_t WS_SPT = WS_UT + (size_t)512 * 32768 * 4;
constexpr size_t WS_QLATB = WS_SPT + (size_t)512 * 32768 * 2;
constexpr size_t WS_PO = WS_QLATB + (size_t)NS * 2048 * 2;
constexpr size_t WS_PML = WS_PO + (size_t)DB * 2 * 32 * 256 * 4;
constexpr size_t WS_QPEB = al256(WS_PML + (size_t)DB * 2 * 32 * 2 * 4);
constexpr size_t WS_WUKB = WS_QPEB + (size_t)NT * 512 * 2;
constexpr size_t WS_END = WS_WUKB + (size_t)8 * 256 * 128 * 2;

constexpr int CW_BAR = 4096;

#define XB_TMO      128
#define XB_XCNT(j)  (256  + 64 * (j))
#define XB_XSUB(j)  (1280 + 64 * (j))
#define XB_XGEN(j)  (2304 + 64 * (j))
#define XB_TOP      3328
#define XB_TOPGEN   3392
#define XCD_BAR_WORDS 3456
#define XB_SPIN_CAP (1u << 25)

DI unsigned xb_ld(unsigned* p)              { return __hip_atomic_load(p, __ATOMIC_RELAXED, __HIP_MEMORY_SCOPE_AGENT); }
DI unsigned xb_add(unsigned* p, unsigned v) { return __hip_atomic_fetch_add(p, v, __ATOMIC_RELAXED, __HIP_MEMORY_SCOPE_AGENT); }
DI unsigned xb_xcc_id() { return (unsigned)__builtin_amdgcn_s_getreg((3 << 11) | 20) & 0xFu; }
#define XB_SPIN(cond, bar) do { unsigned _sp = 0; while (cond) { __builtin_amdgcn_s_sleep(1); \
    if ((++_sp & 255u) == 0u) { if (xb_ld(&(bar)[XB_TMO])) break; if (_sp > XB_SPIN_CAP) { atomicAdd(&(bar)[XB_TMO], 1u); break; } } } } while (0)

struct XcdBarrier { unsigned* bar; unsigned x; volatile LAS unsigned* st; };

DI XcdBarrier xcd_barrier_post(unsigned* bar, volatile LAS unsigned* st) {
    XcdBarrier b; b.bar = bar; b.x = xb_xcc_id(); b.st = st;
    if (threadIdx.x == 0) (void)xb_add(&bar[XB_XCNT(b.x)], 1u);
    return b;
}
DI void xcd_barrier_complete(unsigned* bar, unsigned x, unsigned& nloc, unsigned& nx) {
    const unsigned G = gridDim.x * gridDim.y * gridDim.z;
    unsigned sum, cnt, mine, sp = 0u;
    for (;;) {
        sum = 0u; cnt = 0u; mine = 0u;
#pragma unroll
        for (unsigned j = 0; j < 16; ++j) { const unsigned c = xb_ld(&bar[XB_XCNT(j)]); sum += c; cnt += (c > 0u) ? 1u : 0u; mine = (j == x) ? c : mine; }
        if (sum == G) break;
        __builtin_amdgcn_s_sleep(1);
        if ((++sp & 255u) == 0u) { if (xb_ld(&bar[XB_TMO])) break; if (sp > XB_SPIN_CAP) { atomicAdd(&bar[XB_TMO], 1u); break; } }
    }
    nloc = mine > 0u ? mine : 1u; nx = cnt > 0u ? cnt : 1u;
}
DI void xcd_barrier(const XcdBarrier& b) {
    asm volatile("s_waitcnt vmcnt(0)" ::: "memory");
    __syncthreads();
    if (threadIdx.x == 0) {
        unsigned* bar = b.bar;
        __builtin_amdgcn_s_waitcnt(0);
        unsigned nloc = b.st[0], nx = b.st[1];
        if (nloc == 0u) { xcd_barrier_complete(bar, b.x, nloc, nx); b.st[0] = nloc; b.st[1] = nx; }
        const unsigned old = xb_add(&bar[XB_XSUB(b.x)], 1u);
        const unsigned gen = old / nloc;
        if (old + 1u == (gen + 1u) * nloc) {
            __builtin_amdgcn_fence(__ATOMIC_RELEASE, "agent");
            asm volatile("s_waitcnt vmcnt(0)" ::: "memory");
            const unsigned og = xb_add(&bar[XB_TOP], 1u);
            const unsigned tg = og / nx;
            if (og + 1u == (tg + 1u) * nx) xb_add(&bar[XB_TOPGEN], 1u);
            else XB_SPIN(xb_ld(&bar[XB_TOPGEN]) == tg, bar);
            __builtin_amdgcn_fence(__ATOMIC_ACQUIRE, "agent");
            xb_add(&bar[XB_XGEN(b.x)], 1u);
            asm volatile("s_waitcnt vmcnt(0)" ::: "memory");
        } else {
            XB_SPIN(xb_ld(&bar[XB_XGEN(b.x)]) == gen, bar);
            __builtin_amdgcn_fence(__ATOMIC_ACQUIRE, "agent");
            asm volatile("s_waitcnt vmcnt(0)" ::: "memory");
        }
    }
    __syncthreads();
}

DI float wave_sum(float v) {
#pragma unroll
    for (int o = 1; o < 64; o <<= 1) v += __shfl_xor(v, o);
    return v;
}
DI float wave_max(float v) {
#pragma unroll
    for (int o = 1; o < 64; o <<= 1) v = fmaxf(v, __shfl_xor(v, o));
    return v;
}
DI float sigmoidf_(float x) { return 1.f / (1.f + expf(-x)); }
DI float siluf_(float x) { return x / (1.f + expf(-x)); }
DI int pos_index(int row) { return row < NP ? (row & (SEQ - 1)) : SEQ + ((row - NP) & (DS - 1)); }
DI float lg_gamma(int h) { return h == 0 ? -0.03174869831458027f : h == 1 ? -0.015748356968139112f : h == 2 ? -0.007843177461025892f : -0.003913899321136329f; }


namespace pg8 {
typedef unsigned short bf16_t;
typedef short bf16x8 __attribute__((ext_vector_type(8)));
typedef unsigned u32x4 __attribute__((ext_vector_type(4)));
typedef unsigned u32x2 __attribute__((ext_vector_type(2)));
constexpr int BM = 256, BK = 64, HALF = 128, HTB = HALF * BK * 2, STAGE_BYTES = 8 * HTB, NXCD = 8, WGM = 8;
__host__ __device__ __forceinline__ int lds_byte(int r, int c) { const int st = (r >> 4) * 2 + (c >> 5), rr = r & 15, cc = c & 31, ob = rr * 64 + cc * 2; return st * 1024 + (ob ^ (((ob >> 9) & 1) << 5)); }
__host__ __device__ __forceinline__ void stage_rc(int b, int& R, int& C) { const int st = b / 1024, sb = b % 1024, swz = sb ^ (((sb >> 9) & 1) << 5); R = (st >> 1) * 16 + swz / 64; C = (st & 1) * 32 + (swz % 64) / 2; }
__host__ __device__ __forceinline__ int perm32(int rho) { const int n = rho >> 4, i = rho & 15; return 8 * (i >> 2) + 4 * n + (i & 3); }
struct Unit { int pm, pn; };
struct Gemm { const bf16_t* A; const bf16_t* Bt; int M, N, K, lda, ldb; };
struct StaticOrder {
    int nM, nN, nwg, G, c;
    __host__ __device__ void init(int M, int N, int G_, int c_) { nM = M / BM; nN = N / BM; nwg = nM * nN; G = G_; c = c_; }
    __host__ __device__ bool next(int i, Unit& u) const {
        const long L = (long)i * G + c; if (L >= nwg) return false;
        int wgid = (int)L; { const int q = nwg / NXCD, r = nwg % NXCD, xcd = wgid % NXCD, off = wgid / NXCD; wgid = (xcd < r ? xcd * (q + 1) : r * (q + 1) + (xcd - r) * q) + off; }
        const int nig = WGM * nN, gid = wgid / nig, fm = gid * WGM, gsz = (nM - fm) < WGM ? (nM - fm) : WGM;
        u.pm = fm + ((wgid % nig) % gsz); u.pn = (wgid % nig) / gsz; return true;
    }
    __device__ __forceinline__ void a_ready(const Unit&) const {}
    __device__ __forceinline__ void done(const Unit&) const {}
};
__device__ __forceinline__ unsigned cvt_pk_bf16(float lo, float hi) { return cvtpk(lo, hi); }
struct EpiF32S {
    static constexpr bool PERM = false, AFTER_DRAIN = false;
    float* C; int ldc; int split_tiles; size_t split_stride;
    __device__ __forceinline__ void operator()(const f32x4 (&acc)[2][2][4][2], const Unit& u, int wr, int wc, int fr, int fq) const {
        int pn = u.pn; float* base = C; if (split_tiles) { const int t = pn / split_tiles; base += (size_t)t * split_stride; pn -= t * split_tiles; }
        const int row0 = u.pm * BM + wr * 64 + fr, col0 = pn * BM + wc * 32 + 4 * fq;
#pragma unroll
        for (int ai = 0; ai < 2; ++ai)
#pragma unroll
            for (int m = 0; m < 4; ++m) { float* rowp = base + (size_t)(row0 + ai * HALF + m * 16) * ldc + col0;
#pragma unroll
                for (int bj = 0; bj < 2; ++bj)
#pragma unroll
                    for (int n = 0; n < 2; ++n) *(f32x4*)(rowp + bj * HALF + n * 16) = acc[ai][bj][m][n]; }
    }
};
struct EpiBf16S {
    static constexpr bool PERM = true, AFTER_DRAIN = false;
    bf16_t* O; int ldc;
    __device__ __forceinline__ void operator()(const f32x4 (&acc)[2][2][4][2], const Unit& u, int wr, int wc, int fr, int fq) const {
        const int row0 = u.pm * BM + wr * 64 + fr, col0 = u.pn * BM + wc * 32 + 8 * fq;
#pragma unroll
        for (int ai = 0; ai < 2; ++ai)
#pragma unroll
            for (int m = 0; m < 4; ++m) { bf16_t* rowp = O + (size_t)(row0 + ai * HALF + m * 16) * ldc + col0;
#pragma unroll
                for (int bj = 0; bj < 2; ++bj) { const f32x4 v0 = acc[ai][bj][m][0], v1 = acc[ai][bj][m][1];
                    u32x4 w; w.x = cvt_pk_bf16(v0[0], v0[1]); w.y = cvt_pk_bf16(v0[2], v0[3]); w.z = cvt_pk_bf16(v1[0], v1[1]); w.w = cvt_pk_bf16(v1[2], v1[3]);
                    *(u32x4*)(rowp + bj * HALF) = w; } }
    }
};
struct EpiSwiGLU {
    static constexpr bool PERM = true, AFTER_DRAIN = false;
    bf16_t* O; int ldc;
    __device__ __forceinline__ void operator()(const f32x4 (&acc)[2][2][4][2], const Unit& u, int wr, int wc, int fr, int fq) const {
        const int row0 = u.pm * BM + wr * 64 + fr, col0 = u.pn * (BM / 2) + wc * 16 + 4 * fq;
#pragma unroll
        for (int ai = 0; ai < 2; ++ai)
#pragma unroll
            for (int m = 0; m < 4; ++m) { bf16_t* rowp = O + (size_t)(row0 + ai * HALF + m * 16) * ldc + col0;
#pragma unroll
                for (int bj = 0; bj < 2; ++bj) { const f32x4 v0 = acc[ai][bj][m][0], v1 = acc[ai][bj][m][1];
                    const float a0 = v0[0] / (1.f + __expf(-v0[0])) * v0[1], a1 = v0[2] / (1.f + __expf(-v0[2])) * v0[3];
                    const float a2 = v1[0] / (1.f + __expf(-v1[0])) * v1[1], a3 = v1[2] / (1.f + __expf(-v1[2])) * v1[3];
                    u32x2 w; w.x = cvt_pk_bf16(a0, a1); w.y = cvt_pk_bf16(a2, a3);
                    *(u32x2*)(rowp + bj * (HALF / 2)) = w; } }
    }
};
template <int MODE  > struct EpiGate {
    static constexpr bool PERM = false, AFTER_DRAIN = false;
    const float* gate; int ldg; float* mix; bf16_t* mixb; int ldc;
    __device__ __forceinline__ void operator()(const f32x4 (&acc)[2][2][4][2], const Unit& u, int wr, int wc, int fr, int fq) const {
        const int row0 = u.pm * BM + wr * 64 + fr, col0 = u.pn * BM + wc * 32 + 4 * fq;
#pragma unroll
        for (int ai = 0; ai < 2; ++ai)
#pragma unroll
            for (int m = 0; m < 4; ++m) { const size_t r = (size_t)(row0 + ai * HALF + m * 16);
#pragma unroll
                for (int bj = 0; bj < 2; ++bj)
#pragma unroll
                    for (int n = 0; n < 2; ++n) { const int c = col0 + bj * HALF + n * 16;
                        const f32x4 gz = *(const f32x4*)(gate + r * ldg + c); f32x4 v = acc[ai][bj][m][n];
#pragma unroll
                        for (int e = 0; e < 4; ++e) v[e] = v[e] / (1.f + __expf(-gz[e]));
                        if (MODE >= 1) v += *(const f32x4*)(mix + r * ldc + c);
                        if (MODE <= 1) *(f32x4*)(mix + r * ldc + c) = v;
                        else { u32x2 w; w.x = cvt_pk_bf16(v[0], v[1]); w.y = cvt_pk_bf16(v[2], v[3]); *(u32x2*)(mixb + r * ldc + c) = w; } } }
    }
};
template <class Epi, class Sched, bool ALIGN_EPI = false, bool SP2 = false>
__device__ __forceinline__ void gemm_phase(LAS unsigned char* lds, const Gemm g, const Sched& S, const Epi& E) {
    const int tid = threadIdx.x, wid = __builtin_amdgcn_readfirstlane(tid >> 6), lane = tid & 63, wr = wid >> 2, wc = wid & 3, fr = lane & 15, fq = lane >> 4;
    const int K = g.K, nt = K / BK;
    unsigned voffA[2], voffB[2];
#pragma unroll
    for (int i = 0; i < 2; ++i) { int R, C; stage_rc(tid * 16 + i * 8192, R, C); const int Rb = Epi::PERM ? ((R & ~31) + perm32(R & 31)) : R;
        voffA[i] = (unsigned)(R * g.lda + C) * 2u; voffB[i] = (unsigned)(Rb * g.ldb + C) * 2u; }
    const size_t kstep = (size_t)(BK * 2);
    const size_t hstepA = (size_t)HALF * g.lda * 2, hstepB = (size_t)HALF * g.ldb * 2;
    const size_t tstepA = 2 * hstepA, tstepB = 2 * hstepB;
    const unsigned ldsw = (unsigned)wid * 1024u;
    const int aoff = lds_byte(wr * 64 + fr, fq * 8), boff = lds_byte(wc * 32 + fr, fq * 8);
#define PG8_SA(b, h) (((b) * 2 + (h)) * HTB)
#define PG8_SB(b, h) ((4 + (b) * 2 + (h)) * HTB)
#define PG8_STAGE(bufoff, gbase, voff) do { _Pragma("unroll") for (int _i = 0; _i < 2; ++_i) \
        __builtin_amdgcn_global_load_lds((const unsigned*)((const char*)(gbase) + (voff)[_i]), (LAS unsigned*)(lds + (bufoff) + ldsw + _i * 8192), 16, 0, 0); } while (0)
#define PG8_LDA(dst, b, h) do { _Pragma("unroll") for (int m = 0; m < 4; ++m) _Pragma("unroll") for (int k = 0; k < 2; ++k) dst[m][k] = *(const LAS bf16x8*)(lds + PG8_SA(b, h) + aoff + m * 2048 + k * 1024); } while (0)
#define PG8_LDB(dst, b, h) do { _Pragma("unroll") for (int n = 0; n < 2; ++n) _Pragma("unroll") for (int k = 0; k < 2; ++k) dst[n][k] = *(const LAS bf16x8*)(lds + PG8_SB(b, h) + boff + n * 2048 + k * 1024); } while (0)
#define PG8_MMA(ai, bj, At, Bt) do { __builtin_amdgcn_s_setprio(1); _Pragma("unroll") for (int m = 0; m < 4; ++m) _Pragma("unroll") for (int n = 0; n < 2; ++n) _Pragma("unroll") for (int k = 0; k < 2; ++k) \
        acc[ai][bj][m][n] = __builtin_amdgcn_mfma_f32_16x16x32_bf16(Bt[n][k], At[m][k], acc[ai][bj][m][n], 0, 0, 0); __builtin_amdgcn_s_setprio(0); } while (0)
#define PG8_WAIT_V(n) asm volatile("s_waitcnt vmcnt(" #n ")" ::: "memory")
#define PG8_WAIT_L(n) asm volatile("s_waitcnt lgkmcnt(" #n ")" ::: "memory")
#define PG8_BAR __builtin_amdgcn_s_barrier()
#define PG8_SCHED __builtin_amdgcn_sched_barrier(0)
    Unit cur, nxt; int ui = 0;
    if (!S.next(0, cur)) return;
    f32x4 acc[2][2][4][2];
#pragma unroll
    for (int a = 0; a < 2; ++a)
#pragma unroll
        for (int b = 0; b < 2; ++b)
#pragma unroll
            for (int m = 0; m < 4; ++m)
#pragma unroll
                for (int n = 0; n < 2; ++n) acc[a][b][m][n] = (f32x4){0.f, 0.f, 0.f, 0.f};
    bf16x8 At[4][2], B0[2][2], B1[2][2];
    const char* cA = (const char*)g.A + (size_t)cur.pm * tstepA; const char* cB = (const char*)g.Bt + (size_t)cur.pn * tstepB;
    S.a_ready(cur);
    if constexpr (SP2) {
        PG8_STAGE(PG8_SB(0, 0), cB, voffB); PG8_STAGE(PG8_SB(0, 1), cB + hstepB, voffB); PG8_STAGE(PG8_SA(0, 0), cA, voffA); PG8_STAGE(PG8_SA(0, 1), cA + hstepA, voffA);
        if (wr == 1) PG8_BAR;
        PG8_WAIT_V(2); PG8_BAR;
        PG8_STAGE(PG8_SB(1, 0), cB + kstep, voffB); PG8_STAGE(PG8_SA(1, 0), cA + kstep, voffA); PG8_STAGE(PG8_SB(1, 1), cB + hstepB + kstep, voffB);
        PG8_WAIT_V(6); PG8_BAR;
    } else {
        PG8_STAGE(PG8_SB(0, 0), cB, voffB); PG8_STAGE(PG8_SA(0, 0), cA, voffA); PG8_STAGE(PG8_SB(0, 1), cB + hstepB, voffB); PG8_STAGE(PG8_SA(0, 1), cA + hstepA, voffA);
        if (wr == 1) PG8_BAR;
        PG8_WAIT_V(4); PG8_BAR;
        PG8_STAGE(PG8_SB(1, 0), cB + kstep, voffB); PG8_STAGE(PG8_SA(1, 0), cA + kstep, voffA); PG8_STAGE(PG8_SB(1, 1), cB + hstepB + kstep, voffB);
        PG8_WAIT_V(6); PG8_BAR;
    }
    for (;;) {
        const bool has_next = S.next(ui + 1, nxt);
        const char* nA = has_next ? (const char*)g.A + (size_t)nxt.pm * tstepA : cA; const char* nB = has_next ? (const char*)g.Bt + (size_t)nxt.pn * tstepB : cB;
#pragma unroll 1
        for (int t = 0; t < nt; t += 2) {
            const bool last = (t == nt - 2);
            const char* a1 = cA + (size_t)(t + 1) * kstep;
            const char* a2 = last ? nA : cA + (size_t)(t + 2) * kstep; const char* b2 = last ? nB : cB + (size_t)(t + 2) * kstep;
            const char* a3 = a2 + kstep; const char* b3 = b2 + kstep;
            if (last && has_next) S.a_ready(nxt);
            if constexpr (SP2) {
            PG8_LDB(B0, 0, 0); PG8_LDB(B1, 0, 1); PG8_SCHED; PG8_LDA(At, 0, 0); PG8_STAGE(PG8_SA(1, 1), a1 + hstepA, voffA);
            PG8_WAIT_V(8); PG8_WAIT_L(0); PG8_BAR; PG8_MMA(0, 0, At, B0); PG8_MMA(0, 1, At, B1); PG8_BAR; PG8_SCHED;
            PG8_LDA(At, 0, 1); PG8_STAGE(PG8_SB(0, 0), b2, voffB); PG8_STAGE(PG8_SB(0, 1), b2 + hstepB, voffB); PG8_STAGE(PG8_SA(0, 0), a2, voffA);
            PG8_WAIT_V(8); PG8_WAIT_L(0); PG8_BAR; PG8_MMA(1, 0, At, B0); PG8_MMA(1, 1, At, B1); PG8_BAR; PG8_SCHED;
            PG8_LDB(B0, 1, 0); PG8_LDB(B1, 1, 1); PG8_SCHED; PG8_LDA(At, 1, 0); PG8_STAGE(PG8_SA(0, 1), a2 + hstepA, voffA);
            PG8_WAIT_V(8); PG8_WAIT_L(0); PG8_BAR; PG8_MMA(0, 0, At, B0); PG8_MMA(0, 1, At, B1); PG8_BAR; PG8_SCHED;
            PG8_LDA(At, 1, 1); PG8_STAGE(PG8_SB(1, 0), b3, voffB); PG8_STAGE(PG8_SB(1, 1), b3 + hstepB, voffB); PG8_STAGE(PG8_SA(1, 0), a3, voffA);
            PG8_WAIT_V(8); PG8_WAIT_L(0); PG8_BAR; PG8_MMA(1, 0, At, B0); PG8_MMA(1, 1, At, B1); PG8_BAR; PG8_SCHED;
            } else {
            PG8_LDB(B0, 0, 0); PG8_SCHED; PG8_LDA(At, 0, 0); PG8_STAGE(PG8_SA(1, 1), a1 + hstepA, voffA);
            PG8_WAIT_L(8); PG8_BAR; PG8_WAIT_L(0); PG8_MMA(0, 0, At, B0); PG8_BAR; PG8_SCHED;
            PG8_LDB(B1, 0, 1); PG8_STAGE(PG8_SB(0, 0), b2, voffB);
            PG8_BAR; PG8_WAIT_L(0); PG8_MMA(0, 1, At, B1); PG8_BAR;
            PG8_LDA(At, 0, 1); PG8_STAGE(PG8_SA(0, 0), a2, voffA);
            PG8_BAR; PG8_WAIT_L(0); PG8_MMA(1, 0, At, B0); PG8_BAR; PG8_SCHED;
            PG8_STAGE(PG8_SB(0, 1), b2 + hstepB, voffB);
            PG8_WAIT_V(6); PG8_BAR; PG8_MMA(1, 1, At, B1); PG8_BAR;
            PG8_LDB(B0, 1, 0); PG8_SCHED; PG8_LDA(At, 1, 0); PG8_STAGE(PG8_SA(0, 1), a2 + hstepA, voffA);
            PG8_WAIT_L(8); PG8_BAR; PG8_WAIT_L(0); PG8_MMA(0, 0, At, B0); PG8_BAR; PG8_SCHED;
            PG8_LDB(B1, 1, 1); PG8_STAGE(PG8_SB(1, 0), b3, voffB);
            PG8_BAR; PG8_WAIT_L(0); PG8_MMA(0, 1, At, B1); PG8_BAR;
            PG8_LDA(At, 1, 1); PG8_STAGE(PG8_SA(1, 0), a3, voffA);
            PG8_BAR; PG8_WAIT_L(0); PG8_MMA(1, 0, At, B0); PG8_BAR; PG8_SCHED;
            PG8_STAGE(PG8_SB(1, 1), b3 + hstepB, voffB);
            PG8_WAIT_V(6); PG8_BAR; PG8_MMA(1, 1, At, B1); PG8_BAR;
            }
        }
        if constexpr (ALIGN_EPI) { if (wr == 0) PG8_BAR; }
        if constexpr (!Epi::AFTER_DRAIN) { E(acc, cur, wr, wc, fr, fq); S.done(cur); }
        if (!has_next) break;
#pragma unroll
        for (int a = 0; a < 2; ++a)
#pragma unroll
            for (int b = 0; b < 2; ++b)
#pragma unroll
                for (int m = 0; m < 4; ++m)
#pragma unroll
                    for (int n = 0; n < 2; ++n) acc[a][b][m][n] = (f32x4){0.f, 0.f, 0.f, 0.f};
        cur = nxt; cA = nA; cB = nB; ++ui;
        if constexpr (ALIGN_EPI) { if (wr == 1) PG8_BAR; }
    }
    PG8_WAIT_V(0);
    if constexpr (!ALIGN_EPI) { if (wr == 0) PG8_BAR; }
    PG8_BAR;
    if constexpr (Epi::AFTER_DRAIN) { E.fused(acc, cur, wr, wc, fr, fq, lds, wid, lane); S.done(cur); }
#undef PG8_SA
#undef PG8_SB
#undef PG8_STAGE
#undef PG8_LDA
#undef PG8_LDB
#undef PG8_MMA
#undef PG8_WAIT_V
#undef PG8_WAIT_L
#undef PG8_BAR
#undef PG8_SCHED
}
}
typedef unsigned short bf16_t;
DI unsigned pk2(float lo, float hi) { return pg8::cvt_pk_bf16(lo, hi); }
DI bf16_t f2bf(float f) { return (bf16_t)(pg8::cvt_pk_bf16(f, 0.f) & 0xffffu); }
DI void transpose_item(const float* W, int N, bf16_t* WT, int ldt, int row_off, int rmul, LAS float* scr, int item, int lane) {
    const int nblk = N / 32, kb = item / nblk, nb = item % nblk, k0 = 64 * kb, n0 = 32 * nb;
#pragma unroll 8
    for (int i = 0; i < 32; ++i) { const int kk = 2 * i + (lane >> 5); scr[kk * 33 + (lane & 31)] = W[(size_t)(k0 + kk) * N + n0 + (lane & 31)]; }
    asm volatile("s_waitcnt lgkmcnt(0)" ::: "memory");
    const int c = lane & 7;
#pragma unroll
    for (int j = 0; j < 4; ++j) { const int n = (lane >> 3) + 8 * j; const LAS float* sp = scr + (8 * c) * 33 + n;
        pg8::u32x4 o; o.x = pk2(sp[0 * 33], sp[1 * 33]); o.y = pk2(sp[2 * 33], sp[3 * 33]); o.z = pk2(sp[4 * 33], sp[5 * 33]); o.w = pk2(sp[6 * 33], sp[7 * 33]);
        *(pg8::u32x4*)(WT + (size_t)(row_off + rmul * (n0 + n)) * ldt + k0 + 8 * c) = o; }
    asm volatile("s_waitcnt lgkmcnt(0)" ::: "memory");
}
DI void transpose_w(const float* W, int K, int N, bf16_t* WT, int ldt, int row_off, LAS float* scr, int gw, int NGW, int lane, int& rot, int rmul = 1) {
    const int nitems = (K / 64) * (N / 32);
    int first = gw - (rot % NGW); if (first < 0) first += NGW;
    for (int it = first; it < nitems; it += NGW) transpose_item(W, N, WT, ldt, row_off, rmul, scr, it, lane);
    rot += nitems;
}

struct Args {
    const float* in[29]; float* out; unsigned char* ws; int ph_lo, ph_hi, sub, pad;
};

DI unsigned short f2bf_raw(float f) { unsigned u = __builtin_bit_cast(unsigned, f); return (unsigned short)((u + 0x7fffu + ((u >> 16) & 1u)) >> 16); }
DI void sgemm_naive(LAS float* lds, const float* __restrict__ A, int lda, const float* __restrict__ B, long sbk, long sbn,
                    float* __restrict__ C, int ldc, int M, int N, int K, int bid, int G, unsigned short* Cb = nullptr) {
    LAS float* As = lds;
    LAS float* Bs = lds + 16 * 132;
    const int tid = threadIdx.x, tx = tid & 15, ty = tid >> 4;
    const int ntn = N / 64, ntiles = (M / 128) * ntn;
    for (int t = bid; t < ntiles; t += G) {
        const int m0 = (t / ntn) * 128, n0 = (t % ntn) * 64;
        float acc[4][4];
#pragma unroll
        for (int i = 0; i < 4; ++i)
#pragma unroll
            for (int j = 0; j < 4; ++j) acc[i][j] = 0.f;
        for (int k0 = 0; k0 < K; k0 += 16) {
            {
                const int r = tid >> 2, kq = (tid & 3) * 4;
                const float4 v = *(const float4*)(A + (size_t)(m0 + r) * lda + k0 + kq);
                As[(kq + 0) * 132 + r] = v.x; As[(kq + 1) * 132 + r] = v.y; As[(kq + 2) * 132 + r] = v.z; As[(kq + 3) * 132 + r] = v.w;
            }
#pragma unroll
            for (int i = 0; i < 2; ++i) {
                const int idx = tid + i * 512, kk = idx >> 6, nn = idx & 63;
                Bs[kk * 64 + nn] = B[(size_t)(k0 + kk) * sbk + (size_t)(n0 + nn) * sbn];
            }
            __syncthreads();
#pragma unroll
            for (int kk = 0; kk < 16; ++kk) {
                const f32x4 a = *(const LAS f32x4*)(As + kk * 132 + ty * 4);
                const f32x4 b = *(const LAS f32x4*)(Bs + kk * 64 + tx * 4);
                const float av[4] = {a.x, a.y, a.z, a.w}, bv[4] = {b.x, b.y, b.z, b.w};
#pragma unroll
                for (int i = 0; i < 4; ++i)
#pragma unroll
                    for (int j = 0; j < 4; ++j) acc[i][j] += av[i] * bv[j];
            }
            __syncthreads();
        }
#pragma unroll
        for (int i = 0; i < 4; ++i) {
            float4 o; o.x = acc[i][0]; o.y = acc[i][1]; o.z = acc[i][2]; o.w = acc[i][3];
            if (Cb) { unsigned short* cb = Cb + (size_t)(m0 + ty * 4 + i) * ldc + n0 + tx * 4; cb[0] = f2bf_raw(o.x); cb[1] = f2bf_raw(o.y); cb[2] = f2bf_raw(o.z); cb[3] = f2bf_raw(o.w); }
            else *(float4*)(C + (size_t)(m0 + ty * 4 + i) * ldc + n0 + tx * 4) = o;
        }
    }
}

template <int DQK, int DV, bool V_IN_K, int MODE, class KV, class QF>
DI void attn_naive(LAS float* lds, const KV& kv, int nk_loop, const QF& qf, bool active, int limit, float scale, float lg, int tq, float* optr) {
    constexpr int KS = DQK + 1;
    constexpr int VS = V_IN_K ? KS : DV;
    LAS float* Ks = lds;
    LAS float* Vs = V_IN_K ? Ks : (lds + 64 * KS);
    LAS float* qs = lds + 64 * KS + (V_IN_K ? 0 : 64 * DV);
    LAS float* ps = qs + 8 * DQK;
    static_assert((64 * KS + (V_IN_K ? 0 : 64 * DV) + 8 * DQK + 8 * 64) * 4 <= MISC_OFF, "attn_naive LDS");
    const int tid = threadIdx.x, lane = tid & 63, w = tid >> 6;
    __syncthreads();
    for (int d = lane; d < DQK; d += 64) qs[w * DQK + d] = active ? qf(d) : 0.f;
    float m = -INFINITY, l = 0.f;
    float acc[DV / 64];
#pragma unroll
    for (int c = 0; c < DV / 64; ++c) acc[c] = 0.f;
    for (int base = 0; base < nk_loop; base += 64) {
        __syncthreads();
        for (int idx = tid; idx < 64 * DQK; idx += NTHREADS) { const int j = idx / DQK, d = idx - j * DQK, key = base + j; Ks[j * KS + d] = key < nk_loop ? kv.k(key, d) : 0.f; }
        if (!V_IN_K) for (int idx = tid; idx < 64 * DV; idx += NTHREADS) { const int j = idx / DV, e = idx - j * DV, key = base + j; Vs[j * DV + e] = key < nk_loop ? kv.v(key, e) : 0.f; }
        __syncthreads();
        const int key = base + lane; const bool valid = active && key <= limit && key < nk_loop;
        float s = 0.f;
        for (int d = 0; d < DQK; ++d) s += qs[w * DQK + d] * Ks[lane * KS + d];
        float p;
        if (MODE == 0) {
            s *= scale;
            const float cm = wave_max(valid ? s : -INFINITY);
            const float mn = fmaxf(m, cm);
            const float alpha = (mn == -INFINITY) ? 1.f : expf(m - mn);
            p = valid ? expf(s - mn) : 0.f;
            l = l * alpha + wave_sum(p);
#pragma unroll
            for (int c = 0; c < DV / 64; ++c) acc[c] *= alpha;
            m = mn;
        } else {
            p = valid ? s * expf((float)(tq - key) * lg) : 0.f;
        }
        ps[w * 64 + lane] = p;
        __syncthreads();
        for (int j = 0; j < 64; ++j) { const float pj = ps[w * 64 + j];
#pragma unroll
            for (int c = 0; c < DV / 64; ++c) acc[c] += pj * Vs[j * VS + lane + 64 * c]; }
    }
    if (active) {
#pragma unroll
        for (int c = 0; c < DV / 64; ++c) optr[lane + 64 * c] = (MODE == 0) ? acc[c] / l : acc[c];
    }
}

struct KvMlaPrompt { const float* ckvn; const float* kper; int b;
    DI float k(int key, int d) const { const size_t row = (size_t)b * SEQ + key; return d < KVL ? ckvn[row * KVL + d] : kper[row * DROPE + (d - KVL)]; }
    DI float v(int, int) const { return 0.f; } };
struct KvMlaSample { const float* ckvn; const float* kper; const float* cckv; const float* ckpe; const int* pt; int b;
    DI float k(int key, int d) const {
        if (key < PAST) { const size_t r = (size_t)pt[b * NPAGES + (key >> 7)] * PAGE + (key & (PAGE - 1)); return d < KVL ? cckv[r * KVL + d] : ckpe[r * DROPE + (d - KVL)]; }
        const size_t row = (size_t)NP + b * DS + (key - PAST); return d < KVL ? ckvn[row * KVL + d] : kper[row * DROPE + (d - KVL)]; }
    DI float v(int, int) const { return 0.f; } };
struct KvRet { const float* rk; const float* z; int b, h;
    DI float k(int key, int d) const { return rk[((size_t)b * SEQ + key) * 512 + h * RDK + d]; }
    DI float v(int key, int e) const { return z[((size_t)b * SEQ + key) * ZLD + C_RV + h * RDV + e]; } };
struct KvMem { const float* mk; const float* mv; int b, h;
    DI float k(int key, int d) const { return mk[(((size_t)b * NMEM + key) * XH + h) * XHD + d]; }
    DI float v(int key, int e) const { return mv[(((size_t)b * NMEM + key) * XH + h) * XHD + e]; } };


typedef float f32x16 __attribute__((ext_vector_type(16)));
typedef short bf16x8 __attribute__((ext_vector_type(8)));
typedef short s16x4 __attribute__((ext_vector_type(4)));
typedef unsigned u32x4_t __attribute__((ext_vector_type(4)));
typedef unsigned u32x2_t __attribute__((ext_vector_type(2)));
DI int crow(int i, int h) { return (i & 3) + 8 * (i >> 2) + 4 * h; }
#define MFMA32(a, b, c) __builtin_amdgcn_mfma_f32_32x32x16_bf16((a), (b), (c), 0, 0, 0)
template <int DQK, int DV, bool CAUSAL, class Src>
DI void flash_unit(LAS unsigned char* lds, const Src& src, int qpos0, int ntiles, bf16_t* O, int ldo, float c2) {
    constexpr int KP = DQK + 8, VP = 68, KS = DQK / 16, NBLK = DV / 32;
    constexpr int KBYTES = 64 * KP * 2, VBYTES = DV * VP * 2, BUF = KBYTES + VBYTES;
    constexpr int D8 = DQK / 8, NPK = (64 * D8) / NTHREADS, NPV = (DV * 8) / NTHREADS;
    static_assert((64 * D8) % NTHREADS == 0 && (DV * 8) % NTHREADS == 0 && 2 * BUF <= 131072, "flash_unit geometry");
    const int tid = threadIdx.x, lane = tid & 63, w = __builtin_amdgcn_readfirstlane(tid >> 6), l31 = lane & 31, h = lane >> 5;
    bf16x8 qf[KS];
#pragma unroll
    for (int s_ = 0; s_ < KS; ++s_) qf[s_] = src.qfrag(32 * w + l31, s_, h);
    f32x16 o[NBLK];
#pragma unroll
    for (int b = 0; b < NBLK; ++b)
#pragma unroll
        for (int i = 0; i < 16; ++i) o[b][i] = 0.f;
    float m = -INFINITY, lsum = 0.f;
    u32x4_t kreg[NPK], vreg[NPV];
#define FL_LOAD(t_) do { _Pragma("unroll") for (int i_ = 0; i_ < NPK; ++i_) { const int p_ = tid + i_ * NTHREADS; kreg[i_] = src.kpiece(64 * (t_) + p_ / D8, p_ % D8); } \
                         _Pragma("unroll") for (int i_ = 0; i_ < NPV; ++i_) { const int p_ = tid + i_ * NTHREADS; vreg[i_] = src.vpiece(p_ >> 3, 64 * (t_) + 8 * (p_ & 7)); } } while (0)
#define FL_STORE(buf_) do { _Pragma("unroll") for (int i_ = 0; i_ < NPK; ++i_) { const int p_ = tid + i_ * NTHREADS; *(LAS u32x4_t*)(lds + (buf_) * BUF + ((p_ / D8) * KP + (p_ % D8) * 8) * 2) = kreg[i_]; } \
                          _Pragma("unroll") for (int i_ = 0; i_ < NPV; ++i_) { const int p_ = tid + i_ * NTHREADS; LAS unsigned char* a_ = lds + (buf_) * BUF + KBYTES + ((p_ >> 3) * VP + (p_ & 7) * 8) * 2; \
                              *(LAS u32x2_t*)a_ = (u32x2_t){vreg[i_].x, vreg[i_].y}; *(LAS u32x2_t*)(a_ + 8) = (u32x2_t){vreg[i_].z, vreg[i_].w}; } } while (0)
    __syncthreads();
    FL_LOAD(0); FL_STORE(0);
    __syncthreads();
    const int qmine = qpos0 + 32 * w + l31, qlast = qpos0 + 32 * w + 31;
    for (int t = 0; t < ntiles; ++t) {
        const int buf = t & 1;
        if (t + 1 < ntiles) FL_LOAD(t + 1);
        if (!CAUSAL || 64 * t <= qlast) {
            const LAS unsigned char* kb_ = lds + buf * BUF; const LAS unsigned char* vb_ = kb_ + KBYTES;
            f32x16 st[2];
#pragma unroll
            for (int kb = 0; kb < 2; ++kb) {
#pragma unroll
                for (int i = 0; i < 16; ++i) st[kb][i] = 0.f;
#pragma unroll
                for (int g_ = 0; g_ < KS / 4; ++g_) { bf16x8 kf[4];
#pragma unroll
                    for (int j = 0; j < 4; ++j) kf[j] = *(const LAS bf16x8*)(kb_ + ((32 * kb + l31) * KP + 16 * (4 * g_ + j) + 8 * h) * 2);
#pragma unroll
                    for (int j = 0; j < 4; ++j) st[kb] = MFMA32(kf[j], qf[4 * g_ + j], st[kb]);
                    __builtin_amdgcn_sched_barrier(0); }
            }
            float mx = -INFINITY;
#pragma unroll
            for (int kb = 0; kb < 2; ++kb)
#pragma unroll
                for (int i = 0; i < 16; ++i) { float v = st[kb][i] * c2; if (CAUSAL) { const int key = 64 * t + 32 * kb + crow(i, h); v = key <= qmine ? v : -INFINITY; } st[kb][i] = v; mx = fmaxf(mx, v); }
            mx = fmaxf(mx, __shfl_xor(mx, 32));
            const float mn = fmaxf(m, mx);
            const float alpha = __builtin_amdgcn_exp2f(m - mn);
            m = mn;
            float ps = 0.f;
#pragma unroll
            for (int kb = 0; kb < 2; ++kb)
#pragma unroll
                for (int i = 0; i < 16; ++i) { const float p = __builtin_amdgcn_exp2f(st[kb][i] - mn); st[kb][i] = p; ps += p; }
            lsum = lsum * alpha + ps;
#pragma unroll
            for (int b = 0; b < NBLK; ++b)
#pragma unroll
                for (int i = 0; i < 16; ++i) o[b][i] *= alpha;
            bf16x8 pf[4];
#pragma unroll
            for (int ks = 0; ks < 4; ++ks) { const int kb = ks >> 1, s2 = ks & 1; u32x4_t pk;
                pk.x = cvtpk(st[kb][8 * s2 + 0], st[kb][8 * s2 + 1]); pk.y = cvtpk(st[kb][8 * s2 + 2], st[kb][8 * s2 + 3]);
                pk.z = cvtpk(st[kb][8 * s2 + 4], st[kb][8 * s2 + 5]); pk.w = cvtpk(st[kb][8 * s2 + 6], st[kb][8 * s2 + 7]); pf[ks] = __builtin_bit_cast(bf16x8, pk); }
            __builtin_amdgcn_sched_barrier(0);
#pragma unroll
            for (int b = 0; b < NBLK; ++b) { bf16x8 vf[4];
#pragma unroll
                for (int ks = 0; ks < 4; ++ks) { const LAS unsigned char* a_ = vb_ + ((32 * b + l31) * VP + 16 * ks + 4 * h) * 2;
                    const s16x4 lo = *(const LAS s16x4*)a_, hi = *(const LAS s16x4*)(a_ + 16);
                    vf[ks] = __builtin_shufflevector(lo, hi, 0, 1, 2, 3, 4, 5, 6, 7); }
#pragma unroll
                for (int ks = 0; ks < 4; ++ks) o[b] = MFMA32(vf[ks], pf[ks], o[b]);
                __builtin_amdgcn_sched_barrier(0); }
        }
        if (t + 1 < ntiles) FL_STORE(buf ^ 1);
        __syncthreads();
    }
#undef FL_LOAD
#undef FL_STORE
    lsum += __shfl_xor(lsum, 32);
    const float inv = 1.f / lsum;
    bf16_t* orow = O + (size_t)(32 * w + l31) * ldo;
#pragma unroll
    for (int b = 0; b < NBLK; ++b)
#pragma unroll
        for (int g = 0; g < 4; ++g) { u32x2_t pk; pk.x = cvtpk(o[b][4 * g + 0] * inv, o[b][4 * g + 1] * inv); pk.y = cvtpk(o[b][4 * g + 2] * inv, o[b][4 * g + 3] * inv);
            *(u32x2_t*)(orow + 32 * b + 8 * g + 4 * h) = pk; }
}
struct SrcMlaP { const bf16_t* kn; const bf16_t* kpe; const bf16_t* vt; const bf16_t* qraw; const bf16_t* qpe; int b, hh; size_t row0;
    DI bf16x8 qfrag(int r, int s_, int h8) const { return s_ < 8 ? *(const bf16x8*)(qraw + (row0 + r) * 1536 + hh * DQH + 16 * s_ + 8 * h8) : *(const bf16x8*)(qpe + (row0 + r) * 512 + hh * DROPE + 16 * (s_ - 8) + 8 * h8); }
    DI u32x4_t kpiece(int key, int d8) const { const size_t row = (size_t)b * SEQ + key;
        return d8 < 16 ? *(const u32x4_t*)(kn + row * 1024 + hh * DNOPE + d8 * 8) : *(const u32x4_t*)(kpe + row * DROPE + (d8 - 16) * 8); }
    DI u32x4_t vpiece(int dv, int key0) const { return *(const u32x4_t*)(vt + (size_t)(hh * DVH + dv) * NP + (size_t)b * SEQ + key0); } };
struct SrcMemP { const bf16_t* mk; const bf16_t* mvt; const bf16_t* xq; int b, hh; size_t row0;
    DI bf16x8 qfrag(int r, int s_, int h8) const { return *(const bf16x8*)(xq + (row0 + r) * 256 + hh * XHD + 16 * s_ + 8 * h8); }
    DI u32x4_t kpiece(int key, int d8) const { return *(const u32x4_t*)(mk + ((size_t)b * NMEM + key) * 256 + hh * XHD + d8 * 8); }
    DI u32x4_t vpiece(int dv, int key0) const { return *(const u32x4_t*)(mvt + (size_t)(hh * XHD + dv) * (NB * NMEM) + (size_t)b * NMEM + key0); } };


DI void ret_chunk_state(const bf16_t* __restrict__ RVT, const bf16_t* __restrict__ RKtT, float* __restrict__ UT, int b, int h, int c) {
    const int tid = threadIdx.x, lane = tid & 63, w = __builtin_amdgcn_readfirstlane(tid >> 6), l31 = lane & 31, hh = lane >> 5;
    const size_t tok0 = (size_t)b * SEQ + c * 128;
    f32x16 acc[4];
#pragma unroll
    for (int kb = 0; kb < 4; ++kb)
#pragma unroll
        for (int i = 0; i < 16; ++i) acc[kb][i] = 0.f;
    const bf16_t* ap = RVT + (size_t)(h * RDV + 32 * w + l31) * NT + tok0 + 8 * hh;
    const bf16_t* bp = RKtT + (size_t)(h * RDK + l31) * NP + tok0 + 8 * hh;
#pragma unroll
    for (int s_ = 0; s_ < 8; ++s_) { const bf16x8 a = *(const bf16x8*)(ap + 16 * s_);
#pragma unroll
        for (int kb = 0; kb < 4; ++kb) { const bf16x8 bfr = *(const bf16x8*)(bp + (size_t)(32 * kb) * NP + 16 * s_); acc[kb] = MFMA32(a, bfr, acc[kb]); } }
    float* u = UT + (size_t)(((b * RH + h) * 16) + c) * 32768;
#pragma unroll
    for (int kb = 0; kb < 4; ++kb)
#pragma unroll
        for (int i = 0; i < 16; ++i) u[(32 * w + crow(i, hh)) * RDK + 32 * kb + l31] = acc[kb][i];
}
DI void ret_chunk_out(const bf16_t* __restrict__ RQt, const bf16_t* __restrict__ RKt, const bf16_t* __restrict__ RVT, const bf16_t* __restrict__ SPT, float* __restrict__ ORET, int b, int h, int c) {
    const int tid = threadIdx.x, lane = tid & 63, w = __builtin_amdgcn_readfirstlane(tid >> 6), l31 = lane & 31, hh = lane >> 5;
    const int ib = w & 3, vh = w >> 2;
    const size_t tok0 = (size_t)b * SEQ + c * 128;
    bf16x8 qf[8];
    { const bf16_t* qp = RQt + (tok0 + 32 * ib + l31) * 512 + h * RDK + 8 * hh;
#pragma unroll
      for (int s_ = 0; s_ < 8; ++s_) qf[s_] = *(const bf16x8*)(qp + 16 * s_); }
    f32x16 o[4];
#pragma unroll
    for (int blk = 0; blk < 4; ++blk)
#pragma unroll
        for (int i = 0; i < 16; ++i) o[blk][i] = 0.f;
    const bf16_t* vbase = RVT + (size_t)(h * RDV + 32 * (4 * vh) + l31) * NT + tok0 + 4 * hh;
#pragma unroll 1
    for (int jb = 0; jb <= ib; ++jb) {
        f32x16 x;
#pragma unroll
        for (int i = 0; i < 16; ++i) x[i] = 0.f;
        const bf16_t* kp = RKt + (tok0 + 32 * jb + l31) * 512 + h * RDK + 8 * hh;
#pragma unroll
        for (int s_ = 0; s_ < 8; ++s_) { const bf16x8 kf = *(const bf16x8*)(kp + 16 * s_); x = MFMA32(kf, qf[s_], x); }
        if (jb == ib) {
#pragma unroll
            for (int i = 0; i < 16; ++i) x[i] = (crow(i, hh) <= l31) ? x[i] : 0.f;
        }
#pragma unroll
        for (int s2 = 0; s2 < 2; ++s2) {
            u32x4_t pk; pk.x = cvtpk(x[8 * s2 + 0], x[8 * s2 + 1]); pk.y = cvtpk(x[8 * s2 + 2], x[8 * s2 + 3]); pk.z = cvtpk(x[8 * s2 + 4], x[8 * s2 + 5]); pk.w = cvtpk(x[8 * s2 + 6], x[8 * s2 + 7]);
            const bf16x8 pa = __builtin_bit_cast(bf16x8, pk);
#pragma unroll
            for (int blk = 0; blk < 4; ++blk) { const bf16_t* vp = vbase + (size_t)(32 * blk) * NT + 32 * jb + 16 * s2;
                const s16x4 lo = *(const s16x4*)vp, hi = *(const s16x4*)(vp + 8);
                const bf16x8 vf = __builtin_shufflevector(lo, hi, 0, 1, 2, 3, 4, 5, 6, 7);
                o[blk] = MFMA32(pa, vf, o[blk]); }
        }
    }
    const bf16_t* sp = SPT + (size_t)(((b * RH + h) * 16) + c) * 32768 + (size_t)(32 * (4 * vh) + l31) * RDK + 8 * hh;
#pragma unroll
    for (int s_ = 0; s_ < 8; ++s_)
#pragma unroll
        for (int blk = 0; blk < 4; ++blk) { const bf16x8 sf = *(const bf16x8*)(sp + (size_t)(32 * blk) * RDK + 16 * s_); o[blk] = MFMA32(qf[s_], sf, o[blk]); }
#pragma unroll
    for (int blk = 0; blk < 4; ++blk)
#pragma unroll
        for (int i = 0; i < 16; ++i) ORET[(tok0 + 32 * ib + crow(i, hh)) * 1024 + h * RDV + 32 * (4 * vh + blk) + l31] = o[blk][i];
}


typedef short v4i16_t __attribute__((ext_vector_type(4)));
DI s16x4 vtr(const LAS unsigned char* p) { return __builtin_bit_cast(s16x4, __builtin_amdgcn_ds_read_tr16_b64_v4i16((LAS v4i16_t*)p)); }
constexpr int MS_NSPLIT = 2, MS_KEYS = PAST / MS_NSPLIT, MS_TILES = MS_KEYS / 64;
DI void mla_sample_unit(LAS unsigned char* lds, const float* __restrict__ cckv, const float* __restrict__ ckpe, const int* __restrict__ pt,
                        const bf16_t* __restrict__ QLATb, const bf16_t* __restrict__ QPEb, float* __restrict__ PO, float* __restrict__ PML, int b, int split, float c2) {
    constexpr int KP = 328, KBYTES = 64 * KP * 2;
    const int tid = threadIdx.x, lane = tid & 63, w = __builtin_amdgcn_readfirstlane(tid >> 6), l31 = lane & 31, hh = lane >> 5;
    bf16x8 qf[20];
    { const int t = l31 >> 3, head = l31 & 7;
      const bf16_t* ql = QLATb + (size_t)(b * DS + t) * 2048 + head * KVL + 8 * hh;
      const bf16_t* qp = QPEb + (size_t)(NP + b * DS + t) * 512 + head * DROPE + 8 * hh;
#pragma unroll
      for (int s_ = 0; s_ < 16; ++s_) qf[s_] = *(const bf16x8*)(ql + 16 * s_);
#pragma unroll
      for (int s_ = 0; s_ < 4; ++s_) qf[16 + s_] = *(const bf16x8*)(qp + 16 * s_); }
    f32x16 o;
#pragma unroll
    for (int i = 0; i < 16; ++i) o[i] = 0.f;
    float m = -INFINITY, lsum = 0.f;
    f32x4 cr[8], pr[2];
#define MS_LOAD(t_) do { const int key0_ = split * MS_KEYS + 64 * (t_); const size_t rowb_ = (size_t)pt[b * NPAGES + (key0_ >> 7)] * PAGE + (key0_ & (PAGE - 1)); \
        _Pragma("unroll") for (int i_ = 0; i_ < 8; ++i_) { const int pc_ = tid + i_ * NTHREADS; cr[i_] = __builtin_nontemporal_load((const f32x4*)(cckv + (rowb_ + (pc_ >> 6)) * KVL + 4 * (pc_ & 63))); } \
        _Pragma("unroll") for (int i_ = 0; i_ < 2; ++i_) { const int pc_ = tid + i_ * NTHREADS; pr[i_] = __builtin_nontemporal_load((const f32x4*)(ckpe + (rowb_ + (pc_ >> 4)) * DROPE + 4 * (pc_ & 15))); } } while (0)
#define MS_STORE(buf_) do { \
        _Pragma("unroll") for (int i_ = 0; i_ < 8; ++i_) { const int pc_ = tid + i_ * NTHREADS; *(LAS u32x2_t*)(lds + (buf_) * KBYTES + ((pc_ >> 6) * KP + 4 * (pc_ & 63)) * 2) = (u32x2_t){cvtpk(cr[i_][0], cr[i_][1]), cvtpk(cr[i_][2], cr[i_][3])}; } \
        _Pragma("unroll") for (int i_ = 0; i_ < 2; ++i_) { const int pc_ = tid + i_ * NTHREADS; *(LAS u32x2_t*)(lds + (buf_) * KBYTES + ((pc_ >> 4) * KP + KVL + 4 * (pc_ & 15)) * 2) = (u32x2_t){cvtpk(pr[i_][0], pr[i_][1]), cvtpk(pr[i_][2], pr[i_][3])}; } } while (0)
    __syncthreads();
    MS_LOAD(0); MS_STORE(0);
    __syncthreads();
    const int q4 = (lane & 15) >> 2, p4 = lane & 3, blk = (lane >> 4) & 1;
#pragma unroll 1
    for (int t = 0; t < MS_TILES; ++t) {
        const int buf = t & 1;
        if (t + 1 < MS_TILES) MS_LOAD(t + 1);
        const LAS unsigned char* kb_ = lds + buf * KBYTES;
        f32x16 st[2];
#pragma unroll
        for (int kb = 0; kb < 2; ++kb) {
#pragma unroll
            for (int i = 0; i < 16; ++i) st[kb][i] = 0.f;
#pragma unroll
            for (int g_ = 0; g_ < 5; ++g_) { bf16x8 kf[4];
#pragma unroll
                for (int j = 0; j < 4; ++j) kf[j] = *(const LAS bf16x8*)(kb_ + ((32 * kb + l31) * KP + 16 * (4 * g_ + j) + 8 * hh) * 2);
#pragma unroll
                for (int j = 0; j < 4; ++j) st[kb] = MFMA32(kf[j], qf[4 * g_ + j], st[kb]);
                __builtin_amdgcn_sched_barrier(0); }
        }
        float mx = -INFINITY;
#pragma unroll
        for (int kb = 0; kb < 2; ++kb)
#pragma unroll
            for (int i = 0; i < 16; ++i) { const float v = st[kb][i] * c2; st[kb][i] = v; mx = fmaxf(mx, v); }
        mx = fmaxf(mx, __shfl_xor(mx, 32));
        const float mn = fmaxf(m, mx);
        const float alpha = __builtin_amdgcn_exp2f(m - mn);
        m = mn;
        float ps = 0.f;
#pragma unroll
        for (int kb = 0; kb < 2; ++kb)
#pragma unroll
            for (int i = 0; i < 16; ++i) { const float p = __builtin_amdgcn_exp2f(st[kb][i] - mn); st[kb][i] = p; ps += p; }
        lsum = lsum * alpha + ps;
#pragma unroll
        for (int i = 0; i < 16; ++i) o[i] *= alpha;
        bf16x8 vf[4];
#pragma unroll
        for (int ks = 0; ks < 4; ++ks) { const LAS unsigned char* a_ = kb_ + ((16 * ks + 4 * hh + q4) * KP + 32 * w + 16 * blk + 4 * p4) * 2;
            const s16x4 lo = vtr(a_), hi = vtr(a_ + 8 * KP * 2);
            vf[ks] = __builtin_shufflevector(lo, hi, 0, 1, 2, 3, 4, 5, 6, 7); }
#pragma unroll
        for (int ks = 0; ks < 4; ++ks) { const int kb = ks >> 1, s2 = ks & 1; u32x4_t pk;
            pk.x = cvtpk(st[kb][8 * s2 + 0], st[kb][8 * s2 + 1]); pk.y = cvtpk(st[kb][8 * s2 + 2], st[kb][8 * s2 + 3]);
            pk.z = cvtpk(st[kb][8 * s2 + 4], st[kb][8 * s2 + 5]); pk.w = cvtpk(st[kb][8 * s2 + 6], st[kb][8 * s2 + 7]);
            o = MFMA32(vf[ks], __builtin_bit_cast(bf16x8, pk), o); }
        if (t + 1 < MS_TILES) MS_STORE(buf ^ 1);
        __syncthreads();
    }
#undef MS_LOAD
#undef MS_STORE
    lsum += __shfl_xor(lsum, 32);
    const int item = b * MS_NSPLIT + split;
    if (w == 0 && lane < 32) { PML[(item * 32 + lane) * 2] = m; PML[(item * 32 + lane) * 2 + 1] = lsum; }
#pragma unroll
    for (int i = 0; i < 16; ++i) PO[((size_t)item * 32 + l31) * KVL + 32 * w + crow(i, hh)] = o[i];
}

struct QPtr { const float* p; DI float operator()(int d) const { return p[d]; } };
struct QMla { const float* ql; const float* qp; DI float operator()(int d) const { return d < KVL ? ql[d] : qp[d - KVL]; } };
DI void rms_row(const float* x, const float* g, float* o, int n, int lane) {
    float s = 0.f;
    for (int i = lane; i < n; i += 64) { const float v = x[i]; s += v * v; }
    const float r = rsqrtf(wave_sum(s) / (float)n + EPS);
    for (int i = lane; i < n; i += 64) o[i] = x[i] * r * g[i];
}

DI void rms_row_bf16(const float* x, const float* g, bf16_t* o, int n, int lane) {
    float s = 0.f;
    for (int i = lane; i < n; i += 64) { const float v = x[i]; s += v * v; }
    const float r = rsqrtf(wave_sum(s) / (float)n + EPS);
    for (int i = lane; i < n; i += 64) o[i] = f2bf(x[i] * r * g[i]);
}
#define GEMM_PHASE(EPI, ...) pg8::gemm_phase<EPI, pg8::StaticOrder, true, true>(__VA_ARGS__)
__global__ void __launch_bounds__(NTHREADS, 2) fwd_kernel(Args args) {
    extern __shared__ __attribute__((aligned(16))) unsigned char lds_raw[];
    LAS unsigned char* ldsb = (LAS unsigned char*)lds_raw;
    LAS float* lds = (LAS float*)ldsb;
    volatile LAS unsigned* MISC = (volatile LAS unsigned*)(ldsb + MISC_OFF);
    const int tid = threadIdx.x, lane = tid & 63, wave = tid >> 6;
    const int G = gridDim.x, bid = blockIdx.x;
    const int gw = bid * NWAVES + wave, NGW = G * NWAVES;
    unsigned char* ws = args.ws;
    float* out = args.out;
    const int lo = args.ph_lo, hi = args.ph_hi;

    if (tid < 64) MISC[tid] = 0u;
    __syncthreads();
    XcdBarrier bar; bar.bar = (unsigned*)(ws + WS_CTL) + CW_BAR; bar.x = 0; bar.st = MISC;
    if (hi - lo > 1) bar = xcd_barrier_post((unsigned*)(ws + WS_CTL) + CW_BAR, MISC);
#define IN(k) (lo <= (k) && (k) < hi)
#define SEAM(k) do { if (IN(k) && IN((k) + 1)) xcd_barrier(bar); } while (0)

    const float* x_prompt = args.in[0]; const float* x_sample = args.in[1]; const float* mem_prompt = args.in[2];
    const float* cache_ckv = args.in[3]; const float* cache_kpe = args.in[4]; const int* page_table = (const int*)args.in[5];
    const float* state_ret = args.in[6]; const float* cache_mem_k = args.in[7]; const float* cache_mem_v = args.in[8];
    const float* g_mix_pre = args.in[9]; const float* g_mix_post = args.in[10]; const float* g_ffn_pre = args.in[11]; const float* g_ffn_post = args.in[12];
    const float* g_mem = args.in[13]; const float* g_qlat = args.in[14]; const float* g_kvlat = args.in[15];
    const float* w_in = args.in[16]; const float* w_uq = args.in[17]; const float* w_uk = args.in[18]; const float* w_uv = args.in[19];
    const float* w_mem_k = args.in[20]; const float* w_mem_v = args.in[21]; const float* w_ret_o = args.in[22]; const float* w_mla_o = args.in[23];
    const float* w_x_o = args.in[24]; const float* w_out = args.in[25]; const float* w_gate = args.in[26]; const float* w_up = args.in[27]; const float* w_down = args.in[28];
    float* COSA = (float*)(ws + WS_COSA); float* SINA = (float*)(ws + WS_SINA); float* COSB = (float*)(ws + WS_COSB); float* SINB = (float*)(ws + WS_SINB);
    float* U = (float*)(ws + WS_U); float* MN = (float*)(ws + WS_MN); float* Z = (float*)(ws + WS_Z);
    float* RQ = (float*)(ws + WS_RQ); float* RK = (float*)(ws + WS_RK); float* CQN = (float*)(ws + WS_CQN); float* CKVN = (float*)(ws + WS_CKVN); float* KPER = (float*)(ws + WS_KPER);
    float* Q = (float*)(ws + WS_Q); float* QLAT = (float*)(ws + WS_QLAT); float* QPE = (float*)(ws + WS_QPE);
    float* ORET = (float*)(ws + WS_ORET); float* OLAT = (float*)(ws + WS_OLAT); float* OX = (float*)(ws + WS_OX); float* OMLA = (float*)(ws + WS_OMLA); float* ORETN = (float*)(ws + WS_ORETN);
    float* ARET = (float*)(ws + WS_ARET); float* AMLA = (float*)(ws + WS_AMLA); float* AX = (float*)(ws + WS_AX); float* MIX = (float*)(ws + WS_MIX);
    float* HP = (float*)(ws + WS_HP); float* H = (float*)(ws + WS_H); float* F = (float*)(ws + WS_F);
    float* GU = (float*)(ws + WS_GG); float* FO = (float*)(ws + WS_FO);
    bf16_t* WinT = (bf16_t*)(ws + WS_WIN_T); bf16_t* WmkvT = (bf16_t*)(ws + WS_WMKV_T); bf16_t* WuqT = (bf16_t*)(ws + WS_WUQ_T); bf16_t* WroT = (bf16_t*)(ws + WS_WRO_T);
    bf16_t* WmoT = (bf16_t*)(ws + WS_WMO_T); bf16_t* WxoT = (bf16_t*)(ws + WS_WXO_T); bf16_t* WoT = (bf16_t*)(ws + WS_WO_T); bf16_t* WguT = (bf16_t*)(ws + WS_WGU_T); bf16_t* WdT = (bf16_t*)(ws + WS_WD_T);
    bf16_t* Ub = (bf16_t*)(ws + WS_UB); bf16_t* MNb = (bf16_t*)(ws + WS_MNB); bf16_t* CQNb = (bf16_t*)(ws + WS_CQNB); bf16_t* ORETNb = (bf16_t*)(ws + WS_ORETNB);
    bf16_t* OMLAb = (bf16_t*)(ws + WS_OMLAB); bf16_t* OXb = (bf16_t*)(ws + WS_OXB); bf16_t* MIXb = (bf16_t*)(ws + WS_MIXB); bf16_t* Fb = (bf16_t*)(ws + WS_FB); bf16_t* ACTb = (bf16_t*)(ws + WS_ACTB);
    bf16_t* WukT = (bf16_t*)(ws + WS_WUK_T); bf16_t* WuvT = (bf16_t*)(ws + WS_WUV_T); bf16_t* CKVNb = (bf16_t*)(ws + WS_CKVNB); bf16_t* KPERb = (bf16_t*)(ws + WS_KPERB);
    bf16_t* XQb = (bf16_t*)(ws + WS_XQB); bf16_t* MKb = (bf16_t*)(ws + WS_MKB); bf16_t* MVT = (bf16_t*)(ws + WS_MVT); bf16_t* KN = (bf16_t*)(ws + WS_KN); bf16_t* VT = (bf16_t*)(ws + WS_VT); bf16_t* Qb = (bf16_t*)(ws + WS_QB);
    bf16_t* RQt = (bf16_t*)(ws + WS_RQT); bf16_t* RKt = (bf16_t*)(ws + WS_RKT); bf16_t* RKtT = (bf16_t*)(ws + WS_RKTT); bf16_t* RVT = (bf16_t*)(ws + WS_RVT);
    float* UT = (float*)(ws + WS_UT); bf16_t* SPT = (bf16_t*)(ws + WS_SPT);
    bf16_t* QPEb = (bf16_t*)(ws + WS_QPEB); bf16_t* WukB = (bf16_t*)(ws + WS_WUKB);
    bf16_t* QLATb = (bf16_t*)(ws + WS_QLATB); float* PO = (float*)(ws + WS_PO); float* PML = (float*)(ws + WS_PML);

    if (IN(0)) {
        for (int i = bid * NTHREADS + tid; i < NPOS * 64 + NPOS * 32; i += G * NTHREADS) {
            const bool a = i < NPOS * 64; const int j = a ? i : i - NPOS * 64; const int half = a ? 64 : 32;
            const int p = j / half, f = j % half; const int pos = p < SEQ ? p : PAST + (p - SEQ);
            const float inv = powf(10000.0f, -(float)f / (float)half);
            const float ang = (float)pos * inv;
            double rev = (double)ang * 0.15915494309189535; rev -= floor(rev);
            const float r = (float)rev;
            const float sn = __builtin_amdgcn_sinf(r), cs = __builtin_amdgcn_cosf(r);
            if (a) { COSA[j] = cs; SINA[j] = sn; } else { COSB[j] = cs; SINB[j] = sn; }
        }
        for (int row = gw; row < NT; row += NGW) {
            const float* xr = row < NP ? x_prompt + (size_t)row * DM : x_sample + (size_t)(row - NP) * DM;
            rms_row_bf16(xr, g_mix_pre, Ub + (size_t)row * DM, DM, lane);
        }
        for (int row = gw; row < NB * NMEM; row += NGW) rms_row_bf16(mem_prompt + (size_t)row * DM, g_mem, MNb + (size_t)row * DM, DM, lane);
        {
            LAS float* scr = lds + wave * (64 * 33);
            int rot = 0;
            transpose_w(w_in, 1024, DIN, WinT, 1024, 0, scr, gw, NGW, lane, rot);
            for (int i = bid * NTHREADS + tid; i < (ZLD - DIN) * 1024 / 2; i += G * NTHREADS) ((unsigned*)(WinT + (size_t)DIN * 1024))[i] = 0u;
            for (int i = bid * NTHREADS + tid; i < MH * KVL * DNOPE / 4; i += G * NTHREADS) { const f32x4 v = *(const f32x4*)(w_uk + 4 * (size_t)i); *(u32x2_t*)(WukB + 4 * (size_t)i) = (u32x2_t){cvtpk(v[0], v[1]), cvtpk(v[2], v[3])}; }
            transpose_w(w_mem_k, 1024, 256, WmkvT, 1024, 0, scr, gw, NGW, lane, rot);
            transpose_w(w_mem_v, 1024, 256, WmkvT, 1024, 256, scr, gw, NGW, lane, rot);
            transpose_w(w_uq, QL, 1536, WuqT, QL, 0, scr, gw, NGW, lane, rot);
            transpose_w(w_ret_o, 1024, 1024, WroT, 1024, 0, scr, gw, NGW, lane, rot);
            transpose_w(w_mla_o, 1024, 1024, WmoT, 1024, 0, scr, gw, NGW, lane, rot);
            transpose_w(w_x_o, 256, 1024, WxoT, 256, 0, scr, gw, NGW, lane, rot);
            transpose_w(w_out, 1024, 1024, WoT, 1024, 0, scr, gw, NGW, lane, rot);
            transpose_w(w_gate, 1024, DFF, WguT, 1024, 0, scr, gw, NGW, lane, rot, 2);
            transpose_w(w_up, 1024, DFF, WguT, 1024, 1, scr, gw, NGW, lane, rot, 2);
            transpose_w(w_down, DFF, 1024, WdT, DFF, 0, scr, gw, NGW, lane, rot);
            for (int hh = 0; hh < MH; ++hh) { transpose_w(w_uk + (size_t)hh * KVL * DNOPE, KVL, DNOPE, WukT, KVL, hh * DNOPE, scr, gw, NGW, lane, rot);
                                              transpose_w(w_uv + (size_t)hh * KVL * DVH, KVL, DVH, WuvT, KVL, hh * DVH, scr, gw, NGW, lane, rot); }
        }
    }
    SEAM(0);
    if (IN(1)) {
        { pg8::Gemm g{Ub, WinT, NT, ZLD, 1024, 1024, 1024}; pg8::StaticOrder S; S.init(NT, ZLD, G, bid); pg8::EpiF32S E{Z, ZLD, 0, 0};
          GEMM_PHASE(pg8::EpiF32S, ldsb, g, S, E); }
        __syncthreads();
        { pg8::Gemm g{MNb, WmkvT, NB * NMEM, 512, 1024, 1024, 1024}; pg8::StaticOrder S; S.init(NB * NMEM, 512, G, bid); pg8::EpiF32S E{out + O_MKP, 256, 1, O_MVP - O_MKP};
          GEMM_PHASE(pg8::EpiF32S, ldsb, g, S, E); }
        __syncthreads();
        { pg8::Gemm g{WinT + (size_t)C_RV * 1024, Ub, 1024, NT, 1024, 1024, 1024}; pg8::StaticOrder S; S.init(1024, NT, G, bid); pg8::EpiBf16S E{RVT, NT};
          GEMM_PHASE(pg8::EpiBf16S, ldsb, g, S, E); }
    }
    SEAM(1);
    if (IN(2)) {
        constexpr int KTP = 520;
        LAS bf16_t* Kt = (LAS bf16_t*)ldsb;
        const int ntile = NP / 64, nwork = ntile + (NS + 63) / 64;
        for (int wk = bid; wk < nwork; wk += G) {
            const bool prompt = wk < ntile; const int row_base = prompt ? wk * 64 : NP + (wk - ntile) * 64;
            __syncthreads();
            {
                float zq[8], zk[8], zc[6], zv[4], zx[4], zp, ca, sa, cb, sb; int p;
#define P2_LOAD(r_, ZQ_, ZK_, ZC_, ZV_, ZX_, ZP_, CA_, SA_, CB_, SB_, P_) do { const float* z_ = Z + (size_t)(row_base + (r_)) * ZLD; P_ = pos_index(row_base + (r_)); \
                _Pragma("unroll") for (int h_ = 0; h_ < 4; ++h_) { ZQ_[2 * h_] = z_[C_RQ + h_ * RDK + lane]; ZQ_[2 * h_ + 1] = z_[C_RQ + h_ * RDK + 64 + lane]; ZK_[2 * h_] = z_[C_RK + h_ * RDK + lane]; ZK_[2 * h_ + 1] = z_[C_RK + h_ * RDK + 64 + lane]; } \
                _Pragma("unroll") for (int c_ = 0; c_ < 6; ++c_) ZC_[c_] = z_[C_CQ + lane + 64 * c_]; \
                _Pragma("unroll") for (int c_ = 0; c_ < 4; ++c_) { ZV_[c_] = z_[C_CKV + lane + 64 * c_]; ZX_[c_] = z_[C_XQ + lane + 64 * c_]; } \
                ZP_ = z_[C_KPE + lane]; CA_ = COSA[P_ * 64 + lane]; SA_ = SINA[P_ * 64 + lane]; CB_ = COSB[P_ * 32 + (lane & 31)]; SB_ = SINB[P_ * 32 + (lane & 31)]; } while (0)
                int r = wave;
                P2_LOAD(r, zq, zk, zc, zv, zx, zp, ca, sa, cb, sb, p);
                for (; r < 64; r += NWAVES) {
                    float zqn[8], zkn[8], zcn[6], zvn[4], zxn[4], zpn, can, san, cbn, sbn; int pn;
                    if (r + NWAVES < 64) P2_LOAD(r + NWAVES, zqn, zkn, zcn, zvn, zxn, zpn, can, san, cbn, sbn, pn);
                    const int row = row_base + r; const int il = p & 127;
#pragma unroll
                    for (int h = 0; h < RH; ++h) {
                        const float q1 = zq[2 * h] * ca - zq[2 * h + 1] * sa, q2 = zq[2 * h] * sa + zq[2 * h + 1] * ca;
                        const float sc = 0.08838834764831845f;
                        const float k1 = (zk[2 * h] * ca - zk[2 * h + 1] * sa) * sc, k2 = (zk[2 * h] * sa + zk[2 * h + 1] * ca) * sc;
                        if (prompt) {
                            const float fq = __expf((float)(il - 127) * lg_gamma(h)), fk = 1.f / fq;
                            RQt[(size_t)row * 512 + h * RDK + lane] = f2bf(q1 * fq); RQt[(size_t)row * 512 + h * RDK + 64 + lane] = f2bf(q2 * fq);
                            const bf16_t kb1 = f2bf(k1 * fk), kb2 = f2bf(k2 * fk);
                            RKt[(size_t)row * 512 + h * RDK + lane] = kb1; RKt[(size_t)row * 512 + h * RDK + 64 + lane] = kb2;
                            Kt[r * KTP + h * RDK + lane] = kb1; Kt[r * KTP + h * RDK + 64 + lane] = kb2;
                        } else {
                            RQ[(size_t)row * 512 + h * RDK + lane] = q1; RQ[(size_t)row * 512 + h * RDK + 64 + lane] = q2;
                            RK[(size_t)row * 512 + h * RDK + lane] = k1; RK[(size_t)row * 512 + h * RDK + 64 + lane] = k2;
                        }
                    }
                    {
                        float ss = 0.f;
#pragma unroll
                        for (int c = 0; c < 6; ++c) ss += zc[c] * zc[c];
                        const float rr = rsqrtf(wave_sum(ss) * (1.f / QL) + EPS);
#pragma unroll
                        for (int c = 0; c < 6; ++c) CQNb[(size_t)row * QL + lane + 64 * c] = f2bf(zc[c] * rr * g_qlat[lane + 64 * c]);
                    }
                    {
                        float ss = 0.f;
#pragma unroll
                        for (int c = 0; c < 4; ++c) ss += zv[c] * zv[c];
                        const float rr = rsqrtf(wave_sum(ss) * (1.f / KVL) + EPS);
                        float* ockv = row < NP ? out + O_CKVP + (size_t)row * KVL : out + O_CKVS + (size_t)(row - NP) * KVL;
#pragma unroll
                        for (int c = 0; c < 4; ++c) { const float v = zv[c] * rr * g_kvlat[lane + 64 * c]; ockv[lane + 64 * c] = v; CKVN[(size_t)row * KVL + lane + 64 * c] = v; CKVNb[(size_t)row * KVL + lane + 64 * c] = f2bf(v);
                            XQb[(size_t)row * 256 + lane + 64 * c] = f2bf(zx[c]); }
                    }
                    {
                        const float x2 = __shfl(zp, (lane & 31) + 32), x1 = __shfl(zp, lane & 31);
                        const float o1 = x1 * cb - x2 * sb, o2 = x1 * sb + x2 * cb;
                        if (lane < 32) {
                            KPER[(size_t)row * DROPE + lane] = o1; KPER[(size_t)row * DROPE + 32 + lane] = o2;
                            float* okpe = row < NP ? out + O_KPEP + (size_t)row * DROPE : out + O_KPES + (size_t)(row - NP) * DROPE;
                            okpe[lane] = o1; okpe[32 + lane] = o2;
                            KPERb[(size_t)row * DROPE + lane] = f2bf(o1); KPERb[(size_t)row * DROPE + 32 + lane] = f2bf(o2);
                        }
                    }
#pragma unroll
                    for (int i = 0; i < 8; ++i) { zq[i] = zqn[i]; zk[i] = zkn[i]; }
#pragma unroll
                    for (int i = 0; i < 6; ++i) zc[i] = zcn[i];
#pragma unroll
                    for (int i = 0; i < 4; ++i) { zv[i] = zvn[i]; zx[i] = zxn[i]; }
                    zp = zpn; ca = can; sa = san; cb = cbn; sb = sbn; p = pn;
                }
#undef P2_LOAD
            }
            __syncthreads();
            if (prompt) {
#pragma unroll 2
                for (int i = 0; i < 8; ++i) { const int pc = tid + i * NTHREADS, f = pc >> 3, k8 = pc & 7;
                    const LAS bf16_t* c = Kt + (8 * k8) * KTP + f;
                    pg8::u32x4 o; o.x = (unsigned)c[0] | ((unsigned)c[KTP] << 16); o.y = (unsigned)c[2 * KTP] | ((unsigned)c[3 * KTP] << 16);
                    o.z = (unsigned)c[4 * KTP] | ((unsigned)c[5 * KTP] << 16); o.w = (unsigned)c[6 * KTP] | ((unsigned)c[7 * KTP] << 16);
                    *(pg8::u32x4*)(RKtT + (size_t)f * NP + row_base + 8 * k8) = o; }
            }
        }
    }
    if (IN(2)) {
        for (int i = bid * NTHREADS + tid; i < NB * NMEM * 256; i += G * NTHREADS) { MKb[i] = f2bf(out[O_MKP + i]);
            const int f = i / (NB * NMEM), r = i - f * (NB * NMEM); MVT[i] = f2bf(out[O_MVP + (size_t)r * 256 + f]); }
    }
    SEAM(2);
    if (IN(3)) { pg8::Gemm g{CQNb, WuqT, NT, 1536, QL, QL, QL}; pg8::StaticOrder S; S.init(NT, 1536, G, bid); pg8::EpiBf16S E{Qb, 1536};
        GEMM_PHASE(pg8::EpiBf16S, ldsb, g, S, E);
        __syncthreads();
        { pg8::Gemm g2{CKVNb, WukT, NP, 1024, KVL, KVL, KVL}; pg8::StaticOrder S2; S2.init(NP, 1024, G, bid); pg8::EpiBf16S E2{KN, 1024}; GEMM_PHASE(pg8::EpiBf16S, ldsb, g2, S2, E2); }
        __syncthreads();
        { pg8::Gemm g3{WuvT, CKVNb, 1024, NP, KVL, KVL, KVL}; pg8::StaticOrder S3; S3.init(1024, NP, G, bid); pg8::EpiBf16S E3{VT, NP}; GEMM_PHASE(pg8::EpiBf16S, ldsb, g3, S3, E3); }
        for (int it = bid; it < NB * RH * 16; it += G) { const int c = __builtin_amdgcn_readfirstlane(it & 15), h = __builtin_amdgcn_readfirstlane((it >> 4) & 3), b = __builtin_amdgcn_readfirstlane(it >> 6);
            ret_chunk_state(RVT, RKtT, UT, b, h, c); } }
    SEAM(3);
    if (IN(4)) {
        for (int idx = bid * NTHREADS + tid; idx < NB * RH * 32768; idx += G * NTHREADS) {
            const int bh = idx >> 15, e = idx & 32767; const float g128 = expf(128.f * lg_gamma(bh & 3));
            float sp = 0.f, S = 0.f;
#pragma unroll 4
            for (int c = 0; c < 16; ++c) { const size_t o_ = (size_t)(bh * 16 + c) * 32768 + e; SPT[o_] = f2bf(sp); S = sp + UT[o_]; sp = g128 * S; }
            out[O_RETP + (size_t)bh * 32768 + (size_t)(e & 127) * RDV + (e >> 7)] = S;
        }
        {
            const int hd = lane >> 3, f4 = (lane & 7) * 4;
            u32x2_t x1, x2; f32x4 cb, sb;
#define P4_LOAD(r_, X1_, X2_, C_, S_) do { const bf16_t* q_ = Qb + (size_t)(r_) * 1536 + hd * DQH + DNOPE + f4; X1_ = *(const u32x2_t*)q_; X2_ = *(const u32x2_t*)(q_ + 32); \
            const int p_ = pos_index(r_); C_ = *(const f32x4*)(COSB + p_ * 32 + f4); S_ = *(const f32x4*)(SINB + p_ * 32 + f4); } while (0)
            int row = gw;
            if (row < NT) P4_LOAD(row, x1, x2, cb, sb);
            for (; row < NT; row += NGW) {
                u32x2_t x1n, x2n; f32x4 cbn, sbn; const int nr = row + NGW;
                if (nr < NT) P4_LOAD(nr, x1n, x2n, cbn, sbn);
                const float a0 = __builtin_bit_cast(float, x1.x << 16), a1 = __builtin_bit_cast(float, x1.x & 0xffff0000u), a2 = __builtin_bit_cast(float, x1.y << 16), a3 = __builtin_bit_cast(float, x1.y & 0xffff0000u);
                const float b0 = __builtin_bit_cast(float, x2.x << 16), b1 = __builtin_bit_cast(float, x2.x & 0xffff0000u), b2 = __builtin_bit_cast(float, x2.y << 16), b3 = __builtin_bit_cast(float, x2.y & 0xffff0000u);
                bf16_t* o_ = QPEb + (size_t)row * 512 + hd * DROPE + f4;
                *(u32x2_t*)o_ = (u32x2_t){cvtpk(a0 * cb[0] - b0 * sb[0], a1 * cb[1] - b1 * sb[1]), cvtpk(a2 * cb[2] - b2 * sb[2], a3 * cb[3] - b3 * sb[3])};
                *(u32x2_t*)(o_ + 32) = (u32x2_t){cvtpk(a0 * sb[0] + b0 * cb[0], a1 * sb[1] + b1 * cb[1]), cvtpk(a2 * sb[2] + b2 * cb[2], a3 * sb[3] + b3 * cb[3])};
                x1 = x1n; x2 = x2n; cb = cbn; sb = sbn;
            }
#undef P4_LOAD
        }
        for (int wt = gw; wt < MH * 16 * 2; wt += NGW) {
            const int lh = wt & 1, rb = (wt >> 1) & 15, head = wt >> 5; const int l31 = lane & 31, h8 = lane >> 5;
            f32x16 acc[4];
#pragma unroll
            for (int k_ = 0; k_ < 4; ++k_)
#pragma unroll
                for (int i = 0; i < 16; ++i) acc[k_][i] = 0.f;
            const bf16_t* ap = Qb + ((size_t)NP + 32 * rb + l31) * 1536 + head * DQH + 8 * h8;
            const bf16_t* bp = WukB + ((size_t)head * KVL + 128 * lh + l31) * DNOPE + 8 * h8;
#pragma unroll
            for (int s_ = 0; s_ < 8; ++s_) { const bf16x8 a = *(const bf16x8*)(ap + 16 * s_);
#pragma unroll
                for (int k_ = 0; k_ < 4; ++k_) { const bf16x8 b_ = *(const bf16x8*)(bp + (size_t)(32 * k_) * DNOPE + 16 * s_); acc[k_] = MFMA32(a, b_, acc[k_]); } }
#pragma unroll
            for (int k_ = 0; k_ < 4; ++k_)
#pragma unroll
                for (int i = 0; i < 16; ++i) QLATb[(size_t)(32 * rb + crow(i, h8)) * 2048 + head * KVL + 128 * lh + 32 * k_ + l31] = f2bf(acc[k_][i]);
        }
    }
    SEAM(4);
    if (IN(5)) {
        if (args.sub & 1) for (int it = bid; it < DB * MS_NSPLIT; it += G) { const int split = __builtin_amdgcn_readfirstlane(it % MS_NSPLIT), b = __builtin_amdgcn_readfirstlane(it / MS_NSPLIT);
            mla_sample_unit(ldsb, cache_ckv, cache_kpe, page_table, QLATb, QPEb, PO, PML, b, split, 0.07216878364870322f * 1.4426950408889634f); }
        if (args.sub & 2) for (int it = bid; it < NB * MH * 4; it += G) {
            const int pr = __builtin_amdgcn_readfirstlane(it & 3), hh = __builtin_amdgcn_readfirstlane((it >> 2) & 7), b = __builtin_amdgcn_readfirstlane(it >> 5);
#pragma unroll 1
            for (int half = 0; half < 2; ++half) { const int qb = __builtin_amdgcn_readfirstlane(half ? pr : 7 - pr); const size_t row0 = (size_t)b * SEQ + qb * 256;
                SrcMlaP src{KN, KPERb, VT, Qb, QPEb, b, hh, row0};
                flash_unit<192, 128, true>(ldsb, src, qb * 256, 4 * (qb + 1), OMLAb + row0 * 1024 + hh * DVH, 1024, 0.07216878364870322f * 1.4426950408889634f); }
        }
        if (args.sub & 4) for (int it = bid; it < NB * RH * 16; it += G) { const int c = __builtin_amdgcn_readfirstlane(it & 15), h = __builtin_amdgcn_readfirstlane((it >> 4) & 3), b = __builtin_amdgcn_readfirstlane(it >> 6);
            ret_chunk_out(RQt, RKt, RVT, SPT, ORET, b, h, c); }
        if (args.sub & 8) for (int it = bid; it < DB * RH; it += G) {
            const int h = it & 3, b = it >> 2; const float lg = lg_gamma(h);
            const float* s0 = state_ret + (size_t)it * RDK * RDV;
            LAS float* inner = lds;
            LAS float* qk = lds + 16;
            __syncthreads();
            for (int i = tid; i < 1024; i += NTHREADS) { const int which = i >> 9, ti = (i >> 7) & 3, d = i & 127; const size_t row = (size_t)NP + b * DS + ti;
                qk[i] = which ? RK[row * 512 + h * RDK + d] : RQ[row * 512 + h * RDK + d]; }
            __syncthreads();
            for (int pr = wave; pr < 16; pr += NWAVES) { const int i = pr >> 2, j = pr & 3;
                float s = qk[i * 128 + lane] * qk[512 + j * 128 + lane] + qk[i * 128 + 64 + lane] * qk[512 + j * 128 + 64 + lane];
                s = wave_sum(s);
                if (lane == 0) inner[pr] = (j <= i) ? s * expf((float)(i - j) * lg) : 0.f; }
            __syncthreads();
            {
                const int e = tid & 255, i0 = (tid >> 8) * 2;
                float o0 = 0.f, o1 = 0.f;
                for (int d = 0; d < RDK; ++d) { const float sv = s0[(size_t)d * RDV + e]; o0 += qk[i0 * 128 + d] * sv; o1 += qk[(i0 + 1) * 128 + d] * sv; }
                o0 *= expf((float)(i0 + 1) * lg); o1 *= expf((float)(i0 + 2) * lg);
#pragma unroll
                for (int j = 0; j < DS; ++j) { const float v = Z[((size_t)NP + b * DS + j) * ZLD + C_RV + h * RDV + e]; o0 += inner[i0 * 4 + j] * v; o1 += inner[(i0 + 1) * 4 + j] * v; }
                ORET[((size_t)NP + b * DS + i0) * 1024 + h * RDV + e] = o0; ORET[((size_t)NP + b * DS + i0 + 1) * 1024 + h * RDV + e] = o1;
            }
            {
                const float g4 = expf(4.f * lg);
                float* so = out + O_RETS + (size_t)it * RDK * RDV;
                for (int i = tid; i < RDK * RDV; i += NTHREADS) { const int d = i >> 8, e = i & 255; float a = s0[i] * g4;
#pragma unroll
                    for (int j = 0; j < DS; ++j) a += expf((float)(3 - j) * lg) * qk[512 + j * 128 + d] * Z[((size_t)NP + b * DS + j) * ZLD + C_RV + h * RDV + e];
                    so[i] = a; }
            }
        }
        if (args.sub & 16) for (int it = bid; it < NB * XH * 8; it += G) {
            const int qb = __builtin_amdgcn_readfirstlane(it & 7), hh = __builtin_amdgcn_readfirstlane((it >> 3) & 3), b = __builtin_amdgcn_readfirstlane(it >> 5); const size_t row0 = (size_t)b * SEQ + qb * 256;
            SrcMemP src{MKb, MVT, XQb, b, hh, row0};
            flash_unit<64, 64, false>(ldsb, src, 0, 4, OXb + row0 * 256 + hh * XHD, 256, 0.125f * 1.4426950408889634f);
        }
        if (args.sub & 32) for (int it = bid; it < DB * XH; it += G) {
            const int h = it & 3, b = it >> 2; const size_t row = (size_t)NP + b * DS + (wave & 3);
            KvMem kv{cache_mem_k, cache_mem_v, b, h};
            attn_naive<64, 64, false, 0>(lds, kv, NMEM, QPtr{Z + row * ZLD + C_XQ + h * XHD}, wave < 4, NMEM, 0.125f, 0.f, 0, OX + row * 256 + h * XHD);
        }
    }
    SEAM(5);
    if (IN(6)) {
        for (int b = bid; b < DB; b += G) {
            const int head = wave; const float c2 = 0.07216878364870322f * 1.4426950408889634f;
            LAS float* ol = lds + wave * KVL;
            for (int t = 0; t < DS; ++t) {
                const int qi = t * 8 + head; const size_t qrow = (size_t)b * DS + t;
                float qv[5];
#pragma unroll
                for (int c = 0; c < 5; ++c) { const int d = lane + 64 * c; const bf16_t raw = d < KVL ? QLATb[qrow * 2048 + head * KVL + d] : QPEb[(NP + qrow) * 512 + head * DROPE + (d - KVL)];
                    qv[c] = __builtin_bit_cast(float, (unsigned)raw << 16); }
                float sc[DS]; float M = -INFINITY;
#pragma unroll
                for (int j = 0; j < DS; ++j) { const size_t krow = (size_t)NP + b * DS + j; float a = 0.f;
#pragma unroll
                    for (int c = 0; c < 5; ++c) { const int d = lane + 64 * c; a += qv[c] * (d < KVL ? CKVN[krow * KVL + d] : KPER[krow * DROPE + (d - KVL)]); }
                    a = wave_sum(a) * c2; sc[j] = (j <= t) ? a : -INFINITY; M = fmaxf(M, sc[j]); }
                float ms[MS_NSPLIT], ls[MS_NSPLIT];
#pragma unroll
                for (int sp = 0; sp < MS_NSPLIT; ++sp) { const int item = b * MS_NSPLIT + sp; ms[sp] = PML[(item * 32 + qi) * 2]; ls[sp] = PML[(item * 32 + qi) * 2 + 1]; M = fmaxf(M, ms[sp]); }
                float L = 0.f; float acc[4] = {0.f, 0.f, 0.f, 0.f};
#pragma unroll
                for (int sp = 0; sp < MS_NSPLIT; ++sp) { const int item = b * MS_NSPLIT + sp; const float wgt = __builtin_amdgcn_exp2f(ms[sp] - M); L += ls[sp] * wgt;
#pragma unroll
                    for (int c = 0; c < 4; ++c) acc[c] += wgt * PO[((size_t)item * 32 + qi) * KVL + lane + 64 * c]; }
#pragma unroll
                for (int j = 0; j < DS; ++j) { const float wgt = __builtin_amdgcn_exp2f(sc[j] - M); L += wgt; const size_t krow = (size_t)NP + b * DS + j;
#pragma unroll
                    for (int c = 0; c < 4; ++c) acc[c] += wgt * CKVN[krow * KVL + lane + 64 * c]; }
                const float inv = 1.f / L;
#pragma unroll
                for (int c = 0; c < 4; ++c) ol[lane + 64 * c] = acc[c] * inv;
                __syncthreads();
                float a0 = 0.f, a1 = 0.f; const float* wv = w_uv + (size_t)head * KVL * DVH;
#pragma unroll 8
                for (int l = 0; l < KVL; ++l) { const float x = ol[l]; a0 += x * wv[(size_t)l * DVH + lane]; a1 += x * wv[(size_t)l * DVH + 64 + lane]; }
                OMLAb[((size_t)NP + qrow) * 1024 + head * DVH + lane] = f2bf(a0); OMLAb[((size_t)NP + qrow) * 1024 + head * DVH + 64 + lane] = f2bf(a1);
                __syncthreads();
            }
        }
        for (size_t i = (size_t)bid * NTHREADS + tid; i < (size_t)NS * 256; i += (size_t)G * NTHREADS) OXb[(size_t)NP * 256 + i] = f2bf(OX[(size_t)NP * 256 + i]);
        {
            f32x4 a[4], gz[4];
#define P6_LOAD(r_, A_, B_) do { _Pragma("unroll") for (int j_ = 0; j_ < 4; ++j_) { A_[j_] = *(const f32x4*)(ORET + (size_t)(r_) * 1024 + 4 * lane + 256 * j_); \
                                                                              B_[j_] = *(const f32x4*)(Z + (size_t)(r_) * ZLD + C_RG + 4 * lane + 256 * j_); } } while (0)
            int row = gw;
            if (row < NT) P6_LOAD(row, a, gz);
            for (; row < NT; row += NGW) {
                f32x4 an[4], gn[4]; const int nr = row + NGW;
                if (nr < NT) P6_LOAD(nr, an, gn);
#pragma unroll
                for (int j = 0; j < 4; ++j) {
                    const float ss = wave_sum(a[j][0] * a[j][0] + a[j][1] * a[j][1] + a[j][2] * a[j][2] + a[j][3] * a[j][3]);
                    const float r = rsqrtf(ss * (1.f / RDV) + EPS);
                    float o_[4];
#pragma unroll
                    for (int e = 0; e < 4; ++e) o_[e] = gz[j][e] / (1.f + __expf(-gz[j][e])) * a[j][e] * r;
                    *(u32x2_t*)(ORETNb + (size_t)row * 1024 + 4 * lane + 256 * j) = (u32x2_t){cvtpk(o_[0], o_[1]), cvtpk(o_[2], o_[3])};
                }
#pragma unroll
                for (int j = 0; j < 4; ++j) { a[j] = an[j]; gz[j] = gn[j]; }
            }
#undef P6_LOAD
        }
    }
    SEAM(6);
    if (IN(7)) {
        pg8::StaticOrder S; S.init(NT, 1024, G, bid);
        { pg8::Gemm g{ORETNb, WroT, NT, 1024, 1024, 1024, 1024}; pg8::EpiGate<0> E{Z + C_G, ZLD, ARET, MIXb, 1024}; GEMM_PHASE(pg8::EpiGate<0>, ldsb, g, S, E); }
        __syncthreads();
        { pg8::Gemm g{OMLAb, WmoT, NT, 1024, 1024, 1024, 1024}; pg8::EpiGate<1> E{Z + C_G + 1024, ZLD, ARET, MIXb, 1024}; GEMM_PHASE(pg8::EpiGate<1>, ldsb, g, S, E); }
        __syncthreads();
        { pg8::Gemm g{OXb, WxoT, NT, 1024, 256, 256, 256}; pg8::EpiGate<2> E{Z + C_G + 2048, ZLD, ARET, MIXb, 1024}; GEMM_PHASE(pg8::EpiGate<2>, ldsb, g, S, E); }
    }
    SEAM(7);
    SEAM(8);
    if (IN(9)) { pg8::Gemm g{MIXb, WoT, NT, 1024, 1024, 1024, 1024}; pg8::StaticOrder S; S.init(NT, 1024, G, bid); pg8::EpiF32S E{HP, 1024, 0, 0};
        GEMM_PHASE(pg8::EpiF32S, ldsb, g, S, E); }
    SEAM(9);
    if (IN(10)) {
        f32x4 gp[4], gf[4], a[4], b[4];
#pragma unroll
        for (int j = 0; j < 4; ++j) { gp[j] = *(const f32x4*)(g_mix_post + 4 * lane + 256 * j); gf[j] = *(const f32x4*)(g_ffn_pre + 4 * lane + 256 * j); }
#define P10_LOAD(r_, A_, B_) do { const float* xr_ = (r_) < NP ? x_prompt + (size_t)(r_) * DM : x_sample + (size_t)((r_) - NP) * DM; \
        _Pragma("unroll") for (int j_ = 0; j_ < 4; ++j_) { A_[j_] = *(const f32x4*)(HP + (size_t)(r_) * DM + 4 * lane + 256 * j_); B_[j_] = *(const f32x4*)(xr_ + 4 * lane + 256 * j_); } } while (0)
        int row = gw;
        if (row < NT) P10_LOAD(row, a, b);
        for (; row < NT; row += NGW) {
            f32x4 an[4], bn[4]; const int nr = row + NGW;
            if (nr < NT) P10_LOAD(nr, an, bn);
            float ss = 0.f;
#pragma unroll
            for (int j = 0; j < 4; ++j) ss += a[j][0] * a[j][0] + a[j][1] * a[j][1] + a[j][2] * a[j][2] + a[j][3] * a[j][3];
            float r = rsqrtf(wave_sum(ss) * (1.f / DM) + EPS); ss = 0.f;
#pragma unroll
            for (int j = 0; j < 4; ++j) { a[j] = b[j] + a[j] * r * gp[j]; *(f32x4*)(H + (size_t)row * DM + 4 * lane + 256 * j) = a[j];
                ss += a[j][0] * a[j][0] + a[j][1] * a[j][1] + a[j][2] * a[j][2] + a[j][3] * a[j][3]; }
            r = rsqrtf(wave_sum(ss) * (1.f / DM) + EPS);
#pragma unroll
            for (int j = 0; j < 4; ++j) { const f32x4 f_ = a[j] * r * gf[j]; *(u32x2_t*)(Fb + (size_t)row * DM + 4 * lane + 256 * j) = (u32x2_t){cvtpk(f_[0], f_[1]), cvtpk(f_[2], f_[3])}; }
#pragma unroll
            for (int j = 0; j < 4; ++j) { a[j] = an[j]; b[j] = bn[j]; }
        }
#undef P10_LOAD
    }
    SEAM(10);
    if (IN(11)) {
        pg8::Gemm g{Fb, WguT, NT, 2 * DFF, 1024, 1024, 1024}; pg8::StaticOrder S; S.init(NT, 2 * DFF, G, bid); pg8::EpiSwiGLU E{ACTb, DFF};
        GEMM_PHASE(pg8::EpiSwiGLU, ldsb, g, S, E);
    }
    SEAM(11);
    SEAM(12);
    if (IN(13)) { pg8::Gemm g{ACTb, WdT, NT, 1024, DFF, DFF, DFF}; pg8::StaticOrder S; S.init(NT, 1024, G, bid); pg8::EpiF32S E{FO, 1024, 0, 0};
        GEMM_PHASE(pg8::EpiF32S, ldsb, g, S, E); }
    SEAM(13);
    if (IN(14)) {
        f32x4 gp[4], a[4], b[4];
#pragma unroll
        for (int j = 0; j < 4; ++j) gp[j] = *(const f32x4*)(g_ffn_post + 4 * lane + 256 * j);
#define P14_LOAD(r_, A_, B_) do { _Pragma("unroll") for (int j_ = 0; j_ < 4; ++j_) { A_[j_] = *(const f32x4*)(FO + (size_t)(r_) * DM + 4 * lane + 256 * j_); B_[j_] = *(const f32x4*)(H + (size_t)(r_) * DM + 4 * lane + 256 * j_); } } while (0)
        int row = gw;
        if (row < NT) P14_LOAD(row, a, b);
        for (; row < NT; row += NGW) {
            f32x4 an[4], bn[4]; const int nr = row + NGW;
            if (nr < NT) P14_LOAD(nr, an, bn);
            float ss = 0.f;
#pragma unroll
            for (int j = 0; j < 4; ++j) ss += a[j][0] * a[j][0] + a[j][1] * a[j][1] + a[j][2] * a[j][2] + a[j][3] * a[j][3];
            const float r = rsqrtf(wave_sum(ss) * (1.f / DM) + EPS);
            float* y = row < NP ? out + O_YP + (size_t)row * DM : out + O_YS + (size_t)(row - NP) * DM;
#pragma unroll
            for (int j = 0; j < 4; ++j) *(f32x4*)(y + 4 * lane + 256 * j) = b[j] + a[j] * r * gp[j];
#pragma unroll
            for (int j = 0; j < 4; ++j) { a[j] = an[j]; b[j] = bn[j]; }
        }
#undef P14_LOAD
    }
#undef IN
#undef SEAM
}
constexpr int N_PHASES = 15;
}

extern "C" void kernel_launch(void* const* d_in, const int* in_sizes, int n_in, void* d_out, int out_size, void* d_ws, size_t ws_size, hipStream_t stream) {
    static int grid = 0;
    if (grid == 0) {
        if (n_in != 29 || (size_t)out_size != O_END || ws_size < WS_END) { fprintf(stderr, "kernel_launch: unexpected shapes: n_in %d out %d ws %zu (need %zu)\n", n_in, out_size, ws_size, (size_t)WS_END); grid = -1; return; }
        int dev = 0, cus = 0, per_cu = 0;
        if (hipGetDevice(&dev) != hipSuccess || hipDeviceGetAttribute(&cus, hipDeviceAttributeMultiprocessorCount, dev) != hipSuccess) { grid = -1; return; }
        if (hipFuncSetAttribute((const void*)fwd_kernel, hipFuncAttributeMaxDynamicSharedMemorySize, LDS_BYTES) != hipSuccess) { fprintf(stderr, "kernel_launch: hipFuncSetAttribute failed\n"); grid = -1; return; }
        if (hipOccupancyMaxActiveBlocksPerMultiprocessor(&per_cu, (const void*)fwd_kernel, NTHREADS, LDS_BYTES) != hipSuccess || per_cu < 1) { fprintf(stderr, "kernel_launch: occupancy query says %d\n", per_cu); per_cu = 1; }
        (void)hipGetLastError();
        grid = cus;
    }
    if (grid < 0) return;
    (void)hipMemsetAsync((char*)d_ws + WS_CTL, 0, CTL_BYTES, stream);
    Args a{};
    for (int i = 0; i < 29; ++i) a.in[i] = (const float*)d_in[i];
    a.out = (float*)d_out; a.ws = (unsigned char*)d_ws;
#if MK_ONE_LAUNCH
    a.ph_lo = 0; a.ph_hi = N_PHASES; a.sub = 0xff;
    hipLaunchKernelGGL(fwd_kernel, dim3(grid), dim3(NTHREADS), LDS_BYTES, stream, a);
#if PROBE_DUP >= 0
    a.ph_lo = PROBE_DUP; a.ph_hi = PROBE_DUP + 1; a.sub = PROBE_SUB;
    hipLaunchKernelGGL(fwd_kernel, dim3(grid), dim3(NTHREADS), LDS_BYTES, stream, a);
#endif
#else
    a.sub = 0xff; for (int p = 0; p < N_PHASES; ++p) { a.ph_lo = p; a.ph_hi = p + 1; hipLaunchKernelGGL(fwd_kernel, dim3(grid), dim3(NTHREADS), LDS_BYTES, stream, a); }
#endif
}
```

```cpp
#include <hip/hip_runtime.h>
#include <cstdio>
#include <cstdint>

#ifndef PROBE_DUP
#define PROBE_DUP -1
#endif
#ifndef PROBE_SUB
#define PROBE_SUB 0xff
#endif
#ifndef MK_ONE_LAUNCH
#define MK_ONE_LAUNCH 1
#endif

#define LAS __attribute__((address_space(3)))
#define GAS __attribute__((address_space(1)))
#define DI __device__ __forceinline__
typedef float f32x4 __attribute__((ext_vector_type(4)));
typedef __bf16 bf16x2_t __attribute__((ext_vector_type(2)));
typedef float f32x2_t __attribute__((ext_vector_type(2)));
DI unsigned cvtpk(float lo, float hi) { f32x2_t v = {lo, hi}; bf16x2_t b = __builtin_convertvector(v, bf16x2_t); return __builtin_bit_cast(unsigned, b); }

namespace {
constexpr int DM = 1024, NB = 8, SEQ = 2048, NP = NB * SEQ, DB = 128, DS = 4, NS = DB * DS, NT = NP + NS;
constexpr int PAST = 8192, PAGE = 128, NPAGES = PAST / PAGE;
constexpr int RH = 4, RDK = 128, RDV = 256;
constexpr int MH = 8, QL = 384, KVL = 256, DNOPE = 128, DROPE = 64, DVH = 128, DQH = DNOPE + DROPE;
constexpr int NMEM = 256, XH = 4, XHD = 64;
constexpr int DFF = 2816, DIN = 7104, ZLD = 7168;
constexpr int C_RQ = 0, C_RK = 512, C_RV = 1024, C_RG = 2048, C_CQ = 3072, C_CKV = 3456, C_KPE = 3712, C_XQ = 3776, C_G = 4032;
constexpr float EPS = 1e-6f;
constexpr int NPOS = SEQ + DS;
constexpr int NTHREADS = 512, NWAVES = 8;
constexpr int LDS_BYTES = 147456;
constexpr int MISC_OFF = 147456 - 256;

constexpr size_t O_YP = 0, O_YS = O_YP + (size_t)NP * DM, O_CKVP = O_YS + (size_t)NS * DM, O_KPEP = O_CKVP + (size_t)NP * KVL,
                 O_CKVS = O_KPEP + (size_t)NP * DROPE, O_KPES = O_CKVS + (size_t)NS * KVL, O_RETP = O_KPES + (size_t)NS * DROPE,
                 O_RETS = O_RETP + (size_t)NB * RH * RDK * RDV, O_MKP = O_RETS + (size_t)DB * RH * RDK * RDV, O_MVP = O_MKP + (size_t)NB * NMEM * 256,
                 O_END = O_MVP + (size_t)NB * NMEM * 256;

constexpr size_t al256(size_t x) { return (x + 255) & ~(size_t)255; }
constexpr size_t WS_CTL = 0, CTL_BYTES = 1u << 20;
constexpr size_t WS_COSA = WS_CTL + CTL_BYTES;
constexpr size_t WS_SINA = WS_COSA + al256((size_t)NPOS * 64 * 4);
constexpr size_t WS_COSB = WS_SINA + al256((size_t)NPOS * 64 * 4);
constexpr size_t WS_SINB = WS_COSB + al256((size_t)NPOS * 32 * 4);
constexpr size_t WS_U = WS_SINB + al256((size_t)NPOS * 32 * 4);
constexpr size_t WS_MN = WS_U + (size_t)NT * DM * 4;
constexpr size_t WS_Z = WS_MN + (size_t)NB * NMEM * DM * 4;
constexpr size_t WS_RQ = WS_Z + (size_t)NT * ZLD * 4;
constexpr size_t WS_RK = WS_RQ + (size_t)NT * 512 * 4;
constexpr size_t WS_CQN = WS_RK + (size_t)NT * 512 * 4;
constexpr size_t WS_CKVN = WS_CQN + (size_t)NT * QL * 4;
constexpr size_t WS_KPER = WS_CKVN + (size_t)NT * KVL * 4;
constexpr size_t WS_Q = WS_KPER + (size_t)NT * DROPE * 4;
constexpr size_t WS_QLAT = WS_Q + (size_t)NT * 1536 * 4;
constexpr size_t WS_QPE = WS_QLAT + (size_t)NT * 2048 * 4;
constexpr size_t WS_ORET = WS_QPE + (size_t)NT * 512 * 4;
constexpr size_t WS_OLAT = WS_ORET + (size_t)NT * 1024 * 4;
constexpr size_t WS_OX = WS_OLAT + (size_t)NT * 2048 * 4;
constexpr size_t WS_OMLA = WS_OX + (size_t)NT * 256 * 4;
constexpr size_t WS_ORETN = WS_OMLA + (size_t)NT * 1024 * 4;
constexpr size_t WS_ARET = WS_ORETN + (size_t)NT * 1024 * 4;
constexpr size_t WS_AMLA = WS_ARET + (size_t)NT * 1024 * 4;
constexpr size_t WS_AX = WS_AMLA + (size_t)NT * 1024 * 4;
constexpr size_t WS_MIX = WS_AX + (size_t)NT * 1024 * 4;
constexpr size_t WS_HP = WS_MIX + (size_t)NT * 1024 * 4;
constexpr size_t WS_H = WS_HP + (size_t)NT * 1024 * 4;
constexpr size_t WS_F = WS_H + (size_t)NT * 1024 * 4;
constexpr size_t WS_GG = WS_F + (size_t)NT * 1024 * 4;
constexpr size_t WS_UP = WS_GG + (size_t)NT * DFF * 4;
constexpr size_t WS_ACT = WS_UP + (size_t)NT * DFF * 4;
constexpr size_t WS_FO = WS_ACT + (size_t)NT * DFF * 4;
constexpr size_t WS_F32_END = WS_FO + (size_t)NT * 1024 * 4;
constexpr size_t WS_WIN_T = al256(WS_F32_END);
constexpr size_t WS_WMKV_T = WS_WIN_T + (size_t)ZLD * 1024 * 2;
constexpr size_t WS_WUQ_T = WS_WMKV_T + (size_t)512 * 1024 * 2;
constexpr size_t WS_WRO_T = WS_WUQ_T + (size_t)1536 * 384 * 2;
constexpr size_t WS_WMO_T = WS_WRO_T + (size_t)1024 * 1024 * 2;
constexpr size_t WS_WXO_T = WS_WMO_T + (size_t)1024 * 1024 * 2;
constexpr size_t WS_WO_T = WS_WXO_T + (size_t)1024 * 256 * 2;
constexpr size_t WS_WGU_T = WS_WO_T + (size_t)1024 * 1024 * 2;
constexpr size_t WS_WD_T = WS_WGU_T + (size_t)5632 * 1024 * 2;
constexpr size_t WS_UB = WS_WD_T + (size_t)1024 * 2816 * 2;
constexpr size_t WS_MNB = WS_UB + (size_t)NT * 1024 * 2;
constexpr size_t WS_CQNB = WS_MNB + (size_t)2048 * 1024 * 2;
constexpr size_t WS_ORETNB = WS_CQNB + (size_t)NT * 384 * 2;
constexpr size_t WS_OMLAB = WS_ORETNB + (size_t)NT * 1024 * 2;
constexpr size_t WS_OXB = WS_OMLAB + (size_t)NT * 1024 * 2;
constexpr size_t WS_MIXB = WS_OXB + (size_t)NT * 256 * 2;
constexpr size_t WS_FB = WS_MIXB + (size_t)NT * 1024 * 2;
constexpr size_t WS_ACTB = WS_FB + (size_t)NT * 1024 * 2;
constexpr size_t WS_WUK_T = WS_ACTB + (size_t)NT * 2816 * 2;
constexpr size_t WS_WUV_T = WS_WUK_T + (size_t)1024 * 256 * 2;
constexpr size_t WS_CKVNB = WS_WUV_T + (size_t)1024 * 256 * 2;
constexpr size_t WS_KPERB = WS_CKVNB + (size_t)NT * 256 * 2;
constexpr size_t WS_XQB = WS_KPERB + (size_t)NT * 64 * 2;
constexpr size_t WS_MKB = WS_XQB + (size_t)NT * 256 * 2;
constexpr size_t WS_MVT = WS_MKB + (size_t)2048 * 256 * 2;
constexpr size_t WS_KN = WS_MVT + (size_t)2048 * 256 * 2;
constexpr size_t WS_VT = WS_KN + (size_t)NP * 1024 * 2;
constexpr size_t WS_QB = WS_VT + (size_t)NP * 1024 * 2;
constexpr size_t WS_RQT = WS_QB + (size_t)NT * 1536 * 2;
constexpr size_t WS_RKT = WS_RQT + (size_t)NP * 512 * 2;
constexpr size_t WS_RKTT = WS_RKT + (size_t)NP * 512 * 2;
constexpr size_t WS_RVT = WS_RKTT + (size_t)NP * 512 * 2;
constexpr size_t WS_UT = WS_RVT + (size_t)NT * 1024 * 2;
constexpr size_t WS_SPT = WS_UT + (size_t)512 * 32768 * 4;
constexpr size_t WS_QLATB = WS_SPT + (size_t)512 * 32768 * 2;
constexpr size_t WS_PO = WS_QLATB + (size_t)NS * 2048 * 2;
constexpr size_t WS_PML = WS_PO + (size_t)DB * 2 * 32 * 256 * 4;
constexpr size_t WS_PART = al256(WS_PML + (size_t)DB * 2 * 32 * 2 * 4);
constexpr size_t WS_QPEB_ = WS_PART + (size_t)11 * 512 * 1024 * 4;
constexpr size_t WS_QPEB = al256(WS_QPEB_ + 0 * WS_PML + (size_t)DB * 2 * 32 * 2 * 4);
constexpr size_t WS_WUKB = WS_QPEB + (size_t)NT * 512 * 2;
constexpr size_t WS_END = WS_WUKB + (size_t)8 * 256 * 128 * 2;

constexpr int CW_BAR = 4096;

#define XB_TMO      128
#define XB_XCNT(j)  (256  + 64 * (j))
#define XB_XSUB(j)  (1280 + 64 * (j))
#define XB_XGEN(j)  (2304 + 64 * (j))
#define XB_TOP      3328
#define XB_TOPGEN   3392
#define XCD_BAR_WORDS 3456
#define XB_SPIN_CAP (1u << 25)

DI unsigned xb_ld(unsigned* p)              { return __hip_atomic_load(p, __ATOMIC_RELAXED, __HIP_MEMORY_SCOPE_AGENT); }
DI unsigned xb_add(unsigned* p, unsigned v) { return __hip_atomic_fetch_add(p, v, __ATOMIC_RELAXED, __HIP_MEMORY_SCOPE_AGENT); }
DI unsigned xb_xcc_id() { return (unsigned)__builtin_amdgcn_s_getreg((3 << 11) | 20) & 0xFu; }
#define XB_SPIN(cond, bar) do { unsigned _sp = 0; while (cond) { __builtin_amdgcn_s_sleep(1); \
    if ((++_sp & 255u) == 0u) { if (xb_ld(&(bar)[XB_TMO])) break; if (_sp > XB_SPIN_CAP) { atomicAdd(&(bar)[XB_TMO], 1u); break; } } } } while (0)

struct XcdBarrier { unsigned* bar; unsigned x; volatile LAS unsigned* st; };

DI XcdBarrier xcd_barrier_post(unsigned* bar, volatile LAS unsigned* st) {
    XcdBarrier b; b.bar = bar; b.x = xb_xcc_id(); b.st = st;
    if (threadIdx.x == 0) (void)xb_add(&bar[XB_XCNT(b.x)], 1u);
    return b;
}
DI void xcd_barrier_complete(unsigned* bar, unsigned x, unsigned& nloc, unsigned& nx) {
    const unsigned G = gridDim.x * gridDim.y * gridDim.z;
    unsigned sum, cnt, mine, sp = 0u;
    for (;;) {
        sum = 0u; cnt = 0u; mine = 0u;
#pragma unroll
        for (unsigned j = 0; j < 16; ++j) { const unsigned c = xb_ld(&bar[XB_XCNT(j)]); sum += c; cnt += (c > 0u) ? 1u : 0u; mine = (j == x) ? c : mine; }
        if (sum == G) break;
        __builtin_amdgcn_s_sleep(1);
        if ((++sp & 255u) == 0u) { if (xb_ld(&bar[XB_TMO])) break; if (sp > XB_SPIN_CAP) { atomicAdd(&bar[XB_TMO], 1u); break; } }
    }
    nloc = mine > 0u ? mine : 1u; nx = cnt > 0u ? cnt : 1u;
}
DI void xcd_barrier(const XcdBarrier& b) {
    asm volatile("s_waitcnt vmcnt(0)" ::: "memory");
    __syncthreads();
    if (threadIdx.x == 0) {
        unsigned* bar = b.bar;
        __builtin_amdgcn_s_waitcnt(0);
        unsigned nloc = b.st[0], nx = b.st[1];
        if (nloc == 0u) { xcd_barrier_complete(bar, b.x, nloc, nx); b.st[0] = nloc; b.st[1] = nx; }
        const unsigned old = xb_add(&bar[XB_XSUB(b.x)], 1u);
        const unsigned gen = old / nloc;
        if (old + 1u == (gen + 1u) * nloc) {
            __builtin_amdgcn_fence(__ATOMIC_RELEASE, "agent");
            asm volatile("s_waitcnt vmcnt(0)" ::: "memory");
            const unsigned og = xb_add(&bar[XB_TOP], 1u);
            const unsigned tg = og / nx;
            if (og + 1u == (tg + 1u) * nx) xb_add(&bar[XB_TOPGEN], 1u);
            else XB_SPIN(xb_ld(&bar[XB_TOPGEN]) == tg, bar);
            __builtin_amdgcn_fence(__ATOMIC_ACQUIRE, "agent");
            xb_add(&bar[XB_XGEN(b.x)], 1u);
            asm volatile("s_waitcnt vmcnt(0)" ::: "memory");
        } else {
            XB_SPIN(xb_ld(&bar[XB_XGEN(b.x)]) == gen, bar);
            __builtin_amdgcn_fence(__ATOMIC_ACQUIRE, "agent");
            asm volatile("s_waitcnt vmcnt(0)" ::: "memory");
        }
    }
    __syncthreads();
}

DI float wave_sum(float v) {
#pragma unroll
    for (int o = 1; o < 64; o <<= 1) v += __shfl_xor(v, o);
    return v;
}
DI float wave_max(float v) {
#pragma unroll
    for (int o = 1; o < 64; o <<= 1) v = fmaxf(v, __shfl_xor(v, o));
    return v;
}
DI float sigmoidf_(float x) { return 1.f / (1.f + expf(-x)); }
DI float siluf_(float x) { return x / (1.f + expf(-x)); }
DI int pos_index(int row) { return row < NP ? (row & (SEQ - 1)) : SEQ + ((row - NP) & (DS - 1)); }
DI float lg_gamma(int h) { return h == 0 ? -0.03174869831458027f : h == 1 ? -0.015748356968139112f : h == 2 ? -0.007843177461025892f : -0.003913899321136329f; }


namespace pg8 {
typedef unsigned short bf16_t;
typedef short bf16x8 __attribute__((ext_vector_type(8)));
typedef unsigned u32x4 __attribute__((ext_vector_type(4)));
typedef unsigned u32x2 __attribute__((ext_vector_type(2)));
constexpr int BM = 256, BK = 64, HALF = 128, HTB = HALF * BK * 2, STAGE_BYTES = 8 * HTB, NXCD = 8, WGM = 8;
__host__ __device__ __forceinline__ int lds_byte(int r, int c) { const int st = (r >> 4) * 2 + (c >> 5), rr = r & 15, cc = c & 31, ob = rr * 64 + cc * 2; return st * 1024 + (ob ^ (((ob >> 9) & 1) << 5)); }
__host__ __device__ __forceinline__ void stage_rc(int b, int& R, int& C) { const int st = b / 1024, sb = b % 1024, swz = sb ^ (((sb >> 9) & 1) << 5); R = (st >> 1) * 16 + swz / 64; C = (st & 1) * 32 + (swz % 64) / 2; }
__host__ __device__ __forceinline__ int perm32(int rho) { const int n = rho >> 4, i = rho & 15; return 8 * (i >> 2) + 4 * n + (i & 3); }
struct Unit { int pm, pn, ks; };
struct Gemm { const bf16_t* A; const bf16_t* Bt; int M, N, K, lda, ldb, ksl; };
struct StaticOrder {
    int nM, nN, nwg, G, c;
    __host__ __device__ void init(int M, int N, int G_, int c_) { nM = M / BM; nN = N / BM; nwg = nM * nN; G = G_; c = c_; }
    __host__ __device__ bool next(int i, Unit& u) const {
        const long L = (long)i * G + c; if (L >= nwg) return false;
        int wgid = (int)L; { const int q = nwg / NXCD, r = nwg % NXCD, xcd = wgid % NXCD, off = wgid / NXCD; wgid = (xcd < r ? xcd * (q + 1) : r * (q + 1) + (xcd - r) * q) + off; }
        const int nig = WGM * nN, gid = wgid / nig, fm = gid * WGM, gsz = (nM - fm) < WGM ? (nM - fm) : WGM;
        u.pm = fm + ((wgid % nig) % gsz); u.pn = (wgid % nig) / gsz; u.ks = 0; return true;
    }
    __device__ __forceinline__ void a_ready(const Unit&) const {}
    __device__ __forceinline__ void done(const Unit&) const {}
};
__device__ __forceinline__ unsigned cvt_pk_bf16(float lo, float hi) { return cvtpk(lo, hi); }
struct SplitOrder {
    int KS, c;
    __host__ __device__ bool next(int i, Unit& u) const { if (i != 0 || c >= 8 * KS) return false; const int tile = c / KS; u.ks = c % KS; u.pm = 64 + (tile >> 2); u.pn = tile & 3; return true; }
    __device__ __forceinline__ void a_ready(const Unit&) const {}
    __device__ __forceinline__ void done(const Unit&) const {}
};
struct EpiPart {
    static constexpr bool PERM = false, AFTER_DRAIN = false;
    float* C;
    __device__ __forceinline__ void operator()(const f32x4 (&acc)[2][2][4][2], const Unit& u, int wr, int wc, int fr, int fq) const {
        const int row0 = (u.pm - 64) * BM + wr * 64 + fr, col0 = u.pn * BM + wc * 32 + 4 * fq; float* base = C + (size_t)u.ks * (512 * 1024);
#pragma unroll
        for (int ai = 0; ai < 2; ++ai)
#pragma unroll
            for (int m = 0; m < 4; ++m) { float* rowp = base + (size_t)(row0 + ai * HALF + m * 16) * 1024 + col0;
#pragma unroll
                for (int bj = 0; bj < 2; ++bj)
#pragma unroll
                    for (int n = 0; n < 2; ++n) *(f32x4*)(rowp + bj * HALF + n * 16) = acc[ai][bj][m][n]; }
    }
};
struct P1Order {
    StaticOrder so;
    __host__ __device__ void init(int G_, int c_) { so.init(64 * 256, 24 * 256, G_, c_); }
    __host__ __device__ bool next(int i, Unit& u) const {
        const long L = (long)i * so.G + so.c;
        if (L < 1536) { so.next(i, u); if (u.pn >= 4) u.pn += 4; return true; }
        u.ks = 0;
        if (L < 1536 + 56) { const int idx = (int)L - 1536; u.pm = 64 + idx / 28; u.pn = idx % 28; return true; }
        if (L < 1536 + 56 + 16) { const int idx = (int)L - 1592; u.pm = 66 + idx / 2; u.pn = 28 + idx % 2; return true; }
        return false;
    }
    __device__ __forceinline__ void a_ready(const Unit&) const {}
    __device__ __forceinline__ void done(const Unit&) const {}
};
struct EpiP1 {
    static constexpr bool PERM = false, AFTER_DRAIN = false;
    float* Zp; int ldz; float* mk; float* mv;
    __device__ __forceinline__ void operator()(const f32x4 (&acc)[2][2][4][2], const Unit& u, int wr, int wc, int fr, int fq) const {
        float* base; int ldc, row0, col0;
        if (u.pm < 66) { base = Zp; ldc = ldz; row0 = u.pm * BM + wr * 64 + fr; col0 = u.pn * BM + wc * 32 + 4 * fq; }
        else { base = (u.pn == 28) ? mk : mv; ldc = 256; row0 = (u.pm - 66) * BM + wr * 64 + fr; col0 = wc * 32 + 4 * fq; }
#pragma unroll
        for (int ai = 0; ai < 2; ++ai)
#pragma unroll
            for (int m = 0; m < 4; ++m) { float* rowp = base + (size_t)(row0 + ai * HALF + m * 16) * ldc + col0;
#pragma unroll
                for (int bj = 0; bj < 2; ++bj)
#pragma unroll
                    for (int n = 0; n < 2; ++n) *(f32x4*)(rowp + bj * HALF + n * 16) = acc[ai][bj][m][n]; }
    }
};
struct EpiF32S {
    static constexpr bool PERM = false, AFTER_DRAIN = false;
    float* C; int ldc; int split_tiles; size_t split_stride;
    __device__ __forceinline__ void operator()(const f32x4 (&acc)[2][2][4][2], const Unit& u, int wr, int wc, int fr, int fq) const {
        int pn = u.pn; float* base = C; if (split_tiles) { const int t = pn / split_tiles; base += (size_t)t * split_stride; pn -= t * split_tiles; }
        const int row0 = u.pm * BM + wr * 64 + fr, col0 = pn * BM + wc * 32 + 4 * fq;
#pragma unroll
        for (int ai = 0; ai < 2; ++ai)
#pragma unroll
            for (int m = 0; m < 4; ++m) { float* rowp = base + (size_t)(row0 + ai * HALF + m * 16) * ldc + col0;
#pragma unroll
                for (int bj = 0; bj < 2; ++bj)
#pragma unroll
                    for (int n = 0; n < 2; ++n) *(f32x4*)(rowp + bj * HALF + n * 16) = acc[ai][bj][m][n]; }
    }
};
struct EpiBf16S {
    static constexpr bool PERM = true, AFTER_DRAIN = false;
    bf16_t* O; int ldc;
    __device__ __forceinline__ void operator()(const f32x4 (&acc)[2][2][4][2], const Unit& u, int wr, int wc, int fr, int fq) const {
        const int row0 = u.pm * BM + wr * 64 + fr, col0 = u.pn * BM + wc * 32 + 8 * fq;
#pragma unroll
        for (int ai = 0; ai < 2; ++ai)
#pragma unroll
            for (int m = 0; m < 4; ++m) { bf16_t* rowp = O + (size_t)(row0 + ai * HALF + m * 16) * ldc + col0;
#pragma unroll
                for (int bj = 0; bj < 2; ++bj) { const f32x4 v0 = acc[ai][bj][m][0], v1 = acc[ai][bj][m][1];
                    u32x4 w; w.x = cvt_pk_bf16(v0[0], v0[1]); w.y = cvt_pk_bf16(v0[2], v0[3]); w.z = cvt_pk_bf16(v1[0], v1[1]); w.w = cvt_pk_bf16(v1[2], v1[3]);
                    *(u32x4*)(rowp + bj * HALF) = w; } }
    }
};
struct EpiSwiGLU {
    static constexpr bool PERM = true, AFTER_DRAIN = false;
    bf16_t* O; int ldc;
    __device__ __forceinline__ void operator()(const f32x4 (&acc)[2][2][4][2], const Unit& u, int wr, int wc, int fr, int fq) const {
        const int row0 = u.pm * BM + wr * 64 + fr, col0 = u.pn * (BM / 2) + wc * 16 + 4 * fq;
#pragma unroll
        for (int ai = 0; ai < 2; ++ai)
#pragma unroll
            for (int m = 0; m < 4; ++m) { bf16_t* rowp = O + (size_t)(row0 + ai * HALF + m * 16) * ldc + col0;
#pragma unroll
                for (int bj = 0; bj < 2; ++bj) { const f32x4 v0 = acc[ai][bj][m][0], v1 = acc[ai][bj][m][1];
                    const float a0 = v0[0] / (1.f + __expf(-v0[0])) * v0[1], a1 = v0[2] / (1.f + __expf(-v0[2])) * v0[3];
                    const float a2 = v1[0] / (1.f + __expf(-v1[0])) * v1[1], a3 = v1[2] / (1.f + __expf(-v1[2])) * v1[3];
                    u32x2 w; w.x = cvt_pk_bf16(a0, a1); w.y = cvt_pk_bf16(a2, a3);
                    *(u32x2*)(rowp + bj * (HALF / 2)) = w; } }
    }
};
template <int MODE  > struct EpiGate {
    static constexpr bool PERM = false, AFTER_DRAIN = false;
    const float* gate; int ldg; float* mix; bf16_t* mixb; int ldc;
    __device__ __forceinline__ void operator()(const f32x4 (&acc)[2][2][4][2], const Unit& u, int wr, int wc, int fr, int fq) const {
        const int row0 = u.pm * BM + wr * 64 + fr, col0 = u.pn * BM + wc * 32 + 4 * fq;
#pragma unroll
        for (int ai = 0; ai < 2; ++ai)
#pragma unroll
            for (int m = 0; m < 4; ++m) { const size_t r = (size_t)(row0 + ai * HALF + m * 16);
#pragma unroll
                for (int bj = 0; bj < 2; ++bj)
#pragma unroll
                    for (int n = 0; n < 2; ++n) { const int c = col0 + bj * HALF + n * 16;
                        const f32x4 gz = *(const f32x4*)(gate + r * ldg + c); f32x4 v = acc[ai][bj][m][n];
#pragma unroll
                        for (int e = 0; e < 4; ++e) v[e] = v[e] / (1.f + __expf(-gz[e]));
                        if (MODE >= 1) v += *(const f32x4*)(mix + r * ldc + c);
                        if (MODE <= 1) *(f32x4*)(mix + r * ldc + c) = v;
                        else { u32x2 w; w.x = cvt_pk_bf16(v[0], v[1]); w.y = cvt_pk_bf16(v[2], v[3]); *(u32x2*)(mixb + r * ldc + c) = w; } } }
    }
};
template <class Epi, class Sched, bool ALIGN_EPI = false, bool SP2 = false>
__device__ __forceinline__ void gemm_phase(LAS unsigned char* lds, const Gemm g, const Sched& S, const Epi& E) {
    const int tid = threadIdx.x, wid = __builtin_amdgcn_readfirstlane(tid >> 6), lane = tid & 63, wr = wid >> 2, wc = wid & 3, fr = lane & 15, fq = lane >> 4;
    const int K = g.K, nt = K / BK;
    unsigned voffA[2], voffB[2];
#pragma unroll
    for (int i = 0; i < 2; ++i) { int R, C; stage_rc(tid * 16 + i * 8192, R, C); const int Rb = Epi::PERM ? ((R & ~31) + perm32(R & 31)) : R;
        voffA[i] = (unsigned)(R * g.lda + C) * 2u; voffB[i] = (unsigned)(Rb * g.ldb + C) * 2u; }
    const size_t kstep = (size_t)(BK * 2);
    const size_t hstepA = (size_t)HALF * g.lda * 2, hstepB = (size_t)HALF * g.ldb * 2;
    const size_t tstepA = 2 * hstepA, tstepB = 2 * hstepB;
    const unsigned ldsw = (unsigned)wid * 1024u;
    const int aoff = lds_byte(wr * 64 + fr, fq * 8), boff = lds_byte(wc * 32 + fr, fq * 8);
#define PG8_SA(b, h) (((b) * 2 + (h)) * HTB)
#define PG8_SB(b, h) ((4 + (b) * 2 + (h)) * HTB)
#define PG8_STAGE(bufoff, gbase, voff) do { _Pragma("unroll") for (int _i = 0; _i < 2; ++_i) \
        __builtin_amdgcn_global_load_lds((const unsigned*)((const char*)(gbase) + (voff)[_i]), (LAS unsigned*)(lds + (bufoff) + ldsw + _i * 8192), 16, 0, 0); } while (0)
#define PG8_LDA(dst, b, h) do { _Pragma("unroll") for (int m = 0; m < 4; ++m) _Pragma("unroll") for (int k = 0; k < 2; ++k) dst[m][k] = *(const LAS bf16x8*)(lds + PG8_SA(b, h) + aoff + m * 2048 + k * 1024); } while (0)
#define PG8_LDB(dst, b, h) do { _Pragma("unroll") for (int n = 0; n < 2; ++n) _Pragma("unroll") for (int k = 0; k < 2; ++k) dst[n][k] = *(const LAS bf16x8*)(lds + PG8_SB(b, h) + boff + n * 2048 + k * 1024); } while (0)
#define PG8_MMA(ai, bj, At, Bt) do { __builtin_amdgcn_s_setprio(1); _Pragma("unroll") for (int m = 0; m < 4; ++m) _Pragma("unroll") for (int n = 0; n < 2; ++n) _Pragma("unroll") for (int k = 0; k < 2; ++k) \
        acc[ai][bj][m][n] = __builtin_amdgcn_mfma_f32_16x16x32_bf16(Bt[n][k], At[m][k], acc[ai][bj][m][n], 0, 0, 0); __builtin_amdgcn_s_setprio(0); } while (0)
#define PG8_WAIT_V(n) asm volatile("s_waitcnt vmcnt(" #n ")" ::: "memory")
#define PG8_WAIT_L(n) asm volatile("s_waitcnt lgkmcnt(" #n ")" ::: "memory")
#define PG8_BAR __builtin_amdgcn_s_barrier()
#define PG8_SCHED __builtin_amdgcn_sched_barrier(0)
    Unit cur, nxt; int ui = 0;
    if (!S.next(0, cur)) return;
    f32x4 acc[2][2][4][2];
#pragma unroll
    for (int a = 0; a < 2; ++a)
#pragma unroll
        for (int b = 0; b < 2; ++b)
#pragma unroll
            for (int m = 0; m < 4; ++m)
#pragma unroll
                for (int n = 0; n < 2; ++n) acc[a][b][m][n] = (f32x4){0.f, 0.f, 0.f, 0.f};
    bf16x8 At[4][2], B0[2][2], B1[2][2];
    const size_t kslb = (size_t)g.ksl * 2;
    const char* cA = (const char*)g.A + (size_t)cur.pm * tstepA + cur.ks * kslb; const char* cB = (const char*)g.Bt + (size_t)cur.pn * tstepB + cur.ks * kslb;
    S.a_ready(cur);
    if constexpr (SP2) {
        PG8_STAGE(PG8_SB(0, 0), cB, voffB); PG8_STAGE(PG8_SB(0, 1), cB + hstepB, voffB); PG8_STAGE(PG8_SA(0, 0), cA, voffA); PG8_STAGE(PG8_SA(0, 1), cA + hstepA, voffA);
        if (wr == 1) PG8_BAR;
        PG8_WAIT_V(2); PG8_BAR;
        PG8_STAGE(PG8_SB(1, 0), cB + kstep, voffB); PG8_STAGE(PG8_SA(1, 0), cA + kstep, voffA); PG8_STAGE(PG8_SB(1, 1), cB + hstepB + kstep, voffB);
        PG8_WAIT_V(6); PG8_BAR;
    } else {
        PG8_STAGE(PG8_SB(0, 0), cB, voffB); PG8_STAGE(PG8_SA(0, 0), cA, voffA); PG8_STAGE(PG8_SB(0, 1), cB + hstepB, voffB); PG8_STAGE(PG8_SA(0, 1), cA + hstepA, voffA);
        if (wr == 1) PG8_BAR;
        PG8_WAIT_V(4); PG8_BAR;
        PG8_STAGE(PG8_SB(1, 0), cB + kstep, voffB); PG8_STAGE(PG8_SA(1, 0), cA + kstep, voffA); PG8_STAGE(PG8_SB(1, 1), cB + hstepB + kstep, voffB);
        PG8_WAIT_V(6); PG8_BAR;
    }
    for (;;) {
        const bool has_next = S.next(ui + 1, nxt);
        const char* nA = has_next ? (const char*)g.A + (size_t)nxt.pm * tstepA + nxt.ks * kslb : cA; const char* nB = has_next ? (const char*)g.Bt + (size_t)nxt.pn * tstepB + nxt.ks * kslb : cB;
#pragma unroll 1
        for (int t = 0; t < nt; t += 2) {
            const bool last = (t == nt - 2);
            const char* a1 = cA + (size_t)(t + 1) * kstep;
            const char* a2 = last ? nA : cA + (size_t)(t + 2) * kstep; const char* b2 = last ? nB : cB + (size_t)(t + 2) * kstep;
            const char* a3 = a2 + kstep; const char* b3 = b2 + kstep;
            if (last && has_next) S.a_ready(nxt);
            if constexpr (SP2) {
            PG8_LDB(B0, 0, 0); PG8_LDB(B1, 0, 1); PG8_SCHED; PG8_LDA(At, 0, 0); PG8_STAGE(PG8_SA(1, 1), a1 + hstepA, voffA);
            PG8_WAIT_V(8); PG8_WAIT_L(0); PG8_BAR; PG8_MMA(0, 0, At, B0); PG8_MMA(0, 1, At, B1); PG8_BAR; PG8_SCHED;
            PG8_LDA(At, 0, 1); PG8_STAGE(PG8_SB(0, 0), b2, voffB); PG8_STAGE(PG8_SB(0, 1), b2 + hstepB, voffB); PG8_STAGE(PG8_SA(0, 0), a2, voffA);
            PG8_WAIT_V(8); PG8_WAIT_L(0); PG8_BAR; PG8_MMA(1, 0, At, B0); PG8_MMA(1, 1, At, B1); PG8_BAR; PG8_SCHED;
            PG8_LDB(B0, 1, 0); PG8_LDB(B1, 1, 1); PG8_SCHED; PG8_LDA(At, 1, 0); PG8_STAGE(PG8_SA(0, 1), a2 + hstepA, voffA);
            PG8_WAIT_V(8); PG8_WAIT_L(0); PG8_BAR; PG8_MMA(0, 0, At, B0); PG8_MMA(0, 1, At, B1); PG8_BAR; PG8_SCHED;
            PG8_LDA(At, 1, 1); PG8_STAGE(PG8_SB(1, 0), b3, voffB); PG8_STAGE(PG8_SB(1, 1), b3 + hstepB, voffB); PG8_STAGE(PG8_SA(1, 0), a3, voffA);
            PG8_WAIT_V(8); PG8_WAIT_L(0); PG8_BAR; PG8_MMA(1, 0, At, B0); PG8_MMA(1, 1, At, B1); PG8_BAR; PG8_SCHED;
            } else {
            PG8_LDB(B0, 0, 0); PG8_SCHED; PG8_LDA(At, 0, 0); PG8_STAGE(PG8_SA(1, 1), a1 + hstepA, voffA);
            PG8_WAIT_L(8); PG8_BAR; PG8_WAIT_L(0); PG8_MMA(0, 0, At, B0); PG8_BAR; PG8_SCHED;
            PG8_LDB(B1, 0, 1); PG8_STAGE(PG8_SB(0, 0), b2, voffB);
            PG8_BAR; PG8_WAIT_L(0); PG8_MMA(0, 1, At, B1); PG8_BAR;
            PG8_LDA(At, 0, 1); PG8_STAGE(PG8_SA(0, 0), a2, voffA);
            PG8_BAR; PG8_WAIT_L(0); PG8_MMA(1, 0, At, B0); PG8_BAR; PG8_SCHED;
            PG8_STAGE(PG8_SB(0, 1), b2 + hstepB, voffB);
            PG8_WAIT_V(6); PG8_BAR; PG8_MMA(1, 1, At, B1); PG8_BAR;
            PG8_LDB(B0, 1, 0); PG8_SCHED; PG8_LDA(At, 1, 0); PG8_STAGE(PG8_SA(0, 1), a2 + hstepA, voffA);
            PG8_WAIT_L(8); PG8_BAR; PG8_WAIT_L(0); PG8_MMA(0, 0, At, B0); PG8_BAR; PG8_SCHED;
            PG8_LDB(B1, 1, 1); PG8_STAGE(PG8_SB(1, 0), b3, voffB);
            PG8_BAR; PG8_WAIT_L(0); PG8_MMA(0, 1, At, B1); PG8_BAR;
            PG8_LDA(At, 1, 1); PG8_STAGE(PG8_SA(1, 0), a3, voffA);
            PG8_BAR; PG8_WAIT_L(0); PG8_MMA(1, 0, At, B0); PG8_BAR; PG8_SCHED;
            PG8_STAGE(PG8_SB(1, 1), b3 + hstepB, voffB);
            PG8_WAIT_V(6); PG8_BAR; PG8_MMA(1, 1, At, B1); PG8_BAR;
            }
        }
        if constexpr (ALIGN_EPI) { if (wr == 0) PG8_BAR; }
        if constexpr (!Epi::AFTER_DRAIN) { E(acc, cur, wr, wc, fr, fq); S.done(cur); }
        if (!has_next) break;
#pragma unroll
        for (int a = 0; a < 2; ++a)
#pragma unroll
            for (int b = 0; b < 2; ++b)
#pragma unroll
                for (int m = 0; m < 4; ++m)
#pragma unroll
                    for (int n = 0; n < 2; ++n) acc[a][b][m][n] = (f32x4){0.f, 0.f, 0.f, 0.f};
        cur = nxt; cA = nA; cB = nB; ++ui;
        if constexpr (ALIGN_EPI) { if (wr == 1) PG8_BAR; }
    }
    PG8_WAIT_V(0);
    if constexpr (!ALIGN_EPI) { if (wr == 0) PG8_BAR; }
    PG8_BAR;
    if constexpr (Epi::AFTER_DRAIN) { E.fused(acc, cur, wr, wc, fr, fq, lds, wid, lane); S.done(cur); }
#undef PG8_SA
#undef PG8_SB
#undef PG8_STAGE
#undef PG8_LDA
#undef PG8_LDB
#undef PG8_MMA
#undef PG8_WAIT_V
#undef PG8_WAIT_L
#undef PG8_BAR
#undef PG8_SCHED
}
}
typedef unsigned short bf16_t;
DI unsigned pk2(float lo, float hi) { return pg8::cvt_pk_bf16(lo, hi); }
DI bf16_t f2bf(float f) { return (bf16_t)(pg8::cvt_pk_bf16(f, 0.f) & 0xffffu); }
DI void transpose_item(const float* W, int N, bf16_t* WT, int ldt, int row_off, int rmul, LAS float* scr, int item, int lane) {
    const int nblk = N / 32, kb = item / nblk, nb = item % nblk, k0 = 64 * kb, n0 = 32 * nb;
#pragma unroll 8
    for (int i = 0; i < 32; ++i) { const int kk = 2 * i + (lane >> 5); scr[kk * 33 + (lane & 31)] = W[(size_t)(k0 + kk) * N + n0 + (lane & 31)]; }
    asm volatile("s_waitcnt lgkmcnt(0)" ::: "memory");
    const int c = lane & 7;
#pragma unroll
    for (int j = 0; j < 4; ++j) { const int n = (lane >> 3) + 8 * j; const LAS float* sp = scr + (8 * c) * 33 + n;
        pg8::u32x4 o; o.x = pk2(sp[0 * 33], sp[1 * 33]); o.y = pk2(sp[2 * 33], sp[3 * 33]); o.z = pk2(sp[4 * 33], sp[5 * 33]); o.w = pk2(sp[6 * 33], sp[7 * 33]);
        *(pg8::u32x4*)(WT + (size_t)(row_off + rmul * (n0 + n)) * ldt + k0 + 8 * c) = o; }
    asm volatile("s_waitcnt lgkmcnt(0)" ::: "memory");
}
DI void transpose_w(const float* W, int K, int N, bf16_t* WT, int ldt, int row_off, LAS float* scr, int gw, int NGW, int lane, int& rot, int rmul = 1) {
    const int nitems = (K / 64) * (N / 32);
    int first = gw - (rot % NGW); if (first < 0) first += NGW;
    for (int it = first; it < nitems; it += NGW) transpose_item(W, N, WT, ldt, row_off, rmul, scr, it, lane);
    rot += nitems;
}

struct Args {
    const float* in[29]; float* out; unsigned char* ws; int ph_lo, ph_hi, sub, pad;
};

DI unsigned short f2bf_raw(float f) { unsigned u = __builtin_bit_cast(unsigned, f); return (unsigned short)((u + 0x7fffu + ((u >> 16) & 1u)) >> 16); }
DI void sgemm_naive(LAS float* lds, const float* __restrict__ A, int lda, const float* __restrict__ B, long sbk, long sbn,
                    float* __restrict__ C, int ldc, int M, int N, int K, int bid, int G, unsigned short* Cb = nullptr) {
    LAS float* As = lds;
    LAS float* Bs = lds + 16 * 132;
    const int tid = threadIdx.x, tx = tid & 15, ty = tid >> 4;
    const int ntn = N / 64, ntiles = (M / 128) * ntn;
    for (int t = bid; t < ntiles; t += G) {
        const int m0 = (t / ntn) * 128, n0 = (t % ntn) * 64;
        float acc[4][4];
#pragma unroll
        for (int i = 0; i < 4; ++i)
#pragma unroll
            for (int j = 0; j < 4; ++j) acc[i][j] = 0.f;
        for (int k0 = 0; k0 < K; k0 += 16) {
            {
                const int r = tid >> 2, kq = (tid & 3) * 4;
                const float4 v = *(const float4*)(A + (size_t)(m0 + r) * lda + k0 + kq);
                As[(kq + 0) * 132 + r] = v.x; As[(kq + 1) * 132 + r] = v.y; As[(kq + 2) * 132 + r] = v.z; As[(kq + 3) * 132 + r] = v.w;
            }
#pragma unroll
            for (int i = 0; i < 2; ++i) {
                const int idx = tid + i * 512, kk = idx >> 6, nn = idx & 63;
                Bs[kk * 64 + nn] = B[(size_t)(k0 + kk) * sbk + (size_t)(n0 + nn) * sbn];
            }
            __syncthreads();
#pragma unroll
            for (int kk = 0; kk < 16; ++kk) {
                const f32x4 a = *(const LAS f32x4*)(As + kk * 132 + ty * 4);
                const f32x4 b = *(const LAS f32x4*)(Bs + kk * 64 + tx * 4);
                const float av[4] = {a.x, a.y, a.z, a.w}, bv[4] = {b.x, b.y, b.z, b.w};
#pragma unroll
                for (int i = 0; i < 4; ++i)
#pragma unroll
                    for (int j = 0; j < 4; ++j) acc[i][j] += av[i] * bv[j];
            }
            __syncthreads();
        }
#pragma unroll
        for (int i = 0; i < 4; ++i) {
            float4 o; o.x = acc[i][0]; o.y = acc[i][1]; o.z = acc[i][2]; o.w = acc[i][3];
            if (Cb) { unsigned short* cb = Cb + (size_t)(m0 + ty * 4 + i) * ldc + n0 + tx * 4; cb[0] = f2bf_raw(o.x); cb[1] = f2bf_raw(o.y); cb[2] = f2bf_raw(o.z); cb[3] = f2bf_raw(o.w); }
            else *(float4*)(C + (size_t)(m0 + ty * 4 + i) * ldc + n0 + tx * 4) = o;
        }
    }
}

template <int DQK, int DV, bool V_IN_K, int MODE, class KV, class QF>
DI void attn_naive(LAS float* lds, const KV& kv, int nk_loop, const QF& qf, bool active, int limit, float scale, float lg, int tq, float* optr) {
    constexpr int KS = DQK + 1;
    constexpr int VS = V_IN_K ? KS : DV;
    LAS float* Ks = lds;
    LAS float* Vs = V_IN_K ? Ks : (lds + 64 * KS);
    LAS float* qs = lds + 64 * KS + (V_IN_K ? 0 : 64 * DV);
    LAS float* ps = qs + 8 * DQK;
    static_assert((64 * KS + (V_IN_K ? 0 : 64 * DV) + 8 * DQK + 8 * 64) * 4 <= MISC_OFF, "attn_naive LDS");
    const int tid = threadIdx.x, lane = tid & 63, w = tid >> 6;
    __syncthreads();
    for (int d = lane; d < DQK; d += 64) qs[w * DQK + d] = active ? qf(d) : 0.f;
    float m = -INFINITY, l = 0.f;
    float acc[DV / 64];
#pragma unroll
    for (int c = 0; c < DV / 64; ++c) acc[c] = 0.f;
    for (int base = 0; base < nk_loop; base += 64) {
        __syncthreads();
        for (int idx = tid; idx < 64 * DQK; idx += NTHREADS) { const int j = idx / DQK, d = idx - j * DQK, key = base + j; Ks[j * KS + d] = key < nk_loop ? kv.k(key, d) : 0.f; }
        if (!V_IN_K) for (int idx = tid; idx < 64 * DV; idx += NTHREADS) { const int j = idx / DV, e = idx - j * DV, key = base + j; Vs[j * DV + e] = key < nk_loop ? kv.v(key, e) : 0.f; }
        __syncthreads();
        const int key = base + lane; const bool valid = active && key <= limit && key < nk_loop;
        float s = 0.f;
        for (int d = 0; d < DQK; ++d) s += qs[w * DQK + d] * Ks[lane * KS + d];
        float p;
        if (MODE == 0) {
            s *= scale;
            const float cm = wave_max(valid ? s : -INFINITY);
            const float mn = fmaxf(m, cm);
            const float alpha = (mn == -INFINITY) ? 1.f : expf(m - mn);
            p = valid ? expf(s - mn) : 0.f;
            l = l * alpha + wave_sum(p);
#pragma unroll
            for (int c = 0; c < DV / 64; ++c) acc[c] *= alpha;
            m = mn;
        } else {
            p = valid ? s * expf((float)(tq - key) * lg) : 0.f;
        }
        ps[w * 64 + lane] = p;
        __syncthreads();
        for (int j = 0; j < 64; ++j) { const float pj = ps[w * 64 + j];
#pragma unroll
            for (int c = 0; c < DV / 64; ++c) acc[c] += pj * Vs[j * VS + lane + 64 * c]; }
    }
    if (active) {
#pragma unroll
        for (int c = 0; c < DV / 64; ++c) optr[lane + 64 * c] = (MODE == 0) ? acc[c] / l : acc[c];
    }
}

struct KvMlaPrompt { const float* ckvn; const float* kper; int b;
    DI float k(int key, int d) const { const size_t row = (size_t)b * SEQ + key; return d < KVL ? ckvn[row * KVL + d] : kper[row * DROPE + (d - KVL)]; }
    DI float v(int, int) const { return 0.f; } };
struct KvMlaSample { const float* ckvn; const float* kper; const float* cckv; const float* ckpe; const int* pt; int b;
    DI float k(int key, int d) const {
        if (key < PAST) { const size_t r = (size_t)pt[b * NPAGES + (key >> 7)] * PAGE + (key & (PAGE - 1)); return d < KVL ? cckv[r * KVL + d] : ckpe[r * DROPE + (d - KVL)]; }
        const size_t row = (size_t)NP + b * DS + (key - PAST); return d < KVL ? ckvn[row * KVL + d] : kper[row * DROPE + (d - KVL)]; }
    DI float v(int, int) const { return 0.f; } };
struct KvRet { const float* rk; const float* z; int b, h;
    DI float k(int key, int d) const { return rk[((size_t)b * SEQ + key) * 512 + h * RDK + d]; }
    DI float v(int key, int e) const { return z[((size_t)b * SEQ + key) * ZLD + C_RV + h * RDV + e]; } };
struct KvMem { const float* mk; const float* mv; int b, h;
    DI float k(int key, int d) const { return mk[(((size_t)b * NMEM + key) * XH + h) * XHD + d]; }
    DI float v(int key, int e) const { return mv[(((size_t)b * NMEM + key) * XH + h) * XHD + e]; } };


typedef float f32x16 __attribute__((ext_vector_type(16)));
typedef short bf16x8 __attribute__((ext_vector_type(8)));
typedef short s16x4 __attribute__((ext_vector_type(4)));
typedef unsigned u32x4_t __attribute__((ext_vector_type(4)));
typedef unsigned u32x2_t __attribute__((ext_vector_type(2)));
DI int crow(int i, int h) { return (i & 3) + 8 * (i >> 2) + 4 * h; }
#define MFMA32(a, b, c) __builtin_amdgcn_mfma_f32_32x32x16_bf16((a), (b), (c), 0, 0, 0)
template <int DQK, int DV, bool CAUSAL, class Src>
DI void flash_unit(LAS unsigned char* lds, const Src& src, int qpos0, int ntiles, bf16_t* O, int ldo, float c2) {
    constexpr int KP = DQK + 8, VP = 68, KS = DQK / 16, NBLK = DV / 32;
    constexpr int KBYTES = 64 * KP * 2, VBYTES = DV * VP * 2, BUF = KBYTES + VBYTES;
    constexpr int D8 = DQK / 8, NPK = (64 * D8) / NTHREADS, NPV = (DV * 8) / NTHREADS;
    static_assert((64 * D8) % NTHREADS == 0 && (DV * 8) % NTHREADS == 0 && 2 * BUF <= 131072, "flash_unit geometry");
    const int tid = threadIdx.x, lane = tid & 63, w = __builtin_amdgcn_readfirstlane(tid >> 6), l31 = lane & 31, h = lane >> 5;
    bf16x8 qf[KS];
#pragma unroll
    for (int s_ = 0; s_ < KS; ++s_) qf[s_] = src.qfrag(32 * w + l31, s_, h);
    f32x16 o[NBLK];
#pragma unroll
    for (int b = 0; b < NBLK; ++b)
#pragma unroll
        for (int i = 0; i < 16; ++i) o[b][i] = 0.f;
    float m = -INFINITY, lsum = 0.f;
    u32x4_t kreg[NPK], vreg[NPV];
#define FL_LOAD(t_) do { _Pragma("unroll") for (int i_ = 0; i_ < NPK; ++i_) { const int p_ = tid + i_ * NTHREADS; kreg[i_] = src.kpiece(64 * (t_) + p_ / D8, p_ % D8); } \
                         _Pragma("unroll") for (int i_ = 0; i_ < NPV; ++i_) { const int p_ = tid + i_ * NTHREADS; vreg[i_] = src.vpiece(p_ >> 3, 64 * (t_) + 8 * (p_ & 7)); } } while (0)
#define FL_STORE(buf_) do { _Pragma("unroll") for (int i_ = 0; i_ < NPK; ++i_) { const int p_ = tid + i_ * NTHREADS; *(LAS u32x4_t*)(lds + (buf_) * BUF + ((p_ / D8) * KP + (p_ % D8) * 8) * 2) = kreg[i_]; } \
                          _Pragma("unroll") for (int i_ = 0; i_ < NPV; ++i_) { const int p_ = tid + i_ * NTHREADS; LAS unsigned char* a_ = lds + (buf_) * BUF + KBYTES + ((p_ >> 3) * VP + (p_ & 7) * 8) * 2; \
                              *(LAS u32x2_t*)a_ = (u32x2_t){vreg[i_].x, vreg[i_].y}; *(LAS u32x2_t*)(a_ + 8) = (u32x2_t){vreg[i_].z, vreg[i_].w}; } } while (0)
    __syncthreads();
    FL_LOAD(0); FL_STORE(0);
    __syncthreads();
    const int qmine = qpos0 + 32 * w + l31, qlast = qpos0 + 32 * w + 31;
    for (int t = 0; t < ntiles; ++t) {
        const int buf = t & 1;
        if (t + 1 < ntiles) FL_LOAD(t + 1);
        if (!CAUSAL || 64 * t <= qlast) {
            const LAS unsigned char* kb_ = lds + buf * BUF; const LAS unsigned char* vb_ = kb_ + KBYTES;
            f32x16 st[2];
#pragma unroll
            for (int kb = 0; kb < 2; ++kb) {
#pragma unroll
                for (int i = 0; i < 16; ++i) st[kb][i] = 0.f;
#pragma unroll
                for (int g_ = 0; g_ < KS / 4; ++g_) { bf16x8 kf[4];
#pragma unroll
                    for (int j = 0; j < 4; ++j) kf[j] = *(const LAS bf16x8*)(kb_ + ((32 * kb + l31) * KP + 16 * (4 * g_ + j) + 8 * h) * 2);
#pragma unroll
                    for (int j = 0; j < 4; ++j) st[kb] = MFMA32(kf[j], qf[4 * g_ + j], st[kb]);
                    __builtin_amdgcn_sched_barrier(0); }
            }
            float mx = -INFINITY;
#pragma unroll
            for (int kb = 0; kb < 2; ++kb)
#pragma unroll
                for (int i = 0; i < 16; ++i) { float v = st[kb][i] * c2; if (CAUSAL) { const int key = 64 * t + 32 * kb + crow(i, h); v = key <= qmine ? v : -INFINITY; } st[kb][i] = v; mx = fmaxf(mx, v); }
            mx = fmaxf(mx, __shfl_xor(mx, 32));
            const float mn = fmaxf(m, mx);
            const float alpha = __builtin_amdgcn_exp2f(m - mn);
            m = mn;
            float ps = 0.f;
#pragma unroll
            for (int kb = 0; kb < 2; ++kb)
#pragma unroll
                for (int i = 0; i < 16; ++i) { const float p = __builtin_amdgcn_exp2f(st[kb][i] - mn); st[kb][i] = p; ps += p; }
            lsum = lsum * alpha + ps;
#pragma unroll
            for (int b = 0; b < NBLK; ++b)
#pragma unroll
                for (int i = 0; i < 16; ++i) o[b][i] *= alpha;
            bf16x8 pf[4];
#pragma unroll
            for (int ks = 0; ks < 4; ++ks) { const int kb = ks >> 1, s2 = ks & 1; u32x4_t pk;
                pk.x = cvtpk(st[kb][8 * s2 + 0], st[kb][8 * s2 + 1]); pk.y = cvtpk(st[kb][8 * s2 + 2], st[kb][8 * s2 + 3]);
                pk.z = cvtpk(st[kb][8 * s2 + 4], st[kb][8 * s2 + 5]); pk.w = cvtpk(st[kb][8 * s2 + 6], st[kb][8 * s2 + 7]); pf[ks] = __builtin_bit_cast(bf16x8, pk); }
            __builtin_amdgcn_sched_barrier(0);
#pragma unroll
            for (int b = 0; b < NBLK; ++b) { bf16x8 vf[4];
#pragma unroll
                for (int ks = 0; ks < 4; ++ks) { const LAS unsigned char* a_ = vb_ + ((32 * b + l31) * VP + 16 * ks + 4 * h) * 2;
                    const s16x4 lo = *(const LAS s16x4*)a_, hi = *(const LAS s16x4*)(a_ + 16);
                    vf[ks] = __builtin_shufflevector(lo, hi, 0, 1, 2, 3, 4, 5, 6, 7); }
#pragma unroll
                for (int ks = 0; ks < 4; ++ks) o[b] = MFMA32(vf[ks], pf[ks], o[b]);
                __builtin_amdgcn_sched_barrier(0); }
        }
        if (t + 1 < ntiles) FL_STORE(buf ^ 1);
        __syncthreads();
    }
#undef FL_LOAD
#undef FL_STORE
    lsum += __shfl_xor(lsum, 32);
    const float inv = 1.f / lsum;
    bf16_t* orow = O + (size_t)(32 * w + l31) * ldo;
#pragma unroll
    for (int b = 0; b < NBLK; ++b)
#pragma unroll
        for (int g = 0; g < 4; ++g) { u32x2_t pk; pk.x = cvtpk(o[b][4 * g + 0] * inv, o[b][4 * g + 1] * inv); pk.y = cvtpk(o[b][4 * g + 2] * inv, o[b][4 * g + 3] * inv);
            *(u32x2_t*)(orow + 32 * b + 8 * g + 4 * h) = pk; }
}
struct SrcMlaP { const bf16_t* kn; const bf16_t* kpe; const bf16_t* vt; const bf16_t* qraw; const bf16_t* qpe; int b, hh; size_t row0;
    DI bf16x8 qfrag(int r, int s_, int h8) const { return s_ < 8 ? *(const bf16x8*)(qraw + (row0 + r) * 1536 + hh * DQH + 16 * s_ + 8 * h8) : *(const bf16x8*)(qpe + (row0 + r) * 512 + hh * DROPE + 16 * (s_ - 8) + 8 * h8); }
    DI u32x4_t kpiece(int key, int d8) const { const size_t row = (size_t)b * SEQ + key;
        return d8 < 16 ? *(const u32x4_t*)(kn + row * 1024 + hh * DNOPE + d8 * 8) : *(const u32x4_t*)(kpe + row * DROPE + (d8 - 16) * 8); }
    DI u32x4_t vpiece(int dv, int key0) const { return *(const u32x4_t*)(vt + (size_t)(hh * DVH + dv) * NP + (size_t)b * SEQ + key0); } };
struct SrcMemP { const bf16_t* mk; const bf16_t* mvt; const bf16_t* xq; int b, hh; size_t row0;
    DI bf16x8 qfrag(int r, int s_, int h8) const { return *(const bf16x8*)(xq + (row0 + r) * 256 + hh * XHD + 16 * s_ + 8 * h8); }
    DI u32x4_t kpiece(int key, int d8) const { return *(const u32x4_t*)(mk + ((size_t)b * NMEM + key) * 256 + hh * XHD + d8 * 8); }
    DI u32x4_t vpiece(int dv, int key0) const { return *(const u32x4_t*)(mvt + (size_t)(hh * XHD + dv) * (NB * NMEM) + (size_t)b * NMEM + key0); } };


DI void ret_chunk_state(const bf16_t* __restrict__ RVT, const bf16_t* __restrict__ RKtT, float* __restrict__ UT, int b, int h, int c) {
    const int tid = threadIdx.x, lane = tid & 63, w = __builtin_amdgcn_readfirstlane(tid >> 6), l31 = lane & 31, hh = lane >> 5;
    const size_t tok0 = (size_t)b * SEQ + c * 128;
    f32x16 acc[4];
#pragma unroll
    for (int kb = 0; kb < 4; ++kb)
#pragma unroll
        for (int i = 0; i < 16; ++i) acc[kb][i] = 0.f;
    const bf16_t* ap = RVT + (size_t)(h * RDV + 32 * w + l31) * NT + tok0 + 8 * hh;
    const bf16_t* bp = RKtT + (size_t)(h * RDK + l31) * NP + tok0 + 8 * hh;
#pragma unroll
    for (int s_ = 0; s_ < 8; ++s_) { const bf16x8 a = *(const bf16x8*)(ap + 16 * s_);
#pragma unroll
        for (int kb = 0; kb < 4; ++kb) { const bf16x8 bfr = *(const bf16x8*)(bp + (size_t)(32 * kb) * NP + 16 * s_); acc[kb] = MFMA32(a, bfr, acc[kb]); } }
    float* u = UT + (size_t)(((b * RH + h) * 16) + c) * 32768;
#pragma unroll
    for (int kb = 0; kb < 4; ++kb)
#pragma unroll
        for (int i = 0; i < 16; ++i) u[(32 * w + crow(i, hh)) * RDK + 32 * kb + l31] = acc[kb][i];
}
DI void ret_chunk_out(const bf16_t* __restrict__ RQt, const bf16_t* __restrict__ RKt, const bf16_t* __restrict__ RVT, const bf16_t* __restrict__ SPT, float* __restrict__ ORET, int b, int h, int c) {
    const int tid = threadIdx.x, lane = tid & 63, w = __builtin_amdgcn_readfirstlane(tid >> 6), l31 = lane & 31, hh = lane >> 5;
    const int ib = w & 3, vh = w >> 2;
    const size_t tok0 = (size_t)b * SEQ + c * 128;
    bf16x8 qf[8];
    { const bf16_t* qp = RQt + (tok0 + 32 * ib + l31) * 512 + h * RDK + 8 * hh;
#pragma unroll
      for (int s_ = 0; s_ < 8; ++s_) qf[s_] = *(const bf16x8*)(qp + 16 * s_); }
    f32x16 o[4];
#pragma unroll
    for (int blk = 0; blk < 4; ++blk)
#pragma unroll
        for (int i = 0; i < 16; ++i) o[blk][i] = 0.f;
    const bf16_t* vbase = RVT + (size_t)(h * RDV + 32 * (4 * vh) + l31) * NT + tok0 + 4 * hh;
#pragma unroll 1
    for (int jb = 0; jb <= ib; ++jb) {
        f32x16 x;
#pragma unroll
        for (int i = 0; i < 16; ++i) x[i] = 0.f;
        const bf16_t* kp = RKt + (tok0 + 32 * jb + l31) * 512 + h * RDK + 8 * hh;
#pragma unroll
        for (int s_ = 0; s_ < 8; ++s_) { const bf16x8 kf = *(const bf16x8*)(kp + 16 * s_); x = MFMA32(kf, qf[s_], x); }
        if (jb == ib) {
#pragma unroll
            for (int i = 0; i < 16; ++i) x[i] = (crow(i, hh) <= l31) ? x[i] : 0.f;
        }
#pragma unroll
        for (int s2 = 0; s2 < 2; ++s2) {
            u32x4_t pk; pk.x = cvtpk(x[8 * s2 + 0], x[8 * s2 + 1]); pk.y = cvtpk(x[8 * s2 + 2], x[8 * s2 + 3]); pk.z = cvtpk(x[8 * s2 + 4], x[8 * s2 + 5]); pk.w = cvtpk(x[8 * s2 + 6], x[8 * s2 + 7]);
            const bf16x8 pa = __builtin_bit_cast(bf16x8, pk);
#pragma unroll
            for (int blk = 0; blk < 4; ++blk) { const bf16_t* vp = vbase + (size_t)(32 * blk) * NT + 32 * jb + 16 * s2;
                const s16x4 lo = *(const s16x4*)vp, hi = *(const s16x4*)(vp + 8);
                const bf16x8 vf = __builtin_shufflevector(lo, hi, 0, 1, 2, 3, 4, 5, 6, 7);
                o[blk] = MFMA32(pa, vf, o[blk]); }
        }
    }
    const bf16_t* sp = SPT + (size_t)(((b * RH + h) * 16) + c) * 32768 + (size_t)(32 * (4 * vh) + l31) * RDK + 8 * hh;
#pragma unroll
    for (int s_ = 0; s_ < 8; ++s_)
#pragma unroll
        for (int blk = 0; blk < 4; ++blk) { const bf16x8 sf = *(const bf16x8*)(sp + (size_t)(32 * blk) * RDK + 16 * s_); o[blk] = MFMA32(qf[s_], sf, o[blk]); }
#pragma unroll
    for (int blk = 0; blk < 4; ++blk)
#pragma unroll
        for (int i = 0; i < 16; ++i) ORET[(tok0 + 32 * ib + crow(i, hh)) * 1024 + h * RDV + 32 * (4 * vh + blk) + l31] = o[blk][i];
}


typedef short v4i16_t __attribute__((ext_vector_type(4)));
DI s16x4 vtr(const LAS unsigned char* p) { return __builtin_bit_cast(s16x4, __builtin_amdgcn_ds_read_tr16_b64_v4i16((LAS v4i16_t*)p)); }
constexpr int MS_NSPLIT = 2, MS_KEYS = PAST / MS_NSPLIT, MS_TILES = MS_KEYS / 64;
DI void mla_sample_unit(LAS unsigned char* lds, const float* __restrict__ cckv, const float* __restrict__ ckpe, const int* __restrict__ pt,
                        const bf16_t* __restrict__ QLATb, const bf16_t* __restrict__ QPEb, float* __restrict__ PO, float* __restrict__ PML, int b, int split, float c2) {
    constexpr int KP = 328, KBYTES = 64 * KP * 2;
    const int tid = threadIdx.x, lane = tid & 63, w = __builtin_amdgcn_readfirstlane(tid >> 6), l31 = lane & 31, hh = lane >> 5;
    bf16x8 qf[20];
    { const int t = l31 >> 3, head = l31 & 7;
      const bf16_t* ql = QLATb + (size_t)(b * DS + t) * 2048 + head * KVL + 8 * hh;
      const bf16_t* qp = QPEb + (size_t)(NP + b * DS + t) * 512 + head * DROPE + 8 * hh;
#pragma unroll
      for (int s_ = 0; s_ < 16; ++s_) qf[s_] = *(const bf16x8*)(ql + 16 * s_);
#pragma unroll
      for (int s_ = 0; s_ < 4; ++s_) qf[16 + s_] = *(const bf16x8*)(qp + 16 * s_); }
    f32x16 o;
#pragma unroll
    for (int i = 0; i < 16; ++i) o[i] = 0.f;
    float m = -INFINITY, lsum = 0.f;
    f32x4 cr[8], pr[2];
#define MS_LOAD(t_) do { const int key0_ = split * MS_KEYS + 64 * (t_); const size_t rowb_ = (size_t)pt[b * NPAGES + (key0_ >> 7)] * PAGE + (key0_ & (PAGE - 1)); \
        _Pragma("unroll") for (int i_ = 0; i_ < 8; ++i_) { const int pc_ = tid + i_ * NTHREADS; cr[i_] = __builtin_nontemporal_load((const f32x4*)(cckv + (rowb_ + (pc_ >> 6)) * KVL + 4 * (pc_ & 63))); } \
        _Pragma("unroll") for (int i_ = 0; i_ < 2; ++i_) { const int pc_ = tid + i_ * NTHREADS; pr[i_] = __builtin_nontemporal_load((const f32x4*)(ckpe + (rowb_ + (pc_ >> 4)) * DROPE + 4 * (pc_ & 15))); } } while (0)
#define MS_STORE(buf_) do { \
        _Pragma("unroll") for (int i_ = 0; i_ < 8; ++i_) { const int pc_ = tid + i_ * NTHREADS; *(LAS u32x2_t*)(lds + (buf_) * KBYTES + ((pc_ >> 6) * KP + 4 * (pc_ & 63)) * 2) = (u32x2_t){cvtpk(cr[i_][0], cr[i_][1]), cvtpk(cr[i_][2], cr[i_][3])}; } \
        _Pragma("unroll") for (int i_ = 0; i_ < 2; ++i_) { const int pc_ = tid + i_ * NTHREADS; *(LAS u32x2_t*)(lds + (buf_) * KBYTES + ((pc_ >> 4) * KP + KVL + 4 * (pc_ & 15)) * 2) = (u32x2_t){cvtpk(pr[i_][0], pr[i_][1]), cvtpk(pr[i_][2], pr[i_][3])}; } } while (0)
    __syncthreads();
    MS_LOAD(0); MS_STORE(0);
    __syncthreads();
    const int q4 = (lane & 15) >> 2, p4 = lane & 3, blk = (lane >> 4) & 1;
#pragma unroll 1
    for (int t = 0; t < MS_TILES; ++t) {
        const int buf = t & 1;
        if (t + 1 < MS_TILES) MS_LOAD(t + 1);
        const LAS unsigned char* kb_ = lds + buf * KBYTES;
        f32x16 st[2];
#pragma unroll
        for (int kb = 0; kb < 2; ++kb) {
#pragma unroll
            for (int i = 0; i < 16; ++i) st[kb][i] = 0.f;
#pragma unroll
            for (int g_ = 0; g_ < 5; ++g_) { bf16x8 kf[4];
#pragma unroll
                for (int j = 0; j < 4; ++j) kf[j] = *(const LAS bf16x8*)(kb_ + ((32 * kb + l31) * KP + 16 * (4 * g_ + j) + 8 * hh) * 2);
#pragma unroll
                for (int j = 0; j < 4; ++j) st[kb] = MFMA32(kf[j], qf[4 * g_ + j], st[kb]);
                __builtin_amdgcn_sched_barrier(0); }
        }
        float mx = -INFINITY;
#pragma unroll
        for (int kb = 0; kb < 2; ++kb)
#pragma unroll
            for (int i = 0; i < 16; ++i) { const float v = st[kb][i] * c2; st[kb][i] = v; mx = fmaxf(mx, v); }
        mx = fmaxf(mx, __shfl_xor(mx, 32));
        const float mn = fmaxf(m, mx);
        const float alpha = __builtin_amdgcn_exp2f(m - mn);
        m = mn;
        float ps = 0.f;
#pragma unroll
        for (int kb = 0; kb < 2; ++kb)
#pragma unroll
            for (int i = 0; i < 16; ++i) { const float p = __builtin_amdgcn_exp2f(st[kb][i] - mn); st[kb][i] = p; ps += p; }
        lsum = lsum * alpha + ps;
#pragma unroll
        for (int i = 0; i < 16; ++i) o[i] *= alpha;
        bf16x8 vf[4];
#pragma unroll
        for (int ks = 0; ks < 4; ++ks) { const LAS unsigned char* a_ = kb_ + ((16 * ks + 4 * hh + q4) * KP + 32 * w + 16 * blk + 4 * p4) * 2;
            const s16x4 lo = vtr(a_), hi = vtr(a_ + 8 * KP * 2);
            vf[ks] = __builtin_shufflevector(lo, hi, 0, 1, 2, 3, 4, 5, 6, 7); }
#pragma unroll
        for (int ks = 0; ks < 4; ++ks) { const int kb = ks >> 1, s2 = ks & 1; u32x4_t pk;
            pk.x = cvtpk(st[kb][8 * s2 + 0], st[kb][8 * s2 + 1]); pk.y = cvtpk(st[kb][8 * s2 + 2], st[kb][8 * s2 + 3]);
            pk.z = cvtpk(st[kb][8 * s2 + 4], st[kb][8 * s2 + 5]); pk.w = cvtpk(st[kb][8 * s2 + 6], st[kb][8 * s2 + 7]);
            o = MFMA32(vf[ks], __builtin_bit_cast(bf16x8, pk), o); }
        if (t + 1 < MS_TILES) MS_STORE(buf ^ 1);
        __syncthreads();
    }
#undef MS_LOAD
#undef MS_STORE
    lsum += __shfl_xor(lsum, 32);
    const int item = b * MS_NSPLIT + split;
    if (w == 0 && lane < 32) { PML[(item * 32 + lane) * 2] = m; PML[(item * 32 + lane) * 2 + 1] = lsum; }
#pragma unroll
    for (int i = 0; i < 16; ++i) PO[((size_t)item * 32 + l31) * KVL + 32 * w + crow(i, hh)] = o[i];
}

struct QPtr { const float* p; DI float operator()(int d) const { return p[d]; } };
struct QMla { const float* ql; const float* qp; DI float operator()(int d) const { return d < KVL ? ql[d] : qp[d - KVL]; } };
DI void rms_row(const float* x, const float* g, float* o, int n, int lane) {
    float s = 0.f;
    for (int i = lane; i < n; i += 64) { const float v = x[i]; s += v * v; }
    const float r = rsqrtf(wave_sum(s) / (float)n + EPS);
    for (int i = lane; i < n; i += 64) o[i] = x[i] * r * g[i];
}

DI void rms_row_bf16(const float* x, const float* g, bf16_t* o, int n, int lane) {
    float s = 0.f;
    for (int i = lane; i < n; i += 64) { const float v = x[i]; s += v * v; }
    const float r = rsqrtf(wave_sum(s) / (float)n + EPS);
    for (int i = lane; i < n; i += 64) o[i] = f2bf(x[i] * r * g[i]);
}
#define GEMM_PHASE(EPI, ...) pg8::gemm_phase<EPI, pg8::StaticOrder, true, true>(__VA_ARGS__)
#define GEMM_SPLIT(...) pg8::gemm_phase<pg8::EpiPart, pg8::SplitOrder, true, true>(__VA_ARGS__)
__global__ void __launch_bounds__(NTHREADS, 2) fwd_kernel(Args args) {
    extern __shared__ __attribute__((aligned(16))) unsigned char lds_raw[];
    LAS unsigned char* ldsb = (LAS unsigned char*)lds_raw;
    LAS float* lds = (LAS float*)ldsb;
    volatile LAS unsigned* MISC = (volatile LAS unsigned*)(ldsb + MISC_OFF);
    const int tid = threadIdx.x, lane = tid & 63, wave = tid >> 6;
    const int G = gridDim.x, bid = blockIdx.x;
    const int gw = bid * NWAVES + wave, NGW = G * NWAVES;
    unsigned char* ws = args.ws;
    float* out = args.out;
    const int lo = args.ph_lo, hi = args.ph_hi;

    if (tid < 64) MISC[tid] = 0u;
    __syncthreads();
    XcdBarrier bar; bar.bar = (unsigned*)(ws + WS_CTL) + CW_BAR; bar.x = 0; bar.st = MISC;
    if (hi - lo > 1) bar = xcd_barrier_post((unsigned*)(ws + WS_CTL) + CW_BAR, MISC);
#define IN(k) (lo <= (k) && (k) < hi)
#define SEAM(k) do { if (IN(k) && IN((k) + 1)) xcd_barrier(bar); } while (0)

    const float* x_prompt = args.in[0]; const float* x_sample = args.in[1]; const float* mem_prompt = args.in[2];
    const float* cache_ckv = args.in[3]; const float* cache_kpe = args.in[4]; const int* page_table = (const int*)args.in[5];
    const float* state_ret = args.in[6]; const float* cache_mem_k = args.in[7]; const float* cache_mem_v = args.in[8];
    const float* g_mix_pre = args.in[9]; const float* g_mix_post = args.in[10]; const float* g_ffn_pre = args.in[11]; const float* g_ffn_post = args.in[12];
    const float* g_mem = args.in[13]; const float* g_qlat = args.in[14]; const float* g_kvlat = args.in[15];
    const float* w_in = args.in[16]; const float* w_uq = args.in[17]; const float* w_uk = args.in[18]; const float* w_uv = args.in[19];
    const float* w_mem_k = args.in[20]; const float* w_mem_v = args.in[21]; const float* w_ret_o = args.in[22]; const float* w_mla_o = args.in[23];
    const float* w_x_o = args.in[24]; const float* w_out = args.in[25]; const float* w_gate = args.in[26]; const float* w_up = args.in[27]; const float* w_down = args.in[28];
    float* COSA = (float*)(ws + WS_COSA); float* SINA = (float*)(ws + WS_SINA); float* COSB = (float*)(ws + WS_COSB); float* SINB = (float*)(ws + WS_SINB);
    float* U = (float*)(ws + WS_U); float* MN = (float*)(ws + WS_MN); float* Z = (float*)(ws + WS_Z);
    float* RQ = (float*)(ws + WS_RQ); float* RK = (float*)(ws + WS_RK); float* CQN = (float*)(ws + WS_CQN); float* CKVN = (float*)(ws + WS_CKVN); float* KPER = (float*)(ws + WS_KPER);
    float* Q = (float*)(ws + WS_Q); float* QLAT = (float*)(ws + WS_QLAT); float* QPE = (float*)(ws + WS_QPE);
    float* ORET = (float*)(ws + WS_ORET); float* OLAT = (float*)(ws + WS_OLAT); float* OX = (float*)(ws + WS_OX); float* OMLA = (float*)(ws + WS_OMLA); float* ORETN = (float*)(ws + WS_ORETN);
    float* ARET = (float*)(ws + WS_ARET); float* AMLA = (float*)(ws + WS_AMLA); float* AX = (float*)(ws + WS_AX); float* MIX = (float*)(ws + WS_MIX);
    float* HP = (float*)(ws + WS_HP); float* H = (float*)(ws + WS_H); float* F = (float*)(ws + WS_F);
    float* GU = (float*)(ws + WS_GG); float* FO = (float*)(ws + WS_FO);
    bf16_t* WinT = (bf16_t*)(ws + WS_WIN_T); bf16_t* WmkvT = (bf16_t*)(ws + WS_WMKV_T); bf16_t* WuqT = (bf16_t*)(ws + WS_WUQ_T); bf16_t* WroT = (bf16_t*)(ws + WS_WRO_T);
    bf16_t* WmoT = (bf16_t*)(ws + WS_WMO_T); bf16_t* WxoT = (bf16_t*)(ws + WS_WXO_T); bf16_t* WoT = (bf16_t*)(ws + WS_WO_T); bf16_t* WguT = (bf16_t*)(ws + WS_WGU_T); bf16_t* WdT = (bf16_t*)(ws + WS_WD_T);
    bf16_t* Ub = (bf16_t*)(ws + WS_UB); bf16_t* MNb = (bf16_t*)(ws + WS_MNB); bf16_t* CQNb = (bf16_t*)(ws + WS_CQNB); bf16_t* ORETNb = (bf16_t*)(ws + WS_ORETNB);
    bf16_t* OMLAb = (bf16_t*)(ws + WS_OMLAB); bf16_t* OXb = (bf16_t*)(ws + WS_OXB); bf16_t* MIXb = (bf16_t*)(ws + WS_MIXB); bf16_t* Fb = (bf16_t*)(ws + WS_FB); bf16_t* ACTb = (bf16_t*)(ws + WS_ACTB);
    bf16_t* WukT = (bf16_t*)(ws + WS_WUK_T); bf16_t* WuvT = (bf16_t*)(ws + WS_WUV_T); bf16_t* CKVNb = (bf16_t*)(ws + WS_CKVNB); bf16_t* KPERb = (bf16_t*)(ws + WS_KPERB);
    bf16_t* XQb = (bf16_t*)(ws + WS_XQB); bf16_t* MKb = (bf16_t*)(ws + WS_MKB); bf16_t* MVT = (bf16_t*)(ws + WS_MVT); bf16_t* KN = (bf16_t*)(ws + WS_KN); bf16_t* VT = (bf16_t*)(ws + WS_VT); bf16_t* Qb = (bf16_t*)(ws + WS_QB);
    bf16_t* RQt = (bf16_t*)(ws + WS_RQT); bf16_t* RKt = (bf16_t*)(ws + WS_RKT); bf16_t* RKtT = (bf16_t*)(ws + WS_RKTT); bf16_t* RVT = (bf16_t*)(ws + WS_RVT);
    float* UT = (float*)(ws + WS_UT); bf16_t* SPT = (bf16_t*)(ws + WS_SPT);
    bf16_t* QPEb = (bf16_t*)(ws + WS_QPEB); bf16_t* WukB = (bf16_t*)(ws + WS_WUKB); float* PART = (float*)(ws + WS_PART);
    bf16_t* QLATb = (bf16_t*)(ws + WS_QLATB); float* PO = (float*)(ws + WS_PO); float* PML = (float*)(ws + WS_PML);

    if (IN(0)) {
        for (int i = bid * NTHREADS + tid; i < NPOS * 64 + NPOS * 32; i += G * NTHREADS) {
            const bool a = i < NPOS * 64; const int j = a ? i : i - NPOS * 64; const int half = a ? 64 : 32;
            const int p = j / half, f = j % half; const int pos = p < SEQ ? p : PAST + (p - SEQ);
            const float inv = powf(10000.0f, -(float)f / (float)half);
            const float ang = (float)pos * inv;
            double rev = (double)ang * 0.15915494309189535; rev -= floor(rev);
            const float r = (float)rev;
            const float sn = __builtin_amdgcn_sinf(r), cs = __builtin_amdgcn_cosf(r);
            if (a) { COSA[j] = cs; SINA[j] = sn; } else { COSB[j] = cs; SINB[j] = sn; }
        }
        for (int row = gw; row < NT; row += NGW) {
            const float* xr = row < NP ? x_prompt + (size_t)row * DM : x_sample + (size_t)(row - NP) * DM;
            rms_row_bf16(xr, g_mix_pre, Ub + (size_t)row * DM, DM, lane);
        }
        for (int row = gw; row < NB * NMEM; row += NGW) rms_row_bf16(mem_prompt + (size_t)row * DM, g_mem, MNb + (size_t)row * DM, DM, lane);
        {
            LAS float* scr = lds + wave * (64 * 33);
            int rot = 0;
            transpose_w(w_in, 1024, DIN, WinT, 1024, 0, scr, gw, NGW, lane, rot);
            for (int i = bid * NTHREADS + tid; i < (ZLD - DIN) * 1024 / 2; i += G * NTHREADS) ((unsigned*)(WinT + (size_t)DIN * 1024))[i] = 0u;
            for (int i = bid * NTHREADS + tid; i < MH * KVL * DNOPE / 4; i += G * NTHREADS) { const f32x4 v = *(const f32x4*)(w_uk + 4 * (size_t)i); *(u32x2_t*)(WukB + 4 * (size_t)i) = (u32x2_t){cvtpk(v[0], v[1]), cvtpk(v[2], v[3])}; }
            transpose_w(w_mem_k, 1024, 256, WmkvT, 1024, 0, scr, gw, NGW, lane, rot);
            transpose_w(w_mem_v, 1024, 256, WmkvT, 1024, 256, scr, gw, NGW, lane, rot);
            transpose_w(w_uq, QL, 1536, WuqT, QL, 0, scr, gw, NGW, lane, rot);
            transpose_w(w_ret_o, 1024, 1024, WroT, 1024, 0, scr, gw, NGW, lane, rot);
            transpose_w(w_mla_o, 1024, 1024, WmoT, 1024, 0, scr, gw, NGW, lane, rot);
            transpose_w(w_x_o, 256, 1024, WxoT, 256, 0, scr, gw, NGW, lane, rot);
            transpose_w(w_out, 1024, 1024, WoT, 1024, 0, scr, gw, NGW, lane, rot);
            transpose_w(w_gate, 1024, DFF, WguT, 1024, 0, scr, gw, NGW, lane, rot, 2);
            transpose_w(w_up, 1024, DFF, WguT, 1024, 1, scr, gw, NGW, lane, rot, 2);
            transpose_w(w_down, DFF, 1024, WdT, DFF, 0, scr, gw, NGW, lane, rot);
            for (int hh = 0; hh < MH; ++hh) { transpose_w(w_uk + (size_t)hh * KVL * DNOPE, KVL, DNOPE, WukT, KVL, hh * DNOPE, scr, gw, NGW, lane, rot);
                                              transpose_w(w_uv + (size_t)hh * KVL * DVH, KVL, DVH, WuvT, KVL, hh * DVH, scr, gw, NGW, lane, rot); }
        }
    }
    SEAM(0);
    if (IN(1)) {
        static_assert(WS_MNB == WS_UB + (size_t)NT * 1024 * 2 && WS_WMKV_T == WS_WIN_T + (size_t)ZLD * 1024 * 2, "P1 stacks Ub|MNb and WinT|WmkvT");
        { pg8::Gemm g{Ub, WinT, NT + NB * NMEM, ZLD + 512, 1024, 1024, 1024}; pg8::P1Order S; S.init(G, bid); pg8::EpiP1 E{Z, ZLD, out + O_MKP, out + O_MVP};
          pg8::gemm_phase<pg8::EpiP1, pg8::P1Order, true, true>(ldsb, g, S, E); }
        __syncthreads();
        { pg8::Gemm g{WinT + (size_t)C_RV * 1024, Ub, 1024, NP, 1024, 1024, 1024}; pg8::StaticOrder S; S.init(1024, NP, G, bid); pg8::EpiBf16S E{RVT, NT};
          GEMM_PHASE(pg8::EpiBf16S, ldsb, g, S, E); }
    }
    SEAM(1);
    if (IN(2)) {
        constexpr int KTP = 520;
        LAS bf16_t* Kt = (LAS bf16_t*)ldsb;
        const int ntile = NP / 64, nwork = ntile + (NS + 63) / 64;
        for (int wk = bid; wk < nwork; wk += G) {
            const bool prompt = wk < ntile; const int row_base = prompt ? wk * 64 : NP + (wk - ntile) * 64;
            __syncthreads();
            {
                float zq[8], zk[8], zc[6], zv[4], zx[4], zp, ca, sa, cb, sb; int p;
#define P2_LOAD(r_, ZQ_, ZK_, ZC_, ZV_, ZX_, ZP_, CA_, SA_, CB_, SB_, P_) do { const float* z_ = Z + (size_t)(row_base + (r_)) * ZLD; P_ = pos_index(row_base + (r_)); \
                _Pragma("unroll") for (int h_ = 0; h_ < 4; ++h_) { ZQ_[2 * h_] = z_[C_RQ + h_ * RDK + lane]; ZQ_[2 * h_ + 1] = z_[C_RQ + h_ * RDK + 64 + lane]; ZK_[2 * h_] = z_[C_RK + h_ * RDK + lane]; ZK_[2 * h_ + 1] = z_[C_RK + h_ * RDK + 64 + lane]; } \
                _Pragma("unroll") for (int c_ = 0; c_ < 6; ++c_) ZC_[c_] = z_[C_CQ + lane + 64 * c_]; \
                _Pragma("unroll") for (int c_ = 0; c_ < 4; ++c_) { ZV_[c_] = z_[C_CKV + lane + 64 * c_]; ZX_[c_] = z_[C_XQ + lane + 64 * c_]; } \
                ZP_ = z_[C_KPE + lane]; CA_ = COSA[P_ * 64 + lane]; SA_ = SINA[P_ * 64 + lane]; CB_ = COSB[P_ * 32 + (lane & 31)]; SB_ = SINB[P_ * 32 + (lane & 31)]; } while (0)
                int r = wave;
                P2_LOAD(r, zq, zk, zc, zv, zx, zp, ca, sa, cb, sb, p);
                for (; r < 64; r += NWAVES) {
                    float zqn[8], zkn[8], zcn[6], zvn[4], zxn[4], zpn, can, san, cbn, sbn; int pn;
                    if (r + NWAVES < 64) P2_LOAD(r + NWAVES, zqn, zkn, zcn, zvn, zxn, zpn, can, san, cbn, sbn, pn);
                    const int row = row_base + r; const int il = p & 127;
#pragma unroll
                    for (int h = 0; h < RH; ++h) {
                        const float q1 = zq[2 * h] * ca - zq[2 * h + 1] * sa, q2 = zq[2 * h] * sa + zq[2 * h + 1] * ca;
                        const float sc = 0.08838834764831845f;
                        const float k1 = (zk[2 * h] * ca - zk[2 * h + 1] * sa) * sc, k2 = (zk[2 * h] * sa + zk[2 * h + 1] * ca) * sc;
                        if (prompt) {
                            const float fq = __expf((float)(il - 127) * lg_gamma(h)), fk = 1.f / fq;
                            RQt[(size_t)row * 512 + h * RDK + lane] = f2bf(q1 * fq); RQt[(size_t)row * 512 + h * RDK + 64 + lane] = f2bf(q2 * fq);
                            const bf16_t kb1 = f2bf(k1 * fk), kb2 = f2bf(k2 * fk);
                            RKt[(size_t)row * 512 + h * RDK + lane] = kb1; RKt[(size_t)row * 512 + h * RDK + 64 + lane] = kb2;
                            Kt[r * KTP + h * RDK + lane] = kb1; Kt[r * KTP + h * RDK + 64 + lane] = kb2;
                        } else {
                            RQ[(size_t)row * 512 + h * RDK + lane] = q1; RQ[(size_t)row * 512 + h * RDK + 64 + lane] = q2;
                            RK[(size_t)row * 512 + h * RDK + lane] = k1; RK[(size_t)row * 512 + h * RDK + 64 + lane] = k2;
                        }
                    }
                    {
                        float ss = 0.f;
#pragma unroll
                        for (int c = 0; c < 6; ++c) ss += zc[c] * zc[c];
                        const float rr = rsqrtf(wave_sum(ss) * (1.f / QL) + EPS);
#pragma unroll
                        for (int c = 0; c < 6; ++c) CQNb[(size_t)row * QL + lane + 64 * c] = f2bf(zc[c] * rr * g_qlat[lane + 64 * c]);
                    }
                    {
                        float ss = 0.f;
#pragma unroll
                        for (int c = 0; c < 4; ++c) ss += zv[c] * zv[c];
                        const float rr = rsqrtf(wave_sum(ss) * (1.f / KVL) + EPS);
                        float* ockv = row < NP ? out + O_CKVP + (size_t)row * KVL : out + O_CKVS + (size_t)(row - NP) * KVL;
#pragma unroll
                        for (int c = 0; c < 4; ++c) { const float v = zv[c] * rr * g_kvlat[lane + 64 * c]; ockv[lane + 64 * c] = v; CKVN[(size_t)row * KVL + lane + 64 * c] = v; CKVNb[(size_t)row * KVL + lane + 64 * c] = f2bf(v);
                            XQb[(size_t)row * 256 + lane + 64 * c] = f2bf(zx[c]); }
                    }
                    {
                        const float x2 = __shfl(zp, (lane & 31) + 32), x1 = __shfl(zp, lane & 31);
                        const float o1 = x1 * cb - x2 * sb, o2 = x1 * sb + x2 * cb;
                        if (lane < 32) {
                            KPER[(size_t)row * DROPE + lane] = o1; KPER[(size_t)row * DROPE + 32 + lane] = o2;
                            float* okpe = row < NP ? out + O_KPEP + (size_t)row * DROPE : out + O_KPES + (size_t)(row - NP) * DROPE;
                            okpe[lane] = o1; okpe[32 + lane] = o2;
                            KPERb[(size_t)row * DROPE + lane] = f2bf(o1); KPERb[(size_t)row * DROPE + 32 + lane] = f2bf(o2);
                        }
                    }
#pragma unroll
                    for (int i = 0; i < 8; ++i) { zq[i] = zqn[i]; zk[i] = zkn[i]; }
#pragma unroll
                    for (int i = 0; i < 6; ++i) zc[i] = zcn[i];
#pragma unroll
                    for (int i = 0; i < 4; ++i) { zv[i] = zvn[i]; zx[i] = zxn[i]; }
                    zp = zpn; ca = can; sa = san; cb = cbn; sb = sbn; p = pn;
                }
#undef P2_LOAD
            }
            __syncthreads();
            if (prompt) {
#pragma unroll 2
                for (int i = 0; i < 8; ++i) { const int pc = tid + i * NTHREADS, f = pc >> 3, k8 = pc & 7;
                    const LAS bf16_t* c = Kt + (8 * k8) * KTP + f;
                    pg8::u32x4 o; o.x = (unsigned)c[0] | ((unsigned)c[KTP] << 16); o.y = (unsigned)c[2 * KTP] | ((unsigned)c[3 * KTP] << 16);
                    o.z = (unsigned)c[4 * KTP] | ((unsigned)c[5 * KTP] << 16); o.w = (unsigned)c[6 * KTP] | ((unsigned)c[7 * KTP] << 16);
                    *(pg8::u32x4*)(RKtT + (size_t)f * NP + row_base + 8 * k8) = o; }
            }
        }
    }
    if (IN(2)) {
        for (int i = bid * NTHREADS + tid; i < NB * NMEM * 256; i += G * NTHREADS) { MKb[i] = f2bf(out[O_MKP + i]);
            const int f = i / (NB * NMEM), r = i - f * (NB * NMEM); MVT[i] = f2bf(out[O_MVP + (size_t)r * 256 + f]); }
    }
    SEAM(2);
    if (IN(3)) { pg8::Gemm g{CQNb, WuqT, NT, 1536, QL, QL, QL}; pg8::StaticOrder S; S.init(NT, 1536, G, bid); pg8::EpiBf16S E{Qb, 1536};
        GEMM_PHASE(pg8::EpiBf16S, ldsb, g, S, E);
        __syncthreads();
        { pg8::Gemm g2{CKVNb, WukT, NP, 1024, KVL, KVL, KVL}; pg8::StaticOrder S2; S2.init(NP, 1024, G, bid); pg8::EpiBf16S E2{KN, 1024}; GEMM_PHASE(pg8::EpiBf16S, ldsb, g2, S2, E2); }
        __syncthreads();
        { pg8::Gemm g3{WuvT, CKVNb, 1024, NP, KVL, KVL, KVL}; pg8::StaticOrder S3; S3.init(1024, NP, G, bid); pg8::EpiBf16S E3{VT, NP}; GEMM_PHASE(pg8::EpiBf16S, ldsb, g3, S3, E3); }
        for (int it = bid; it < NB * RH * 16; it += G) { const int c = __builtin_amdgcn_readfirstlane(it & 15), h = __builtin_amdgcn_readfirstlane((it >> 4) & 3), b = __builtin_amdgcn_readfirstlane(it >> 6);
            ret_chunk_state(RVT, RKtT, UT, b, h, c); } }
    SEAM(3);
    if (IN(4)) {
        for (int idx = bid * NTHREADS + tid; idx < NB * RH * 32768; idx += G * NTHREADS) {
            const int bh = idx >> 15, e = idx & 32767; const float g128 = expf(128.f * lg_gamma(bh & 3));
            float sp = 0.f, S = 0.f;
#pragma unroll 4
            for (int c = 0; c < 16; ++c) { const size_t o_ = (size_t)(bh * 16 + c) * 32768 + e; SPT[o_] = f2bf(sp); S = sp + UT[o_]; sp = g128 * S; }
            out[O_RETP + (size_t)bh * 32768 + (size_t)(e & 127) * RDV + (e >> 7)] = S;
        }
        {
            const int hd = lane >> 3, f4 = (lane & 7) * 4;
            u32x2_t x1, x2; f32x4 cb, sb;
#define P4_LOAD(r_, X1_, X2_, C_, S_) do { const bf16_t* q_ = Qb + (size_t)(r_) * 1536 + hd * DQH + DNOPE + f4; X1_ = *(const u32x2_t*)q_; X2_ = *(const u32x2_t*)(q_ + 32); \
            const int p_ = pos_index(r_); C_ = *(const f32x4*)(COSB + p_ * 32 + f4); S_ = *(const f32x4*)(SINB + p_ * 32 + f4); } while (0)
            int row = gw;
            if (row < NT) P4_LOAD(row, x1, x2, cb, sb);
            for (; row < NT; row += NGW) {
                u32x2_t x1n, x2n; f32x4 cbn, sbn; const int nr = row + NGW;
                if (nr < NT) P4_LOAD(nr, x1n, x2n, cbn, sbn);
                const float a0 = __builtin_bit_cast(float, x1.x << 16), a1 = __builtin_bit_cast(float, x1.x & 0xffff0000u), a2 = __builtin_bit_cast(float, x1.y << 16), a3 = __builtin_bit_cast(float, x1.y & 0xffff0000u);
                const float b0 = __builtin_bit_cast(float, x2.x << 16), b1 = __builtin_bit_cast(float, x2.x & 0xffff0000u), b2 = __builtin_bit_cast(float, x2.y << 16), b3 = __builtin_bit_cast(float, x2.y & 0xffff0000u);
                bf16_t* o_ = QPEb + (size_t)row * 512 + hd * DROPE + f4;
                *(u32x2_t*)o_ = (u32x2_t){cvtpk(a0 * cb[0] - b0 * sb[0], a1 * cb[1] - b1 * sb[1]), cvtpk(a2 * cb[2] - b2 * sb[2], a3 * cb[3] - b3 * sb[3])};
                *(u32x2_t*)(o_ + 32) = (u32x2_t){cvtpk(a0 * sb[0] + b0 * cb[0], a1 * sb[1] + b1 * cb[1]), cvtpk(a2 * sb[2] + b2 * cb[2], a3 * sb[3] + b3 * cb[3])};
                x1 = x1n; x2 = x2n; cb = cbn; sb = sbn;
            }
#undef P4_LOAD
        }
        for (int wt = gw; wt < MH * 16 * 2; wt += NGW) {
            const int lh = wt & 1, rb = (wt >> 1) & 15, head = wt >> 5; const int l31 = lane & 31, h8 = lane >> 5;
            f32x16 acc[4];
#pragma unroll
            for (int k_ = 0; k_ < 4; ++k_)
#pragma unroll
                for (int i = 0; i < 16; ++i) acc[k_][i] = 0.f;
            const bf16_t* ap = Qb + ((size_t)NP + 32 * rb + l31) * 1536 + head * DQH + 8 * h8;
            const bf16_t* bp = WukB + ((size_t)head * KVL + 128 * lh + l31) * DNOPE + 8 * h8;
#pragma unroll
            for (int s_ = 0; s_ < 8; ++s_) { const bf16x8 a = *(const bf16x8*)(ap + 16 * s_);
#pragma unroll
                for (int k_ = 0; k_ < 4; ++k_) { const bf16x8 b_ = *(const bf16x8*)(bp + (size_t)(32 * k_) * DNOPE + 16 * s_); acc[k_] = MFMA32(a, b_, acc[k_]); } }
#pragma unroll
            for (int k_ = 0; k_ < 4; ++k_)
#pragma unroll
                for (int i = 0; i < 16; ++i) QLATb[(size_t)(32 * rb + crow(i, h8)) * 2048 + head * KVL + 128 * lh + 32 * k_ + l31] = f2bf(acc[k_][i]);
        }
    }
    SEAM(4);
    if (IN(5)) {
        if (args.sub & 1) for (int it = bid; it < DB * MS_NSPLIT; it += G) { const int split = __builtin_amdgcn_readfirstlane(it % MS_NSPLIT), b = __builtin_amdgcn_readfirstlane(it / MS_NSPLIT);
            mla_sample_unit(ldsb, cache_ckv, cache_kpe, page_table, QLATb, QPEb, PO, PML, b, split, 0.07216878364870322f * 1.4426950408889634f); }
        if (args.sub & 2) for (int it = bid; it < NB * MH * 4; it += G) {
            const int pr = __builtin_amdgcn_readfirstlane(it & 3), hh = __builtin_amdgcn_readfirstlane((it >> 2) & 7), b = __builtin_amdgcn_readfirstlane(it >> 5);
#pragma unroll 1
            for (int half = 0; half < 2; ++half) { const int qb = __builtin_amdgcn_readfirstlane(half ? pr : 7 - pr); const size_t row0 = (size_t)b * SEQ + qb * 256;
                SrcMlaP src{KN, KPERb, VT, Qb, QPEb, b, hh, row0};
                flash_unit<192, 128, true>(ldsb, src, qb * 256, 4 * (qb + 1), OMLAb + row0 * 1024 + hh * DVH, 1024, 0.07216878364870322f * 1.4426950408889634f); }
        }
        if (args.sub & 4) for (int it = bid; it < NB * RH * 16; it += G) { const int c = __builtin_amdgcn_readfirstlane(it & 15), h = __builtin_amdgcn_readfirstlane((it >> 4) & 3), b = __builtin_amdgcn_readfirstlane(it >> 6);
            ret_chunk_out(RQt, RKt, RVT, SPT, ORET, b, h, c); }
        if (args.sub & 8) for (int it = bid; it < DB * RH; it += G) {
            const int h = it & 3, b = it >> 2; const float lg = lg_gamma(h);
            const float* s0 = state_ret + (size_t)it * RDK * RDV;
            float* so = out + O_RETS + (size_t)it * RDK * RDV;
            LAS float* inner = lds;
            LAS float* qk = lds + 16;
            LAS float* vls = lds + 1040;
            LAS float* red = lds + 2064;
            f32x4 sv[16], vv[4];
#pragma unroll
            for (int r = 0; r < 16; ++r) sv[r] = __builtin_nontemporal_load((const f32x4*)(s0 + (size_t)(wave + 8 * r) * RDV + 4 * lane));
#pragma unroll
            for (int j = 0; j < DS; ++j) vv[j] = *(const f32x4*)(Z + ((size_t)NP + b * DS + j) * ZLD + C_RV + h * RDV + 4 * lane);
            __syncthreads();
            for (int i = tid; i < 1024; i += NTHREADS) { const int which = i >> 9, ti = (i >> 7) & 3, d = i & 127; const size_t row = (size_t)NP + b * DS + ti;
                qk[i] = which ? RK[row * 512 + h * RDK + d] : RQ[row * 512 + h * RDK + d]; }
            if (wave == 0) {
#pragma unroll
                for (int j = 0; j < DS; ++j) *(LAS f32x4*)(vls + j * 256 + 4 * lane) = vv[j]; }
            __syncthreads();
            for (int pr = wave; pr < 16; pr += NWAVES) { const int i = pr >> 2, j = pr & 3;
                float s_ = qk[i * 128 + lane] * qk[512 + j * 128 + lane] + qk[i * 128 + 64 + lane] * qk[512 + j * 128 + 64 + lane];
                s_ = wave_sum(s_);
                if (lane == 0) inner[pr] = (j <= i) ? s_ * __expf((float)(i - j) * lg) : 0.f; }
            const float g4 = __expf(4.f * lg), gk0 = __expf(3.f * lg), gk1 = __expf(2.f * lg), gk2 = __expf(lg);
            f32x4 po[4];
#pragma unroll
            for (int i = 0; i < 4; ++i) po[i] = (f32x4){0.f, 0.f, 0.f, 0.f};
#pragma unroll
            for (int r = 0; r < 16; ++r) { const int d = wave + 8 * r; const f32x4 sx = sv[r];
                f32x4 a = sx * g4 + (gk0 * qk[512 + d]) * vv[0] + (gk1 * qk[512 + 128 + d]) * vv[1] + (gk2 * qk[512 + 256 + d]) * vv[2] + qk[512 + 384 + d] * vv[3];
                __builtin_nontemporal_store(a, (f32x4*)(so + (size_t)d * RDV + 4 * lane));
#pragma unroll
                for (int i = 0; i < 4; ++i) po[i] += qk[i * 128 + d] * sx; }
#pragma unroll
            for (int i = 0; i < 4; ++i) *(LAS f32x4*)(red + (wave * 4 + i) * 256 + 4 * lane) = po[i];
            __syncthreads();
            {
                const int i = tid >> 7, e2 = (tid & 127) * 2;
                float o0 = 0.f, o1 = 0.f;
#pragma unroll
                for (int w_ = 0; w_ < NWAVES; ++w_) { o0 += red[(w_ * 4 + i) * 256 + e2]; o1 += red[(w_ * 4 + i) * 256 + e2 + 1]; }
                const float gi = __expf((float)(i + 1) * lg); o0 *= gi; o1 *= gi;
#pragma unroll
                for (int j = 0; j < DS; ++j) { const float w_ = inner[i * 4 + j]; o0 += w_ * vls[j * 256 + e2]; o1 += w_ * vls[j * 256 + e2 + 1]; }
                *(f32x2_t*)(ORET + ((size_t)NP + b * DS + i) * 1024 + h * RDV + e2) = (f32x2_t){o0, o1};
            }
        }
        if (args.sub & 16) for (int it = bid; it < NB * XH * 8; it += G) {
            const int qb = __builtin_amdgcn_readfirstlane(it & 7), hh = __builtin_amdgcn_readfirstlane((it >> 3) & 3), b = __builtin_amdgcn_readfirstlane(it >> 5); const size_t row0 = (size_t)b * SEQ + qb * 256;
            SrcMemP src{MKb, MVT, XQb, b, hh, row0};
            flash_unit<64, 64, false>(ldsb, src, 0, 4, OXb + row0 * 256 + hh * XHD, 256, 0.125f * 1.4426950408889634f);
        }
        if (args.sub & 32) for (int b = bid; b < DB; b += G) {
            LAS float* sc = lds;
            LAS float* red = lds + 4096;
            const float* kb_ = cache_mem_k + (size_t)b * NMEM * 256; const float* vb_ = cache_mem_v + (size_t)b * NMEM * 256;
            f32x4 qr[4];
#pragma unroll
            for (int q = 0; q < DS; ++q) qr[q] = *(const f32x4*)(Z + ((size_t)NP + b * DS + q) * ZLD + C_XQ + 4 * lane);
            __syncthreads();
#pragma unroll 8
            for (int kk = 0; kk < 32; ++kk) { const int key = 32 * wave + kk; const f32x4 kv = __builtin_nontemporal_load((const f32x4*)(kb_ + (size_t)key * 256 + 4 * lane));
                float pq[4];
#pragma unroll
                for (int q = 0; q < 4; ++q) { float a = kv[0] * qr[q][0] + kv[1] * qr[q][1] + kv[2] * qr[q][2] + kv[3] * qr[q][3];
                    a += __shfl_xor(a, 1); a += __shfl_xor(a, 2); a += __shfl_xor(a, 4); a += __shfl_xor(a, 8); pq[q] = a; }
                if ((lane & 15) == 0) {
#pragma unroll
                    for (int q = 0; q < 4; ++q) sc[(q * 4 + (lane >> 4)) * 256 + key] = pq[q] * (0.125f * 1.4426950408889634f); } }
            __syncthreads();
            for (int rr = wave * 2; rr < wave * 2 + 2; ++rr) {
                f32x4 v = *(LAS f32x4*)(sc + rr * 256 + 4 * lane);
                const float mx = wave_max(fmaxf(fmaxf(v[0], v[1]), fmaxf(v[2], v[3])));
#pragma unroll
                for (int e = 0; e < 4; ++e) v[e] = __builtin_amdgcn_exp2f(v[e] - mx);
                const float inv = 1.f / wave_sum(v[0] + v[1] + v[2] + v[3]);
                *(LAS f32x4*)(sc + rr * 256 + 4 * lane) = v * inv; }
            __syncthreads();
            f32x4 acc[4];
#pragma unroll
            for (int q = 0; q < 4; ++q) acc[q] = (f32x4){0.f, 0.f, 0.f, 0.f};
#pragma unroll 8
            for (int kk = 0; kk < 32; ++kk) { const int key = 32 * wave + kk; const f32x4 vv = __builtin_nontemporal_load((const f32x4*)(vb_ + (size_t)key * 256 + 4 * lane));
#pragma unroll
                for (int q = 0; q < 4; ++q) acc[q] += sc[(q * 4 + (lane >> 4)) * 256 + key] * vv; }
#pragma unroll
            for (int q = 0; q < 4; ++q) *(LAS f32x4*)(red + (wave * 4 + q) * 256 + 4 * lane) = acc[q];
            __syncthreads();
            { const int q = tid >> 7, e2 = (tid & 127) * 2; float o0 = 0.f, o1 = 0.f;
#pragma unroll
              for (int w_ = 0; w_ < NWAVES; ++w_) { o0 += red[(w_ * 4 + q) * 256 + e2]; o1 += red[(w_ * 4 + q) * 256 + e2 + 1]; }
              *(unsigned*)(OXb + ((size_t)NP + b * DS + q) * 256 + e2) = cvtpk(o0, o1); }
        }
    }
    SEAM(5);
    if (IN(6)) {
        for (int b = bid; b < DB; b += G) {
            const int head = wave; const float c2 = 0.07216878364870322f * 1.4426950408889634f;
            LAS float* ol = lds + wave * KVL;
            for (int t = 0; t < DS; ++t) {
                const int qi = t * 8 + head; const size_t qrow = (size_t)b * DS + t;
                float qv[5];
#pragma unroll
                for (int c = 0; c < 5; ++c) { const int d = lane + 64 * c; const bf16_t raw = d < KVL ? QLATb[qrow * 2048 + head * KVL + d] : QPEb[(NP + qrow) * 512 + head * DROPE + (d - KVL)];
                    qv[c] = __builtin_bit_cast(float, (unsigned)raw << 16); }
                float sc[DS]; float M = -INFINITY;
#pragma unroll
                for (int j = 0; j < DS; ++j) { const size_t krow = (size_t)NP + b * DS + j; float a = 0.f;
#pragma unroll
                    for (int c = 0; c < 5; ++c) { const int d = lane + 64 * c; a += qv[c] * (d < KVL ? CKVN[krow * KVL + d] : KPER[krow * DROPE + (d - KVL)]); }
                    a = wave_sum(a) * c2; sc[j] = (j <= t) ? a : -INFINITY; M = fmaxf(M, sc[j]); }
                float ms[MS_NSPLIT], ls[MS_NSPLIT];
#pragma unroll
                for (int sp = 0; sp < MS_NSPLIT; ++sp) { const int item = b * MS_NSPLIT + sp; ms[sp] = PML[(item * 32 + qi) * 2]; ls[sp] = PML[(item * 32 + qi) * 2 + 1]; M = fmaxf(M, ms[sp]); }
                float L = 0.f; float acc[4] = {0.f, 0.f, 0.f, 0.f};
#pragma unroll
                for (int sp = 0; sp < MS_NSPLIT; ++sp) { const int item = b * MS_NSPLIT + sp; const float wgt = __builtin_amdgcn_exp2f(ms[sp] - M); L += ls[sp] * wgt;
#pragma unroll
                    for (int c = 0; c < 4; ++c) acc[c] += wgt * PO[((size_t)item * 32 + qi) * KVL + lane + 64 * c]; }
#pragma unroll
                for (int j = 0; j < DS; ++j) { const float wgt = __builtin_amdgcn_exp2f(sc[j] - M); L += wgt; const size_t krow = (size_t)NP + b * DS + j;
#pragma unroll
                    for (int c = 0; c < 4; ++c) acc[c] += wgt * CKVN[krow * KVL + lane + 64 * c]; }
                const float inv = 1.f / L;
#pragma unroll
                for (int c = 0; c < 4; ++c) ol[lane + 64 * c] = acc[c] * inv;
                __syncthreads();
                float a0 = 0.f, a1 = 0.f; const float* wv = w_uv + (size_t)head * KVL * DVH;
#pragma unroll 8
                for (int l = 0; l < KVL; ++l) { const float x = ol[l]; a0 += x * wv[(size_t)l * DVH + lane]; a1 += x * wv[(size_t)l * DVH + 64 + lane]; }
                OMLAb[((size_t)NP + qrow) * 1024 + head * DVH + lane] = f2bf(a0); OMLAb[((size_t)NP + qrow) * 1024 + head * DVH + 64 + lane] = f2bf(a1);
                __syncthreads();
            }
        }
        {
            f32x4 a[4], gz[4];
#define P6_LOAD(r_, A_, B_) do { _Pragma("unroll") for (int j_ = 0; j_ < 4; ++j_) { A_[j_] = *(const f32x4*)(ORET + (size_t)(r_) * 1024 + 4 * lane + 256 * j_); \
                                                                              B_[j_] = *(const f32x4*)(Z + (size_t)(r_) * ZLD + C_RG + 4 * lane + 256 * j_); } } while (0)
            int row = gw;
            if (row < NT) P6_LOAD(row, a, gz);
            for (; row < NT; row += NGW) {
                f32x4 an[4], gn[4]; const int nr = row + NGW;
                if (nr < NT) P6_LOAD(nr, an, gn);
#pragma unroll
                for (int j = 0; j < 4; ++j) {
                    const float ss = wave_sum(a[j][0] * a[j][0] + a[j][1] * a[j][1] + a[j][2] * a[j][2] + a[j][3] * a[j][3]);
                    const float r = rsqrtf(ss * (1.f / RDV) + EPS);
                    float o_[4];
#pragma unroll
                    for (int e = 0; e < 4; ++e) o_[e] = gz[j][e] / (1.f + __expf(-gz[j][e])) * a[j][e] * r;
                    *(u32x2_t*)(ORETNb + (size_t)row * 1024 + 4 * lane + 256 * j) = (u32x2_t){cvtpk(o_[0], o_[1]), cvtpk(o_[2], o_[3])};
                }
#pragma unroll
                for (int j = 0; j < 4; ++j) { a[j] = an[j]; gz[j] = gn[j]; }
            }
#undef P6_LOAD
        }
    }
    SEAM(6);
    if (IN(7)) {
        pg8::StaticOrder S; S.init(NP, 1024, G, bid);
        { pg8::Gemm g{ORETNb, WroT, NP, 1024, 1024, 1024, 1024}; pg8::EpiGate<0> E{Z + C_G, ZLD, ARET, MIXb, 1024}; GEMM_PHASE(pg8::EpiGate<0>, ldsb, g, S, E); }
        __syncthreads();
        { pg8::Gemm g{OMLAb, WmoT, NP, 1024, 1024, 1024, 1024}; pg8::EpiGate<1> E{Z + C_G + 1024, ZLD, ARET, MIXb, 1024}; GEMM_PHASE(pg8::EpiGate<1>, ldsb, g, S, E); }
        __syncthreads();
        { pg8::Gemm g{OXb, WxoT, NP, 1024, 256, 256, 256}; pg8::EpiGate<2> E{Z + C_G + 2048, ZLD, ARET, MIXb, 1024}; GEMM_PHASE(pg8::EpiGate<2>, ldsb, g, S, E); }
        __syncthreads();
        { pg8::Gemm g{ORETNb, WroT, NT, 1024, 256, 1024, 1024, 256}; pg8::SplitOrder SS{4, bid}; pg8::EpiPart E{PART}; GEMM_SPLIT(ldsb, g, SS, E); }
        __syncthreads();
        { pg8::Gemm g{OMLAb, WmoT, NT, 1024, 256, 1024, 1024, 256}; pg8::SplitOrder SS{4, (bid + 224) % G}; pg8::EpiPart E{PART + (size_t)4 * 512 * 1024}; GEMM_SPLIT(ldsb, g, SS, E); }
        __syncthreads();
        { pg8::Gemm g{OXb, WxoT, NT, 1024, 256, 256, 256, 256}; pg8::SplitOrder SS{1, (bid + 128) % G}; pg8::EpiPart E{PART + (size_t)8 * 512 * 1024}; GEMM_SPLIT(ldsb, g, SS, E); }
    }
    SEAM(7);
    if (IN(8)) {
        for (int i = bid * NTHREADS + tid; i < NS * 256; i += G * NTHREADS) { const int r = i >> 8, c4 = (i & 255) * 4; const size_t o_ = (size_t)r * 1024 + c4;
            f32x4 mix = {0.f, 0.f, 0.f, 0.f};
#pragma unroll
            for (int br = 0; br < 3; ++br) { f32x4 a = *(const f32x4*)(PART + (size_t)(br == 2 ? 8 : 4 * br) * (512 * 1024) + o_);
                if (br < 2) {
#pragma unroll
                    for (int k_ = 1; k_ < 4; ++k_) a += *(const f32x4*)(PART + (size_t)(4 * br + k_) * (512 * 1024) + o_); }
                const f32x4 gz = *(const f32x4*)(Z + (size_t)(NP + r) * ZLD + C_G + br * 1024 + c4);
#pragma unroll
                for (int e = 0; e < 4; ++e) mix[e] += a[e] / (1.f + __expf(-gz[e])); }
            *(u32x2_t*)(MIXb + (size_t)(NP + r) * 1024 + c4) = (u32x2_t){cvtpk(mix[0], mix[1]), cvtpk(mix[2], mix[3])}; }
    }
    SEAM(8);
    if (IN(9)) { pg8::Gemm g{MIXb, WoT, NP, 1024, 1024, 1024, 1024}; pg8::StaticOrder S; S.init(NP, 1024, G, bid); pg8::EpiF32S E{HP, 1024, 0, 0};
        GEMM_PHASE(pg8::EpiF32S, ldsb, g, S, E);
        __syncthreads();
        { pg8::Gemm g2{MIXb, WoT, NT, 1024, 256, 1024, 1024, 256}; pg8::SplitOrder SS{4, bid}; pg8::EpiPart E2{PART}; GEMM_SPLIT(ldsb, g2, SS, E2); } }
    SEAM(9);
    if (IN(10)) {
        f32x4 gp[4], gf[4], a[4], b[4];
#pragma unroll
        for (int j = 0; j < 4; ++j) { gp[j] = *(const f32x4*)(g_mix_post + 4 * lane + 256 * j); gf[j] = *(const f32x4*)(g_ffn_pre + 4 * lane + 256 * j); }
#define P10_LOAD(r_, A_, B_) do { const float* xr_ = (r_) < NP ? x_prompt + (size_t)(r_) * DM : x_sample + (size_t)((r_) - NP) * DM; \
        _Pragma("unroll") for (int j_ = 0; j_ < 4; ++j_) { B_[j_] = *(const f32x4*)(xr_ + 4 * lane + 256 * j_); \
            if ((r_) < NP) A_[j_] = *(const f32x4*)(HP + (size_t)(r_) * DM + 4 * lane + 256 * j_); \
            else { const float* p_ = PART + (size_t)((r_) - NP) * DM + 4 * lane + 256 * j_; A_[j_] = (*(const f32x4*)p_ + *(const f32x4*)(p_ + 512 * 1024)) + (*(const f32x4*)(p_ + 2 * 512 * 1024) + *(const f32x4*)(p_ + 3 * 512 * 1024)); } } } while (0)
        int row = gw;
        if (row < NT) P10_LOAD(row, a, b);
        for (; row < NT; row += NGW) {
            f32x4 an[4], bn[4]; const int nr = row + NGW;
            if (nr < NT) P10_LOAD(nr, an, bn);
            float ss = 0.f;
#pragma unroll
            for (int j = 0; j < 4; ++j) ss += a[j][0] * a[j][0] + a[j][1] * a[j][1] + a[j][2] * a[j][2] + a[j][3] * a[j][3];
            float r = rsqrtf(wave_sum(ss) * (1.f / DM) + EPS); ss = 0.f;
#pragma unroll
            for (int j = 0; j < 4; ++j) { a[j] = b[j] + a[j] * r * gp[j]; *(f32x4*)(H + (size_t)row * DM + 4 * lane + 256 * j) = a[j];
                ss += a[j][0] * a[j][0] + a[j][1] * a[j][1] + a[j][2] * a[j][2] + a[j][3] * a[j][3]; }
            r = rsqrtf(wave_sum(ss) * (1.f / DM) + EPS);
#pragma unroll
            for (int j = 0; j < 4; ++j) { const f32x4 f_ = a[j] * r * gf[j]; *(u32x2_t*)(Fb + (size_t)row * DM + 4 * lane + 256 * j) = (u32x2_t){cvtpk(f_[0], f_[1]), cvtpk(f_[2], f_[3])}; }
#pragma unroll
            for (int j = 0; j < 4; ++j) { a[j] = an[j]; b[j] = bn[j]; }
        }
#undef P10_LOAD
    }
    SEAM(10);
    if (IN(11)) {
        pg8::Gemm g{Fb, WguT, NT, 2 * DFF, 1024, 1024, 1024}; pg8::StaticOrder S; S.init(NT, 2 * DFF, G, bid); pg8::EpiSwiGLU E{ACTb, DFF};
        GEMM_PHASE(pg8::EpiSwiGLU, ldsb, g, S, E);
    }
    SEAM(11);
    if (IN(13)) { pg8::Gemm g{ACTb, WdT, NP, 1024, DFF, DFF, DFF}; pg8::StaticOrder S; S.init(NP, 1024, G, bid); pg8::EpiF32S E{FO, 1024, 0, 0};
        GEMM_PHASE(pg8::EpiF32S, ldsb, g, S, E);
        __syncthreads();
        { pg8::Gemm g2{ACTb, WdT, NT, 1024, 256, DFF, DFF, 256}; pg8::SplitOrder SS{11, bid}; pg8::EpiPart E2{PART}; GEMM_SPLIT(ldsb, g2, SS, E2); } }
    SEAM(13);
    if (IN(14)) {
        f32x4 gp[4], a[4], b[4];
#pragma unroll
        for (int j = 0; j < 4; ++j) gp[j] = *(const f32x4*)(g_ffn_post + 4 * lane + 256 * j);
#define P14_LOAD(r_, A_, B_) do { _Pragma("unroll") for (int j_ = 0; j_ < 4; ++j_) { B_[j_] = *(const f32x4*)(H + (size_t)(r_) * DM + 4 * lane + 256 * j_); \
            if ((r_) < NP) A_[j_] = *(const f32x4*)(FO + (size_t)(r_) * DM + 4 * lane + 256 * j_); \
            else { const float* p_ = PART + (size_t)((r_) - NP) * DM + 4 * lane + 256 * j_; f32x4 a_ = *(const f32x4*)p_; \
                _Pragma("unroll") for (int k_ = 1; k_ < 11; ++k_) a_ += *(const f32x4*)(p_ + (size_t)k_ * 512 * 1024); A_[j_] = a_; } } } while (0)
        int row = gw;
        if (row < NT) P14_LOAD(row, a, b);
        for (; row < NT; row += NGW) {
            f32x4 an[4], bn[4]; const int nr = row + NGW;
            if (nr < NT) P14_LOAD(nr, an, bn);
            float ss = 0.f;
#pragma unroll
            for (int j = 0; j < 4; ++j) ss += a[j][0] * a[j][0] + a[j][1] * a[j][1] + a[j][2] * a[j][2] + a[j][3] * a[j][3];
            const float r = rsqrtf(wave_sum(ss) * (1.f / DM) + EPS);
            float* y = row < NP ? out + O_YP + (size_t)row * DM : out + O_YS + (size_t)(row - NP) * DM;
#pragma unroll
            for (int j = 0; j < 4; ++j) *(f32x4*)(y + 4 * lane + 256 * j) = b[j] + a[j] * r * gp[j];
#pragma unroll
            for (int j = 0; j < 4; ++j) { a[j] = an[j]; b[j] = bn[j]; }
        }
#undef P14_LOAD
    }
#undef IN
#undef SEAM
}
constexpr int N_PHASES = 15;
}

extern "C" void kernel_launch(void* const* d_in, const int* in_sizes, int n_in, void* d_out, int out_size, void* d_ws, size_t ws_size, hipStream_t stream) {
    static int grid = 0;
    if (grid == 0) {
        if (n_in != 29 || (size_t)out_size != O_END || ws_size < WS_END) { fprintf(stderr, "kernel_launch: unexpected shapes: n_in %d out %d ws %zu (need %zu)\n", n_in, out_size, ws_size, (size_t)WS_END); grid = -1; return; }
        int dev = 0, cus = 0, per_cu = 0;
        if (hipGetDevice(&dev) != hipSuccess || hipDeviceGetAttribute(&cus, hipDeviceAttributeMultiprocessorCount, dev) != hipSuccess) { grid = -1; return; }
        if (hipFuncSetAttribute((const void*)fwd_kernel, hipFuncAttributeMaxDynamicSharedMemorySize, LDS_BYTES) != hipSuccess) { fprintf(stderr, "kernel_launch: hipFuncSetAttribute failed\n"); grid = -1; return; }
        if (hipOccupancyMaxActiveBlocksPerMultiprocessor(&per_cu, (const void*)fwd_kernel, NTHREADS, LDS_BYTES) != hipSuccess || per_cu < 1) { fprintf(stderr, "kernel_launch: occupancy query says %d\n", per_cu); per_cu = 1; }
        (void)hipGetLastError();
        grid = cus;
    }
    if (grid < 0) return;
    (void)hipMemsetAsync((char*)d_ws + WS_CTL, 0, CTL_BYTES, stream);
    Args a{};
    for (int i = 0; i < 29; ++i) a.in[i] = (const float*)d_in[i];
    a.out = (float*)d_out; a.ws = (unsigned char*)d_ws;
#if MK_ONE_LAUNCH
    a.ph_lo = 0; a.ph_hi = N_PHASES; a.sub = 0xff;
    hipLaunchKernelGGL(fwd_kernel, dim3(grid), dim3(NTHREADS), LDS_BYTES, stream, a);
#if PROBE_DUP >= 0
    a.ph_lo = PROBE_DUP; a.ph_hi = PROBE_DUP + 1; a.sub = PROBE_SUB;
    hipLaunchKernelGGL(fwd_kernel, dim3(grid), dim3(NTHREADS), LDS_BYTES, stream, a);
#endif
#else
    a.sub = 0xff; for (int p = 0; p < N_PHASES; ++p) { a.ph_lo = p; a.ph_hi = p + 1; hipLaunchKernelGGL(fwd_kernel, dim3(grid), dim3(NTHREADS), LDS_BYTES, stream, a); }
#endif
}
```

```cpp
#include <hip/hip_runtime.h>
#include <cstdio>
#include <cstdint>

#ifndef PROBE_DUP
#define PROBE_DUP -1
#endif
#ifndef PROBE_SUB
#define PROBE_SUB 0xff
#endif
#ifndef MK_ONE_LAUNCH
#define MK_ONE_LAUNCH 1
#endif

#define LAS __attribute__((address_space(3)))
#define GAS __attribute__((address_space(1)))
#define DI __device__ __forceinline__
typedef float f32x4 __attribute__((ext_vector_type(4)));
typedef __bf16 bf16x2_t __attribute__((ext_vector_type(2)));
typedef float f32x2_t __attribute__((ext_vector_type(2)));
DI unsigned cvtpk(float lo, float hi) { f32x2_t v = {lo, hi}; bf16x2_t b = __builtin_convertvector(v, bf16x2_t); return __builtin_bit_cast(unsigned, b); }

namespace {
constexpr int DM = 1024, NB = 8, SEQ = 2048, NP = NB * SEQ, DB = 128, DS = 4, NS = DB * DS, NT = NP + NS;
constexpr int PAST = 8192, PAGE = 128, NPAGES = PAST / PAGE;
constexpr int RH = 4, RDK = 128, RDV = 256;
constexpr int MH = 8, QL = 384, KVL = 256, DNOPE = 128, DROPE = 64, DVH = 128, DQH = DNOPE + DROPE;
constexpr int NMEM = 256, XH = 4, XHD = 64;
constexpr int DFF = 2816, DIN = 7104, ZLD = 7168;
constexpr int C_RQ = 0, C_RK = 512, C_RV = 1024, C_RG = 2048, C_CQ = 3072, C_CKV = 3456, C_KPE = 3712, C_XQ = 3776, C_G = 4032;
constexpr float EPS = 1e-6f;
constexpr int NPOS = SEQ + DS;
constexpr int NTHREADS = 512, NWAVES = 8;
constexpr int LDS_BYTES = 147456;
constexpr int MISC_OFF = 147456 - 256;

constexpr size_t O_YP = 0, O_YS = O_YP + (size_t)NP * DM, O_CKVP = O_YS + (size_t)NS * DM, O_KPEP = O_CKVP + (size_t)NP * KVL,
                 O_CKVS = O_KPEP + (size_t)NP * DROPE, O_KPES = O_CKVS + (size_t)NS * KVL, O_RETP = O_KPES + (size_t)NS * DROPE,
                 O_RETS = O_RETP + (size_t)NB * RH * RDK * RDV, O_MKP = O_RETS + (size_t)DB * RH * RDK * RDV, O_MVP = O_MKP + (size_t)NB * NMEM * 256,
                 O_END = O_MVP + (size_t)NB * NMEM * 256;

constexpr size_t al256(size_t x) { return (x + 255) & ~(size_t)255; }
constexpr size_t WS_CTL = 0, CTL_BYTES = 1u << 20;
constexpr size_t WS_COSA = WS_CTL + CTL_BYTES;
constexpr size_t WS_SINA = WS_COSA + al256((size_t)NPOS * 64 * 4);
constexpr size_t WS_COSB = WS_SINA + al256((size_t)NPOS * 64 * 4);
constexpr size_t WS_SINB = WS_COSB + al256((size_t)NPOS * 32 * 4);
constexpr size_t WS_U = WS_SINB + al256((size_t)NPOS * 32 * 4);
constexpr size_t WS_MN = WS_U + (size_t)NT * DM * 4;
constexpr size_t WS_Z = WS_MN + (size_t)NB * NMEM * DM * 4;
constexpr size_t WS_RQ = WS_Z + (size_t)NT * ZLD * 4;
constexpr size_t WS_RK = WS_RQ + (size_t)NT * 512 * 4;
constexpr size_t WS_CQN = WS_RK + (size_t)NT * 512 * 4;
constexpr size_t WS_CKVN = WS_CQN + (size_t)NT * QL * 4;
constexpr size_t WS_KPER = WS_CKVN + (size_t)NT * KVL * 4;
constexpr size_t WS_Q = WS_KPER + (size_t)NT * DROPE * 4;
constexpr size_t WS_QLAT = WS_Q + (size_t)NT * 1536 * 4;
constexpr size_t WS_QPE = WS_QLAT + (size_t)NT * 2048 * 4;
constexpr size_t WS_ORET = WS_QPE + (size_t)NT * 512 * 4;
constexpr size_t WS_OLAT = WS_ORET + (size_t)NT * 1024 * 4;
constexpr size_t WS_OX = WS_OLAT + (size_t)NT * 2048 * 4;
constexpr size_t WS_OMLA = WS_OX + (size_t)NT * 256 * 4;
constexpr size_t WS_ORETN = WS_OMLA + (size_t)NT * 1024 * 4;
constexpr size_t WS_ARET = WS_ORETN + (size_t)NT * 1024 * 4;
constexpr size_t WS_AMLA = WS_ARET + (size_t)NT * 1024 * 4;
constexpr size_t WS_AX = WS_AMLA + (size_t)NT * 1024 * 4;
constexpr size_t WS_MIX = WS_AX + (size_t)NT * 1024 * 4;
constexpr size_t WS_HP = WS_MIX + (size_t)NT * 1024 * 4;
constexpr size_t WS_H = WS_HP + (size_t)NT * 1024 * 4;
constexpr size_t WS_F = WS_H + (size_t)NT * 1024 * 4;
constexpr size_t WS_GG = WS_F + (size_t)NT * 1024 * 4;
constexpr size_t WS_UP = WS_GG + (size_t)NT * DFF * 4;
constexpr size_t WS_ACT = WS_UP + (size_t)NT * DFF * 4;
constexpr size_t WS_FO = WS_ACT + (size_t)NT * DFF * 4;
constexpr size_t WS_F32_END = WS_FO + (size_t)NT * 1024 * 4;
constexpr size_t WS_WIN_T = al256(WS_F32_END);
constexpr size_t WS_WMKV_T = WS_WIN_T + (size_t)ZLD * 1024 * 2;
constexpr size_t WS_WUQ_T = WS_WMKV_T + (size_t)512 * 1024 * 2;
constexpr size_t WS_WRO_T = WS_WUQ_T + (size_t)1536 * 384 * 2;
constexpr size_t WS_WMO_T = WS_WRO_T + (size_t)1024 * 1024 * 2;
constexpr size_t WS_WXO_T = WS_WMO_T + (size_t)1024 * 1024 * 2;
constexpr size_t WS_WO_T = WS_WXO_T + (size_t)1024 * 256 * 2;
constexpr size_t WS_WGU_T = WS_WO_T + (size_t)1024 * 1024 * 2;
constexpr size_t WS_WD_T = WS_WGU_T + (size_t)5632 * 1024 * 2;
constexpr size_t WS_UB = WS_WD_T + (size_t)1024 * 2816 * 2;
constexpr size_t WS_MNB = WS_UB + (size_t)NT * 1024 * 2;
constexpr size_t WS_CQNB = WS_MNB + (size_t)2048 * 1024 * 2;
constexpr size_t WS_ORETNB = WS_CQNB + (size_t)NT * 384 * 2;
constexpr size_t WS_OMLAB = WS_ORETNB + (size_t)NT * 1024 * 2;
constexpr size_t WS_OXB = WS_OMLAB + (size_t)NT * 1024 * 2;
constexpr size_t WS_MIXB = WS_OXB + (size_t)NT * 256 * 2;
constexpr size_t WS_FB = WS_MIXB + (size_t)NT * 1024 * 2;
constexpr size_t WS_ACTB = WS_FB + (size_t)NT * 1024 * 2;
constexpr size_t WS_WUK_T = WS_ACTB + (size_t)NT * 2816 * 2;
constexpr size_t WS_WUV_T = WS_WUK_T + (size_t)1024 * 256 * 2;
constexpr size_t WS_CKVNB = WS_WUV_T + (size_t)1024 * 256 * 2;
constexpr size_t WS_KPERB = WS_CKVNB + (size_t)NT * 256 * 2;
constexpr size_t WS_XQB = WS_KPERB + (size_t)NT * 64 * 2;
constexpr size_t WS_MKB = WS_XQB + (size_t)NT * 256 * 2;
constexpr size_t WS_MVT = WS_MKB + (size_t)2048 * 256 * 2;
constexpr size_t WS_KN = WS_MVT + (size_t)2048 * 256 * 2;
constexpr size_t WS_VT = WS_KN + (size_t)NP * 1024 * 2;
constexpr size_t WS_QB = WS_VT + (size_t)NP * 1024 * 2;
constexpr size_t WS_RQT = WS_QB + (size_t)NT * 1536 * 2;
constexpr size_t WS_RKT = WS_RQT + (size_t)NP * 512 * 2;
constexpr size_t WS_RKTT = WS_RKT + (size_t)NP * 512 * 2;
constexpr size_t WS_RVT = WS_RKTT + (size_t)NP * 512 * 2;
constexpr size_t WS_UT = WS_RVT + (size_t)NT * 1024 * 2;
constexpr size_t WS_SPT = WS_UT + (size_t)512 * 32768 * 4;
constexpr size_t WS_QLATB = WS_SPT + (size_t)512 * 32768 * 2;
constexpr size_t WS_PO = WS_QLATB + (size_t)NS * 2048 * 2;
constexpr size_t WS_PML = WS_PO + (size_t)DB * 2 * 32 * 256 * 4;
constexpr size_t WS_PART = al256(WS_PML + (size_t)DB * 2 * 32 * 2 * 4);
constexpr size_t WS_QPEB_ = WS_PART + (size_t)11 * 512 * 1024 * 4;
constexpr size_t WS_QPEB = al256(WS_QPEB_ + 0 * WS_PML + (size_t)DB * 2 * 32 * 2 * 4);
constexpr size_t WS_SGB = WS_QPEB + (size_t)NT * 512 * 2;
constexpr size_t WS_SRGB = WS_SGB + (size_t)NT * 3072 * 2;
constexpr size_t WS_T0B = WS_SRGB + (size_t)NT * 1024 * 2;
constexpr size_t WS_T1B = WS_T0B + (size_t)NT * 1024 * 2;
constexpr size_t WS_WUKB = WS_T1B + (size_t)NT * 1024 * 2;
constexpr size_t WS_END = WS_WUKB + (size_t)8 * 256 * 128 * 2;

constexpr int CW_BAR = 4096;

#define XB_TMO      128
#define XB_XCNT(j)  (256  + 64 * (j))
#define XB_XSUB(j)  (1280 + 64 * (j))
#define XB_XGEN(j)  (2304 + 64 * (j))
#define XB_TOP      3328
#define XB_TOPGEN   3392
#define XCD_BAR_WORDS 3456
#define XB_SPIN_CAP (1u << 25)

DI unsigned xb_ld(unsigned* p)              { return __hip_atomic_load(p, __ATOMIC_RELAXED, __HIP_MEMORY_SCOPE_AGENT); }
DI unsigned xb_add(unsigned* p, unsigned v) { return __hip_atomic_fetch_add(p, v, __ATOMIC_RELAXED, __HIP_MEMORY_SCOPE_AGENT); }
DI unsigned xb_xcc_id() { return (unsigned)__builtin_amdgcn_s_getreg((3 << 11) | 20) & 0xFu; }
#define XB_SPIN(cond, bar) do { unsigned _sp = 0; while (cond) { __builtin_amdgcn_s_sleep(1); \
    if ((++_sp & 255u) == 0u) { if (xb_ld(&(bar)[XB_TMO])) break; if (_sp > XB_SPIN_CAP) { atomicAdd(&(bar)[XB_TMO], 1u); break; } } } } while (0)

struct XcdBarrier { unsigned* bar; unsigned x; volatile LAS unsigned* st; };

DI XcdBarrier xcd_barrier_post(unsigned* bar, volatile LAS unsigned* st) {
    XcdBarrier b; b.bar = bar; b.x = xb_xcc_id(); b.st = st;
    if (threadIdx.x == 0) (void)xb_add(&bar[XB_XCNT(b.x)], 1u);
    return b;
}
DI void xcd_barrier_complete(unsigned* bar, unsigned x, unsigned& nloc, unsigned& nx) {
    const unsigned G = gridDim.x * gridDim.y * gridDim.z;
    unsigned sum, cnt, mine, sp = 0u;
    for (;;) {
        sum = 0u; cnt = 0u; mine = 0u;
#pragma unroll
        for (unsigned j = 0; j < 16; ++j) { const unsigned c = xb_ld(&bar[XB_XCNT(j)]); sum += c; cnt += (c > 0u) ? 1u : 0u; mine = (j == x) ? c : mine; }
        if (sum == G) break;
        __builtin_amdgcn_s_sleep(1);
        if ((++sp & 255u) == 0u) { if (xb_ld(&bar[XB_TMO])) break; if (sp > XB_SPIN_CAP) { atomicAdd(&bar[XB_TMO], 1u); break; } }
    }
    nloc = mine > 0u ? mine : 1u; nx = cnt > 0u ? cnt : 1u;
}
DI void xcd_barrier(const XcdBarrier& b) {
    asm volatile("s_waitcnt vmcnt(0)" ::: "memory");
    __syncthreads();
    if (threadIdx.x == 0) {
        unsigned* bar = b.bar;
        __builtin_amdgcn_s_waitcnt(0);
        unsigned nloc = b.st[0], nx = b.st[1];
        if (nloc == 0u) { xcd_barrier_complete(bar, b.x, nloc, nx); b.st[0] = nloc; b.st[1] = nx; }
        const unsigned old = xb_add(&bar[XB_XSUB(b.x)], 1u);
        const unsigned gen = old / nloc;
        if (old + 1u == (gen + 1u) * nloc) {
            __builtin_amdgcn_fence(__ATOMIC_RELEASE, "agent");
            asm volatile("s_waitcnt vmcnt(0)" ::: "memory");
            const unsigned og = xb_add(&bar[XB_TOP], 1u);
            const unsigned tg = og / nx;
            if (og + 1u == (tg + 1u) * nx) xb_add(&bar[XB_TOPGEN], 1u);
            else XB_SPIN(xb_ld(&bar[XB_TOPGEN]) == tg, bar);
            __builtin_amdgcn_fence(__ATOMIC_ACQUIRE, "agent");
            xb_add(&bar[XB_XGEN(b.x)], 1u);
            asm volatile("s_waitcnt vmcnt(0)" ::: "memory");
        } else {
            XB_SPIN(xb_ld(&bar[XB_XGEN(b.x)]) == gen, bar);
            __builtin_amdgcn_fence(__ATOMIC_ACQUIRE, "agent");
            asm volatile("s_waitcnt vmcnt(0)" ::: "memory");
        }
    }
    __syncthreads();
}

DI float wave_sum(float v) {
#pragma unroll
    for (int o = 1; o < 64; o <<= 1) v += __shfl_xor(v, o);
    return v;
}
DI float wave_max(float v) {
#pragma unroll
    for (int o = 1; o < 64; o <<= 1) v = fmaxf(v, __shfl_xor(v, o));
    return v;
}
DI float sigmoidf_(float x) { return 1.f / (1.f + expf(-x)); }
DI float siluf_(float x) { return x / (1.f + expf(-x)); }
DI int pos_index(int row) { return row < NP ? (row & (SEQ - 1)) : SEQ + ((row - NP) & (DS - 1)); }
DI float lg_gamma(int h) { return h == 0 ? -0.03174869831458027f : h == 1 ? -0.015748356968139112f : h == 2 ? -0.007843177461025892f : -0.003913899321136329f; }


namespace pg8 {
typedef unsigned short bf16_t;
typedef short bf16x8 __attribute__((ext_vector_type(8)));
typedef unsigned u32x4 __attribute__((ext_vector_type(4)));
typedef unsigned u32x2 __attribute__((ext_vector_type(2)));
constexpr int BM = 256, BK = 64, HALF = 128, HTB = HALF * BK * 2, STAGE_BYTES = 8 * HTB, NXCD = 8, WGM = 8;
__host__ __device__ __forceinline__ int lds_byte(int r, int c) { const int st = (r >> 4) * 2 + (c >> 5), rr = r & 15, cc = c & 31, ob = rr * 64 + cc * 2; return st * 1024 + (ob ^ (((ob >> 9) & 1) << 5)); }
__host__ __device__ __forceinline__ void stage_rc(int b, int& R, int& C) { const int st = b / 1024, sb = b % 1024, swz = sb ^ (((sb >> 9) & 1) << 5); R = (st >> 1) * 16 + swz / 64; C = (st & 1) * 32 + (swz % 64) / 2; }
__host__ __device__ __forceinline__ int perm32(int rho) { const int n = rho >> 4, i = rho & 15; return 8 * (i >> 2) + 4 * n + (i & 3); }
struct Unit { int pm, pn, ks; };
struct Gemm { const bf16_t* A; const bf16_t* Bt; int M, N, K, lda, ldb, ksl; };
struct StaticOrder {
    int nM, nN, nwg, G, c;
    __host__ __device__ void init(int M, int N, int G_, int c_) { nM = M / BM; nN = N / BM; nwg = nM * nN; G = G_; c = c_; }
    __host__ __device__ bool next(int i, Unit& u) const {
        const long L = (long)i * G + c; if (L >= nwg) return false;
        int wgid = (int)L; { const int q = nwg / NXCD, r = nwg % NXCD, xcd = wgid % NXCD, off = wgid / NXCD; wgid = (xcd < r ? xcd * (q + 1) : r * (q + 1) + (xcd - r) * q) + off; }
        const int nig = WGM * nN, gid = wgid / nig, fm = gid * WGM, gsz = (nM - fm) < WGM ? (nM - fm) : WGM;
        u.pm = fm + ((wgid % nig) % gsz); u.pn = (wgid % nig) / gsz; u.ks = 0; return true;
    }
    __device__ __forceinline__ void a_ready(const Unit&) const {}
    __device__ __forceinline__ void done(const Unit&) const {}
};
__device__ __forceinline__ unsigned cvt_pk_bf16(float lo, float hi) { return cvtpk(lo, hi); }
struct SplitOrder {
    int KS, c;
    __host__ __device__ bool next(int i, Unit& u) const { if (i != 0 || c >= 8 * KS) return false; const int tile = c / KS; u.ks = c % KS; u.pm = 64 + (tile >> 2); u.pn = tile & 3; return true; }
    __device__ __forceinline__ void a_ready(const Unit&) const {}
    __device__ __forceinline__ void done(const Unit&) const {}
};
struct EpiPart {
    static constexpr bool PERM = false, AFTER_DRAIN = false;
    float* C;
    __device__ __forceinline__ void operator()(const f32x4 (&acc)[2][2][4][2], const Unit& u, int wr, int wc, int fr, int fq) const {
        const int row0 = (u.pm - 64) * BM + wr * 64 + fr, col0 = u.pn * BM + wc * 32 + 4 * fq; float* base = C + (size_t)u.ks * (512 * 1024);
#pragma unroll
        for (int ai = 0; ai < 2; ++ai)
#pragma unroll
            for (int m = 0; m < 4; ++m) { float* rowp = base + (size_t)(row0 + ai * HALF + m * 16) * 1024 + col0;
#pragma unroll
                for (int bj = 0; bj < 2; ++bj)
#pragma unroll
                    for (int n = 0; n < 2; ++n) *(f32x4*)(rowp + bj * HALF + n * 16) = acc[ai][bj][m][n]; }
    }
};
struct P1Order {
    StaticOrder so;
    __host__ __device__ void init(int G_, int c_) { so.init(64 * 256, 24 * 256, G_, c_); }
    __host__ __device__ bool next(int i, Unit& u) const {
        const long L = (long)i * so.G + so.c;
        if (L < 1536) { so.next(i, u); if (u.pn >= 4) u.pn += 4; return true; }
        u.ks = 0;
        if (L < 1536 + 56) { const int idx = (int)L - 1536; u.pm = 64 + idx / 28; u.pn = idx % 28; return true; }
        if (L < 1536 + 56 + 16) { const int idx = (int)L - 1592; u.pm = 66 + idx / 2; u.pn = 28 + idx % 2; return true; }
        return false;
    }
    __device__ __forceinline__ void a_ready(const Unit&) const {}
    __device__ __forceinline__ void done(const Unit&) const {}
};
struct EpiP1 {
    static constexpr bool PERM = false, AFTER_DRAIN = false;
    float* Zp; int ldz; float* mk; float* mv; bf16_t* srg; bf16_t* sg; int c_rg, c_g;
    __device__ __forceinline__ void operator()(const f32x4 (&acc)[2][2][4][2], const Unit& u, int wr, int wc, int fr, int fq) const {
        if (u.pm >= 66) {
            float* base = (u.pn == 28) ? mk : mv; const int row0 = (u.pm - 66) * BM + wr * 64 + fr, col0 = wc * 32 + 4 * fq;
#pragma unroll
            for (int ai = 0; ai < 2; ++ai)
#pragma unroll
                for (int m = 0; m < 4; ++m) { float* rowp = base + (size_t)(row0 + ai * HALF + m * 16) * 256 + col0;
#pragma unroll
                    for (int bj = 0; bj < 2; ++bj)
#pragma unroll
                        for (int n = 0; n < 2; ++n) *(f32x4*)(rowp + bj * HALF + n * 16) = acc[ai][bj][m][n]; }
            return;
        }
        const int row0 = u.pm * BM + wr * 64 + fr, col0 = u.pn * BM + wc * 32 + 4 * fq;
#pragma unroll
        for (int ai = 0; ai < 2; ++ai)
#pragma unroll
            for (int m = 0; m < 4; ++m) { const size_t r = (size_t)(row0 + ai * HALF + m * 16);
#pragma unroll
                for (int bj = 0; bj < 2; ++bj)
#pragma unroll
                    for (int n = 0; n < 2; ++n) { const int c = col0 + bj * HALF + n * 16; const f32x4 v = acc[ai][bj][m][n];
                        if (c >= c_g + 3072) {   }
                        else if (c >= c_g) { u32x2 w; w.x = cvt_pk_bf16(1.f / (1.f + __expf(-v[0])), 1.f / (1.f + __expf(-v[1]))); w.y = cvt_pk_bf16(1.f / (1.f + __expf(-v[2])), 1.f / (1.f + __expf(-v[3])));
                            *(u32x2*)(sg + r * 3072 + (c - c_g)) = w; }
                        else if (c >= c_rg && c < c_rg + 1024) { u32x2 w; w.x = cvt_pk_bf16(v[0] / (1.f + __expf(-v[0])), v[1] / (1.f + __expf(-v[1]))); w.y = cvt_pk_bf16(v[2] / (1.f + __expf(-v[2])), v[3] / (1.f + __expf(-v[3])));
                            *(u32x2*)(srg + r * 1024 + (c - c_rg)) = w; }
                        else *(f32x4*)(Zp + r * ldz + c) = v; } }
    }
};
struct EpiF32S {
    static constexpr bool PERM = false, AFTER_DRAIN = false;
    float* C; int ldc; int split_tiles; size_t split_stride;
    __device__ __forceinline__ void operator()(const f32x4 (&acc)[2][2][4][2], const Unit& u, int wr, int wc, int fr, int fq) const {
        int pn = u.pn; float* base = C; if (split_tiles) { const int t = pn / split_tiles; base += (size_t)t * split_stride; pn -= t * split_tiles; }
        const int row0 = u.pm * BM + wr * 64 + fr, col0 = pn * BM + wc * 32 + 4 * fq;
#pragma unroll
        for (int ai = 0; ai < 2; ++ai)
#pragma unroll
            for (int m = 0; m < 4; ++m) { float* rowp = base + (size_t)(row0 + ai * HALF + m * 16) * ldc + col0;
#pragma unroll
                for (int bj = 0; bj < 2; ++bj)
#pragma unroll
                    for (int n = 0; n < 2; ++n) *(f32x4*)(rowp + bj * HALF + n * 16) = acc[ai][bj][m][n]; }
    }
};
struct EpiBf16S {
    static constexpr bool PERM = true, AFTER_DRAIN = false;
    bf16_t* O; int ldc;
    __device__ __forceinline__ void operator()(const f32x4 (&acc)[2][2][4][2], const Unit& u, int wr, int wc, int fr, int fq) const {
        const int row0 = u.pm * BM + wr * 64 + fr, col0 = u.pn * BM + wc * 32 + 8 * fq;
#pragma unroll
        for (int ai = 0; ai < 2; ++ai)
#pragma unroll
            for (int m = 0; m < 4; ++m) { bf16_t* rowp = O + (size_t)(row0 + ai * HALF + m * 16) * ldc + col0;
#pragma unroll
                for (int bj = 0; bj < 2; ++bj) { const f32x4 v0 = acc[ai][bj][m][0], v1 = acc[ai][bj][m][1];
                    u32x4 w; w.x = cvt_pk_bf16(v0[0], v0[1]); w.y = cvt_pk_bf16(v0[2], v0[3]); w.z = cvt_pk_bf16(v1[0], v1[1]); w.w = cvt_pk_bf16(v1[2], v1[3]);
                    *(u32x4*)(rowp + bj * HALF) = w; } }
    }
};
struct EpiSwiGLU {
    static constexpr bool PERM = true, AFTER_DRAIN = false;
    bf16_t* O; int ldc;
    __device__ __forceinline__ void operator()(const f32x4 (&acc)[2][2][4][2], const Unit& u, int wr, int wc, int fr, int fq) const {
        const int row0 = u.pm * BM + wr * 64 + fr, col0 = u.pn * (BM / 2) + wc * 16 + 4 * fq;
#pragma unroll
        for (int ai = 0; ai < 2; ++ai)
#pragma unroll
            for (int m = 0; m < 4; ++m) { bf16_t* rowp = O + (size_t)(row0 + ai * HALF + m * 16) * ldc + col0;
#pragma unroll
                for (int bj = 0; bj < 2; ++bj) { const f32x4 v0 = acc[ai][bj][m][0], v1 = acc[ai][bj][m][1];
                    const float a0 = v0[0] / (1.f + __expf(-v0[0])) * v0[1], a1 = v0[2] / (1.f + __expf(-v0[2])) * v0[3];
                    const float a2 = v1[0] / (1.f + __expf(-v1[0])) * v1[1], a3 = v1[2] / (1.f + __expf(-v1[2])) * v1[3];
                    u32x2 w; w.x = cvt_pk_bf16(a0, a1); w.y = cvt_pk_bf16(a2, a3);
                    *(u32x2*)(rowp + bj * (HALF / 2)) = w; } }
    }
};
template <int MODE  > struct EpiGate {
    static constexpr bool PERM = true, AFTER_DRAIN = false;
    const bf16_t* sg; const bf16_t* tin; bf16_t* tout; int ldc;
    __device__ __forceinline__ void operator()(const f32x4 (&acc)[2][2][4][2], const Unit& u, int wr, int wc, int fr, int fq) const {
        const int row0 = u.pm * BM + wr * 64 + fr, col0 = u.pn * BM + wc * 32 + 8 * fq;
#pragma unroll
        for (int ai = 0; ai < 2; ++ai)
#pragma unroll
            for (int m = 0; m < 4; ++m) { const size_t r = (size_t)(row0 + ai * HALF + m * 16);
#pragma unroll
                for (int bj = 0; bj < 2; ++bj) { const int c = col0 + bj * HALF;
                    const u32x4 gq = *(const u32x4*)(sg + r * 3072 + c); u32x4 tq = {0u, 0u, 0u, 0u}; if (MODE >= 1) tq = *(const u32x4*)(tin + r * ldc + c);
                    const f32x4 v0 = acc[ai][bj][m][0], v1 = acc[ai][bj][m][1]; u32x4 w;
#define EG_ONE(dst, x0, x1, gw_, tw_) { float a_ = (x0) * __builtin_bit_cast(float, (gw_) << 16), b_ = (x1) * __builtin_bit_cast(float, (gw_) & 0xffff0000u); \
                        if (MODE >= 1) { a_ += __builtin_bit_cast(float, (tw_) << 16); b_ += __builtin_bit_cast(float, (tw_) & 0xffff0000u); } dst = cvt_pk_bf16(a_, b_); }
                    EG_ONE(w.x, v0[0], v0[1], gq.x, tq.x) EG_ONE(w.y, v0[2], v0[3], gq.y, tq.y) EG_ONE(w.z, v1[0], v1[1], gq.z, tq.z) EG_ONE(w.w, v1[2], v1[3], gq.w, tq.w)
#undef EG_ONE
                    *(u32x4*)(tout + r * ldc + c) = w; } }
    }
};
template <class Epi, class Sched, bool ALIGN_EPI = false, bool SP2 = false>
__device__ __forceinline__ void gemm_phase(LAS unsigned char* lds, const Gemm g, const Sched& S, const Epi& E) {
    const int tid = threadIdx.x, wid = __builtin_amdgcn_readfirstlane(tid >> 6), lane = tid & 63, wr = wid >> 2, wc = wid & 3, fr = lane & 15, fq = lane >> 4;
    const int K = g.K, nt = K / BK;
    unsigned voffA[2], voffB[2];
#pragma unroll
    for (int i = 0; i < 2; ++i) { int R, C; stage_rc(tid * 16 + i * 8192, R, C); const int Rb = Epi::PERM ? ((R & ~31) + perm32(R & 31)) : R;
        voffA[i] = (unsigned)(R * g.lda + C) * 2u; voffB[i] = (unsigned)(Rb * g.ldb + C) * 2u; }
    const size_t kstep = (size_t)(BK * 2);
    const size_t hstepA = (size_t)HALF * g.lda * 2, hstepB = (size_t)HALF * g.ldb * 2;
    const size_t tstepA = 2 * hstepA, tstepB = 2 * hstepB;
    const unsigned ldsw = (unsigned)wid * 1024u;
    const int aoff = lds_byte(wr * 64 + fr, fq * 8), boff = lds_byte(wc * 32 + fr, fq * 8);
#define PG8_SA(b, h) (((b) * 2 + (h)) * HTB)
#define PG8_SB(b, h) ((4 + (b) * 2 + (h)) * HTB)
#define PG8_STAGE(bufoff, gbase, voff) do { _Pragma("unroll") for (int _i = 0; _i < 2; ++_i) \
        __builtin_amdgcn_global_load_lds((const unsigned*)((const char*)(gbase) + (voff)[_i]), (LAS unsigned*)(lds + (bufoff) + ldsw + _i * 8192), 16, 0, 0); } while (0)
#define PG8_LDA(dst, b, h) do { _Pragma("unroll") for (int m = 0; m < 4; ++m) _Pragma("unroll") for (int k = 0; k < 2; ++k) dst[m][k] = *(const LAS bf16x8*)(lds + PG8_SA(b, h) + aoff + m * 2048 + k * 1024); } while (0)
#define PG8_LDB(dst, b, h) do { _Pragma("unroll") for (int n = 0; n < 2; ++n) _Pragma("unroll") for (int k = 0; k < 2; ++k) dst[n][k] = *(const LAS bf16x8*)(lds + PG8_SB(b, h) + boff + n * 2048 + k * 1024); } while (0)
#define PG8_MMA(ai, bj, At, Bt) do { __builtin_amdgcn_s_setprio(1); _Pragma("unroll") for (int m = 0; m < 4; ++m) _Pragma("unroll") for (int n = 0; n < 2; ++n) _Pragma("unroll") for (int k = 0; k < 2; ++k) \
        acc[ai][bj][m][n] = __builtin_amdgcn_mfma_f32_16x16x32_bf16(Bt[n][k], At[m][k], acc[ai][bj][m][n], 0, 0, 0); __builtin_amdgcn_s_setprio(0); } while (0)
#define PG8_WAIT_V(n) asm volatile("s_waitcnt vmcnt(" #n ")" ::: "memory")
#define PG8_WAIT_L(n) asm volatile("s_waitcnt lgkmcnt(" #n ")" ::: "memory")
#define PG8_BAR __builtin_amdgcn_s_barrier()
#define PG8_SCHED __builtin_amdgcn_sched_barrier(0)
    Unit cur, nxt; int ui = 0;
    if (!S.next(0, cur)) return;
    f32x4 acc[2][2][4][2];
#pragma unroll
    for (int a = 0; a < 2; ++a)
#pragma unroll
        for (int b = 0; b < 2; ++b)
#pragma unroll
            for (int m = 0; m < 4; ++m)
#pragma unroll
                for (int n = 0; n < 2; ++n) acc[a][b][m][n] = (f32x4){0.f, 0.f, 0.f, 0.f};
    bf16x8 At[4][2], B0[2][2], B1[2][2];
    const size_t kslb = (size_t)g.ksl * 2;
    const char* cA = (const char*)g.A + (size_t)cur.pm * tstepA + cur.ks * kslb; const char* cB = (const char*)g.Bt + (size_t)cur.pn * tstepB + cur.ks * kslb;
    S.a_ready(cur);
    if constexpr (SP2) {
        PG8_STAGE(PG8_SB(0, 0), cB, voffB); PG8_STAGE(PG8_SB(0, 1), cB + hstepB, voffB); PG8_STAGE(PG8_SA(0, 0), cA, voffA); PG8_STAGE(PG8_SA(0, 1), cA + hstepA, voffA);
        if (wr == 1) PG8_BAR;
        PG8_WAIT_V(2); PG8_BAR;
        PG8_STAGE(PG8_SB(1, 0), cB + kstep, voffB); PG8_STAGE(PG8_SA(1, 0), cA + kstep, voffA); PG8_STAGE(PG8_SB(1, 1), cB + hstepB + kstep, voffB);
        PG8_WAIT_V(6); PG8_BAR;
    } else {
        PG8_STAGE(PG8_SB(0, 0), cB, voffB); PG8_STAGE(PG8_SA(0, 0), cA, voffA); PG8_STAGE(PG8_SB(0, 1), cB + hstepB, voffB); PG8_STAGE(PG8_SA(0, 1), cA + hstepA, voffA);
        if (wr == 1) PG8_BAR;
        PG8_WAIT_V(4); PG8_BAR;
        PG8_STAGE(PG8_SB(1, 0), cB + kstep, voffB); PG8_STAGE(PG8_SA(1, 0), cA + kstep, voffA); PG8_STAGE(PG8_SB(1, 1), cB + hstepB + kstep, voffB);
        PG8_WAIT_V(6); PG8_BAR;
    }
    for (;;) {
        const bool has_next = S.next(ui + 1, nxt);
        const char* nA = has_next ? (const char*)g.A + (size_t)nxt.pm * tstepA + nxt.ks * kslb : cA; const char* nB = has_next ? (const char*)g.Bt + (size_t)nxt.pn * tstepB + nxt.ks * kslb : cB;
#pragma unroll 1
        for (int t = 0; t < nt; t += 2) {
            const bool last = (t == nt - 2);
            const char* a1 = cA + (size_t)(t + 1) * kstep;
            const char* a2 = last ? nA : cA + (size_t)(t + 2) * kstep; const char* b2 = last ? nB : cB + (size_t)(t + 2) * kstep;
            const char* a3 = a2 + kstep; const char* b3 = b2 + kstep;
            if (last && has_next) S.a_ready(nxt);
            if constexpr (SP2) {
            PG8_LDB(B0, 0, 0); PG8_LDB(B1, 0, 1); PG8_SCHED; PG8_LDA(At, 0, 0); PG8_STAGE(PG8_SA(1, 1), a1 + hstepA, voffA);
            PG8_WAIT_V(8); PG8_WAIT_L(0); PG8_BAR; PG8_MMA(0, 0, At, B0); PG8_MMA(0, 1, At, B1); PG8_BAR; PG8_SCHED;
            PG8_LDA(At, 0, 1); PG8_STAGE(PG8_SB(0, 0), b2, voffB); PG8_STAGE(PG8_SB(0, 1), b2 + hstepB, voffB); PG8_STAGE(PG8_SA(0, 0), a2, voffA);
            PG8_WAIT_V(8); PG8_WAIT_L(0); PG8_BAR; PG8_MMA(1, 0, At, B0); PG8_MMA(1, 1, At, B1); PG8_BAR; PG8_SCHED;
            PG8_LDB(B0, 1, 0); PG8_LDB(B1, 1, 1); PG8_SCHED; PG8_LDA(At, 1, 0); PG8_STAGE(PG8_SA(0, 1), a2 + hstepA, voffA);
            PG8_WAIT_V(8); PG8_WAIT_L(0); PG8_BAR; PG8_MMA(0, 0, At, B0); PG8_MMA(0, 1, At, B1); PG8_BAR; PG8_SCHED;
            PG8_LDA(At, 1, 1); PG8_STAGE(PG8_SB(1, 0), b3, voffB); PG8_STAGE(PG8_SB(1, 1), b3 + hstepB, voffB); PG8_STAGE(PG8_SA(1, 0), a3, voffA);
            PG8_WAIT_V(8); PG8_WAIT_L(0); PG8_BAR; PG8_MMA(1, 0, At, B0); PG8_MMA(1, 1, At, B1); PG8_BAR; PG8_SCHED;
            } else {
            PG8_LDB(B0, 0, 0); PG8_SCHED; PG8_LDA(At, 0, 0); PG8_STAGE(PG8_SA(1, 1), a1 + hstepA, voffA);
            PG8_WAIT_L(8); PG8_BAR; PG8_WAIT_L(0); PG8_MMA(0, 0, At, B0); PG8_BAR; PG8_SCHED;
            PG8_LDB(B1, 0, 1); PG8_STAGE(PG8_SB(0, 0), b2, voffB);
            PG8_BAR; PG8_WAIT_L(0); PG8_MMA(0, 1, At, B1); PG8_BAR;
            PG8_LDA(At, 0, 1); PG8_STAGE(PG8_SA(0, 0), a2, voffA);
            PG8_BAR; PG8_WAIT_L(0); PG8_MMA(1, 0, At, B0); PG8_BAR; PG8_SCHED;
            PG8_STAGE(PG8_SB(0, 1), b2 + hstepB, voffB);
            PG8_WAIT_V(6); PG8_BAR; PG8_MMA(1, 1, At, B1); PG8_BAR;
            PG8_LDB(B0, 1, 0); PG8_SCHED; PG8_LDA(At, 1, 0); PG8_STAGE(PG8_SA(0, 1), a2 + hstepA, voffA);
            PG8_WAIT_L(8); PG8_BAR; PG8_WAIT_L(0); PG8_MMA(0, 0, At, B0); PG8_BAR; PG8_SCHED;
            PG8_LDB(B1, 1, 1); PG8_STAGE(PG8_SB(1, 0), b3, voffB);
            PG8_BAR; PG8_WAIT_L(0); PG8_MMA(0, 1, At, B1); PG8_BAR;
            PG8_LDA(At, 1, 1); PG8_STAGE(PG8_SA(1, 0), a3, voffA);
            PG8_BAR; PG8_WAIT_L(0); PG8_MMA(1, 0, At, B0); PG8_BAR; PG8_SCHED;
            PG8_STAGE(PG8_SB(1, 1), b3 + hstepB, voffB);
            PG8_WAIT_V(6); PG8_BAR; PG8_MMA(1, 1, At, B1); PG8_BAR;
            }
        }
        if constexpr (ALIGN_EPI) { if (wr == 0) PG8_BAR; }
        if constexpr (!Epi::AFTER_DRAIN) { E(acc, cur, wr, wc, fr, fq); S.done(cur); }
        if (!has_next) break;
#pragma unroll
        for (int a = 0; a < 2; ++a)
#pragma unroll
            for (int b = 0; b < 2; ++b)
#pragma unroll
                for (int m = 0; m < 4; ++m)
#pragma unroll
                    for (int n = 0; n < 2; ++n) acc[a][b][m][n] = (f32x4){0.f, 0.f, 0.f, 0.f};
        cur = nxt; cA = nA; cB = nB; ++ui;
        if constexpr (ALIGN_EPI) { if (wr == 1) PG8_BAR; }
    }
    PG8_WAIT_V(0);
    if constexpr (!ALIGN_EPI) { if (wr == 0) PG8_BAR; }
    PG8_BAR;
    if constexpr (Epi::AFTER_DRAIN) { E.fused(acc, cur, wr, wc, fr, fq, lds, wid, lane); S.done(cur); }
#undef PG8_SA
#undef PG8_SB
#undef PG8_STAGE
#undef PG8_LDA
#undef PG8_LDB
#undef PG8_MMA
#undef PG8_WAIT_V
#undef PG8_WAIT_L
#undef PG8_BAR
#undef PG8_SCHED
}
}
typedef unsigned short bf16_t;
DI unsigned pk2(float lo, float hi) { return pg8::cvt_pk_bf16(lo, hi); }
DI bf16_t f2bf(float f) { return (bf16_t)(pg8::cvt_pk_bf16(f, 0.f) & 0xffffu); }
DI void transpose_item(const float* W, int N, bf16_t* WT, int ldt, int row_off, int rmul, LAS float* scr, int item, int lane) {
    const int nblk = N / 32, kb = item / nblk, nb = item % nblk, k0 = 64 * kb, n0 = 32 * nb;
#pragma unroll 8
    for (int i = 0; i < 32; ++i) { const int kk = 2 * i + (lane >> 5); scr[kk * 33 + (lane & 31)] = W[(size_t)(k0 + kk) * N + n0 + (lane & 31)]; }
    asm volatile("s_waitcnt lgkmcnt(0)" ::: "memory");
    const int c = lane & 7;
#pragma unroll
    for (int j = 0; j < 4; ++j) { const int n = (lane >> 3) + 8 * j; const LAS float* sp = scr + (8 * c) * 33 + n;
        pg8::u32x4 o; o.x = pk2(sp[0 * 33], sp[1 * 33]); o.y = pk2(sp[2 * 33], sp[3 * 33]); o.z = pk2(sp[4 * 33], sp[5 * 33]); o.w = pk2(sp[6 * 33], sp[7 * 33]);
        *(pg8::u32x4*)(WT + (size_t)(row_off + rmul * (n0 + n)) * ldt + k0 + 8 * c) = o; }
    asm volatile("s_waitcnt lgkmcnt(0)" ::: "memory");
}
DI void transpose_w(const float* W, int K, int N, bf16_t* WT, int ldt, int row_off, LAS float* scr, int gw, int NGW, int lane, int& rot, int rmul = 1) {
    const int nitems = (K / 64) * (N / 32);
    int first = gw - (rot % NGW); if (first < 0) first += NGW;
    for (int it = first; it < nitems; it += NGW) transpose_item(W, N, WT, ldt, row_off, rmul, scr, it, lane);
    rot += nitems;
}

struct Args {
    const float* in[29]; float* out; unsigned char* ws; int ph_lo, ph_hi, sub, pad;
};

DI unsigned short f2bf_raw(float f) { unsigned u = __builtin_bit_cast(unsigned, f); return (unsigned short)((u + 0x7fffu + ((u >> 16) & 1u)) >> 16); }
DI void sgemm_naive(LAS float* lds, const float* __restrict__ A, int lda, const float* __restrict__ B, long sbk, long sbn,
                    float* __restrict__ C, int ldc, int M, int N, int K, int bid, int G, unsigned short* Cb = nullptr) {
    LAS float* As = lds;
    LAS float* Bs = lds + 16 * 132;
    const int tid = threadIdx.x, tx = tid & 15, ty = tid >> 4;
    const int ntn = N / 64, ntiles = (M / 128) * ntn;
    for (int t = bid; t < ntiles; t += G) {
        const int m0 = (t / ntn) * 128, n0 = (t % ntn) * 64;
        float acc[4][4];
#pragma unroll
        for (int i = 0; i < 4; ++i)
#pragma unroll
            for (int j = 0; j < 4; ++j) acc[i][j] = 0.f;
        for (int k0 = 0; k0 < K; k0 += 16) {
            {
                const int r = tid >> 2, kq = (tid & 3) * 4;
                const float4 v = *(const float4*)(A + (size_t)(m0 + r) * lda + k0 + kq);
                As[(kq + 0) * 132 + r] = v.x; As[(kq + 1) * 132 + r] = v.y; As[(kq + 2) * 132 + r] = v.z; As[(kq + 3) * 132 + r] = v.w;
            }
#pragma unroll
            for (int i = 0; i < 2; ++i) {
                const int idx = tid + i * 512, kk = idx >> 6, nn = idx & 63;
                Bs[kk * 64 + nn] = B[(size_t)(k0 + kk) * sbk + (size_t)(n0 + nn) * sbn];
            }
            __syncthreads();
#pragma unroll
            for (int kk = 0; kk < 16; ++kk) {
                const f32x4 a = *(const LAS f32x4*)(As + kk * 132 + ty * 4);
                const f32x4 b = *(const LAS f32x4*)(Bs + kk * 64 + tx * 4);
                const float av[4] = {a.x, a.y, a.z, a.w}, bv[4] = {b.x, b.y, b.z, b.w};
#pragma unroll
                for (int i = 0; i < 4; ++i)
#pragma unroll
                    for (int j = 0; j < 4; ++j) acc[i][j] += av[i] * bv[j];
            }
            __syncthreads();
        }
#pragma unroll
        for (int i = 0; i < 4; ++i) {
            float4 o; o.x = acc[i][0]; o.y = acc[i][1]; o.z = acc[i][2]; o.w = acc[i][3];
            if (Cb) { unsigned short* cb = Cb + (size_t)(m0 + ty * 4 + i) * ldc + n0 + tx * 4; cb[0] = f2bf_raw(o.x); cb[1] = f2bf_raw(o.y); cb[2] = f2bf_raw(o.z); cb[3] = f2bf_raw(o.w); }
            else *(float4*)(C + (size_t)(m0 + ty * 4 + i) * ldc + n0 + tx * 4) = o;
        }
    }
}

template <int DQK, int DV, bool V_IN_K, int MODE, class KV, class QF>
DI void attn_naive(LAS float* lds, const KV& kv, int nk_loop, const QF& qf, bool active, int limit, float scale, float lg, int tq, float* optr) {
    constexpr int KS = DQK + 1;
    constexpr int VS = V_IN_K ? KS : DV;
    LAS float* Ks = lds;
    LAS float* Vs = V_IN_K ? Ks : (lds + 64 * KS);
    LAS float* qs = lds + 64 * KS + (V_IN_K ? 0 : 64 * DV);
    LAS float* ps = qs + 8 * DQK;
    static_assert((64 * KS + (V_IN_K ? 0 : 64 * DV) + 8 * DQK + 8 * 64) * 4 <= MISC_OFF, "attn_naive LDS");
    const int tid = threadIdx.x, lane = tid & 63, w = tid >> 6;
    __syncthreads();
    for (int d = lane; d < DQK; d += 64) qs[w * DQK + d] = active ? qf(d) : 0.f;
    float m = -INFINITY, l = 0.f;
    float acc[DV / 64];
#pragma unroll
    for (int c = 0; c < DV / 64; ++c) acc[c] = 0.f;
    for (int base = 0; base < nk_loop; base += 64) {
        __syncthreads();
        for (int idx = tid; idx < 64 * DQK; idx += NTHREADS) { const int j = idx / DQK, d = idx - j * DQK, key = base + j; Ks[j * KS + d] = key < nk_loop ? kv.k(key, d) : 0.f; }
        if (!V_IN_K) for (int idx = tid; idx < 64 * DV; idx += NTHREADS) { const int j = idx / DV, e = idx - j * DV, key = base + j; Vs[j * DV + e] = key < nk_loop ? kv.v(key, e) : 0.f; }
        __syncthreads();
        const int key = base + lane; const bool valid = active && key <= limit && key < nk_loop;
        float s = 0.f;
        for (int d = 0; d < DQK; ++d) s += qs[w * DQK + d] * Ks[lane * KS + d];
        float p;
        if (MODE == 0) {
            s *= scale;
            const float cm = wave_max(valid ? s : -INFINITY);
            const float mn = fmaxf(m, cm);
            const float alpha = (mn == -INFINITY) ? 1.f : expf(m - mn);
            p = valid ? expf(s - mn) : 0.f;
            l = l * alpha + wave_sum(p);
#pragma unroll
            for (int c = 0; c < DV / 64; ++c) acc[c] *= alpha;
            m = mn;
        } else {
            p = valid ? s * expf((float)(tq - key) * lg) : 0.f;
        }
        ps[w * 64 + lane] = p;
        __syncthreads();
        for (int j = 0; j < 64; ++j) { const float pj = ps[w * 64 + j];
#pragma unroll
            for (int c = 0; c < DV / 64; ++c) acc[c] += pj * Vs[j * VS + lane + 64 * c]; }
    }
    if (active) {
#pragma unroll
        for (int c = 0; c < DV / 64; ++c) optr[lane + 64 * c] = (MODE == 0) ? acc[c] / l : acc[c];
    }
}

struct KvMlaPrompt { const float* ckvn; const float* kper; int b;
    DI float k(int key, int d) const { const size_t row = (size_t)b * SEQ + key; return d < KVL ? ckvn[row * KVL + d] : kper[row * DROPE + (d - KVL)]; }
    DI float v(int, int) const { return 0.f; } };
struct KvMlaSample { const float* ckvn; const float* kper; const float* cckv; const float* ckpe; const int* pt; int b;
    DI float k(int key, int d) const {
        if (key < PAST) { const size_t r = (size_t)pt[b * NPAGES + (key >> 7)] * PAGE + (key & (PAGE - 1)); return d < KVL ? cckv[r * KVL + d] : ckpe[r * DROPE + (d - KVL)]; }
        const size_t row = (size_t)NP + b * DS + (key - PAST); return d < KVL ? ckvn[row * KVL + d] : kper[row * DROPE + (d - KVL)]; }
    DI float v(int, int) const { return 0.f; } };
struct KvRet { const float* rk; const float* z; int b, h;
    DI float k(int key, int d) const { return rk[((size_t)b * SEQ + key) * 512 + h * RDK + d]; }
    DI float v(int key, int e) const { return z[((size_t)b * SEQ + key) * ZLD + C_RV + h * RDV + e]; } };
struct KvMem { const float* mk; const float* mv; int b, h;
    DI float k(int key, int d) const { return mk[(((size_t)b * NMEM + key) * XH + h) * XHD + d]; }
    DI float v(int key, int e) const { return mv[(((size_t)b * NMEM + key) * XH + h) * XHD + e]; } };


typedef float f32x16 __attribute__((ext_vector_type(16)));
typedef short bf16x8 __attribute__((ext_vector_type(8)));
typedef short s16x4 __attribute__((ext_vector_type(4)));
typedef unsigned u32x4_t __attribute__((ext_vector_type(4)));
typedef unsigned u32x2_t __attribute__((ext_vector_type(2)));
DI int crow(int i, int h) { return (i & 3) + 8 * (i >> 2) + 4 * h; }
#define MFMA32(a, b, c) __builtin_amdgcn_mfma_f32_32x32x16_bf16((a), (b), (c), 0, 0, 0)
template <int DQK, int DV, bool CAUSAL, class Src>
DI void flash_unit(LAS unsigned char* lds, const Src& src, int qpos0, int ntiles, bf16_t* O, int ldo, float c2) {
    constexpr int KP = DQK + 8, VP = 68, KS = DQK / 16, NBLK = DV / 32;
    constexpr int KBYTES = 64 * KP * 2, VBYTES = DV * VP * 2, BUF = KBYTES + VBYTES;
    constexpr int D8 = DQK / 8, NPK = (64 * D8) / NTHREADS, NPV = (DV * 8) / NTHREADS;
    static_assert((64 * D8) % NTHREADS == 0 && (DV * 8) % NTHREADS == 0 && 2 * BUF <= 131072, "flash_unit geometry");
    const int tid = threadIdx.x, lane = tid & 63, w = __builtin_amdgcn_readfirstlane(tid >> 6), l31 = lane & 31, h = lane >> 5;
    bf16x8 qf[KS];
#pragma unroll
    for (int s_ = 0; s_ < KS; ++s_) qf[s_] = src.qfrag(32 * w + l31, s_, h);
    f32x16 o[NBLK];
#pragma unroll
    for (int b = 0; b < NBLK; ++b)
#pragma unroll
        for (int i = 0; i < 16; ++i) o[b][i] = 0.f;
    float m = -INFINITY, lsum = 0.f;
    u32x4_t kreg[NPK], vreg[NPV];
#define FL_LOAD(t_) do { _Pragma("unroll") for (int i_ = 0; i_ < NPK; ++i_) { const int p_ = tid + i_ * NTHREADS; kreg[i_] = src.kpiece(64 * (t_) + p_ / D8, p_ % D8); } \
                         _Pragma("unroll") for (int i_ = 0; i_ < NPV; ++i_) { const int p_ = tid + i_ * NTHREADS; vreg[i_] = src.vpiece(p_ >> 3, 64 * (t_) + 8 * (p_ & 7)); } } while (0)
#define FL_STORE(buf_) do { _Pragma("unroll") for (int i_ = 0; i_ < NPK; ++i_) { const int p_ = tid + i_ * NTHREADS; *(LAS u32x4_t*)(lds + (buf_) * BUF + ((p_ / D8) * KP + (p_ % D8) * 8) * 2) = kreg[i_]; } \
                          _Pragma("unroll") for (int i_ = 0; i_ < NPV; ++i_) { const int p_ = tid + i_ * NTHREADS; LAS unsigned char* a_ = lds + (buf_) * BUF + KBYTES + ((p_ >> 3) * VP + (p_ & 7) * 8) * 2; \
                              *(LAS u32x2_t*)a_ = (u32x2_t){vreg[i_].x, vreg[i_].y}; *(LAS u32x2_t*)(a_ + 8) = (u32x2_t){vreg[i_].z, vreg[i_].w}; } } while (0)
    __syncthreads();
    FL_LOAD(0); FL_STORE(0);
    __syncthreads();
    const int qmine = qpos0 + 32 * w + l31, qlast = qpos0 + 32 * w + 31;
    for (int t = 0; t < ntiles; ++t) {
        const int buf = t & 1;
        if (t + 1 < ntiles) FL_LOAD(t + 1);
        if (!CAUSAL || 64 * t <= qlast) {
            const LAS unsigned char* kb_ = lds + buf * BUF; const LAS unsigned char* vb_ = kb_ + KBYTES;
            f32x16 st[2];
#pragma unroll
            for (int kb = 0; kb < 2; ++kb) {
#pragma unroll
                for (int i = 0; i < 16; ++i) st[kb][i] = 0.f;
#pragma unroll
                for (int g_ = 0; g_ < KS / 4; ++g_) { bf16x8 kf[4];
#pragma unroll
                    for (int j = 0; j < 4; ++j) kf[j] = *(const LAS bf16x8*)(kb_ + ((32 * kb + l31) * KP + 16 * (4 * g_ + j) + 8 * h) * 2);
#pragma unroll
                    for (int j = 0; j < 4; ++j) st[kb] = MFMA32(kf[j], qf[4 * g_ + j], st[kb]);
                    __builtin_amdgcn_sched_barrier(0); }
            }
            float mx = -INFINITY;
#pragma unroll
            for (int kb = 0; kb < 2; ++kb)
#pragma unroll
                for (int i = 0; i < 16; ++i) { float v = st[kb][i] * c2; if (CAUSAL) { const int key = 64 * t + 32 * kb + crow(i, h); v = key <= qmine ? v : -INFINITY; } st[kb][i] = v; mx = fmaxf(mx, v); }
            mx = fmaxf(mx, __shfl_xor(mx, 32));
            const float mn = fmaxf(m, mx);
            const float alpha = __builtin_amdgcn_exp2f(m - mn);
            m = mn;
            float ps = 0.f;
#pragma unroll
            for (int kb = 0; kb < 2; ++kb)
#pragma unroll
                for (int i = 0; i < 16; ++i) { const float p = __builtin_amdgcn_exp2f(st[kb][i] - mn); st[kb][i] = p; ps += p; }
            lsum = lsum * alpha + ps;
#pragma unroll
            for (int b = 0; b < NBLK; ++b)
#pragma unroll
                for (int i = 0; i < 16; ++i) o[b][i] *= alpha;
            bf16x8 pf[4];
#pragma unroll
            for (int ks = 0; ks < 4; ++ks) { const int kb = ks >> 1, s2 = ks & 1; u32x4_t pk;
                pk.x = cvtpk(st[kb][8 * s2 + 0], st[kb][8 * s2 + 1]); pk.y = cvtpk(st[kb][8 * s2 + 2], st[kb][8 * s2 + 3]);
                pk.z = cvtpk(st[kb][8 * s2 + 4], st[kb][8 * s2 + 5]); pk.w = cvtpk(st[kb][8 * s2 + 6], st[kb][8 * s2 + 7]); pf[ks] = __builtin_bit_cast(bf16x8, pk); }
            __builtin_amdgcn_sched_barrier(0);
#pragma unroll
            for (int b = 0; b < NBLK; ++b) { bf16x8 vf[4];
#pragma unroll
                for (int ks = 0; ks < 4; ++ks) { const LAS unsigned char* a_ = vb_ + ((32 * b + l31) * VP + 16 * ks + 4 * h) * 2;
                    const s16x4 lo = *(const LAS s16x4*)a_, hi = *(const LAS s16x4*)(a_ + 16);
                    vf[ks] = __builtin_shufflevector(lo, hi, 0, 1, 2, 3, 4, 5, 6, 7); }
#pragma unroll
                for (int ks = 0; ks < 4; ++ks) o[b] = MFMA32(vf[ks], pf[ks], o[b]);
                __builtin_amdgcn_sched_barrier(0); }
        }
        if (t + 1 < ntiles) FL_STORE(buf ^ 1);
        __syncthreads();
    }
#undef FL_LOAD
#undef FL_STORE
    lsum += __shfl_xor(lsum, 32);
    const float inv = 1.f / lsum;
    bf16_t* orow = O + (size_t)(32 * w + l31) * ldo;
#pragma unroll
    for (int b = 0; b < NBLK; ++b)
#pragma unroll
        for (int g = 0; g < 4; ++g) { u32x2_t pk; pk.x = cvtpk(o[b][4 * g + 0] * inv, o[b][4 * g + 1] * inv); pk.y = cvtpk(o[b][4 * g + 2] * inv, o[b][4 * g + 3] * inv);
            *(u32x2_t*)(orow + 32 * b + 8 * g + 4 * h) = pk; }
}
struct SrcMlaP { const bf16_t* kn; const bf16_t* kpe; const bf16_t* vt; const bf16_t* qraw; const bf16_t* qpe; int b, hh; size_t row0;
    DI bf16x8 qfrag(int r, int s_, int h8) const { return s_ < 8 ? *(const bf16x8*)(qraw + (row0 + r) * 1536 + hh * DQH + 16 * s_ + 8 * h8) : *(const bf16x8*)(qpe + (row0 + r) * 512 + hh * DROPE + 16 * (s_ - 8) + 8 * h8); }
    DI u32x4_t kpiece(int key, int d8) const { const size_t row = (size_t)b * SEQ + key;
        return d8 < 16 ? *(const u32x4_t*)(kn + row * 1024 + hh * DNOPE + d8 * 8) : *(const u32x4_t*)(kpe + row * DROPE + (d8 - 16) * 8); }
    DI u32x4_t vpiece(int dv, int key0) const { return *(const u32x4_t*)(vt + (size_t)(hh * DVH + dv) * NP + (size_t)b * SEQ + key0); } };
struct SrcMemP { const bf16_t* mk; const bf16_t* mvt; const bf16_t* xq; int b, hh; size_t row0;
    DI bf16x8 qfrag(int r, int s_, int h8) const { return *(const bf16x8*)(xq + (row0 + r) * 256 + hh * XHD + 16 * s_ + 8 * h8); }
    DI u32x4_t kpiece(int key, int d8) const { return *(const u32x4_t*)(mk + ((size_t)b * NMEM + key) * 256 + hh * XHD + d8 * 8); }
    DI u32x4_t vpiece(int dv, int key0) const { return *(const u32x4_t*)(mvt + (size_t)(hh * XHD + dv) * (NB * NMEM) + (size_t)b * NMEM + key0); } };


DI void ret_chunk_state(const bf16_t* __restrict__ RVT, const bf16_t* __restrict__ RKtT, float* __restrict__ UT, int b, int h, int c) {
    const int tid = threadIdx.x, lane = tid & 63, w = __builtin_amdgcn_readfirstlane(tid >> 6), l31 = lane & 31, hh = lane >> 5;
    const size_t tok0 = (size_t)b * SEQ + c * 128;
    f32x16 acc[4];
#pragma unroll
    for (int kb = 0; kb < 4; ++kb)
#pragma unroll
        for (int i = 0; i < 16; ++i) acc[kb][i] = 0.f;
    const bf16_t* ap = RVT + (size_t)(h * RDV + 32 * w + l31) * NT + tok0 + 8 * hh;
    const bf16_t* bp = RKtT + (size_t)(h * RDK + l31) * NP + tok0 + 8 * hh;
#pragma unroll
    for (int s_ = 0; s_ < 8; ++s_) { const bf16x8 a = *(const bf16x8*)(ap + 16 * s_);
#pragma unroll
        for (int kb = 0; kb < 4; ++kb) { const bf16x8 bfr = *(const bf16x8*)(bp + (size_t)(32 * kb) * NP + 16 * s_); acc[kb] = MFMA32(a, bfr, acc[kb]); } }
    float* u = UT + (size_t)(((b * RH + h) * 16) + c) * 32768;
#pragma unroll
    for (int kb = 0; kb < 4; ++kb)
#pragma unroll
        for (int i = 0; i < 16; ++i) u[(32 * w + crow(i, hh)) * RDK + 32 * kb + l31] = acc[kb][i];
}
DI void ret_chunk_out(const bf16_t* __restrict__ RQt, const bf16_t* __restrict__ RKt, const bf16_t* __restrict__ RVT, const bf16_t* __restrict__ SPT, float* __restrict__ ORET, int b, int h, int c) {
    const int tid = threadIdx.x, lane = tid & 63, w = __builtin_amdgcn_readfirstlane(tid >> 6), l31 = lane & 31, hh = lane >> 5;
    const int ib = w & 3, vh = w >> 2;
    const size_t tok0 = (size_t)b * SEQ + c * 128;
    bf16x8 qf[8];
    { const bf16_t* qp = RQt + (tok0 + 32 * ib + l31) * 512 + h * RDK + 8 * hh;
#pragma unroll
      for (int s_ = 0; s_ < 8; ++s_) qf[s_] = *(const bf16x8*)(qp + 16 * s_); }
    f32x16 o[4];
#pragma unroll
    for (int blk = 0; blk < 4; ++blk)
#pragma unroll
        for (int i = 0; i < 16; ++i) o[blk][i] = 0.f;
    const bf16_t* vbase = RVT + (size_t)(h * RDV + 32 * (4 * vh) + l31) * NT + tok0 + 4 * hh;
#pragma unroll 1
    for (int jb = 0; jb <= ib; ++jb) {
        f32x16 x;
#pragma unroll
        for (int i = 0; i < 16; ++i) x[i] = 0.f;
        const bf16_t* kp = RKt + (tok0 + 32 * jb + l31) * 512 + h * RDK + 8 * hh;
#pragma unroll
        for (int s_ = 0; s_ < 8; ++s_) { const bf16x8 kf = *(const bf16x8*)(kp + 16 * s_); x = MFMA32(kf, qf[s_], x); }
        if (jb == ib) {
#pragma unroll
            for (int i = 0; i < 16; ++i) x[i] = (crow(i, hh) <= l31) ? x[i] : 0.f;
        }
#pragma unroll
        for (int s2 = 0; s2 < 2; ++s2) {
            u32x4_t pk; pk.x = cvtpk(x[8 * s2 + 0], x[8 * s2 + 1]); pk.y = cvtpk(x[8 * s2 + 2], x[8 * s2 + 3]); pk.z = cvtpk(x[8 * s2 + 4], x[8 * s2 + 5]); pk.w = cvtpk(x[8 * s2 + 6], x[8 * s2 + 7]);
            const bf16x8 pa = __builtin_bit_cast(bf16x8, pk);
#pragma unroll
            for (int blk = 0; blk < 4; ++blk) { const bf16_t* vp = vbase + (size_t)(32 * blk) * NT + 32 * jb + 16 * s2;
                const s16x4 lo = *(const s16x4*)vp, hi = *(const s16x4*)(vp + 8);
                const bf16x8 vf = __builtin_shufflevector(lo, hi, 0, 1, 2, 3, 4, 5, 6, 7);
                o[blk] = MFMA32(pa, vf, o[blk]); }
        }
    }
    const bf16_t* sp = SPT + (size_t)(((b * RH + h) * 16) + c) * 32768 + (size_t)(32 * (4 * vh) + l31) * RDK + 8 * hh;
#pragma unroll
    for (int s_ = 0; s_ < 8; ++s_)
#pragma unroll
        for (int blk = 0; blk < 4; ++blk) { const bf16x8 sf = *(const bf16x8*)(sp + (size_t)(32 * blk) * RDK + 16 * s_); o[blk] = MFMA32(qf[s_], sf, o[blk]); }
#pragma unroll
    for (int blk = 0; blk < 4; ++blk)
#pragma unroll
        for (int i = 0; i < 16; ++i) ORET[(tok0 + 32 * ib + crow(i, hh)) * 1024 + h * RDV + 32 * (4 * vh + blk) + l31] = o[blk][i];
}


typedef short v4i16_t __attribute__((ext_vector_type(4)));
DI s16x4 vtr(const LAS unsigned char* p) { return __builtin_bit_cast(s16x4, __builtin_amdgcn_ds_read_tr16_b64_v4i16((LAS v4i16_t*)p)); }
constexpr int MS_NSPLIT = 2, MS_KEYS = PAST / MS_NSPLIT, MS_TILES = MS_KEYS / 64;
DI void mla_sample_unit(LAS unsigned char* lds, const float* __restrict__ cckv, const float* __restrict__ ckpe, const int* __restrict__ pt,
                        const bf16_t* __restrict__ QLATb, const bf16_t* __restrict__ QPEb, float* __restrict__ PO, float* __restrict__ PML, int b, int split, float c2) {
    constexpr int KP = 328, KBYTES = 64 * KP * 2;
    const int tid = threadIdx.x, lane = tid & 63, w = __builtin_amdgcn_readfirstlane(tid >> 6), l31 = lane & 31, hh = lane >> 5;
    bf16x8 qf[20];
    { const int t = l31 >> 3, head = l31 & 7;
      const bf16_t* ql = QLATb + (size_t)(b * DS + t) * 2048 + head * KVL + 8 * hh;
      const bf16_t* qp = QPEb + (size_t)(NP + b * DS + t) * 512 + head * DROPE + 8 * hh;
#pragma unroll
      for (int s_ = 0; s_ < 16; ++s_) qf[s_] = *(const bf16x8*)(ql + 16 * s_);
#pragma unroll
      for (int s_ = 0; s_ < 4; ++s_) qf[16 + s_] = *(const bf16x8*)(qp + 16 * s_); }
    f32x16 o;
#pragma unroll
    for (int i = 0; i < 16; ++i) o[i] = 0.f;
    float m = -INFINITY, lsum = 0.f;
    f32x4 cr[8], pr[2];
#define MS_LOAD(t_) do { const int key0_ = split * MS_KEYS + 64 * (t_); const size_t rowb_ = (size_t)pt[b * NPAGES + (key0_ >> 7)] * PAGE + (key0_ & (PAGE - 1)); \
        _Pragma("unroll") for (int i_ = 0; i_ < 8; ++i_) { const int pc_ = tid + i_ * NTHREADS; cr[i_] = __builtin_nontemporal_load((const f32x4*)(cckv + (rowb_ + (pc_ >> 6)) * KVL + 4 * (pc_ & 63))); } \
        _Pragma("unroll") for (int i_ = 0; i_ < 2; ++i_) { const int pc_ = tid + i_ * NTHREADS; pr[i_] = __builtin_nontemporal_load((const f32x4*)(ckpe + (rowb_ + (pc_ >> 4)) * DROPE + 4 * (pc_ & 15))); } } while (0)
#define MS_STORE(buf_) do { \
        _Pragma("unroll") for (int i_ = 0; i_ < 8; ++i_) { const int pc_ = tid + i_ * NTHREADS; *(LAS u32x2_t*)(lds + (buf_) * KBYTES + ((pc_ >> 6) * KP + 4 * (pc_ & 63)) * 2) = (u32x2_t){cvtpk(cr[i_][0], cr[i_][1]), cvtpk(cr[i_][2], cr[i_][3])}; } \
        _Pragma("unroll") for (int i_ = 0; i_ < 2; ++i_) { const int pc_ = tid + i_ * NTHREADS; *(LAS u32x2_t*)(lds + (buf_) * KBYTES + ((pc_ >> 4) * KP + KVL + 4 * (pc_ & 15)) * 2) = (u32x2_t){cvtpk(pr[i_][0], pr[i_][1]), cvtpk(pr[i_][2], pr[i_][3])}; } } while (0)
    __syncthreads();
    MS_LOAD(0); MS_STORE(0);
    __syncthreads();
    const int q4 = (lane & 15) >> 2, p4 = lane & 3, blk = (lane >> 4) & 1;
#pragma unroll 1
    for (int t = 0; t < MS_TILES; ++t) {
        const int buf = t & 1;
        if (t + 1 < MS_TILES) MS_LOAD(t + 1);
        const LAS unsigned char* kb_ = lds + buf * KBYTES;
        f32x16 st[2];
#pragma unroll
        for (int kb = 0; kb < 2; ++kb) {
#pragma unroll
            for (int i = 0; i < 16; ++i) st[kb][i] = 0.f;
#pragma unroll
            for (int g_ = 0; g_ < 5; ++g_) { bf16x8 kf[4];
#pragma unroll
                for (int j = 0; j < 4; ++j) kf[j] = *(const LAS bf16x8*)(kb_ + ((32 * kb + l31) * KP + 16 * (4 * g_ + j) + 8 * hh) * 2);
#pragma unroll
                for (int j = 0; j < 4; ++j) st[kb] = MFMA32(kf[j], qf[4 * g_ + j], st[kb]);
                __builtin_amdgcn_sched_barrier(0); }
        }
        float mx = -INFINITY;
#pragma unroll
        for (int kb = 0; kb < 2; ++kb)
#pragma unroll
            for (int i = 0; i < 16; ++i) { const float v = st[kb][i] * c2; st[kb][i] = v; mx = fmaxf(mx, v); }
        mx = fmaxf(mx, __shfl_xor(mx, 32));
        const float mn = fmaxf(m, mx);
        const float alpha = __builtin_amdgcn_exp2f(m - mn);
        m = mn;
        float ps = 0.f;
#pragma unroll
        for (int kb = 0; kb < 2; ++kb)
#pragma unroll
            for (int i = 0; i < 16; ++i) { const float p = __builtin_amdgcn_exp2f(st[kb][i] - mn); st[kb][i] = p; ps += p; }
        lsum = lsum * alpha + ps;
#pragma unroll
        for (int i = 0; i < 16; ++i) o[i] *= alpha;
        bf16x8 vf[4];
#pragma unroll
        for (int ks = 0; ks < 4; ++ks) { const LAS unsigned char* a_ = kb_ + ((16 * ks + 4 * hh + q4) * KP + 32 * w + 16 * blk + 4 * p4) * 2;
            const s16x4 lo = vtr(a_), hi = vtr(a_ + 8 * KP * 2);
            vf[ks] = __builtin_shufflevector(lo, hi, 0, 1, 2, 3, 4, 5, 6, 7); }
#pragma unroll
        for (int ks = 0; ks < 4; ++ks) { const int kb = ks >> 1, s2 = ks & 1; u32x4_t pk;
            pk.x = cvtpk(st[kb][8 * s2 + 0], st[kb][8 * s2 + 1]); pk.y = cvtpk(st[kb][8 * s2 + 2], st[kb][8 * s2 + 3]);
            pk.z = cvtpk(st[kb][8 * s2 + 4], st[kb][8 * s2 + 5]); pk.w = cvtpk(st[kb][8 * s2 + 6], st[kb][8 * s2 + 7]);
            o = MFMA32(vf[ks], __builtin_bit_cast(bf16x8, pk), o); }
        if (t + 1 < MS_TILES) MS_STORE(buf ^ 1);
        __syncthreads();
    }
#undef MS_LOAD
#undef MS_STORE
    lsum += __shfl_xor(lsum, 32);
    const int item = b * MS_NSPLIT + split;
    if (w == 0 && lane < 32) { PML[(item * 32 + lane) * 2] = m; PML[(item * 32 + lane) * 2 + 1] = lsum; }
#pragma unroll
    for (int i = 0; i < 16; ++i) PO[((size_t)item * 32 + l31) * KVL + 32 * w + crow(i, hh)] = o[i];
}


struct RetItem { int b, h, c, vh; };
DI RetItem ret_item(int it) { RetItem r; r.vh = it & 1; r.c = (it >> 1) & 15; r.h = (it >> 5) & 3; r.b = it >> 7; return r; }
DI void ret_out_phase(LAS unsigned char* lds, const bf16_t* __restrict__ RQt, const bf16_t* __restrict__ RKt, const bf16_t* __restrict__ RVT, const bf16_t* __restrict__ SPT, float* __restrict__ ORET, int bid, int G) {
    constexpr int PITCH = 136, TILE = 128 * PITCH * 2;
    const int tid = threadIdx.x, lane = tid & 63, w = __builtin_amdgcn_readfirstlane(tid >> 6), l31 = lane & 31, hh = lane >> 5;
    const int ib = w & 3, dq = w >> 2;
    u32x4_t st[12];
#define RO_LOAD(it_) do { const RetItem q_ = ret_item(it_); const size_t tok0_ = (size_t)q_.b * SEQ + q_.c * 128; \
        _Pragma("unroll") for (int i_ = 0; i_ < 12; ++i_) { const int p_ = tid + i_ * NTHREADS, tl_ = p_ >> 11, row_ = (p_ >> 4) & 127, c16_ = p_ & 15; const bf16_t* src_; \
            if (tl_ == 0) src_ = RKt + (tok0_ + row_) * 512 + q_.h * RDK + 8 * c16_; \
            else if (tl_ == 1) src_ = RVT + (size_t)(q_.h * RDV + 128 * q_.vh + row_) * NT + tok0_ + 8 * c16_; \
            else src_ = SPT + (size_t)(((q_.b * RH + q_.h) * 16) + q_.c) * 32768 + (size_t)(128 * q_.vh + row_) * RDK + 8 * c16_; \
            st[i_] = *(const u32x4_t*)src_; } } while (0)
#define RO_STORE() do { _Pragma("unroll") for (int i_ = 0; i_ < 12; ++i_) { const int p_ = tid + i_ * NTHREADS, tl_ = p_ >> 11, row_ = (p_ >> 4) & 127, c16_ = p_ & 15; \
            *(LAS u32x4_t*)(lds + tl_ * TILE + (row_ * PITCH + 8 * c16_) * 2) = st[i_]; } } while (0)
    int it = bid;
    if (it < NB * RH * 16 * 2) RO_LOAD(it);
    for (; it < NB * RH * 16 * 2; it += G) {
        const RetItem q = ret_item(it); const size_t tok0 = (size_t)q.b * SEQ + q.c * 128;
        __syncthreads();
        RO_STORE();
        bf16x8 qf[8];
        { const bf16_t* qp = RQt + (tok0 + 32 * ib + l31) * 512 + q.h * RDK + 8 * hh;
#pragma unroll
          for (int s_ = 0; s_ < 8; ++s_) qf[s_] = *(const bf16x8*)(qp + 16 * s_); }
        __syncthreads();
        if (it + G < NB * RH * 16 * 2) RO_LOAD(it + G);
        const LAS unsigned char* Kl = lds; const LAS unsigned char* Vl = lds + TILE; const LAS unsigned char* Sl = lds + 2 * TILE;
        f32x16 o[2];
#pragma unroll
        for (int blk = 0; blk < 2; ++blk)
#pragma unroll
            for (int i = 0; i < 16; ++i) o[blk][i] = 0.f;
#pragma unroll 1
        for (int jb = 0; jb <= ib; ++jb) {
            f32x16 x;
#pragma unroll
            for (int i = 0; i < 16; ++i) x[i] = 0.f;
#pragma unroll
            for (int s_ = 0; s_ < 8; ++s_) { const bf16x8 kf = *(const LAS bf16x8*)(Kl + ((32 * jb + l31) * PITCH + 16 * s_ + 8 * hh) * 2); x = MFMA32(kf, qf[s_], x); }
            if (jb == ib) {
#pragma unroll
                for (int i = 0; i < 16; ++i) x[i] = (crow(i, hh) <= l31) ? x[i] : 0.f;
            }
#pragma unroll
            for (int s2 = 0; s2 < 2; ++s2) {
                u32x4_t pk; pk.x = cvtpk(x[8 * s2 + 0], x[8 * s2 + 1]); pk.y = cvtpk(x[8 * s2 + 2], x[8 * s2 + 3]); pk.z = cvtpk(x[8 * s2 + 4], x[8 * s2 + 5]); pk.w = cvtpk(x[8 * s2 + 6], x[8 * s2 + 7]);
                const bf16x8 pa = __builtin_bit_cast(bf16x8, pk);
#pragma unroll
                for (int blk = 0; blk < 2; ++blk) { const LAS unsigned char* vp = Vl + ((64 * dq + 32 * blk + l31) * PITCH + 32 * jb + 16 * s2 + 4 * hh) * 2;
                    const s16x4 lo = *(const LAS s16x4*)vp, hi = *(const LAS s16x4*)(vp + 16);
                    o[blk] = MFMA32(pa, __builtin_shufflevector(lo, hi, 0, 1, 2, 3, 4, 5, 6, 7), o[blk]); }
            }
        }
#pragma unroll
        for (int s_ = 0; s_ < 8; ++s_)
#pragma unroll
            for (int blk = 0; blk < 2; ++blk) { const bf16x8 sf = *(const LAS bf16x8*)(Sl + ((64 * dq + 32 * blk + l31) * PITCH + 16 * s_ + 8 * hh) * 2); o[blk] = MFMA32(qf[s_], sf, o[blk]); }
#pragma unroll
        for (int blk = 0; blk < 2; ++blk)
#pragma unroll
            for (int i = 0; i < 16; ++i) ORET[(tok0 + 32 * ib + crow(i, hh)) * 1024 + q.h * RDV + 128 * q.vh + 64 * dq + 32 * blk + l31] = o[blk][i];
    }
#undef RO_LOAD
#undef RO_STORE
}

struct QPtr { const float* p; DI float operator()(int d) const { return p[d]; } };
struct QMla { const float* ql; const float* qp; DI float operator()(int d) const { return d < KVL ? ql[d] : qp[d - KVL]; } };
DI void rms_row(const float* x, const float* g, float* o, int n, int lane) {
    float s = 0.f;
    for (int i = lane; i < n; i += 64) { const float v = x[i]; s += v * v; }
    const float r = rsqrtf(wave_sum(s) / (float)n + EPS);
    for (int i = lane; i < n; i += 64) o[i] = x[i] * r * g[i];
}

DI void rms_row_bf16(const float* x, const float* g, bf16_t* o, int n, int lane) {
    float s = 0.f;
    for (int i = lane; i < n; i += 64) { const float v = x[i]; s += v * v; }
    const float r = rsqrtf(wave_sum(s) / (float)n + EPS);
    for (int i = lane; i < n; i += 64) o[i] = f2bf(x[i] * r * g[i]);
}
#define GEMM_PHASE(EPI, ...) pg8::gemm_phase<EPI, pg8::StaticOrder, true, true>(__VA_ARGS__)
#define GEMM_SPLIT(...) pg8::gemm_phase<pg8::EpiPart, pg8::SplitOrder, true, true>(__VA_ARGS__)
__global__ void __launch_bounds__(NTHREADS, 2) fwd_kernel(Args args) {
    extern __shared__ __attribute__((aligned(16))) unsigned char lds_raw[];
    LAS unsigned char* ldsb = (LAS unsigned char*)lds_raw;
    LAS float* lds = (LAS float*)ldsb;
    volatile LAS unsigned* MISC = (volatile LAS unsigned*)(ldsb + MISC_OFF);
    const int tid = threadIdx.x, lane = tid & 63, wave = tid >> 6;
    const int G = gridDim.x, bid = blockIdx.x;
    const int gw = bid * NWAVES + wave, NGW = G * NWAVES;
    unsigned char* ws = args.ws;
    float* out = args.out;
    const int lo = args.ph_lo, hi = args.ph_hi;

    if (tid < 64) MISC[tid] = 0u;
    __syncthreads();
    XcdBarrier bar; bar.bar = (unsigned*)(ws + WS_CTL) + CW_BAR; bar.x = 0; bar.st = MISC;
    if (hi - lo > 1) bar = xcd_barrier_post((unsigned*)(ws + WS_CTL) + CW_BAR, MISC);
#define IN(k) (lo <= (k) && (k) < hi)
#define SEAM(k) do { if (IN(k) && IN((k) + 1)) xcd_barrier(bar); } while (0)

    const float* x_prompt = args.in[0]; const float* x_sample = args.in[1]; const float* mem_prompt = args.in[2];
    const float* cache_ckv = args.in[3]; const float* cache_kpe = args.in[4]; const int* page_table = (const int*)args.in[5];
    const float* state_ret = args.in[6]; const float* cache_mem_k = args.in[7]; const float* cache_mem_v = args.in[8];
    const float* g_mix_pre = args.in[9]; const float* g_mix_post = args.in[10]; const float* g_ffn_pre = args.in[11]; const float* g_ffn_post = args.in[12];
    const float* g_mem = args.in[13]; const float* g_qlat = args.in[14]; const float* g_kvlat = args.in[15];
    const float* w_in = args.in[16]; const float* w_uq = args.in[17]; const float* w_uk = args.in[18]; const float* w_uv = args.in[19];
    const float* w_mem_k = args.in[20]; const float* w_mem_v = args.in[21]; const float* w_ret_o = args.in[22]; const float* w_mla_o = args.in[23];
    const float* w_x_o = args.in[24]; const float* w_out = args.in[25]; const float* w_gate = args.in[26]; const float* w_up = args.in[27]; const float* w_down = args.in[28];
    float* COSA = (float*)(ws + WS_COSA); float* SINA = (float*)(ws + WS_SINA); float* COSB = (float*)(ws + WS_COSB); float* SINB = (float*)(ws + WS_SINB);
    float* U = (float*)(ws + WS_U); float* MN = (float*)(ws + WS_MN); float* Z = (float*)(ws + WS_Z);
    float* RQ = (float*)(ws + WS_RQ); float* RK = (float*)(ws + WS_RK); float* CQN = (float*)(ws + WS_CQN); float* CKVN = (float*)(ws + WS_CKVN); float* KPER = (float*)(ws + WS_KPER);
    float* Q = (float*)(ws + WS_Q); float* QLAT = (float*)(ws + WS_QLAT); float* QPE = (float*)(ws + WS_QPE);
    float* ORET = (float*)(ws + WS_ORET); float* OLAT = (float*)(ws + WS_OLAT); float* OX = (float*)(ws + WS_OX); float* OMLA = (float*)(ws + WS_OMLA); float* ORETN = (float*)(ws + WS_ORETN);
    float* ARET = (float*)(ws + WS_ARET); float* AMLA = (float*)(ws + WS_AMLA); float* AX = (float*)(ws + WS_AX); float* MIX = (float*)(ws + WS_MIX);
    float* HP = (float*)(ws + WS_HP); float* H = (float*)(ws + WS_H); float* F = (float*)(ws + WS_F);
    float* GU = (float*)(ws + WS_GG); float* FO = (float*)(ws + WS_FO);
    bf16_t* WinT = (bf16_t*)(ws + WS_WIN_T); bf16_t* WmkvT = (bf16_t*)(ws + WS_WMKV_T); bf16_t* WuqT = (bf16_t*)(ws + WS_WUQ_T); bf16_t* WroT = (bf16_t*)(ws + WS_WRO_T);
    bf16_t* WmoT = (bf16_t*)(ws + WS_WMO_T); bf16_t* WxoT = (bf16_t*)(ws + WS_WXO_T); bf16_t* WoT = (bf16_t*)(ws + WS_WO_T); bf16_t* WguT = (bf16_t*)(ws + WS_WGU_T); bf16_t* WdT = (bf16_t*)(ws + WS_WD_T);
    bf16_t* Ub = (bf16_t*)(ws + WS_UB); bf16_t* MNb = (bf16_t*)(ws + WS_MNB); bf16_t* CQNb = (bf16_t*)(ws + WS_CQNB); bf16_t* ORETNb = (bf16_t*)(ws + WS_ORETNB);
    bf16_t* OMLAb = (bf16_t*)(ws + WS_OMLAB); bf16_t* OXb = (bf16_t*)(ws + WS_OXB); bf16_t* MIXb = (bf16_t*)(ws + WS_MIXB); bf16_t* Fb = (bf16_t*)(ws + WS_FB); bf16_t* ACTb = (bf16_t*)(ws + WS_ACTB);
    bf16_t* WukT = (bf16_t*)(ws + WS_WUK_T); bf16_t* WuvT = (bf16_t*)(ws + WS_WUV_T); bf16_t* CKVNb = (bf16_t*)(ws + WS_CKVNB); bf16_t* KPERb = (bf16_t*)(ws + WS_KPERB);
    bf16_t* XQb = (bf16_t*)(ws + WS_XQB); bf16_t* MKb = (bf16_t*)(ws + WS_MKB); bf16_t* MVT = (bf16_t*)(ws + WS_MVT); bf16_t* KN = (bf16_t*)(ws + WS_KN); bf16_t* VT = (bf16_t*)(ws + WS_VT); bf16_t* Qb = (bf16_t*)(ws + WS_QB);
    bf16_t* RQt = (bf16_t*)(ws + WS_RQT); bf16_t* RKt = (bf16_t*)(ws + WS_RKT); bf16_t* RKtT = (bf16_t*)(ws + WS_RKTT); bf16_t* RVT = (bf16_t*)(ws + WS_RVT);
    float* UT = (float*)(ws + WS_UT); bf16_t* SPT = (bf16_t*)(ws + WS_SPT);
    bf16_t* QPEb = (bf16_t*)(ws + WS_QPEB); bf16_t* WukB = (bf16_t*)(ws + WS_WUKB); float* PART = (float*)(ws + WS_PART);
    bf16_t* SGb = (bf16_t*)(ws + WS_SGB); bf16_t* SRGb = (bf16_t*)(ws + WS_SRGB); bf16_t* T0b = (bf16_t*)(ws + WS_T0B); bf16_t* T1b = (bf16_t*)(ws + WS_T1B);
    bf16_t* QLATb = (bf16_t*)(ws + WS_QLATB); float* PO = (float*)(ws + WS_PO); float* PML = (float*)(ws + WS_PML);

    if (IN(0)) {
        for (int i = bid * NTHREADS + tid; i < NPOS * 64 + NPOS * 32; i += G * NTHREADS) {
            const bool a = i < NPOS * 64; const int j = a ? i : i - NPOS * 64; const int half = a ? 64 : 32;
            const int p = j / half, f = j % half; const int pos = p < SEQ ? p : PAST + (p - SEQ);
            const float inv = powf(10000.0f, -(float)f / (float)half);
            const float ang = (float)pos * inv;
            double rev = (double)ang * 0.15915494309189535; rev -= floor(rev);
            const float r = (float)rev;
            const float sn = __builtin_amdgcn_sinf(r), cs = __builtin_amdgcn_cosf(r);
            if (a) { COSA[j] = cs; SINA[j] = sn; } else { COSB[j] = cs; SINB[j] = sn; }
        }
#pragma unroll 1
        for (int pass = 0; pass < 2; ++pass) {
            const int nrows = pass ? NB * NMEM : NT; const float* gsrc = pass ? g_mem : g_mix_pre; bf16_t* dst = pass ? MNb : Ub;
            f32x4 a[4];
#define P0_SRC(r_) (pass ? mem_prompt + (size_t)(r_) * DM : (r_) < NP ? x_prompt + (size_t)(r_) * DM : x_sample + (size_t)((r_) - NP) * DM)
#define P0_LOAD(r_, A_) do { const float* s_ = P0_SRC(r_); _Pragma("unroll") for (int j_ = 0; j_ < 4; ++j_) A_[j_] = *(const f32x4*)(s_ + 4 * lane + 256 * j_); } while (0)
            int row = gw;
            if (row < nrows) P0_LOAD(row, a);
#pragma unroll 1
            for (; row < nrows; row += NGW) {
                f32x4 an[4]; const int nr = row + NGW;
                if (nr < nrows) P0_LOAD(nr, an);
                float ss = 0.f;
#pragma unroll
                for (int j = 0; j < 4; ++j) ss += a[j][0] * a[j][0] + a[j][1] * a[j][1] + a[j][2] * a[j][2] + a[j][3] * a[j][3];
                const float r = rsqrtf(wave_sum(ss) * (1.f / DM) + EPS);
#pragma unroll
                for (int j = 0; j < 4; ++j) { const f32x4 v = a[j] * r * *(const f32x4*)(gsrc + 4 * lane + 256 * j); *(u32x2_t*)(dst + (size_t)row * DM + 4 * lane + 256 * j) = (u32x2_t){cvtpk(v[0], v[1]), cvtpk(v[2], v[3])}; }
#pragma unroll
                for (int j = 0; j < 4; ++j) a[j] = an[j];
            }
#undef P0_LOAD
#undef P0_SRC
        }
        {
            LAS float* scr = lds + wave * (64 * 33);
            int rot = 0;
            transpose_w(w_in, 1024, DIN, WinT, 1024, 0, scr, gw, NGW, lane, rot);
            for (int i = bid * NTHREADS + tid; i < (ZLD - DIN) * 1024 / 2; i += G * NTHREADS) ((unsigned*)(WinT + (size_t)DIN * 1024))[i] = 0u;
            for (int i = bid * NTHREADS + tid; i < MH * KVL * DNOPE / 4; i += G * NTHREADS) { const f32x4 v = *(const f32x4*)(w_uk + 4 * (size_t)i); *(u32x2_t*)(WukB + 4 * (size_t)i) = (u32x2_t){cvtpk(v[0], v[1]), cvtpk(v[2], v[3])}; }
            transpose_w(w_mem_k, 1024, 256, WmkvT, 1024, 0, scr, gw, NGW, lane, rot);
            transpose_w(w_mem_v, 1024, 256, WmkvT, 1024, 256, scr, gw, NGW, lane, rot);
            transpose_w(w_uq, QL, 1536, WuqT, QL, 0, scr, gw, NGW, lane, rot);
            transpose_w(w_ret_o, 1024, 1024, WroT, 1024, 0, scr, gw, NGW, lane, rot);
            transpose_w(w_mla_o, 1024, 1024, WmoT, 1024, 0, scr, gw, NGW, lane, rot);
            transpose_w(w_x_o, 256, 1024, WxoT, 256, 0, scr, gw, NGW, lane, rot);
            transpose_w(w_out, 1024, 1024, WoT, 1024, 0, scr, gw, NGW, lane, rot);
            transpose_w(w_gate, 1024, DFF, WguT, 1024, 0, scr, gw, NGW, lane, rot, 2);
            transpose_w(w_up, 1024, DFF, WguT, 1024, 1, scr, gw, NGW, lane, rot, 2);
            transpose_w(w_down, DFF, 1024, WdT, DFF, 0, scr, gw, NGW, lane, rot);
            for (int hh = 0; hh < MH; ++hh) { transpose_w(w_uk + (size_t)hh * KVL * DNOPE, KVL, DNOPE, WukT, KVL, hh * DNOPE, scr, gw, NGW, lane, rot);
                                              transpose_w(w_uv + (size_t)hh * KVL * DVH, KVL, DVH, WuvT, KVL, hh * DVH, scr, gw, NGW, lane, rot); }
        }
    }
    SEAM(0);
    if (IN(1)) {
        static_assert(WS_MNB == WS_UB + (size_t)NT * 1024 * 2 && WS_WMKV_T == WS_WIN_T + (size_t)ZLD * 1024 * 2, "P1 stacks Ub|MNb and WinT|WmkvT");
        { pg8::Gemm g{Ub, WinT, NT + NB * NMEM, ZLD + 512, 1024, 1024, 1024}; pg8::P1Order S; S.init(G, bid); pg8::EpiP1 E{Z, ZLD, out + O_MKP, out + O_MVP, SRGb, SGb, C_RG, C_G};
          pg8::gemm_phase<pg8::EpiP1, pg8::P1Order, true, true>(ldsb, g, S, E); }
        __syncthreads();
        { pg8::Gemm g{WinT + (size_t)C_RV * 1024, Ub, 1024, NP, 1024, 1024, 1024}; pg8::StaticOrder S; S.init(1024, NP, G, bid); pg8::EpiBf16S E{RVT, NT};
          GEMM_PHASE(pg8::EpiBf16S, ldsb, g, S, E); }
    }
    SEAM(1);
    if (IN(2)) {
        constexpr int KTP = 520;
        LAS bf16_t* Kt = (LAS bf16_t*)ldsb;
        const int ntile = NP / 64, nwork = ntile + (NS + 63) / 64;
        for (int wk = bid; wk < nwork; wk += G) {
            const bool prompt = wk < ntile; const int row_base = prompt ? wk * 64 : NP + (wk - ntile) * 64;
            __syncthreads();
            {
                float zq[8], zk[8], zc[6], zv[4], zx[4], zp, ca, sa, cb, sb; int p;
#define P2_LOAD(r_, ZQ_, ZK_, ZC_, ZV_, ZX_, ZP_, CA_, SA_, CB_, SB_, P_) do { const float* z_ = Z + (size_t)(row_base + (r_)) * ZLD; P_ = pos_index(row_base + (r_)); \
                _Pragma("unroll") for (int h_ = 0; h_ < 4; ++h_) { ZQ_[2 * h_] = z_[C_RQ + h_ * RDK + lane]; ZQ_[2 * h_ + 1] = z_[C_RQ + h_ * RDK + 64 + lane]; ZK_[2 * h_] = z_[C_RK + h_ * RDK + lane]; ZK_[2 * h_ + 1] = z_[C_RK + h_ * RDK + 64 + lane]; } \
                _Pragma("unroll") for (int c_ = 0; c_ < 6; ++c_) ZC_[c_] = z_[C_CQ + lane + 64 * c_]; \
                _Pragma("unroll") for (int c_ = 0; c_ < 4; ++c_) { ZV_[c_] = z_[C_CKV + lane + 64 * c_]; ZX_[c_] = z_[C_XQ + lane + 64 * c_]; } \
                ZP_ = z_[C_KPE + lane]; CA_ = COSA[P_ * 64 + lane]; SA_ = SINA[P_ * 64 + lane]; CB_ = COSB[P_ * 32 + (lane & 31)]; SB_ = SINB[P_ * 32 + (lane & 31)]; } while (0)
                int r = wave;
                P2_LOAD(r, zq, zk, zc, zv, zx, zp, ca, sa, cb, sb, p);
                for (; r < 64; r += NWAVES) {
                    float zqn[8], zkn[8], zcn[6], zvn[4], zxn[4], zpn, can, san, cbn, sbn; int pn;
                    if (r + NWAVES < 64) P2_LOAD(r + NWAVES, zqn, zkn, zcn, zvn, zxn, zpn, can, san, cbn, sbn, pn);
                    const int row = row_base + r; const int il = p & 127;
#pragma unroll
                    for (int h = 0; h < RH; ++h) {
                        const float q1 = zq[2 * h] * ca - zq[2 * h + 1] * sa, q2 = zq[2 * h] * sa + zq[2 * h + 1] * ca;
                        const float sc = 0.08838834764831845f;
                        const float k1 = (zk[2 * h] * ca - zk[2 * h + 1] * sa) * sc, k2 = (zk[2 * h] * sa + zk[2 * h + 1] * ca) * sc;
                        if (prompt) {
                            const float fq = __expf((float)(il - 127) * lg_gamma(h)), fk = 1.f / fq;
                            RQt[(size_t)row * 512 + h * RDK + lane] = f2bf(q1 * fq); RQt[(size_t)row * 512 + h * RDK + 64 + lane] = f2bf(q2 * fq);
                            const bf16_t kb1 = f2bf(k1 * fk), kb2 = f2bf(k2 * fk);
                            RKt[(size_t)row * 512 + h * RDK + lane] = kb1; RKt[(size_t)row * 512 + h * RDK + 64 + lane] = kb2;
                            Kt[r * KTP + h * RDK + lane] = kb1; Kt[r * KTP + h * RDK + 64 + lane] = kb2;
                        } else {
                            RQ[(size_t)row * 512 + h * RDK + lane] = q1; RQ[(size_t)row * 512 + h * RDK + 64 + lane] = q2;
                            RK[(size_t)row * 512 + h * RDK + lane] = k1; RK[(size_t)row * 512 + h * RDK + 64 + lane] = k2;
                        }
                    }
                    {
                        float ss = 0.f;
#pragma unroll
                        for (int c = 0; c < 6; ++c) ss += zc[c] * zc[c];
                        const float rr = rsqrtf(wave_sum(ss) * (1.f / QL) + EPS);
#pragma unroll
                        for (int c = 0; c < 6; ++c) CQNb[(size_t)row * QL + lane + 64 * c] = f2bf(zc[c] * rr * g_qlat[lane + 64 * c]);
                    }
                    {
                        float ss = 0.f;
#pragma unroll
                        for (int c = 0; c < 4; ++c) ss += zv[c] * zv[c];
                        const float rr = rsqrtf(wave_sum(ss) * (1.f / KVL) + EPS);
                        float* ockv = row < NP ? out + O_CKVP + (size_t)row * KVL : out + O_CKVS + (size_t)(row - NP) * KVL;
#pragma unroll
                        for (int c = 0; c < 4; ++c) { const float v = zv[c] * rr * g_kvlat[lane + 64 * c]; ockv[lane + 64 * c] = v; CKVN[(size_t)row * KVL + lane + 64 * c] = v; CKVNb[(size_t)row * KVL + lane + 64 * c] = f2bf(v);
                            XQb[(size_t)row * 256 + lane + 64 * c] = f2bf(zx[c]); }
                    }
                    {
                        const float x2 = __shfl(zp, (lane & 31) + 32), x1 = __shfl(zp, lane & 31);
                        const float o1 = x1 * cb - x2 * sb, o2 = x1 * sb + x2 * cb;
                        if (lane < 32) {
                            KPER[(size_t)row * DROPE + lane] = o1; KPER[(size_t)row * DROPE + 32 + lane] = o2;
                            float* okpe = row < NP ? out + O_KPEP + (size_t)row * DROPE : out + O_KPES + (size_t)(row - NP) * DROPE;
                            okpe[lane] = o1; okpe[32 + lane] = o2;
                            KPERb[(size_t)row * DROPE + lane] = f2bf(o1); KPERb[(size_t)row * DROPE + 32 + lane] = f2bf(o2);
                        }
                    }
#pragma unroll
                    for (int i = 0; i < 8; ++i) { zq[i] = zqn[i]; zk[i] = zkn[i]; }
#pragma unroll
                    for (int i = 0; i < 6; ++i) zc[i] = zcn[i];
#pragma unroll
                    for (int i = 0; i < 4; ++i) { zv[i] = zvn[i]; zx[i] = zxn[i]; }
                    zp = zpn; ca = can; sa = san; cb = cbn; sb = sbn; p = pn;
                }
#undef P2_LOAD
            }
            __syncthreads();
            if (prompt) {
#pragma unroll 2
                for (int i = 0; i < 8; ++i) { const int pc = tid + i * NTHREADS, f = pc >> 3, k8 = pc & 7;
                    const LAS bf16_t* c = Kt + (8 * k8) * KTP + f;
                    pg8::u32x4 o; o.x = (unsigned)c[0] | ((unsigned)c[KTP] << 16); o.y = (unsigned)c[2 * KTP] | ((unsigned)c[3 * KTP] << 16);
                    o.z = (unsigned)c[4 * KTP] | ((unsigned)c[5 * KTP] << 16); o.w = (unsigned)c[6 * KTP] | ((unsigned)c[7 * KTP] << 16);
                    *(pg8::u32x4*)(RKtT + (size_t)f * NP + row_base + 8 * k8) = o; }
            }
        }
    }
    if (IN(2)) {
        for (int i = bid * NTHREADS + tid; i < NB * NMEM * 256; i += G * NTHREADS) { MKb[i] = f2bf(out[O_MKP + i]);
            const int f = i / (NB * NMEM), r = i - f * (NB * NMEM); MVT[i] = f2bf(out[O_MVP + (size_t)r * 256 + f]); }
    }
    SEAM(2);
    if (IN(3)) { pg8::Gemm g{CQNb, WuqT, NT, 1536, QL, QL, QL}; pg8::StaticOrder S; S.init(NT, 1536, G, bid); pg8::EpiBf16S E{Qb, 1536};
        GEMM_PHASE(pg8::EpiBf16S, ldsb, g, S, E);
        __syncthreads();
        { pg8::Gemm g2{CKVNb, WukT, NP, 1024, KVL, KVL, KVL}; pg8::StaticOrder S2; S2.init(NP, 1024, G, bid); pg8::EpiBf16S E2{KN, 1024}; GEMM_PHASE(pg8::EpiBf16S, ldsb, g2, S2, E2); }
        __syncthreads();
        { pg8::Gemm g3{WuvT, CKVNb, 1024, NP, KVL, KVL, KVL}; pg8::StaticOrder S3; S3.init(1024, NP, G, bid); pg8::EpiBf16S E3{VT, NP}; GEMM_PHASE(pg8::EpiBf16S, ldsb, g3, S3, E3); }
        for (int it = bid; it < NB * RH * 16; it += G) { const int c = __builtin_amdgcn_readfirstlane(it & 15), h = __builtin_amdgcn_readfirstlane((it >> 4) & 3), b = __builtin_amdgcn_readfirstlane(it >> 6);
            ret_chunk_state(RVT, RKtT, UT, b, h, c); } }
    SEAM(3);
    if (IN(4)) {
        for (int idx = bid * NTHREADS + tid; idx < NB * RH * 8192; idx += G * NTHREADS) {
            const int bh = idx >> 13, e = (idx & 8191) * 4; const float g128 = __expf(128.f * lg_gamma(bh & 3));
            f32x4 u[16];
#pragma unroll
            for (int c = 0; c < 16; ++c) u[c] = __builtin_nontemporal_load((const f32x4*)(UT + (size_t)(bh * 16 + c) * 32768 + e));
            f32x4 sp = {0.f, 0.f, 0.f, 0.f}, S = sp;
#pragma unroll
            for (int c = 0; c < 16; ++c) { *(u32x2_t*)(SPT + (size_t)(bh * 16 + c) * 32768 + e) = (u32x2_t){cvtpk(sp[0], sp[1]), cvtpk(sp[2], sp[3])}; S = sp + u[c]; sp = S * g128; }
            const int dv = e >> 7, dk = e & 127; float* o_ = out + O_RETP + (size_t)bh * 32768 + (size_t)dk * RDV + dv;
            o_[0] = S[0]; o_[RDV] = S[1]; o_[2 * RDV] = S[2]; o_[3 * RDV] = S[3];
        }
        {
            const int hd = lane >> 3, f4 = (lane & 7) * 4;
            u32x2_t x1, x2; f32x4 cb, sb;
#define P4_LOAD(r_, X1_, X2_, C_, S_) do { const bf16_t* q_ = Qb + (size_t)(r_) * 1536 + hd * DQH + DNOPE + f4; X1_ = *(const u32x2_t*)q_; X2_ = *(const u32x2_t*)(q_ + 32); \
            const int p_ = pos_index(r_); C_ = *(const f32x4*)(COSB + p_ * 32 + f4); S_ = *(const f32x4*)(SINB + p_ * 32 + f4); } while (0)
            int row = gw;
            if (row < NT) P4_LOAD(row, x1, x2, cb, sb);
            for (; row < NT; row += NGW) {
                u32x2_t x1n, x2n; f32x4 cbn, sbn; const int nr = row + NGW;
                if (nr < NT) P4_LOAD(nr, x1n, x2n, cbn, sbn);
                const float a0 = __builtin_bit_cast(float, x1.x << 16), a1 = __builtin_bit_cast(float, x1.x & 0xffff0000u), a2 = __builtin_bit_cast(float, x1.y << 16), a3 = __builtin_bit_cast(float, x1.y & 0xffff0000u);
                const float b0 = __builtin_bit_cast(float, x2.x << 16), b1 = __builtin_bit_cast(float, x2.x & 0xffff0000u), b2 = __builtin_bit_cast(float, x2.y << 16), b3 = __builtin_bit_cast(float, x2.y & 0xffff0000u);
                bf16_t* o_ = QPEb + (size_t)row * 512 + hd * DROPE + f4;
                *(u32x2_t*)o_ = (u32x2_t){cvtpk(a0 * cb[0] - b0 * sb[0], a1 * cb[1] - b1 * sb[1]), cvtpk(a2 * cb[2] - b2 * sb[2], a3 * cb[3] - b3 * sb[3])};
                *(u32x2_t*)(o_ + 32) = (u32x2_t){cvtpk(a0 * sb[0] + b0 * cb[0], a1 * sb[1] + b1 * cb[1]), cvtpk(a2 * sb[2] + b2 * cb[2], a3 * sb[3] + b3 * cb[3])};
                x1 = x1n; x2 = x2n; cb = cbn; sb = sbn;
            }
#undef P4_LOAD
        }
        for (int wt = gw; wt < MH * 16 * 2; wt += NGW) {
            const int lh = wt & 1, rb = (wt >> 1) & 15, head = wt >> 5; const int l31 = lane & 31, h8 = lane >> 5;
            f32x16 acc[4];
#pragma unroll
            for (int k_ = 0; k_ < 4; ++k_)
#pragma unroll
                for (int i = 0; i < 16; ++i) acc[k_][i] = 0.f;
            const bf16_t* ap = Qb + ((size_t)NP + 32 * rb + l31) * 1536 + head * DQH + 8 * h8;
            const bf16_t* bp = WukB + ((size_t)head * KVL + 128 * lh + l31) * DNOPE + 8 * h8;
#pragma unroll
            for (int s_ = 0; s_ < 8; ++s_) { const bf16x8 a = *(const bf16x8*)(ap + 16 * s_);
#pragma unroll
                for (int k_ = 0; k_ < 4; ++k_) { const bf16x8 b_ = *(const bf16x8*)(bp + (size_t)(32 * k_) * DNOPE + 16 * s_); acc[k_] = MFMA32(a, b_, acc[k_]); } }
#pragma unroll
            for (int k_ = 0; k_ < 4; ++k_)
#pragma unroll
                for (int i = 0; i < 16; ++i) QLATb[(size_t)(32 * rb + crow(i, h8)) * 2048 + head * KVL + 128 * lh + 32 * k_ + l31] = f2bf(acc[k_][i]);
        }
    }
    SEAM(4);
    if (IN(5)) {
        if (args.sub & 1) for (int it = bid; it < DB * MS_NSPLIT; it += G) { const int split = __builtin_amdgcn_readfirstlane(it % MS_NSPLIT), b = __builtin_amdgcn_readfirstlane(it / MS_NSPLIT);
            mla_sample_unit(ldsb, cache_ckv, cache_kpe, page_table, QLATb, QPEb, PO, PML, b, split, 0.07216878364870322f * 1.4426950408889634f); }
        if (args.sub & 2) for (int it = bid; it < NB * MH * 4; it += G) {
            const int pr = __builtin_amdgcn_readfirstlane(it & 3), hh = __builtin_amdgcn_readfirstlane((it >> 2) & 7), b = __builtin_amdgcn_readfirstlane(it >> 5);
#pragma unroll 1
            for (int half = 0; half < 2; ++half) { const int qb = __builtin_amdgcn_readfirstlane(half ? pr : 7 - pr); const size_t row0 = (size_t)b * SEQ + qb * 256;
                SrcMlaP src{KN, KPERb, VT, Qb, QPEb, b, hh, row0};
                flash_unit<192, 128, true>(ldsb, src, qb * 256, 4 * (qb + 1), OMLAb + row0 * 1024 + hh * DVH, 1024, 0.07216878364870322f * 1.4426950408889634f); }
        }
        if (args.sub & 4) ret_out_phase(ldsb, RQt, RKt, RVT, SPT, ORET, bid, G);
        if (args.sub & 8) for (int it = bid; it < DB * RH; it += G) {
            const int h = it & 3, b = it >> 2; const float lg = lg_gamma(h);
            const float* s0 = state_ret + (size_t)it * RDK * RDV;
            float* so = out + O_RETS + (size_t)it * RDK * RDV;
            LAS float* inner = lds;
            LAS float* qk = lds + 16;
            LAS float* vls = lds + 1040;
            LAS float* red = lds + 2064;
            f32x4 sv[16], vv[4];
#pragma unroll
            for (int r = 0; r < 16; ++r) sv[r] = __builtin_nontemporal_load((const f32x4*)(s0 + (size_t)(wave + 8 * r) * RDV + 4 * lane));
#pragma unroll
            for (int j = 0; j < DS; ++j) vv[j] = *(const f32x4*)(Z + ((size_t)NP + b * DS + j) * ZLD + C_RV + h * RDV + 4 * lane);
            __syncthreads();
            for (int i = tid; i < 1024; i += NTHREADS) { const int which = i >> 9, ti = (i >> 7) & 3, d = i & 127; const size_t row = (size_t)NP + b * DS + ti;
                qk[i] = which ? RK[row * 512 + h * RDK + d] : RQ[row * 512 + h * RDK + d]; }
            if (wave == 0) {
#pragma unroll
                for (int j = 0; j < DS; ++j) *(LAS f32x4*)(vls + j * 256 + 4 * lane) = vv[j]; }
            __syncthreads();
            for (int pr = wave; pr < 16; pr += NWAVES) { const int i = pr >> 2, j = pr & 3;
                float s_ = qk[i * 128 + lane] * qk[512 + j * 128 + lane] + qk[i * 128 + 64 + lane] * qk[512 + j * 128 + 64 + lane];
                s_ = wave_sum(s_);
                if (lane == 0) inner[pr] = (j <= i) ? s_ * __expf((float)(i - j) * lg) : 0.f; }
            const float g4 = __expf(4.f * lg), gk0 = __expf(3.f * lg), gk1 = __expf(2.f * lg), gk2 = __expf(lg);
            f32x4 po[4];
#pragma unroll
            for (int i = 0; i < 4; ++i) po[i] = (f32x4){0.f, 0.f, 0.f, 0.f};
#pragma unroll
            for (int r = 0; r < 16; ++r) { const int d = wave + 8 * r; const f32x4 sx = sv[r];
                f32x4 a = sx * g4 + (gk0 * qk[512 + d]) * vv[0] + (gk1 * qk[512 + 128 + d]) * vv[1] + (gk2 * qk[512 + 256 + d]) * vv[2] + qk[512 + 384 + d] * vv[3];
                __builtin_nontemporal_store(a, (f32x4*)(so + (size_t)d * RDV + 4 * lane));
#pragma unroll
                for (int i = 0; i < 4; ++i) po[i] += qk[i * 128 + d] * sx; }
#pragma unroll
            for (int i = 0; i < 4; ++i) *(LAS f32x4*)(red + (wave * 4 + i) * 256 + 4 * lane) = po[i];
            __syncthreads();
            {
                const int i = tid >> 7, e2 = (tid & 127) * 2;
                float o0 = 0.f, o1 = 0.f;
#pragma unroll
                for (int w_ = 0; w_ < NWAVES; ++w_) { o0 += red[(w_ * 4 + i) * 256 + e2]; o1 += red[(w_ * 4 + i) * 256 + e2 + 1]; }
                const float gi = __expf((float)(i + 1) * lg); o0 *= gi; o1 *= gi;
#pragma unroll
                for (int j = 0; j < DS; ++j) { const float w_ = inner[i * 4 + j]; o0 += w_ * vls[j * 256 + e2]; o1 += w_ * vls[j * 256 + e2 + 1]; }
                *(f32x2_t*)(ORET + ((size_t)NP + b * DS + i) * 1024 + h * RDV + e2) = (f32x2_t){o0, o1};
            }
        }
        if (args.sub & 16) for (int it = bid; it < NB * XH * 8; it += G) {
            const int qb = __builtin_amdgcn_readfirstlane(it & 7), hh = __builtin_amdgcn_readfirstlane((it >> 3) & 3), b = __builtin_amdgcn_readfirstlane(it >> 5); const size_t row0 = (size_t)b * SEQ + qb * 256;
            SrcMemP src{MKb, MVT, XQb, b, hh, row0};
            flash_unit<64, 64, false>(ldsb, src, 0, 4, OXb + row0 * 256 + hh * XHD, 256, 0.125f * 1.4426950408889634f);
        }
        if (args.sub & 32) for (int b = bid; b < DB; b += G) {
            LAS float* sc = lds;
            LAS float* red = lds + 4096;
            const float* kb_ = cache_mem_k + (size_t)b * NMEM * 256; const float* vb_ = cache_mem_v + (size_t)b * NMEM * 256;
            f32x4 qr[4];
#pragma unroll
            for (int q = 0; q < DS; ++q) qr[q] = *(const f32x4*)(Z + ((size_t)NP + b * DS + q) * ZLD + C_XQ + 4 * lane);
            __syncthreads();
#pragma unroll 8
            for (int kk = 0; kk < 32; ++kk) { const int key = 32 * wave + kk; const f32x4 kv = __builtin_nontemporal_load((const f32x4*)(kb_ + (size_t)key * 256 + 4 * lane));
                float pq[4];
#pragma unroll
                for (int q = 0; q < 4; ++q) { float a = kv[0] * qr[q][0] + kv[1] * qr[q][1] + kv[2] * qr[q][2] + kv[3] * qr[q][3];
                    a += __shfl_xor(a, 1); a += __shfl_xor(a, 2); a += __shfl_xor(a, 4); a += __shfl_xor(a, 8); pq[q] = a; }
                if ((lane & 15) == 0) {
#pragma unroll
                    for (int q = 0; q < 4; ++q) sc[(q * 4 + (lane >> 4)) * 256 + key] = pq[q] * (0.125f * 1.4426950408889634f); } }
            __syncthreads();
            for (int rr = wave * 2; rr < wave * 2 + 2; ++rr) {
                f32x4 v = *(LAS f32x4*)(sc + rr * 256 + 4 * lane);
                const float mx = wave_max(fmaxf(fmaxf(v[0], v[1]), fmaxf(v[2], v[3])));
#pragma unroll
                for (int e = 0; e < 4; ++e) v[e] = __builtin_amdgcn_exp2f(v[e] - mx);
                const float inv = 1.f / wave_sum(v[0] + v[1] + v[2] + v[3]);
                *(LAS f32x4*)(sc + rr * 256 + 4 * lane) = v * inv; }
            __syncthreads();
            f32x4 acc[4];
#pragma unroll
            for (int q = 0; q < 4; ++q) acc[q] = (f32x4){0.f, 0.f, 0.f, 0.f};
#pragma unroll 8
            for (int kk = 0; kk < 32; ++kk) { const int key = 32 * wave + kk; const f32x4 vv = __builtin_nontemporal_load((const f32x4*)(vb_ + (size_t)key * 256 + 4 * lane));
#pragma unroll
                for (int q = 0; q < 4; ++q) acc[q] += sc[(q * 4 + (lane >> 4)) * 256 + key] * vv; }
#pragma unroll
            for (int q = 0; q < 4; ++q) *(LAS f32x4*)(red + (wave * 4 + q) * 256 + 4 * lane) = acc[q];
            __syncthreads();
            { const int q = tid >> 7, e2 = (tid & 127) * 2; float o0 = 0.f, o1 = 0.f;
#pragma unroll
              for (int w_ = 0; w_ < NWAVES; ++w_) { o0 += red[(w_ * 4 + q) * 256 + e2]; o1 += red[(w_ * 4 + q) * 256 + e2 + 1]; }
              *(unsigned*)(OXb + ((size_t)NP + b * DS + q) * 256 + e2) = cvtpk(o0, o1); }
        }
    }
    SEAM(5);
    if (IN(6)) {
        for (int bt = bid; bt < NS; bt += G) {
            const int b = bt >> 2;
            const int head = wave; const float c2 = 0.07216878364870322f * 1.4426950408889634f;
            LAS float* ol = lds + wave * KVL;
            { const int t = bt & 3;
                const int qi = t * 8 + head; const size_t qrow = (size_t)b * DS + t;
                float qv[5];
#pragma unroll
                for (int c = 0; c < 5; ++c) { const int d = lane + 64 * c; const bf16_t raw = d < KVL ? QLATb[qrow * 2048 + head * KVL + d] : QPEb[(NP + qrow) * 512 + head * DROPE + (d - KVL)];
                    qv[c] = __builtin_bit_cast(float, (unsigned)raw << 16); }
                float sc[DS]; float M = -INFINITY;
#pragma unroll
                for (int j = 0; j < DS; ++j) { const size_t krow = (size_t)NP + b * DS + j; float a = 0.f;
#pragma unroll
                    for (int c = 0; c < 5; ++c) { const int d = lane + 64 * c; a += qv[c] * (d < KVL ? CKVN[krow * KVL + d] : KPER[krow * DROPE + (d - KVL)]); }
                    a = wave_sum(a) * c2; sc[j] = (j <= t) ? a : -INFINITY; M = fmaxf(M, sc[j]); }
                float ms[MS_NSPLIT], ls[MS_NSPLIT];
#pragma unroll
                for (int sp = 0; sp < MS_NSPLIT; ++sp) { const int item = b * MS_NSPLIT + sp; ms[sp] = PML[(item * 32 + qi) * 2]; ls[sp] = PML[(item * 32 + qi) * 2 + 1]; M = fmaxf(M, ms[sp]); }
                float L = 0.f; float acc[4] = {0.f, 0.f, 0.f, 0.f};
#pragma unroll
                for (int sp = 0; sp < MS_NSPLIT; ++sp) { const int item = b * MS_NSPLIT + sp; const float wgt = __builtin_amdgcn_exp2f(ms[sp] - M); L += ls[sp] * wgt;
#pragma unroll
                    for (int c = 0; c < 4; ++c) acc[c] += wgt * PO[((size_t)item * 32 + qi) * KVL + lane + 64 * c]; }
#pragma unroll
                for (int j = 0; j < DS; ++j) { const float wgt = __builtin_amdgcn_exp2f(sc[j] - M); L += wgt; const size_t krow = (size_t)NP + b * DS + j;
#pragma unroll
                    for (int c = 0; c < 4; ++c) acc[c] += wgt * CKVN[krow * KVL + lane + 64 * c]; }
                const float inv = 1.f / L;
#pragma unroll
                for (int c = 0; c < 4; ++c) ol[lane + 64 * c] = acc[c] * inv;
                __syncthreads();
                float a0 = 0.f, a1 = 0.f; const float* wv = w_uv + (size_t)head * KVL * DVH;
#pragma unroll 8
                for (int l = 0; l < KVL; ++l) { const float x = ol[l]; a0 += x * wv[(size_t)l * DVH + lane]; a1 += x * wv[(size_t)l * DVH + 64 + lane]; }
                OMLAb[((size_t)NP + qrow) * 1024 + head * DVH + lane] = f2bf(a0); OMLAb[((size_t)NP + qrow) * 1024 + head * DVH + 64 + lane] = f2bf(a1);
                __syncthreads();
            }
        }
        {
            f32x4 a[4]; u32x2_t gz[4];
#define P6_LOAD(r_, A_, B_) do { _Pragma("unroll") for (int j_ = 0; j_ < 4; ++j_) { A_[j_] = *(const f32x4*)(ORET + (size_t)(r_) * 1024 + 4 * lane + 256 * j_); \
                                                                              B_[j_] = *(const u32x2_t*)(SRGb + (size_t)(r_) * 1024 + 4 * lane + 256 * j_); } } while (0)
            int row = gw;
            if (row < NT) P6_LOAD(row, a, gz);
            for (; row < NT; row += NGW) {
                f32x4 an[4]; u32x2_t gn[4]; const int nr = row + NGW;
                if (nr < NT) P6_LOAD(nr, an, gn);
#pragma unroll
                for (int j = 0; j < 4; ++j) {
                    const float ss = wave_sum(a[j][0] * a[j][0] + a[j][1] * a[j][1] + a[j][2] * a[j][2] + a[j][3] * a[j][3]);
                    const float r = rsqrtf(ss * (1.f / RDV) + EPS);
                    float o_[4];
#pragma unroll
                    for (int e = 0; e < 4; ++e) { const unsigned gw_ = e < 2 ? gz[j].x : gz[j].y; o_[e] = __builtin_bit_cast(float, (e & 1) ? (gw_ & 0xffff0000u) : (gw_ << 16)) * a[j][e] * r; }
                    *(u32x2_t*)(ORETNb + (size_t)row * 1024 + 4 * lane + 256 * j) = (u32x2_t){cvtpk(o_[0], o_[1]), cvtpk(o_[2], o_[3])};
                }
#pragma unroll
                for (int j = 0; j < 4; ++j) { a[j] = an[j]; gz[j] = gn[j]; }
            }
#undef P6_LOAD
        }
    }
    SEAM(6);
    if (IN(7)) {
        pg8::StaticOrder S; S.init(NP, 1024, G, bid);
        { pg8::Gemm g{ORETNb, WroT, NP, 1024, 1024, 1024, 1024}; pg8::EpiGate<0> E{SGb, T0b, T0b, 1024}; GEMM_PHASE(pg8::EpiGate<0>, ldsb, g, S, E); }
        __syncthreads();
        { pg8::Gemm g{OMLAb, WmoT, NP, 1024, 1024, 1024, 1024}; pg8::EpiGate<1> E{SGb + 1024, T0b, T1b, 1024}; GEMM_PHASE(pg8::EpiGate<1>, ldsb, g, S, E); }
        __syncthreads();
        { pg8::Gemm g{OXb, WxoT, NP, 1024, 256, 256, 256}; pg8::EpiGate<1> E{SGb + 2048, T1b, MIXb, 1024}; GEMM_PHASE(pg8::EpiGate<1>, ldsb, g, S, E); }
        __syncthreads();
        { pg8::Gemm g{ORETNb, WroT, NT, 1024, 256, 1024, 1024, 256}; pg8::SplitOrder SS{4, bid}; pg8::EpiPart E{PART}; GEMM_SPLIT(ldsb, g, SS, E); }
        __syncthreads();
        { pg8::Gemm g{OMLAb, WmoT, NT, 1024, 256, 1024, 1024, 256}; pg8::SplitOrder SS{4, (bid + 224) % G}; pg8::EpiPart E{PART + (size_t)4 * 512 * 1024}; GEMM_SPLIT(ldsb, g, SS, E); }
        __syncthreads();
        { pg8::Gemm g{OXb, WxoT, NT, 1024, 256, 256, 256, 256}; pg8::SplitOrder SS{1, (bid + 128) % G}; pg8::EpiPart E{PART + (size_t)8 * 512 * 1024}; GEMM_SPLIT(ldsb, g, SS, E); }
    }
    SEAM(7);
    if (IN(8)) {
        for (int i = bid * NTHREADS + tid; i < NS * 256; i += G * NTHREADS) { const int r = i >> 8, c4 = (i & 255) * 4; const size_t o_ = (size_t)r * 1024 + c4;
            f32x4 mix = {0.f, 0.f, 0.f, 0.f};
#pragma unroll
            for (int br = 0; br < 3; ++br) { f32x4 a = *(const f32x4*)(PART + (size_t)(br == 2 ? 8 : 4 * br) * (512 * 1024) + o_);
                if (br < 2) {
#pragma unroll
                    for (int k_ = 1; k_ < 4; ++k_) a += *(const f32x4*)(PART + (size_t)(4 * br + k_) * (512 * 1024) + o_); }
                const u32x2_t gq = *(const u32x2_t*)(SGb + (size_t)(NP + r) * 3072 + br * 1024 + c4);
                mix[0] += a[0] * __builtin_bit_cast(float, gq.x << 16); mix[1] += a[1] * __builtin_bit_cast(float, gq.x & 0xffff0000u);
                mix[2] += a[2] * __builtin_bit_cast(float, gq.y << 16); mix[3] += a[3] * __builtin_bit_cast(float, gq.y & 0xffff0000u); }
            *(u32x2_t*)(MIXb + (size_t)(NP + r) * 1024 + c4) = (u32x2_t){cvtpk(mix[0], mix[1]), cvtpk(mix[2], mix[3])}; }
    }
    SEAM(8);
    if (IN(9)) { pg8::Gemm g{MIXb, WoT, NP, 1024, 1024, 1024, 1024}; pg8::StaticOrder S; S.init(NP, 1024, G, bid); pg8::EpiF32S E{HP, 1024, 0, 0};
        GEMM_PHASE(pg8::EpiF32S, ldsb, g, S, E);
        __syncthreads();
        { pg8::Gemm g2{MIXb, WoT, NT, 1024, 256, 1024, 1024, 256}; pg8::SplitOrder SS{4, bid}; pg8::EpiPart E2{PART}; GEMM_SPLIT(ldsb, g2, SS, E2); } }
    SEAM(9);
    if (IN(10)) {
        f32x4 gp[4], gf[4], a[4], b[4];
#pragma unroll
        for (int j = 0; j < 4; ++j) { gp[j] = *(const f32x4*)(g_mix_post + 4 * lane + 256 * j); gf[j] = *(const f32x4*)(g_ffn_pre + 4 * lane + 256 * j); }
#define P10_LOAD(r_, A_, B_) do { const float* xr_ = (r_) < NP ? x_prompt + (size_t)(r_) * DM : x_sample + (size_t)((r_) - NP) * DM; \
        _Pragma("unroll") for (int j_ = 0; j_ < 4; ++j_) { B_[j_] = *(const f32x4*)(xr_ + 4 * lane + 256 * j_); \
            if ((r_) < NP) A_[j_] = *(const f32x4*)(HP + (size_t)(r_) * DM + 4 * lane + 256 * j_); \
            else { const float* p_ = PART + (size_t)((r_) - NP) * DM + 4 * lane + 256 * j_; A_[j_] = (*(const f32x4*)p_ + *(const f32x4*)(p_ + 512 * 1024)) + (*(const f32x4*)(p_ + 2 * 512 * 1024) + *(const f32x4*)(p_ + 3 * 512 * 1024)); } } } while (0)
        int row = gw;
        if (row < NT) P10_LOAD(row, a, b);
        for (; row < NT; row += NGW) {
            f32x4 an[4], bn[4]; const int nr = row + NGW;
            if (nr < NT) P10_LOAD(nr, an, bn);
            float ss = 0.f;
#pragma unroll
            for (int j = 0; j < 4; ++j) ss += a[j][0] * a[j][0] + a[j][1] * a[j][1] + a[j][2] * a[j][2] + a[j][3] * a[j][3];
            float r = rsqrtf(wave_sum(ss) * (1.f / DM) + EPS); ss = 0.f;
#pragma unroll
            for (int j = 0; j < 4; ++j) { a[j] = b[j] + a[j] * r * gp[j]; *(f32x4*)(H + (size_t)row * DM + 4 * lane + 256 * j) = a[j];
                ss += a[j][0] * a[j][0] + a[j][1] * a[j][1] + a[j][2] * a[j][2] + a[j][3] * a[j][3]; }
            r = rsqrtf(wave_sum(ss) * (1.f / DM) + EPS);
#pragma unroll
            for (int j = 0; j < 4; ++j) { const f32x4 f_ = a[j] * r * gf[j]; *(u32x2_t*)(Fb + (size_t)row * DM + 4 * lane + 256 * j) = (u32x2_t){cvtpk(f_[0], f_[1]), cvtpk(f_[2], f_[3])}; }
#pragma unroll
            for (int j = 0; j < 4; ++j) { a[j] = an[j]; b[j] = bn[j]; }
        }
#undef P10_LOAD
    }
    SEAM(10);
    if (IN(11)) {
        pg8::Gemm g{Fb, WguT, NT, 2 * DFF, 1024, 1024, 1024}; pg8::StaticOrder S; S.init(NT, 2 * DFF, G, bid); pg8::EpiSwiGLU E{ACTb, DFF};
        GEMM_PHASE(pg8::EpiSwiGLU, ldsb, g, S, E);
    }
    SEAM(11);
    if (IN(13)) { pg8::Gemm g{ACTb, WdT, NP, 1024, DFF, DFF, DFF}; pg8::StaticOrder S; S.init(NP, 1024, G, bid); pg8::EpiF32S E{FO, 1024, 0, 0};
        GEMM_PHASE(pg8::EpiF32S, ldsb, g, S, E);
        __syncthreads();
        { pg8::Gemm g2{ACTb, WdT, NT, 1024, 256, DFF, DFF, 256}; pg8::SplitOrder SS{11, bid}; pg8::EpiPart E2{PART}; GEMM_SPLIT(ldsb, g2, SS, E2); } }
    SEAM(13);
    if (IN(14)) {
        f32x4 gp[4], a[4], b[4];
#pragma unroll
        for (int j = 0; j < 4; ++j) gp[j] = *(const f32x4*)(g_ffn_post + 4 * lane + 256 * j);
#define P14_LOAD(r_, A_, B_) do { _Pragma("unroll") for (int j_ = 0; j_ < 4; ++j_) { B_[j_] = *(const f32x4*)(H + (size_t)(r_) * DM + 4 * lane + 256 * j_); \
            if ((r_) < NP) A_[j_] = *(const f32x4*)(FO + (size_t)(r_) * DM + 4 * lane + 256 * j_); \
            else { const float* p_ = PART + (size_t)((r_) - NP) * DM + 4 * lane + 256 * j_; f32x4 a_ = *(const f32x4*)p_; \
                _Pragma("unroll") for (int k_ = 1; k_ < 11; ++k_) a_ += *(const f32x4*)(p_ + (size_t)k_ * 512 * 1024); A_[j_] = a_; } } } while (0)
        int row = gw;
        if (row < NT) P14_LOAD(row, a, b);
        for (; row < NT; row += NGW) {
            f32x4 an[4], bn[4]; const int nr = row + NGW;
            if (nr < NT) P14_LOAD(nr, an, bn);
            float ss = 0.f;
#pragma unroll
            for (int j = 0; j < 4; ++j) ss += a[j][0] * a[j][0] + a[j][1] * a[j][1] + a[j][2] * a[j][2] + a[j][3] * a[j][3];
            const float r = rsqrtf(wave_sum(ss) * (1.f / DM) + EPS);
            float* y = row < NP ? out + O_YP + (size_t)row * DM : out + O_YS + (size_t)(row - NP) * DM;
#pragma unroll
            for (int j = 0; j < 4; ++j) *(f32x4*)(y + 4 * lane + 256 * j) = b[j] + a[j] * r * gp[j];
#pragma unroll
            for (int j = 0; j < 4; ++j) { a[j] = an[j]; b[j] = bn[j]; }
        }
#undef P14_LOAD
    }
#undef IN
#undef SEAM
}
constexpr int N_PHASES = 15;
}

extern "C" void kernel_launch(void* const* d_in, const int* in_sizes, int n_in, void* d_out, int out_size, void* d_ws, size_t ws_size, hipStream_t stream) {
    static int grid = 0;
    if (grid == 0) {
        if (n_in != 29 || (size_t)out_size != O_END || ws_size < WS_END) { fprintf(stderr, "kernel_launch: unexpected shapes: n_in %d out %d ws %zu (need %zu)\n", n_in, out_size, ws_size, (size_t)WS_END); grid = -1; return; }
        int dev = 0, cus = 0, per_cu = 0;
        if (hipGetDevice(&dev) != hipSuccess || hipDeviceGetAttribute(&cus, hipDeviceAttributeMultiprocessorCount, dev) != hipSuccess) { grid = -1; return; }
        if (hipFuncSetAttribute((const void*)fwd_kernel, hipFuncAttributeMaxDynamicSharedMemorySize, LDS_BYTES) != hipSuccess) { fprintf(stderr, "kernel_launch: hipFuncSetAttribute failed\n"); grid = -1; return; }
        if (hipOccupancyMaxActiveBlocksPerMultiprocessor(&per_cu, (const void*)fwd_kernel, NTHREADS, LDS_BYTES) != hipSuccess || per_cu < 1) { fprintf(stderr, "kernel_launch: occupancy query says %d\n", per_cu); per_cu = 1; }
        (void)hipGetLastError();
        grid = cus;
    }
    if (grid < 0) return;
    (void)hipMemsetAsync((char*)d_ws + WS_CTL, 0, CTL_BYTES, stream);
    Args a{};
    for (int i = 0; i < 29; ++i) a.in[i] = (const float*)d_in[i];
    a.out = (float*)d_out; a.ws = (unsigned char*)d_ws;
#if MK_ONE_LAUNCH
    a.ph_lo = 0; a.ph_hi = N_PHASES; a.sub = 0xff;
    hipLaunchKernelGGL(fwd_kernel, dim3(grid), dim3(NTHREADS), LDS_BYTES, stream, a);
#if PROBE_DUP >= 0
    a.ph_lo = PROBE_DUP; a.ph_hi = PROBE_DUP + 1; a.sub = PROBE_SUB;
    hipLaunchKernelGGL(fwd_kernel, dim3(grid), dim3(NTHREADS), LDS_BYTES, stream, a);
#endif
#else
    a.sub = 0xff; for (int p = 0; p < N_PHASES; ++p) { a.ph_lo = p; a.ph_hi = p + 1; hipLaunchKernelGGL(fwd_kernel, dim3(grid), dim3(NTHREADS), LDS_BYTES, stream, a); }
#endif
}
```

```cpp
#include <hip/hip_runtime.h>
#include <cstdio>
#include <cstdint>

#ifndef PROBE_DUP
#define PROBE_DUP -1
#endif
#ifndef PROBE_SUB
#define PROBE_SUB 0xff
#endif
#ifndef MK_ONE_LAUNCH
#define MK_ONE_LAUNCH 1
#endif

#define LAS __attribute__((address_space(3)))
#define GAS __attribute__((address_space(1)))
#define DI __device__ __forceinline__
typedef float f32x4 __attribute__((ext_vector_type(4)));
typedef __bf16 bf16x2_t __attribute__((ext_vector_type(2)));
typedef float f32x2_t __attribute__((ext_vector_type(2)));
DI unsigned cvtpk(float lo, float hi) { f32x2_t v = {lo, hi}; bf16x2_t b = __builtin_convertvector(v, bf16x2_t); return __builtin_bit_cast(unsigned, b); }

namespace {
constexpr int DM = 1024, NB = 8, SEQ = 2048, NP = NB * SEQ, DB = 128, DS = 4, NS = DB * DS, NT = NP + NS;
constexpr int PAST = 8192, PAGE = 128, NPAGES = PAST / PAGE;
constexpr int RH = 4, RDK = 128, RDV = 256;
constexpr int MH = 8, QL = 384, KVL = 256, DNOPE = 128, DROPE = 64, DVH = 128, DQH = DNOPE + DROPE;
constexpr int NMEM = 256, XH = 4, XHD = 64;
constexpr int DFF = 2816, DIN = 7104, ZLD = 7168;
constexpr int C_RQ = 0, C_RK = 512, C_RV = 1024, C_RG = 2048, C_CQ = 3072, C_CKV = 3456, C_KPE = 3712, C_XQ = 3776, C_G = 4032;
constexpr float EPS = 1e-6f;
constexpr int NPOS = SEQ + DS;
constexpr int NTHREADS = 512, NWAVES = 8;
constexpr int LDS_BYTES = 147456;
constexpr int MISC_OFF = 147456 - 256;

constexpr size_t O_YP = 0, O_YS = O_YP + (size_t)NP * DM, O_CKVP = O_YS + (size_t)NS * DM, O_KPEP = O_CKVP + (size_t)NP * KVL,
                 O_CKVS = O_KPEP + (size_t)NP * DROPE, O_KPES = O_CKVS + (size_t)NS * KVL, O_RETP = O_KPES + (size_t)NS * DROPE,
                 O_RETS = O_RETP + (size_t)NB * RH * RDK * RDV, O_MKP = O_RETS + (size_t)DB * RH * RDK * RDV, O_MVP = O_MKP + (size_t)NB * NMEM * 256,
                 O_END = O_MVP + (size_t)NB * NMEM * 256;

constexpr size_t al256(size_t x) { return (x + 255) & ~(size_t)255; }
constexpr size_t WS_CTL = 0, CTL_BYTES = 1u << 20;
constexpr size_t WS_COSA = WS_CTL + CTL_BYTES;
constexpr size_t WS_SINA = WS_COSA + al256((size_t)NPOS * 64 * 4);
constexpr size_t WS_COSB = WS_SINA + al256((size_t)NPOS * 64 * 4);
constexpr size_t WS_SINB = WS_COSB + al256((size_t)NPOS * 32 * 4);
constexpr size_t WS_U = WS_SINB + al256((size_t)NPOS * 32 * 4);
constexpr size_t WS_MN = WS_U + (size_t)NT * DM * 4;
constexpr size_t WS_Z = WS_MN + (size_t)NB * NMEM * DM * 4;
constexpr size_t WS_RQ = WS_Z + (size_t)NT * ZLD * 4;
constexpr size_t WS_RK = WS_RQ + (size_t)NT * 512 * 4;
constexpr size_t WS_CQN = WS_RK + (size_t)NT * 512 * 4;
constexpr size_t WS_CKVN = WS_CQN + (size_t)NT * QL * 4;
constexpr size_t WS_KPER = WS_CKVN + (size_t)NT * KVL * 4;
constexpr size_t WS_Q = WS_KPER + (size_t)NT * DROPE * 4;
constexpr size_t WS_QLAT = WS_Q + (size_t)NT * 1536 * 4;
constexpr size_t WS_QPE = WS_QLAT + (size_t)NT * 2048 * 4;
constexpr size_t WS_ORET = WS_QPE + (size_t)NT * 512 * 4;
constexpr size_t WS_OLAT = WS_ORET + (size_t)NT * 1024 * 4;
constexpr size_t WS_OX = WS_OLAT + (size_t)NT * 2048 * 4;
constexpr size_t WS_OMLA = WS_OX + (size_t)NT * 256 * 4;
constexpr size_t WS_ORETN = WS_OMLA + (size_t)NT * 1024 * 4;
constexpr size_t WS_ARET = WS_ORETN + (size_t)NT * 1024 * 4;
constexpr size_t WS_AMLA = WS_ARET + (size_t)NT * 1024 * 4;
constexpr size_t WS_AX = WS_AMLA + (size_t)NT * 1024 * 4;
constexpr size_t WS_MIX = WS_AX + (size_t)NT * 1024 * 4;
constexpr size_t WS_HP = WS_MIX + (size_t)NT * 1024 * 4;
constexpr size_t WS_H = WS_HP + (size_t)NT * 1024 * 4;
constexpr size_t WS_F = WS_H + (size_t)NT * 1024 * 4;
constexpr size_t WS_GG = WS_F + (size_t)NT * 1024 * 4;
constexpr size_t WS_UP = WS_GG + (size_t)NT * DFF * 4;
constexpr size_t WS_ACT = WS_UP + (size_t)NT * DFF * 4;
constexpr size_t WS_FO = WS_ACT + (size_t)NT * DFF * 4;
constexpr size_t WS_F32_END = WS_FO + (size_t)NT * 1024 * 4;
constexpr size_t WS_WIN_T = al256(WS_F32_END);
constexpr size_t WS_WMKV_T = WS_WIN_T + (size_t)ZLD * 1024 * 2;
constexpr size_t WS_WUQ_T = WS_WMKV_T + (size_t)512 * 1024 * 2;
constexpr size_t WS_WRO_T = WS_WUQ_T + (size_t)1536 * 384 * 2;
constexpr size_t WS_WMO_T = WS_WRO_T + (size_t)1024 * 1024 * 2;
constexpr size_t WS_WXO_T = WS_WMO_T + (size_t)1024 * 1024 * 2;
constexpr size_t WS_WO_T = WS_WXO_T + (size_t)1024 * 256 * 2;
constexpr size_t WS_WGU_T = WS_WO_T + (size_t)1024 * 1024 * 2;
constexpr size_t WS_WD_T = WS_WGU_T + (size_t)5632 * 1024 * 2;
constexpr size_t WS_UB = WS_WD_T + (size_t)1024 * 2816 * 2;
constexpr size_t WS_MNB = WS_UB + (size_t)NT * 1024 * 2;
constexpr size_t WS_CQNB = WS_MNB + (size_t)2048 * 1024 * 2;
constexpr size_t WS_ORETNB = WS_CQNB + (size_t)NT * 384 * 2;
constexpr size_t WS_OMLAB = WS_ORETNB + (size_t)NT * 1024 * 2;
constexpr size_t WS_OXB = WS_OMLAB + (size_t)NT * 1024 * 2;
constexpr size_t WS_MIXB = WS_OXB + (size_t)NT * 256 * 2;
constexpr size_t WS_FB = WS_MIXB + (size_t)NT * 1024 * 2;
constexpr size_t WS_ACTB = WS_FB + (size_t)NT * 1024 * 2;
constexpr size_t WS_WUK_T = WS_ACTB + (size_t)NT * 2816 * 2;
constexpr size_t WS_WUV_T = WS_WUK_T + (size_t)1024 * 256 * 2;
constexpr size_t WS_CKVNB = WS_WUV_T + (size_t)1024 * 256 * 2;
constexpr size_t WS_KPERB = WS_CKVNB + (size_t)NT * 256 * 2;
constexpr size_t WS_XQB = WS_KPERB + (size_t)NT * 64 * 2;
constexpr size_t WS_MKB = WS_XQB + (size_t)NT * 256 * 2;
constexpr size_t WS_MVT = WS_MKB + (size_t)2048 * 256 * 2;
constexpr size_t WS_KN = WS_MVT + (size_t)2048 * 256 * 2;
constexpr size_t WS_VT = WS_KN + (size_t)NP * 1024 * 2;
constexpr size_t WS_QB = WS_VT + (size_t)NP * 1024 * 2;
constexpr size_t WS_RQT = WS_QB + (size_t)NT * 1536 * 2;
constexpr size_t WS_RKT = WS_RQT + (size_t)NP * 512 * 2;
constexpr size_t WS_RKTT = WS_RKT + (size_t)NP * 512 * 2;
constexpr size_t WS_RVT = WS_RKTT + (size_t)NP * 512 * 2;
constexpr size_t WS_UT = WS_RVT + (size_t)NT * 1024 * 2;
constexpr size_t WS_SPT = WS_UT + (size_t)512 * 32768 * 4;
constexpr size_t WS_QLATB = WS_SPT + (size_t)512 * 32768 * 2;
constexpr size_t WS_PO = WS_QLATB + (size_t)NS * 2048 * 2;
constexpr size_t WS_PML = WS_PO + (size_t)DB * 2 * 32 * 256 * 4;
constexpr size_t WS_PART = al256(WS_PML + (size_t)DB * 2 * 32 * 2 * 4);
constexpr size_t WS_QPEB_ = WS_PART + (size_t)11 * 512 * 1024 * 4;
constexpr size_t WS_QPEB = al256(WS_QPEB_ + 0 * WS_PML + (size_t)DB * 2 * 32 * 2 * 4);
constexpr size_t WS_SGB = WS_QPEB + (size_t)NT * 512 * 2;
constexpr size_t WS_SRGB = WS_SGB + (size_t)NT * 3072 * 2;
constexpr size_t WS_T0B = WS_SRGB + (size_t)NT * 1024 * 2;
constexpr size_t WS_T1B = WS_T0B + (size_t)NT * 1024 * 2;
constexpr size_t WS_WUKB = WS_T1B + (size_t)NT * 1024 * 2;
constexpr size_t WS_END = WS_WUKB + (size_t)8 * 256 * 128 * 2;

constexpr int CW_BAR = 4096;

#define XB_TMO      128
#define XB_XCNT(j)  (256  + 64 * (j))
#define XB_XSUB(j)  (1280 + 64 * (j))
#define XB_XGEN(j)  (2304 + 64 * (j))
#define XB_TOP      3328
#define XB_TOPGEN   3392
#define XCD_BAR_WORDS 3456
#define XB_SPIN_CAP (1u << 25)

DI unsigned xb_ld(unsigned* p)              { return __hip_atomic_load(p, __ATOMIC_RELAXED, __HIP_MEMORY_SCOPE_AGENT); }
DI unsigned xb_add(unsigned* p, unsigned v) { return __hip_atomic_fetch_add(p, v, __ATOMIC_RELAXED, __HIP_MEMORY_SCOPE_AGENT); }
DI unsigned xb_xcc_id() { return (unsigned)__builtin_amdgcn_s_getreg((3 << 11) | 20) & 0xFu; }
#define XB_SPIN(cond, bar) do { unsigned _sp = 0; while (cond) { __builtin_amdgcn_s_sleep(1); \
    if ((++_sp & 255u) == 0u) { if (xb_ld(&(bar)[XB_TMO])) break; if (_sp > XB_SPIN_CAP) { atomicAdd(&(bar)[XB_TMO], 1u); break; } } } } while (0)

struct XcdBarrier { unsigned* bar; unsigned x; volatile LAS unsigned* st; };

DI XcdBarrier xcd_barrier_post(unsigned* bar, volatile LAS unsigned* st) {
    XcdBarrier b; b.bar = bar; b.x = xb_xcc_id(); b.st = st;
    if (threadIdx.x == 0) (void)xb_add(&bar[XB_XCNT(b.x)], 1u);
    return b;
}
DI void xcd_barrier_complete(unsigned* bar, unsigned x, unsigned& nloc, unsigned& nx) {
    const unsigned G = gridDim.x * gridDim.y * gridDim.z;
    unsigned sum, cnt, mine, sp = 0u;
    for (;;) {
        sum = 0u; cnt = 0u; mine = 0u;
#pragma unroll
        for (unsigned j = 0; j < 16; ++j) { const unsigned c = xb_ld(&bar[XB_XCNT(j)]); sum += c; cnt += (c > 0u) ? 1u : 0u; mine = (j == x) ? c : mine; }
        if (sum == G) break;
        __builtin_amdgcn_s_sleep(1);
        if ((++sp & 255u) == 0u) { if (xb_ld(&bar[XB_TMO])) break; if (sp > XB_SPIN_CAP) { atomicAdd(&bar[XB_TMO], 1u); break; } }
    }
    nloc = mine > 0u ? mine : 1u; nx = cnt > 0u ? cnt : 1u;
}
DI void xcd_barrier(const XcdBarrier& b) {
    asm volatile("s_waitcnt vmcnt(0)" ::: "memory");
    __syncthreads();
    if (threadIdx.x == 0) {
        unsigned* bar = b.bar;
        __builtin_amdgcn_s_waitcnt(0);
        unsigned nloc = b.st[0], nx = b.st[1];
        if (nloc == 0u) { xcd_barrier_complete(bar, b.x, nloc, nx); b.st[0] = nloc; b.st[1] = nx; }
        const unsigned old = xb_add(&bar[XB_XSUB(b.x)], 1u);
        const unsigned gen = old / nloc;
        if (old + 1u == (gen + 1u) * nloc) {
            __builtin_amdgcn_fence(__ATOMIC_RELEASE, "agent");
            asm volatile("s_waitcnt vmcnt(0)" ::: "memory");
            const unsigned og = xb_add(&bar[XB_TOP], 1u);
            const unsigned tg = og / nx;
            if (og + 1u == (tg + 1u) * nx) xb_add(&bar[XB_TOPGEN], 1u);
            else XB_SPIN(xb_ld(&bar[XB_TOPGEN]) == tg, bar);
            __builtin_amdgcn_fence(__ATOMIC_ACQUIRE, "agent");
            xb_add(&bar[XB_XGEN(b.x)], 1u);
            asm volatile("s_waitcnt vmcnt(0)" ::: "memory");
        } else {
            XB_SPIN(xb_ld(&bar[XB_XGEN(b.x)]) == gen, bar);
            __builtin_amdgcn_fence(__ATOMIC_ACQUIRE, "agent");
            asm volatile("s_waitcnt vmcnt(0)" ::: "memory");
        }
    }
    __syncthreads();
}

DI float wave_sum(float v) {
#pragma unroll
    for (int o = 1; o < 64; o <<= 1) v += __shfl_xor(v, o);
    return v;
}
DI float wave_max(float v) {
#pragma unroll
    for (int o = 1; o < 64; o <<= 1) v = fmaxf(v, __shfl_xor(v, o));
    return v;
}
DI float sigmoidf_(float x) { return 1.f / (1.f + expf(-x)); }
DI float siluf_(float x) { return x / (1.f + expf(-x)); }
DI int pos_index(int row) { return row < NP ? (row & (SEQ - 1)) : SEQ + ((row - NP) & (DS - 1)); }
DI float lg_gamma(int h) { return h == 0 ? -0.03174869831458027f : h == 1 ? -0.015748356968139112f : h == 2 ? -0.007843177461025892f : -0.003913899321136329f; }


namespace pg8 {
typedef unsigned short bf16_t;
typedef short bf16x8 __attribute__((ext_vector_type(8)));
typedef unsigned u32x4 __attribute__((ext_vector_type(4)));
typedef unsigned u32x2 __attribute__((ext_vector_type(2)));
constexpr int BM = 256, BK = 64, HALF = 128, HTB = HALF * BK * 2, STAGE_BYTES = 8 * HTB, NXCD = 8, WGM = 8;
__host__ __device__ __forceinline__ int lds_byte(int r, int c) { const int st = (r >> 4) * 2 + (c >> 5), rr = r & 15, cc = c & 31, ob = rr * 64 + cc * 2; return st * 1024 + (ob ^ (((ob >> 9) & 1) << 5)); }
__host__ __device__ __forceinline__ void stage_rc(int b, int& R, int& C) { const int st = b / 1024, sb = b % 1024, swz = sb ^ (((sb >> 9) & 1) << 5); R = (st >> 1) * 16 + swz / 64; C = (st & 1) * 32 + (swz % 64) / 2; }
__host__ __device__ __forceinline__ int perm32(int rho) { const int n = rho >> 4, i = rho & 15; return 8 * (i >> 2) + 4 * n + (i & 3); }
struct Unit { int pm, pn, ks; };
struct Gemm { const bf16_t* A; const bf16_t* Bt; int M, N, K, lda, ldb, ksl; };
struct StaticOrder {
    int nM, nN, nwg, G, c;
    __host__ __device__ void init(int M, int N, int G_, int c_) { nM = M / BM; nN = N / BM; nwg = nM * nN; G = G_; c = c_; }
    __host__ __device__ bool next(int i, Unit& u) const {
        const long L = (long)i * G + c; if (L >= nwg) return false;
        int wgid = (int)L; { const int q = nwg / NXCD, r = nwg % NXCD, xcd = wgid % NXCD, off = wgid / NXCD; wgid = (xcd < r ? xcd * (q + 1) : r * (q + 1) + (xcd - r) * q) + off; }
        const int nig = WGM * nN, gid = wgid / nig, fm = gid * WGM, gsz = (nM - fm) < WGM ? (nM - fm) : WGM;
        u.pm = fm + ((wgid % nig) % gsz); u.pn = (wgid % nig) / gsz; u.ks = 0; return true;
    }
    __device__ __forceinline__ void a_ready(const Unit&) const {}
    __device__ __forceinline__ void done(const Unit&) const {}
};
__device__ __forceinline__ unsigned cvt_pk_bf16(float lo, float hi) { return cvtpk(lo, hi); }
struct SplitOrder {
    int KS, c;
    __host__ __device__ bool next(int i, Unit& u) const { if (i != 0 || c >= 8 * KS) return false; const int tile = c / KS; u.ks = c % KS; u.pm = 64 + (tile >> 2); u.pn = tile & 3; return true; }
    __device__ __forceinline__ void a_ready(const Unit&) const {}
    __device__ __forceinline__ void done(const Unit&) const {}
};
struct EpiPart {
    static constexpr bool PERM = false, AFTER_DRAIN = false;
    float* C;
    __device__ __forceinline__ void operator()(const f32x4 (&acc)[2][2][4][2], const Unit& u, int wr, int wc, int fr, int fq) const {
        const int row0 = (u.pm - 64) * BM + wr * 64 + fr, col0 = u.pn * BM + wc * 32 + 4 * fq; float* base = C + (size_t)u.ks * (512 * 1024);
#pragma unroll
        for (int ai = 0; ai < 2; ++ai)
#pragma unroll
            for (int m = 0; m < 4; ++m) { float* rowp = base + (size_t)(row0 + ai * HALF + m * 16) * 1024 + col0;
#pragma unroll
                for (int bj = 0; bj < 2; ++bj)
#pragma unroll
                    for (int n = 0; n < 2; ++n) *(f32x4*)(rowp + bj * HALF + n * 16) = acc[ai][bj][m][n]; }
    }
};
struct P1Order {
    StaticOrder so;
    __host__ __device__ void init(int G_, int c_) { so.init(64 * 256, 24 * 256, G_, c_); }
    __host__ __device__ bool next(int i, Unit& u) const {
        const long L = (long)i * so.G + so.c;
        if (L < 1536) { so.next(i, u); if (u.pn >= 4) u.pn += 4; return true; }
        u.ks = 0;
        if (L < 1536 + 56) { const int idx = (int)L - 1536; u.pm = 64 + idx / 28; u.pn = idx % 28; return true; }
        if (L < 1536 + 56 + 16) { const int idx = (int)L - 1592; u.pm = 66 + idx / 2; u.pn = 28 + idx % 2; return true; }
        return false;
    }
    __device__ __forceinline__ void a_ready(const Unit&) const {}
    __device__ __forceinline__ void done(const Unit&) const {}
};
struct EpiP1 {
    static constexpr bool PERM = true, AFTER_DRAIN = false;
    bf16_t* Zp; int ldz; float* mk; float* mv; bf16_t* srg; bf16_t* sg; int c_rg, c_g;
    __device__ __forceinline__ void operator()(const f32x4 (&acc)[2][2][4][2], const Unit& u, int wr, int wc, int fr, int fq) const {
        if (u.pm >= 66) {
            float* base = (u.pn == 28) ? mk : mv; const int row0 = (u.pm - 66) * BM + wr * 64 + fr, col0 = wc * 32 + 8 * fq;
#pragma unroll
            for (int ai = 0; ai < 2; ++ai)
#pragma unroll
                for (int m = 0; m < 4; ++m) { float* rowp = base + (size_t)(row0 + ai * HALF + m * 16) * 256 + col0;
#pragma unroll
                    for (int bj = 0; bj < 2; ++bj) { *(f32x4*)(rowp + bj * HALF) = acc[ai][bj][m][0]; *(f32x4*)(rowp + bj * HALF + 4) = acc[ai][bj][m][1]; } }
            return;
        }
        const int row0 = u.pm * BM + wr * 64 + fr, col0 = u.pn * BM + wc * 32 + 8 * fq;
#pragma unroll
        for (int bj = 0; bj < 2; ++bj) { const int c = col0 + bj * HALF;
            if (c >= c_g + 3072) continue;
            const int kind = c >= c_g ? 2 : (c >= c_rg && c < c_rg + 1024) ? 1 : 0;
            bf16_t* dst = kind == 2 ? sg + (c - c_g) : kind == 1 ? srg + (c - c_rg) : Zp + c; const int ld = kind == 2 ? 3072 : kind == 1 ? 1024 : ldz;
#pragma unroll
            for (int ai = 0; ai < 2; ++ai)
#pragma unroll
                for (int m = 0; m < 4; ++m) { f32x4 v0 = acc[ai][bj][m][0], v1 = acc[ai][bj][m][1];
                    if (kind) {
#pragma unroll
                        for (int e = 0; e < 4; ++e) { const float s0 = 1.f / (1.f + __expf(-v0[e])), s1 = 1.f / (1.f + __expf(-v1[e])); v0[e] = kind == 2 ? s0 : v0[e] * s0; v1[e] = kind == 2 ? s1 : v1[e] * s1; } }
                    u32x4 w; w.x = cvt_pk_bf16(v0[0], v0[1]); w.y = cvt_pk_bf16(v0[2], v0[3]); w.z = cvt_pk_bf16(v1[0], v1[1]); w.w = cvt_pk_bf16(v1[2], v1[3]);
                    *(u32x4*)(dst + (size_t)(row0 + ai * HALF + m * 16) * ld) = w; } }
    }
};
struct EpiF32S {
    static constexpr bool PERM = false, AFTER_DRAIN = false;
    float* C; int ldc; int split_tiles; size_t split_stride;
    __device__ __forceinline__ void operator()(const f32x4 (&acc)[2][2][4][2], const Unit& u, int wr, int wc, int fr, int fq) const {
        int pn = u.pn; float* base = C; if (split_tiles) { const int t = pn / split_tiles; base += (size_t)t * split_stride; pn -= t * split_tiles; }
        const int row0 = u.pm * BM + wr * 64 + fr, col0 = pn * BM + wc * 32 + 4 * fq;
#pragma unroll
        for (int ai = 0; ai < 2; ++ai)
#pragma unroll
            for (int m = 0; m < 4; ++m) { float* rowp = base + (size_t)(row0 + ai * HALF + m * 16) * ldc + col0;
#pragma unroll
                for (int bj = 0; bj < 2; ++bj)
#pragma unroll
                    for (int n = 0; n < 2; ++n) *(f32x4*)(rowp + bj * HALF + n * 16) = acc[ai][bj][m][n]; }
    }
};
struct EpiBf16S {
    static constexpr bool PERM = true, AFTER_DRAIN = false;
    bf16_t* O; int ldc;
    __device__ __forceinline__ void operator()(const f32x4 (&acc)[2][2][4][2], const Unit& u, int wr, int wc, int fr, int fq) const {
        const int row0 = u.pm * BM + wr * 64 + fr, col0 = u.pn * BM + wc * 32 + 8 * fq;
#pragma unroll
        for (int ai = 0; ai < 2; ++ai)
#pragma unroll
            for (int m = 0; m < 4; ++m) { bf16_t* rowp = O + (size_t)(row0 + ai * HALF + m * 16) * ldc + col0;
#pragma unroll
                for (int bj = 0; bj < 2; ++bj) { const f32x4 v0 = acc[ai][bj][m][0], v1 = acc[ai][bj][m][1];
                    u32x4 w; w.x = cvt_pk_bf16(v0[0], v0[1]); w.y = cvt_pk_bf16(v0[2], v0[3]); w.z = cvt_pk_bf16(v1[0], v1[1]); w.w = cvt_pk_bf16(v1[2], v1[3]);
                    *(u32x4*)(rowp + bj * HALF) = w; } }
    }
};
struct EpiSwiGLU {
    static constexpr bool PERM = true, AFTER_DRAIN = false;
    bf16_t* O; int ldc;
    __device__ __forceinline__ void operator()(const f32x4 (&acc)[2][2][4][2], const Unit& u, int wr, int wc, int fr, int fq) const {
        const int row0 = u.pm * BM + wr * 64 + fr, col0 = u.pn * (BM / 2) + wc * 16 + 4 * fq;
#pragma unroll
        for (int ai = 0; ai < 2; ++ai)
#pragma unroll
            for (int m = 0; m < 4; ++m) { bf16_t* rowp = O + (size_t)(row0 + ai * HALF + m * 16) * ldc + col0;
#pragma unroll
                for (int bj = 0; bj < 2; ++bj) { const f32x4 v0 = acc[ai][bj][m][0], v1 = acc[ai][bj][m][1];
                    const float a0 = v0[0] / (1.f + __expf(-v0[0])) * v0[1], a1 = v0[2] / (1.f + __expf(-v0[2])) * v0[3];
                    const float a2 = v1[0] / (1.f + __expf(-v1[0])) * v1[1], a3 = v1[2] / (1.f + __expf(-v1[2])) * v1[3];
                    u32x2 w; w.x = cvt_pk_bf16(a0, a1); w.y = cvt_pk_bf16(a2, a3);
                    *(u32x2*)(rowp + bj * (HALF / 2)) = w; } }
    }
};
template <int MODE  > struct EpiGate {
    static constexpr bool PERM = true, AFTER_DRAIN = false;
    const bf16_t* sg; const bf16_t* tin; bf16_t* tout; int ldc;
    __device__ __forceinline__ void operator()(const f32x4 (&acc)[2][2][4][2], const Unit& u, int wr, int wc, int fr, int fq) const {
        const int row0 = u.pm * BM + wr * 64 + fr, col0 = u.pn * BM + wc * 32 + 8 * fq;
#pragma unroll
        for (int ai = 0; ai < 2; ++ai)
#pragma unroll
            for (int m = 0; m < 4; ++m) { const size_t r = (size_t)(row0 + ai * HALF + m * 16);
#pragma unroll
                for (int bj = 0; bj < 2; ++bj) { const int c = col0 + bj * HALF;
                    const u32x4 gq = *(const u32x4*)(sg + r * 3072 + c); u32x4 tq = {0u, 0u, 0u, 0u}; if (MODE >= 1) tq = *(const u32x4*)(tin + r * ldc + c);
                    const f32x4 v0 = acc[ai][bj][m][0], v1 = acc[ai][bj][m][1]; u32x4 w;
#define EG_ONE(dst, x0, x1, gw_, tw_) { float a_ = (x0) * __builtin_bit_cast(float, (gw_) << 16), b_ = (x1) * __builtin_bit_cast(float, (gw_) & 0xffff0000u); \
                        if (MODE >= 1) { a_ += __builtin_bit_cast(float, (tw_) << 16); b_ += __builtin_bit_cast(float, (tw_) & 0xffff0000u); } dst = cvt_pk_bf16(a_, b_); }
                    EG_ONE(w.x, v0[0], v0[1], gq.x, tq.x) EG_ONE(w.y, v0[2], v0[3], gq.y, tq.y) EG_ONE(w.z, v1[0], v1[1], gq.z, tq.z) EG_ONE(w.w, v1[2], v1[3], gq.w, tq.w)
#undef EG_ONE
                    *(u32x4*)(tout + r * ldc + c) = w; } }
    }
};
template <class Epi, class Sched, bool ALIGN_EPI = false, bool SP2 = false>
__device__ __forceinline__ void gemm_phase(LAS unsigned char* lds, const Gemm g, const Sched& S, const Epi& E) {
    const int tid = threadIdx.x, wid = __builtin_amdgcn_readfirstlane(tid >> 6), lane = tid & 63, wr = wid >> 2, wc = wid & 3, fr = lane & 15, fq = lane >> 4;
    const int K = g.K, nt = K / BK;
    unsigned voffA[2], voffB[2];
#pragma unroll
    for (int i = 0; i < 2; ++i) { int R, C; stage_rc(tid * 16 + i * 8192, R, C); const int Rb = Epi::PERM ? ((R & ~31) + perm32(R & 31)) : R;
        voffA[i] = (unsigned)(R * g.lda + C) * 2u; voffB[i] = (unsigned)(Rb * g.ldb + C) * 2u; }
    const size_t kstep = (size_t)(BK * 2);
    const size_t hstepA = (size_t)HALF * g.lda * 2, hstepB = (size_t)HALF * g.ldb * 2;
    const size_t tstepA = 2 * hstepA, tstepB = 2 * hstepB;
    const unsigned ldsw = (unsigned)wid * 1024u;
    const int aoff = lds_byte(wr * 64 + fr, fq * 8), boff = lds_byte(wc * 32 + fr, fq * 8);
#define PG8_SA(b, h) (((b) * 2 + (h)) * HTB)
#define PG8_SB(b, h) ((4 + (b) * 2 + (h)) * HTB)
#define PG8_STAGE(bufoff, gbase, voff) do { _Pragma("unroll") for (int _i = 0; _i < 2; ++_i) \
        __builtin_amdgcn_global_load_lds((const unsigned*)((const char*)(gbase) + (voff)[_i]), (LAS unsigned*)(lds + (bufoff) + ldsw + _i * 8192), 16, 0, 0); } while (0)
#define PG8_LDA(dst, b, h) do { _Pragma("unroll") for (int m = 0; m < 4; ++m) _Pragma("unroll") for (int k = 0; k < 2; ++k) dst[m][k] = *(const LAS bf16x8*)(lds + PG8_SA(b, h) + aoff + m * 2048 + k * 1024); } while (0)
#define PG8_LDB(dst, b, h) do { _Pragma("unroll") for (int n = 0; n < 2; ++n) _Pragma("unroll") for (int k = 0; k < 2; ++k) dst[n][k] = *(const LAS bf16x8*)(lds + PG8_SB(b, h) + boff + n * 2048 + k * 1024); } while (0)
#define PG8_MMA(ai, bj, At, Bt) do { __builtin_amdgcn_s_setprio(1); _Pragma("unroll") for (int m = 0; m < 4; ++m) _Pragma("unroll") for (int n = 0; n < 2; ++n) _Pragma("unroll") for (int k = 0; k < 2; ++k) \
        acc[ai][bj][m][n] = __builtin_amdgcn_mfma_f32_16x16x32_bf16(Bt[n][k], At[m][k], acc[ai][bj][m][n], 0, 0, 0); __builtin_amdgcn_s_setprio(0); } while (0)
#define PG8_WAIT_V(n) asm volatile("s_waitcnt vmcnt(" #n ")" ::: "memory")
#define PG8_WAIT_L(n) asm volatile("s_waitcnt lgkmcnt(" #n ")" ::: "memory")
#define PG8_BAR __builtin_amdgcn_s_barrier()
#define PG8_SCHED __builtin_amdgcn_sched_barrier(0)
    Unit cur, nxt; int ui = 0;
    if (!S.next(0, cur)) return;
    f32x4 acc[2][2][4][2];
#pragma unroll
    for (int a = 0; a < 2; ++a)
#pragma unroll
        for (int b = 0; b < 2; ++b)
#pragma unroll
            for (int m = 0; m < 4; ++m)
#pragma unroll
                for (int n = 0; n < 2; ++n) acc[a][b][m][n] = (f32x4){0.f, 0.f, 0.f, 0.f};
    bf16x8 At[4][2], B0[2][2], B1[2][2];
    const size_t kslb = (size_t)g.ksl * 2;
    const char* cA = (const char*)g.A + (size_t)cur.pm * tstepA + cur.ks * kslb; const char* cB = (const char*)g.Bt + (size_t)cur.pn * tstepB + cur.ks * kslb;
    S.a_ready(cur);
    if constexpr (SP2) {
        PG8_STAGE(PG8_SB(0, 0), cB, voffB); PG8_STAGE(PG8_SB(0, 1), cB + hstepB, voffB); PG8_STAGE(PG8_SA(0, 0), cA, voffA); PG8_STAGE(PG8_SA(0, 1), cA + hstepA, voffA);
        if (wr == 1) PG8_BAR;
        PG8_WAIT_V(2); PG8_BAR;
        PG8_STAGE(PG8_SB(1, 0), cB + kstep, voffB); PG8_STAGE(PG8_SA(1, 0), cA + kstep, voffA); PG8_STAGE(PG8_SB(1, 1), cB + hstepB + kstep, voffB);
        PG8_WAIT_V(6); PG8_BAR;
    } else {
        PG8_STAGE(PG8_SB(0, 0), cB, voffB); PG8_STAGE(PG8_SA(0, 0), cA, voffA); PG8_STAGE(PG8_SB(0, 1), cB + hstepB, voffB); PG8_STAGE(PG8_SA(0, 1), cA + hstepA, voffA);
        if (wr == 1) PG8_BAR;
        PG8_WAIT_V(4); PG8_BAR;
        PG8_STAGE(PG8_SB(1, 0), cB + kstep, voffB); PG8_STAGE(PG8_SA(1, 0), cA + kstep, voffA); PG8_STAGE(PG8_SB(1, 1), cB + hstepB + kstep, voffB);
        PG8_WAIT_V(6); PG8_BAR;
    }
    for (;;) {
        const bool has_next = S.next(ui + 1, nxt);
        const char* nA = has_next ? (const char*)g.A + (size_t)nxt.pm * tstepA + nxt.ks * kslb : cA; const char* nB = has_next ? (const char*)g.Bt + (size_t)nxt.pn * tstepB + nxt.ks * kslb : cB;
#pragma unroll 1
        for (int t = 0; t < nt; t += 2) {
            const bool last = (t == nt - 2);
            const char* a1 = cA + (size_t)(t + 1) * kstep;
            const char* a2 = last ? nA : cA + (size_t)(t + 2) * kstep; const char* b2 = last ? nB : cB + (size_t)(t + 2) * kstep;
            const char* a3 = a2 + kstep; const char* b3 = b2 + kstep;
            if (last && has_next) S.a_ready(nxt);
            if constexpr (SP2) {
            PG8_LDB(B0, 0, 0); PG8_LDB(B1, 0, 1); PG8_SCHED; PG8_LDA(At, 0, 0); PG8_STAGE(PG8_SA(1, 1), a1 + hstepA, voffA);
            PG8_WAIT_V(8); PG8_WAIT_L(0); PG8_BAR; PG8_MMA(0, 0, At, B0); PG8_MMA(0, 1, At, B1); PG8_BAR; PG8_SCHED;
            PG8_LDA(At, 0, 1); PG8_STAGE(PG8_SB(0, 0), b2, voffB); PG8_STAGE(PG8_SB(0, 1), b2 + hstepB, voffB); PG8_STAGE(PG8_SA(0, 0), a2, voffA);
            PG8_WAIT_V(8); PG8_WAIT_L(0); PG8_BAR; PG8_MMA(1, 0, At, B0); PG8_MMA(1, 1, At, B1); PG8_BAR; PG8_SCHED;
            PG8_LDB(B0, 1, 0); PG8_LDB(B1, 1, 1); PG8_SCHED; PG8_LDA(At, 1, 0); PG8_STAGE(PG8_SA(0, 1), a2 + hstepA, voffA);
            PG8_WAIT_V(8); PG8_WAIT_L(0); PG8_BAR; PG8_MMA(0, 0, At, B0); PG8_MMA(0, 1, At, B1); PG8_BAR; PG8_SCHED;
            PG8_LDA(At, 1, 1); PG8_STAGE(PG8_SB(1, 0), b3, voffB); PG8_STAGE(PG8_SB(1, 1), b3 + hstepB, voffB); PG8_STAGE(PG8_SA(1, 0), a3, voffA);
            PG8_WAIT_V(8); PG8_WAIT_L(0); PG8_BAR; PG8_MMA(1, 0, At, B0); PG8_MMA(1, 1, At, B1); PG8_BAR; PG8_SCHED;
            } else {
            PG8_LDB(B0, 0, 0); PG8_SCHED; PG8_LDA(At, 0, 0); PG8_STAGE(PG8_SA(1, 1), a1 + hstepA, voffA);
            PG8_WAIT_L(8); PG8_BAR; PG8_WAIT_L(0); PG8_MMA(0, 0, At, B0); PG8_BAR; PG8_SCHED;
            PG8_LDB(B1, 0, 1); PG8_STAGE(PG8_SB(0, 0), b2, voffB);
            PG8_BAR; PG8_WAIT_L(0); PG8_MMA(0, 1, At, B1); PG8_BAR;
            PG8_LDA(At, 0, 1); PG8_STAGE(PG8_SA(0, 0), a2, voffA);
            PG8_BAR; PG8_WAIT_L(0); PG8_MMA(1, 0, At, B0); PG8_BAR; PG8_SCHED;
            PG8_STAGE(PG8_SB(0, 1), b2 + hstepB, voffB);
            PG8_WAIT_V(6); PG8_BAR; PG8_MMA(1, 1, At, B1); PG8_BAR;
            PG8_LDB(B0, 1, 0); PG8_SCHED; PG8_LDA(At, 1, 0); PG8_STAGE(PG8_SA(0, 1), a2 + hstepA, voffA);
            PG8_WAIT_L(8); PG8_BAR; PG8_WAIT_L(0); PG8_MMA(0, 0, At, B0); PG8_BAR; PG8_SCHED;
            PG8_LDB(B1, 1, 1); PG8_STAGE(PG8_SB(1, 0), b3, voffB);
            PG8_BAR; PG8_WAIT_L(0); PG8_MMA(0, 1, At, B1); PG8_BAR;
            PG8_LDA(At, 1, 1); PG8_STAGE(PG8_SA(1, 0), a3, voffA);
            PG8_BAR; PG8_WAIT_L(0); PG8_MMA(1, 0, At, B0); PG8_BAR; PG8_SCHED;
            PG8_STAGE(PG8_SB(1, 1), b3 + hstepB, voffB);
            PG8_WAIT_V(6); PG8_BAR; PG8_MMA(1, 1, At, B1); PG8_BAR;
            }
        }
        if constexpr (ALIGN_EPI) { if (wr == 0) PG8_BAR; }
        if constexpr (!Epi::AFTER_DRAIN) { E(acc, cur, wr, wc, fr, fq); S.done(cur); }
        if (!has_next) break;
#pragma unroll
        for (int a = 0; a < 2; ++a)
#pragma unroll
            for (int b = 0; b < 2; ++b)
#pragma unroll
                for (int m = 0; m < 4; ++m)
#pragma unroll
                    for (int n = 0; n < 2; ++n) acc[a][b][m][n] = (f32x4){0.f, 0.f, 0.f, 0.f};
        cur = nxt; cA = nA; cB = nB; ++ui;
        if constexpr (ALIGN_EPI) { if (wr == 1) PG8_BAR; }
    }
    PG8_WAIT_V(0);
    if constexpr (!ALIGN_EPI) { if (wr == 0) PG8_BAR; }
    PG8_BAR;
    if constexpr (Epi::AFTER_DRAIN) { E.fused(acc, cur, wr, wc, fr, fq, lds, wid, lane); S.done(cur); }
#undef PG8_SA
#undef PG8_SB
#undef PG8_STAGE
#undef PG8_LDA
#undef PG8_LDB
#undef PG8_MMA
#undef PG8_WAIT_V
#undef PG8_WAIT_L
#undef PG8_BAR
#undef PG8_SCHED
}
}
typedef unsigned short bf16_t;
DI unsigned pk2(float lo, float hi) { return pg8::cvt_pk_bf16(lo, hi); }
DI bf16_t f2bf(float f) { return (bf16_t)(pg8::cvt_pk_bf16(f, 0.f) & 0xffffu); }
DI void transpose_item(const float* W, int N, bf16_t* WT, int ldt, int row_off, int rmul, LAS float* scr, int item, int lane) {
    const int nblk = N / 32, kb = item / nblk, nb = item % nblk, k0 = 64 * kb, n0 = 32 * nb;
#pragma unroll 8
    for (int i = 0; i < 32; ++i) { const int kk = 2 * i + (lane >> 5); scr[kk * 33 + (lane & 31)] = W[(size_t)(k0 + kk) * N + n0 + (lane & 31)]; }
    asm volatile("s_waitcnt lgkmcnt(0)" ::: "memory");
    const int c = lane & 7;
#pragma unroll
    for (int j = 0; j < 4; ++j) { const int n = (lane >> 3) + 8 * j; const LAS float* sp = scr + (8 * c) * 33 + n;
        pg8::u32x4 o; o.x = pk2(sp[0 * 33], sp[1 * 33]); o.y = pk2(sp[2 * 33], sp[3 * 33]); o.z = pk2(sp[4 * 33], sp[5 * 33]); o.w = pk2(sp[6 * 33], sp[7 * 33]);
        *(pg8::u32x4*)(WT + (size_t)(row_off + rmul * (n0 + n)) * ldt + k0 + 8 * c) = o; }
    asm volatile("s_waitcnt lgkmcnt(0)" ::: "memory");
}
DI void transpose_w(const float* W, int K, int N, bf16_t* WT, int ldt, int row_off, LAS float* scr, int gw, int NGW, int lane, int& rot, int rmul = 1) {
    const int nitems = (K / 64) * (N / 32);
    int first = gw - (rot % NGW); if (first < 0) first += NGW;
    for (int it = first; it < nitems; it += NGW) transpose_item(W, N, WT, ldt, row_off, rmul, scr, it, lane);
    rot += nitems;
}

struct Args {
    const float* in[29]; float* out; unsigned char* ws; int ph_lo, ph_hi, sub, pad;
};

DI unsigned short f2bf_raw(float f) { unsigned u = __builtin_bit_cast(unsigned, f); return (unsigned short)((u + 0x7fffu + ((u >> 16) & 1u)) >> 16); }
DI void sgemm_naive(LAS float* lds, const float* __restrict__ A, int lda, const float* __restrict__ B, long sbk, long sbn,
                    float* __restrict__ C, int ldc, int M, int N, int K, int bid, int G, unsigned short* Cb = nullptr) {
    LAS float* As = lds;
    LAS float* Bs = lds + 16 * 132;
    const int tid = threadIdx.x, tx = tid & 15, ty = tid >> 4;
    const int ntn = N / 64, ntiles = (M / 128) * ntn;
    for (int t = bid; t < ntiles; t += G) {
        const int m0 = (t / ntn) * 128, n0 = (t % ntn) * 64;
        float acc[4][4];
#pragma unroll
        for (int i = 0; i < 4; ++i)
#pragma unroll
            for (int j = 0; j < 4; ++j) acc[i][j] = 0.f;
        for (int k0 = 0; k0 < K; k0 += 16) {
            {
                const int r = tid >> 2, kq = (tid & 3) * 4;
                const float4 v = *(const float4*)(A + (size_t)(m0 + r) * lda + k0 + kq);
                As[(kq + 0) * 132 + r] = v.x; As[(kq + 1) * 132 + r] = v.y; As[(kq + 2) * 132 + r] = v.z; As[(kq + 3) * 132 + r] = v.w;
            }
#pragma unroll
            for (int i = 0; i < 2; ++i) {
                const int idx = tid + i * 512, kk = idx >> 6, nn = idx & 63;
                Bs[kk * 64 + nn] = B[(size_t)(k0 + kk) * sbk + (size_t)(n0 + nn) * sbn];
            }
            __syncthreads();
#pragma unroll
            for (int kk = 0; kk < 16; ++kk) {
                const f32x4 a = *(const LAS f32x4*)(As + kk * 132 + ty * 4);
                const f32x4 b = *(const LAS f32x4*)(Bs + kk * 64 + tx * 4);
                const float av[4] = {a.x, a.y, a.z, a.w}, bv[4] = {b.x, b.y, b.z, b.w};
#pragma unroll
                for (int i = 0; i < 4; ++i)
#pragma unroll
                    for (int j = 0; j < 4; ++j) acc[i][j] += av[i] * bv[j];
            }
            __syncthreads();
        }
#pragma unroll
        for (int i = 0; i < 4; ++i) {
            float4 o; o.x = acc[i][0]; o.y = acc[i][1]; o.z = acc[i][2]; o.w = acc[i][3];
            if (Cb) { unsigned short* cb = Cb + (size_t)(m0 + ty * 4 + i) * ldc + n0 + tx * 4; cb[0] = f2bf_raw(o.x); cb[1] = f2bf_raw(o.y); cb[2] = f2bf_raw(o.z); cb[3] = f2bf_raw(o.w); }
            else *(float4*)(C + (size_t)(m0 + ty * 4 + i) * ldc + n0 + tx * 4) = o;
        }
    }
}

template <int DQK, int DV, bool V_IN_K, int MODE, class KV, class QF>
DI void attn_naive(LAS float* lds, const KV& kv, int nk_loop, const QF& qf, bool active, int limit, float scale, float lg, int tq, float* optr) {
    constexpr int KS = DQK + 1;
    constexpr int VS = V_IN_K ? KS : DV;
    LAS float* Ks = lds;
    LAS float* Vs = V_IN_K ? Ks : (lds + 64 * KS);
    LAS float* qs = lds + 64 * KS + (V_IN_K ? 0 : 64 * DV);
    LAS float* ps = qs + 8 * DQK;
    static_assert((64 * KS + (V_IN_K ? 0 : 64 * DV) + 8 * DQK + 8 * 64) * 4 <= MISC_OFF, "attn_naive LDS");
    const int tid = threadIdx.x, lane = tid & 63, w = tid >> 6;
    __syncthreads();
    for (int d = lane; d < DQK; d += 64) qs[w * DQK + d] = active ? qf(d) : 0.f;
    float m = -INFINITY, l = 0.f;
    float acc[DV / 64];
#pragma unroll
    for (int c = 0; c < DV / 64; ++c) acc[c] = 0.f;
    for (int base = 0; base < nk_loop; base += 64) {
        __syncthreads();
        for (int idx = tid; idx < 64 * DQK; idx += NTHREADS) { const int j = idx / DQK, d = idx - j * DQK, key = base + j; Ks[j * KS + d] = key < nk_loop ? kv.k(key, d) : 0.f; }
        if (!V_IN_K) for (int idx = tid; idx < 64 * DV; idx += NTHREADS) { const int j = idx / DV, e = idx - j * DV, key = base + j; Vs[j * DV + e] = key < nk_loop ? kv.v(key, e) : 0.f; }
        __syncthreads();
        const int key = base + lane; const bool valid = active && key <= limit && key < nk_loop;
        float s = 0.f;
        for (int d = 0; d < DQK; ++d) s += qs[w * DQK + d] * Ks[lane * KS + d];
        float p;
        if (MODE == 0) {
            s *= scale;
            const float cm = wave_max(valid ? s : -INFINITY);
            const float mn = fmaxf(m, cm);
            const float alpha = (mn == -INFINITY) ? 1.f : expf(m - mn);
            p = valid ? expf(s - mn) : 0.f;
            l = l * alpha + wave_sum(p);
#pragma unroll
            for (int c = 0; c < DV / 64; ++c) acc[c] *= alpha;
            m = mn;
        } else {
            p = valid ? s * expf((float)(tq - key) * lg) : 0.f;
        }
        ps[w * 64 + lane] = p;
        __syncthreads();
        for (int j = 0; j < 64; ++j) { const float pj = ps[w * 64 + j];
#pragma unroll
            for (int c = 0; c < DV / 64; ++c) acc[c] += pj * Vs[j * VS + lane + 64 * c]; }
    }
    if (active) {
#pragma unroll
        for (int c = 0; c < DV / 64; ++c) optr[lane + 64 * c] = (MODE == 0) ? acc[c] / l : acc[c];
    }
}

struct KvMlaPrompt { const float* ckvn; const float* kper; int b;
    DI float k(int key, int d) const { const size_t row = (size_t)b * SEQ + key; return d < KVL ? ckvn[row * KVL + d] : kper[row * DROPE + (d - KVL)]; }
    DI float v(int, int) const { return 0.f; } };
struct KvMlaSample { const float* ckvn; const float* kper; const float* cckv; const float* ckpe; const int* pt; int b;
    DI float k(int key, int d) const {
        if (key < PAST) { const size_t r = (size_t)pt[b * NPAGES + (key >> 7)] * PAGE + (key & (PAGE - 1)); return d < KVL ? cckv[r * KVL + d] : ckpe[r * DROPE + (d - KVL)]; }
        const size_t row = (size_t)NP + b * DS + (key - PAST); return d < KVL ? ckvn[row * KVL + d] : kper[row * DROPE + (d - KVL)]; }
    DI float v(int, int) const { return 0.f; } };
struct KvRet { const float* rk; const float* z; int b, h;
    DI float k(int key, int d) const { return rk[((size_t)b * SEQ + key) * 512 + h * RDK + d]; }
    DI float v(int key, int e) const { return z[((size_t)b * SEQ + key) * ZLD + C_RV + h * RDV + e]; } };
struct KvMem { const float* mk; const float* mv; int b, h;
    DI float k(int key, int d) const { return mk[(((size_t)b * NMEM + key) * XH + h) * XHD + d]; }
    DI float v(int key, int e) const { return mv[(((size_t)b * NMEM + key) * XH + h) * XHD + e]; } };


typedef float f32x16 __attribute__((ext_vector_type(16)));
typedef short bf16x8 __attribute__((ext_vector_type(8)));
typedef short s16x4 __attribute__((ext_vector_type(4)));
typedef unsigned u32x4_t __attribute__((ext_vector_type(4)));
typedef unsigned u32x2_t __attribute__((ext_vector_type(2)));
DI int crow(int i, int h) { return (i & 3) + 8 * (i >> 2) + 4 * h; }
#define MFMA32(a, b, c) __builtin_amdgcn_mfma_f32_32x32x16_bf16((a), (b), (c), 0, 0, 0)
template <int DQK, int DV, bool CAUSAL, class Src>
DI void flash_unit(LAS unsigned char* lds, const Src& src, int qpos0, int ntiles, bf16_t* O, int ldo, float c2) {
    constexpr int KP = DQK + 8, VP = 68, KS = DQK / 16, NBLK = DV / 32;
    constexpr int KBYTES = 64 * KP * 2, VBYTES = DV * VP * 2, BUF = KBYTES + VBYTES;
    constexpr int D8 = DQK / 8, NPK = (64 * D8) / NTHREADS, NPV = (DV * 8) / NTHREADS;
    static_assert((64 * D8) % NTHREADS == 0 && (DV * 8) % NTHREADS == 0 && 2 * BUF <= 131072, "flash_unit geometry");
    const int tid = threadIdx.x, lane = tid & 63, w = __builtin_amdgcn_readfirstlane(tid >> 6), l31 = lane & 31, h = lane >> 5;
    bf16x8 qf[KS];
#pragma unroll
    for (int s_ = 0; s_ < KS; ++s_) qf[s_] = src.qfrag(32 * w + l31, s_, h);
    f32x16 o[NBLK];
#pragma unroll
    for (int b = 0; b < NBLK; ++b)
#pragma unroll
        for (int i = 0; i < 16; ++i) o[b][i] = 0.f;
    float m = -INFINITY, lsum = 0.f;
    u32x4_t kreg[NPK], vreg[NPV];
#define FL_LOAD(t_) do { _Pragma("unroll") for (int i_ = 0; i_ < NPK; ++i_) { const int p_ = tid + i_ * NTHREADS; kreg[i_] = src.kpiece(64 * (t_) + p_ / D8, p_ % D8); } \
                         _Pragma("unroll") for (int i_ = 0; i_ < NPV; ++i_) { const int p_ = tid + i_ * NTHREADS; vreg[i_] = src.vpiece(p_ >> 3, 64 * (t_) + 8 * (p_ & 7)); } } while (0)
#define FL_STORE(buf_) do { _Pragma("unroll") for (int i_ = 0; i_ < NPK; ++i_) { const int p_ = tid + i_ * NTHREADS; *(LAS u32x4_t*)(lds + (buf_) * BUF + ((p_ / D8) * KP + (p_ % D8) * 8) * 2) = kreg[i_]; } \
                          _Pragma("unroll") for (int i_ = 0; i_ < NPV; ++i_) { const int p_ = tid + i_ * NTHREADS; LAS unsigned char* a_ = lds + (buf_) * BUF + KBYTES + ((p_ >> 3) * VP + (p_ & 7) * 8) * 2; \
                              *(LAS u32x2_t*)a_ = (u32x2_t){vreg[i_].x, vreg[i_].y}; *(LAS u32x2_t*)(a_ + 8) = (u32x2_t){vreg[i_].z, vreg[i_].w}; } } while (0)
    __syncthreads();
    FL_LOAD(0); FL_STORE(0);
    __syncthreads();
    const int qmine = qpos0 + 32 * w + l31, qlast = qpos0 + 32 * w + 31;
    for (int t = 0; t < ntiles; ++t) {
        const int buf = t & 1;
        if (t + 1 < ntiles) FL_LOAD(t + 1);
        if (!CAUSAL || 64 * t <= qlast) {
            const LAS unsigned char* kb_ = lds + buf * BUF; const LAS unsigned char* vb_ = kb_ + KBYTES;
            f32x16 st[2];
#pragma unroll
            for (int kb = 0; kb < 2; ++kb) {
#pragma unroll
                for (int i = 0; i < 16; ++i) st[kb][i] = 0.f;
#pragma unroll
                for (int g_ = 0; g_ < KS / 4; ++g_) { bf16x8 kf[4];
#pragma unroll
                    for (int j = 0; j < 4; ++j) kf[j] = *(const LAS bf16x8*)(kb_ + ((32 * kb + l31) * KP + 16 * (4 * g_ + j) + 8 * h) * 2);
#pragma unroll
                    for (int j = 0; j < 4; ++j) st[kb] = MFMA32(kf[j], qf[4 * g_ + j], st[kb]);
                    __builtin_amdgcn_sched_barrier(0); }
            }
            if (CAUSAL && 64 * t + 63 > qpos0 + 32 * w) {
#pragma unroll
                for (int kb = 0; kb < 2; ++kb)
#pragma unroll
                    for (int i = 0; i < 16; ++i) { const int key = 64 * t + 32 * kb + crow(i, h); st[kb][i] = key <= qmine ? st[kb][i] : -INFINITY; }
            }
            float mx = -INFINITY;
#pragma unroll
            for (int kb = 0; kb < 2; ++kb)
#pragma unroll
                for (int i = 0; i < 16; ++i) mx = fmaxf(mx, st[kb][i]);
            mx = fmaxf(mx, __shfl_xor(mx, 32));
            const float mn = fmaxf(m, mx);
            { const float alpha = __builtin_amdgcn_exp2f((m - mn) * c2);
                lsum *= alpha;
#pragma unroll
                for (int b = 0; b < NBLK; ++b)
#pragma unroll
                    for (int i = 0; i < 16; ++i) o[b][i] *= alpha;
                m = mn;
            }
            const float nmc = -mn * c2;
            float ps = 0.f;
#pragma unroll
            for (int kb = 0; kb < 2; ++kb)
#pragma unroll
                for (int i = 0; i < 16; ++i) { const float p = __builtin_amdgcn_exp2f(__builtin_fmaf(st[kb][i], c2, nmc)); st[kb][i] = p; ps += p; }
            lsum += ps;
            bf16x8 pf[4];
#pragma unroll
            for (int ks = 0; ks < 4; ++ks) { const int kb = ks >> 1, s2 = ks & 1; u32x4_t pk;
                pk.x = cvtpk(st[kb][8 * s2 + 0], st[kb][8 * s2 + 1]); pk.y = cvtpk(st[kb][8 * s2 + 2], st[kb][8 * s2 + 3]);
                pk.z = cvtpk(st[kb][8 * s2 + 4], st[kb][8 * s2 + 5]); pk.w = cvtpk(st[kb][8 * s2 + 6], st[kb][8 * s2 + 7]); pf[ks] = __builtin_bit_cast(bf16x8, pk); }
            __builtin_amdgcn_sched_barrier(0);
#pragma unroll
            for (int b = 0; b < NBLK; ++b) { bf16x8 vf[4];
#pragma unroll
                for (int ks = 0; ks < 4; ++ks) { const LAS unsigned char* a_ = vb_ + ((32 * b + l31) * VP + 16 * ks + 4 * h) * 2;
                    const s16x4 lo = *(const LAS s16x4*)a_, hi = *(const LAS s16x4*)(a_ + 16);
                    vf[ks] = __builtin_shufflevector(lo, hi, 0, 1, 2, 3, 4, 5, 6, 7); }
#pragma unroll
                for (int ks = 0; ks < 4; ++ks) o[b] = MFMA32(vf[ks], pf[ks], o[b]);
                __builtin_amdgcn_sched_barrier(0); }
        }
        if (t + 1 < ntiles) FL_STORE(buf ^ 1);
        __syncthreads();
    }
#undef FL_LOAD
#undef FL_STORE
    lsum += __shfl_xor(lsum, 32);
    const float inv = 1.f / lsum;
    bf16_t* orow = O + (size_t)(32 * w + l31) * ldo;
#pragma unroll
    for (int b = 0; b < NBLK; ++b)
#pragma unroll
        for (int g = 0; g < 4; ++g) { u32x2_t pk; pk.x = cvtpk(o[b][4 * g + 0] * inv, o[b][4 * g + 1] * inv); pk.y = cvtpk(o[b][4 * g + 2] * inv, o[b][4 * g + 3] * inv);
            *(u32x2_t*)(orow + 32 * b + 8 * g + 4 * h) = pk; }
}
struct SrcMlaP { const bf16_t* kn; const bf16_t* kpe; const bf16_t* vt; const bf16_t* qraw; const bf16_t* qpe; int b, hh; size_t row0;
    DI bf16x8 qfrag(int r, int s_, int h8) const { return s_ < 8 ? *(const bf16x8*)(qraw + (row0 + r) * 1536 + hh * DQH + 16 * s_ + 8 * h8) : *(const bf16x8*)(qpe + (row0 + r) * 512 + hh * DROPE + 16 * (s_ - 8) + 8 * h8); }
    DI u32x4_t kpiece(int key, int d8) const { const size_t row = (size_t)b * SEQ + key;
        return d8 < 16 ? *(const u32x4_t*)(kn + row * 1024 + hh * DNOPE + d8 * 8) : *(const u32x4_t*)(kpe + row * DROPE + (d8 - 16) * 8); }
    DI u32x4_t vpiece(int dv, int key0) const { return *(const u32x4_t*)(vt + (size_t)(hh * DVH + dv) * NP + (size_t)b * SEQ + key0); } };
struct SrcMemP { const bf16_t* mk; const bf16_t* mvt; const bf16_t* xq; int b, hh; size_t row0;
    DI bf16x8 qfrag(int r, int s_, int h8) const { return *(const bf16x8*)(xq + (row0 + r) * ZLD + hh * XHD + 16 * s_ + 8 * h8); }
    DI u32x4_t kpiece(int key, int d8) const { return *(const u32x4_t*)(mk + ((size_t)b * NMEM + key) * 256 + hh * XHD + d8 * 8); }
    DI u32x4_t vpiece(int dv, int key0) const { return *(const u32x4_t*)(mvt + (size_t)(hh * XHD + dv) * (NB * NMEM) + (size_t)b * NMEM + key0); } };


DI void ret_chunk_state(const bf16_t* __restrict__ RVT, const bf16_t* __restrict__ RKtT, float* __restrict__ UT, int b, int h, int c) {
    const int tid = threadIdx.x, lane = tid & 63, w = __builtin_amdgcn_readfirstlane(tid >> 6), l31 = lane & 31, hh = lane >> 5;
    const size_t tok0 = (size_t)b * SEQ + c * 128;
    f32x16 acc[4];
#pragma unroll
    for (int kb = 0; kb < 4; ++kb)
#pragma unroll
        for (int i = 0; i < 16; ++i) acc[kb][i] = 0.f;
    const bf16_t* ap = RVT + (size_t)(h * RDV + 32 * w + l31) * NT + tok0 + 8 * hh;
    const bf16_t* bp = RKtT + (size_t)(h * RDK + l31) * NP + tok0 + 8 * hh;
#pragma unroll
    for (int s_ = 0; s_ < 8; ++s_) { const bf16x8 a = *(const bf16x8*)(ap + 16 * s_);
#pragma unroll
        for (int kb = 0; kb < 4; ++kb) { const bf16x8 bfr = *(const bf16x8*)(bp + (size_t)(32 * kb) * NP + 16 * s_); acc[kb] = MFMA32(a, bfr, acc[kb]); } }
    float* u = UT + (size_t)(((b * RH + h) * 16) + c) * 32768;
#pragma unroll
    for (int kb = 0; kb < 4; ++kb)
#pragma unroll
        for (int i = 0; i < 16; ++i) u[(32 * w + crow(i, hh)) * RDK + 32 * kb + l31] = acc[kb][i];
}
DI void ret_chunk_out(const bf16_t* __restrict__ RQt, const bf16_t* __restrict__ RKt, const bf16_t* __restrict__ RVT, const bf16_t* __restrict__ SPT, float* __restrict__ ORET, int b, int h, int c) {
    const int tid = threadIdx.x, lane = tid & 63, w = __builtin_amdgcn_readfirstlane(tid >> 6), l31 = lane & 31, hh = lane >> 5;
    const int ib = w & 3, vh = w >> 2;
    const size_t tok0 = (size_t)b * SEQ + c * 128;
    bf16x8 qf[8];
    { const bf16_t* qp = RQt + (tok0 + 32 * ib + l31) * 512 + h * RDK + 8 * hh;
#pragma unroll
      for (int s_ = 0; s_ < 8; ++s_) qf[s_] = *(const bf16x8*)(qp + 16 * s_); }
    f32x16 o[4];
#pragma unroll
    for (int blk = 0; blk < 4; ++blk)
#pragma unroll
        for (int i = 0; i < 16; ++i) o[blk][i] = 0.f;
    const bf16_t* vbase = RVT + (size_t)(h * RDV + 32 * (4 * vh) + l31) * NT + tok0 + 4 * hh;
#pragma unroll 1
    for (int jb = 0; jb <= ib; ++jb) {
        f32x16 x;
#pragma unroll
        for (int i = 0; i < 16; ++i) x[i] = 0.f;
        const bf16_t* kp = RKt + (tok0 + 32 * jb + l31) * 512 + h * RDK + 8 * hh;
#pragma unroll
        for (int s_ = 0; s_ < 8; ++s_) { const bf16x8 kf = *(const bf16x8*)(kp + 16 * s_); x = MFMA32(kf, qf[s_], x); }
        if (jb == ib) {
#pragma unroll
            for (int i = 0; i < 16; ++i) x[i] = (crow(i, hh) <= l31) ? x[i] : 0.f;
        }
#pragma unroll
        for (int s2 = 0; s2 < 2; ++s2) {
            u32x4_t pk; pk.x = cvtpk(x[8 * s2 + 0], x[8 * s2 + 1]); pk.y = cvtpk(x[8 * s2 + 2], x[8 * s2 + 3]); pk.z = cvtpk(x[8 * s2 + 4], x[8 * s2 + 5]); pk.w = cvtpk(x[8 * s2 + 6], x[8 * s2 + 7]);
            const bf16x8 pa = __builtin_bit_cast(bf16x8, pk);
#pragma unroll
            for (int blk = 0; blk < 4; ++blk) { const bf16_t* vp = vbase + (size_t)(32 * blk) * NT + 32 * jb + 16 * s2;
                const s16x4 lo = *(const s16x4*)vp, hi = *(const s16x4*)(vp + 8);
                const bf16x8 vf = __builtin_shufflevector(lo, hi, 0, 1, 2, 3, 4, 5, 6, 7);
                o[blk] = MFMA32(pa, vf, o[blk]); }
        }
    }
    const bf16_t* sp = SPT + (size_t)(((b * RH + h) * 16) + c) * 32768 + (size_t)(32 * (4 * vh) + l31) * RDK + 8 * hh;
#pragma unroll
    for (int s_ = 0; s_ < 8; ++s_)
#pragma unroll
        for (int blk = 0; blk < 4; ++blk) { const bf16x8 sf = *(const bf16x8*)(sp + (size_t)(32 * blk) * RDK + 16 * s_); o[blk] = MFMA32(qf[s_], sf, o[blk]); }
#pragma unroll
    for (int blk = 0; blk < 4; ++blk)
#pragma unroll
        for (int i = 0; i < 16; ++i) ORET[(tok0 + 32 * ib + crow(i, hh)) * 1024 + h * RDV + 32 * (4 * vh + blk) + l31] = o[blk][i];
}


typedef short v4i16_t __attribute__((ext_vector_type(4)));
DI s16x4 vtr(const LAS unsigned char* p) { return __builtin_bit_cast(s16x4, __builtin_amdgcn_ds_read_tr16_b64_v4i16((LAS v4i16_t*)p)); }
constexpr int MS_NSPLIT = 2, MS_KEYS = PAST / MS_NSPLIT, MS_TILES = MS_KEYS / 64;
DI void mla_sample_unit(LAS unsigned char* lds, const float* __restrict__ cckv, const float* __restrict__ ckpe, const int* __restrict__ pt,
                        const bf16_t* __restrict__ QLATb, const bf16_t* __restrict__ QPEb, float* __restrict__ PO, float* __restrict__ PML, int b, int split, float c2) {
    constexpr int KP = 328, KBYTES = 64 * KP * 2;
    const int tid = threadIdx.x, lane = tid & 63, w = __builtin_amdgcn_readfirstlane(tid >> 6), l31 = lane & 31, hh = lane >> 5;
    bf16x8 qf[20];
    { const int t = l31 >> 3, head = l31 & 7;
      const bf16_t* ql = QLATb + (size_t)(b * DS + t) * 2048 + head * KVL + 8 * hh;
      const bf16_t* qp = QPEb + (size_t)(NP + b * DS + t) * 512 + head * DROPE + 8 * hh;
#pragma unroll
      for (int s_ = 0; s_ < 16; ++s_) qf[s_] = *(const bf16x8*)(ql + 16 * s_);
#pragma unroll
      for (int s_ = 0; s_ < 4; ++s_) qf[16 + s_] = *(const bf16x8*)(qp + 16 * s_); }
    f32x16 o;
#pragma unroll
    for (int i = 0; i < 16; ++i) o[i] = 0.f;
    float m = -INFINITY, lsum = 0.f;
    f32x4 cr[8], pr[2];
#define MS_LOAD(t_) do { const int key0_ = split * MS_KEYS + 64 * (t_); const size_t rowb_ = (size_t)pt[b * NPAGES + (key0_ >> 7)] * PAGE + (key0_ & (PAGE - 1)); \
        _Pragma("unroll") for (int i_ = 0; i_ < 8; ++i_) { const int pc_ = tid + i_ * NTHREADS; cr[i_] = __builtin_nontemporal_load((const f32x4*)(cckv + (rowb_ + (pc_ >> 6)) * KVL + 4 * (pc_ & 63))); } \
        _Pragma("unroll") for (int i_ = 0; i_ < 2; ++i_) { const int pc_ = tid + i_ * NTHREADS; pr[i_] = __builtin_nontemporal_load((const f32x4*)(ckpe + (rowb_ + (pc_ >> 4)) * DROPE + 4 * (pc_ & 15))); } } while (0)
#define MS_STORE(buf_) do { \
        _Pragma("unroll") for (int i_ = 0; i_ < 8; ++i_) { const int pc_ = tid + i_ * NTHREADS; *(LAS u32x2_t*)(lds + (buf_) * KBYTES + ((pc_ >> 6) * KP + 4 * (pc_ & 63)) * 2) = (u32x2_t){cvtpk(cr[i_][0], cr[i_][1]), cvtpk(cr[i_][2], cr[i_][3])}; } \
        _Pragma("unroll") for (int i_ = 0; i_ < 2; ++i_) { const int pc_ = tid + i_ * NTHREADS; *(LAS u32x2_t*)(lds + (buf_) * KBYTES + ((pc_ >> 4) * KP + KVL + 4 * (pc_ & 15)) * 2) = (u32x2_t){cvtpk(pr[i_][0], pr[i_][1]), cvtpk(pr[i_][2], pr[i_][3])}; } } while (0)
    __syncthreads();
    MS_LOAD(0); MS_STORE(0);
    __syncthreads();
    const int q4 = (lane & 15) >> 2, p4 = lane & 3, blk = (lane >> 4) & 1;
#pragma unroll 1
    for (int t = 0; t < MS_TILES; ++t) {
        const int buf = t & 1;
        if (t + 1 < MS_TILES) MS_LOAD(t + 1);
        const LAS unsigned char* kb_ = lds + buf * KBYTES;
        f32x16 st[2];
#pragma unroll
        for (int kb = 0; kb < 2; ++kb) {
#pragma unroll
            for (int i = 0; i < 16; ++i) st[kb][i] = 0.f;
#pragma unroll
            for (int g_ = 0; g_ < 5; ++g_) { bf16x8 kf[4];
#pragma unroll
                for (int j = 0; j < 4; ++j) kf[j] = *(const LAS bf16x8*)(kb_ + ((32 * kb + l31) * KP + 16 * (4 * g_ + j) + 8 * hh) * 2);
#pragma unroll
                for (int j = 0; j < 4; ++j) st[kb] = MFMA32(kf[j], qf[4 * g_ + j], st[kb]);
                __builtin_amdgcn_sched_barrier(0); }
        }
        float mx = -INFINITY;
#pragma unroll
        for (int kb = 0; kb < 2; ++kb)
#pragma unroll
            for (int i = 0; i < 16; ++i) mx = fmaxf(mx, st[kb][i]);
        mx = fmaxf(mx, __shfl_xor(mx, 32));
        const float mn = fmaxf(m, mx);
        if (__builtin_amdgcn_ballot_w64(mn > m) != 0ull) {
            const float alpha = __builtin_amdgcn_exp2f((m - mn) * c2);
            lsum *= alpha;
#pragma unroll
            for (int i = 0; i < 16; ++i) o[i] *= alpha;
            m = mn;
        }
        const float nmc = -mn * c2;
        float ps = 0.f;
#pragma unroll
        for (int kb = 0; kb < 2; ++kb)
#pragma unroll
            for (int i = 0; i < 16; ++i) { const float p = __builtin_amdgcn_exp2f(__builtin_fmaf(st[kb][i], c2, nmc)); st[kb][i] = p; ps += p; }
        lsum += ps;
        bf16x8 vf[4];
#pragma unroll
        for (int ks = 0; ks < 4; ++ks) { const LAS unsigned char* a_ = kb_ + ((16 * ks + 4 * hh + q4) * KP + 32 * w + 16 * blk + 4 * p4) * 2;
            const s16x4 lo = vtr(a_), hi = vtr(a_ + 8 * KP * 2);
            vf[ks] = __builtin_shufflevector(lo, hi, 0, 1, 2, 3, 4, 5, 6, 7); }
#pragma unroll
        for (int ks = 0; ks < 4; ++ks) { const int kb = ks >> 1, s2 = ks & 1; u32x4_t pk;
            pk.x = cvtpk(st[kb][8 * s2 + 0], st[kb][8 * s2 + 1]); pk.y = cvtpk(st[kb][8 * s2 + 2], st[kb][8 * s2 + 3]);
            pk.z = cvtpk(st[kb][8 * s2 + 4], st[kb][8 * s2 + 5]); pk.w = cvtpk(st[kb][8 * s2 + 6], st[kb][8 * s2 + 7]);
            o = MFMA32(vf[ks], __builtin_bit_cast(bf16x8, pk), o); }
        if (t + 1 < MS_TILES) MS_STORE(buf ^ 1);
        __syncthreads();
    }
#undef MS_LOAD
#undef MS_STORE
    lsum += __shfl_xor(lsum, 32);
    const int item = b * MS_NSPLIT + split;
    if (w == 0 && lane < 32) { PML[(item * 32 + lane) * 2] = m * c2; PML[(item * 32 + lane) * 2 + 1] = lsum; }
#pragma unroll
    for (int i = 0; i < 16; ++i) PO[((size_t)item * 32 + l31) * KVL + 32 * w + crow(i, hh)] = o[i];
}


struct RetItem { int b, h, c, vh; };
DI RetItem ret_item(int it) { RetItem r; r.vh = it & 1; r.c = (it >> 1) & 15; r.h = (it >> 5) & 3; r.b = it >> 7; return r; }
DI void ret_out_phase(LAS unsigned char* lds, const bf16_t* __restrict__ RQt, const bf16_t* __restrict__ RKt, const bf16_t* __restrict__ RVT, const bf16_t* __restrict__ SPT, float* __restrict__ ORET, int bid, int G) {
    constexpr int PITCH = 136, TILE = 128 * PITCH * 2;
    const int tid = threadIdx.x, lane = tid & 63, w = __builtin_amdgcn_readfirstlane(tid >> 6), l31 = lane & 31, hh = lane >> 5;
    const int ib = w & 3, dq = w >> 2;
    u32x4_t st[12];
#define RO_LOAD(it_) do { const RetItem q_ = ret_item(it_); const size_t tok0_ = (size_t)q_.b * SEQ + q_.c * 128; \
        _Pragma("unroll") for (int i_ = 0; i_ < 12; ++i_) { const int p_ = tid + i_ * NTHREADS, tl_ = p_ >> 11, row_ = (p_ >> 4) & 127, c16_ = p_ & 15; const bf16_t* src_; \
            if (tl_ == 0) src_ = RKt + (tok0_ + row_) * 512 + q_.h * RDK + 8 * c16_; \
            else if (tl_ == 1) src_ = RVT + (size_t)(q_.h * RDV + 128 * q_.vh + row_) * NT + tok0_ + 8 * c16_; \
            else src_ = SPT + (size_t)(((q_.b * RH + q_.h) * 16) + q_.c) * 32768 + (size_t)(128 * q_.vh + row_) * RDK + 8 * c16_; \
            st[i_] = *(const u32x4_t*)src_; } } while (0)
#define RO_STORE() do { _Pragma("unroll") for (int i_ = 0; i_ < 12; ++i_) { const int p_ = tid + i_ * NTHREADS, tl_ = p_ >> 11, row_ = (p_ >> 4) & 127, c16_ = p_ & 15; \
            *(LAS u32x4_t*)(lds + tl_ * TILE + (row_ * PITCH + 8 * c16_) * 2) = st[i_]; } } while (0)
    int it = bid;
    if (it < NB * RH * 16 * 2) RO_LOAD(it);
    for (; it < NB * RH * 16 * 2; it += G) {
        const RetItem q = ret_item(it); const size_t tok0 = (size_t)q.b * SEQ + q.c * 128;
        __syncthreads();
        RO_STORE();
        bf16x8 qf[8];
        { const bf16_t* qp = RQt + (tok0 + 32 * ib + l31) * 512 + q.h * RDK + 8 * hh;
#pragma unroll
          for (int s_ = 0; s_ < 8; ++s_) qf[s_] = *(const bf16x8*)(qp + 16 * s_); }
        __syncthreads();
        if (it + G < NB * RH * 16 * 2) RO_LOAD(it + G);
        const LAS unsigned char* Kl = lds; const LAS unsigned char* Vl = lds + TILE; const LAS unsigned char* Sl = lds + 2 * TILE;
        f32x16 o[2];
#pragma unroll
        for (int blk = 0; blk < 2; ++blk)
#pragma unroll
            for (int i = 0; i < 16; ++i) o[blk][i] = 0.f;
#pragma unroll 1
        for (int jb = 0; jb <= ib; ++jb) {
            f32x16 x;
#pragma unroll
            for (int i = 0; i < 16; ++i) x[i] = 0.f;
#pragma unroll
            for (int s_ = 0; s_ < 8; ++s_) { const bf16x8 kf = *(const LAS bf16x8*)(Kl + ((32 * jb + l31) * PITCH + 16 * s_ + 8 * hh) * 2); x = MFMA32(kf, qf[s_], x); }
            if (jb == ib) {
#pragma unroll
                for (int i = 0; i < 16; ++i) x[i] = (crow(i, hh) <= l31) ? x[i] : 0.f;
            }
#pragma unroll
            for (int s2 = 0; s2 < 2; ++s2) {
                u32x4_t pk; pk.x = cvtpk(x[8 * s2 + 0], x[8 * s2 + 1]); pk.y = cvtpk(x[8 * s2 + 2], x[8 * s2 + 3]); pk.z = cvtpk(x[8 * s2 + 4], x[8 * s2 + 5]); pk.w = cvtpk(x[8 * s2 + 6], x[8 * s2 + 7]);
                const bf16x8 pa = __builtin_bit_cast(bf16x8, pk);
#pragma unroll
                for (int blk = 0; blk < 2; ++blk) { const LAS unsigned char* vp = Vl + ((64 * dq + 32 * blk + l31) * PITCH + 32 * jb + 16 * s2 + 4 * hh) * 2;
                    const s16x4 lo = *(const LAS s16x4*)vp, hi = *(const LAS s16x4*)(vp + 16);
                    o[blk] = MFMA32(pa, __builtin_shufflevector(lo, hi, 0, 1, 2, 3, 4, 5, 6, 7), o[blk]); }
            }
        }
#pragma unroll
        for (int s_ = 0; s_ < 8; ++s_)
#pragma unroll
            for (int blk = 0; blk < 2; ++blk) { const bf16x8 sf = *(const LAS bf16x8*)(Sl + ((64 * dq + 32 * blk + l31) * PITCH + 16 * s_ + 8 * hh) * 2); o[blk] = MFMA32(qf[s_], sf, o[blk]); }
#pragma unroll
        for (int blk = 0; blk < 2; ++blk)
#pragma unroll
            for (int i = 0; i < 16; ++i) ORET[(tok0 + 32 * ib + crow(i, hh)) * 1024 + q.h * RDV + 128 * q.vh + 64 * dq + 32 * blk + l31] = o[blk][i];
    }
#undef RO_LOAD
#undef RO_STORE
}


DI void ret_state_phase(LAS unsigned char* lds, const bf16_t* __restrict__ RVT, const bf16_t* __restrict__ RKtT, float* __restrict__ UT, int bid, int G) {
    constexpr int PITCH = 136;
    const int tid = threadIdx.x, lane = tid & 63, w = __builtin_amdgcn_readfirstlane(tid >> 6), l31 = lane & 31, hh = lane >> 5;
    u32x4_t st[12];
#define RS_LOAD(it_) do { const int c_ = (it_) & 15, h_ = ((it_) >> 4) & 3, b_ = (it_) >> 6; const size_t tok0_ = (size_t)b_ * SEQ + c_ * 128; \
        _Pragma("unroll") for (int i_ = 0; i_ < 12; ++i_) { const int p_ = tid + i_ * NTHREADS, row_ = p_ >> 4, c16_ = p_ & 15; \
            const bf16_t* src_ = row_ < 256 ? RVT + (size_t)(h_ * RDV + row_) * NT + tok0_ + 8 * c16_ : RKtT + (size_t)(h_ * RDK + (row_ - 256)) * NP + tok0_ + 8 * c16_; \
            st[i_] = *(const u32x4_t*)src_; } } while (0)
    int it = bid;
    if (it < NB * RH * 16) RS_LOAD(it);
    for (; it < NB * RH * 16; it += G) {
        __syncthreads();
#pragma unroll
        for (int i = 0; i < 12; ++i) { const int p = tid + i * NTHREADS; *(LAS u32x4_t*)(lds + ((p >> 4) * PITCH + 8 * (p & 15)) * 2) = st[i]; }
        __syncthreads();
        if (it + G < NB * RH * 16) RS_LOAD(it + G);
        f32x16 acc[4];
#pragma unroll
        for (int kb = 0; kb < 4; ++kb)
#pragma unroll
            for (int i = 0; i < 16; ++i) acc[kb][i] = 0.f;
#pragma unroll
        for (int s_ = 0; s_ < 8; ++s_) { const bf16x8 a = *(const LAS bf16x8*)(lds + ((32 * w + l31) * PITCH + 16 * s_ + 8 * hh) * 2);
#pragma unroll
            for (int kb = 0; kb < 4; ++kb) { const bf16x8 b_ = *(const LAS bf16x8*)(lds + ((256 + 32 * kb + l31) * PITCH + 16 * s_ + 8 * hh) * 2); acc[kb] = MFMA32(a, b_, acc[kb]); } }
        float* u = UT + (size_t)it * 32768;
#pragma unroll
        for (int kb = 0; kb < 4; ++kb)
#pragma unroll
            for (int i = 0; i < 16; ++i) u[(32 * w + crow(i, hh)) * RDK + 32 * kb + l31] = acc[kb][i];
    }
#undef RS_LOAD
}

struct QPtr { const float* p; DI float operator()(int d) const { return p[d]; } };
struct QMla { const float* ql; const float* qp; DI float operator()(int d) const { return d < KVL ? ql[d] : qp[d - KVL]; } };
DI void rms_row(const float* x, const float* g, float* o, int n, int lane) {
    float s = 0.f;
    for (int i = lane; i < n; i += 64) { const float v = x[i]; s += v * v; }
    const float r = rsqrtf(wave_sum(s) / (float)n + EPS);
    for (int i = lane; i < n; i += 64) o[i] = x[i] * r * g[i];
}

DI void rms_row_bf16(const float* x, const float* g, bf16_t* o, int n, int lane) {
    float s = 0.f;
    for (int i = lane; i < n; i += 64) { const float v = x[i]; s += v * v; }
    const float r = rsqrtf(wave_sum(s) / (float)n + EPS);
    for (int i = lane; i < n; i += 64) o[i] = f2bf(x[i] * r * g[i]);
}
#define GEMM_PHASE(EPI, ...) pg8::gemm_phase<EPI, pg8::StaticOrder, true, true>(__VA_ARGS__)
#define GEMM_SPLIT(...) pg8::gemm_phase<pg8::EpiPart, pg8::SplitOrder, true, true>(__VA_ARGS__)
__global__ void __launch_bounds__(NTHREADS, 2) fwd_kernel(Args args) {
    extern __shared__ __attribute__((aligned(16))) unsigned char lds_raw[];
    LAS unsigned char* ldsb = (LAS unsigned char*)lds_raw;
    LAS float* lds = (LAS float*)ldsb;
    volatile LAS unsigned* MISC = (volatile LAS unsigned*)(ldsb + MISC_OFF);
    const int tid = threadIdx.x, lane = tid & 63, wave = tid >> 6;
    const int G = gridDim.x, bid = blockIdx.x;
    const int gw = bid * NWAVES + wave, NGW = G * NWAVES;
    unsigned char* ws = args.ws;
    float* out = args.out;
    const int lo = args.ph_lo, hi = args.ph_hi;

    if (tid < 64) MISC[tid] = 0u;
    __syncthreads();
    XcdBarrier bar; bar.bar = (unsigned*)(ws + WS_CTL) + CW_BAR; bar.x = 0; bar.st = MISC;
    if (hi - lo > 1) bar = xcd_barrier_post((unsigned*)(ws + WS_CTL) + CW_BAR, MISC);
#define IN(k) (lo <= (k) && (k) < hi)
#define SEAM(k) do { if (IN(k) && IN((k) + 1)) xcd_barrier(bar); } while (0)

    const float* x_prompt = args.in[0]; const float* x_sample = args.in[1]; const float* mem_prompt = args.in[2];
    const float* cache_ckv = args.in[3]; const float* cache_kpe = args.in[4]; const int* page_table = (const int*)args.in[5];
    const float* state_ret = args.in[6]; const float* cache_mem_k = args.in[7]; const float* cache_mem_v = args.in[8];
    const float* g_mix_pre = args.in[9]; const float* g_mix_post = args.in[10]; const float* g_ffn_pre = args.in[11]; const float* g_ffn_post = args.in[12];
    const float* g_mem = args.in[13]; const float* g_qlat = args.in[14]; const float* g_kvlat = args.in[15];
    const float* w_in = args.in[16]; const float* w_uq = args.in[17]; const float* w_uk = args.in[18]; const float* w_uv = args.in[19];
    const float* w_mem_k = args.in[20]; const float* w_mem_v = args.in[21]; const float* w_ret_o = args.in[22]; const float* w_mla_o = args.in[23];
    const float* w_x_o = args.in[24]; const float* w_out = args.in[25]; const float* w_gate = args.in[26]; const float* w_up = args.in[27]; const float* w_down = args.in[28];
    float* COSA = (float*)(ws + WS_COSA); float* SINA = (float*)(ws + WS_SINA); float* COSB = (float*)(ws + WS_COSB); float* SINB = (float*)(ws + WS_SINB);
    float* U = (float*)(ws + WS_U); float* MN = (float*)(ws + WS_MN); bf16_t* Zb = (bf16_t*)(ws + WS_Z);
    float* RQ = (float*)(ws + WS_RQ); float* RK = (float*)(ws + WS_RK); float* CQN = (float*)(ws + WS_CQN); float* CKVN = (float*)(ws + WS_CKVN); float* KPER = (float*)(ws + WS_KPER);
    float* Q = (float*)(ws + WS_Q); float* QLAT = (float*)(ws + WS_QLAT); float* QPE = (float*)(ws + WS_QPE);
    float* ORET = (float*)(ws + WS_ORET); float* OLAT = (float*)(ws + WS_OLAT); float* OX = (float*)(ws + WS_OX); float* OMLA = (float*)(ws + WS_OMLA); float* ORETN = (float*)(ws + WS_ORETN);
    float* ARET = (float*)(ws + WS_ARET); float* AMLA = (float*)(ws + WS_AMLA); float* AX = (float*)(ws + WS_AX); float* MIX = (float*)(ws + WS_MIX);
    float* HP = (float*)(ws + WS_HP); float* H = (float*)(ws + WS_H); float* F = (float*)(ws + WS_F);
    float* GU = (float*)(ws + WS_GG); float* FO = (float*)(ws + WS_FO);
    bf16_t* WinT = (bf16_t*)(ws + WS_WIN_T); bf16_t* WmkvT = (bf16_t*)(ws + WS_WMKV_T); bf16_t* WuqT = (bf16_t*)(ws + WS_WUQ_T); bf16_t* WroT = (bf16_t*)(ws + WS_WRO_T);
    bf16_t* WmoT = (bf16_t*)(ws + WS_WMO_T); bf16_t* WxoT = (bf16_t*)(ws + WS_WXO_T); bf16_t* WoT = (bf16_t*)(ws + WS_WO_T); bf16_t* WguT = (bf16_t*)(ws + WS_WGU_T); bf16_t* WdT = (bf16_t*)(ws + WS_WD_T);
    bf16_t* Ub = (bf16_t*)(ws + WS_UB); bf16_t* MNb = (bf16_t*)(ws + WS_MNB); bf16_t* CQNb = (bf16_t*)(ws + WS_CQNB); bf16_t* ORETNb = (bf16_t*)(ws + WS_ORETNB);
    bf16_t* OMLAb = (bf16_t*)(ws + WS_OMLAB); bf16_t* OXb = (bf16_t*)(ws + WS_OXB); bf16_t* MIXb = (bf16_t*)(ws + WS_MIXB); bf16_t* Fb = (bf16_t*)(ws + WS_FB); bf16_t* ACTb = (bf16_t*)(ws + WS_ACTB);
    bf16_t* WukT = (bf16_t*)(ws + WS_WUK_T); bf16_t* WuvT = (bf16_t*)(ws + WS_WUV_T); bf16_t* CKVNb = (bf16_t*)(ws + WS_CKVNB); bf16_t* KPERb = (bf16_t*)(ws + WS_KPERB);
    bf16_t* XQb = (bf16_t*)(ws + WS_XQB); bf16_t* MKb = (bf16_t*)(ws + WS_MKB); bf16_t* MVT = (bf16_t*)(ws + WS_MVT); bf16_t* KN = (bf16_t*)(ws + WS_KN); bf16_t* VT = (bf16_t*)(ws + WS_VT); bf16_t* Qb = (bf16_t*)(ws + WS_QB);
    bf16_t* RQt = (bf16_t*)(ws + WS_RQT); bf16_t* RKt = (bf16_t*)(ws + WS_RKT); bf16_t* RKtT = (bf16_t*)(ws + WS_RKTT); bf16_t* RVT = (bf16_t*)(ws + WS_RVT);
    float* UT = (float*)(ws + WS_UT); bf16_t* SPT = (bf16_t*)(ws + WS_SPT);
    bf16_t* QPEb = (bf16_t*)(ws + WS_QPEB); bf16_t* WukB = (bf16_t*)(ws + WS_WUKB); float* PART = (float*)(ws + WS_PART);
    bf16_t* SGb = (bf16_t*)(ws + WS_SGB); bf16_t* SRGb = (bf16_t*)(ws + WS_SRGB); bf16_t* T0b = (bf16_t*)(ws + WS_T0B); bf16_t* T1b = (bf16_t*)(ws + WS_T1B);
    bf16_t* QLATb = (bf16_t*)(ws + WS_QLATB); float* PO = (float*)(ws + WS_PO); float* PML = (float*)(ws + WS_PML);

    if (IN(0)) {
        for (int i = bid * NTHREADS + tid; i < NPOS * 64 + NPOS * 32; i += G * NTHREADS) {
            const bool a = i < NPOS * 64; const int j = a ? i : i - NPOS * 64; const int half = a ? 64 : 32;
            const int p = j / half, f = j % half; const int pos = p < SEQ ? p : PAST + (p - SEQ);
            const float inv = powf(10000.0f, -(float)f / (float)half);
            const float ang = (float)pos * inv;
            double rev = (double)ang * 0.15915494309189535; rev -= floor(rev);
            const float r = (float)rev;
            const float sn = __builtin_amdgcn_sinf(r), cs = __builtin_amdgcn_cosf(r);
            if (a) { COSA[j] = cs; SINA[j] = sn; } else { COSB[j] = cs; SINB[j] = sn; }
        }
#pragma unroll 1
        for (int pass = 0; pass < 2; ++pass) {
            const int nrows = pass ? NB * NMEM : NT; const float* gsrc = pass ? g_mem : g_mix_pre; bf16_t* dst = pass ? MNb : Ub;
            f32x4 a[4];
#define P0_SRC(r_) (pass ? mem_prompt + (size_t)(r_) * DM : (r_) < NP ? x_prompt + (size_t)(r_) * DM : x_sample + (size_t)((r_) - NP) * DM)
#define P0_LOAD(r_, A_) do { const float* s_ = P0_SRC(r_); _Pragma("unroll") for (int j_ = 0; j_ < 4; ++j_) A_[j_] = *(const f32x4*)(s_ + 4 * lane + 256 * j_); } while (0)
            int row = gw;
            if (row < nrows) P0_LOAD(row, a);
#pragma unroll 1
            for (; row < nrows; row += NGW) {
                f32x4 an[4]; const int nr = row + NGW;
                if (nr < nrows) P0_LOAD(nr, an);
                float ss = 0.f;
#pragma unroll
                for (int j = 0; j < 4; ++j) ss += a[j][0] * a[j][0] + a[j][1] * a[j][1] + a[j][2] * a[j][2] + a[j][3] * a[j][3];
                const float r = rsqrtf(wave_sum(ss) * (1.f / DM) + EPS);
#pragma unroll
                for (int j = 0; j < 4; ++j) { const f32x4 v = a[j] * r * *(const f32x4*)(gsrc + 4 * lane + 256 * j); *(u32x2_t*)(dst + (size_t)row * DM + 4 * lane + 256 * j) = (u32x2_t){cvtpk(v[0], v[1]), cvtpk(v[2], v[3])}; }
#pragma unroll
                for (int j = 0; j < 4; ++j) a[j] = an[j];
            }
#undef P0_LOAD
#undef P0_SRC
        }
        {
            LAS float* scr = lds + wave * (64 * 33);
            int rot = 0;
            transpose_w(w_in, 1024, DIN, WinT, 1024, 0, scr, gw, NGW, lane, rot);
            for (int i = bid * NTHREADS + tid; i < (ZLD - DIN) * 1024 / 2; i += G * NTHREADS) ((unsigned*)(WinT + (size_t)DIN * 1024))[i] = 0u;
            for (int i = bid * NTHREADS + tid; i < MH * KVL * DNOPE / 4; i += G * NTHREADS) { const f32x4 v = *(const f32x4*)(w_uk + 4 * (size_t)i); *(u32x2_t*)(WukB + 4 * (size_t)i) = (u32x2_t){cvtpk(v[0], v[1]), cvtpk(v[2], v[3])}; }
            transpose_w(w_mem_k, 1024, 256, WmkvT, 1024, 0, scr, gw, NGW, lane, rot);
            transpose_w(w_mem_v, 1024, 256, WmkvT, 1024, 256, scr, gw, NGW, lane, rot);
            transpose_w(w_uq, QL, 1536, WuqT, QL, 0, scr, gw, NGW, lane, rot);
            transpose_w(w_ret_o, 1024, 1024, WroT, 1024, 0, scr, gw, NGW, lane, rot);
            transpose_w(w_mla_o, 1024, 1024, WmoT, 1024, 0, scr, gw, NGW, lane, rot);
            transpose_w(w_x_o, 256, 1024, WxoT, 256, 0, scr, gw, NGW, lane, rot);
            transpose_w(w_out, 1024, 1024, WoT, 1024, 0, scr, gw, NGW, lane, rot);
            transpose_w(w_gate, 1024, DFF, WguT, 1024, 0, scr, gw, NGW, lane, rot, 2);
            transpose_w(w_up, 1024, DFF, WguT, 1024, 1, scr, gw, NGW, lane, rot, 2);
            transpose_w(w_down, DFF, 1024, WdT, DFF, 0, scr, gw, NGW, lane, rot);
            for (int hh = 0; hh < MH; ++hh) { transpose_w(w_uk + (size_t)hh * KVL * DNOPE, KVL, DNOPE, WukT, KVL, hh * DNOPE, scr, gw, NGW, lane, rot);
                                              transpose_w(w_uv + (size_t)hh * KVL * DVH, KVL, DVH, WuvT, KVL, hh * DVH, scr, gw, NGW, lane, rot); }
        }
    }
    SEAM(0);
    if (IN(1)) {
        static_assert(WS_MNB == WS_UB + (size_t)NT * 1024 * 2 && WS_WMKV_T == WS_WIN_T + (size_t)ZLD * 1024 * 2, "P1 stacks Ub|MNb and WinT|WmkvT");
        { pg8::Gemm g{Ub, WinT, NT + NB * NMEM, ZLD + 512, 1024, 1024, 1024}; pg8::P1Order S; S.init(G, bid); pg8::EpiP1 E{Zb, ZLD, out + O_MKP, out + O_MVP, SRGb, SGb, C_RG, C_G};
          pg8::gemm_phase<pg8::EpiP1, pg8::P1Order, true, true>(ldsb, g, S, E); }
        __syncthreads();
        { pg8::Gemm g{WinT + (size_t)C_RV * 1024, Ub, 1024, NP, 1024, 1024, 1024}; pg8::StaticOrder S; S.init(1024, NP, G, bid); pg8::EpiBf16S E{RVT, NT};
          GEMM_PHASE(pg8::EpiBf16S, ldsb, g, S, E); }
    }
    SEAM(1);
    if (IN(2)) {
        constexpr int KTP = 520;
        LAS bf16_t* Kt = (LAS bf16_t*)ldsb;
        const int ntile = NP / 64, nwork = ntile + (NS + 63) / 64;
        for (int wk = bid; wk < nwork; wk += G) {
            const bool prompt = wk < ntile; const int row_base = prompt ? wk * 64 : NP + (wk - ntile) * 64;
            __syncthreads();
            {
                const int hq = lane >> 4, f4 = (lane & 15) * 4;
                u32x2_t q1, q2, k1, k2, cv, p1, p2; u32x4_t cq8; f32x4 ca, sa, cb, sb; int p;
#define P2_LOAD(r_, Q1_, Q2_, K1_, K2_, CQ_, CV_, P1_, P2_, CA_, SA_, CB_, SB_, P_) do { const bf16_t* z_ = Zb + (size_t)(row_base + (r_)) * ZLD; P_ = pos_index(row_base + (r_)); \
                Q1_ = *(const u32x2_t*)(z_ + C_RQ + hq * RDK + f4); Q2_ = *(const u32x2_t*)(z_ + C_RQ + hq * RDK + 64 + f4); K1_ = *(const u32x2_t*)(z_ + C_RK + hq * RDK + f4); K2_ = *(const u32x2_t*)(z_ + C_RK + hq * RDK + 64 + f4); \
                CQ_ = (u32x4_t){0u, 0u, 0u, 0u}; if (lane < 48) CQ_ = *(const u32x4_t*)(z_ + C_CQ + 8 * lane); CV_ = *(const u32x2_t*)(z_ + C_CKV + 4 * lane); \
                P1_ = (u32x2_t){0u, 0u}; P2_ = P1_; CB_ = (f32x4){0.f, 0.f, 0.f, 0.f}; SB_ = CB_; \
                if (lane < 8) { P1_ = *(const u32x2_t*)(z_ + C_KPE + 4 * lane); P2_ = *(const u32x2_t*)(z_ + C_KPE + 32 + 4 * lane); CB_ = *(const f32x4*)(COSB + P_ * 32 + 4 * lane); SB_ = *(const f32x4*)(SINB + P_ * 32 + 4 * lane); } \
                CA_ = *(const f32x4*)(COSA + P_ * 64 + f4); SA_ = *(const f32x4*)(SINA + P_ * 64 + f4); } while (0)
#define BLO(x_) __builtin_bit_cast(float, (x_) << 16)
#define BHI(x_) __builtin_bit_cast(float, (x_) & 0xffff0000u)
                int r = wave;
                P2_LOAD(r, q1, q2, k1, k2, cq8, cv, p1, p2, ca, sa, cb, sb, p);
                for (; r < 64; r += NWAVES) {
                    u32x2_t q1n, q2n, k1n, k2n, cvn, p1n, p2n; u32x4_t cq8n; f32x4 can, san, cbn, sbn; int pn;
                    if (r + NWAVES < 64) P2_LOAD(r + NWAVES, q1n, q2n, k1n, k2n, cq8n, cvn, p1n, p2n, can, san, cbn, sbn, pn);
                    const int row = row_base + r; const int il = p & 127;
                    {
                        const float x1q[4] = {BLO(q1.x), BHI(q1.x), BLO(q1.y), BHI(q1.y)}, x2q[4] = {BLO(q2.x), BHI(q2.x), BLO(q2.y), BHI(q2.y)};
                        const float x1k[4] = {BLO(k1.x), BHI(k1.x), BLO(k1.y), BHI(k1.y)}, x2k[4] = {BLO(k2.x), BHI(k2.x), BLO(k2.y), BHI(k2.y)};
                        const float sc = 0.08838834764831845f;
                        float oq1[4], oq2[4], ok1[4], ok2[4];
#pragma unroll
                        for (int e = 0; e < 4; ++e) { oq1[e] = x1q[e] * ca[e] - x2q[e] * sa[e]; oq2[e] = x1q[e] * sa[e] + x2q[e] * ca[e];
                            ok1[e] = (x1k[e] * ca[e] - x2k[e] * sa[e]) * sc; ok2[e] = (x1k[e] * sa[e] + x2k[e] * ca[e]) * sc; }
                        if (prompt) {
                            const float fq = __expf((float)(il - 127) * lg_gamma(hq)), fk = 1.f / fq;
                            *(u32x2_t*)(RQt + (size_t)row * 512 + hq * RDK + f4) = (u32x2_t){cvtpk(oq1[0] * fq, oq1[1] * fq), cvtpk(oq1[2] * fq, oq1[3] * fq)};
                            *(u32x2_t*)(RQt + (size_t)row * 512 + hq * RDK + 64 + f4) = (u32x2_t){cvtpk(oq2[0] * fq, oq2[1] * fq), cvtpk(oq2[2] * fq, oq2[3] * fq)};
                            const u32x2_t kb1 = {cvtpk(ok1[0] * fk, ok1[1] * fk), cvtpk(ok1[2] * fk, ok1[3] * fk)}, kb2 = {cvtpk(ok2[0] * fk, ok2[1] * fk), cvtpk(ok2[2] * fk, ok2[3] * fk)};
                            *(u32x2_t*)(RKt + (size_t)row * 512 + hq * RDK + f4) = kb1; *(u32x2_t*)(RKt + (size_t)row * 512 + hq * RDK + 64 + f4) = kb2;
                            *(LAS u32x2_t*)(Kt + r * KTP + hq * RDK + f4) = kb1; *(LAS u32x2_t*)(Kt + r * KTP + hq * RDK + 64 + f4) = kb2;
                        } else {
                            *(f32x4*)(RQ + (size_t)row * 512 + hq * RDK + f4) = (f32x4){oq1[0], oq1[1], oq1[2], oq1[3]}; *(f32x4*)(RQ + (size_t)row * 512 + hq * RDK + 64 + f4) = (f32x4){oq2[0], oq2[1], oq2[2], oq2[3]};
                            *(f32x4*)(RK + (size_t)row * 512 + hq * RDK + f4) = (f32x4){ok1[0], ok1[1], ok1[2], ok1[3]}; *(f32x4*)(RK + (size_t)row * 512 + hq * RDK + 64 + f4) = (f32x4){ok2[0], ok2[1], ok2[2], ok2[3]};
                        }
                    }
                    {
                        const float c_[8] = {BLO(cq8.x), BHI(cq8.x), BLO(cq8.y), BHI(cq8.y), BLO(cq8.z), BHI(cq8.z), BLO(cq8.w), BHI(cq8.w)};
                        float ss = 0.f;
#pragma unroll
                        for (int e = 0; e < 8; ++e) ss += c_[e] * c_[e];
                        const float rr = rsqrtf(wave_sum(ss) * (1.f / QL) + EPS);
                        if (lane < 48) { const f32x4 g0 = *(const f32x4*)(g_qlat + 8 * lane), g1 = *(const f32x4*)(g_qlat + 8 * lane + 4);
                            *(u32x4_t*)(CQNb + (size_t)row * QL + 8 * lane) = (u32x4_t){cvtpk(c_[0] * rr * g0[0], c_[1] * rr * g0[1]), cvtpk(c_[2] * rr * g0[2], c_[3] * rr * g0[3]),
                                                                                     cvtpk(c_[4] * rr * g1[0], c_[5] * rr * g1[1]), cvtpk(c_[6] * rr * g1[2], c_[7] * rr * g1[3])}; }
                    }
                    {
                        const float v_[4] = {BLO(cv.x), BHI(cv.x), BLO(cv.y), BHI(cv.y)};
                        const float rr = rsqrtf(wave_sum(v_[0] * v_[0] + v_[1] * v_[1] + v_[2] * v_[2] + v_[3] * v_[3]) * (1.f / KVL) + EPS);
                        const f32x4 g0 = *(const f32x4*)(g_kvlat + 4 * lane); const f32x4 o_ = {v_[0] * rr * g0[0], v_[1] * rr * g0[1], v_[2] * rr * g0[2], v_[3] * rr * g0[3]};
                        float* ockv = row < NP ? out + O_CKVP + (size_t)row * KVL : out + O_CKVS + (size_t)(row - NP) * KVL;
                        *(f32x4*)(ockv + 4 * lane) = o_; *(f32x4*)(CKVN + (size_t)row * KVL + 4 * lane) = o_;
                        *(u32x2_t*)(CKVNb + (size_t)row * KVL + 4 * lane) = (u32x2_t){cvtpk(o_[0], o_[1]), cvtpk(o_[2], o_[3])};
                    }
                    if (lane < 8) {
                        const float x1[4] = {BLO(p1.x), BHI(p1.x), BLO(p1.y), BHI(p1.y)}, x2[4] = {BLO(p2.x), BHI(p2.x), BLO(p2.y), BHI(p2.y)};
                        f32x4 o1, o2;
#pragma unroll
                        for (int e = 0; e < 4; ++e) { o1[e] = x1[e] * cb[e] - x2[e] * sb[e]; o2[e] = x1[e] * sb[e] + x2[e] * cb[e]; }
                        *(f32x4*)(KPER + (size_t)row * DROPE + 4 * lane) = o1; *(f32x4*)(KPER + (size_t)row * DROPE + 32 + 4 * lane) = o2;
                        float* okpe = row < NP ? out + O_KPEP + (size_t)row * DROPE : out + O_KPES + (size_t)(row - NP) * DROPE;
                        *(f32x4*)(okpe + 4 * lane) = o1; *(f32x4*)(okpe + 32 + 4 * lane) = o2;
                        *(u32x2_t*)(KPERb + (size_t)row * DROPE + 4 * lane) = (u32x2_t){cvtpk(o1[0], o1[1]), cvtpk(o1[2], o1[3])}; *(u32x2_t*)(KPERb + (size_t)row * DROPE + 32 + 4 * lane) = (u32x2_t){cvtpk(o2[0], o2[1]), cvtpk(o2[2], o2[3])};
                    }
                    q1 = q1n; q2 = q2n; k1 = k1n; k2 = k2n; cq8 = cq8n; cv = cvn; p1 = p1n; p2 = p2n; ca = can; sa = san; cb = cbn; sb = sbn; p = pn;
                }
#undef P2_LOAD
            }
            __syncthreads();
            if (prompt) {
#pragma unroll 2
                for (int i = 0; i < 8; ++i) { const int pc = tid + i * NTHREADS, f = pc >> 3, k8 = pc & 7;
                    const LAS bf16_t* c = Kt + (8 * k8) * KTP + f;
                    pg8::u32x4 o; o.x = (unsigned)c[0] | ((unsigned)c[KTP] << 16); o.y = (unsigned)c[2 * KTP] | ((unsigned)c[3 * KTP] << 16);
                    o.z = (unsigned)c[4 * KTP] | ((unsigned)c[5 * KTP] << 16); o.w = (unsigned)c[6 * KTP] | ((unsigned)c[7 * KTP] << 16);
                    *(pg8::u32x4*)(RKtT + (size_t)f * NP + row_base + 8 * k8) = o; }
            }
        }
    }
    if (IN(2)) {
        for (int i = bid * NTHREADS + tid; i < NB * NMEM * 256; i += G * NTHREADS) { MKb[i] = f2bf(out[O_MKP + i]);
            const int f = i / (NB * NMEM), r = i - f * (NB * NMEM); MVT[i] = f2bf(out[O_MVP + (size_t)r * 256 + f]); }
    }
    SEAM(2);
    if (IN(3)) { pg8::Gemm g{CQNb, WuqT, NT, 1536, QL, QL, QL}; pg8::StaticOrder S; S.init(NT, 1536, G, bid); pg8::EpiBf16S E{Qb, 1536};
        GEMM_PHASE(pg8::EpiBf16S, ldsb, g, S, E);
        __syncthreads();
        { pg8::Gemm g2{CKVNb, WukT, NP, 1024, KVL, KVL, KVL}; pg8::StaticOrder S2; S2.init(NP, 1024, G, bid); pg8::EpiBf16S E2{KN, 1024}; GEMM_PHASE(pg8::EpiBf16S, ldsb, g2, S2, E2); }
        __syncthreads();
        { pg8::Gemm g3{WuvT, CKVNb, 1024, NP, KVL, KVL, KVL}; pg8::StaticOrder S3; S3.init(1024, NP, G, bid); pg8::EpiBf16S E3{VT, NP}; GEMM_PHASE(pg8::EpiBf16S, ldsb, g3, S3, E3); }
        ret_state_phase(ldsb, RVT, RKtT, UT, bid, G); }
    SEAM(3);
    if (IN(4)) {
        for (int idx = bid * NTHREADS + tid; idx < NB * RH * 8192; idx += G * NTHREADS) {
            const int bh = idx >> 13, e = (idx & 8191) * 4; const float g128 = __expf(128.f * lg_gamma(bh & 3));
            f32x4 u[16];
#pragma unroll
            for (int c = 0; c < 16; ++c) u[c] = __builtin_nontemporal_load((const f32x4*)(UT + (size_t)(bh * 16 + c) * 32768 + e));
            f32x4 sp = {0.f, 0.f, 0.f, 0.f}, S = sp;
#pragma unroll
            for (int c = 0; c < 16; ++c) { *(u32x2_t*)(SPT + (size_t)(bh * 16 + c) * 32768 + e) = (u32x2_t){cvtpk(sp[0], sp[1]), cvtpk(sp[2], sp[3])}; S = sp + u[c]; sp = S * g128; }
            const int dv = e >> 7, dk = e & 127; float* o_ = out + O_RETP + (size_t)bh * 32768 + (size_t)dk * RDV + dv;
            o_[0] = S[0]; o_[RDV] = S[1]; o_[2 * RDV] = S[2]; o_[3 * RDV] = S[3];
        }
        {
            const int hd = lane >> 3, f4 = (lane & 7) * 4;
            u32x2_t x1, x2; f32x4 cb, sb;
#define P4_LOAD(r_, X1_, X2_, C_, S_) do { const bf16_t* q_ = Qb + (size_t)(r_) * 1536 + hd * DQH + DNOPE + f4; X1_ = *(const u32x2_t*)q_; X2_ = *(const u32x2_t*)(q_ + 32); \
            const int p_ = pos_index(r_); C_ = *(const f32x4*)(COSB + p_ * 32 + f4); S_ = *(const f32x4*)(SINB + p_ * 32 + f4); } while (0)
            int row = gw;
            if (row < NT) P4_LOAD(row, x1, x2, cb, sb);
            for (; row < NT; row += NGW) {
                u32x2_t x1n, x2n; f32x4 cbn, sbn; const int nr = row + NGW;
                if (nr < NT) P4_LOAD(nr, x1n, x2n, cbn, sbn);
                const float a0 = __builtin_bit_cast(float, x1.x << 16), a1 = __builtin_bit_cast(float, x1.x & 0xffff0000u), a2 = __builtin_bit_cast(float, x1.y << 16), a3 = __builtin_bit_cast(float, x1.y & 0xffff0000u);
                const float b0 = __builtin_bit_cast(float, x2.x << 16), b1 = __builtin_bit_cast(float, x2.x & 0xffff0000u), b2 = __builtin_bit_cast(float, x2.y << 16), b3 = __builtin_bit_cast(float, x2.y & 0xffff0000u);
                bf16_t* o_ = QPEb + (size_t)row * 512 + hd * DROPE + f4;
                *(u32x2_t*)o_ = (u32x2_t){cvtpk(a0 * cb[0] - b0 * sb[0], a1 * cb[1] - b1 * sb[1]), cvtpk(a2 * cb[2] - b2 * sb[2], a3 * cb[3] - b3 * sb[3])};
                *(u32x2_t*)(o_ + 32) = (u32x2_t){cvtpk(a0 * sb[0] + b0 * cb[0], a1 * sb[1] + b1 * cb[1]), cvtpk(a2 * sb[2] + b2 * cb[2], a3 * sb[3] + b3 * cb[3])};
                x1 = x1n; x2 = x2n; cb = cbn; sb = sbn;
            }
#undef P4_LOAD
        }
        for (int wt = gw; wt < MH * 16 * 2; wt += NGW) {
            const int lh = wt & 1, rb = (wt >> 1) & 15, head = wt >> 5; const int l31 = lane & 31, h8 = lane >> 5;
            f32x16 acc[4];
#pragma unroll
            for (int k_ = 0; k_ < 4; ++k_)
#pragma unroll
                for (int i = 0; i < 16; ++i) acc[k_][i] = 0.f;
            const bf16_t* ap = Qb + ((size_t)NP + 32 * rb + l31) * 1536 + head * DQH + 8 * h8;
            const bf16_t* bp = WukB + ((size_t)head * KVL + 128 * lh + l31) * DNOPE + 8 * h8;
#pragma unroll
            for (int s_ = 0; s_ < 8; ++s_) { const bf16x8 a = *(const bf16x8*)(ap + 16 * s_);
#pragma unroll
                for (int k_ = 0; k_ < 4; ++k_) { const bf16x8 b_ = *(const bf16x8*)(bp + (size_t)(32 * k_) * DNOPE + 16 * s_); acc[k_] = MFMA32(a, b_, acc[k_]); } }
#pragma unroll
            for (int k_ = 0; k_ < 4; ++k_)
#pragma unroll
                for (int i = 0; i < 16; ++i) QLATb[(size_t)(32 * rb + crow(i, h8)) * 2048 + head * KVL + 128 * lh + 32 * k_ + l31] = f2bf(acc[k_][i]);
        }
    }
    SEAM(4);
    if (IN(5)) {
        if (args.sub & 1) for (int it = bid; it < DB * MS_NSPLIT; it += G) { const int split = __builtin_amdgcn_readfirstlane(it % MS_NSPLIT), b = __builtin_amdgcn_readfirstlane(it / MS_NSPLIT);
            mla_sample_unit(ldsb, cache_ckv, cache_kpe, page_table, QLATb, QPEb, PO, PML, b, split, 0.07216878364870322f * 1.4426950408889634f); }
        if (args.sub & 2) for (int it = bid; it < NB * MH * 4; it += G) {
            const int pr = __builtin_amdgcn_readfirstlane(it & 3), hh = __builtin_amdgcn_readfirstlane((it >> 2) & 7), b = __builtin_amdgcn_readfirstlane(it >> 5);
#pragma unroll 1
            for (int half = 0; half < 2; ++half) { const int qb = __builtin_amdgcn_readfirstlane(half ? pr : 7 - pr); const size_t row0 = (size_t)b * SEQ + qb * 256;
                SrcMlaP src{KN, KPERb, VT, Qb, QPEb, b, hh, row0};
                flash_unit<192, 128, true>(ldsb, src, qb * 256, 4 * (qb + 1), OMLAb + row0 * 1024 + hh * DVH, 1024, 0.07216878364870322f * 1.4426950408889634f); }
        }
        if (args.sub & 4) ret_out_phase(ldsb, RQt, RKt, RVT, SPT, ORET, bid, G);
        if (args.sub & 8) for (int it = bid; it < DB * RH; it += G) {
            const int h = it & 3, b = it >> 2; const float lg = lg_gamma(h);
            const float* s0 = state_ret + (size_t)it * RDK * RDV;
            float* so = out + O_RETS + (size_t)it * RDK * RDV;
            LAS float* inner = lds;
            LAS float* qk = lds + 16;
            LAS float* vls = lds + 1040;
            LAS float* red = lds + 2064;
            f32x4 sv[16], vv[4];
#pragma unroll
            for (int r = 0; r < 16; ++r) sv[r] = __builtin_nontemporal_load((const f32x4*)(s0 + (size_t)(wave + 8 * r) * RDV + 4 * lane));
#pragma unroll
            for (int j = 0; j < DS; ++j) { const u32x2_t t_ = *(const u32x2_t*)(Zb + ((size_t)NP + b * DS + j) * ZLD + C_RV + h * RDV + 4 * lane); vv[j] = (f32x4){BLO(t_.x), BHI(t_.x), BLO(t_.y), BHI(t_.y)}; }
            __syncthreads();
            for (int i = tid; i < 1024; i += NTHREADS) { const int which = i >> 9, ti = (i >> 7) & 3, d = i & 127; const size_t row = (size_t)NP + b * DS + ti;
                qk[i] = which ? RK[row * 512 + h * RDK + d] : RQ[row * 512 + h * RDK + d]; }
            if (wave == 0) {
#pragma unroll
                for (int j = 0; j < DS; ++j) *(LAS f32x4*)(vls + j * 256 + 4 * lane) = vv[j]; }
            __syncthreads();
            for (int pr = wave; pr < 16; pr += NWAVES) { const int i = pr >> 2, j = pr & 3;
                float s_ = qk[i * 128 + lane] * qk[512 + j * 128 + lane] + qk[i * 128 + 64 + lane] * qk[512 + j * 128 + 64 + lane];
                s_ = wave_sum(s_);
                if (lane == 0) inner[pr] = (j <= i) ? s_ * __expf((float)(i - j) * lg) : 0.f; }
            const float g4 = __expf(4.f * lg), gk0 = __expf(3.f * lg), gk1 = __expf(2.f * lg), gk2 = __expf(lg);
            f32x4 po[4];
#pragma unroll
            for (int i = 0; i < 4; ++i) po[i] = (f32x4){0.f, 0.f, 0.f, 0.f};
#pragma unroll
            for (int r = 0; r < 16; ++r) { const int d = wave + 8 * r; const f32x4 sx = sv[r];
                f32x4 a = sx * g4 + (gk0 * qk[512 + d]) * vv[0] + (gk1 * qk[512 + 128 + d]) * vv[1] + (gk2 * qk[512 + 256 + d]) * vv[2] + qk[512 + 384 + d] * vv[3];
                __builtin_nontemporal_store(a, (f32x4*)(so + (size_t)d * RDV + 4 * lane));
#pragma unroll
                for (int i = 0; i < 4; ++i) po[i] += qk[i * 128 + d] * sx; }
#pragma unroll
            for (int i = 0; i < 4; ++i) *(LAS f32x4*)(red + (wave * 4 + i) * 256 + 4 * lane) = po[i];
            __syncthreads();
            {
                const int i = tid >> 7, e2 = (tid & 127) * 2;
                float o0 = 0.f, o1 = 0.f;
#pragma unroll
                for (int w_ = 0; w_ < NWAVES; ++w_) { o0 += red[(w_ * 4 + i) * 256 + e2]; o1 += red[(w_ * 4 + i) * 256 + e2 + 1]; }
                const float gi = __expf((float)(i + 1) * lg); o0 *= gi; o1 *= gi;
#pragma unroll
                for (int j = 0; j < DS; ++j) { const float w_ = inner[i * 4 + j]; o0 += w_ * vls[j * 256 + e2]; o1 += w_ * vls[j * 256 + e2 + 1]; }
                *(f32x2_t*)(ORET + ((size_t)NP + b * DS + i) * 1024 + h * RDV + e2) = (f32x2_t){o0, o1};
            }
        }
        if (args.sub & 16) for (int it = bid; it < NB * XH * 8; it += G) {
            const int qb = __builtin_amdgcn_readfirstlane(it & 7), hh = __builtin_amdgcn_readfirstlane((it >> 3) & 3), b = __builtin_amdgcn_readfirstlane(it >> 5); const size_t row0 = (size_t)b * SEQ + qb * 256;
            SrcMemP src{MKb, MVT, Zb + C_XQ, b, hh, row0};
            flash_unit<64, 64, false>(ldsb, src, 0, 4, OXb + row0 * 256 + hh * XHD, 256, 0.125f * 1.4426950408889634f);
        }
        if (args.sub & 32) for (int b = bid; b < DB; b += G) {
            LAS float* sc = lds;
            LAS float* red = lds + 4096;
            const float* kb_ = cache_mem_k + (size_t)b * NMEM * 256; const float* vb_ = cache_mem_v + (size_t)b * NMEM * 256;
            f32x4 qr[4];
#pragma unroll
            for (int q = 0; q < DS; ++q) { const u32x2_t t_ = *(const u32x2_t*)(Zb + ((size_t)NP + b * DS + q) * ZLD + C_XQ + 4 * lane); qr[q] = (f32x4){BLO(t_.x), BHI(t_.x), BLO(t_.y), BHI(t_.y)}; }
            __syncthreads();
#pragma unroll 8
            for (int kk = 0; kk < 32; ++kk) { const int key = 32 * wave + kk; const f32x4 kv = __builtin_nontemporal_load((const f32x4*)(kb_ + (size_t)key * 256 + 4 * lane));
                float pq[4];
#pragma unroll
                for (int q = 0; q < 4; ++q) { float a = kv[0] * qr[q][0] + kv[1] * qr[q][1] + kv[2] * qr[q][2] + kv[3] * qr[q][3];
                    a += __shfl_xor(a, 1); a += __shfl_xor(a, 2); a += __shfl_xor(a, 4); a += __shfl_xor(a, 8); pq[q] = a; }
                if ((lane & 15) == 0) {
#pragma unroll
                    for (int q = 0; q < 4; ++q) sc[(q * 4 + (lane >> 4)) * 256 + key] = pq[q] * (0.125f * 1.4426950408889634f); } }
            __syncthreads();
            for (int rr = wave * 2; rr < wave * 2 + 2; ++rr) {
                f32x4 v = *(LAS f32x4*)(sc + rr * 256 + 4 * lane);
                const float mx = wave_max(fmaxf(fmaxf(v[0], v[1]), fmaxf(v[2], v[3])));
#pragma unroll
                for (int e = 0; e < 4; ++e) v[e] = __builtin_amdgcn_exp2f(v[e] - mx);
                const float inv = 1.f / wave_sum(v[0] + v[1] + v[2] + v[3]);
                *(LAS f32x4*)(sc + rr * 256 + 4 * lane) = v * inv; }
            __syncthreads();
            f32x4 acc[4];
#pragma unroll
            for (int q = 0; q < 4; ++q) acc[q] = (f32x4){0.f, 0.f, 0.f, 0.f};
#pragma unroll 8
            for (int kk = 0; kk < 32; ++kk) { const int key = 32 * wave + kk; const f32x4 vv = __builtin_nontemporal_load((const f32x4*)(vb_ + (size_t)key * 256 + 4 * lane));
#pragma unroll
                for (int q = 0; q < 4; ++q) acc[q] += sc[(q * 4 + (lane >> 4)) * 256 + key] * vv; }
#pragma unroll
            for (int q = 0; q < 4; ++q) *(LAS f32x4*)(red + (wave * 4 + q) * 256 + 4 * lane) = acc[q];
            __syncthreads();
            { const int q = tid >> 7, e2 = (tid & 127) * 2; float o0 = 0.f, o1 = 0.f;
#pragma unroll
              for (int w_ = 0; w_ < NWAVES; ++w_) { o0 += red[(w_ * 4 + q) * 256 + e2]; o1 += red[(w_ * 4 + q) * 256 + e2 + 1]; }
              *(unsigned*)(OXb + ((size_t)NP + b * DS + q) * 256 + e2) = cvtpk(o0, o1); }
        }
    }
    SEAM(5);
    if (IN(6)) {
        for (int bt = bid; bt < NS; bt += G) {
            const int b = bt >> 2;
            const int head = wave; const float c2 = 0.07216878364870322f * 1.4426950408889634f;
            LAS float* ol = lds + wave * KVL;
            { const int t = bt & 3;
                const int qi = t * 8 + head; const size_t qrow = (size_t)b * DS + t;
                float qv[5];
#pragma unroll
                for (int c = 0; c < 5; ++c) { const int d = lane + 64 * c; const bf16_t raw = d < KVL ? QLATb[qrow * 2048 + head * KVL + d] : QPEb[(NP + qrow) * 512 + head * DROPE + (d - KVL)];
                    qv[c] = __builtin_bit_cast(float, (unsigned)raw << 16); }
                float sc[DS]; float M = -INFINITY;
#pragma unroll
                for (int j = 0; j < DS; ++j) { const size_t krow = (size_t)NP + b * DS + j; float a = 0.f;
#pragma unroll
                    for (int c = 0; c < 5; ++c) { const int d = lane + 64 * c; a += qv[c] * (d < KVL ? CKVN[krow * KVL + d] : KPER[krow * DROPE + (d - KVL)]); }
                    a = wave_sum(a) * c2; sc[j] = (j <= t) ? a : -INFINITY; M = fmaxf(M, sc[j]); }
                float ms[MS_NSPLIT], ls[MS_NSPLIT];
#pragma unroll
                for (int sp = 0; sp < MS_NSPLIT; ++sp) { const int item = b * MS_NSPLIT + sp; ms[sp] = PML[(item * 32 + qi) * 2]; ls[sp] = PML[(item * 32 + qi) * 2 + 1]; M = fmaxf(M, ms[sp]); }
                float L = 0.f; float acc[4] = {0.f, 0.f, 0.f, 0.f};
#pragma unroll
                for (int sp = 0; sp < MS_NSPLIT; ++sp) { const int item = b * MS_NSPLIT + sp; const float wgt = __builtin_amdgcn_exp2f(ms[sp] - M); L += ls[sp] * wgt;
#pragma unroll
                    for (int c = 0; c < 4; ++c) acc[c] += wgt * PO[((size_t)item * 32 + qi) * KVL + lane + 64 * c]; }
#pragma unroll
                for (int j = 0; j < DS; ++j) { const float wgt = __builtin_amdgcn_exp2f(sc[j] - M); L += wgt; const size_t krow = (size_t)NP + b * DS + j;
#pragma unroll
                    for (int c = 0; c < 4; ++c) acc[c] += wgt * CKVN[krow * KVL + lane + 64 * c]; }
                const float inv = 1.f / L;
#pragma unroll
                for (int c = 0; c < 4; ++c) ol[lane + 64 * c] = acc[c] * inv;
                __syncthreads();
                float a0 = 0.f, a1 = 0.f; const float* wv = w_uv + (size_t)head * KVL * DVH;
#pragma unroll 8
                for (int l = 0; l < KVL; ++l) { const float x = ol[l]; a0 += x * wv[(size_t)l * DVH + lane]; a1 += x * wv[(size_t)l * DVH + 64 + lane]; }
                OMLAb[((size_t)NP + qrow) * 1024 + head * DVH + lane] = f2bf(a0); OMLAb[((size_t)NP + qrow) * 1024 + head * DVH + 64 + lane] = f2bf(a1);
                __syncthreads();
            }
        }
        {
            f32x4 a[4]; u32x2_t gz[4];
#define P6_LOAD(r_, A_, B_) do { _Pragma("unroll") for (int j_ = 0; j_ < 4; ++j_) { A_[j_] = *(const f32x4*)(ORET + (size_t)(r_) * 1024 + 4 * lane + 256 * j_); \
                                                                              B_[j_] = *(const u32x2_t*)(SRGb + (size_t)(r_) * 1024 + 4 * lane + 256 * j_); } } while (0)
            int row = gw;
            if (row < NT) P6_LOAD(row, a, gz);
            for (; row < NT; row += NGW) {
                f32x4 an[4]; u32x2_t gn[4]; const int nr = row + NGW;
                if (nr < NT) P6_LOAD(nr, an, gn);
#pragma unroll
                for (int j = 0; j < 4; ++j) {
                    const float ss = wave_sum(a[j][0] * a[j][0] + a[j][1] * a[j][1] + a[j][2] * a[j][2] + a[j][3] * a[j][3]);
                    const float r = rsqrtf(ss * (1.f / RDV) + EPS);
                    float o_[4];
#pragma unroll
                    for (int e = 0; e < 4; ++e) { const unsigned gw_ = e < 2 ? gz[j].x : gz[j].y; o_[e] = __builtin_bit_cast(float, (e & 1) ? (gw_ & 0xffff0000u) : (gw_ << 16)) * a[j][e] * r; }
                    *(u32x2_t*)(ORETNb + (size_t)row * 1024 + 4 * lane + 256 * j) = (u32x2_t){cvtpk(o_[0], o_[1]), cvtpk(o_[2], o_[3])};
                }
#pragma unroll
                for (int j = 0; j < 4; ++j) { a[j] = an[j]; gz[j] = gn[j]; }
            }
#undef P6_LOAD
        }
    }
    SEAM(6);
    if (IN(7)) {
        pg8::StaticOrder S; S.init(NP, 1024, G, bid);
        { pg8::Gemm g{ORETNb, WroT, NP, 1024, 1024, 1024, 1024}; pg8::EpiGate<0> E{SGb, T0b, T0b, 1024}; GEMM_PHASE(pg8::EpiGate<0>, ldsb, g, S, E); }
        __syncthreads();
        { pg8::Gemm g{OMLAb, WmoT, NP, 1024, 1024, 1024, 1024}; pg8::EpiGate<1> E{SGb + 1024, T0b, T1b, 1024}; GEMM_PHASE(pg8::EpiGate<1>, ldsb, g, S, E); }
        __syncthreads();
        { pg8::Gemm g{OXb, WxoT, NP, 1024, 256, 256, 256}; pg8::EpiGate<1> E{SGb + 2048, T1b, MIXb, 1024}; GEMM_PHASE(pg8::EpiGate<1>, ldsb, g, S, E); }
        __syncthreads();
        { pg8::Gemm g{ORETNb, WroT, NT, 1024, 256, 1024, 1024, 256}; pg8::SplitOrder SS{4, bid}; pg8::EpiPart E{PART}; GEMM_SPLIT(ldsb, g, SS, E); }
        __syncthreads();
        { pg8::Gemm g{OMLAb, WmoT, NT, 1024, 256, 1024, 1024, 256}; pg8::SplitOrder SS{4, (bid + 224) % G}; pg8::EpiPart E{PART + (size_t)4 * 512 * 1024}; GEMM_SPLIT(ldsb, g, SS, E); }
        __syncthreads();
        { pg8::Gemm g{OXb, WxoT, NT, 1024, 256, 256, 256, 256}; pg8::SplitOrder SS{1, (bid + 128) % G}; pg8::EpiPart E{PART + (size_t)8 * 512 * 1024}; GEMM_SPLIT(ldsb, g, SS, E); }
    }
    SEAM(7);
    if (IN(8)) {
        for (int i = bid * NTHREADS + tid; i < NS * 256; i += G * NTHREADS) { const int r = i >> 8, c4 = (i & 255) * 4; const size_t o_ = (size_t)r * 1024 + c4;
            f32x4 mix = {0.f, 0.f, 0.f, 0.f};
#pragma unroll
            for (int br = 0; br < 3; ++br) { f32x4 a = *(const f32x4*)(PART + (size_t)(br == 2 ? 8 : 4 * br) * (512 * 1024) + o_);
                if (br < 2) {
#pragma unroll
                    for (int k_ = 1; k_ < 4; ++k_) a += *(const f32x4*)(PART + (size_t)(4 * br + k_) * (512 * 1024) + o_); }
                const u32x2_t gq = *(const u32x2_t*)(SGb + (size_t)(NP + r) * 3072 + br * 1024 + c4);
                mix[0] += a[0] * __builtin_bit_cast(float, gq.x << 16); mix[1] += a[1] * __builtin_bit_cast(float, gq.x & 0xffff0000u);
                mix[2] += a[2] * __builtin_bit_cast(float, gq.y << 16); mix[3] += a[3] * __builtin_bit_cast(float, gq.y & 0xffff0000u); }
            *(u32x2_t*)(MIXb + (size_t)(NP + r) * 1024 + c4) = (u32x2_t){cvtpk(mix[0], mix[1]), cvtpk(mix[2], mix[3])}; }
    }
    SEAM(8);
    if (IN(9)) { pg8::Gemm g{MIXb, WoT, NP, 1024, 1024, 1024, 1024}; pg8::StaticOrder S; S.init(NP, 1024, G, bid); pg8::EpiF32S E{HP, 1024, 0, 0};
        GEMM_PHASE(pg8::EpiF32S, ldsb, g, S, E);
        __syncthreads();
        { pg8::Gemm g2{MIXb, WoT, NT, 1024, 256, 1024, 1024, 256}; pg8::SplitOrder SS{4, bid}; pg8::EpiPart E2{PART}; GEMM_SPLIT(ldsb, g2, SS, E2); } }
    SEAM(9);
    if (IN(10)) {
        f32x4 gp[4], gf[4], a[4], b[4];
#pragma unroll
        for (int j = 0; j < 4; ++j) { gp[j] = *(const f32x4*)(g_mix_post + 4 * lane + 256 * j); gf[j] = *(const f32x4*)(g_ffn_pre + 4 * lane + 256 * j); }
#define P10_LOAD(r_, A_, B_) do { const float* xr_ = (r_) < NP ? x_prompt + (size_t)(r_) * DM : x_sample + (size_t)((r_) - NP) * DM; \
        _Pragma("unroll") for (int j_ = 0; j_ < 4; ++j_) { B_[j_] = *(const f32x4*)(xr_ + 4 * lane + 256 * j_); \
            if ((r_) < NP) A_[j_] = *(const f32x4*)(HP + (size_t)(r_) * DM + 4 * lane + 256 * j_); \
            else { const float* p_ = PART + (size_t)((r_) - NP) * DM + 4 * lane + 256 * j_; A_[j_] = (*(const f32x4*)p_ + *(const f32x4*)(p_ + 512 * 1024)) + (*(const f32x4*)(p_ + 2 * 512 * 1024) + *(const f32x4*)(p_ + 3 * 512 * 1024)); } } } while (0)
        int row = gw;
        if (row < NT) P10_LOAD(row, a, b);
        for (; row < NT; row += NGW) {
            f32x4 an[4], bn[4]; const int nr = row + NGW;
            if (nr < NT) P10_LOAD(nr, an, bn);
            float ss = 0.f;
#pragma unroll
            for (int j = 0; j < 4; ++j) ss += a[j][0] * a[j][0] + a[j][1] * a[j][1] + a[j][2] * a[j][2] + a[j][3] * a[j][3];
            float r = rsqrtf(wave_sum(ss) * (1.f / DM) + EPS); ss = 0.f;
#pragma unroll
            for (int j = 0; j < 4; ++j) { a[j] = b[j] + a[j] * r * gp[j]; *(f32x4*)(H + (size_t)row * DM + 4 * lane + 256 * j) = a[j];
                ss += a[j][0] * a[j][0] + a[j][1] * a[j][1] + a[j][2] * a[j][2] + a[j][3] * a[j][3]; }
            r = rsqrtf(wave_sum(ss) * (1.f / DM) + EPS);
#pragma unroll
            for (int j = 0; j < 4; ++j) { const f32x4 f_ = a[j] * r * gf[j]; *(u32x2_t*)(Fb + (size_t)row * DM + 4 * lane + 256 * j) = (u32x2_t){cvtpk(f_[0], f_[1]), cvtpk(f_[2], f_[3])}; }
#pragma unroll
            for (int j = 0; j < 4; ++j) { a[j] = an[j]; b[j] = bn[j]; }
        }
#undef P10_LOAD
    }
    SEAM(10);
    if (IN(11)) {
        pg8::Gemm g{Fb, WguT, NT, 2 * DFF, 1024, 1024, 1024}; pg8::StaticOrder S; S.init(NT, 2 * DFF, G, bid); pg8::EpiSwiGLU E{ACTb, DFF};
        GEMM_PHASE(pg8::EpiSwiGLU, ldsb, g, S, E);
    }
    SEAM(11);
    if (IN(13)) { pg8::Gemm g{ACTb, WdT, NP, 1024, DFF, DFF, DFF}; pg8::StaticOrder S; S.init(NP, 1024, G, bid); pg8::EpiF32S E{FO, 1024, 0, 0};
        GEMM_PHASE(pg8::EpiF32S, ldsb, g, S, E);
        __syncthreads();
        { pg8::Gemm g2{ACTb, WdT, NT, 1024, 256, DFF, DFF, 256}; pg8::SplitOrder SS{11, bid}; pg8::EpiPart E2{PART}; GEMM_SPLIT(ldsb, g2, SS, E2); } }
    SEAM(13);
    if (IN(14)) {
        f32x4 gp[4], a[4], b[4];
#pragma unroll
        for (int j = 0; j < 4; ++j) gp[j] = *(const f32x4*)(g_ffn_post + 4 * lane + 256 * j);
#define P14_LOAD(r_, A_, B_) do { _Pragma("unroll") for (int j_ = 0; j_ < 4; ++j_) { B_[j_] = *(const f32x4*)(H + (size_t)(r_) * DM + 4 * lane + 256 * j_); \
            if ((r_) < NP) A_[j_] = *(const f32x4*)(FO + (size_t)(r_) * DM + 4 * lane + 256 * j_); \
            else { const float* p_ = PART + (size_t)((r_) - NP) * DM + 4 * lane + 256 * j_; f32x4 a_ = *(const f32x4*)p_; \
                _Pragma("unroll") for (int k_ = 1; k_ < 11; ++k_) a_ += *(const f32x4*)(p_ + (size_t)k_ * 512 * 1024); A_[j_] = a_; } } } while (0)
        int row = gw;
        if (row < NT) P14_LOAD(row, a, b);
        for (; row < NT; row += NGW) {
            f32x4 an[4], bn[4]; const int nr = row + NGW;
            if (nr < NT) P14_LOAD(nr, an, bn);
            float ss = 0.f;
#pragma unroll
            for (int j = 0; j < 4; ++j) ss += a[j][0] * a[j][0] + a[j][1] * a[j][1] + a[j][2] * a[j][2] + a[j][3] * a[j][3];
            const float r = rsqrtf(wave_sum(ss) * (1.f / DM) + EPS);
            float* y = row < NP ? out + O_YP + (size_t)row * DM : out + O_YS + (size_t)(row - NP) * DM;
#pragma unroll
            for (int j = 0; j < 4; ++j) *(f32x4*)(y + 4 * lane + 256 * j) = b[j] + a[j] * r * gp[j];
#pragma unroll
            for (int j = 0; j < 4; ++j) { a[j] = an[j]; b[j] = bn[j]; }
        }
#undef P14_LOAD
    }
#undef IN
#undef SEAM
}
constexpr int N_PHASES = 15;
}

extern "C" void kernel_launch(void* const* d_in, const int* in_sizes, int n_in, void* d_out, int out_size, void* d_ws, size_t ws_size, hipStream_t stream) {
    static int grid = 0;
    if (grid == 0) {
        if (n_in != 29 || (size_t)out_size != O_END || ws_size < WS_END) { fprintf(stderr, "kernel_launch: unexpected shapes: n_in %d out %d ws %zu (need %zu)\n", n_in, out_size, ws_size, (size_t)WS_END); grid = -1; return; }
        int dev = 0, cus = 0, per_cu = 0;
        if (hipGetDevice(&dev) != hipSuccess || hipDeviceGetAttribute(&cus, hipDeviceAttributeMultiprocessorCount, dev) != hipSuccess) { grid = -1; return; }
        if (hipFuncSetAttribute((const void*)fwd_kernel, hipFuncAttributeMaxDynamicSharedMemorySize, LDS_BYTES) != hipSuccess) { fprintf(stderr, "kernel_launch: hipFuncSetAttribute failed\n"); grid = -1; return; }
        if (hipOccupancyMaxActiveBlocksPerMultiprocessor(&per_cu, (const void*)fwd_kernel, NTHREADS, LDS_BYTES) != hipSuccess || per_cu < 1) { fprintf(stderr, "kernel_launch: occupancy query says %d\n", per_cu); per_cu = 1; }
        (void)hipGetLastError();
        grid = cus;
    }
    if (grid < 0) return;
    (void)hipMemsetAsync((char*)d_ws + WS_CTL, 0, CTL_BYTES, stream);
    Args a{};
    for (int i = 0; i < 29; ++i) a.in[i] = (const float*)d_in[i];
    a.out = (float*)d_out; a.ws = (unsigned char*)d_ws;
#if MK_ONE_LAUNCH
    a.ph_lo = 0; a.ph_hi = N_PHASES; a.sub = 0xff;
    hipLaunchKernelGGL(fwd_kernel, dim3(grid), dim3(NTHREADS), LDS_BYTES, stream, a);
#if PROBE_DUP >= 0
    a.ph_lo = PROBE_DUP; a.ph_hi = PROBE_DUP + 1; a.sub = PROBE_SUB;
    hipLaunchKernelGGL(fwd_kernel, dim3(grid), dim3(NTHREADS), LDS_BYTES, stream, a);
#endif
#else
    a.sub = 0xff; for (int p = 0; p < N_PHASES; ++p) { a.ph_lo = p; a.ph_hi = p + 1; hipLaunchKernelGGL(fwd_kernel, dim3(grid), dim3(NTHREADS), LDS_BYTES, stream, a); }
#endif
}
```

```cpp
#include <hip/hip_runtime.h>
#include <cstdio>
#include <cstdint>

#ifndef PROBE_DUP
#define PROBE_DUP -1
#endif
#ifndef PROBE_SUB
#define PROBE_SUB 0xff
#endif
#ifndef MK_ONE_LAUNCH
#define MK_ONE_LAUNCH 1
#endif

#define LAS __attribute__((address_space(3)))
#define GAS __attribute__((address_space(1)))
#define DI __device__ __forceinline__
typedef float f32x4 __attribute__((ext_vector_type(4)));
typedef __bf16 bf16x2_t __attribute__((ext_vector_type(2)));
typedef float f32x2_t __attribute__((ext_vector_type(2)));
DI unsigned cvtpk(float lo, float hi) { f32x2_t v = {lo, hi}; bf16x2_t b = __builtin_convertvector(v, bf16x2_t); return __builtin_bit_cast(unsigned, b); }

namespace {
constexpr int DM = 1024, NB = 8, SEQ = 2048, NP = NB * SEQ, DB = 128, DS = 4, NS = DB * DS, NT = NP + NS;
constexpr int PAST = 8192, PAGE = 128, NPAGES = PAST / PAGE;
constexpr int RH = 4, RDK = 128, RDV = 256;
constexpr int MH = 8, QL = 384, KVL = 256, DNOPE = 128, DROPE = 64, DVH = 128, DQH = DNOPE + DROPE;
constexpr int NMEM = 256, XH = 4, XHD = 64;
constexpr int DFF = 2816, DIN = 7104, ZLD = 7168;
constexpr int C_RQ = 0, C_RK = 512, C_RV = 1024, C_RG = 2048, C_CQ = 3072, C_CKV = 3456, C_KPE = 3712, C_XQ = 3776, C_G = 4032;
constexpr float EPS = 1e-6f;
constexpr int NPOS = SEQ + DS;
constexpr int NTHREADS = 512, NWAVES = 8;
constexpr int LDS_BYTES = 147456;
constexpr int MISC_OFF = 147456 - 256;

constexpr size_t O_YP = 0, O_YS = O_YP + (size_t)NP * DM, O_CKVP = O_YS + (size_t)NS * DM, O_KPEP = O_CKVP + (size_t)NP * KVL,
                 O_CKVS = O_KPEP + (size_t)NP * DROPE, O_KPES = O_CKVS + (size_t)NS * KVL, O_RETP = O_KPES + (size_t)NS * DROPE,
                 O_RETS = O_RETP + (size_t)NB * RH * RDK * RDV, O_MKP = O_RETS + (size_t)DB * RH * RDK * RDV, O_MVP = O_MKP + (size_t)NB * NMEM * 256,
                 O_END = O_MVP + (size_t)NB * NMEM * 256;

constexpr size_t al256(size_t x) { return (x + 255) & ~(size_t)255; }
constexpr size_t WS_CTL = 0, CTL_BYTES = 1u << 20;
constexpr size_t WS_COSA = WS_CTL + CTL_BYTES;
constexpr size_t WS_SINA = WS_COSA + al256((size_t)NPOS * 64 * 4);
constexpr size_t WS_COSB = WS_SINA + al256((size_t)NPOS * 64 * 4);
constexpr size_t WS_SINB = WS_COSB + al256((size_t)NPOS * 32 * 4);
constexpr size_t WS_U = WS_SINB + al256((size_t)NPOS * 32 * 4);
constexpr size_t WS_MN = WS_U + (size_t)NT * DM * 4;
constexpr size_t WS_Z = WS_MN + (size_t)NB * NMEM * DM * 4;
constexpr size_t WS_RQ = WS_Z + (size_t)NT * ZLD * 4;
constexpr size_t WS_RK = WS_RQ + (size_t)NT * 512 * 4;
constexpr size_t WS_CQN = WS_RK + (size_t)NT * 512 * 4;
constexpr size_t WS_CKVN = WS_CQN + (size_t)NT * QL * 4;
constexpr size_t WS_KPER = WS_CKVN + (size_t)NT * KVL * 4;
constexpr size_t WS_Q = WS_KPER + (size_t)NT * DROPE * 4;
constexpr size_t WS_QLAT = WS_Q + (size_t)NT * 1536 * 4;
constexpr size_t WS_QPE = WS_QLAT + (size_t)NT * 2048 * 4;
constexpr size_t WS_ORET = WS_QPE + (size_t)NT * 512 * 4;
constexpr size_t WS_OLAT = WS_ORET + (size_t)NT * 1024 * 4;
constexpr size_t WS_OX = WS_OLAT + (size_t)NT * 2048 * 4;
constexpr size_t WS_OMLA = WS_OX + (size_t)NT * 256 * 4;
constexpr size_t WS_ORETN = WS_OMLA + (size_t)NT * 1024 * 4;
constexpr size_t WS_ARET = WS_ORETN + (size_t)NT * 1024 * 4;
constexpr size_t WS_AMLA = WS_ARET + (size_t)NT * 1024 * 4;
constexpr size_t WS_AX = WS_AMLA + (size_t)NT * 1024 * 4;
constexpr size_t WS_MIX = WS_AX + (size_t)NT * 1024 * 4;
constexpr size_t WS_HP = WS_MIX + (size_t)NT * 1024 * 4;
constexpr size_t WS_H = WS_HP + (size_t)NT * 1024 * 4;
constexpr size_t WS_F = WS_H + (size_t)NT * 1024 * 4;
constexpr size_t WS_GG = WS_F + (size_t)NT * 1024 * 4;
constexpr size_t WS_UP = WS_GG + (size_t)NT * DFF * 4;
constexpr size_t WS_ACT = WS_UP + (size_t)NT * DFF * 4;
constexpr size_t WS_FO = WS_ACT + (size_t)NT * DFF * 4;
constexpr size_t WS_F32_END = WS_FO + (size_t)NT * 1024 * 4;
constexpr size_t WS_WIN_T = al256(WS_F32_END);
constexpr size_t WS_WMKV_T = WS_WIN_T + (size_t)ZLD * 1024 * 2;
constexpr size_t WS_WUQ_T = WS_WMKV_T + (size_t)512 * 1024 * 2;
constexpr size_t WS_WRO_T = WS_WUQ_T + (size_t)1536 * 384 * 2;
constexpr size_t WS_WMO_T = WS_WRO_T + (size_t)1024 * 1024 * 2;
constexpr size_t WS_WXO_T = WS_WMO_T + (size_t)1024 * 1024 * 2;
constexpr size_t WS_WO_T = WS_WXO_T + (size_t)1024 * 256 * 2;
constexpr size_t WS_WGU_T = WS_WO_T + (size_t)1024 * 1024 * 2;
constexpr size_t WS_WD_T = WS_WGU_T + (size_t)5632 * 1024 * 2;
constexpr size_t WS_UB = WS_WD_T + (size_t)1024 * 2816 * 2;
constexpr size_t WS_MNB = WS_UB + (size_t)NT * 1024 * 2;
constexpr size_t WS_CQNB = WS_MNB + (size_t)2048 * 1024 * 2;
constexpr size_t WS_ORETNB = WS_CQNB + (size_t)NT * 384 * 2;
constexpr size_t WS_OMLAB = WS_ORETNB + (size_t)NT * 1024 * 2;
constexpr size_t WS_OXB = WS_OMLAB + (size_t)NT * 1024 * 2;
constexpr size_t WS_MIXB = WS_OXB + (size_t)NT * 256 * 2;
constexpr size_t WS_FB = WS_MIXB + (size_t)NT * 1024 * 2;
constexpr size_t WS_ACTB = WS_FB + (size_t)NT * 1024 * 2;
constexpr size_t WS_WUK_T = WS_ACTB + (size_t)NT * 2816 * 2;
constexpr size_t WS_WUV_T = WS_WUK_T + (size_t)1024 * 256 * 2;
constexpr size_t WS_CKVNB = WS_WUV_T + (size_t)1024 * 256 * 2;
constexpr size_t WS_KPERB = WS_CKVNB + (size_t)NT * 256 * 2;
constexpr size_t WS_XQB = WS_KPERB + (size_t)NT * 64 * 2;
constexpr size_t WS_MKB = WS_XQB + (size_t)NT * 256 * 2;
constexpr size_t WS_MVT = WS_MKB + (size_t)2048 * 256 * 2;
constexpr size_t WS_KN = WS_MVT + (size_t)2048 * 256 * 2;
constexpr size_t WS_VT = WS_KN + (size_t)NP * 1024 * 2;
constexpr size_t WS_QB = WS_VT + (size_t)NP * 1024 * 2;
constexpr size_t WS_RQT = WS_QB + (size_t)NT * 1536 * 2;
constexpr size_t WS_RKT = WS_RQT + (size_t)NP * 512 * 2;
constexpr size_t WS_RKTT = WS_RKT + (size_t)NP * 512 * 2;
constexpr size_t WS_RVT = WS_RKTT + (size_t)NP * 512 * 2;
constexpr size_t WS_UT = WS_RVT + (size_t)NT * 1024 * 2;
constexpr size_t WS_SPT = WS_UT + (size_t)512 * 32768 * 4;
constexpr size_t WS_QLATB = WS_SPT + (size_t)512 * 32768 * 2;
constexpr size_t WS_PO = WS_QLATB + (size_t)NS * 2048 * 2;
constexpr size_t WS_PML = WS_PO + (size_t)DB * 2 * 32 * 256 * 4;
constexpr size_t WS_PART = al256(WS_PML + (size_t)DB * 2 * 32 * 2 * 4);
constexpr size_t WS_QPEB_ = WS_PART + (size_t)11 * 512 * 1024 * 4;
constexpr size_t WS_QPEB = al256(WS_QPEB_ + 0 * WS_PML + (size_t)DB * 2 * 32 * 2 * 4);
constexpr size_t WS_SGB = WS_QPEB + (size_t)NT * 512 * 2;
constexpr size_t WS_SRGB = WS_SGB + (size_t)NT * 3072 * 2;
constexpr size_t WS_T0B = WS_SRGB + (size_t)NT * 1024 * 2;
constexpr size_t WS_T1B = WS_T0B + (size_t)NT * 1024 * 2;
constexpr size_t WS_WUKB = WS_T1B + (size_t)NT * 1024 * 2;
constexpr size_t WS_END = WS_WUKB + (size_t)8 * 256 * 128 * 2;

constexpr int CW_BAR = 4096;

#define XB_TMO      128
#define XB_XCNT(j)  (256  + 64 * (j))
#define XB_XSUB(j)  (1280 + 64 * (j))
#define XB_XGEN(j)  (2304 + 64 * (j))
#define XB_TOP      3328
#define XB_TOPGEN   3392
#define XCD_BAR_WORDS 3456
#define XB_SPIN_CAP (1u << 25)

DI unsigned xb_ld(unsigned* p)              { return __hip_atomic_load(p, __ATOMIC_RELAXED, __HIP_MEMORY_SCOPE_AGENT); }
DI unsigned xb_add(unsigned* p, unsigned v) { return __hip_atomic_fetch_add(p, v, __ATOMIC_RELAXED, __HIP_MEMORY_SCOPE_AGENT); }
DI unsigned xb_xcc_id() { return (unsigned)__builtin_amdgcn_s_getreg((3 << 11) | 20) & 0xFu; }
#define XB_SPIN(cond, bar) do { unsigned _sp = 0; while (cond) { __builtin_amdgcn_s_sleep(1); \
    if ((++_sp & 255u) == 0u) { if (xb_ld(&(bar)[XB_TMO])) break; if (_sp > XB_SPIN_CAP) { atomicAdd(&(bar)[XB_TMO], 1u); break; } } } } while (0)

struct XcdBarrier { unsigned* bar; unsigned x; volatile LAS unsigned* st; };

DI XcdBarrier xcd_barrier_post(unsigned* bar, volatile LAS unsigned* st) {
    XcdBarrier b; b.bar = bar; b.x = xb_xcc_id(); b.st = st;
    if (threadIdx.x == 0) (void)xb_add(&bar[XB_XCNT(b.x)], 1u);
    return b;
}
DI void xcd_barrier_complete(unsigned* bar, unsigned x, unsigned& nloc, unsigned& nx) {
    const unsigned G = gridDim.x * gridDim.y * gridDim.z;
    unsigned sum, cnt, mine, sp = 0u;
    for (;;) {
        sum = 0u; cnt = 0u; mine = 0u;
#pragma unroll
        for (unsigned j = 0; j < 16; ++j) { const unsigned c = xb_ld(&bar[XB_XCNT(j)]); sum += c; cnt += (c > 0u) ? 1u : 0u; mine = (j == x) ? c : mine; }
        if (sum == G) break;
        __builtin_amdgcn_s_sleep(1);
        if ((++sp & 255u) == 0u) { if (xb_ld(&bar[XB_TMO])) break; if (sp > XB_SPIN_CAP) { atomicAdd(&bar[XB_TMO], 1u); break; } }
    }
    nloc = mine > 0u ? mine : 1u; nx = cnt > 0u ? cnt : 1u;
}
DI void xcd_barrier(const XcdBarrier& b) {
    asm volatile("s_waitcnt vmcnt(0)" ::: "memory");
    __syncthreads();
    if (threadIdx.x == 0) {
        unsigned* bar = b.bar;
        __builtin_amdgcn_s_waitcnt(0);
        unsigned nloc = b.st[0], nx = b.st[1];
        if (nloc == 0u) { xcd_barrier_complete(bar, b.x, nloc, nx); b.st[0] = nloc; b.st[1] = nx; }
        const unsigned old = xb_add(&bar[XB_XSUB(b.x)], 1u);
        const unsigned gen = old / nloc;
        if (old + 1u == (gen + 1u) * nloc) {
            __builtin_amdgcn_fence(__ATOMIC_RELEASE, "agent");
            asm volatile("s_waitcnt vmcnt(0)" ::: "memory");
            const unsigned og = xb_add(&bar[XB_TOP], 1u);
            const unsigned tg = og / nx;
            if (og + 1u == (tg + 1u) * nx) xb_add(&bar[XB_TOPGEN], 1u);
            else XB_SPIN(xb_ld(&bar[XB_TOPGEN]) == tg, bar);
            __builtin_amdgcn_fence(__ATOMIC_ACQUIRE, "agent");
            xb_add(&bar[XB_XGEN(b.x)], 1u);
            asm volatile("s_waitcnt vmcnt(0)" ::: "memory");
        } else {
            XB_SPIN(xb_ld(&bar[XB_XGEN(b.x)]) == gen, bar);
            __builtin_amdgcn_fence(__ATOMIC_ACQUIRE, "agent");
            asm volatile("s_waitcnt vmcnt(0)" ::: "memory");
        }
    }
    __syncthreads();
}

DI float wave_sum(float v) {
#pragma unroll
    for (int o = 1; o < 64; o <<= 1) v += __shfl_xor(v, o);
    return v;
}
DI float wave_max(float v) {
#pragma unroll
    for (int o = 1; o < 64; o <<= 1) v = fmaxf(v, __shfl_xor(v, o));
    return v;
}
DI float sigmoidf_(float x) { return 1.f / (1.f + expf(-x)); }
DI float siluf_(float x) { return x / (1.f + expf(-x)); }
DI int pos_index(int row) { return row < NP ? (row & (SEQ - 1)) : SEQ + ((row - NP) & (DS - 1)); }
DI float lg_gamma(int h) { return h == 0 ? -0.03174869831458027f : h == 1 ? -0.015748356968139112f : h == 2 ? -0.007843177461025892f : -0.003913899321136329f; }


namespace pg8 {
typedef unsigned short bf16_t;
typedef short bf16x8 __attribute__((ext_vector_type(8)));
typedef unsigned u32x4 __attribute__((ext_vector_type(4)));
typedef unsigned u32x2 __attribute__((ext_vector_type(2)));
constexpr int BM = 256, BK = 64, HALF = 128, HTB = HALF * BK * 2, STAGE_BYTES = 8 * HTB, NXCD = 8, WGM = 8;
__host__ __device__ __forceinline__ int lds_byte(int r, int c) { const int st = (r >> 4) * 2 + (c >> 5), rr = r & 15, cc = c & 31, ob = rr * 64 + cc * 2; return st * 1024 + (ob ^ (((ob >> 9) & 1) << 5)); }
__host__ __device__ __forceinline__ void stage_rc(int b, int& R, int& C) { const int st = b / 1024, sb = b % 1024, swz = sb ^ (((sb >> 9) & 1) << 5); R = (st >> 1) * 16 + swz / 64; C = (st & 1) * 32 + (swz % 64) / 2; }
__host__ __device__ __forceinline__ int perm32(int rho) { const int n = rho >> 4, i = rho & 15; return 8 * (i >> 2) + 4 * n + (i & 3); }
struct Unit { int pm, pn, ks; };
struct Gemm { const bf16_t* A; const bf16_t* Bt; int M, N, K, lda, ldb, ksl; };
struct StaticOrder {
    int nM, nN, nwg, G, c;
    __host__ __device__ void init(int M, int N, int G_, int c_) { nM = M / BM; nN = N / BM; nwg = nM * nN; G = G_; c = c_; }
    __host__ __device__ bool next(int i, Unit& u) const {
        const long L = (long)i * G + c; if (L >= nwg) return false;
        int wgid = (int)L; { const int q = nwg / NXCD, r = nwg % NXCD, xcd = wgid % NXCD, off = wgid / NXCD; wgid = (xcd < r ? xcd * (q + 1) : r * (q + 1) + (xcd - r) * q) + off; }
        const int nig = WGM * nN, gid = wgid / nig, fm = gid * WGM, gsz = (nM - fm) < WGM ? (nM - fm) : WGM;
        u.pm = fm + ((wgid % nig) % gsz); u.pn = (wgid % nig) / gsz; u.ks = 0; return true;
    }
    __device__ __forceinline__ void a_ready(const Unit&) const {}
    __device__ __forceinline__ void done(const Unit&) const {}
};
__device__ __forceinline__ unsigned cvt_pk_bf16(float lo, float hi) { return cvtpk(lo, hi); }
struct SplitOrder {
    int KS, c;
    __host__ __device__ bool next(int i, Unit& u) const { if (i != 0 || c >= 8 * KS) return false; const int tile = c / KS; u.ks = c % KS; u.pm = 64 + (tile >> 2); u.pn = tile & 3; return true; }
    __device__ __forceinline__ void a_ready(const Unit&) const {}
    __device__ __forceinline__ void done(const Unit&) const {}
};
struct EpiPart {
    static constexpr bool PERM = false, AFTER_DRAIN = false;
    float* C;
    __device__ __forceinline__ void operator()(const f32x4 (&acc)[2][2][4][2], const Unit& u, int wr, int wc, int fr, int fq) const {
        const int row0 = (u.pm - 64) * BM + wr * 64 + fr, col0 = u.pn * BM + wc * 32 + 4 * fq; float* base = C + (size_t)u.ks * (512 * 1024);
#pragma unroll
        for (int ai = 0; ai < 2; ++ai)
#pragma unroll
            for (int m = 0; m < 4; ++m) { float* rowp = base + (size_t)(row0 + ai * HALF + m * 16) * 1024 + col0;
#pragma unroll
                for (int bj = 0; bj < 2; ++bj)
#pragma unroll
                    for (int n = 0; n < 2; ++n) *(f32x4*)(rowp + bj * HALF + n * 16) = acc[ai][bj][m][n]; }
    }
};
struct P1Order {
    StaticOrder so;
    __host__ __device__ void init(int G_, int c_) { so.init(64 * 256, 24 * 256, G_, c_); }
    __host__ __device__ bool next(int i, Unit& u) const {
        const long L = (long)i * so.G + so.c;
        if (L < 1536) { so.next(i, u); if (u.pn >= 4) u.pn += 4; return true; }
        u.ks = 0;
        if (L < 1536 + 56) { const int idx = (int)L - 1536; u.pm = 64 + idx / 28; u.pn = idx % 28; return true; }
        if (L < 1536 + 56 + 16) { const int idx = (int)L - 1592; u.pm = 66 + idx / 2; u.pn = 28 + idx % 2; return true; }
        return false;
    }
    __device__ __forceinline__ void a_ready(const Unit&) const {}
    __device__ __forceinline__ void done(const Unit&) const {}
};
struct EpiP1 {
    static constexpr bool PERM = true, AFTER_DRAIN = false;
    bf16_t* Zp; int ldz; float* mk; float* mv; bf16_t* srg; bf16_t* sg; int c_rg, c_g;
    __device__ __forceinline__ void operator()(const f32x4 (&acc)[2][2][4][2], const Unit& u, int wr, int wc, int fr, int fq) const {
        if (u.pm >= 66) {
            float* base = (u.pn == 28) ? mk : mv; const int row0 = (u.pm - 66) * BM + wr * 64 + fr, col0 = wc * 32 + 8 * fq;
#pragma unroll
            for (int ai = 0; ai < 2; ++ai)
#pragma unroll
                for (int m = 0; m < 4; ++m) { float* rowp = base + (size_t)(row0 + ai * HALF + m * 16) * 256 + col0;
#pragma unroll
                    for (int bj = 0; bj < 2; ++bj) { *(f32x4*)(rowp + bj * HALF) = acc[ai][bj][m][0]; *(f32x4*)(rowp + bj * HALF + 4) = acc[ai][bj][m][1]; } }
            return;
        }
        const int row0 = u.pm * BM + wr * 64 + fr, col0 = u.pn * BM + wc * 32 + 8 * fq;
#pragma unroll
        for (int bj = 0; bj < 2; ++bj) { const int c = col0 + bj * HALF;
            if (c >= c_g + 3072) continue;
            const int kind = c >= c_g ? 2 : (c >= c_rg && c < c_rg + 1024) ? 1 : 0;
            bf16_t* dst = kind == 2 ? sg + (c - c_g) : kind == 1 ? srg + (c - c_rg) : Zp + c; const int ld = kind == 2 ? 3072 : kind == 1 ? 1024 : ldz;
#pragma unroll
            for (int ai = 0; ai < 2; ++ai)
#pragma unroll
                for (int m = 0; m < 4; ++m) { f32x4 v0 = acc[ai][bj][m][0], v1 = acc[ai][bj][m][1];
                    if (kind) {
#pragma unroll
                        for (int e = 0; e < 4; ++e) { const float s0 = 1.f / (1.f + __expf(-v0[e])), s1 = 1.f / (1.f + __expf(-v1[e])); v0[e] = kind == 2 ? s0 : v0[e] * s0; v1[e] = kind == 2 ? s1 : v1[e] * s1; } }
                    u32x4 w; w.x = cvt_pk_bf16(v0[0], v0[1]); w.y = cvt_pk_bf16(v0[2], v0[3]); w.z = cvt_pk_bf16(v1[0], v1[1]); w.w = cvt_pk_bf16(v1[2], v1[3]);
                    *(u32x4*)(dst + (size_t)(row0 + ai * HALF + m * 16) * ld) = w; } }
    }
};
struct EpiF32S {
    static constexpr bool PERM = false, AFTER_DRAIN = false;
    float* C; int ldc; int split_tiles; size_t split_stride;
    __device__ __forceinline__ void operator()(const f32x4 (&acc)[2][2][4][2], const Unit& u, int wr, int wc, int fr, int fq) const {
        int pn = u.pn; float* base = C; if (split_tiles) { const int t = pn / split_tiles; base += (size_t)t * split_stride; pn -= t * split_tiles; }
        const int row0 = u.pm * BM + wr * 64 + fr, col0 = pn * BM + wc * 32 + 4 * fq;
#pragma unroll
        for (int ai = 0; ai < 2; ++ai)
#pragma unroll
            for (int m = 0; m < 4; ++m) { float* rowp = base + (size_t)(row0 + ai * HALF + m * 16) * ldc + col0;
#pragma unroll
                for (int bj = 0; bj < 2; ++bj)
#pragma unroll
                    for (int n = 0; n < 2; ++n) *(f32x4*)(rowp + bj * HALF + n * 16) = acc[ai][bj][m][n]; }
    }
};
struct EpiBf16S {
    static constexpr bool PERM = true, AFTER_DRAIN = false;
    bf16_t* O; int ldc;
    __device__ __forceinline__ void operator()(const f32x4 (&acc)[2][2][4][2], const Unit& u, int wr, int wc, int fr, int fq) const {
        const int row0 = u.pm * BM + wr * 64 + fr, col0 = u.pn * BM + wc * 32 + 8 * fq;
#pragma unroll
        for (int ai = 0; ai < 2; ++ai)
#pragma unroll
            for (int m = 0; m < 4; ++m) { bf16_t* rowp = O + (size_t)(row0 + ai * HALF + m * 16) * ldc + col0;
#pragma unroll
                for (int bj = 0; bj < 2; ++bj) { const f32x4 v0 = acc[ai][bj][m][0], v1 = acc[ai][bj][m][1];
                    u32x4 w; w.x = cvt_pk_bf16(v0[0], v0[1]); w.y = cvt_pk_bf16(v0[2], v0[3]); w.z = cvt_pk_bf16(v1[0], v1[1]); w.w = cvt_pk_bf16(v1[2], v1[3]);
                    *(u32x4*)(rowp + bj * HALF) = w; } }
    }
};
struct EpiSwiGLU {
    static constexpr bool PERM = true, AFTER_DRAIN = false;
    bf16_t* O; int ldc;
    __device__ __forceinline__ void operator()(const f32x4 (&acc)[2][2][4][2], const Unit& u, int wr, int wc, int fr, int fq) const {
        const int row0 = u.pm * BM + wr * 64 + fr, col0 = u.pn * (BM / 2) + wc * 16 + 4 * fq;
#pragma unroll
        for (int ai = 0; ai < 2; ++ai)
#pragma unroll
            for (int m = 0; m < 4; ++m) { bf16_t* rowp = O + (size_t)(row0 + ai * HALF + m * 16) * ldc + col0;
#pragma unroll
                for (int bj = 0; bj < 2; ++bj) { const f32x4 v0 = acc[ai][bj][m][0], v1 = acc[ai][bj][m][1];
                    const float a0 = v0[0] / (1.f + __expf(-v0[0])) * v0[1], a1 = v0[2] / (1.f + __expf(-v0[2])) * v0[3];
                    const float a2 = v1[0] / (1.f + __expf(-v1[0])) * v1[1], a3 = v1[2] / (1.f + __expf(-v1[2])) * v1[3];
                    u32x2 w; w.x = cvt_pk_bf16(a0, a1); w.y = cvt_pk_bf16(a2, a3);
                    *(u32x2*)(rowp + bj * (HALF / 2)) = w; } }
    }
};
template <int MODE  > struct EpiGate {
    static constexpr bool PERM = true, AFTER_DRAIN = false;
    const bf16_t* sg; const bf16_t* tin; bf16_t* tout; int ldc;
    __device__ __forceinline__ void operator()(const f32x4 (&acc)[2][2][4][2], const Unit& u, int wr, int wc, int fr, int fq) const {
        const int row0 = u.pm * BM + wr * 64 + fr, col0 = u.pn * BM + wc * 32 + 8 * fq;
#pragma unroll
        for (int ai = 0; ai < 2; ++ai)
#pragma unroll
            for (int m = 0; m < 4; ++m) { const size_t r = (size_t)(row0 + ai * HALF + m * 16);
#pragma unroll
                for (int bj = 0; bj < 2; ++bj) { const int c = col0 + bj * HALF;
                    const u32x4 gq = *(const u32x4*)(sg + r * 3072 + c); u32x4 tq = {0u, 0u, 0u, 0u}; if (MODE >= 1) tq = *(const u32x4*)(tin + r * ldc + c);
                    const f32x4 v0 = acc[ai][bj][m][0], v1 = acc[ai][bj][m][1]; u32x4 w;
#define EG_ONE(dst, x0, x1, gw_, tw_) { float a_ = (x0) * __builtin_bit_cast(float, (gw_) << 16), b_ = (x1) * __builtin_bit_cast(float, (gw_) & 0xffff0000u); \
                        if (MODE >= 1) { a_ += __builtin_bit_cast(float, (tw_) << 16); b_ += __builtin_bit_cast(float, (tw_) & 0xffff0000u); } dst = cvt_pk_bf16(a_, b_); }
                    EG_ONE(w.x, v0[0], v0[1], gq.x, tq.x) EG_ONE(w.y, v0[2], v0[3], gq.y, tq.y) EG_ONE(w.z, v1[0], v1[1], gq.z, tq.z) EG_ONE(w.w, v1[2], v1[3], gq.w, tq.w)
#undef EG_ONE
                    *(u32x4*)(tout + r * ldc + c) = w; } }
    }
};
template <class Epi, class Sched, bool ALIGN_EPI = false, bool SP2 = false>
__device__ __forceinline__ void gemm_phase(LAS unsigned char* lds, const Gemm g, const Sched& S, const Epi& E) {
    const int tid = threadIdx.x, wid = __builtin_amdgcn_readfirstlane(tid >> 6), lane = tid & 63, wr = wid >> 2, wc = wid & 3, fr = lane & 15, fq = lane >> 4;
    const int K = g.K, nt = K / BK;
    unsigned voffA[2], voffB[2];
#pragma unroll
    for (int i = 0; i < 2; ++i) { int R, C; stage_rc(tid * 16 + i * 8192, R, C); const int Rb = Epi::PERM ? ((R & ~31) + perm32(R & 31)) : R;
        voffA[i] = (unsigned)(R * g.lda + C) * 2u; voffB[i] = (unsigned)(Rb * g.ldb + C) * 2u; }
    const size_t kstep = (size_t)(BK * 2);
    const size_t hstepA = (size_t)HALF * g.lda * 2, hstepB = (size_t)HALF * g.ldb * 2;
    const size_t tstepA = 2 * hstepA, tstepB = 2 * hstepB;
    const unsigned ldsw = (unsigned)wid * 1024u;
    const int aoff = lds_byte(wr * 64 + fr, fq * 8), boff = lds_byte(wc * 32 + fr, fq * 8);
#define PG8_SA(b, h) (((b) * 2 + (h)) * HTB)
#define PG8_SB(b, h) ((4 + (b) * 2 + (h)) * HTB)
#define PG8_STAGE(bufoff, gbase, voff) do { _Pragma("unroll") for (int _i = 0; _i < 2; ++_i) \
        __builtin_amdgcn_global_load_lds((const unsigned*)((const char*)(gbase) + (voff)[_i]), (LAS unsigned*)(lds + (bufoff) + ldsw + _i * 8192), 16, 0, 0); } while (0)
#define PG8_LDA(dst, b, h) do { _Pragma("unroll") for (int m = 0; m < 4; ++m) _Pragma("unroll") for (int k = 0; k < 2; ++k) dst[m][k] = *(const LAS bf16x8*)(lds + PG8_SA(b, h) + aoff + m * 2048 + k * 1024); } while (0)
#define PG8_LDB(dst, b, h) do { _Pragma("unroll") for (int n = 0; n < 2; ++n) _Pragma("unroll") for (int k = 0; k < 2; ++k) dst[n][k] = *(const LAS bf16x8*)(lds + PG8_SB(b, h) + boff + n * 2048 + k * 1024); } while (0)
#define PG8_MMA(ai, bj, At, Bt) do { __builtin_amdgcn_s_setprio(1); _Pragma("unroll") for (int m = 0; m < 4; ++m) _Pragma("unroll") for (int n = 0; n < 2; ++n) _Pragma("unroll") for (int k = 0; k < 2; ++k) \
        acc[ai][bj][m][n] = __builtin_amdgcn_mfma_f32_16x16x32_bf16(Bt[n][k], At[m][k], acc[ai][bj][m][n], 0, 0, 0); __builtin_amdgcn_s_setprio(0); } while (0)
#define PG8_WAIT_V(n) asm volatile("s_waitcnt vmcnt(" #n ")" ::: "memory")
#define PG8_WAIT_L(n) asm volatile("s_waitcnt lgkmcnt(" #n ")" ::: "memory")
#define PG8_BAR __builtin_amdgcn_s_barrier()
#define PG8_SCHED __builtin_amdgcn_sched_barrier(0)
    Unit cur, nxt; int ui = 0;
    if (!S.next(0, cur)) return;
    f32x4 acc[2][2][4][2];
#pragma unroll
    for (int a = 0; a < 2; ++a)
#pragma unroll
        for (int b = 0; b < 2; ++b)
#pragma unroll
            for (int m = 0; m < 4; ++m)
#pragma unroll
                for (int n = 0; n < 2; ++n) acc[a][b][m][n] = (f32x4){0.f, 0.f, 0.f, 0.f};
    bf16x8 At[4][2], B0[2][2], B1[2][2];
    const size_t kslb = (size_t)g.ksl * 2;
    const char* cA = (const char*)g.A + (size_t)cur.pm * tstepA + cur.ks * kslb; const char* cB = (const char*)g.Bt + (size_t)cur.pn * tstepB + cur.ks * kslb;
    S.a_ready(cur);
    if constexpr (SP2) {
        PG8_STAGE(PG8_SB(0, 0), cB, voffB); PG8_STAGE(PG8_SB(0, 1), cB + hstepB, voffB); PG8_STAGE(PG8_SA(0, 0), cA, voffA); PG8_STAGE(PG8_SA(0, 1), cA + hstepA, voffA);
        if (wr == 1) PG8_BAR;
        PG8_WAIT_V(2); PG8_BAR;
        PG8_STAGE(PG8_SB(1, 0), cB + kstep, voffB); PG8_STAGE(PG8_SA(1, 0), cA + kstep, voffA); PG8_STAGE(PG8_SB(1, 1), cB + hstepB + kstep, voffB);
        PG8_WAIT_V(6); PG8_BAR;
    } else {
        PG8_STAGE(PG8_SB(0, 0), cB, voffB); PG8_STAGE(PG8_SA(0, 0), cA, voffA); PG8_STAGE(PG8_SB(0, 1), cB + hstepB, voffB); PG8_STAGE(PG8_SA(0, 1), cA + hstepA, voffA);
        if (wr == 1) PG8_BAR;
        PG8_WAIT_V(4); PG8_BAR;
        PG8_STAGE(PG8_SB(1, 0), cB + kstep, voffB); PG8_STAGE(PG8_SA(1, 0), cA + kstep, voffA); PG8_STAGE(PG8_SB(1, 1), cB + hstepB + kstep, voffB);
        PG8_WAIT_V(6); PG8_BAR;
    }
    for (;;) {
        const bool has_next = S.next(ui + 1, nxt);
        const char* nA = has_next ? (const char*)g.A + (size_t)nxt.pm * tstepA + nxt.ks * kslb : cA; const char* nB = has_next ? (const char*)g.Bt + (size_t)nxt.pn * tstepB + nxt.ks * kslb : cB;
#pragma unroll 1
        for (int t = 0; t < nt; t += 2) {
            const bool last = (t == nt - 2);
            const char* a1 = cA + (size_t)(t + 1) * kstep;
            const char* a2 = last ? nA : cA + (size_t)(t + 2) * kstep; const char* b2 = last ? nB : cB + (size_t)(t + 2) * kstep;
            const char* a3 = a2 + kstep; const char* b3 = b2 + kstep;
            if (last && has_next) S.a_ready(nxt);
            if constexpr (SP2) {
            PG8_LDB(B0, 0, 0); PG8_LDB(B1, 0, 1); PG8_SCHED; PG8_LDA(At, 0, 0); PG8_STAGE(PG8_SA(1, 1), a1 + hstepA, voffA);
            PG8_WAIT_V(8); PG8_WAIT_L(0); PG8_BAR; PG8_MMA(0, 0, At, B0); PG8_MMA(0, 1, At, B1); PG8_BAR; PG8_SCHED;
            PG8_LDA(At, 0, 1); PG8_STAGE(PG8_SB(0, 0), b2, voffB); PG8_STAGE(PG8_SB(0, 1), b2 + hstepB, voffB); PG8_STAGE(PG8_SA(0, 0), a2, voffA);
            PG8_WAIT_V(8); PG8_WAIT_L(0); PG8_BAR; PG8_MMA(1, 0, At, B0); PG8_MMA(1, 1, At, B1); PG8_BAR; PG8_SCHED;
            PG8_LDB(B0, 1, 0); PG8_LDB(B1, 1, 1); PG8_SCHED; PG8_LDA(At, 1, 0); PG8_STAGE(PG8_SA(0, 1), a2 + hstepA, voffA);
            PG8_WAIT_V(8); PG8_WAIT_L(0); PG8_BAR; PG8_MMA(0, 0, At, B0); PG8_MMA(0, 1, At, B1); PG8_BAR; PG8_SCHED;
            PG8_LDA(At, 1, 1); PG8_STAGE(PG8_SB(1, 0), b3, voffB); PG8_STAGE(PG8_SB(1, 1), b3 + hstepB, voffB); PG8_STAGE(PG8_SA(1, 0), a3, voffA);
            PG8_WAIT_V(8); PG8_WAIT_L(0); PG8_BAR; PG8_MMA(1, 0, At, B0); PG8_MMA(1, 1, At, B1); PG8_BAR; PG8_SCHED;
            } else {
            PG8_LDB(B0, 0, 0); PG8_SCHED; PG8_LDA(At, 0, 0); PG8_STAGE(PG8_SA(1, 1), a1 + hstepA, voffA);
            PG8_WAIT_L(8); PG8_BAR; PG8_WAIT_L(0); PG8_MMA(0, 0, At, B0); PG8_BAR; PG8_SCHED;
            PG8_LDB(B1, 0, 1); PG8_STAGE(PG8_SB(0, 0), b2, voffB);
            PG8_BAR; PG8_WAIT_L(0); PG8_MMA(0, 1, At, B1); PG8_BAR;
            PG8_LDA(At, 0, 1); PG8_STAGE(PG8_SA(0, 0), a2, voffA);
            PG8_BAR; PG8_WAIT_L(0); PG8_MMA(1, 0, At, B0); PG8_BAR; PG8_SCHED;
            PG8_STAGE(PG8_SB(0, 1), b2 + hstepB, voffB);
            PG8_WAIT_V(6); PG8_BAR; PG8_MMA(1, 1, At, B1); PG8_BAR;
            PG8_LDB(B0, 1, 0); PG8_SCHED; PG8_LDA(At, 1, 0); PG8_STAGE(PG8_SA(0, 1), a2 + hstepA, voffA);
            PG8_WAIT_L(8); PG8_BAR; PG8_WAIT_L(0); PG8_MMA(0, 0, At, B0); PG8_BAR; PG8_SCHED;
            PG8_LDB(B1, 1, 1); PG8_STAGE(PG8_SB(1, 0), b3, voffB);
            PG8_BAR; PG8_WAIT_L(0); PG8_MMA(0, 1, At, B1); PG8_BAR;
            PG8_LDA(At, 1, 1); PG8_STAGE(PG8_SA(1, 0), a3, voffA);
            PG8_BAR; PG8_WAIT_L(0); PG8_MMA(1, 0, At, B0); PG8_BAR; PG8_SCHED;
            PG8_STAGE(PG8_SB(1, 1), b3 + hstepB, voffB);
            PG8_WAIT_V(6); PG8_BAR; PG8_MMA(1, 1, At, B1); PG8_BAR;
            }
        }
        if constexpr (ALIGN_EPI) { if (wr == 0) PG8_BAR; }
        if constexpr (!Epi::AFTER_DRAIN) { E(acc, cur, wr, wc, fr, fq); S.done(cur); }
        if (!has_next) break;
#pragma unroll
        for (int a = 0; a < 2; ++a)
#pragma unroll
            for (int b = 0; b < 2; ++b)
#pragma unroll
                for (int m = 0; m < 4; ++m)
#pragma unroll
                    for (int n = 0; n < 2; ++n) acc[a][b][m][n] = (f32x4){0.f, 0.f, 0.f, 0.f};
        cur = nxt; cA = nA; cB = nB; ++ui;
        if constexpr (ALIGN_EPI) { if (wr == 1) PG8_BAR; }
    }
    PG8_WAIT_V(0);
    if constexpr (!ALIGN_EPI) { if (wr == 0) PG8_BAR; }
    PG8_BAR;
    if constexpr (Epi::AFTER_DRAIN) { E.fused(acc, cur, wr, wc, fr, fq, lds, wid, lane); S.done(cur); }
#undef PG8_SA
#undef PG8_SB
#undef PG8_STAGE
#undef PG8_LDA
#undef PG8_LDB
#undef PG8_MMA
#undef PG8_WAIT_V
#undef PG8_WAIT_L
#undef PG8_BAR
#undef PG8_SCHED
}
}
typedef unsigned short bf16_t;
DI unsigned pk2(float lo, float hi) { return pg8::cvt_pk_bf16(lo, hi); }
DI bf16_t f2bf(float f) { return (bf16_t)(pg8::cvt_pk_bf16(f, 0.f) & 0xffffu); }
DI void transpose_item(const float* W, int N, bf16_t* WT, int ldt, int row_off, int rmul, LAS float* scr, int item, int lane) {
    const int nblk = N / 32, kb = item / nblk, nb = item % nblk, k0 = 64 * kb, n0 = 32 * nb;
#pragma unroll 8
    for (int i = 0; i < 32; ++i) { const int kk = 2 * i + (lane >> 5); scr[kk * 33 + (lane & 31)] = W[(size_t)(k0 + kk) * N + n0 + (lane & 31)]; }
    asm volatile("s_waitcnt lgkmcnt(0)" ::: "memory");
    const int c = lane & 7;
#pragma unroll
    for (int j = 0; j < 4; ++j) { const int n = (lane >> 3) + 8 * j; const LAS float* sp = scr + (8 * c) * 33 + n;
        pg8::u32x4 o; o.x = pk2(sp[0 * 33], sp[1 * 33]); o.y = pk2(sp[2 * 33], sp[3 * 33]); o.z = pk2(sp[4 * 33], sp[5 * 33]); o.w = pk2(sp[6 * 33], sp[7 * 33]);
        *(pg8::u32x4*)(WT + (size_t)(row_off + rmul * (n0 + n)) * ldt + k0 + 8 * c) = o; }
    asm volatile("s_waitcnt lgkmcnt(0)" ::: "memory");
}
DI void transpose_w(const float* W, int K, int N, bf16_t* WT, int ldt, int row_off, LAS float* scr, int gw, int NGW, int lane, int& rot, int rmul = 1) {
    const int nitems = (K / 64) * (N / 32);
    int first = gw - (rot % NGW); if (first < 0) first += NGW;
    for (int it = first; it < nitems; it += NGW) transpose_item(W, N, WT, ldt, row_off, rmul, scr, it, lane);
    rot += nitems;
}

struct Args {
    const float* in[29]; float* out; unsigned char* ws; int ph_lo, ph_hi, sub, pad;
};

DI unsigned short f2bf_raw(float f) { unsigned u = __builtin_bit_cast(unsigned, f); return (unsigned short)((u + 0x7fffu + ((u >> 16) & 1u)) >> 16); }
DI void sgemm_naive(LAS float* lds, const float* __restrict__ A, int lda, const float* __restrict__ B, long sbk, long sbn,
                    float* __restrict__ C, int ldc, int M, int N, int K, int bid, int G, unsigned short* Cb = nullptr) {
    LAS float* As = lds;
    LAS float* Bs = lds + 16 * 132;
    const int tid = threadIdx.x, tx = tid & 15, ty = tid >> 4;
    const int ntn = N / 64, ntiles = (M / 128) * ntn;
    for (int t = bid; t < ntiles; t += G) {
        const int m0 = (t / ntn) * 128, n0 = (t % ntn) * 64;
        float acc[4][4];
#pragma unroll
        for (int i = 0; i < 4; ++i)
#pragma unroll
            for (int j = 0; j < 4; ++j) acc[i][j] = 0.f;
        for (int k0 = 0; k0 < K; k0 += 16) {
            {
                const int r = tid >> 2, kq = (tid & 3) * 4;
                const float4 v = *(const float4*)(A + (size_t)(m0 + r) * lda + k0 + kq);
                As[(kq + 0) * 132 + r] = v.x; As[(kq + 1) * 132 + r] = v.y; As[(kq + 2) * 132 + r] = v.z; As[(kq + 3) * 132 + r] = v.w;
            }
#pragma unroll
            for (int i = 0; i < 2; ++i) {
                const int idx = tid + i * 512, kk = idx >> 6, nn = idx & 63;
                Bs[kk * 64 + nn] = B[(size_t)(k0 + kk) * sbk + (size_t)(n0 + nn) * sbn];
            }
            __syncthreads();
#pragma unroll
            for (int kk = 0; kk < 16; ++kk) {
                const f32x4 a = *(const LAS f32x4*)(As + kk * 132 + ty * 4);
                const f32x4 b = *(const LAS f32x4*)(Bs + kk * 64 + tx * 4);
                const float av[4] = {a.x, a.y, a.z, a.w}, bv[4] = {b.x, b.y, b.z, b.w};
#pragma unroll
                for (int i = 0; i < 4; ++i)
#pragma unroll
                    for (int j = 0; j < 4; ++j) acc[i][j] += av[i] * bv[j];
            }
            __syncthreads();
        }
#pragma unroll
        for (int i = 0; i < 4; ++i) {
            float4 o; o.x = acc[i][0]; o.y = acc[i][1]; o.z = acc[i][2]; o.w = acc[i][3];
            if (Cb) { unsigned short* cb = Cb + (size_t)(m0 + ty * 4 + i) * ldc + n0 + tx * 4; cb[0] = f2bf_raw(o.x); cb[1] = f2bf_raw(o.y); cb[2] = f2bf_raw(o.z); cb[3] = f2bf_raw(o.w); }
            else *(float4*)(C + (size_t)(m0 + ty * 4 + i) * ldc + n0 + tx * 4) = o;
        }
    }
}

template <int DQK, int DV, bool V_IN_K, int MODE, class KV, class QF>
DI void attn_naive(LAS float* lds, const KV& kv, int nk_loop, const QF& qf, bool active, int limit, float scale, float lg, int tq, float* optr) {
    constexpr int KS = DQK + 1;
    constexpr int VS = V_IN_K ? KS : DV;
    LAS float* Ks = lds;
    LAS float* Vs = V_IN_K ? Ks : (lds + 64 * KS);
    LAS float* qs = lds + 64 * KS + (V_IN_K ? 0 : 64 * DV);
    LAS float* ps = qs + 8 * DQK;
    static_assert((64 * KS + (V_IN_K ? 0 : 64 * DV) + 8 * DQK + 8 * 64) * 4 <= MISC_OFF, "attn_naive LDS");
    const int tid = threadIdx.x, lane = tid & 63, w = tid >> 6;
    __syncthreads();
    for (int d = lane; d < DQK; d += 64) qs[w * DQK + d] = active ? qf(d) : 0.f;
    float m = -INFINITY, l = 0.f;
    float acc[DV / 64];
#pragma unroll
    for (int c = 0; c < DV / 64; ++c) acc[c] = 0.f;
    for (int base = 0; base < nk_loop; base += 64) {
        __syncthreads();
        for (int idx = tid; idx < 64 * DQK; idx += NTHREADS) { const int j = idx / DQK, d = idx - j * DQK, key = base + j; Ks[j * KS + d] = key < nk_loop ? kv.k(key, d) : 0.f; }
        if (!V_IN_K) for (int idx = tid; idx < 64 * DV; idx += NTHREADS) { const int j = idx / DV, e = idx - j * DV, key = base + j; Vs[j * DV + e] = key < nk_loop ? kv.v(key, e) : 0.f; }
        __syncthreads();
        const int key = base + lane; const bool valid = active && key <= limit && key < nk_loop;
        float s = 0.f;
        for (int d = 0; d < DQK; ++d) s += qs[w * DQK + d] * Ks[lane * KS + d];
        float p;
        if (MODE == 0) {
            s *= scale;
            const float cm = wave_max(valid ? s : -INFINITY);
            const float mn = fmaxf(m, cm);
            const float alpha = (mn == -INFINITY) ? 1.f : expf(m - mn);
            p = valid ? expf(s - mn) : 0.f;
            l = l * alpha + wave_sum(p);
#pragma unroll
            for (int c = 0; c < DV / 64; ++c) acc[c] *= alpha;
            m = mn;
        } else {
            p = valid ? s * expf((float)(tq - key) * lg) : 0.f;
        }
        ps[w * 64 + lane] = p;
        __syncthreads();
        for (int j = 0; j < 64; ++j) { const float pj = ps[w * 64 + j];
#pragma unroll
            for (int c = 0; c < DV / 64; ++c) acc[c] += pj * Vs[j * VS + lane + 64 * c]; }
    }
    if (active) {
#pragma unroll
        for (int c = 0; c < DV / 64; ++c) optr[lane + 64 * c] = (MODE == 0) ? acc[c] / l : acc[c];
    }
}

struct KvMlaPrompt { const float* ckvn; const float* kper; int b;
    DI float k(int key, int d) const { const size_t row = (size_t)b * SEQ + key; return d < KVL ? ckvn[row * KVL + d] : kper[row * DROPE + (d - KVL)]; }
    DI float v(int, int) const { return 0.f; } };
struct KvMlaSample { const float* ckvn; const float* kper; const float* cckv; const float* ckpe; const int* pt; int b;
    DI float k(int key, int d) const {
        if (key < PAST) { const size_t r = (size_t)pt[b * NPAGES + (key >> 7)] * PAGE + (key & (PAGE - 1)); return d < KVL ? cckv[r * KVL + d] : ckpe[r * DROPE + (d - KVL)]; }
        const size_t row = (size_t)NP + b * DS + (key - PAST); return d < KVL ? ckvn[row * KVL + d] : kper[row * DROPE + (d - KVL)]; }
    DI float v(int, int) const { return 0.f; } };
struct KvRet { const float* rk; const float* z; int b, h;
    DI float k(int key, int d) const { return rk[((size_t)b * SEQ + key) * 512 + h * RDK + d]; }
    DI float v(int key, int e) const { return z[((size_t)b * SEQ + key) * ZLD + C_RV + h * RDV + e]; } };
struct KvMem { const float* mk; const float* mv; int b, h;
    DI float k(int key, int d) const { return mk[(((size_t)b * NMEM + key) * XH + h) * XHD + d]; }
    DI float v(int key, int e) const { return mv[(((size_t)b * NMEM + key) * XH + h) * XHD + e]; } };


typedef float f32x16 __attribute__((ext_vector_type(16)));
typedef short bf16x8 __attribute__((ext_vector_type(8)));
typedef short s16x4 __attribute__((ext_vector_type(4)));
typedef unsigned u32x4_t __attribute__((ext_vector_type(4)));
typedef unsigned u32x2_t __attribute__((ext_vector_type(2)));
DI int crow(int i, int h) { return (i & 3) + 8 * (i >> 2) + 4 * h; }
#define MFMA32(a, b, c) __builtin_amdgcn_mfma_f32_32x32x16_bf16((a), (b), (c), 0, 0, 0)
template <int DQK, int DV, bool CAUSAL, class Src>
DI void flash_unit(LAS unsigned char* lds, const Src& src, int qpos0, int ntiles, bf16_t* O, int ldo, float c2) {
    constexpr int KP = DQK + 8, VP = 68, KS = DQK / 16, NBLK = DV / 32;
    constexpr int KBYTES = 64 * KP * 2, VBYTES = DV * VP * 2, BUF = KBYTES + VBYTES;
    constexpr int D8 = DQK / 8, NPK = (64 * D8) / NTHREADS, NPV = (DV * 8) / NTHREADS;
    static_assert((64 * D8) % NTHREADS == 0 && (DV * 8) % NTHREADS == 0 && 2 * BUF <= 131072, "flash_unit geometry");
    const int tid = threadIdx.x, lane = tid & 63, w = __builtin_amdgcn_readfirstlane(tid >> 6), l31 = lane & 31, h = lane >> 5;
    bf16x8 qf[KS];
#pragma unroll
    for (int s_ = 0; s_ < KS; ++s_) qf[s_] = src.qfrag(32 * w + l31, s_, h);
    f32x16 o[NBLK];
#pragma unroll
    for (int b = 0; b < NBLK; ++b)
#pragma unroll
        for (int i = 0; i < 16; ++i) o[b][i] = 0.f;
    float m = -INFINITY, lsum = 0.f;
    u32x4_t kreg[NPK], vreg[NPV];
#define FL_LOAD(t_) do { _Pragma("unroll") for (int i_ = 0; i_ < NPK; ++i_) { const int p_ = tid + i_ * NTHREADS; kreg[i_] = src.kpiece(64 * (t_) + p_ / D8, p_ % D8); } \
                         _Pragma("unroll") for (int i_ = 0; i_ < NPV; ++i_) { const int p_ = tid + i_ * NTHREADS; vreg[i_] = src.vpiece(p_ >> 3, 64 * (t_) + 8 * (p_ & 7)); } } while (0)
#define FL_STORE(buf_) do { _Pragma("unroll") for (int i_ = 0; i_ < NPK; ++i_) { const int p_ = tid + i_ * NTHREADS; *(LAS u32x4_t*)(lds + (buf_) * BUF + ((p_ / D8) * KP + (p_ % D8) * 8) * 2) = kreg[i_]; } \
                          _Pragma("unroll") for (int i_ = 0; i_ < NPV; ++i_) { const int p_ = tid + i_ * NTHREADS; LAS unsigned char* a_ = lds + (buf_) * BUF + KBYTES + ((p_ >> 3) * VP + (p_ & 7) * 8) * 2; \
                              *(LAS u32x2_t*)a_ = (u32x2_t){vreg[i_].x, vreg[i_].y}; *(LAS u32x2_t*)(a_ + 8) = (u32x2_t){vreg[i_].z, vreg[i_].w}; } } while (0)
    __syncthreads();
    FL_LOAD(0); FL_STORE(0);
    __syncthreads();
    const int qmine = qpos0 + 32 * w + l31, qlast = qpos0 + 32 * w + 31;
    for (int t = 0; t < ntiles; ++t) {
        const int buf = t & 1;
        if (t + 1 < ntiles) FL_LOAD(t + 1);
        if (!CAUSAL || 64 * t <= qlast) {
            const LAS unsigned char* kb_ = lds + buf * BUF; const LAS unsigned char* vb_ = kb_ + KBYTES;
            f32x16 st[2];
#pragma unroll
            for (int kb = 0; kb < 2; ++kb) {
#pragma unroll
                for (int i = 0; i < 16; ++i) st[kb][i] = 0.f;
#pragma unroll
                for (int g_ = 0; g_ < KS / 4; ++g_) { bf16x8 kf[4];
#pragma unroll
                    for (int j = 0; j < 4; ++j) kf[j] = *(const LAS bf16x8*)(kb_ + ((32 * kb + l31) * KP + 16 * (4 * g_ + j) + 8 * h) * 2);
#pragma unroll
                    for (int j = 0; j < 4; ++j) st[kb] = MFMA32(kf[j], qf[4 * g_ + j], st[kb]);
                    __builtin_amdgcn_sched_barrier(0); }
            }
            if (CAUSAL && 64 * t + 63 > qpos0 + 32 * w) {
#pragma unroll
                for (int kb = 0; kb < 2; ++kb)
#pragma unroll
                    for (int i = 0; i < 16; ++i) { const int key = 64 * t + 32 * kb + crow(i, h); st[kb][i] = key <= qmine ? st[kb][i] : -INFINITY; }
            }
            float mx = -INFINITY;
#pragma unroll
            for (int kb = 0; kb < 2; ++kb)
#pragma unroll
                for (int i = 0; i < 16; ++i) mx = fmaxf(mx, st[kb][i]);
            mx = fmaxf(mx, __shfl_xor(mx, 32));
            const float mn = fmaxf(m, mx);
            { const float alpha = __builtin_amdgcn_exp2f((m - mn) * c2);
                lsum *= alpha;
#pragma unroll
                for (int b = 0; b < NBLK; ++b)
#pragma unroll
                    for (int i = 0; i < 16; ++i) o[b][i] *= alpha;
                m = mn;
            }
            const float nmc = -mn * c2;
            float ps = 0.f;
#pragma unroll
            for (int kb = 0; kb < 2; ++kb)
#pragma unroll
                for (int i = 0; i < 16; ++i) { const float p = __builtin_amdgcn_exp2f(__builtin_fmaf(st[kb][i], c2, nmc)); st[kb][i] = p; ps += p; }
            lsum += ps;
            bf16x8 pf[4];
#pragma unroll
            for (int ks = 0; ks < 4; ++ks) { const int kb = ks >> 1, s2 = ks & 1; u32x4_t pk;
                pk.x = cvtpk(st[kb][8 * s2 + 0], st[kb][8 * s2 + 1]); pk.y = cvtpk(st[kb][8 * s2 + 2], st[kb][8 * s2 + 3]);
                pk.z = cvtpk(st[kb][8 * s2 + 4], st[kb][8 * s2 + 5]); pk.w = cvtpk(st[kb][8 * s2 + 6], st[kb][8 * s2 + 7]); pf[ks] = __builtin_bit_cast(bf16x8, pk); }
            __builtin_amdgcn_sched_barrier(0);
#pragma unroll
            for (int b = 0; b < NBLK; ++b) { bf16x8 vf[4];
#pragma unroll
                for (int ks = 0; ks < 4; ++ks) { const LAS unsigned char* a_ = vb_ + ((32 * b + l31) * VP + 16 * ks + 4 * h) * 2;
                    const s16x4 lo = *(const LAS s16x4*)a_, hi = *(const LAS s16x4*)(a_ + 16);
                    vf[ks] = __builtin_shufflevector(lo, hi, 0, 1, 2, 3, 4, 5, 6, 7); }
#pragma unroll
                for (int ks = 0; ks < 4; ++ks) o[b] = MFMA32(vf[ks], pf[ks], o[b]);
                __builtin_amdgcn_sched_barrier(0); }
        }
        if (t + 1 < ntiles) FL_STORE(buf ^ 1);
        __syncthreads();
    }
#undef FL_LOAD
#undef FL_STORE
    lsum += __shfl_xor(lsum, 32);
    const float inv = 1.f / lsum;
    bf16_t* orow = O + (size_t)(32 * w + l31) * ldo;
#pragma unroll
    for (int b = 0; b < NBLK; ++b)
#pragma unroll
        for (int g = 0; g < 4; ++g) { u32x2_t pk; pk.x = cvtpk(o[b][4 * g + 0] * inv, o[b][4 * g + 1] * inv); pk.y = cvtpk(o[b][4 * g + 2] * inv, o[b][4 * g + 3] * inv);
            *(u32x2_t*)(orow + 32 * b + 8 * g + 4 * h) = pk; }
}
struct SrcMlaP { const bf16_t* kn; const bf16_t* kpe; const bf16_t* vt; const bf16_t* qraw; const bf16_t* qpe; int b, hh; size_t row0;
    DI bf16x8 qfrag(int r, int s_, int h8) const { return s_ < 8 ? *(const bf16x8*)(qraw + (row0 + r) * 1536 + hh * DQH + 16 * s_ + 8 * h8) : *(const bf16x8*)(qpe + (row0 + r) * 512 + hh * DROPE + 16 * (s_ - 8) + 8 * h8); }
    DI u32x4_t kpiece(int key, int d8) const { const size_t row = (size_t)b * SEQ + key;
        return d8 < 16 ? *(const u32x4_t*)(kn + row * 1024 + hh * DNOPE + d8 * 8) : *(const u32x4_t*)(kpe + row * DROPE + (d8 - 16) * 8); }
    DI u32x4_t vpiece(int dv, int key0) const { return *(const u32x4_t*)(vt + (size_t)(hh * DVH + dv) * NP + (size_t)b * SEQ + key0); } };
struct SrcMemP { const bf16_t* mk; const bf16_t* mvt; const bf16_t* xq; int b, hh; size_t row0;
    DI bf16x8 qfrag(int r, int s_, int h8) const { return *(const bf16x8*)(xq + (row0 + r) * ZLD + hh * XHD + 16 * s_ + 8 * h8); }
    DI u32x4_t kpiece(int key, int d8) const { return *(const u32x4_t*)(mk + ((size_t)b * NMEM + key) * 256 + hh * XHD + d8 * 8); }
    DI u32x4_t vpiece(int dv, int key0) const { return *(const u32x4_t*)(mvt + (size_t)(hh * XHD + dv) * (NB * NMEM) + (size_t)b * NMEM + key0); } };


DI void ret_chunk_state(const bf16_t* __restrict__ RVT, const bf16_t* __restrict__ RKtT, float* __restrict__ UT, int b, int h, int c) {
    const int tid = threadIdx.x, lane = tid & 63, w = __builtin_amdgcn_readfirstlane(tid >> 6), l31 = lane & 31, hh = lane >> 5;
    const size_t tok0 = (size_t)b * SEQ + c * 128;
    f32x16 acc[4];
#pragma unroll
    for (int kb = 0; kb < 4; ++kb)
#pragma unroll
        for (int i = 0; i < 16; ++i) acc[kb][i] = 0.f;
    const bf16_t* ap = RVT + (size_t)(h * RDV + 32 * w + l31) * NT + tok0 + 8 * hh;
    const bf16_t* bp = RKtT + (size_t)(h * RDK + l31) * NP + tok0 + 8 * hh;
#pragma unroll
    for (int s_ = 0; s_ < 8; ++s_) { const bf16x8 a = *(const bf16x8*)(ap + 16 * s_);
#pragma unroll
        for (int kb = 0; kb < 4; ++kb) { const bf16x8 bfr = *(const bf16x8*)(bp + (size_t)(32 * kb) * NP + 16 * s_); acc[kb] = MFMA32(a, bfr, acc[kb]); } }
    float* u = UT + (size_t)(((b * RH + h) * 16) + c) * 32768;
#pragma unroll
    for (int kb = 0; kb < 4; ++kb)
#pragma unroll
        for (int i = 0; i < 16; ++i) u[(32 * w + crow(i, hh)) * RDK + 32 * kb + l31] = acc[kb][i];
}
DI void ret_chunk_out(const bf16_t* __restrict__ RQt, const bf16_t* __restrict__ RKt, const bf16_t* __restrict__ RVT, const bf16_t* __restrict__ SPT, float* __restrict__ ORET, int b, int h, int c) {
    const int tid = threadIdx.x, lane = tid & 63, w = __builtin_amdgcn_readfirstlane(tid >> 6), l31 = lane & 31, hh = lane >> 5;
    const int ib = w & 3, vh = w >> 2;
    const size_t tok0 = (size_t)b * SEQ + c * 128;
    bf16x8 qf[8];
    { const bf16_t* qp = RQt + (tok0 + 32 * ib + l31) * 512 + h * RDK + 8 * hh;
#pragma unroll
      for (int s_ = 0; s_ < 8; ++s_) qf[s_] = *(const bf16x8*)(qp + 16 * s_); }
    f32x16 o[4];
#pragma unroll
    for (int blk = 0; blk < 4; ++blk)
#pragma unroll
        for (int i = 0; i < 16; ++i) o[blk][i] = 0.f;
    const bf16_t* vbase = RVT + (size_t)(h * RDV + 32 * (4 * vh) + l31) * NT + tok0 + 4 * hh;
#pragma unroll 1
    for (int jb = 0; jb <= ib; ++jb) {
        f32x16 x;
#pragma unroll
        for (int i = 0; i < 16; ++i) x[i] = 0.f;
        const bf16_t* kp = RKt + (tok0 + 32 * jb + l31) * 512 + h * RDK + 8 * hh;
#pragma unroll
        for (int s_ = 0; s_ < 8; ++s_) { const bf16x8 kf = *(const bf16x8*)(kp + 16 * s_); x = MFMA32(kf, qf[s_], x); }
        if (jb == ib) {
#pragma unroll
            for (int i = 0; i < 16; ++i) x[i] = (crow(i, hh) <= l31) ? x[i] : 0.f;
        }
#pragma unroll
        for (int s2 = 0; s2 < 2; ++s2) {
            u32x4_t pk; pk.x = cvtpk(x[8 * s2 + 0], x[8 * s2 + 1]); pk.y = cvtpk(x[8 * s2 + 2], x[8 * s2 + 3]); pk.z = cvtpk(x[8 * s2 + 4], x[8 * s2 + 5]); pk.w = cvtpk(x[8 * s2 + 6], x[8 * s2 + 7]);
            const bf16x8 pa = __builtin_bit_cast(bf16x8, pk);
#pragma unroll
            for (int blk = 0; blk < 4; ++blk) { const bf16_t* vp = vbase + (size_t)(32 * blk) * NT + 32 * jb + 16 * s2;
                const s16x4 lo = *(const s16x4*)vp, hi = *(const s16x4*)(vp + 8);
                const bf16x8 vf = __builtin_shufflevector(lo, hi, 0, 1, 2, 3, 4, 5, 6, 7);
                o[blk] = MFMA32(pa, vf, o[blk]); }
        }
    }
    const bf16_t* sp = SPT + (size_t)(((b * RH + h) * 16) + c) * 32768 + (size_t)(32 * (4 * vh) + l31) * RDK + 8 * hh;
#pragma unroll
    for (int s_ = 0; s_ < 8; ++s_)
#pragma unroll
        for (int blk = 0; blk < 4; ++blk) { const bf16x8 sf = *(const bf16x8*)(sp + (size_t)(32 * blk) * RDK + 16 * s_); o[blk] = MFMA32(qf[s_], sf, o[blk]); }
#pragma unroll
    for (int blk = 0; blk < 4; ++blk)
#pragma unroll
        for (int i = 0; i < 16; ++i) ORET[(tok0 + 32 * ib + crow(i, hh)) * 1024 + h * RDV + 32 * (4 * vh + blk) + l31] = o[blk][i];
}


typedef short v4i16_t __attribute__((ext_vector_type(4)));
DI s16x4 vtr(const LAS unsigned char* p) { return __builtin_bit_cast(s16x4, __builtin_amdgcn_ds_read_tr16_b64_v4i16((LAS v4i16_t*)p)); }
constexpr int MS_NSPLIT = 2, MS_KEYS = PAST / MS_NSPLIT, MS_TILES = MS_KEYS / 64;
DI void mla_sample_unit(LAS unsigned char* lds, const float* __restrict__ cckv, const float* __restrict__ ckpe, const int* __restrict__ pt,
                        const bf16_t* __restrict__ QLATb, const bf16_t* __restrict__ QPEb, float* __restrict__ PO, float* __restrict__ PML, int b, int split, float c2) {
    constexpr int KP = 328, KBYTES = 64 * KP * 2;
    const int tid = threadIdx.x, lane = tid & 63, w = __builtin_amdgcn_readfirstlane(tid >> 6), l31 = lane & 31, hh = lane >> 5;
    bf16x8 qf[20];
    { const int t = l31 >> 3, head = l31 & 7;
      const bf16_t* ql = QLATb + (size_t)(b * DS + t) * 2048 + head * KVL + 8 * hh;
      const bf16_t* qp = QPEb + (size_t)(NP + b * DS + t) * 512 + head * DROPE + 8 * hh;
#pragma unroll
      for (int s_ = 0; s_ < 16; ++s_) qf[s_] = *(const bf16x8*)(ql + 16 * s_);
#pragma unroll
      for (int s_ = 0; s_ < 4; ++s_) qf[16 + s_] = *(const bf16x8*)(qp + 16 * s_); }
    f32x16 o;
#pragma unroll
    for (int i = 0; i < 16; ++i) o[i] = 0.f;
    float m = -INFINITY, lsum = 0.f;
    f32x4 cr[8], pr[2];
#define MS_LOAD(t_) do { const int key0_ = split * MS_KEYS + 64 * (t_); const size_t rowb_ = (size_t)pt[b * NPAGES + (key0_ >> 7)] * PAGE + (key0_ & (PAGE - 1)); \
        _Pragma("unroll") for (int i_ = 0; i_ < 8; ++i_) { const int pc_ = tid + i_ * NTHREADS; cr[i_] = __builtin_nontemporal_load((const f32x4*)(cckv + (rowb_ + (pc_ >> 6)) * KVL + 4 * (pc_ & 63))); } \
        _Pragma("unroll") for (int i_ = 0; i_ < 2; ++i_) { const int pc_ = tid + i_ * NTHREADS; pr[i_] = __builtin_nontemporal_load((const f32x4*)(ckpe + (rowb_ + (pc_ >> 4)) * DROPE + 4 * (pc_ & 15))); } } while (0)
#define MS_STORE(buf_) do { \
        _Pragma("unroll") for (int i_ = 0; i_ < 8; ++i_) { const int pc_ = tid + i_ * NTHREADS; *(LAS u32x2_t*)(lds + (buf_) * KBYTES + ((pc_ >> 6) * KP + 4 * (pc_ & 63)) * 2) = (u32x2_t){cvtpk(cr[i_][0], cr[i_][1]), cvtpk(cr[i_][2], cr[i_][3])}; } \
        _Pragma("unroll") for (int i_ = 0; i_ < 2; ++i_) { const int pc_ = tid + i_ * NTHREADS; *(LAS u32x2_t*)(lds + (buf_) * KBYTES + ((pc_ >> 4) * KP + KVL + 4 * (pc_ & 15)) * 2) = (u32x2_t){cvtpk(pr[i_][0], pr[i_][1]), cvtpk(pr[i_][2], pr[i_][3])}; } } while (0)
    __syncthreads();
    MS_LOAD(0); MS_STORE(0);
    __syncthreads();
    const int q4 = (lane & 15) >> 2, p4 = lane & 3, blk = (lane >> 4) & 1;
#pragma unroll 1
    for (int t = 0; t < MS_TILES; ++t) {
        const int buf = t & 1;
        if (t + 1 < MS_TILES) MS_LOAD(t + 1);
        const LAS unsigned char* kb_ = lds + buf * KBYTES;
        f32x16 st[2];
#pragma unroll
        for (int kb = 0; kb < 2; ++kb) {
#pragma unroll
            for (int i = 0; i < 16; ++i) st[kb][i] = 0.f;
#pragma unroll
            for (int g_ = 0; g_ < 5; ++g_) { bf16x8 kf[4];
#pragma unroll
                for (int j = 0; j < 4; ++j) kf[j] = *(const LAS bf16x8*)(kb_ + ((32 * kb + l31) * KP + 16 * (4 * g_ + j) + 8 * hh) * 2);
#pragma unroll
                for (int j = 0; j < 4; ++j) st[kb] = MFMA32(kf[j], qf[4 * g_ + j], st[kb]);
                __builtin_amdgcn_sched_barrier(0); }
        }
        float mx = -INFINITY;
#pragma unroll
        for (int kb = 0; kb < 2; ++kb)
#pragma unroll
            for (int i = 0; i < 16; ++i) mx = fmaxf(mx, st[kb][i]);
        mx = fmaxf(mx, __shfl_xor(mx, 32));
        const float mn = fmaxf(m, mx);
        if (__builtin_amdgcn_ballot_w64(mn > m) != 0ull) {
            const float alpha = __builtin_amdgcn_exp2f((m - mn) * c2);
            lsum *= alpha;
#pragma unroll
            for (int i = 0; i < 16; ++i) o[i] *= alpha;
            m = mn;
        }
        const float nmc = -mn * c2;
        float ps = 0.f;
#pragma unroll
        for (int kb = 0; kb < 2; ++kb)
#pragma unroll
            for (int i = 0; i < 16; ++i) { const float p = __builtin_amdgcn_exp2f(__builtin_fmaf(st[kb][i], c2, nmc)); st[kb][i] = p; ps += p; }
        lsum += ps;
        bf16x8 vf[4];
#pragma unroll
        for (int ks = 0; ks < 4; ++ks) { const LAS unsigned char* a_ = kb_ + ((16 * ks + 4 * hh + q4) * KP + 32 * w + 16 * blk + 4 * p4) * 2;
            const s16x4 lo = vtr(a_), hi = vtr(a_ + 8 * KP * 2);
            vf[ks] = __builtin_shufflevector(lo, hi, 0, 1, 2, 3, 4, 5, 6, 7); }
#pragma unroll
        for (int ks = 0; ks < 4; ++ks) { const int kb = ks >> 1, s2 = ks & 1; u32x4_t pk;
            pk.x = cvtpk(st[kb][8 * s2 + 0], st[kb][8 * s2 + 1]); pk.y = cvtpk(st[kb][8 * s2 + 2], st[kb][8 * s2 + 3]);
            pk.z = cvtpk(st[kb][8 * s2 + 4], st[kb][8 * s2 + 5]); pk.w = cvtpk(st[kb][8 * s2 + 6], st[kb][8 * s2 + 7]);
            o = MFMA32(vf[ks], __builtin_bit_cast(bf16x8, pk), o); }
        if (t + 1 < MS_TILES) MS_STORE(buf ^ 1);
        __syncthreads();
    }
#undef MS_LOAD
#undef MS_STORE
    lsum += __shfl_xor(lsum, 32);
    const int item = b * MS_NSPLIT + split;
    if (w == 0 && lane < 32) { PML[(item * 32 + lane) * 2] = m * c2; PML[(item * 32 + lane) * 2 + 1] = lsum; }
#pragma unroll
    for (int i = 0; i < 16; ++i) PO[((size_t)item * 32 + l31) * KVL + 32 * w + crow(i, hh)] = o[i];
}


struct RetItem { int b, h, c, vh; };
DI RetItem ret_item(int it) { RetItem r; r.vh = it & 1; r.c = (it >> 1) & 15; r.h = (it >> 5) & 3; r.b = it >> 7; return r; }
DI void ret_out_phase(LAS unsigned char* lds, const bf16_t* __restrict__ RQt, const bf16_t* __restrict__ RKt, const bf16_t* __restrict__ RVT, const bf16_t* __restrict__ SPT, float* __restrict__ ORET, int bid, int G) {
    constexpr int PITCH = 136, TILE = 128 * PITCH * 2;
    const int tid = threadIdx.x, lane = tid & 63, w = __builtin_amdgcn_readfirstlane(tid >> 6), l31 = lane & 31, hh = lane >> 5;
    const int ib = w & 3, dq = w >> 2;
    u32x4_t st[12];
#define RO_LOAD(it_) do { const RetItem q_ = ret_item(it_); const size_t tok0_ = (size_t)q_.b * SEQ + q_.c * 128; \
        _Pragma("unroll") for (int i_ = 0; i_ < 12; ++i_) { const int p_ = tid + i_ * NTHREADS, tl_ = p_ >> 11, row_ = (p_ >> 4) & 127, c16_ = p_ & 15; const bf16_t* src_; \
            if (tl_ == 0) src_ = RKt + (tok0_ + row_) * 512 + q_.h * RDK + 8 * c16_; \
            else if (tl_ == 1) src_ = RVT + (size_t)(q_.h * RDV + 128 * q_.vh + row_) * NT + tok0_ + 8 * c16_; \
            else src_ = SPT + (size_t)(((q_.b * RH + q_.h) * 16) + q_.c) * 32768 + (size_t)(128 * q_.vh + row_) * RDK + 8 * c16_; \
            st[i_] = *(const u32x4_t*)src_; } } while (0)
#define RO_STORE() do { _Pragma("unroll") for (int i_ = 0; i_ < 12; ++i_) { const int p_ = tid + i_ * NTHREADS, tl_ = p_ >> 11, row_ = (p_ >> 4) & 127, c16_ = p_ & 15; \
            *(LAS u32x4_t*)(lds + tl_ * TILE + (row_ * PITCH + 8 * c16_) * 2) = st[i_]; } } while (0)
    int it = bid;
    if (it < NB * RH * 16 * 2) RO_LOAD(it);
    for (; it < NB * RH * 16 * 2; it += G) {
        const RetItem q = ret_item(it); const size_t tok0 = (size_t)q.b * SEQ + q.c * 128;
        __syncthreads();
        RO_STORE();
        bf16x8 qf[8];
        { const bf16_t* qp = RQt + (tok0 + 32 * ib + l31) * 512 + q.h * RDK + 8 * hh;
#pragma unroll
          for (int s_ = 0; s_ < 8; ++s_) qf[s_] = *(const bf16x8*)(qp + 16 * s_); }
        __syncthreads();
        if (it + G < NB * RH * 16 * 2) RO_LOAD(it + G);
        const LAS unsigned char* Kl = lds; const LAS unsigned char* Vl = lds + TILE; const LAS unsigned char* Sl = lds + 2 * TILE;
        f32x16 o[2];
#pragma unroll
        for (int blk = 0; blk < 2; ++blk)
#pragma unroll
            for (int i = 0; i < 16; ++i) o[blk][i] = 0.f;
#pragma unroll 1
        for (int jb = 0; jb <= ib; ++jb) {
            f32x16 x;
#pragma unroll
            for (int i = 0; i < 16; ++i) x[i] = 0.f;
#pragma unroll
            for (int s_ = 0; s_ < 8; ++s_) { const bf16x8 kf = *(const LAS bf16x8*)(Kl + ((32 * jb + l31) * PITCH + 16 * s_ + 8 * hh) * 2); x = MFMA32(kf, qf[s_], x); }
            if (jb == ib) {
#pragma unroll
                for (int i = 0; i < 16; ++i) x[i] = (crow(i, hh) <= l31) ? x[i] : 0.f;
            }
#pragma unroll
            for (int s2 = 0; s2 < 2; ++s2) {
                u32x4_t pk; pk.x = cvtpk(x[8 * s2 + 0], x[8 * s2 + 1]); pk.y = cvtpk(x[8 * s2 + 2], x[8 * s2 + 3]); pk.z = cvtpk(x[8 * s2 + 4], x[8 * s2 + 5]); pk.w = cvtpk(x[8 * s2 + 6], x[8 * s2 + 7]);
                const bf16x8 pa = __builtin_bit_cast(bf16x8, pk);
#pragma unroll
                for (int blk = 0; blk < 2; ++blk) { const LAS unsigned char* vp = Vl + ((64 * dq + 32 * blk + l31) * PITCH + 32 * jb + 16 * s2 + 4 * hh) * 2;
                    const s16x4 lo = *(const LAS s16x4*)vp, hi = *(const LAS s16x4*)(vp + 16);
                    o[blk] = MFMA32(pa, __builtin_shufflevector(lo, hi, 0, 1, 2, 3, 4, 5, 6, 7), o[blk]); }
            }
        }
#pragma unroll
        for (int s_ = 0; s_ < 8; ++s_)
#pragma unroll
            for (int blk = 0; blk < 2; ++blk) { const bf16x8 sf = *(const LAS bf16x8*)(Sl + ((64 * dq + 32 * blk + l31) * PITCH + 16 * s_ + 8 * hh) * 2); o[blk] = MFMA32(qf[s_], sf, o[blk]); }
#pragma unroll
        for (int blk = 0; blk < 2; ++blk)
#pragma unroll
            for (int i = 0; i < 16; ++i) ORET[(tok0 + 32 * ib + crow(i, hh)) * 1024 + q.h * RDV + 128 * q.vh + 64 * dq + 32 * blk + l31] = o[blk][i];
    }
#undef RO_LOAD
#undef RO_STORE
}


DI void ret_state_phase(LAS unsigned char* lds, const bf16_t* __restrict__ RVT, const bf16_t* __restrict__ RKtT, float* __restrict__ UT, int bid, int G) {
    constexpr int PITCH = 136;
    const int tid = threadIdx.x, lane = tid & 63, w = __builtin_amdgcn_readfirstlane(tid >> 6), l31 = lane & 31, hh = lane >> 5;
    u32x4_t st[12];
#define RS_LOAD(it_) do { const int c_ = (it_) & 15, h_ = ((it_) >> 4) & 3, b_ = (it_) >> 6; const size_t tok0_ = (size_t)b_ * SEQ + c_ * 128; \
        _Pragma("unroll") for (int i_ = 0; i_ < 12; ++i_) { const int p_ = tid + i_ * NTHREADS, row_ = p_ >> 4, c16_ = p_ & 15; \
            const bf16_t* src_ = row_ < 256 ? RVT + (size_t)(h_ * RDV + row_) * NT + tok0_ + 8 * c16_ : RKtT + (size_t)(h_ * RDK + (row_ - 256)) * NP + tok0_ + 8 * c16_; \
            st[i_] = *(const u32x4_t*)src_; } } while (0)
    int it = bid;
    if (it < NB * RH * 16) RS_LOAD(it);
    for (; it < NB * RH * 16; it += G) {
        __syncthreads();
#pragma unroll
        for (int i = 0; i < 12; ++i) { const int p = tid + i * NTHREADS; *(LAS u32x4_t*)(lds + ((p >> 4) * PITCH + 8 * (p & 15)) * 2) = st[i]; }
        __syncthreads();
        if (it + G < NB * RH * 16) RS_LOAD(it + G);
        f32x16 acc[4];
#pragma unroll
        for (int kb = 0; kb < 4; ++kb)
#pragma unroll
            for (int i = 0; i < 16; ++i) acc[kb][i] = 0.f;
#pragma unroll
        for (int s_ = 0; s_ < 8; ++s_) { const bf16x8 a = *(const LAS bf16x8*)(lds + ((32 * w + l31) * PITCH + 16 * s_ + 8 * hh) * 2);
#pragma unroll
            for (int kb = 0; kb < 4; ++kb) { const bf16x8 b_ = *(const LAS bf16x8*)(lds + ((256 + 32 * kb + l31) * PITCH + 16 * s_ + 8 * hh) * 2); acc[kb] = MFMA32(a, b_, acc[kb]); } }
        float* u = UT + (size_t)it * 32768;
#pragma unroll
        for (int kb = 0; kb < 4; ++kb)
#pragma unroll
            for (int i = 0; i < 16; ++i) u[(32 * w + crow(i, hh)) * RDK + 32 * kb + l31] = acc[kb][i];
    }
#undef RS_LOAD
}

struct QPtr { const float* p; DI float operator()(int d) const { return p[d]; } };
struct QMla { const float* ql; const float* qp; DI float operator()(int d) const { return d < KVL ? ql[d] : qp[d - KVL]; } };
DI void rms_row(const float* x, const float* g, float* o, int n, int lane) {
    float s = 0.f;
    for (int i = lane; i < n; i += 64) { const float v = x[i]; s += v * v; }
    const float r = rsqrtf(wave_sum(s) / (float)n + EPS);
    for (int i = lane; i < n; i += 64) o[i] = x[i] * r * g[i];
}

DI void rms_row_bf16(const float* x, const float* g, bf16_t* o, int n, int lane) {
    float s = 0.f;
    for (int i = lane; i < n; i += 64) { const float v = x[i]; s += v * v; }
    const float r = rsqrtf(wave_sum(s) / (float)n + EPS);
    for (int i = lane; i < n; i += 64) o[i] = f2bf(x[i] * r * g[i]);
}
#define GEMM_PHASE(EPI, ...) pg8::gemm_phase<EPI, pg8::StaticOrder, true, true>(__VA_ARGS__)
#define GEMM_SPLIT(...) pg8::gemm_phase<pg8::EpiPart, pg8::SplitOrder, true, true>(__VA_ARGS__)
__global__ void __launch_bounds__(NTHREADS, 2) fwd_kernel(Args args) {
    extern __shared__ __attribute__((aligned(16))) unsigned char lds_raw[];
    LAS unsigned char* ldsb = (LAS unsigned char*)lds_raw;
    LAS float* lds = (LAS float*)ldsb;
    volatile LAS unsigned* MISC = (volatile LAS unsigned*)(ldsb + MISC_OFF);
    const int tid = threadIdx.x, lane = tid & 63, wave = tid >> 6;
    const int G = gridDim.x, bid = blockIdx.x;
    const int gw = bid * NWAVES + wave, NGW = G * NWAVES;
    unsigned char* ws = args.ws;
    float* out = args.out;
    const int lo = args.ph_lo, hi = args.ph_hi;

    if (tid < 64) MISC[tid] = 0u;
    __syncthreads();
    XcdBarrier bar; bar.bar = (unsigned*)(ws + WS_CTL) + CW_BAR; bar.x = 0; bar.st = MISC;
    if (hi - lo > 1) bar = xcd_barrier_post((unsigned*)(ws + WS_CTL) + CW_BAR, MISC);
#define IN(k) (lo <= (k) && (k) < hi)
#define SEAM(k) do { if (IN(k) && IN((k) + 1)) xcd_barrier(bar); } while (0)

#define x_prompt ((const float*)(args.in[0]))
#define x_sample ((const float*)(args.in[1]))
#define mem_prompt ((const float*)(args.in[2]))
#define cache_ckv ((const float*)(args.in[3]))
#define cache_kpe ((const float*)(args.in[4]))
#define page_table ((const int*)args.in[5])
#define state_ret ((const float*)(args.in[6]))
#define cache_mem_k ((const float*)(args.in[7]))
#define cache_mem_v ((const float*)(args.in[8]))
#define g_mix_pre ((const float*)(args.in[9]))
#define g_mix_post ((const float*)(args.in[10]))
#define g_ffn_pre ((const float*)(args.in[11]))
#define g_ffn_post ((const float*)(args.in[12]))
#define g_mem ((const float*)(args.in[13]))
#define g_qlat ((const float*)(args.in[14]))
#define g_kvlat ((const float*)(args.in[15]))
#define w_in ((const float*)(args.in[16]))
#define w_uq ((const float*)(args.in[17]))
#define w_uk ((const float*)(args.in[18]))
#define w_uv ((const float*)(args.in[19]))
#define w_mem_k ((const float*)(args.in[20]))
#define w_mem_v ((const float*)(args.in[21]))
#define w_ret_o ((const float*)(args.in[22]))
#define w_mla_o ((const float*)(args.in[23]))
#define w_x_o ((const float*)(args.in[24]))
#define w_out ((const float*)(args.in[25]))
#define w_gate ((const float*)(args.in[26]))
#define w_up ((const float*)(args.in[27]))
#define w_down ((const float*)(args.in[28]))
#define COSA ((float*)(ws + WS_COSA))
#define SINA ((float*)(ws + WS_SINA))
#define COSB ((float*)(ws + WS_COSB))
#define SINB ((float*)(ws + WS_SINB))
#define U ((float*)(ws + WS_U))
#define MN ((float*)(ws + WS_MN))
#define Zb ((bf16_t*)(ws + WS_Z))
#define RQ ((float*)(ws + WS_RQ))
#define RK ((float*)(ws + WS_RK))
#define CQN ((float*)(ws + WS_CQN))
#define CKVN ((float*)(ws + WS_CKVN))
#define KPER ((float*)(ws + WS_KPER))
#define Q ((float*)(ws + WS_Q))
#define QLAT ((float*)(ws + WS_QLAT))
#define QPE ((float*)(ws + WS_QPE))
#define ORET ((float*)(ws + WS_ORET))
#define OLAT ((float*)(ws + WS_OLAT))
#define OX ((float*)(ws + WS_OX))
#define OMLA ((float*)(ws + WS_OMLA))
#define ORETN ((float*)(ws + WS_ORETN))
#define ARET ((float*)(ws + WS_ARET))
#define AMLA ((float*)(ws + WS_AMLA))
#define AX ((float*)(ws + WS_AX))
#define MIX ((float*)(ws + WS_MIX))
#define HP ((float*)(ws + WS_HP))
#define H ((float*)(ws + WS_H))
#define F ((float*)(ws + WS_F))
#define GU ((float*)(ws + WS_GG))
#define FO ((float*)(ws + WS_FO))
#define WinT ((bf16_t*)(ws + WS_WIN_T))
#define WmkvT ((bf16_t*)(ws + WS_WMKV_T))
#define WuqT ((bf16_t*)(ws + WS_WUQ_T))
#define WroT ((bf16_t*)(ws + WS_WRO_T))
#define WmoT ((bf16_t*)(ws + WS_WMO_T))
#define WxoT ((bf16_t*)(ws + WS_WXO_T))
#define WoT ((bf16_t*)(ws + WS_WO_T))
#define WguT ((bf16_t*)(ws + WS_WGU_T))
#define WdT ((bf16_t*)(ws + WS_WD_T))
#define Ub ((bf16_t*)(ws + WS_UB))
#define MNb ((bf16_t*)(ws + WS_MNB))
#define CQNb ((bf16_t*)(ws + WS_CQNB))
#define ORETNb ((bf16_t*)(ws + WS_ORETNB))
#define OMLAb ((bf16_t*)(ws + WS_OMLAB))
#define OXb ((bf16_t*)(ws + WS_OXB))
#define MIXb ((bf16_t*)(ws + WS_MIXB))
#define Fb ((bf16_t*)(ws + WS_FB))
#define ACTb ((bf16_t*)(ws + WS_ACTB))
#define WukT ((bf16_t*)(ws + WS_WUK_T))
#define WuvT ((bf16_t*)(ws + WS_WUV_T))
#define CKVNb ((bf16_t*)(ws + WS_CKVNB))
#define KPERb ((bf16_t*)(ws + WS_KPERB))
#define XQb ((bf16_t*)(ws + WS_XQB))
#define MKb ((bf16_t*)(ws + WS_MKB))
#define MVT ((bf16_t*)(ws + WS_MVT))
#define KN ((bf16_t*)(ws + WS_KN))
#define VT ((bf16_t*)(ws + WS_VT))
#define Qb ((bf16_t*)(ws + WS_QB))
#define RQt ((bf16_t*)(ws + WS_RQT))
#define RKt ((bf16_t*)(ws + WS_RKT))
#define RKtT ((bf16_t*)(ws + WS_RKTT))
#define RVT ((bf16_t*)(ws + WS_RVT))
#define UT ((float*)(ws + WS_UT))
#define SPT ((bf16_t*)(ws + WS_SPT))
#define QPEb ((bf16_t*)(ws + WS_QPEB))
#define WukB ((bf16_t*)(ws + WS_WUKB))
#define PART ((float*)(ws + WS_PART))
#define SGb ((bf16_t*)(ws + WS_SGB))
#define SRGb ((bf16_t*)(ws + WS_SRGB))
#define T0b ((bf16_t*)(ws + WS_T0B))
#define T1b ((bf16_t*)(ws + WS_T1B))
#define QLATb ((bf16_t*)(ws + WS_QLATB))
#define PO ((float*)(ws + WS_PO))
#define PML ((float*)(ws + WS_PML))
    if (IN(0)) {
        for (int i = bid * NTHREADS + tid; i < NPOS * 64 + NPOS * 32; i += G * NTHREADS) {
            const bool a = i < NPOS * 64; const int j = a ? i : i - NPOS * 64; const int half = a ? 64 : 32;
            const int p = j / half, f = j % half; const int pos = p < SEQ ? p : PAST + (p - SEQ);
            const float inv = powf(10000.0f, -(float)f / (float)half);
            const float ang = (float)pos * inv;
            double rev = (double)ang * 0.15915494309189535; rev -= floor(rev);
            const float r = (float)rev;
            const float sn = __builtin_amdgcn_sinf(r), cs = __builtin_amdgcn_cosf(r);
            if (a) { COSA[j] = cs; SINA[j] = sn; } else { COSB[j] = cs; SINB[j] = sn; }
        }
#pragma unroll 1
        for (int pass = 0; pass < 2; ++pass) {
            const int nrows = pass ? NB * NMEM : NT; const float* gsrc = pass ? g_mem : g_mix_pre; bf16_t* dst = pass ? MNb : Ub;
            f32x4 a[4];
#define P0_SRC(r_) (pass ? mem_prompt + (size_t)(r_) * DM : (r_) < NP ? x_prompt + (size_t)(r_) * DM : x_sample + (size_t)((r_) - NP) * DM)
#define P0_LOAD(r_, A_) do { const float* s_ = P0_SRC(r_); _Pragma("unroll") for (int j_ = 0; j_ < 4; ++j_) A_[j_] = *(const f32x4*)(s_ + 4 * lane + 256 * j_); } while (0)
            int row = gw;
            if (row < nrows) P0_LOAD(row, a);
#pragma unroll 1
            for (; row < nrows; row += NGW) {
                f32x4 an[4]; const int nr = row + NGW;
                if (nr < nrows) P0_LOAD(nr, an);
                float ss = 0.f;
#pragma unroll
                for (int j = 0; j < 4; ++j) ss += a[j][0] * a[j][0] + a[j][1] * a[j][1] + a[j][2] * a[j][2] + a[j][3] * a[j][3];
                const float r = rsqrtf(wave_sum(ss) * (1.f / DM) + EPS);
#pragma unroll
                for (int j = 0; j < 4; ++j) { const f32x4 v = a[j] * r * *(const f32x4*)(gsrc + 4 * lane + 256 * j); *(u32x2_t*)(dst + (size_t)row * DM + 4 * lane + 256 * j) = (u32x2_t){cvtpk(v[0], v[1]), cvtpk(v[2], v[3])}; }
#pragma unroll
                for (int j = 0; j < 4; ++j) a[j] = an[j];
            }
#undef P0_LOAD
#undef P0_SRC
        }
        {
            LAS float* scr = lds + wave * (64 * 33);
            int rot = 0;
            transpose_w(w_in, 1024, DIN, WinT, 1024, 0, scr, gw, NGW, lane, rot);
            for (int i = bid * NTHREADS + tid; i < (ZLD - DIN) * 1024 / 2; i += G * NTHREADS) ((unsigned*)(WinT + (size_t)DIN * 1024))[i] = 0u;
            for (int i = bid * NTHREADS + tid; i < MH * KVL * DNOPE / 4; i += G * NTHREADS) { const f32x4 v = *(const f32x4*)(w_uk + 4 * (size_t)i); *(u32x2_t*)(WukB + 4 * (size_t)i) = (u32x2_t){cvtpk(v[0], v[1]), cvtpk(v[2], v[3])}; }
            transpose_w(w_mem_k, 1024, 256, WmkvT, 1024, 0, scr, gw, NGW, lane, rot);
            transpose_w(w_mem_v, 1024, 256, WmkvT, 1024, 256, scr, gw, NGW, lane, rot);
            transpose_w(w_uq, QL, 1536, WuqT, QL, 0, scr, gw, NGW, lane, rot);
            transpose_w(w_ret_o, 1024, 1024, WroT, 1024, 0, scr, gw, NGW, lane, rot);
            transpose_w(w_mla_o, 1024, 1024, WmoT, 1024, 0, scr, gw, NGW, lane, rot);
            transpose_w(w_x_o, 256, 1024, WxoT, 256, 0, scr, gw, NGW, lane, rot);
            transpose_w(w_out, 1024, 1024, WoT, 1024, 0, scr, gw, NGW, lane, rot);
            transpose_w(w_gate, 1024, DFF, WguT, 1024, 0, scr, gw, NGW, lane, rot, 2);
            transpose_w(w_up, 1024, DFF, WguT, 1024, 1, scr, gw, NGW, lane, rot, 2);
            transpose_w(w_down, DFF, 1024, WdT, DFF, 0, scr, gw, NGW, lane, rot);
            for (int hh = 0; hh < MH; ++hh) { transpose_w(w_uk + (size_t)hh * KVL * DNOPE, KVL, DNOPE, WukT, KVL, hh * DNOPE, scr, gw, NGW, lane, rot);
                                              transpose_w(w_uv + (size_t)hh * KVL * DVH, KVL, DVH, WuvT, KVL, hh * DVH, scr, gw, NGW, lane, rot); }
        }
    }
    SEAM(0);
    if (IN(1)) {
        static_assert(WS_MNB == WS_UB + (size_t)NT * 1024 * 2 && WS_WMKV_T == WS_WIN_T + (size_t)ZLD * 1024 * 2, "P1 stacks Ub|MNb and WinT|WmkvT");
        { pg8::Gemm g{Ub, WinT, NT + NB * NMEM, ZLD + 512, 1024, 1024, 1024}; pg8::P1Order S; S.init(G, bid); pg8::EpiP1 E{Zb, ZLD, out + O_MKP, out + O_MVP, SRGb, SGb, C_RG, C_G};
          pg8::gemm_phase<pg8::EpiP1, pg8::P1Order, true, true>(ldsb, g, S, E); }
        __syncthreads();
        { pg8::Gemm g{WinT + (size_t)C_RV * 1024, Ub, 1024, NP, 1024, 1024, 1024}; pg8::StaticOrder S; S.init(1024, NP, G, bid); pg8::EpiBf16S E{RVT, NT};
          GEMM_PHASE(pg8::EpiBf16S, ldsb, g, S, E); }
    }
    SEAM(1);
    if (IN(2)) {
        constexpr int KTP = 520;
        LAS bf16_t* Kt = (LAS bf16_t*)ldsb;
        const int ntile = NP / 64, nwork = ntile + (NS + 63) / 64;
        for (int wk = bid; wk < nwork; wk += G) {
            const bool prompt = wk < ntile; const int row_base = prompt ? wk * 64 : NP + (wk - ntile) * 64;
            __syncthreads();
            {
                const int hq = lane >> 4, f4 = (lane & 15) * 4;
                u32x2_t q1, q2, k1, k2, cv, p1, p2; u32x4_t cq8; f32x4 ca, sa, cb, sb; int p;
#define P2_LOAD(r_, Q1_, Q2_, K1_, K2_, CQ_, CV_, P1_, P2_, CA_, SA_, CB_, SB_, P_) do { const bf16_t* z_ = Zb + (size_t)(row_base + (r_)) * ZLD; P_ = pos_index(row_base + (r_)); \
                Q1_ = *(const u32x2_t*)(z_ + C_RQ + hq * RDK + f4); Q2_ = *(const u32x2_t*)(z_ + C_RQ + hq * RDK + 64 + f4); K1_ = *(const u32x2_t*)(z_ + C_RK + hq * RDK + f4); K2_ = *(const u32x2_t*)(z_ + C_RK + hq * RDK + 64 + f4); \
                CQ_ = (u32x4_t){0u, 0u, 0u, 0u}; if (lane < 48) CQ_ = *(const u32x4_t*)(z_ + C_CQ + 8 * lane); CV_ = *(const u32x2_t*)(z_ + C_CKV + 4 * lane); \
                P1_ = (u32x2_t){0u, 0u}; P2_ = P1_; CB_ = (f32x4){0.f, 0.f, 0.f, 0.f}; SB_ = CB_; \
                if (lane < 8) { P1_ = *(const u32x2_t*)(z_ + C_KPE + 4 * lane); P2_ = *(const u32x2_t*)(z_ + C_KPE + 32 + 4 * lane); CB_ = *(const f32x4*)(COSB + P_ * 32 + 4 * lane); SB_ = *(const f32x4*)(SINB + P_ * 32 + 4 * lane); } \
                CA_ = *(const f32x4*)(COSA + P_ * 64 + f4); SA_ = *(const f32x4*)(SINA + P_ * 64 + f4); } while (0)
#define BLO(x_) __builtin_bit_cast(float, (x_) << 16)
#define BHI(x_) __builtin_bit_cast(float, (x_) & 0xffff0000u)
                int r = wave;
                P2_LOAD(r, q1, q2, k1, k2, cq8, cv, p1, p2, ca, sa, cb, sb, p);
                for (; r < 64; r += NWAVES) {
                    u32x2_t q1n, q2n, k1n, k2n, cvn, p1n, p2n; u32x4_t cq8n; f32x4 can, san, cbn, sbn; int pn;
                    if (r + NWAVES < 64) P2_LOAD(r + NWAVES, q1n, q2n, k1n, k2n, cq8n, cvn, p1n, p2n, can, san, cbn, sbn, pn);
                    const int row = row_base + r; const int il = p & 127;
                    {
                        const float x1q[4] = {BLO(q1.x), BHI(q1.x), BLO(q1.y), BHI(q1.y)}, x2q[4] = {BLO(q2.x), BHI(q2.x), BLO(q2.y), BHI(q2.y)};
                        const float x1k[4] = {BLO(k1.x), BHI(k1.x), BLO(k1.y), BHI(k1.y)}, x2k[4] = {BLO(k2.x), BHI(k2.x), BLO(k2.y), BHI(k2.y)};
                        const float sc = 0.08838834764831845f;
                        float oq1[4], oq2[4], ok1[4], ok2[4];
#pragma unroll
                        for (int e = 0; e < 4; ++e) { oq1[e] = x1q[e] * ca[e] - x2q[e] * sa[e]; oq2[e] = x1q[e] * sa[e] + x2q[e] * ca[e];
                            ok1[e] = (x1k[e] * ca[e] - x2k[e] * sa[e]) * sc; ok2[e] = (x1k[e] * sa[e] + x2k[e] * ca[e]) * sc; }
                        if (prompt) {
                            const float fq = __expf((float)(il - 127) * lg_gamma(hq)), fk = 1.f / fq;
                            *(u32x2_t*)(RQt + (size_t)row * 512 + hq * RDK + f4) = (u32x2_t){cvtpk(oq1[0] * fq, oq1[1] * fq), cvtpk(oq1[2] * fq, oq1[3] * fq)};
                            *(u32x2_t*)(RQt + (size_t)row * 512 + hq * RDK + 64 + f4) = (u32x2_t){cvtpk(oq2[0] * fq, oq2[1] * fq), cvtpk(oq2[2] * fq, oq2[3] * fq)};
                            const u32x2_t kb1 = {cvtpk(ok1[0] * fk, ok1[1] * fk), cvtpk(ok1[2] * fk, ok1[3] * fk)}, kb2 = {cvtpk(ok2[0] * fk, ok2[1] * fk), cvtpk(ok2[2] * fk, ok2[3] * fk)};
                            *(u32x2_t*)(RKt + (size_t)row * 512 + hq * RDK + f4) = kb1; *(u32x2_t*)(RKt + (size_t)row * 512 + hq * RDK + 64 + f4) = kb2;
                            *(LAS u32x2_t*)(Kt + r * KTP + hq * RDK + f4) = kb1; *(LAS u32x2_t*)(Kt + r * KTP + hq * RDK + 64 + f4) = kb2;
                        } else {
                            *(f32x4*)(RQ + (size_t)row * 512 + hq * RDK + f4) = (f32x4){oq1[0], oq1[1], oq1[2], oq1[3]}; *(f32x4*)(RQ + (size_t)row * 512 + hq * RDK + 64 + f4) = (f32x4){oq2[0], oq2[1], oq2[2], oq2[3]};
                            *(f32x4*)(RK + (size_t)row * 512 + hq * RDK + f4) = (f32x4){ok1[0], ok1[1], ok1[2], ok1[3]}; *(f32x4*)(RK + (size_t)row * 512 + hq * RDK + 64 + f4) = (f32x4){ok2[0], ok2[1], ok2[2], ok2[3]};
                        }
                    }
                    {
                        const float c_[8] = {BLO(cq8.x), BHI(cq8.x), BLO(cq8.y), BHI(cq8.y), BLO(cq8.z), BHI(cq8.z), BLO(cq8.w), BHI(cq8.w)};
                        float ss = 0.f;
#pragma unroll
                        for (int e = 0; e < 8; ++e) ss += c_[e] * c_[e];
                        const float rr = rsqrtf(wave_sum(ss) * (1.f / QL) + EPS);
                        if (lane < 48) { const f32x4 g0 = *(const f32x4*)(g_qlat + 8 * lane), g1 = *(const f32x4*)(g_qlat + 8 * lane + 4);
                            *(u32x4_t*)(CQNb + (size_t)row * QL + 8 * lane) = (u32x4_t){cvtpk(c_[0] * rr * g0[0], c_[1] * rr * g0[1]), cvtpk(c_[2] * rr * g0[2], c_[3] * rr * g0[3]),
                                                                                     cvtpk(c_[4] * rr * g1[0], c_[5] * rr * g1[1]), cvtpk(c_[6] * rr * g1[2], c_[7] * rr * g1[3])}; }
                    }
                    {
                        const float v_[4] = {BLO(cv.x), BHI(cv.x), BLO(cv.y), BHI(cv.y)};
                        const float rr = rsqrtf(wave_sum(v_[0] * v_[0] + v_[1] * v_[1] + v_[2] * v_[2] + v_[3] * v_[3]) * (1.f / KVL) + EPS);
                        const f32x4 g0 = *(const f32x4*)(g_kvlat + 4 * lane); const f32x4 o_ = {v_[0] * rr * g0[0], v_[1] * rr * g0[1], v_[2] * rr * g0[2], v_[3] * rr * g0[3]};
                        float* ockv = row < NP ? out + O_CKVP + (size_t)row * KVL : out + O_CKVS + (size_t)(row - NP) * KVL;
                        *(f32x4*)(ockv + 4 * lane) = o_; *(f32x4*)(CKVN + (size_t)row * KVL + 4 * lane) = o_;
                        *(u32x2_t*)(CKVNb + (size_t)row * KVL + 4 * lane) = (u32x2_t){cvtpk(o_[0], o_[1]), cvtpk(o_[2], o_[3])};
                    }
                    if (lane < 8) {
                        const float x1[4] = {BLO(p1.x), BHI(p1.x), BLO(p1.y), BHI(p1.y)}, x2[4] = {BLO(p2.x), BHI(p2.x), BLO(p2.y), BHI(p2.y)};
                        f32x4 o1, o2;
#pragma unroll
                        for (int e = 0; e < 4; ++e) { o1[e] = x1[e] * cb[e] - x2[e] * sb[e]; o2[e] = x1[e] * sb[e] + x2[e] * cb[e]; }
                        *(f32x4*)(KPER + (size_t)row * DROPE + 4 * lane) = o1; *(f32x4*)(KPER + (size_t)row * DROPE + 32 + 4 * lane) = o2;
                        float* okpe = row < NP ? out + O_KPEP + (size_t)row * DROPE : out + O_KPES + (size_t)(row - NP) * DROPE;
                        *(f32x4*)(okpe + 4 * lane) = o1; *(f32x4*)(okpe + 32 + 4 * lane) = o2;
                        *(u32x2_t*)(KPERb + (size_t)row * DROPE + 4 * lane) = (u32x2_t){cvtpk(o1[0], o1[1]), cvtpk(o1[2], o1[3])}; *(u32x2_t*)(KPERb + (size_t)row * DROPE + 32 + 4 * lane) = (u32x2_t){cvtpk(o2[0], o2[1]), cvtpk(o2[2], o2[3])};
                    }
                    q1 = q1n; q2 = q2n; k1 = k1n; k2 = k2n; cq8 = cq8n; cv = cvn; p1 = p1n; p2 = p2n; ca = can; sa = san; cb = cbn; sb = sbn; p = pn;
                }
#undef P2_LOAD
            }
            __syncthreads();
            if (prompt) {
#pragma unroll 2
                for (int i = 0; i < 8; ++i) { const int pc = tid + i * NTHREADS, f = pc >> 3, k8 = pc & 7;
                    const LAS bf16_t* c = Kt + (8 * k8) * KTP + f;
                    pg8::u32x4 o; o.x = (unsigned)c[0] | ((unsigned)c[KTP] << 16); o.y = (unsigned)c[2 * KTP] | ((unsigned)c[3 * KTP] << 16);
                    o.z = (unsigned)c[4 * KTP] | ((unsigned)c[5 * KTP] << 16); o.w = (unsigned)c[6 * KTP] | ((unsigned)c[7 * KTP] << 16);
                    *(pg8::u32x4*)(RKtT + (size_t)f * NP + row_base + 8 * k8) = o; }
            }
        }
    }
    if (IN(2)) {
        for (int i = bid * NTHREADS + tid; i < NB * NMEM * 256; i += G * NTHREADS) { MKb[i] = f2bf(out[O_MKP + i]);
            const int f = i / (NB * NMEM), r = i - f * (NB * NMEM); MVT[i] = f2bf(out[O_MVP + (size_t)r * 256 + f]); }
    }
    SEAM(2);
    if (IN(3)) { pg8::Gemm g{CQNb, WuqT, NT, 1536, QL, QL, QL}; pg8::StaticOrder S; S.init(NT, 1536, G, bid); pg8::EpiBf16S E{Qb, 1536};
        GEMM_PHASE(pg8::EpiBf16S, ldsb, g, S, E);
        __syncthreads();
        { pg8::Gemm g2{CKVNb, WukT, NP, 1024, KVL, KVL, KVL}; pg8::StaticOrder S2; S2.init(NP, 1024, G, bid); pg8::EpiBf16S E2{KN, 1024}; GEMM_PHASE(pg8::EpiBf16S, ldsb, g2, S2, E2); }
        __syncthreads();
        { pg8::Gemm g3{WuvT, CKVNb, 1024, NP, KVL, KVL, KVL}; pg8::StaticOrder S3; S3.init(1024, NP, G, bid); pg8::EpiBf16S E3{VT, NP}; GEMM_PHASE(pg8::EpiBf16S, ldsb, g3, S3, E3); }
        ret_state_phase(ldsb, RVT, RKtT, UT, bid, G); }
    SEAM(3);
    if (IN(4)) {
        for (int idx = bid * NTHREADS + tid; idx < NB * RH * 8192; idx += G * NTHREADS) {
            const int bh = idx >> 13, e = (idx & 8191) * 4; const float g128 = __expf(128.f * lg_gamma(bh & 3));
            f32x4 u[16];
#pragma unroll
            for (int c = 0; c < 16; ++c) u[c] = __builtin_nontemporal_load((const f32x4*)(UT + (size_t)(bh * 16 + c) * 32768 + e));
            f32x4 sp = {0.f, 0.f, 0.f, 0.f}, S = sp;
#pragma unroll
            for (int c = 0; c < 16; ++c) { *(u32x2_t*)(SPT + (size_t)(bh * 16 + c) * 32768 + e) = (u32x2_t){cvtpk(sp[0], sp[1]), cvtpk(sp[2], sp[3])}; S = sp + u[c]; sp = S * g128; }
            const int dv = e >> 7, dk = e & 127; float* o_ = out + O_RETP + (size_t)bh * 32768 + (size_t)dk * RDV + dv;
            o_[0] = S[0]; o_[RDV] = S[1]; o_[2 * RDV] = S[2]; o_[3 * RDV] = S[3];
        }
        {
            const int hd = lane >> 3, f4 = (lane & 7) * 4;
            u32x2_t x1, x2; f32x4 cb, sb;
#define P4_LOAD(r_, X1_, X2_, C_, S_) do { const bf16_t* q_ = Qb + (size_t)(r_) * 1536 + hd * DQH + DNOPE + f4; X1_ = *(const u32x2_t*)q_; X2_ = *(const u32x2_t*)(q_ + 32); \
            const int p_ = pos_index(r_); C_ = *(const f32x4*)(COSB + p_ * 32 + f4); S_ = *(const f32x4*)(SINB + p_ * 32 + f4); } while (0)
            int row = gw;
            if (row < NT) P4_LOAD(row, x1, x2, cb, sb);
            for (; row < NT; row += NGW) {
                u32x2_t x1n, x2n; f32x4 cbn, sbn; const int nr = row + NGW;
                if (nr < NT) P4_LOAD(nr, x1n, x2n, cbn, sbn);
                const float a0 = __builtin_bit_cast(float, x1.x << 16), a1 = __builtin_bit_cast(float, x1.x & 0xffff0000u), a2 = __builtin_bit_cast(float, x1.y << 16), a3 = __builtin_bit_cast(float, x1.y & 0xffff0000u);
                const float b0 = __builtin_bit_cast(float, x2.x << 16), b1 = __builtin_bit_cast(float, x2.x & 0xffff0000u), b2 = __builtin_bit_cast(float, x2.y << 16), b3 = __builtin_bit_cast(float, x2.y & 0xffff0000u);
                bf16_t* o_ = QPEb + (size_t)row * 512 + hd * DROPE + f4;
                *(u32x2_t*)o_ = (u32x2_t){cvtpk(a0 * cb[0] - b0 * sb[0], a1 * cb[1] - b1 * sb[1]), cvtpk(a2 * cb[2] - b2 * sb[2], a3 * cb[3] - b3 * sb[3])};
                *(u32x2_t*)(o_ + 32) = (u32x2_t){cvtpk(a0 * sb[0] + b0 * cb[0], a1 * sb[1] + b1 * cb[1]), cvtpk(a2 * sb[2] + b2 * cb[2], a3 * sb[3] + b3 * cb[3])};
                x1 = x1n; x2 = x2n; cb = cbn; sb = sbn;
            }
#undef P4_LOAD
        }
        for (int wt = gw; wt < MH * 16 * 2; wt += NGW) {
            const int lh = wt & 1, rb = (wt >> 1) & 15, head = wt >> 5; const int l31 = lane & 31, h8 = lane >> 5;
            f32x16 acc[4];
#pragma unroll
            for (int k_ = 0; k_ < 4; ++k_)
#pragma unroll
                for (int i = 0; i < 16; ++i) acc[k_][i] = 0.f;
            const bf16_t* ap = Qb + ((size_t)NP + 32 * rb + l31) * 1536 + head * DQH + 8 * h8;
            const bf16_t* bp = WukB + ((size_t)head * KVL + 128 * lh + l31) * DNOPE + 8 * h8;
#pragma unroll
            for (int s_ = 0; s_ < 8; ++s_) { const bf16x8 a = *(const bf16x8*)(ap + 16 * s_);
#pragma unroll
                for (int k_ = 0; k_ < 4; ++k_) { const bf16x8 b_ = *(const bf16x8*)(bp + (size_t)(32 * k_) * DNOPE + 16 * s_); acc[k_] = MFMA32(a, b_, acc[k_]); } }
#pragma unroll
            for (int k_ = 0; k_ < 4; ++k_)
#pragma unroll
                for (int i = 0; i < 16; ++i) QLATb[(size_t)(32 * rb + crow(i, h8)) * 2048 + head * KVL + 128 * lh + 32 * k_ + l31] = f2bf(acc[k_][i]);
        }
    }
    SEAM(4);
    if (IN(5)) {
        auto compute_units = [&]() __attribute__((always_inline)) {
        if (args.sub & 2) for (int it = bid; it < NB * MH * 4; it += G) {
            const int pr = __builtin_amdgcn_readfirstlane(it & 3), hh = __builtin_amdgcn_readfirstlane((it >> 2) & 7), b = __builtin_amdgcn_readfirstlane(it >> 5);
#pragma unroll 1
            for (int half = 0; half < 2; ++half) { const int qb = __builtin_amdgcn_readfirstlane(half ? pr : 7 - pr); const size_t row0 = (size_t)b * SEQ + qb * 256;
                SrcMlaP src{KN, KPERb, VT, Qb, QPEb, b, hh, row0};
                flash_unit<192, 128, true>(ldsb, src, qb * 256, 4 * (qb + 1), OMLAb + row0 * 1024 + hh * DVH, 1024, 0.07216878364870322f * 1.4426950408889634f); }
        }
        if (args.sub & 4) ret_out_phase(ldsb, RQt, RKt, RVT, SPT, ORET, bid, G);
        if (args.sub & 16) for (int it = bid; it < NB * XH * 8; it += G) {
            const int qb = __builtin_amdgcn_readfirstlane(it & 7), hh = __builtin_amdgcn_readfirstlane((it >> 3) & 3), b = __builtin_amdgcn_readfirstlane(it >> 5); const size_t row0 = (size_t)b * SEQ + qb * 256;
            SrcMemP src{MKb, MVT, Zb + C_XQ, b, hh, row0};
            flash_unit<64, 64, false>(ldsb, src, 0, 4, OXb + row0 * 256 + hh * XHD, 256, 0.125f * 1.4426950408889634f);
        }
        };
        const bool compute_first = ((bid >> 3) & 1) != 0;
        if (compute_first) compute_units();
        if (args.sub & 1) for (int it = bid; it < DB * MS_NSPLIT; it += G) { const int split = __builtin_amdgcn_readfirstlane(it % MS_NSPLIT), b = __builtin_amdgcn_readfirstlane(it / MS_NSPLIT);
            mla_sample_unit(ldsb, cache_ckv, cache_kpe, page_table, QLATb, QPEb, PO, PML, b, split, 0.07216878364870322f * 1.4426950408889634f); }
        if (args.sub & 8) for (int it = bid; it < DB * RH; it += G) {
            const int h = it & 3, b = it >> 2; const float lg = lg_gamma(h);
            const float* s0 = state_ret + (size_t)it * RDK * RDV;
            float* so = out + O_RETS + (size_t)it * RDK * RDV;
            LAS float* inner = lds;
            LAS float* qk = lds + 16;
            LAS float* vls = lds + 1040;
            LAS float* red = lds + 2064;
            f32x4 sv[16], vv[4];
#pragma unroll
            for (int r = 0; r < 16; ++r) sv[r] = __builtin_nontemporal_load((const f32x4*)(s0 + (size_t)(wave + 8 * r) * RDV + 4 * lane));
#pragma unroll
            for (int j = 0; j < DS; ++j) { const u32x2_t t_ = *(const u32x2_t*)(Zb + ((size_t)NP + b * DS + j) * ZLD + C_RV + h * RDV + 4 * lane); vv[j] = (f32x4){BLO(t_.x), BHI(t_.x), BLO(t_.y), BHI(t_.y)}; }
            __syncthreads();
            for (int i = tid; i < 1024; i += NTHREADS) { const int which = i >> 9, ti = (i >> 7) & 3, d = i & 127; const size_t row = (size_t)NP + b * DS + ti;
                qk[i] = which ? RK[row * 512 + h * RDK + d] : RQ[row * 512 + h * RDK + d]; }
            if (wave == 0) {
#pragma unroll
                for (int j = 0; j < DS; ++j) *(LAS f32x4*)(vls + j * 256 + 4 * lane) = vv[j]; }
            __syncthreads();
            for (int pr = wave; pr < 16; pr += NWAVES) { const int i = pr >> 2, j = pr & 3;
                float s_ = qk[i * 128 + lane] * qk[512 + j * 128 + lane] + qk[i * 128 + 64 + lane] * qk[512 + j * 128 + 64 + lane];
                s_ = wave_sum(s_);
                if (lane == 0) inner[pr] = (j <= i) ? s_ * __expf((float)(i - j) * lg) : 0.f; }
            const float g4 = __expf(4.f * lg), gk0 = __expf(3.f * lg), gk1 = __expf(2.f * lg), gk2 = __expf(lg);
            f32x4 po[4];
#pragma unroll
            for (int i = 0; i < 4; ++i) po[i] = (f32x4){0.f, 0.f, 0.f, 0.f};
#pragma unroll
            for (int r = 0; r < 16; ++r) { const int d = wave + 8 * r; const f32x4 sx = sv[r];
                f32x4 a = sx * g4 + (gk0 * qk[512 + d]) * vv[0] + (gk1 * qk[512 + 128 + d]) * vv[1] + (gk2 * qk[512 + 256 + d]) * vv[2] + qk[512 + 384 + d] * vv[3];
                __builtin_nontemporal_store(a, (f32x4*)(so + (size_t)d * RDV + 4 * lane));
#pragma unroll
                for (int i = 0; i < 4; ++i) po[i] += qk[i * 128 + d] * sx; }
#pragma unroll
            for (int i = 0; i < 4; ++i) *(LAS f32x4*)(red + (wave * 4 + i) * 256 + 4 * lane) = po[i];
            __syncthreads();
            {
                const int i = tid >> 7, e2 = (tid & 127) * 2;
                float o0 = 0.f, o1 = 0.f;
#pragma unroll
                for (int w_ = 0; w_ < NWAVES; ++w_) { o0 += red[(w_ * 4 + i) * 256 + e2]; o1 += red[(w_ * 4 + i) * 256 + e2 + 1]; }
                const float gi = __expf((float)(i + 1) * lg); o0 *= gi; o1 *= gi;
#pragma unroll
                for (int j = 0; j < DS; ++j) { const float w_ = inner[i * 4 + j]; o0 += w_ * vls[j * 256 + e2]; o1 += w_ * vls[j * 256 + e2 + 1]; }
                *(f32x2_t*)(ORET + ((size_t)NP + b * DS + i) * 1024 + h * RDV + e2) = (f32x2_t){o0, o1};
            }
        }
        if (args.sub & 32) for (int b = bid; b < DB; b += G) {
            LAS float* sc = lds;
            LAS float* red = lds + 4096;
            const float* kb_ = cache_mem_k + (size_t)b * NMEM * 256; const float* vb_ = cache_mem_v + (size_t)b * NMEM * 256;
            f32x4 qr[4];
#pragma unroll
            for (int q = 0; q < DS; ++q) { const u32x2_t t_ = *(const u32x2_t*)(Zb + ((size_t)NP + b * DS + q) * ZLD + C_XQ + 4 * lane); qr[q] = (f32x4){BLO(t_.x), BHI(t_.x), BLO(t_.y), BHI(t_.y)}; }
            __syncthreads();
#pragma unroll 8
            for (int kk = 0; kk < 32; ++kk) { const int key = 32 * wave + kk; const f32x4 kv = __builtin_nontemporal_load((const f32x4*)(kb_ + (size_t)key * 256 + 4 * lane));
                float pq[4];
#pragma unroll
                for (int q = 0; q < 4; ++q) { float a = kv[0] * qr[q][0] + kv[1] * qr[q][1] + kv[2] * qr[q][2] + kv[3] * qr[q][3];
                    a += __shfl_xor(a, 1); a += __shfl_xor(a, 2); a += __shfl_xor(a, 4); a += __shfl_xor(a, 8); pq[q] = a; }
                if ((lane & 15) == 0) {
#pragma unroll
                    for (int q = 0; q < 4; ++q) sc[(q * 4 + (lane >> 4)) * 256 + key] = pq[q] * (0.125f * 1.4426950408889634f); } }
            __syncthreads();
            for (int rr = wave * 2; rr < wave * 2 + 2; ++rr) {
                f32x4 v = *(LAS f32x4*)(sc + rr * 256 + 4 * lane);
                const float mx = wave_max(fmaxf(fmaxf(v[0], v[1]), fmaxf(v[2], v[3])));
#pragma unroll
                for (int e = 0; e < 4; ++e) v[e] = __builtin_amdgcn_exp2f(v[e] - mx);
                const float inv = 1.f / wave_sum(v[0] + v[1] + v[2] + v[3]);
                *(LAS f32x4*)(sc + rr * 256 + 4 * lane) = v * inv; }
            __syncthreads();
            f32x4 acc[4];
#pragma unroll
            for (int q = 0; q < 4; ++q) acc[q] = (f32x4){0.f, 0.f, 0.f, 0.f};
#pragma unroll 8
            for (int kk = 0; kk < 32; ++kk) { const int key = 32 * wave + kk; const f32x4 vv = __builtin_nontemporal_load((const f32x4*)(vb_ + (size_t)key * 256 + 4 * lane));
#pragma unroll
                for (int q = 0; q < 4; ++q) acc[q] += sc[(q * 4 + (lane >> 4)) * 256 + key] * vv; }
#pragma unroll
            for (int q = 0; q < 4; ++q) *(LAS f32x4*)(red + (wave * 4 + q) * 256 + 4 * lane) = acc[q];
            __syncthreads();
            { const int q = tid >> 7, e2 = (tid & 127) * 2; float o0 = 0.f, o1 = 0.f;
#pragma unroll
              for (int w_ = 0; w_ < NWAVES; ++w_) { o0 += red[(w_ * 4 + q) * 256 + e2]; o1 += red[(w_ * 4 + q) * 256 + e2 + 1]; }
              *(unsigned*)(OXb + ((size_t)NP + b * DS + q) * 256 + e2) = cvtpk(o0, o1); }
        }
            if (!compute_first) compute_units();
    }
    SEAM(5);
    if (IN(6)) {
        for (int bt = bid; bt < NS; bt += G) {
            const int b = bt >> 2;
            const int head = wave; const float c2 = 0.07216878364870322f * 1.4426950408889634f;
            LAS float* ol = lds + wave * KVL;
            { const int t = bt & 3;
                const int qi = t * 8 + head; const size_t qrow = (size_t)b * DS + t;
                float qv[5];
#pragma unroll
                for (int c = 0; c < 5; ++c) { const int d = lane + 64 * c; const bf16_t raw = d < KVL ? QLATb[qrow * 2048 + head * KVL + d] : QPEb[(NP + qrow) * 512 + head * DROPE + (d - KVL)];
                    qv[c] = __builtin_bit_cast(float, (unsigned)raw << 16); }
                float sc[DS]; float M = -INFINITY;
#pragma unroll
                for (int j = 0; j < DS; ++j) { const size_t krow = (size_t)NP + b * DS + j; float a = 0.f;
#pragma unroll
                    for (int c = 0; c < 5; ++c) { const int d = lane + 64 * c; a += qv[c] * (d < KVL ? CKVN[krow * KVL + d] : KPER[krow * DROPE + (d - KVL)]); }
                    a = wave_sum(a) * c2; sc[j] = (j <= t) ? a : -INFINITY; M = fmaxf(M, sc[j]); }
                float ms[MS_NSPLIT], ls[MS_NSPLIT];
#pragma unroll
                for (int sp = 0; sp < MS_NSPLIT; ++sp) { const int item = b * MS_NSPLIT + sp; ms[sp] = PML[(item * 32 + qi) * 2]; ls[sp] = PML[(item * 32 + qi) * 2 + 1]; M = fmaxf(M, ms[sp]); }
                float L = 0.f; float acc[4] = {0.f, 0.f, 0.f, 0.f};
#pragma unroll
                for (int sp = 0; sp < MS_NSPLIT; ++sp) { const int item = b * MS_NSPLIT + sp; const float wgt = __builtin_amdgcn_exp2f(ms[sp] - M); L += ls[sp] * wgt;
#pragma unroll
                    for (int c = 0; c < 4; ++c) acc[c] += wgt * PO[((size_t)item * 32 + qi) * KVL + lane + 64 * c]; }
#pragma unroll
                for (int j = 0; j < DS; ++j) { const float wgt = __builtin_amdgcn_exp2f(sc[j] - M); L += wgt; const size_t krow = (size_t)NP + b * DS + j;
#pragma unroll
                    for (int c = 0; c < 4; ++c) acc[c] += wgt * CKVN[krow * KVL + lane + 64 * c]; }
                const float inv = 1.f / L;
#pragma unroll
                for (int c = 0; c < 4; ++c) ol[lane + 64 * c] = acc[c] * inv;
                __syncthreads();
                float a0 = 0.f, a1 = 0.f; const float* wv = w_uv + (size_t)head * KVL * DVH;
#pragma unroll 8
                for (int l = 0; l < KVL; ++l) { const float x = ol[l]; a0 += x * wv[(size_t)l * DVH + lane]; a1 += x * wv[(size_t)l * DVH + 64 + lane]; }
                OMLAb[((size_t)NP + qrow) * 1024 + head * DVH + lane] = f2bf(a0); OMLAb[((size_t)NP + qrow) * 1024 + head * DVH + 64 + lane] = f2bf(a1);
                __syncthreads();
            }
        }
        {
            f32x4 a[4]; u32x2_t gz[4];
#define P6_LOAD(r_, A_, B_) do { _Pragma("unroll") for (int j_ = 0; j_ < 4; ++j_) { A_[j_] = *(const f32x4*)(ORET + (size_t)(r_) * 1024 + 4 * lane + 256 * j_); \
                                                                              B_[j_] = *(const u32x2_t*)(SRGb + (size_t)(r_) * 1024 + 4 * lane + 256 * j_); } } while (0)
            int row = gw;
            if (row < NT) P6_LOAD(row, a, gz);
            for (; row < NT; row += NGW) {
                f32x4 an[4]; u32x2_t gn[4]; const int nr = row + NGW;
                if (nr < NT) P6_LOAD(nr, an, gn);
#pragma unroll
                for (int j = 0; j < 4; ++j) {
                    const float ss = wave_sum(a[j][0] * a[j][0] + a[j][1] * a[j][1] + a[j][2] * a[j][2] + a[j][3] * a[j][3]);
                    const float r = rsqrtf(ss * (1.f / RDV) + EPS);
                    float o_[4];
#pragma unroll
                    for (int e = 0; e < 4; ++e) { const unsigned gw_ = e < 2 ? gz[j].x : gz[j].y; o_[e] = __builtin_bit_cast(float, (e & 1) ? (gw_ & 0xffff0000u) : (gw_ << 16)) * a[j][e] * r; }
                    *(u32x2_t*)(ORETNb + (size_t)row * 1024 + 4 * lane + 256 * j) = (u32x2_t){cvtpk(o_[0], o_[1]), cvtpk(o_[2], o_[3])};
                }
#pragma unroll
                for (int j = 0; j < 4; ++j) { a[j] = an[j]; gz[j] = gn[j]; }
            }
#undef P6_LOAD
        }
    }
    SEAM(6);
    if (IN(7)) {
        pg8::StaticOrder S; S.init(NP, 1024, G, bid);
        { pg8::Gemm g{ORETNb, WroT, NP, 1024, 1024, 1024, 1024}; pg8::EpiGate<0> E{SGb, T0b, T0b, 1024}; GEMM_PHASE(pg8::EpiGate<0>, ldsb, g, S, E); }
        __syncthreads();
        { pg8::Gemm g{OMLAb, WmoT, NP, 1024, 1024, 1024, 1024}; pg8::EpiGate<1> E{SGb + 1024, T0b, T1b, 1024}; GEMM_PHASE(pg8::EpiGate<1>, ldsb, g, S, E); }
        __syncthreads();
        { pg8::Gemm g{OXb, WxoT, NP, 1024, 256, 256, 256}; pg8::EpiGate<1> E{SGb + 2048, T1b, MIXb, 1024}; GEMM_PHASE(pg8::EpiGate<1>, ldsb, g, S, E); }
        __syncthreads();
        { pg8::Gemm g{ORETNb, WroT, NT, 1024, 256, 1024, 1024, 256}; pg8::SplitOrder SS{4, bid}; pg8::EpiPart E{PART}; GEMM_SPLIT(ldsb, g, SS, E); }
        __syncthreads();
        { pg8::Gemm g{OMLAb, WmoT, NT, 1024, 256, 1024, 1024, 256}; pg8::SplitOrder SS{4, (bid + 224) % G}; pg8::EpiPart E{PART + (size_t)4 * 512 * 1024}; GEMM_SPLIT(ldsb, g, SS, E); }
        __syncthreads();
        { pg8::Gemm g{OXb, WxoT, NT, 1024, 256, 256, 256, 256}; pg8::SplitOrder SS{1, (bid + 128) % G}; pg8::EpiPart E{PART + (size_t)8 * 512 * 1024}; GEMM_SPLIT(ldsb, g, SS, E); }
    }
    SEAM(7);
    if (IN(8)) {
        for (int i = bid * NTHREADS + tid; i < NS * 256; i += G * NTHREADS) { const int r = i >> 8, c4 = (i & 255) * 4; const size_t o_ = (size_t)r * 1024 + c4;
            f32x4 mix = {0.f, 0.f, 0.f, 0.f};
#pragma unroll
            for (int br = 0; br < 3; ++br) { f32x4 a = *(const f32x4*)(PART + (size_t)(br == 2 ? 8 : 4 * br) * (512 * 1024) + o_);
                if (br < 2) {
#pragma unroll
                    for (int k_ = 1; k_ < 4; ++k_) a += *(const f32x4*)(PART + (size_t)(4 * br + k_) * (512 * 1024) + o_); }
                const u32x2_t gq = *(const u32x2_t*)(SGb + (size_t)(NP + r) * 3072 + br * 1024 + c4);
                mix[0] += a[0] * __builtin_bit_cast(float, gq.x << 16); mix[1] += a[1] * __builtin_bit_cast(float, gq.x & 0xffff0000u);
                mix[2] += a[2] * __builtin_bit_cast(float, gq.y << 16); mix[3] += a[3] * __builtin_bit_cast(float, gq.y & 0xffff0000u); }
            *(u32x2_t*)(MIXb + (size_t)(NP + r) * 1024 + c4) = (u32x2_t){cvtpk(mix[0], mix[1]), cvtpk(mix[2], mix[3])}; }
    }
    SEAM(8);
    if (IN(9)) { pg8::Gemm g{MIXb, WoT, NP, 1024, 1024, 1024, 1024}; pg8::StaticOrder S; S.init(NP, 1024, G, bid); pg8::EpiF32S E{HP, 1024, 0, 0};
        GEMM_PHASE(pg8::EpiF32S, ldsb, g, S, E);
        __syncthreads();
        { pg8::Gemm g2{MIXb, WoT, NT, 1024, 256, 1024, 1024, 256}; pg8::SplitOrder SS{4, bid}; pg8::EpiPart E2{PART}; GEMM_SPLIT(ldsb, g2, SS, E2); } }
    SEAM(9);
    if (IN(10)) {
        f32x4 gp[4], gf[4], a[4], b[4];
#pragma unroll
        for (int j = 0; j < 4; ++j) { gp[j] = *(const f32x4*)(g_mix_post + 4 * lane + 256 * j); gf[j] = *(const f32x4*)(g_ffn_pre + 4 * lane + 256 * j); }
#define P10_LOAD(r_, A_, B_) do { const float* xr_ = (r_) < NP ? x_prompt + (size_t)(r_) * DM : x_sample + (size_t)((r_) - NP) * DM; \
        _Pragma("unroll") for (int j_ = 0; j_ < 4; ++j_) { B_[j_] = *(const f32x4*)(xr_ + 4 * lane + 256 * j_); \
            if ((r_) < NP) A_[j_] = *(const f32x4*)(HP + (size_t)(r_) * DM + 4 * lane + 256 * j_); \
            else { const float* p_ = PART + (size_t)((r_) - NP) * DM + 4 * lane + 256 * j_; A_[j_] = (*(const f32x4*)p_ + *(const f32x4*)(p_ + 512 * 1024)) + (*(const f32x4*)(p_ + 2 * 512 * 1024) + *(const f32x4*)(p_ + 3 * 512 * 1024)); } } } while (0)
        int row = gw;
        if (row < NT) P10_LOAD(row, a, b);
        for (; row < NT; row += NGW) {
            f32x4 an[4], bn[4]; const int nr = row + NGW;
            if (nr < NT) P10_LOAD(nr, an, bn);
            float ss = 0.f;
#pragma unroll
            for (int j = 0; j < 4; ++j) ss += a[j][0] * a[j][0] + a[j][1] * a[j][1] + a[j][2] * a[j][2] + a[j][3] * a[j][3];
            float r = rsqrtf(wave_sum(ss) * (1.f / DM) + EPS); ss = 0.f;
#pragma unroll
            for (int j = 0; j < 4; ++j) { a[j] = b[j] + a[j] * r * gp[j]; *(f32x4*)(H + (size_t)row * DM + 4 * lane + 256 * j) = a[j];
                ss += a[j][0] * a[j][0] + a[j][1] * a[j][1] + a[j][2] * a[j][2] + a[j][3] * a[j][3]; }
            r = rsqrtf(wave_sum(ss) * (1.f / DM) + EPS);
#pragma unroll
            for (int j = 0; j < 4; ++j) { const f32x4 f_ = a[j] * r * gf[j]; *(u32x2_t*)(Fb + (size_t)row * DM + 4 * lane + 256 * j) = (u32x2_t){cvtpk(f_[0], f_[1]), cvtpk(f_[2], f_[3])}; }
#pragma unroll
            for (int j = 0; j < 4; ++j) { a[j] = an[j]; b[j] = bn[j]; }
        }
#undef P10_LOAD
    }
    SEAM(10);
    if (IN(11)) {
        pg8::Gemm g{Fb, WguT, NT, 2 * DFF, 1024, 1024, 1024}; pg8::StaticOrder S; S.init(NT, 2 * DFF, G, bid); pg8::EpiSwiGLU E{ACTb, DFF};
        GEMM_PHASE(pg8::EpiSwiGLU, ldsb, g, S, E);
    }
    SEAM(11);
    if (IN(13)) { pg8::Gemm g{ACTb, WdT, NP, 1024, DFF, DFF, DFF}; pg8::StaticOrder S; S.init(NP, 1024, G, bid); pg8::EpiF32S E{FO, 1024, 0, 0};
        GEMM_PHASE(pg8::EpiF32S, ldsb, g, S, E);
        __syncthreads();
        { pg8::Gemm g2{ACTb, WdT, NT, 1024, 256, DFF, DFF, 256}; pg8::SplitOrder SS{11, bid}; pg8::EpiPart E2{PART}; GEMM_SPLIT(ldsb, g2, SS, E2); } }
    SEAM(13);
    if (IN(14)) {
        f32x4 gp[4], a[4], b[4];
#pragma unroll
        for (int j = 0; j < 4; ++j) gp[j] = *(const f32x4*)(g_ffn_post + 4 * lane + 256 * j);
#define P14_LOAD(r_, A_, B_) do { _Pragma("unroll") for (int j_ = 0; j_ < 4; ++j_) { B_[j_] = *(const f32x4*)(H + (size_t)(r_) * DM + 4 * lane + 256 * j_); \
            if ((r_) < NP) A_[j_] = *(const f32x4*)(FO + (size_t)(r_) * DM + 4 * lane + 256 * j_); \
            else { const float* p_ = PART + (size_t)((r_) - NP) * DM + 4 * lane + 256 * j_; f32x4 a_ = *(const f32x4*)p_; \
                _Pragma("unroll") for (int k_ = 1; k_ < 11; ++k_) a_ += *(const f32x4*)(p_ + (size_t)k_ * 512 * 1024); A_[j_] = a_; } } } while (0)
        int row = gw;
        if (row < NT) P14_LOAD(row, a, b);
        for (; row < NT; row += NGW) {
            f32x4 an[4], bn[4]; const int nr = row + NGW;
            if (nr < NT) P14_LOAD(nr, an, bn);
            float ss = 0.f;
#pragma unroll
            for (int j = 0; j < 4; ++j) ss += a[j][0] * a[j][0] + a[j][1] * a[j][1] + a[j][2] * a[j][2] + a[j][3] * a[j][3];
            const float r = rsqrtf(wave_sum(ss) * (1.f / DM) + EPS);
            float* y = row < NP ? out + O_YP + (size_t)row * DM : out + O_YS + (size_t)(row - NP) * DM;
#pragma unroll
            for (int j = 0; j < 4; ++j) *(f32x4*)(y + 4 * lane + 256 * j) = b[j] + a[j] * r * gp[j];
#pragma unroll
            for (int j = 0; j < 4; ++j) { a[j] = an[j]; b[j] = bn[j]; }
        }
#undef P14_LOAD
    }
#undef IN
#undef SEAM
}
#undef x_prompt
#undef x_sample
#undef mem_prompt
#undef cache_ckv
#undef cache_kpe
#undef page_table
#undef state_ret
#undef cache_mem_k
#undef cache_mem_v
#undef g_mix_pre
#undef g_mix_post
#undef g_ffn_pre
#undef g_ffn_post
#undef g_mem
#undef g_qlat
#undef g_kvlat
#undef w_in
#undef w_uq
#undef w_uk
#undef w_uv
#undef w_mem_k
#undef w_mem_v
#undef w_ret_o
#undef w_mla_o
#undef w_x_o
#undef w_out
#undef w_gate
#undef w_up
#undef w_down
#undef COSA
#undef SINA
#undef COSB
#undef SINB
#undef U
#undef MN
#undef Zb
#undef RQ
#undef RK
#undef CQN
#undef CKVN
#undef KPER
#undef Q
#undef QLAT
#undef QPE
#undef ORET
#undef OLAT
#undef OX
#undef OMLA
#undef ORETN
#undef ARET
#undef AMLA
#undef AX
#undef MIX
#undef HP
#undef H
#undef F
#undef GU
#undef FO
#undef WinT
#undef WmkvT
#undef WuqT
#undef WroT
#undef WmoT
#undef WxoT
#undef WoT
#undef WguT
#undef WdT
#undef Ub
#undef MNb
#undef CQNb
#undef ORETNb
#undef OMLAb
#undef OXb
#undef MIXb
#undef Fb
#undef ACTb
#undef WukT
#undef WuvT
#undef CKVNb
#undef KPERb
#undef XQb
#undef MKb
#undef MVT
#undef KN
#undef VT
#undef Qb
#undef RQt
#undef RKt
#undef RKtT
#undef RVT
#undef UT
#undef SPT
#undef QPEb
#undef WukB
#undef PART
#undef SGb
#undef SRGb
#undef T0b
#undef T1b
#undef QLATb
#undef PO
#undef PML
constexpr int N_PHASES = 15;
}

extern "C" void kernel_launch(void* const* d_in, const int* in_sizes, int n_in, void* d_out, int out_size, void* d_ws, size_t ws_size, hipStream_t stream) {
    static int grid = 0;
    if (grid == 0) {
        if (n_in != 29 || (size_t)out_size != O_END || ws_size < WS_END) { fprintf(stderr, "kernel_launch: unexpected shapes: n_in %d out %d ws %zu (need %zu)\n", n_in, out_size, ws_size, (size_t)WS_END); grid = -1; return; }
        int dev = 0, cus = 0, per_cu = 0;
        if (hipGetDevice(&dev) != hipSuccess || hipDeviceGetAttribute(&cus, hipDeviceAttributeMultiprocessorCount, dev) != hipSuccess) { grid = -1; return; }
        if (hipFuncSetAttribute((const void*)fwd_kernel, hipFuncAttributeMaxDynamicSharedMemorySize, LDS_BYTES) != hipSuccess) { fprintf(stderr, "kernel_launch: hipFuncSetAttribute failed\n"); grid = -1; return; }
        if (hipOccupancyMaxActiveBlocksPerMultiprocessor(&per_cu, (const void*)fwd_kernel, NTHREADS, LDS_BYTES) != hipSuccess || per_cu < 1) { fprintf(stderr, "kernel_launch: occupancy query says %d\n", per_cu); per_cu = 1; }
        (void)hipGetLastError();
        grid = cus;
    }
    if (grid < 0) return;
    (void)hipMemsetAsync((char*)d_ws + WS_CTL, 0, CTL_BYTES, stream);
    Args a{};
    for (int i = 0; i < 29; ++i) a.in[i] = (const float*)d_in[i];
    a.out = (float*)d_out; a.ws = (unsigned char*)d_ws;
#if MK_ONE_LAUNCH
    a.ph_lo = 0; a.ph_hi = N_PHASES; a.sub = 0xff;
    hipLaunchKernelGGL(fwd_kernel, dim3(grid), dim3(NTHREADS), LDS_BYTES, stream, a);
#if PROBE_DUP >= 0
    a.ph_lo = PROBE_DUP; a.ph_hi = PROBE_DUP + 1; a.sub = PROBE_SUB;
    hipLaunchKernelGGL(fwd_kernel, dim3(grid), dim3(NTHREADS), LDS_BYTES, stream, a);
#endif
#else
    a.sub = 0xff; for (int p = 0; p < N_PHASES; ++p) { a.ph_lo = p; a.ph_hi = p + 1; hipLaunchKernelGGL(fwd_kernel, dim3(grid), dim3(NTHREADS), LDS_BYTES, stream, a); }
#endif
}
```

```cpp
#include <hip/hip_runtime.h>
#include <cstdio>
#include <cstdint>

#ifndef PROBE_DUP
#define PROBE_DUP -1
#endif
#ifndef PROBE_SUB
#define PROBE_SUB 0xff
#endif
#ifndef MK_ONE_LAUNCH
#define MK_ONE_LAUNCH 1
#endif

#define LAS __attribute__((address_space(3)))
#define GAS __attribute__((address_space(1)))
#define DI __device__ __forceinline__
typedef float f32x4 __attribute__((ext_vector_type(4)));
typedef __bf16 bf16x2_t __attribute__((ext_vector_type(2)));
typedef float f32x2_t __attribute__((ext_vector_type(2)));
DI unsigned cvtpk(float lo, float hi) { f32x2_t v = {lo, hi}; bf16x2_t b = __builtin_convertvector(v, bf16x2_t); return __builtin_bit_cast(unsigned, b); }

namespace {
constexpr int DM = 1024, NB = 8, SEQ = 2048, NP = NB * SEQ, DB = 128, DS = 4, NS = DB * DS, NT = NP + NS;
constexpr int PAST = 8192, PAGE = 128, NPAGES = PAST / PAGE;
constexpr int RH = 4, RDK = 128, RDV = 256;
constexpr int MH = 8, QL = 384, KVL = 256, DNOPE = 128, DROPE = 64, DVH = 128, DQH = DNOPE + DROPE;
constexpr int NMEM = 256, XH = 4, XHD = 64;
constexpr int DFF = 2816, DIN = 7104, ZLD = 7168;
constexpr int C_RQ = 0, C_RK = 512, C_RV = 1024, C_RG = 2048, C_CQ = 3072, C_CKV = 3456, C_KPE = 3712, C_XQ = 3776, C_G = 4032;
constexpr float EPS = 1e-6f;
constexpr int NPOS = SEQ + DS;
constexpr int NTHREADS = 512, NWAVES = 8;
constexpr int LDS_BYTES = 147456;
constexpr int MISC_OFF = 147456 - 256;

constexpr size_t O_YP = 0, O_YS = O_YP + (size_t)NP * DM, O_CKVP = O_YS + (size_t)NS * DM, O_KPEP = O_CKVP + (size_t)NP * KVL,
                 O_CKVS = O_KPEP + (size_t)NP * DROPE, O_KPES = O_CKVS + (size_t)NS * KVL, O_RETP = O_KPES + (size_t)NS * DROPE,
                 O_RETS = O_RETP + (size_t)NB * RH * RDK * RDV, O_MKP = O_RETS + (size_t)DB * RH * RDK * RDV, O_MVP = O_MKP + (size_t)NB * NMEM * 256,
                 O_END = O_MVP + (size_t)NB * NMEM * 256;

constexpr size_t al256(size_t x) { return (x + 255) & ~(size_t)255; }
constexpr size_t WS_CTL = 0, CTL_BYTES = 1u << 20;
constexpr size_t WS_COSA = WS_CTL + CTL_BYTES;
constexpr size_t WS_SINA = WS_COSA + al256((size_t)NPOS * 64 * 4);
constexpr size_t WS_COSB = WS_SINA + al256((size_t)NPOS * 64 * 4);
constexpr size_t WS_SINB = WS_COSB + al256((size_t)NPOS * 32 * 4);
constexpr size_t WS_U = WS_SINB + al256((size_t)NPOS * 32 * 4);
constexpr size_t WS_MN = WS_U + (size_t)NT * DM * 4;
constexpr size_t WS_Z = WS_MN + (size_t)NB * NMEM * DM * 4;
constexpr size_t WS_RQ = WS_Z + (size_t)NT * ZLD * 4;
constexpr size_t WS_RK = WS_RQ + (size_t)NT * 512 * 4;
constexpr size_t WS_CQN = WS_RK + (size_t)NT * 512 * 4;
constexpr size_t WS_CKVN = WS_CQN + (size_t)NT * QL * 4;
constexpr size_t WS_KPER = WS_CKVN + (size_t)NT * KVL * 4;
constexpr size_t WS_Q = WS_KPER + (size_t)NT * DROPE * 4;
constexpr size_t WS_QLAT = WS_Q + (size_t)NT * 1536 * 4;
constexpr size_t WS_QPE = WS_QLAT + (size_t)NT * 2048 * 4;
constexpr size_t WS_ORET = WS_QPE + (size_t)NT * 512 * 4;
constexpr size_t WS_OLAT = WS_ORET + (size_t)NT * 1024 * 4;
constexpr size_t WS_OX = WS_OLAT + (size_t)NT * 2048 * 4;
constexpr size_t WS_OMLA = WS_OX + (size_t)NT * 256 * 4;
constexpr size_t WS_ORETN = WS_OMLA + (size_t)NT * 1024 * 4;
constexpr size_t WS_ARET = WS_ORETN + (size_t)NT * 1024 * 4;
constexpr size_t WS_AMLA = WS_ARET + (size_t)NT * 1024 * 4;
constexpr size_t WS_AX = WS_AMLA + (size_t)NT * 1024 * 4;
constexpr size_t WS_MIX = WS_AX + (size_t)NT * 1024 * 4;
constexpr size_t WS_HP = WS_MIX + (size_t)NT * 1024 * 4;
constexpr size_t WS_H = WS_HP + (size_t)NT * 1024 * 4;
constexpr size_t WS_F = WS_H + (size_t)NT * 1024 * 4;
constexpr size_t WS_GG = WS_F + (size_t)NT * 1024 * 4;
constexpr size_t WS_UP = WS_GG + (size_t)NT * DFF * 4;
constexpr size_t WS_ACT = WS_UP + (size_t)NT * DFF * 4;
constexpr size_t WS_FO = WS_ACT + (size_t)NT * DFF * 4;
constexpr size_t WS_F32_END = WS_FO + (size_t)NT * 1024 * 4;
constexpr size_t WS_WIN_T = al256(WS_F32_END);
constexpr size_t WS_WMKV_T = WS_WIN_T + (size_t)ZLD * 1024 * 2;
constexpr size_t WS_WUQ_T = WS_WMKV_T + (size_t)512 * 1024 * 2;
constexpr size_t WS_WRO_T = WS_WUQ_T + (size_t)1536 * 384 * 2;
constexpr size_t WS_WMO_T = WS_WRO_T + (size_t)1024 * 1024 * 2;
constexpr size_t WS_WXO_T = WS_WMO_T + (size_t)1024 * 1024 * 2;
constexpr size_t WS_WO_T = WS_WXO_T + (size_t)1024 * 256 * 2;
constexpr size_t WS_WGU_T = WS_WO_T + (size_t)1024 * 1024 * 2;
constexpr size_t WS_WD_T = WS_WGU_T + (size_t)5632 * 1024 * 2;
constexpr size_t WS_UB = WS_WD_T + (size_t)1024 * 2816 * 2;
constexpr size_t WS_MNB = WS_UB + (size_t)NT * 1024 * 2;
constexpr size_t WS_CQNB = WS_MNB + (size_t)2048 * 1024 * 2;
constexpr size_t WS_ORETNB = WS_CQNB + (size_t)NT * 384 * 2;
constexpr size_t WS_OMLAB = WS_ORETNB + (size_t)NT * 1024 * 2;
constexpr size_t WS_OXB = WS_OMLAB + (size_t)NT * 1024 * 2;
constexpr size_t WS_MIXB = WS_OXB + (size_t)NT * 256 * 2;
constexpr size_t WS_FB = WS_MIXB + (size_t)NT * 1024 * 2;
constexpr size_t WS_ACTB = WS_FB + (size_t)NT * 1024 * 2;
constexpr size_t WS_WUK_T = WS_ACTB + (size_t)NT * 2816 * 2;
constexpr size_t WS_WUV_T = WS_WUK_T + (size_t)1024 * 256 * 2;
constexpr size_t WS_CKVNB = WS_WUV_T + (size_t)1024 * 256 * 2;
constexpr size_t WS_KPERB = WS_CKVNB + (size_t)NT * 256 * 2;
constexpr size_t WS_XQB = WS_KPERB + (size_t)NT * 64 * 2;
constexpr size_t WS_MKB = WS_XQB + (size_t)NT * 256 * 2;
constexpr size_t WS_MVT = WS_MKB + (size_t)2048 * 256 * 2;
constexpr size_t WS_KN = WS_MVT + (size_t)2048 * 256 * 2;
constexpr size_t WS_VT = WS_KN + (size_t)NP * 1024 * 2;
constexpr size_t WS_QB = WS_VT + (size_t)NP * 1024 * 2;
constexpr size_t WS_RQT = WS_QB + (size_t)NT * 1536 * 2;
constexpr size_t WS_RKT = WS_RQT + (size_t)NP * 512 * 2;
constexpr size_t WS_RKTT = WS_RKT + (size_t)NP * 512 * 2;
constexpr size_t WS_RVT = WS_RKTT + (size_t)NP * 512 * 2;
constexpr size_t WS_UT = WS_RVT + (size_t)NT * 1024 * 2;
constexpr size_t WS_SPT = WS_UT + (size_t)512 * 32768 * 4;
constexpr size_t WS_QLATB = WS_SPT + (size_t)512 * 32768 * 2;
constexpr size_t WS_PO = WS_QLATB + (size_t)NS * 2048 * 2;
constexpr size_t WS_PML = WS_PO + (size_t)DB * 2 * 32 * 256 * 4;
constexpr size_t WS_PART = al256(WS_PML + (size_t)DB * 2 * 32 * 2 * 4);
constexpr size_t WS_QPEB_ = WS_PART + (size_t)11 * 512 * 1024 * 4;
constexpr size_t WS_QPEB = al256(WS_QPEB_ + 0 * WS_PML + (size_t)DB * 2 * 32 * 2 * 4);
constexpr size_t WS_SGB = WS_QPEB + (size_t)NT * 512 * 2;
constexpr size_t WS_SRGB = WS_SGB + (size_t)NT * 3072 * 2;
constexpr size_t WS_T0B = WS_SRGB + (size_t)NT * 1024 * 2;
constexpr size_t WS_T1B = WS_T0B + (size_t)NT * 1024 * 2;
constexpr size_t WS_WUKB = WS_T1B + (size_t)NT * 1024 * 2;
constexpr size_t WS_END = WS_WUKB + (size_t)8 * 256 * 128 * 2;

constexpr int CW_BAR = 4096;

#define XB_TMO      128
#define XB_XCNT(j)  (256  + 64 * (j))
#define XB_XSUB(j)  (1280 + 64 * (j))
#define XB_XGEN(j)  (2304 + 64 * (j))
#define XB_TOP      3328
#define XB_TOPGEN   3392
#define XCD_BAR_WORDS 3456
#define XB_SPIN_CAP (1u << 25)

DI unsigned xb_ld(unsigned* p)              { return __hip_atomic_load(p, __ATOMIC_RELAXED, __HIP_MEMORY_SCOPE_AGENT); }
DI unsigned xb_add(unsigned* p, unsigned v) { return __hip_atomic_fetch_add(p, v, __ATOMIC_RELAXED, __HIP_MEMORY_SCOPE_AGENT); }
DI unsigned xb_xcc_id() { return (unsigned)__builtin_amdgcn_s_getreg((3 << 11) | 20) & 0xFu; }
#define XB_SPIN(cond, bar) do { unsigned _sp = 0; while (cond) { __builtin_amdgcn_s_sleep(1); \
    if ((++_sp & 255u) == 0u) { if (xb_ld(&(bar)[XB_TMO])) break; if (_sp > XB_SPIN_CAP) { atomicAdd(&(bar)[XB_TMO], 1u); break; } } } } while (0)

struct XcdBarrier { unsigned* bar; unsigned x; volatile LAS unsigned* st; };

DI XcdBarrier xcd_barrier_post(unsigned* bar, volatile LAS unsigned* st) {
    XcdBarrier b; b.bar = bar; b.x = xb_xcc_id(); b.st = st;
    if (threadIdx.x == 0) (void)xb_add(&bar[XB_XCNT(b.x)], 1u);
    return b;
}
DI void xcd_barrier_complete(unsigned* bar, unsigned x, unsigned& nloc, unsigned& nx) {
    const unsigned G = gridDim.x * gridDim.y * gridDim.z;
    unsigned sum, cnt, mine, sp = 0u;
    for (;;) {
        sum = 0u; cnt = 0u; mine = 0u;
#pragma unroll
        for (unsigned j = 0; j < 16; ++j) { const unsigned c = xb_ld(&bar[XB_XCNT(j)]); sum += c; cnt += (c > 0u) ? 1u : 0u; mine = (j == x) ? c : mine; }
        if (sum == G) break;
        __builtin_amdgcn_s_sleep(1);
        if ((++sp & 255u) == 0u) { if (xb_ld(&bar[XB_TMO])) break; if (sp > XB_SPIN_CAP) { atomicAdd(&bar[XB_TMO], 1u); break; } }
    }
    nloc = mine > 0u ? mine : 1u; nx = cnt > 0u ? cnt : 1u;
}
DI void xcd_barrier(const XcdBarrier& b) {
    asm volatile("s_waitcnt vmcnt(0)" ::: "memory");
    __syncthreads();
    if (threadIdx.x == 0) {
        unsigned* bar = b.bar;
        __builtin_amdgcn_s_waitcnt(0);
        unsigned nloc = b.st[0], nx = b.st[1];
        if (nloc == 0u) { xcd_barrier_complete(bar, b.x, nloc, nx); b.st[0] = nloc; b.st[1] = nx; }
        const unsigned old = xb_add(&bar[XB_XSUB(b.x)], 1u);
        const unsigned gen = old / nloc;
        if (old + 1u == (gen + 1u) * nloc) {
            __builtin_amdgcn_fence(__ATOMIC_RELEASE, "agent");
            asm volatile("s_waitcnt vmcnt(0)" ::: "memory");
            const unsigned og = xb_add(&bar[XB_TOP], 1u);
            const unsigned tg = og / nx;
            if (og + 1u == (tg + 1u) * nx) xb_add(&bar[XB_TOPGEN], 1u);
            else XB_SPIN(xb_ld(&bar[XB_TOPGEN]) == tg, bar);
            __builtin_amdgcn_fence(__ATOMIC_ACQUIRE, "agent");
            xb_add(&bar[XB_XGEN(b.x)], 1u);
            asm volatile("s_waitcnt vmcnt(0)" ::: "memory");
        } else {
            XB_SPIN(xb_ld(&bar[XB_XGEN(b.x)]) == gen, bar);
            __builtin_amdgcn_fence(__ATOMIC_ACQUIRE, "agent");
            asm volatile("s_waitcnt vmcnt(0)" ::: "memory");
        }
    }
    __syncthreads();
}

DI float wave_sum(float v) {
#pragma unroll
    for (int o = 1; o < 64; o <<= 1) v += __shfl_xor(v, o);
    return v;
}
DI float wave_max(float v) {
#pragma unroll
    for (int o = 1; o < 64; o <<= 1) v = fmaxf(v, __shfl_xor(v, o));
    return v;
}
DI float sigmoidf_(float x) { return 1.f / (1.f + expf(-x)); }
DI float siluf_(float x) { return x / (1.f + expf(-x)); }
DI int pos_index(int row) { return row < NP ? (row & (SEQ - 1)) : SEQ + ((row - NP) & (DS - 1)); }
DI float lg_gamma(int h) { return h == 0 ? -0.03174869831458027f : h == 1 ? -0.015748356968139112f : h == 2 ? -0.007843177461025892f : -0.003913899321136329f; }


namespace pg8 {
typedef unsigned short bf16_t;
typedef short bf16x8 __attribute__((ext_vector_type(8)));
typedef unsigned u32x4 __attribute__((ext_vector_type(4)));
typedef unsigned u32x2 __attribute__((ext_vector_type(2)));
constexpr int BM = 256, BK = 64, HALF = 128, HTB = HALF * BK * 2, STAGE_BYTES = 8 * HTB, NXCD = 8, WGM = 8;
__host__ __device__ __forceinline__ int lds_byte(int r, int c) { const int st = (r >> 4) * 2 + (c >> 5), rr = r & 15, cc = c & 31, ob = rr * 64 + cc * 2; return st * 1024 + (ob ^ (((ob >> 9) & 1) << 5)); }
__host__ __device__ __forceinline__ void stage_rc(int b, int& R, int& C) { const int st = b / 1024, sb = b % 1024, swz = sb ^ (((sb >> 9) & 1) << 5); R = (st >> 1) * 16 + swz / 64; C = (st & 1) * 32 + (swz % 64) / 2; }
__host__ __device__ __forceinline__ int perm32(int rho) { const int n = rho >> 4, i = rho & 15; return 8 * (i >> 2) + 4 * n + (i & 3); }
struct Unit { int pm, pn, ks; };
struct Gemm { const bf16_t* A; const bf16_t* Bt; int M, N, K, lda, ldb, ksl; };
struct StaticOrder {
    int nM, nN, nwg, G, c;
    __host__ __device__ void init(int M, int N, int G_, int c_) { nM = M / BM; nN = N / BM; nwg = nM * nN; G = G_; c = c_; }
    __host__ __device__ bool next(int i, Unit& u) const {
        const long L = (long)i * G + c; if (L >= nwg) return false;
        int wgid = (int)L; { const int q = nwg / NXCD, r = nwg % NXCD, xcd = wgid % NXCD, off = wgid / NXCD; wgid = (xcd < r ? xcd * (q + 1) : r * (q + 1) + (xcd - r) * q) + off; }
        const int nig = WGM * nN, gid = wgid / nig, fm = gid * WGM, gsz = (nM - fm) < WGM ? (nM - fm) : WGM;
        u.pm = fm + ((wgid % nig) % gsz); u.pn = (wgid % nig) / gsz; u.ks = 0; return true;
    }
    __device__ __forceinline__ void a_ready(const Unit&) const {}
    __device__ __forceinline__ void done(const Unit&) const {}
};
__device__ __forceinline__ unsigned cvt_pk_bf16(float lo, float hi) { return cvtpk(lo, hi); }
struct SplitOrder {
    int KS, c;
    __host__ __device__ bool next(int i, Unit& u) const { if (i != 0 || c >= 8 * KS) return false; const int tile = c / KS; u.ks = c % KS; u.pm = 64 + (tile >> 2); u.pn = tile & 3; return true; }
    __device__ __forceinline__ void a_ready(const Unit&) const {}
    __device__ __forceinline__ void done(const Unit&) const {}
};
struct EpiPart {
    static constexpr bool PERM = false, AFTER_DRAIN = false;
    float* C;
    __device__ __forceinline__ void operator()(const f32x4 (&acc)[2][2][4][2], const Unit& u, int wr, int wc, int fr, int fq) const {
        const int row0 = (u.pm - 64) * BM + wr * 64 + fr, col0 = u.pn * BM + wc * 32 + 4 * fq; float* base = C + (size_t)u.ks * (512 * 1024);
#pragma unroll
        for (int ai = 0; ai < 2; ++ai)
#pragma unroll
            for (int m = 0; m < 4; ++m) { float* rowp = base + (size_t)(row0 + ai * HALF + m * 16) * 1024 + col0;
#pragma unroll
                for (int bj = 0; bj < 2; ++bj)
#pragma unroll
                    for (int n = 0; n < 2; ++n) *(f32x4*)(rowp + bj * HALF + n * 16) = acc[ai][bj][m][n]; }
    }
};
struct P1Order {
    StaticOrder so;
    __host__ __device__ void init(int G_, int c_) { so.init(64 * 256, 24 * 256, G_, c_); }
    __host__ __device__ bool next(int i, Unit& u) const {
        const long L = (long)i * so.G + so.c;
        if (L < 1536) { so.next(i, u); if (u.pn >= 4) u.pn += 4; return true; }
        u.ks = 0;
        if (L < 1536 + 56) { const int idx = (int)L - 1536; u.pm = 64 + idx / 28; u.pn = idx % 28; return true; }
        if (L < 1536 + 56 + 16) { const int idx = (int)L - 1592; u.pm = 66 + idx / 2; u.pn = 28 + idx % 2; return true; }
        return false;
    }
    __device__ __forceinline__ void a_ready(const Unit&) const {}
    __device__ __forceinline__ void done(const Unit&) const {}
};
struct EpiP1 {
    static constexpr bool PERM = true, AFTER_DRAIN = false;
    bf16_t* Zp; int ldz; float* mk; float* mv; bf16_t* srg; bf16_t* sg; int c_rg, c_g;
    __device__ __forceinline__ void operator()(const f32x4 (&acc)[2][2][4][2], const Unit& u, int wr, int wc, int fr, int fq) const {
        if (u.pm >= 66) {
            float* base = (u.pn == 28) ? mk : mv; const int row0 = (u.pm - 66) * BM + wr * 64 + fr, col0 = wc * 32 + 8 * fq;
#pragma unroll
            for (int ai = 0; ai < 2; ++ai)
#pragma unroll
                for (int m = 0; m < 4; ++m) { float* rowp = base + (size_t)(row0 + ai * HALF + m * 16) * 256 + col0;
#pragma unroll
                    for (int bj = 0; bj < 2; ++bj) { *(f32x4*)(rowp + bj * HALF) = acc[ai][bj][m][0]; *(f32x4*)(rowp + bj * HALF + 4) = acc[ai][bj][m][1]; } }
            return;
        }
        const int row0 = u.pm * BM + wr * 64 + fr, col0 = u.pn * BM + wc * 32 + 8 * fq;
#pragma unroll
        for (int bj = 0; bj < 2; ++bj) { const int c = col0 + bj * HALF;
            if (c >= c_g + 3072) continue;
            const int kind = c >= c_g ? 2 : (c >= c_rg && c < c_rg + 1024) ? 1 : 0;
            bf16_t* dst = kind == 2 ? sg + (c - c_g) : kind == 1 ? srg + (c - c_rg) : Zp + c; const int ld = kind == 2 ? 3072 : kind == 1 ? 1024 : ldz;
#pragma unroll
            for (int ai = 0; ai < 2; ++ai)
#pragma unroll
                for (int m = 0; m < 4; ++m) { f32x4 v0 = acc[ai][bj][m][0], v1 = acc[ai][bj][m][1];
                    if (kind) {
#pragma unroll
                        for (int e = 0; e < 4; ++e) { const float s0 = 1.f / (1.f + __expf(-v0[e])), s1 = 1.f / (1.f + __expf(-v1[e])); v0[e] = kind == 2 ? s0 : v0[e] * s0; v1[e] = kind == 2 ? s1 : v1[e] * s1; } }
                    u32x4 w; w.x = cvt_pk_bf16(v0[0], v0[1]); w.y = cvt_pk_bf16(v0[2], v0[3]); w.z = cvt_pk_bf16(v1[0], v1[1]); w.w = cvt_pk_bf16(v1[2], v1[3]);
                    *(u32x4*)(dst + (size_t)(row0 + ai * HALF + m * 16) * ld) = w; } }
    }
};
struct EpiF32S {
    static constexpr bool PERM = false, AFTER_DRAIN = false;
    float* C; int ldc; int split_tiles; size_t split_stride;
    __device__ __forceinline__ void operator()(const f32x4 (&acc)[2][2][4][2], const Unit& u, int wr, int wc, int fr, int fq) const {
        int pn = u.pn; float* base = C; if (split_tiles) { const int t = pn / split_tiles; base += (size_t)t * split_stride; pn -= t * split_tiles; }
        const int row0 = u.pm * BM + wr * 64 + fr, col0 = pn * BM + wc * 32 + 4 * fq;
#pragma unroll
        for (int ai = 0; ai < 2; ++ai)
#pragma unroll
            for (int m = 0; m < 4; ++m) { float* rowp = base + (size_t)(row0 + ai * HALF + m * 16) * ldc + col0;
#pragma unroll
                for (int bj = 0; bj < 2; ++bj)
#pragma unroll
                    for (int n = 0; n < 2; ++n) *(f32x4*)(rowp + bj * HALF + n * 16) = acc[ai][bj][m][n]; }
    }
};
struct EpiBf16S {
    static constexpr bool PERM = true, AFTER_DRAIN = false;
    bf16_t* O; int ldc;
    __device__ __forceinline__ void operator()(const f32x4 (&acc)[2][2][4][2], const Unit& u, int wr, int wc, int fr, int fq) const {
        const int row0 = u.pm * BM + wr * 64 + fr, col0 = u.pn * BM + wc * 32 + 8 * fq;
#pragma unroll
        for (int ai = 0; ai < 2; ++ai)
#pragma unroll
            for (int m = 0; m < 4; ++m) { bf16_t* rowp = O + (size_t)(row0 + ai * HALF + m * 16) * ldc + col0;
#pragma unroll
                for (int bj = 0; bj < 2; ++bj) { const f32x4 v0 = acc[ai][bj][m][0], v1 = acc[ai][bj][m][1];
                    u32x4 w; w.x = cvt_pk_bf16(v0[0], v0[1]); w.y = cvt_pk_bf16(v0[2], v0[3]); w.z = cvt_pk_bf16(v1[0], v1[1]); w.w = cvt_pk_bf16(v1[2], v1[3]);
                    *(u32x4*)(rowp + bj * HALF) = w; } }
    }
};
struct EpiSwiGLU {
    static constexpr bool PERM = true, AFTER_DRAIN = false;
    bf16_t* O; int ldc;
    __device__ __forceinline__ void operator()(const f32x4 (&acc)[2][2][4][2], const Unit& u, int wr, int wc, int fr, int fq) const {
        const int row0 = u.pm * BM + wr * 64 + fr, col0 = u.pn * (BM / 2) + wc * 16 + 4 * fq;
#pragma unroll
        for (int ai = 0; ai < 2; ++ai)
#pragma unroll
            for (int m = 0; m < 4; ++m) { bf16_t* rowp = O + (size_t)(row0 + ai * HALF + m * 16) * ldc + col0;
#pragma unroll
                for (int bj = 0; bj < 2; ++bj) { const f32x4 v0 = acc[ai][bj][m][0], v1 = acc[ai][bj][m][1];
                    const float a0 = v0[0] / (1.f + __expf(-v0[0])) * v0[1], a1 = v0[2] / (1.f + __expf(-v0[2])) * v0[3];
                    const float a2 = v1[0] / (1.f + __expf(-v1[0])) * v1[1], a3 = v1[2] / (1.f + __expf(-v1[2])) * v1[3];
                    u32x2 w; w.x = cvt_pk_bf16(a0, a1); w.y = cvt_pk_bf16(a2, a3);
                    *(u32x2*)(rowp + bj * (HALF / 2)) = w; } }
    }
};
template <int MODE  > struct EpiGate {
    static constexpr bool PERM = true, AFTER_DRAIN = false;
    const bf16_t* sg; const bf16_t* tin; bf16_t* tout; int ldc;
    __device__ __forceinline__ void operator()(const f32x4 (&acc)[2][2][4][2], const Unit& u, int wr, int wc, int fr, int fq) const {
        const int row0 = u.pm * BM + wr * 64 + fr, col0 = u.pn * BM + wc * 32 + 8 * fq;
#pragma unroll
        for (int ai = 0; ai < 2; ++ai)
#pragma unroll
            for (int m = 0; m < 4; ++m) { const size_t r = (size_t)(row0 + ai * HALF + m * 16);
#pragma unroll
                for (int bj = 0; bj < 2; ++bj) { const int c = col0 + bj * HALF;
                    const u32x4 gq = *(const u32x4*)(sg + r * 3072 + c); u32x4 tq = {0u, 0u, 0u, 0u}; if (MODE >= 1) tq = *(const u32x4*)(tin + r * ldc + c);
                    const f32x4 v0 = acc[ai][bj][m][0], v1 = acc[ai][bj][m][1]; u32x4 w;
#define EG_ONE(dst, x0, x1, gw_, tw_) { float a_ = (x0) * __builtin_bit_cast(float, (gw_) << 16), b_ = (x1) * __builtin_bit_cast(float, (gw_) & 0xffff0000u); \
                        if (MODE >= 1) { a_ += __builtin_bit_cast(float, (tw_) << 16); b_ += __builtin_bit_cast(float, (tw_) & 0xffff0000u); } dst = cvt_pk_bf16(a_, b_); }
                    EG_ONE(w.x, v0[0], v0[1], gq.x, tq.x) EG_ONE(w.y, v0[2], v0[3], gq.y, tq.y) EG_ONE(w.z, v1[0], v1[1], gq.z, tq.z) EG_ONE(w.w, v1[2], v1[3], gq.w, tq.w)
#undef EG_ONE
                    *(u32x4*)(tout + r * ldc + c) = w; } }
    }
};
template <class Epi, class Sched, bool ALIGN_EPI = false, bool SP2 = false>
__device__ __forceinline__ void gemm_phase(LAS unsigned char* lds, const Gemm g, const Sched& S, const Epi& E) {
    const int tid = threadIdx.x, wid = __builtin_amdgcn_readfirstlane(tid >> 6), lane = tid & 63, wr = wid >> 2, wc = wid & 3, fr = lane & 15, fq = lane >> 4;
    const int K = g.K, nt = K / BK;
    unsigned voffA[2], voffB[2];
#pragma unroll
    for (int i = 0; i < 2; ++i) { int R, C; stage_rc(tid * 16 + i * 8192, R, C); const int Rb = Epi::PERM ? ((R & ~31) + perm32(R & 31)) : R;
        voffA[i] = (unsigned)(R * g.lda + C) * 2u; voffB[i] = (unsigned)(Rb * g.ldb + C) * 2u; }
    const size_t kstep = (size_t)(BK * 2);
    const size_t hstepA = (size_t)HALF * g.lda * 2, hstepB = (size_t)HALF * g.ldb * 2;
    const size_t tstepA = 2 * hstepA, tstepB = 2 * hstepB;
    const unsigned ldsw = (unsigned)wid * 1024u;
    const int aoff = lds_byte(wr * 64 + fr, fq * 8), boff = lds_byte(wc * 32 + fr, fq * 8);
#define PG8_SA(b, h) (((b) * 2 + (h)) * HTB)
#define PG8_SB(b, h) ((4 + (b) * 2 + (h)) * HTB)
#define PG8_STAGE(bufoff, gbase, voff) do { _Pragma("unroll") for (int _i = 0; _i < 2; ++_i) \
        __builtin_amdgcn_global_load_lds((const unsigned*)((const char*)(gbase) + (voff)[_i]), (LAS unsigned*)(lds + (bufoff) + ldsw + _i * 8192), 16, 0, 0); } while (0)
#define PG8_LDA(dst, b, h) do { _Pragma("unroll") for (int m = 0; m < 4; ++m) _Pragma("unroll") for (int k = 0; k < 2; ++k) dst[m][k] = *(const LAS bf16x8*)(lds + PG8_SA(b, h) + aoff + m * 2048 + k * 1024); } while (0)
#define PG8_LDB(dst, b, h) do { _Pragma("unroll") for (int n = 0; n < 2; ++n) _Pragma("unroll") for (int k = 0; k < 2; ++k) dst[n][k] = *(const LAS bf16x8*)(lds + PG8_SB(b, h) + boff + n * 2048 + k * 1024); } while (0)
#define PG8_MMA(ai, bj, At, Bt) do { __builtin_amdgcn_s_setprio(1); _Pragma("unroll") for (int m = 0; m < 4; ++m) _Pragma("unroll") for (int n = 0; n < 2; ++n) _Pragma("unroll") for (int k = 0; k < 2; ++k) \
        acc[ai][bj][m][n] = __builtin_amdgcn_mfma_f32_16x16x32_bf16(Bt[n][k], At[m][k], acc[ai][bj][m][n], 0, 0, 0); __builtin_amdgcn_s_setprio(0); } while (0)
#define PG8_WAIT_V(n) asm volatile("s_waitcnt vmcnt(" #n ")" ::: "memory")
#define PG8_WAIT_L(n) asm volatile("s_waitcnt lgkmcnt(" #n ")" ::: "memory")
#define PG8_BAR __builtin_amdgcn_s_barrier()
#define PG8_SCHED __builtin_amdgcn_sched_barrier(0)
    Unit cur, nxt; int ui = 0;
    if (!S.next(0, cur)) return;
    f32x4 acc[2][2][4][2];
#pragma unroll
    for (int a = 0; a < 2; ++a)
#pragma unroll
        for (int b = 0; b < 2; ++b)
#pragma unroll
            for (int m = 0; m < 4; ++m)
#pragma unroll
                for (int n = 0; n < 2; ++n) acc[a][b][m][n] = (f32x4){0.f, 0.f, 0.f, 0.f};
    bf16x8 At[4][2], B0[2][2], B1[2][2];
    const size_t kslb = (size_t)g.ksl * 2;
    const char* cA = (const char*)g.A + (size_t)cur.pm * tstepA + cur.ks * kslb; const char* cB = (const char*)g.Bt + (size_t)cur.pn * tstepB + cur.ks * kslb;
    S.a_ready(cur);
    if constexpr (SP2) {
        PG8_STAGE(PG8_SB(0, 0), cB, voffB); PG8_STAGE(PG8_SB(0, 1), cB + hstepB, voffB); PG8_STAGE(PG8_SA(0, 0), cA, voffA); PG8_STAGE(PG8_SA(0, 1), cA + hstepA, voffA);
        if (wr == 1) PG8_BAR;
        PG8_WAIT_V(2); PG8_BAR;
        PG8_STAGE(PG8_SB(1, 0), cB + kstep, voffB); PG8_STAGE(PG8_SA(1, 0), cA + kstep, voffA); PG8_STAGE(PG8_SB(1, 1), cB + hstepB + kstep, voffB);
        PG8_WAIT_V(6); PG8_BAR;
    } else {
        PG8_STAGE(PG8_SB(0, 0), cB, voffB); PG8_STAGE(PG8_SA(0, 0), cA, voffA); PG8_STAGE(PG8_SB(0, 1), cB + hstepB, voffB); PG8_STAGE(PG8_SA(0, 1), cA + hstepA, voffA);
        if (wr == 1) PG8_BAR;
        PG8_WAIT_V(4); PG8_BAR;
        PG8_STAGE(PG8_SB(1, 0), cB + kstep, voffB); PG8_STAGE(PG8_SA(1, 0), cA + kstep, voffA); PG8_STAGE(PG8_SB(1, 1), cB + hstepB + kstep, voffB);
        PG8_WAIT_V(6); PG8_BAR;
    }
    for (;;) {
        const bool has_next = S.next(ui + 1, nxt);
        const char* nA = has_next ? (const char*)g.A + (size_t)nxt.pm * tstepA + nxt.ks * kslb : cA; const char* nB = has_next ? (const char*)g.Bt + (size_t)nxt.pn * tstepB + nxt.ks * kslb : cB;
#pragma unroll 1
        for (int t = 0; t < nt; t += 2) {
            const bool last = (t == nt - 2);
            const char* a1 = cA + (size_t)(t + 1) * kstep;
            const char* a2 = last ? nA : cA + (size_t)(t + 2) * kstep; const char* b2 = last ? nB : cB + (size_t)(t + 2) * kstep;
            const char* a3 = a2 + kstep; const char* b3 = b2 + kstep;
            if (last && has_next) S.a_ready(nxt);
            if constexpr (SP2) {
            PG8_LDB(B0, 0, 0); PG8_LDB(B1, 0, 1); PG8_SCHED; PG8_LDA(At, 0, 0); PG8_STAGE(PG8_SA(1, 1), a1 + hstepA, voffA);
            PG8_WAIT_V(8); PG8_WAIT_L(0); PG8_BAR; PG8_MMA(0, 0, At, B0); PG8_MMA(0, 1, At, B1); PG8_BAR; PG8_SCHED;
            PG8_LDA(At, 0, 1); PG8_STAGE(PG8_SB(0, 0), b2, voffB); PG8_STAGE(PG8_SB(0, 1), b2 + hstepB, voffB); PG8_STAGE(PG8_SA(0, 0), a2, voffA);
            PG8_WAIT_V(8); PG8_WAIT_L(0); PG8_BAR; PG8_MMA(1, 0, At, B0); PG8_MMA(1, 1, At, B1); PG8_BAR; PG8_SCHED;
            PG8_LDB(B0, 1, 0); PG8_LDB(B1, 1, 1); PG8_SCHED; PG8_LDA(At, 1, 0); PG8_STAGE(PG8_SA(0, 1), a2 + hstepA, voffA);
            PG8_WAIT_V(8); PG8_WAIT_L(0); PG8_BAR; PG8_MMA(0, 0, At, B0); PG8_MMA(0, 1, At, B1); PG8_BAR; PG8_SCHED;
            PG8_LDA(At, 1, 1); PG8_STAGE(PG8_SB(1, 0), b3, voffB); PG8_STAGE(PG8_SB(1, 1), b3 + hstepB, voffB); PG8_STAGE(PG8_SA(1, 0), a3, voffA);
            PG8_WAIT_V(8); PG8_WAIT_L(0); PG8_BAR; PG8_MMA(1, 0, At, B0); PG8_MMA(1, 1, At, B1); PG8_BAR; PG8_SCHED;
            } else {
            PG8_LDB(B0, 0, 0); PG8_SCHED; PG8_LDA(At, 0, 0); PG8_STAGE(PG8_SA(1, 1), a1 + hstepA, voffA);
            PG8_WAIT_L(8); PG8_BAR; PG8_WAIT_L(0); PG8_MMA(0, 0, At, B0); PG8_BAR; PG8_SCHED;
            PG8_LDB(B1, 0, 1); PG8_STAGE(PG8_SB(0, 0), b2, voffB);
            PG8_BAR; PG8_WAIT_L(0); PG8_MMA(0, 1, At, B1); PG8_BAR;
            PG8_LDA(At, 0, 1); PG8_STAGE(PG8_SA(0, 0), a2, voffA);
            PG8_BAR; PG8_WAIT_L(0); PG8_MMA(1, 0, At, B0); PG8_BAR; PG8_SCHED;
            PG8_STAGE(PG8_SB(0, 1), b2 + hstepB, voffB);
            PG8_WAIT_V(6); PG8_BAR; PG8_MMA(1, 1, At, B1); PG8_BAR;
            PG8_LDB(B0, 1, 0); PG8_SCHED; PG8_LDA(At, 1, 0); PG8_STAGE(PG8_SA(0, 1), a2 + hstepA, voffA);
            PG8_WAIT_L(8); PG8_BAR; PG8_WAIT_L(0); PG8_MMA(0, 0, At, B0); PG8_BAR; PG8_SCHED;
            PG8_LDB(B1, 1, 1); PG8_STAGE(PG8_SB(1, 0), b3, voffB);
            PG8_BAR; PG8_WAIT_L(0); PG8_MMA(0, 1, At, B1); PG8_BAR;
            PG8_LDA(At, 1, 1); PG8_STAGE(PG8_SA(1, 0), a3, voffA);
            PG8_BAR; PG8_WAIT_L(0); PG8_MMA(1, 0, At, B0); PG8_BAR; PG8_SCHED;
            PG8_STAGE(PG8_SB(1, 1), b3 + hstepB, voffB);
            PG8_WAIT_V(6); PG8_BAR; PG8_MMA(1, 1, At, B1); PG8_BAR;
            }
        }
        if constexpr (ALIGN_EPI) { if (wr == 0) PG8_BAR; }
        if constexpr (!Epi::AFTER_DRAIN) { E(acc, cur, wr, wc, fr, fq); S.done(cur); }
        if (!has_next) break;
#pragma unroll
        for (int a = 0; a < 2; ++a)
#pragma unroll
            for (int b = 0; b < 2; ++b)
#pragma unroll
                for (int m = 0; m < 4; ++m)
#pragma unroll
                    for (int n = 0; n < 2; ++n) acc[a][b][m][n] = (f32x4){0.f, 0.f, 0.f, 0.f};
        cur = nxt; cA = nA; cB = nB; ++ui;
        if constexpr (ALIGN_EPI) { if (wr == 1) PG8_BAR; }
    }
    PG8_WAIT_V(0);
    if constexpr (!ALIGN_EPI) { if (wr == 0) PG8_BAR; }
    PG8_BAR;
    if constexpr (Epi::AFTER_DRAIN) { E.fused(acc, cur, wr, wc, fr, fq, lds, wid, lane); S.done(cur); }
#undef PG8_SA
#undef PG8_SB
#undef PG8_STAGE
#undef PG8_LDA
#undef PG8_LDB
#undef PG8_MMA
#undef PG8_WAIT_V
#undef PG8_WAIT_L
#undef PG8_BAR
#undef PG8_SCHED
}
}
typedef unsigned short bf16_t;
DI unsigned pk2(float lo, float hi) { return pg8::cvt_pk_bf16(lo, hi); }
DI bf16_t f2bf(float f) { return (bf16_t)(pg8::cvt_pk_bf16(f, 0.f) & 0xffffu); }
DI void transpose_item(const float* W, int N, bf16_t* WT, int ldt, int row_off, int rmul, LAS float* scr, int item, int lane) {
    const int nblk = N / 32, kb = item / nblk, nb = item % nblk, k0 = 64 * kb, n0 = 32 * nb;
#pragma unroll 8
    for (int i = 0; i < 32; ++i) { const int kk = 2 * i + (lane >> 5); scr[kk * 33 + (lane & 31)] = W[(size_t)(k0 + kk) * N + n0 + (lane & 31)]; }
    asm volatile("s_waitcnt lgkmcnt(0)" ::: "memory");
    const int c = lane & 7;
#pragma unroll
    for (int j = 0; j < 4; ++j) { const int n = (lane >> 3) + 8 * j; const LAS float* sp = scr + (8 * c) * 33 + n;
        pg8::u32x4 o; o.x = pk2(sp[0 * 33], sp[1 * 33]); o.y = pk2(sp[2 * 33], sp[3 * 33]); o.z = pk2(sp[4 * 33], sp[5 * 33]); o.w = pk2(sp[6 * 33], sp[7 * 33]);
        *(pg8::u32x4*)(WT + (size_t)(row_off + rmul * (n0 + n)) * ldt + k0 + 8 * c) = o; }
    asm volatile("s_waitcnt lgkmcnt(0)" ::: "memory");
}
DI void transpose_w(const float* W, int K, int N, bf16_t* WT, int ldt, int row_off, LAS float* scr, int gw, int NGW, int lane, int& rot, int rmul = 1) {
    const int nitems = (K / 64) * (N / 32);
    int first = gw - (rot % NGW); if (first < 0) first += NGW;
    for (int it = first; it < nitems; it += NGW) transpose_item(W, N, WT, ldt, row_off, rmul, scr, it, lane);
    rot += nitems;
}

struct Args {
    const float* in[29]; float* out; unsigned char* ws; int ph_lo, ph_hi, sub, pad;
};

DI unsigned short f2bf_raw(float f) { unsigned u = __builtin_bit_cast(unsigned, f); return (unsigned short)((u + 0x7fffu + ((u >> 16) & 1u)) >> 16); }
DI void sgemm_naive(LAS float* lds, const float* __restrict__ A, int lda, const float* __restrict__ B, long sbk, long sbn,
                    float* __restrict__ C, int ldc, int M, int N, int K, int bid, int G, unsigned short* Cb = nullptr) {
    LAS float* As = lds;
    LAS float* Bs = lds + 16 * 132;
    const int tid = threadIdx.x, tx = tid & 15, ty = tid >> 4;
    const int ntn = N / 64, ntiles = (M / 128) * ntn;
    for (int t = bid; t < ntiles; t += G) {
        const int m0 = (t / ntn) * 128, n0 = (t % ntn) * 64;
        float acc[4][4];
#pragma unroll
        for (int i = 0; i < 4; ++i)
#pragma unroll
            for (int j = 0; j < 4; ++j) acc[i][j] = 0.f;
        for (int k0 = 0; k0 < K; k0 += 16) {
            {
                const int r = tid >> 2, kq = (tid & 3) * 4;
                const float4 v = *(const float4*)(A + (size_t)(m0 + r) * lda + k0 + kq);
                As[(kq + 0) * 132 + r] = v.x; As[(kq + 1) * 132 + r] = v.y; As[(kq + 2) * 132 + r] = v.z; As[(kq + 3) * 132 + r] = v.w;
            }
#pragma unroll
            for (int i = 0; i < 2; ++i) {
                const int idx = tid + i * 512, kk = idx >> 6, nn = idx & 63;
                Bs[kk * 64 + nn] = B[(size_t)(k0 + kk) * sbk + (size_t)(n0 + nn) * sbn];
            }
            __syncthreads();
#pragma unroll
            for (int kk = 0; kk < 16; ++kk) {
                const f32x4 a = *(const LAS f32x4*)(As + kk * 132 + ty * 4);
                const f32x4 b = *(const LAS f32x4*)(Bs + kk * 64 + tx * 4);
                const float av[4] = {a.x, a.y, a.z, a.w}, bv[4] = {b.x, b.y, b.z, b.w};
#pragma unroll
                for (int i = 0; i < 4; ++i)
#pragma unroll
                    for (int j = 0; j < 4; ++j) acc[i][j] += av[i] * bv[j];
            }
            __syncthreads();
        }
#pragma unroll
        for (int i = 0; i < 4; ++i) {
            float4 o; o.x = acc[i][0]; o.y = acc[i][1]; o.z = acc[i][2]; o.w = acc[i][3];
            if (Cb) { unsigned short* cb = Cb + (size_t)(m0 + ty * 4 + i) * ldc + n0 + tx * 4; cb[0] = f2bf_raw(o.x); cb[1] = f2bf_raw(o.y); cb[2] = f2bf_raw(o.z); cb[3] = f2bf_raw(o.w); }
            else *(float4*)(C + (size_t)(m0 + ty * 4 + i) * ldc + n0 + tx * 4) = o;
        }
    }
}

template <int DQK, int DV, bool V_IN_K, int MODE, class KV, class QF>
DI void attn_naive(LAS float* lds, const KV& kv, int nk_loop, const QF& qf, bool active, int limit, float scale, float lg, int tq, float* optr) {
    constexpr int KS = DQK + 1;
    constexpr int VS = V_IN_K ? KS : DV;
    LAS float* Ks = lds;
    LAS float* Vs = V_IN_K ? Ks : (lds + 64 * KS);
    LAS float* qs = lds + 64 * KS + (V_IN_K ? 0 : 64 * DV);
    LAS float* ps = qs + 8 * DQK;
    static_assert((64 * KS + (V_IN_K ? 0 : 64 * DV) + 8 * DQK + 8 * 64) * 4 <= MISC_OFF, "attn_naive LDS");
    const int tid = threadIdx.x, lane = tid & 63, w = tid >> 6;
    __syncthreads();
    for (int d = lane; d < DQK; d += 64) qs[w * DQK + d] = active ? qf(d) : 0.f;
    float m = -INFINITY, l = 0.f;
    float acc[DV / 64];
#pragma unroll
    for (int c = 0; c < DV / 64; ++c) acc[c] = 0.f;
    for (int base = 0; base < nk_loop; base += 64) {
        __syncthreads();
        for (int idx = tid; idx < 64 * DQK; idx += NTHREADS) { const int j = idx / DQK, d = idx - j * DQK, key = base + j; Ks[j * KS + d] = key < nk_loop ? kv.k(key, d) : 0.f; }
        if (!V_IN_K) for (int idx = tid; idx < 64 * DV; idx += NTHREADS) { const int j = idx / DV, e = idx - j * DV, key = base + j; Vs[j * DV + e] = key < nk_loop ? kv.v(key, e) : 0.f; }
        __syncthreads();
        const int key = base + lane; const bool valid = active && key <= limit && key < nk_loop;
        float s = 0.f;
        for (int d = 0; d < DQK; ++d) s += qs[w * DQK + d] * Ks[lane * KS + d];
        float p;
        if (MODE == 0) {
            s *= scale;
            const float cm = wave_max(valid ? s : -INFINITY);
            const float mn = fmaxf(m, cm);
            const float alpha = (mn == -INFINITY) ? 1.f : expf(m - mn);
            p = valid ? expf(s - mn) : 0.f;
            l = l * alpha + wave_sum(p);
#pragma unroll
            for (int c = 0; c < DV / 64; ++c) acc[c] *= alpha;
            m = mn;
        } else {
            p = valid ? s * expf((float)(tq - key) * lg) : 0.f;
        }
        ps[w * 64 + lane] = p;
        __syncthreads();
        for (int j = 0; j < 64; ++j) { const float pj = ps[w * 64 + j];
#pragma unroll
            for (int c = 0; c < DV / 64; ++c) acc[c] += pj * Vs[j * VS + lane + 64 * c]; }
    }
    if (active) {
#pragma unroll
        for (int c = 0; c < DV / 64; ++c) optr[lane + 64 * c] = (MODE == 0) ? acc[c] / l : acc[c];
    }
}

struct KvMlaPrompt { const float* ckvn; const float* kper; int b;
    DI float k(int key, int d) const { const size_t row = (size_t)b * SEQ + key; return d < KVL ? ckvn[row * KVL + d] : kper[row * DROPE + (d - KVL)]; }
    DI float v(int, int) const { return 0.f; } };
struct KvMlaSample { const float* ckvn; const float* kper; const float* cckv; const float* ckpe; const int* pt; int b;
    DI float k(int key, int d) const {
        if (key < PAST) { const size_t r = (size_t)pt[b * NPAGES + (key >> 7)] * PAGE + (key & (PAGE - 1)); return d < KVL ? cckv[r * KVL + d] : ckpe[r * DROPE + (d - KVL)]; }
        const size_t row = (size_t)NP + b * DS + (key - PAST); return d < KVL ? ckvn[row * KVL + d] : kper[row * DROPE + (d - KVL)]; }
    DI float v(int, int) const { return 0.f; } };
struct KvRet { const float* rk; const float* z; int b, h;
    DI float k(int key, int d) const { return rk[((size_t)b * SEQ + key) * 512 + h * RDK + d]; }
    DI float v(int key, int e) const { return z[((size_t)b * SEQ + key) * ZLD + C_RV + h * RDV + e]; } };
struct KvMem { const float* mk; const float* mv; int b, h;
    DI float k(int key, int d) const { return mk[(((size_t)b * NMEM + key) * XH + h) * XHD + d]; }
    DI float v(int key, int e) const { return mv[(((size_t)b * NMEM + key) * XH + h) * XHD + e]; } };


typedef float f32x16 __attribute__((ext_vector_type(16)));
typedef short bf16x8 __attribute__((ext_vector_type(8)));
typedef short s16x4 __attribute__((ext_vector_type(4)));
typedef unsigned u32x4_t __attribute__((ext_vector_type(4)));
typedef unsigned u32x2_t __attribute__((ext_vector_type(2)));
DI int crow(int i, int h) { return (i & 3) + 8 * (i >> 2) + 4 * h; }
#define MFMA32(a, b, c) __builtin_amdgcn_mfma_f32_32x32x16_bf16((a), (b), (c), 0, 0, 0)
template <int DQK, int DV, bool CAUSAL, class Src>
DI void flash_unit(LAS unsigned char* lds, const Src& src, int qpos0, int ntiles, bf16_t* O, int ldo, float c2) {
    constexpr int KP = DQK + 8, VP = 68, KS = DQK / 16, NBLK = DV / 32;
    constexpr int KBYTES = 64 * KP * 2, VBYTES = DV * VP * 2, BUF = KBYTES + VBYTES;
    constexpr int D8 = DQK / 8, NPK = (64 * D8) / NTHREADS, NPV = (DV * 8) / NTHREADS;
    static_assert((64 * D8) % NTHREADS == 0 && (DV * 8) % NTHREADS == 0 && 2 * BUF <= 131072, "flash_unit geometry");
    const int tid = threadIdx.x, lane = tid & 63, w = __builtin_amdgcn_readfirstlane(tid >> 6), l31 = lane & 31, h = lane >> 5;
    bf16x8 qf[KS];
#pragma unroll
    for (int s_ = 0; s_ < KS; ++s_) qf[s_] = src.qfrag(32 * w + l31, s_, h);
    f32x16 o[NBLK];
#pragma unroll
    for (int b = 0; b < NBLK; ++b)
#pragma unroll
        for (int i = 0; i < 16; ++i) o[b][i] = 0.f;
    float m = -INFINITY, lsum = 0.f;
    u32x4_t kreg[NPK], vreg[NPV];
#define FL_LOAD(t_) do { _Pragma("unroll") for (int i_ = 0; i_ < NPK; ++i_) { const int p_ = tid + i_ * NTHREADS; kreg[i_] = src.kpiece(64 * (t_) + p_ / D8, p_ % D8); } \
                         _Pragma("unroll") for (int i_ = 0; i_ < NPV; ++i_) { const int p_ = tid + i_ * NTHREADS; vreg[i_] = src.vpiece(p_ >> 3, 64 * (t_) + 8 * (p_ & 7)); } } while (0)
#define FL_STORE(buf_) do { _Pragma("unroll") for (int i_ = 0; i_ < NPK; ++i_) { const int p_ = tid + i_ * NTHREADS; *(LAS u32x4_t*)(lds + (buf_) * BUF + ((p_ / D8) * KP + (p_ % D8) * 8) * 2) = kreg[i_]; } \
                          _Pragma("unroll") for (int i_ = 0; i_ < NPV; ++i_) { const int p_ = tid + i_ * NTHREADS; LAS unsigned char* a_ = lds + (buf_) * BUF + KBYTES + ((p_ >> 3) * VP + (p_ & 7) * 8) * 2; \
                              *(LAS u32x2_t*)a_ = (u32x2_t){vreg[i_].x, vreg[i_].y}; *(LAS u32x2_t*)(a_ + 8) = (u32x2_t){vreg[i_].z, vreg[i_].w}; } } while (0)
    __syncthreads();
    FL_LOAD(0); FL_STORE(0);
    __syncthreads();
    const int qmine = qpos0 + 32 * w + l31, qlast = qpos0 + 32 * w + 31;
    for (int t = 0; t < ntiles; ++t) {
        const int buf = t & 1;
        if (t + 1 < ntiles) FL_LOAD(t + 1);
        if (!CAUSAL || 64 * t <= qlast) {
            const LAS unsigned char* kb_ = lds + buf * BUF; const LAS unsigned char* vb_ = kb_ + KBYTES;
            f32x16 st[2];
#pragma unroll
            for (int kb = 0; kb < 2; ++kb) {
#pragma unroll
                for (int i = 0; i < 16; ++i) st[kb][i] = 0.f;
#pragma unroll
                for (int g_ = 0; g_ < KS / 4; ++g_) { bf16x8 kf[4];
#pragma unroll
                    for (int j = 0; j < 4; ++j) kf[j] = *(const LAS bf16x8*)(kb_ + ((32 * kb + l31) * KP + 16 * (4 * g_ + j) + 8 * h) * 2);
#pragma unroll
                    for (int j = 0; j < 4; ++j) st[kb] = MFMA32(kf[j], qf[4 * g_ + j], st[kb]);
                    __builtin_amdgcn_sched_barrier(0); }
            }
            if (CAUSAL && 64 * t + 63 > qpos0 + 32 * w) {
#pragma unroll
                for (int kb = 0; kb < 2; ++kb)
#pragma unroll
                    for (int i = 0; i < 16; ++i) { const int key = 64 * t + 32 * kb + crow(i, h); st[kb][i] = key <= qmine ? st[kb][i] : -INFINITY; }
            }
            float mx = -INFINITY;
#pragma unroll
            for (int kb = 0; kb < 2; ++kb)
#pragma unroll
                for (int i = 0; i < 16; ++i) mx = fmaxf(mx, st[kb][i]);
            mx = fmaxf(mx, __shfl_xor(mx, 32));
            const float mn = fmaxf(m, mx);
            { const float alpha = __builtin_amdgcn_exp2f((m - mn) * c2);
                lsum *= alpha;
#pragma unroll
                for (int b = 0; b < NBLK; ++b)
#pragma unroll
                    for (int i = 0; i < 16; ++i) o[b][i] *= alpha;
                m = mn;
            }
            const float nmc = -mn * c2;
            float ps = 0.f;
#pragma unroll
            for (int kb = 0; kb < 2; ++kb)
#pragma unroll
                for (int i = 0; i < 16; ++i) { const float p = __builtin_amdgcn_exp2f(__builtin_fmaf(st[kb][i], c2, nmc)); st[kb][i] = p; ps += p; }
            lsum += ps;
            bf16x8 pf[4];
#pragma unroll
            for (int ks = 0; ks < 4; ++ks) { const int kb = ks >> 1, s2 = ks & 1; u32x4_t pk;
                pk.x = cvtpk(st[kb][8 * s2 + 0], st[kb][8 * s2 + 1]); pk.y = cvtpk(st[kb][8 * s2 + 2], st[kb][8 * s2 + 3]);
                pk.z = cvtpk(st[kb][8 * s2 + 4], st[kb][8 * s2 + 5]); pk.w = cvtpk(st[kb][8 * s2 + 6], st[kb][8 * s2 + 7]); pf[ks] = __builtin_bit_cast(bf16x8, pk); }
            __builtin_amdgcn_sched_barrier(0);
#pragma unroll
            for (int b = 0; b < NBLK; ++b) { bf16x8 vf[4];
#pragma unroll
                for (int ks = 0; ks < 4; ++ks) { const LAS unsigned char* a_ = vb_ + ((32 * b + l31) * VP + 16 * ks + 4 * h) * 2;
                    const s16x4 lo = *(const LAS s16x4*)a_, hi = *(const LAS s16x4*)(a_ + 16);
                    vf[ks] = __builtin_shufflevector(lo, hi, 0, 1, 2, 3, 4, 5, 6, 7); }
#pragma unroll
                for (int ks = 0; ks < 4; ++ks) o[b] = MFMA32(vf[ks], pf[ks], o[b]);
                __builtin_amdgcn_sched_barrier(0); }
        }
        if (t + 1 < ntiles) FL_STORE(buf ^ 1);
        __syncthreads();
    }
#undef FL_LOAD
#undef FL_STORE
    lsum += __shfl_xor(lsum, 32);
    const float inv = 1.f / lsum;
    bf16_t* orow = O + (size_t)(32 * w + l31) * ldo;
#pragma unroll
    for (int b = 0; b < NBLK; ++b)
#pragma unroll
        for (int g = 0; g < 4; ++g) { u32x2_t pk; pk.x = cvtpk(o[b][4 * g + 0] * inv, o[b][4 * g + 1] * inv); pk.y = cvtpk(o[b][4 * g + 2] * inv, o[b][4 * g + 3] * inv);
            *(u32x2_t*)(orow + 32 * b + 8 * g + 4 * h) = pk; }
}
struct SrcMlaP { const bf16_t* kn; const bf16_t* kpe; const bf16_t* vt; const bf16_t* qraw; const bf16_t* qpe; int b, hh; size_t row0;
    DI bf16x8 qfrag(int r, int s_, int h8) const { return s_ < 8 ? *(const bf16x8*)(qraw + (row0 + r) * 1536 + hh * DQH + 16 * s_ + 8 * h8) : *(const bf16x8*)(qpe + (row0 + r) * 512 + hh * DROPE + 16 * (s_ - 8) + 8 * h8); }
    DI u32x4_t kpiece(int key, int d8) const { const size_t row = (size_t)b * SEQ + key;
        return d8 < 16 ? *(const u32x4_t*)(kn + row * 1024 + hh * DNOPE + d8 * 8) : *(const u32x4_t*)(kpe + row * DROPE + (d8 - 16) * 8); }
    DI u32x4_t vpiece(int dv, int key0) const { return *(const u32x4_t*)(vt + (size_t)(hh * DVH + dv) * NP + (size_t)b * SEQ + key0); } };
struct SrcMemP { const bf16_t* mk; const bf16_t* mvt; const bf16_t* xq; int b, hh; size_t row0;
    DI bf16x8 qfrag(int r, int s_, int h8) const { return *(const bf16x8*)(xq + (row0 + r) * ZLD + hh * XHD + 16 * s_ + 8 * h8); }
    DI u32x4_t kpiece(int key, int d8) const { return *(const u32x4_t*)(mk + ((size_t)b * NMEM + key) * 256 + hh * XHD + d8 * 8); }
    DI u32x4_t vpiece(int dv, int key0) const { return *(const u32x4_t*)(mvt + (size_t)(hh * XHD + dv) * (NB * NMEM) + (size_t)b * NMEM + key0); } };


DI void ret_chunk_state(const bf16_t* __restrict__ RVT, const bf16_t* __restrict__ RKtT, float* __restrict__ UT, int b, int h, int c) {
    const int tid = threadIdx.x, lane = tid & 63, w = __builtin_amdgcn_readfirstlane(tid >> 6), l31 = lane & 31, hh = lane >> 5;
    const size_t tok0 = (size_t)b * SEQ + c * 128;
    f32x16 acc[4];
#pragma unroll
    for (int kb = 0; kb < 4; ++kb)
#pragma unroll
        for (int i = 0; i < 16; ++i) acc[kb][i] = 0.f;
    const bf16_t* ap = RVT + (size_t)(h * RDV + 32 * w + l31) * NT + tok0 + 8 * hh;
    const bf16_t* bp = RKtT + (size_t)(h * RDK + l31) * NP + tok0 + 8 * hh;
#pragma unroll
    for (int s_ = 0; s_ < 8; ++s_) { const bf16x8 a = *(const bf16x8*)(ap + 16 * s_);
#pragma unroll
        for (int kb = 0; kb < 4; ++kb) { const bf16x8 bfr = *(const bf16x8*)(bp + (size_t)(32 * kb) * NP + 16 * s_); acc[kb] = MFMA32(a, bfr, acc[kb]); } }
    float* u = UT + (size_t)(((b * RH + h) * 16) + c) * 32768;
#pragma unroll
    for (int kb = 0; kb < 4; ++kb)
#pragma unroll
        for (int i = 0; i < 16; ++i) u[(32 * w + crow(i, hh)) * RDK + 32 * kb + l31] = acc[kb][i];
}
DI void ret_chunk_out(const bf16_t* __restrict__ RQt, const bf16_t* __restrict__ RKt, const bf16_t* __restrict__ RVT, const bf16_t* __restrict__ SPT, float* __restrict__ ORET, int b, int h, int c) {
    const int tid = threadIdx.x, lane = tid & 63, w = __builtin_amdgcn_readfirstlane(tid >> 6), l31 = lane & 31, hh = lane >> 5;
    const int ib = w & 3, vh = w >> 2;
    const size_t tok0 = (size_t)b * SEQ + c * 128;
    bf16x8 qf[8];
    { const bf16_t* qp = RQt + (tok0 + 32 * ib + l31) * 512 + h * RDK + 8 * hh;
#pragma unroll
      for (int s_ = 0; s_ < 8; ++s_) qf[s_] = *(const bf16x8*)(qp + 16 * s_); }
    f32x16 o[4];
#pragma unroll
    for (int blk = 0; blk < 4; ++blk)
#pragma unroll
        for (int i = 0; i < 16; ++i) o[blk][i] = 0.f;
    const bf16_t* vbase = RVT + (size_t)(h * RDV + 32 * (4 * vh) + l31) * NT + tok0 + 4 * hh;
#pragma unroll 1
    for (int jb = 0; jb <= ib; ++jb) {
        f32x16 x;
#pragma unroll
        for (int i = 0; i < 16; ++i) x[i] = 0.f;
        const bf16_t* kp = RKt + (tok0 + 32 * jb + l31) * 512 + h * RDK + 8 * hh;
#pragma unroll
        for (int s_ = 0; s_ < 8; ++s_) { const bf16x8 kf = *(const bf16x8*)(kp + 16 * s_); x = MFMA32(kf, qf[s_], x); }
        if (jb == ib) {
#pragma unroll
            for (int i = 0; i < 16; ++i) x[i] = (crow(i, hh) <= l31) ? x[i] : 0.f;
        }
#pragma unroll
        for (int s2 = 0; s2 < 2; ++s2) {
            u32x4_t pk; pk.x = cvtpk(x[8 * s2 + 0], x[8 * s2 + 1]); pk.y = cvtpk(x[8 * s2 + 2], x[8 * s2 + 3]); pk.z = cvtpk(x[8 * s2 + 4], x[8 * s2 + 5]); pk.w = cvtpk(x[8 * s2 + 6], x[8 * s2 + 7]);
            const bf16x8 pa = __builtin_bit_cast(bf16x8, pk);
#pragma unroll
            for (int blk = 0; blk < 4; ++blk) { const bf16_t* vp = vbase + (size_t)(32 * blk) * NT + 32 * jb + 16 * s2;
                const s16x4 lo = *(const s16x4*)vp, hi = *(const s16x4*)(vp + 8);
                const bf16x8 vf = __builtin_shufflevector(lo, hi, 0, 1, 2, 3, 4, 5, 6, 7);
                o[blk] = MFMA32(pa, vf, o[blk]); }
        }
    }
    const bf16_t* sp = SPT + (size_t)(((b * RH + h) * 16) + c) * 32768 + (size_t)(32 * (4 * vh) + l31) * RDK + 8 * hh;
#pragma unroll
    for (int s_ = 0; s_ < 8; ++s_)
#pragma unroll
        for (int blk = 0; blk < 4; ++blk) { const bf16x8 sf = *(const bf16x8*)(sp + (size_t)(32 * blk) * RDK + 16 * s_); o[blk] = MFMA32(qf[s_], sf, o[blk]); }
#pragma unroll
    for (int blk = 0; blk < 4; ++blk)
#pragma unroll
        for (int i = 0; i < 16; ++i) ORET[(tok0 + 32 * ib + crow(i, hh)) * 1024 + h * RDV + 32 * (4 * vh + blk) + l31] = o[blk][i];
}


typedef short v4i16_t __attribute__((ext_vector_type(4)));
DI s16x4 vtr(const LAS unsigned char* p) { return __builtin_bit_cast(s16x4, __builtin_amdgcn_ds_read_tr16_b64_v4i16((LAS v4i16_t*)p)); }
constexpr int MS_NSPLIT = 2, MS_KEYS = PAST / MS_NSPLIT, MS_TILES = MS_KEYS / 64;
DI void mla_sample_unit(LAS unsigned char* lds, const float* __restrict__ cckv, const float* __restrict__ ckpe, const int* __restrict__ pt,
                        const bf16_t* __restrict__ QLATb, const bf16_t* __restrict__ QPEb, float* __restrict__ PO, float* __restrict__ PML, int b, int split, float c2) {
    constexpr int KP = 328, KBYTES = 64 * KP * 2, SP = 68;
    LAS float* Sc = (LAS float*)(lds + 2 * KBYTES);
    const int tid = threadIdx.x, lane = tid & 63, w = __builtin_amdgcn_readfirstlane(tid >> 6), l31 = lane & 31, hh = lane >> 5, l15 = lane & 15, g4 = lane >> 4;
    const int kg = w >> 1, qg = w & 1;
    bf16x8 qf[10];
    { const int qi = 16 * qg + l15, t = qi >> 3, head = qi & 7;
      const bf16_t* ql = QLATb + (size_t)(b * DS + t) * 2048 + head * KVL + 8 * g4;
      const bf16_t* qp = QPEb + (size_t)(NP + b * DS + t) * 512 + head * DROPE + 8 * g4;
#pragma unroll
      for (int s_ = 0; s_ < 8; ++s_) qf[s_] = *(const bf16x8*)(ql + 32 * s_);
#pragma unroll
      for (int s_ = 0; s_ < 2; ++s_) qf[8 + s_] = *(const bf16x8*)(qp + 32 * s_); }
    f32x16 o;
#pragma unroll
    for (int i = 0; i < 16; ++i) o[i] = 0.f;
    float m = -INFINITY, lsum = 0.f;
    f32x4 crA[8], prA[2], crB[8], prB[2];
    const unsigned voffc = (unsigned)(((tid >> 6) * KVL + 4 * (tid & 63)) * 4), voffp = (unsigned)(((tid >> 4) * DROPE + 4 * (tid & 15)) * 4);
#define MS_LOAD(t_, CR_, PR_) do { const int key0_ = split * MS_KEYS + 64 * (t_); const int pg_ = __builtin_amdgcn_readfirstlane(pt[b * NPAGES + (key0_ >> 7)]); \
        const size_t rowb_ = (size_t)pg_ * PAGE + (key0_ & (PAGE - 1)); const char* cb_ = (const char*)(cckv + rowb_ * KVL); const char* pb_ = (const char*)(ckpe + rowb_ * DROPE); \
        _Pragma("unroll") for (int i_ = 0; i_ < 8; ++i_) CR_[i_] = __builtin_nontemporal_load((const f32x4*)(cb_ + (size_t)i_ * (8 * KVL * 4) + voffc)); \
        _Pragma("unroll") for (int i_ = 0; i_ < 2; ++i_) PR_[i_] = __builtin_nontemporal_load((const f32x4*)(pb_ + (size_t)i_ * (32 * DROPE * 4) + voffp)); } while (0)
#define MS_STORE(buf_, CR_, PR_) do { \
        _Pragma("unroll") for (int i_ = 0; i_ < 8; ++i_) { const int pc_ = tid + i_ * NTHREADS; *(LAS u32x2_t*)(lds + (buf_) * KBYTES + ((pc_ >> 6) * KP + 4 * (pc_ & 63)) * 2) = (u32x2_t){cvtpk(CR_[i_][0], CR_[i_][1]), cvtpk(CR_[i_][2], CR_[i_][3])}; } \
        _Pragma("unroll") for (int i_ = 0; i_ < 2; ++i_) { const int pc_ = tid + i_ * NTHREADS; *(LAS u32x2_t*)(lds + (buf_) * KBYTES + ((pc_ >> 4) * KP + KVL + 4 * (pc_ & 15)) * 2) = (u32x2_t){cvtpk(PR_[i_][0], PR_[i_][1]), cvtpk(PR_[i_][2], PR_[i_][3])}; } } while (0)
    __syncthreads();
    MS_LOAD(0, crA, prA); MS_LOAD(1, crB, prB); MS_STORE(0, crA, prA); MS_LOAD(2, crA, prA);
    __syncthreads();
    const int q4 = (lane & 15) >> 2, p4 = lane & 3, blk = (lane >> 4) & 1;
    auto tile = [&](const int buf) __attribute__((always_inline)) {
        const LAS unsigned char* kb_ = lds + buf * KBYTES;
        {   f32x4 s4 = {0.f, 0.f, 0.f, 0.f};
            const LAS unsigned char* kr_ = kb_ + ((16 * kg + l15) * KP + 8 * g4) * 2;
#pragma unroll
            for (int g_ = 0; g_ < 2; ++g_) { bf16x8 kf[5];
#pragma unroll
                for (int j = 0; j < 5; ++j) kf[j] = *(const LAS bf16x8*)(kr_ + 64 * (5 * g_ + j));
#pragma unroll
                for (int j = 0; j < 5; ++j) s4 = __builtin_amdgcn_mfma_f32_16x16x32_bf16(kf[j], qf[5 * g_ + j], s4, 0, 0, 0); }
            *(LAS f32x4*)(Sc + (16 * qg + l15) * SP + 16 * kg + 4 * g4) = s4; }
        __syncthreads();
        f32x4 sv[8];
#pragma unroll
        for (int i = 0; i < 8; ++i) sv[i] = *(const LAS f32x4*)(Sc + l31 * SP + 8 * i + 4 * hh);
        float mx = -INFINITY;
#pragma unroll
        for (int i = 0; i < 8; ++i) mx = fmaxf(mx, fmaxf(fmaxf(sv[i][0], sv[i][1]), fmaxf(sv[i][2], sv[i][3])));
        mx = fmaxf(mx, __shfl_xor(mx, 32));
        const float mn = fmaxf(m, mx);
        if (__builtin_amdgcn_ballot_w64(mn > m) != 0ull) {
            const float alpha = __builtin_amdgcn_exp2f((m - mn) * c2);
            lsum *= alpha;
#pragma unroll
            for (int i = 0; i < 16; ++i) o[i] *= alpha;
            m = mn;
        }
        const float nmc = -mn * c2;
        float ps = 0.f;
#pragma unroll
        for (int i = 0; i < 8; ++i)
#pragma unroll
            for (int e = 0; e < 4; ++e) { const float p = __builtin_amdgcn_exp2f(__builtin_fmaf(sv[i][e], c2, nmc)); sv[i][e] = p; ps += p; }
        lsum += ps;
#pragma unroll
        for (int ks = 0; ks < 4; ++ks) { const LAS unsigned char* a_ = kb_ + ((16 * ks + 4 * hh + q4) * KP + 32 * w + 16 * blk + 4 * p4) * 2;
            const s16x4 lo = vtr(a_), hi = vtr(a_ + 8 * KP * 2);
            const bf16x8 vf = __builtin_shufflevector(lo, hi, 0, 1, 2, 3, 4, 5, 6, 7); u32x4_t pk;
            pk.x = cvtpk(sv[2 * ks][0], sv[2 * ks][1]); pk.y = cvtpk(sv[2 * ks][2], sv[2 * ks][3]);
            pk.z = cvtpk(sv[2 * ks + 1][0], sv[2 * ks + 1][1]); pk.w = cvtpk(sv[2 * ks + 1][2], sv[2 * ks + 1][3]);
            o = MFMA32(vf, __builtin_bit_cast(bf16x8, pk), o); }
    };
    static_assert(MS_TILES % 2 == 0 && MS_TILES >= 4 && 2 * KBYTES + 32 * SP * 4 <= MISC_OFF, "mla_sample_unit pipeline");
#pragma unroll 1
    for (int t = 0; t < MS_TILES; t += 2) {
        tile(0);
        MS_STORE(1, crB, prB);
        if (t + 3 < MS_TILES) MS_LOAD(t + 3, crB, prB);
        __syncthreads();
        tile(1);
        if (t + 2 < MS_TILES) { MS_STORE(0, crA, prA); }
        if (t + 4 < MS_TILES) MS_LOAD(t + 4, crA, prA);
        __syncthreads();
    }
#undef MS_LOAD
#undef MS_STORE
    lsum += __shfl_xor(lsum, 32);
    const int item = b * MS_NSPLIT + split;
    if (w == 0 && lane < 32) { PML[(item * 32 + lane) * 2] = m * c2; PML[(item * 32 + lane) * 2 + 1] = lsum; }
#pragma unroll
    for (int i = 0; i < 16; ++i) PO[((size_t)item * 32 + l31) * KVL + 32 * w + crow(i, hh)] = o[i];
}


struct RetItem { int b, h, c, vh; };
DI RetItem ret_item(int it) { RetItem r; r.vh = it & 1; r.c = (it >> 1) & 15; r.h = (it >> 5) & 3; r.b = it >> 7; return r; }
DI void ret_out_phase(LAS unsigned char* lds, const bf16_t* __restrict__ RQt, const bf16_t* __restrict__ RKt, const bf16_t* __restrict__ RVT, const bf16_t* __restrict__ SPT, float* __restrict__ ORET, int bid, int G) {
    constexpr int PITCH = 136, TILE = 128 * PITCH * 2;
    const int tid = threadIdx.x, lane = tid & 63, w = __builtin_amdgcn_readfirstlane(tid >> 6), l31 = lane & 31, hh = lane >> 5;
    const int ib = w & 3, dq = w >> 2;
    u32x4_t st[12];
#define RO_LOAD(it_) do { const RetItem q_ = ret_item(it_); const size_t tok0_ = (size_t)q_.b * SEQ + q_.c * 128; \
        _Pragma("unroll") for (int i_ = 0; i_ < 12; ++i_) { const int p_ = tid + i_ * NTHREADS, tl_ = p_ >> 11, row_ = (p_ >> 4) & 127, c16_ = p_ & 15; const bf16_t* src_; \
            if (tl_ == 0) src_ = RKt + (tok0_ + row_) * 512 + q_.h * RDK + 8 * c16_; \
            else if (tl_ == 1) src_ = RVT + (size_t)(q_.h * RDV + 128 * q_.vh + row_) * NT + tok0_ + 8 * c16_; \
            else src_ = SPT + (size_t)(((q_.b * RH + q_.h) * 16) + q_.c) * 32768 + (size_t)(128 * q_.vh + row_) * RDK + 8 * c16_; \
            st[i_] = *(const u32x4_t*)src_; } } while (0)
#define RO_STORE() do { _Pragma("unroll") for (int i_ = 0; i_ < 12; ++i_) { const int p_ = tid + i_ * NTHREADS, tl_ = p_ >> 11, row_ = (p_ >> 4) & 127, c16_ = p_ & 15; \
            *(LAS u32x4_t*)(lds + tl_ * TILE + (row_ * PITCH + 8 * c16_) * 2) = st[i_]; } } while (0)
    int it = bid;
    if (it < NB * RH * 16 * 2) RO_LOAD(it);
    for (; it < NB * RH * 16 * 2; it += G) {
        const RetItem q = ret_item(it); const size_t tok0 = (size_t)q.b * SEQ + q.c * 128;
        __syncthreads();
        RO_STORE();
        bf16x8 qf[8];
        { const bf16_t* qp = RQt + (tok0 + 32 * ib + l31) * 512 + q.h * RDK + 8 * hh;
#pragma unroll
          for (int s_ = 0; s_ < 8; ++s_) qf[s_] = *(const bf16x8*)(qp + 16 * s_); }
        __syncthreads();
        if (it + G < NB * RH * 16 * 2) RO_LOAD(it + G);
        const LAS unsigned char* Kl = lds; const LAS unsigned char* Vl = lds + TILE; const LAS unsigned char* Sl = lds + 2 * TILE;
        f32x16 o[2];
#pragma unroll
        for (int blk = 0; blk < 2; ++blk)
#pragma unroll
            for (int i = 0; i < 16; ++i) o[blk][i] = 0.f;
#pragma unroll 1
        for (int jb = 0; jb <= ib; ++jb) {
            f32x16 x;
#pragma unroll
            for (int i = 0; i < 16; ++i) x[i] = 0.f;
#pragma unroll
            for (int s_ = 0; s_ < 8; ++s_) { const bf16x8 kf = *(const LAS bf16x8*)(Kl + ((32 * jb + l31) * PITCH + 16 * s_ + 8 * hh) * 2); x = MFMA32(kf, qf[s_], x); }
            if (jb == ib) {
#pragma unroll
                for (int i = 0; i < 16; ++i) x[i] = (crow(i, hh) <= l31) ? x[i] : 0.f;
            }
#pragma unroll
            for (int s2 = 0; s2 < 2; ++s2) {
                u32x4_t pk; pk.x = cvtpk(x[8 * s2 + 0], x[8 * s2 + 1]); pk.y = cvtpk(x[8 * s2 + 2], x[8 * s2 + 3]); pk.z = cvtpk(x[8 * s2 + 4], x[8 * s2 + 5]); pk.w = cvtpk(x[8 * s2 + 6], x[8 * s2 + 7]);
                const bf16x8 pa = __builtin_bit_cast(bf16x8, pk);
#pragma unroll
                for (int blk = 0; blk < 2; ++blk) { const LAS unsigned char* vp = Vl + ((64 * dq + 32 * blk + l31) * PITCH + 32 * jb + 16 * s2 + 4 * hh) * 2;
                    const s16x4 lo = *(const LAS s16x4*)vp, hi = *(const LAS s16x4*)(vp + 16);
                    o[blk] = MFMA32(pa, __builtin_shufflevector(lo, hi, 0, 1, 2, 3, 4, 5, 6, 7), o[blk]); }
            }
        }
#pragma unroll
        for (int s_ = 0; s_ < 8; ++s_)
#pragma unroll
            for (int blk = 0; blk < 2; ++blk) { const bf16x8 sf = *(const LAS bf16x8*)(Sl + ((64 * dq + 32 * blk + l31) * PITCH + 16 * s_ + 8 * hh) * 2); o[blk] = MFMA32(qf[s_], sf, o[blk]); }
#pragma unroll
        for (int blk = 0; blk < 2; ++blk)
#pragma unroll
            for (int i = 0; i < 16; ++i) ORET[(tok0 + 32 * ib + crow(i, hh)) * 1024 + q.h * RDV + 128 * q.vh + 64 * dq + 32 * blk + l31] = o[blk][i];
    }
#undef RO_LOAD
#undef RO_STORE
}


DI void ret_state_phase(LAS unsigned char* lds, const bf16_t* __restrict__ RVT, const bf16_t* __restrict__ RKtT, float* __restrict__ UT, int bid, int G) {
    constexpr int PITCH = 136;
    const int tid = threadIdx.x, lane = tid & 63, w = __builtin_amdgcn_readfirstlane(tid >> 6), l31 = lane & 31, hh = lane >> 5;
    u32x4_t st[12];
#define RS_LOAD(it_) do { const int c_ = (it_) & 15, h_ = ((it_) >> 4) & 3, b_ = (it_) >> 6; const size_t tok0_ = (size_t)b_ * SEQ + c_ * 128; \
        _Pragma("unroll") for (int i_ = 0; i_ < 12; ++i_) { const int p_ = tid + i_ * NTHREADS, row_ = p_ >> 4, c16_ = p_ & 15; \
            const bf16_t* src_ = row_ < 256 ? RVT + (size_t)(h_ * RDV + row_) * NT + tok0_ + 8 * c16_ : RKtT + (size_t)(h_ * RDK + (row_ - 256)) * NP + tok0_ + 8 * c16_; \
            st[i_] = *(const u32x4_t*)src_; } } while (0)
    int it = bid;
    if (it < NB * RH * 16) RS_LOAD(it);
    for (; it < NB * RH * 16; it += G) {
        __syncthreads();
#pragma unroll
        for (int i = 0; i < 12; ++i) { const int p = tid + i * NTHREADS; *(LAS u32x4_t*)(lds + ((p >> 4) * PITCH + 8 * (p & 15)) * 2) = st[i]; }
        __syncthreads();
        if (it + G < NB * RH * 16) RS_LOAD(it + G);
        f32x16 acc[4];
#pragma unroll
        for (int kb = 0; kb < 4; ++kb)
#pragma unroll
            for (int i = 0; i < 16; ++i) acc[kb][i] = 0.f;
#pragma unroll
        for (int s_ = 0; s_ < 8; ++s_) { const bf16x8 a = *(const LAS bf16x8*)(lds + ((32 * w + l31) * PITCH + 16 * s_ + 8 * hh) * 2);
#pragma unroll
            for (int kb = 0; kb < 4; ++kb) { const bf16x8 b_ = *(const LAS bf16x8*)(lds + ((256 + 32 * kb + l31) * PITCH + 16 * s_ + 8 * hh) * 2); acc[kb] = MFMA32(a, b_, acc[kb]); } }
        float* u = UT + (size_t)it * 32768;
#pragma unroll
        for (int kb = 0; kb < 4; ++kb)
#pragma unroll
            for (int i = 0; i < 16; ++i) u[(32 * w + crow(i, hh)) * RDK + 32 * kb + l31] = acc[kb][i];
    }
#undef RS_LOAD
}

struct QPtr { const float* p; DI float operator()(int d) const { return p[d]; } };
struct QMla { const float* ql; const float* qp; DI float operator()(int d) const { return d < KVL ? ql[d] : qp[d - KVL]; } };
DI void rms_row(const float* x, const float* g, float* o, int n, int lane) {
    float s = 0.f;
    for (int i = lane; i < n; i += 64) { const float v = x[i]; s += v * v; }
    const float r = rsqrtf(wave_sum(s) / (float)n + EPS);
    for (int i = lane; i < n; i += 64) o[i] = x[i] * r * g[i];
}

DI void rms_row_bf16(const float* x, const float* g, bf16_t* o, int n, int lane) {
    float s = 0.f;
    for (int i = lane; i < n; i += 64) { const float v = x[i]; s += v * v; }
    const float r = rsqrtf(wave_sum(s) / (float)n + EPS);
    for (int i = lane; i < n; i += 64) o[i] = f2bf(x[i] * r * g[i]);
}
#define GEMM_PHASE(EPI, ...) pg8::gemm_phase<EPI, pg8::StaticOrder, true, true>(__VA_ARGS__)
#define GEMM_SPLIT(...) pg8::gemm_phase<pg8::EpiPart, pg8::SplitOrder, true, true>(__VA_ARGS__)
__global__ void __launch_bounds__(NTHREADS, 2) fwd_kernel(Args args) {
    extern __shared__ __attribute__((aligned(16))) unsigned char lds_raw[];
    LAS unsigned char* ldsb = (LAS unsigned char*)lds_raw;
    LAS float* lds = (LAS float*)ldsb;
    volatile LAS unsigned* MISC = (volatile LAS unsigned*)(ldsb + MISC_OFF);
    const int tid = threadIdx.x, lane = tid & 63, wave = tid >> 6;
    const int G = gridDim.x, bid = blockIdx.x;
    const int gw = bid * NWAVES + wave, NGW = G * NWAVES;
    unsigned char* ws = args.ws;
    float* out = args.out;
    const int lo = args.ph_lo, hi = args.ph_hi;

    if (tid < 64) MISC[tid] = 0u;
    __syncthreads();
    XcdBarrier bar; bar.bar = (unsigned*)(ws + WS_CTL) + CW_BAR; bar.x = 0; bar.st = MISC;
    if (hi - lo > 1) bar = xcd_barrier_post((unsigned*)(ws + WS_CTL) + CW_BAR, MISC);
#define IN(k) (lo <= (k) && (k) < hi)
#define SEAM(k) do { if (IN(k) && IN((k) + 1)) xcd_barrier(bar); } while (0)

#define x_prompt ((const float*)(args.in[0]))
#define x_sample ((const float*)(args.in[1]))
#define mem_prompt ((const float*)(args.in[2]))
#define cache_ckv ((const float*)(args.in[3]))
#define cache_kpe ((const float*)(args.in[4]))
#define page_table ((const int*)args.in[5])
#define state_ret ((const float*)(args.in[6]))
#define cache_mem_k ((const float*)(args.in[7]))
#define cache_mem_v ((const float*)(args.in[8]))
#define g_mix_pre ((const float*)(args.in[9]))
#define g_mix_post ((const float*)(args.in[10]))
#define g_ffn_pre ((const float*)(args.in[11]))
#define g_ffn_post ((const float*)(args.in[12]))
#define g_mem ((const float*)(args.in[13]))
#define g_qlat ((const float*)(args.in[14]))
#define g_kvlat ((const float*)(args.in[15]))
#define w_in ((const float*)(args.in[16]))
#define w_uq ((const float*)(args.in[17]))
#define w_uk ((const float*)(args.in[18]))
#define w_uv ((const float*)(args.in[19]))
#define w_mem_k ((const float*)(args.in[20]))
#define w_mem_v ((const float*)(args.in[21]))
#define w_ret_o ((const float*)(args.in[22]))
#define w_mla_o ((const float*)(args.in[23]))
#define w_x_o ((const float*)(args.in[24]))
#define w_out ((const float*)(args.in[25]))
#define w_gate ((const float*)(args.in[26]))
#define w_up ((const float*)(args.in[27]))
#define w_down ((const float*)(args.in[28]))
#define COSA ((float*)(ws + WS_COSA))
#define SINA ((float*)(ws + WS_SINA))
#define COSB ((float*)(ws + WS_COSB))
#define SINB ((float*)(ws + WS_SINB))
#define U ((float*)(ws + WS_U))
#define MN ((float*)(ws + WS_MN))
#define Zb ((bf16_t*)(ws + WS_Z))
#define RQ ((float*)(ws + WS_RQ))
#define RK ((float*)(ws + WS_RK))
#define CQN ((float*)(ws + WS_CQN))
#define CKVN ((float*)(ws + WS_CKVN))
#define KPER ((float*)(ws + WS_KPER))
#define Q ((float*)(ws + WS_Q))
#define QLAT ((float*)(ws + WS_QLAT))
#define QPE ((float*)(ws + WS_QPE))
#define ORET ((float*)(ws + WS_ORET))
#define OLAT ((float*)(ws + WS_OLAT))
#define OX ((float*)(ws + WS_OX))
#define OMLA ((float*)(ws + WS_OMLA))
#define ORETN ((float*)(ws + WS_ORETN))
#define ARET ((float*)(ws + WS_ARET))
#define AMLA ((float*)(ws + WS_AMLA))
#define AX ((float*)(ws + WS_AX))
#define MIX ((float*)(ws + WS_MIX))
#define HP ((float*)(ws + WS_HP))
#define H ((float*)(ws + WS_H))
#define F ((float*)(ws + WS_F))
#define GU ((float*)(ws + WS_GG))
#define FO ((float*)(ws + WS_FO))
#define WinT ((bf16_t*)(ws + WS_WIN_T))
#define WmkvT ((bf16_t*)(ws + WS_WMKV_T))
#define WuqT ((bf16_t*)(ws + WS_WUQ_T))
#define WroT ((bf16_t*)(ws + WS_WRO_T))
#define WmoT ((bf16_t*)(ws + WS_WMO_T))
#define WxoT ((bf16_t*)(ws + WS_WXO_T))
#define WoT ((bf16_t*)(ws + WS_WO_T))
#define WguT ((bf16_t*)(ws + WS_WGU_T))
#define WdT ((bf16_t*)(ws + WS_WD_T))
#define Ub ((bf16_t*)(ws + WS_UB))
#define MNb ((bf16_t*)(ws + WS_MNB))
#define CQNb ((bf16_t*)(ws + WS_CQNB))
#define ORETNb ((bf16_t*)(ws + WS_ORETNB))
#define OMLAb ((bf16_t*)(ws + WS_OMLAB))
#define OXb ((bf16_t*)(ws + WS_OXB))
#define MIXb ((bf16_t*)(ws + WS_MIXB))
#define Fb ((bf16_t*)(ws + WS_FB))
#define ACTb ((bf16_t*)(ws + WS_ACTB))
#define WukT ((bf16_t*)(ws + WS_WUK_T))
#define WuvT ((bf16_t*)(ws + WS_WUV_T))
#define CKVNb ((bf16_t*)(ws + WS_CKVNB))
#define KPERb ((bf16_t*)(ws + WS_KPERB))
#define XQb ((bf16_t*)(ws + WS_XQB))
#define MKb ((bf16_t*)(ws + WS_MKB))
#define MVT ((bf16_t*)(ws + WS_MVT))
#define KN ((bf16_t*)(ws + WS_KN))
#define VT ((bf16_t*)(ws + WS_VT))
#define Qb ((bf16_t*)(ws + WS_QB))
#define RQt ((bf16_t*)(ws + WS_RQT))
#define RKt ((bf16_t*)(ws + WS_RKT))
#define RKtT ((bf16_t*)(ws + WS_RKTT))
#define RVT ((bf16_t*)(ws + WS_RVT))
#define UT ((float*)(ws + WS_UT))
#define SPT ((bf16_t*)(ws + WS_SPT))
#define QPEb ((bf16_t*)(ws + WS_QPEB))
#define WukB ((bf16_t*)(ws + WS_WUKB))
#define PART ((float*)(ws + WS_PART))
#define SGb ((bf16_t*)(ws + WS_SGB))
#define SRGb ((bf16_t*)(ws + WS_SRGB))
#define T0b ((bf16_t*)(ws + WS_T0B))
#define T1b ((bf16_t*)(ws + WS_T1B))
#define QLATb ((bf16_t*)(ws + WS_QLATB))
#define PO ((float*)(ws + WS_PO))
#define PML ((float*)(ws + WS_PML))
    if (IN(0)) {
        for (int i = bid * NTHREADS + tid; i < NPOS * 64 + NPOS * 32; i += G * NTHREADS) {
            const bool a = i < NPOS * 64; const int j = a ? i : i - NPOS * 64; const int half = a ? 64 : 32;
            const int p = j / half, f = j % half; const int pos = p < SEQ ? p : PAST + (p - SEQ);
            const float inv = powf(10000.0f, -(float)f / (float)half);
            const float ang = (float)pos * inv;
            double rev = (double)ang * 0.15915494309189535; rev -= floor(rev);
            const float r = (float)rev;
            const float sn = __builtin_amdgcn_sinf(r), cs = __builtin_amdgcn_cosf(r);
            if (a) { COSA[j] = cs; SINA[j] = sn; } else { COSB[j] = cs; SINB[j] = sn; }
        }
#pragma unroll 1
        for (int pass = 0; pass < 2; ++pass) {
            const int nrows = pass ? NB * NMEM : NT; const float* gsrc = pass ? g_mem : g_mix_pre; bf16_t* dst = pass ? MNb : Ub;
            f32x4 a[4];
#define P0_SRC(r_) (pass ? mem_prompt + (size_t)(r_) * DM : (r_) < NP ? x_prompt + (size_t)(r_) * DM : x_sample + (size_t)((r_) - NP) * DM)
#define P0_LOAD(r_, A_) do { const float* s_ = P0_SRC(r_); _Pragma("unroll") for (int j_ = 0; j_ < 4; ++j_) A_[j_] = *(const f32x4*)(s_ + 4 * lane + 256 * j_); } while (0)
            int row = gw;
            if (row < nrows) P0_LOAD(row, a);
#pragma unroll 1
            for (; row < nrows; row += NGW) {
                f32x4 an[4]; const int nr = row + NGW;
                if (nr < nrows) P0_LOAD(nr, an);
                float ss = 0.f;
#pragma unroll
                for (int j = 0; j < 4; ++j) ss += a[j][0] * a[j][0] + a[j][1] * a[j][1] + a[j][2] * a[j][2] + a[j][3] * a[j][3];
                const float r = rsqrtf(wave_sum(ss) * (1.f / DM) + EPS);
#pragma unroll
                for (int j = 0; j < 4; ++j) { const f32x4 v = a[j] * r * *(const f32x4*)(gsrc + 4 * lane + 256 * j); *(u32x2_t*)(dst + (size_t)row * DM + 4 * lane + 256 * j) = (u32x2_t){cvtpk(v[0], v[1]), cvtpk(v[2], v[3])}; }
#pragma unroll
                for (int j = 0; j < 4; ++j) a[j] = an[j];
            }
#undef P0_LOAD
#undef P0_SRC
        }
        {
            LAS float* scr = lds + wave * (64 * 33);
            int rot = 0;
            transpose_w(w_in, 1024, DIN, WinT, 1024, 0, scr, gw, NGW, lane, rot);
            for (int i = bid * NTHREADS + tid; i < (ZLD - DIN) * 1024 / 2; i += G * NTHREADS) ((unsigned*)(WinT + (size_t)DIN * 1024))[i] = 0u;
            for (int i = bid * NTHREADS + tid; i < MH * KVL * DNOPE / 4; i += G * NTHREADS) { const f32x4 v = *(const f32x4*)(w_uk + 4 * (size_t)i); *(u32x2_t*)(WukB + 4 * (size_t)i) = (u32x2_t){cvtpk(v[0], v[1]), cvtpk(v[2], v[3])}; }
            transpose_w(w_mem_k, 1024, 256, WmkvT, 1024, 0, scr, gw, NGW, lane, rot);
            transpose_w(w_mem_v, 1024, 256, WmkvT, 1024, 256, scr, gw, NGW, lane, rot);
            transpose_w(w_uq, QL, 1536, WuqT, QL, 0, scr, gw, NGW, lane, rot);
            transpose_w(w_ret_o, 1024, 1024, WroT, 1024, 0, scr, gw, NGW, lane, rot);
            transpose_w(w_mla_o, 1024, 1024, WmoT, 1024, 0, scr, gw, NGW, lane, rot);
            transpose_w(w_x_o, 256, 1024, WxoT, 256, 0, scr, gw, NGW, lane, rot);
            transpose_w(w_out, 1024, 1024, WoT, 1024, 0, scr, gw, NGW, lane, rot);
            transpose_w(w_gate, 1024, DFF, WguT, 1024, 0, scr, gw, NGW, lane, rot, 2);
            transpose_w(w_up, 1024, DFF, WguT, 1024, 1, scr, gw, NGW, lane, rot, 2);
            transpose_w(w_down, DFF, 1024, WdT, DFF, 0, scr, gw, NGW, lane, rot);
            for (int hh = 0; hh < MH; ++hh) { transpose_w(w_uk + (size_t)hh * KVL * DNOPE, KVL, DNOPE, WukT, KVL, hh * DNOPE, scr, gw, NGW, lane, rot);
                                              transpose_w(w_uv + (size_t)hh * KVL * DVH, KVL, DVH, WuvT, KVL, hh * DVH, scr, gw, NGW, lane, rot); }
        }
    }
    SEAM(0);
    if (IN(1)) {
        static_assert(WS_MNB == WS_UB + (size_t)NT * 1024 * 2 && WS_WMKV_T == WS_WIN_T + (size_t)ZLD * 1024 * 2, "P1 stacks Ub|MNb and WinT|WmkvT");
        { pg8::Gemm g{Ub, WinT, NT + NB * NMEM, ZLD + 512, 1024, 1024, 1024}; pg8::P1Order S; S.init(G, bid); pg8::EpiP1 E{Zb, ZLD, out + O_MKP, out + O_MVP, SRGb, SGb, C_RG, C_G};
          pg8::gemm_phase<pg8::EpiP1, pg8::P1Order, true, true>(ldsb, g, S, E); }
        __syncthreads();
        { pg8::Gemm g{WinT + (size_t)C_RV * 1024, Ub, 1024, NP, 1024, 1024, 1024}; pg8::StaticOrder S; S.init(1024, NP, G, bid); pg8::EpiBf16S E{RVT, NT};
          GEMM_PHASE(pg8::EpiBf16S, ldsb, g, S, E); }
    }
    SEAM(1);
    if (IN(2)) {
        constexpr int KTP = 520;
        LAS bf16_t* Kt = (LAS bf16_t*)ldsb;
        const int ntile = NP / 64, nwork = ntile + (NS + 63) / 64;
        for (int wk = bid; wk < nwork; wk += G) {
            const bool prompt = wk < ntile; const int row_base = prompt ? wk * 64 : NP + (wk - ntile) * 64;
            __syncthreads();
            {
                const int hq = lane >> 4, f4 = (lane & 15) * 4;
                u32x2_t q1, q2, k1, k2, cv, p1, p2; u32x4_t cq8; f32x4 ca, sa, cb, sb; int p;
#define P2_LOAD(r_, Q1_, Q2_, K1_, K2_, CQ_, CV_, P1_, P2_, CA_, SA_, CB_, SB_, P_) do { const bf16_t* z_ = Zb + (size_t)(row_base + (r_)) * ZLD; P_ = pos_index(row_base + (r_)); \
                Q1_ = *(const u32x2_t*)(z_ + C_RQ + hq * RDK + f4); Q2_ = *(const u32x2_t*)(z_ + C_RQ + hq * RDK + 64 + f4); K1_ = *(const u32x2_t*)(z_ + C_RK + hq * RDK + f4); K2_ = *(const u32x2_t*)(z_ + C_RK + hq * RDK + 64 + f4); \
                CQ_ = (u32x4_t){0u, 0u, 0u, 0u}; if (lane < 48) CQ_ = *(const u32x4_t*)(z_ + C_CQ + 8 * lane); CV_ = *(const u32x2_t*)(z_ + C_CKV + 4 * lane); \
                P1_ = (u32x2_t){0u, 0u}; P2_ = P1_; CB_ = (f32x4){0.f, 0.f, 0.f, 0.f}; SB_ = CB_; \
                if (lane < 8) { P1_ = *(const u32x2_t*)(z_ + C_KPE + 4 * lane); P2_ = *(const u32x2_t*)(z_ + C_KPE + 32 + 4 * lane); CB_ = *(const f32x4*)(COSB + P_ * 32 + 4 * lane); SB_ = *(const f32x4*)(SINB + P_ * 32 + 4 * lane); } \
                CA_ = *(const f32x4*)(COSA + P_ * 64 + f4); SA_ = *(const f32x4*)(SINA + P_ * 64 + f4); } while (0)
#define BLO(x_) __builtin_bit_cast(float, (x_) << 16)
#define BHI(x_) __builtin_bit_cast(float, (x_) & 0xffff0000u)
                int r = wave;
                P2_LOAD(r, q1, q2, k1, k2, cq8, cv, p1, p2, ca, sa, cb, sb, p);
                for (; r < 64; r += NWAVES) {
                    u32x2_t q1n, q2n, k1n, k2n, cvn, p1n, p2n; u32x4_t cq8n; f32x4 can, san, cbn, sbn; int pn;
                    if (r + NWAVES < 64) P2_LOAD(r + NWAVES, q1n, q2n, k1n, k2n, cq8n, cvn, p1n, p2n, can, san, cbn, sbn, pn);
                    const int row = row_base + r; const int il = p & 127;
                    {
                        const float x1q[4] = {BLO(q1.x), BHI(q1.x), BLO(q1.y), BHI(q1.y)}, x2q[4] = {BLO(q2.x), BHI(q2.x), BLO(q2.y), BHI(q2.y)};
                        const float x1k[4] = {BLO(k1.x), BHI(k1.x), BLO(k1.y), BHI(k1.y)}, x2k[4] = {BLO(k2.x), BHI(k2.x), BLO(k2.y), BHI(k2.y)};
                        const float sc = 0.08838834764831845f;
                        float oq1[4], oq2[4], ok1[4], ok2[4];
#pragma unroll
                        for (int e = 0; e < 4; ++e) { oq1[e] = x1q[e] * ca[e] - x2q[e] * sa[e]; oq2[e] = x1q[e] * sa[e] + x2q[e] * ca[e];
                            ok1[e] = (x1k[e] * ca[e] - x2k[e] * sa[e]) * sc; ok2[e] = (x1k[e] * sa[e] + x2k[e] * ca[e]) * sc; }
                        if (prompt) {
                            const float fq = __expf((float)(il - 127) * lg_gamma(hq)), fk = 1.f / fq;
                            *(u32x2_t*)(RQt + (size_t)row * 512 + hq * RDK + f4) = (u32x2_t){cvtpk(oq1[0] * fq, oq1[1] * fq), cvtpk(oq1[2] * fq, oq1[3] * fq)};
                            *(u32x2_t*)(RQt + (size_t)row * 512 + hq * RDK + 64 + f4) = (u32x2_t){cvtpk(oq2[0] * fq, oq2[1] * fq), cvtpk(oq2[2] * fq, oq2[3] * fq)};
                            const u32x2_t kb1 = {cvtpk(ok1[0] * fk, ok1[1] * fk), cvtpk(ok1[2] * fk, ok1[3] * fk)}, kb2 = {cvtpk(ok2[0] * fk, ok2[1] * fk), cvtpk(ok2[2] * fk, ok2[3] * fk)};
                            *(u32x2_t*)(RKt + (size_t)row * 512 + hq * RDK + f4) = kb1; *(u32x2_t*)(RKt + (size_t)row * 512 + hq * RDK + 64 + f4) = kb2;
                            *(LAS u32x2_t*)(Kt + r * KTP + hq * RDK + f4) = kb1; *(LAS u32x2_t*)(Kt + r * KTP + hq * RDK + 64 + f4) = kb2;
                        } else {
                            *(f32x4*)(RQ + (size_t)row * 512 + hq * RDK + f4) = (f32x4){oq1[0], oq1[1], oq1[2], oq1[3]}; *(f32x4*)(RQ + (size_t)row * 512 + hq * RDK + 64 + f4) = (f32x4){oq2[0], oq2[1], oq2[2], oq2[3]};
                            *(f32x4*)(RK + (size_t)row * 512 + hq * RDK + f4) = (f32x4){ok1[0], ok1[1], ok1[2], ok1[3]}; *(f32x4*)(RK + (size_t)row * 512 + hq * RDK + 64 + f4) = (f32x4){ok2[0], ok2[1], ok2[2], ok2[3]};
                        }
                    }
                    {
                        const float c_[8] = {BLO(cq8.x), BHI(cq8.x), BLO(cq8.y), BHI(cq8.y), BLO(cq8.z), BHI(cq8.z), BLO(cq8.w), BHI(cq8.w)};
                        float ss = 0.f;
#pragma unroll
                        for (int e = 0; e < 8; ++e) ss += c_[e] * c_[e];
                        const float rr = rsqrtf(wave_sum(ss) * (1.f / QL) + EPS);
                        if (lane < 48) { const f32x4 g0 = *(const f32x4*)(g_qlat + 8 * lane), g1 = *(const f32x4*)(g_qlat + 8 * lane + 4);
                            *(u32x4_t*)(CQNb + (size_t)row * QL + 8 * lane) = (u32x4_t){cvtpk(c_[0] * rr * g0[0], c_[1] * rr * g0[1]), cvtpk(c_[2] * rr * g0[2], c_[3] * rr * g0[3]),
                                                                                     cvtpk(c_[4] * rr * g1[0], c_[5] * rr * g1[1]), cvtpk(c_[6] * rr * g1[2], c_[7] * rr * g1[3])}; }
                    }
                    {
                        const float v_[4] = {BLO(cv.x), BHI(cv.x), BLO(cv.y), BHI(cv.y)};
                        const float rr = rsqrtf(wave_sum(v_[0] * v_[0] + v_[1] * v_[1] + v_[2] * v_[2] + v_[3] * v_[3]) * (1.f / KVL) + EPS);
                        const f32x4 g0 = *(const f32x4*)(g_kvlat + 4 * lane); const f32x4 o_ = {v_[0] * rr * g0[0], v_[1] * rr * g0[1], v_[2] * rr * g0[2], v_[3] * rr * g0[3]};
                        float* ockv = row < NP ? out + O_CKVP + (size_t)row * KVL : out + O_CKVS + (size_t)(row - NP) * KVL;
                        *(f32x4*)(ockv + 4 * lane) = o_; *(f32x4*)(CKVN + (size_t)row * KVL + 4 * lane) = o_;
                        *(u32x2_t*)(CKVNb + (size_t)row * KVL + 4 * lane) = (u32x2_t){cvtpk(o_[0], o_[1]), cvtpk(o_[2], o_[3])};
                    }
                    if (lane < 8) {
                        const float x1[4] = {BLO(p1.x), BHI(p1.x), BLO(p1.y), BHI(p1.y)}, x2[4] = {BLO(p2.x), BHI(p2.x), BLO(p2.y), BHI(p2.y)};
                        f32x4 o1, o2;
#pragma unroll
                        for (int e = 0; e < 4; ++e) { o1[e] = x1[e] * cb[e] - x2[e] * sb[e]; o2[e] = x1[e] * sb[e] + x2[e] * cb[e]; }
                        *(f32x4*)(KPER + (size_t)row * DROPE + 4 * lane) = o1; *(f32x4*)(KPER + (size_t)row * DROPE + 32 + 4 * lane) = o2;
                        float* okpe = row < NP ? out + O_KPEP + (size_t)row * DROPE : out + O_KPES + (size_t)(row - NP) * DROPE;
                        *(f32x4*)(okpe + 4 * lane) = o1; *(f32x4*)(okpe + 32 + 4 * lane) = o2;
                        *(u32x2_t*)(KPERb + (size_t)row * DROPE + 4 * lane) = (u32x2_t){cvtpk(o1[0], o1[1]), cvtpk(o1[2], o1[3])}; *(u32x2_t*)(KPERb + (size_t)row * DROPE + 32 + 4 * lane) = (u32x2_t){cvtpk(o2[0], o2[1]), cvtpk(o2[2], o2[3])};
                    }
                    q1 = q1n; q2 = q2n; k1 = k1n; k2 = k2n; cq8 = cq8n; cv = cvn; p1 = p1n; p2 = p2n; ca = can; sa = san; cb = cbn; sb = sbn; p = pn;
                }
#undef P2_LOAD
            }
            __syncthreads();
            if (prompt) {
#pragma unroll 2
                for (int i = 0; i < 8; ++i) { const int pc = tid + i * NTHREADS, f = pc >> 3, k8 = pc & 7;
                    const LAS bf16_t* c = Kt + (8 * k8) * KTP + f;
                    pg8::u32x4 o; o.x = (unsigned)c[0] | ((unsigned)c[KTP] << 16); o.y = (unsigned)c[2 * KTP] | ((unsigned)c[3 * KTP] << 16);
                    o.z = (unsigned)c[4 * KTP] | ((unsigned)c[5 * KTP] << 16); o.w = (unsigned)c[6 * KTP] | ((unsigned)c[7 * KTP] << 16);
                    *(pg8::u32x4*)(RKtT + (size_t)f * NP + row_base + 8 * k8) = o; }
            }
        }
    }
    if (IN(2)) {
        for (int i = bid * NTHREADS + tid; i < NB * NMEM * 256; i += G * NTHREADS) { MKb[i] = f2bf(out[O_MKP + i]);
            const int f = i / (NB * NMEM), r = i - f * (NB * NMEM); MVT[i] = f2bf(out[O_MVP + (size_t)r * 256 + f]); }
    }
    SEAM(2);
    if (IN(3)) { pg8::Gemm g{CQNb, WuqT, NT, 1536, QL, QL, QL}; pg8::StaticOrder S; S.init(NT, 1536, G, bid); pg8::EpiBf16S E{Qb, 1536};
        GEMM_PHASE(pg8::EpiBf16S, ldsb, g, S, E);
        __syncthreads();
        { pg8::Gemm g2{CKVNb, WukT, NP, 1024, KVL, KVL, KVL}; pg8::StaticOrder S2; S2.init(NP, 1024, G, bid); pg8::EpiBf16S E2{KN, 1024}; GEMM_PHASE(pg8::EpiBf16S, ldsb, g2, S2, E2); }
        __syncthreads();
        { pg8::Gemm g3{WuvT, CKVNb, 1024, NP, KVL, KVL, KVL}; pg8::StaticOrder S3; S3.init(1024, NP, G, bid); pg8::EpiBf16S E3{VT, NP}; GEMM_PHASE(pg8::EpiBf16S, ldsb, g3, S3, E3); }
        ret_state_phase(ldsb, RVT, RKtT, UT, bid, G); }
    SEAM(3);
    if (IN(4)) {
        for (int idx = bid * NTHREADS + tid; idx < NB * RH * 8192; idx += G * NTHREADS) {
            const int bh = idx >> 13, e = (idx & 8191) * 4; const float g128 = __expf(128.f * lg_gamma(bh & 3));
            f32x4 u[16];
#pragma unroll
            for (int c = 0; c < 16; ++c) u[c] = __builtin_nontemporal_load((const f32x4*)(UT + (size_t)(bh * 16 + c) * 32768 + e));
            f32x4 sp = {0.f, 0.f, 0.f, 0.f}, S = sp;
#pragma unroll
            for (int c = 0; c < 16; ++c) { *(u32x2_t*)(SPT + (size_t)(bh * 16 + c) * 32768 + e) = (u32x2_t){cvtpk(sp[0], sp[1]), cvtpk(sp[2], sp[3])}; S = sp + u[c]; sp = S * g128; }
            const int dv = e >> 7, dk = e & 127; float* o_ = out + O_RETP + (size_t)bh * 32768 + (size_t)dk * RDV + dv;
            o_[0] = S[0]; o_[RDV] = S[1]; o_[2 * RDV] = S[2]; o_[3 * RDV] = S[3];
        }
        {
            const int hd = lane >> 3, f4 = (lane & 7) * 4;
            u32x2_t x1, x2; f32x4 cb, sb;
#define P4_LOAD(r_, X1_, X2_, C_, S_) do { const bf16_t* q_ = Qb + (size_t)(r_) * 1536 + hd * DQH + DNOPE + f4; X1_ = *(const u32x2_t*)q_; X2_ = *(const u32x2_t*)(q_ + 32); \
            const int p_ = pos_index(r_); C_ = *(const f32x4*)(COSB + p_ * 32 + f4); S_ = *(const f32x4*)(SINB + p_ * 32 + f4); } while (0)
            int row = gw;
            if (row < NT) P4_LOAD(row, x1, x2, cb, sb);
            for (; row < NT; row += NGW) {
                u32x2_t x1n, x2n; f32x4 cbn, sbn; const int nr = row + NGW;
                if (nr < NT) P4_LOAD(nr, x1n, x2n, cbn, sbn);
                const float a0 = __builtin_bit_cast(float, x1.x << 16), a1 = __builtin_bit_cast(float, x1.x & 0xffff0000u), a2 = __builtin_bit_cast(float, x1.y << 16), a3 = __builtin_bit_cast(float, x1.y & 0xffff0000u);
                const float b0 = __builtin_bit_cast(float, x2.x << 16), b1 = __builtin_bit_cast(float, x2.x & 0xffff0000u), b2 = __builtin_bit_cast(float, x2.y << 16), b3 = __builtin_bit_cast(float, x2.y & 0xffff0000u);
                bf16_t* o_ = QPEb + (size_t)row * 512 + hd * DROPE + f4;
                *(u32x2_t*)o_ = (u32x2_t){cvtpk(a0 * cb[0] - b0 * sb[0], a1 * cb[1] - b1 * sb[1]), cvtpk(a2 * cb[2] - b2 * sb[2], a3 * cb[3] - b3 * sb[3])};
                *(u32x2_t*)(o_ + 32) = (u32x2_t){cvtpk(a0 * sb[0] + b0 * cb[0], a1 * sb[1] + b1 * cb[1]), cvtpk(a2 * sb[2] + b2 * cb[2], a3 * sb[3] + b3 * cb[3])};
                x1 = x1n; x2 = x2n; cb = cbn; sb = sbn;
            }
#undef P4_LOAD
        }
        for (int wt = gw; wt < MH * 16 * 2; wt += NGW) {
            const int lh = wt & 1, rb = (wt >> 1) & 15, head = wt >> 5; const int l31 = lane & 31, h8 = lane >> 5;
            f32x16 acc[4];
#pragma unroll
            for (int k_ = 0; k_ < 4; ++k_)
#pragma unroll
                for (int i = 0; i < 16; ++i) acc[k_][i] = 0.f;
            const bf16_t* ap = Qb + ((size_t)NP + 32 * rb + l31) * 1536 + head * DQH + 8 * h8;
            const bf16_t* bp = WukB + ((size_t)head * KVL + 128 * lh + l31) * DNOPE + 8 * h8;
#pragma unroll
            for (int s_ = 0; s_ < 8; ++s_) { const bf16x8 a = *(const bf16x8*)(ap + 16 * s_);
#pragma unroll
                for (int k_ = 0; k_ < 4; ++k_) { const bf16x8 b_ = *(const bf16x8*)(bp + (size_t)(32 * k_) * DNOPE + 16 * s_); acc[k_] = MFMA32(a, b_, acc[k_]); } }
#pragma unroll
            for (int k_ = 0; k_ < 4; ++k_)
#pragma unroll
                for (int i = 0; i < 16; ++i) QLATb[(size_t)(32 * rb + crow(i, h8)) * 2048 + head * KVL + 128 * lh + 32 * k_ + l31] = f2bf(acc[k_][i]);
        }
    }
    SEAM(4);
    if (IN(5)) {
        auto compute_units = [&]() __attribute__((always_inline)) {
        if (args.sub & 2) for (int it = bid; it < NB * MH * 4; it += G) {
            const int pr = __builtin_amdgcn_readfirstlane(it & 3), hh = __builtin_amdgcn_readfirstlane((it >> 2) & 7), b = __builtin_amdgcn_readfirstlane(it >> 5);
#pragma unroll 1
            for (int half = 0; half < 2; ++half) { const int qb = __builtin_amdgcn_readfirstlane(half ? pr : 7 - pr); const size_t row0 = (size_t)b * SEQ + qb * 256;
                SrcMlaP src{KN, KPERb, VT, Qb, QPEb, b, hh, row0};
                flash_unit<192, 128, true>(ldsb, src, qb * 256, 4 * (qb + 1), OMLAb + row0 * 1024 + hh * DVH, 1024, 0.07216878364870322f * 1.4426950408889634f); }
        }
        if (args.sub & 4) ret_out_phase(ldsb, RQt, RKt, RVT, SPT, ORET, bid, G);
        if (args.sub & 16) for (int it = bid; it < NB * XH * 8; it += G) {
            const int qb = __builtin_amdgcn_readfirstlane(it & 7), hh = __builtin_amdgcn_readfirstlane((it >> 3) & 3), b = __builtin_amdgcn_readfirstlane(it >> 5); const size_t row0 = (size_t)b * SEQ + qb * 256;
            SrcMemP src{MKb, MVT, Zb + C_XQ, b, hh, row0};
            flash_unit<64, 64, false>(ldsb, src, 0, 4, OXb + row0 * 256 + hh * XHD, 256, 0.125f * 1.4426950408889634f);
        }
        };
        const bool compute_first = ((bid >> 3) & 1) != 0;
        if (compute_first) compute_units();
        if (args.sub & 1) for (int it = bid; it < DB * MS_NSPLIT; it += G) { const int split = __builtin_amdgcn_readfirstlane(it % MS_NSPLIT), b = __builtin_amdgcn_readfirstlane(it / MS_NSPLIT);
            mla_sample_unit(ldsb, cache_ckv, cache_kpe, page_table, QLATb, QPEb, PO, PML, b, split, 0.07216878364870322f * 1.4426950408889634f); }
        if (args.sub & 8) for (int it = bid; it < DB * RH; it += G) {
            const int h = it & 3, b = it >> 2; const float lg = lg_gamma(h);
            const float* s0 = state_ret + (size_t)it * RDK * RDV;
            float* so = out + O_RETS + (size_t)it * RDK * RDV;
            LAS float* inner = lds;
            LAS float* qk = lds + 16;
            LAS float* vls = lds + 1040;
            LAS float* red = lds + 2064;
            f32x4 sv[16], vv[4];
#pragma unroll
            for (int r = 0; r < 16; ++r) sv[r] = __builtin_nontemporal_load((const f32x4*)(s0 + (size_t)(wave + 8 * r) * RDV + 4 * lane));
#pragma unroll
            for (int j = 0; j < DS; ++j) { const u32x2_t t_ = *(const u32x2_t*)(Zb + ((size_t)NP + b * DS + j) * ZLD + C_RV + h * RDV + 4 * lane); vv[j] = (f32x4){BLO(t_.x), BHI(t_.x), BLO(t_.y), BHI(t_.y)}; }
            __syncthreads();
            for (int i = tid; i < 1024; i += NTHREADS) { const int which = i >> 9, ti = (i >> 7) & 3, d = i & 127; const size_t row = (size_t)NP + b * DS + ti;
                qk[i] = which ? RK[row * 512 + h * RDK + d] : RQ[row * 512 + h * RDK + d]; }
            if (wave == 0) {
#pragma unroll
                for (int j = 0; j < DS; ++j) *(LAS f32x4*)(vls + j * 256 + 4 * lane) = vv[j]; }
            __syncthreads();
            for (int pr = wave; pr < 16; pr += NWAVES) { const int i = pr >> 2, j = pr & 3;
                float s_ = qk[i * 128 + lane] * qk[512 + j * 128 + lane] + qk[i * 128 + 64 + lane] * qk[512 + j * 128 + 64 + lane];
                s_ = wave_sum(s_);
                if (lane == 0) inner[pr] = (j <= i) ? s_ * __expf((float)(i - j) * lg) : 0.f; }
            const float g4 = __expf(4.f * lg), gk0 = __expf(3.f * lg), gk1 = __expf(2.f * lg), gk2 = __expf(lg);
            f32x4 po[4];
#pragma unroll
            for (int i = 0; i < 4; ++i) po[i] = (f32x4){0.f, 0.f, 0.f, 0.f};
#pragma unroll
            for (int r = 0; r < 16; ++r) { const int d = wave + 8 * r; const f32x4 sx = sv[r];
                f32x4 a = sx * g4 + (gk0 * qk[512 + d]) * vv[0] + (gk1 * qk[512 + 128 + d]) * vv[1] + (gk2 * qk[512 + 256 + d]) * vv[2] + qk[512 + 384 + d] * vv[3];
                __builtin_nontemporal_store(a, (f32x4*)(so + (size_t)d * RDV + 4 * lane));
#pragma unroll
                for (int i = 0; i < 4; ++i) po[i] += qk[i * 128 + d] * sx; }
#pragma unroll
            for (int i = 0; i < 4; ++i) *(LAS f32x4*)(red + (wave * 4 + i) * 256 + 4 * lane) = po[i];
            __syncthreads();
            {
                const int i = tid >> 7, e2 = (tid & 127) * 2;
                float o0 = 0.f, o1 = 0.f;
#pragma unroll
                for (int w_ = 0; w_ < NWAVES; ++w_) { o0 += red[(w_ * 4 + i) * 256 + e2]; o1 += red[(w_ * 4 + i) * 256 + e2 + 1]; }
                const float gi = __expf((float)(i + 1) * lg); o0 *= gi; o1 *= gi;
#pragma unroll
                for (int j = 0; j < DS; ++j) { const float w_ = inner[i * 4 + j]; o0 += w_ * vls[j * 256 + e2]; o1 += w_ * vls[j * 256 + e2 + 1]; }
                *(f32x2_t*)(ORET + ((size_t)NP + b * DS + i) * 1024 + h * RDV + e2) = (f32x2_t){o0, o1};
            }
        }
        if (args.sub & 32) for (int b = bid; b < DB; b += G) {
            LAS float* sc = lds;
            LAS float* red = lds + 4096;
            const float* kb_ = cache_mem_k + (size_t)b * NMEM * 256; const float* vb_ = cache_mem_v + (size_t)b * NMEM * 256;
            f32x4 qr[4];
#pragma unroll
            for (int q = 0; q < DS; ++q) { const u32x2_t t_ = *(const u32x2_t*)(Zb + ((size_t)NP + b * DS + q) * ZLD + C_XQ + 4 * lane); qr[q] = (f32x4){BLO(t_.x), BHI(t_.x), BLO(t_.y), BHI(t_.y)}; }
            __syncthreads();
#pragma unroll 8
            for (int kk = 0; kk < 32; ++kk) { const int key = 32 * wave + kk; const f32x4 kv = __builtin_nontemporal_load((const f32x4*)(kb_ + (size_t)key * 256 + 4 * lane));
                float pq[4];
#pragma unroll
                for (int q = 0; q < 4; ++q) { float a = kv[0] * qr[q][0] + kv[1] * qr[q][1] + kv[2] * qr[q][2] + kv[3] * qr[q][3];
                    a += __shfl_xor(a, 1); a += __shfl_xor(a, 2); a += __shfl_xor(a, 4); a += __shfl_xor(a, 8); pq[q] = a; }
                if ((lane & 15) == 0) {
#pragma unroll
                    for (int q = 0; q < 4; ++q) sc[(q * 4 + (lane >> 4)) * 256 + key] = pq[q] * (0.125f * 1.4426950408889634f); } }
            __syncthreads();
            for (int rr = wave * 2; rr < wave * 2 + 2; ++rr) {
                f32x4 v = *(LAS f32x4*)(sc + rr * 256 + 4 * lane);
                const float mx = wave_max(fmaxf(fmaxf(v[0], v[1]), fmaxf(v[2], v[3])));
#pragma unroll
                for (int e = 0; e < 4; ++e) v[e] = __builtin_amdgcn_exp2f(v[e] - mx);
                const float inv = 1.f / wave_sum(v[0] + v[1] + v[2] + v[3]);
                *(LAS f32x4*)(sc + rr * 256 + 4 * lane) = v * inv; }
            __syncthreads();
            f32x4 acc[4];
#pragma unroll
            for (int q = 0; q < 4; ++q) acc[q] = (f32x4){0.f, 0.f, 0.f, 0.f};
#pragma unroll 8
            for (int kk = 0; kk < 32; ++kk) { const int key = 32 * wave + kk; const f32x4 vv = __builtin_nontemporal_load((const f32x4*)(vb_ + (size_t)key * 256 + 4 * lane));
#pragma unroll
                for (int q = 0; q < 4; ++q) acc[q] += sc[(q * 4 + (lane >> 4)) * 256 + key] * vv; }
#pragma unroll
            for (int q = 0; q < 4; ++q) *(LAS f32x4*)(red + (wave * 4 + q) * 256 + 4 * lane) = acc[q];
            __syncthreads();
            { const int q = tid >> 7, e2 = (tid & 127) * 2; float o0 = 0.f, o1 = 0.f;
#pragma unroll
              for (int w_ = 0; w_ < NWAVES; ++w_) { o0 += red[(w_ * 4 + q) * 256 + e2]; o1 += red[(w_ * 4 + q) * 256 + e2 + 1]; }
              *(unsigned*)(OXb + ((size_t)NP + b * DS + q) * 256 + e2) = cvtpk(o0, o1); }
        }
            if (!compute_first) compute_units();
    }
    SEAM(5);
    if (IN(6)) {
        for (int bt = bid; bt < NS; bt += G) {
            const int b = bt >> 2;
            const int head = wave; const float c2 = 0.07216878364870322f * 1.4426950408889634f;
            LAS float* ol = lds + wave * KVL;
            { const int t = bt & 3;
                const int qi = t * 8 + head; const size_t qrow = (size_t)b * DS + t;
                float qv[5];
#pragma unroll
                for (int c = 0; c < 5; ++c) { const int d = lane + 64 * c; const bf16_t raw = d < KVL ? QLATb[qrow * 2048 + head * KVL + d] : QPEb[(NP + qrow) * 512 + head * DROPE + (d - KVL)];
                    qv[c] = __builtin_bit_cast(float, (unsigned)raw << 16); }
                float sc[DS]; float M = -INFINITY;
#pragma unroll
                for (int j = 0; j < DS; ++j) { const size_t krow = (size_t)NP + b * DS + j; float a = 0.f;
#pragma unroll
                    for (int c = 0; c < 5; ++c) { const int d = lane + 64 * c; a += qv[c] * (d < KVL ? CKVN[krow * KVL + d] : KPER[krow * DROPE + (d - KVL)]); }
                    a = wave_sum(a) * c2; sc[j] = (j <= t) ? a : -INFINITY; M = fmaxf(M, sc[j]); }
                float ms[MS_NSPLIT], ls[MS_NSPLIT];
#pragma unroll
                for (int sp = 0; sp < MS_NSPLIT; ++sp) { const int item = b * MS_NSPLIT + sp; ms[sp] = PML[(item * 32 + qi) * 2]; ls[sp] = PML[(item * 32 + qi) * 2 + 1]; M = fmaxf(M, ms[sp]); }
                float L = 0.f; float acc[4] = {0.f, 0.f, 0.f, 0.f};
#pragma unroll
                for (int sp = 0; sp < MS_NSPLIT; ++sp) { const int item = b * MS_NSPLIT + sp; const float wgt = __builtin_amdgcn_exp2f(ms[sp] - M); L += ls[sp] * wgt;
#pragma unroll
                    for (int c = 0; c < 4; ++c) acc[c] += wgt * PO[((size_t)item * 32 + qi) * KVL + lane + 64 * c]; }
#pragma unroll
                for (int j = 0; j < DS; ++j) { const float wgt = __builtin_amdgcn_exp2f(sc[j] - M); L += wgt; const size_t krow = (size_t)NP + b * DS + j;
#pragma unroll
                    for (int c = 0; c < 4; ++c) acc[c] += wgt * CKVN[krow * KVL + lane + 64 * c]; }
                const float inv = 1.f / L;
#pragma unroll
                for (int c = 0; c < 4; ++c) ol[lane + 64 * c] = acc[c] * inv;
                __syncthreads();
                float a0 = 0.f, a1 = 0.f; const float* wv = w_uv + (size_t)head * KVL * DVH;
#pragma unroll 8
                for (int l = 0; l < KVL; ++l) { const float x = ol[l]; a0 += x * wv[(size_t)l * DVH + lane]; a1 += x * wv[(size_t)l * DVH + 64 + lane]; }
                OMLAb[((size_t)NP + qrow) * 1024 + head * DVH + lane] = f2bf(a0); OMLAb[((size_t)NP + qrow) * 1024 + head * DVH + 64 + lane] = f2bf(a1);
                __syncthreads();
            }
        }
        {
            f32x4 a[4]; u32x2_t gz[4];
#define P6_LOAD(r_, A_, B_) do { _Pragma("unroll") for (int j_ = 0; j_ < 4; ++j_) { A_[j_] = *(const f32x4*)(ORET + (size_t)(r_) * 1024 + 4 * lane + 256 * j_); \
                                                                              B_[j_] = *(const u32x2_t*)(SRGb + (size_t)(r_) * 1024 + 4 * lane + 256 * j_); } } while (0)
            int row = gw;
            if (row < NT) P6_LOAD(row, a, gz);
            for (; row < NT; row += NGW) {
                f32x4 an[4]; u32x2_t gn[4]; const int nr = row + NGW;
                if (nr < NT) P6_LOAD(nr, an, gn);
#pragma unroll
                for (int j = 0; j < 4; ++j) {
                    const float ss = wave_sum(a[j][0] * a[j][0] + a[j][1] * a[j][1] + a[j][2] * a[j][2] + a[j][3] * a[j][3]);
                    const float r = rsqrtf(ss * (1.f / RDV) + EPS);
                    float o_[4];
#pragma unroll
                    for (int e = 0; e < 4; ++e) { const unsigned gw_ = e < 2 ? gz[j].x : gz[j].y; o_[e] = __builtin_bit_cast(float, (e & 1) ? (gw_ & 0xffff0000u) : (gw_ << 16)) * a[j][e] * r; }
                    *(u32x2_t*)(ORETNb + (size_t)row * 1024 + 4 * lane + 256 * j) = (u32x2_t){cvtpk(o_[0], o_[1]), cvtpk(o_[2], o_[3])};
                }
#pragma unroll
                for (int j = 0; j < 4; ++j) { a[j] = an[j]; gz[j] = gn[j]; }
            }
#undef P6_LOAD
        }
    }
    SEAM(6);
    if (IN(7)) {
        pg8::StaticOrder S; S.init(NP, 1024, G, bid);
        { pg8::Gemm g{ORETNb, WroT, NP, 1024, 1024, 1024, 1024}; pg8::EpiGate<0> E{SGb, T0b, T0b, 1024}; GEMM_PHASE(pg8::EpiGate<0>, ldsb, g, S, E); }
        __syncthreads();
        { pg8::Gemm g{OMLAb, WmoT, NP, 1024, 1024, 1024, 1024}; pg8::EpiGate<1> E{SGb + 1024, T0b, T1b, 1024}; GEMM_PHASE(pg8::EpiGate<1>, ldsb, g, S, E); }
        __syncthreads();
        { pg8::Gemm g{OXb, WxoT, NP, 1024, 256, 256, 256}; pg8::EpiGate<1> E{SGb + 2048, T1b, MIXb, 1024}; GEMM_PHASE(pg8::EpiGate<1>, ldsb, g, S, E); }
        __syncthreads();
        { pg8::Gemm g{ORETNb, WroT, NT, 1024, 256, 1024, 1024, 256}; pg8::SplitOrder SS{4, bid}; pg8::EpiPart E{PART}; GEMM_SPLIT(ldsb, g, SS, E); }
        __syncthreads();
        { pg8::Gemm g{OMLAb, WmoT, NT, 1024, 256, 1024, 1024, 256}; pg8::SplitOrder SS{4, (bid + 224) % G}; pg8::EpiPart E{PART + (size_t)4 * 512 * 1024}; GEMM_SPLIT(ldsb, g, SS, E); }
        __syncthreads();
        { pg8::Gemm g{OXb, WxoT, NT, 1024, 256, 256, 256, 256}; pg8::SplitOrder SS{1, (bid + 128) % G}; pg8::EpiPart E{PART + (size_t)8 * 512 * 1024}; GEMM_SPLIT(ldsb, g, SS, E); }
    }
    SEAM(7);
    if (IN(8)) {
        for (int i = bid * NTHREADS + tid; i < NS * 256; i += G * NTHREADS) { const int r = i >> 8, c4 = (i & 255) * 4; const size_t o_ = (size_t)r * 1024 + c4;
            f32x4 mix = {0.f, 0.f, 0.f, 0.f};
#pragma unroll
            for (int br = 0; br < 3; ++br) { f32x4 a = *(const f32x4*)(PART + (size_t)(br == 2 ? 8 : 4 * br) * (512 * 1024) + o_);
                if (br < 2) {
#pragma unroll
                    for (int k_ = 1; k_ < 4; ++k_) a += *(const f32x4*)(PART + (size_t)(4 * br + k_) * (512 * 1024) + o_); }
                const u32x2_t gq = *(const u32x2_t*)(SGb + (size_t)(NP + r) * 3072 + br * 1024 + c4);
                mix[0] += a[0] * __builtin_bit_cast(float, gq.x << 16); mix[1] += a[1] * __builtin_bit_cast(float, gq.x & 0xffff0000u);
                mix[2] += a[2] * __builtin_bit_cast(float, gq.y << 16); mix[3] += a[3] * __builtin_bit_cast(float, gq.y & 0xffff0000u); }
            *(u32x2_t*)(MIXb + (size_t)(NP + r) * 1024 + c4) = (u32x2_t){cvtpk(mix[0], mix[1]), cvtpk(mix[2], mix[3])}; }
    }
    SEAM(8);
    if (IN(9)) { pg8::Gemm g{MIXb, WoT, NP, 1024, 1024, 1024, 1024}; pg8::StaticOrder S; S.init(NP, 1024, G, bid); pg8::EpiF32S E{HP, 1024, 0, 0};
        GEMM_PHASE(pg8::EpiF32S, ldsb, g, S, E);
        __syncthreads();
        { pg8::Gemm g2{MIXb, WoT, NT, 1024, 256, 1024, 1024, 256}; pg8::SplitOrder SS{4, bid}; pg8::EpiPart E2{PART}; GEMM_SPLIT(ldsb, g2, SS, E2); } }
    SEAM(9);
    if (IN(10)) {
        f32x4 gp[4], gf[4], a[4], b[4];
#pragma unroll
        for (int j = 0; j < 4; ++j) { gp[j] = *(const f32x4*)(g_mix_post + 4 * lane + 256 * j); gf[j] = *(const f32x4*)(g_ffn_pre + 4 * lane + 256 * j); }
#define P10_LOAD(r_, A_, B_) do { const float* xr_ = (r_) < NP ? x_prompt + (size_t)(r_) * DM : x_sample + (size_t)((r_) - NP) * DM; \
        _Pragma("unroll") for (int j_ = 0; j_ < 4; ++j_) { B_[j_] = *(const f32x4*)(xr_ + 4 * lane + 256 * j_); \
            if ((r_) < NP) A_[j_] = *(const f32x4*)(HP + (size_t)(r_) * DM + 4 * lane + 256 * j_); \
            else { const float* p_ = PART + (size_t)((r_) - NP) * DM + 4 * lane + 256 * j_; A_[j_] = (*(const f32x4*)p_ + *(const f32x4*)(p_ + 512 * 1024)) + (*(const f32x4*)(p_ + 2 * 512 * 1024) + *(const f32x4*)(p_ + 3 * 512 * 1024)); } } } while (0)
        int row = gw;
        if (row < NT) P10_LOAD(row, a, b);
        for (; row < NT; row += NGW) {
            f32x4 an[4], bn[4]; const int nr = row + NGW;
            if (nr < NT) P10_LOAD(nr, an, bn);
            float ss = 0.f;
#pragma unroll
            for (int j = 0; j < 4; ++j) ss += a[j][0] * a[j][0] + a[j][1] * a[j][1] + a[j][2] * a[j][2] + a[j][3] * a[j][3];
            float r = rsqrtf(wave_sum(ss) * (1.f / DM) + EPS); ss = 0.f;
#pragma unroll
            for (int j = 0; j < 4; ++j) { a[j] = b[j] + a[j] * r * gp[j]; *(f32x4*)(H + (size_t)row * DM + 4 * lane + 256 * j) = a[j];
                ss += a[j][0] * a[j][0] + a[j][1] * a[j][1] + a[j][2] * a[j][2] + a[j][3] * a[j][3]; }
            r = rsqrtf(wave_sum(ss) * (1.f / DM) + EPS);
#pragma unroll
            for (int j = 0; j < 4; ++j) { const f32x4 f_ = a[j] * r * gf[j]; *(u32x2_t*)(Fb + (size_t)row * DM + 4 * lane + 256 * j) = (u32x2_t){cvtpk(f_[0], f_[1]), cvtpk(f_[2], f_[3])}; }
#pragma unroll
            for (int j = 0; j < 4; ++j) { a[j] = an[j]; b[j] = bn[j]; }
        }
#undef P10_LOAD
    }
    SEAM(10);
    if (IN(11)) {
        pg8::Gemm g{Fb, WguT, NT, 2 * DFF, 1024, 1024, 1024}; pg8::StaticOrder S; S.init(NT, 2 * DFF, G, bid); pg8::EpiSwiGLU E{ACTb, DFF};
        GEMM_PHASE(pg8::EpiSwiGLU, ldsb, g, S, E);
    }
    SEAM(11);
    if (IN(13)) { pg8::Gemm g{ACTb, WdT, NP, 1024, DFF, DFF, DFF}; pg8::StaticOrder S; S.init(NP, 1024, G, bid); pg8::EpiF32S E{FO, 1024, 0, 0};
        GEMM_PHASE(pg8::EpiF32S, ldsb, g, S, E);
        __syncthreads();
        { pg8::Gemm g2{ACTb, WdT, NT, 1024, 256, DFF, DFF, 256}; pg8::SplitOrder SS{11, bid}; pg8::EpiPart E2{PART}; GEMM_SPLIT(ldsb, g2, SS, E2); } }
    SEAM(13);
    if (IN(14)) {
        f32x4 gp[4], a[4], b[4];
#pragma unroll
        for (int j = 0; j < 4; ++j) gp[j] = *(const f32x4*)(g_ffn_post + 4 * lane + 256 * j);
#define P14_LOAD(r_, A_, B_) do { _Pragma("unroll") for (int j_ = 0; j_ < 4; ++j_) { B_[j_] = *(const f32x4*)(H + (size_t)(r_) * DM + 4 * lane + 256 * j_); \
            if ((r_) < NP) A_[j_] = *(const f32x4*)(FO + (size_t)(r_) * DM + 4 * lane + 256 * j_); \
            else { const float* p_ = PART + (size_t)((r_) - NP) * DM + 4 * lane + 256 * j_; f32x4 a_ = *(const f32x4*)p_; \
                _Pragma("unroll") for (int k_ = 1; k_ < 11; ++k_) a_ += *(const f32x4*)(p_ + (size_t)k_ * 512 * 1024); A_[j_] = a_; } } } while (0)
        int row = gw;
        if (row < NT) P14_LOAD(row, a, b);
        for (; row < NT; row += NGW) {
            f32x4 an[4], bn[4]; const int nr = row + NGW;
            if (nr < NT) P14_LOAD(nr, an, bn);
            float ss = 0.f;
#pragma unroll
            for (int j = 0; j < 4; ++j) ss += a[j][0] * a[j][0] + a[j][1] * a[j][1] + a[j][2] * a[j][2] + a[j][3] * a[j][3];
            const float r = rsqrtf(wave_sum(ss) * (1.f / DM) + EPS);
            float* y = row < NP ? out + O_YP + (size_t)row * DM : out + O_YS + (size_t)(row - NP) * DM;
#pragma unroll
            for (int j = 0; j < 4; ++j) *(f32x4*)(y + 4 * lane + 256 * j) = b[j] + a[j] * r * gp[j];
#pragma unroll
            for (int j = 0; j < 4; ++j) { a[j] = an[j]; b[j] = bn[j]; }
        }
#undef P14_LOAD
    }
#undef IN
#undef SEAM
}
#undef x_prompt
#undef x_sample
#undef mem_prompt
#undef cache_ckv
#undef cache_kpe
#undef page_table
#undef state_ret
#undef cache_mem_k
#undef cache_mem_v
#undef g_mix_pre
#undef g_mix_post
#undef g_ffn_pre
#undef g_ffn_post
#undef g_mem
#undef g_qlat
#undef g_kvlat
#undef w_in
#undef w_uq
#undef w_uk
#undef w_uv
#undef w_mem_k
#undef w_mem_v
#undef w_ret_o
#undef w_mla_o
#undef w_x_o
#undef w_out
#undef w_gate
#undef w_up
#undef w_down
#undef COSA
#undef SINA
#undef COSB
#undef SINB
#undef U
#undef MN
#undef Zb
#undef RQ
#undef RK
#undef CQN
#undef CKVN
#undef KPER
#undef Q
#undef QLAT
#undef QPE
#undef ORET
#undef OLAT
#undef OX
#undef OMLA
#undef ORETN
#undef ARET
#undef AMLA
#undef AX
#undef MIX
#undef HP
#undef H
#undef F
#undef GU
#undef FO
#undef WinT
#undef WmkvT
#undef WuqT
#undef WroT
#undef WmoT
#undef WxoT
#undef WoT
#undef WguT
#undef WdT
#undef Ub
#undef MNb
#undef CQNb
#undef ORETNb
#undef OMLAb
#undef OXb
#undef MIXb
#undef Fb
#undef ACTb
#undef WukT
#undef WuvT
#undef CKVNb
#undef KPERb
#undef XQb
#undef MKb
#undef MVT
#undef KN
#undef VT
#undef Qb
#undef RQt
#undef RKt
#undef RKtT
#undef RVT
#undef UT
#undef SPT
#undef QPEb
#undef WukB
#undef PART
#undef SGb
#undef SRGb
#undef T0b
#undef T1b
#undef QLATb
#undef PO
#undef PML
constexpr int N_PHASES = 15;
}

extern "C" void kernel_launch(void* const* d_in, const int* in_sizes, int n_in, void* d_out, int out_size, void* d_ws, size_t ws_size, hipStream_t stream) {
    static int grid = 0;
    if (grid == 0) {
        if (n_in != 29 || (size_t)out_size != O_END || ws_size < WS_END) { fprintf(stderr, "kernel_launch: unexpected shapes: n_in %d out %d ws %zu (need %zu)\n", n_in, out_size, ws_size, (size_t)WS_END); grid = -1; return; }
        int dev = 0, cus = 0, per_cu = 0;
        if (hipGetDevice(&dev) != hipSuccess || hipDeviceGetAttribute(&cus, hipDeviceAttributeMultiprocessorCount, dev) != hipSuccess) { grid = -1; return; }
        if (hipFuncSetAttribute((const void*)fwd_kernel, hipFuncAttributeMaxDynamicSharedMemorySize, LDS_BYTES) != hipSuccess) { fprintf(stderr, "kernel_launch: hipFuncSetAttribute failed\n"); grid = -1; return; }
        if (hipOccupancyMaxActiveBlocksPerMultiprocessor(&per_cu, (const void*)fwd_kernel, NTHREADS, LDS_BYTES) != hipSuccess || per_cu < 1) { fprintf(stderr, "kernel_launch: occupancy query says %d\n", per_cu); per_cu = 1; }
        (void)hipGetLastError();
        grid = cus;
    }
    if (grid < 0) return;
    (void)hipMemsetAsync((char*)d_ws + WS_CTL, 0, CTL_BYTES, stream);
    Args a{};
    for (int i = 0; i < 29; ++i) a.in[i] = (const float*)d_in[i];
    a.out = (float*)d_out; a.ws = (unsigned char*)d_ws;
#if MK_ONE_LAUNCH
    a.ph_lo = 0; a.ph_hi = N_PHASES; a.sub = 0xff;
    hipLaunchKernelGGL(fwd_kernel, dim3(grid), dim3(NTHREADS), LDS_BYTES, stream, a);
#if PROBE_DUP >= 0
    a.ph_lo = PROBE_DUP; a.ph_hi = PROBE_DUP + 1; a.sub = PROBE_SUB;
    hipLaunchKernelGGL(fwd_kernel, dim3(grid), dim3(NTHREADS), LDS_BYTES, stream, a);
#endif
#else
    a.sub = 0xff; for (int p = 0; p < N_PHASES; ++p) { a.ph_lo = p; a.ph_hi = p + 1; hipLaunchKernelGGL(fwd_kernel, dim3(grid), dim3(NTHREADS), LDS_BYTES, stream, a); }
#endif
}
```

```cpp
#include <hip/hip_runtime.h>
#include <cstdio>
#include <cstdint>

#ifndef PROBE_DUP
#define PROBE_DUP -1
#endif
#ifndef PROBE_SUB
#define PROBE_SUB 0xff
#endif
#ifndef MK_ONE_LAUNCH
#define MK_ONE_LAUNCH 1
#endif

#define LAS __attribute__((address_space(3)))
#define GAS __attribute__((address_space(1)))
#define DI __device__ __forceinline__
typedef float f32x4 __attribute__((ext_vector_type(4)));
typedef __bf16 bf16x2_t __attribute__((ext_vector_type(2)));
typedef float f32x2_t __attribute__((ext_vector_type(2)));
DI unsigned cvtpk(float lo, float hi) { f32x2_t v = {lo, hi}; bf16x2_t b = __builtin_convertvector(v, bf16x2_t); return __builtin_bit_cast(unsigned, b); }

namespace {
constexpr int DM = 1024, NB = 8, SEQ = 2048, NP = NB * SEQ, DB = 128, DS = 4, NS = DB * DS, NT = NP + NS;
constexpr int PAST = 8192, PAGE = 128, NPAGES = PAST / PAGE;
constexpr int RH = 4, RDK = 128, RDV = 256;
constexpr int MH = 8, QL = 384, KVL = 256, DNOPE = 128, DROPE = 64, DVH = 128, DQH = DNOPE + DROPE;
constexpr int NMEM = 256, XH = 4, XHD = 64;
constexpr int DFF = 2816, DIN = 7104, ZLD = 7168;
constexpr int C_RQ = 0, C_RK = 512, C_RV = 1024, C_RG = 2048, C_CQ = 3072, C_CKV = 3456, C_KPE = 3712, C_XQ = 3776, C_G = 4032;
constexpr float EPS = 1e-6f;
constexpr int NPOS = SEQ + DS;
constexpr int NTHREADS = 512, NWAVES = 8;
constexpr int LDS_BYTES = 147456;
constexpr int MISC_OFF = 147456 - 256;

constexpr size_t O_YP = 0, O_YS = O_YP + (size_t)NP * DM, O_CKVP = O_YS + (size_t)NS * DM, O_KPEP = O_CKVP + (size_t)NP * KVL,
                 O_CKVS = O_KPEP + (size_t)NP * DROPE, O_KPES = O_CKVS + (size_t)NS * KVL, O_RETP = O_KPES + (size_t)NS * DROPE,
                 O_RETS = O_RETP + (size_t)NB * RH * RDK * RDV, O_MKP = O_RETS + (size_t)DB * RH * RDK * RDV, O_MVP = O_MKP + (size_t)NB * NMEM * 256,
                 O_END = O_MVP + (size_t)NB * NMEM * 256;

constexpr size_t al256(size_t x) { return (x + 255) & ~(size_t)255; }
constexpr size_t WS_CTL = 0, CTL_BYTES = 1u << 20;
constexpr size_t WS_COSA = WS_CTL + CTL_BYTES;
constexpr size_t WS_SINA = WS_COSA + al256((size_t)NPOS * 64 * 4);
constexpr size_t WS_COSB = WS_SINA + al256((size_t)NPOS * 64 * 4);
constexpr size_t WS_SINB = WS_COSB + al256((size_t)NPOS * 32 * 4);
constexpr size_t WS_U = WS_SINB + al256((size_t)NPOS * 32 * 4);
constexpr size_t WS_MN = WS_U + (size_t)NT * DM * 4;
constexpr size_t WS_Z = WS_MN + (size_t)NB * NMEM * DM * 4;
constexpr size_t WS_RQ = WS_Z + (size_t)NT * ZLD * 4;
constexpr size_t WS_RK = WS_RQ + (size_t)NT * 512 * 4;
constexpr size_t WS_CQN = WS_RK + (size_t)NT * 512 * 4;
constexpr size_t WS_CKVN = WS_CQN + (size_t)NT * QL * 4;
constexpr size_t WS_KPER = WS_CKVN + (size_t)NT * KVL * 4;
constexpr size_t WS_Q = WS_KPER + (size_t)NT * DROPE * 4;
constexpr size_t WS_QLAT = WS_Q + (size_t)NT * 1536 * 4;
constexpr size_t WS_QPE = WS_QLAT + (size_t)NT * 2048 * 4;
constexpr size_t WS_ORET = WS_QPE + (size_t)NT * 512 * 4;
constexpr size_t WS_OLAT = WS_ORET + (size_t)NT * 1024 * 4;
constexpr size_t WS_OX = WS_OLAT + (size_t)NT * 2048 * 4;
constexpr size_t WS_OMLA = WS_OX + (size_t)NT * 256 * 4;
constexpr size_t WS_ORETN = WS_OMLA + (size_t)NT * 1024 * 4;
constexpr size_t WS_ARET = WS_ORETN + (size_t)NT * 1024 * 4;
constexpr size_t WS_AMLA = WS_ARET + (size_t)NT * 1024 * 4;
constexpr size_t WS_AX = WS_AMLA + (size_t)NT * 1024 * 4;
constexpr size_t WS_MIX = WS_AX + (size_t)NT * 1024 * 4;
constexpr size_t WS_HP = WS_MIX + (size_t)NT * 1024 * 4;
constexpr size_t WS_H = WS_HP + (size_t)NT * 1024 * 4;
constexpr size_t WS_F = WS_H + (size_t)NT * 1024 * 4;
constexpr size_t WS_GG = WS_F + (size_t)NT * 1024 * 4;
constexpr size_t WS_UP = WS_GG + (size_t)NT * DFF * 4;
constexpr size_t WS_ACT = WS_UP + (size_t)NT * DFF * 4;
constexpr size_t WS_FO = WS_ACT + (size_t)NT * DFF * 4;
constexpr size_t WS_F32_END = WS_FO + (size_t)NT * 1024 * 4;
constexpr size_t WS_WIN_T = al256(WS_F32_END);
constexpr size_t WS_WMKV_T = WS_WIN_T + (size_t)ZLD * 1024 * 2;
constexpr size_t WS_WUQ_T = WS_WMKV_T + (size_t)512 * 1024 * 2;
constexpr size_t WS_WRO_T = WS_WUQ_T + (size_t)1536 * 384 * 2;
constexpr size_t WS_WMO_T = WS_WRO_T + (size_t)1024 * 1024 * 2;
constexpr size_t WS_WXO_T = WS_WMO_T + (size_t)1024 * 1024 * 2;
constexpr size_t WS_WO_T = WS_WXO_T + (size_t)1024 * 256 * 2;
constexpr size_t WS_WGU_T = WS_WO_T + (size_t)1024 * 1024 * 2;
constexpr size_t WS_WD_T = WS_WGU_T + (size_t)5632 * 1024 * 2;
constexpr size_t WS_UB = WS_WD_T + (size_t)1024 * 2816 * 2;
constexpr size_t WS_MNB = WS_UB + (size_t)NT * 1024 * 2;
constexpr size_t WS_CQNB = WS_MNB + (size_t)2048 * 1024 * 2;
constexpr size_t WS_ORETNB = WS_CQNB + (size_t)NT * 384 * 2;
constexpr size_t WS_OMLAB = WS_ORETNB + (size_t)NT * 1024 * 2;
constexpr size_t WS_OXB = WS_OMLAB + (size_t)NT * 1024 * 2;
constexpr size_t WS_MIXB = WS_OXB + (size_t)NT * 256 * 2;
constexpr size_t WS_FB = WS_MIXB + (size_t)NT * 1024 * 2;
constexpr size_t WS_ACTB = WS_FB + (size_t)NT * 1024 * 2;
constexpr size_t WS_WUK_T = WS_ACTB + (size_t)NT * 2816 * 2;
constexpr size_t WS_WUV_T = WS_WUK_T + (size_t)1024 * 256 * 2;
constexpr size_t WS_CKVNB = WS_WUV_T + (size_t)1024 * 256 * 2;
constexpr size_t WS_KPERB = WS_CKVNB + (size_t)NT * 256 * 2;
constexpr size_t WS_XQB = WS_KPERB + (size_t)NT * 64 * 2;
constexpr size_t WS_MKB = WS_XQB + (size_t)NT * 256 * 2;
constexpr size_t WS_MVT = WS_MKB + (size_t)2048 * 256 * 2;
constexpr size_t WS_KN = WS_MVT + (size_t)2048 * 256 * 2;
constexpr size_t WS_VT = WS_KN + (size_t)NP * 1024 * 2;
constexpr size_t WS_QB = WS_VT + (size_t)NP * 1024 * 2;
constexpr size_t WS_RQT = WS_QB + (size_t)NT * 1536 * 2;
constexpr size_t WS_RKT = WS_RQT + (size_t)NP * 512 * 2;
constexpr size_t WS_RKTT = WS_RKT + (size_t)NP * 512 * 2;
constexpr size_t WS_RVT = WS_RKTT + (size_t)NP * 512 * 2;
constexpr size_t WS_UT = WS_RVT + (size_t)NT * 1024 * 2;
constexpr size_t WS_SPT = WS_UT + (size_t)512 * 32768 * 4;
constexpr size_t WS_QLATB = WS_SPT + (size_t)512 * 32768 * 2;
constexpr size_t WS_PO = WS_QLATB + (size_t)NS * 2048 * 2;
constexpr size_t WS_PML = WS_PO + (size_t)DB * 2 * 32 * 256 * 4;
constexpr size_t WS_PART = al256(WS_PML + (size_t)DB * 2 * 32 * 2 * 4);
constexpr size_t WS_QPEB_ = WS_PART + (size_t)11 * 512 * 1024 * 4;
constexpr size_t WS_QPEB = al256(WS_QPEB_ + 0 * WS_PML + (size_t)DB * 2 * 32 * 2 * 4);
constexpr size_t WS_SGB = WS_QPEB + (size_t)NT * 512 * 2;
constexpr size_t WS_SRGB = WS_SGB + (size_t)NT * 3072 * 2;
constexpr size_t WS_T0B = WS_SRGB + (size_t)NT * 1024 * 2;
constexpr size_t WS_T1B = WS_T0B + (size_t)NT * 1024 * 2;
constexpr size_t WS_WUKB = WS_T1B + (size_t)NT * 1024 * 2;
constexpr size_t WS_END = WS_WUKB + (size_t)8 * 256 * 128 * 2;

static_assert(WS_OMLAB == WS_ORETNB + (size_t)NT * 1024 * 2 && WS_OXB == WS_OMLAB + (size_t)NT * 1024 * 2 && WS_MIXB == WS_OXB + (size_t)NT * 256 * 2, "CATb = [o_ret_n | o_mla | o_x] rows of 2304");
static_assert(WS_WMO_T == WS_WRO_T + (size_t)1024 * 1024 * 2 && WS_WXO_T == WS_WMO_T + (size_t)1024 * 1024 * 2 && WS_WO_T == WS_WXO_T + (size_t)1024 * 256 * 2, "WcatT = [w_ret_o | w_mla_o | w_x_o]^T rows of 2304");
constexpr int CATLD = 2304;
constexpr int CW_BAR = 4096;

#define XB_TMO      128
#define XB_XCNT(j)  (256  + 64 * (j))
#define XB_XSUB(j)  (1280 + 64 * (j))
#define XB_XGEN(j)  (2304 + 64 * (j))
#define XB_TOP      3328
#define XB_TOPGEN   3392
#define XCD_BAR_WORDS 3456
#define XB_SPIN_CAP (1u << 25)

DI unsigned xb_ld(unsigned* p)              { return __hip_atomic_load(p, __ATOMIC_RELAXED, __HIP_MEMORY_SCOPE_AGENT); }
DI unsigned xb_add(unsigned* p, unsigned v) { return __hip_atomic_fetch_add(p, v, __ATOMIC_RELAXED, __HIP_MEMORY_SCOPE_AGENT); }
DI unsigned xb_xcc_id() { return (unsigned)__builtin_amdgcn_s_getreg((3 << 11) | 20) & 0xFu; }
#define XB_SPIN(cond, bar) do { unsigned _sp = 0; while (cond) { __builtin_amdgcn_s_sleep(1); \
    if ((++_sp & 255u) == 0u) { if (xb_ld(&(bar)[XB_TMO])) break; if (_sp > XB_SPIN_CAP) { atomicAdd(&(bar)[XB_TMO], 1u); break; } } } } while (0)

struct XcdBarrier { unsigned* bar; unsigned x; volatile LAS unsigned* st; };

DI XcdBarrier xcd_barrier_post(unsigned* bar, volatile LAS unsigned* st) {
    XcdBarrier b; b.bar = bar; b.x = xb_xcc_id(); b.st = st;
    if (threadIdx.x == 0) (void)xb_add(&bar[XB_XCNT(b.x)], 1u);
    return b;
}
DI void xcd_barrier_complete(unsigned* bar, unsigned x, unsigned& nloc, unsigned& nx) {
    const unsigned G = gridDim.x * gridDim.y * gridDim.z;
    unsigned sum, cnt, mine, sp = 0u;
    for (;;) {
        sum = 0u; cnt = 0u; mine = 0u;
#pragma unroll
        for (unsigned j = 0; j < 16; ++j) { const unsigned c = xb_ld(&bar[XB_XCNT(j)]); sum += c; cnt += (c > 0u) ? 1u : 0u; mine = (j == x) ? c : mine; }
        if (sum == G) break;
        __builtin_amdgcn_s_sleep(1);
        if ((++sp & 255u) == 0u) { if (xb_ld(&bar[XB_TMO])) break; if (sp > XB_SPIN_CAP) { atomicAdd(&bar[XB_TMO], 1u); break; } }
    }
    nloc = mine > 0u ? mine : 1u; nx = cnt > 0u ? cnt : 1u;
}
DI void xcd_barrier(const XcdBarrier& b) {
    asm volatile("s_waitcnt vmcnt(0)" ::: "memory");
    __syncthreads();
    if (threadIdx.x == 0) {
        unsigned* bar = b.bar;
        __builtin_amdgcn_s_waitcnt(0);
        unsigned nloc = b.st[0], nx = b.st[1];
        if (nloc == 0u) { xcd_barrier_complete(bar, b.x, nloc, nx); b.st[0] = nloc; b.st[1] = nx; }
        const unsigned old = xb_add(&bar[XB_XSUB(b.x)], 1u);
        const unsigned gen = old / nloc;
        if (old + 1u == (gen + 1u) * nloc) {
            __builtin_amdgcn_fence(__ATOMIC_RELEASE, "agent");
            asm volatile("s_waitcnt vmcnt(0)" ::: "memory");
            const unsigned og = xb_add(&bar[XB_TOP], 1u);
            const unsigned tg = og / nx;
            if (og + 1u == (tg + 1u) * nx) xb_add(&bar[XB_TOPGEN], 1u);
            else XB_SPIN(xb_ld(&bar[XB_TOPGEN]) == tg, bar);
            __builtin_amdgcn_fence(__ATOMIC_ACQUIRE, "agent");
            xb_add(&bar[XB_XGEN(b.x)], 1u);
            asm volatile("s_waitcnt vmcnt(0)" ::: "memory");
        } else {
            XB_SPIN(xb_ld(&bar[XB_XGEN(b.x)]) == gen, bar);
            __builtin_amdgcn_fence(__ATOMIC_ACQUIRE, "agent");
            asm volatile("s_waitcnt vmcnt(0)" ::: "memory");
        }
    }
    __syncthreads();
}

DI float wave_sum(float v) {
#pragma unroll
    for (int o = 1; o < 64; o <<= 1) v += __shfl_xor(v, o);
    return v;
}
DI float wave_max(float v) {
#pragma unroll
    for (int o = 1; o < 64; o <<= 1) v = fmaxf(v, __shfl_xor(v, o));
    return v;
}
DI float sigmoidf_(float x) { return 1.f / (1.f + expf(-x)); }
DI float siluf_(float x) { return x / (1.f + expf(-x)); }
DI f32x4 bf4_to_f32(unsigned lo, unsigned hi) { return (f32x4){__builtin_bit_cast(float, lo << 16), __builtin_bit_cast(float, lo & 0xffff0000u), __builtin_bit_cast(float, hi << 16), __builtin_bit_cast(float, hi & 0xffff0000u)}; }
DI int pos_index(int row) { return row < NP ? (row & (SEQ - 1)) : SEQ + ((row - NP) & (DS - 1)); }
DI float lg_gamma(int h) { return h == 0 ? -0.03174869831458027f : h == 1 ? -0.015748356968139112f : h == 2 ? -0.007843177461025892f : -0.003913899321136329f; }


namespace pg8 {
typedef unsigned short bf16_t;
typedef short bf16x8 __attribute__((ext_vector_type(8)));
typedef unsigned u32x4 __attribute__((ext_vector_type(4)));
typedef unsigned u32x2 __attribute__((ext_vector_type(2)));
constexpr int BM = 256, BK = 64, HALF = 128, HTB = HALF * BK * 2, STAGE_BYTES = 8 * HTB, NXCD = 8, WGM = 8;
__host__ __device__ __forceinline__ int lds_byte(int r, int c) { const int st = (r >> 4) * 2 + (c >> 5), rr = r & 15, cc = c & 31, ob = rr * 64 + cc * 2; return st * 1024 + (ob ^ (((ob >> 9) & 1) << 5)); }
__host__ __device__ __forceinline__ void stage_rc(int b, int& R, int& C) { const int st = b / 1024, sb = b % 1024, swz = sb ^ (((sb >> 9) & 1) << 5); R = (st >> 1) * 16 + swz / 64; C = (st & 1) * 32 + (swz % 64) / 2; }
__host__ __device__ __forceinline__ int perm32(int rho) { const int n = rho >> 4, i = rho & 15; return 8 * (i >> 2) + 4 * n + (i & 3); }
struct Unit { int pm, pn, ks; };
struct Gemm { const bf16_t* A; const bf16_t* Bt; int M, N, K, lda, ldb, ksl; };
struct StaticOrder {
    int nM, nN, nwg, G, c;
    __host__ __device__ void init(int M, int N, int G_, int c_) { nM = M / BM; nN = N / BM; nwg = nM * nN; G = G_; c = c_; }
    __host__ __device__ bool next(int i, Unit& u) const {
        const long L = (long)i * G + c; if (L >= nwg) return false;
        int wgid = (int)L; { const int q = nwg / NXCD, r = nwg % NXCD, xcd = wgid % NXCD, off = wgid / NXCD; wgid = (xcd < r ? xcd * (q + 1) : r * (q + 1) + (xcd - r) * q) + off; }
        const int nig = WGM * nN, gid = wgid / nig, fm = gid * WGM, gsz = (nM - fm) < WGM ? (nM - fm) : WGM;
        u.pm = fm + ((wgid % nig) % gsz); u.pn = (wgid % nig) / gsz; u.ks = 0; return true;
    }
    __device__ __forceinline__ void a_ready(const Unit&) const {}
    __device__ __forceinline__ void done(const Unit&) const {}
};
__device__ __forceinline__ unsigned cvt_pk_bf16(float lo, float hi) { return cvtpk(lo, hi); }
struct SplitOrder {
    int KS, c;
    __host__ __device__ bool next(int i, Unit& u) const { if (i != 0 || c >= 8 * KS) return false; const int tile = c / KS; u.ks = c % KS; u.pm = 64 + (tile >> 2); u.pn = tile & 3; return true; }
    __device__ __forceinline__ void a_ready(const Unit&) const {}
    __device__ __forceinline__ void done(const Unit&) const {}
};
struct EpiPart {
    static constexpr bool PERM = false, AFTER_DRAIN = false, HAS_MID = false;
    float* C;
    __device__ __forceinline__ void operator()(const f32x4 (&acc)[2][2][4][2], const Unit& u, int wr, int wc, int fr, int fq) const {
        const int row0 = (u.pm - 64) * BM + wr * 64 + fr, col0 = u.pn * BM + wc * 32 + 4 * fq; float* base = C + (size_t)u.ks * (512 * 1024);
#pragma unroll
        for (int ai = 0; ai < 2; ++ai)
#pragma unroll
            for (int m = 0; m < 4; ++m) { float* rowp = base + (size_t)(row0 + ai * HALF + m * 16) * 1024 + col0;
#pragma unroll
                for (int bj = 0; bj < 2; ++bj)
#pragma unroll
                    for (int n = 0; n < 2; ++n) *(f32x4*)(rowp + bj * HALF + n * 16) = acc[ai][bj][m][n]; }
    }
};
struct P1Order {
    StaticOrder so;
    __host__ __device__ void init(int G_, int c_) { so.init(64 * 256, 24 * 256, G_, c_); }
    __host__ __device__ bool next(int i, Unit& u) const {
        const long L = (long)i * so.G + so.c;
        if (L < 1536) { so.next(i, u); if (u.pn >= 4) u.pn += 4; return true; }
        u.ks = 0;
        if (L < 1536 + 56) { const int idx = (int)L - 1536; u.pm = 64 + idx / 28; u.pn = idx % 28; return true; }
        if (L < 1536 + 56 + 16) { const int idx = (int)L - 1592; u.pm = 66 + idx / 2; u.pn = 28 + idx % 2; return true; }
        return false;
    }
    __device__ __forceinline__ void a_ready(const Unit&) const {}
    __device__ __forceinline__ void done(const Unit&) const {}
};
struct EpiP1 {
    static constexpr bool PERM = true, AFTER_DRAIN = false, HAS_MID = false;
    bf16_t* Zp; int ldz; float* mk; float* mv; bf16_t* srg; bf16_t* sg; int c_rg, c_g;
    __device__ __forceinline__ void operator()(const f32x4 (&acc)[2][2][4][2], const Unit& u, int wr, int wc, int fr, int fq) const {
        if (u.pm >= 66) {
            float* base = (u.pn == 28) ? mk : mv; const int row0 = (u.pm - 66) * BM + wr * 64 + fr, col0 = wc * 32 + 8 * fq;
#pragma unroll
            for (int ai = 0; ai < 2; ++ai)
#pragma unroll
                for (int m = 0; m < 4; ++m) { float* rowp = base + (size_t)(row0 + ai * HALF + m * 16) * 256 + col0;
#pragma unroll
                    for (int bj = 0; bj < 2; ++bj) { *(f32x4*)(rowp + bj * HALF) = acc[ai][bj][m][0]; *(f32x4*)(rowp + bj * HALF + 4) = acc[ai][bj][m][1]; } }
            return;
        }
        const int row0 = u.pm * BM + wr * 64 + fr, col0 = u.pn * BM + wc * 32 + 8 * fq;
#pragma unroll
        for (int bj = 0; bj < 2; ++bj) { const int c = col0 + bj * HALF;
            if (c >= c_g + 3072) continue;
            const int kind = c >= c_g ? 2 : (c >= c_rg && c < c_rg + 1024) ? 1 : 0;
            bf16_t* dst = kind == 2 ? sg + (c - c_g) : kind == 1 ? srg + (c - c_rg) : Zp + c; const int ld = kind == 2 ? 3072 : kind == 1 ? 1024 : ldz;
#pragma unroll
            for (int ai = 0; ai < 2; ++ai)
#pragma unroll
                for (int m = 0; m < 4; ++m) { f32x4 v0 = acc[ai][bj][m][0], v1 = acc[ai][bj][m][1];
                    if (kind) {
#pragma unroll
                        for (int e = 0; e < 4; ++e) { const float s0 = 1.f / (1.f + __expf(-v0[e])), s1 = 1.f / (1.f + __expf(-v1[e])); v0[e] = kind == 2 ? s0 : v0[e] * s0; v1[e] = kind == 2 ? s1 : v1[e] * s1; } }
                    u32x4 w; w.x = cvt_pk_bf16(v0[0], v0[1]); w.y = cvt_pk_bf16(v0[2], v0[3]); w.z = cvt_pk_bf16(v1[0], v1[1]); w.w = cvt_pk_bf16(v1[2], v1[3]);
                    *(u32x4*)(dst + (size_t)(row0 + ai * HALF + m * 16) * ld) = w; } }
    }
};
struct EpiF32S {
    static constexpr bool PERM = false, AFTER_DRAIN = false, HAS_MID = false;
    float* C; int ldc; int split_tiles; size_t split_stride;
    __device__ __forceinline__ void operator()(const f32x4 (&acc)[2][2][4][2], const Unit& u, int wr, int wc, int fr, int fq) const {
        int pn = u.pn; float* base = C; if (split_tiles) { const int t = pn / split_tiles; base += (size_t)t * split_stride; pn -= t * split_tiles; }
        const int row0 = u.pm * BM + wr * 64 + fr, col0 = pn * BM + wc * 32 + 4 * fq;
#pragma unroll
        for (int ai = 0; ai < 2; ++ai)
#pragma unroll
            for (int m = 0; m < 4; ++m) { float* rowp = base + (size_t)(row0 + ai * HALF + m * 16) * ldc + col0;
#pragma unroll
                for (int bj = 0; bj < 2; ++bj)
#pragma unroll
                    for (int n = 0; n < 2; ++n) *(f32x4*)(rowp + bj * HALF + n * 16) = acc[ai][bj][m][n]; }
    }
};
struct EpiBf16S {
    static constexpr bool PERM = true, AFTER_DRAIN = false, HAS_MID = false;
    bf16_t* O; int ldc;
    __device__ __forceinline__ void operator()(const f32x4 (&acc)[2][2][4][2], const Unit& u, int wr, int wc, int fr, int fq) const {
        const int row0 = u.pm * BM + wr * 64 + fr, col0 = u.pn * BM + wc * 32 + 8 * fq;
#pragma unroll
        for (int ai = 0; ai < 2; ++ai)
#pragma unroll
            for (int m = 0; m < 4; ++m) { bf16_t* rowp = O + (size_t)(row0 + ai * HALF + m * 16) * ldc + col0;
#pragma unroll
                for (int bj = 0; bj < 2; ++bj) { const f32x4 v0 = acc[ai][bj][m][0], v1 = acc[ai][bj][m][1];
                    u32x4 w; w.x = cvt_pk_bf16(v0[0], v0[1]); w.y = cvt_pk_bf16(v0[2], v0[3]); w.z = cvt_pk_bf16(v1[0], v1[1]); w.w = cvt_pk_bf16(v1[2], v1[3]);
                    *(u32x4*)(rowp + bj * HALF) = w; } }
    }
};
struct EpiSwiGLU {
    static constexpr bool PERM = true, AFTER_DRAIN = false, HAS_MID = false;
    bf16_t* O; int ldc;
    __device__ __forceinline__ void operator()(const f32x4 (&acc)[2][2][4][2], const Unit& u, int wr, int wc, int fr, int fq) const {
        const int row0 = u.pm * BM + wr * 64 + fr, col0 = u.pn * (BM / 2) + wc * 16 + 4 * fq;
#pragma unroll
        for (int ai = 0; ai < 2; ++ai)
#pragma unroll
            for (int m = 0; m < 4; ++m) { bf16_t* rowp = O + (size_t)(row0 + ai * HALF + m * 16) * ldc + col0;
#pragma unroll
                for (int bj = 0; bj < 2; ++bj) { const f32x4 v0 = acc[ai][bj][m][0], v1 = acc[ai][bj][m][1];
                    const float a0 = v0[0] / (1.f + __expf(-v0[0])) * v0[1], a1 = v0[2] / (1.f + __expf(-v0[2])) * v0[3];
                    const float a2 = v1[0] / (1.f + __expf(-v1[0])) * v1[1], a3 = v1[2] / (1.f + __expf(-v1[2])) * v1[3];
                    u32x2 w; w.x = cvt_pk_bf16(a0, a1); w.y = cvt_pk_bf16(a2, a3);
                    *(u32x2*)(rowp + bj * (HALF / 2)) = w; } }
    }
};
template <int MODE  > struct EpiGate {
    static constexpr bool PERM = true, AFTER_DRAIN = false, HAS_MID = false;
    const bf16_t* sg; const bf16_t* tin; bf16_t* tout; int ldc;
    __device__ __forceinline__ void operator()(const f32x4 (&acc)[2][2][4][2], const Unit& u, int wr, int wc, int fr, int fq) const {
        const int row0 = u.pm * BM + wr * 64 + fr, col0 = u.pn * BM + wc * 32 + 8 * fq;
#pragma unroll
        for (int ai = 0; ai < 2; ++ai)
#pragma unroll
            for (int m = 0; m < 4; ++m) { const size_t r = (size_t)(row0 + ai * HALF + m * 16);
#pragma unroll
                for (int bj = 0; bj < 2; ++bj) { const int c = col0 + bj * HALF;
                    const u32x4 gq = *(const u32x4*)(sg + r * 3072 + c); u32x4 tq = {0u, 0u, 0u, 0u}; if (MODE >= 1) tq = *(const u32x4*)(tin + r * ldc + c);
                    const f32x4 v0 = acc[ai][bj][m][0], v1 = acc[ai][bj][m][1]; u32x4 w;
#define EG_ONE(dst, x0, x1, gw_, tw_) { float a_ = (x0) * __builtin_bit_cast(float, (gw_) << 16), b_ = (x1) * __builtin_bit_cast(float, (gw_) & 0xffff0000u); \
                        if (MODE >= 1) { a_ += __builtin_bit_cast(float, (tw_) << 16); b_ += __builtin_bit_cast(float, (tw_) & 0xffff0000u); } dst = cvt_pk_bf16(a_, b_); }
                    EG_ONE(w.x, v0[0], v0[1], gq.x, tq.x) EG_ONE(w.y, v0[2], v0[3], gq.y, tq.y) EG_ONE(w.z, v1[0], v1[1], gq.z, tq.z) EG_ONE(w.w, v1[2], v1[3], gq.w, tq.w)
#undef EG_ONE
                    *(u32x4*)(tout + r * ldc + c) = w; } }
    }
};
struct EpiGate3 {
    static constexpr bool PERM = true, AFTER_DRAIN = false, HAS_MID = true;
    const bf16_t* sg; bf16_t* out; int ldc; int t1, t2;
    __device__ __forceinline__ void mid(f32x4 (&acc)[2][2][4][2], const Unit& u, int wr, int wc, int fr, int fq, int seam) const {
        int row0 = u.pm * BM + wr * 64 + fr, col0 = u.pn * BM + wc * 32 + 8 * fq;
        asm volatile("" : "+v"(row0), "+v"(col0));
#pragma unroll
        for (int ai = 0; ai < 2; ++ai)
#pragma unroll
            for (int m = 0; m < 4; ++m) { const bf16_t* gp = sg + (size_t)(row0 + ai * HALF + m * 16) * 3072 + seam * 1024 + col0;
#pragma unroll
                for (int bj = 0; bj < 2; ++bj) { const u32x4 ga = *(const u32x4*)(gp + bj * HALF), gb = *(const u32x4*)(gp + 1024 + bj * HALF);
#define EG3_R(a_, b_, hi_) (fmaxf(__builtin_bit_cast(float, (hi_) ? ((a_) & 0xffff0000u) : ((a_) << 16)), 1e-30f) * __builtin_amdgcn_rcpf(fmaxf(__builtin_bit_cast(float, (hi_) ? ((b_) & 0xffff0000u) : ((b_) << 16)), 1e-30f)))
                    acc[ai][bj][m][0][0] *= EG3_R(ga.x, gb.x, 0); acc[ai][bj][m][0][1] *= EG3_R(ga.x, gb.x, 1); acc[ai][bj][m][0][2] *= EG3_R(ga.y, gb.y, 0); acc[ai][bj][m][0][3] *= EG3_R(ga.y, gb.y, 1);
                    acc[ai][bj][m][1][0] *= EG3_R(ga.z, gb.z, 0); acc[ai][bj][m][1][1] *= EG3_R(ga.z, gb.z, 1); acc[ai][bj][m][1][2] *= EG3_R(ga.w, gb.w, 0); acc[ai][bj][m][1][3] *= EG3_R(ga.w, gb.w, 1);
#undef EG3_R
                } }
    }
    __device__ __forceinline__ void operator()(const f32x4 (&acc)[2][2][4][2], const Unit& u, int wr, int wc, int fr, int fq) const {
        const int row0 = u.pm * BM + wr * 64 + fr, col0 = u.pn * BM + wc * 32 + 8 * fq;
#pragma unroll
        for (int ai = 0; ai < 2; ++ai)
#pragma unroll
            for (int m = 0; m < 4; ++m) { const size_t r = (size_t)(row0 + ai * HALF + m * 16);
#pragma unroll
                for (int bj = 0; bj < 2; ++bj) { const int c = col0 + bj * HALF;
                    const u32x4 gq = *(const u32x4*)(sg + r * 3072 + 2048 + c); const f32x4 v0 = acc[ai][bj][m][0], v1 = acc[ai][bj][m][1]; u32x4 w;
#define EG3_G(g_, hi_) fmaxf(__builtin_bit_cast(float, (hi_) ? ((g_) & 0xffff0000u) : ((g_) << 16)), 1e-30f)
                    w.x = cvt_pk_bf16(v0[0] * EG3_G(gq.x, 0), v0[1] * EG3_G(gq.x, 1)); w.y = cvt_pk_bf16(v0[2] * EG3_G(gq.y, 0), v0[3] * EG3_G(gq.y, 1));
                    w.z = cvt_pk_bf16(v1[0] * EG3_G(gq.z, 0), v1[1] * EG3_G(gq.z, 1)); w.w = cvt_pk_bf16(v1[2] * EG3_G(gq.w, 0), v1[3] * EG3_G(gq.w, 1));
#undef EG3_G
                    *(u32x4*)(out + r * ldc + c) = w; } }
    }
};
template <class Epi, class Sched, bool ALIGN_EPI = false, bool SP2 = false>
__device__ __forceinline__ void gemm_phase(LAS unsigned char* lds, const Gemm g, const Sched& S, const Epi& E) {
    int tid_ = threadIdx.x; asm volatile("" : "+v"(tid_));
    const int tid = tid_, wid = __builtin_amdgcn_readfirstlane(tid >> 6), lane = tid & 63, wr = wid >> 2, wc = wid & 3, fr = lane & 15, fq = lane >> 4;
    const int K = g.K, nt = K / BK;
    unsigned voffA[2], voffB[2];
#pragma unroll
    for (int i = 0; i < 2; ++i) { int R, C; stage_rc(tid * 16 + i * 8192, R, C); const int Rb = Epi::PERM ? ((R & ~31) + perm32(R & 31)) : R;
        voffA[i] = (unsigned)(R * g.lda + C) * 2u; voffB[i] = (unsigned)(Rb * g.ldb + C) * 2u; }
    const size_t kstep = (size_t)(BK * 2);
    const size_t hstepA = (size_t)HALF * g.lda * 2, hstepB = (size_t)HALF * g.ldb * 2;
    const size_t tstepA = 2 * hstepA, tstepB = 2 * hstepB;
    const unsigned ldsw = (unsigned)wid * 1024u;
    const int aoff = lds_byte(wr * 64 + fr, fq * 8), boff = lds_byte(wc * 32 + fr, fq * 8);
#define PG8_SA(b, h) (((b) * 2 + (h)) * HTB)
#define PG8_SB(b, h) ((4 + (b) * 2 + (h)) * HTB)
#define PG8_STAGE(bufoff, gbase, voff) do { _Pragma("unroll") for (int _i = 0; _i < 2; ++_i) \
        __builtin_amdgcn_global_load_lds((const unsigned*)((const char*)(gbase) + (voff)[_i]), (LAS unsigned*)(lds + (bufoff) + ldsw + _i * 8192), 16, 0, 0); } while (0)
#define PG8_LDA(dst, b, h) do { _Pragma("unroll") for (int m = 0; m < 4; ++m) _Pragma("unroll") for (int k = 0; k < 2; ++k) dst[m][k] = *(const LAS bf16x8*)(lds + PG8_SA(b, h) + aoff + m * 2048 + k * 1024); } while (0)
#define PG8_LDB(dst, b, h) do { _Pragma("unroll") for (int n = 0; n < 2; ++n) _Pragma("unroll") for (int k = 0; k < 2; ++k) dst[n][k] = *(const LAS bf16x8*)(lds + PG8_SB(b, h) + boff + n * 2048 + k * 1024); } while (0)
#define PG8_MMA(ai, bj, At, Bt) do { __builtin_amdgcn_s_setprio(1); _Pragma("unroll") for (int m = 0; m < 4; ++m) _Pragma("unroll") for (int n = 0; n < 2; ++n) _Pragma("unroll") for (int k = 0; k < 2; ++k) \
        acc[ai][bj][m][n] = __builtin_amdgcn_mfma_f32_16x16x32_bf16(Bt[n][k], At[m][k], acc[ai][bj][m][n], 0, 0, 0); __builtin_amdgcn_s_setprio(0); } while (0)
#define PG8_WAIT_V(n) asm volatile("s_waitcnt vmcnt(" #n ")" ::: "memory")
#define PG8_WAIT_L(n) asm volatile("s_waitcnt lgkmcnt(" #n ")" ::: "memory")
#define PG8_BAR __builtin_amdgcn_s_barrier()
#define PG8_SCHED __builtin_amdgcn_sched_barrier(0)
    Unit cur, nxt; int ui = 0;
    if (!S.next(0, cur)) return;
    f32x4 acc[2][2][4][2];
#pragma unroll
    for (int a = 0; a < 2; ++a)
#pragma unroll
        for (int b = 0; b < 2; ++b)
#pragma unroll
            for (int m = 0; m < 4; ++m)
#pragma unroll
                for (int n = 0; n < 2; ++n) acc[a][b][m][n] = (f32x4){0.f, 0.f, 0.f, 0.f};
    bf16x8 At[4][2], B0[2][2], B1[2][2];
    const size_t kslb = (size_t)g.ksl * 2;
    const char* cA = (const char*)g.A + (size_t)cur.pm * tstepA + cur.ks * kslb; const char* cB = (const char*)g.Bt + (size_t)cur.pn * tstepB + cur.ks * kslb;
    S.a_ready(cur);
    if constexpr (SP2) {
        PG8_STAGE(PG8_SB(0, 0), cB, voffB); PG8_STAGE(PG8_SB(0, 1), cB + hstepB, voffB); PG8_STAGE(PG8_SA(0, 0), cA, voffA); PG8_STAGE(PG8_SA(0, 1), cA + hstepA, voffA);
        if (wr == 1) PG8_BAR;
        PG8_WAIT_V(2); PG8_BAR;
        PG8_STAGE(PG8_SB(1, 0), cB + kstep, voffB); PG8_STAGE(PG8_SA(1, 0), cA + kstep, voffA); PG8_STAGE(PG8_SB(1, 1), cB + hstepB + kstep, voffB);
        PG8_WAIT_V(6); PG8_BAR;
    } else {
        PG8_STAGE(PG8_SB(0, 0), cB, voffB); PG8_STAGE(PG8_SA(0, 0), cA, voffA); PG8_STAGE(PG8_SB(0, 1), cB + hstepB, voffB); PG8_STAGE(PG8_SA(0, 1), cA + hstepA, voffA);
        if (wr == 1) PG8_BAR;
        PG8_WAIT_V(4); PG8_BAR;
        PG8_STAGE(PG8_SB(1, 0), cB + kstep, voffB); PG8_STAGE(PG8_SA(1, 0), cA + kstep, voffA); PG8_STAGE(PG8_SB(1, 1), cB + hstepB + kstep, voffB);
        PG8_WAIT_V(6); PG8_BAR;
    }
    for (;;) {
        const bool has_next = S.next(ui + 1, nxt);
        const char* nA = has_next ? (const char*)g.A + (size_t)nxt.pm * tstepA + nxt.ks * kslb : cA; const char* nB = has_next ? (const char*)g.Bt + (size_t)nxt.pn * tstepB + nxt.ks * kslb : cB;
#pragma unroll 1
        for (int t = 0; t < nt; t += 2) {
            const bool last = (t == nt - 2);
            const char* a1 = cA + (size_t)(t + 1) * kstep;
            const char* a2 = last ? nA : cA + (size_t)(t + 2) * kstep; const char* b2 = last ? nB : cB + (size_t)(t + 2) * kstep;
            const char* a3 = a2 + kstep; const char* b3 = b2 + kstep;
            if (last && has_next) S.a_ready(nxt);
            if constexpr (Epi::HAS_MID) { if (t == E.t1 || t == E.t2) E.mid(acc, cur, wr, wc, fr, fq, t == E.t1 ? 0 : 1); }
            if constexpr (SP2) {
            PG8_LDB(B0, 0, 0); PG8_LDB(B1, 0, 1); PG8_SCHED; PG8_LDA(At, 0, 0); PG8_STAGE(PG8_SA(1, 1), a1 + hstepA, voffA);
            PG8_WAIT_V(8); PG8_WAIT_L(0); PG8_BAR; PG8_MMA(0, 0, At, B0); PG8_MMA(0, 1, At, B1); PG8_BAR; PG8_SCHED;
            PG8_LDA(At, 0, 1); PG8_STAGE(PG8_SB(0, 0), b2, voffB); PG8_STAGE(PG8_SB(0, 1), b2 + hstepB, voffB); PG8_STAGE(PG8_SA(0, 0), a2, voffA);
            PG8_WAIT_V(8); PG8_WAIT_L(0); PG8_BAR; PG8_MMA(1, 0, At, B0); PG8_MMA(1, 1, At, B1); PG8_BAR; PG8_SCHED;
            PG8_LDB(B0, 1, 0); PG8_LDB(B1, 1, 1); PG8_SCHED; PG8_LDA(At, 1, 0); PG8_STAGE(PG8_SA(0, 1), a2 + hstepA, voffA);
            PG8_WAIT_V(8); PG8_WAIT_L(0); PG8_BAR; PG8_MMA(0, 0, At, B0); PG8_MMA(0, 1, At, B1); PG8_BAR; PG8_SCHED;
            PG8_LDA(At, 1, 1); PG8_STAGE(PG8_SB(1, 0), b3, voffB); PG8_STAGE(PG8_SB(1, 1), b3 + hstepB, voffB); PG8_STAGE(PG8_SA(1, 0), a3, voffA);
            PG8_WAIT_V(8); PG8_WAIT_L(0); PG8_BAR; PG8_MMA(1, 0, At, B0); PG8_MMA(1, 1, At, B1); PG8_BAR; PG8_SCHED;
            } else {
            PG8_LDB(B0, 0, 0); PG8_SCHED; PG8_LDA(At, 0, 0); PG8_STAGE(PG8_SA(1, 1), a1 + hstepA, voffA);
            PG8_WAIT_L(8); PG8_BAR; PG8_WAIT_L(0); PG8_MMA(0, 0, At, B0); PG8_BAR; PG8_SCHED;
            PG8_LDB(B1, 0, 1); PG8_STAGE(PG8_SB(0, 0), b2, voffB);
            PG8_BAR; PG8_WAIT_L(0); PG8_MMA(0, 1, At, B1); PG8_BAR;
            PG8_LDA(At, 0, 1); PG8_STAGE(PG8_SA(0, 0), a2, voffA);
            PG8_BAR; PG8_WAIT_L(0); PG8_MMA(1, 0, At, B0); PG8_BAR; PG8_SCHED;
            PG8_STAGE(PG8_SB(0, 1), b2 + hstepB, voffB);
            PG8_WAIT_V(6); PG8_BAR; PG8_MMA(1, 1, At, B1); PG8_BAR;
            PG8_LDB(B0, 1, 0); PG8_SCHED; PG8_LDA(At, 1, 0); PG8_STAGE(PG8_SA(0, 1), a2 + hstepA, voffA);
            PG8_WAIT_L(8); PG8_BAR; PG8_WAIT_L(0); PG8_MMA(0, 0, At, B0); PG8_BAR; PG8_SCHED;
            PG8_LDB(B1, 1, 1); PG8_STAGE(PG8_SB(1, 0), b3, voffB);
            PG8_BAR; PG8_WAIT_L(0); PG8_MMA(0, 1, At, B1); PG8_BAR;
            PG8_LDA(At, 1, 1); PG8_STAGE(PG8_SA(1, 0), a3, voffA);
            PG8_BAR; PG8_WAIT_L(0); PG8_MMA(1, 0, At, B0); PG8_BAR; PG8_SCHED;
            PG8_STAGE(PG8_SB(1, 1), b3 + hstepB, voffB);
            PG8_WAIT_V(6); PG8_BAR; PG8_MMA(1, 1, At, B1); PG8_BAR;
            }
        }
        if constexpr (ALIGN_EPI) { if (wr == 0) PG8_BAR; }
        if constexpr (!Epi::AFTER_DRAIN) { E(acc, cur, wr, wc, fr, fq); S.done(cur); }
        if (!has_next) break;
#pragma unroll
        for (int a = 0; a < 2; ++a)
#pragma unroll
            for (int b = 0; b < 2; ++b)
#pragma unroll
                for (int m = 0; m < 4; ++m)
#pragma unroll
                    for (int n = 0; n < 2; ++n) acc[a][b][m][n] = (f32x4){0.f, 0.f, 0.f, 0.f};
        cur = nxt; cA = nA; cB = nB; ++ui;
        if constexpr (ALIGN_EPI) { if (wr == 1) PG8_BAR; }
    }
    PG8_WAIT_V(0);
    if constexpr (!ALIGN_EPI) { if (wr == 0) PG8_BAR; }
    PG8_BAR;
    if constexpr (Epi::AFTER_DRAIN) { E.fused(acc, cur, wr, wc, fr, fq, lds, wid, lane); S.done(cur); }
#undef PG8_SA
#undef PG8_SB
#undef PG8_STAGE
#undef PG8_LDA
#undef PG8_LDB
#undef PG8_MMA
#undef PG8_WAIT_V
#undef PG8_WAIT_L
#undef PG8_BAR
#undef PG8_SCHED
}
}
typedef unsigned short bf16_t;
DI unsigned pk2(float lo, float hi) { return pg8::cvt_pk_bf16(lo, hi); }
DI bf16_t f2bf(float f) { return (bf16_t)(pg8::cvt_pk_bf16(f, 0.f) & 0xffffu); }
DI void transpose_item(const float* W, int N, bf16_t* WT, int ldt, int row_off, int rmul, LAS float* scr, int item, int lane) {
    const int nblk = N / 32, kb = item / nblk, nb = item % nblk, k0 = 64 * kb, n0 = 32 * nb;
#pragma unroll 8
    for (int i = 0; i < 32; ++i) { const int kk = 2 * i + (lane >> 5); scr[kk * 33 + (lane & 31)] = W[(size_t)(k0 + kk) * N + n0 + (lane & 31)]; }
    asm volatile("s_waitcnt lgkmcnt(0)" ::: "memory");
    const int c = lane & 7;
#pragma unroll
    for (int j = 0; j < 4; ++j) { const int n = (lane >> 3) + 8 * j; const LAS float* sp = scr + (8 * c) * 33 + n;
        pg8::u32x4 o; o.x = pk2(sp[0 * 33], sp[1 * 33]); o.y = pk2(sp[2 * 33], sp[3 * 33]); o.z = pk2(sp[4 * 33], sp[5 * 33]); o.w = pk2(sp[6 * 33], sp[7 * 33]);
        *(pg8::u32x4*)(WT + (size_t)(row_off + rmul * (n0 + n)) * ldt + k0 + 8 * c) = o; }
    asm volatile("s_waitcnt lgkmcnt(0)" ::: "memory");
}
DI void transpose_w(const float* W, int K, int N, bf16_t* WT, int ldt, int row_off, LAS float* scr, int gw, int NGW, int lane, int& rot, int rmul = 1) {
    const int nitems = (K / 64) * (N / 32);
    int first = gw - (rot % NGW); if (first < 0) first += NGW;
    for (int it = first; it < nitems; it += NGW) transpose_item(W, N, WT, ldt, row_off, rmul, scr, it, lane);
    rot += nitems;
}

struct Args {
    const float* in[29]; float* out; unsigned char* ws; int ph_lo, ph_hi, sub, pad;
};

DI unsigned short f2bf_raw(float f) { unsigned u = __builtin_bit_cast(unsigned, f); return (unsigned short)((u + 0x7fffu + ((u >> 16) & 1u)) >> 16); }
DI void sgemm_naive(LAS float* lds, const float* __restrict__ A, int lda, const float* __restrict__ B, long sbk, long sbn,
                    float* __restrict__ C, int ldc, int M, int N, int K, int bid, int G, unsigned short* Cb = nullptr) {
    LAS float* As = lds;
    LAS float* Bs = lds + 16 * 132;
    const int tid = threadIdx.x, tx = tid & 15, ty = tid >> 4;
    const int ntn = N / 64, ntiles = (M / 128) * ntn;
    for (int t = bid; t < ntiles; t += G) {
        const int m0 = (t / ntn) * 128, n0 = (t % ntn) * 64;
        float acc[4][4];
#pragma unroll
        for (int i = 0; i < 4; ++i)
#pragma unroll
            for (int j = 0; j < 4; ++j) acc[i][j] = 0.f;
        for (int k0 = 0; k0 < K; k0 += 16) {
            {
                const int r = tid >> 2, kq = (tid & 3) * 4;
                const float4 v = *(const float4*)(A + (size_t)(m0 + r) * lda + k0 + kq);
                As[(kq + 0) * 132 + r] = v.x; As[(kq + 1) * 132 + r] = v.y; As[(kq + 2) * 132 + r] = v.z; As[(kq + 3) * 132 + r] = v.w;
            }
#pragma unroll
            for (int i = 0; i < 2; ++i) {
                const int idx = tid + i * 512, kk = idx >> 6, nn = idx & 63;
                Bs[kk * 64 + nn] = B[(size_t)(k0 + kk) * sbk + (size_t)(n0 + nn) * sbn];
            }
            __syncthreads();
#pragma unroll
            for (int kk = 0; kk < 16; ++kk) {
                const f32x4 a = *(const LAS f32x4*)(As + kk * 132 + ty * 4);
                const f32x4 b = *(const LAS f32x4*)(Bs + kk * 64 + tx * 4);
                const float av[4] = {a.x, a.y, a.z, a.w}, bv[4] = {b.x, b.y, b.z, b.w};
#pragma unroll
                for (int i = 0; i < 4; ++i)
#pragma unroll
                    for (int j = 0; j < 4; ++j) acc[i][j] += av[i] * bv[j];
            }
            __syncthreads();
        }
#pragma unroll
        for (int i = 0; i < 4; ++i) {
            float4 o; o.x = acc[i][0]; o.y = acc[i][1]; o.z = acc[i][2]; o.w = acc[i][3];
            if (Cb) { unsigned short* cb = Cb + (size_t)(m0 + ty * 4 + i) * ldc + n0 + tx * 4; cb[0] = f2bf_raw(o.x); cb[1] = f2bf_raw(o.y); cb[2] = f2bf_raw(o.z); cb[3] = f2bf_raw(o.w); }
            else *(float4*)(C + (size_t)(m0 + ty * 4 + i) * ldc + n0 + tx * 4) = o;
        }
    }
}

template <int DQK, int DV, bool V_IN_K, int MODE, class KV, class QF>
DI void attn_naive(LAS float* lds, const KV& kv, int nk_loop, const QF& qf, bool active, int limit, float scale, float lg, int tq, float* optr) {
    constexpr int KS = DQK + 1;
    constexpr int VS = V_IN_K ? KS : DV;
    LAS float* Ks = lds;
    LAS float* Vs = V_IN_K ? Ks : (lds + 64 * KS);
    LAS float* qs = lds + 64 * KS + (V_IN_K ? 0 : 64 * DV);
    LAS float* ps = qs + 8 * DQK;
    static_assert((64 * KS + (V_IN_K ? 0 : 64 * DV) + 8 * DQK + 8 * 64) * 4 <= MISC_OFF, "attn_naive LDS");
    const int tid = threadIdx.x, lane = tid & 63, w = tid >> 6;
    __syncthreads();
    for (int d = lane; d < DQK; d += 64) qs[w * DQK + d] = active ? qf(d) : 0.f;
    float m = -INFINITY, l = 0.f;
    float acc[DV / 64];
#pragma unroll
    for (int c = 0; c < DV / 64; ++c) acc[c] = 0.f;
    for (int base = 0; base < nk_loop; base += 64) {
        __syncthreads();
        for (int idx = tid; idx < 64 * DQK; idx += NTHREADS) { const int j = idx / DQK, d = idx - j * DQK, key = base + j; Ks[j * KS + d] = key < nk_loop ? kv.k(key, d) : 0.f; }
        if (!V_IN_K) for (int idx = tid; idx < 64 * DV; idx += NTHREADS) { const int j = idx / DV, e = idx - j * DV, key = base + j; Vs[j * DV + e] = key < nk_loop ? kv.v(key, e) : 0.f; }
        __syncthreads();
        const int key = base + lane; const bool valid = active && key <= limit && key < nk_loop;
        float s = 0.f;
        for (int d = 0; d < DQK; ++d) s += qs[w * DQK + d] * Ks[lane * KS + d];
        float p;
        if (MODE == 0) {
            s *= scale;
            const float cm = wave_max(valid ? s : -INFINITY);
            const float mn = fmaxf(m, cm);
            const float alpha = (mn == -INFINITY) ? 1.f : expf(m - mn);
            p = valid ? expf(s - mn) : 0.f;
            l = l * alpha + wave_sum(p);
#pragma unroll
            for (int c = 0; c < DV / 64; ++c) acc[c] *= alpha;
            m = mn;
        } else {
            p = valid ? s * expf((float)(tq - key) * lg) : 0.f;
        }
        ps[w * 64 + lane] = p;
        __syncthreads();
        for (int j = 0; j < 64; ++j) { const float pj = ps[w * 64 + j];
#pragma unroll
            for (int c = 0; c < DV / 64; ++c) acc[c] += pj * Vs[j * VS + lane + 64 * c]; }
    }
    if (active) {
#pragma unroll
        for (int c = 0; c < DV / 64; ++c) optr[lane + 64 * c] = (MODE == 0) ? acc[c] / l : acc[c];
    }
}

struct KvMlaPrompt { const float* ckvn; const float* kper; int b;
    DI float k(int key, int d) const { const size_t row = (size_t)b * SEQ + key; return d < KVL ? ckvn[row * KVL + d] : kper[row * DROPE + (d - KVL)]; }
    DI float v(int, int) const { return 0.f; } };
struct KvMlaSample { const float* ckvn; const float* kper; const float* cckv; const float* ckpe; const int* pt; int b;
    DI float k(int key, int d) const {
        if (key < PAST) { const size_t r = (size_t)pt[b * NPAGES + (key >> 7)] * PAGE + (key & (PAGE - 1)); return d < KVL ? cckv[r * KVL + d] : ckpe[r * DROPE + (d - KVL)]; }
        const size_t row = (size_t)NP + b * DS + (key - PAST); return d < KVL ? ckvn[row * KVL + d] : kper[row * DROPE + (d - KVL)]; }
    DI float v(int, int) const { return 0.f; } };
struct KvRet { const float* rk; const float* z; int b, h;
    DI float k(int key, int d) const { return rk[((size_t)b * SEQ + key) * 512 + h * RDK + d]; }
    DI float v(int key, int e) const { return z[((size_t)b * SEQ + key) * ZLD + C_RV + h * RDV + e]; } };
struct KvMem { const float* mk; const float* mv; int b, h;
    DI float k(int key, int d) const { return mk[(((size_t)b * NMEM + key) * XH + h) * XHD + d]; }
    DI float v(int key, int e) const { return mv[(((size_t)b * NMEM + key) * XH + h) * XHD + e]; } };


typedef float f32x16 __attribute__((ext_vector_type(16)));
typedef short bf16x8 __attribute__((ext_vector_type(8)));
typedef short s16x4 __attribute__((ext_vector_type(4)));
typedef unsigned u32x4_t __attribute__((ext_vector_type(4)));
typedef unsigned u32x2_t __attribute__((ext_vector_type(2)));
DI int crow(int i, int h) { return (i & 3) + 8 * (i >> 2) + 4 * h; }
#define MFMA32(a, b, c) __builtin_amdgcn_mfma_f32_32x32x16_bf16((a), (b), (c), 0, 0, 0)
template <int DQK, int DV, bool CAUSAL, class Src>
DI void flash_unit(LAS unsigned char* lds, const Src& src, int qpos0, int ntiles, bf16_t* O, int ldo, float c2) {
    constexpr int KP = DQK + 8, VP = 68, KS = DQK / 16, NBLK = DV / 32;
    constexpr int KBYTES = 64 * KP * 2, VBYTES = DV * VP * 2, BUF = KBYTES + VBYTES;
    constexpr int D8 = DQK / 8, NPK = (64 * D8) / NTHREADS, NPV = (DV * 8) / NTHREADS;
    static_assert((64 * D8) % NTHREADS == 0 && (DV * 8) % NTHREADS == 0 && 2 * BUF <= 131072, "flash_unit geometry");
    const int tid = threadIdx.x, lane = tid & 63, w = __builtin_amdgcn_readfirstlane(tid >> 6), l31 = lane & 31, h = lane >> 5;
    bf16x8 qf[KS];
#pragma unroll
    for (int s_ = 0; s_ < KS; ++s_) qf[s_] = src.qfrag(32 * w + l31, s_, h);
    f32x16 o[NBLK];
#pragma unroll
    for (int b = 0; b < NBLK; ++b)
#pragma unroll
        for (int i = 0; i < 16; ++i) o[b][i] = 0.f;
    float m = -INFINITY, lsum = 0.f;
    u32x4_t kreg[NPK], vreg[NPV];
#define FL_LOAD(t_) do { _Pragma("unroll") for (int i_ = 0; i_ < NPK; ++i_) { const int p_ = tid + i_ * NTHREADS; kreg[i_] = src.kpiece(64 * (t_) + p_ / D8, p_ % D8); } \
                         _Pragma("unroll") for (int i_ = 0; i_ < NPV; ++i_) { const int p_ = tid + i_ * NTHREADS; vreg[i_] = src.vpiece(p_ >> 3, 64 * (t_) + 8 * (p_ & 7)); } } while (0)
#define FL_STORE(buf_) do { _Pragma("unroll") for (int i_ = 0; i_ < NPK; ++i_) { const int p_ = tid + i_ * NTHREADS; *(LAS u32x4_t*)(lds + (buf_) * BUF + ((p_ / D8) * KP + (p_ % D8) * 8) * 2) = kreg[i_]; } \
                          _Pragma("unroll") for (int i_ = 0; i_ < NPV; ++i_) { const int p_ = tid + i_ * NTHREADS; LAS unsigned char* a_ = lds + (buf_) * BUF + KBYTES + ((p_ >> 3) * VP + (p_ & 7) * 8) * 2; \
                              *(LAS u32x2_t*)a_ = (u32x2_t){vreg[i_].x, vreg[i_].y}; *(LAS u32x2_t*)(a_ + 8) = (u32x2_t){vreg[i_].z, vreg[i_].w}; } } while (0)
    __syncthreads();
    FL_LOAD(0); FL_STORE(0);
    __syncthreads();
    const int qmine = qpos0 + 32 * w + l31, qlast = qpos0 + 32 * w + 31;
    for (int t = 0; t < ntiles; ++t) {
        const int buf = t & 1;
        if (t + 1 < ntiles) FL_LOAD(t + 1);
        if (!CAUSAL || 64 * t <= qlast) {
            const LAS unsigned char* kb_ = lds + buf * BUF; const LAS unsigned char* vb_ = kb_ + KBYTES;
            f32x16 st[2];
#pragma unroll
            for (int kb = 0; kb < 2; ++kb) {
#pragma unroll
                for (int i = 0; i < 16; ++i) st[kb][i] = 0.f;
#pragma unroll
                for (int g_ = 0; g_ < KS / 4; ++g_) { bf16x8 kf[4];
#pragma unroll
                    for (int j = 0; j < 4; ++j) kf[j] = *(const LAS bf16x8*)(kb_ + ((32 * kb + l31) * KP + 16 * (4 * g_ + j) + 8 * h) * 2);
#pragma unroll
                    for (int j = 0; j < 4; ++j) st[kb] = MFMA32(kf[j], qf[4 * g_ + j], st[kb]);
                    __builtin_amdgcn_sched_barrier(0); }
            }
            if (CAUSAL && 64 * t + 63 > qpos0 + 32 * w) {
#pragma unroll
                for (int kb = 0; kb < 2; ++kb)
#pragma unroll
                    for (int i = 0; i < 16; ++i) { const int key = 64 * t + 32 * kb + crow(i, h); st[kb][i] = key <= qmine ? st[kb][i] : -INFINITY; }
            }
            float mx = -INFINITY;
#pragma unroll
            for (int kb = 0; kb < 2; ++kb)
#pragma unroll
                for (int i = 0; i < 16; ++i) mx = fmaxf(mx, st[kb][i]);
            mx = fmaxf(mx, __shfl_xor(mx, 32));
            const float mn = fmaxf(m, mx);
            { const float alpha = __builtin_amdgcn_exp2f((m - mn) * c2);
                lsum *= alpha;
#pragma unroll
                for (int b = 0; b < NBLK; ++b)
#pragma unroll
                    for (int i = 0; i < 16; ++i) o[b][i] *= alpha;
                m = mn;
            }
            const float nmc = -mn * c2;
            float ps = 0.f;
#pragma unroll
            for (int kb = 0; kb < 2; ++kb)
#pragma unroll
                for (int i = 0; i < 16; ++i) { const float p = __builtin_amdgcn_exp2f(__builtin_fmaf(st[kb][i], c2, nmc)); st[kb][i] = p; ps += p; }
            lsum += ps;
            bf16x8 pf[4];
#pragma unroll
            for (int ks = 0; ks < 4; ++ks) { const int kb = ks >> 1, s2 = ks & 1; u32x4_t pk;
                pk.x = cvtpk(st[kb][8 * s2 + 0], st[kb][8 * s2 + 1]); pk.y = cvtpk(st[kb][8 * s2 + 2], st[kb][8 * s2 + 3]);
                pk.z = cvtpk(st[kb][8 * s2 + 4], st[kb][8 * s2 + 5]); pk.w = cvtpk(st[kb][8 * s2 + 6], st[kb][8 * s2 + 7]); pf[ks] = __builtin_bit_cast(bf16x8, pk); }
            __builtin_amdgcn_sched_barrier(0);
#pragma unroll
            for (int b = 0; b < NBLK; ++b) { bf16x8 vf[4];
#pragma unroll
                for (int ks = 0; ks < 4; ++ks) { const LAS unsigned char* a_ = vb_ + ((32 * b + l31) * VP + 16 * ks + 4 * h) * 2;
                    const s16x4 lo = *(const LAS s16x4*)a_, hi = *(const LAS s16x4*)(a_ + 16);
                    vf[ks] = __builtin_shufflevector(lo, hi, 0, 1, 2, 3, 4, 5, 6, 7); }
#pragma unroll
                for (int ks = 0; ks < 4; ++ks) o[b] = MFMA32(vf[ks], pf[ks], o[b]);
                __builtin_amdgcn_sched_barrier(0); }
        }
        if (t + 1 < ntiles) FL_STORE(buf ^ 1);
        __syncthreads();
    }
#undef FL_LOAD
#undef FL_STORE
    lsum += __shfl_xor(lsum, 32);
    const float inv = 1.f / lsum;
    bf16_t* orow = O + (size_t)(32 * w + l31) * ldo;
#pragma unroll
    for (int b = 0; b < NBLK; ++b)
#pragma unroll
        for (int g = 0; g < 4; ++g) { u32x2_t pk; pk.x = cvtpk(o[b][4 * g + 0] * inv, o[b][4 * g + 1] * inv); pk.y = cvtpk(o[b][4 * g + 2] * inv, o[b][4 * g + 3] * inv);
            *(u32x2_t*)(orow + 32 * b + 8 * g + 4 * h) = pk; }
}
struct SrcMlaP { const bf16_t* kn; const bf16_t* kpe; const bf16_t* vt; const bf16_t* qraw; const bf16_t* qpe; int b, hh; size_t row0;
    DI bf16x8 qfrag(int r, int s_, int h8) const { return s_ < 8 ? *(const bf16x8*)(qraw + (row0 + r) * 1536 + hh * DQH + 16 * s_ + 8 * h8) : *(const bf16x8*)(qpe + (row0 + r) * 512 + hh * DROPE + 16 * (s_ - 8) + 8 * h8); }
    DI u32x4_t kpiece(int key, int d8) const { const size_t row = (size_t)b * SEQ + key;
        return d8 < 16 ? *(const u32x4_t*)(kn + row * 1024 + hh * DNOPE + d8 * 8) : *(const u32x4_t*)(kpe + row * DROPE + (d8 - 16) * 8); }
    DI u32x4_t vpiece(int dv, int key0) const { return *(const u32x4_t*)(vt + (size_t)(hh * DVH + dv) * NP + (size_t)b * SEQ + key0); } };
struct SrcMemP { const bf16_t* mk; const bf16_t* mvt; const bf16_t* xq; int b, hh; size_t row0;
    DI bf16x8 qfrag(int r, int s_, int h8) const { return *(const bf16x8*)(xq + (row0 + r) * ZLD + hh * XHD + 16 * s_ + 8 * h8); }
    DI u32x4_t kpiece(int key, int d8) const { return *(const u32x4_t*)(mk + ((size_t)b * NMEM + key) * 256 + hh * XHD + d8 * 8); }
    DI u32x4_t vpiece(int dv, int key0) const { return *(const u32x4_t*)(mvt + (size_t)(hh * XHD + dv) * (NB * NMEM) + (size_t)b * NMEM + key0); } };


DI void ret_chunk_state(const bf16_t* __restrict__ RVT, const bf16_t* __restrict__ RKtT, float* __restrict__ UT, int b, int h, int c) {
    const int tid = threadIdx.x, lane = tid & 63, w = __builtin_amdgcn_readfirstlane(tid >> 6), l31 = lane & 31, hh = lane >> 5;
    const size_t tok0 = (size_t)b * SEQ + c * 128;
    f32x16 acc[4];
#pragma unroll
    for (int kb = 0; kb < 4; ++kb)
#pragma unroll
        for (int i = 0; i < 16; ++i) acc[kb][i] = 0.f;
    const bf16_t* ap = RVT + (size_t)(h * RDV + 32 * w + l31) * NT + tok0 + 8 * hh;
    const bf16_t* bp = RKtT + (size_t)(h * RDK + l31) * NP + tok0 + 8 * hh;
#pragma unroll
    for (int s_ = 0; s_ < 8; ++s_) { const bf16x8 a = *(const bf16x8*)(ap + 16 * s_);
#pragma unroll
        for (int kb = 0; kb < 4; ++kb) { const bf16x8 bfr = *(const bf16x8*)(bp + (size_t)(32 * kb) * NP + 16 * s_); acc[kb] = MFMA32(a, bfr, acc[kb]); } }
    float* u = UT + (size_t)(((b * RH + h) * 16) + c) * 32768;
#pragma unroll
    for (int kb = 0; kb < 4; ++kb)
#pragma unroll
        for (int i = 0; i < 16; ++i) u[(32 * w + crow(i, hh)) * RDK + 32 * kb + l31] = acc[kb][i];
}
DI void ret_chunk_out(const bf16_t* __restrict__ RQt, const bf16_t* __restrict__ RKt, const bf16_t* __restrict__ RVT, const bf16_t* __restrict__ SPT, float* __restrict__ ORET, int b, int h, int c) {
    const int tid = threadIdx.x, lane = tid & 63, w = __builtin_amdgcn_readfirstlane(tid >> 6), l31 = lane & 31, hh = lane >> 5;
    const int ib = w & 3, vh = w >> 2;
    const size_t tok0 = (size_t)b * SEQ + c * 128;
    bf16x8 qf[8];
    { const bf16_t* qp = RQt + (tok0 + 32 * ib + l31) * 512 + h * RDK + 8 * hh;
#pragma unroll
      for (int s_ = 0; s_ < 8; ++s_) qf[s_] = *(const bf16x8*)(qp + 16 * s_); }
    f32x16 o[4];
#pragma unroll
    for (int blk = 0; blk < 4; ++blk)
#pragma unroll
        for (int i = 0; i < 16; ++i) o[blk][i] = 0.f;
    const bf16_t* vbase = RVT + (size_t)(h * RDV + 32 * (4 * vh) + l31) * NT + tok0 + 4 * hh;
#pragma unroll 1
    for (int jb = 0; jb <= ib; ++jb) {
        f32x16 x;
#pragma unroll
        for (int i = 0; i < 16; ++i) x[i] = 0.f;
        const bf16_t* kp = RKt + (tok0 + 32 * jb + l31) * 512 + h * RDK + 8 * hh;
#pragma unroll
        for (int s_ = 0; s_ < 8; ++s_) { const bf16x8 kf = *(const bf16x8*)(kp + 16 * s_); x = MFMA32(kf, qf[s_], x); }
        if (jb == ib) {
#pragma unroll
            for (int i = 0; i < 16; ++i) x[i] = (crow(i, hh) <= l31) ? x[i] : 0.f;
        }
#pragma unroll
        for (int s2 = 0; s2 < 2; ++s2) {
            u32x4_t pk; pk.x = cvtpk(x[8 * s2 + 0], x[8 * s2 + 1]); pk.y = cvtpk(x[8 * s2 + 2], x[8 * s2 + 3]); pk.z = cvtpk(x[8 * s2 + 4], x[8 * s2 + 5]); pk.w = cvtpk(x[8 * s2 + 6], x[8 * s2 + 7]);
            const bf16x8 pa = __builtin_bit_cast(bf16x8, pk);
#pragma unroll
            for (int blk = 0; blk < 4; ++blk) { const bf16_t* vp = vbase + (size_t)(32 * blk) * NT + 32 * jb + 16 * s2;
                const s16x4 lo = *(const s16x4*)vp, hi = *(const s16x4*)(vp + 8);
                const bf16x8 vf = __builtin_shufflevector(lo, hi, 0, 1, 2, 3, 4, 5, 6, 7);
                o[blk] = MFMA32(pa, vf, o[blk]); }
        }
    }
    const bf16_t* sp = SPT + (size_t)(((b * RH + h) * 16) + c) * 32768 + (size_t)(32 * (4 * vh) + l31) * RDK + 8 * hh;
#pragma unroll
    for (int s_ = 0; s_ < 8; ++s_)
#pragma unroll
        for (int blk = 0; blk < 4; ++blk) { const bf16x8 sf = *(const bf16x8*)(sp + (size_t)(32 * blk) * RDK + 16 * s_); o[blk] = MFMA32(qf[s_], sf, o[blk]); }
#pragma unroll
    for (int blk = 0; blk < 4; ++blk)
#pragma unroll
        for (int i = 0; i < 16; ++i) ORET[(tok0 + 32 * ib + crow(i, hh)) * 1024 + h * RDV + 32 * (4 * vh + blk) + l31] = o[blk][i];
}


typedef short v4i16_t __attribute__((ext_vector_type(4)));
DI s16x4 vtr(const LAS unsigned char* p) { return __builtin_bit_cast(s16x4, __builtin_amdgcn_ds_read_tr16_b64_v4i16((LAS v4i16_t*)p)); }
constexpr int MS_NSPLIT = 2, MS_KEYS = PAST / MS_NSPLIT, MS_TILES = MS_KEYS / 64;
DI void mla_sample_unit(LAS unsigned char* lds, const float* __restrict__ cckv, const float* __restrict__ ckpe, const int* __restrict__ pt,
                        const bf16_t* __restrict__ QLATb, const bf16_t* __restrict__ QPEb, float* __restrict__ PO, float* __restrict__ PML, int b, int split, float c2) {
    constexpr int KP = 328, KBYTES = 64 * KP * 2, SP = 68;
    LAS float* Sc = (LAS float*)(lds + 2 * KBYTES);
    const int tid = threadIdx.x, lane = tid & 63, w = __builtin_amdgcn_readfirstlane(tid >> 6), l31 = lane & 31, hh = lane >> 5, l15 = lane & 15, g4 = lane >> 4;
    const int kg = w >> 1, qg = w & 1;
    bf16x8 qf[10];
    { const int qi = 16 * qg + l15, t = qi >> 3, head = qi & 7;
      const bf16_t* ql = QLATb + (size_t)(b * DS + t) * 2048 + head * KVL + 8 * g4;
      const bf16_t* qp = QPEb + (size_t)(NP + b * DS + t) * 512 + head * DROPE + 8 * g4;
#pragma unroll
      for (int s_ = 0; s_ < 8; ++s_) qf[s_] = *(const bf16x8*)(ql + 32 * s_);
#pragma unroll
      for (int s_ = 0; s_ < 2; ++s_) qf[8 + s_] = *(const bf16x8*)(qp + 32 * s_); }
    f32x16 o;
#pragma unroll
    for (int i = 0; i < 16; ++i) o[i] = 0.f;
    float m = -INFINITY, lsum = 0.f;
    f32x4 crA[8], prA[2], crB[8], prB[2];
    const unsigned voffc = (unsigned)(((tid >> 6) * KVL + 4 * (tid & 63)) * 4), voffp = (unsigned)(((tid >> 4) * DROPE + 4 * (tid & 15)) * 4);
#define MS_LOAD(t_, CR_, PR_) do { const int key0_ = split * MS_KEYS + 64 * (t_); const int pg_ = __builtin_amdgcn_readfirstlane(pt[b * NPAGES + (key0_ >> 7)]); \
        const size_t rowb_ = (size_t)pg_ * PAGE + (key0_ & (PAGE - 1)); const char* cb_ = (const char*)(cckv + rowb_ * KVL); const char* pb_ = (const char*)(ckpe + rowb_ * DROPE); \
        _Pragma("unroll") for (int i_ = 0; i_ < 8; ++i_) CR_[i_] = __builtin_nontemporal_load((const f32x4*)(cb_ + (size_t)i_ * (8 * KVL * 4) + voffc)); \
        _Pragma("unroll") for (int i_ = 0; i_ < 2; ++i_) PR_[i_] = __builtin_nontemporal_load((const f32x4*)(pb_ + (size_t)i_ * (32 * DROPE * 4) + voffp)); } while (0)
#define MS_STORE(buf_, CR_, PR_) do { \
        _Pragma("unroll") for (int i_ = 0; i_ < 8; ++i_) { const int pc_ = tid + i_ * NTHREADS; *(LAS u32x2_t*)(lds + (buf_) * KBYTES + ((pc_ >> 6) * KP + 4 * (pc_ & 63)) * 2) = (u32x2_t){cvtpk(CR_[i_][0], CR_[i_][1]), cvtpk(CR_[i_][2], CR_[i_][3])}; } \
        _Pragma("unroll") for (int i_ = 0; i_ < 2; ++i_) { const int pc_ = tid + i_ * NTHREADS; *(LAS u32x2_t*)(lds + (buf_) * KBYTES + ((pc_ >> 4) * KP + KVL + 4 * (pc_ & 15)) * 2) = (u32x2_t){cvtpk(PR_[i_][0], PR_[i_][1]), cvtpk(PR_[i_][2], PR_[i_][3])}; } } while (0)
    __syncthreads();
    MS_LOAD(0, crA, prA); MS_LOAD(1, crB, prB); MS_STORE(0, crA, prA); MS_LOAD(2, crA, prA);
    __syncthreads();
    const int q4 = (lane & 15) >> 2, p4 = lane & 3, blk = (lane >> 4) & 1;
    auto tile = [&](const int buf) __attribute__((always_inline)) {
        const LAS unsigned char* kb_ = lds + buf * KBYTES;
        {   f32x4 s4 = {0.f, 0.f, 0.f, 0.f};
            const LAS unsigned char* kr_ = kb_ + ((16 * kg + l15) * KP + 8 * g4) * 2;
#pragma unroll
            for (int g_ = 0; g_ < 2; ++g_) { bf16x8 kf[5];
#pragma unroll
                for (int j = 0; j < 5; ++j) kf[j] = *(const LAS bf16x8*)(kr_ + 64 * (5 * g_ + j));
#pragma unroll
                for (int j = 0; j < 5; ++j) s4 = __builtin_amdgcn_mfma_f32_16x16x32_bf16(kf[j], qf[5 * g_ + j], s4, 0, 0, 0); }
            *(LAS f32x4*)(Sc + (16 * qg + l15) * SP + 16 * kg + 4 * g4) = s4; }
        __syncthreads();
        f32x4 sv[8];
#pragma unroll
        for (int i = 0; i < 8; ++i) sv[i] = *(const LAS f32x4*)(Sc + l31 * SP + 8 * i + 4 * hh);
        float mx = -INFINITY;
#pragma unroll
        for (int i = 0; i < 8; ++i) mx = fmaxf(mx, fmaxf(fmaxf(sv[i][0], sv[i][1]), fmaxf(sv[i][2], sv[i][3])));
        mx = fmaxf(mx, __shfl_xor(mx, 32));
        const float mn = fmaxf(m, mx);
        if (__builtin_amdgcn_ballot_w64(mn > m) != 0ull) {
            const float alpha = __builtin_amdgcn_exp2f((m - mn) * c2);
            lsum *= alpha;
#pragma unroll
            for (int i = 0; i < 16; ++i) o[i] *= alpha;
            m = mn;
        }
        const float nmc = -mn * c2;
        float ps = 0.f;
#pragma unroll
        for (int i = 0; i < 8; ++i)
#pragma unroll
            for (int e = 0; e < 4; ++e) { const float p = __builtin_amdgcn_exp2f(__builtin_fmaf(sv[i][e], c2, nmc)); sv[i][e] = p; ps += p; }
        lsum += ps;
#pragma unroll
        for (int ks = 0; ks < 4; ++ks) { const LAS unsigned char* a_ = kb_ + ((16 * ks + 4 * hh + q4) * KP + 32 * w + 16 * blk + 4 * p4) * 2;
            const s16x4 lo = vtr(a_), hi = vtr(a_ + 8 * KP * 2);
            const bf16x8 vf = __builtin_shufflevector(lo, hi, 0, 1, 2, 3, 4, 5, 6, 7); u32x4_t pk;
            pk.x = cvtpk(sv[2 * ks][0], sv[2 * ks][1]); pk.y = cvtpk(sv[2 * ks][2], sv[2 * ks][3]);
            pk.z = cvtpk(sv[2 * ks + 1][0], sv[2 * ks + 1][1]); pk.w = cvtpk(sv[2 * ks + 1][2], sv[2 * ks + 1][3]);
            o = MFMA32(vf, __builtin_bit_cast(bf16x8, pk), o); }
    };
    static_assert(MS_TILES % 2 == 0 && MS_TILES >= 4 && 2 * KBYTES + 32 * SP * 4 <= MISC_OFF, "mla_sample_unit pipeline");
#pragma unroll 1
    for (int t = 0; t < MS_TILES; t += 2) {
        tile(0);
        MS_STORE(1, crB, prB);
        if (t + 3 < MS_TILES) MS_LOAD(t + 3, crB, prB);
        __syncthreads();
        tile(1);
        if (t + 2 < MS_TILES) { MS_STORE(0, crA, prA); }
        if (t + 4 < MS_TILES) MS_LOAD(t + 4, crA, prA);
        __syncthreads();
    }
#undef MS_LOAD
#undef MS_STORE
    lsum += __shfl_xor(lsum, 32);
    const int item = b * MS_NSPLIT + split;
    if (w == 0 && lane < 32) { PML[(item * 32 + lane) * 2] = m * c2; PML[(item * 32 + lane) * 2 + 1] = lsum; }
#pragma unroll
    for (int i = 0; i < 16; ++i) PO[((size_t)item * 32 + l31) * KVL + 32 * w + crow(i, hh)] = o[i];
}


struct RetItem { int b, h, c, vh; };
DI RetItem ret_item(int it) { RetItem r; r.vh = it & 1; r.c = (it >> 1) & 15; r.h = (it >> 5) & 3; r.b = it >> 7; return r; }
DI void ret_out_phase(LAS unsigned char* lds, const bf16_t* __restrict__ RQt, const bf16_t* __restrict__ RKt, const bf16_t* __restrict__ RVT, const bf16_t* __restrict__ SPT, float* __restrict__ ORET, int bid, int G) {
    constexpr int PITCH = 136, TILE = 128 * PITCH * 2;
    const int tid = threadIdx.x, lane = tid & 63, w = __builtin_amdgcn_readfirstlane(tid >> 6), l31 = lane & 31, hh = lane >> 5;
    const int ib = w & 3, dq = w >> 2;
    u32x4_t st[12];
#define RO_LOAD(it_) do { const RetItem q_ = ret_item(it_); const size_t tok0_ = (size_t)q_.b * SEQ + q_.c * 128; \
        _Pragma("unroll") for (int i_ = 0; i_ < 12; ++i_) { const int p_ = tid + i_ * NTHREADS, tl_ = p_ >> 11, row_ = (p_ >> 4) & 127, c16_ = p_ & 15; const bf16_t* src_; \
            if (tl_ == 0) src_ = RKt + (tok0_ + row_) * 512 + q_.h * RDK + 8 * c16_; \
            else if (tl_ == 1) src_ = RVT + (size_t)(q_.h * RDV + 128 * q_.vh + row_) * NT + tok0_ + 8 * c16_; \
            else src_ = SPT + (size_t)(((q_.b * RH + q_.h) * 16) + q_.c) * 32768 + (size_t)(128 * q_.vh + row_) * RDK + 8 * c16_; \
            st[i_] = *(const u32x4_t*)src_; } } while (0)
#define RO_STORE() do { _Pragma("unroll") for (int i_ = 0; i_ < 12; ++i_) { const int p_ = tid + i_ * NTHREADS, tl_ = p_ >> 11, row_ = (p_ >> 4) & 127, c16_ = p_ & 15; \
            *(LAS u32x4_t*)(lds + tl_ * TILE + (row_ * PITCH + 8 * c16_) * 2) = st[i_]; } } while (0)
    int it = bid;
    if (it < NB * RH * 16 * 2) RO_LOAD(it);
    for (; it < NB * RH * 16 * 2; it += G) {
        const RetItem q = ret_item(it); const size_t tok0 = (size_t)q.b * SEQ + q.c * 128;
        __syncthreads();
        RO_STORE();
        bf16x8 qf[8];
        { const bf16_t* qp = RQt + (tok0 + 32 * ib + l31) * 512 + q.h * RDK + 8 * hh;
#pragma unroll
          for (int s_ = 0; s_ < 8; ++s_) qf[s_] = *(const bf16x8*)(qp + 16 * s_); }
        __syncthreads();
        if (it + G < NB * RH * 16 * 2) RO_LOAD(it + G);
        const LAS unsigned char* Kl = lds; const LAS unsigned char* Vl = lds + TILE; const LAS unsigned char* Sl = lds + 2 * TILE;
        f32x16 o[2];
#pragma unroll
        for (int blk = 0; blk < 2; ++blk)
#pragma unroll
            for (int i = 0; i < 16; ++i) o[blk][i] = 0.f;
#pragma unroll 1
        for (int jb = 0; jb <= ib; ++jb) {
            f32x16 x;
#pragma unroll
            for (int i = 0; i < 16; ++i) x[i] = 0.f;
#pragma unroll
            for (int s_ = 0; s_ < 8; ++s_) { const bf16x8 kf = *(const LAS bf16x8*)(Kl + ((32 * jb + l31) * PITCH + 16 * s_ + 8 * hh) * 2); x = MFMA32(kf, qf[s_], x); }
            if (jb == ib) {
#pragma unroll
                for (int i = 0; i < 16; ++i) x[i] = (crow(i, hh) <= l31) ? x[i] : 0.f;
            }
#pragma unroll
            for (int s2 = 0; s2 < 2; ++s2) {
                u32x4_t pk; pk.x = cvtpk(x[8 * s2 + 0], x[8 * s2 + 1]); pk.y = cvtpk(x[8 * s2 + 2], x[8 * s2 + 3]); pk.z = cvtpk(x[8 * s2 + 4], x[8 * s2 + 5]); pk.w = cvtpk(x[8 * s2 + 6], x[8 * s2 + 7]);
                const bf16x8 pa = __builtin_bit_cast(bf16x8, pk);
#pragma unroll
                for (int blk = 0; blk < 2; ++blk) { const LAS unsigned char* vp = Vl + ((64 * dq + 32 * blk + l31) * PITCH + 32 * jb + 16 * s2 + 4 * hh) * 2;
                    const s16x4 lo = *(const LAS s16x4*)vp, hi = *(const LAS s16x4*)(vp + 16);
                    o[blk] = MFMA32(pa, __builtin_shufflevector(lo, hi, 0, 1, 2, 3, 4, 5, 6, 7), o[blk]); }
            }
        }
#pragma unroll
        for (int s_ = 0; s_ < 8; ++s_)
#pragma unroll
            for (int blk = 0; blk < 2; ++blk) { const bf16x8 sf = *(const LAS bf16x8*)(Sl + ((64 * dq + 32 * blk + l31) * PITCH + 16 * s_ + 8 * hh) * 2); o[blk] = MFMA32(qf[s_], sf, o[blk]); }
#pragma unroll
        for (int blk = 0; blk < 2; ++blk)
#pragma unroll
            for (int i = 0; i < 16; ++i) ORET[(tok0 + 32 * ib + crow(i, hh)) * 1024 + q.h * RDV + 128 * q.vh + 64 * dq + 32 * blk + l31] = o[blk][i];
    }
#undef RO_LOAD
#undef RO_STORE
}


DI void ret_state_phase(LAS unsigned char* lds, const bf16_t* __restrict__ RVT, const bf16_t* __restrict__ RKtT, float* __restrict__ UT, int bid, int G) {
    constexpr int PITCH = 136;
    const int tid = threadIdx.x, lane = tid & 63, w = __builtin_amdgcn_readfirstlane(tid >> 6), l31 = lane & 31, hh = lane >> 5;
    u32x4_t st[12];
#define RS_LOAD(it_) do { const int c_ = (it_) & 15, h_ = ((it_) >> 4) & 3, b_ = (it_) >> 6; const size_t tok0_ = (size_t)b_ * SEQ + c_ * 128; \
        _Pragma("unroll") for (int i_ = 0; i_ < 12; ++i_) { const int p_ = tid + i_ * NTHREADS, row_ = p_ >> 4, c16_ = p_ & 15; \
            const bf16_t* src_ = row_ < 256 ? RVT + (size_t)(h_ * RDV + row_) * NT + tok0_ + 8 * c16_ : RKtT + (size_t)(h_ * RDK + (row_ - 256)) * NP + tok0_ + 8 * c16_; \
            st[i_] = *(const u32x4_t*)src_; } } while (0)
    int it = bid;
    if (it < NB * RH * 16) RS_LOAD(it);
    for (; it < NB * RH * 16; it += G) {
        __syncthreads();
#pragma unroll
        for (int i = 0; i < 12; ++i) { const int p = tid + i * NTHREADS; *(LAS u32x4_t*)(lds + ((p >> 4) * PITCH + 8 * (p & 15)) * 2) = st[i]; }
        __syncthreads();
        if (it + G < NB * RH * 16) RS_LOAD(it + G);
        f32x16 acc[4];
#pragma unroll
        for (int kb = 0; kb < 4; ++kb)
#pragma unroll
            for (int i = 0; i < 16; ++i) acc[kb][i] = 0.f;
#pragma unroll
        for (int s_ = 0; s_ < 8; ++s_) { const bf16x8 a = *(const LAS bf16x8*)(lds + ((32 * w + l31) * PITCH + 16 * s_ + 8 * hh) * 2);
#pragma unroll
            for (int kb = 0; kb < 4; ++kb) { const bf16x8 b_ = *(const LAS bf16x8*)(lds + ((256 + 32 * kb + l31) * PITCH + 16 * s_ + 8 * hh) * 2); acc[kb] = MFMA32(a, b_, acc[kb]); } }
        float* u = UT + (size_t)it * 32768;
#pragma unroll
        for (int kb = 0; kb < 4; ++kb)
#pragma unroll
            for (int i = 0; i < 16; ++i) u[(32 * w + crow(i, hh)) * RDK + 32 * kb + l31] = acc[kb][i];
    }
#undef RS_LOAD
}

struct QPtr { const float* p; DI float operator()(int d) const { return p[d]; } };
struct QMla { const float* ql; const float* qp; DI float operator()(int d) const { return d < KVL ? ql[d] : qp[d - KVL]; } };
DI void rms_row(const float* x, const float* g, float* o, int n, int lane) {
    float s = 0.f;
    for (int i = lane; i < n; i += 64) { const float v = x[i]; s += v * v; }
    const float r = rsqrtf(wave_sum(s) / (float)n + EPS);
    for (int i = lane; i < n; i += 64) o[i] = x[i] * r * g[i];
}

DI void rms_row_bf16(const float* x, const float* g, bf16_t* o, int n, int lane) {
    float s = 0.f;
    for (int i = lane; i < n; i += 64) { const float v = x[i]; s += v * v; }
    const float r = rsqrtf(wave_sum(s) / (float)n + EPS);
    for (int i = lane; i < n; i += 64) o[i] = f2bf(x[i] * r * g[i]);
}
#define GEMM_PHASE(EPI, ...) pg8::gemm_phase<EPI, pg8::StaticOrder, true, true>(__VA_ARGS__)
#define GEMM_SPLIT(...) pg8::gemm_phase<pg8::EpiPart, pg8::SplitOrder, true, true>(__VA_ARGS__)
__global__ void __launch_bounds__(NTHREADS, 2) fwd_kernel(Args args) {
    extern __shared__ __attribute__((aligned(16))) unsigned char lds_raw[];
    LAS unsigned char* ldsb = (LAS unsigned char*)lds_raw;
    LAS float* lds = (LAS float*)ldsb;
    volatile LAS unsigned* MISC = (volatile LAS unsigned*)(ldsb + MISC_OFF);
    const int tid = threadIdx.x, lane = tid & 63, wave = tid >> 6;
    const int G = gridDim.x, bid = blockIdx.x;
    const int gw = bid * NWAVES + wave, NGW = G * NWAVES;
    unsigned char* ws = args.ws;
    float* out = args.out;
    const int lo = args.ph_lo, hi = args.ph_hi;

    if (tid < 64) MISC[tid] = 0u;
    __syncthreads();
    XcdBarrier bar; bar.bar = (unsigned*)(ws + WS_CTL) + CW_BAR; bar.x = 0; bar.st = MISC;
    if (hi - lo > 1) bar = xcd_barrier_post((unsigned*)(ws + WS_CTL) + CW_BAR, MISC);
#define IN(k) (lo <= (k) && (k) < hi)
#define SEAM(k) do { if (IN(k) && IN((k) + 1)) xcd_barrier(bar); } while (0)

#define x_prompt ((const float*)(args.in[0]))
#define x_sample ((const float*)(args.in[1]))
#define mem_prompt ((const float*)(args.in[2]))
#define cache_ckv ((const float*)(args.in[3]))
#define cache_kpe ((const float*)(args.in[4]))
#define page_table ((const int*)args.in[5])
#define state_ret ((const float*)(args.in[6]))
#define cache_mem_k ((const float*)(args.in[7]))
#define cache_mem_v ((const float*)(args.in[8]))
#define g_mix_pre ((const float*)(args.in[9]))
#define g_mix_post ((const float*)(args.in[10]))
#define g_ffn_pre ((const float*)(args.in[11]))
#define g_ffn_post ((const float*)(args.in[12]))
#define g_mem ((const float*)(args.in[13]))
#define g_qlat ((const float*)(args.in[14]))
#define g_kvlat ((const float*)(args.in[15]))
#define w_in ((const float*)(args.in[16]))
#define w_uq ((const float*)(args.in[17]))
#define w_uk ((const float*)(args.in[18]))
#define w_uv ((const float*)(args.in[19]))
#define w_mem_k ((const float*)(args.in[20]))
#define w_mem_v ((const float*)(args.in[21]))
#define w_ret_o ((const float*)(args.in[22]))
#define w_mla_o ((const float*)(args.in[23]))
#define w_x_o ((const float*)(args.in[24]))
#define w_out ((const float*)(args.in[25]))
#define w_gate ((const float*)(args.in[26]))
#define w_up ((const float*)(args.in[27]))
#define w_down ((const float*)(args.in[28]))
#define COSA ((float*)(ws + WS_COSA))
#define SINA ((float*)(ws + WS_SINA))
#define COSB ((float*)(ws + WS_COSB))
#define SINB ((float*)(ws + WS_SINB))
#define U ((float*)(ws + WS_U))
#define MN ((float*)(ws + WS_MN))
#define Zb ((bf16_t*)(ws + WS_Z))
#define RQ ((float*)(ws + WS_RQ))
#define RK ((float*)(ws + WS_RK))
#define CQN ((float*)(ws + WS_CQN))
#define CKVN ((float*)(ws + WS_CKVN))
#define KPER ((float*)(ws + WS_KPER))
#define Q ((float*)(ws + WS_Q))
#define QLAT ((float*)(ws + WS_QLAT))
#define QPE ((float*)(ws + WS_QPE))
#define ORET ((float*)(ws + WS_ORET))
#define OLAT ((float*)(ws + WS_OLAT))
#define OX ((float*)(ws + WS_OX))
#define OMLA ((float*)(ws + WS_OMLA))
#define ORETN ((float*)(ws + WS_ORETN))
#define ARET ((float*)(ws + WS_ARET))
#define AMLA ((float*)(ws + WS_AMLA))
#define AX ((float*)(ws + WS_AX))
#define MIX ((float*)(ws + WS_MIX))
#define HPb ((bf16_t*)(ws + WS_HP))
#define Hb ((bf16_t*)(ws + WS_H))
#define F ((float*)(ws + WS_F))
#define GU ((float*)(ws + WS_GG))
#define FOb ((bf16_t*)(ws + WS_FO))
#define WinT ((bf16_t*)(ws + WS_WIN_T))
#define WmkvT ((bf16_t*)(ws + WS_WMKV_T))
#define WuqT ((bf16_t*)(ws + WS_WUQ_T))
#define WcatT ((bf16_t*)(ws + WS_WRO_T))
#define CATb ((bf16_t*)(ws + WS_ORETNB))
#define WroT ((bf16_t*)(ws + WS_WRO_T))
#define WmoT ((bf16_t*)(ws + WS_WMO_T))
#define WxoT ((bf16_t*)(ws + WS_WXO_T))
#define WoT ((bf16_t*)(ws + WS_WO_T))
#define WguT ((bf16_t*)(ws + WS_WGU_T))
#define WdT ((bf16_t*)(ws + WS_WD_T))
#define Ub ((bf16_t*)(ws + WS_UB))
#define MNb ((bf16_t*)(ws + WS_MNB))
#define CQNb ((bf16_t*)(ws + WS_CQNB))
#define ORETNb ((bf16_t*)(ws + WS_ORETNB))
#define OMLAb ((bf16_t*)(ws + WS_OMLAB))
#define OXb ((bf16_t*)(ws + WS_OXB))
#define MIXb ((bf16_t*)(ws + WS_MIXB))
#define Fb ((bf16_t*)(ws + WS_FB))
#define ACTb ((bf16_t*)(ws + WS_ACTB))
#define WukT ((bf16_t*)(ws + WS_WUK_T))
#define WuvT ((bf16_t*)(ws + WS_WUV_T))
#define CKVNb ((bf16_t*)(ws + WS_CKVNB))
#define KPERb ((bf16_t*)(ws + WS_KPERB))
#define XQb ((bf16_t*)(ws + WS_XQB))
#define MKb ((bf16_t*)(ws + WS_MKB))
#define MVT ((bf16_t*)(ws + WS_MVT))
#define KN ((bf16_t*)(ws + WS_KN))
#define VT ((bf16_t*)(ws + WS_VT))
#define Qb ((bf16_t*)(ws + WS_QB))
#define RQt ((bf16_t*)(ws + WS_RQT))
#define RKt ((bf16_t*)(ws + WS_RKT))
#define RKtT ((bf16_t*)(ws + WS_RKTT))
#define RVT ((bf16_t*)(ws + WS_RVT))
#define UT ((float*)(ws + WS_UT))
#define SPT ((bf16_t*)(ws + WS_SPT))
#define QPEb ((bf16_t*)(ws + WS_QPEB))
#define WukB ((bf16_t*)(ws + WS_WUKB))
#define PART ((float*)(ws + WS_PART))
#define SGb ((bf16_t*)(ws + WS_SGB))
#define SRGb ((bf16_t*)(ws + WS_SRGB))
#define T0b ((bf16_t*)(ws + WS_T0B))
#define T1b ((bf16_t*)(ws + WS_T1B))
#define QLATb ((bf16_t*)(ws + WS_QLATB))
#define PO ((float*)(ws + WS_PO))
#define PML ((float*)(ws + WS_PML))
    if (IN(0)) {
        for (int i = bid * NTHREADS + tid; i < NPOS * 64 + NPOS * 32; i += G * NTHREADS) {
            const bool a = i < NPOS * 64; const int j = a ? i : i - NPOS * 64; const int half = a ? 64 : 32;
            const int p = j / half, f = j % half; const int pos = p < SEQ ? p : PAST + (p - SEQ);
            const float inv = powf(10000.0f, -(float)f / (float)half);
            const float ang = (float)pos * inv;
            double rev = (double)ang * 0.15915494309189535; rev -= floor(rev);
            const float r = (float)rev;
            const float sn = __builtin_amdgcn_sinf(r), cs = __builtin_amdgcn_cosf(r);
            if (a) { COSA[j] = cs; SINA[j] = sn; } else { COSB[j] = cs; SINB[j] = sn; }
        }
#pragma unroll 1
        for (int pass = 0; pass < 2; ++pass) {
            const int nrows = pass ? NB * NMEM : NT; const float* gsrc = pass ? g_mem : g_mix_pre; bf16_t* dst = pass ? MNb : Ub;
            f32x4 a[4];
#define P0_SRC(r_) (pass ? mem_prompt + (size_t)(r_) * DM : (r_) < NP ? x_prompt + (size_t)(r_) * DM : x_sample + (size_t)((r_) - NP) * DM)
#define P0_LOAD(r_, A_) do { const float* s_ = P0_SRC(r_); _Pragma("unroll") for (int j_ = 0; j_ < 4; ++j_) A_[j_] = *(const f32x4*)(s_ + 4 * lane + 256 * j_); } while (0)
            int row = gw;
            if (row < nrows) P0_LOAD(row, a);
#pragma unroll 1
            for (; row < nrows; row += NGW) {
                f32x4 an[4]; const int nr = row + NGW;
                if (nr < nrows) P0_LOAD(nr, an);
                float ss = 0.f;
#pragma unroll
                for (int j = 0; j < 4; ++j) ss += a[j][0] * a[j][0] + a[j][1] * a[j][1] + a[j][2] * a[j][2] + a[j][3] * a[j][3];
                const float r = rsqrtf(wave_sum(ss) * (1.f / DM) + EPS);
#pragma unroll
                for (int j = 0; j < 4; ++j) { const f32x4 v = a[j] * r * *(const f32x4*)(gsrc + 4 * lane + 256 * j); *(u32x2_t*)(dst + (size_t)row * DM + 4 * lane + 256 * j) = (u32x2_t){cvtpk(v[0], v[1]), cvtpk(v[2], v[3])}; }
#pragma unroll
                for (int j = 0; j < 4; ++j) a[j] = an[j];
            }
#undef P0_LOAD
#undef P0_SRC
        }
        {
            LAS float* scr = lds + wave * (64 * 33);
            int rot = 0;
            transpose_w(w_in, 1024, DIN, WinT, 1024, 0, scr, gw, NGW, lane, rot);
            for (int i = bid * NTHREADS + tid; i < (ZLD - DIN) * 1024 / 2; i += G * NTHREADS) ((unsigned*)(WinT + (size_t)DIN * 1024))[i] = 0u;
            for (int i = bid * NTHREADS + tid; i < MH * KVL * DNOPE / 4; i += G * NTHREADS) { const f32x4 v = *(const f32x4*)(w_uk + 4 * (size_t)i); *(u32x2_t*)(WukB + 4 * (size_t)i) = (u32x2_t){cvtpk(v[0], v[1]), cvtpk(v[2], v[3])}; }
            transpose_w(w_mem_k, 1024, 256, WmkvT, 1024, 0, scr, gw, NGW, lane, rot);
            transpose_w(w_mem_v, 1024, 256, WmkvT, 1024, 256, scr, gw, NGW, lane, rot);
            transpose_w(w_uq, QL, 1536, WuqT, QL, 0, scr, gw, NGW, lane, rot);
            transpose_w(w_ret_o, 1024, 1024, WcatT, CATLD, 0, scr, gw, NGW, lane, rot);
            transpose_w(w_mla_o, 1024, 1024, WcatT + 1024, CATLD, 0, scr, gw, NGW, lane, rot);
            transpose_w(w_x_o, 256, 1024, WcatT + 2048, CATLD, 0, scr, gw, NGW, lane, rot);
            transpose_w(w_out, 1024, 1024, WoT, 1024, 0, scr, gw, NGW, lane, rot);
            transpose_w(w_gate, 1024, DFF, WguT, 1024, 0, scr, gw, NGW, lane, rot, 2);
            transpose_w(w_up, 1024, DFF, WguT, 1024, 1, scr, gw, NGW, lane, rot, 2);
            transpose_w(w_down, DFF, 1024, WdT, DFF, 0, scr, gw, NGW, lane, rot);
            for (int hh = 0; hh < MH; ++hh) { transpose_w(w_uk + (size_t)hh * KVL * DNOPE, KVL, DNOPE, WukT, KVL, hh * DNOPE, scr, gw, NGW, lane, rot);
                                              transpose_w(w_uv + (size_t)hh * KVL * DVH, KVL, DVH, WuvT, KVL, hh * DVH, scr, gw, NGW, lane, rot); }
        }
    }
    SEAM(0);
    if (IN(1)) {
        static_assert(WS_MNB == WS_UB + (size_t)NT * 1024 * 2 && WS_WMKV_T == WS_WIN_T + (size_t)ZLD * 1024 * 2, "P1 stacks Ub|MNb and WinT|WmkvT");
        { pg8::Gemm g{Ub, WinT, NT + NB * NMEM, ZLD + 512, 1024, 1024, 1024}; pg8::P1Order S; S.init(G, bid); pg8::EpiP1 E{Zb, ZLD, out + O_MKP, out + O_MVP, SRGb, SGb, C_RG, C_G};
          pg8::gemm_phase<pg8::EpiP1, pg8::P1Order, true, true>(ldsb, g, S, E); }
        __syncthreads();
        { pg8::Gemm g{WinT + (size_t)C_RV * 1024, Ub, 1024, NP, 1024, 1024, 1024}; pg8::StaticOrder S; S.init(1024, NP, G, bid); pg8::EpiBf16S E{RVT, NT};
          GEMM_PHASE(pg8::EpiBf16S, ldsb, g, S, E); }
    }
    SEAM(1);
    if (IN(2)) {
        constexpr int KTP = 520;
        LAS bf16_t* Kt = (LAS bf16_t*)ldsb;
        const int ntile = NP / 64, nwork = ntile + (NS + 63) / 64;
        for (int wk = bid; wk < nwork; wk += G) {
            const bool prompt = wk < ntile; const int row_base = prompt ? wk * 64 : NP + (wk - ntile) * 64;
            __syncthreads();
            {
                const int hq = lane >> 4, f4 = (lane & 15) * 4;
                u32x2_t q1, q2, k1, k2, cv, p1, p2; u32x4_t cq8; f32x4 ca, sa, cb, sb; int p;
#define P2_LOAD(r_, Q1_, Q2_, K1_, K2_, CQ_, CV_, P1_, P2_, CA_, SA_, CB_, SB_, P_) do { const bf16_t* z_ = Zb + (size_t)(row_base + (r_)) * ZLD; P_ = pos_index(row_base + (r_)); \
                Q1_ = *(const u32x2_t*)(z_ + C_RQ + hq * RDK + f4); Q2_ = *(const u32x2_t*)(z_ + C_RQ + hq * RDK + 64 + f4); K1_ = *(const u32x2_t*)(z_ + C_RK + hq * RDK + f4); K2_ = *(const u32x2_t*)(z_ + C_RK + hq * RDK + 64 + f4); \
                CQ_ = (u32x4_t){0u, 0u, 0u, 0u}; if (lane < 48) CQ_ = *(const u32x4_t*)(z_ + C_CQ + 8 * lane); CV_ = *(const u32x2_t*)(z_ + C_CKV + 4 * lane); \
                P1_ = (u32x2_t){0u, 0u}; P2_ = P1_; CB_ = (f32x4){0.f, 0.f, 0.f, 0.f}; SB_ = CB_; \
                if (lane < 8) { P1_ = *(const u32x2_t*)(z_ + C_KPE + 4 * lane); P2_ = *(const u32x2_t*)(z_ + C_KPE + 32 + 4 * lane); CB_ = *(const f32x4*)(COSB + P_ * 32 + 4 * lane); SB_ = *(const f32x4*)(SINB + P_ * 32 + 4 * lane); } \
                CA_ = *(const f32x4*)(COSA + P_ * 64 + f4); SA_ = *(const f32x4*)(SINA + P_ * 64 + f4); } while (0)
#define BLO(x_) __builtin_bit_cast(float, (x_) << 16)
#define BHI(x_) __builtin_bit_cast(float, (x_) & 0xffff0000u)
                int r = wave;
                P2_LOAD(r, q1, q2, k1, k2, cq8, cv, p1, p2, ca, sa, cb, sb, p);
                for (; r < 64; r += NWAVES) {
                    u32x2_t q1n, q2n, k1n, k2n, cvn, p1n, p2n; u32x4_t cq8n; f32x4 can, san, cbn, sbn; int pn;
                    if (r + NWAVES < 64) P2_LOAD(r + NWAVES, q1n, q2n, k1n, k2n, cq8n, cvn, p1n, p2n, can, san, cbn, sbn, pn);
                    const int row = row_base + r; const int il = p & 127;
                    {
                        const float x1q[4] = {BLO(q1.x), BHI(q1.x), BLO(q1.y), BHI(q1.y)}, x2q[4] = {BLO(q2.x), BHI(q2.x), BLO(q2.y), BHI(q2.y)};
                        const float x1k[4] = {BLO(k1.x), BHI(k1.x), BLO(k1.y), BHI(k1.y)}, x2k[4] = {BLO(k2.x), BHI(k2.x), BLO(k2.y), BHI(k2.y)};
                        const float sc = 0.08838834764831845f;
                        float oq1[4], oq2[4], ok1[4], ok2[4];
#pragma unroll
                        for (int e = 0; e < 4; ++e) { oq1[e] = x1q[e] * ca[e] - x2q[e] * sa[e]; oq2[e] = x1q[e] * sa[e] + x2q[e] * ca[e];
                            ok1[e] = (x1k[e] * ca[e] - x2k[e] * sa[e]) * sc; ok2[e] = (x1k[e] * sa[e] + x2k[e] * ca[e]) * sc; }
                        if (prompt) {
                            const float fq = __expf((float)(il - 127) * lg_gamma(hq)), fk = 1.f / fq;
                            *(u32x2_t*)(RQt + (size_t)row * 512 + hq * RDK + f4) = (u32x2_t){cvtpk(oq1[0] * fq, oq1[1] * fq), cvtpk(oq1[2] * fq, oq1[3] * fq)};
                            *(u32x2_t*)(RQt + (size_t)row * 512 + hq * RDK + 64 + f4) = (u32x2_t){cvtpk(oq2[0] * fq, oq2[1] * fq), cvtpk(oq2[2] * fq, oq2[3] * fq)};
                            const u32x2_t kb1 = {cvtpk(ok1[0] * fk, ok1[1] * fk), cvtpk(ok1[2] * fk, ok1[3] * fk)}, kb2 = {cvtpk(ok2[0] * fk, ok2[1] * fk), cvtpk(ok2[2] * fk, ok2[3] * fk)};
                            *(u32x2_t*)(RKt + (size_t)row * 512 + hq * RDK + f4) = kb1; *(u32x2_t*)(RKt + (size_t)row * 512 + hq * RDK + 64 + f4) = kb2;
                            *(LAS u32x2_t*)(Kt + r * KTP + hq * RDK + f4) = kb1; *(LAS u32x2_t*)(Kt + r * KTP + hq * RDK + 64 + f4) = kb2;
                        } else {
                            *(f32x4*)(RQ + (size_t)row * 512 + hq * RDK + f4) = (f32x4){oq1[0], oq1[1], oq1[2], oq1[3]}; *(f32x4*)(RQ + (size_t)row * 512 + hq * RDK + 64 + f4) = (f32x4){oq2[0], oq2[1], oq2[2], oq2[3]};
                            *(f32x4*)(RK + (size_t)row * 512 + hq * RDK + f4) = (f32x4){ok1[0], ok1[1], ok1[2], ok1[3]}; *(f32x4*)(RK + (size_t)row * 512 + hq * RDK + 64 + f4) = (f32x4){ok2[0], ok2[1], ok2[2], ok2[3]};
                        }
                    }
                    {
                        const float c_[8] = {BLO(cq8.x), BHI(cq8.x), BLO(cq8.y), BHI(cq8.y), BLO(cq8.z), BHI(cq8.z), BLO(cq8.w), BHI(cq8.w)};
                        float ss = 0.f;
#pragma unroll
                        for (int e = 0; e < 8; ++e) ss += c_[e] * c_[e];
                        const float rr = rsqrtf(wave_sum(ss) * (1.f / QL) + EPS);
                        if (lane < 48) { const f32x4 g0 = *(const f32x4*)(g_qlat + 8 * lane), g1 = *(const f32x4*)(g_qlat + 8 * lane + 4);
                            *(u32x4_t*)(CQNb + (size_t)row * QL + 8 * lane) = (u32x4_t){cvtpk(c_[0] * rr * g0[0], c_[1] * rr * g0[1]), cvtpk(c_[2] * rr * g0[2], c_[3] * rr * g0[3]),
                                                                                     cvtpk(c_[4] * rr * g1[0], c_[5] * rr * g1[1]), cvtpk(c_[6] * rr * g1[2], c_[7] * rr * g1[3])}; }
                    }
                    {
                        const float v_[4] = {BLO(cv.x), BHI(cv.x), BLO(cv.y), BHI(cv.y)};
                        const float rr = rsqrtf(wave_sum(v_[0] * v_[0] + v_[1] * v_[1] + v_[2] * v_[2] + v_[3] * v_[3]) * (1.f / KVL) + EPS);
                        const f32x4 g0 = *(const f32x4*)(g_kvlat + 4 * lane); const f32x4 o_ = {v_[0] * rr * g0[0], v_[1] * rr * g0[1], v_[2] * rr * g0[2], v_[3] * rr * g0[3]};
                        float* ockv = row < NP ? out + O_CKVP + (size_t)row * KVL : out + O_CKVS + (size_t)(row - NP) * KVL;
                        *(f32x4*)(ockv + 4 * lane) = o_; *(f32x4*)(CKVN + (size_t)row * KVL + 4 * lane) = o_;
                        *(u32x2_t*)(CKVNb + (size_t)row * KVL + 4 * lane) = (u32x2_t){cvtpk(o_[0], o_[1]), cvtpk(o_[2], o_[3])};
                    }
                    if (lane < 8) {
                        const float x1[4] = {BLO(p1.x), BHI(p1.x), BLO(p1.y), BHI(p1.y)}, x2[4] = {BLO(p2.x), BHI(p2.x), BLO(p2.y), BHI(p2.y)};
                        f32x4 o1, o2;
#pragma unroll
                        for (int e = 0; e < 4; ++e) { o1[e] = x1[e] * cb[e] - x2[e] * sb[e]; o2[e] = x1[e] * sb[e] + x2[e] * cb[e]; }
                        *(f32x4*)(KPER + (size_t)row * DROPE + 4 * lane) = o1; *(f32x4*)(KPER + (size_t)row * DROPE + 32 + 4 * lane) = o2;
                        float* okpe = row < NP ? out + O_KPEP + (size_t)row * DROPE : out + O_KPES + (size_t)(row - NP) * DROPE;
                        *(f32x4*)(okpe + 4 * lane) = o1; *(f32x4*)(okpe + 32 + 4 * lane) = o2;
                        *(u32x2_t*)(KPERb + (size_t)row * DROPE + 4 * lane) = (u32x2_t){cvtpk(o1[0], o1[1]), cvtpk(o1[2], o1[3])}; *(u32x2_t*)(KPERb + (size_t)row * DROPE + 32 + 4 * lane) = (u32x2_t){cvtpk(o2[0], o2[1]), cvtpk(o2[2], o2[3])};
                    }
                    q1 = q1n; q2 = q2n; k1 = k1n; k2 = k2n; cq8 = cq8n; cv = cvn; p1 = p1n; p2 = p2n; ca = can; sa = san; cb = cbn; sb = sbn; p = pn;
                }
#undef P2_LOAD
            }
            __syncthreads();
            if (prompt) {
#pragma unroll 2
                for (int i = 0; i < 8; ++i) { const int pc = tid + i * NTHREADS, f = pc >> 3, k8 = pc & 7;
                    const LAS bf16_t* c = Kt + (8 * k8) * KTP + f;
                    pg8::u32x4 o; o.x = (unsigned)c[0] | ((unsigned)c[KTP] << 16); o.y = (unsigned)c[2 * KTP] | ((unsigned)c[3 * KTP] << 16);
                    o.z = (unsigned)c[4 * KTP] | ((unsigned)c[5 * KTP] << 16); o.w = (unsigned)c[6 * KTP] | ((unsigned)c[7 * KTP] << 16);
                    *(pg8::u32x4*)(RKtT + (size_t)f * NP + row_base + 8 * k8) = o; }
            }
        }
    }
    if (IN(2)) {
        for (int i = bid * NTHREADS + tid; i < NB * NMEM * 256; i += G * NTHREADS) { MKb[i] = f2bf(out[O_MKP + i]);
            const int f = i / (NB * NMEM), r = i - f * (NB * NMEM); MVT[i] = f2bf(out[O_MVP + (size_t)r * 256 + f]); }
    }
    SEAM(2);
    if (IN(3)) { pg8::Gemm g{CQNb, WuqT, NT, 1536, QL, QL, QL}; pg8::StaticOrder S; S.init(NT, 1536, G, bid); pg8::EpiBf16S E{Qb, 1536};
        GEMM_PHASE(pg8::EpiBf16S, ldsb, g, S, E);
        __syncthreads();
        { pg8::Gemm g2{CKVNb, WukT, NP, 1024, KVL, KVL, KVL}; pg8::StaticOrder S2; S2.init(NP, 1024, G, bid); pg8::EpiBf16S E2{KN, 1024}; GEMM_PHASE(pg8::EpiBf16S, ldsb, g2, S2, E2); }
        __syncthreads();
        { pg8::Gemm g3{WuvT, CKVNb, 1024, NP, KVL, KVL, KVL}; pg8::StaticOrder S3; S3.init(1024, NP, G, bid); pg8::EpiBf16S E3{VT, NP}; GEMM_PHASE(pg8::EpiBf16S, ldsb, g3, S3, E3); }
        ret_state_phase(ldsb, RVT, RKtT, UT, bid, G); }
    SEAM(3);
    if (IN(4)) {
        for (int idx = bid * NTHREADS + tid; idx < NB * RH * 8192; idx += G * NTHREADS) {
            const int bh = idx >> 13, e = (idx & 8191) * 4; const float g128 = __expf(128.f * lg_gamma(bh & 3));
            f32x4 u[16];
#pragma unroll
            for (int c = 0; c < 16; ++c) u[c] = __builtin_nontemporal_load((const f32x4*)(UT + (size_t)(bh * 16 + c) * 32768 + e));
            f32x4 sp = {0.f, 0.f, 0.f, 0.f}, S = sp;
#pragma unroll
            for (int c = 0; c < 16; ++c) { *(u32x2_t*)(SPT + (size_t)(bh * 16 + c) * 32768 + e) = (u32x2_t){cvtpk(sp[0], sp[1]), cvtpk(sp[2], sp[3])}; S = sp + u[c]; sp = S * g128; }
            const int dv = e >> 7, dk = e & 127; float* o_ = out + O_RETP + (size_t)bh * 32768 + (size_t)dk * RDV + dv;
            o_[0] = S[0]; o_[RDV] = S[1]; o_[2 * RDV] = S[2]; o_[3 * RDV] = S[3];
        }
        {
            const int hd = lane >> 3, f4 = (lane & 7) * 4;
            u32x2_t x1, x2; f32x4 cb, sb;
#define P4_LOAD(r_, X1_, X2_, C_, S_) do { const bf16_t* q_ = Qb + (size_t)(r_) * 1536 + hd * DQH + DNOPE + f4; X1_ = *(const u32x2_t*)q_; X2_ = *(const u32x2_t*)(q_ + 32); \
            const int p_ = pos_index(r_); C_ = *(const f32x4*)(COSB + p_ * 32 + f4); S_ = *(const f32x4*)(SINB + p_ * 32 + f4); } while (0)
            int row = gw;
            if (row < NT) P4_LOAD(row, x1, x2, cb, sb);
            for (; row < NT; row += NGW) {
                u32x2_t x1n, x2n; f32x4 cbn, sbn; const int nr = row + NGW;
                if (nr < NT) P4_LOAD(nr, x1n, x2n, cbn, sbn);
                const float a0 = __builtin_bit_cast(float, x1.x << 16), a1 = __builtin_bit_cast(float, x1.x & 0xffff0000u), a2 = __builtin_bit_cast(float, x1.y << 16), a3 = __builtin_bit_cast(float, x1.y & 0xffff0000u);
                const float b0 = __builtin_bit_cast(float, x2.x << 16), b1 = __builtin_bit_cast(float, x2.x & 0xffff0000u), b2 = __builtin_bit_cast(float, x2.y << 16), b3 = __builtin_bit_cast(float, x2.y & 0xffff0000u);
                bf16_t* o_ = QPEb + (size_t)row * 512 + hd * DROPE + f4;
                *(u32x2_t*)o_ = (u32x2_t){cvtpk(a0 * cb[0] - b0 * sb[0], a1 * cb[1] - b1 * sb[1]), cvtpk(a2 * cb[2] - b2 * sb[2], a3 * cb[3] - b3 * sb[3])};
                *(u32x2_t*)(o_ + 32) = (u32x2_t){cvtpk(a0 * sb[0] + b0 * cb[0], a1 * sb[1] + b1 * cb[1]), cvtpk(a2 * sb[2] + b2 * cb[2], a3 * sb[3] + b3 * cb[3])};
                x1 = x1n; x2 = x2n; cb = cbn; sb = sbn;
            }
#undef P4_LOAD
        }
        for (int wt = gw; wt < MH * 16 * 2; wt += NGW) {
            const int lh = wt & 1, rb = (wt >> 1) & 15, head = wt >> 5; const int l31 = lane & 31, h8 = lane >> 5;
            f32x16 acc[4];
#pragma unroll
            for (int k_ = 0; k_ < 4; ++k_)
#pragma unroll
                for (int i = 0; i < 16; ++i) acc[k_][i] = 0.f;
            const bf16_t* ap = Qb + ((size_t)NP + 32 * rb + l31) * 1536 + head * DQH + 8 * h8;
            const bf16_t* bp = WukB + ((size_t)head * KVL + 128 * lh + l31) * DNOPE + 8 * h8;
#pragma unroll
            for (int s_ = 0; s_ < 8; ++s_) { const bf16x8 a = *(const bf16x8*)(ap + 16 * s_);
#pragma unroll
                for (int k_ = 0; k_ < 4; ++k_) { const bf16x8 b_ = *(const bf16x8*)(bp + (size_t)(32 * k_) * DNOPE + 16 * s_); acc[k_] = MFMA32(a, b_, acc[k_]); } }
#pragma unroll
            for (int k_ = 0; k_ < 4; ++k_)
#pragma unroll
                for (int i = 0; i < 16; ++i) QLATb[(size_t)(32 * rb + crow(i, h8)) * 2048 + head * KVL + 128 * lh + 32 * k_ + l31] = f2bf(acc[k_][i]);
        }
    }
    SEAM(4);
    if (IN(5)) {
        auto compute_units = [&]() __attribute__((always_inline)) {
        if (args.sub & 2) for (int it = bid; it < NB * MH * 4; it += G) {
            const int pr = __builtin_amdgcn_readfirstlane(it & 3), hh = __builtin_amdgcn_readfirstlane((it >> 2) & 7), b = __builtin_amdgcn_readfirstlane(it >> 5);
#pragma unroll 1
            for (int half = 0; half < 2; ++half) { const int qb = __builtin_amdgcn_readfirstlane(half ? pr : 7 - pr); const size_t row0 = (size_t)b * SEQ + qb * 256;
                SrcMlaP src{KN, KPERb, VT, Qb, QPEb, b, hh, row0};
                flash_unit<192, 128, true>(ldsb, src, qb * 256, 4 * (qb + 1), CATb + row0 * CATLD + 1024 + hh * DVH, CATLD, 0.07216878364870322f * 1.4426950408889634f); }
        }
        if (args.sub & 4) ret_out_phase(ldsb, RQt, RKt, RVT, SPT, ORET, bid, G);
        if (args.sub & 16) for (int it = bid; it < NB * XH * 8; it += G) {
            const int qb = __builtin_amdgcn_readfirstlane(it & 7), hh = __builtin_amdgcn_readfirstlane((it >> 3) & 3), b = __builtin_amdgcn_readfirstlane(it >> 5); const size_t row0 = (size_t)b * SEQ + qb * 256;
            SrcMemP src{MKb, MVT, Zb + C_XQ, b, hh, row0};
            flash_unit<64, 64, false>(ldsb, src, 0, 4, CATb + row0 * CATLD + 2048 + hh * XHD, CATLD, 0.125f * 1.4426950408889634f);
        }
        };
        const bool compute_first = ((bid >> 3) & 1) != 0;
        if (compute_first) compute_units();
        if (args.sub & 1) for (int it = bid; it < DB * MS_NSPLIT; it += G) { const int split = __builtin_amdgcn_readfirstlane(it % MS_NSPLIT), b = __builtin_amdgcn_readfirstlane(it / MS_NSPLIT);
            mla_sample_unit(ldsb, cache_ckv, cache_kpe, page_table, QLATb, QPEb, PO, PML, b, split, 0.07216878364870322f * 1.4426950408889634f); }
        if (args.sub & 8) for (int it = bid; it < DB * RH; it += G) {
            const int h = it & 3, b = it >> 2; const float lg = lg_gamma(h);
            const float* s0 = state_ret + (size_t)it * RDK * RDV;
            float* so = out + O_RETS + (size_t)it * RDK * RDV;
            LAS float* inner = lds;
            LAS float* qk = lds + 16;
            LAS float* vls = lds + 1040;
            LAS float* red = lds + 2064;
            f32x4 sv[16], vv[4];
#pragma unroll
            for (int r = 0; r < 16; ++r) sv[r] = __builtin_nontemporal_load((const f32x4*)(s0 + (size_t)(wave + 8 * r) * RDV + 4 * lane));
#pragma unroll
            for (int j = 0; j < DS; ++j) { const u32x2_t t_ = *(const u32x2_t*)(Zb + ((size_t)NP + b * DS + j) * ZLD + C_RV + h * RDV + 4 * lane); vv[j] = (f32x4){BLO(t_.x), BHI(t_.x), BLO(t_.y), BHI(t_.y)}; }
            __syncthreads();
            for (int i = tid; i < 1024; i += NTHREADS) { const int which = i >> 9, ti = (i >> 7) & 3, d = i & 127; const size_t row = (size_t)NP + b * DS + ti;
                qk[i] = which ? RK[row * 512 + h * RDK + d] : RQ[row * 512 + h * RDK + d]; }
            if (wave == 0) {
#pragma unroll
                for (int j = 0; j < DS; ++j) *(LAS f32x4*)(vls + j * 256 + 4 * lane) = vv[j]; }
            __syncthreads();
            for (int pr = wave; pr < 16; pr += NWAVES) { const int i = pr >> 2, j = pr & 3;
                float s_ = qk[i * 128 + lane] * qk[512 + j * 128 + lane] + qk[i * 128 + 64 + lane] * qk[512 + j * 128 + 64 + lane];
                s_ = wave_sum(s_);
                if (lane == 0) inner[pr] = (j <= i) ? s_ * __expf((float)(i - j) * lg) : 0.f; }
            const float g4 = __expf(4.f * lg), gk0 = __expf(3.f * lg), gk1 = __expf(2.f * lg), gk2 = __expf(lg);
            f32x4 po[4];
#pragma unroll
            for (int i = 0; i < 4; ++i) po[i] = (f32x4){0.f, 0.f, 0.f, 0.f};
#pragma unroll
            for (int r = 0; r < 16; ++r) { const int d = wave + 8 * r; const f32x4 sx = sv[r];
                f32x4 a = sx * g4 + (gk0 * qk[512 + d]) * vv[0] + (gk1 * qk[512 + 128 + d]) * vv[1] + (gk2 * qk[512 + 256 + d]) * vv[2] + qk[512 + 384 + d] * vv[3];
                __builtin_nontemporal_store(a, (f32x4*)(so + (size_t)d * RDV + 4 * lane));
#pragma unroll
                for (int i = 0; i < 4; ++i) po[i] += qk[i * 128 + d] * sx; }
#pragma unroll
            for (int i = 0; i < 4; ++i) *(LAS f32x4*)(red + (wave * 4 + i) * 256 + 4 * lane) = po[i];
            __syncthreads();
            {
                const int i = tid >> 7, e2 = (tid & 127) * 2;
                float o0 = 0.f, o1 = 0.f;
#pragma unroll
                for (int w_ = 0; w_ < NWAVES; ++w_) { o0 += red[(w_ * 4 + i) * 256 + e2]; o1 += red[(w_ * 4 + i) * 256 + e2 + 1]; }
                const float gi = __expf((float)(i + 1) * lg); o0 *= gi; o1 *= gi;
#pragma unroll
                for (int j = 0; j < DS; ++j) { const float w_ = inner[i * 4 + j]; o0 += w_ * vls[j * 256 + e2]; o1 += w_ * vls[j * 256 + e2 + 1]; }
                *(f32x2_t*)(ORET + ((size_t)NP + b * DS + i) * 1024 + h * RDV + e2) = (f32x2_t){o0, o1};
            }
        }
        if (args.sub & 32) for (int b = bid; b < DB; b += G) {
            LAS float* sc = lds;
            LAS float* red = lds + 4096;
            const float* kb_ = cache_mem_k + (size_t)b * NMEM * 256; const float* vb_ = cache_mem_v + (size_t)b * NMEM * 256;
            f32x4 qr[4];
#pragma unroll
            for (int q = 0; q < DS; ++q) { const u32x2_t t_ = *(const u32x2_t*)(Zb + ((size_t)NP + b * DS + q) * ZLD + C_XQ + 4 * lane); qr[q] = (f32x4){BLO(t_.x), BHI(t_.x), BLO(t_.y), BHI(t_.y)}; }
            __syncthreads();
#pragma unroll 8
            for (int kk = 0; kk < 32; ++kk) { const int key = 32 * wave + kk; const f32x4 kv = __builtin_nontemporal_load((const f32x4*)(kb_ + (size_t)key * 256 + 4 * lane));
                float pq[4];
#pragma unroll
                for (int q = 0; q < 4; ++q) { float a = kv[0] * qr[q][0] + kv[1] * qr[q][1] + kv[2] * qr[q][2] + kv[3] * qr[q][3];
                    a += __shfl_xor(a, 1); a += __shfl_xor(a, 2); a += __shfl_xor(a, 4); a += __shfl_xor(a, 8); pq[q] = a; }
                if ((lane & 15) == 0) {
#pragma unroll
                    for (int q = 0; q < 4; ++q) sc[(q * 4 + (lane >> 4)) * 256 + key] = pq[q] * (0.125f * 1.4426950408889634f); } }
            __syncthreads();
            for (int rr = wave * 2; rr < wave * 2 + 2; ++rr) {
                f32x4 v = *(LAS f32x4*)(sc + rr * 256 + 4 * lane);
                const float mx = wave_max(fmaxf(fmaxf(v[0], v[1]), fmaxf(v[2], v[3])));
#pragma unroll
                for (int e = 0; e < 4; ++e) v[e] = __builtin_amdgcn_exp2f(v[e] - mx);
                const float inv = 1.f / wave_sum(v[0] + v[1] + v[2] + v[3]);
                *(LAS f32x4*)(sc + rr * 256 + 4 * lane) = v * inv; }
            __syncthreads();
            f32x4 acc[4];
#pragma unroll
            for (int q = 0; q < 4; ++q) acc[q] = (f32x4){0.f, 0.f, 0.f, 0.f};
#pragma unroll 8
            for (int kk = 0; kk < 32; ++kk) { const int key = 32 * wave + kk; const f32x4 vv = __builtin_nontemporal_load((const f32x4*)(vb_ + (size_t)key * 256 + 4 * lane));
#pragma unroll
                for (int q = 0; q < 4; ++q) acc[q] += sc[(q * 4 + (lane >> 4)) * 256 + key] * vv; }
#pragma unroll
            for (int q = 0; q < 4; ++q) *(LAS f32x4*)(red + (wave * 4 + q) * 256 + 4 * lane) = acc[q];
            __syncthreads();
            { const int q = tid >> 7, e2 = (tid & 127) * 2; float o0 = 0.f, o1 = 0.f;
#pragma unroll
              for (int w_ = 0; w_ < NWAVES; ++w_) { o0 += red[(w_ * 4 + q) * 256 + e2]; o1 += red[(w_ * 4 + q) * 256 + e2 + 1]; }
              *(unsigned*)(CATb + ((size_t)NP + b * DS + q) * CATLD + 2048 + e2) = cvtpk(o0, o1); }
        }
            if (!compute_first) compute_units();
    }
    SEAM(5);
    if (IN(6)) {
        for (int bt = bid; bt < NS; bt += G) {
            const int b = bt >> 2;
            const int head = wave; const float c2 = 0.07216878364870322f * 1.4426950408889634f;
            LAS float* ol = lds + wave * KVL;
            { const int t = bt & 3;
                const int qi = t * 8 + head; const size_t qrow = (size_t)b * DS + t;
                float qv[5];
#pragma unroll
                for (int c = 0; c < 5; ++c) { const int d = lane + 64 * c; const bf16_t raw = d < KVL ? QLATb[qrow * 2048 + head * KVL + d] : QPEb[(NP + qrow) * 512 + head * DROPE + (d - KVL)];
                    qv[c] = __builtin_bit_cast(float, (unsigned)raw << 16); }
                float sc[DS]; float M = -INFINITY;
#pragma unroll
                for (int j = 0; j < DS; ++j) { const size_t krow = (size_t)NP + b * DS + j; float a = 0.f;
#pragma unroll
                    for (int c = 0; c < 5; ++c) { const int d = lane + 64 * c; a += qv[c] * (d < KVL ? CKVN[krow * KVL + d] : KPER[krow * DROPE + (d - KVL)]); }
                    a = wave_sum(a) * c2; sc[j] = (j <= t) ? a : -INFINITY; M = fmaxf(M, sc[j]); }
                float ms[MS_NSPLIT], ls[MS_NSPLIT];
#pragma unroll
                for (int sp = 0; sp < MS_NSPLIT; ++sp) { const int item = b * MS_NSPLIT + sp; ms[sp] = PML[(item * 32 + qi) * 2]; ls[sp] = PML[(item * 32 + qi) * 2 + 1]; M = fmaxf(M, ms[sp]); }
                float L = 0.f; float acc[4] = {0.f, 0.f, 0.f, 0.f};
#pragma unroll
                for (int sp = 0; sp < MS_NSPLIT; ++sp) { const int item = b * MS_NSPLIT + sp; const float wgt = __builtin_amdgcn_exp2f(ms[sp] - M); L += ls[sp] * wgt;
#pragma unroll
                    for (int c = 0; c < 4; ++c) acc[c] += wgt * PO[((size_t)item * 32 + qi) * KVL + lane + 64 * c]; }
#pragma unroll
                for (int j = 0; j < DS; ++j) { const float wgt = __builtin_amdgcn_exp2f(sc[j] - M); L += wgt; const size_t krow = (size_t)NP + b * DS + j;
#pragma unroll
                    for (int c = 0; c < 4; ++c) acc[c] += wgt * CKVN[krow * KVL + lane + 64 * c]; }
                const float inv = 1.f / L;
#pragma unroll
                for (int c = 0; c < 4; ++c) ol[lane + 64 * c] = acc[c] * inv;
                __syncthreads();
                float a0 = 0.f, a1 = 0.f; const float* wv = w_uv + (size_t)head * KVL * DVH;
#pragma unroll 8
                for (int l = 0; l < KVL; ++l) { const float x = ol[l]; a0 += x * wv[(size_t)l * DVH + lane]; a1 += x * wv[(size_t)l * DVH + 64 + lane]; }
                CATb[((size_t)NP + qrow) * CATLD + 1024 + head * DVH + lane] = f2bf(a0); CATb[((size_t)NP + qrow) * CATLD + 1024 + head * DVH + 64 + lane] = f2bf(a1);
                __syncthreads();
            }
        }
        {
            f32x4 a[4]; u32x2_t gz[4];
#define P6_LOAD(r_, A_, B_) do { _Pragma("unroll") for (int j_ = 0; j_ < 4; ++j_) { A_[j_] = *(const f32x4*)(ORET + (size_t)(r_) * 1024 + 4 * lane + 256 * j_); \
                                                                              B_[j_] = *(const u32x2_t*)(SRGb + (size_t)(r_) * 1024 + 4 * lane + 256 * j_); } } while (0)
            int row = gw;
            if (row < NT) P6_LOAD(row, a, gz);
            for (; row < NT; row += NGW) {
                f32x4 an[4]; u32x2_t gn[4]; const int nr = row + NGW;
                if (nr < NT) P6_LOAD(nr, an, gn);
#pragma unroll
                for (int j = 0; j < 4; ++j) {
                    const float ss = wave_sum(a[j][0] * a[j][0] + a[j][1] * a[j][1] + a[j][2] * a[j][2] + a[j][3] * a[j][3]);
                    const float r = rsqrtf(ss * (1.f / RDV) + EPS);
                    float o_[4];
#pragma unroll
                    for (int e = 0; e < 4; ++e) { const unsigned gw_ = e < 2 ? gz[j].x : gz[j].y; o_[e] = __builtin_bit_cast(float, (e & 1) ? (gw_ & 0xffff0000u) : (gw_ << 16)) * a[j][e] * r; }
                    *(u32x2_t*)(CATb + (size_t)row * CATLD + 4 * lane + 256 * j) = (u32x2_t){cvtpk(o_[0], o_[1]), cvtpk(o_[2], o_[3])};
                }
#pragma unroll
                for (int j = 0; j < 4; ++j) { a[j] = an[j]; gz[j] = gn[j]; }
            }
#undef P6_LOAD
        }
    }
    SEAM(6);
    if (IN(7)) {
        { pg8::StaticOrder S; S.init(NP, 1024, G, bid); pg8::Gemm g{CATb, WcatT, NP, 1024, CATLD, CATLD, CATLD}; pg8::EpiGate3 E{SGb, MIXb, 1024, 16, 32};
          pg8::gemm_phase<pg8::EpiGate3, pg8::StaticOrder, true, true>(ldsb, g, S, E); }
        __syncthreads();
        { pg8::Gemm g{CATb, WcatT, NT, 1024, 256, CATLD, CATLD, 256}; pg8::SplitOrder SS{9, bid}; pg8::EpiPart E{PART}; GEMM_SPLIT(ldsb, g, SS, E); }
    }
    SEAM(7);
    if (IN(8)) {
        for (int i = bid * NTHREADS + tid; i < NS * 256; i += G * NTHREADS) { const int r = i >> 8, c4 = (i & 255) * 4; const size_t o_ = (size_t)r * 1024 + c4;
            f32x4 mix = {0.f, 0.f, 0.f, 0.f};
#pragma unroll
            for (int br = 0; br < 3; ++br) { f32x4 a = *(const f32x4*)(PART + (size_t)(br == 2 ? 8 : 4 * br) * (512 * 1024) + o_);
                if (br < 2) {
#pragma unroll
                    for (int k_ = 1; k_ < 4; ++k_) a += *(const f32x4*)(PART + (size_t)(4 * br + k_) * (512 * 1024) + o_); }
                const u32x2_t gq = *(const u32x2_t*)(SGb + (size_t)(NP + r) * 3072 + br * 1024 + c4);
                mix[0] += a[0] * __builtin_bit_cast(float, gq.x << 16); mix[1] += a[1] * __builtin_bit_cast(float, gq.x & 0xffff0000u);
                mix[2] += a[2] * __builtin_bit_cast(float, gq.y << 16); mix[3] += a[3] * __builtin_bit_cast(float, gq.y & 0xffff0000u); }
            *(u32x2_t*)(MIXb + (size_t)(NP + r) * 1024 + c4) = (u32x2_t){cvtpk(mix[0], mix[1]), cvtpk(mix[2], mix[3])}; }
    }
    SEAM(8);
    if (IN(9)) { pg8::Gemm g{MIXb, WoT, NP, 1024, 1024, 1024, 1024}; pg8::StaticOrder S; S.init(NP, 1024, G, bid); pg8::EpiBf16S E{HPb, 1024};
        GEMM_PHASE(pg8::EpiBf16S, ldsb, g, S, E);
        __syncthreads();
        { pg8::Gemm g2{MIXb, WoT, NT, 1024, 256, 1024, 1024, 256}; pg8::SplitOrder SS{4, bid}; pg8::EpiPart E2{PART}; GEMM_SPLIT(ldsb, g2, SS, E2); } }
    SEAM(9);
    if (IN(10)) {
        f32x4 gp[4], gf[4], a[4], b[4];
#pragma unroll
        for (int j = 0; j < 4; ++j) { gp[j] = *(const f32x4*)(g_mix_post + 4 * lane + 256 * j); gf[j] = *(const f32x4*)(g_ffn_pre + 4 * lane + 256 * j); }
#define P10_LOAD(r_, A_, B_) do { const float* xr_ = (r_) < NP ? x_prompt + (size_t)(r_) * DM : x_sample + (size_t)((r_) - NP) * DM; \
        _Pragma("unroll") for (int j_ = 0; j_ < 4; ++j_) { B_[j_] = *(const f32x4*)(xr_ + 4 * lane + 256 * j_); \
            if ((r_) < NP) { const u32x2_t h_ = *(const u32x2_t*)(HPb + (size_t)(r_) * DM + 4 * lane + 256 * j_); A_[j_] = bf4_to_f32(h_.x, h_.y); } \
            else { const float* p_ = PART + (size_t)((r_) - NP) * DM + 4 * lane + 256 * j_; A_[j_] = (*(const f32x4*)p_ + *(const f32x4*)(p_ + 512 * 1024)) + (*(const f32x4*)(p_ + 2 * 512 * 1024) + *(const f32x4*)(p_ + 3 * 512 * 1024)); } } } while (0)
        int row = gw;
        if (row < NT) P10_LOAD(row, a, b);
        for (; row < NT; row += NGW) {
            f32x4 an[4], bn[4]; const int nr = row + NGW;
            if (nr < NT) P10_LOAD(nr, an, bn);
            float ss = 0.f;
#pragma unroll
            for (int j = 0; j < 4; ++j) ss += a[j][0] * a[j][0] + a[j][1] * a[j][1] + a[j][2] * a[j][2] + a[j][3] * a[j][3];
            float r = rsqrtf(wave_sum(ss) * (1.f / DM) + EPS); ss = 0.f;
#pragma unroll
            for (int j = 0; j < 4; ++j) { a[j] = b[j] + a[j] * r * gp[j]; *(u32x2_t*)(Hb + (size_t)row * DM + 4 * lane + 256 * j) = (u32x2_t){cvtpk(a[j][0], a[j][1]), cvtpk(a[j][2], a[j][3])};
                ss += a[j][0] * a[j][0] + a[j][1] * a[j][1] + a[j][2] * a[j][2] + a[j][3] * a[j][3]; }
            r = rsqrtf(wave_sum(ss) * (1.f / DM) + EPS);
#pragma unroll
            for (int j = 0; j < 4; ++j) { const f32x4 f_ = a[j] * r * gf[j]; *(u32x2_t*)(Fb + (size_t)row * DM + 4 * lane + 256 * j) = (u32x2_t){cvtpk(f_[0], f_[1]), cvtpk(f_[2], f_[3])}; }
#pragma unroll
            for (int j = 0; j < 4; ++j) { a[j] = an[j]; b[j] = bn[j]; }
        }
#undef P10_LOAD
    }
    SEAM(10);
    if (IN(11)) {
        pg8::Gemm g{Fb, WguT, NT, 2 * DFF, 1024, 1024, 1024}; pg8::StaticOrder S; S.init(NT, 2 * DFF, G, bid); pg8::EpiSwiGLU E{ACTb, DFF};
        GEMM_PHASE(pg8::EpiSwiGLU, ldsb, g, S, E);
    }
    SEAM(11);
    if (IN(13)) { pg8::Gemm g{ACTb, WdT, NP, 1024, DFF, DFF, DFF}; pg8::StaticOrder S; S.init(NP, 1024, G, bid); pg8::EpiBf16S E{FOb, 1024};
        GEMM_PHASE(pg8::EpiBf16S, ldsb, g, S, E);
        __syncthreads();
        { pg8::Gemm g2{ACTb, WdT, NT, 1024, 256, DFF, DFF, 256}; pg8::SplitOrder SS{11, bid}; pg8::EpiPart E2{PART}; GEMM_SPLIT(ldsb, g2, SS, E2); } }
    SEAM(13);
    if (IN(14)) {
        f32x4 gp[4], a[4], b[4];
#pragma unroll
        for (int j = 0; j < 4; ++j) gp[j] = *(const f32x4*)(g_ffn_post + 4 * lane + 256 * j);
#define P14_LOAD(r_, A_, B_) do { _Pragma("unroll") for (int j_ = 0; j_ < 4; ++j_) { { const u32x2_t h_ = *(const u32x2_t*)(Hb + (size_t)(r_) * DM + 4 * lane + 256 * j_); B_[j_] = bf4_to_f32(h_.x, h_.y); } \
            if ((r_) < NP) { const u32x2_t f_ = *(const u32x2_t*)(FOb + (size_t)(r_) * DM + 4 * lane + 256 * j_); A_[j_] = bf4_to_f32(f_.x, f_.y); } \
            else { const float* p_ = PART + (size_t)((r_) - NP) * DM + 4 * lane + 256 * j_; f32x4 a_ = *(const f32x4*)p_; \
                _Pragma("unroll") for (int k_ = 1; k_ < 11; ++k_) a_ += *(const f32x4*)(p_ + (size_t)k_ * 512 * 1024); A_[j_] = a_; } } } while (0)
        int row = gw;
        if (row < NT) P14_LOAD(row, a, b);
        for (; row < NT; row += NGW) {
            f32x4 an[4], bn[4]; const int nr = row + NGW;
            if (nr < NT) P14_LOAD(nr, an, bn);
            float ss = 0.f;
#pragma unroll
            for (int j = 0; j < 4; ++j) ss += a[j][0] * a[j][0] + a[j][1] * a[j][1] + a[j][2] * a[j][2] + a[j][3] * a[j][3];
            const float r = rsqrtf(wave_sum(ss) * (1.f / DM) + EPS);
            float* y = row < NP ? out + O_YP + (size_t)row * DM : out + O_YS + (size_t)(row - NP) * DM;
#pragma unroll
            for (int j = 0; j < 4; ++j) *(f32x4*)(y + 4 * lane + 256 * j) = b[j] + a[j] * r * gp[j];
#pragma unroll
            for (int j = 0; j < 4; ++j) { a[j] = an[j]; b[j] = bn[j]; }
        }
#undef P14_LOAD
    }
#undef IN
#undef SEAM
}
#undef x_prompt
#undef x_sample
#undef mem_prompt
#undef cache_ckv
#undef cache_kpe
#undef page_table
#undef state_ret
#undef cache_mem_k
#undef cache_mem_v
#undef g_mix_pre
#undef g_mix_post
#undef g_ffn_pre
#undef g_ffn_post
#undef g_mem
#undef g_qlat
#undef g_kvlat
#undef w_in
#undef w_uq
#undef w_uk
#undef w_uv
#undef w_mem_k
#undef w_mem_v
#undef w_ret_o
#undef w_mla_o
#undef w_x_o
#undef w_out
#undef w_gate
#undef w_up
#undef w_down
#undef COSA
#undef SINA
#undef COSB
#undef SINB
#undef U
#undef MN
#undef Zb
#undef RQ
#undef RK
#undef CQN
#undef CKVN
#undef KPER
#undef Q
#undef QLAT
#undef QPE
#undef ORET
#undef OLAT
#undef OX
#undef OMLA
#undef ORETN
#undef ARET
#undef AMLA
#undef AX
#undef MIX
#undef HPb
#undef Hb
#undef F
#undef GU
#undef FOb
#undef WinT
#undef WmkvT
#undef WuqT
#undef WcatT
#undef CATb
#undef WroT
#undef WmoT
#undef WxoT
#undef WoT
#undef WguT
#undef WdT
#undef Ub
#undef MNb
#undef CQNb
#undef ORETNb
#undef OMLAb
#undef OXb
#undef MIXb
#undef Fb
#undef ACTb
#undef WukT
#undef WuvT
#undef CKVNb
#undef KPERb
#undef XQb
#undef MKb
#undef MVT
#undef KN
#undef VT
#undef Qb
#undef RQt
#undef RKt
#undef RKtT
#undef RVT
#undef UT
#undef SPT
#undef QPEb
#undef WukB
#undef PART
#undef SGb
#undef SRGb
#undef T0b
#undef T1b
#undef QLATb
#undef PO
#undef PML
constexpr int N_PHASES = 15;
}

extern "C" void kernel_launch(void* const* d_in, const int* in_sizes, int n_in, void* d_out, int out_size, void* d_ws, size_t ws_size, hipStream_t stream) {
    static int grid = 0;
    if (grid == 0) {
        if (n_in != 29 || (size_t)out_size != O_END || ws_size < WS_END) { fprintf(stderr, "kernel_launch: unexpected shapes: n_in %d out %d ws %zu (need %zu)\n", n_in, out_size, ws_size, (size_t)WS_END); grid = -1; return; }
        int dev = 0, cus = 0, per_cu = 0;
        if (hipGetDevice(&dev) != hipSuccess || hipDeviceGetAttribute(&cus, hipDeviceAttributeMultiprocessorCount, dev) != hipSuccess) { grid = -1; return; }
        if (hipFuncSetAttribute((const void*)fwd_kernel, hipFuncAttributeMaxDynamicSharedMemorySize, LDS_BYTES) != hipSuccess) { fprintf(stderr, "kernel_launch: hipFuncSetAttribute failed\n"); grid = -1; return; }
        if (hipOccupancyMaxActiveBlocksPerMultiprocessor(&per_cu, (const void*)fwd_kernel, NTHREADS, LDS_BYTES) != hipSuccess || per_cu < 1) { fprintf(stderr, "kernel_launch: occupancy query says %d\n", per_cu); per_cu = 1; }
        (void)hipGetLastError();
        grid = cus;
    }
    if (grid < 0) return;
    (void)hipMemsetAsync((char*)d_ws + WS_CTL, 0, CTL_BYTES, stream);
    Args a{};
    for (int i = 0; i < 29; ++i) a.in[i] = (const float*)d_in[i];
    a.out = (float*)d_out; a.ws = (unsigned char*)d_ws;
#if MK_ONE_LAUNCH
    a.ph_lo = 0; a.ph_hi = N_PHASES; a.sub = 0xff;
    hipLaunchKernelGGL(fwd_kernel, dim3(grid), dim3(NTHREADS), LDS_BYTES, stream, a);
#if PROBE_DUP >= 0
    a.ph_lo = PROBE_DUP; a.ph_hi = PROBE_DUP + 1; a.sub = PROBE_SUB;
    hipLaunchKernelGGL(fwd_kernel, dim3(grid), dim3(NTHREADS), LDS_BYTES, stream, a);
#endif
#else
    a.sub = 0xff; for (int p = 0; p < N_PHASES; ++p) { a.ph_lo = p; a.ph_hi = p + 1; hipLaunchKernelGGL(fwd_kernel, dim3(grid), dim3(NTHREADS), LDS_BYTES, stream, a); }
#endif
}
```

```cpp
#include <hip/hip_runtime.h>
#include <cstdio>
#include <cstdint>

#ifndef PROBE_DUP
#define PROBE_DUP -1
#endif
#ifndef PROBE_SUB
#define PROBE_SUB 0xff
#endif
#ifndef MK_ONE_LAUNCH
#define MK_ONE_LAUNCH 1
#endif

#define LAS __attribute__((address_space(3)))
#define GAS __attribute__((address_space(1)))
#define DI __device__ __forceinline__
typedef float f32x4 __attribute__((ext_vector_type(4)));
typedef __bf16 bf16x2_t __attribute__((ext_vector_type(2)));
typedef float f32x2_t __attribute__((ext_vector_type(2)));
DI unsigned cvtpk(float lo, float hi) { f32x2_t v = {lo, hi}; bf16x2_t b = __builtin_convertvector(v, bf16x2_t); return __builtin_bit_cast(unsigned, b); }

namespace {
constexpr int DM = 1024, NB = 8, SEQ = 2048, NP = NB * SEQ, DB = 128, DS = 4, NS = DB * DS, NT = NP + NS;
constexpr int PAST = 8192, PAGE = 128, NPAGES = PAST / PAGE;
constexpr int RH = 4, RDK = 128, RDV = 256;
constexpr int MH = 8, QL = 384, KVL = 256, DNOPE = 128, DROPE = 64, DVH = 128, DQH = DNOPE + DROPE;
constexpr int NMEM = 256, XH = 4, XHD = 64;
constexpr int DFF = 2816, DIN = 7104, ZLD = 7168;
constexpr int C_RQ = 0, C_RK = 512, C_RV = 1024, C_RG = 2048, C_CQ = 3072, C_CKV = 3456, C_KPE = 3712, C_XQ = 3776, C_G = 4032;
constexpr float EPS = 1e-6f;
constexpr int NPOS = SEQ + DS;
constexpr int NTHREADS = 512, NWAVES = 8;
constexpr int LDS_BYTES = 147456;
constexpr int MISC_OFF = 147456 - 256;

constexpr size_t O_YP = 0, O_YS = O_YP + (size_t)NP * DM, O_CKVP = O_YS + (size_t)NS * DM, O_KPEP = O_CKVP + (size_t)NP * KVL,
                 O_CKVS = O_KPEP + (size_t)NP * DROPE, O_KPES = O_CKVS + (size_t)NS * KVL, O_RETP = O_KPES + (size_t)NS * DROPE,
                 O_RETS = O_RETP + (size_t)NB * RH * RDK * RDV, O_MKP = O_RETS + (size_t)DB * RH * RDK * RDV, O_MVP = O_MKP + (size_t)NB * NMEM * 256,
                 O_END = O_MVP + (size_t)NB * NMEM * 256;

constexpr size_t al256(size_t x) { return (x + 255) & ~(size_t)255; }
constexpr size_t WS_CTL = 0, CTL_BYTES = 1u << 20;
constexpr size_t WS_COSA = WS_CTL + CTL_BYTES;
constexpr size_t WS_SINA = WS_COSA + al256((size_t)NPOS * 64 * 4);
constexpr size_t WS_COSB = WS_SINA + al256((size_t)NPOS * 64 * 4);
constexpr size_t WS_SINB = WS_COSB + al256((size_t)NPOS * 32 * 4);
constexpr size_t WS_U = WS_SINB + al256((size_t)NPOS * 32 * 4);
constexpr size_t WS_MN = WS_U + (size_t)NT * DM * 4;
constexpr size_t WS_Z = WS_MN + (size_t)NB * NMEM * DM * 4;
constexpr size_t WS_RQ = WS_Z + (size_t)NT * ZLD * 4;
constexpr size_t WS_RK = WS_RQ + (size_t)NT * 512 * 4;
constexpr size_t WS_CQN = WS_RK + (size_t)NT * 512 * 4;
constexpr size_t WS_CKVN = WS_CQN + (size_t)NT * QL * 4;
constexpr size_t WS_KPER = WS_CKVN + (size_t)NT * KVL * 4;
constexpr size_t WS_Q = WS_KPER + (size_t)NT * DROPE * 4;
constexpr size_t WS_QLAT = WS_Q + (size_t)NT * 1536 * 4;
constexpr size_t WS_QPE = WS_QLAT + (size_t)NT * 2048 * 4;
constexpr size_t WS_ORET = WS_QPE + (size_t)NT * 512 * 4;
constexpr size_t WS_OLAT = WS_ORET + (size_t)NT * 1024 * 4;
constexpr size_t WS_OX = WS_OLAT + (size_t)NT * 2048 * 4;
constexpr size_t WS_OMLA = WS_OX + (size_t)NT * 256 * 4;
constexpr size_t WS_ORETN = WS_OMLA + (size_t)NT * 1024 * 4;
constexpr size_t WS_ARET = WS_ORETN + (size_t)NT * 1024 * 4;
constexpr size_t WS_AMLA = WS_ARET + (size_t)NT * 1024 * 4;
constexpr size_t WS_AX = WS_AMLA + (size_t)NT * 1024 * 4;
constexpr size_t WS_MIX = WS_AX + (size_t)NT * 1024 * 4;
constexpr size_t WS_HP = WS_MIX + (size_t)NT * 1024 * 4;
constexpr size_t WS_H = WS_HP + (size_t)NT * 1024 * 4;
constexpr size_t WS_F = WS_H + (size_t)NT * 1024 * 4;
constexpr size_t WS_GG = WS_F + (size_t)NT * 1024 * 4;
constexpr size_t WS_UP = WS_GG + (size_t)NT * DFF * 4;
constexpr size_t WS_ACT = WS_UP + (size_t)NT * DFF * 4;
constexpr size_t WS_FO = WS_ACT + (size_t)NT * DFF * 4;
constexpr size_t WS_F32_END = WS_FO + (size_t)NT * 1024 * 4;
constexpr size_t WS_WIN_T = al256(WS_F32_END);
constexpr size_t WS_WMKV_T = WS_WIN_T + (size_t)ZLD * 1024 * 2;
constexpr size_t WS_WUQ_T = WS_WMKV_T + (size_t)512 * 1024 * 2;
constexpr size_t WS_WRO_T = WS_WUQ_T + (size_t)1536 * 384 * 2;
constexpr size_t WS_WMO_T = WS_WRO_T + (size_t)1024 * 1024 * 2;
constexpr size_t WS_WXO_T = WS_WMO_T + (size_t)1024 * 1024 * 2;
constexpr size_t WS_WO_T = WS_WXO_T + (size_t)1024 * 256 * 2;
constexpr size_t WS_WGU_T = WS_WO_T + (size_t)1024 * 1024 * 2;
constexpr size_t WS_WD_T = WS_WGU_T + (size_t)5632 * 1024 * 2;
constexpr size_t WS_UB = WS_WD_T + (size_t)1024 * 2816 * 2;
constexpr size_t WS_MNB = WS_UB + (size_t)NT * 1024 * 2;
constexpr size_t WS_CQNB = WS_MNB + (size_t)2048 * 1024 * 2;
constexpr size_t WS_ORETNB = WS_CQNB + (size_t)NT * 384 * 2;
constexpr size_t WS_OMLAB = WS_ORETNB + (size_t)NT * 1024 * 2;
constexpr size_t WS_OXB = WS_OMLAB + (size_t)NT * 1024 * 2;
constexpr size_t WS_MIXB = WS_OXB + (size_t)NT * 256 * 2;
constexpr size_t WS_FB = WS_MIXB + (size_t)NT * 1024 * 2;
constexpr size_t WS_ACTB = WS_FB + (size_t)NT * 1024 * 2;
constexpr size_t WS_WUK_T = WS_ACTB + (size_t)NT * 2816 * 2;
constexpr size_t WS_WUV_T = WS_WUK_T + (size_t)1024 * 256 * 2;
constexpr size_t WS_CKVNB = WS_WUV_T + (size_t)1024 * 256 * 2;
constexpr size_t WS_KPERB = WS_CKVNB + (size_t)NT * 256 * 2;
constexpr size_t WS_XQB = WS_KPERB + (size_t)NT * 64 * 2;
constexpr size_t WS_MKB = WS_XQB + (size_t)NT * 256 * 2;
constexpr size_t WS_MVT = WS_MKB + (size_t)2048 * 256 * 2;
constexpr size_t WS_KN = WS_MVT + (size_t)2048 * 256 * 2;
constexpr size_t WS_VT = WS_KN + (size_t)NP * 1024 * 2;
constexpr size_t WS_QB = WS_VT + (size_t)NP * 1024 * 2;
constexpr size_t WS_RQT = WS_QB + (size_t)NT * 1536 * 2;
constexpr size_t WS_RKT = WS_RQT + (size_t)NP * 512 * 2;
constexpr size_t WS_RKTT = WS_RKT + (size_t)NP * 512 * 2;
constexpr size_t WS_RVT = WS_RKTT + (size_t)NP * 512 * 2;
constexpr size_t WS_UT = WS_RVT + (size_t)NT * 1024 * 2;
constexpr size_t WS_SPT = WS_UT + (size_t)512 * 32768 * 4;
constexpr size_t WS_QLATB = WS_SPT + (size_t)512 * 32768 * 2;
constexpr size_t WS_PO = WS_QLATB + (size_t)NS * 2048 * 2;
constexpr size_t WS_PML = WS_PO + (size_t)DB * 2 * 32 * 256 * 4;
constexpr size_t WS_PART = al256(WS_PML + (size_t)DB * 2 * 32 * 2 * 4);
constexpr size_t WS_QPEB_ = WS_PART + (size_t)11 * 512 * 1024 * 4;
constexpr size_t WS_QPEB = al256(WS_QPEB_ + 0 * WS_PML + (size_t)DB * 2 * 32 * 2 * 4);
constexpr size_t WS_SGB = WS_QPEB + (size_t)NT * 512 * 2;
constexpr size_t WS_SRGB = WS_SGB + (size_t)NT * 3072 * 2;
constexpr size_t WS_T0B = WS_SRGB + (size_t)NT * 1024 * 2;
constexpr size_t WS_T1B = WS_T0B + (size_t)NT * 1024 * 2;
constexpr size_t WS_WUKB = WS_T1B + (size_t)NT * 1024 * 2;
constexpr size_t WS_END = WS_WUKB + (size_t)8 * 256 * 128 * 2;

static_assert(WS_OMLAB == WS_ORETNB + (size_t)NT * 1024 * 2 && WS_OXB == WS_OMLAB + (size_t)NT * 1024 * 2 && WS_MIXB == WS_OXB + (size_t)NT * 256 * 2, "CATb = [o_ret_n | o_mla | o_x] rows of 2304");
static_assert(WS_WMO_T == WS_WRO_T + (size_t)1024 * 1024 * 2 && WS_WXO_T == WS_WMO_T + (size_t)1024 * 1024 * 2 && WS_WO_T == WS_WXO_T + (size_t)1024 * 256 * 2, "WcatT = [w_ret_o | w_mla_o | w_x_o]^T rows of 2304");
constexpr int CATLD = 2304;
constexpr int CW_BAR = 4096;

#define XB_TMO      128
#define XB_XCNT(j)  (256  + 64 * (j))
#define XB_XSUB(j)  (1280 + 64 * (j))
#define XB_XGEN(j)  (2304 + 64 * (j))
#define XB_TOP      3328
#define XB_TOPGEN   3392
#define XCD_BAR_WORDS 3456
#define XB_SPIN_CAP (1u << 25)

DI unsigned xb_ld(unsigned* p)              { return __hip_atomic_load(p, __ATOMIC_RELAXED, __HIP_MEMORY_SCOPE_AGENT); }
DI unsigned xb_add(unsigned* p, unsigned v) { return __hip_atomic_fetch_add(p, v, __ATOMIC_RELAXED, __HIP_MEMORY_SCOPE_AGENT); }
DI unsigned xb_xcc_id() { return (unsigned)__builtin_amdgcn_s_getreg((3 << 11) | 20) & 0xFu; }
#define XB_SPIN(cond, bar) do { unsigned _sp = 0; while (cond) { __builtin_amdgcn_s_sleep(1); \
    if ((++_sp & 255u) == 0u) { if (xb_ld(&(bar)[XB_TMO])) break; if (_sp > XB_SPIN_CAP) { atomicAdd(&(bar)[XB_TMO], 1u); break; } } } } while (0)

struct XcdBarrier { unsigned* bar; unsigned x; volatile LAS unsigned* st; };

DI XcdBarrier xcd_barrier_post(unsigned* bar, volatile LAS unsigned* st) {
    XcdBarrier b; b.bar = bar; b.x = xb_xcc_id(); b.st = st;
    if (threadIdx.x == 0) (void)xb_add(&bar[XB_XCNT(b.x)], 1u);
    return b;
}
DI void xcd_barrier_complete(unsigned* bar, unsigned x, unsigned& nloc, unsigned& nx) {
    const unsigned G = gridDim.x * gridDim.y * gridDim.z;
    unsigned sum, cnt, mine, sp = 0u;
    for (;;) {
        sum = 0u; cnt = 0u; mine = 0u;
#pragma unroll
        for (unsigned j = 0; j < 16; ++j) { const unsigned c = xb_ld(&bar[XB_XCNT(j)]); sum += c; cnt += (c > 0u) ? 1u : 0u; mine = (j == x) ? c : mine; }
        if (sum == G) break;
        __builtin_amdgcn_s_sleep(1);
        if ((++sp & 255u) == 0u) { if (xb_ld(&bar[XB_TMO])) break; if (sp > XB_SPIN_CAP) { atomicAdd(&bar[XB_TMO], 1u); break; } }
    }
    nloc = mine > 0u ? mine : 1u; nx = cnt > 0u ? cnt : 1u;
}
DI void xcd_barrier(const XcdBarrier& b) {
    asm volatile("s_waitcnt vmcnt(0)" ::: "memory");
    __syncthreads();
    if (threadIdx.x == 0) {
        unsigned* bar = b.bar;
        __builtin_amdgcn_s_waitcnt(0);
        unsigned nloc = b.st[0], nx = b.st[1];
        if (nloc == 0u) { xcd_barrier_complete(bar, b.x, nloc, nx); b.st[0] = nloc; b.st[1] = nx; }
        const unsigned old = xb_add(&bar[XB_XSUB(b.x)], 1u);
        const unsigned gen = old / nloc;
        if (old + 1u == (gen + 1u) * nloc) {
            __builtin_amdgcn_fence(__ATOMIC_RELEASE, "agent");
            asm volatile("s_waitcnt vmcnt(0)" ::: "memory");
            const unsigned og = xb_add(&bar[XB_TOP], 1u);
            const unsigned tg = og / nx;
            if (og + 1u == (tg + 1u) * nx) xb_add(&bar[XB_TOPGEN], 1u);
            else XB_SPIN(xb_ld(&bar[XB_TOPGEN]) == tg, bar);
            __builtin_amdgcn_fence(__ATOMIC_ACQUIRE, "agent");
            xb_add(&bar[XB_XGEN(b.x)], 1u);
            asm volatile("s_waitcnt vmcnt(0)" ::: "memory");
        } else {
            XB_SPIN(xb_ld(&bar[XB_XGEN(b.x)]) == gen, bar);
            __builtin_amdgcn_fence(__ATOMIC_ACQUIRE, "agent");
            asm volatile("s_waitcnt vmcnt(0)" ::: "memory");
        }
    }
    __syncthreads();
}

DI float wave_sum(float v) {
#pragma unroll
    for (int o = 1; o < 64; o <<= 1) v += __shfl_xor(v, o);
    return v;
}
DI float wave_max(float v) {
#pragma unroll
    for (int o = 1; o < 64; o <<= 1) v = fmaxf(v, __shfl_xor(v, o));
    return v;
}
DI float sigmoidf_(float x) { return 1.f / (1.f + expf(-x)); }
DI float siluf_(float x) { return x / (1.f + expf(-x)); }
DI f32x4 bf4_to_f32(unsigned lo, unsigned hi) { return (f32x4){__builtin_bit_cast(float, lo << 16), __builtin_bit_cast(float, lo & 0xffff0000u), __builtin_bit_cast(float, hi << 16), __builtin_bit_cast(float, hi & 0xffff0000u)}; }
DI int pos_index(int row) { return row < NP ? (row & (SEQ - 1)) : SEQ + ((row - NP) & (DS - 1)); }
DI float lg_gamma(int h) { return h == 0 ? -0.03174869831458027f : h == 1 ? -0.015748356968139112f : h == 2 ? -0.007843177461025892f : -0.003913899321136329f; }


namespace pg8 {
typedef unsigned short bf16_t;
typedef short bf16x8 __attribute__((ext_vector_type(8)));
typedef unsigned u32x4 __attribute__((ext_vector_type(4)));
typedef unsigned u32x2 __attribute__((ext_vector_type(2)));
constexpr int BM = 256, BK = 64, HALF = 128, HTB = HALF * BK * 2, STAGE_BYTES = 8 * HTB, NXCD = 8, WGM = 8;
__host__ __device__ __forceinline__ int lds_byte(int r, int c) { const int st = (r >> 4) * 2 + (c >> 5), rr = r & 15, cc = c & 31, ob = rr * 64 + cc * 2; return st * 1024 + (ob ^ (((ob >> 9) & 1) << 5)); }
__host__ __device__ __forceinline__ void stage_rc(int b, int& R, int& C) { const int st = b / 1024, sb = b % 1024, swz = sb ^ (((sb >> 9) & 1) << 5); R = (st >> 1) * 16 + swz / 64; C = (st & 1) * 32 + (swz % 64) / 2; }
__host__ __device__ __forceinline__ int perm32(int rho) { const int n = rho >> 4, i = rho & 15; return 8 * (i >> 2) + 4 * n + (i & 3); }
struct Unit { int pm, pn, ks; };
struct Gemm { const bf16_t* A; const bf16_t* Bt; int M, N, K, lda, ldb, ksl; };
struct StaticOrder {
    int nM, nN, nwg, G, c;
    __host__ __device__ void init(int M, int N, int G_, int c_) { nM = M / BM; nN = N / BM; nwg = nM * nN; G = G_; c = c_; }
    __host__ __device__ bool next(int i, Unit& u) const {
        const long L = (long)i * G + c; if (L >= nwg) return false;
        int wgid = (int)L; { const int q = nwg / NXCD, r = nwg % NXCD, xcd = wgid % NXCD, off = wgid / NXCD; wgid = (xcd < r ? xcd * (q + 1) : r * (q + 1) + (xcd - r) * q) + off; }
        const int nig = WGM * nN, gid = wgid / nig, fm = gid * WGM, gsz = (nM - fm) < WGM ? (nM - fm) : WGM;
        u.pm = fm + ((wgid % nig) % gsz); u.pn = (wgid % nig) / gsz; u.ks = 0; return true;
    }
    __device__ __forceinline__ void a_ready(const Unit&) const {}
    __device__ __forceinline__ void done(const Unit&) const {}
};
__device__ __forceinline__ unsigned cvt_pk_bf16(float lo, float hi) { return cvtpk(lo, hi); }
struct SplitOrder {
    int KS, c;
    __host__ __device__ bool next(int i, Unit& u) const { if (i != 0 || c >= 8 * KS) return false; const int tile = c / KS; u.ks = c % KS; u.pm = 64 + (tile >> 2); u.pn = tile & 3; return true; }
    __device__ __forceinline__ void a_ready(const Unit&) const {}
    __device__ __forceinline__ void done(const Unit&) const {}
};
struct EpiPart {
    static constexpr bool PERM = false, AFTER_DRAIN = false, HAS_MID = false;
    float* C;
    __device__ __forceinline__ void operator()(const f32x4 (&acc)[2][2][4][2], const Unit& u, int wr, int wc, int fr, int fq) const {
        const int row0 = (u.pm - 64) * BM + wr * 64 + fr, col0 = u.pn * BM + wc * 32 + 4 * fq; float* base = C + (size_t)u.ks * (512 * 1024);
#pragma unroll
        for (int ai = 0; ai < 2; ++ai)
#pragma unroll
            for (int m = 0; m < 4; ++m) { float* rowp = base + (size_t)(row0 + ai * HALF + m * 16) * 1024 + col0;
#pragma unroll
                for (int bj = 0; bj < 2; ++bj)
#pragma unroll
                    for (int n = 0; n < 2; ++n) *(f32x4*)(rowp + bj * HALF + n * 16) = acc[ai][bj][m][n]; }
    }
};
struct P1Order {
    StaticOrder so;
    __host__ __device__ void init(int G_, int c_) { so.init(64 * 256, 24 * 256, G_, c_); }
    __host__ __device__ bool next(int i, Unit& u) const {
        const long L = (long)i * so.G + so.c;
        if (L < 1536) { so.next(i, u); if (u.pn >= 4) u.pn += 4; return true; }
        u.ks = 0;
        if (L < 1536 + 56) { const int idx = (int)L - 1536; u.pm = 64 + idx / 28; u.pn = idx % 28; return true; }
        if (L < 1536 + 56 + 16) { const int idx = (int)L - 1592; u.pm = 66 + idx / 2; u.pn = 28 + idx % 2; return true; }
        return false;
    }
    __device__ __forceinline__ void a_ready(const Unit&) const {}
    __device__ __forceinline__ void done(const Unit&) const {}
};
struct EpiP1 {
    static constexpr bool PERM = true, AFTER_DRAIN = false, HAS_MID = false;
    bf16_t* Zp; int ldz; float* mk; float* mv; bf16_t* srg; bf16_t* sg; int c_rg, c_g;
    __device__ __forceinline__ void operator()(const f32x4 (&acc)[2][2][4][2], const Unit& u, int wr, int wc, int fr, int fq) const {
        if (u.pm >= 66) {
            float* base = (u.pn == 28) ? mk : mv; const int row0 = (u.pm - 66) * BM + wr * 64 + fr, col0 = wc * 32 + 8 * fq;
#pragma unroll
            for (int ai = 0; ai < 2; ++ai)
#pragma unroll
                for (int m = 0; m < 4; ++m) { float* rowp = base + (size_t)(row0 + ai * HALF + m * 16) * 256 + col0;
#pragma unroll
                    for (int bj = 0; bj < 2; ++bj) { *(f32x4*)(rowp + bj * HALF) = acc[ai][bj][m][0]; *(f32x4*)(rowp + bj * HALF + 4) = acc[ai][bj][m][1]; } }
            return;
        }
        const int row0 = u.pm * BM + wr * 64 + fr, col0 = u.pn * BM + wc * 32 + 8 * fq;
#pragma unroll
        for (int bj = 0; bj < 2; ++bj) { const int c = col0 + bj * HALF;
            if (c >= c_g + 3072) continue;
            const int kind = c >= c_g ? 2 : (c >= c_rg && c < c_rg + 1024) ? 1 : 0;
            bf16_t* dst = kind == 2 ? sg + (c - c_g) : kind == 1 ? srg + (c - c_rg) : Zp + c; const int ld = kind == 2 ? 3072 : kind == 1 ? 1024 : ldz;
#pragma unroll
            for (int ai = 0; ai < 2; ++ai)
#pragma unroll
                for (int m = 0; m < 4; ++m) { f32x4 v0 = acc[ai][bj][m][0], v1 = acc[ai][bj][m][1];
                    if (kind) {
#pragma unroll
                        for (int e = 0; e < 4; ++e) { const float s0 = 1.f / (1.f + __expf(-v0[e])), s1 = 1.f / (1.f + __expf(-v1[e])); v0[e] = kind == 2 ? s0 : v0[e] * s0; v1[e] = kind == 2 ? s1 : v1[e] * s1; } }
                    u32x4 w; w.x = cvt_pk_bf16(v0[0], v0[1]); w.y = cvt_pk_bf16(v0[2], v0[3]); w.z = cvt_pk_bf16(v1[0], v1[1]); w.w = cvt_pk_bf16(v1[2], v1[3]);
                    *(u32x4*)(dst + (size_t)(row0 + ai * HALF + m * 16) * ld) = w; } }
    }
};
struct EpiF32S {
    static constexpr bool PERM = false, AFTER_DRAIN = false, HAS_MID = false;
    float* C; int ldc; int split_tiles; size_t split_stride;
    __device__ __forceinline__ void operator()(const f32x4 (&acc)[2][2][4][2], const Unit& u, int wr, int wc, int fr, int fq) const {
        int pn = u.pn; float* base = C; if (split_tiles) { const int t = pn / split_tiles; base += (size_t)t * split_stride; pn -= t * split_tiles; }
        const int row0 = u.pm * BM + wr * 64 + fr, col0 = pn * BM + wc * 32 + 4 * fq;
#pragma unroll
        for (int ai = 0; ai < 2; ++ai)
#pragma unroll
            for (int m = 0; m < 4; ++m) { float* rowp = base + (size_t)(row0 + ai * HALF + m * 16) * ldc + col0;
#pragma unroll
                for (int bj = 0; bj < 2; ++bj)
#pragma unroll
                    for (int n = 0; n < 2; ++n) *(f32x4*)(rowp + bj * HALF + n * 16) = acc[ai][bj][m][n]; }
    }
};
struct EpiBf16S {
    static constexpr bool PERM = true, AFTER_DRAIN = false, HAS_MID = false;
    bf16_t* O; int ldc;
    __device__ __forceinline__ void operator()(const f32x4 (&acc)[2][2][4][2], const Unit& u, int wr, int wc, int fr, int fq) const {
        const int row0 = u.pm * BM + wr * 64 + fr, col0 = u.pn * BM + wc * 32 + 8 * fq;
#pragma unroll
        for (int ai = 0; ai < 2; ++ai)
#pragma unroll
            for (int m = 0; m < 4; ++m) { bf16_t* rowp = O + (size_t)(row0 + ai * HALF + m * 16) * ldc + col0;
#pragma unroll
                for (int bj = 0; bj < 2; ++bj) { const f32x4 v0 = acc[ai][bj][m][0], v1 = acc[ai][bj][m][1];
                    u32x4 w; w.x = cvt_pk_bf16(v0[0], v0[1]); w.y = cvt_pk_bf16(v0[2], v0[3]); w.z = cvt_pk_bf16(v1[0], v1[1]); w.w = cvt_pk_bf16(v1[2], v1[3]);
                    *(u32x4*)(rowp + bj * HALF) = w; } }
    }
};
struct EpiSwiGLU {
    static constexpr bool PERM = true, AFTER_DRAIN = false, HAS_MID = false;
    bf16_t* O; int ldc;
    __device__ __forceinline__ void operator()(const f32x4 (&acc)[2][2][4][2], const Unit& u, int wr, int wc, int fr, int fq) const {
        const int row0 = u.pm * BM + wr * 64 + fr, col0 = u.pn * (BM / 2) + wc * 16 + 4 * fq;
#pragma unroll
        for (int ai = 0; ai < 2; ++ai)
#pragma unroll
            for (int m = 0; m < 4; ++m) { bf16_t* rowp = O + (size_t)(row0 + ai * HALF + m * 16) * ldc + col0;
#pragma unroll
                for (int bj = 0; bj < 2; ++bj) { const f32x4 v0 = acc[ai][bj][m][0], v1 = acc[ai][bj][m][1];
                    const float a0 = v0[0] / (1.f + __expf(-v0[0])) * v0[1], a1 = v0[2] / (1.f + __expf(-v0[2])) * v0[3];
                    const float a2 = v1[0] / (1.f + __expf(-v1[0])) * v1[1], a3 = v1[2] / (1.f + __expf(-v1[2])) * v1[3];
                    u32x2 w; w.x = cvt_pk_bf16(a0, a1); w.y = cvt_pk_bf16(a2, a3);
                    *(u32x2*)(rowp + bj * (HALF / 2)) = w; } }
    }
};
template <int MODE  > struct EpiGate {
    static constexpr bool PERM = true, AFTER_DRAIN = false, HAS_MID = false;
    const bf16_t* sg; const bf16_t* tin; bf16_t* tout; int ldc;
    __device__ __forceinline__ void operator()(const f32x4 (&acc)[2][2][4][2], const Unit& u, int wr, int wc, int fr, int fq) const {
        const int row0 = u.pm * BM + wr * 64 + fr, col0 = u.pn * BM + wc * 32 + 8 * fq;
#pragma unroll
        for (int ai = 0; ai < 2; ++ai)
#pragma unroll
            for (int m = 0; m < 4; ++m) { const size_t r = (size_t)(row0 + ai * HALF + m * 16);
#pragma unroll
                for (int bj = 0; bj < 2; ++bj) { const int c = col0 + bj * HALF;
                    const u32x4 gq = *(const u32x4*)(sg + r * 3072 + c); u32x4 tq = {0u, 0u, 0u, 0u}; if (MODE >= 1) tq = *(const u32x4*)(tin + r * ldc + c);
                    const f32x4 v0 = acc[ai][bj][m][0], v1 = acc[ai][bj][m][1]; u32x4 w;
#define EG_ONE(dst, x0, x1, gw_, tw_) { float a_ = (x0) * __builtin_bit_cast(float, (gw_) << 16), b_ = (x1) * __builtin_bit_cast(float, (gw_) & 0xffff0000u); \
                        if (MODE >= 1) { a_ += __builtin_bit_cast(float, (tw_) << 16); b_ += __builtin_bit_cast(float, (tw_) & 0xffff0000u); } dst = cvt_pk_bf16(a_, b_); }
                    EG_ONE(w.x, v0[0], v0[1], gq.x, tq.x) EG_ONE(w.y, v0[2], v0[3], gq.y, tq.y) EG_ONE(w.z, v1[0], v1[1], gq.z, tq.z) EG_ONE(w.w, v1[2], v1[3], gq.w, tq.w)
#undef EG_ONE
                    *(u32x4*)(tout + r * ldc + c) = w; } }
    }
};
struct EpiGate3 {
    static constexpr bool PERM = true, AFTER_DRAIN = false, HAS_MID = true;
    const bf16_t* sg; bf16_t* out; int ldc; int t1, t2;
    __device__ __forceinline__ void mid(f32x4 (&acc)[2][2][4][2], const Unit& u, int wr, int wc, int fr, int fq, int seam) const {
        int row0 = u.pm * BM + wr * 64 + fr, col0 = u.pn * BM + wc * 32 + 8 * fq;
        asm volatile("" : "+v"(row0), "+v"(col0));
#pragma unroll
        for (int ai = 0; ai < 2; ++ai)
#pragma unroll
            for (int m = 0; m < 4; ++m) { const bf16_t* gp = sg + (size_t)(row0 + ai * HALF + m * 16) * 3072 + seam * 1024 + col0;
#pragma unroll
                for (int bj = 0; bj < 2; ++bj) { const u32x4 ga = *(const u32x4*)(gp + bj * HALF), gb = *(const u32x4*)(gp + 1024 + bj * HALF);
#define EG3_R(a_, b_, hi_) (fmaxf(__builtin_bit_cast(float, (hi_) ? ((a_) & 0xffff0000u) : ((a_) << 16)), 1e-30f) * __builtin_amdgcn_rcpf(fmaxf(__builtin_bit_cast(float, (hi_) ? ((b_) & 0xffff0000u) : ((b_) << 16)), 1e-30f)))
                    acc[ai][bj][m][0][0] *= EG3_R(ga.x, gb.x, 0); acc[ai][bj][m][0][1] *= EG3_R(ga.x, gb.x, 1); acc[ai][bj][m][0][2] *= EG3_R(ga.y, gb.y, 0); acc[ai][bj][m][0][3] *= EG3_R(ga.y, gb.y, 1);
                    acc[ai][bj][m][1][0] *= EG3_R(ga.z, gb.z, 0); acc[ai][bj][m][1][1] *= EG3_R(ga.z, gb.z, 1); acc[ai][bj][m][1][2] *= EG3_R(ga.w, gb.w, 0); acc[ai][bj][m][1][3] *= EG3_R(ga.w, gb.w, 1);
#undef EG3_R
                } }
    }
    __device__ __forceinline__ void operator()(const f32x4 (&acc)[2][2][4][2], const Unit& u, int wr, int wc, int fr, int fq) const {
        const int row0 = u.pm * BM + wr * 64 + fr, col0 = u.pn * BM + wc * 32 + 8 * fq;
#pragma unroll
        for (int ai = 0; ai < 2; ++ai)
#pragma unroll
            for (int m = 0; m < 4; ++m) { const size_t r = (size_t)(row0 + ai * HALF + m * 16);
#pragma unroll
                for (int bj = 0; bj < 2; ++bj) { const int c = col0 + bj * HALF;
                    const u32x4 gq = *(const u32x4*)(sg + r * 3072 + 2048 + c); const f32x4 v0 = acc[ai][bj][m][0], v1 = acc[ai][bj][m][1]; u32x4 w;
#define EG3_G(g_, hi_) fmaxf(__builtin_bit_cast(float, (hi_) ? ((g_) & 0xffff0000u) : ((g_) << 16)), 1e-30f)
                    w.x = cvt_pk_bf16(v0[0] * EG3_G(gq.x, 0), v0[1] * EG3_G(gq.x, 1)); w.y = cvt_pk_bf16(v0[2] * EG3_G(gq.y, 0), v0[3] * EG3_G(gq.y, 1));
                    w.z = cvt_pk_bf16(v1[0] * EG3_G(gq.z, 0), v1[1] * EG3_G(gq.z, 1)); w.w = cvt_pk_bf16(v1[2] * EG3_G(gq.w, 0), v1[3] * EG3_G(gq.w, 1));
#undef EG3_G
                    *(u32x4*)(out + r * ldc + c) = w; } }
    }
};
template <class Epi, class Sched, bool ALIGN_EPI = false, bool SP2 = false>
__device__ __forceinline__ void gemm_phase(LAS unsigned char* lds, const Gemm g, const Sched& S, const Epi& E) {
    int tid_ = threadIdx.x; asm volatile("" : "+v"(tid_));
    const int tid = tid_, wid = __builtin_amdgcn_readfirstlane(tid >> 6), lane = tid & 63, wr = wid >> 2, wc = wid & 3, fr = lane & 15, fq = lane >> 4;
    const int K = g.K, nt = K / BK;
    unsigned voffA[2], voffB[2];
#pragma unroll
    for (int i = 0; i < 2; ++i) { int R, C; stage_rc(tid * 16 + i * 8192, R, C); const int Rb = Epi::PERM ? ((R & ~31) + perm32(R & 31)) : R;
        voffA[i] = (unsigned)(R * g.lda + C) * 2u; voffB[i] = (unsigned)(Rb * g.ldb + C) * 2u; }
    const size_t kstep = (size_t)(BK * 2);
    const size_t hstepA = (size_t)HALF * g.lda * 2, hstepB = (size_t)HALF * g.ldb * 2;
    const size_t tstepA = 2 * hstepA, tstepB = 2 * hstepB;
    const unsigned ldsw = (unsigned)wid * 1024u;
    const int aoff = lds_byte(wr * 64 + fr, fq * 8), boff = lds_byte(wc * 32 + fr, fq * 8);
#define PG8_SA(b, h) (((b) * 2 + (h)) * HTB)
#define PG8_SB(b, h) ((4 + (b) * 2 + (h)) * HTB)
#define PG8_STAGE(bufoff, gbase, voff) do { _Pragma("unroll") for (int _i = 0; _i < 2; ++_i) \
        __builtin_amdgcn_global_load_lds((const unsigned*)((const char*)(gbase) + (voff)[_i]), (LAS unsigned*)(lds + (bufoff) + ldsw + _i * 8192), 16, 0, 0); } while (0)
#define PG8_LDA(dst, b, h) do { _Pragma("unroll") for (int m = 0; m < 4; ++m) _Pragma("unroll") for (int k = 0; k < 2; ++k) dst[m][k] = *(const LAS bf16x8*)(lds + PG8_SA(b, h) + aoff + m * 2048 + k * 1024); } while (0)
#define PG8_LDB(dst, b, h) do { _Pragma("unroll") for (int n = 0; n < 2; ++n) _Pragma("unroll") for (int k = 0; k < 2; ++k) dst[n][k] = *(const LAS bf16x8*)(lds + PG8_SB(b, h) + boff + n * 2048 + k * 1024); } while (0)
#define PG8_MMA(ai, bj, At, Bt) do { __builtin_amdgcn_s_setprio(1); _Pragma("unroll") for (int m = 0; m < 4; ++m) _Pragma("unroll") for (int n = 0; n < 2; ++n) _Pragma("unroll") for (int k = 0; k < 2; ++k) \
        acc[ai][bj][m][n] = __builtin_amdgcn_mfma_f32_16x16x32_bf16(Bt[n][k], At[m][k], acc[ai][bj][m][n], 0, 0, 0); __builtin_amdgcn_s_setprio(0); } while (0)
#define PG8_WAIT_V(n) asm volatile("s_waitcnt vmcnt(" #n ")" ::: "memory")
#define PG8_WAIT_L(n) asm volatile("s_waitcnt lgkmcnt(" #n ")" ::: "memory")
#define PG8_BAR __builtin_amdgcn_s_barrier()
#define PG8_SCHED __builtin_amdgcn_sched_barrier(0)
    Unit cur, nxt; int ui = 0;
    if (!S.next(0, cur)) return;
    f32x4 acc[2][2][4][2];
#pragma unroll
    for (int a = 0; a < 2; ++a)
#pragma unroll
        for (int b = 0; b < 2; ++b)
#pragma unroll
            for (int m = 0; m < 4; ++m)
#pragma unroll
                for (int n = 0; n < 2; ++n) acc[a][b][m][n] = (f32x4){0.f, 0.f, 0.f, 0.f};
    bf16x8 At[4][2], B0[2][2], B1[2][2];
    const size_t kslb = (size_t)g.ksl * 2;
    const char* cA = (const char*)g.A + (size_t)cur.pm * tstepA + cur.ks * kslb; const char* cB = (const char*)g.Bt + (size_t)cur.pn * tstepB + cur.ks * kslb;
    S.a_ready(cur);
    if constexpr (SP2) {
        PG8_STAGE(PG8_SB(0, 0), cB, voffB); PG8_STAGE(PG8_SB(0, 1), cB + hstepB, voffB); PG8_STAGE(PG8_SA(0, 0), cA, voffA); PG8_STAGE(PG8_SA(0, 1), cA + hstepA, voffA);
        if (wr == 1) PG8_BAR;
        PG8_WAIT_V(2); PG8_BAR;
        PG8_STAGE(PG8_SB(1, 0), cB + kstep, voffB); PG8_STAGE(PG8_SA(1, 0), cA + kstep, voffA); PG8_STAGE(PG8_SB(1, 1), cB + hstepB + kstep, voffB);
        PG8_WAIT_V(6); PG8_BAR;
    } else {
        PG8_STAGE(PG8_SB(0, 0), cB, voffB); PG8_STAGE(PG8_SA(0, 0), cA, voffA); PG8_STAGE(PG8_SB(0, 1), cB + hstepB, voffB); PG8_STAGE(PG8_SA(0, 1), cA + hstepA, voffA);
        if (wr == 1) PG8_BAR;
        PG8_WAIT_V(4); PG8_BAR;
        PG8_STAGE(PG8_SB(1, 0), cB + kstep, voffB); PG8_STAGE(PG8_SA(1, 0), cA + kstep, voffA); PG8_STAGE(PG8_SB(1, 1), cB + hstepB + kstep, voffB);
        PG8_WAIT_V(6); PG8_BAR;
    }
    for (;;) {
        const bool has_next = S.next(ui + 1, nxt);
        const char* nA = has_next ? (const char*)g.A + (size_t)nxt.pm * tstepA + nxt.ks * kslb : cA; const char* nB = has_next ? (const char*)g.Bt + (size_t)nxt.pn * tstepB + nxt.ks * kslb : cB;
#pragma unroll 1
        for (int t = 0; t < nt; t += 2) {
            const bool last = (t == nt - 2);
            const char* a1 = cA + (size_t)(t + 1) * kstep;
            const char* a2 = last ? nA : cA + (size_t)(t + 2) * kstep; const char* b2 = last ? nB : cB + (size_t)(t + 2) * kstep;
            const char* a3 = a2 + kstep; const char* b3 = b2 + kstep;
            if (last && has_next) S.a_ready(nxt);
            if constexpr (Epi::HAS_MID) { if (t == E.t1 || t == E.t2) E.mid(acc, cur, wr, wc, fr, fq, t == E.t1 ? 0 : 1); }
            if constexpr (SP2) {
            PG8_LDB(B0, 0, 0); PG8_LDB(B1, 0, 1); PG8_SCHED; PG8_LDA(At, 0, 0); PG8_STAGE(PG8_SA(1, 1), a1 + hstepA, voffA);
            PG8_WAIT_V(8); PG8_WAIT_L(0); PG8_BAR; PG8_MMA(0, 0, At, B0); PG8_MMA(0, 1, At, B1); PG8_BAR; PG8_SCHED;
            PG8_LDA(At, 0, 1); PG8_STAGE(PG8_SB(0, 0), b2, voffB); PG8_STAGE(PG8_SB(0, 1), b2 + hstepB, voffB); PG8_STAGE(PG8_SA(0, 0), a2, voffA);
            PG8_WAIT_V(8); PG8_WAIT_L(0); PG8_BAR; PG8_MMA(1, 0, At, B0); PG8_MMA(1, 1, At, B1); PG8_BAR; PG8_SCHED;
            PG8_LDB(B0, 1, 0); PG8_LDB(B1, 1, 1); PG8_SCHED; PG8_LDA(At, 1, 0); PG8_STAGE(PG8_SA(0, 1), a2 + hstepA, voffA);
            PG8_WAIT_V(8); PG8_WAIT_L(0); PG8_BAR; PG8_MMA(0, 0, At, B0); PG8_MMA(0, 1, At, B1); PG8_BAR; PG8_SCHED;
            PG8_LDA(At, 1, 1); PG8_STAGE(PG8_SB(1, 0), b3, voffB); PG8_STAGE(PG8_SB(1, 1), b3 + hstepB, voffB); PG8_STAGE(PG8_SA(1, 0), a3, voffA);
            PG8_WAIT_V(8); PG8_WAIT_L(0); PG8_BAR; PG8_MMA(1, 0, At, B0); PG8_MMA(1, 1, At, B1); PG8_BAR; PG8_SCHED;
            } else {
            PG8_LDB(B0, 0, 0); PG8_SCHED; PG8_LDA(At, 0, 0); PG8_STAGE(PG8_SA(1, 1), a1 + hstepA, voffA);
            PG8_WAIT_L(8); PG8_BAR; PG8_WAIT_L(0); PG8_MMA(0, 0, At, B0); PG8_BAR; PG8_SCHED;
            PG8_LDB(B1, 0, 1); PG8_STAGE(PG8_SB(0, 0), b2, voffB);
            PG8_BAR; PG8_WAIT_L(0); PG8_MMA(0, 1, At, B1); PG8_BAR;
            PG8_LDA(At, 0, 1); PG8_STAGE(PG8_SA(0, 0), a2, voffA);
            PG8_BAR; PG8_WAIT_L(0); PG8_MMA(1, 0, At, B0); PG8_BAR; PG8_SCHED;
            PG8_STAGE(PG8_SB(0, 1), b2 + hstepB, voffB);
            PG8_WAIT_V(6); PG8_BAR; PG8_MMA(1, 1, At, B1); PG8_BAR;
            PG8_LDB(B0, 1, 0); PG8_SCHED; PG8_LDA(At, 1, 0); PG8_STAGE(PG8_SA(0, 1), a2 + hstepA, voffA);
            PG8_WAIT_L(8); PG8_BAR; PG8_WAIT_L(0); PG8_MMA(0, 0, At, B0); PG8_BAR; PG8_SCHED;
            PG8_LDB(B1, 1, 1); PG8_STAGE(PG8_SB(1, 0), b3, voffB);
            PG8_BAR; PG8_WAIT_L(0); PG8_MMA(0, 1, At, B1); PG8_BAR;
            PG8_LDA(At, 1, 1); PG8_STAGE(PG8_SA(1, 0), a3, voffA);
            PG8_BAR; PG8_WAIT_L(0); PG8_MMA(1, 0, At, B0); PG8_BAR; PG8_SCHED;
            PG8_STAGE(PG8_SB(1, 1), b3 + hstepB, voffB);
            PG8_WAIT_V(6); PG8_BAR; PG8_MMA(1, 1, At, B1); PG8_BAR;
            }
        }
        if constexpr (ALIGN_EPI) { if (wr == 0) PG8_BAR; }
        if constexpr (!Epi::AFTER_DRAIN) { E(acc, cur, wr, wc, fr, fq); S.done(cur); }
        if (!has_next) break;
#pragma unroll
        for (int a = 0; a < 2; ++a)
#pragma unroll
            for (int b = 0; b < 2; ++b)
#pragma unroll
                for (int m = 0; m < 4; ++m)
#pragma unroll
                    for (int n = 0; n < 2; ++n) acc[a][b][m][n] = (f32x4){0.f, 0.f, 0.f, 0.f};
        cur = nxt; cA = nA; cB = nB; ++ui;
        if constexpr (ALIGN_EPI) { if (wr == 1) PG8_BAR; }
    }
    PG8_WAIT_V(0);
    if constexpr (!ALIGN_EPI) { if (wr == 0) PG8_BAR; }
    PG8_BAR;
    if constexpr (Epi::AFTER_DRAIN) { E.fused(acc, cur, wr, wc, fr, fq, lds, wid, lane); S.done(cur); }
#undef PG8_SA
#undef PG8_SB
#undef PG8_STAGE
#undef PG8_LDA
#undef PG8_LDB
#undef PG8_MMA
#undef PG8_WAIT_V
#undef PG8_WAIT_L
#undef PG8_BAR
#undef PG8_SCHED
}
}
typedef unsigned short bf16_t;
DI unsigned pk2(float lo, float hi) { return pg8::cvt_pk_bf16(lo, hi); }
DI bf16_t f2bf(float f) { return (bf16_t)(pg8::cvt_pk_bf16(f, 0.f) & 0xffffu); }
DI void transpose_item(const float* W, int N, bf16_t* WT, int ldt, int row_off, int rmul, LAS float* scr, int item, int lane) {
    const int nblk = N / 32, kb = item / nblk, nb = item % nblk, k0 = 64 * kb, n0 = 32 * nb;
#pragma unroll 8
    for (int i = 0; i < 32; ++i) { const int kk = 2 * i + (lane >> 5); scr[kk * 33 + (lane & 31)] = W[(size_t)(k0 + kk) * N + n0 + (lane & 31)]; }
    asm volatile("s_waitcnt lgkmcnt(0)" ::: "memory");
    const int c = lane & 7;
#pragma unroll
    for (int j = 0; j < 4; ++j) { const int n = (lane >> 3) + 8 * j; const LAS float* sp = scr + (8 * c) * 33 + n;
        pg8::u32x4 o; o.x = pk2(sp[0 * 33], sp[1 * 33]); o.y = pk2(sp[2 * 33], sp[3 * 33]); o.z = pk2(sp[4 * 33], sp[5 * 33]); o.w = pk2(sp[6 * 33], sp[7 * 33]);
        *(pg8::u32x4*)(WT + (size_t)(row_off + rmul * (n0 + n)) * ldt + k0 + 8 * c) = o; }
    asm volatile("s_waitcnt lgkmcnt(0)" ::: "memory");
}
DI void transpose_w(const float* W, int K, int N, bf16_t* WT, int ldt, int row_off, LAS float* scr, int gw, int NGW, int lane, int& rot, int rmul = 1) {
    const int nitems = (K / 64) * (N / 32);
    int first = gw - (rot % NGW); if (first < 0) first += NGW;
    for (int it = first; it < nitems; it += NGW) transpose_item(W, N, WT, ldt, row_off, rmul, scr, it, lane);
    rot += nitems;
}

struct Args {
    const float* in[29]; float* out; unsigned char* ws; int ph_lo, ph_hi, sub, pad;
};

DI unsigned short f2bf_raw(float f) { unsigned u = __builtin_bit_cast(unsigned, f); return (unsigned short)((u + 0x7fffu + ((u >> 16) & 1u)) >> 16); }
DI void sgemm_naive(LAS float* lds, const float* __restrict__ A, int lda, const float* __restrict__ B, long sbk, long sbn,
                    float* __restrict__ C, int ldc, int M, int N, int K, int bid, int G, unsigned short* Cb = nullptr) {
    LAS float* As = lds;
    LAS float* Bs = lds + 16 * 132;
    const int tid = threadIdx.x, tx = tid & 15, ty = tid >> 4;
    const int ntn = N / 64, ntiles = (M / 128) * ntn;
    for (int t = bid; t < ntiles; t += G) {
        const int m0 = (t / ntn) * 128, n0 = (t % ntn) * 64;
        float acc[4][4];
#pragma unroll
        for (int i = 0; i < 4; ++i)
#pragma unroll
            for (int j = 0; j < 4; ++j) acc[i][j] = 0.f;
        for (int k0 = 0; k0 < K; k0 += 16) {
            {
                const int r = tid >> 2, kq = (tid & 3) * 4;
                const float4 v = *(const float4*)(A + (size_t)(m0 + r) * lda + k0 + kq);
                As[(kq + 0) * 132 + r] = v.x; As[(kq + 1) * 132 + r] = v.y; As[(kq + 2) * 132 + r] = v.z; As[(kq + 3) * 132 + r] = v.w;
            }
#pragma unroll
            for (int i = 0; i < 2; ++i) {
                const int idx = tid + i * 512, kk = idx >> 6, nn = idx & 63;
                Bs[kk * 64 + nn] = B[(size_t)(k0 + kk) * sbk + (size_t)(n0 + nn) * sbn];
            }
            __syncthreads();
#pragma unroll
            for (int kk = 0; kk < 16; ++kk) {
                const f32x4 a = *(const LAS f32x4*)(As + kk * 132 + ty * 4);
                const f32x4 b = *(const LAS f32x4*)(Bs + kk * 64 + tx * 4);
                const float av[4] = {a.x, a.y, a.z, a.w}, bv[4] = {b.x, b.y, b.z, b.w};
#pragma unroll
                for (int i = 0; i < 4; ++i)
#pragma unroll
                    for (int j = 0; j < 4; ++j) acc[i][j] += av[i] * bv[j];
            }
            __syncthreads();
        }
#pragma unroll
        for (int i = 0; i < 4; ++i) {
            float4 o; o.x = acc[i][0]; o.y = acc[i][1]; o.z = acc[i][2]; o.w = acc[i][3];
            if (Cb) { unsigned short* cb = Cb + (size_t)(m0 + ty * 4 + i) * ldc + n0 + tx * 4; cb[0] = f2bf_raw(o.x); cb[1] = f2bf_raw(o.y); cb[2] = f2bf_raw(o.z); cb[3] = f2bf_raw(o.w); }
            else *(float4*)(C + (size_t)(m0 + ty * 4 + i) * ldc + n0 + tx * 4) = o;
        }
    }
}

template <int DQK, int DV, bool V_IN_K, int MODE, class KV, class QF>
DI void attn_naive(LAS float* lds, const KV& kv, int nk_loop, const QF& qf, bool active, int limit, float scale, float lg, int tq, float* optr) {
    constexpr int KS = DQK + 1;
    constexpr int VS = V_IN_K ? KS : DV;
    LAS float* Ks = lds;
    LAS float* Vs = V_IN_K ? Ks : (lds + 64 * KS);
    LAS float* qs = lds + 64 * KS + (V_IN_K ? 0 : 64 * DV);
    LAS float* ps = qs + 8 * DQK;
    static_assert((64 * KS + (V_IN_K ? 0 : 64 * DV) + 8 * DQK + 8 * 64) * 4 <= MISC_OFF, "attn_naive LDS");
    const int tid = threadIdx.x, lane = tid & 63, w = tid >> 6;
    __syncthreads();
    for (int d = lane; d < DQK; d += 64) qs[w * DQK + d] = active ? qf(d) : 0.f;
    float m = -INFINITY, l = 0.f;
    float acc[DV / 64];
#pragma unroll
    for (int c = 0; c < DV / 64; ++c) acc[c] = 0.f;
    for (int base = 0; base < nk_loop; base += 64) {
        __syncthreads();
        for (int idx = tid; idx < 64 * DQK; idx += NTHREADS) { const int j = idx / DQK, d = idx - j * DQK, key = base + j; Ks[j * KS + d] = key < nk_loop ? kv.k(key, d) : 0.f; }
        if (!V_IN_K) for (int idx = tid; idx < 64 * DV; idx += NTHREADS) { const int j = idx / DV, e = idx - j * DV, key = base + j; Vs[j * DV + e] = key < nk_loop ? kv.v(key, e) : 0.f; }
        __syncthreads();
        const int key = base + lane; const bool valid = active && key <= limit && key < nk_loop;
        float s = 0.f;
        for (int d = 0; d < DQK; ++d) s += qs[w * DQK + d] * Ks[lane * KS + d];
        float p;
        if (MODE == 0) {
            s *= scale;
            const float cm = wave_max(valid ? s : -INFINITY);
            const float mn = fmaxf(m, cm);
            const float alpha = (mn == -INFINITY) ? 1.f : expf(m - mn);
            p = valid ? expf(s - mn) : 0.f;
            l = l * alpha + wave_sum(p);
#pragma unroll
            for (int c = 0; c < DV / 64; ++c) acc[c] *= alpha;
            m = mn;
        } else {
            p = valid ? s * expf((float)(tq - key) * lg) : 0.f;
        }
        ps[w * 64 + lane] = p;
        __syncthreads();
        for (int j = 0; j < 64; ++j) { const float pj = ps[w * 64 + j];
#pragma unroll
            for (int c = 0; c < DV / 64; ++c) acc[c] += pj * Vs[j * VS + lane + 64 * c]; }
    }
    if (active) {
#pragma unroll
        for (int c = 0; c < DV / 64; ++c) optr[lane + 64 * c] = (MODE == 0) ? acc[c] / l : acc[c];
    }
}

struct KvMlaPrompt { const float* ckvn; const float* kper; int b;
    DI float k(int key, int d) const { const size_t row = (size_t)b * SEQ + key; return d < KVL ? ckvn[row * KVL + d] : kper[row * DROPE + (d - KVL)]; }
    DI float v(int, int) const { return 0.f; } };
struct KvMlaSample { const float* ckvn; const float* kper; const float* cckv; const float* ckpe; const int* pt; int b;
    DI float k(int key, int d) const {
        if (key < PAST) { const size_t r = (size_t)pt[b * NPAGES + (key >> 7)] * PAGE + (key & (PAGE - 1)); return d < KVL ? cckv[r * KVL + d] : ckpe[r * DROPE + (d - KVL)]; }
        const size_t row = (size_t)NP + b * DS + (key - PAST); return d < KVL ? ckvn[row * KVL + d] : kper[row * DROPE + (d - KVL)]; }
    DI float v(int, int) const { return 0.f; } };
struct KvRet { const float* rk; const float* z; int b, h;
    DI float k(int key, int d) const { return rk[((size_t)b * SEQ + key) * 512 + h * RDK + d]; }
    DI float v(int key, int e) const { return z[((size_t)b * SEQ + key) * ZLD + C_RV + h * RDV + e]; } };
struct KvMem { const float* mk; const float* mv; int b, h;
    DI float k(int key, int d) const { return mk[(((size_t)b * NMEM + key) * XH + h) * XHD + d]; }
    DI float v(int key, int e) const { return mv[(((size_t)b * NMEM + key) * XH + h) * XHD + e]; } };


typedef float f32x16 __attribute__((ext_vector_type(16)));
typedef short bf16x8 __attribute__((ext_vector_type(8)));
typedef short s16x4 __attribute__((ext_vector_type(4)));
typedef unsigned u32x4_t __attribute__((ext_vector_type(4)));
typedef unsigned u32x2_t __attribute__((ext_vector_type(2)));
DI int crow(int i, int h) { return (i & 3) + 8 * (i >> 2) + 4 * h; }
#define MFMA32(a, b, c) __builtin_amdgcn_mfma_f32_32x32x16_bf16((a), (b), (c), 0, 0, 0)
template <int DQK, int DV, bool CAUSAL, class Src>
DI void flash_unit(LAS unsigned char* lds, const Src& src, int qpos0, int ntiles, bf16_t* O, int ldo, float c2) {
    constexpr int KP = DQK + 8, VP = 68, KS = DQK / 16, NBLK = DV / 32;
    constexpr int KBYTES = 64 * KP * 2, VBYTES = DV * VP * 2, BUF = KBYTES + VBYTES;
    constexpr int D8 = DQK / 8, NPK = (64 * D8) / NTHREADS, NPV = (DV * 8) / NTHREADS;
    static_assert((64 * D8) % NTHREADS == 0 && (DV * 8) % NTHREADS == 0 && 2 * BUF <= 131072, "flash_unit geometry");
    const int tid = threadIdx.x, lane = tid & 63, w = __builtin_amdgcn_readfirstlane(tid >> 6), l31 = lane & 31, h = lane >> 5;
    bf16x8 qf[KS];
#pragma unroll
    for (int s_ = 0; s_ < KS; ++s_) qf[s_] = src.qfrag(32 * w + l31, s_, h);
    f32x16 o[NBLK];
#pragma unroll
    for (int b = 0; b < NBLK; ++b)
#pragma unroll
        for (int i = 0; i < 16; ++i) o[b][i] = 0.f;
    float m = -INFINITY, lsum = 0.f;
    u32x4_t kreg[NPK], vreg[NPV];
#define FL_LOAD(t_) do { _Pragma("unroll") for (int i_ = 0; i_ < NPK; ++i_) { const int p_ = tid + i_ * NTHREADS; kreg[i_] = src.kpiece(64 * (t_) + p_ / D8, p_ % D8); } \
                         _Pragma("unroll") for (int i_ = 0; i_ < NPV; ++i_) { const int p_ = tid + i_ * NTHREADS; vreg[i_] = src.vpiece(p_ >> 3, 64 * (t_) + 8 * (p_ & 7)); } } while (0)
#define FL_STORE(buf_) do { _Pragma("unroll") for (int i_ = 0; i_ < NPK; ++i_) { const int p_ = tid + i_ * NTHREADS; *(LAS u32x4_t*)(lds + (buf_) * BUF + ((p_ / D8) * KP + (p_ % D8) * 8) * 2) = kreg[i_]; } \
                          _Pragma("unroll") for (int i_ = 0; i_ < NPV; ++i_) { const int p_ = tid + i_ * NTHREADS; LAS unsigned char* a_ = lds + (buf_) * BUF + KBYTES + ((p_ >> 3) * VP + (p_ & 7) * 8) * 2; \
                              *(LAS u32x2_t*)a_ = (u32x2_t){vreg[i_].x, vreg[i_].y}; *(LAS u32x2_t*)(a_ + 8) = (u32x2_t){vreg[i_].z, vreg[i_].w}; } } while (0)
    __syncthreads();
    FL_LOAD(0); FL_STORE(0);
    __syncthreads();
    const int qmine = qpos0 + 32 * w + l31, qlast = qpos0 + 32 * w + 31;
    for (int t = 0; t < ntiles; ++t) {
        const int buf = t & 1;
        if (t + 1 < ntiles) FL_LOAD(t + 1);
        if (!CAUSAL || 64 * t <= qlast) {
            const LAS unsigned char* kb_ = lds + buf * BUF; const LAS unsigned char* vb_ = kb_ + KBYTES;
            f32x16 st[2];
#pragma unroll
            for (int kb = 0; kb < 2; ++kb) {
#pragma unroll
                for (int i = 0; i < 16; ++i) st[kb][i] = 0.f;
#pragma unroll
                for (int g_ = 0; g_ < KS / 4; ++g_) { bf16x8 kf[4];
#pragma unroll
                    for (int j = 0; j < 4; ++j) kf[j] = *(const LAS bf16x8*)(kb_ + ((32 * kb + l31) * KP + 16 * (4 * g_ + j) + 8 * h) * 2);
#pragma unroll
                    for (int j = 0; j < 4; ++j) st[kb] = MFMA32(kf[j], qf[4 * g_ + j], st[kb]);
                    __builtin_amdgcn_sched_barrier(0); }
            }
            if (CAUSAL && 64 * t + 63 > qpos0 + 32 * w) {
#pragma unroll
                for (int kb = 0; kb < 2; ++kb)
#pragma unroll
                    for (int i = 0; i < 16; ++i) { const int key = 64 * t + 32 * kb + crow(i, h); st[kb][i] = key <= qmine ? st[kb][i] : -INFINITY; }
            }
            float mx = -INFINITY;
#pragma unroll
            for (int kb = 0; kb < 2; ++kb)
#pragma unroll
                for (int i = 0; i < 16; ++i) mx = fmaxf(mx, st[kb][i]);
            mx = fmaxf(mx, __shfl_xor(mx, 32));
            const float mn = fmaxf(m, mx);
            { const float alpha = __builtin_amdgcn_exp2f((m - mn) * c2);
                lsum *= alpha;
#pragma unroll
                for (int b = 0; b < NBLK; ++b)
#pragma unroll
                    for (int i = 0; i < 16; ++i) o[b][i] *= alpha;
                m = mn;
            }
            const float nmc = -mn * c2;
            float ps = 0.f;
#pragma unroll
            for (int kb = 0; kb < 2; ++kb)
#pragma unroll
                for (int i = 0; i < 16; ++i) { const float p = __builtin_amdgcn_exp2f(__builtin_fmaf(st[kb][i], c2, nmc)); st[kb][i] = p; ps += p; }
            lsum += ps;
            bf16x8 pf[4];
#pragma unroll
            for (int ks = 0; ks < 4; ++ks) { const int kb = ks >> 1, s2 = ks & 1; u32x4_t pk;
                pk.x = cvtpk(st[kb][8 * s2 + 0], st[kb][8 * s2 + 1]); pk.y = cvtpk(st[kb][8 * s2 + 2], st[kb][8 * s2 + 3]);
                pk.z = cvtpk(st[kb][8 * s2 + 4], st[kb][8 * s2 + 5]); pk.w = cvtpk(st[kb][8 * s2 + 6], st[kb][8 * s2 + 7]); pf[ks] = __builtin_bit_cast(bf16x8, pk); }
            __builtin_amdgcn_sched_barrier(0);
#pragma unroll
            for (int b = 0; b < NBLK; ++b) { bf16x8 vf[4];
#pragma unroll
                for (int ks = 0; ks < 4; ++ks) { const LAS unsigned char* a_ = vb_ + ((32 * b + l31) * VP + 16 * ks + 4 * h) * 2;
                    const s16x4 lo = *(const LAS s16x4*)a_, hi = *(const LAS s16x4*)(a_ + 16);
                    vf[ks] = __builtin_shufflevector(lo, hi, 0, 1, 2, 3, 4, 5, 6, 7); }
#pragma unroll
                for (int ks = 0; ks < 4; ++ks) o[b] = MFMA32(vf[ks], pf[ks], o[b]);
                __builtin_amdgcn_sched_barrier(0); }
        }
        if (t + 1 < ntiles) FL_STORE(buf ^ 1);
        __syncthreads();
    }
#undef FL_LOAD
#undef FL_STORE
    lsum += __shfl_xor(lsum, 32);
    const float inv = 1.f / lsum;
    bf16_t* orow = O + (size_t)(32 * w + l31) * ldo;
#pragma unroll
    for (int b = 0; b < NBLK; ++b)
#pragma unroll
        for (int g = 0; g < 4; ++g) { u32x2_t pk; pk.x = cvtpk(o[b][4 * g + 0] * inv, o[b][4 * g + 1] * inv); pk.y = cvtpk(o[b][4 * g + 2] * inv, o[b][4 * g + 3] * inv);
            *(u32x2_t*)(orow + 32 * b + 8 * g + 4 * h) = pk; }
}
struct SrcMlaP { const bf16_t* kn; const bf16_t* kpe; const bf16_t* vt; const bf16_t* qraw; const bf16_t* qpe; int b, hh; size_t row0;
    DI bf16x8 qfrag(int r, int s_, int h8) const { return s_ < 8 ? *(const bf16x8*)(qraw + (row0 + r) * 1536 + hh * DQH + 16 * s_ + 8 * h8) : *(const bf16x8*)(qpe + (row0 + r) * 512 + hh * DROPE + 16 * (s_ - 8) + 8 * h8); }
    DI u32x4_t kpiece(int key, int d8) const { const size_t row = (size_t)b * SEQ + key;
        return d8 < 16 ? *(const u32x4_t*)(kn + row * 1024 + hh * DNOPE + d8 * 8) : *(const u32x4_t*)(kpe + row * DROPE + (d8 - 16) * 8); }
    DI u32x4_t vpiece(int dv, int key0) const { return *(const u32x4_t*)(vt + (size_t)(hh * DVH + dv) * NP + (size_t)b * SEQ + key0); } };
struct SrcMemP { const bf16_t* mk; const bf16_t* mvt; const bf16_t* xq; int b, hh; size_t row0;
    DI bf16x8 qfrag(int r, int s_, int h8) const { return *(const bf16x8*)(xq + (row0 + r) * ZLD + hh * XHD + 16 * s_ + 8 * h8); }
    DI u32x4_t kpiece(int key, int d8) const { return *(const u32x4_t*)(mk + ((size_t)b * NMEM + key) * 256 + hh * XHD + d8 * 8); }
    DI u32x4_t vpiece(int dv, int key0) const { return *(const u32x4_t*)(mvt + (size_t)(hh * XHD + dv) * (NB * NMEM) + (size_t)b * NMEM + key0); } };


DI void ret_chunk_state(const bf16_t* __restrict__ RVT, const bf16_t* __restrict__ RKtT, float* __restrict__ UT, int b, int h, int c) {
    const int tid = threadIdx.x, lane = tid & 63, w = __builtin_amdgcn_readfirstlane(tid >> 6), l31 = lane & 31, hh = lane >> 5;
    const size_t tok0 = (size_t)b * SEQ + c * 128;
    f32x16 acc[4];
#pragma unroll
    for (int kb = 0; kb < 4; ++kb)
#pragma unroll
        for (int i = 0; i < 16; ++i) acc[kb][i] = 0.f;
    const bf16_t* ap = RVT + (size_t)(h * RDV + 32 * w + l31) * NT + tok0 + 8 * hh;
    const bf16_t* bp = RKtT + (size_t)(h * RDK + l31) * NP + tok0 + 8 * hh;
#pragma unroll
    for (int s_ = 0; s_ < 8; ++s_) { const bf16x8 a = *(const bf16x8*)(ap + 16 * s_);
#pragma unroll
        for (int kb = 0; kb < 4; ++kb) { const bf16x8 bfr = *(const bf16x8*)(bp + (size_t)(32 * kb) * NP + 16 * s_); acc[kb] = MFMA32(a, bfr, acc[kb]); } }
    float* u = UT + (size_t)(((b * RH + h) * 16) + c) * 32768;
#pragma unroll
    for (int kb = 0; kb < 4; ++kb)
#pragma unroll
        for (int i = 0; i < 16; ++i) u[(32 * w + crow(i, hh)) * RDK + 32 * kb + l31] = acc[kb][i];
}
DI void ret_chunk_out(const bf16_t* __restrict__ RQt, const bf16_t* __restrict__ RKt, const bf16_t* __restrict__ RVT, const bf16_t* __restrict__ SPT, float* __restrict__ ORET, int b, int h, int c) {
    const int tid = threadIdx.x, lane = tid & 63, w = __builtin_amdgcn_readfirstlane(tid >> 6), l31 = lane & 31, hh = lane >> 5;
    const int ib = w & 3, vh = w >> 2;
    const size_t tok0 = (size_t)b * SEQ + c * 128;
    bf16x8 qf[8];
    { const bf16_t* qp = RQt + (tok0 + 32 * ib + l31) * 512 + h * RDK + 8 * hh;
#pragma unroll
      for (int s_ = 0; s_ < 8; ++s_) qf[s_] = *(const bf16x8*)(qp + 16 * s_); }
    f32x16 o[4];
#pragma unroll
    for (int blk = 0; blk < 4; ++blk)
#pragma unroll
        for (int i = 0; i < 16; ++i) o[blk][i] = 0.f;
    const bf16_t* vbase = RVT + (size_t)(h * RDV + 32 * (4 * vh) + l31) * NT + tok0 + 4 * hh;
#pragma unroll 1
    for (int jb = 0; jb <= ib; ++jb) {
        f32x16 x;
#pragma unroll
        for (int i = 0; i < 16; ++i) x[i] = 0.f;
        const bf16_t* kp = RKt + (tok0 + 32 * jb + l31) * 512 + h * RDK + 8 * hh;
#pragma unroll
        for (int s_ = 0; s_ < 8; ++s_) { const bf16x8 kf = *(const bf16x8*)(kp + 16 * s_); x = MFMA32(kf, qf[s_], x); }
        if (jb == ib) {
#pragma unroll
            for (int i = 0; i < 16; ++i) x[i] = (crow(i, hh) <= l31) ? x[i] : 0.f;
        }
#pragma unroll
        for (int s2 = 0; s2 < 2; ++s2) {
            u32x4_t pk; pk.x = cvtpk(x[8 * s2 + 0], x[8 * s2 + 1]); pk.y = cvtpk(x[8 * s2 + 2], x[8 * s2 + 3]); pk.z = cvtpk(x[8 * s2 + 4], x[8 * s2 + 5]); pk.w = cvtpk(x[8 * s2 + 6], x[8 * s2 + 7]);
            const bf16x8 pa = __builtin_bit_cast(bf16x8, pk);
#pragma unroll
            for (int blk = 0; blk < 4; ++blk) { const bf16_t* vp = vbase + (size_t)(32 * blk) * NT + 32 * jb + 16 * s2;
                const s16x4 lo = *(const s16x4*)vp, hi = *(const s16x4*)(vp + 8);
                const bf16x8 vf = __builtin_shufflevector(lo, hi, 0, 1, 2, 3, 4, 5, 6, 7);
                o[blk] = MFMA32(pa, vf, o[blk]); }
        }
    }
    const bf16_t* sp = SPT + (size_t)(((b * RH + h) * 16) + c) * 32768 + (size_t)(32 * (4 * vh) + l31) * RDK + 8 * hh;
#pragma unroll
    for (int s_ = 0; s_ < 8; ++s_)
#pragma unroll
        for (int blk = 0; blk < 4; ++blk) { const bf16x8 sf = *(const bf16x8*)(sp + (size_t)(32 * blk) * RDK + 16 * s_); o[blk] = MFMA32(qf[s_], sf, o[blk]); }
#pragma unroll
    for (int blk = 0; blk < 4; ++blk)
#pragma unroll
        for (int i = 0; i < 16; ++i) ORET[(tok0 + 32 * ib + crow(i, hh)) * 1024 + h * RDV + 32 * (4 * vh + blk) + l31] = o[blk][i];
}


typedef short v4i16_t __attribute__((ext_vector_type(4)));
DI s16x4 vtr(const LAS unsigned char* p) { return __builtin_bit_cast(s16x4, __builtin_amdgcn_ds_read_tr16_b64_v4i16((LAS v4i16_t*)p)); }
constexpr int MS_NSPLIT = 2, MS_KEYS = PAST / MS_NSPLIT, MS_TILES = MS_KEYS / 64;
DI void mla_sample_unit(LAS unsigned char* lds, const float* __restrict__ cckv, const float* __restrict__ ckpe, const int* __restrict__ pt,
                        const bf16_t* __restrict__ QLATb, const bf16_t* __restrict__ QPEb, float* __restrict__ PO, float* __restrict__ PML, int b, int split, float c2) {
    constexpr int KP = 328, KBYTES = 64 * KP * 2, SP = 68;
    LAS float* Sc = (LAS float*)(lds + 2 * KBYTES);
    const int tid = threadIdx.x, lane = tid & 63, w = __builtin_amdgcn_readfirstlane(tid >> 6), l31 = lane & 31, hh = lane >> 5, l15 = lane & 15, g4 = lane >> 4;
    const int kg = w >> 1, qg = w & 1;
    bf16x8 qf[10];
    { const int qi = 16 * qg + l15, t = qi >> 3, head = qi & 7;
      const bf16_t* ql = QLATb + (size_t)(b * DS + t) * 2048 + head * KVL + 8 * g4;
      const bf16_t* qp = QPEb + (size_t)(NP + b * DS + t) * 512 + head * DROPE + 8 * g4;
#pragma unroll
      for (int s_ = 0; s_ < 8; ++s_) qf[s_] = *(const bf16x8*)(ql + 32 * s_);
#pragma unroll
      for (int s_ = 0; s_ < 2; ++s_) qf[8 + s_] = *(const bf16x8*)(qp + 32 * s_); }
    f32x16 o;
#pragma unroll
    for (int i = 0; i < 16; ++i) o[i] = 0.f;
    float m = -INFINITY, lsum = 0.f;
    f32x4 crA[8], prA[2], crB[8], prB[2];
    const unsigned voffc = (unsigned)(((tid >> 6) * KVL + 4 * (tid & 63)) * 4), voffp = (unsigned)(((tid >> 4) * DROPE + 4 * (tid & 15)) * 4);
#define MS_LOAD(t_, CR_, PR_) do { const int key0_ = split * MS_KEYS + 64 * (t_); const int pg_ = __builtin_amdgcn_readfirstlane(pt[b * NPAGES + (key0_ >> 7)]); \
        const size_t rowb_ = (size_t)pg_ * PAGE + (key0_ & (PAGE - 1)); const char* cb_ = (const char*)(cckv + rowb_ * KVL); const char* pb_ = (const char*)(ckpe + rowb_ * DROPE); \
        _Pragma("unroll") for (int i_ = 0; i_ < 8; ++i_) CR_[i_] = __builtin_nontemporal_load((const f32x4*)(cb_ + (size_t)i_ * (8 * KVL * 4) + voffc)); \
        _Pragma("unroll") for (int i_ = 0; i_ < 2; ++i_) PR_[i_] = __builtin_nontemporal_load((const f32x4*)(pb_ + (size_t)i_ * (32 * DROPE * 4) + voffp)); } while (0)
#define MS_STORE(buf_, CR_, PR_) do { \
        _Pragma("unroll") for (int i_ = 0; i_ < 8; ++i_) { const int pc_ = tid + i_ * NTHREADS; *(LAS u32x2_t*)(lds + (buf_) * KBYTES + ((pc_ >> 6) * KP + 4 * (pc_ & 63)) * 2) = (u32x2_t){cvtpk(CR_[i_][0], CR_[i_][1]), cvtpk(CR_[i_][2], CR_[i_][3])}; } \
        _Pragma("unroll") for (int i_ = 0; i_ < 2; ++i_) { const int pc_ = tid + i_ * NTHREADS; *(LAS u32x2_t*)(lds + (buf_) * KBYTES + ((pc_ >> 4) * KP + KVL + 4 * (pc_ & 15)) * 2) = (u32x2_t){cvtpk(PR_[i_][0], PR_[i_][1]), cvtpk(PR_[i_][2], PR_[i_][3])}; } } while (0)
    __syncthreads();
    MS_LOAD(0, crA, prA); MS_LOAD(1, crB, prB); MS_STORE(0, crA, prA); MS_LOAD(2, crA, prA);
    __syncthreads();
    const int q4 = (lane & 15) >> 2, p4 = lane & 3, blk = (lane >> 4) & 1;
    auto tile = [&](const int buf) __attribute__((always_inline)) {
        const LAS unsigned char* kb_ = lds + buf * KBYTES;
        {   f32x4 s4 = {0.f, 0.f, 0.f, 0.f};
            const LAS unsigned char* kr_ = kb_ + ((16 * kg + l15) * KP + 8 * g4) * 2;
#pragma unroll
            for (int g_ = 0; g_ < 2; ++g_) { bf16x8 kf[5];
#pragma unroll
                for (int j = 0; j < 5; ++j) kf[j] = *(const LAS bf16x8*)(kr_ + 64 * (5 * g_ + j));
#pragma unroll
                for (int j = 0; j < 5; ++j) s4 = __builtin_amdgcn_mfma_f32_16x16x32_bf16(kf[j], qf[5 * g_ + j], s4, 0, 0, 0); }
            *(LAS f32x4*)(Sc + (16 * qg + l15) * SP + 16 * kg + 4 * g4) = s4; }
        __syncthreads();
        f32x4 sv[8];
#pragma unroll
        for (int i = 0; i < 8; ++i) sv[i] = *(const LAS f32x4*)(Sc + l31 * SP + 8 * i + 4 * hh);
        float mx = -INFINITY;
#pragma unroll
        for (int i = 0; i < 8; ++i) mx = fmaxf(mx, fmaxf(fmaxf(sv[i][0], sv[i][1]), fmaxf(sv[i][2], sv[i][3])));
        mx = fmaxf(mx, __shfl_xor(mx, 32));
        const float mn = fmaxf(m, mx);
        if (__builtin_amdgcn_ballot_w64(mn > m) != 0ull) {
            const float alpha = __builtin_amdgcn_exp2f((m - mn) * c2);
            lsum *= alpha;
#pragma unroll
            for (int i = 0; i < 16; ++i) o[i] *= alpha;
            m = mn;
        }
        const float nmc = -mn * c2;
        float ps = 0.f;
#pragma unroll
        for (int i = 0; i < 8; ++i)
#pragma unroll
            for (int e = 0; e < 4; ++e) { const float p = __builtin_amdgcn_exp2f(__builtin_fmaf(sv[i][e], c2, nmc)); sv[i][e] = p; ps += p; }
        lsum += ps;
#pragma unroll
        for (int ks = 0; ks < 4; ++ks) { const LAS unsigned char* a_ = kb_ + ((16 * ks + 4 * hh + q4) * KP + 32 * w + 16 * blk + 4 * p4) * 2;
            const s16x4 lo = vtr(a_), hi = vtr(a_ + 8 * KP * 2);
            const bf16x8 vf = __builtin_shufflevector(lo, hi, 0, 1, 2, 3, 4, 5, 6, 7); u32x4_t pk;
            pk.x = cvtpk(sv[2 * ks][0], sv[2 * ks][1]); pk.y = cvtpk(sv[2 * ks][2], sv[2 * ks][3]);
            pk.z = cvtpk(sv[2 * ks + 1][0], sv[2 * ks + 1][1]); pk.w = cvtpk(sv[2 * ks + 1][2], sv[2 * ks + 1][3]);
            o = MFMA32(vf, __builtin_bit_cast(bf16x8, pk), o); }
    };
    static_assert(MS_TILES % 2 == 0 && MS_TILES >= 4 && 2 * KBYTES + 32 * SP * 4 <= MISC_OFF, "mla_sample_unit pipeline");
#pragma unroll 1
    for (int t = 0; t < MS_TILES; t += 2) {
        tile(0);
        MS_STORE(1, crB, prB);
        if (t + 3 < MS_TILES) MS_LOAD(t + 3, crB, prB);
        __syncthreads();
        tile(1);
        if (t + 2 < MS_TILES) { MS_STORE(0, crA, prA); }
        if (t + 4 < MS_TILES) MS_LOAD(t + 4, crA, prA);
        __syncthreads();
    }
#undef MS_LOAD
#undef MS_STORE
    lsum += __shfl_xor(lsum, 32);
    const int item = b * MS_NSPLIT + split;
    if (w == 0 && lane < 32) { PML[(item * 32 + lane) * 2] = m * c2; PML[(item * 32 + lane) * 2 + 1] = lsum; }
#pragma unroll
    for (int i = 0; i < 16; ++i) PO[((size_t)item * 32 + l31) * KVL + 32 * w + crow(i, hh)] = o[i];
}


struct RetItem { int b, h, c, vh; };
DI RetItem ret_item(int it) { RetItem r; r.vh = it & 1; r.c = (it >> 1) & 15; r.h = (it >> 5) & 3; r.b = it >> 7; return r; }
DI void ret_out_phase(LAS unsigned char* lds, const bf16_t* __restrict__ RQt, const bf16_t* __restrict__ RKt, const bf16_t* __restrict__ RVT, const bf16_t* __restrict__ SPT, float* __restrict__ ORET, int bid, int G) {
    constexpr int PITCH = 136, TILE = 128 * PITCH * 2;
    const int tid = threadIdx.x, lane = tid & 63, w = __builtin_amdgcn_readfirstlane(tid >> 6), l31 = lane & 31, hh = lane >> 5;
    const int ib = w & 3, dq = w >> 2;
    u32x4_t st[12];
#define RO_LOAD(it_) do { const RetItem q_ = ret_item(it_); const size_t tok0_ = (size_t)q_.b * SEQ + q_.c * 128; \
        _Pragma("unroll") for (int i_ = 0; i_ < 12; ++i_) { const int p_ = tid + i_ * NTHREADS, tl_ = p_ >> 11, row_ = (p_ >> 4) & 127, c16_ = p_ & 15; const bf16_t* src_; \
            if (tl_ == 0) src_ = RKt + (tok0_ + row_) * 512 + q_.h * RDK + 8 * c16_; \
            else if (tl_ == 1) src_ = RVT + (size_t)(q_.h * RDV + 128 * q_.vh + row_) * NT + tok0_ + 8 * c16_; \
            else src_ = SPT + (size_t)(((q_.b * RH + q_.h) * 16) + q_.c) * 32768 + (size_t)(128 * q_.vh + row_) * RDK + 8 * c16_; \
            st[i_] = *(const u32x4_t*)src_; } } while (0)
#define RO_STORE() do { _Pragma("unroll") for (int i_ = 0; i_ < 12; ++i_) { const int p_ = tid + i_ * NTHREADS, tl_ = p_ >> 11, row_ = (p_ >> 4) & 127, c16_ = p_ & 15; \
            *(LAS u32x4_t*)(lds + tl_ * TILE + (row_ * PITCH + 8 * c16_) * 2) = st[i_]; } } while (0)
    int it = bid;
    if (it < NB * RH * 16 * 2) RO_LOAD(it);
    for (; it < NB * RH * 16 * 2; it += G) {
        const RetItem q = ret_item(it); const size_t tok0 = (size_t)q.b * SEQ + q.c * 128;
        __syncthreads();
        RO_STORE();
        bf16x8 qf[8];
        { const bf16_t* qp = RQt + (tok0 + 32 * ib + l31) * 512 + q.h * RDK + 8 * hh;
#pragma unroll
          for (int s_ = 0; s_ < 8; ++s_) qf[s_] = *(const bf16x8*)(qp + 16 * s_); }
        __syncthreads();
        if (it + G < NB * RH * 16 * 2) RO_LOAD(it + G);
        const LAS unsigned char* Kl = lds; const LAS unsigned char* Vl = lds + TILE; const LAS unsigned char* Sl = lds + 2 * TILE;
        f32x16 o[2];
#pragma unroll
        for (int blk = 0; blk < 2; ++blk)
#pragma unroll
            for (int i = 0; i < 16; ++i) o[blk][i] = 0.f;
#pragma unroll 1
        for (int jb = 0; jb <= ib; ++jb) {
            f32x16 x;
#pragma unroll
            for (int i = 0; i < 16; ++i) x[i] = 0.f;
#pragma unroll
            for (int s_ = 0; s_ < 8; ++s_) { const bf16x8 kf = *(const LAS bf16x8*)(Kl + ((32 * jb + l31) * PITCH + 16 * s_ + 8 * hh) * 2); x = MFMA32(kf, qf[s_], x); }
            if (jb == ib) {
#pragma unroll
                for (int i = 0; i < 16; ++i) x[i] = (crow(i, hh) <= l31) ? x[i] : 0.f;
            }
#pragma unroll
            for (int s2 = 0; s2 < 2; ++s2) {
                u32x4_t pk; pk.x = cvtpk(x[8 * s2 + 0], x[8 * s2 + 1]); pk.y = cvtpk(x[8 * s2 + 2], x[8 * s2 + 3]); pk.z = cvtpk(x[8 * s2 + 4], x[8 * s2 + 5]); pk.w = cvtpk(x[8 * s2 + 6], x[8 * s2 + 7]);
                const bf16x8 pa = __builtin_bit_cast(bf16x8, pk);
#pragma unroll
                for (int blk = 0; blk < 2; ++blk) { const LAS unsigned char* vp = Vl + ((64 * dq + 32 * blk + l31) * PITCH + 32 * jb + 16 * s2 + 4 * hh) * 2;
                    const s16x4 lo = *(const LAS s16x4*)vp, hi = *(const LAS s16x4*)(vp + 16);
                    o[blk] = MFMA32(pa, __builtin_shufflevector(lo, hi, 0, 1, 2, 3, 4, 5, 6, 7), o[blk]); }
            }
        }
#pragma unroll
        for (int s_ = 0; s_ < 8; ++s_)
#pragma unroll
            for (int blk = 0; blk < 2; ++blk) { const bf16x8 sf = *(const LAS bf16x8*)(Sl + ((64 * dq + 32 * blk + l31) * PITCH + 16 * s_ + 8 * hh) * 2); o[blk] = MFMA32(qf[s_], sf, o[blk]); }
#pragma unroll
        for (int blk = 0; blk < 2; ++blk)
#pragma unroll
            for (int i = 0; i < 16; ++i) ORET[(tok0 + 32 * ib + crow(i, hh)) * 1024 + q.h * RDV + 128 * q.vh + 64 * dq + 32 * blk + l31] = o[blk][i];
    }
#undef RO_LOAD
#undef RO_STORE
}


DI void ret_state_phase(LAS unsigned char* lds, const bf16_t* __restrict__ RVT, const bf16_t* __restrict__ RKtT, float* __restrict__ UT, int bid, int G) {
    constexpr int PITCH = 136;
    const int tid = threadIdx.x, lane = tid & 63, w = __builtin_amdgcn_readfirstlane(tid >> 6), l31 = lane & 31, hh = lane >> 5;
    u32x4_t st[12];
#define RS_LOAD(it_) do { const int c_ = (it_) & 15, h_ = ((it_) >> 4) & 3, b_ = (it_) >> 6; const size_t tok0_ = (size_t)b_ * SEQ + c_ * 128; \
        _Pragma("unroll") for (int i_ = 0; i_ < 12; ++i_) { const int p_ = tid + i_ * NTHREADS, row_ = p_ >> 4, c16_ = p_ & 15; \
            const bf16_t* src_ = row_ < 256 ? RVT + (size_t)(h_ * RDV + row_) * NT + tok0_ + 8 * c16_ : RKtT + (size_t)(h_ * RDK + (row_ - 256)) * NP + tok0_ + 8 * c16_; \
            st[i_] = *(const u32x4_t*)src_; } } while (0)
    int it = bid;
    if (it < NB * RH * 16) RS_LOAD(it);
    for (; it < NB * RH * 16; it += G) {
        __syncthreads();
#pragma unroll
        for (int i = 0; i < 12; ++i) { const int p = tid + i * NTHREADS; *(LAS u32x4_t*)(lds + ((p >> 4) * PITCH + 8 * (p & 15)) * 2) = st[i]; }
        __syncthreads();
        if (it + G < NB * RH * 16) RS_LOAD(it + G);
        f32x16 acc[4];
#pragma unroll
        for (int kb = 0; kb < 4; ++kb)
#pragma unroll
            for (int i = 0; i < 16; ++i) acc[kb][i] = 0.f;
#pragma unroll
        for (int s_ = 0; s_ < 8; ++s_) { const bf16x8 a = *(const LAS bf16x8*)(lds + ((32 * w + l31) * PITCH + 16 * s_ + 8 * hh) * 2);
#pragma unroll
            for (int kb = 0; kb < 4; ++kb) { const bf16x8 b_ = *(const LAS bf16x8*)(lds + ((256 + 32 * kb + l31) * PITCH + 16 * s_ + 8 * hh) * 2); acc[kb] = MFMA32(a, b_, acc[kb]); } }
        float* u = UT + (size_t)it * 32768;
#pragma unroll
        for (int kb = 0; kb < 4; ++kb)
#pragma unroll
            for (int i = 0; i < 16; ++i) u[(32 * w + crow(i, hh)) * RDK + 32 * kb + l31] = acc[kb][i];
    }
#undef RS_LOAD
}

struct QPtr { const float* p; DI float operator()(int d) const { return p[d]; } };
struct QMla { const float* ql; const float* qp; DI float operator()(int d) const { return d < KVL ? ql[d] : qp[d - KVL]; } };
DI void rms_row(const float* x, const float* g, float* o, int n, int lane) {
    float s = 0.f;
    for (int i = lane; i < n; i += 64) { const float v = x[i]; s += v * v; }
    const float r = rsqrtf(wave_sum(s) / (float)n + EPS);
    for (int i = lane; i < n; i += 64) o[i] = x[i] * r * g[i];
}

DI void rms_row_bf16(const float* x, const float* g, bf16_t* o, int n, int lane) {
    float s = 0.f;
    for (int i = lane; i < n; i += 64) { const float v = x[i]; s += v * v; }
    const float r = rsqrtf(wave_sum(s) / (float)n + EPS);
    for (int i = lane; i < n; i += 64) o[i] = f2bf(x[i] * r * g[i]);
}
#define GEMM_PHASE(EPI, ...) pg8::gemm_phase<EPI, pg8::StaticOrder, true, true>(__VA_ARGS__)
#define GEMM_SPLIT(...) pg8::gemm_phase<pg8::EpiPart, pg8::SplitOrder, true, true>(__VA_ARGS__)
__global__ void __launch_bounds__(NTHREADS, 2) fwd_kernel(Args args) {
    extern __shared__ __attribute__((aligned(16))) unsigned char lds_raw[];
    LAS unsigned char* ldsb = (LAS unsigned char*)lds_raw;
    LAS float* lds = (LAS float*)ldsb;
    volatile LAS unsigned* MISC = (volatile LAS unsigned*)(ldsb + MISC_OFF);
    const int tid = threadIdx.x, lane = tid & 63, wave = tid >> 6;
    const int G = gridDim.x, bid = blockIdx.x;
    const int gw = bid * NWAVES + wave, NGW = G * NWAVES;
    unsigned char* ws = args.ws;
    float* out = args.out;
    const int lo = args.ph_lo, hi = args.ph_hi;

    if (tid < 64) MISC[tid] = 0u;
    __syncthreads();
    XcdBarrier bar; bar.bar = (unsigned*)(ws + WS_CTL) + CW_BAR; bar.x = 0; bar.st = MISC;
    if (hi - lo > 1) bar = xcd_barrier_post((unsigned*)(ws + WS_CTL) + CW_BAR, MISC);
#define IN(k) (lo <= (k) && (k) < hi)
#define PHASE_IDS int tid_l_ = threadIdx.x; asm volatile("" : "+v"(tid_l_)); const int tid = tid_l_, lane = tid & 63, wave = tid >> 6, gw = bid * NWAVES + wave; (void)tid; (void)lane; (void)wave; (void)gw;
#define SEAM(k) do { if (IN(k) && IN((k) + 1)) xcd_barrier(bar); } while (0)

#define x_prompt ((const float*)(args.in[0]))
#define x_sample ((const float*)(args.in[1]))
#define mem_prompt ((const float*)(args.in[2]))
#define cache_ckv ((const float*)(args.in[3]))
#define cache_kpe ((const float*)(args.in[4]))
#define page_table ((const int*)args.in[5])
#define state_ret ((const float*)(args.in[6]))
#define cache_mem_k ((const float*)(args.in[7]))
#define cache_mem_v ((const float*)(args.in[8]))
#define g_mix_pre ((const float*)(args.in[9]))
#define g_mix_post ((const float*)(args.in[10]))
#define g_ffn_pre ((const float*)(args.in[11]))
#define g_ffn_post ((const float*)(args.in[12]))
#define g_mem ((const float*)(args.in[13]))
#define g_qlat ((const float*)(args.in[14]))
#define g_kvlat ((const float*)(args.in[15]))
#define w_in ((const float*)(args.in[16]))
#define w_uq ((const float*)(args.in[17]))
#define w_uk ((const float*)(args.in[18]))
#define w_uv ((const float*)(args.in[19]))
#define w_mem_k ((const float*)(args.in[20]))
#define w_mem_v ((const float*)(args.in[21]))
#define w_ret_o ((const float*)(args.in[22]))
#define w_mla_o ((const float*)(args.in[23]))
#define w_x_o ((const float*)(args.in[24]))
#define w_out ((const float*)(args.in[25]))
#define w_gate ((const float*)(args.in[26]))
#define w_up ((const float*)(args.in[27]))
#define w_down ((const float*)(args.in[28]))
#define COSA ((float*)(ws + WS_COSA))
#define SINA ((float*)(ws + WS_SINA))
#define COSB ((float*)(ws + WS_COSB))
#define SINB ((float*)(ws + WS_SINB))
#define U ((float*)(ws + WS_U))
#define MN ((float*)(ws + WS_MN))
#define Zb ((bf16_t*)(ws + WS_Z))
#define RQ ((float*)(ws + WS_RQ))
#define RK ((float*)(ws + WS_RK))
#define CQN ((float*)(ws + WS_CQN))
#define CKVN ((float*)(ws + WS_CKVN))
#define KPER ((float*)(ws + WS_KPER))
#define Q ((float*)(ws + WS_Q))
#define QLAT ((float*)(ws + WS_QLAT))
#define QPE ((float*)(ws + WS_QPE))
#define ORET ((float*)(ws + WS_ORET))
#define OLAT ((float*)(ws + WS_OLAT))
#define OX ((float*)(ws + WS_OX))
#define OMLA ((float*)(ws + WS_OMLA))
#define ORETN ((float*)(ws + WS_ORETN))
#define ARET ((float*)(ws + WS_ARET))
#define AMLA ((float*)(ws + WS_AMLA))
#define AX ((float*)(ws + WS_AX))
#define MIX ((float*)(ws + WS_MIX))
#define HPb ((bf16_t*)(ws + WS_HP))
#define Hb ((bf16_t*)(ws + WS_H))
#define F ((float*)(ws + WS_F))
#define GU ((float*)(ws + WS_GG))
#define FOb ((bf16_t*)(ws + WS_FO))
#define WinT ((bf16_t*)(ws + WS_WIN_T))
#define WmkvT ((bf16_t*)(ws + WS_WMKV_T))
#define WuqT ((bf16_t*)(ws + WS_WUQ_T))
#define WcatT ((bf16_t*)(ws + WS_WRO_T))
#define CATb ((bf16_t*)(ws + WS_ORETNB))
#define WroT ((bf16_t*)(ws + WS_WRO_T))
#define WmoT ((bf16_t*)(ws + WS_WMO_T))
#define WxoT ((bf16_t*)(ws + WS_WXO_T))
#define WoT ((bf16_t*)(ws + WS_WO_T))
#define WguT ((bf16_t*)(ws + WS_WGU_T))
#define WdT ((bf16_t*)(ws + WS_WD_T))
#define Ub ((bf16_t*)(ws + WS_UB))
#define MNb ((bf16_t*)(ws + WS_MNB))
#define CQNb ((bf16_t*)(ws + WS_CQNB))
#define ORETNb ((bf16_t*)(ws + WS_ORETNB))
#define OMLAb ((bf16_t*)(ws + WS_OMLAB))
#define OXb ((bf16_t*)(ws + WS_OXB))
#define MIXb ((bf16_t*)(ws + WS_MIXB))
#define Fb ((bf16_t*)(ws + WS_FB))
#define ACTb ((bf16_t*)(ws + WS_ACTB))
#define WukT ((bf16_t*)(ws + WS_WUK_T))
#define WuvT ((bf16_t*)(ws + WS_WUV_T))
#define CKVNb ((bf16_t*)(ws + WS_CKVNB))
#define KPERb ((bf16_t*)(ws + WS_KPERB))
#define XQb ((bf16_t*)(ws + WS_XQB))
#define MKb ((bf16_t*)(ws + WS_MKB))
#define MVT ((bf16_t*)(ws + WS_MVT))
#define KN ((bf16_t*)(ws + WS_KN))
#define VT ((bf16_t*)(ws + WS_VT))
#define Qb ((bf16_t*)(ws + WS_QB))
#define RQt ((bf16_t*)(ws + WS_RQT))
#define RKt ((bf16_t*)(ws + WS_RKT))
#define RKtT ((bf16_t*)(ws + WS_RKTT))
#define RVT ((bf16_t*)(ws + WS_RVT))
#define UT ((float*)(ws + WS_UT))
#define SPT ((bf16_t*)(ws + WS_SPT))
#define QPEb ((bf16_t*)(ws + WS_QPEB))
#define WukB ((bf16_t*)(ws + WS_WUKB))
#define PART ((float*)(ws + WS_PART))
#define SGb ((bf16_t*)(ws + WS_SGB))
#define SRGb ((bf16_t*)(ws + WS_SRGB))
#define T0b ((bf16_t*)(ws + WS_T0B))
#define T1b ((bf16_t*)(ws + WS_T1B))
#define QLATb ((bf16_t*)(ws + WS_QLATB))
#define PO ((float*)(ws + WS_PO))
#define PML ((float*)(ws + WS_PML))
    if (IN(0)) { PHASE_IDS
        for (int i = bid * NTHREADS + tid; i < NPOS * 64 + NPOS * 32; i += G * NTHREADS) {
            const bool a = i < NPOS * 64; const int j = a ? i : i - NPOS * 64; const int half = a ? 64 : 32;
            const int p = j / half, f = j % half; const int pos = p < SEQ ? p : PAST + (p - SEQ);
            const float inv = powf(10000.0f, -(float)f / (float)half);
            const float ang = (float)pos * inv;
            double rev = (double)ang * 0.15915494309189535; rev -= floor(rev);
            const float r = (float)rev;
            const float sn = __builtin_amdgcn_sinf(r), cs = __builtin_amdgcn_cosf(r);
            if (a) { COSA[j] = cs; SINA[j] = sn; } else { COSB[j] = cs; SINB[j] = sn; }
        }
#pragma unroll 1
        for (int pass = 0; pass < 2; ++pass) {
            const int nrows = pass ? NB * NMEM : NT; const float* gsrc = pass ? g_mem : g_mix_pre; bf16_t* dst = pass ? MNb : Ub;
            f32x4 a[4];
#define P0_SRC(r_) (pass ? mem_prompt + (size_t)(r_) * DM : (r_) < NP ? x_prompt + (size_t)(r_) * DM : x_sample + (size_t)((r_) - NP) * DM)
#define P0_LOAD(r_, A_) do { const float* s_ = P0_SRC(r_); _Pragma("unroll") for (int j_ = 0; j_ < 4; ++j_) A_[j_] = *(const f32x4*)(s_ + 4 * lane + 256 * j_); } while (0)
            int row = gw;
            if (row < nrows) P0_LOAD(row, a);
#pragma unroll 1
            for (; row < nrows; row += NGW) {
                f32x4 an[4]; const int nr = row + NGW;
                if (nr < nrows) P0_LOAD(nr, an);
                float ss = 0.f;
#pragma unroll
                for (int j = 0; j < 4; ++j) ss += a[j][0] * a[j][0] + a[j][1] * a[j][1] + a[j][2] * a[j][2] + a[j][3] * a[j][3];
                const float r = rsqrtf(wave_sum(ss) * (1.f / DM) + EPS);
#pragma unroll
                for (int j = 0; j < 4; ++j) { const f32x4 v = a[j] * r * *(const f32x4*)(gsrc + 4 * lane + 256 * j); *(u32x2_t*)(dst + (size_t)row * DM + 4 * lane + 256 * j) = (u32x2_t){cvtpk(v[0], v[1]), cvtpk(v[2], v[3])}; }
#pragma unroll
                for (int j = 0; j < 4; ++j) a[j] = an[j];
            }
#undef P0_LOAD
#undef P0_SRC
        }
        {
            LAS float* scr = lds + wave * (64 * 33);
            int rot = 0;
            transpose_w(w_in, 1024, DIN, WinT, 1024, 0, scr, gw, NGW, lane, rot);
            for (int i = bid * NTHREADS + tid; i < (ZLD - DIN) * 1024 / 2; i += G * NTHREADS) ((unsigned*)(WinT + (size_t)DIN * 1024))[i] = 0u;
            for (int i = bid * NTHREADS + tid; i < MH * KVL * DNOPE / 4; i += G * NTHREADS) { const f32x4 v = *(const f32x4*)(w_uk + 4 * (size_t)i); *(u32x2_t*)(WukB + 4 * (size_t)i) = (u32x2_t){cvtpk(v[0], v[1]), cvtpk(v[2], v[3])}; }
            transpose_w(w_mem_k, 1024, 256, WmkvT, 1024, 0, scr, gw, NGW, lane, rot);
            transpose_w(w_mem_v, 1024, 256, WmkvT, 1024, 256, scr, gw, NGW, lane, rot);
            transpose_w(w_uq, QL, 1536, WuqT, QL, 0, scr, gw, NGW, lane, rot);
            transpose_w(w_ret_o, 1024, 1024, WcatT, CATLD, 0, scr, gw, NGW, lane, rot);
            transpose_w(w_mla_o, 1024, 1024, WcatT + 1024, CATLD, 0, scr, gw, NGW, lane, rot);
            transpose_w(w_x_o, 256, 1024, WcatT + 2048, CATLD, 0, scr, gw, NGW, lane, rot);
            transpose_w(w_out, 1024, 1024, WoT, 1024, 0, scr, gw, NGW, lane, rot);
            transpose_w(w_gate, 1024, DFF, WguT, 1024, 0, scr, gw, NGW, lane, rot, 2);
            transpose_w(w_up, 1024, DFF, WguT, 1024, 1, scr, gw, NGW, lane, rot, 2);
            transpose_w(w_down, DFF, 1024, WdT, DFF, 0, scr, gw, NGW, lane, rot);
            for (int hh = 0; hh < MH; ++hh) { transpose_w(w_uk + (size_t)hh * KVL * DNOPE, KVL, DNOPE, WukT, KVL, hh * DNOPE, scr, gw, NGW, lane, rot);
                                              transpose_w(w_uv + (size_t)hh * KVL * DVH, KVL, DVH, WuvT, KVL, hh * DVH, scr, gw, NGW, lane, rot); }
        }
    }
    SEAM(0);
    if (IN(1)) {
        static_assert(WS_MNB == WS_UB + (size_t)NT * 1024 * 2 && WS_WMKV_T == WS_WIN_T + (size_t)ZLD * 1024 * 2, "P1 stacks Ub|MNb and WinT|WmkvT");
        { pg8::Gemm g{Ub, WinT, NT + NB * NMEM, ZLD + 512, 1024, 1024, 1024}; pg8::P1Order S; S.init(G, bid); pg8::EpiP1 E{Zb, ZLD, out + O_MKP, out + O_MVP, SRGb, SGb, C_RG, C_G};
          pg8::gemm_phase<pg8::EpiP1, pg8::P1Order, true, true>(ldsb, g, S, E); }
        __syncthreads();
        { pg8::Gemm g{WinT + (size_t)C_RV * 1024, Ub, 1024, NP, 1024, 1024, 1024}; pg8::StaticOrder S; S.init(1024, NP, G, bid); pg8::EpiBf16S E{RVT, NT};
          GEMM_PHASE(pg8::EpiBf16S, ldsb, g, S, E); }
    }
    SEAM(1);
    if (IN(2)) { PHASE_IDS
        constexpr int KTP = 520;
        LAS bf16_t* Kt = (LAS bf16_t*)ldsb;
        const int ntile = NP / 64, nwork = ntile + (NS + 63) / 64;
        for (int wk = bid; wk < nwork; wk += G) {
            const bool prompt = wk < ntile; const int row_base = prompt ? wk * 64 : NP + (wk - ntile) * 64;
            __syncthreads();
            {
                const int hq = lane >> 4, f4 = (lane & 15) * 4;
                u32x2_t q1, q2, k1, k2, cv, p1, p2; u32x4_t cq8; f32x4 ca, sa, cb, sb; int p;
#define P2_LOAD(r_, Q1_, Q2_, K1_, K2_, CQ_, CV_, P1_, P2_, CA_, SA_, CB_, SB_, P_) do { const bf16_t* z_ = Zb + (size_t)(row_base + (r_)) * ZLD; P_ = pos_index(row_base + (r_)); \
                Q1_ = *(const u32x2_t*)(z_ + C_RQ + hq * RDK + f4); Q2_ = *(const u32x2_t*)(z_ + C_RQ + hq * RDK + 64 + f4); K1_ = *(const u32x2_t*)(z_ + C_RK + hq * RDK + f4); K2_ = *(const u32x2_t*)(z_ + C_RK + hq * RDK + 64 + f4); \
                CQ_ = (u32x4_t){0u, 0u, 0u, 0u}; if (lane < 48) CQ_ = *(const u32x4_t*)(z_ + C_CQ + 8 * lane); CV_ = *(const u32x2_t*)(z_ + C_CKV + 4 * lane); \
                P1_ = (u32x2_t){0u, 0u}; P2_ = P1_; CB_ = (f32x4){0.f, 0.f, 0.f, 0.f}; SB_ = CB_; \
                if (lane < 8) { P1_ = *(const u32x2_t*)(z_ + C_KPE + 4 * lane); P2_ = *(const u32x2_t*)(z_ + C_KPE + 32 + 4 * lane); CB_ = *(const f32x4*)(COSB + P_ * 32 + 4 * lane); SB_ = *(const f32x4*)(SINB + P_ * 32 + 4 * lane); } \
                CA_ = *(const f32x4*)(COSA + P_ * 64 + f4); SA_ = *(const f32x4*)(SINA + P_ * 64 + f4); } while (0)
#define BLO(x_) __builtin_bit_cast(float, (x_) << 16)
#define BHI(x_) __builtin_bit_cast(float, (x_) & 0xffff0000u)
                int r = wave;
                P2_LOAD(r, q1, q2, k1, k2, cq8, cv, p1, p2, ca, sa, cb, sb, p);
                for (; r < 64; r += NWAVES) {
                    u32x2_t q1n, q2n, k1n, k2n, cvn, p1n, p2n; u32x4_t cq8n; f32x4 can, san, cbn, sbn; int pn;
                    if (r + NWAVES < 64) P2_LOAD(r + NWAVES, q1n, q2n, k1n, k2n, cq8n, cvn, p1n, p2n, can, san, cbn, sbn, pn);
                    const int row = row_base + r; const int il = p & 127;
                    {
                        const float x1q[4] = {BLO(q1.x), BHI(q1.x), BLO(q1.y), BHI(q1.y)}, x2q[4] = {BLO(q2.x), BHI(q2.x), BLO(q2.y), BHI(q2.y)};
                        const float x1k[4] = {BLO(k1.x), BHI(k1.x), BLO(k1.y), BHI(k1.y)}, x2k[4] = {BLO(k2.x), BHI(k2.x), BLO(k2.y), BHI(k2.y)};
                        const float sc = 0.08838834764831845f;
                        float oq1[4], oq2[4], ok1[4], ok2[4];
#pragma unroll
                        for (int e = 0; e < 4; ++e) { oq1[e] = x1q[e] * ca[e] - x2q[e] * sa[e]; oq2[e] = x1q[e] * sa[e] + x2q[e] * ca[e];
                            ok1[e] = (x1k[e] * ca[e] - x2k[e] * sa[e]) * sc; ok2[e] = (x1k[e] * sa[e] + x2k[e] * ca[e]) * sc; }
                        if (prompt) {
                            const float fq = __expf((float)(il - 127) * lg_gamma(hq)), fk = 1.f / fq;
                            *(u32x2_t*)(RQt + (size_t)row * 512 + hq * RDK + f4) = (u32x2_t){cvtpk(oq1[0] * fq, oq1[1] * fq), cvtpk(oq1[2] * fq, oq1[3] * fq)};
                            *(u32x2_t*)(RQt + (size_t)row * 512 + hq * RDK + 64 + f4) = (u32x2_t){cvtpk(oq2[0] * fq, oq2[1] * fq), cvtpk(oq2[2] * fq, oq2[3] * fq)};
                            const u32x2_t kb1 = {cvtpk(ok1[0] * fk, ok1[1] * fk), cvtpk(ok1[2] * fk, ok1[3] * fk)}, kb2 = {cvtpk(ok2[0] * fk, ok2[1] * fk), cvtpk(ok2[2] * fk, ok2[3] * fk)};
                            *(u32x2_t*)(RKt + (size_t)row * 512 + hq * RDK + f4) = kb1; *(u32x2_t*)(RKt + (size_t)row * 512 + hq * RDK + 64 + f4) = kb2;
                            *(LAS u32x2_t*)(Kt + r * KTP + hq * RDK + f4) = kb1; *(LAS u32x2_t*)(Kt + r * KTP + hq * RDK + 64 + f4) = kb2;
                        } else {
                            *(f32x4*)(RQ + (size_t)row * 512 + hq * RDK + f4) = (f32x4){oq1[0], oq1[1], oq1[2], oq1[3]}; *(f32x4*)(RQ + (size_t)row * 512 + hq * RDK + 64 + f4) = (f32x4){oq2[0], oq2[1], oq2[2], oq2[3]};
                            *(f32x4*)(RK + (size_t)row * 512 + hq * RDK + f4) = (f32x4){ok1[0], ok1[1], ok1[2], ok1[3]}; *(f32x4*)(RK + (size_t)row * 512 + hq * RDK + 64 + f4) = (f32x4){ok2[0], ok2[1], ok2[2], ok2[3]};
                        }
                    }
                    {
                        const float c_[8] = {BLO(cq8.x), BHI(cq8.x), BLO(cq8.y), BHI(cq8.y), BLO(cq8.z), BHI(cq8.z), BLO(cq8.w), BHI(cq8.w)};
                        float ss = 0.f;
#pragma unroll
                        for (int e = 0; e < 8; ++e) ss += c_[e] * c_[e];
                        const float rr = rsqrtf(wave_sum(ss) * (1.f / QL) + EPS);
                        if (lane < 48) { const f32x4 g0 = *(const f32x4*)(g_qlat + 8 * lane), g1 = *(const f32x4*)(g_qlat + 8 * lane + 4);
                            *(u32x4_t*)(CQNb + (size_t)row * QL + 8 * lane) = (u32x4_t){cvtpk(c_[0] * rr * g0[0], c_[1] * rr * g0[1]), cvtpk(c_[2] * rr * g0[2], c_[3] * rr * g0[3]),
                                                                                     cvtpk(c_[4] * rr * g1[0], c_[5] * rr * g1[1]), cvtpk(c_[6] * rr * g1[2], c_[7] * rr * g1[3])}; }
                    }
                    {
                        const float v_[4] = {BLO(cv.x), BHI(cv.x), BLO(cv.y), BHI(cv.y)};
                        const float rr = rsqrtf(wave_sum(v_[0] * v_[0] + v_[1] * v_[1] + v_[2] * v_[2] + v_[3] * v_[3]) * (1.f / KVL) + EPS);
                        const f32x4 g0 = *(const f32x4*)(g_kvlat + 4 * lane); const f32x4 o_ = {v_[0] * rr * g0[0], v_[1] * rr * g0[1], v_[2] * rr * g0[2], v_[3] * rr * g0[3]};
                        float* ockv = row < NP ? out + O_CKVP + (size_t)row * KVL : out + O_CKVS + (size_t)(row - NP) * KVL;
                        *(f32x4*)(ockv + 4 * lane) = o_; *(f32x4*)(CKVN + (size_t)row * KVL + 4 * lane) = o_;
                        *(u32x2_t*)(CKVNb + (size_t)row * KVL + 4 * lane) = (u32x2_t){cvtpk(o_[0], o_[1]), cvtpk(o_[2], o_[3])};
                    }
                    if (lane < 8) {
                        const float x1[4] = {BLO(p1.x), BHI(p1.x), BLO(p1.y), BHI(p1.y)}, x2[4] = {BLO(p2.x), BHI(p2.x), BLO(p2.y), BHI(p2.y)};
                        f32x4 o1, o2;
#pragma unroll
                        for (int e = 0; e < 4; ++e) { o1[e] = x1[e] * cb[e] - x2[e] * sb[e]; o2[e] = x1[e] * sb[e] + x2[e] * cb[e]; }
                        *(f32x4*)(KPER + (size_t)row * DROPE + 4 * lane) = o1; *(f32x4*)(KPER + (size_t)row * DROPE + 32 + 4 * lane) = o2;
                        float* okpe = row < NP ? out + O_KPEP + (size_t)row * DROPE : out + O_KPES + (size_t)(row - NP) * DROPE;
                        *(f32x4*)(okpe + 4 * lane) = o1; *(f32x4*)(okpe + 32 + 4 * lane) = o2;
                        *(u32x2_t*)(KPERb + (size_t)row * DROPE + 4 * lane) = (u32x2_t){cvtpk(o1[0], o1[1]), cvtpk(o1[2], o1[3])}; *(u32x2_t*)(KPERb + (size_t)row * DROPE + 32 + 4 * lane) = (u32x2_t){cvtpk(o2[0], o2[1]), cvtpk(o2[2], o2[3])};
                    }
                    q1 = q1n; q2 = q2n; k1 = k1n; k2 = k2n; cq8 = cq8n; cv = cvn; p1 = p1n; p2 = p2n; ca = can; sa = san; cb = cbn; sb = sbn; p = pn;
                }
#undef P2_LOAD
            }
            __syncthreads();
            if (prompt) {
#pragma unroll 2
                for (int i = 0; i < 8; ++i) { const int pc = tid + i * NTHREADS, f = pc >> 3, k8 = pc & 7;
                    const LAS bf16_t* c = Kt + (8 * k8) * KTP + f;
                    pg8::u32x4 o; o.x = (unsigned)c[0] | ((unsigned)c[KTP] << 16); o.y = (unsigned)c[2 * KTP] | ((unsigned)c[3 * KTP] << 16);
                    o.z = (unsigned)c[4 * KTP] | ((unsigned)c[5 * KTP] << 16); o.w = (unsigned)c[6 * KTP] | ((unsigned)c[7 * KTP] << 16);
                    *(pg8::u32x4*)(RKtT + (size_t)f * NP + row_base + 8 * k8) = o; }
            }
        }
    }
    if (IN(2)) { PHASE_IDS
        for (int i = bid * NTHREADS + tid; i < NB * NMEM * 256; i += G * NTHREADS) { MKb[i] = f2bf(out[O_MKP + i]);
            const int f = i / (NB * NMEM), r = i - f * (NB * NMEM); MVT[i] = f2bf(out[O_MVP + (size_t)r * 256 + f]); }
    }
    SEAM(2);
    if (IN(3)) { pg8::Gemm g{CQNb, WuqT, NT, 1536, QL, QL, QL}; pg8::StaticOrder S; S.init(NT, 1536, G, bid); pg8::EpiBf16S E{Qb, 1536};
        GEMM_PHASE(pg8::EpiBf16S, ldsb, g, S, E);
        __syncthreads();
        { pg8::Gemm g2{CKVNb, WukT, NP, 1024, KVL, KVL, KVL}; pg8::StaticOrder S2; S2.init(NP, 1024, G, bid); pg8::EpiBf16S E2{KN, 1024}; GEMM_PHASE(pg8::EpiBf16S, ldsb, g2, S2, E2); }
        __syncthreads();
        { pg8::Gemm g3{WuvT, CKVNb, 1024, NP, KVL, KVL, KVL}; pg8::StaticOrder S3; S3.init(1024, NP, G, bid); pg8::EpiBf16S E3{VT, NP}; GEMM_PHASE(pg8::EpiBf16S, ldsb, g3, S3, E3); }
        ret_state_phase(ldsb, RVT, RKtT, UT, bid, G); }
    SEAM(3);
    if (IN(4)) { PHASE_IDS
        for (int idx = bid * NTHREADS + tid; idx < NB * RH * 8192; idx += G * NTHREADS) {
            const int bh = idx >> 13, e = (idx & 8191) * 4; const float g128 = __expf(128.f * lg_gamma(bh & 3));
            f32x4 u[16];
#pragma unroll
            for (int c = 0; c < 16; ++c) u[c] = __builtin_nontemporal_load((const f32x4*)(UT + (size_t)(bh * 16 + c) * 32768 + e));
            f32x4 sp = {0.f, 0.f, 0.f, 0.f}, S = sp;
#pragma unroll
            for (int c = 0; c < 16; ++c) { *(u32x2_t*)(SPT + (size_t)(bh * 16 + c) * 32768 + e) = (u32x2_t){cvtpk(sp[0], sp[1]), cvtpk(sp[2], sp[3])}; S = sp + u[c]; sp = S * g128; }
            const int dv = e >> 7, dk = e & 127; float* o_ = out + O_RETP + (size_t)bh * 32768 + (size_t)dk * RDV + dv;
            o_[0] = S[0]; o_[RDV] = S[1]; o_[2 * RDV] = S[2]; o_[3 * RDV] = S[3];
        }
        {
            const int hd = lane >> 3, f4 = (lane & 7) * 4;
            u32x2_t x1, x2; f32x4 cb, sb;
#define P4_LOAD(r_, X1_, X2_, C_, S_) do { const bf16_t* q_ = Qb + (size_t)(r_) * 1536 + hd * DQH + DNOPE + f4; X1_ = *(const u32x2_t*)q_; X2_ = *(const u32x2_t*)(q_ + 32); \
            const int p_ = pos_index(r_); C_ = *(const f32x4*)(COSB + p_ * 32 + f4); S_ = *(const f32x4*)(SINB + p_ * 32 + f4); } while (0)
            int row = gw;
            if (row < NT) P4_LOAD(row, x1, x2, cb, sb);
            for (; row < NT; row += NGW) {
                u32x2_t x1n, x2n; f32x4 cbn, sbn; const int nr = row + NGW;
                if (nr < NT) P4_LOAD(nr, x1n, x2n, cbn, sbn);
                const float a0 = __builtin_bit_cast(float, x1.x << 16), a1 = __builtin_bit_cast(float, x1.x & 0xffff0000u), a2 = __builtin_bit_cast(float, x1.y << 16), a3 = __builtin_bit_cast(float, x1.y & 0xffff0000u);
                const float b0 = __builtin_bit_cast(float, x2.x << 16), b1 = __builtin_bit_cast(float, x2.x & 0xffff0000u), b2 = __builtin_bit_cast(float, x2.y << 16), b3 = __builtin_bit_cast(float, x2.y & 0xffff0000u);
                bf16_t* o_ = QPEb + (size_t)row * 512 + hd * DROPE + f4;
                *(u32x2_t*)o_ = (u32x2_t){cvtpk(a0 * cb[0] - b0 * sb[0], a1 * cb[1] - b1 * sb[1]), cvtpk(a2 * cb[2] - b2 * sb[2], a3 * cb[3] - b3 * sb[3])};
                *(u32x2_t*)(o_ + 32) = (u32x2_t){cvtpk(a0 * sb[0] + b0 * cb[0], a1 * sb[1] + b1 * cb[1]), cvtpk(a2 * sb[2] + b2 * cb[2], a3 * sb[3] + b3 * cb[3])};
                x1 = x1n; x2 = x2n; cb = cbn; sb = sbn;
            }
#undef P4_LOAD
        }
        for (int wt = gw; wt < MH * 16 * 2; wt += NGW) {
            const int lh = wt & 1, rb = (wt >> 1) & 15, head = wt >> 5; const int l31 = lane & 31, h8 = lane >> 5;
            f32x16 acc[4];
#pragma unroll
            for (int k_ = 0; k_ < 4; ++k_)
#pragma unroll
                for (int i = 0; i < 16; ++i) acc[k_][i] = 0.f;
            const bf16_t* ap = Qb + ((size_t)NP + 32 * rb + l31) * 1536 + head * DQH + 8 * h8;
            const bf16_t* bp = WukB + ((size_t)head * KVL + 128 * lh + l31) * DNOPE + 8 * h8;
#pragma unroll
            for (int s_ = 0; s_ < 8; ++s_) { const bf16x8 a = *(const bf16x8*)(ap + 16 * s_);
#pragma unroll
                for (int k_ = 0; k_ < 4; ++k_) { const bf16x8 b_ = *(const bf16x8*)(bp + (size_t)(32 * k_) * DNOPE + 16 * s_); acc[k_] = MFMA32(a, b_, acc[k_]); } }
#pragma unroll
            for (int k_ = 0; k_ < 4; ++k_)
#pragma unroll
                for (int i = 0; i < 16; ++i) QLATb[(size_t)(32 * rb + crow(i, h8)) * 2048 + head * KVL + 128 * lh + 32 * k_ + l31] = f2bf(acc[k_][i]);
        }
    }
    SEAM(4);
    if (IN(5)) { PHASE_IDS
        auto compute_units = [&]() __attribute__((always_inline)) {
        if (args.sub & 2) for (int it = bid; it < NB * MH * 4; it += G) {
            const int pr = __builtin_amdgcn_readfirstlane(it & 3), hh = __builtin_amdgcn_readfirstlane((it >> 2) & 7), b = __builtin_amdgcn_readfirstlane(it >> 5);
#pragma unroll 1
            for (int half = 0; half < 2; ++half) { const int qb = __builtin_amdgcn_readfirstlane(half ? pr : 7 - pr); const size_t row0 = (size_t)b * SEQ + qb * 256;
                SrcMlaP src{KN, KPERb, VT, Qb, QPEb, b, hh, row0};
                flash_unit<192, 128, true>(ldsb, src, qb * 256, 4 * (qb + 1), CATb + row0 * CATLD + 1024 + hh * DVH, CATLD, 0.07216878364870322f * 1.4426950408889634f); }
        }
        if (args.sub & 4) ret_out_phase(ldsb, RQt, RKt, RVT, SPT, ORET, bid, G);
        if (args.sub & 16) for (int it = bid; it < NB * XH * 8; it += G) {
            const int qb = __builtin_amdgcn_readfirstlane(it & 7), hh = __builtin_amdgcn_readfirstlane((it >> 3) & 3), b = __builtin_amdgcn_readfirstlane(it >> 5); const size_t row0 = (size_t)b * SEQ + qb * 256;
            SrcMemP src{MKb, MVT, Zb + C_XQ, b, hh, row0};
            flash_unit<64, 64, false>(ldsb, src, 0, 4, CATb + row0 * CATLD + 2048 + hh * XHD, CATLD, 0.125f * 1.4426950408889634f);
        }
        };
        const bool compute_first = ((bid >> 3) & 1) != 0;
        if (compute_first) compute_units();
        if (args.sub & 1) for (int it = bid; it < DB * MS_NSPLIT; it += G) { const int split = __builtin_amdgcn_readfirstlane(it % MS_NSPLIT), b = __builtin_amdgcn_readfirstlane(it / MS_NSPLIT);
            mla_sample_unit(ldsb, cache_ckv, cache_kpe, page_table, QLATb, QPEb, PO, PML, b, split, 0.07216878364870322f * 1.4426950408889634f); }
        if (args.sub & 8) for (int it = bid; it < DB * RH; it += G) {
            const int h = it & 3, b = it >> 2; const float lg = lg_gamma(h);
            const float* s0 = state_ret + (size_t)it * RDK * RDV;
            float* so = out + O_RETS + (size_t)it * RDK * RDV;
            LAS float* inner = lds;
            LAS float* qk = lds + 16;
            LAS float* vls = lds + 1040;
            LAS float* red = lds + 2064;
            f32x4 sv[16], vv[4];
#pragma unroll
            for (int r = 0; r < 16; ++r) sv[r] = __builtin_nontemporal_load((const f32x4*)(s0 + (size_t)(wave + 8 * r) * RDV + 4 * lane));
#pragma unroll
            for (int j = 0; j < DS; ++j) { const u32x2_t t_ = *(const u32x2_t*)(Zb + ((size_t)NP + b * DS + j) * ZLD + C_RV + h * RDV + 4 * lane); vv[j] = (f32x4){BLO(t_.x), BHI(t_.x), BLO(t_.y), BHI(t_.y)}; }
            __syncthreads();
            for (int i = tid; i < 1024; i += NTHREADS) { const int which = i >> 9, ti = (i >> 7) & 3, d = i & 127; const size_t row = (size_t)NP + b * DS + ti;
                qk[i] = which ? RK[row * 512 + h * RDK + d] : RQ[row * 512 + h * RDK + d]; }
            if (wave == 0) {
#pragma unroll
                for (int j = 0; j < DS; ++j) *(LAS f32x4*)(vls + j * 256 + 4 * lane) = vv[j]; }
            __syncthreads();
            for (int pr = wave; pr < 16; pr += NWAVES) { const int i = pr >> 2, j = pr & 3;
                float s_ = qk[i * 128 + lane] * qk[512 + j * 128 + lane] + qk[i * 128 + 64 + lane] * qk[512 + j * 128 + 64 + lane];
                s_ = wave_sum(s_);
                if (lane == 0) inner[pr] = (j <= i) ? s_ * __expf((float)(i - j) * lg) : 0.f; }
            const float g4 = __expf(4.f * lg), gk0 = __expf(3.f * lg), gk1 = __expf(2.f * lg), gk2 = __expf(lg);
            f32x4 po[4];
#pragma unroll
            for (int i = 0; i < 4; ++i) po[i] = (f32x4){0.f, 0.f, 0.f, 0.f};
#pragma unroll
            for (int r = 0; r < 16; ++r) { const int d = wave + 8 * r; const f32x4 sx = sv[r];
                f32x4 a = sx * g4 + (gk0 * qk[512 + d]) * vv[0] + (gk1 * qk[512 + 128 + d]) * vv[1] + (gk2 * qk[512 + 256 + d]) * vv[2] + qk[512 + 384 + d] * vv[3];
                __builtin_nontemporal_store(a, (f32x4*)(so + (size_t)d * RDV + 4 * lane));
#pragma unroll
                for (int i = 0; i < 4; ++i) po[i] += qk[i * 128 + d] * sx; }
#pragma unroll
            for (int i = 0; i < 4; ++i) *(LAS f32x4*)(red + (wave * 4 + i) * 256 + 4 * lane) = po[i];
            __syncthreads();
            {
                const int i = tid >> 7, e2 = (tid & 127) * 2;
                float o0 = 0.f, o1 = 0.f;
#pragma unroll
                for (int w_ = 0; w_ < NWAVES; ++w_) { o0 += red[(w_ * 4 + i) * 256 + e2]; o1 += red[(w_ * 4 + i) * 256 + e2 + 1]; }
                const float gi = __expf((float)(i + 1) * lg); o0 *= gi; o1 *= gi;
#pragma unroll
                for (int j = 0; j < DS; ++j) { const float w_ = inner[i * 4 + j]; o0 += w_ * vls[j * 256 + e2]; o1 += w_ * vls[j * 256 + e2 + 1]; }
                *(f32x2_t*)(ORET + ((size_t)NP + b * DS + i) * 1024 + h * RDV + e2) = (f32x2_t){o0, o1};
            }
        }
        if (args.sub & 32) for (int b = bid; b < DB; b += G) {
            LAS float* sc = lds;
            LAS float* red = lds + 4096;
            const float* kb_ = cache_mem_k + (size_t)b * NMEM * 256; const float* vb_ = cache_mem_v + (size_t)b * NMEM * 256;
            f32x4 qr[4];
#pragma unroll
            for (int q = 0; q < DS; ++q) { const u32x2_t t_ = *(const u32x2_t*)(Zb + ((size_t)NP + b * DS + q) * ZLD + C_XQ + 4 * lane); qr[q] = (f32x4){BLO(t_.x), BHI(t_.x), BLO(t_.y), BHI(t_.y)}; }
            __syncthreads();
#pragma unroll 8
            for (int kk = 0; kk < 32; ++kk) { const int key = 32 * wave + kk; const f32x4 kv = __builtin_nontemporal_load((const f32x4*)(kb_ + (size_t)key * 256 + 4 * lane));
                float pq[4];
#pragma unroll
                for (int q = 0; q < 4; ++q) { float a = kv[0] * qr[q][0] + kv[1] * qr[q][1] + kv[2] * qr[q][2] + kv[3] * qr[q][3];
                    a += __shfl_xor(a, 1); a += __shfl_xor(a, 2); a += __shfl_xor(a, 4); a += __shfl_xor(a, 8); pq[q] = a; }
                if ((lane & 15) == 0) {
#pragma unroll
                    for (int q = 0; q < 4; ++q) sc[(q * 4 + (lane >> 4)) * 256 + key] = pq[q] * (0.125f * 1.4426950408889634f); } }
            __syncthreads();
            for (int rr = wave * 2; rr < wave * 2 + 2; ++rr) {
                f32x4 v = *(LAS f32x4*)(sc + rr * 256 + 4 * lane);
                const float mx = wave_max(fmaxf(fmaxf(v[0], v[1]), fmaxf(v[2], v[3])));
#pragma unroll
                for (int e = 0; e < 4; ++e) v[e] = __builtin_amdgcn_exp2f(v[e] - mx);
                const float inv = 1.f / wave_sum(v[0] + v[1] + v[2] + v[3]);
                *(LAS f32x4*)(sc + rr * 256 + 4 * lane) = v * inv; }
            __syncthreads();
            f32x4 acc[4];
#pragma unroll
            for (int q = 0; q < 4; ++q) acc[q] = (f32x4){0.f, 0.f, 0.f, 0.f};
#pragma unroll 8
            for (int kk = 0; kk < 32; ++kk) { const int key = 32 * wave + kk; const f32x4 vv = __builtin_nontemporal_load((const f32x4*)(vb_ + (size_t)key * 256 + 4 * lane));
#pragma unroll
                for (int q = 0; q < 4; ++q) acc[q] += sc[(q * 4 + (lane >> 4)) * 256 + key] * vv; }
#pragma unroll
            for (int q = 0; q < 4; ++q) *(LAS f32x4*)(red + (wave * 4 + q) * 256 + 4 * lane) = acc[q];
            __syncthreads();
            { const int q = tid >> 7, e2 = (tid & 127) * 2; float o0 = 0.f, o1 = 0.f;
#pragma unroll
              for (int w_ = 0; w_ < NWAVES; ++w_) { o0 += red[(w_ * 4 + q) * 256 + e2]; o1 += red[(w_ * 4 + q) * 256 + e2 + 1]; }
              *(unsigned*)(CATb + ((size_t)NP + b * DS + q) * CATLD + 2048 + e2) = cvtpk(o0, o1); }
        }
            if (!compute_first) compute_units();
    }
    SEAM(5);
    if (IN(6)) { PHASE_IDS
        for (int task = bid; task < (NS / 32) * MH; task += G) {
            const int head = task & 7, rb = task >> 3, b = 8 * rb + wave; const float c2 = 0.07216878364870322f * 1.4426950408889634f;
            constexpr int OLP = 264;
            LAS bf16_t* ol = (LAS bf16_t*)ldsb;
            __syncthreads();
            float kn[DS][5];
#pragma unroll
            for (int j = 0; j < DS; ++j) { const size_t krow = (size_t)NP + b * DS + j;
#pragma unroll
                for (int c = 0; c < 5; ++c) { const int d = lane + 64 * c; kn[j][c] = d < KVL ? CKVN[krow * KVL + d] : KPER[krow * DROPE + (d - KVL)]; } }
#pragma unroll
            for (int t = 0; t < DS; ++t) {
                const int qi = t * 8 + head; const size_t qrow = (size_t)b * DS + t;
                float qv[5];
#pragma unroll
                for (int c = 0; c < 5; ++c) { const int d = lane + 64 * c; const bf16_t raw = d < KVL ? QLATb[qrow * 2048 + head * KVL + d] : QPEb[(NP + qrow) * 512 + head * DROPE + (d - KVL)];
                    qv[c] = __builtin_bit_cast(float, (unsigned)raw << 16); }
                float sc[DS]; float M = -INFINITY;
#pragma unroll
                for (int j = 0; j < DS; ++j) { float a_ = 0.f;
#pragma unroll
                    for (int c = 0; c < 5; ++c) a_ += qv[c] * kn[j][c];
                    a_ = wave_sum(a_) * c2; sc[j] = (j <= t) ? a_ : -INFINITY; M = fmaxf(M, sc[j]); }
                float ms[MS_NSPLIT], ls[MS_NSPLIT];
#pragma unroll
                for (int sp = 0; sp < MS_NSPLIT; ++sp) { const int item = b * MS_NSPLIT + sp; ms[sp] = PML[(item * 32 + qi) * 2]; ls[sp] = PML[(item * 32 + qi) * 2 + 1]; M = fmaxf(M, ms[sp]); }
                float L = 0.f; float acc[4] = {0.f, 0.f, 0.f, 0.f};
#pragma unroll
                for (int sp = 0; sp < MS_NSPLIT; ++sp) { const int item = b * MS_NSPLIT + sp; const float wgt = __builtin_amdgcn_exp2f(ms[sp] - M); L += ls[sp] * wgt;
#pragma unroll
                    for (int c = 0; c < 4; ++c) acc[c] += wgt * PO[((size_t)item * 32 + qi) * KVL + lane + 64 * c]; }
#pragma unroll
                for (int j = 0; j < DS; ++j) { const float wgt = __builtin_amdgcn_exp2f(sc[j] - M); L += wgt;
#pragma unroll
                    for (int c = 0; c < 4; ++c) acc[c] += wgt * kn[j][c]; }
                const float inv = 1.f / L;
#pragma unroll
                for (int c = 0; c < 4; ++c) ol[(4 * wave + t) * OLP + lane + 64 * c] = f2bf(acc[c] * inv);
            }
            __syncthreads();
            if (wave < 4) {
                const int l31 = lane & 31, h8 = lane >> 5;
                f32x16 acc;
#pragma unroll
                for (int i = 0; i < 16; ++i) acc[i] = 0.f;
                const bf16_t* bp = WuvT + (size_t)(head * DVH + 32 * wave + l31) * KVL + 8 * h8;
#pragma unroll
                for (int s_ = 0; s_ < 16; ++s_) { const bf16x8 a_ = *(const LAS bf16x8*)(ol + l31 * OLP + 16 * s_ + 8 * h8); const bf16x8 b_ = *(const bf16x8*)(bp + 16 * s_); acc = MFMA32(a_, b_, acc); }
#pragma unroll
                for (int i = 0; i < 16; ++i) CATb[((size_t)NP + 32 * rb + crow(i, h8)) * CATLD + 1024 + head * DVH + 32 * wave + l31] = f2bf(acc[i]);
            }
        }
        {
            f32x4 a[4]; u32x2_t gz[4];
#define P6_LOAD(r_, A_, B_) do { _Pragma("unroll") for (int j_ = 0; j_ < 4; ++j_) { A_[j_] = *(const f32x4*)(ORET + (size_t)(r_) * 1024 + 4 * lane + 256 * j_); \
                                                                              B_[j_] = *(const u32x2_t*)(SRGb + (size_t)(r_) * 1024 + 4 * lane + 256 * j_); } } while (0)
            int row = gw;
            if (row < NT) P6_LOAD(row, a, gz);
            for (; row < NT; row += NGW) {
                f32x4 an[4]; u32x2_t gn[4]; const int nr = row + NGW;
                if (nr < NT) P6_LOAD(nr, an, gn);
#pragma unroll
                for (int j = 0; j < 4; ++j) {
                    const float ss = wave_sum(a[j][0] * a[j][0] + a[j][1] * a[j][1] + a[j][2] * a[j][2] + a[j][3] * a[j][3]);
                    const float r = rsqrtf(ss * (1.f / RDV) + EPS);
                    float o_[4];
#pragma unroll
                    for (int e = 0; e < 4; ++e) { const unsigned gw_ = e < 2 ? gz[j].x : gz[j].y; o_[e] = __builtin_bit_cast(float, (e & 1) ? (gw_ & 0xffff0000u) : (gw_ << 16)) * a[j][e] * r; }
                    *(u32x2_t*)(CATb + (size_t)row * CATLD + 4 * lane + 256 * j) = (u32x2_t){cvtpk(o_[0], o_[1]), cvtpk(o_[2], o_[3])};
                }
#pragma unroll
                for (int j = 0; j < 4; ++j) { a[j] = an[j]; gz[j] = gn[j]; }
            }
#undef P6_LOAD
        }
    }
    SEAM(6);
    if (IN(7)) {
        { pg8::StaticOrder S; S.init(NP, 1024, G, bid); pg8::Gemm g{CATb, WcatT, NP, 1024, CATLD, CATLD, CATLD}; pg8::EpiGate3 E{SGb, MIXb, 1024, 16, 32};
          pg8::gemm_phase<pg8::EpiGate3, pg8::StaticOrder, true, true>(ldsb, g, S, E); }
        __syncthreads();
        { pg8::Gemm g{CATb, WcatT, NT, 1024, 256, CATLD, CATLD, 256}; pg8::SplitOrder SS{9, bid}; pg8::EpiPart E{PART}; GEMM_SPLIT(ldsb, g, SS, E); }
    }
    SEAM(7);
    if (IN(8)) { PHASE_IDS
        for (int i = bid * NTHREADS + tid; i < NS * 256; i += G * NTHREADS) { const int r = i >> 8, c4 = (i & 255) * 4; const size_t o_ = (size_t)r * 1024 + c4;
            f32x4 mix = {0.f, 0.f, 0.f, 0.f};
#pragma unroll
            for (int br = 0; br < 3; ++br) { f32x4 a = *(const f32x4*)(PART + (size_t)(br == 2 ? 8 : 4 * br) * (512 * 1024) + o_);
                if (br < 2) {
#pragma unroll
                    for (int k_ = 1; k_ < 4; ++k_) a += *(const f32x4*)(PART + (size_t)(4 * br + k_) * (512 * 1024) + o_); }
                const u32x2_t gq = *(const u32x2_t*)(SGb + (size_t)(NP + r) * 3072 + br * 1024 + c4);
                mix[0] += a[0] * __builtin_bit_cast(float, gq.x << 16); mix[1] += a[1] * __builtin_bit_cast(float, gq.x & 0xffff0000u);
                mix[2] += a[2] * __builtin_bit_cast(float, gq.y << 16); mix[3] += a[3] * __builtin_bit_cast(float, gq.y & 0xffff0000u); }
            *(u32x2_t*)(MIXb + (size_t)(NP + r) * 1024 + c4) = (u32x2_t){cvtpk(mix[0], mix[1]), cvtpk(mix[2], mix[3])}; }
    }
    SEAM(8);
    if (IN(9)) { pg8::Gemm g{MIXb, WoT, NP, 1024, 1024, 1024, 1024}; pg8::StaticOrder S; S.init(NP, 1024, G, bid); pg8::EpiBf16S E{HPb, 1024};
        GEMM_PHASE(pg8::EpiBf16S, ldsb, g, S, E);
        __syncthreads();
        { pg8::Gemm g2{MIXb, WoT, NT, 1024, 256, 1024, 1024, 256}; pg8::SplitOrder SS{4, bid}; pg8::EpiPart E2{PART}; GEMM_SPLIT(ldsb, g2, SS, E2); } }
    SEAM(9);
    if (IN(10)) { PHASE_IDS
        f32x4 gp[4], gf[4], a[4], b[4];
#pragma unroll
        for (int j = 0; j < 4; ++j) { gp[j] = *(const f32x4*)(g_mix_post + 4 * lane + 256 * j); gf[j] = *(const f32x4*)(g_ffn_pre + 4 * lane + 256 * j); }
#define P10_LOAD(r_, A_, B_) do { const float* xr_ = (r_) < NP ? x_prompt + (size_t)(r_) * DM : x_sample + (size_t)((r_) - NP) * DM; \
        _Pragma("unroll") for (int j_ = 0; j_ < 4; ++j_) { B_[j_] = *(const f32x4*)(xr_ + 4 * lane + 256 * j_); \
            if ((r_) < NP) { const u32x2_t h_ = *(const u32x2_t*)(HPb + (size_t)(r_) * DM + 4 * lane + 256 * j_); A_[j_] = bf4_to_f32(h_.x, h_.y); } \
            else { const float* p_ = PART + (size_t)((r_) - NP) * DM + 4 * lane + 256 * j_; A_[j_] = (*(const f32x4*)p_ + *(const f32x4*)(p_ + 512 * 1024)) + (*(const f32x4*)(p_ + 2 * 512 * 1024) + *(const f32x4*)(p_ + 3 * 512 * 1024)); } } } while (0)
        int row = gw;
        if (row < NT) P10_LOAD(row, a, b);
        for (; row < NT; row += NGW) {
            f32x4 an[4], bn[4]; const int nr = row + NGW;
            if (nr < NT) P10_LOAD(nr, an, bn);
            float ss = 0.f;
#pragma unroll
            for (int j = 0; j < 4; ++j) ss += a[j][0] * a[j][0] + a[j][1] * a[j][1] + a[j][2] * a[j][2] + a[j][3] * a[j][3];
            float r = rsqrtf(wave_sum(ss) * (1.f / DM) + EPS); ss = 0.f;
#pragma unroll
            for (int j = 0; j < 4; ++j) { a[j] = b[j] + a[j] * r * gp[j]; *(u32x2_t*)(Hb + (size_t)row * DM + 4 * lane + 256 * j) = (u32x2_t){cvtpk(a[j][0], a[j][1]), cvtpk(a[j][2], a[j][3])};
                ss += a[j][0] * a[j][0] + a[j][1] * a[j][1] + a[j][2] * a[j][2] + a[j][3] * a[j][3]; }
            r = rsqrtf(wave_sum(ss) * (1.f / DM) + EPS);
#pragma unroll
            for (int j = 0; j < 4; ++j) { const f32x4 f_ = a[j] * r * gf[j]; *(u32x2_t*)(Fb + (size_t)row * DM + 4 * lane + 256 * j) = (u32x2_t){cvtpk(f_[0], f_[1]), cvtpk(f_[2], f_[3])}; }
#pragma unroll
            for (int j = 0; j < 4; ++j) { a[j] = an[j]; b[j] = bn[j]; }
        }
#undef P10_LOAD
    }
    SEAM(10);
    if (IN(11)) {
        pg8::Gemm g{Fb, WguT, NT, 2 * DFF, 1024, 1024, 1024}; pg8::StaticOrder S; S.init(NT, 2 * DFF, G, bid); pg8::EpiSwiGLU E{ACTb, DFF};
        GEMM_PHASE(pg8::EpiSwiGLU, ldsb, g, S, E);
    }
    SEAM(11);
    if (IN(13)) { pg8::Gemm g{ACTb, WdT, NP, 1024, DFF, DFF, DFF}; pg8::StaticOrder S; S.init(NP, 1024, G, bid); pg8::EpiBf16S E{FOb, 1024};
        GEMM_PHASE(pg8::EpiBf16S, ldsb, g, S, E);
        __syncthreads();
        { pg8::Gemm g2{ACTb, WdT, NT, 1024, 256, DFF, DFF, 256}; pg8::SplitOrder SS{11, bid}; pg8::EpiPart E2{PART}; GEMM_SPLIT(ldsb, g2, SS, E2); } }
    SEAM(13);
    if (IN(14)) { PHASE_IDS
        f32x4 gp[4], a[4], b[4];
#pragma unroll
        for (int j = 0; j < 4; ++j) gp[j] = *(const f32x4*)(g_ffn_post + 4 * lane + 256 * j);
#define P14_LOAD(r_, A_, B_) do { _Pragma("unroll") for (int j_ = 0; j_ < 4; ++j_) { { const u32x2_t h_ = *(const u32x2_t*)(Hb + (size_t)(r_) * DM + 4 * lane + 256 * j_); B_[j_] = bf4_to_f32(h_.x, h_.y); } \
            if ((r_) < NP) { const u32x2_t f_ = *(const u32x2_t*)(FOb + (size_t)(r_) * DM + 4 * lane + 256 * j_); A_[j_] = bf4_to_f32(f_.x, f_.y); } \
            else { const float* p_ = PART + (size_t)((r_) - NP) * DM + 4 * lane + 256 * j_; f32x4 a_ = *(const f32x4*)p_; \
                _Pragma("unroll") for (int k_ = 1; k_ < 11; ++k_) a_ += *(const f32x4*)(p_ + (size_t)k_ * 512 * 1024); A_[j_] = a_; } } } while (0)
        int row = gw;
        if (row < NT) P14_LOAD(row, a, b);
        for (; row < NT; row += NGW) {
            f32x4 an[4], bn[4]; const int nr = row + NGW;
            if (nr < NT) P14_LOAD(nr, an, bn);
            float ss = 0.f;
#pragma unroll
            for (int j = 0; j < 4; ++j) ss += a[j][0] * a[j][0] + a[j][1] * a[j][1] + a[j][2] * a[j][2] + a[j][3] * a[j][3];
            const float r = rsqrtf(wave_sum(ss) * (1.f / DM) + EPS);
            float* y = row < NP ? out + O_YP + (size_t)row * DM : out + O_YS + (size_t)(row - NP) * DM;
#pragma unroll
            for (int j = 0; j < 4; ++j) *(f32x4*)(y + 4 * lane + 256 * j) = b[j] + a[j] * r * gp[j];
#pragma unroll
            for (int j = 0; j < 4; ++j) { a[j] = an[j]; b[j] = bn[j]; }
        }
#undef P14_LOAD
    }
#undef IN
#undef SEAM
#undef PHASE_IDS
}
#undef x_prompt
#undef x_sample
#undef mem_prompt
#undef cache_ckv
#undef cache_kpe
#undef page_table
#undef state_ret
#undef cache_mem_k
#undef cache_mem_v
#undef g_mix_pre
#undef g_mix_post
#undef g_ffn_pre
#undef g_ffn_post
#undef g_mem
#undef g_qlat
#undef g_kvlat
#undef w_in
#undef w_uq
#undef w_uk
#undef w_uv
#undef w_mem_k
#undef w_mem_v
#undef w_ret_o
#undef w_mla_o
#undef w_x_o
#undef w_out
#undef w_gate
#undef w_up
#undef w_down
#undef COSA
#undef SINA
#undef COSB
#undef SINB
#undef U
#undef MN
#undef Zb
#undef RQ
#undef RK
#undef CQN
#undef CKVN
#undef KPER
#undef Q
#undef QLAT
#undef QPE
#undef ORET
#undef OLAT
#undef OX
#undef OMLA
#undef ORETN
#undef ARET
#undef AMLA
#undef AX
#undef MIX
#undef HPb
#undef Hb
#undef F
#undef GU
#undef FOb
#undef WinT
#undef WmkvT
#undef WuqT
#undef WcatT
#undef CATb
#undef WroT
#undef WmoT
#undef WxoT
#undef WoT
#undef WguT
#undef WdT
#undef Ub
#undef MNb
#undef CQNb
#undef ORETNb
#undef OMLAb
#undef OXb
#undef MIXb
#undef Fb
#undef ACTb
#undef WukT
#undef WuvT
#undef CKVNb
#undef KPERb
#undef XQb
#undef MKb
#undef MVT
#undef KN
#undef VT
#undef Qb
#undef RQt
#undef RKt
#undef RKtT
#undef RVT
#undef UT
#undef SPT
#undef QPEb
#undef WukB
#undef PART
#undef SGb
#undef SRGb
#undef T0b
#undef T1b
#undef QLATb
#undef PO
#undef PML
constexpr int N_PHASES = 15;
}

extern "C" void kernel_launch(void* const* d_in, const int* in_sizes, int n_in, void* d_out, int out_size, void* d_ws, size_t ws_size, hipStream_t stream) {
    static int grid = 0;
    if (grid == 0) {
        if (n_in != 29 || (size_t)out_size != O_END || ws_size < WS_END) { fprintf(stderr, "kernel_launch: unexpected shapes: n_in %d out %d ws %zu (need %zu)\n", n_in, out_size, ws_size, (size_t)WS_END); grid = -1; return; }
        int dev = 0, cus = 0, per_cu = 0;
        if (hipGetDevice(&dev) != hipSuccess || hipDeviceGetAttribute(&cus, hipDeviceAttributeMultiprocessorCount, dev) != hipSuccess) { grid = -1; return; }
        if (hipFuncSetAttribute((const void*)fwd_kernel, hipFuncAttributeMaxDynamicSharedMemorySize, LDS_BYTES) != hipSuccess) { fprintf(stderr, "kernel_launch: hipFuncSetAttribute failed\n"); grid = -1; return; }
        if (hipOccupancyMaxActiveBlocksPerMultiprocessor(&per_cu, (const void*)fwd_kernel, NTHREADS, LDS_BYTES) != hipSuccess || per_cu < 1) { fprintf(stderr, "kernel_launch: occupancy query says %d\n", per_cu); per_cu = 1; }
        (void)hipGetLastError();
        grid = cus;
    }
    if (grid < 0) return;
    (void)hipMemsetAsync((char*)d_ws + WS_CTL, 0, CTL_BYTES, stream);
    Args a{};
    for (int i = 0; i < 29; ++i) a.in[i] = (const float*)d_in[i];
    a.out = (float*)d_out; a.ws = (unsigned char*)d_ws;
#if MK_ONE_LAUNCH
    a.ph_lo = 0; a.ph_hi = N_PHASES; a.sub = 0xff;
    hipLaunchKernelGGL(fwd_kernel, dim3(grid), dim3(NTHREADS), LDS_BYTES, stream, a);
#if PROBE_DUP >= 0
    a.ph_lo = PROBE_DUP; a.ph_hi = PROBE_DUP + 1; a.sub = PROBE_SUB;
    hipLaunchKernelGGL(fwd_kernel, dim3(grid), dim3(NTHREADS), LDS_BYTES, stream, a);
#endif
#else
    a.sub = 0xff; for (int p = 0; p < N_PHASES; ++p) { a.ph_lo = p; a.ph_hi = p + 1; hipLaunchKernelGGL(fwd_kernel, dim3(grid), dim3(NTHREADS), LDS_BYTES, stream, a); }
#endif
}
```

```cpp
#include <hip/hip_runtime.h>
#include <cstdio>
#include <cstdint>

#ifndef PROBE_DUP
#define PROBE_DUP -1
#endif
#ifndef PROBE_SUB
#define PROBE_SUB 0xff
#endif
#ifndef MK_ONE_LAUNCH
#define MK_ONE_LAUNCH 1
#endif

#define LAS __attribute__((address_space(3)))
#define GAS __attribute__((address_space(1)))
#define DI __device__ __forceinline__
typedef float f32x4 __attribute__((ext_vector_type(4)));
typedef __bf16 bf16x2_t __attribute__((ext_vector_type(2)));
typedef float f32x2_t __attribute__((ext_vector_type(2)));
DI unsigned cvtpk(float lo, float hi) { f32x2_t v = {lo, hi}; bf16x2_t b = __builtin_convertvector(v, bf16x2_t); return __builtin_bit_cast(unsigned, b); }

namespace {
constexpr int DM = 1024, NB = 8, SEQ = 2048, NP = NB * SEQ, DB = 128, DS = 4, NS = DB * DS, NT = NP + NS;
constexpr int PAST = 8192, PAGE = 128, NPAGES = PAST / PAGE;
constexpr int RH = 4, RDK = 128, RDV = 256;
constexpr int MH = 8, QL = 384, KVL = 256, DNOPE = 128, DROPE = 64, DVH = 128, DQH = DNOPE + DROPE;
constexpr int NMEM = 256, XH = 4, XHD = 64;
constexpr int DFF = 2816, DIN = 7104, ZLD = 7168;
constexpr int C_RQ = 0, C_RK = 512, C_RV = 1024, C_RG = 2048, C_CQ = 3072, C_CKV = 3456, C_KPE = 3712, C_XQ = 3776, C_G = 4032;
constexpr float EPS = 1e-6f;
constexpr int NPOS = SEQ + DS;
constexpr int NTHREADS = 512, NWAVES = 8;
constexpr int LDS_BYTES = 147456;
constexpr int MISC_OFF = 147456 - 256;

constexpr size_t O_YP = 0, O_YS = O_YP + (size_t)NP * DM, O_CKVP = O_YS + (size_t)NS * DM, O_KPEP = O_CKVP + (size_t)NP * KVL,
                 O_CKVS = O_KPEP + (size_t)NP * DROPE, O_KPES = O_CKVS + (size_t)NS * KVL, O_RETP = O_KPES + (size_t)NS * DROPE,
                 O_RETS = O_RETP + (size_t)NB * RH * RDK * RDV, O_MKP = O_RETS + (size_t)DB * RH * RDK * RDV, O_MVP = O_MKP + (size_t)NB * NMEM * 256,
                 O_END = O_MVP + (size_t)NB * NMEM * 256;

constexpr size_t al256(size_t x) { return (x + 255) & ~(size_t)255; }
constexpr size_t WS_CTL = 0, CTL_BYTES = 1u << 20;
constexpr size_t WS_COSA = WS_CTL + CTL_BYTES;
constexpr size_t WS_SINA = WS_COSA + al256((size_t)NPOS * 64 * 4);
constexpr size_t WS_COSB = WS_SINA + al256((size_t)NPOS * 64 * 4);
constexpr size_t WS_SINB = WS_COSB + al256((size_t)NPOS * 32 * 4);
constexpr size_t WS_U = WS_SINB + al256((size_t)NPOS * 32 * 4);
constexpr size_t WS_MN = WS_U + (size_t)NT * DM * 4;
constexpr size_t WS_Z = WS_MN + (size_t)NB * NMEM * DM * 4;
constexpr size_t WS_RQ = WS_Z + (size_t)NT * ZLD * 4;
constexpr size_t WS_RK = WS_RQ + (size_t)NT * 512 * 4;
constexpr size_t WS_CQN = WS_RK + (size_t)NT * 512 * 4;
constexpr size_t WS_CKVN = WS_CQN + (size_t)NT * QL * 4;
constexpr size_t WS_KPER = WS_CKVN + (size_t)NT * KVL * 4;
constexpr size_t WS_Q = WS_KPER + (size_t)NT * DROPE * 4;
constexpr size_t WS_QLAT = WS_Q + (size_t)NT * 1536 * 4;
constexpr size_t WS_QPE = WS_QLAT + (size_t)NT * 2048 * 4;
constexpr size_t WS_ORET = WS_QPE + (size_t)NT * 512 * 4;
constexpr size_t WS_OLAT = WS_ORET + (size_t)NT * 1024 * 4;
constexpr size_t WS_OX = WS_OLAT + (size_t)NT * 2048 * 4;
constexpr size_t WS_OMLA = WS_OX + (size_t)NT * 256 * 4;
constexpr size_t WS_ORETN = WS_OMLA + (size_t)NT * 1024 * 4;
constexpr size_t WS_ARET = WS_ORETN + (size_t)NT * 1024 * 4;
constexpr size_t WS_AMLA = WS_ARET + (size_t)NT * 1024 * 4;
constexpr size_t WS_AX = WS_AMLA + (size_t)NT * 1024 * 4;
constexpr size_t WS_MIX = WS_AX + (size_t)NT * 1024 * 4;
constexpr size_t WS_HP = WS_MIX + (size_t)NT * 1024 * 4;
constexpr size_t WS_H = WS_HP + (size_t)NT * 1024 * 4;
constexpr size_t WS_F = WS_H + (size_t)NT * 1024 * 4;
constexpr size_t WS_GG = WS_F + (size_t)NT * 1024 * 4;
constexpr size_t WS_UP = WS_GG + (size_t)NT * DFF * 4;
constexpr size_t WS_ACT = WS_UP + (size_t)NT * DFF * 4;
constexpr size_t WS_FO = WS_ACT + (size_t)NT * DFF * 4;
constexpr size_t WS_F32_END = WS_FO + (size_t)NT * 1024 * 4;
constexpr size_t WS_WIN_T = al256(WS_F32_END);
constexpr size_t WS_WMKV_T = WS_WIN_T + (size_t)ZLD * 1024 * 2;
constexpr size_t WS_WUQ_T = WS_WMKV_T + (size_t)512 * 1024 * 2;
constexpr size_t WS_WRO_T = WS_WUQ_T + (size_t)1536 * 384 * 2;
constexpr size_t WS_WMO_T = WS_WRO_T + (size_t)1024 * 1024 * 2;
constexpr size_t WS_WXO_T = WS_WMO_T + (size_t)1024 * 1024 * 2;
constexpr size_t WS_WO_T = WS_WXO_T + (size_t)1024 * 256 * 2;
constexpr size_t WS_WGU_T = WS_WO_T + (size_t)1024 * 1024 * 2;
constexpr size_t WS_WD_T = WS_WGU_T + (size_t)5632 * 1024 * 2;
constexpr size_t WS_UB = WS_WD_T + (size_t)1024 * 2816 * 2;
constexpr size_t WS_MNB = WS_UB + (size_t)NT * 1024 * 2;
constexpr size_t WS_CQNB = WS_MNB + (size_t)2048 * 1024 * 2;
constexpr size_t WS_ORETNB = WS_CQNB + (size_t)NT * 384 * 2;
constexpr size_t WS_OMLAB = WS_ORETNB + (size_t)NT * 1024 * 2;
constexpr size_t WS_OXB = WS_OMLAB + (size_t)NT * 1024 * 2;
constexpr size_t WS_MIXB = WS_OXB + (size_t)NT * 256 * 2;
constexpr size_t WS_FB = WS_MIXB + (size_t)NT * 1024 * 2;
constexpr size_t WS_ACTB = WS_FB + (size_t)NT * 1024 * 2;
constexpr size_t WS_WUK_T = WS_ACTB + (size_t)NT * 2816 * 2;
constexpr size_t WS_WUV_T = WS_WUK_T + (size_t)1024 * 256 * 2;
constexpr size_t WS_CKVNB = WS_WUV_T + (size_t)1024 * 256 * 2;
constexpr size_t WS_KPERB = WS_CKVNB + (size_t)NT * 256 * 2;
constexpr size_t WS_XQB = WS_KPERB + (size_t)NT * 64 * 2;
constexpr size_t WS_MKB = WS_XQB + (size_t)NT * 256 * 2;
constexpr size_t WS_MVT = WS_MKB + (size_t)2048 * 256 * 2;
constexpr size_t WS_KN = WS_MVT + (size_t)2048 * 256 * 2;
constexpr size_t WS_VT = WS_KN + (size_t)NP * 1024 * 2;
constexpr size_t WS_QB = WS_VT + (size_t)NP * 1024 * 2;
constexpr size_t WS_RQT = WS_QB + (size_t)NT * 1536 * 2;
constexpr size_t WS_RKT = WS_RQT + (size_t)NP * 512 * 2;
constexpr size_t WS_RKTT = WS_RKT + (size_t)NP * 512 * 2;
constexpr size_t WS_RVT = WS_RKTT + (size_t)NP * 512 * 2;
constexpr size_t WS_UT = WS_RVT + (size_t)NT * 1024 * 2;
constexpr size_t WS_SPT = WS_UT + (size_t)512 * 32768 * 4;
constexpr size_t WS_QLATB = WS_SPT + (size_t)512 * 32768 * 2;
constexpr size_t WS_PO = WS_QLATB + (size_t)NS * 2048 * 2;
constexpr size_t WS_PML = WS_PO + (size_t)DB * 2 * 32 * 256 * 4;
constexpr size_t WS_PART = al256(WS_PML + (size_t)DB * 2 * 32 * 2 * 4);
constexpr size_t WS_QPEB_ = WS_PART + (size_t)11 * 512 * 1024 * 4;
constexpr size_t WS_QPEB = al256(WS_QPEB_ + 0 * WS_PML + (size_t)DB * 2 * 32 * 2 * 4);
constexpr size_t WS_SGB = WS_QPEB + (size_t)NT * 512 * 2;
constexpr size_t WS_SRGB = WS_SGB + (size_t)NT * 3072 * 2;
constexpr size_t WS_T0B = WS_SRGB + (size_t)NT * 1024 * 2;
constexpr size_t WS_T1B = WS_T0B + (size_t)NT * 1024 * 2;
constexpr size_t WS_WUKB = WS_T1B + (size_t)NT * 1024 * 2;
constexpr size_t WS_END = WS_WUKB + (size_t)8 * 256 * 128 * 2;

static_assert(WS_OMLAB == WS_ORETNB + (size_t)NT * 1024 * 2 && WS_OXB == WS_OMLAB + (size_t)NT * 1024 * 2 && WS_MIXB == WS_OXB + (size_t)NT * 256 * 2, "CATb = [o_ret_n | o_mla | o_x] rows of 2304");
static_assert(WS_WMO_T == WS_WRO_T + (size_t)1024 * 1024 * 2 && WS_WXO_T == WS_WMO_T + (size_t)1024 * 1024 * 2 && WS_WO_T == WS_WXO_T + (size_t)1024 * 256 * 2, "WcatT = [w_ret_o | w_mla_o | w_x_o]^T rows of 2304");
constexpr int CATLD = 2304;
constexpr int CW_BAR = 4096;

#define XB_TMO      128
#define XB_XCNT(j)  (256  + 64 * (j))
#define XB_XSUB(j)  (1280 + 64 * (j))
#define XB_XGEN(j)  (2304 + 64 * (j))
#define XB_TOP      3328
#define XB_TOPGEN   3392
#define XCD_BAR_WORDS 3456
#define XB_SPIN_CAP (1u << 25)

DI unsigned xb_ld(unsigned* p)              { return __hip_atomic_load(p, __ATOMIC_RELAXED, __HIP_MEMORY_SCOPE_AGENT); }
DI unsigned xb_add(unsigned* p, unsigned v) { return __hip_atomic_fetch_add(p, v, __ATOMIC_RELAXED, __HIP_MEMORY_SCOPE_AGENT); }
DI unsigned xb_xcc_id() { return (unsigned)__builtin_amdgcn_s_getreg((3 << 11) | 20) & 0xFu; }
#define XB_SPIN(cond, bar) do { unsigned _sp = 0; while (cond) { __builtin_amdgcn_s_sleep(1); \
    if ((++_sp & 255u) == 0u) { if (xb_ld(&(bar)[XB_TMO])) break; if (_sp > XB_SPIN_CAP) { atomicAdd(&(bar)[XB_TMO], 1u); break; } } } } while (0)

struct XcdBarrier { unsigned* bar; unsigned x; volatile LAS unsigned* st; };

DI XcdBarrier xcd_barrier_post(unsigned* bar, volatile LAS unsigned* st) {
    XcdBarrier b; b.bar = bar; b.x = xb_xcc_id(); b.st = st;
    if (threadIdx.x == 0) (void)xb_add(&bar[XB_XCNT(b.x)], 1u);
    return b;
}
DI void xcd_barrier_complete(unsigned* bar, unsigned x, unsigned& nloc, unsigned& nx) {
    const unsigned G = gridDim.x * gridDim.y * gridDim.z;
    unsigned sum, cnt, mine, sp = 0u;
    for (;;) {
        sum = 0u; cnt = 0u; mine = 0u;
#pragma unroll
        for (unsigned j = 0; j < 16; ++j) { const unsigned c = xb_ld(&bar[XB_XCNT(j)]); sum += c; cnt += (c > 0u) ? 1u : 0u; mine = (j == x) ? c : mine; }
        if (sum == G) break;
        __builtin_amdgcn_s_sleep(1);
        if ((++sp & 255u) == 0u) { if (xb_ld(&bar[XB_TMO])) break; if (sp > XB_SPIN_CAP) { atomicAdd(&bar[XB_TMO], 1u); break; } }
    }
    nloc = mine > 0u ? mine : 1u; nx = cnt > 0u ? cnt : 1u;
}
DI void xcd_barrier(const XcdBarrier& b) {
    asm volatile("s_waitcnt vmcnt(0)" ::: "memory");
    __syncthreads();
    if (threadIdx.x == 0) {
        unsigned* bar = b.bar;
        __builtin_amdgcn_s_waitcnt(0);
        unsigned nloc = b.st[0], nx = b.st[1];
        if (nloc == 0u) { xcd_barrier_complete(bar, b.x, nloc, nx); b.st[0] = nloc; b.st[1] = nx; }
        const unsigned old = xb_add(&bar[XB_XSUB(b.x)], 1u);
        const unsigned gen = old / nloc;
        if (old + 1u == (gen + 1u) * nloc) {
            __builtin_amdgcn_fence(__ATOMIC_RELEASE, "agent");
            asm volatile("s_waitcnt vmcnt(0)" ::: "memory");
            const unsigned og = xb_add(&bar[XB_TOP], 1u);
            const unsigned tg = og / nx;
            if (og + 1u == (tg + 1u) * nx) xb_add(&bar[XB_TOPGEN], 1u);
            else XB_SPIN(xb_ld(&bar[XB_TOPGEN]) == tg, bar);
            __builtin_amdgcn_fence(__ATOMIC_ACQUIRE, "agent");
            xb_add(&bar[XB_XGEN(b.x)], 1u);
            asm volatile("s_waitcnt vmcnt(0)" ::: "memory");
        } else {
            XB_SPIN(xb_ld(&bar[XB_XGEN(b.x)]) == gen, bar);
            __builtin_amdgcn_fence(__ATOMIC_ACQUIRE, "agent");
            asm volatile("s_waitcnt vmcnt(0)" ::: "memory");
        }
    }
    __syncthreads();
}

DI float wave_sum(float v) {
#pragma unroll
    for (int o = 1; o < 64; o <<= 1) v += __shfl_xor(v, o);
    return v;
}
DI float wave_max(float v) {
#pragma unroll
    for (int o = 1; o < 64; o <<= 1) v = fmaxf(v, __shfl_xor(v, o));
    return v;
}
DI float sigmoidf_(float x) { return 1.f / (1.f + expf(-x)); }
DI float siluf_(float x) { return x / (1.f + expf(-x)); }
DI f32x4 bf4_to_f32(unsigned lo, unsigned hi) { return (f32x4){__builtin_bit_cast(float, lo << 16), __builtin_bit_cast(float, lo & 0xffff0000u), __builtin_bit_cast(float, hi << 16), __builtin_bit_cast(float, hi & 0xffff0000u)}; }
DI int pos_index(int row) { return row < NP ? (row & (SEQ - 1)) : SEQ + ((row - NP) & (DS - 1)); }
DI float lg_gamma(int h) { return h == 0 ? -0.03174869831458027f : h == 1 ? -0.015748356968139112f : h == 2 ? -0.007843177461025892f : -0.003913899321136329f; }


namespace pg8 {
typedef unsigned short bf16_t;
typedef short bf16x8 __attribute__((ext_vector_type(8)));
typedef unsigned u32x4 __attribute__((ext_vector_type(4)));
typedef unsigned u32x2 __attribute__((ext_vector_type(2)));
constexpr int BM = 256, BK = 64, HALF = 128, HTB = HALF * BK * 2, STAGE_BYTES = 8 * HTB, NXCD = 8, WGM = 8;
__host__ __device__ __forceinline__ int lds_byte(int r, int c) { const int st = (r >> 4) * 2 + (c >> 5), rr = r & 15, cc = c & 31, ob = rr * 64 + cc * 2; return st * 1024 + (ob ^ (((ob >> 9) & 1) << 5)); }
__host__ __device__ __forceinline__ void stage_rc(int b, int& R, int& C) { const int st = b / 1024, sb = b % 1024, swz = sb ^ (((sb >> 9) & 1) << 5); R = (st >> 1) * 16 + swz / 64; C = (st & 1) * 32 + (swz % 64) / 2; }
__host__ __device__ __forceinline__ int perm32(int rho) { const int n = rho >> 4, i = rho & 15; return 8 * (i >> 2) + 4 * n + (i & 3); }
struct Unit { int pm, pn, ks; };
struct Gemm { const bf16_t* A; const bf16_t* Bt; int M, N, K, lda, ldb, ksl; };
struct StaticOrder {
    int nM, nN, nwg, G, c;
    __host__ __device__ void init(int M, int N, int G_, int c_) { nM = M / BM; nN = N / BM; nwg = nM * nN; G = G_; c = c_; }
    __host__ __device__ bool next(int i, Unit& u) const {
        const long L = (long)i * G + c; if (L >= nwg) return false;
        int wgid = (int)L; { const int q = nwg / NXCD, r = nwg % NXCD, xcd = wgid % NXCD, off = wgid / NXCD; wgid = (xcd < r ? xcd * (q + 1) : r * (q + 1) + (xcd - r) * q) + off; }
        const int nig = WGM * nN, gid = wgid / nig, fm = gid * WGM, gsz = (nM - fm) < WGM ? (nM - fm) : WGM;
        u.pm = fm + ((wgid % nig) % gsz); u.pn = (wgid % nig) / gsz; u.ks = 0; return true;
    }
    __device__ __forceinline__ void a_ready(const Unit&) const {}
    __device__ __forceinline__ void done(const Unit&) const {}
};
__device__ __forceinline__ unsigned cvt_pk_bf16(float lo, float hi) { return cvtpk(lo, hi); }
struct SplitOrder {
    int KS, c;
    __host__ __device__ bool next(int i, Unit& u) const { if (i != 0 || c >= 8 * KS) return false; const int tile = c / KS; u.ks = c % KS; u.pm = 64 + (tile >> 2); u.pn = tile & 3; return true; }
    __device__ __forceinline__ void a_ready(const Unit&) const {}
    __device__ __forceinline__ void done(const Unit&) const {}
};
struct EpiPart {
    static constexpr bool PERM = false, AFTER_DRAIN = false, HAS_MID = false;
    float* C;
    __device__ __forceinline__ void operator()(const f32x4 (&acc)[2][2][4][2], const Unit& u, int wr, int wc, int fr, int fq) const {
        const int row0 = (u.pm - 64) * BM + wr * 64 + fr, col0 = u.pn * BM + wc * 32 + 4 * fq; float* base = C + (size_t)u.ks * (512 * 1024);
#pragma unroll
        for (int ai = 0; ai < 2; ++ai)
#pragma unroll
            for (int m = 0; m < 4; ++m) { float* rowp = base + (size_t)(row0 + ai * HALF + m * 16) * 1024 + col0;
#pragma unroll
                for (int bj = 0; bj < 2; ++bj)
#pragma unroll
                    for (int n = 0; n < 2; ++n) *(f32x4*)(rowp + bj * HALF + n * 16) = acc[ai][bj][m][n]; }
    }
};
struct P1Order {
    StaticOrder so;
    __host__ __device__ void init(int G_, int c_) { so.init(64 * 256, 24 * 256, G_, c_); }
    __host__ __device__ bool next(int i, Unit& u) const {
        const long L = (long)i * so.G + so.c;
        if (L < 1536) { so.next(i, u); if (u.pn >= 4) u.pn += 4; return true; }
        u.ks = 0;
        if (L < 1536 + 56) { const int idx = (int)L - 1536; u.pm = 64 + idx / 28; u.pn = idx % 28; return true; }
        if (L < 1536 + 56 + 16) { const int idx = (int)L - 1592; u.pm = 66 + idx / 2; u.pn = 28 + idx % 2; return true; }
        return false;
    }
    __device__ __forceinline__ void a_ready(const Unit&) const {}
    __device__ __forceinline__ void done(const Unit&) const {}
};
struct EpiP1 {
    static constexpr bool PERM = true, AFTER_DRAIN = false, HAS_MID = false;
    bf16_t* Zp; int ldz; float* mk; float* mv; bf16_t* srg; bf16_t* sg; int c_rg, c_g;
    __device__ __forceinline__ void operator()(const f32x4 (&acc)[2][2][4][2], const Unit& u, int wr, int wc, int fr, int fq) const {
        if (u.pm >= 66) {
            float* base = (u.pn == 28) ? mk : mv; const int row0 = (u.pm - 66) * BM + wr * 64 + fr, col0 = wc * 32 + 8 * fq;
#pragma unroll
            for (int ai = 0; ai < 2; ++ai)
#pragma unroll
                for (int m = 0; m < 4; ++m) { float* rowp = base + (size_t)(row0 + ai * HALF + m * 16) * 256 + col0;
#pragma unroll
                    for (int bj = 0; bj < 2; ++bj) { *(f32x4*)(rowp + bj * HALF) = acc[ai][bj][m][0]; *(f32x4*)(rowp + bj * HALF + 4) = acc[ai][bj][m][1]; } }
            return;
        }
        const int row0 = u.pm * BM + wr * 64 + fr, col0 = u.pn * BM + wc * 32 + 8 * fq;
#pragma unroll
        for (int bj = 0; bj < 2; ++bj) { const int c = col0 + bj * HALF;
            if (c >= c_g + 3072) continue;
            const int kind = c >= c_g ? 2 : (c >= c_rg && c < c_rg + 1024) ? 1 : 0;
            bf16_t* dst = kind == 2 ? sg + (c - c_g) : kind == 1 ? srg + (c - c_rg) : Zp + c; const int ld = kind == 2 ? 3072 : kind == 1 ? 1024 : ldz;
#pragma unroll
            for (int ai = 0; ai < 2; ++ai)
#pragma unroll
                for (int m = 0; m < 4; ++m) { f32x4 v0 = acc[ai][bj][m][0], v1 = acc[ai][bj][m][1];
                    if (kind) {
#pragma unroll
                        for (int e = 0; e < 4; ++e) { const float s0 = 1.f / (1.f + __expf(-v0[e])), s1 = 1.f / (1.f + __expf(-v1[e])); v0[e] = kind == 2 ? s0 : v0[e] * s0; v1[e] = kind == 2 ? s1 : v1[e] * s1; } }
                    u32x4 w; w.x = cvt_pk_bf16(v0[0], v0[1]); w.y = cvt_pk_bf16(v0[2], v0[3]); w.z = cvt_pk_bf16(v1[0], v1[1]); w.w = cvt_pk_bf16(v1[2], v1[3]);
                    *(u32x4*)(dst + (size_t)(row0 + ai * HALF + m * 16) * ld) = w; } }
    }
};
struct EpiF32S {
    static constexpr bool PERM = false, AFTER_DRAIN = false, HAS_MID = false;
    float* C; int ldc; int split_tiles; size_t split_stride;
    __device__ __forceinline__ void operator()(const f32x4 (&acc)[2][2][4][2], const Unit& u, int wr, int wc, int fr, int fq) const {
        int pn = u.pn; float* base = C; if (split_tiles) { const int t = pn / split_tiles; base += (size_t)t * split_stride; pn -= t * split_tiles; }
        const int row0 = u.pm * BM + wr * 64 + fr, col0 = pn * BM + wc * 32 + 4 * fq;
#pragma unroll
        for (int ai = 0; ai < 2; ++ai)
#pragma unroll
            for (int m = 0; m < 4; ++m) { float* rowp = base + (size_t)(row0 + ai * HALF + m * 16) * ldc + col0;
#pragma unroll
                for (int bj = 0; bj < 2; ++bj)
#pragma unroll
                    for (int n = 0; n < 2; ++n) *(f32x4*)(rowp + bj * HALF + n * 16) = acc[ai][bj][m][n]; }
    }
};
struct EpiBf16S {
    static constexpr bool PERM = true, AFTER_DRAIN = false, HAS_MID = false;
    bf16_t* O; int ldc;
    __device__ __forceinline__ void operator()(const f32x4 (&acc)[2][2][4][2], const Unit& u, int wr, int wc, int fr, int fq) const {
        const int row0 = u.pm * BM + wr * 64 + fr, col0 = u.pn * BM + wc * 32 + 8 * fq;
#pragma unroll
        for (int ai = 0; ai < 2; ++ai)
#pragma unroll
            for (int m = 0; m < 4; ++m) { bf16_t* rowp = O + (size_t)(row0 + ai * HALF + m * 16) * ldc + col0;
#pragma unroll
                for (int bj = 0; bj < 2; ++bj) { const f32x4 v0 = acc[ai][bj][m][0], v1 = acc[ai][bj][m][1];
                    u32x4 w; w.x = cvt_pk_bf16(v0[0], v0[1]); w.y = cvt_pk_bf16(v0[2], v0[3]); w.z = cvt_pk_bf16(v1[0], v1[1]); w.w = cvt_pk_bf16(v1[2], v1[3]);
                    *(u32x4*)(rowp + bj * HALF) = w; } }
    }
};
struct EpiSwiGLU {
    static constexpr bool PERM = true, AFTER_DRAIN = false, HAS_MID = false;
    bf16_t* O; int ldc;
    __device__ __forceinline__ void operator()(const f32x4 (&acc)[2][2][4][2], const Unit& u, int wr, int wc, int fr, int fq) const {
        const int row0 = u.pm * BM + wr * 64 + fr, col0 = u.pn * (BM / 2) + wc * 16 + 4 * fq;
#pragma unroll
        for (int ai = 0; ai < 2; ++ai)
#pragma unroll
            for (int m = 0; m < 4; ++m) { bf16_t* rowp = O + (size_t)(row0 + ai * HALF + m * 16) * ldc + col0;
#pragma unroll
                for (int bj = 0; bj < 2; ++bj) { const f32x4 v0 = acc[ai][bj][m][0], v1 = acc[ai][bj][m][1];
                    const float a0 = v0[0] / (1.f + __expf(-v0[0])) * v0[1], a1 = v0[2] / (1.f + __expf(-v0[2])) * v0[3];
                    const float a2 = v1[0] / (1.f + __expf(-v1[0])) * v1[1], a3 = v1[2] / (1.f + __expf(-v1[2])) * v1[3];
                    u32x2 w; w.x = cvt_pk_bf16(a0, a1); w.y = cvt_pk_bf16(a2, a3);
                    *(u32x2*)(rowp + bj * (HALF / 2)) = w; } }
    }
};
template <int MODE  > struct EpiGate {
    static constexpr bool PERM = true, AFTER_DRAIN = false, HAS_MID = false;
    const bf16_t* sg; const bf16_t* tin; bf16_t* tout; int ldc;
    __device__ __forceinline__ void operator()(const f32x4 (&acc)[2][2][4][2], const Unit& u, int wr, int wc, int fr, int fq) const {
        const int row0 = u.pm * BM + wr * 64 + fr, col0 = u.pn * BM + wc * 32 + 8 * fq;
#pragma unroll
        for (int ai = 0; ai < 2; ++ai)
#pragma unroll
            for (int m = 0; m < 4; ++m) { const size_t r = (size_t)(row0 + ai * HALF + m * 16);
#pragma unroll
                for (int bj = 0; bj < 2; ++bj) { const int c = col0 + bj * HALF;
                    const u32x4 gq = *(const u32x4*)(sg + r * 3072 + c); u32x4 tq = {0u, 0u, 0u, 0u}; if (MODE >= 1) tq = *(const u32x4*)(tin + r * ldc + c);
                    const f32x4 v0 = acc[ai][bj][m][0], v1 = acc[ai][bj][m][1]; u32x4 w;
#define EG_ONE(dst, x0, x1, gw_, tw_) { float a_ = (x0) * __builtin_bit_cast(float, (gw_) << 16), b_ = (x1) * __builtin_bit_cast(float, (gw_) & 0xffff0000u); \
                        if (MODE >= 1) { a_ += __builtin_bit_cast(float, (tw_) << 16); b_ += __builtin_bit_cast(float, (tw_) & 0xffff0000u); } dst = cvt_pk_bf16(a_, b_); }
                    EG_ONE(w.x, v0[0], v0[1], gq.x, tq.x) EG_ONE(w.y, v0[2], v0[3], gq.y, tq.y) EG_ONE(w.z, v1[0], v1[1], gq.z, tq.z) EG_ONE(w.w, v1[2], v1[3], gq.w, tq.w)
#undef EG_ONE
                    *(u32x4*)(tout + r * ldc + c) = w; } }
    }
};
struct EpiGate3 {
    static constexpr bool PERM = true, AFTER_DRAIN = false, HAS_MID = true;
    const bf16_t* sg; bf16_t* out; int ldc; int t1, t2;
    __device__ __forceinline__ void mid(f32x4 (&acc)[2][2][4][2], const Unit& u, int wr, int wc, int fr, int fq, int seam) const {
        int row0 = u.pm * BM + wr * 64 + fr, col0 = u.pn * BM + wc * 32 + 8 * fq;
        asm volatile("" : "+v"(row0), "+v"(col0));
#pragma unroll
        for (int ai = 0; ai < 2; ++ai)
#pragma unroll
            for (int m = 0; m < 4; ++m) { const bf16_t* gp = sg + (size_t)(row0 + ai * HALF + m * 16) * 3072 + seam * 1024 + col0;
#pragma unroll
                for (int bj = 0; bj < 2; ++bj) { const u32x4 ga = *(const u32x4*)(gp + bj * HALF), gb = *(const u32x4*)(gp + 1024 + bj * HALF);
#define EG3_R(a_, b_, hi_) (fmaxf(__builtin_bit_cast(float, (hi_) ? ((a_) & 0xffff0000u) : ((a_) << 16)), 1e-30f) * __builtin_amdgcn_rcpf(fmaxf(__builtin_bit_cast(float, (hi_) ? ((b_) & 0xffff0000u) : ((b_) << 16)), 1e-30f)))
                    acc[ai][bj][m][0][0] *= EG3_R(ga.x, gb.x, 0); acc[ai][bj][m][0][1] *= EG3_R(ga.x, gb.x, 1); acc[ai][bj][m][0][2] *= EG3_R(ga.y, gb.y, 0); acc[ai][bj][m][0][3] *= EG3_R(ga.y, gb.y, 1);
                    acc[ai][bj][m][1][0] *= EG3_R(ga.z, gb.z, 0); acc[ai][bj][m][1][1] *= EG3_R(ga.z, gb.z, 1); acc[ai][bj][m][1][2] *= EG3_R(ga.w, gb.w, 0); acc[ai][bj][m][1][3] *= EG3_R(ga.w, gb.w, 1);
#undef EG3_R
                } }
    }
    __device__ __forceinline__ void operator()(const f32x4 (&acc)[2][2][4][2], const Unit& u, int wr, int wc, int fr, int fq) const {
        const int row0 = u.pm * BM + wr * 64 + fr, col0 = u.pn * BM + wc * 32 + 8 * fq;
#pragma unroll
        for (int ai = 0; ai < 2; ++ai)
#pragma unroll
            for (int m = 0; m < 4; ++m) { const size_t r = (size_t)(row0 + ai * HALF + m * 16);
#pragma unroll
                for (int bj = 0; bj < 2; ++bj) { const int c = col0 + bj * HALF;
                    const u32x4 gq = *(const u32x4*)(sg + r * 3072 + 2048 + c); const f32x4 v0 = acc[ai][bj][m][0], v1 = acc[ai][bj][m][1]; u32x4 w;
#define EG3_G(g_, hi_) fmaxf(__builtin_bit_cast(float, (hi_) ? ((g_) & 0xffff0000u) : ((g_) << 16)), 1e-30f)
                    w.x = cvt_pk_bf16(v0[0] * EG3_G(gq.x, 0), v0[1] * EG3_G(gq.x, 1)); w.y = cvt_pk_bf16(v0[2] * EG3_G(gq.y, 0), v0[3] * EG3_G(gq.y, 1));
                    w.z = cvt_pk_bf16(v1[0] * EG3_G(gq.z, 0), v1[1] * EG3_G(gq.z, 1)); w.w = cvt_pk_bf16(v1[2] * EG3_G(gq.w, 0), v1[3] * EG3_G(gq.w, 1));
#undef EG3_G
                    *(u32x4*)(out + r * ldc + c) = w; } }
    }
};
template <class Epi, class Sched, bool ALIGN_EPI = false, bool SP2 = false>
__device__ __forceinline__ void gemm_phase(LAS unsigned char* lds, const Gemm g, const Sched& S, const Epi& E) {
    int tid_ = threadIdx.x; asm volatile("" : "+v"(tid_));
    const int tid = tid_, wid = __builtin_amdgcn_readfirstlane(tid >> 6), lane = tid & 63, wr = wid >> 2, wc = wid & 3, fr = lane & 15, fq = lane >> 4;
    const int K = g.K, nt = K / BK;
    unsigned voffA[2], voffB[2];
#pragma unroll
    for (int i = 0; i < 2; ++i) { int R, C; stage_rc(tid * 16 + i * 8192, R, C); const int Rb = Epi::PERM ? ((R & ~31) + perm32(R & 31)) : R;
        voffA[i] = (unsigned)(R * g.lda + C) * 2u; voffB[i] = (unsigned)(Rb * g.ldb + C) * 2u; }
    const size_t kstep = (size_t)(BK * 2);
    const size_t hstepA = (size_t)HALF * g.lda * 2, hstepB = (size_t)HALF * g.ldb * 2;
    const size_t tstepA = 2 * hstepA, tstepB = 2 * hstepB;
    const unsigned ldsw = (unsigned)wid * 1024u;
    const int aoff = lds_byte(wr * 64 + fr, fq * 8), boff = lds_byte(wc * 32 + fr, fq * 8);
#define PG8_SA(b, h) (((b) * 2 + (h)) * HTB)
#define PG8_SB(b, h) ((4 + (b) * 2 + (h)) * HTB)
#define PG8_STAGE(bufoff, gbase, voff) do { _Pragma("unroll") for (int _i = 0; _i < 2; ++_i) \
        __builtin_amdgcn_global_load_lds((const unsigned*)((const char*)(gbase) + (voff)[_i]), (LAS unsigned*)(lds + (bufoff) + ldsw + _i * 8192), 16, 0, 0); } while (0)
#define PG8_LDA(dst, b, h) do { _Pragma("unroll") for (int m = 0; m < 4; ++m) _Pragma("unroll") for (int k = 0; k < 2; ++k) dst[m][k] = *(const LAS bf16x8*)(lds + PG8_SA(b, h) + aoff + m * 2048 + k * 1024); } while (0)
#define PG8_LDB(dst, b, h) do { _Pragma("unroll") for (int n = 0; n < 2; ++n) _Pragma("unroll") for (int k = 0; k < 2; ++k) dst[n][k] = *(const LAS bf16x8*)(lds + PG8_SB(b, h) + boff + n * 2048 + k * 1024); } while (0)
#define PG8_MMA(ai, bj, At, Bt) do { __builtin_amdgcn_s_setprio(1); _Pragma("unroll") for (int m = 0; m < 4; ++m) _Pragma("unroll") for (int n = 0; n < 2; ++n) _Pragma("unroll") for (int k = 0; k < 2; ++k) \
        acc[ai][bj][m][n] = __builtin_amdgcn_mfma_f32_16x16x32_bf16(Bt[n][k], At[m][k], acc[ai][bj][m][n], 0, 0, 0); __builtin_amdgcn_s_setprio(0); } while (0)
#define PG8_WAIT_V(n) asm volatile("s_waitcnt vmcnt(" #n ")" ::: "memory")
#define PG8_WAIT_L(n) asm volatile("s_waitcnt lgkmcnt(" #n ")" ::: "memory")
#define PG8_BAR __builtin_amdgcn_s_barrier()
#define PG8_SCHED __builtin_amdgcn_sched_barrier(0)
    Unit cur, nxt; int ui = 0;
    if (!S.next(0, cur)) return;
    f32x4 acc[2][2][4][2];
#pragma unroll
    for (int a = 0; a < 2; ++a)
#pragma unroll
        for (int b = 0; b < 2; ++b)
#pragma unroll
            for (int m = 0; m < 4; ++m)
#pragma unroll
                for (int n = 0; n < 2; ++n) acc[a][b][m][n] = (f32x4){0.f, 0.f, 0.f, 0.f};
    bf16x8 At[4][2], B0[2][2], B1[2][2];
    const size_t kslb = (size_t)g.ksl * 2;
    const char* cA = (const char*)g.A + (size_t)cur.pm * tstepA + cur.ks * kslb; const char* cB = (const char*)g.Bt + (size_t)cur.pn * tstepB + cur.ks * kslb;
    S.a_ready(cur);
    if constexpr (SP2) {
        PG8_STAGE(PG8_SB(0, 0), cB, voffB); PG8_STAGE(PG8_SB(0, 1), cB + hstepB, voffB); PG8_STAGE(PG8_SA(0, 0), cA, voffA); PG8_STAGE(PG8_SA(0, 1), cA + hstepA, voffA);
        if (wr == 1) PG8_BAR;
        PG8_WAIT_V(2); PG8_BAR;
        PG8_STAGE(PG8_SB(1, 0), cB + kstep, voffB); PG8_STAGE(PG8_SA(1, 0), cA + kstep, voffA); PG8_STAGE(PG8_SB(1, 1), cB + hstepB + kstep, voffB);
        PG8_WAIT_V(6); PG8_BAR;
    } else {
        PG8_STAGE(PG8_SB(0, 0), cB, voffB); PG8_STAGE(PG8_SA(0, 0), cA, voffA); PG8_STAGE(PG8_SB(0, 1), cB + hstepB, voffB); PG8_STAGE(PG8_SA(0, 1), cA + hstepA, voffA);
        if (wr == 1) PG8_BAR;
        PG8_WAIT_V(4); PG8_BAR;
        PG8_STAGE(PG8_SB(1, 0), cB + kstep, voffB); PG8_STAGE(PG8_SA(1, 0), cA + kstep, voffA); PG8_STAGE(PG8_SB(1, 1), cB + hstepB + kstep, voffB);
        PG8_WAIT_V(6); PG8_BAR;
    }
    for (;;) {
        const bool has_next = S.next(ui + 1, nxt);
        const char* nA = has_next ? (const char*)g.A + (size_t)nxt.pm * tstepA + nxt.ks * kslb : cA; const char* nB = has_next ? (const char*)g.Bt + (size_t)nxt.pn * tstepB + nxt.ks * kslb : cB;
#pragma unroll 1
        for (int t = 0; t < nt; t += 2) {
            const bool last = (t == nt - 2);
            const char* a1 = cA + (size_t)(t + 1) * kstep;
            const char* a2 = last ? nA : cA + (size_t)(t + 2) * kstep; const char* b2 = last ? nB : cB + (size_t)(t + 2) * kstep;
            const char* a3 = a2 + kstep; const char* b3 = b2 + kstep;
            if (last && has_next) S.a_ready(nxt);
            if constexpr (Epi::HAS_MID) { if (t == E.t1 || t == E.t2) E.mid(acc, cur, wr, wc, fr, fq, t == E.t1 ? 0 : 1); }
            if constexpr (SP2) {
            PG8_LDB(B0, 0, 0); PG8_LDB(B1, 0, 1); PG8_SCHED; PG8_LDA(At, 0, 0); PG8_STAGE(PG8_SA(1, 1), a1 + hstepA, voffA);
            PG8_WAIT_V(8); PG8_WAIT_L(0); PG8_BAR; PG8_MMA(0, 0, At, B0); PG8_MMA(0, 1, At, B1); PG8_BAR; PG8_SCHED;
            PG8_LDA(At, 0, 1); PG8_STAGE(PG8_SB(0, 0), b2, voffB); PG8_STAGE(PG8_SB(0, 1), b2 + hstepB, voffB); PG8_STAGE(PG8_SA(0, 0), a2, voffA);
            PG8_WAIT_V(8); PG8_WAIT_L(0); PG8_BAR; PG8_MMA(1, 0, At, B0); PG8_MMA(1, 1, At, B1); PG8_BAR; PG8_SCHED;
            PG8_LDB(B0, 1, 0); PG8_LDB(B1, 1, 1); PG8_SCHED; PG8_LDA(At, 1, 0); PG8_STAGE(PG8_SA(0, 1), a2 + hstepA, voffA);
            PG8_WAIT_V(8); PG8_WAIT_L(0); PG8_BAR; PG8_MMA(0, 0, At, B0); PG8_MMA(0, 1, At, B1); PG8_BAR; PG8_SCHED;
            PG8_LDA(At, 1, 1); PG8_STAGE(PG8_SB(1, 0), b3, voffB); PG8_STAGE(PG8_SB(1, 1), b3 + hstepB, voffB); PG8_STAGE(PG8_SA(1, 0), a3, voffA);
            PG8_WAIT_V(8); PG8_WAIT_L(0); PG8_BAR; PG8_MMA(1, 0, At, B0); PG8_MMA(1, 1, At, B1); PG8_BAR; PG8_SCHED;
            } else {
            PG8_LDB(B0, 0, 0); PG8_SCHED; PG8_LDA(At, 0, 0); PG8_STAGE(PG8_SA(1, 1), a1 + hstepA, voffA);
            PG8_WAIT_L(8); PG8_BAR; PG8_WAIT_L(0); PG8_MMA(0, 0, At, B0); PG8_BAR; PG8_SCHED;
            PG8_LDB(B1, 0, 1); PG8_STAGE(PG8_SB(0, 0), b2, voffB);
            PG8_BAR; PG8_WAIT_L(0); PG8_MMA(0, 1, At, B1); PG8_BAR;
            PG8_LDA(At, 0, 1); PG8_STAGE(PG8_SA(0, 0), a2, voffA);
            PG8_BAR; PG8_WAIT_L(0); PG8_MMA(1, 0, At, B0); PG8_BAR; PG8_SCHED;
            PG8_STAGE(PG8_SB(0, 1), b2 + hstepB, voffB);
            PG8_WAIT_V(6); PG8_BAR; PG8_MMA(1, 1, At, B1); PG8_BAR;
            PG8_LDB(B0, 1, 0); PG8_SCHED; PG8_LDA(At, 1, 0); PG8_STAGE(PG8_SA(0, 1), a2 + hstepA, voffA);
            PG8_WAIT_L(8); PG8_BAR; PG8_WAIT_L(0); PG8_MMA(0, 0, At, B0); PG8_BAR; PG8_SCHED;
            PG8_LDB(B1, 1, 1); PG8_STAGE(PG8_SB(1, 0), b3, voffB);
            PG8_BAR; PG8_WAIT_L(0); PG8_MMA(0, 1, At, B1); PG8_BAR;
            PG8_LDA(At, 1, 1); PG8_STAGE(PG8_SA(1, 0), a3, voffA);
            PG8_BAR; PG8_WAIT_L(0); PG8_MMA(1, 0, At, B0); PG8_BAR; PG8_SCHED;
            PG8_STAGE(PG8_SB(1, 1), b3 + hstepB, voffB);
            PG8_WAIT_V(6); PG8_BAR; PG8_MMA(1, 1, At, B1); PG8_BAR;
            }
        }
        if constexpr (ALIGN_EPI) { if (wr == 0) PG8_BAR; }
        if constexpr (!Epi::AFTER_DRAIN) { E(acc, cur, wr, wc, fr, fq); S.done(cur); }
        if (!has_next) break;
#pragma unroll
        for (int a = 0; a < 2; ++a)
#pragma unroll
            for (int b = 0; b < 2; ++b)
#pragma unroll
                for (int m = 0; m < 4; ++m)
#pragma unroll
                    for (int n = 0; n < 2; ++n) acc[a][b][m][n] = (f32x4){0.f, 0.f, 0.f, 0.f};
        cur = nxt; cA = nA; cB = nB; ++ui;
        if constexpr (ALIGN_EPI) { if (wr == 1) PG8_BAR; }
    }
    PG8_WAIT_V(0);
    if constexpr (!ALIGN_EPI) { if (wr == 0) PG8_BAR; }
    PG8_BAR;
    if constexpr (Epi::AFTER_DRAIN) { E.fused(acc, cur, wr, wc, fr, fq, lds, wid, lane); S.done(cur); }
#undef PG8_SA
#undef PG8_SB
#undef PG8_STAGE
#undef PG8_LDA
#undef PG8_LDB
#undef PG8_MMA
#undef PG8_WAIT_V
#undef PG8_WAIT_L
#undef PG8_BAR
#undef PG8_SCHED
}
}
typedef unsigned short bf16_t;
DI unsigned pk2(float lo, float hi) { return pg8::cvt_pk_bf16(lo, hi); }
DI bf16_t f2bf(float f) { return (bf16_t)(pg8::cvt_pk_bf16(f, 0.f) & 0xffffu); }
DI void transpose_item(const float* W, int N, bf16_t* WT, int ldt, int row_off, int rmul, LAS float* scr, int item, int lane) {
    const int nblk = N / 32, kb = item / nblk, nb = item % nblk, k0 = 64 * kb, n0 = 32 * nb;
#pragma unroll 8
    for (int i = 0; i < 32; ++i) { const int kk = 2 * i + (lane >> 5); scr[kk * 33 + (lane & 31)] = W[(size_t)(k0 + kk) * N + n0 + (lane & 31)]; }
    asm volatile("s_waitcnt lgkmcnt(0)" ::: "memory");
    const int c = lane & 7;
#pragma unroll
    for (int j = 0; j < 4; ++j) { const int n = (lane >> 3) + 8 * j; const LAS float* sp = scr + (8 * c) * 33 + n;
        pg8::u32x4 o; o.x = pk2(sp[0 * 33], sp[1 * 33]); o.y = pk2(sp[2 * 33], sp[3 * 33]); o.z = pk2(sp[4 * 33], sp[5 * 33]); o.w = pk2(sp[6 * 33], sp[7 * 33]);
        *(pg8::u32x4*)(WT + (size_t)(row_off + rmul * (n0 + n)) * ldt + k0 + 8 * c) = o; }
    asm volatile("s_waitcnt lgkmcnt(0)" ::: "memory");
}
DI void transpose_w(const float* W, int K, int N, bf16_t* WT, int ldt, int row_off, LAS float* scr, int gw, int NGW, int lane, int& rot, int rmul = 1) {
    const int nitems = (K / 64) * (N / 32);
    int first = gw - (rot % NGW); if (first < 0) first += NGW;
    for (int it = first; it < nitems; it += NGW) transpose_item(W, N, WT, ldt, row_off, rmul, scr, it, lane);
    rot += nitems;
}

struct Args {
    const float* in[29]; float* out; unsigned char* ws; int ph_lo, ph_hi, sub, pad;
};

DI unsigned short f2bf_raw(float f) { unsigned u = __builtin_bit_cast(unsigned, f); return (unsigned short)((u + 0x7fffu + ((u >> 16) & 1u)) >> 16); }
DI void sgemm_naive(LAS float* lds, const float* __restrict__ A, int lda, const float* __restrict__ B, long sbk, long sbn,
                    float* __restrict__ C, int ldc, int M, int N, int K, int bid, int G, unsigned short* Cb = nullptr) {
    LAS float* As = lds;
    LAS float* Bs = lds + 16 * 132;
    const int tid = threadIdx.x, tx = tid & 15, ty = tid >> 4;
    const int ntn = N / 64, ntiles = (M / 128) * ntn;
    for (int t = bid; t < ntiles; t += G) {
        const int m0 = (t / ntn) * 128, n0 = (t % ntn) * 64;
        float acc[4][4];
#pragma unroll
        for (int i = 0; i < 4; ++i)
#pragma unroll
            for (int j = 0; j < 4; ++j) acc[i][j] = 0.f;
        for (int k0 = 0; k0 < K; k0 += 16) {
            {
                const int r = tid >> 2, kq = (tid & 3) * 4;
                const float4 v = *(const float4*)(A + (size_t)(m0 + r) * lda + k0 + kq);
                As[(kq + 0) * 132 + r] = v.x; As[(kq + 1) * 132 + r] = v.y; As[(kq + 2) * 132 + r] = v.z; As[(kq + 3) * 132 + r] = v.w;
            }
#pragma unroll
            for (int i = 0; i < 2; ++i) {
                const int idx = tid + i * 512, kk = idx >> 6, nn = idx & 63;
                Bs[kk * 64 + nn] = B[(size_t)(k0 + kk) * sbk + (size_t)(n0 + nn) * sbn];
            }
            __syncthreads();
#pragma unroll
            for (int kk = 0; kk < 16; ++kk) {
                const f32x4 a = *(const LAS f32x4*)(As + kk * 132 + ty * 4);
                const f32x4 b = *(const LAS f32x4*)(Bs + kk * 64 + tx * 4);
                const float av[4] = {a.x, a.y, a.z, a.w}, bv[4] = {b.x, b.y, b.z, b.w};
#pragma unroll
                for (int i = 0; i < 4; ++i)
#pragma unroll
                    for (int j = 0; j < 4; ++j) acc[i][j] += av[i] * bv[j];
            }
            __syncthreads();
        }
#pragma unroll
        for (int i = 0; i < 4; ++i) {
            float4 o; o.x = acc[i][0]; o.y = acc[i][1]; o.z = acc[i][2]; o.w = acc[i][3];
            if (Cb) { unsigned short* cb = Cb + (size_t)(m0 + ty * 4 + i) * ldc + n0 + tx * 4; cb[0] = f2bf_raw(o.x); cb[1] = f2bf_raw(o.y); cb[2] = f2bf_raw(o.z); cb[3] = f2bf_raw(o.w); }
            else *(float4*)(C + (size_t)(m0 + ty * 4 + i) * ldc + n0 + tx * 4) = o;
        }
    }
}

template <int DQK, int DV, bool V_IN_K, int MODE, class KV, class QF>
DI void attn_naive(LAS float* lds, const KV& kv, int nk_loop, const QF& qf, bool active, int limit, float scale, float lg, int tq, float* optr) {
    constexpr int KS = DQK + 1;
    constexpr int VS = V_IN_K ? KS : DV;
    LAS float* Ks = lds;
    LAS float* Vs = V_IN_K ? Ks : (lds + 64 * KS);
    LAS float* qs = lds + 64 * KS + (V_IN_K ? 0 : 64 * DV);
    LAS float* ps = qs + 8 * DQK;
    static_assert((64 * KS + (V_IN_K ? 0 : 64 * DV) + 8 * DQK + 8 * 64) * 4 <= MISC_OFF, "attn_naive LDS");
    const int tid = threadIdx.x, lane = tid & 63, w = tid >> 6;
    __syncthreads();
    for (int d = lane; d < DQK; d += 64) qs[w * DQK + d] = active ? qf(d) : 0.f;
    float m = -INFINITY, l = 0.f;
    float acc[DV / 64];
#pragma unroll
    for (int c = 0; c < DV / 64; ++c) acc[c] = 0.f;
    for (int base = 0; base < nk_loop; base += 64) {
        __syncthreads();
        for (int idx = tid; idx < 64 * DQK; idx += NTHREADS) { const int j = idx / DQK, d = idx - j * DQK, key = base + j; Ks[j * KS + d] = key < nk_loop ? kv.k(key, d) : 0.f; }
        if (!V_IN_K) for (int idx = tid; idx < 64 * DV; idx += NTHREADS) { const int j = idx / DV, e = idx - j * DV, key = base + j; Vs[j * DV + e] = key < nk_loop ? kv.v(key, e) : 0.f; }
        __syncthreads();
        const int key = base + lane; const bool valid = active && key <= limit && key < nk_loop;
        float s = 0.f;
        for (int d = 0; d < DQK; ++d) s += qs[w * DQK + d] * Ks[lane * KS + d];
        float p;
        if (MODE == 0) {
            s *= scale;
            const float cm = wave_max(valid ? s : -INFINITY);
            const float mn = fmaxf(m, cm);
            const float alpha = (mn == -INFINITY) ? 1.f : expf(m - mn);
            p = valid ? expf(s - mn) : 0.f;
            l = l * alpha + wave_sum(p);
#pragma unroll
            for (int c = 0; c < DV / 64; ++c) acc[c] *= alpha;
            m = mn;
        } else {
            p = valid ? s * expf((float)(tq - key) * lg) : 0.f;
        }
        ps[w * 64 + lane] = p;
        __syncthreads();
        for (int j = 0; j < 64; ++j) { const float pj = ps[w * 64 + j];
#pragma unroll
            for (int c = 0; c < DV / 64; ++c) acc[c] += pj * Vs[j * VS + lane + 64 * c]; }
    }
    if (active) {
#pragma unroll
        for (int c = 0; c < DV / 64; ++c) optr[lane + 64 * c] = (MODE == 0) ? acc[c] / l : acc[c];
    }
}

struct KvMlaPrompt { const float* ckvn; const float* kper; int b;
    DI float k(int key, int d) const { const size_t row = (size_t)b * SEQ + key; return d < KVL ? ckvn[row * KVL + d] : kper[row * DROPE + (d - KVL)]; }
    DI float v(int, int) const { return 0.f; } };
struct KvMlaSample { const float* ckvn; const float* kper; const float* cckv; const float* ckpe; const int* pt; int b;
    DI float k(int key, int d) const {
        if (key < PAST) { const size_t r = (size_t)pt[b * NPAGES + (key >> 7)] * PAGE + (key & (PAGE - 1)); return d < KVL ? cckv[r * KVL + d] : ckpe[r * DROPE + (d - KVL)]; }
        const size_t row = (size_t)NP + b * DS + (key - PAST); return d < KVL ? ckvn[row * KVL + d] : kper[row * DROPE + (d - KVL)]; }
    DI float v(int, int) const { return 0.f; } };
struct KvRet { const float* rk; const float* z; int b, h;
    DI float k(int key, int d) const { return rk[((size_t)b * SEQ + key) * 512 + h * RDK + d]; }
    DI float v(int key, int e) const { return z[((size_t)b * SEQ + key) * ZLD + C_RV + h * RDV + e]; } };
struct KvMem { const float* mk; const float* mv; int b, h;
    DI float k(int key, int d) const { return mk[(((size_t)b * NMEM + key) * XH + h) * XHD + d]; }
    DI float v(int key, int e) const { return mv[(((size_t)b * NMEM + key) * XH + h) * XHD + e]; } };


typedef float f32x16 __attribute__((ext_vector_type(16)));
typedef short bf16x8 __attribute__((ext_vector_type(8)));
typedef short s16x4 __attribute__((ext_vector_type(4)));
typedef unsigned u32x4_t __attribute__((ext_vector_type(4)));
typedef unsigned u32x2_t __attribute__((ext_vector_type(2)));
DI int crow(int i, int h) { return (i & 3) + 8 * (i >> 2) + 4 * h; }
#define MFMA32(a, b, c) __builtin_amdgcn_mfma_f32_32x32x16_bf16((a), (b), (c), 0, 0, 0)
template <int DQK, int DV, bool CAUSAL, class Src>
DI void flash_unit(LAS unsigned char* lds, const Src& src, int qpos0, int ntiles, bf16_t* O, int ldo, float c2) {
    constexpr int KP = DQK + 8, VP = 68, KS = DQK / 16, NBLK = DV / 32;
    constexpr int KBYTES = 64 * KP * 2, VBYTES = DV * VP * 2, BUF = KBYTES + VBYTES;
    constexpr int D8 = DQK / 8, NPK = (64 * D8) / NTHREADS, NPV = (DV * 8) / NTHREADS;
    static_assert((64 * D8) % NTHREADS == 0 && (DV * 8) % NTHREADS == 0 && 2 * BUF <= 131072, "flash_unit geometry");
    const int tid = threadIdx.x, lane = tid & 63, w = __builtin_amdgcn_readfirstlane(tid >> 6), l31 = lane & 31, h = lane >> 5;
    bf16x8 qf[KS];
#pragma unroll
    for (int s_ = 0; s_ < KS; ++s_) qf[s_] = src.qfrag(32 * w + l31, s_, h);
    f32x16 o[NBLK];
#pragma unroll
    for (int b = 0; b < NBLK; ++b)
#pragma unroll
        for (int i = 0; i < 16; ++i) o[b][i] = 0.f;
    float m = -INFINITY, lsum = 0.f;
    u32x4_t kreg[NPK], vreg[NPV];
#define FL_LOAD(t_) do { _Pragma("unroll") for (int i_ = 0; i_ < NPK; ++i_) { const int p_ = tid + i_ * NTHREADS; kreg[i_] = src.kpiece(64 * (t_) + p_ / D8, p_ % D8); } \
                         _Pragma("unroll") for (int i_ = 0; i_ < NPV; ++i_) { const int p_ = tid + i_ * NTHREADS; vreg[i_] = src.vpiece(p_ >> 3, 64 * (t_) + 8 * (p_ & 7)); } } while (0)
#define FL_STORE(buf_) do { _Pragma("unroll") for (int i_ = 0; i_ < NPK; ++i_) { const int p_ = tid + i_ * NTHREADS; *(LAS u32x4_t*)(lds + (buf_) * BUF + ((p_ / D8) * KP + (p_ % D8) * 8) * 2) = kreg[i_]; } \
                          _Pragma("unroll") for (int i_ = 0; i_ < NPV; ++i_) { const int p_ = tid + i_ * NTHREADS; LAS unsigned char* a_ = lds + (buf_) * BUF + KBYTES + ((p_ >> 3) * VP + (p_ & 7) * 8) * 2; \
                              *(LAS u32x2_t*)a_ = (u32x2_t){vreg[i_].x, vreg[i_].y}; *(LAS u32x2_t*)(a_ + 8) = (u32x2_t){vreg[i_].z, vreg[i_].w}; } } while (0)
    __syncthreads();
    FL_LOAD(0); FL_STORE(0);
    __syncthreads();
    const int qmine = qpos0 + 32 * w + l31, qlast = qpos0 + 32 * w + 31;
    for (int t = 0; t < ntiles; ++t) {
        const int buf = t & 1;
        if (t + 1 < ntiles) FL_LOAD(t + 1);
        if (!CAUSAL || 64 * t <= qlast) {
            const LAS unsigned char* kb_ = lds + buf * BUF; const LAS unsigned char* vb_ = kb_ + KBYTES;
            f32x16 st[2];
#pragma unroll
            for (int kb = 0; kb < 2; ++kb) {
#pragma unroll
                for (int i = 0; i < 16; ++i) st[kb][i] = 0.f;
#pragma unroll
                for (int g_ = 0; g_ < KS / 4; ++g_) { bf16x8 kf[4];
#pragma unroll
                    for (int j = 0; j < 4; ++j) kf[j] = *(const LAS bf16x8*)(kb_ + ((32 * kb + l31) * KP + 16 * (4 * g_ + j) + 8 * h) * 2);
#pragma unroll
                    for (int j = 0; j < 4; ++j) st[kb] = MFMA32(kf[j], qf[4 * g_ + j], st[kb]);
                    __builtin_amdgcn_sched_barrier(0); }
            }
            if (CAUSAL && 64 * t + 63 > qpos0 + 32 * w) {
#pragma unroll
                for (int kb = 0; kb < 2; ++kb)
#pragma unroll
                    for (int i = 0; i < 16; ++i) { const int key = 64 * t + 32 * kb + crow(i, h); st[kb][i] = key <= qmine ? st[kb][i] : -INFINITY; }
            }
            float mx = -INFINITY;
#pragma unroll
            for (int kb = 0; kb < 2; ++kb)
#pragma unroll
                for (int i = 0; i < 16; ++i) mx = fmaxf(mx, st[kb][i]);
            mx = fmaxf(mx, __shfl_xor(mx, 32));
            const float mn = fmaxf(m, mx);
            { const float alpha = __builtin_amdgcn_exp2f((m - mn) * c2);
                lsum *= alpha;
#pragma unroll
                for (int b = 0; b < NBLK; ++b)
#pragma unroll
                    for (int i = 0; i < 16; ++i) o[b][i] *= alpha;
                m = mn;
            }
            const float nmc = -mn * c2;
            float ps = 0.f;
#pragma unroll
            for (int kb = 0; kb < 2; ++kb)
#pragma unroll
                for (int i = 0; i < 16; ++i) { const float p = __builtin_amdgcn_exp2f(__builtin_fmaf(st[kb][i], c2, nmc)); st[kb][i] = p; ps += p; }
            lsum += ps;
            bf16x8 pf[4];
#pragma unroll
            for (int ks = 0; ks < 4; ++ks) { const int kb = ks >> 1, s2 = ks & 1; u32x4_t pk;
                pk.x = cvtpk(st[kb][8 * s2 + 0], st[kb][8 * s2 + 1]); pk.y = cvtpk(st[kb][8 * s2 + 2], st[kb][8 * s2 + 3]);
                pk.z = cvtpk(st[kb][8 * s2 + 4], st[kb][8 * s2 + 5]); pk.w = cvtpk(st[kb][8 * s2 + 6], st[kb][8 * s2 + 7]); pf[ks] = __builtin_bit_cast(bf16x8, pk); }
            __builtin_amdgcn_sched_barrier(0);
#pragma unroll
            for (int b = 0; b < NBLK; ++b) { bf16x8 vf[4];
#pragma unroll
                for (int ks = 0; ks < 4; ++ks) { const LAS unsigned char* a_ = vb_ + ((32 * b + l31) * VP + 16 * ks + 4 * h) * 2;
                    const s16x4 lo = *(const LAS s16x4*)a_, hi = *(const LAS s16x4*)(a_ + 16);
                    vf[ks] = __builtin_shufflevector(lo, hi, 0, 1, 2, 3, 4, 5, 6, 7); }
#pragma unroll
                for (int ks = 0; ks < 4; ++ks) o[b] = MFMA32(vf[ks], pf[ks], o[b]);
                __builtin_amdgcn_sched_barrier(0); }
        }
        if (t + 1 < ntiles) FL_STORE(buf ^ 1);
        __syncthreads();
    }
#undef FL_LOAD
#undef FL_STORE
    lsum += __shfl_xor(lsum, 32);
    const float inv = 1.f / lsum;
    bf16_t* orow = O + (size_t)(32 * w + l31) * ldo;
#pragma unroll
    for (int b = 0; b < NBLK; ++b)
#pragma unroll
        for (int g = 0; g < 4; ++g) { u32x2_t pk; pk.x = cvtpk(o[b][4 * g + 0] * inv, o[b][4 * g + 1] * inv); pk.y = cvtpk(o[b][4 * g + 2] * inv, o[b][4 * g + 3] * inv);
            *(u32x2_t*)(orow + 32 * b + 8 * g + 4 * h) = pk; }
}
struct SrcMlaP { const bf16_t* kn; const bf16_t* kpe; const bf16_t* vt; const bf16_t* qraw; const bf16_t* qpe; int b, hh; size_t row0;
    DI bf16x8 qfrag(int r, int s_, int h8) const { return s_ < 8 ? *(const bf16x8*)(qraw + (row0 + r) * 1536 + hh * DQH + 16 * s_ + 8 * h8) : *(const bf16x8*)(qpe + (row0 + r) * 512 + hh * DROPE + 16 * (s_ - 8) + 8 * h8); }
    DI u32x4_t kpiece(int key, int d8) const { const size_t row = (size_t)b * SEQ + key;
        return d8 < 16 ? *(const u32x4_t*)(kn + row * 1024 + hh * DNOPE + d8 * 8) : *(const u32x4_t*)(kpe + row * DROPE + (d8 - 16) * 8); }
    DI u32x4_t vpiece(int dv, int key0) const { return *(const u32x4_t*)(vt + (size_t)(hh * DVH + dv) * NP + (size_t)b * SEQ + key0); } };
struct SrcMemP { const bf16_t* mk; const bf16_t* mvt; const bf16_t* xq; int b, hh; size_t row0;
    DI bf16x8 qfrag(int r, int s_, int h8) const { return *(const bf16x8*)(xq + (row0 + r) * ZLD + hh * XHD + 16 * s_ + 8 * h8); }
    DI u32x4_t kpiece(int key, int d8) const { return *(const u32x4_t*)(mk + ((size_t)b * NMEM + key) * 256 + hh * XHD + d8 * 8); }
    DI u32x4_t vpiece(int dv, int key0) const { return *(const u32x4_t*)(mvt + (size_t)(hh * XHD + dv) * (NB * NMEM) + (size_t)b * NMEM + key0); } };


DI void ret_chunk_state(const bf16_t* __restrict__ RVT, const bf16_t* __restrict__ RKtT, float* __restrict__ UT, int b, int h, int c) {
    const int tid = threadIdx.x, lane = tid & 63, w = __builtin_amdgcn_readfirstlane(tid >> 6), l31 = lane & 31, hh = lane >> 5;
    const size_t tok0 = (size_t)b * SEQ + c * 128;
    f32x16 acc[4];
#pragma unroll
    for (int kb = 0; kb < 4; ++kb)
#pragma unroll
        for (int i = 0; i < 16; ++i) acc[kb][i] = 0.f;
    const bf16_t* ap = RVT + (size_t)(h * RDV + 32 * w + l31) * NT + tok0 + 8 * hh;
    const bf16_t* bp = RKtT + (size_t)(h * RDK + l31) * NP + tok0 + 8 * hh;
#pragma unroll
    for (int s_ = 0; s_ < 8; ++s_) { const bf16x8 a = *(const bf16x8*)(ap + 16 * s_);
#pragma unroll
        for (int kb = 0; kb < 4; ++kb) { const bf16x8 bfr = *(const bf16x8*)(bp + (size_t)(32 * kb) * NP + 16 * s_); acc[kb] = MFMA32(a, bfr, acc[kb]); } }
    float* u = UT + (size_t)(((b * RH + h) * 16) + c) * 32768;
#pragma unroll
    for (int kb = 0; kb < 4; ++kb)
#pragma unroll
        for (int i = 0; i < 16; ++i) u[(32 * w + crow(i, hh)) * RDK + 32 * kb + l31] = acc[kb][i];
}
DI void ret_chunk_out(const bf16_t* __restrict__ RQt, const bf16_t* __restrict__ RKt, const bf16_t* __restrict__ RVT, const bf16_t* __restrict__ SPT, float* __restrict__ ORET, int b, int h, int c) {
    const int tid = threadIdx.x, lane = tid & 63, w = __builtin_amdgcn_readfirstlane(tid >> 6), l31 = lane & 31, hh = lane >> 5;
    const int ib = w & 3, vh = w >> 2;
    const size_t tok0 = (size_t)b * SEQ + c * 128;
    bf16x8 qf[8];
    { const bf16_t* qp = RQt + (tok0 + 32 * ib + l31) * 512 + h * RDK + 8 * hh;
#pragma unroll
      for (int s_ = 0; s_ < 8; ++s_) qf[s_] = *(const bf16x8*)(qp + 16 * s_); }
    f32x16 o[4];
#pragma unroll
    for (int blk = 0; blk < 4; ++blk)
#pragma unroll
        for (int i = 0; i < 16; ++i) o[blk][i] = 0.f;
    const bf16_t* vbase = RVT + (size_t)(h * RDV + 32 * (4 * vh) + l31) * NT + tok0 + 4 * hh;
#pragma unroll 1
    for (int jb = 0; jb <= ib; ++jb) {
        f32x16 x;
#pragma unroll
        for (int i = 0; i < 16; ++i) x[i] = 0.f;
        const bf16_t* kp = RKt + (tok0 + 32 * jb + l31) * 512 + h * RDK + 8 * hh;
#pragma unroll
        for (int s_ = 0; s_ < 8; ++s_) { const bf16x8 kf = *(const bf16x8*)(kp + 16 * s_); x = MFMA32(kf, qf[s_], x); }
        if (jb == ib) {
#pragma unroll
            for (int i = 0; i < 16; ++i) x[i] = (crow(i, hh) <= l31) ? x[i] : 0.f;
        }
#pragma unroll
        for (int s2 = 0; s2 < 2; ++s2) {
            u32x4_t pk; pk.x = cvtpk(x[8 * s2 + 0], x[8 * s2 + 1]); pk.y = cvtpk(x[8 * s2 + 2], x[8 * s2 + 3]); pk.z = cvtpk(x[8 * s2 + 4], x[8 * s2 + 5]); pk.w = cvtpk(x[8 * s2 + 6], x[8 * s2 + 7]);
            const bf16x8 pa = __builtin_bit_cast(bf16x8, pk);
#pragma unroll
            for (int blk = 0; blk < 4; ++blk) { const bf16_t* vp = vbase + (size_t)(32 * blk) * NT + 32 * jb + 16 * s2;
                const s16x4 lo = *(const s16x4*)vp, hi = *(const s16x4*)(vp + 8);
                const bf16x8 vf = __builtin_shufflevector(lo, hi, 0, 1, 2, 3, 4, 5, 6, 7);
                o[blk] = MFMA32(pa, vf, o[blk]); }
        }
    }
    const bf16_t* sp = SPT + (size_t)(((b * RH + h) * 16) + c) * 32768 + (size_t)(32 * (4 * vh) + l31) * RDK + 8 * hh;
#pragma unroll
    for (int s_ = 0; s_ < 8; ++s_)
#pragma unroll
        for (int blk = 0; blk < 4; ++blk) { const bf16x8 sf = *(const bf16x8*)(sp + (size_t)(32 * blk) * RDK + 16 * s_); o[blk] = MFMA32(qf[s_], sf, o[blk]); }
#pragma unroll
    for (int blk = 0; blk < 4; ++blk)
#pragma unroll
        for (int i = 0; i < 16; ++i) ORET[(tok0 + 32 * ib + crow(i, hh)) * 1024 + h * RDV + 32 * (4 * vh + blk) + l31] = o[blk][i];
}


typedef short v4i16_t __attribute__((ext_vector_type(4)));
DI s16x4 vtr(const LAS unsigned char* p) { return __builtin_bit_cast(s16x4, __builtin_amdgcn_ds_read_tr16_b64_v4i16((LAS v4i16_t*)p)); }
constexpr int MS_NSPLIT = 2, MS_KEYS = PAST / MS_NSPLIT, MS_TILES = MS_KEYS / 64;
DI void mla_sample_unit(LAS unsigned char* lds, const float* __restrict__ cckv, const float* __restrict__ ckpe, const int* __restrict__ pt,
                        const bf16_t* __restrict__ QLATb, const bf16_t* __restrict__ QPEb, float* __restrict__ PO, float* __restrict__ PML, int b, int split, float c2) {
    constexpr int KP = 328, KBYTES = 64 * KP * 2, SP = 68;
    LAS float* Sc = (LAS float*)(lds + 2 * KBYTES);
    const int tid = threadIdx.x, lane = tid & 63, w = __builtin_amdgcn_readfirstlane(tid >> 6), l31 = lane & 31, hh = lane >> 5, l15 = lane & 15, g4 = lane >> 4;
    const int kg = w >> 1, qg = w & 1;
    bf16x8 qf[10];
    { const int qi = 16 * qg + l15, t = qi >> 3, head = qi & 7;
      const bf16_t* ql = QLATb + (size_t)(b * DS + t) * 2048 + head * KVL + 8 * g4;
      const bf16_t* qp = QPEb + (size_t)(NP + b * DS + t) * 512 + head * DROPE + 8 * g4;
#pragma unroll
      for (int s_ = 0; s_ < 8; ++s_) qf[s_] = *(const bf16x8*)(ql + 32 * s_);
#pragma unroll
      for (int s_ = 0; s_ < 2; ++s_) qf[8 + s_] = *(const bf16x8*)(qp + 32 * s_); }
    f32x16 o;
#pragma unroll
    for (int i = 0; i < 16; ++i) o[i] = 0.f;
    float m = -INFINITY, lsum = 0.f;
    f32x4 crA[8], prA[2], crB[8], prB[2];
    const unsigned voffc = (unsigned)(((tid >> 6) * KVL + 4 * (tid & 63)) * 4), voffp = (unsigned)(((tid >> 4) * DROPE + 4 * (tid & 15)) * 4);
#define MS_LOAD(t_, CR_, PR_) do { const int key0_ = split * MS_KEYS + 64 * (t_); const int pg_ = __builtin_amdgcn_readfirstlane(pt[b * NPAGES + (key0_ >> 7)]); \
        const size_t rowb_ = (size_t)pg_ * PAGE + (key0_ & (PAGE - 1)); const char* cb_ = (const char*)(cckv + rowb_ * KVL); const char* pb_ = (const char*)(ckpe + rowb_ * DROPE); \
        _Pragma("unroll") for (int i_ = 0; i_ < 8; ++i_) CR_[i_] = __builtin_nontemporal_load((const f32x4*)(cb_ + (size_t)i_ * (8 * KVL * 4) + voffc)); \
        _Pragma("unroll") for (int i_ = 0; i_ < 2; ++i_) PR_[i_] = __builtin_nontemporal_load((const f32x4*)(pb_ + (size_t)i_ * (32 * DROPE * 4) + voffp)); } while (0)
#define MS_STORE(buf_, CR_, PR_) do { \
        _Pragma("unroll") for (int i_ = 0; i_ < 8; ++i_) { const int pc_ = tid + i_ * NTHREADS; *(LAS u32x2_t*)(lds + (buf_) * KBYTES + ((pc_ >> 6) * KP + 4 * (pc_ & 63)) * 2) = (u32x2_t){cvtpk(CR_[i_][0], CR_[i_][1]), cvtpk(CR_[i_][2], CR_[i_][3])}; } \
        _Pragma("unroll") for (int i_ = 0; i_ < 2; ++i_) { const int pc_ = tid + i_ * NTHREADS; *(LAS u32x2_t*)(lds + (buf_) * KBYTES + ((pc_ >> 4) * KP + KVL + 4 * (pc_ & 15)) * 2) = (u32x2_t){cvtpk(PR_[i_][0], PR_[i_][1]), cvtpk(PR_[i_][2], PR_[i_][3])}; } } while (0)
    __syncthreads();
    MS_LOAD(0, crA, prA); MS_LOAD(1, crB, prB); MS_STORE(0, crA, prA); MS_LOAD(2, crA, prA);
    __syncthreads();
    const int q4 = (lane & 15) >> 2, p4 = lane & 3, blk = (lane >> 4) & 1;
    auto tile = [&](const int buf) __attribute__((always_inline)) {
        const LAS unsigned char* kb_ = lds + buf * KBYTES;
        {   f32x4 s4 = {0.f, 0.f, 0.f, 0.f};
            const LAS unsigned char* kr_ = kb_ + ((16 * kg + l15) * KP + 8 * g4) * 2;
#pragma unroll
            for (int g_ = 0; g_ < 2; ++g_) { bf16x8 kf[5];
#pragma unroll
                for (int j = 0; j < 5; ++j) kf[j] = *(const LAS bf16x8*)(kr_ + 64 * (5 * g_ + j));
#pragma unroll
                for (int j = 0; j < 5; ++j) s4 = __builtin_amdgcn_mfma_f32_16x16x32_bf16(kf[j], qf[5 * g_ + j], s4, 0, 0, 0); }
            *(LAS f32x4*)(Sc + (16 * qg + l15) * SP + 16 * kg + 4 * g4) = s4; }
        __syncthreads();
        f32x4 sv[8];
#pragma unroll
        for (int i = 0; i < 8; ++i) sv[i] = *(const LAS f32x4*)(Sc + l31 * SP + 8 * i + 4 * hh);
        float mx = -INFINITY;
#pragma unroll
        for (int i = 0; i < 8; ++i) mx = fmaxf(mx, fmaxf(fmaxf(sv[i][0], sv[i][1]), fmaxf(sv[i][2], sv[i][3])));
        mx = fmaxf(mx, __shfl_xor(mx, 32));
        const float mn = fmaxf(m, mx);
        if (__builtin_amdgcn_ballot_w64(mn > m) != 0ull) {
            const float alpha = __builtin_amdgcn_exp2f((m - mn) * c2);
            lsum *= alpha;
#pragma unroll
            for (int i = 0; i < 16; ++i) o[i] *= alpha;
            m = mn;
        }
        const float nmc = -mn * c2;
        float ps = 0.f;
#pragma unroll
        for (int i = 0; i < 8; ++i)
#pragma unroll
            for (int e = 0; e < 4; ++e) { const float p = __builtin_amdgcn_exp2f(__builtin_fmaf(sv[i][e], c2, nmc)); sv[i][e] = p; ps += p; }
        lsum += ps;
#pragma unroll
        for (int ks = 0; ks < 4; ++ks) { const LAS unsigned char* a_ = kb_ + ((16 * ks + 4 * hh + q4) * KP + 32 * w + 16 * blk + 4 * p4) * 2;
            const s16x4 lo = vtr(a_), hi = vtr(a_ + 8 * KP * 2);
            const bf16x8 vf = __builtin_shufflevector(lo, hi, 0, 1, 2, 3, 4, 5, 6, 7); u32x4_t pk;
            pk.x = cvtpk(sv[2 * ks][0], sv[2 * ks][1]); pk.y = cvtpk(sv[2 * ks][2], sv[2 * ks][3]);
            pk.z = cvtpk(sv[2 * ks + 1][0], sv[2 * ks + 1][1]); pk.w = cvtpk(sv[2 * ks + 1][2], sv[2 * ks + 1][3]);
            o = MFMA32(vf, __builtin_bit_cast(bf16x8, pk), o); }
    };
    static_assert(MS_TILES % 2 == 0 && MS_TILES >= 4 && 2 * KBYTES + 32 * SP * 4 <= MISC_OFF, "mla_sample_unit pipeline");
#pragma unroll 1
    for (int t = 0; t < MS_TILES; t += 2) {
        tile(0);
        MS_STORE(1, crB, prB);
        if (t + 3 < MS_TILES) MS_LOAD(t + 3, crB, prB);
        __syncthreads();
        tile(1);
        if (t + 2 < MS_TILES) { MS_STORE(0, crA, prA); }
        if (t + 4 < MS_TILES) MS_LOAD(t + 4, crA, prA);
        __syncthreads();
    }
#undef MS_LOAD
#undef MS_STORE
    lsum += __shfl_xor(lsum, 32);
    const int item = b * MS_NSPLIT + split;
    if (w == 0 && lane < 32) { PML[(item * 32 + lane) * 2] = m * c2; PML[(item * 32 + lane) * 2 + 1] = lsum; }
#pragma unroll
    for (int i = 0; i < 16; ++i) PO[((size_t)item * 32 + l31) * KVL + 32 * w + crow(i, hh)] = o[i];
}


struct RetItem { int b, h, c, vh; };
DI RetItem ret_item(int it) { RetItem r; r.vh = it & 1; r.c = (it >> 1) & 15; r.h = (it >> 5) & 3; r.b = it >> 7; return r; }
DI void ret_out_phase(LAS unsigned char* lds, const bf16_t* __restrict__ RQt, const bf16_t* __restrict__ RKt, const bf16_t* __restrict__ RVT, const bf16_t* __restrict__ SPT, float* __restrict__ ORET, int bid, int G) {
    constexpr int PITCH = 136, TILE = 128 * PITCH * 2;
    const int tid = threadIdx.x, lane = tid & 63, w = __builtin_amdgcn_readfirstlane(tid >> 6), l31 = lane & 31, hh = lane >> 5;
    const int ib = w & 3, dq = w >> 2;
    u32x4_t st[12];
#define RO_LOAD(it_) do { const RetItem q_ = ret_item(it_); const size_t tok0_ = (size_t)q_.b * SEQ + q_.c * 128; \
        _Pragma("unroll") for (int i_ = 0; i_ < 12; ++i_) { const int p_ = tid + i_ * NTHREADS, tl_ = p_ >> 11, row_ = (p_ >> 4) & 127, c16_ = p_ & 15; const bf16_t* src_; \
            if (tl_ == 0) src_ = RKt + (tok0_ + row_) * 512 + q_.h * RDK + 8 * c16_; \
            else if (tl_ == 1) src_ = RVT + (size_t)(q_.h * RDV + 128 * q_.vh + row_) * NT + tok0_ + 8 * c16_; \
            else src_ = SPT + (size_t)(((q_.b * RH + q_.h) * 16) + q_.c) * 32768 + (size_t)(128 * q_.vh + row_) * RDK + 8 * c16_; \
            st[i_] = *(const u32x4_t*)src_; } } while (0)
#define RO_STORE() do { _Pragma("unroll") for (int i_ = 0; i_ < 12; ++i_) { const int p_ = tid + i_ * NTHREADS, tl_ = p_ >> 11, row_ = (p_ >> 4) & 127, c16_ = p_ & 15; \
            *(LAS u32x4_t*)(lds + tl_ * TILE + (row_ * PITCH + 8 * c16_) * 2) = st[i_]; } } while (0)
    int it = bid;
    if (it < NB * RH * 16 * 2) RO_LOAD(it);
    for (; it < NB * RH * 16 * 2; it += G) {
        const RetItem q = ret_item(it); const size_t tok0 = (size_t)q.b * SEQ + q.c * 128;
        __syncthreads();
        RO_STORE();
        bf16x8 qf[8];
        { const bf16_t* qp = RQt + (tok0 + 32 * ib + l31) * 512 + q.h * RDK + 8 * hh;
#pragma unroll
          for (int s_ = 0; s_ < 8; ++s_) qf[s_] = *(const bf16x8*)(qp + 16 * s_); }
        __syncthreads();
        if (it + G < NB * RH * 16 * 2) RO_LOAD(it + G);
        const LAS unsigned char* Kl = lds; const LAS unsigned char* Vl = lds + TILE; const LAS unsigned char* Sl = lds + 2 * TILE;
        f32x16 o[2];
#pragma unroll
        for (int blk = 0; blk < 2; ++blk)
#pragma unroll
            for (int i = 0; i < 16; ++i) o[blk][i] = 0.f;
#pragma unroll 1
        for (int jb = 0; jb <= ib; ++jb) {
            f32x16 x;
#pragma unroll
            for (int i = 0; i < 16; ++i) x[i] = 0.f;
#pragma unroll
            for (int s_ = 0; s_ < 8; ++s_) { const bf16x8 kf = *(const LAS bf16x8*)(Kl + ((32 * jb + l31) * PITCH + 16 * s_ + 8 * hh) * 2); x = MFMA32(kf, qf[s_], x); }
            if (jb == ib) {
#pragma unroll
                for (int i = 0; i < 16; ++i) x[i] = (crow(i, hh) <= l31) ? x[i] : 0.f;
            }
#pragma unroll
            for (int s2 = 0; s2 < 2; ++s2) {
                u32x4_t pk; pk.x = cvtpk(x[8 * s2 + 0], x[8 * s2 + 1]); pk.y = cvtpk(x[8 * s2 + 2], x[8 * s2 + 3]); pk.z = cvtpk(x[8 * s2 + 4], x[8 * s2 + 5]); pk.w = cvtpk(x[8 * s2 + 6], x[8 * s2 + 7]);
                const bf16x8 pa = __builtin_bit_cast(bf16x8, pk);
#pragma unroll
                for (int blk = 0; blk < 2; ++blk) { const LAS unsigned char* vp = Vl + ((64 * dq + 32 * blk + l31) * PITCH + 32 * jb + 16 * s2 + 4 * hh) * 2;
                    const s16x4 lo = *(const LAS s16x4*)vp, hi = *(const LAS s16x4*)(vp + 16);
                    o[blk] = MFMA32(pa, __builtin_shufflevector(lo, hi, 0, 1, 2, 3, 4, 5, 6, 7), o[blk]); }
            }
        }
#pragma unroll
        for (int s_ = 0; s_ < 8; ++s_)
#pragma unroll
            for (int blk = 0; blk < 2; ++blk) { const bf16x8 sf = *(const LAS bf16x8*)(Sl + ((64 * dq + 32 * blk + l31) * PITCH + 16 * s_ + 8 * hh) * 2); o[blk] = MFMA32(qf[s_], sf, o[blk]); }
#pragma unroll
        for (int blk = 0; blk < 2; ++blk)
#pragma unroll
            for (int i = 0; i < 16; ++i) ORET[(tok0 + 32 * ib + crow(i, hh)) * 1024 + q.h * RDV + 128 * q.vh + 64 * dq + 32 * blk + l31] = o[blk][i];
    }
#undef RO_LOAD
#undef RO_STORE
}


DI void ret_state_phase(LAS unsigned char* lds, const bf16_t* __restrict__ RVT, const bf16_t* __restrict__ RKtT, float* __restrict__ UT, int bid, int G) {
    constexpr int PITCH = 136;
    const int tid = threadIdx.x, lane = tid & 63, w = __builtin_amdgcn_readfirstlane(tid >> 6), l31 = lane & 31, hh = lane >> 5;
    u32x4_t st[12];
#define RS_LOAD(it_) do { const int c_ = (it_) & 15, h_ = ((it_) >> 4) & 3, b_ = (it_) >> 6; const size_t tok0_ = (size_t)b_ * SEQ + c_ * 128; \
        _Pragma("unroll") for (int i_ = 0; i_ < 12; ++i_) { const int p_ = tid + i_ * NTHREADS, row_ = p_ >> 4, c16_ = p_ & 15; \
            const bf16_t* src_ = row_ < 256 ? RVT + (size_t)(h_ * RDV + row_) * NT + tok0_ + 8 * c16_ : RKtT + (size_t)(h_ * RDK + (row_ - 256)) * NP + tok0_ + 8 * c16_; \
            st[i_] = *(const u32x4_t*)src_; } } while (0)
    int it = bid;
    if (it < NB * RH * 16) RS_LOAD(it);
    for (; it < NB * RH * 16; it += G) {
        __syncthreads();
#pragma unroll
        for (int i = 0; i < 12; ++i) { const int p = tid + i * NTHREADS; *(LAS u32x4_t*)(lds + ((p >> 4) * PITCH + 8 * (p & 15)) * 2) = st[i]; }
        __syncthreads();
        if (it + G < NB * RH * 16) RS_LOAD(it + G);
        f32x16 acc[4];
#pragma unroll
        for (int kb = 0; kb < 4; ++kb)
#pragma unroll
            for (int i = 0; i < 16; ++i) acc[kb][i] = 0.f;
#pragma unroll
        for (int s_ = 0; s_ < 8; ++s_) { const bf16x8 a = *(const LAS bf16x8*)(lds + ((32 * w + l31) * PITCH + 16 * s_ + 8 * hh) * 2);
#pragma unroll
            for (int kb = 0; kb < 4; ++kb) { const bf16x8 b_ = *(const LAS bf16x8*)(lds + ((256 + 32 * kb + l31) * PITCH + 16 * s_ + 8 * hh) * 2); acc[kb] = MFMA32(a, b_, acc[kb]); } }
        float* u = UT + (size_t)it * 32768;
#pragma unroll
        for (int kb = 0; kb < 4; ++kb)
#pragma unroll
            for (int i = 0; i < 16; ++i) u[(32 * w + crow(i, hh)) * RDK + 32 * kb + l31] = acc[kb][i];
    }
#undef RS_LOAD
}

struct QPtr { const float* p; DI float operator()(int d) const { return p[d]; } };
struct QMla { const float* ql; const float* qp; DI float operator()(int d) const { return d < KVL ? ql[d] : qp[d - KVL]; } };
DI void rms_row(const float* x, const float* g, float* o, int n, int lane) {
    float s = 0.f;
    for (int i = lane; i < n; i += 64) { const float v = x[i]; s += v * v; }
    const float r = rsqrtf(wave_sum(s) / (float)n + EPS);
    for (int i = lane; i < n; i += 64) o[i] = x[i] * r * g[i];
}

DI void rms_row_bf16(const float* x, const float* g, bf16_t* o, int n, int lane) {
    float s = 0.f;
    for (int i = lane; i < n; i += 64) { const float v = x[i]; s += v * v; }
    const float r = rsqrtf(wave_sum(s) / (float)n + EPS);
    for (int i = lane; i < n; i += 64) o[i] = f2bf(x[i] * r * g[i]);
}
#define GEMM_PHASE(EPI, ...) pg8::gemm_phase<EPI, pg8::StaticOrder, true, true>(__VA_ARGS__)
#define GEMM_SPLIT(...) pg8::gemm_phase<pg8::EpiPart, pg8::SplitOrder, true, true>(__VA_ARGS__)
__global__ void __launch_bounds__(NTHREADS, 2) fwd_kernel(Args args) {
    extern __shared__ __attribute__((aligned(16))) unsigned char lds_raw[];
    LAS unsigned char* ldsb = (LAS unsigned char*)lds_raw;
    LAS float* lds = (LAS float*)ldsb;
    volatile LAS unsigned* MISC = (volatile LAS unsigned*)(ldsb + MISC_OFF);
    const int tid = threadIdx.x, lane = tid & 63, wave = tid >> 6;
    const int G = gridDim.x, bid = blockIdx.x;
    const int gw = bid * NWAVES + wave, NGW = G * NWAVES;
    unsigned char* ws = args.ws;
    float* out = args.out;
    const int lo = args.ph_lo, hi = args.ph_hi;

    if (tid < 64) MISC[tid] = 0u;
    __syncthreads();
    XcdBarrier bar; bar.bar = (unsigned*)(ws + WS_CTL) + CW_BAR; bar.x = 0; bar.st = MISC;
    if (hi - lo > 1) bar = xcd_barrier_post((unsigned*)(ws + WS_CTL) + CW_BAR, MISC);
#define IN(k) (lo <= (k) && (k) < hi)
#define PHASE_IDS int tid_l_ = threadIdx.x; asm volatile("" : "+v"(tid_l_)); const int tid = tid_l_, lane = tid & 63, wave = tid >> 6, gw = bid * NWAVES + wave; (void)tid; (void)lane; (void)wave; (void)gw;
#define SEAM(k) do { if (IN(k) && IN((k) + 1)) xcd_barrier(bar); } while (0)

#define x_prompt ((const float*)(args.in[0]))
#define x_sample ((const float*)(args.in[1]))
#define mem_prompt ((const float*)(args.in[2]))
#define cache_ckv ((const float*)(args.in[3]))
#define cache_kpe ((const float*)(args.in[4]))
#define page_table ((const int*)args.in[5])
#define state_ret ((const float*)(args.in[6]))
#define cache_mem_k ((const float*)(args.in[7]))
#define cache_mem_v ((const float*)(args.in[8]))
#define g_mix_pre ((const float*)(args.in[9]))
#define g_mix_post ((const float*)(args.in[10]))
#define g_ffn_pre ((const float*)(args.in[11]))
#define g_ffn_post ((const float*)(args.in[12]))
#define g_mem ((const float*)(args.in[13]))
#define g_qlat ((const float*)(args.in[14]))
#define g_kvlat ((const float*)(args.in[15]))
#define w_in ((const float*)(args.in[16]))
#define w_uq ((const float*)(args.in[17]))
#define w_uk ((const float*)(args.in[18]))
#define w_uv ((const float*)(args.in[19]))
#define w_mem_k ((const float*)(args.in[20]))
#define w_mem_v ((const float*)(args.in[21]))
#define w_ret_o ((const float*)(args.in[22]))
#define w_mla_o ((const float*)(args.in[23]))
#define w_x_o ((const float*)(args.in[24]))
#define w_out ((const float*)(args.in[25]))
#define w_gate ((const float*)(args.in[26]))
#define w_up ((const float*)(args.in[27]))
#define w_down ((const float*)(args.in[28]))
#define COSA ((float*)(ws + WS_COSA))
#define SINA ((float*)(ws + WS_SINA))
#define COSB ((float*)(ws + WS_COSB))
#define SINB ((float*)(ws + WS_SINB))
#define U ((float*)(ws + WS_U))
#define MN ((float*)(ws + WS_MN))
#define Zb ((bf16_t*)(ws + WS_Z))
#define RQ ((float*)(ws + WS_RQ))
#define RK ((float*)(ws + WS_RK))
#define CQN ((float*)(ws + WS_CQN))
#define CKVN ((float*)(ws + WS_CKVN))
#define KPER ((float*)(ws + WS_KPER))
#define Q ((float*)(ws + WS_Q))
#define QLAT ((float*)(ws + WS_QLAT))
#define QPE ((float*)(ws + WS_QPE))
#define ORET ((float*)(ws + WS_ORET))
#define OLAT ((float*)(ws + WS_OLAT))
#define OX ((float*)(ws + WS_OX))
#define OMLA ((float*)(ws + WS_OMLA))
#define ORETN ((float*)(ws + WS_ORETN))
#define ARET ((float*)(ws + WS_ARET))
#define AMLA ((float*)(ws + WS_AMLA))
#define AX ((float*)(ws + WS_AX))
#define MIX ((float*)(ws + WS_MIX))
#define HPb ((bf16_t*)(ws + WS_HP))
#define Hb ((bf16_t*)(ws + WS_H))
#define F ((float*)(ws + WS_F))
#define GU ((float*)(ws + WS_GG))
#define FOb ((bf16_t*)(ws + WS_FO))
#define WinT ((bf16_t*)(ws + WS_WIN_T))
#define WmkvT ((bf16_t*)(ws + WS_WMKV_T))
#define WuqT ((bf16_t*)(ws + WS_WUQ_T))
#define WcatT ((bf16_t*)(ws + WS_WRO_T))
#define CATb ((bf16_t*)(ws + WS_ORETNB))
#define WroT ((bf16_t*)(ws + WS_WRO_T))
#define WmoT ((bf16_t*)(ws + WS_WMO_T))
#define WxoT ((bf16_t*)(ws + WS_WXO_T))
#define WoT ((bf16_t*)(ws + WS_WO_T))
#define WguT ((bf16_t*)(ws + WS_WGU_T))
#define WdT ((bf16_t*)(ws + WS_WD_T))
#define Ub ((bf16_t*)(ws + WS_UB))
#define MNb ((bf16_t*)(ws + WS_MNB))
#define CQNb ((bf16_t*)(ws + WS_CQNB))
#define ORETNb ((bf16_t*)(ws + WS_ORETNB))
#define OMLAb ((bf16_t*)(ws + WS_OMLAB))
#define OXb ((bf16_t*)(ws + WS_OXB))
#define MIXb ((bf16_t*)(ws + WS_MIXB))
#define Fb ((bf16_t*)(ws + WS_FB))
#define ACTb ((bf16_t*)(ws + WS_ACTB))
#define WukT ((bf16_t*)(ws + WS_WUK_T))
#define WuvT ((bf16_t*)(ws + WS_WUV_T))
#define CKVNb ((bf16_t*)(ws + WS_CKVNB))
#define KPERb ((bf16_t*)(ws + WS_KPERB))
#define XQb ((bf16_t*)(ws + WS_XQB))
#define MKb ((bf16_t*)(ws + WS_MKB))
#define MVT ((bf16_t*)(ws + WS_MVT))
#define KN ((bf16_t*)(ws + WS_KN))
#define VT ((bf16_t*)(ws + WS_VT))
#define Qb ((bf16_t*)(ws + WS_QB))
#define RQt ((bf16_t*)(ws + WS_RQT))
#define RKt ((bf16_t*)(ws + WS_RKT))
#define RKtT ((bf16_t*)(ws + WS_RKTT))
#define RVT ((bf16_t*)(ws + WS_RVT))
#define UT ((float*)(ws + WS_UT))
#define SPT ((bf16_t*)(ws + WS_SPT))
#define QPEb ((bf16_t*)(ws + WS_QPEB))
#define WukB ((bf16_t*)(ws + WS_WUKB))
#define PART ((float*)(ws + WS_PART))
#define SGb ((bf16_t*)(ws + WS_SGB))
#define SRGb ((bf16_t*)(ws + WS_SRGB))
#define T0b ((bf16_t*)(ws + WS_T0B))
#define T1b ((bf16_t*)(ws + WS_T1B))
#define QLATb ((bf16_t*)(ws + WS_QLATB))
#define PO ((float*)(ws + WS_PO))
#define PML ((float*)(ws + WS_PML))
    if (IN(0)) { PHASE_IDS
        for (int i = bid * NTHREADS + tid; i < NPOS * 64 + NPOS * 32; i += G * NTHREADS) {
            const bool a = i < NPOS * 64; const int j = a ? i : i - NPOS * 64; const int half = a ? 64 : 32;
            const int p = j / half, f = j % half; const int pos = p < SEQ ? p : PAST + (p - SEQ);
            const float inv = powf(10000.0f, -(float)f / (float)half);
            const float ang = (float)pos * inv;
            double rev = (double)ang * 0.15915494309189535; rev -= floor(rev);
            const float r = (float)rev;
            const float sn = __builtin_amdgcn_sinf(r), cs = __builtin_amdgcn_cosf(r);
            if (a) { COSA[j] = cs; SINA[j] = sn; } else { COSB[j] = cs; SINB[j] = sn; }
        }
#pragma unroll 1
        for (int pass = 0; pass < 2; ++pass) {
            const int nrows = pass ? NB * NMEM : NT; const float* gsrc = pass ? g_mem : g_mix_pre; bf16_t* dst = pass ? MNb : Ub;
            f32x4 a[4];
#define P0_SRC(r_) (pass ? mem_prompt + (size_t)(r_) * DM : (r_) < NP ? x_prompt + (size_t)(r_) * DM : x_sample + (size_t)((r_) - NP) * DM)
#define P0_LOAD(r_, A_) do { const float* s_ = P0_SRC(r_); _Pragma("unroll") for (int j_ = 0; j_ < 4; ++j_) A_[j_] = *(const f32x4*)(s_ + 4 * lane + 256 * j_); } while (0)
            int row = gw;
            if (row < nrows) P0_LOAD(row, a);
#pragma unroll 1
            for (; row < nrows; row += NGW) {
                f32x4 an[4]; const int nr = row + NGW;
                if (nr < nrows) P0_LOAD(nr, an);
                float ss = 0.f;
#pragma unroll
                for (int j = 0; j < 4; ++j) ss += a[j][0] * a[j][0] + a[j][1] * a[j][1] + a[j][2] * a[j][2] + a[j][3] * a[j][3];
                const float r = rsqrtf(wave_sum(ss) * (1.f / DM) + EPS);
#pragma unroll
                for (int j = 0; j < 4; ++j) { const f32x4 v = a[j] * r * *(const f32x4*)(gsrc + 4 * lane + 256 * j); *(u32x2_t*)(dst + (size_t)row * DM + 4 * lane + 256 * j) = (u32x2_t){cvtpk(v[0], v[1]), cvtpk(v[2], v[3])}; }
#pragma unroll
                for (int j = 0; j < 4; ++j) a[j] = an[j];
            }
#undef P0_LOAD
#undef P0_SRC
        }
        {
            LAS float* scr = lds + wave * (64 * 33);
            int rot = 0;
            transpose_w(w_in, 1024, DIN, WinT, 1024, 0, scr, gw, NGW, lane, rot);
            for (int i = bid * NTHREADS + tid; i < (ZLD - DIN) * 1024 / 2; i += G * NTHREADS) ((unsigned*)(WinT + (size_t)DIN * 1024))[i] = 0u;
            for (int i = bid * NTHREADS + tid; i < MH * KVL * DNOPE / 4; i += G * NTHREADS) { const f32x4 v = *(const f32x4*)(w_uk + 4 * (size_t)i); *(u32x2_t*)(WukB + 4 * (size_t)i) = (u32x2_t){cvtpk(v[0], v[1]), cvtpk(v[2], v[3])}; }
            transpose_w(w_mem_k, 1024, 256, WmkvT, 1024, 0, scr, gw, NGW, lane, rot);
            transpose_w(w_mem_v, 1024, 256, WmkvT, 1024, 256, scr, gw, NGW, lane, rot);
            transpose_w(w_uq, QL, 1536, WuqT, QL, 0, scr, gw, NGW, lane, rot);
            transpose_w(w_ret_o, 1024, 1024, WcatT, CATLD, 0, scr, gw, NGW, lane, rot);
            transpose_w(w_mla_o, 1024, 1024, WcatT + 1024, CATLD, 0, scr, gw, NGW, lane, rot);
            transpose_w(w_x_o, 256, 1024, WcatT + 2048, CATLD, 0, scr, gw, NGW, lane, rot);
            transpose_w(w_out, 1024, 1024, WoT, 1024, 0, scr, gw, NGW, lane, rot);
            transpose_w(w_gate, 1024, DFF, WguT, 1024, 0, scr, gw, NGW, lane, rot, 2);
            transpose_w(w_up, 1024, DFF, WguT, 1024, 1, scr, gw, NGW, lane, rot, 2);
            transpose_w(w_down, DFF, 1024, WdT, DFF, 0, scr, gw, NGW, lane, rot);
            for (int hh = 0; hh < MH; ++hh) { transpose_w(w_uk + (size_t)hh * KVL * DNOPE, KVL, DNOPE, WukT, KVL, hh * DNOPE, scr, gw, NGW, lane, rot);
                                              transpose_w(w_uv + (size_t)hh * KVL * DVH, KVL, DVH, WuvT, KVL, hh * DVH, scr, gw, NGW, lane, rot); }
        }
    }
    SEAM(0);
    if (IN(1)) {
        static_assert(WS_MNB == WS_UB + (size_t)NT * 1024 * 2 && WS_WMKV_T == WS_WIN_T + (size_t)ZLD * 1024 * 2, "P1 stacks Ub|MNb and WinT|WmkvT");
        { pg8::Gemm g{Ub, WinT, NT + NB * NMEM, ZLD + 512, 1024, 1024, 1024}; pg8::P1Order S; S.init(G, bid); pg8::EpiP1 E{Zb, ZLD, out + O_MKP, out + O_MVP, SRGb, SGb, C_RG, C_G};
          pg8::gemm_phase<pg8::EpiP1, pg8::P1Order, true, true>(ldsb, g, S, E); }
        __syncthreads();
        { pg8::Gemm g{WinT + (size_t)C_RV * 1024, Ub, 1024, NP, 1024, 1024, 1024}; pg8::StaticOrder S; S.init(1024, NP, G, bid); pg8::EpiBf16S E{RVT, NT};
          GEMM_PHASE(pg8::EpiBf16S, ldsb, g, S, E); }
    }
    SEAM(1);
    if (IN(2)) { PHASE_IDS
        constexpr int KTP = 520;
        LAS bf16_t* Kt = (LAS bf16_t*)ldsb;
        const int ntile = NP / 64, nwork = ntile + (NS + 63) / 64;
        for (int wk = bid; wk < nwork; wk += G) {
            const bool prompt = wk < ntile; const int row_base = prompt ? wk * 64 : NP + (wk - ntile) * 64;
            __syncthreads();
            {
                const int hq = lane >> 4, f4 = (lane & 15) * 4;
                u32x2_t q1, q2, k1, k2, cv, p1, p2; u32x4_t cq8; f32x4 ca, sa, cb, sb; int p;
#define P2_LOAD(r_, Q1_, Q2_, K1_, K2_, CQ_, CV_, P1_, P2_, CA_, SA_, CB_, SB_, P_) do { const bf16_t* z_ = Zb + (size_t)(row_base + (r_)) * ZLD; P_ = pos_index(row_base + (r_)); \
                Q1_ = *(const u32x2_t*)(z_ + C_RQ + hq * RDK + f4); Q2_ = *(const u32x2_t*)(z_ + C_RQ + hq * RDK + 64 + f4); K1_ = *(const u32x2_t*)(z_ + C_RK + hq * RDK + f4); K2_ = *(const u32x2_t*)(z_ + C_RK + hq * RDK + 64 + f4); \
                CQ_ = (u32x4_t){0u, 0u, 0u, 0u}; if (lane < 48) CQ_ = *(const u32x4_t*)(z_ + C_CQ + 8 * lane); CV_ = *(const u32x2_t*)(z_ + C_CKV + 4 * lane); \
                P1_ = (u32x2_t){0u, 0u}; P2_ = P1_; CB_ = (f32x4){0.f, 0.f, 0.f, 0.f}; SB_ = CB_; \
                if (lane < 8) { P1_ = *(const u32x2_t*)(z_ + C_KPE + 4 * lane); P2_ = *(const u32x2_t*)(z_ + C_KPE + 32 + 4 * lane); CB_ = *(const f32x4*)(COSB + P_ * 32 + 4 * lane); SB_ = *(const f32x4*)(SINB + P_ * 32 + 4 * lane); } \
                CA_ = *(const f32x4*)(COSA + P_ * 64 + f4); SA_ = *(const f32x4*)(SINA + P_ * 64 + f4); } while (0)
#define BLO(x_) __builtin_bit_cast(float, (x_) << 16)
#define BHI(x_) __builtin_bit_cast(float, (x_) & 0xffff0000u)
                int r = wave;
                P2_LOAD(r, q1, q2, k1, k2, cq8, cv, p1, p2, ca, sa, cb, sb, p);
                for (; r < 64; r += NWAVES) {
                    u32x2_t q1n, q2n, k1n, k2n, cvn, p1n, p2n; u32x4_t cq8n; f32x4 can, san, cbn, sbn; int pn;
                    if (r + NWAVES < 64) P2_LOAD(r + NWAVES, q1n, q2n, k1n, k2n, cq8n, cvn, p1n, p2n, can, san, cbn, sbn, pn);
                    const int row = row_base + r; const int il = p & 127;
                    {
                        const float x1q[4] = {BLO(q1.x), BHI(q1.x), BLO(q1.y), BHI(q1.y)}, x2q[4] = {BLO(q2.x), BHI(q2.x), BLO(q2.y), BHI(q2.y)};
                        const float x1k[4] = {BLO(k1.x), BHI(k1.x), BLO(k1.y), BHI(k1.y)}, x2k[4] = {BLO(k2.x), BHI(k2.x), BLO(k2.y), BHI(k2.y)};
                        const float sc = 0.08838834764831845f;
                        float oq1[4], oq2[4], ok1[4], ok2[4];
#pragma unroll
                        for (int e = 0; e < 4; ++e) { oq1[e] = x1q[e] * ca[e] - x2q[e] * sa[e]; oq2[e] = x1q[e] * sa[e] + x2q[e] * ca[e];
                            ok1[e] = (x1k[e] * ca[e] - x2k[e] * sa[e]) * sc; ok2[e] = (x1k[e] * sa[e] + x2k[e] * ca[e]) * sc; }
                        if (prompt) {
                            const float fq = __expf((float)(il - 127) * lg_gamma(hq)), fk = 1.f / fq;
                            *(u32x2_t*)(RQt + (size_t)row * 512 + hq * RDK + f4) = (u32x2_t){cvtpk(oq1[0] * fq, oq1[1] * fq), cvtpk(oq1[2] * fq, oq1[3] * fq)};
                            *(u32x2_t*)(RQt + (size_t)row * 512 + hq * RDK + 64 + f4) = (u32x2_t){cvtpk(oq2[0] * fq, oq2[1] * fq), cvtpk(oq2[2] * fq, oq2[3] * fq)};
                            const u32x2_t kb1 = {cvtpk(ok1[0] * fk, ok1[1] * fk), cvtpk(ok1[2] * fk, ok1[3] * fk)}, kb2 = {cvtpk(ok2[0] * fk, ok2[1] * fk), cvtpk(ok2[2] * fk, ok2[3] * fk)};
                            *(u32x2_t*)(RKt + (size_t)row * 512 + hq * RDK + f4) = kb1; *(u32x2_t*)(RKt + (size_t)row * 512 + hq * RDK + 64 + f4) = kb2;
                            *(LAS u32x2_t*)(Kt + r * KTP + hq * RDK + f4) = kb1; *(LAS u32x2_t*)(Kt + r * KTP + hq * RDK + 64 + f4) = kb2;
                        } else {
                            *(f32x4*)(RQ + (size_t)row * 512 + hq * RDK + f4) = (f32x4){oq1[0], oq1[1], oq1[2], oq1[3]}; *(f32x4*)(RQ + (size_t)row * 512 + hq * RDK + 64 + f4) = (f32x4){oq2[0], oq2[1], oq2[2], oq2[3]};
                            *(f32x4*)(RK + (size_t)row * 512 + hq * RDK + f4) = (f32x4){ok1[0], ok1[1], ok1[2], ok1[3]}; *(f32x4*)(RK + (size_t)row * 512 + hq * RDK + 64 + f4) = (f32x4){ok2[0], ok2[1], ok2[2], ok2[3]};
                        }
                    }
                    {
                        const float c_[8] = {BLO(cq8.x), BHI(cq8.x), BLO(cq8.y), BHI(cq8.y), BLO(cq8.z), BHI(cq8.z), BLO(cq8.w), BHI(cq8.w)};
                        float ss = 0.f;
#pragma unroll
                        for (int e = 0; e < 8; ++e) ss += c_[e] * c_[e];
                        const float rr = rsqrtf(wave_sum(ss) * (1.f / QL) + EPS);
                        if (lane < 48) { const f32x4 g0 = *(const f32x4*)(g_qlat + 8 * lane), g1 = *(const f32x4*)(g_qlat + 8 * lane + 4);
                            *(u32x4_t*)(CQNb + (size_t)row * QL + 8 * lane) = (u32x4_t){cvtpk(c_[0] * rr * g0[0], c_[1] * rr * g0[1]), cvtpk(c_[2] * rr * g0[2], c_[3] * rr * g0[3]),
                                                                                     cvtpk(c_[4] * rr * g1[0], c_[5] * rr * g1[1]), cvtpk(c_[6] * rr * g1[2], c_[7] * rr * g1[3])}; }
                    }
                    {
                        const float v_[4] = {BLO(cv.x), BHI(cv.x), BLO(cv.y), BHI(cv.y)};
                        const float rr = rsqrtf(wave_sum(v_[0] * v_[0] + v_[1] * v_[1] + v_[2] * v_[2] + v_[3] * v_[3]) * (1.f / KVL) + EPS);
                        const f32x4 g0 = *(const f32x4*)(g_kvlat + 4 * lane); const f32x4 o_ = {v_[0] * rr * g0[0], v_[1] * rr * g0[1], v_[2] * rr * g0[2], v_[3] * rr * g0[3]};
                        float* ockv = row < NP ? out + O_CKVP + (size_t)row * KVL : out + O_CKVS + (size_t)(row - NP) * KVL;
                        *(f32x4*)(ockv + 4 * lane) = o_; *(f32x4*)(CKVN + (size_t)row * KVL + 4 * lane) = o_;
                        *(u32x2_t*)(CKVNb + (size_t)row * KVL + 4 * lane) = (u32x2_t){cvtpk(o_[0], o_[1]), cvtpk(o_[2], o_[3])};
                    }
                    if (lane < 8) {
                        const float x1[4] = {BLO(p1.x), BHI(p1.x), BLO(p1.y), BHI(p1.y)}, x2[4] = {BLO(p2.x), BHI(p2.x), BLO(p2.y), BHI(p2.y)};
                        f32x4 o1, o2;
#pragma unroll
                        for (int e = 0; e < 4; ++e) { o1[e] = x1[e] * cb[e] - x2[e] * sb[e]; o2[e] = x1[e] * sb[e] + x2[e] * cb[e]; }
                        *(f32x4*)(KPER + (size_t)row * DROPE + 4 * lane) = o1; *(f32x4*)(KPER + (size_t)row * DROPE + 32 + 4 * lane) = o2;
                        float* okpe = row < NP ? out + O_KPEP + (size_t)row * DROPE : out + O_KPES + (size_t)(row - NP) * DROPE;
                        *(f32x4*)(okpe + 4 * lane) = o1; *(f32x4*)(okpe + 32 + 4 * lane) = o2;
                        *(u32x2_t*)(KPERb + (size_t)row * DROPE + 4 * lane) = (u32x2_t){cvtpk(o1[0], o1[1]), cvtpk(o1[2], o1[3])}; *(u32x2_t*)(KPERb + (size_t)row * DROPE + 32 + 4 * lane) = (u32x2_t){cvtpk(o2[0], o2[1]), cvtpk(o2[2], o2[3])};
                    }
                    q1 = q1n; q2 = q2n; k1 = k1n; k2 = k2n; cq8 = cq8n; cv = cvn; p1 = p1n; p2 = p2n; ca = can; sa = san; cb = cbn; sb = sbn; p = pn;
                }
#undef P2_LOAD
            }
            __syncthreads();
            if (prompt) {
#pragma unroll 2
                for (int i = 0; i < 8; ++i) { const int pc = tid + i * NTHREADS, f = pc >> 3, k8 = pc & 7;
                    const LAS bf16_t* c = Kt + (8 * k8) * KTP + f;
                    pg8::u32x4 o; o.x = (unsigned)c[0] | ((unsigned)c[KTP] << 16); o.y = (unsigned)c[2 * KTP] | ((unsigned)c[3 * KTP] << 16);
                    o.z = (unsigned)c[4 * KTP] | ((unsigned)c[5 * KTP] << 16); o.w = (unsigned)c[6 * KTP] | ((unsigned)c[7 * KTP] << 16);
                    *(pg8::u32x4*)(RKtT + (size_t)f * NP + row_base + 8 * k8) = o; }
            }
        }
    }
    if (IN(2)) { PHASE_IDS
        for (int i = bid * NTHREADS + tid; i < NB * NMEM * 256; i += G * NTHREADS) { MKb[i] = f2bf(out[O_MKP + i]);
            const int f = i / (NB * NMEM), r = i - f * (NB * NMEM); MVT[i] = f2bf(out[O_MVP + (size_t)r * 256 + f]); }
    }
    SEAM(2);
    if (IN(3)) { pg8::Gemm g{CQNb, WuqT, NT, 1536, QL, QL, QL}; pg8::StaticOrder S; S.init(NT, 1536, G, bid); pg8::EpiBf16S E{Qb, 1536};
        GEMM_PHASE(pg8::EpiBf16S, ldsb, g, S, E);
        __syncthreads();
        { pg8::Gemm g2{CKVNb, WukT, NP, 1024, KVL, KVL, KVL}; pg8::StaticOrder S2; S2.init(NP, 1024, G, bid); pg8::EpiBf16S E2{KN, 1024}; GEMM_PHASE(pg8::EpiBf16S, ldsb, g2, S2, E2); }
        __syncthreads();
        { pg8::Gemm g3{WuvT, CKVNb, 1024, NP, KVL, KVL, KVL}; pg8::StaticOrder S3; S3.init(1024, NP, G, bid); pg8::EpiBf16S E3{VT, NP}; GEMM_PHASE(pg8::EpiBf16S, ldsb, g3, S3, E3); }
        ret_state_phase(ldsb, RVT, RKtT, UT, bid, G); }
    SEAM(3);
    if (IN(4)) { PHASE_IDS
        for (int idx = bid * NTHREADS + tid; idx < NB * RH * 8192; idx += G * NTHREADS) {
            const int bh = idx >> 13, e = (idx & 8191) * 4; const float g128 = __expf(128.f * lg_gamma(bh & 3));
            f32x4 u[16];
#pragma unroll
            for (int c = 0; c < 16; ++c) u[c] = __builtin_nontemporal_load((const f32x4*)(UT + (size_t)(bh * 16 + c) * 32768 + e));
            f32x4 sp = {0.f, 0.f, 0.f, 0.f}, S = sp;
#pragma unroll
            for (int c = 0; c < 16; ++c) { *(u32x2_t*)(SPT + (size_t)(bh * 16 + c) * 32768 + e) = (u32x2_t){cvtpk(sp[0], sp[1]), cvtpk(sp[2], sp[3])}; S = sp + u[c]; sp = S * g128; }
            const int dv = e >> 7, dk = e & 127; float* o_ = out + O_RETP + (size_t)bh * 32768 + (size_t)dk * RDV + dv;
            o_[0] = S[0]; o_[RDV] = S[1]; o_[2 * RDV] = S[2]; o_[3 * RDV] = S[3];
        }
        {
            const int hd = lane >> 3, f4 = (lane & 7) * 4;
            u32x2_t x1, x2; f32x4 cb, sb;
#define P4_LOAD(r_, X1_, X2_, C_, S_) do { const bf16_t* q_ = Qb + (size_t)(r_) * 1536 + hd * DQH + DNOPE + f4; X1_ = *(const u32x2_t*)q_; X2_ = *(const u32x2_t*)(q_ + 32); \
            const int p_ = pos_index(r_); C_ = *(const f32x4*)(COSB + p_ * 32 + f4); S_ = *(const f32x4*)(SINB + p_ * 32 + f4); } while (0)
            int row = gw;
            if (row < NT) P4_LOAD(row, x1, x2, cb, sb);
            for (; row < NT; row += NGW) {
                u32x2_t x1n, x2n; f32x4 cbn, sbn; const int nr = row + NGW;
                if (nr < NT) P4_LOAD(nr, x1n, x2n, cbn, sbn);
                const float a0 = __builtin_bit_cast(float, x1.x << 16), a1 = __builtin_bit_cast(float, x1.x & 0xffff0000u), a2 = __builtin_bit_cast(float, x1.y << 16), a3 = __builtin_bit_cast(float, x1.y & 0xffff0000u);
                const float b0 = __builtin_bit_cast(float, x2.x << 16), b1 = __builtin_bit_cast(float, x2.x & 0xffff0000u), b2 = __builtin_bit_cast(float, x2.y << 16), b3 = __builtin_bit_cast(float, x2.y & 0xffff0000u);
                bf16_t* o_ = QPEb + (size_t)row * 512 + hd * DROPE + f4;
                *(u32x2_t*)o_ = (u32x2_t){cvtpk(a0 * cb[0] - b0 * sb[0], a1 * cb[1] - b1 * sb[1]), cvtpk(a2 * cb[2] - b2 * sb[2], a3 * cb[3] - b3 * sb[3])};
                *(u32x2_t*)(o_ + 32) = (u32x2_t){cvtpk(a0 * sb[0] + b0 * cb[0], a1 * sb[1] + b1 * cb[1]), cvtpk(a2 * sb[2] + b2 * cb[2], a3 * sb[3] + b3 * cb[3])};
                x1 = x1n; x2 = x2n; cb = cbn; sb = sbn;
            }
#undef P4_LOAD
        }
        for (int wt = gw; wt < MH * 16 * 2; wt += NGW) {
            const int lh = wt & 1, rb = (wt >> 1) & 15, head = wt >> 5; const int l31 = lane & 31, h8 = lane >> 5;
            f32x16 acc[4];
#pragma unroll
            for (int k_ = 0; k_ < 4; ++k_)
#pragma unroll
                for (int i = 0; i < 16; ++i) acc[k_][i] = 0.f;
            const bf16_t* ap = Qb + ((size_t)NP + 32 * rb + l31) * 1536 + head * DQH + 8 * h8;
            const bf16_t* bp = WukB + ((size_t)head * KVL + 128 * lh + l31) * DNOPE + 8 * h8;
#pragma unroll
            for (int s_ = 0; s_ < 8; ++s_) { const bf16x8 a = *(const bf16x8*)(ap + 16 * s_);
#pragma unroll
                for (int k_ = 0; k_ < 4; ++k_) { const bf16x8 b_ = *(const bf16x8*)(bp + (size_t)(32 * k_) * DNOPE + 16 * s_); acc[k_] = MFMA32(a, b_, acc[k_]); } }
#pragma unroll
            for (int k_ = 0; k_ < 4; ++k_)
#pragma unroll
                for (int i = 0; i < 16; ++i) QLATb[(size_t)(32 * rb + crow(i, h8)) * 2048 + head * KVL + 128 * lh + 32 * k_ + l31] = f2bf(acc[k_][i]);
        }
    }
    SEAM(4);
    if (IN(5)) { PHASE_IDS
        auto compute_units = [&]() __attribute__((always_inline)) {
        if (args.sub & 2) for (int it = bid; it < NB * MH * 4; it += G) {
            const int pr = __builtin_amdgcn_readfirstlane(it & 3), hh = __builtin_amdgcn_readfirstlane((it >> 2) & 7), b = __builtin_amdgcn_readfirstlane(it >> 5);
#pragma unroll 1
            for (int half = 0; half < 2; ++half) { const int qb = __builtin_amdgcn_readfirstlane(half ? pr : 7 - pr); const size_t row0 = (size_t)b * SEQ + qb * 256;
                SrcMlaP src{KN, KPERb, VT, Qb, QPEb, b, hh, row0};
                flash_unit<192, 128, true>(ldsb, src, qb * 256, 4 * (qb + 1), CATb + row0 * CATLD + 1024 + hh * DVH, CATLD, 0.07216878364870322f * 1.4426950408889634f); }
        }
        if (args.sub & 4) ret_out_phase(ldsb, RQt, RKt, RVT, SPT, ORET, bid, G);
        if (args.sub & 16) for (int it = bid; it < NB * XH * 8; it += G) {
            const int qb = __builtin_amdgcn_readfirstlane(it & 7), hh = __builtin_amdgcn_readfirstlane((it >> 3) & 3), b = __builtin_amdgcn_readfirstlane(it >> 5); const size_t row0 = (size_t)b * SEQ + qb * 256;
            SrcMemP src{MKb, MVT, Zb + C_XQ, b, hh, row0};
            flash_unit<64, 64, false>(ldsb, src, 0, 4, CATb + row0 * CATLD + 2048 + hh * XHD, CATLD, 0.125f * 1.4426950408889634f);
        }
        };
        const bool compute_first = ((bid >> 3) & 1) != 0;
        if (compute_first) compute_units();
        if (args.sub & 1) for (int it = bid; it < DB * MS_NSPLIT; it += G) { const int split = __builtin_amdgcn_readfirstlane(it % MS_NSPLIT), b = __builtin_amdgcn_readfirstlane(it / MS_NSPLIT);
            mla_sample_unit(ldsb, cache_ckv, cache_kpe, page_table, QLATb, QPEb, PO, PML, b, split, 0.07216878364870322f * 1.4426950408889634f); }
        if (args.sub & 8) for (int it = bid; it < DB * RH; it += G) {
            const int h = it & 3, b = it >> 2; const float lg = lg_gamma(h);
            const float* s0 = state_ret + (size_t)it * RDK * RDV;
            float* so = out + O_RETS + (size_t)it * RDK * RDV;
            LAS float* inner = lds;
            LAS float* qk = lds + 16;
            LAS float* vls = lds + 1040;
            LAS float* red = lds + 2064;
            f32x4 sv[16], vv[4];
#pragma unroll
            for (int r = 0; r < 16; ++r) sv[r] = __builtin_nontemporal_load((const f32x4*)(s0 + (size_t)(wave + 8 * r) * RDV + 4 * lane));
#pragma unroll
            for (int j = 0; j < DS; ++j) { const u32x2_t t_ = *(const u32x2_t*)(Zb + ((size_t)NP + b * DS + j) * ZLD + C_RV + h * RDV + 4 * lane); vv[j] = (f32x4){BLO(t_.x), BHI(t_.x), BLO(t_.y), BHI(t_.y)}; }
            __syncthreads();
            for (int i = tid; i < 1024; i += NTHREADS) { const int which = i >> 9, ti = (i >> 7) & 3, d = i & 127; const size_t row = (size_t)NP + b * DS + ti;
                qk[i] = which ? RK[row * 512 + h * RDK + d] : RQ[row * 512 + h * RDK + d]; }
            if (wave == 0) {
#pragma unroll
                for (int j = 0; j < DS; ++j) *(LAS f32x4*)(vls + j * 256 + 4 * lane) = vv[j]; }
            __syncthreads();
            for (int pr = wave; pr < 16; pr += NWAVES) { const int i = pr >> 2, j = pr & 3;
                float s_ = qk[i * 128 + lane] * qk[512 + j * 128 + lane] + qk[i * 128 + 64 + lane] * qk[512 + j * 128 + 64 + lane];
                s_ = wave_sum(s_);
                if (lane == 0) inner[pr] = (j <= i) ? s_ * __expf((float)(i - j) * lg) : 0.f; }
            const float g4 = __expf(4.f * lg), gk0 = __expf(3.f * lg), gk1 = __expf(2.f * lg), gk2 = __expf(lg);
            f32x4 po[4];
#pragma unroll
            for (int i = 0; i < 4; ++i) po[i] = (f32x4){0.f, 0.f, 0.f, 0.f};
#pragma unroll
            for (int r = 0; r < 16; ++r) { const int d = wave + 8 * r; const f32x4 sx = sv[r];
                f32x4 a = sx * g4 + (gk0 * qk[512 + d]) * vv[0] + (gk1 * qk[512 + 128 + d]) * vv[1] + (gk2 * qk[512 + 256 + d]) * vv[2] + qk[512 + 384 + d] * vv[3];
                __builtin_nontemporal_store(a, (f32x4*)(so + (size_t)d * RDV + 4 * lane));
#pragma unroll
                for (int i = 0; i < 4; ++i) po[i] += qk[i * 128 + d] * sx; }
#pragma unroll
            for (int i = 0; i < 4; ++i) *(LAS f32x4*)(red + (wave * 4 + i) * 256 + 4 * lane) = po[i];
            __syncthreads();
            {
                const int i = tid >> 7, e2 = (tid & 127) * 2;
                float o0 = 0.f, o1 = 0.f;
#pragma unroll
                for (int w_ = 0; w_ < NWAVES; ++w_) { o0 += red[(w_ * 4 + i) * 256 + e2]; o1 += red[(w_ * 4 + i) * 256 + e2 + 1]; }
                const float gi = __expf((float)(i + 1) * lg); o0 *= gi; o1 *= gi;
#pragma unroll
                for (int j = 0; j < DS; ++j) { const float w_ = inner[i * 4 + j]; o0 += w_ * vls[j * 256 + e2]; o1 += w_ * vls[j * 256 + e2 + 1]; }
                *(f32x2_t*)(ORET + ((size_t)NP + b * DS + i) * 1024 + h * RDV + e2) = (f32x2_t){o0, o1};
            }
        }
        if (args.sub & 32) for (int it = bid; it < DB * 2; it += G) {
            const int hp = it & 1, b = it >> 1, kh = lane >> 5, hl = (lane >> 4) & 1;
            LAS float* sc = lds;
            LAS float* red = lds + 2048;
            const float* kb_ = cache_mem_k + (size_t)b * NMEM * 256 + hp * 128 + 4 * (lane & 31); const float* vb_ = cache_mem_v + (size_t)b * NMEM * 256 + hp * 128 + 4 * (lane & 31);
            f32x4 qr[4];
#pragma unroll
            for (int q = 0; q < DS; ++q) { const u32x2_t t_ = *(const u32x2_t*)(Zb + ((size_t)NP + b * DS + q) * ZLD + C_XQ + hp * 128 + 4 * (lane & 31)); qr[q] = (f32x4){BLO(t_.x), BHI(t_.x), BLO(t_.y), BHI(t_.y)}; }
            __syncthreads();
            f32x4 kv[16];
#pragma unroll
            for (int kk = 0; kk < 16; ++kk) kv[kk] = __builtin_nontemporal_load((const f32x4*)(kb_ + (size_t)(32 * wave + 2 * kk + kh) * 256));
#pragma unroll
            for (int kk = 0; kk < 16; ++kk) { const int key = 32 * wave + 2 * kk + kh;
                float pq[4];
#pragma unroll
                for (int q = 0; q < 4; ++q) { float a = kv[kk][0] * qr[q][0] + kv[kk][1] * qr[q][1] + kv[kk][2] * qr[q][2] + kv[kk][3] * qr[q][3];
                    a += __shfl_xor(a, 1); a += __shfl_xor(a, 2); a += __shfl_xor(a, 4); a += __shfl_xor(a, 8); pq[q] = a; }
                if ((lane & 15) == 0) {
#pragma unroll
                    for (int q = 0; q < 4; ++q) sc[(q * 2 + hl) * 256 + key] = pq[q] * (0.125f * 1.4426950408889634f); } }
#pragma unroll
            for (int kk = 0; kk < 16; ++kk) kv[kk] = __builtin_nontemporal_load((const f32x4*)(vb_ + (size_t)(32 * wave + 2 * kk + kh) * 256));
            __syncthreads();
            {
                f32x4 v = *(LAS f32x4*)(sc + wave * 256 + 4 * lane);
                const float mx = wave_max(fmaxf(fmaxf(v[0], v[1]), fmaxf(v[2], v[3])));
#pragma unroll
                for (int e = 0; e < 4; ++e) v[e] = __builtin_amdgcn_exp2f(v[e] - mx);
                const float inv = 1.f / wave_sum(v[0] + v[1] + v[2] + v[3]);
                *(LAS f32x4*)(sc + wave * 256 + 4 * lane) = v * inv; }
            __syncthreads();
            f32x4 acc[4];
#pragma unroll
            for (int q = 0; q < 4; ++q) acc[q] = (f32x4){0.f, 0.f, 0.f, 0.f};
#pragma unroll
            for (int kk = 0; kk < 16; ++kk) { const int key = 32 * wave + 2 * kk + kh;
#pragma unroll
                for (int q = 0; q < 4; ++q) acc[q] += sc[(q * 2 + hl) * 256 + key] * kv[kk]; }
#pragma unroll
            for (int q = 0; q < 4; ++q) *(LAS f32x4*)(red + ((wave * 2 + kh) * 4 + q) * 128 + 4 * (lane & 31)) = acc[q];
            __syncthreads();
            { const int q = tid >> 7, e = tid & 127; float o0 = 0.f;
#pragma unroll
              for (int w_ = 0; w_ < 2 * NWAVES; ++w_) o0 += red[(w_ * 4 + q) * 128 + e];
              const float o1 = __shfl_xor(o0, 1);
              if ((tid & 1) == 0) *(unsigned*)(CATb + ((size_t)NP + b * DS + q) * CATLD + 2048 + hp * 128 + e) = cvtpk(o0, o1); }
        }
        if (!compute_first) compute_units();
    }
    SEAM(5);
    if (IN(6)) { PHASE_IDS
        for (int task = bid; task < (NS / 32) * MH; task += G) {
            const int head = task & 7, rb = task >> 3, b = 8 * rb + wave; const float c2 = 0.07216878364870322f * 1.4426950408889634f;
            constexpr int OLP = 264;
            LAS bf16_t* ol = (LAS bf16_t*)ldsb;
            __syncthreads();
            float kn[DS][5];
#pragma unroll
            for (int j = 0; j < DS; ++j) { const size_t krow = (size_t)NP + b * DS + j;
#pragma unroll
                for (int c = 0; c < 5; ++c) { const int d = lane + 64 * c; kn[j][c] = d < KVL ? CKVN[krow * KVL + d] : KPER[krow * DROPE + (d - KVL)]; } }
#pragma unroll
            for (int t = 0; t < DS; ++t) {
                const int qi = t * 8 + head; const size_t qrow = (size_t)b * DS + t;
                float qv[5];
#pragma unroll
                for (int c = 0; c < 5; ++c) { const int d = lane + 64 * c; const bf16_t raw = d < KVL ? QLATb[qrow * 2048 + head * KVL + d] : QPEb[(NP + qrow) * 512 + head * DROPE + (d - KVL)];
                    qv[c] = __builtin_bit_cast(float, (unsigned)raw << 16); }
                float sc[DS]; float M = -INFINITY;
#pragma unroll
                for (int j = 0; j < DS; ++j) { float a_ = 0.f;
#pragma unroll
                    for (int c = 0; c < 5; ++c) a_ += qv[c] * kn[j][c];
                    a_ = wave_sum(a_) * c2; sc[j] = (j <= t) ? a_ : -INFINITY; M = fmaxf(M, sc[j]); }
                float ms[MS_NSPLIT], ls[MS_NSPLIT];
#pragma unroll
                for (int sp = 0; sp < MS_NSPLIT; ++sp) { const int item = b * MS_NSPLIT + sp; ms[sp] = PML[(item * 32 + qi) * 2]; ls[sp] = PML[(item * 32 + qi) * 2 + 1]; M = fmaxf(M, ms[sp]); }
                float L = 0.f; float acc[4] = {0.f, 0.f, 0.f, 0.f};
#pragma unroll
                for (int sp = 0; sp < MS_NSPLIT; ++sp) { const int item = b * MS_NSPLIT + sp; const float wgt = __builtin_amdgcn_exp2f(ms[sp] - M); L += ls[sp] * wgt;
#pragma unroll
                    for (int c = 0; c < 4; ++c) acc[c] += wgt * PO[((size_t)item * 32 + qi) * KVL + lane + 64 * c]; }
#pragma unroll
                for (int j = 0; j < DS; ++j) { const float wgt = __builtin_amdgcn_exp2f(sc[j] - M); L += wgt;
#pragma unroll
                    for (int c = 0; c < 4; ++c) acc[c] += wgt * kn[j][c]; }
                const float inv = 1.f / L;
#pragma unroll
                for (int c = 0; c < 4; ++c) ol[(4 * wave + t) * OLP + lane + 64 * c] = f2bf(acc[c] * inv);
            }
            __syncthreads();
            if (wave < 4) {
                const int l31 = lane & 31, h8 = lane >> 5;
                f32x16 acc;
#pragma unroll
                for (int i = 0; i < 16; ++i) acc[i] = 0.f;
                const bf16_t* bp = WuvT + (size_t)(head * DVH + 32 * wave + l31) * KVL + 8 * h8;
#pragma unroll
                for (int s_ = 0; s_ < 16; ++s_) { const bf16x8 a_ = *(const LAS bf16x8*)(ol + l31 * OLP + 16 * s_ + 8 * h8); const bf16x8 b_ = *(const bf16x8*)(bp + 16 * s_); acc = MFMA32(a_, b_, acc); }
#pragma unroll
                for (int i = 0; i < 16; ++i) CATb[((size_t)NP + 32 * rb + crow(i, h8)) * CATLD + 1024 + head * DVH + 32 * wave + l31] = f2bf(acc[i]);
            }
        }
        {
            f32x4 a[4]; u32x2_t gz[4];
#define P6_LOAD(r_, A_, B_) do { _Pragma("unroll") for (int j_ = 0; j_ < 4; ++j_) { A_[j_] = *(const f32x4*)(ORET + (size_t)(r_) * 1024 + 4 * lane + 256 * j_); \
                                                                              B_[j_] = *(const u32x2_t*)(SRGb + (size_t)(r_) * 1024 + 4 * lane + 256 * j_); } } while (0)
            int row = gw;
            if (row < NT) P6_LOAD(row, a, gz);
            for (; row < NT; row += NGW) {
                f32x4 an[4]; u32x2_t gn[4]; const int nr = row + NGW;
                if (nr < NT) P6_LOAD(nr, an, gn);
#pragma unroll
                for (int j = 0; j < 4; ++j) {
                    const float ss = wave_sum(a[j][0] * a[j][0] + a[j][1] * a[j][1] + a[j][2] * a[j][2] + a[j][3] * a[j][3]);
                    const float r = rsqrtf(ss * (1.f / RDV) + EPS);
                    float o_[4];
#pragma unroll
                    for (int e = 0; e < 4; ++e) { const unsigned gw_ = e < 2 ? gz[j].x : gz[j].y; o_[e] = __builtin_bit_cast(float, (e & 1) ? (gw_ & 0xffff0000u) : (gw_ << 16)) * a[j][e] * r; }
                    *(u32x2_t*)(CATb + (size_t)row * CATLD + 4 * lane + 256 * j) = (u32x2_t){cvtpk(o_[0], o_[1]), cvtpk(o_[2], o_[3])};
                }
#pragma unroll
                for (int j = 0; j < 4; ++j) { a[j] = an[j]; gz[j] = gn[j]; }
            }
#undef P6_LOAD
        }
    }
    SEAM(6);
    if (IN(7)) {
        { pg8::StaticOrder S; S.init(NP, 1024, G, bid); pg8::Gemm g{CATb, WcatT, NP, 1024, CATLD, CATLD, CATLD}; pg8::EpiGate3 E{SGb, MIXb, 1024, 16, 32};
          pg8::gemm_phase<pg8::EpiGate3, pg8::StaticOrder, true, true>(ldsb, g, S, E); }
        __syncthreads();
        { pg8::Gemm g{CATb, WcatT, NT, 1024, 256, CATLD, CATLD, 256}; pg8::SplitOrder SS{9, bid}; pg8::EpiPart E{PART}; GEMM_SPLIT(ldsb, g, SS, E); }
    }
    SEAM(7);
    if (IN(8)) { PHASE_IDS
        for (int i = bid * NTHREADS + tid; i < NS * 256; i += G * NTHREADS) { const int r = i >> 8, c4 = (i & 255) * 4; const size_t o_ = (size_t)r * 1024 + c4;
            f32x4 mix = {0.f, 0.f, 0.f, 0.f};
#pragma unroll
            for (int br = 0; br < 3; ++br) { f32x4 a = *(const f32x4*)(PART + (size_t)(br == 2 ? 8 : 4 * br) * (512 * 1024) + o_);
                if (br < 2) {
#pragma unroll
                    for (int k_ = 1; k_ < 4; ++k_) a += *(const f32x4*)(PART + (size_t)(4 * br + k_) * (512 * 1024) + o_); }
                const u32x2_t gq = *(const u32x2_t*)(SGb + (size_t)(NP + r) * 3072 + br * 1024 + c4);
                mix[0] += a[0] * __builtin_bit_cast(float, gq.x << 16); mix[1] += a[1] * __builtin_bit_cast(float, gq.x & 0xffff0000u);
                mix[2] += a[2] * __builtin_bit_cast(float, gq.y << 16); mix[3] += a[3] * __builtin_bit_cast(float, gq.y & 0xffff0000u); }
            *(u32x2_t*)(MIXb + (size_t)(NP + r) * 1024 + c4) = (u32x2_t){cvtpk(mix[0], mix[1]), cvtpk(mix[2], mix[3])}; }
    }
    SEAM(8);
    if (IN(9)) { pg8::Gemm g{MIXb, WoT, NP, 1024, 1024, 1024, 1024}; pg8::StaticOrder S; S.init(NP, 1024, G, bid); pg8::EpiBf16S E{HPb, 1024};
        GEMM_PHASE(pg8::EpiBf16S, ldsb, g, S, E);
        __syncthreads();
        { pg8::Gemm g2{MIXb, WoT, NT, 1024, 256, 1024, 1024, 256}; pg8::SplitOrder SS{4, bid}; pg8::EpiPart E2{PART}; GEMM_SPLIT(ldsb, g2, SS, E2); } }
    SEAM(9);
    if (IN(10)) { PHASE_IDS
        f32x4 gp[4], gf[4], a[4], b[4];
#pragma unroll
        for (int j = 0; j < 4; ++j) { gp[j] = *(const f32x4*)(g_mix_post + 4 * lane + 256 * j); gf[j] = *(const f32x4*)(g_ffn_pre + 4 * lane + 256 * j); }
#define P10_LOAD(r_, A_, B_) do { const float* xr_ = (r_) < NP ? x_prompt + (size_t)(r_) * DM : x_sample + (size_t)((r_) - NP) * DM; \
        _Pragma("unroll") for (int j_ = 0; j_ < 4; ++j_) { B_[j_] = *(const f32x4*)(xr_ + 4 * lane + 256 * j_); \
            if ((r_) < NP) { const u32x2_t h_ = *(const u32x2_t*)(HPb + (size_t)(r_) * DM + 4 * lane + 256 * j_); A_[j_] = bf4_to_f32(h_.x, h_.y); } \
            else { const float* p_ = PART + (size_t)((r_) - NP) * DM + 4 * lane + 256 * j_; A_[j_] = (*(const f32x4*)p_ + *(const f32x4*)(p_ + 512 * 1024)) + (*(const f32x4*)(p_ + 2 * 512 * 1024) + *(const f32x4*)(p_ + 3 * 512 * 1024)); } } } while (0)
        int row = gw;
        if (row < NT) P10_LOAD(row, a, b);
        for (; row < NT; row += NGW) {
            f32x4 an[4], bn[4]; const int nr = row + NGW;
            if (nr < NT) P10_LOAD(nr, an, bn);
            float ss = 0.f;
#pragma unroll
            for (int j = 0; j < 4; ++j) ss += a[j][0] * a[j][0] + a[j][1] * a[j][1] + a[j][2] * a[j][2] + a[j][3] * a[j][3];
            float r = rsqrtf(wave_sum(ss) * (1.f / DM) + EPS); ss = 0.f;
#pragma unroll
            for (int j = 0; j < 4; ++j) { a[j] = b[j] + a[j] * r * gp[j]; *(u32x2_t*)(Hb + (size_t)row * DM + 4 * lane + 256 * j) = (u32x2_t){cvtpk(a[j][0], a[j][1]), cvtpk(a[j][2], a[j][3])};
                ss += a[j][0] * a[j][0] + a[j][1] * a[j][1] + a[j][2] * a[j][2] + a[j][3] * a[j][3]; }
            r = rsqrtf(wave_sum(ss) * (1.f / DM) + EPS);
#pragma unroll
            for (int j = 0; j < 4; ++j) { const f32x4 f_ = a[j] * r * gf[j]; *(u32x2_t*)(Fb + (size_t)row * DM + 4 * lane + 256 * j) = (u32x2_t){cvtpk(f_[0], f_[1]), cvtpk(f_[2], f_[3])}; }
#pragma unroll
            for (int j = 0; j < 4; ++j) { a[j] = an[j]; b[j] = bn[j]; }
        }
#undef P10_LOAD
    }
    SEAM(10);
    if (IN(11)) {
        pg8::Gemm g{Fb, WguT, NT, 2 * DFF, 1024, 1024, 1024}; pg8::StaticOrder S; S.init(NT, 2 * DFF, G, bid); pg8::EpiSwiGLU E{ACTb, DFF};
        GEMM_PHASE(pg8::EpiSwiGLU, ldsb, g, S, E);
    }
    SEAM(11);
    if (IN(13)) { pg8::Gemm g{ACTb, WdT, NP, 1024, DFF, DFF, DFF}; pg8::StaticOrder S; S.init(NP, 1024, G, bid); pg8::EpiBf16S E{FOb, 1024};
        GEMM_PHASE(pg8::EpiBf16S, ldsb, g, S, E);
        __syncthreads();
        { pg8::Gemm g2{ACTb, WdT, NT, 1024, 256, DFF, DFF, 256}; pg8::SplitOrder SS{11, bid}; pg8::EpiPart E2{PART}; GEMM_SPLIT(ldsb, g2, SS, E2); } }
    SEAM(13);
    if (IN(14)) { PHASE_IDS
        f32x4 gp[4], a[4], b[4];
#pragma unroll
        for (int j = 0; j < 4; ++j) gp[j] = *(const f32x4*)(g_ffn_post + 4 * lane + 256 * j);
#define P14_LOAD(r_, A_, B_) do { _Pragma("unroll") for (int j_ = 0; j_ < 4; ++j_) { { const u32x2_t h_ = *(const u32x2_t*)(Hb + (size_t)(r_) * DM + 4 * lane + 256 * j_); B_[j_] = bf4_to_f32(h_.x, h_.y); } \
            if ((r_) < NP) { const u32x2_t f_ = *(const u32x2_t*)(FOb + (size_t)(r_) * DM + 4 * lane + 256 * j_); A_[j_] = bf4_to_f32(f_.x, f_.y); } \
            else { const float* p_ = PART + (size_t)((r_) - NP) * DM + 4 * lane + 256 * j_; f32x4 a_ = *(const f32x4*)p_; \
                _Pragma("unroll") for (int k_ = 1; k_ < 11; ++k_) a_ += *(const f32x4*)(p_ + (size_t)k_ * 512 * 1024); A_[j_] = a_; } } } while (0)
        int row = gw;
        if (row < NT) P14_LOAD(row, a, b);
        for (; row < NT; row += NGW) {
            f32x4 an[4], bn[4]; const int nr = row + NGW;
            if (nr < NT) P14_LOAD(nr, an, bn);
            float ss = 0.f;
#pragma unroll
            for (int j = 0; j < 4; ++j) ss += a[j][0] * a[j][0] + a[j][1] * a[j][1] + a[j][2] * a[j][2] + a[j][3] * a[j][3];
            const float r = rsqrtf(wave_sum(ss) * (1.f / DM) + EPS);
            float* y = row < NP ? out + O_YP + (size_t)row * DM : out + O_YS + (size_t)(row - NP) * DM;
#pragma unroll
            for (int j = 0; j < 4; ++j) *(f32x4*)(y + 4 * lane + 256 * j) = b[j] + a[j] * r * gp[j];
#pragma unroll
            for (int j = 0; j < 4; ++j) { a[j] = an[j]; b[j] = bn[j]; }
        }
#undef P14_LOAD
    }
#undef IN
#undef SEAM
#undef PHASE_IDS
}
#undef x_prompt
#undef x_sample
#undef mem_prompt
#undef cache_ckv
#undef cache_kpe
#undef page_table
#undef state_ret
#undef cache_mem_k
#undef cache_mem_v
#undef g_mix_pre
#undef g_mix_post
#undef g_ffn_pre
#undef g_ffn_post
#undef g_mem
#undef g_qlat
#undef g_kvlat
#undef w_in
#undef w_uq
#undef w_uk
#undef w_uv
#undef w_mem_k
#undef w_mem_v
#undef w_ret_o
#undef w_mla_o
#undef w_x_o
#undef w_out
#undef w_gate
#undef w_up
#undef w_down
#undef COSA
#undef SINA
#undef COSB
#undef SINB
#undef U
#undef MN
#undef Zb
#undef RQ
#undef RK
#undef CQN
#undef CKVN
#undef KPER
#undef Q
#undef QLAT
#undef QPE
#undef ORET
#undef OLAT
#undef OX
#undef OMLA
#undef ORETN
#undef ARET
#undef AMLA
#undef AX
#undef MIX
#undef HPb
#undef Hb
#undef F
#undef GU
#undef FOb
#undef WinT
#undef WmkvT
#undef WuqT
#undef WcatT
#undef CATb
#undef WroT
#undef WmoT
#undef WxoT
#undef WoT
#undef WguT
#undef WdT
#undef Ub
#undef MNb
#undef CQNb
#undef ORETNb
#undef OMLAb
#undef OXb
#undef MIXb
#undef Fb
#undef ACTb
#undef WukT
#undef WuvT
#undef CKVNb
#undef KPERb
#undef XQb
#undef MKb
#undef MVT
#undef KN
#undef VT
#undef Qb
#undef RQt
#undef RKt
#undef RKtT
#undef RVT
#undef UT
#undef SPT
#undef QPEb
#undef WukB
#undef PART
#undef SGb
#undef SRGb
#undef T0b
#undef T1b
#undef QLATb
#undef PO
#undef PML
constexpr int N_PHASES = 15;
}

extern "C" void kernel_launch(void* const* d_in, const int* in_sizes, int n_in, void* d_out, int out_size, void* d_ws, size_t ws_size, hipStream_t stream) {
    static int grid = 0;
    if (grid == 0) {
        if (n_in != 29 || (size_t)out_size != O_END || ws_size < WS_END) { fprintf(stderr, "kernel_launch: unexpected shapes: n_in %d out %d ws %zu (need %zu)\n", n_in, out_size, ws_size, (size_t)WS_END); grid = -1; return; }
        int dev = 0, cus = 0, per_cu = 0;
        if (hipGetDevice(&dev) != hipSuccess || hipDeviceGetAttribute(&cus, hipDeviceAttributeMultiprocessorCount, dev) != hipSuccess) { grid = -1; return; }
        if (hipFuncSetAttribute((const void*)fwd_kernel, hipFuncAttributeMaxDynamicSharedMemorySize, LDS_BYTES) != hipSuccess) { fprintf(stderr, "kernel_launch: hipFuncSetAttribute failed\n"); grid = -1; return; }
        if (hipOccupancyMaxActiveBlocksPerMultiprocessor(&per_cu, (const void*)fwd_kernel, NTHREADS, LDS_BYTES) != hipSuccess || per_cu < 1) { fprintf(stderr, "kernel_launch: occupancy query says %d\n", per_cu); per_cu = 1; }
        (void)hipGetLastError();
        grid = cus;
    }
    if (grid < 0) return;
    (void)hipMemsetAsync((char*)d_ws + WS_CTL, 0, CTL_BYTES, stream);
    Args a{};
    for (int i = 0; i < 29; ++i) a.in[i] = (const float*)d_in[i];
    a.out = (float*)d_out; a.ws = (unsigned char*)d_ws;
#if MK_ONE_LAUNCH
    a.ph_lo = 0; a.ph_hi = N_PHASES; a.sub = 0xff;
    hipLaunchKernelGGL(fwd_kernel, dim3(grid), dim3(NTHREADS), LDS_BYTES, stream, a);
#if PROBE_DUP >= 0
    a.ph_lo = PROBE_DUP; a.ph_hi = PROBE_DUP + 1; a.sub = PROBE_SUB;
    hipLaunchKernelGGL(fwd_kernel, dim3(grid), dim3(NTHREADS), LDS_BYTES, stream, a);
#endif
#else
    a.sub = 0xff; for (int p = 0; p < N_PHASES; ++p) { a.ph_lo = p; a.ph_hi = p + 1; hipLaunchKernelGGL(fwd_kernel, dim3(grid), dim3(NTHREADS), LDS_BYTES, stream, a); }
#endif
}
```

```cpp
#include <hip/hip_runtime.h>
#include <cstdio>
#include <cstdint>

#ifndef PROBE_DUP
#define PROBE_DUP -1
#endif
#ifndef PROBE_SUB
#define PROBE_SUB 0xff
#endif
#ifndef MK_ONE_LAUNCH
#define MK_ONE_LAUNCH 1
#endif

#define LAS __attribute__((address_space(3)))
#define GAS __attribute__((address_space(1)))
#define DI __device__ __forceinline__
typedef float f32x4 __attribute__((ext_vector_type(4)));
typedef __bf16 bf16x2_t __attribute__((ext_vector_type(2)));
typedef float f32x2_t __attribute__((ext_vector_type(2)));
DI unsigned cvtpk(float lo, float hi) { f32x2_t v = {lo, hi}; bf16x2_t b = __builtin_convertvector(v, bf16x2_t); return __builtin_bit_cast(unsigned, b); }

namespace {
constexpr int DM = 1024, NB = 8, SEQ = 2048, NP = NB * SEQ, DB = 128, DS = 4, NS = DB * DS, NT = NP + NS;
constexpr int PAST = 8192, PAGE = 128, NPAGES = PAST / PAGE;
constexpr int RH = 4, RDK = 128, RDV = 256;
constexpr int MH = 8, QL = 384, KVL = 256, DNOPE = 128, DROPE = 64, DVH = 128, DQH = DNOPE + DROPE;
constexpr int NMEM = 256, XH = 4, XHD = 64;
constexpr int DFF = 2816, DIN = 7104, ZLD = 7168;
constexpr int C_RQ = 0, C_RK = 512, C_RV = 1024, C_RG = 2048, C_CQ = 3072, C_CKV = 3456, C_KPE = 3712, C_XQ = 3776, C_G = 4032;
constexpr float EPS = 1e-6f;
constexpr int NPOS = SEQ + DS;
constexpr int NTHREADS = 512, NWAVES = 8;
constexpr int LDS_BYTES = 147456;
constexpr int MISC_OFF = 147456 - 256;

constexpr size_t O_YP = 0, O_YS = O_YP + (size_t)NP * DM, O_CKVP = O_YS + (size_t)NS * DM, O_KPEP = O_CKVP + (size_t)NP * KVL,
                 O_CKVS = O_KPEP + (size_t)NP * DROPE, O_KPES = O_CKVS + (size_t)NS * KVL, O_RETP = O_KPES + (size_t)NS * DROPE,
                 O_RETS = O_RETP + (size_t)NB * RH * RDK * RDV, O_MKP = O_RETS + (size_t)DB * RH * RDK * RDV, O_MVP = O_MKP + (size_t)NB * NMEM * 256,
                 O_END = O_MVP + (size_t)NB * NMEM * 256;

constexpr size_t al256(size_t x) { return (x + 255) & ~(size_t)255; }
constexpr size_t WS_CTL = 0, CTL_BYTES = 1u << 20;
constexpr size_t WS_COSA = WS_CTL + CTL_BYTES;
constexpr size_t WS_SINA = WS_COSA + al256((size_t)NPOS * 64 * 4);
constexpr size_t WS_COSB = WS_SINA + al256((size_t)NPOS * 64 * 4);
constexpr size_t WS_SINB = WS_COSB + al256((size_t)NPOS * 32 * 4);
constexpr size_t WS_U = WS_SINB + al256((size_t)NPOS * 32 * 4);
constexpr size_t WS_MN = WS_U + (size_t)NT * DM * 4;
constexpr size_t WS_Z = WS_MN + (size_t)NB * NMEM * DM * 4;
constexpr size_t WS_RQ = WS_Z + (size_t)NT * ZLD * 4;
constexpr size_t WS_RK = WS_RQ + (size_t)NT * 512 * 4;
constexpr size_t WS_CQN = WS_RK + (size_t)NT * 512 * 4;
constexpr size_t WS_CKVN = WS_CQN + (size_t)NT * QL * 4;
constexpr size_t WS_KPER = WS_CKVN + (size_t)NT * KVL * 4;
constexpr size_t WS_Q = WS_KPER + (size_t)NT * DROPE * 4;
constexpr size_t WS_QLAT = WS_Q + (size_t)NT * 1536 * 4;
constexpr size_t WS_QPE = WS_QLAT + (size_t)NT * 2048 * 4;
constexpr size_t WS_ORET = WS_QPE + (size_t)NT * 512 * 4;
constexpr size_t WS_OLAT = WS_ORET + (size_t)NT * 1024 * 4;
constexpr size_t WS_OX = WS_OLAT + (size_t)NT * 2048 * 4;
constexpr size_t WS_OMLA = WS_OX + (size_t)NT * 256 * 4;
constexpr size_t WS_ORETN = WS_OMLA + (size_t)NT * 1024 * 4;
constexpr size_t WS_ARET = WS_ORETN + (size_t)NT * 1024 * 4;
constexpr size_t WS_AMLA = WS_ARET + (size_t)NT * 1024 * 4;
constexpr size_t WS_AX = WS_AMLA + (size_t)NT * 1024 * 4;
constexpr size_t WS_MIX = WS_AX + (size_t)NT * 1024 * 4;
constexpr size_t WS_HP = WS_MIX + (size_t)NT * 1024 * 4;
constexpr size_t WS_H = WS_HP + (size_t)NT * 1024 * 4;
constexpr size_t WS_F = WS_H + (size_t)NT * 1024 * 4;
constexpr size_t WS_GG = WS_F + (size_t)NT * 1024 * 4;
constexpr size_t WS_UP = WS_GG + (size_t)NT * DFF * 4;
constexpr size_t WS_ACT = WS_UP + (size_t)NT * DFF * 4;
constexpr size_t WS_FO = WS_ACT + (size_t)NT * DFF * 4;
constexpr size_t WS_F32_END = WS_FO + (size_t)NT * 1024 * 4;
constexpr size_t WS_WIN_T = al256(WS_F32_END);
constexpr size_t WS_WMKV_T = WS_WIN_T + (size_t)ZLD * 1024 * 2;
constexpr size_t WS_WUQ_T = WS_WMKV_T + (size_t)512 * 1024 * 2;
constexpr size_t WS_WRO_T = WS_WUQ_T + (size_t)1536 * 384 * 2;
constexpr size_t WS_WMO_T = WS_WRO_T + (size_t)1024 * 1024 * 2;
constexpr size_t WS_WXO_T = WS_WMO_T + (size_t)1024 * 1024 * 2;
constexpr size_t WS_WO_T = WS_WXO_T + (size_t)1024 * 256 * 2;
constexpr size_t WS_WGU_T = WS_WO_T + (size_t)1024 * 1024 * 2;
constexpr size_t WS_WD_T = WS_WGU_T + (size_t)5632 * 1024 * 2;
constexpr size_t WS_UB = WS_WD_T + (size_t)1024 * 2816 * 2;
constexpr size_t WS_MNB = WS_UB + (size_t)NT * 1024 * 2;
constexpr size_t WS_CQNB = WS_MNB + (size_t)2048 * 1024 * 2;
constexpr size_t WS_ORETNB = WS_CQNB + (size_t)NT * 384 * 2;
constexpr size_t WS_OMLAB = WS_ORETNB + (size_t)NT * 1024 * 2;
constexpr size_t WS_OXB = WS_OMLAB + (size_t)NT * 1024 * 2;
constexpr size_t WS_MIXB = WS_OXB + (size_t)NT * 256 * 2;
constexpr size_t WS_FB = WS_MIXB + (size_t)NT * 1024 * 2;
constexpr size_t WS_ACTB = WS_FB + (size_t)NT * 1024 * 2;
constexpr size_t WS_WUK_T = WS_ACTB + (size_t)NT * 2816 * 2;
constexpr size_t WS_WUV_T = WS_WUK_T + (size_t)1024 * 256 * 2;
constexpr size_t WS_CKVNB = WS_WUV_T + (size_t)1024 * 256 * 2;
constexpr size_t WS_KPERB = WS_CKVNB + (size_t)NT * 256 * 2;
constexpr size_t WS_XQB = WS_KPERB + (size_t)NT * 64 * 2;
constexpr size_t WS_MKB = WS_XQB + (size_t)NT * 256 * 2;
constexpr size_t WS_MVT = WS_MKB + (size_t)2048 * 256 * 2;
constexpr size_t WS_KN = WS_MVT + (size_t)2048 * 256 * 2;
constexpr size_t WS_VT = WS_KN + (size_t)NP * 1024 * 2;
constexpr size_t WS_QB = WS_VT + (size_t)NP * 1024 * 2;
constexpr size_t WS_RQT = WS_QB + (size_t)NT * 1536 * 2;
constexpr size_t WS_RKT = WS_RQT + (size_t)NP * 512 * 2;
constexpr size_t WS_RKTT = WS_RKT + (size_t)NP * 512 * 2;
constexpr size_t WS_RVT = WS_RKTT + (size_t)NP * 512 * 2;
constexpr size_t WS_UT = WS_RVT + (size_t)NT * 1024 * 2;
constexpr size_t WS_SPT = WS_UT + (size_t)512 * 32768 * 4;
constexpr size_t WS_QLATB = WS_SPT + (size_t)512 * 32768 * 2;
constexpr size_t WS_PO = WS_QLATB + (size_t)NS * 2048 * 2;
constexpr size_t WS_PML = WS_PO + (size_t)DB * 2 * 32 * 256 * 4;
constexpr size_t WS_PART = al256(WS_PML + (size_t)DB * 2 * 32 * 2 * 4);
constexpr size_t WS_QPEB_ = WS_PART + (size_t)11 * 512 * 1024 * 4;
constexpr size_t WS_QPEB = al256(WS_QPEB_ + 0 * WS_PML + (size_t)DB * 2 * 32 * 2 * 4);
constexpr size_t WS_SGB = WS_QPEB + (size_t)NT * 512 * 2;
constexpr size_t WS_SRGB = WS_SGB + (size_t)NT * 3072 * 2;
constexpr size_t WS_T0B = WS_SRGB + (size_t)NT * 1024 * 2;
constexpr size_t WS_T1B = WS_T0B + (size_t)NT * 1024 * 2;
constexpr size_t WS_WUKB = WS_T1B + (size_t)NT * 1024 * 2;
constexpr size_t WS_END = WS_WUKB + (size_t)8 * 256 * 128 * 2;

static_assert(WS_OMLAB == WS_ORETNB + (size_t)NT * 1024 * 2 && WS_OXB == WS_OMLAB + (size_t)NT * 1024 * 2 && WS_MIXB == WS_OXB + (size_t)NT * 256 * 2, "CATb = [o_ret_n | o_mla | o_x] rows of 2304");
static_assert(WS_WMO_T == WS_WRO_T + (size_t)1024 * 1024 * 2 && WS_WXO_T == WS_WMO_T + (size_t)1024 * 1024 * 2 && WS_WO_T == WS_WXO_T + (size_t)1024 * 256 * 2, "WcatT = [w_ret_o | w_mla_o | w_x_o]^T rows of 2304");
constexpr int CATLD = 2304;
constexpr int CW_BAR = 4096;

#define XB_TMO      128
#define XB_XCNT(j)  (256  + 64 * (j))
#define XB_XSUB(j)  (1280 + 64 * (j))
#define XB_XGEN(j)  (2304 + 64 * (j))
#define XB_TOP      3328
#define XB_TOPGEN   3392
#define XCD_BAR_WORDS 3456
#define XB_SPIN_CAP (1u << 25)

DI unsigned xb_ld(unsigned* p)              { return __hip_atomic_load(p, __ATOMIC_RELAXED, __HIP_MEMORY_SCOPE_AGENT); }
DI unsigned xb_add(unsigned* p, unsigned v) { return __hip_atomic_fetch_add(p, v, __ATOMIC_RELAXED, __HIP_MEMORY_SCOPE_AGENT); }
DI unsigned xb_xcc_id() { return (unsigned)__builtin_amdgcn_s_getreg((3 << 11) | 20) & 0xFu; }
#define XB_SPIN(cond, bar) do { unsigned _sp = 0; while (cond) { __builtin_amdgcn_s_sleep(1); \
    if ((++_sp & 255u) == 0u) { if (xb_ld(&(bar)[XB_TMO])) break; if (_sp > XB_SPIN_CAP) { atomicAdd(&(bar)[XB_TMO], 1u); break; } } } } while (0)

struct XcdBarrier { unsigned* bar; unsigned x; volatile LAS unsigned* st; };

DI XcdBarrier xcd_barrier_post(unsigned* bar, volatile LAS unsigned* st) {
    XcdBarrier b; b.bar = bar; b.x = xb_xcc_id(); b.st = st;
    if (threadIdx.x == 0) (void)xb_add(&bar[XB_XCNT(b.x)], 1u);
    return b;
}
DI void xcd_barrier_complete(unsigned* bar, unsigned x, unsigned& nloc, unsigned& nx) {
    const unsigned G = gridDim.x * gridDim.y * gridDim.z;
    unsigned sum, cnt, mine, sp = 0u;
    for (;;) {
        sum = 0u; cnt = 0u; mine = 0u;
#pragma unroll
        for (unsigned j = 0; j < 16; ++j) { const unsigned c = xb_ld(&bar[XB_XCNT(j)]); sum += c; cnt += (c > 0u) ? 1u : 0u; mine = (j == x) ? c : mine; }
        if (sum == G) break;
        __builtin_amdgcn_s_sleep(1);
        if ((++sp & 255u) == 0u) { if (xb_ld(&bar[XB_TMO])) break; if (sp > XB_SPIN_CAP) { atomicAdd(&bar[XB_TMO], 1u); break; } }
    }
    nloc = mine > 0u ? mine : 1u; nx = cnt > 0u ? cnt : 1u;
}
DI void xcd_barrier(const XcdBarrier& b) {
    asm volatile("s_waitcnt vmcnt(0)" ::: "memory");
    __syncthreads();
    if (threadIdx.x == 0) {
        unsigned* bar = b.bar;
        __builtin_amdgcn_s_waitcnt(0);
        unsigned nloc = b.st[0], nx = b.st[1];
        if (nloc == 0u) { xcd_barrier_complete(bar, b.x, nloc, nx); b.st[0] = nloc; b.st[1] = nx; }
        const unsigned old = xb_add(&bar[XB_XSUB(b.x)], 1u);
        const unsigned gen = old / nloc;
        if (old + 1u == (gen + 1u) * nloc) {
            __builtin_amdgcn_fence(__ATOMIC_RELEASE, "agent");
            asm volatile("s_waitcnt vmcnt(0)" ::: "memory");
            const unsigned og = xb_add(&bar[XB_TOP], 1u);
            const unsigned tg = og / nx;
            if (og + 1u == (tg + 1u) * nx) xb_add(&bar[XB_TOPGEN], 1u);
            else XB_SPIN(xb_ld(&bar[XB_TOPGEN]) == tg, bar);
            __builtin_amdgcn_fence(__ATOMIC_ACQUIRE, "agent");
            xb_add(&bar[XB_XGEN(b.x)], 1u);
            asm volatile("s_waitcnt vmcnt(0)" ::: "memory");
        } else {
            XB_SPIN(xb_ld(&bar[XB_XGEN(b.x)]) == gen, bar);
            __builtin_amdgcn_fence(__ATOMIC_ACQUIRE, "agent");
            asm volatile("s_waitcnt vmcnt(0)" ::: "memory");
        }
    }
    __syncthreads();
}

DI float wave_sum(float v) {
#pragma unroll
    for (int o = 1; o < 64; o <<= 1) v += __shfl_xor(v, o);
    return v;
}
DI float wave_max(float v) {
#pragma unroll
    for (int o = 1; o < 64; o <<= 1) v = fmaxf(v, __shfl_xor(v, o));
    return v;
}
DI float sigmoidf_(float x) { return 1.f / (1.f + expf(-x)); }
DI float siluf_(float x) { return x / (1.f + expf(-x)); }
DI f32x4 bf4_to_f32(unsigned lo, unsigned hi) { return (f32x4){__builtin_bit_cast(float, lo << 16), __builtin_bit_cast(float, lo & 0xffff0000u), __builtin_bit_cast(float, hi << 16), __builtin_bit_cast(float, hi & 0xffff0000u)}; }
DI int pos_index(int row) { return row < NP ? (row & (SEQ - 1)) : SEQ + ((row - NP) & (DS - 1)); }
DI float lg_gamma(int h) { return h == 0 ? -0.03174869831458027f : h == 1 ? -0.015748356968139112f : h == 2 ? -0.007843177461025892f : -0.003913899321136329f; }


namespace pg8 {
typedef unsigned short bf16_t;
typedef short bf16x8 __attribute__((ext_vector_type(8)));
typedef unsigned u32x4 __attribute__((ext_vector_type(4)));
typedef unsigned u32x2 __attribute__((ext_vector_type(2)));
constexpr int BM = 256, BK = 64, HALF = 128, HTB = HALF * BK * 2, STAGE_BYTES = 8 * HTB, NXCD = 8, WGM = 8;
__host__ __device__ __forceinline__ int lds_byte(int r, int c) { const int st = (r >> 4) * 2 + (c >> 5), rr = r & 15, cc = c & 31, ob = rr * 64 + cc * 2; return st * 1024 + (ob ^ (((ob >> 9) & 1) << 5)); }
__host__ __device__ __forceinline__ void stage_rc(int b, int& R, int& C) { const int st = b / 1024, sb = b % 1024, swz = sb ^ (((sb >> 9) & 1) << 5); R = (st >> 1) * 16 + swz / 64; C = (st & 1) * 32 + (swz % 64) / 2; }
__host__ __device__ __forceinline__ int perm32(int rho) { const int n = rho >> 4, i = rho & 15; return 8 * (i >> 2) + 4 * n + (i & 3); }
struct Unit { int pm, pn, ks; };
struct Gemm { const bf16_t* A; const bf16_t* Bt; int M, N, K, lda, ldb, ksl; };
struct StaticOrder {
    int nM, nN, nwg, G, c;
    __host__ __device__ void init(int M, int N, int G_, int c_) { nM = M / BM; nN = N / BM; nwg = nM * nN; G = G_; c = c_; }
    __host__ __device__ bool next(int i, Unit& u) const {
        const long L = (long)i * G + c; if (L >= nwg) return false;
        int wgid = (int)L; { const int q = nwg / NXCD, r = nwg % NXCD, xcd = wgid % NXCD, off = wgid / NXCD; wgid = (xcd < r ? xcd * (q + 1) : r * (q + 1) + (xcd - r) * q) + off; }
        const int nig = WGM * nN, gid = wgid / nig, fm = gid * WGM, gsz = (nM - fm) < WGM ? (nM - fm) : WGM;
        u.pm = fm + ((wgid % nig) % gsz); u.pn = (wgid % nig) / gsz; u.ks = 0; return true;
    }
    __device__ __forceinline__ void a_ready(const Unit&) const {}
    __device__ __forceinline__ void done(const Unit&) const {}
};
__device__ __forceinline__ unsigned cvt_pk_bf16(float lo, float hi) { return cvtpk(lo, hi); }
struct SplitOrder {
    int KS, c;
    __host__ __device__ bool next(int i, Unit& u) const { if (i != 0 || c >= 8 * KS) return false; const int tile = c / KS; u.ks = c % KS; u.pm = 64 + (tile >> 2); u.pn = tile & 3; return true; }
    __device__ __forceinline__ void a_ready(const Unit&) const {}
    __device__ __forceinline__ void done(const Unit&) const {}
};
struct EpiPart {
    static constexpr bool PERM = false, AFTER_DRAIN = false, HAS_MID = false;
    float* C;
    __device__ __forceinline__ void operator()(const f32x4 (&acc)[2][2][4][2], const Unit& u, int wr, int wc, int fr, int fq) const {
        const int row0 = (u.pm - 64) * BM + wr * 64 + fr, col0 = u.pn * BM + wc * 32 + 4 * fq; float* base = C + (size_t)u.ks * (512 * 1024);
#pragma unroll
        for (int ai = 0; ai < 2; ++ai)
#pragma unroll
            for (int m = 0; m < 4; ++m) { float* rowp = base + (size_t)(row0 + ai * HALF + m * 16) * 1024 + col0;
#pragma unroll
                for (int bj = 0; bj < 2; ++bj)
#pragma unroll
                    for (int n = 0; n < 2; ++n) *(f32x4*)(rowp + bj * HALF + n * 16) = acc[ai][bj][m][n]; }
    }
};
struct P1Order {
    StaticOrder so;
    __host__ __device__ void init(int G_, int c_) { so.init(64 * 256, 24 * 256, G_, c_); }
    __host__ __device__ bool next(int i, Unit& u) const {
        const long L = (long)i * so.G + so.c;
        if (L < 1536) { so.next(i, u); if (u.pn >= 4) u.pn += 4; return true; }
        u.ks = 0;
        if (L < 1536 + 56) { const int idx = (int)L - 1536; u.pm = 64 + idx / 28; u.pn = idx % 28; return true; }
        if (L < 1536 + 56 + 16) { const int idx = (int)L - 1592; u.pm = 66 + idx / 2; u.pn = 28 + idx % 2; return true; }
        return false;
    }
    __device__ __forceinline__ void a_ready(const Unit&) const {}
    __device__ __forceinline__ void done(const Unit&) const {}
};
struct EpiP1 {
    static constexpr bool PERM = true, AFTER_DRAIN = false, HAS_MID = false;
    bf16_t* Zp; int ldz; float* mk; float* mv; bf16_t* srg; bf16_t* sg; int c_rg, c_g;
    __device__ __forceinline__ void operator()(const f32x4 (&acc)[2][2][4][2], const Unit& u, int wr, int wc, int fr, int fq) const {
        if (u.pm >= 66) {
            float* base = (u.pn == 28) ? mk : mv; const int row0 = (u.pm - 66) * BM + wr * 64 + fr, col0 = wc * 32 + 8 * fq;
#pragma unroll
            for (int ai = 0; ai < 2; ++ai)
#pragma unroll
                for (int m = 0; m < 4; ++m) { float* rowp = base + (size_t)(row0 + ai * HALF + m * 16) * 256 + col0;
#pragma unroll
                    for (int bj = 0; bj < 2; ++bj) { *(f32x4*)(rowp + bj * HALF) = acc[ai][bj][m][0]; *(f32x4*)(rowp + bj * HALF + 4) = acc[ai][bj][m][1]; } }
            return;
        }
        const int row0 = u.pm * BM + wr * 64 + fr, col0 = u.pn * BM + wc * 32 + 8 * fq;
#pragma unroll
        for (int bj = 0; bj < 2; ++bj) { const int c = col0 + bj * HALF;
            if (c >= c_g + 3072) continue;
            const int kind = c >= c_g ? 2 : (c >= c_rg && c < c_rg + 1024) ? 1 : 0;
            bf16_t* dst = kind == 2 ? sg + (c - c_g) : kind == 1 ? srg + (c - c_rg) : Zp + c; const int ld = kind == 2 ? 3072 : kind == 1 ? 1024 : ldz;
#pragma unroll
            for (int ai = 0; ai < 2; ++ai)
#pragma unroll
                for (int m = 0; m < 4; ++m) { f32x4 v0 = acc[ai][bj][m][0], v1 = acc[ai][bj][m][1];
                    if (kind) {
#pragma unroll
                        for (int e = 0; e < 4; ++e) { const float s0 = 1.f / (1.f + __expf(-v0[e])), s1 = 1.f / (1.f + __expf(-v1[e])); v0[e] = kind == 2 ? s0 : v0[e] * s0; v1[e] = kind == 2 ? s1 : v1[e] * s1; } }
                    u32x4 w; w.x = cvt_pk_bf16(v0[0], v0[1]); w.y = cvt_pk_bf16(v0[2], v0[3]); w.z = cvt_pk_bf16(v1[0], v1[1]); w.w = cvt_pk_bf16(v1[2], v1[3]);
                    *(u32x4*)(dst + (size_t)(row0 + ai * HALF + m * 16) * ld) = w; } }
    }
};
struct EpiF32S {
    static constexpr bool PERM = false, AFTER_DRAIN = false, HAS_MID = false;
    float* C; int ldc; int split_tiles; size_t split_stride;
    __device__ __forceinline__ void operator()(const f32x4 (&acc)[2][2][4][2], const Unit& u, int wr, int wc, int fr, int fq) const {
        int pn = u.pn; float* base = C; if (split_tiles) { const int t = pn / split_tiles; base += (size_t)t * split_stride; pn -= t * split_tiles; }
        const int row0 = u.pm * BM + wr * 64 + fr, col0 = pn * BM + wc * 32 + 4 * fq;
#pragma unroll
        for (int ai = 0; ai < 2; ++ai)
#pragma unroll
            for (int m = 0; m < 4; ++m) { float* rowp = base + (size_t)(row0 + ai * HALF + m * 16) * ldc + col0;
#pragma unroll
                for (int bj = 0; bj < 2; ++bj)
#pragma unroll
                    for (int n = 0; n < 2; ++n) *(f32x4*)(rowp + bj * HALF + n * 16) = acc[ai][bj][m][n]; }
    }
};
struct EpiBf16S {
    static constexpr bool PERM = true, AFTER_DRAIN = false, HAS_MID = false;
    bf16_t* O; int ldc;
    __device__ __forceinline__ void operator()(const f32x4 (&acc)[2][2][4][2], const Unit& u, int wr, int wc, int fr, int fq) const {
        const int row0 = u.pm * BM + wr * 64 + fr, col0 = u.pn * BM + wc * 32 + 8 * fq;
#pragma unroll
        for (int ai = 0; ai < 2; ++ai)
#pragma unroll
            for (int m = 0; m < 4; ++m) { bf16_t* rowp = O + (size_t)(row0 + ai * HALF + m * 16) * ldc + col0;
#pragma unroll
                for (int bj = 0; bj < 2; ++bj) { const f32x4 v0 = acc[ai][bj][m][0], v1 = acc[ai][bj][m][1];
                    u32x4 w; w.x = cvt_pk_bf16(v0[0], v0[1]); w.y = cvt_pk_bf16(v0[2], v0[3]); w.z = cvt_pk_bf16(v1[0], v1[1]); w.w = cvt_pk_bf16(v1[2], v1[3]);
                    *(u32x4*)(rowp + bj * HALF) = w; } }
    }
};
struct EpiSwiGLU {
    static constexpr bool PERM = true, AFTER_DRAIN = false, HAS_MID = false;
    bf16_t* O; int ldc;
    __device__ __forceinline__ void operator()(const f32x4 (&acc)[2][2][4][2], const Unit& u, int wr, int wc, int fr, int fq) const {
        const int row0 = u.pm * BM + wr * 64 + fr, col0 = u.pn * (BM / 2) + wc * 16 + 4 * fq;
#pragma unroll
        for (int ai = 0; ai < 2; ++ai)
#pragma unroll
            for (int m = 0; m < 4; ++m) { bf16_t* rowp = O + (size_t)(row0 + ai * HALF + m * 16) * ldc + col0;
#pragma unroll
                for (int bj = 0; bj < 2; ++bj) { const f32x4 v0 = acc[ai][bj][m][0], v1 = acc[ai][bj][m][1];
                    const float a0 = v0[0] / (1.f + __expf(-v0[0])) * v0[1], a1 = v0[2] / (1.f + __expf(-v0[2])) * v0[3];
                    const float a2 = v1[0] / (1.f + __expf(-v1[0])) * v1[1], a3 = v1[2] / (1.f + __expf(-v1[2])) * v1[3];
                    u32x2 w; w.x = cvt_pk_bf16(a0, a1); w.y = cvt_pk_bf16(a2, a3);
                    *(u32x2*)(rowp + bj * (HALF / 2)) = w; } }
    }
};
template <int MODE  > struct EpiGate {
    static constexpr bool PERM = true, AFTER_DRAIN = false, HAS_MID = false;
    const bf16_t* sg; const bf16_t* tin; bf16_t* tout; int ldc;
    __device__ __forceinline__ void operator()(const f32x4 (&acc)[2][2][4][2], const Unit& u, int wr, int wc, int fr, int fq) const {
        const int row0 = u.pm * BM + wr * 64 + fr, col0 = u.pn * BM + wc * 32 + 8 * fq;
#pragma unroll
        for (int ai = 0; ai < 2; ++ai)
#pragma unroll
            for (int m = 0; m < 4; ++m) { const size_t r = (size_t)(row0 + ai * HALF + m * 16);
#pragma unroll
                for (int bj = 0; bj < 2; ++bj) { const int c = col0 + bj * HALF;
                    const u32x4 gq = *(const u32x4*)(sg + r * 3072 + c); u32x4 tq = {0u, 0u, 0u, 0u}; if (MODE >= 1) tq = *(const u32x4*)(tin + r * ldc + c);
                    const f32x4 v0 = acc[ai][bj][m][0], v1 = acc[ai][bj][m][1]; u32x4 w;
#define EG_ONE(dst, x0, x1, gw_, tw_) { float a_ = (x0) * __builtin_bit_cast(float, (gw_) << 16), b_ = (x1) * __builtin_bit_cast(float, (gw_) & 0xffff0000u); \
                        if (MODE >= 1) { a_ += __builtin_bit_cast(float, (tw_) << 16); b_ += __builtin_bit_cast(float, (tw_) & 0xffff0000u); } dst = cvt_pk_bf16(a_, b_); }
                    EG_ONE(w.x, v0[0], v0[1], gq.x, tq.x) EG_ONE(w.y, v0[2], v0[3], gq.y, tq.y) EG_ONE(w.z, v1[0], v1[1], gq.z, tq.z) EG_ONE(w.w, v1[2], v1[3], gq.w, tq.w)
#undef EG_ONE
                    *(u32x4*)(tout + r * ldc + c) = w; } }
    }
};
struct EpiGate3 {
    static constexpr bool PERM = true, AFTER_DRAIN = false, HAS_MID = true;
    const bf16_t* sg; bf16_t* out; int ldc; int t1, t2;
    __device__ __forceinline__ void mid(f32x4 (&acc)[2][2][4][2], const Unit& u, int wr, int wc, int fr, int fq, int seam) const {
        int row0 = u.pm * BM + wr * 64 + fr, col0 = u.pn * BM + wc * 32 + 8 * fq;
        asm volatile("" : "+v"(row0), "+v"(col0));
#pragma unroll
        for (int ai = 0; ai < 2; ++ai)
#pragma unroll
            for (int m = 0; m < 4; ++m) { const bf16_t* gp = sg + (size_t)(row0 + ai * HALF + m * 16) * 3072 + seam * 1024 + col0;
#pragma unroll
                for (int bj = 0; bj < 2; ++bj) { const u32x4 ga = *(const u32x4*)(gp + bj * HALF), gb = *(const u32x4*)(gp + 1024 + bj * HALF);
#define EG3_R(a_, b_, hi_) (fmaxf(__builtin_bit_cast(float, (hi_) ? ((a_) & 0xffff0000u) : ((a_) << 16)), 1e-30f) * __builtin_amdgcn_rcpf(fmaxf(__builtin_bit_cast(float, (hi_) ? ((b_) & 0xffff0000u) : ((b_) << 16)), 1e-30f)))
                    acc[ai][bj][m][0][0] *= EG3_R(ga.x, gb.x, 0); acc[ai][bj][m][0][1] *= EG3_R(ga.x, gb.x, 1); acc[ai][bj][m][0][2] *= EG3_R(ga.y, gb.y, 0); acc[ai][bj][m][0][3] *= EG3_R(ga.y, gb.y, 1);
                    acc[ai][bj][m][1][0] *= EG3_R(ga.z, gb.z, 0); acc[ai][bj][m][1][1] *= EG3_R(ga.z, gb.z, 1); acc[ai][bj][m][1][2] *= EG3_R(ga.w, gb.w, 0); acc[ai][bj][m][1][3] *= EG3_R(ga.w, gb.w, 1);
#undef EG3_R
                } }
    }
    __device__ __forceinline__ void operator()(const f32x4 (&acc)[2][2][4][2], const Unit& u, int wr, int wc, int fr, int fq) const {
        const int row0 = u.pm * BM + wr * 64 + fr, col0 = u.pn * BM + wc * 32 + 8 * fq;
#pragma unroll
        for (int ai = 0; ai < 2; ++ai)
#pragma unroll
            for (int m = 0; m < 4; ++m) { const size_t r = (size_t)(row0 + ai * HALF + m * 16);
#pragma unroll
                for (int bj = 0; bj < 2; ++bj) { const int c = col0 + bj * HALF;
                    const u32x4 gq = *(const u32x4*)(sg + r * 3072 + 2048 + c); const f32x4 v0 = acc[ai][bj][m][0], v1 = acc[ai][bj][m][1]; u32x4 w;
#define EG3_G(g_, hi_) fmaxf(__builtin_bit_cast(float, (hi_) ? ((g_) & 0xffff0000u) : ((g_) << 16)), 1e-30f)
                    w.x = cvt_pk_bf16(v0[0] * EG3_G(gq.x, 0), v0[1] * EG3_G(gq.x, 1)); w.y = cvt_pk_bf16(v0[2] * EG3_G(gq.y, 0), v0[3] * EG3_G(gq.y, 1));
                    w.z = cvt_pk_bf16(v1[0] * EG3_G(gq.z, 0), v1[1] * EG3_G(gq.z, 1)); w.w = cvt_pk_bf16(v1[2] * EG3_G(gq.w, 0), v1[3] * EG3_G(gq.w, 1));
#undef EG3_G
                    *(u32x4*)(out + r * ldc + c) = w; } }
    }
};
template <class Epi, class Sched, bool ALIGN_EPI = false, bool SP2 = false>
__device__ __forceinline__ void gemm_phase(LAS unsigned char* lds, const Gemm g, const Sched& S, const Epi& E) {
    int tid_ = threadIdx.x; asm volatile("" : "+v"(tid_));
    const int tid = tid_, wid = __builtin_amdgcn_readfirstlane(tid >> 6), lane = tid & 63, wr = wid >> 2, wc = wid & 3, fr = lane & 15, fq = lane >> 4;
    const int K = g.K, nt = K / BK;
    unsigned voffA[2], voffB[2];
#pragma unroll
    for (int i = 0; i < 2; ++i) { int R, C; stage_rc(tid * 16 + i * 8192, R, C); const int Rb = Epi::PERM ? ((R & ~31) + perm32(R & 31)) : R;
        voffA[i] = (unsigned)(R * g.lda + C) * 2u; voffB[i] = (unsigned)(Rb * g.ldb + C) * 2u; }
    const size_t kstep = (size_t)(BK * 2);
    const size_t hstepA = (size_t)HALF * g.lda * 2, hstepB = (size_t)HALF * g.ldb * 2;
    const size_t tstepA = 2 * hstepA, tstepB = 2 * hstepB;
    const unsigned ldsw = (unsigned)wid * 1024u;
    const int aoff = lds_byte(wr * 64 + fr, fq * 8), boff = lds_byte(wc * 32 + fr, fq * 8);
#define PG8_SA(b, h) (((b) * 2 + (h)) * HTB)
#define PG8_SB(b, h) ((4 + (b) * 2 + (h)) * HTB)
#define PG8_STAGE(bufoff, gbase, voff) do { _Pragma("unroll") for (int _i = 0; _i < 2; ++_i) \
        __builtin_amdgcn_global_load_lds((const unsigned*)((const char*)(gbase) + (voff)[_i]), (LAS unsigned*)(lds + (bufoff) + ldsw + _i * 8192), 16, 0, 0); } while (0)
#define PG8_LDA(dst, b, h) do { _Pragma("unroll") for (int m = 0; m < 4; ++m) _Pragma("unroll") for (int k = 0; k < 2; ++k) dst[m][k] = *(const LAS bf16x8*)(lds + PG8_SA(b, h) + aoff + m * 2048 + k * 1024); } while (0)
#define PG8_LDB(dst, b, h) do { _Pragma("unroll") for (int n = 0; n < 2; ++n) _Pragma("unroll") for (int k = 0; k < 2; ++k) dst[n][k] = *(const LAS bf16x8*)(lds + PG8_SB(b, h) + boff + n * 2048 + k * 1024); } while (0)
#define PG8_MMA(ai, bj, At, Bt) do { __builtin_amdgcn_s_setprio(1); _Pragma("unroll") for (int m = 0; m < 4; ++m) _Pragma("unroll") for (int n = 0; n < 2; ++n) _Pragma("unroll") for (int k = 0; k < 2; ++k) \
        acc[ai][bj][m][n] = __builtin_amdgcn_mfma_f32_16x16x32_bf16(Bt[n][k], At[m][k], acc[ai][bj][m][n], 0, 0, 0); __builtin_amdgcn_s_setprio(0); } while (0)
#define PG8_WAIT_V(n) asm volatile("s_waitcnt vmcnt(" #n ")" ::: "memory")
#define PG8_WAIT_L(n) asm volatile("s_waitcnt lgkmcnt(" #n ")" ::: "memory")
#define PG8_BAR __builtin_amdgcn_s_barrier()
#define PG8_SCHED __builtin_amdgcn_sched_barrier(0)
    Unit cur, nxt; int ui = 0;
    if (!S.next(0, cur)) return;
    f32x4 acc[2][2][4][2];
#pragma unroll
    for (int a = 0; a < 2; ++a)
#pragma unroll
        for (int b = 0; b < 2; ++b)
#pragma unroll
            for (int m = 0; m < 4; ++m)
#pragma unroll
                for (int n = 0; n < 2; ++n) acc[a][b][m][n] = (f32x4){0.f, 0.f, 0.f, 0.f};
    bf16x8 At[4][2], B0[2][2], B1[2][2];
    const size_t kslb = (size_t)g.ksl * 2;
    const char* cA = (const char*)g.A + (size_t)cur.pm * tstepA + cur.ks * kslb; const char* cB = (const char*)g.Bt + (size_t)cur.pn * tstepB + cur.ks * kslb;
    S.a_ready(cur);
    if constexpr (SP2) {
        PG8_STAGE(PG8_SB(0, 0), cB, voffB); PG8_STAGE(PG8_SB(0, 1), cB + hstepB, voffB); PG8_STAGE(PG8_SA(0, 0), cA, voffA); PG8_STAGE(PG8_SA(0, 1), cA + hstepA, voffA);
        if (wr == 1) PG8_BAR;
        PG8_WAIT_V(2); PG8_BAR;
        PG8_STAGE(PG8_SB(1, 0), cB + kstep, voffB); PG8_STAGE(PG8_SA(1, 0), cA + kstep, voffA); PG8_STAGE(PG8_SB(1, 1), cB + hstepB + kstep, voffB);
        PG8_WAIT_V(6); PG8_BAR;
    } else {
        PG8_STAGE(PG8_SB(0, 0), cB, voffB); PG8_STAGE(PG8_SA(0, 0), cA, voffA); PG8_STAGE(PG8_SB(0, 1), cB + hstepB, voffB); PG8_STAGE(PG8_SA(0, 1), cA + hstepA, voffA);
        if (wr == 1) PG8_BAR;
        PG8_WAIT_V(4); PG8_BAR;
        PG8_STAGE(PG8_SB(1, 0), cB + kstep, voffB); PG8_STAGE(PG8_SA(1, 0), cA + kstep, voffA); PG8_STAGE(PG8_SB(1, 1), cB + hstepB + kstep, voffB);
        PG8_WAIT_V(6); PG8_BAR;
    }
    for (;;) {
        const bool has_next = S.next(ui + 1, nxt);
        const char* nA = has_next ? (const char*)g.A + (size_t)nxt.pm * tstepA + nxt.ks * kslb : cA; const char* nB = has_next ? (const char*)g.Bt + (size_t)nxt.pn * tstepB + nxt.ks * kslb : cB;
#pragma unroll 1
        for (int t = 0; t < nt; t += 2) {
            const bool last = (t == nt - 2);
            const char* a1 = cA + (size_t)(t + 1) * kstep;
            const char* a2 = last ? nA : cA + (size_t)(t + 2) * kstep; const char* b2 = last ? nB : cB + (size_t)(t + 2) * kstep;
            const char* a3 = a2 + kstep; const char* b3 = b2 + kstep;
            if (last && has_next) S.a_ready(nxt);
            if constexpr (Epi::HAS_MID) { if (t == E.t1 || t == E.t2) E.mid(acc, cur, wr, wc, fr, fq, t == E.t1 ? 0 : 1); }
            if constexpr (SP2) {
            PG8_LDB(B0, 0, 0); PG8_LDB(B1, 0, 1); PG8_SCHED; PG8_LDA(At, 0, 0); PG8_STAGE(PG8_SA(1, 1), a1 + hstepA, voffA);
            PG8_WAIT_V(8); PG8_WAIT_L(0); PG8_BAR; PG8_MMA(0, 0, At, B0); PG8_MMA(0, 1, At, B1); PG8_BAR; PG8_SCHED;
            PG8_LDA(At, 0, 1); PG8_STAGE(PG8_SB(0, 0), b2, voffB); PG8_STAGE(PG8_SB(0, 1), b2 + hstepB, voffB); PG8_STAGE(PG8_SA(0, 0), a2, voffA);
            PG8_WAIT_V(8); PG8_WAIT_L(0); PG8_BAR; PG8_MMA(1, 0, At, B0); PG8_MMA(1, 1, At, B1); PG8_BAR; PG8_SCHED;
            PG8_LDB(B0, 1, 0); PG8_LDB(B1, 1, 1); PG8_SCHED; PG8_LDA(At, 1, 0); PG8_STAGE(PG8_SA(0, 1), a2 + hstepA, voffA);
            PG8_WAIT_V(8); PG8_WAIT_L(0); PG8_BAR; PG8_MMA(0, 0, At, B0); PG8_MMA(0, 1, At, B1); PG8_BAR; PG8_SCHED;
            PG8_LDA(At, 1, 1); PG8_STAGE(PG8_SB(1, 0), b3, voffB); PG8_STAGE(PG8_SB(1, 1), b3 + hstepB, voffB); PG8_STAGE(PG8_SA(1, 0), a3, voffA);
            PG8_WAIT_V(8); PG8_WAIT_L(0); PG8_BAR; PG8_MMA(1, 0, At, B0); PG8_MMA(1, 1, At, B1); PG8_BAR; PG8_SCHED;
            } else {
            PG8_LDB(B0, 0, 0); PG8_SCHED; PG8_LDA(At, 0, 0); PG8_STAGE(PG8_SA(1, 1), a1 + hstepA, voffA);
            PG8_WAIT_L(8); PG8_BAR; PG8_WAIT_L(0); PG8_MMA(0, 0, At, B0); PG8_BAR; PG8_SCHED;
            PG8_LDB(B1, 0, 1); PG8_STAGE(PG8_SB(0, 0), b2, voffB);
            PG8_BAR; PG8_WAIT_L(0); PG8_MMA(0, 1, At, B1); PG8_BAR;
            PG8_LDA(At, 0, 1); PG8_STAGE(PG8_SA(0, 0), a2, voffA);
            PG8_BAR; PG8_WAIT_L(0); PG8_MMA(1, 0, At, B0); PG8_BAR; PG8_SCHED;
            PG8_STAGE(PG8_SB(0, 1), b2 + hstepB, voffB);
            PG8_WAIT_V(6); PG8_BAR; PG8_MMA(1, 1, At, B1); PG8_BAR;
            PG8_LDB(B0, 1, 0); PG8_SCHED; PG8_LDA(At, 1, 0); PG8_STAGE(PG8_SA(0, 1), a2 + hstepA, voffA);
            PG8_WAIT_L(8); PG8_BAR; PG8_WAIT_L(0); PG8_MMA(0, 0, At, B0); PG8_BAR; PG8_SCHED;
            PG8_LDB(B1, 1, 1); PG8_STAGE(PG8_SB(1, 0), b3, voffB);
            PG8_BAR; PG8_WAIT_L(0); PG8_MMA(0, 1, At, B1); PG8_BAR;
            PG8_LDA(At, 1, 1); PG8_STAGE(PG8_SA(1, 0), a3, voffA);
            PG8_BAR; PG8_WAIT_L(0); PG8_MMA(1, 0, At, B0); PG8_BAR; PG8_SCHED;
            PG8_STAGE(PG8_SB(1, 1), b3 + hstepB, voffB);
            PG8_WAIT_V(6); PG8_BAR; PG8_MMA(1, 1, At, B1); PG8_BAR;
            }
        }
        if constexpr (ALIGN_EPI) { if (wr == 0) PG8_BAR; }
        if constexpr (!Epi::AFTER_DRAIN) { E(acc, cur, wr, wc, fr, fq); S.done(cur); }
        if (!has_next) break;
#pragma unroll
        for (int a = 0; a < 2; ++a)
#pragma unroll
            for (int b = 0; b < 2; ++b)
#pragma unroll
                for (int m = 0; m < 4; ++m)
#pragma unroll
                    for (int n = 0; n < 2; ++n) acc[a][b][m][n] = (f32x4){0.f, 0.f, 0.f, 0.f};
        cur = nxt; cA = nA; cB = nB; ++ui;
        if constexpr (ALIGN_EPI) { if (wr == 1) PG8_BAR; }
    }
    PG8_WAIT_V(0);
    if constexpr (!ALIGN_EPI) { if (wr == 0) PG8_BAR; }
    PG8_BAR;
    if constexpr (Epi::AFTER_DRAIN) { E.fused(acc, cur, wr, wc, fr, fq, lds, wid, lane); S.done(cur); }
#undef PG8_SA
#undef PG8_SB
#undef PG8_STAGE
#undef PG8_LDA
#undef PG8_LDB
#undef PG8_MMA
#undef PG8_WAIT_V
#undef PG8_WAIT_L
#undef PG8_BAR
#undef PG8_SCHED
}
}
typedef unsigned short bf16_t;
DI unsigned pk2(float lo, float hi) { return pg8::cvt_pk_bf16(lo, hi); }
DI bf16_t f2bf(float f) { return (bf16_t)(pg8::cvt_pk_bf16(f, 0.f) & 0xffffu); }
DI void transpose_item(const float* W, int N, bf16_t* WT, int ldt, int row_off, int rmul, LAS float* scr, int item, int lane) {
    const int nblk = N / 32, kb = item / nblk, nb = item % nblk, k0 = 64 * kb, n0 = 32 * nb;
#pragma unroll 8
    for (int i = 0; i < 32; ++i) { const int kk = 2 * i + (lane >> 5); scr[kk * 33 + (lane & 31)] = W[(size_t)(k0 + kk) * N + n0 + (lane & 31)]; }
    asm volatile("s_waitcnt lgkmcnt(0)" ::: "memory");
    const int c = lane & 7;
#pragma unroll
    for (int j = 0; j < 4; ++j) { const int n = (lane >> 3) + 8 * j; const LAS float* sp = scr + (8 * c) * 33 + n;
        pg8::u32x4 o; o.x = pk2(sp[0 * 33], sp[1 * 33]); o.y = pk2(sp[2 * 33], sp[3 * 33]); o.z = pk2(sp[4 * 33], sp[5 * 33]); o.w = pk2(sp[6 * 33], sp[7 * 33]);
        *(pg8::u32x4*)(WT + (size_t)(row_off + rmul * (n0 + n)) * ldt + k0 + 8 * c) = o; }
    asm volatile("s_waitcnt lgkmcnt(0)" ::: "memory");
}
DI void transpose_w(const float* W, int K, int N, bf16_t* WT, int ldt, int row_off, LAS float* scr, int gw, int NGW, int lane, int& rot, int rmul = 1) {
    const int nitems = (K / 64) * (N / 32);
    int first = gw - (rot % NGW); if (first < 0) first += NGW;
    for (int it = first; it < nitems; it += NGW) transpose_item(W, N, WT, ldt, row_off, rmul, scr, it, lane);
    rot += nitems;
}

struct Args {
    const float* in[29]; float* out; unsigned char* ws; int ph_lo, ph_hi, sub, pad;
};

DI unsigned short f2bf_raw(float f) { unsigned u = __builtin_bit_cast(unsigned, f); return (unsigned short)((u + 0x7fffu + ((u >> 16) & 1u)) >> 16); }
DI void sgemm_naive(LAS float* lds, const float* __restrict__ A, int lda, const float* __restrict__ B, long sbk, long sbn,
                    float* __restrict__ C, int ldc, int M, int N, int K, int bid, int G, unsigned short* Cb = nullptr) {
    LAS float* As = lds;
    LAS float* Bs = lds + 16 * 132;
    const int tid = threadIdx.x, tx = tid & 15, ty = tid >> 4;
    const int ntn = N / 64, ntiles = (M / 128) * ntn;
    for (int t = bid; t < ntiles; t += G) {
        const int m0 = (t / ntn) * 128, n0 = (t % ntn) * 64;
        float acc[4][4];
#pragma unroll
        for (int i = 0; i < 4; ++i)
#pragma unroll
            for (int j = 0; j < 4; ++j) acc[i][j] = 0.f;
        for (int k0 = 0; k0 < K; k0 += 16) {
            {
                const int r = tid >> 2, kq = (tid & 3) * 4;
                const float4 v = *(const float4*)(A + (size_t)(m0 + r) * lda + k0 + kq);
                As[(kq + 0) * 132 + r] = v.x; As[(kq + 1) * 132 + r] = v.y; As[(kq + 2) * 132 + r] = v.z; As[(kq + 3) * 132 + r] = v.w;
            }
#pragma unroll
            for (int i = 0; i < 2; ++i) {
                const int idx = tid + i * 512, kk = idx >> 6, nn = idx & 63;
                Bs[kk * 64 + nn] = B[(size_t)(k0 + kk) * sbk + (size_t)(n0 + nn) * sbn];
            }
            __syncthreads();
#pragma unroll
            for (int kk = 0; kk < 16; ++kk) {
                const f32x4 a = *(const LAS f32x4*)(As + kk * 132 + ty * 4);
                const f32x4 b = *(const LAS f32x4*)(Bs + kk * 64 + tx * 4);
                const float av[4] = {a.x, a.y, a.z, a.w}, bv[4] = {b.x, b.y, b.z, b.w};
#pragma unroll
                for (int i = 0; i < 4; ++i)
#pragma unroll
                    for (int j = 0; j < 4; ++j) acc[i][j] += av[i] * bv[j];
            }
            __syncthreads();
        }
#pragma unroll
        for (int i = 0; i < 4; ++i) {
            float4 o; o.x = acc[i][0]; o.y = acc[i][1]; o.z = acc[i][2]; o.w = acc[i][3];
            if (Cb) { unsigned short* cb = Cb + (size_t)(m0 + ty * 4 + i) * ldc + n0 + tx * 4; cb[0] = f2bf_raw(o.x); cb[1] = f2bf_raw(o.y); cb[2] = f2bf_raw(o.z); cb[3] = f2bf_raw(o.w); }
            else *(float4*)(C + (size_t)(m0 + ty * 4 + i) * ldc + n0 + tx * 4) = o;
        }
    }
}

template <int DQK, int DV, bool V_IN_K, int MODE, class KV, class QF>
DI void attn_naive(LAS float* lds, const KV& kv, int nk_loop, const QF& qf, bool active, int limit, float scale, float lg, int tq, float* optr) {
    constexpr int KS = DQK + 1;
    constexpr int VS = V_IN_K ? KS : DV;
    LAS float* Ks = lds;
    LAS float* Vs = V_IN_K ? Ks : (lds + 64 * KS);
    LAS float* qs = lds + 64 * KS + (V_IN_K ? 0 : 64 * DV);
    LAS float* ps = qs + 8 * DQK;
    static_assert((64 * KS + (V_IN_K ? 0 : 64 * DV) + 8 * DQK + 8 * 64) * 4 <= MISC_OFF, "attn_naive LDS");
    const int tid = threadIdx.x, lane = tid & 63, w = tid >> 6;
    __syncthreads();
    for (int d = lane; d < DQK; d += 64) qs[w * DQK + d] = active ? qf(d) : 0.f;
    float m = -INFINITY, l = 0.f;
    float acc[DV / 64];
#pragma unroll
    for (int c = 0; c < DV / 64; ++c) acc[c] = 0.f;
    for (int base = 0; base < nk_loop; base += 64) {
        __syncthreads();
        for (int idx = tid; idx < 64 * DQK; idx += NTHREADS) { const int j = idx / DQK, d = idx - j * DQK, key = base + j; Ks[j * KS + d] = key < nk_loop ? kv.k(key, d) : 0.f; }
        if (!V_IN_K) for (int idx = tid; idx < 64 * DV; idx += NTHREADS) { const int j = idx / DV, e = idx - j * DV, key = base + j; Vs[j * DV + e] = key < nk_loop ? kv.v(key, e) : 0.f; }
        __syncthreads();
        const int key = base + lane; const bool valid = active && key <= limit && key < nk_loop;
        float s = 0.f;
        for (int d = 0; d < DQK; ++d) s += qs[w * DQK + d] * Ks[lane * KS + d];
        float p;
        if (MODE == 0) {
            s *= scale;
            const float cm = wave_max(valid ? s : -INFINITY);
            const float mn = fmaxf(m, cm);
            const float alpha = (mn == -INFINITY) ? 1.f : expf(m - mn);
            p = valid ? expf(s - mn) : 0.f;
            l = l * alpha + wave_sum(p);
#pragma unroll
            for (int c = 0; c < DV / 64; ++c) acc[c] *= alpha;
            m = mn;
        } else {
            p = valid ? s * expf((float)(tq - key) * lg) : 0.f;
        }
        ps[w * 64 + lane] = p;
        __syncthreads();
        for (int j = 0; j < 64; ++j) { const float pj = ps[w * 64 + j];
#pragma unroll
            for (int c = 0; c < DV / 64; ++c) acc[c] += pj * Vs[j * VS + lane + 64 * c]; }
    }
    if (active) {
#pragma unroll
        for (int c = 0; c < DV / 64; ++c) optr[lane + 64 * c] = (MODE == 0) ? acc[c] / l : acc[c];
    }
}

struct KvMlaPrompt { const float* ckvn; const float* kper; int b;
    DI float k(int key, int d) const { const size_t row = (size_t)b * SEQ + key; return d < KVL ? ckvn[row * KVL + d] : kper[row * DROPE + (d - KVL)]; }
    DI float v(int, int) const { return 0.f; } };
struct KvMlaSample { const float* ckvn; const float* kper; const float* cckv; const float* ckpe; const int* pt; int b;
    DI float k(int key, int d) const {
        if (key < PAST) { const size_t r = (size_t)pt[b * NPAGES + (key >> 7)] * PAGE + (key & (PAGE - 1)); return d < KVL ? cckv[r * KVL + d] : ckpe[r * DROPE + (d - KVL)]; }
        const size_t row = (size_t)NP + b * DS + (key - PAST); return d < KVL ? ckvn[row * KVL + d] : kper[row * DROPE + (d - KVL)]; }
    DI float v(int, int) const { return 0.f; } };
struct KvRet { const float* rk; const float* z; int b, h;
    DI float k(int key, int d) const { return rk[((size_t)b * SEQ + key) * 512 + h * RDK + d]; }
    DI float v(int key, int e) const { return z[((size_t)b * SEQ + key) * ZLD + C_RV + h * RDV + e]; } };
struct KvMem { const float* mk; const float* mv; int b, h;
    DI float k(int key, int d) const { return mk[(((size_t)b * NMEM + key) * XH + h) * XHD + d]; }
    DI float v(int key, int e) const { return mv[(((size_t)b * NMEM + key) * XH + h) * XHD + e]; } };


typedef float f32x16 __attribute__((ext_vector_type(16)));
typedef short bf16x8 __attribute__((ext_vector_type(8)));
typedef short s16x4 __attribute__((ext_vector_type(4)));
typedef unsigned u32x4_t __attribute__((ext_vector_type(4)));
typedef unsigned u32x2_t __attribute__((ext_vector_type(2)));
DI int crow(int i, int h) { return (i & 3) + 8 * (i >> 2) + 4 * h; }
#define MFMA32(a, b, c) __builtin_amdgcn_mfma_f32_32x32x16_bf16((a), (b), (c), 0, 0, 0)
template <int DQK, int DV, bool CAUSAL, class Src>
DI void flash_unit(LAS unsigned char* lds, const Src& src, int qpos0, int ntiles, bf16_t* O, int ldo, float c2) {
    constexpr int KP = DQK + 8, VP = 68, KS = DQK / 16, NBLK = DV / 32;
    constexpr int KBYTES = 64 * KP * 2, VBYTES = DV * VP * 2, BUF = KBYTES + VBYTES;
    constexpr int D8 = DQK / 8, NPK = (64 * D8) / NTHREADS, NPV = (DV * 8) / NTHREADS;
    static_assert((64 * D8) % NTHREADS == 0 && (DV * 8) % NTHREADS == 0 && 2 * BUF <= 131072, "flash_unit geometry");
    const int tid = threadIdx.x, lane = tid & 63, w = __builtin_amdgcn_readfirstlane(tid >> 6), l31 = lane & 31, h = lane >> 5;
    bf16x8 qf[KS];
#pragma unroll
    for (int s_ = 0; s_ < KS; ++s_) qf[s_] = src.qfrag(32 * w + l31, s_, h);
    f32x16 o[NBLK];
#pragma unroll
    for (int b = 0; b < NBLK; ++b)
#pragma unroll
        for (int i = 0; i < 16; ++i) o[b][i] = 0.f;
    float m = -INFINITY, lsum = 0.f;
    u32x4_t kreg[NPK], vreg[NPV];
#define FL_LOAD(t_) do { _Pragma("unroll") for (int i_ = 0; i_ < NPK; ++i_) { const int p_ = tid + i_ * NTHREADS; kreg[i_] = src.kpiece(64 * (t_) + p_ / D8, p_ % D8); } \
                         _Pragma("unroll") for (int i_ = 0; i_ < NPV; ++i_) { const int p_ = tid + i_ * NTHREADS; vreg[i_] = src.vpiece(p_ >> 3, 64 * (t_) + 8 * (p_ & 7)); } } while (0)
#define FL_STORE(buf_) do { _Pragma("unroll") for (int i_ = 0; i_ < NPK; ++i_) { const int p_ = tid + i_ * NTHREADS; *(LAS u32x4_t*)(lds + (buf_) * BUF + ((p_ / D8) * KP + (p_ % D8) * 8) * 2) = kreg[i_]; } \
                          _Pragma("unroll") for (int i_ = 0; i_ < NPV; ++i_) { const int p_ = tid + i_ * NTHREADS; LAS unsigned char* a_ = lds + (buf_) * BUF + KBYTES + ((p_ >> 3) * VP + (p_ & 7) * 8) * 2; \
                              *(LAS u32x2_t*)a_ = (u32x2_t){vreg[i_].x, vreg[i_].y}; *(LAS u32x2_t*)(a_ + 8) = (u32x2_t){vreg[i_].z, vreg[i_].w}; } } while (0)
    __syncthreads();
    FL_LOAD(0); FL_STORE(0);
    __syncthreads();
    const int qmine = qpos0 + 32 * w + l31, qlast = qpos0 + 32 * w + 31;
    for (int t = 0; t < ntiles; ++t) {
        const int buf = t & 1;
        if (t + 1 < ntiles) FL_LOAD(t + 1);
        if (!CAUSAL || 64 * t <= qlast) {
            const LAS unsigned char* kb_ = lds + buf * BUF; const LAS unsigned char* vb_ = kb_ + KBYTES;
            f32x16 st[2];
#pragma unroll
            for (int kb = 0; kb < 2; ++kb) {
#pragma unroll
                for (int i = 0; i < 16; ++i) st[kb][i] = 0.f;
#pragma unroll
                for (int g_ = 0; g_ < KS / 4; ++g_) { bf16x8 kf[4];
#pragma unroll
                    for (int j = 0; j < 4; ++j) kf[j] = *(const LAS bf16x8*)(kb_ + ((32 * kb + l31) * KP + 16 * (4 * g_ + j) + 8 * h) * 2);
#pragma unroll
                    for (int j = 0; j < 4; ++j) st[kb] = MFMA32(kf[j], qf[4 * g_ + j], st[kb]);
                    __builtin_amdgcn_sched_barrier(0); }
            }
            if (CAUSAL && 64 * t + 63 > qpos0 + 32 * w) {
#pragma unroll
                for (int kb = 0; kb < 2; ++kb)
#pragma unroll
                    for (int i = 0; i < 16; ++i) { const int key = 64 * t + 32 * kb + crow(i, h); st[kb][i] = key <= qmine ? st[kb][i] : -INFINITY; }
            }
            float mx = -INFINITY;
#pragma unroll
            for (int kb = 0; kb < 2; ++kb)
#pragma unroll
                for (int i = 0; i < 16; ++i) mx = fmaxf(mx, st[kb][i]);
            mx = fmaxf(mx, __shfl_xor(mx, 32));
            const float mn = fmaxf(m, mx);
            { const float alpha = __builtin_amdgcn_exp2f((m - mn) * c2);
                lsum *= alpha;
#pragma unroll
                for (int b = 0; b < NBLK; ++b)
#pragma unroll
                    for (int i = 0; i < 16; ++i) o[b][i] *= alpha;
                m = mn;
            }
            const float nmc = -mn * c2;
            float ps = 0.f;
#pragma unroll
            for (int kb = 0; kb < 2; ++kb)
#pragma unroll
                for (int i = 0; i < 16; ++i) { const float p = __builtin_amdgcn_exp2f(__builtin_fmaf(st[kb][i], c2, nmc)); st[kb][i] = p; ps += p; }
            lsum += ps;
            bf16x8 pf[4];
#pragma unroll
            for (int ks = 0; ks < 4; ++ks) { const int kb = ks >> 1, s2 = ks & 1; u32x4_t pk;
                pk.x = cvtpk(st[kb][8 * s2 + 0], st[kb][8 * s2 + 1]); pk.y = cvtpk(st[kb][8 * s2 + 2], st[kb][8 * s2 + 3]);
                pk.z = cvtpk(st[kb][8 * s2 + 4], st[kb][8 * s2 + 5]); pk.w = cvtpk(st[kb][8 * s2 + 6], st[kb][8 * s2 + 7]); pf[ks] = __builtin_bit_cast(bf16x8, pk); }
            __builtin_amdgcn_sched_barrier(0);
#pragma unroll
            for (int b = 0; b < NBLK; ++b) { bf16x8 vf[4];
#pragma unroll
                for (int ks = 0; ks < 4; ++ks) { const LAS unsigned char* a_ = vb_ + ((32 * b + l31) * VP + 16 * ks + 4 * h) * 2;
                    const s16x4 lo = *(const LAS s16x4*)a_, hi = *(const LAS s16x4*)(a_ + 16);
                    vf[ks] = __builtin_shufflevector(lo, hi, 0, 1, 2, 3, 4, 5, 6, 7); }
#pragma unroll
                for (int ks = 0; ks < 4; ++ks) o[b] = MFMA32(vf[ks], pf[ks], o[b]);
                __builtin_amdgcn_sched_barrier(0); }
        }
        if (t + 1 < ntiles) FL_STORE(buf ^ 1);
        __syncthreads();
    }
#undef FL_LOAD
#undef FL_STORE
    lsum += __shfl_xor(lsum, 32);
    const float inv = 1.f / lsum;
    bf16_t* orow = O + (size_t)(32 * w + l31) * ldo;
#pragma unroll
    for (int b = 0; b < NBLK; ++b)
#pragma unroll
        for (int g = 0; g < 4; ++g) { u32x2_t pk; pk.x = cvtpk(o[b][4 * g + 0] * inv, o[b][4 * g + 1] * inv); pk.y = cvtpk(o[b][4 * g + 2] * inv, o[b][4 * g + 3] * inv);
            *(u32x2_t*)(orow + 32 * b + 8 * g + 4 * h) = pk; }
}
struct SrcMlaP { const bf16_t* kn; const bf16_t* kpe; const bf16_t* vt; const bf16_t* qraw; const bf16_t* qpe; int b, hh; size_t row0;
    DI bf16x8 qfrag(int r, int s_, int h8) const { return s_ < 8 ? *(const bf16x8*)(qraw + (row0 + r) * 1536 + hh * DQH + 16 * s_ + 8 * h8) : *(const bf16x8*)(qpe + (row0 + r) * 512 + hh * DROPE + 16 * (s_ - 8) + 8 * h8); }
    DI u32x4_t kpiece(int key, int d8) const { const size_t row = (size_t)b * SEQ + key;
        return d8 < 16 ? *(const u32x4_t*)(kn + row * 1024 + hh * DNOPE + d8 * 8) : *(const u32x4_t*)(kpe + row * DROPE + (d8 - 16) * 8); }
    DI u32x4_t vpiece(int dv, int key0) const { return *(const u32x4_t*)(vt + (size_t)(hh * DVH + dv) * NP + (size_t)b * SEQ + key0); } };
struct SrcMemP { const bf16_t* mk; const bf16_t* mvt; const bf16_t* xq; int b, hh; size_t row0;
    DI bf16x8 qfrag(int r, int s_, int h8) const { return *(const bf16x8*)(xq + (row0 + r) * ZLD + hh * XHD + 16 * s_ + 8 * h8); }
    DI u32x4_t kpiece(int key, int d8) const { return *(const u32x4_t*)(mk + ((size_t)b * NMEM + key) * 256 + hh * XHD + d8 * 8); }
    DI u32x4_t vpiece(int dv, int key0) const { return *(const u32x4_t*)(mvt + (size_t)(hh * XHD + dv) * (NB * NMEM) + (size_t)b * NMEM + key0); } };


typedef short v4i16_t __attribute__((ext_vector_type(4)));
DI s16x4 vtr(const LAS unsigned char* p) { return __builtin_bit_cast(s16x4, __builtin_amdgcn_ds_read_tr16_b64_v4i16((LAS v4i16_t*)p)); }
constexpr int MS_NSPLIT = 2, MS_KEYS = PAST / MS_NSPLIT, MS_TILES = MS_KEYS / 64;
DI void mla_sample_unit(LAS unsigned char* lds, const float* __restrict__ cckv, const float* __restrict__ ckpe, const int* __restrict__ pt,
                        const bf16_t* __restrict__ QLATb, const bf16_t* __restrict__ QPEb, float* __restrict__ PO, float* __restrict__ PML, int b, int split, float c2) {
    constexpr int KP = 328, KBYTES = 64 * KP * 2, SP = 68;
    LAS float* Sc = (LAS float*)(lds + 2 * KBYTES);
    const int tid = threadIdx.x, lane = tid & 63, w = __builtin_amdgcn_readfirstlane(tid >> 6), l31 = lane & 31, hh = lane >> 5, l15 = lane & 15, g4 = lane >> 4;
    const int kg = w >> 1, qg = w & 1;
    bf16x8 qf[10];
    { const int qi = 16 * qg + l15, t = qi >> 3, head = qi & 7;
      const bf16_t* ql = QLATb + (size_t)(b * DS + t) * 2048 + head * KVL + 8 * g4;
      const bf16_t* qp = QPEb + (size_t)(NP + b * DS + t) * 512 + head * DROPE + 8 * g4;
#pragma unroll
      for (int s_ = 0; s_ < 8; ++s_) qf[s_] = *(const bf16x8*)(ql + 32 * s_);
#pragma unroll
      for (int s_ = 0; s_ < 2; ++s_) qf[8 + s_] = *(const bf16x8*)(qp + 32 * s_); }
    f32x16 o;
#pragma unroll
    for (int i = 0; i < 16; ++i) o[i] = 0.f;
    float m = -INFINITY, lsum = 0.f;
    f32x4 crA[8], prA[2], crB[8], prB[2];
    const unsigned voffc = (unsigned)(((tid >> 6) * KVL + 4 * (tid & 63)) * 4), voffp = (unsigned)(((tid >> 4) * DROPE + 4 * (tid & 15)) * 4);
#define MS_LOAD(t_, CR_, PR_) do { const int key0_ = split * MS_KEYS + 64 * (t_); const int pg_ = __builtin_amdgcn_readfirstlane(pt[b * NPAGES + (key0_ >> 7)]); \
        const size_t rowb_ = (size_t)pg_ * PAGE + (key0_ & (PAGE - 1)); const char* cb_ = (const char*)(cckv + rowb_ * KVL); const char* pb_ = (const char*)(ckpe + rowb_ * DROPE); \
        _Pragma("unroll") for (int i_ = 0; i_ < 8; ++i_) CR_[i_] = __builtin_nontemporal_load((const f32x4*)(cb_ + (size_t)i_ * (8 * KVL * 4) + voffc)); \
        _Pragma("unroll") for (int i_ = 0; i_ < 2; ++i_) PR_[i_] = __builtin_nontemporal_load((const f32x4*)(pb_ + (size_t)i_ * (32 * DROPE * 4) + voffp)); } while (0)
#define MS_STORE(buf_, CR_, PR_) do { \
        _Pragma("unroll") for (int i_ = 0; i_ < 8; ++i_) { const int pc_ = tid + i_ * NTHREADS; *(LAS u32x2_t*)(lds + (buf_) * KBYTES + ((pc_ >> 6) * KP + 4 * (pc_ & 63)) * 2) = (u32x2_t){cvtpk(CR_[i_][0], CR_[i_][1]), cvtpk(CR_[i_][2], CR_[i_][3])}; } \
        _Pragma("unroll") for (int i_ = 0; i_ < 2; ++i_) { const int pc_ = tid + i_ * NTHREADS; *(LAS u32x2_t*)(lds + (buf_) * KBYTES + ((pc_ >> 4) * KP + KVL + 4 * (pc_ & 15)) * 2) = (u32x2_t){cvtpk(PR_[i_][0], PR_[i_][1]), cvtpk(PR_[i_][2], PR_[i_][3])}; } } while (0)
    __syncthreads();
    MS_LOAD(0, crA, prA); MS_LOAD(1, crB, prB); MS_STORE(0, crA, prA); MS_LOAD(2, crA, prA);
    __syncthreads();
    const int q4 = (lane & 15) >> 2, p4 = lane & 3, blk = (lane >> 4) & 1;
    auto tile = [&](const int buf) __attribute__((always_inline)) {
        const LAS unsigned char* kb_ = lds + buf * KBYTES;
        {   f32x4 s4 = {0.f, 0.f, 0.f, 0.f};
            const LAS unsigned char* kr_ = kb_ + ((16 * kg + l15) * KP + 8 * g4) * 2;
#pragma unroll
            for (int g_ = 0; g_ < 2; ++g_) { bf16x8 kf[5];
#pragma unroll
                for (int j = 0; j < 5; ++j) kf[j] = *(const LAS bf16x8*)(kr_ + 64 * (5 * g_ + j));
#pragma unroll
                for (int j = 0; j < 5; ++j) s4 = __builtin_amdgcn_mfma_f32_16x16x32_bf16(kf[j], qf[5 * g_ + j], s4, 0, 0, 0); }
            *(LAS f32x4*)(Sc + (16 * qg + l15) * SP + 16 * kg + 4 * g4) = s4; }
        __syncthreads();
        f32x4 sv[8];
#pragma unroll
        for (int i = 0; i < 8; ++i) sv[i] = *(const LAS f32x4*)(Sc + l31 * SP + 8 * i + 4 * hh);
        float mx = -INFINITY;
#pragma unroll
        for (int i = 0; i < 8; ++i) mx = fmaxf(mx, fmaxf(fmaxf(sv[i][0], sv[i][1]), fmaxf(sv[i][2], sv[i][3])));
        mx = fmaxf(mx, __shfl_xor(mx, 32));
        const float mn = fmaxf(m, mx);
        if (__builtin_amdgcn_ballot_w64(mn > m) != 0ull) {
            const float alpha = __builtin_amdgcn_exp2f((m - mn) * c2);
            lsum *= alpha;
#pragma unroll
            for (int i = 0; i < 16; ++i) o[i] *= alpha;
            m = mn;
        }
        const float nmc = -mn * c2;
        float ps = 0.f;
#pragma unroll
        for (int i = 0; i < 8; ++i)
#pragma unroll
            for (int e = 0; e < 4; ++e) { const float p = __builtin_amdgcn_exp2f(__builtin_fmaf(sv[i][e], c2, nmc)); sv[i][e] = p; ps += p; }
        lsum += ps;
#pragma unroll
        for (int ks = 0; ks < 4; ++ks) { const LAS unsigned char* a_ = kb_ + ((16 * ks + 4 * hh + q4) * KP + 32 * w + 16 * blk + 4 * p4) * 2;
            const s16x4 lo = vtr(a_), hi = vtr(a_ + 8 * KP * 2);
            const bf16x8 vf = __builtin_shufflevector(lo, hi, 0, 1, 2, 3, 4, 5, 6, 7); u32x4_t pk;
            pk.x = cvtpk(sv[2 * ks][0], sv[2 * ks][1]); pk.y = cvtpk(sv[2 * ks][2], sv[2 * ks][3]);
            pk.z = cvtpk(sv[2 * ks + 1][0], sv[2 * ks + 1][1]); pk.w = cvtpk(sv[2 * ks + 1][2], sv[2 * ks + 1][3]);
            o = MFMA32(vf, __builtin_bit_cast(bf16x8, pk), o); }
    };
    static_assert(MS_TILES % 2 == 0 && MS_TILES >= 4 && 2 * KBYTES + 32 * SP * 4 <= MISC_OFF, "mla_sample_unit pipeline");
#pragma unroll 1
    for (int t = 0; t < MS_TILES; t += 2) {
        tile(0);
        MS_STORE(1, crB, prB);
        if (t + 3 < MS_TILES) MS_LOAD(t + 3, crB, prB);
        __syncthreads();
        tile(1);
        if (t + 2 < MS_TILES) { MS_STORE(0, crA, prA); }
        if (t + 4 < MS_TILES) MS_LOAD(t + 4, crA, prA);
        __syncthreads();
    }
#undef MS_LOAD
#undef MS_STORE
    lsum += __shfl_xor(lsum, 32);
    const int item = b * MS_NSPLIT + split;
    if (w == 0 && lane < 32) { PML[(item * 32 + lane) * 2] = m * c2; PML[(item * 32 + lane) * 2 + 1] = lsum; }
#pragma unroll
    for (int i = 0; i < 16; ++i) PO[((size_t)item * 32 + l31) * KVL + 32 * w + crow(i, hh)] = o[i];
}


DI void ret_fused_phase(LAS unsigned char* lds, const bf16_t* __restrict__ RQt, const bf16_t* __restrict__ RKt, const bf16_t* __restrict__ RVT, bf16_t* __restrict__ ORETb, float* __restrict__ state_out, int bid, int G) {
    constexpr int PITCH = 136, KT_B = 128 * PITCH * 2, VT_B = 32 * PITCH * 2, NCH = SEQ / 128;
    int tid_ = threadIdx.x; asm volatile("" : "+v"(tid_));
    const int tid = tid_, lane = tid & 63, w = __builtin_amdgcn_readfirstlane(tid >> 6), l31 = lane & 31, hh = lane >> 5;
    const int ib = w < 4 ? 3 - (w >> 1) : (w >> 1) - 2, kh = w & 1;
    const int q4 = (lane & 15) >> 2, p4 = lane & 3, blk = (lane >> 4) & 1;
    LAS unsigned char* Kt = lds; LAS unsigned char* Vt = lds + KT_B; LAS unsigned char* SPl = Vt + VT_B; LAS float* RED = (LAS float*)(SPl + VT_B);
    static_assert(KT_B + 2 * VT_B + 4 * 16 * 64 * 4 <= MISC_OFF, "ret_fused_phase LDS");
    for (int it = bid; it < NB * RH * 8; it += G) {
        const int ds = it & 7, h = (it >> 3) & 3, b = it >> 5; const float g128 = __expf(128.f * lg_gamma(h));
        f32x16 S;
#pragma unroll
        for (int i = 0; i < 16; ++i) S[i] = 0.f;
        u32x4_t kreg[4], vreg;
#define RF_LOAD(c_) do { const size_t tok0_ = (size_t)b * SEQ + (c_) * 128; \
            _Pragma("unroll") for (int i_ = 0; i_ < 4; ++i_) { const int p_ = tid + i_ * NTHREADS; kreg[i_] = *(const u32x4_t*)(RKt + (tok0_ + (p_ >> 4)) * 512 + h * RDK + 8 * (p_ & 15)); } \
            vreg = *(const u32x4_t*)(RVT + (size_t)(h * RDV + 32 * ds + (tid >> 4)) * NT + tok0_ + 8 * (tid & 15)); } while (0)
#define RF_LOADQ(c_, Q_) do { const bf16_t* qp_ = RQt + ((size_t)b * SEQ + (c_) * 128 + 32 * ib + l31) * 512 + h * RDK + 64 * kh + 8 * hh; _Pragma("unroll") for (int s_ = 0; s_ < 4; ++s_) Q_[s_] = *(const bf16x8*)(qp_ + 16 * s_); } while (0)
        bf16x8 qf[4], qfn[4];
        RF_LOAD(0); RF_LOADQ(0, qfn);
        __syncthreads();
        for (int i = tid; i < VT_B / 16; i += NTHREADS) *(LAS u32x4_t*)(SPl + i * 16) = (u32x4_t){0u, 0u, 0u, 0u};
        u32x2_t opk[4] = {{0u, 0u}, {0u, 0u}, {0u, 0u}, {0u, 0u}};
#define RF_FLUSH(c_) do { if (kh == 0) { bf16_t* orow_ = ORETb + ((size_t)b * SEQ + (c_) * 128 + 32 * ib + l31) * 1024 + h * RDV + 32 * ds + 4 * hh; \
            _Pragma("unroll") for (int g_ = 0; g_ < 4; ++g_) *(u32x2_t*)(orow_ + 8 * g_) = opk[g_]; } } while (0)
#pragma unroll 1
        for (int c = 0; c < NCH; ++c) {
            const size_t tok0 = (size_t)b * SEQ + c * 128; (void)tok0;
#pragma unroll
            for (int i = 0; i < 4; ++i) { const int p = tid + i * NTHREADS; *(LAS u32x4_t*)(Kt + ((p >> 4) * PITCH + 8 * (p & 15)) * 2) = kreg[i]; }
            *(LAS u32x4_t*)(Vt + ((tid >> 4) * PITCH + 8 * (tid & 15)) * 2) = vreg;
#pragma unroll
            for (int s_ = 0; s_ < 4; ++s_) qf[s_] = qfn[s_];
            __syncthreads();
            if (c > 0) RF_FLUSH(c - 1);
            if (c + 1 < NCH) { RF_LOAD(c + 1); RF_LOADQ(c + 1, qfn); }
            f32x16 o, o1;
#pragma unroll
            for (int i = 0; i < 16; ++i) { o[i] = 0.f; o1[i] = 0.f; }
#pragma unroll 1
            for (int jb = 0; jb <= ib; ++jb) {
                f32x16 x, x1;
#pragma unroll
                for (int i = 0; i < 16; ++i) { x[i] = 0.f; x1[i] = 0.f; }
#pragma unroll
                for (int s_ = 0; s_ < 2; ++s_) { const LAS unsigned char* kp_ = Kt + ((32 * jb + l31) * PITCH + 64 * kh + 16 * s_ + 8 * hh) * 2;
                    x = MFMA32(*(const LAS bf16x8*)kp_, qf[s_], x); x1 = MFMA32(*(const LAS bf16x8*)(kp_ + 64), qf[s_ + 2], x1); }
#pragma unroll
                for (int i = 0; i < 16; ++i) x[i] += x1[i];
                if (jb == ib) {
#pragma unroll
                    for (int i = 0; i < 16; ++i) x[i] = (crow(i, hh) <= l31) ? x[i] : 0.f;
                }
#pragma unroll
                for (int s2 = 0; s2 < 2; ++s2) {
                    u32x4_t pk; pk.x = cvtpk(x[8 * s2 + 0], x[8 * s2 + 1]); pk.y = cvtpk(x[8 * s2 + 2], x[8 * s2 + 3]); pk.z = cvtpk(x[8 * s2 + 4], x[8 * s2 + 5]); pk.w = cvtpk(x[8 * s2 + 6], x[8 * s2 + 7]);
                    const LAS unsigned char* vp = Vt + (l31 * PITCH + 32 * jb + 16 * s2 + 4 * hh) * 2;
                    const s16x4 lo = *(const LAS s16x4*)vp, hi = *(const LAS s16x4*)(vp + 16);
                    if (s2 == 0) o = MFMA32(__builtin_shufflevector(lo, hi, 0, 1, 2, 3, 4, 5, 6, 7), __builtin_bit_cast(bf16x8, pk), o);
                    else o1 = MFMA32(__builtin_shufflevector(lo, hi, 0, 1, 2, 3, 4, 5, 6, 7), __builtin_bit_cast(bf16x8, pk), o1); }
            }
#pragma unroll
            for (int s_ = 0; s_ < 2; ++s_) { const LAS unsigned char* sp_ = SPl + (l31 * PITCH + 64 * kh + 16 * s_ + 8 * hh) * 2;
                o = MFMA32(*(const LAS bf16x8*)sp_, qf[s_], o); o1 = MFMA32(*(const LAS bf16x8*)(sp_ + 64), qf[s_ + 2], o1); }
#pragma unroll
            for (int i = 0; i < 16; ++i) o[i] += o1[i];
            if (kh == 1) {
#pragma unroll
                for (int i = 0; i < 16; ++i) RED[(ib * 16 + i) * 64 + lane] = o[i];
            }
            if (w < 4) {
                f32x16 u, u1;
#pragma unroll
                for (int i = 0; i < 16; ++i) { u[i] = 0.f; u1[i] = 0.f; }
#pragma unroll
                for (int s_ = 0; s_ < 8; ++s_) { const LAS unsigned char* a_ = Kt + ((16 * s_ + 4 * hh + q4) * PITCH + 32 * w + 16 * blk + 4 * p4) * 2;
                    const s16x4 alo = vtr(a_), ahi = vtr(a_ + 8 * PITCH * 2);
                    const LAS unsigned char* vp = Vt + (l31 * PITCH + 16 * s_ + 4 * hh) * 2;
                    const s16x4 blo = *(const LAS s16x4*)vp, bhi = *(const LAS s16x4*)(vp + 16);
                    if (s_ & 1) u1 = MFMA32(__builtin_shufflevector(alo, ahi, 0, 1, 2, 3, 4, 5, 6, 7), __builtin_shufflevector(blo, bhi, 0, 1, 2, 3, 4, 5, 6, 7), u1);
                    else u = MFMA32(__builtin_shufflevector(alo, ahi, 0, 1, 2, 3, 4, 5, 6, 7), __builtin_shufflevector(blo, bhi, 0, 1, 2, 3, 4, 5, 6, 7), u); }
#pragma unroll
                for (int i = 0; i < 16; ++i) S[i] = S[i] * g128 + (u[i] + u1[i]);
            }
            __syncthreads();
            if (kh == 0) {
#pragma unroll
                for (int g = 0; g < 4; ++g) { const float o0 = o[4 * g + 0] + RED[(ib * 16 + 4 * g + 0) * 64 + lane], o1 = o[4 * g + 1] + RED[(ib * 16 + 4 * g + 1) * 64 + lane],
                                                       o2 = o[4 * g + 2] + RED[(ib * 16 + 4 * g + 2) * 64 + lane], o3 = o[4 * g + 3] + RED[(ib * 16 + 4 * g + 3) * 64 + lane];
                    opk[g] = (u32x2_t){cvtpk(o0, o1), cvtpk(o2, o3)}; }
            }
            if (w < 4) {
#pragma unroll
                for (int g = 0; g < 4; ++g) *(LAS u32x2_t*)(SPl + (l31 * PITCH + 32 * w + 8 * g + 4 * hh) * 2) = (u32x2_t){cvtpk(S[4 * g + 0] * g128, S[4 * g + 1] * g128), cvtpk(S[4 * g + 2] * g128, S[4 * g + 3] * g128)};
            }
        }
        RF_FLUSH(NCH - 1);
#undef RF_LOAD
#undef RF_LOADQ
#undef RF_FLUSH
        if (w < 4) {
            float* so = state_out + ((size_t)(b * RH + h) * RDK + 32 * w) * RDV + 32 * ds + l31;
#pragma unroll
            for (int i = 0; i < 16; ++i) so[(size_t)crow(i, hh) * RDV] = S[i];
        }
    }
}

struct QPtr { const float* p; DI float operator()(int d) const { return p[d]; } };
struct QMla { const float* ql; const float* qp; DI float operator()(int d) const { return d < KVL ? ql[d] : qp[d - KVL]; } };
DI void rms_row(const float* x, const float* g, float* o, int n, int lane) {
    float s = 0.f;
    for (int i = lane; i < n; i += 64) { const float v = x[i]; s += v * v; }
    const float r = rsqrtf(wave_sum(s) / (float)n + EPS);
    for (int i = lane; i < n; i += 64) o[i] = x[i] * r * g[i];
}

DI void rms_row_bf16(const float* x, const float* g, bf16_t* o, int n, int lane) {
    float s = 0.f;
    for (int i = lane; i < n; i += 64) { const float v = x[i]; s += v * v; }
    const float r = rsqrtf(wave_sum(s) / (float)n + EPS);
    for (int i = lane; i < n; i += 64) o[i] = f2bf(x[i] * r * g[i]);
}
#define GEMM_PHASE(EPI, ...) pg8::gemm_phase<EPI, pg8::StaticOrder, true, true>(__VA_ARGS__)
#define GEMM_SPLIT(...) pg8::gemm_phase<pg8::EpiPart, pg8::SplitOrder, true, true>(__VA_ARGS__)
__global__ void __launch_bounds__(NTHREADS, 2) fwd_kernel(Args args) {
    extern __shared__ __attribute__((aligned(16))) unsigned char lds_raw[];
    LAS unsigned char* ldsb = (LAS unsigned char*)lds_raw;
    LAS float* lds = (LAS float*)ldsb;
    volatile LAS unsigned* MISC = (volatile LAS unsigned*)(ldsb + MISC_OFF);
    const int tid = threadIdx.x, lane = tid & 63, wave = tid >> 6;
    const int G = gridDim.x, bid = blockIdx.x;
    const int gw = bid * NWAVES + wave, NGW = G * NWAVES;
    unsigned char* ws = args.ws;
    float* out = args.out;
    const int lo = args.ph_lo, hi = args.ph_hi;

    if (tid < 64) MISC[tid] = 0u;
    __syncthreads();
    XcdBarrier bar; bar.bar = (unsigned*)(ws + WS_CTL) + CW_BAR; bar.x = 0; bar.st = MISC;
    if (hi - lo > 1) bar = xcd_barrier_post((unsigned*)(ws + WS_CTL) + CW_BAR, MISC);
#define IN(k) (lo <= (k) && (k) < hi)
#define PHASE_IDS int tid_l_ = threadIdx.x; asm volatile("" : "+v"(tid_l_)); const int tid = tid_l_, lane = tid & 63, wave = tid >> 6, gw = bid * NWAVES + wave; (void)tid; (void)lane; (void)wave; (void)gw;
#define SEAM(k) do { if (IN(k) && IN((k) + 1)) xcd_barrier(bar); } while (0)

#define x_prompt ((const float*)(args.in[0]))
#define x_sample ((const float*)(args.in[1]))
#define mem_prompt ((const float*)(args.in[2]))
#define cache_ckv ((const float*)(args.in[3]))
#define cache_kpe ((const float*)(args.in[4]))
#define page_table ((const int*)args.in[5])
#define state_ret ((const float*)(args.in[6]))
#define cache_mem_k ((const float*)(args.in[7]))
#define cache_mem_v ((const float*)(args.in[8]))
#define g_mix_pre ((const float*)(args.in[9]))
#define g_mix_post ((const float*)(args.in[10]))
#define g_ffn_pre ((const float*)(args.in[11]))
#define g_ffn_post ((const float*)(args.in[12]))
#define g_mem ((const float*)(args.in[13]))
#define g_qlat ((const float*)(args.in[14]))
#define g_kvlat ((const float*)(args.in[15]))
#define w_in ((const float*)(args.in[16]))
#define w_uq ((const float*)(args.in[17]))
#define w_uk ((const float*)(args.in[18]))
#define w_uv ((const float*)(args.in[19]))
#define w_mem_k ((const float*)(args.in[20]))
#define w_mem_v ((const float*)(args.in[21]))
#define w_ret_o ((const float*)(args.in[22]))
#define w_mla_o ((const float*)(args.in[23]))
#define w_x_o ((const float*)(args.in[24]))
#define w_out ((const float*)(args.in[25]))
#define w_gate ((const float*)(args.in[26]))
#define w_up ((const float*)(args.in[27]))
#define w_down ((const float*)(args.in[28]))
#define COSA ((float*)(ws + WS_COSA))
#define SINA ((float*)(ws + WS_SINA))
#define COSB ((float*)(ws + WS_COSB))
#define SINB ((float*)(ws + WS_SINB))
#define U ((float*)(ws + WS_U))
#define MN ((float*)(ws + WS_MN))
#define Zb ((bf16_t*)(ws + WS_Z))
#define RQ ((float*)(ws + WS_RQ))
#define RK ((float*)(ws + WS_RK))
#define CQN ((float*)(ws + WS_CQN))
#define CKVN ((float*)(ws + WS_CKVN))
#define KPER ((float*)(ws + WS_KPER))
#define Q ((float*)(ws + WS_Q))
#define QLAT ((float*)(ws + WS_QLAT))
#define QPE ((float*)(ws + WS_QPE))
#define ORETb ((bf16_t*)(ws + WS_ORET))
#define OLAT ((float*)(ws + WS_OLAT))
#define OX ((float*)(ws + WS_OX))
#define OMLA ((float*)(ws + WS_OMLA))
#define ORETN ((float*)(ws + WS_ORETN))
#define ARET ((float*)(ws + WS_ARET))
#define AMLA ((float*)(ws + WS_AMLA))
#define AX ((float*)(ws + WS_AX))
#define MIX ((float*)(ws + WS_MIX))
#define HPb ((bf16_t*)(ws + WS_HP))
#define Hb ((bf16_t*)(ws + WS_H))
#define F ((float*)(ws + WS_F))
#define GU ((float*)(ws + WS_GG))
#define FOb ((bf16_t*)(ws + WS_FO))
#define WinT ((bf16_t*)(ws + WS_WIN_T))
#define WmkvT ((bf16_t*)(ws + WS_WMKV_T))
#define WuqT ((bf16_t*)(ws + WS_WUQ_T))
#define WcatT ((bf16_t*)(ws + WS_WRO_T))
#define CATb ((bf16_t*)(ws + WS_ORETNB))
#define WroT ((bf16_t*)(ws + WS_WRO_T))
#define WmoT ((bf16_t*)(ws + WS_WMO_T))
#define WxoT ((bf16_t*)(ws + WS_WXO_T))
#define WoT ((bf16_t*)(ws + WS_WO_T))
#define WguT ((bf16_t*)(ws + WS_WGU_T))
#define WdT ((bf16_t*)(ws + WS_WD_T))
#define Ub ((bf16_t*)(ws + WS_UB))
#define MNb ((bf16_t*)(ws + WS_MNB))
#define CQNb ((bf16_t*)(ws + WS_CQNB))
#define ORETNb ((bf16_t*)(ws + WS_ORETNB))
#define OMLAb ((bf16_t*)(ws + WS_OMLAB))
#define OXb ((bf16_t*)(ws + WS_OXB))
#define MIXb ((bf16_t*)(ws + WS_MIXB))
#define Fb ((bf16_t*)(ws + WS_FB))
#define ACTb ((bf16_t*)(ws + WS_ACTB))
#define WukT ((bf16_t*)(ws + WS_WUK_T))
#define WuvT ((bf16_t*)(ws + WS_WUV_T))
#define CKVNb ((bf16_t*)(ws + WS_CKVNB))
#define KPERb ((bf16_t*)(ws + WS_KPERB))
#define XQb ((bf16_t*)(ws + WS_XQB))
#define MKb ((bf16_t*)(ws + WS_MKB))
#define MVT ((bf16_t*)(ws + WS_MVT))
#define KN ((bf16_t*)(ws + WS_KN))
#define VT ((bf16_t*)(ws + WS_VT))
#define Qb ((bf16_t*)(ws + WS_QB))
#define RQt ((bf16_t*)(ws + WS_RQT))
#define RKt ((bf16_t*)(ws + WS_RKT))
#define RKtT ((bf16_t*)(ws + WS_RKTT))
#define RVT ((bf16_t*)(ws + WS_RVT))
#define UT ((float*)(ws + WS_UT))
#define SPT ((bf16_t*)(ws + WS_SPT))
#define QPEb ((bf16_t*)(ws + WS_QPEB))
#define WukB ((bf16_t*)(ws + WS_WUKB))
#define PART ((float*)(ws + WS_PART))
#define SGb ((bf16_t*)(ws + WS_SGB))
#define SRGb ((bf16_t*)(ws + WS_SRGB))
#define T0b ((bf16_t*)(ws + WS_T0B))
#define T1b ((bf16_t*)(ws + WS_T1B))
#define QLATb ((bf16_t*)(ws + WS_QLATB))
#define PO ((float*)(ws + WS_PO))
#define PML ((float*)(ws + WS_PML))
    if (IN(0)) { PHASE_IDS
        for (int i = bid * NTHREADS + tid; i < NPOS * 64 + NPOS * 32; i += G * NTHREADS) {
            const bool a = i < NPOS * 64; const int j = a ? i : i - NPOS * 64; const int half = a ? 64 : 32;
            const int p = j / half, f = j % half; const int pos = p < SEQ ? p : PAST + (p - SEQ);
            const float inv = powf(10000.0f, -(float)f / (float)half);
            const float ang = (float)pos * inv;
            double rev = (double)ang * 0.15915494309189535; rev -= floor(rev);
            const float r = (float)rev;
            const float sn = __builtin_amdgcn_sinf(r), cs = __builtin_amdgcn_cosf(r);
            if (a) { COSA[j] = cs; SINA[j] = sn; } else { COSB[j] = cs; SINB[j] = sn; }
        }
#pragma unroll 1
        for (int pass = 0; pass < 2; ++pass) {
            const int nrows = pass ? NB * NMEM : NT; const float* gsrc = pass ? g_mem : g_mix_pre; bf16_t* dst = pass ? MNb : Ub;
            f32x4 a[4];
#define P0_SRC(r_) (pass ? mem_prompt + (size_t)(r_) * DM : (r_) < NP ? x_prompt + (size_t)(r_) * DM : x_sample + (size_t)((r_) - NP) * DM)
#define P0_LOAD(r_, A_) do { const float* s_ = P0_SRC(r_); _Pragma("unroll") for (int j_ = 0; j_ < 4; ++j_) A_[j_] = *(const f32x4*)(s_ + 4 * lane + 256 * j_); } while (0)
            int row = gw;
            if (row < nrows) P0_LOAD(row, a);
#pragma unroll 1
            for (; row < nrows; row += NGW) {
                f32x4 an[4]; const int nr = row + NGW;
                if (nr < nrows) P0_LOAD(nr, an);
                float ss = 0.f;
#pragma unroll
                for (int j = 0; j < 4; ++j) ss += a[j][0] * a[j][0] + a[j][1] * a[j][1] + a[j][2] * a[j][2] + a[j][3] * a[j][3];
                const float r = rsqrtf(wave_sum(ss) * (1.f / DM) + EPS);
#pragma unroll
                for (int j = 0; j < 4; ++j) { const f32x4 v = a[j] * r * *(const f32x4*)(gsrc + 4 * lane + 256 * j); *(u32x2_t*)(dst + (size_t)row * DM + 4 * lane + 256 * j) = (u32x2_t){cvtpk(v[0], v[1]), cvtpk(v[2], v[3])}; }
#pragma unroll
                for (int j = 0; j < 4; ++j) a[j] = an[j];
            }
#undef P0_LOAD
#undef P0_SRC
        }
        {
            LAS float* scr = lds + wave * (64 * 33);
            int rot = 0;
            transpose_w(w_in, 1024, DIN, WinT, 1024, 0, scr, gw, NGW, lane, rot);
            for (int i = bid * NTHREADS + tid; i < (ZLD - DIN) * 1024 / 2; i += G * NTHREADS) ((unsigned*)(WinT + (size_t)DIN * 1024))[i] = 0u;
            for (int i = bid * NTHREADS + tid; i < MH * KVL * DNOPE / 4; i += G * NTHREADS) { const f32x4 v = *(const f32x4*)(w_uk + 4 * (size_t)i); *(u32x2_t*)(WukB + 4 * (size_t)i) = (u32x2_t){cvtpk(v[0], v[1]), cvtpk(v[2], v[3])}; }
            transpose_w(w_mem_k, 1024, 256, WmkvT, 1024, 0, scr, gw, NGW, lane, rot);
            transpose_w(w_mem_v, 1024, 256, WmkvT, 1024, 256, scr, gw, NGW, lane, rot);
            transpose_w(w_uq, QL, 1536, WuqT, QL, 0, scr, gw, NGW, lane, rot);
            transpose_w(w_ret_o, 1024, 1024, WcatT, CATLD, 0, scr, gw, NGW, lane, rot);
            transpose_w(w_mla_o, 1024, 1024, WcatT + 1024, CATLD, 0, scr, gw, NGW, lane, rot);
            transpose_w(w_x_o, 256, 1024, WcatT + 2048, CATLD, 0, scr, gw, NGW, lane, rot);
            transpose_w(w_out, 1024, 1024, WoT, 1024, 0, scr, gw, NGW, lane, rot);
            transpose_w(w_gate, 1024, DFF, WguT, 1024, 0, scr, gw, NGW, lane, rot, 2);
            transpose_w(w_up, 1024, DFF, WguT, 1024, 1, scr, gw, NGW, lane, rot, 2);
            transpose_w(w_down, DFF, 1024, WdT, DFF, 0, scr, gw, NGW, lane, rot);
            for (int hh = 0; hh < MH; ++hh) { transpose_w(w_uk + (size_t)hh * KVL * DNOPE, KVL, DNOPE, WukT, KVL, hh * DNOPE, scr, gw, NGW, lane, rot);
                                              transpose_w(w_uv + (size_t)hh * KVL * DVH, KVL, DVH, WuvT, KVL, hh * DVH, scr, gw, NGW, lane, rot); }
        }
    }
    SEAM(0);
    if (IN(1)) {
        static_assert(WS_MNB == WS_UB + (size_t)NT * 1024 * 2 && WS_WMKV_T == WS_WIN_T + (size_t)ZLD * 1024 * 2, "P1 stacks Ub|MNb and WinT|WmkvT");
        { pg8::Gemm g{Ub, WinT, NT + NB * NMEM, ZLD + 512, 1024, 1024, 1024}; pg8::P1Order S; S.init(G, bid); pg8::EpiP1 E{Zb, ZLD, out + O_MKP, out + O_MVP, SRGb, SGb, C_RG, C_G};
          pg8::gemm_phase<pg8::EpiP1, pg8::P1Order, true, true>(ldsb, g, S, E); }
        __syncthreads();
        { pg8::Gemm g{WinT + (size_t)C_RV * 1024, Ub, 1024, NP, 1024, 1024, 1024}; pg8::StaticOrder S; S.init(1024, NP, G, bid); pg8::EpiBf16S E{RVT, NT};
          GEMM_PHASE(pg8::EpiBf16S, ldsb, g, S, E); }
    }
    SEAM(1);
    if (IN(2)) { PHASE_IDS
        const int ntile = NP / 64, nwork = ntile + (NS + 63) / 64;
        for (int wk = bid; wk < nwork; wk += G) {
            const bool prompt = wk < ntile; const int row_base = prompt ? wk * 64 : NP + (wk - ntile) * 64;
            __syncthreads();
            {
                const int hq = lane >> 4, f4 = (lane & 15) * 4;
                u32x2_t q1, q2, k1, k2, cv, p1, p2; u32x4_t cq8; f32x4 ca, sa, cb, sb; int p;
#define P2_LOAD(r_, Q1_, Q2_, K1_, K2_, CQ_, CV_, P1_, P2_, CA_, SA_, CB_, SB_, P_) do { const bf16_t* z_ = Zb + (size_t)(row_base + (r_)) * ZLD; P_ = pos_index(row_base + (r_)); \
                Q1_ = *(const u32x2_t*)(z_ + C_RQ + hq * RDK + f4); Q2_ = *(const u32x2_t*)(z_ + C_RQ + hq * RDK + 64 + f4); K1_ = *(const u32x2_t*)(z_ + C_RK + hq * RDK + f4); K2_ = *(const u32x2_t*)(z_ + C_RK + hq * RDK + 64 + f4); \
                CQ_ = (u32x4_t){0u, 0u, 0u, 0u}; if (lane < 48) CQ_ = *(const u32x4_t*)(z_ + C_CQ + 8 * lane); CV_ = *(const u32x2_t*)(z_ + C_CKV + 4 * lane); \
                P1_ = (u32x2_t){0u, 0u}; P2_ = P1_; CB_ = (f32x4){0.f, 0.f, 0.f, 0.f}; SB_ = CB_; \
                if (lane < 8) { P1_ = *(const u32x2_t*)(z_ + C_KPE + 4 * lane); P2_ = *(const u32x2_t*)(z_ + C_KPE + 32 + 4 * lane); CB_ = *(const f32x4*)(COSB + P_ * 32 + 4 * lane); SB_ = *(const f32x4*)(SINB + P_ * 32 + 4 * lane); } \
                CA_ = *(const f32x4*)(COSA + P_ * 64 + f4); SA_ = *(const f32x4*)(SINA + P_ * 64 + f4); } while (0)
#define BLO(x_) __builtin_bit_cast(float, (x_) << 16)
#define BHI(x_) __builtin_bit_cast(float, (x_) & 0xffff0000u)
                int r = wave;
                P2_LOAD(r, q1, q2, k1, k2, cq8, cv, p1, p2, ca, sa, cb, sb, p);
                for (; r < 64; r += NWAVES) {
                    u32x2_t q1n, q2n, k1n, k2n, cvn, p1n, p2n; u32x4_t cq8n; f32x4 can, san, cbn, sbn; int pn;
                    if (r + NWAVES < 64) P2_LOAD(r + NWAVES, q1n, q2n, k1n, k2n, cq8n, cvn, p1n, p2n, can, san, cbn, sbn, pn);
                    const int row = row_base + r; const int il = p & 127;
                    {
                        const float x1q[4] = {BLO(q1.x), BHI(q1.x), BLO(q1.y), BHI(q1.y)}, x2q[4] = {BLO(q2.x), BHI(q2.x), BLO(q2.y), BHI(q2.y)};
                        const float x1k[4] = {BLO(k1.x), BHI(k1.x), BLO(k1.y), BHI(k1.y)}, x2k[4] = {BLO(k2.x), BHI(k2.x), BLO(k2.y), BHI(k2.y)};
                        const float sc = 0.08838834764831845f;
                        float oq1[4], oq2[4], ok1[4], ok2[4];
#pragma unroll
                        for (int e = 0; e < 4; ++e) { oq1[e] = x1q[e] * ca[e] - x2q[e] * sa[e]; oq2[e] = x1q[e] * sa[e] + x2q[e] * ca[e];
                            ok1[e] = (x1k[e] * ca[e] - x2k[e] * sa[e]) * sc; ok2[e] = (x1k[e] * sa[e] + x2k[e] * ca[e]) * sc; }
                        if (prompt) {
                            const float fq = __expf((float)(il - 127) * lg_gamma(hq)), fk = 1.f / fq;
                            *(u32x2_t*)(RQt + (size_t)row * 512 + hq * RDK + f4) = (u32x2_t){cvtpk(oq1[0] * fq, oq1[1] * fq), cvtpk(oq1[2] * fq, oq1[3] * fq)};
                            *(u32x2_t*)(RQt + (size_t)row * 512 + hq * RDK + 64 + f4) = (u32x2_t){cvtpk(oq2[0] * fq, oq2[1] * fq), cvtpk(oq2[2] * fq, oq2[3] * fq)};
                            const u32x2_t kb1 = {cvtpk(ok1[0] * fk, ok1[1] * fk), cvtpk(ok1[2] * fk, ok1[3] * fk)}, kb2 = {cvtpk(ok2[0] * fk, ok2[1] * fk), cvtpk(ok2[2] * fk, ok2[3] * fk)};
                            *(u32x2_t*)(RKt + (size_t)row * 512 + hq * RDK + f4) = kb1; *(u32x2_t*)(RKt + (size_t)row * 512 + hq * RDK + 64 + f4) = kb2;
                        } else {
                            *(f32x4*)(RQ + (size_t)row * 512 + hq * RDK + f4) = (f32x4){oq1[0], oq1[1], oq1[2], oq1[3]}; *(f32x4*)(RQ + (size_t)row * 512 + hq * RDK + 64 + f4) = (f32x4){oq2[0], oq2[1], oq2[2], oq2[3]};
                            *(f32x4*)(RK + (size_t)row * 512 + hq * RDK + f4) = (f32x4){ok1[0], ok1[1], ok1[2], ok1[3]}; *(f32x4*)(RK + (size_t)row * 512 + hq * RDK + 64 + f4) = (f32x4){ok2[0], ok2[1], ok2[2], ok2[3]};
                        }
                    }
                    {
                        const float c_[8] = {BLO(cq8.x), BHI(cq8.x), BLO(cq8.y), BHI(cq8.y), BLO(cq8.z), BHI(cq8.z), BLO(cq8.w), BHI(cq8.w)};
                        float ss = 0.f;
#pragma unroll
                        for (int e = 0; e < 8; ++e) ss += c_[e] * c_[e];
                        const float rr = rsqrtf(wave_sum(ss) * (1.f / QL) + EPS);
                        if (lane < 48) { const f32x4 g0 = *(const f32x4*)(g_qlat + 8 * lane), g1 = *(const f32x4*)(g_qlat + 8 * lane + 4);
                            *(u32x4_t*)(CQNb + (size_t)row * QL + 8 * lane) = (u32x4_t){cvtpk(c_[0] * rr * g0[0], c_[1] * rr * g0[1]), cvtpk(c_[2] * rr * g0[2], c_[3] * rr * g0[3]),
                                                                                     cvtpk(c_[4] * rr * g1[0], c_[5] * rr * g1[1]), cvtpk(c_[6] * rr * g1[2], c_[7] * rr * g1[3])}; }
                    }
                    {
                        const float v_[4] = {BLO(cv.x), BHI(cv.x), BLO(cv.y), BHI(cv.y)};
                        const float rr = rsqrtf(wave_sum(v_[0] * v_[0] + v_[1] * v_[1] + v_[2] * v_[2] + v_[3] * v_[3]) * (1.f / KVL) + EPS);
                        const f32x4 g0 = *(const f32x4*)(g_kvlat + 4 * lane); const f32x4 o_ = {v_[0] * rr * g0[0], v_[1] * rr * g0[1], v_[2] * rr * g0[2], v_[3] * rr * g0[3]};
                        float* ockv = row < NP ? out + O_CKVP + (size_t)row * KVL : out + O_CKVS + (size_t)(row - NP) * KVL;
                        *(f32x4*)(ockv + 4 * lane) = o_; *(f32x4*)(CKVN + (size_t)row * KVL + 4 * lane) = o_;
                        *(u32x2_t*)(CKVNb + (size_t)row * KVL + 4 * lane) = (u32x2_t){cvtpk(o_[0], o_[1]), cvtpk(o_[2], o_[3])};
                    }
                    if (lane < 8) {
                        const float x1[4] = {BLO(p1.x), BHI(p1.x), BLO(p1.y), BHI(p1.y)}, x2[4] = {BLO(p2.x), BHI(p2.x), BLO(p2.y), BHI(p2.y)};
                        f32x4 o1, o2;
#pragma unroll
                        for (int e = 0; e < 4; ++e) { o1[e] = x1[e] * cb[e] - x2[e] * sb[e]; o2[e] = x1[e] * sb[e] + x2[e] * cb[e]; }
                        *(f32x4*)(KPER + (size_t)row * DROPE + 4 * lane) = o1; *(f32x4*)(KPER + (size_t)row * DROPE + 32 + 4 * lane) = o2;
                        float* okpe = row < NP ? out + O_KPEP + (size_t)row * DROPE : out + O_KPES + (size_t)(row - NP) * DROPE;
                        *(f32x4*)(okpe + 4 * lane) = o1; *(f32x4*)(okpe + 32 + 4 * lane) = o2;
                        *(u32x2_t*)(KPERb + (size_t)row * DROPE + 4 * lane) = (u32x2_t){cvtpk(o1[0], o1[1]), cvtpk(o1[2], o1[3])}; *(u32x2_t*)(KPERb + (size_t)row * DROPE + 32 + 4 * lane) = (u32x2_t){cvtpk(o2[0], o2[1]), cvtpk(o2[2], o2[3])};
                    }
                    q1 = q1n; q2 = q2n; k1 = k1n; k2 = k2n; cq8 = cq8n; cv = cvn; p1 = p1n; p2 = p2n; ca = can; sa = san; cb = cbn; sb = sbn; p = pn;
                }
#undef P2_LOAD
            }
        }
    }
    if (IN(2)) { PHASE_IDS
        for (int i = bid * NTHREADS + tid; i < NB * NMEM * 256; i += G * NTHREADS) { MKb[i] = f2bf(out[O_MKP + i]);
            const int f = i / (NB * NMEM), r = i - f * (NB * NMEM); MVT[i] = f2bf(out[O_MVP + (size_t)r * 256 + f]); }
    }
    SEAM(2);
    if (IN(3)) { pg8::Gemm g{CQNb, WuqT, NT, 1536, QL, QL, QL}; pg8::StaticOrder S; S.init(NT, 1536, G, bid); pg8::EpiBf16S E{Qb, 1536};
        GEMM_PHASE(pg8::EpiBf16S, ldsb, g, S, E);
        __syncthreads();
        { pg8::Gemm g2{CKVNb, WukT, NP, 1024, KVL, KVL, KVL}; pg8::StaticOrder S2; S2.init(NP, 1024, G, bid); pg8::EpiBf16S E2{KN, 1024}; GEMM_PHASE(pg8::EpiBf16S, ldsb, g2, S2, E2); }
        __syncthreads();
        { pg8::Gemm g3{WuvT, CKVNb, 1024, NP, KVL, KVL, KVL}; pg8::StaticOrder S3; S3.init(1024, NP, G, bid); pg8::EpiBf16S E3{VT, NP}; GEMM_PHASE(pg8::EpiBf16S, ldsb, g3, S3, E3); }
        }
    SEAM(3);
    if (IN(4)) { PHASE_IDS
        {
            const int hd = lane >> 3, f4 = (lane & 7) * 4;
            u32x2_t x1, x2; f32x4 cb, sb;
#define P4_LOAD(r_, X1_, X2_, C_, S_) do { const bf16_t* q_ = Qb + (size_t)(r_) * 1536 + hd * DQH + DNOPE + f4; X1_ = *(const u32x2_t*)q_; X2_ = *(const u32x2_t*)(q_ + 32); \
            const int p_ = pos_index(r_); C_ = *(const f32x4*)(COSB + p_ * 32 + f4); S_ = *(const f32x4*)(SINB + p_ * 32 + f4); } while (0)
            int row = gw;
            if (row < NT) P4_LOAD(row, x1, x2, cb, sb);
            for (; row < NT; row += NGW) {
                u32x2_t x1n, x2n; f32x4 cbn, sbn; const int nr = row + NGW;
                if (nr < NT) P4_LOAD(nr, x1n, x2n, cbn, sbn);
                const float a0 = __builtin_bit_cast(float, x1.x << 16), a1 = __builtin_bit_cast(float, x1.x & 0xffff0000u), a2 = __builtin_bit_cast(float, x1.y << 16), a3 = __builtin_bit_cast(float, x1.y & 0xffff0000u);
                const float b0 = __builtin_bit_cast(float, x2.x << 16), b1 = __builtin_bit_cast(float, x2.x & 0xffff0000u), b2 = __builtin_bit_cast(float, x2.y << 16), b3 = __builtin_bit_cast(float, x2.y & 0xffff0000u);
                bf16_t* o_ = QPEb + (size_t)row * 512 + hd * DROPE + f4;
                *(u32x2_t*)o_ = (u32x2_t){cvtpk(a0 * cb[0] - b0 * sb[0], a1 * cb[1] - b1 * sb[1]), cvtpk(a2 * cb[2] - b2 * sb[2], a3 * cb[3] - b3 * sb[3])};
                *(u32x2_t*)(o_ + 32) = (u32x2_t){cvtpk(a0 * sb[0] + b0 * cb[0], a1 * sb[1] + b1 * cb[1]), cvtpk(a2 * sb[2] + b2 * cb[2], a3 * sb[3] + b3 * cb[3])};
                x1 = x1n; x2 = x2n; cb = cbn; sb = sbn;
            }
#undef P4_LOAD
        }
        for (int wt = gw; wt < MH * 16 * 2; wt += NGW) {
            const int lh = wt & 1, rb = (wt >> 1) & 15, head = wt >> 5; const int l31 = lane & 31, h8 = lane >> 5;
            f32x16 acc[4];
#pragma unroll
            for (int k_ = 0; k_ < 4; ++k_)
#pragma unroll
                for (int i = 0; i < 16; ++i) acc[k_][i] = 0.f;
            const bf16_t* ap = Qb + ((size_t)NP + 32 * rb + l31) * 1536 + head * DQH + 8 * h8;
            const bf16_t* bp = WukB + ((size_t)head * KVL + 128 * lh + l31) * DNOPE + 8 * h8;
#pragma unroll
            for (int s_ = 0; s_ < 8; ++s_) { const bf16x8 a = *(const bf16x8*)(ap + 16 * s_);
#pragma unroll
                for (int k_ = 0; k_ < 4; ++k_) { const bf16x8 b_ = *(const bf16x8*)(bp + (size_t)(32 * k_) * DNOPE + 16 * s_); acc[k_] = MFMA32(a, b_, acc[k_]); } }
#pragma unroll
            for (int k_ = 0; k_ < 4; ++k_)
#pragma unroll
                for (int i = 0; i < 16; ++i) QLATb[(size_t)(32 * rb + crow(i, h8)) * 2048 + head * KVL + 128 * lh + 32 * k_ + l31] = f2bf(acc[k_][i]);
        }
    }
    SEAM(4);
    if (IN(5)) { PHASE_IDS
        auto compute_units = [&]() __attribute__((always_inline)) {
        if (args.sub & 2) for (int it = bid; it < NB * MH * 4; it += G) {
            const int pr = __builtin_amdgcn_readfirstlane(it & 3), hh = __builtin_amdgcn_readfirstlane((it >> 2) & 7), b = __builtin_amdgcn_readfirstlane(it >> 5);
#pragma unroll 1
            for (int half = 0; half < 2; ++half) { const int qb = __builtin_amdgcn_readfirstlane(half ? pr : 7 - pr); const size_t row0 = (size_t)b * SEQ + qb * 256;
                SrcMlaP src{KN, KPERb, VT, Qb, QPEb, b, hh, row0};
                flash_unit<192, 128, true>(ldsb, src, qb * 256, 4 * (qb + 1), CATb + row0 * CATLD + 1024 + hh * DVH, CATLD, 0.07216878364870322f * 1.4426950408889634f); }
        }
        if (args.sub & 4) ret_fused_phase(ldsb, RQt, RKt, RVT, ORETb, out + O_RETP, bid, G);
        if (args.sub & 16) for (int it = bid; it < NB * XH * 8; it += G) {
            const int qb = __builtin_amdgcn_readfirstlane(it & 7), hh = __builtin_amdgcn_readfirstlane((it >> 3) & 3), b = __builtin_amdgcn_readfirstlane(it >> 5); const size_t row0 = (size_t)b * SEQ + qb * 256;
            SrcMemP src{MKb, MVT, Zb + C_XQ, b, hh, row0};
            flash_unit<64, 64, false>(ldsb, src, 0, 4, CATb + row0 * CATLD + 2048 + hh * XHD, CATLD, 0.125f * 1.4426950408889634f);
        }
        };
        const bool compute_first = ((bid >> 3) & 1) != 0;
        if (compute_first) compute_units();
        if (args.sub & 1) for (int it = bid; it < DB * MS_NSPLIT; it += G) { const int split = __builtin_amdgcn_readfirstlane(it % MS_NSPLIT), b = __builtin_amdgcn_readfirstlane(it / MS_NSPLIT);
            mla_sample_unit(ldsb, cache_ckv, cache_kpe, page_table, QLATb, QPEb, PO, PML, b, split, 0.07216878364870322f * 1.4426950408889634f); }
        if (args.sub & 8) for (int it = bid; it < DB * RH; it += G) {
            const int h = it & 3, b = it >> 2; const float lg = lg_gamma(h);
            const float* s0 = state_ret + (size_t)it * RDK * RDV;
            float* so = out + O_RETS + (size_t)it * RDK * RDV;
            LAS float* inner = lds;
            LAS float* qk = lds + 16;
            LAS float* vls = lds + 1040;
            LAS float* red = lds + 2064;
            f32x4 sv[16], vv[4];
#pragma unroll
            for (int r = 0; r < 16; ++r) sv[r] = __builtin_nontemporal_load((const f32x4*)(s0 + (size_t)(wave + 8 * r) * RDV + 4 * lane));
#pragma unroll
            for (int j = 0; j < DS; ++j) { const u32x2_t t_ = *(const u32x2_t*)(Zb + ((size_t)NP + b * DS + j) * ZLD + C_RV + h * RDV + 4 * lane); vv[j] = (f32x4){BLO(t_.x), BHI(t_.x), BLO(t_.y), BHI(t_.y)}; }
            __syncthreads();
            for (int i = tid; i < 1024; i += NTHREADS) { const int which = i >> 9, ti = (i >> 7) & 3, d = i & 127; const size_t row = (size_t)NP + b * DS + ti;
                qk[i] = which ? RK[row * 512 + h * RDK + d] : RQ[row * 512 + h * RDK + d]; }
            if (wave == 0) {
#pragma unroll
                for (int j = 0; j < DS; ++j) *(LAS f32x4*)(vls + j * 256 + 4 * lane) = vv[j]; }
            __syncthreads();
            for (int pr = wave; pr < 16; pr += NWAVES) { const int i = pr >> 2, j = pr & 3;
                float s_ = qk[i * 128 + lane] * qk[512 + j * 128 + lane] + qk[i * 128 + 64 + lane] * qk[512 + j * 128 + 64 + lane];
                s_ = wave_sum(s_);
                if (lane == 0) inner[pr] = (j <= i) ? s_ * __expf((float)(i - j) * lg) : 0.f; }
            const float g4 = __expf(4.f * lg), gk0 = __expf(3.f * lg), gk1 = __expf(2.f * lg), gk2 = __expf(lg);
            f32x4 po[4];
#pragma unroll
            for (int i = 0; i < 4; ++i) po[i] = (f32x4){0.f, 0.f, 0.f, 0.f};
#pragma unroll
            for (int r = 0; r < 16; ++r) { const int d = wave + 8 * r; const f32x4 sx = sv[r];
                f32x4 a = sx * g4 + (gk0 * qk[512 + d]) * vv[0] + (gk1 * qk[512 + 128 + d]) * vv[1] + (gk2 * qk[512 + 256 + d]) * vv[2] + qk[512 + 384 + d] * vv[3];
                __builtin_nontemporal_store(a, (f32x4*)(so + (size_t)d * RDV + 4 * lane));
#pragma unroll
                for (int i = 0; i < 4; ++i) po[i] += qk[i * 128 + d] * sx; }
#pragma unroll
            for (int i = 0; i < 4; ++i) *(LAS f32x4*)(red + (wave * 4 + i) * 256 + 4 * lane) = po[i];
            __syncthreads();
            {
                const int i = tid >> 7, e2 = (tid & 127) * 2;
                float o0 = 0.f, o1 = 0.f;
#pragma unroll
                for (int w_ = 0; w_ < NWAVES; ++w_) { o0 += red[(w_ * 4 + i) * 256 + e2]; o1 += red[(w_ * 4 + i) * 256 + e2 + 1]; }
                const float gi = __expf((float)(i + 1) * lg); o0 *= gi; o1 *= gi;
#pragma unroll
                for (int j = 0; j < DS; ++j) { const float w_ = inner[i * 4 + j]; o0 += w_ * vls[j * 256 + e2]; o1 += w_ * vls[j * 256 + e2 + 1]; }
                *(unsigned*)(ORETb + ((size_t)NP + b * DS + i) * 1024 + h * RDV + e2) = cvtpk(o0, o1);
            }
        }
        if (args.sub & 32) for (int it = bid; it < DB * 2; it += G) {
            const int hp = it & 1, b = it >> 1, kh = lane >> 5, hl = (lane >> 4) & 1;
            LAS float* sc = lds;
            LAS float* red = lds + 2048;
            const float* kb_ = cache_mem_k + (size_t)b * NMEM * 256 + hp * 128 + 4 * (lane & 31); const float* vb_ = cache_mem_v + (size_t)b * NMEM * 256 + hp * 128 + 4 * (lane & 31);
            f32x4 qr[4];
#pragma unroll
            for (int q = 0; q < DS; ++q) { const u32x2_t t_ = *(const u32x2_t*)(Zb + ((size_t)NP + b * DS + q) * ZLD + C_XQ + hp * 128 + 4 * (lane & 31)); qr[q] = (f32x4){BLO(t_.x), BHI(t_.x), BLO(t_.y), BHI(t_.y)}; }
            __syncthreads();
            f32x4 kv[16];
#pragma unroll
            for (int kk = 0; kk < 16; ++kk) kv[kk] = __builtin_nontemporal_load((const f32x4*)(kb_ + (size_t)(32 * wave + 2 * kk + kh) * 256));
#pragma unroll
            for (int kk = 0; kk < 16; ++kk) { const int key = 32 * wave + 2 * kk + kh;
                float pq[4];
#pragma unroll
                for (int q = 0; q < 4; ++q) { float a = kv[kk][0] * qr[q][0] + kv[kk][1] * qr[q][1] + kv[kk][2] * qr[q][2] + kv[kk][3] * qr[q][3];
                    a += __shfl_xor(a, 1); a += __shfl_xor(a, 2); a += __shfl_xor(a, 4); a += __shfl_xor(a, 8); pq[q] = a; }
                if ((lane & 15) == 0) {
#pragma unroll
                    for (int q = 0; q < 4; ++q) sc[(q * 2 + hl) * 256 + key] = pq[q] * (0.125f * 1.4426950408889634f); } }
#pragma unroll
            for (int kk = 0; kk < 16; ++kk) kv[kk] = __builtin_nontemporal_load((const f32x4*)(vb_ + (size_t)(32 * wave + 2 * kk + kh) * 256));
            __syncthreads();
            {
                f32x4 v = *(LAS f32x4*)(sc + wave * 256 + 4 * lane);
                const float mx = wave_max(fmaxf(fmaxf(v[0], v[1]), fmaxf(v[2], v[3])));
#pragma unroll
                for (int e = 0; e < 4; ++e) v[e] = __builtin_amdgcn_exp2f(v[e] - mx);
                const float inv = 1.f / wave_sum(v[0] + v[1] + v[2] + v[3]);
                *(LAS f32x4*)(sc + wave * 256 + 4 * lane) = v * inv; }
            __syncthreads();
            f32x4 acc[4];
#pragma unroll
            for (int q = 0; q < 4; ++q) acc[q] = (f32x4){0.f, 0.f, 0.f, 0.f};
#pragma unroll
            for (int kk = 0; kk < 16; ++kk) { const int key = 32 * wave + 2 * kk + kh;
#pragma unroll
                for (int q = 0; q < 4; ++q) acc[q] += sc[(q * 2 + hl) * 256 + key] * kv[kk]; }
#pragma unroll
            for (int q = 0; q < 4; ++q) *(LAS f32x4*)(red + ((wave * 2 + kh) * 4 + q) * 128 + 4 * (lane & 31)) = acc[q];
            __syncthreads();
            { const int q = tid >> 7, e = tid & 127; float o0 = 0.f;
#pragma unroll
              for (int w_ = 0; w_ < 2 * NWAVES; ++w_) o0 += red[(w_ * 4 + q) * 128 + e];
              const float o1 = __shfl_xor(o0, 1);
              if ((tid & 1) == 0) *(unsigned*)(CATb + ((size_t)NP + b * DS + q) * CATLD + 2048 + hp * 128 + e) = cvtpk(o0, o1); }
        }
        if (!compute_first) compute_units();
    }
    SEAM(5);
    if (IN(6)) { PHASE_IDS
        for (int task = bid; task < (NS / 32) * MH; task += G) {
            const int head = task & 7, rb = task >> 3, b = 8 * rb + wave; const float c2 = 0.07216878364870322f * 1.4426950408889634f;
            constexpr int OLP = 264;
            LAS bf16_t* ol = (LAS bf16_t*)ldsb;
            __syncthreads();
            float kn[DS][5];
#pragma unroll
            for (int j = 0; j < DS; ++j) { const size_t krow = (size_t)NP + b * DS + j;
#pragma unroll
                for (int c = 0; c < 5; ++c) { const int d = lane + 64 * c; kn[j][c] = d < KVL ? CKVN[krow * KVL + d] : KPER[krow * DROPE + (d - KVL)]; } }
#pragma unroll
            for (int t = 0; t < DS; ++t) {
                const int qi = t * 8 + head; const size_t qrow = (size_t)b * DS + t;
                float qv[5];
#pragma unroll
                for (int c = 0; c < 5; ++c) { const int d = lane + 64 * c; const bf16_t raw = d < KVL ? QLATb[qrow * 2048 + head * KVL + d] : QPEb[(NP + qrow) * 512 + head * DROPE + (d - KVL)];
                    qv[c] = __builtin_bit_cast(float, (unsigned)raw << 16); }
                float sc[DS]; float M = -INFINITY;
#pragma unroll
                for (int j = 0; j < DS; ++j) { float a_ = 0.f;
#pragma unroll
                    for (int c = 0; c < 5; ++c) a_ += qv[c] * kn[j][c];
                    a_ = wave_sum(a_) * c2; sc[j] = (j <= t) ? a_ : -INFINITY; M = fmaxf(M, sc[j]); }
                float ms[MS_NSPLIT], ls[MS_NSPLIT];
#pragma unroll
                for (int sp = 0; sp < MS_NSPLIT; ++sp) { const int item = b * MS_NSPLIT + sp; ms[sp] = PML[(item * 32 + qi) * 2]; ls[sp] = PML[(item * 32 + qi) * 2 + 1]; M = fmaxf(M, ms[sp]); }
                float L = 0.f; float acc[4] = {0.f, 0.f, 0.f, 0.f};
#pragma unroll
                for (int sp = 0; sp < MS_NSPLIT; ++sp) { const int item = b * MS_NSPLIT + sp; const float wgt = __builtin_amdgcn_exp2f(ms[sp] - M); L += ls[sp] * wgt;
#pragma unroll
                    for (int c = 0; c < 4; ++c) acc[c] += wgt * PO[((size_t)item * 32 + qi) * KVL + lane + 64 * c]; }
#pragma unroll
                for (int j = 0; j < DS; ++j) { const float wgt = __builtin_amdgcn_exp2f(sc[j] - M); L += wgt;
#pragma unroll
                    for (int c = 0; c < 4; ++c) acc[c] += wgt * kn[j][c]; }
                const float inv = 1.f / L;
#pragma unroll
                for (int c = 0; c < 4; ++c) ol[(4 * wave + t) * OLP + lane + 64 * c] = f2bf(acc[c] * inv);
            }
            __syncthreads();
            if (wave < 4) {
                const int l31 = lane & 31, h8 = lane >> 5;
                f32x16 acc;
#pragma unroll
                for (int i = 0; i < 16; ++i) acc[i] = 0.f;
                const bf16_t* bp = WuvT + (size_t)(head * DVH + 32 * wave + l31) * KVL + 8 * h8;
#pragma unroll
                for (int s_ = 0; s_ < 16; ++s_) { const bf16x8 a_ = *(const LAS bf16x8*)(ol + l31 * OLP + 16 * s_ + 8 * h8); const bf16x8 b_ = *(const bf16x8*)(bp + 16 * s_); acc = MFMA32(a_, b_, acc); }
#pragma unroll
                for (int i = 0; i < 16; ++i) CATb[((size_t)NP + 32 * rb + crow(i, h8)) * CATLD + 1024 + head * DVH + 32 * wave + l31] = f2bf(acc[i]);
            }
        }
        {
            f32x4 a[4]; u32x2_t gz[4];
#define P6_LOAD(r_, A_, B_) do { _Pragma("unroll") for (int j_ = 0; j_ < 4; ++j_) { { const u32x2_t o_ = *(const u32x2_t*)(ORETb + (size_t)(r_) * 1024 + 4 * lane + 256 * j_); A_[j_] = bf4_to_f32(o_.x, o_.y); } \
                                                                              B_[j_] = *(const u32x2_t*)(SRGb + (size_t)(r_) * 1024 + 4 * lane + 256 * j_); } } while (0)
            int row = gw;
            if (row < NT) P6_LOAD(row, a, gz);
            for (; row < NT; row += NGW) {
                f32x4 an[4]; u32x2_t gn[4]; const int nr = row + NGW;
                if (nr < NT) P6_LOAD(nr, an, gn);
#pragma unroll
                for (int j = 0; j < 4; ++j) {
                    const float ss = wave_sum(a[j][0] * a[j][0] + a[j][1] * a[j][1] + a[j][2] * a[j][2] + a[j][3] * a[j][3]);
                    const float r = rsqrtf(ss * (1.f / RDV) + EPS);
                    float o_[4];
#pragma unroll
                    for (int e = 0; e < 4; ++e) { const unsigned gw_ = e < 2 ? gz[j].x : gz[j].y; o_[e] = __builtin_bit_cast(float, (e & 1) ? (gw_ & 0xffff0000u) : (gw_ << 16)) * a[j][e] * r; }
                    *(u32x2_t*)(CATb + (size_t)row * CATLD + 4 * lane + 256 * j) = (u32x2_t){cvtpk(o_[0], o_[1]), cvtpk(o_[2], o_[3])};
                }
#pragma unroll
                for (int j = 0; j < 4; ++j) { a[j] = an[j]; gz[j] = gn[j]; }
            }
#undef P6_LOAD
        }
    }
    SEAM(6);
    if (IN(7)) {
        { pg8::StaticOrder S; S.init(NP, 1024, G, bid); pg8::Gemm g{CATb, WcatT, NP, 1024, CATLD, CATLD, CATLD}; pg8::EpiGate3 E{SGb, MIXb, 1024, 16, 32};
          pg8::gemm_phase<pg8::EpiGate3, pg8::StaticOrder, true, true>(ldsb, g, S, E); }
        __syncthreads();
        { pg8::Gemm g{CATb, WcatT, NT, 1024, 256, CATLD, CATLD, 256}; pg8::SplitOrder SS{9, bid}; pg8::EpiPart E{PART}; GEMM_SPLIT(ldsb, g, SS, E); }
    }
    SEAM(7);
    if (IN(8)) { PHASE_IDS
        for (int i = bid * NTHREADS + tid; i < NS * 256; i += G * NTHREADS) { const int r = i >> 8, c4 = (i & 255) * 4; const size_t o_ = (size_t)r * 1024 + c4;
            f32x4 mix = {0.f, 0.f, 0.f, 0.f};
#pragma unroll
            for (int br = 0; br < 3; ++br) { f32x4 a = *(const f32x4*)(PART + (size_t)(br == 2 ? 8 : 4 * br) * (512 * 1024) + o_);
                if (br < 2) {
#pragma unroll
                    for (int k_ = 1; k_ < 4; ++k_) a += *(const f32x4*)(PART + (size_t)(4 * br + k_) * (512 * 1024) + o_); }
                const u32x2_t gq = *(const u32x2_t*)(SGb + (size_t)(NP + r) * 3072 + br * 1024 + c4);
                mix[0] += a[0] * __builtin_bit_cast(float, gq.x << 16); mix[1] += a[1] * __builtin_bit_cast(float, gq.x & 0xffff0000u);
                mix[2] += a[2] * __builtin_bit_cast(float, gq.y << 16); mix[3] += a[3] * __builtin_bit_cast(float, gq.y & 0xffff0000u); }
            *(u32x2_t*)(MIXb + (size_t)(NP + r) * 1024 + c4) = (u32x2_t){cvtpk(mix[0], mix[1]), cvtpk(mix[2], mix[3])}; }
    }
    SEAM(8);
    if (IN(9)) { pg8::Gemm g{MIXb, WoT, NP, 1024, 1024, 1024, 1024}; pg8::StaticOrder S; S.init(NP, 1024, G, bid); pg8::EpiBf16S E{HPb, 1024};
        GEMM_PHASE(pg8::EpiBf16S, ldsb, g, S, E);
        __syncthreads();
        { pg8::Gemm g2{MIXb, WoT, NT, 1024, 256, 1024, 1024, 256}; pg8::SplitOrder SS{4, bid}; pg8::EpiPart E2{PART}; GEMM_SPLIT(ldsb, g2, SS, E2); } }
    SEAM(9);
    if (IN(10)) { PHASE_IDS
        f32x4 gp[4], gf[4], a[4], b[4];
#pragma unroll
        for (int j = 0; j < 4; ++j) { gp[j] = *(const f32x4*)(g_mix_post + 4 * lane + 256 * j); gf[j] = *(const f32x4*)(g_ffn_pre + 4 * lane + 256 * j); }
#define P10_LOAD(r_, A_, B_) do { const float* xr_ = (r_) < NP ? x_prompt + (size_t)(r_) * DM : x_sample + (size_t)((r_) - NP) * DM; \
        _Pragma("unroll") for (int j_ = 0; j_ < 4; ++j_) { B_[j_] = *(const f32x4*)(xr_ + 4 * lane + 256 * j_); \
            if ((r_) < NP) { const u32x2_t h_ = *(const u32x2_t*)(HPb + (size_t)(r_) * DM + 4 * lane + 256 * j_); A_[j_] = bf4_to_f32(h_.x, h_.y); } \
            else { const float* p_ = PART + (size_t)((r_) - NP) * DM + 4 * lane + 256 * j_; A_[j_] = (*(const f32x4*)p_ + *(const f32x4*)(p_ + 512 * 1024)) + (*(const f32x4*)(p_ + 2 * 512 * 1024) + *(const f32x4*)(p_ + 3 * 512 * 1024)); } } } while (0)
        int row = gw;
        if (row < NT) P10_LOAD(row, a, b);
        for (; row < NT; row += NGW) {
            f32x4 an[4], bn[4]; const int nr = row + NGW;
            if (nr < NT) P10_LOAD(nr, an, bn);
            float ss = 0.f;
#pragma unroll
            for (int j = 0; j < 4; ++j) ss += a[j][0] * a[j][0] + a[j][1] * a[j][1] + a[j][2] * a[j][2] + a[j][3] * a[j][3];
            float r = rsqrtf(wave_sum(ss) * (1.f / DM) + EPS); ss = 0.f;
#pragma unroll
            for (int j = 0; j < 4; ++j) { a[j] = b[j] + a[j] * r * gp[j]; *(u32x2_t*)(Hb + (size_t)row * DM + 4 * lane + 256 * j) = (u32x2_t){cvtpk(a[j][0], a[j][1]), cvtpk(a[j][2], a[j][3])};
                ss += a[j][0] * a[j][0] + a[j][1] * a[j][1] + a[j][2] * a[j][2] + a[j][3] * a[j][3]; }
            r = rsqrtf(wave_sum(ss) * (1.f / DM) + EPS);
#pragma unroll
            for (int j = 0; j < 4; ++j) { const f32x4 f_ = a[j] * r * gf[j]; *(u32x2_t*)(Fb + (size_t)row * DM + 4 * lane + 256 * j) = (u32x2_t){cvtpk(f_[0], f_[1]), cvtpk(f_[2], f_[3])}; }
#pragma unroll
            for (int j = 0; j < 4; ++j) { a[j] = an[j]; b[j] = bn[j]; }
        }
#undef P10_LOAD
    }
    SEAM(10);
    if (IN(11)) {
        pg8::Gemm g{Fb, WguT, NT, 2 * DFF, 1024, 1024, 1024}; pg8::StaticOrder S; S.init(NT, 2 * DFF, G, bid); pg8::EpiSwiGLU E{ACTb, DFF};
        GEMM_PHASE(pg8::EpiSwiGLU, ldsb, g, S, E);
    }
    SEAM(11);
    if (IN(13)) { pg8::Gemm g{ACTb, WdT, NP, 1024, DFF, DFF, DFF}; pg8::StaticOrder S; S.init(NP, 1024, G, bid); pg8::EpiBf16S E{FOb, 1024};
        GEMM_PHASE(pg8::EpiBf16S, ldsb, g, S, E);
        __syncthreads();
        { pg8::Gemm g2{ACTb, WdT, NT, 1024, 256, DFF, DFF, 256}; pg8::SplitOrder SS{11, bid}; pg8::EpiPart E2{PART}; GEMM_SPLIT(ldsb, g2, SS, E2); } }
    SEAM(13);
    if (IN(14)) { PHASE_IDS
        f32x4 gp[4], a[4], b[4];
#pragma unroll
        for (int j = 0; j < 4; ++j) gp[j] = *(const f32x4*)(g_ffn_post + 4 * lane + 256 * j);
#define P14_LOAD(r_, A_, B_) do { _Pragma("unroll") for (int j_ = 0; j_ < 4; ++j_) { { const u32x2_t h_ = *(const u32x2_t*)(Hb + (size_t)(r_) * DM + 4 * lane + 256 * j_); B_[j_] = bf4_to_f32(h_.x, h_.y); } \
            if ((r_) < NP) { const u32x2_t f_ = *(const u32x2_t*)(FOb + (size_t)(r_) * DM + 4 * lane + 256 * j_); A_[j_] = bf4_to_f32(f_.x, f_.y); } \
            else { const float* p_ = PART + (size_t)((r_) - NP) * DM + 4 * lane + 256 * j_; f32x4 a_ = *(const f32x4*)p_; \
                _Pragma("unroll") for (int k_ = 1; k_ < 11; ++k_) a_ += *(const f32x4*)(p_ + (size_t)k_ * 512 * 1024); A_[j_] = a_; } } } while (0)
        int row = gw;
        if (row < NT) P14_LOAD(row, a, b);
        for (; row < NT; row += NGW) {
            f32x4 an[4], bn[4]; const int nr = row + NGW;
            if (nr < NT) P14_LOAD(nr, an, bn);
            float ss = 0.f;
#pragma unroll
            for (int j = 0; j < 4; ++j) ss += a[j][0] * a[j][0] + a[j][1] * a[j][1] + a[j][2] * a[j][2] + a[j][3] * a[j][3];
            const float r = rsqrtf(wave_sum(ss) * (1.f / DM) + EPS);
            float* y = row < NP ? out + O_YP + (size_t)row * DM : out + O_YS + (size_t)(row - NP) * DM;
#pragma unroll
            for (int j = 0; j < 4; ++j) *(f32x4*)(y + 4 * lane + 256 * j) = b[j] + a[j] * r * gp[j];
#pragma unroll
            for (int j = 0; j < 4; ++j) { a[j] = an[j]; b[j] = bn[j]; }
        }
#undef P14_LOAD
    }
#undef IN
#undef SEAM
#undef PHASE_IDS
}
#undef x_prompt
#undef x_sample
#undef mem_prompt
#undef cache_ckv
#undef cache_kpe
#undef page_table
#undef state_ret
#undef cache_mem_k
#undef cache_mem_v
#undef g_mix_pre
#undef g_mix_post
#undef g_ffn_pre
#undef g_ffn_post
#undef g_mem
#undef g_qlat
#undef g_kvlat
#undef w_in
#undef w_uq
#undef w_uk
#undef w_uv
#undef w_mem_k
#undef w_mem_v
#undef w_ret_o
#undef w_mla_o
#undef w_x_o
#undef w_out
#undef w_gate
#undef w_up
#undef w_down
#undef COSA
#undef SINA
#undef COSB
#undef SINB
#undef U
#undef MN
#undef Zb
#undef RQ
#undef RK
#undef CQN
#undef CKVN
#undef KPER
#undef Q
#undef QLAT
#undef QPE
#undef ORETb
#undef OLAT
#undef OX
#undef OMLA
#undef ORETN
#undef ARET
#undef AMLA
#undef AX
#undef MIX
#undef HPb
#undef Hb
#undef F
#undef GU
#undef FOb
#undef WinT
#undef WmkvT
#undef WuqT
#undef WcatT
#undef CATb
#undef WroT
#undef WmoT
#undef WxoT
#undef WoT
#undef WguT
#undef WdT
#undef Ub
#undef MNb
#undef CQNb
#undef ORETNb
#undef OMLAb
#undef OXb
#undef MIXb
#undef Fb
#undef ACTb
#undef WukT
#undef WuvT
#undef CKVNb
#undef KPERb
#undef XQb
#undef MKb
#undef MVT
#undef KN
#undef VT
#undef Qb
#undef RQt
#undef RKt
#undef RKtT
#undef RVT
#undef UT
#undef SPT
#undef QPEb
#undef WukB
#undef PART
#undef SGb
#undef SRGb
#undef T0b
#undef T1b
#undef QLATb
#undef PO
#undef PML
constexpr int N_PHASES = 15;
}

extern "C" void kernel_launch(void* const* d_in, const int* in_sizes, int n_in, void* d_out, int out_size, void* d_ws, size_t ws_size, hipStream_t stream) {
    static int grid = 0;
    if (grid == 0) {
        if (n_in != 29 || (size_t)out_size != O_END || ws_size < WS_END) { fprintf(stderr, "kernel_launch: unexpected shapes: n_in %d out %d ws %zu (need %zu)\n", n_in, out_size, ws_size, (size_t)WS_END); grid = -1; return; }
        int dev = 0, cus = 0, per_cu = 0;
        if (hipGetDevice(&dev) != hipSuccess || hipDeviceGetAttribute(&cus, hipDeviceAttributeMultiprocessorCount, dev) != hipSuccess) { grid = -1; return; }
        if (hipFuncSetAttribute((const void*)fwd_kernel, hipFuncAttributeMaxDynamicSharedMemorySize, LDS_BYTES) != hipSuccess) { fprintf(stderr, "kernel_launch: hipFuncSetAttribute failed\n"); grid = -1; return; }
        if (hipOccupancyMaxActiveBlocksPerMultiprocessor(&per_cu, (const void*)fwd_kernel, NTHREADS, LDS_BYTES) != hipSuccess || per_cu < 1) { fprintf(stderr, "kernel_launch: occupancy query says %d\n", per_cu); per_cu = 1; }
        (void)hipGetLastError();
        grid = cus;
    }
    if (grid < 0) return;
    (void)hipMemsetAsync((char*)d_ws + WS_CTL, 0, CTL_BYTES, stream);
    Args a{};
    for (int i = 0; i < 29; ++i) a.in[i] = (const float*)d_in[i];
    a.out = (float*)d_out; a.ws = (unsigned char*)d_ws;
#if MK_ONE_LAUNCH
    a.ph_lo = 0; a.ph_hi = N_PHASES; a.sub = 0xff;
    hipLaunchKernelGGL(fwd_kernel, dim3(grid), dim3(NTHREADS), LDS_BYTES, stream, a);
#if PROBE_DUP >= 0
    a.ph_lo = PROBE_DUP; a.ph_hi = PROBE_DUP + 1; a.sub = PROBE_SUB;
    hipLaunchKernelGGL(fwd_kernel, dim3(grid), dim3(NTHREADS), LDS_BYTES, stream, a);
#endif
#else
    a.sub = 0xff; for (int p = 0; p < N_PHASES; ++p) { a.ph_lo = p; a.ph_hi = p + 1; hipLaunchKernelGGL(fwd_kernel, dim3(grid), dim3(NTHREADS), LDS_BYTES, stream, a); }
#endif
}
```

```cpp
#include <hip/hip_runtime.h>
#include <cstdio>
#include <cstdint>

#ifndef PROBE_DUP
#define PROBE_DUP -1
#endif
#ifndef PROBE_REP
#define PROBE_REP 4
#endif
#ifndef PROBE_SUB
#define PROBE_SUB 0xff
#endif
#ifndef MK_ONE_LAUNCH
#define MK_ONE_LAUNCH 1
#endif

#define LAS __attribute__((address_space(3)))
#define GAS __attribute__((address_space(1)))
#define DI __device__ __forceinline__
typedef float f32x4 __attribute__((ext_vector_type(4)));
typedef __bf16 bf16x2_t __attribute__((ext_vector_type(2)));
typedef float f32x2_t __attribute__((ext_vector_type(2)));
DI unsigned cvtpk(float lo, float hi) { f32x2_t v = {lo, hi}; bf16x2_t b = __builtin_convertvector(v, bf16x2_t); return __builtin_bit_cast(unsigned, b); }

namespace {
constexpr int DM = 1024, NB = 8, SEQ = 2048, NP = NB * SEQ, DB = 128, DS = 4, NS = DB * DS, NT = NP + NS;
constexpr int PAST = 8192, PAGE = 128, NPAGES = PAST / PAGE;
constexpr int RH = 4, RDK = 128, RDV = 256;
constexpr int MH = 8, QL = 384, KVL = 256, DNOPE = 128, DROPE = 64, DVH = 128, DQH = DNOPE + DROPE;
constexpr int NMEM = 256, XH = 4, XHD = 64;
constexpr int DFF = 2816, DIN = 7104, ZLD = 7168;
constexpr int C_RQ = 0, C_RK = 512, C_RV = 1024, C_RG = 2048, C_CQ = 3072, C_CKV = 3456, C_KPE = 3712, C_XQ = 3776, C_G = 4032;
constexpr float EPS = 1e-6f;
constexpr int NPOS = SEQ + DS;
constexpr int NTHREADS = 512, NWAVES = 8;
constexpr int LDS_BYTES = 147456;
constexpr int MISC_OFF = 147456 - 256;

constexpr size_t O_YP = 0, O_YS = O_YP + (size_t)NP * DM, O_CKVP = O_YS + (size_t)NS * DM, O_KPEP = O_CKVP + (size_t)NP * KVL,
                 O_CKVS = O_KPEP + (size_t)NP * DROPE, O_KPES = O_CKVS + (size_t)NS * KVL, O_RETP = O_KPES + (size_t)NS * DROPE,
                 O_RETS = O_RETP + (size_t)NB * RH * RDK * RDV, O_MKP = O_RETS + (size_t)DB * RH * RDK * RDV, O_MVP = O_MKP + (size_t)NB * NMEM * 256,
                 O_END = O_MVP + (size_t)NB * NMEM * 256;

constexpr size_t al256(size_t x) { return (x + 255) & ~(size_t)255; }
constexpr size_t WS_CTL = 0, CTL_BYTES = 1u << 20;
constexpr size_t WS_COSA = WS_CTL + CTL_BYTES;
constexpr size_t WS_SINA = WS_COSA + al256((size_t)NPOS * 64 * 4);
constexpr size_t WS_COSB = WS_SINA + al256((size_t)NPOS * 64 * 4);
constexpr size_t WS_SINB = WS_COSB + al256((size_t)NPOS * 32 * 4);
constexpr size_t WS_U = WS_SINB + al256((size_t)NPOS * 32 * 4);
constexpr size_t WS_MN = WS_U + (size_t)NT * DM * 4;
constexpr size_t WS_Z = WS_MN + (size_t)NB * NMEM * DM * 4;
constexpr size_t WS_RQ = WS_Z + (size_t)NT * ZLD * 4;
constexpr size_t WS_RK = WS_RQ + (size_t)NT * 512 * 4;
constexpr size_t WS_CQN = WS_RK + (size_t)NT * 512 * 4;
constexpr size_t WS_CKVN = WS_CQN + (size_t)NT * QL * 4;
constexpr size_t WS_KPER = WS_CKVN + (size_t)NT * KVL * 4;
constexpr size_t WS_Q = WS_KPER + (size_t)NT * DROPE * 4;
constexpr size_t WS_QLAT = WS_Q + (size_t)NT * 1536 * 4;
constexpr size_t WS_QPE = WS_QLAT + (size_t)NT * 2048 * 4;
constexpr size_t WS_ORET = WS_QPE + (size_t)NT * 512 * 4;
constexpr size_t WS_OLAT = WS_ORET + (size_t)NT * 1024 * 4;
constexpr size_t WS_OX = WS_OLAT + (size_t)NT * 2048 * 4;
constexpr size_t WS_OMLA = WS_OX + (size_t)NT * 256 * 4;
constexpr size_t WS_ORETN = WS_OMLA + (size_t)NT * 1024 * 4;
constexpr size_t WS_ARET = WS_ORETN + (size_t)NT * 1024 * 4;
constexpr size_t WS_AMLA = WS_ARET + (size_t)NT * 1024 * 4;
constexpr size_t WS_AX = WS_AMLA + (size_t)NT * 1024 * 4;
constexpr size_t WS_MIX = WS_AX + (size_t)NT * 1024 * 4;
constexpr size_t WS_HP = WS_MIX + (size_t)NT * 1024 * 4;
constexpr size_t WS_H = WS_HP + (size_t)NT * 1024 * 4;
constexpr size_t WS_F = WS_H + (size_t)NT * 1024 * 4;
constexpr size_t WS_GG = WS_F + (size_t)NT * 1024 * 4;
constexpr size_t WS_UP = WS_GG + (size_t)NT * DFF * 4;
constexpr size_t WS_ACT = WS_UP + (size_t)NT * DFF * 4;
constexpr size_t WS_FO = WS_ACT + (size_t)NT * DFF * 4;
constexpr size_t WS_F32_END = WS_FO + (size_t)NT * 1024 * 4;
constexpr size_t WS_WIN_T = al256(WS_F32_END);
constexpr size_t WS_WMKV_T = WS_WIN_T + (size_t)ZLD * 1024 * 2;
constexpr size_t WS_WUQ_T = WS_WMKV_T + (size_t)512 * 1024 * 2;
constexpr size_t WS_WRO_T = WS_WUQ_T + (size_t)1536 * 384 * 2;
constexpr size_t WS_WMO_T = WS_WRO_T + (size_t)1024 * 1024 * 2;
constexpr size_t WS_WXO_T = WS_WMO_T + (size_t)1024 * 1024 * 2;
constexpr size_t WS_WO_T = WS_WXO_T + (size_t)1024 * 256 * 2;
constexpr size_t WS_WGU_T = WS_WO_T + (size_t)1024 * 1024 * 2;
constexpr size_t WS_WD_T = WS_WGU_T + (size_t)5632 * 1024 * 2;
constexpr size_t WS_UB = WS_WD_T + (size_t)1024 * 2816 * 2;
constexpr size_t WS_MNB = WS_UB + (size_t)NT * 1024 * 2;
constexpr size_t WS_CQNB = WS_MNB + (size_t)2048 * 1024 * 2;
constexpr size_t WS_ORETNB = WS_CQNB + (size_t)NT * 384 * 2;
constexpr size_t WS_OMLAB = WS_ORETNB + (size_t)NT * 1024 * 2;
constexpr size_t WS_OXB = WS_OMLAB + (size_t)NT * 1024 * 2;
constexpr size_t WS_MIXB = WS_OXB + (size_t)NT * 256 * 2;
constexpr size_t WS_FB = WS_MIXB + (size_t)NT * 1024 * 2;
constexpr size_t WS_ACTB = WS_FB + (size_t)NT * 1024 * 2;
constexpr size_t WS_WUK_T = WS_ACTB + (size_t)NT * 2816 * 2;
constexpr size_t WS_WUV_T = WS_WUK_T + (size_t)1024 * 256 * 2;
constexpr size_t WS_CKVNB = WS_WUV_T + (size_t)1024 * 256 * 2;
constexpr size_t WS_KPERB = WS_CKVNB + (size_t)NT * 256 * 2;
constexpr size_t WS_XQB = WS_KPERB + (size_t)NT * 64 * 2;
constexpr size_t WS_MKB = WS_XQB + (size_t)NT * 256 * 2;
constexpr size_t WS_MVT = WS_MKB + (size_t)2048 * 256 * 2;
constexpr size_t WS_KN = WS_MVT + (size_t)2048 * 256 * 2;
constexpr size_t WS_VT = WS_KN + (size_t)NP * 1024 * 2;
constexpr size_t WS_QB = WS_VT + (size_t)NP * 1024 * 2;
constexpr size_t WS_RQT = WS_QB + (size_t)NT * 1536 * 2;
constexpr size_t WS_RKT = WS_RQT + (size_t)NP * 512 * 2;
constexpr size_t WS_RKTT = WS_RKT + (size_t)NP * 512 * 2;
constexpr size_t WS_RVT = WS_RKTT + (size_t)NP * 512 * 2;
constexpr size_t WS_UT = WS_RVT + (size_t)NT * 1024 * 2;
constexpr size_t WS_SPT = WS_UT + (size_t)512 * 32768 * 4;
constexpr size_t WS_QLATB = WS_SPT + (size_t)512 * 32768 * 2;
constexpr size_t WS_PO = WS_QLATB + (size_t)NS * 2048 * 2;
constexpr size_t WS_PML = WS_PO + (size_t)DB * 2 * 32 * 256 * 4;
constexpr size_t WS_PART = al256(WS_PML + (size_t)DB * 2 * 32 * 2 * 4);
constexpr size_t WS_QPEB_ = WS_PART + (size_t)11 * 512 * 1024 * 4;
constexpr size_t WS_QPEB = al256(WS_QPEB_ + 0 * WS_PML + (size_t)DB * 2 * 32 * 2 * 4);
constexpr size_t WS_SGB = WS_QPEB + (size_t)NT * 512 * 2;
constexpr size_t WS_SRGB = WS_SGB + (size_t)NT * 3072 * 2;
constexpr size_t WS_T0B = WS_SRGB + (size_t)NT * 1024 * 2;
constexpr size_t WS_T1B = WS_T0B + (size_t)NT * 1024 * 2;
constexpr size_t WS_WUKB = WS_T1B + (size_t)NT * 1024 * 2;
constexpr size_t WS_END = WS_WUKB + (size_t)8 * 256 * 128 * 2;

static_assert(WS_OMLAB == WS_ORETNB + (size_t)NT * 1024 * 2 && WS_OXB == WS_OMLAB + (size_t)NT * 1024 * 2 && WS_MIXB == WS_OXB + (size_t)NT * 256 * 2, "CATb = [o_ret_n | o_mla | o_x] rows of 2304");
static_assert(WS_WMO_T == WS_WRO_T + (size_t)1024 * 1024 * 2 && WS_WXO_T == WS_WMO_T + (size_t)1024 * 1024 * 2 && WS_WO_T == WS_WXO_T + (size_t)1024 * 256 * 2, "WcatT = [w_ret_o | w_mla_o | w_x_o]^T rows of 2304");
constexpr int CATLD = 2304;
constexpr int CW_BAR = 4096;

#define XB_TMO      128
#define XB_XCNT(j)  (256  + 64 * (j))
#define XB_XSUB(j)  (1280 + 64 * (j))
#define XB_XGEN(j)  (2304 + 64 * (j))
#define XB_TOP      3328
#define XB_TOPGEN   3392
#define XCD_BAR_WORDS 3456
#define XB_SPIN_CAP (1u << 25)

DI unsigned xb_ld(unsigned* p)              { return __hip_atomic_load(p, __ATOMIC_RELAXED, __HIP_MEMORY_SCOPE_AGENT); }
DI unsigned xb_add(unsigned* p, unsigned v) { return __hip_atomic_fetch_add(p, v, __ATOMIC_RELAXED, __HIP_MEMORY_SCOPE_AGENT); }
DI unsigned xb_xcc_id() { return (unsigned)__builtin_amdgcn_s_getreg((3 << 11) | 20) & 0xFu; }
#define XB_SPIN(cond, bar) do { unsigned _sp = 0; while (cond) { __builtin_amdgcn_s_sleep(1); \
    if ((++_sp & 255u) == 0u) { if (xb_ld(&(bar)[XB_TMO])) break; if (_sp > XB_SPIN_CAP) { atomicAdd(&(bar)[XB_TMO], 1u); break; } } } } while (0)

struct XcdBarrier { unsigned* bar; unsigned x; volatile LAS unsigned* st; };

DI XcdBarrier xcd_barrier_post(unsigned* bar, volatile LAS unsigned* st) {
    XcdBarrier b; b.bar = bar; b.x = xb_xcc_id(); b.st = st;
    if (threadIdx.x == 0) (void)xb_add(&bar[XB_XCNT(b.x)], 1u);
    return b;
}
DI void xcd_barrier_complete(unsigned* bar, unsigned x, unsigned& nloc, unsigned& nx) {
    const unsigned G = gridDim.x * gridDim.y * gridDim.z;
    unsigned sum, cnt, mine, sp = 0u;
    for (;;) {
        sum = 0u; cnt = 0u; mine = 0u;
#pragma unroll
        for (unsigned j = 0; j < 16; ++j) { const unsigned c = xb_ld(&bar[XB_XCNT(j)]); sum += c; cnt += (c > 0u) ? 1u : 0u; mine = (j == x) ? c : mine; }
        if (sum == G) break;
        __builtin_amdgcn_s_sleep(1);
        if ((++sp & 255u) == 0u) { if (xb_ld(&bar[XB_TMO])) break; if (sp > XB_SPIN_CAP) { atomicAdd(&bar[XB_TMO], 1u); break; } }
    }
    nloc = mine > 0u ? mine : 1u; nx = cnt > 0u ? cnt : 1u;
}
DI void xcd_barrier(const XcdBarrier& b) {
    asm volatile("s_waitcnt vmcnt(0)" ::: "memory");
    __syncthreads();
    if (threadIdx.x == 0) {
        unsigned* bar = b.bar;
        __builtin_amdgcn_s_waitcnt(0);
        unsigned nloc = b.st[0], nx = b.st[1];
        if (nloc == 0u) { xcd_barrier_complete(bar, b.x, nloc, nx); b.st[0] = nloc; b.st[1] = nx; }
        const unsigned old = xb_add(&bar[XB_XSUB(b.x)], 1u);
        const unsigned gen = old / nloc;
        if (old + 1u == (gen + 1u) * nloc) {
            __builtin_amdgcn_fence(__ATOMIC_RELEASE, "agent");
            asm volatile("s_waitcnt vmcnt(0)" ::: "memory");
            const unsigned og = xb_add(&bar[XB_TOP], 1u);
            const unsigned tg = og / nx;
            if (og + 1u == (tg + 1u) * nx) xb_add(&bar[XB_TOPGEN], 1u);
            else XB_SPIN(xb_ld(&bar[XB_TOPGEN]) == tg, bar);
            __builtin_amdgcn_fence(__ATOMIC_ACQUIRE, "agent");
            xb_add(&bar[XB_XGEN(b.x)], 1u);
            asm volatile("s_waitcnt vmcnt(0)" ::: "memory");
        } else {
            XB_SPIN(xb_ld(&bar[XB_XGEN(b.x)]) == gen, bar);
            __builtin_amdgcn_fence(__ATOMIC_ACQUIRE, "agent");
            asm volatile("s_waitcnt vmcnt(0)" ::: "memory");
        }
    }
    __syncthreads();
}

DI float wave_sum(float v) {
#pragma unroll
    for (int o = 1; o < 64; o <<= 1) v += __shfl_xor(v, o);
    return v;
}
DI float wave_max(float v) {
#pragma unroll
    for (int o = 1; o < 64; o <<= 1) v = fmaxf(v, __shfl_xor(v, o));
    return v;
}
DI float sigmoidf_(float x) { return 1.f / (1.f + expf(-x)); }
DI float siluf_(float x) { return x / (1.f + expf(-x)); }
DI f32x4 bf4_to_f32(unsigned lo, unsigned hi) { return (f32x4){__builtin_bit_cast(float, lo << 16), __builtin_bit_cast(float, lo & 0xffff0000u), __builtin_bit_cast(float, hi << 16), __builtin_bit_cast(float, hi & 0xffff0000u)}; }
DI int pos_index(int row) { return row < NP ? (row & (SEQ - 1)) : SEQ + ((row - NP) & (DS - 1)); }
DI float lg_gamma(int h) { return h == 0 ? -0.03174869831458027f : h == 1 ? -0.015748356968139112f : h == 2 ? -0.007843177461025892f : -0.003913899321136329f; }


namespace pg8 {
typedef unsigned short bf16_t;
typedef short bf16x8 __attribute__((ext_vector_type(8)));
typedef unsigned u32x4 __attribute__((ext_vector_type(4)));
typedef unsigned u32x2 __attribute__((ext_vector_type(2)));
constexpr int BM = 256, BK = 64, HALF = 128, HTB = HALF * BK * 2, STAGE_BYTES = 8 * HTB, NXCD = 8, WGM = 8;
__host__ __device__ __forceinline__ int lds_byte(int r, int c) { const int st = (r >> 4) * 2 + (c >> 5), rr = r & 15, cc = c & 31, ob = rr * 64 + cc * 2; return st * 1024 + (ob ^ (((ob >> 9) & 1) << 5)); }
__host__ __device__ __forceinline__ void stage_rc(int b, int& R, int& C) { const int st = b / 1024, sb = b % 1024, swz = sb ^ (((sb >> 9) & 1) << 5); R = (st >> 1) * 16 + swz / 64; C = (st & 1) * 32 + (swz % 64) / 2; }
__host__ __device__ __forceinline__ int perm32(int rho) { const int n = rho >> 4, i = rho & 15; return 8 * (i >> 2) + 4 * n + (i & 3); }
struct Unit { int pm, pn, ks; };
struct Gemm { const bf16_t* A; const bf16_t* Bt; int M, N, K, lda, ldb, ksl; };
struct StaticOrder {
    int nM, nN, nwg, G, c;
    __host__ __device__ void init(int M, int N, int G_, int c_) { nM = M / BM; nN = N / BM; nwg = nM * nN; G = G_; c = c_; }
    __host__ __device__ bool next(int i, Unit& u) const {
        const long L = (long)i * G + c; if (L >= nwg) return false;
        int wgid = (int)L; { const int q = nwg / NXCD, r = nwg % NXCD, xcd = wgid % NXCD, off = wgid / NXCD; wgid = (xcd < r ? xcd * (q + 1) : r * (q + 1) + (xcd - r) * q) + off; }
        const int nig = WGM * nN, gid = wgid / nig, fm = gid * WGM, gsz = (nM - fm) < WGM ? (nM - fm) : WGM;
        u.pm = fm + ((wgid % nig) % gsz); u.pn = (wgid % nig) / gsz; u.ks = 0; return true;
    }
    __device__ __forceinline__ void a_ready(const Unit&) const {}
    __device__ __forceinline__ void done(const Unit&) const {}
};
__device__ __forceinline__ unsigned cvt_pk_bf16(float lo, float hi) { return cvtpk(lo, hi); }
struct SplitOrder {
    int KS, c;
    __host__ __device__ bool next(int i, Unit& u) const { if (i != 0 || c >= 8 * KS) return false; const int tile = c / KS; u.ks = c % KS; u.pm = 64 + (tile >> 2); u.pn = tile & 3; return true; }
    __device__ __forceinline__ void a_ready(const Unit&) const {}
    __device__ __forceinline__ void done(const Unit&) const {}
};
struct EpiPart {
    static constexpr bool PERM = false, AFTER_DRAIN = false, HAS_MID = false;
    float* C;
    __device__ __forceinline__ void operator()(const f32x4 (&acc)[2][2][4][2], const Unit& u, int wr, int wc, int fr, int fq) const {
        const int row0 = (u.pm - 64) * BM + wr * 64 + fr, col0 = u.pn * BM + wc * 32 + 4 * fq; float* base = C + (size_t)u.ks * (512 * 1024);
#pragma unroll
        for (int ai = 0; ai < 2; ++ai)
#pragma unroll
            for (int m = 0; m < 4; ++m) { float* rowp = base + (size_t)(row0 + ai * HALF + m * 16) * 1024 + col0;
#pragma unroll
                for (int bj = 0; bj < 2; ++bj)
#pragma unroll
                    for (int n = 0; n < 2; ++n) *(f32x4*)(rowp + bj * HALF + n * 16) = acc[ai][bj][m][n]; }
    }
};
struct P1Order {
    StaticOrder so;
    __host__ __device__ void init(int G_, int c_) { so.init(64 * 256, 24 * 256, G_, c_); }
    __host__ __device__ bool next(int i, Unit& u) const {
        const long L = (long)i * so.G + so.c;
        if (L < 1536) { so.next(i, u); if (u.pn >= 4) u.pn += 4; return true; }
        u.ks = 0;
        if (L < 1536 + 56) { const int idx = (int)L - 1536; u.pm = 64 + idx / 28; u.pn = idx % 28; return true; }
        if (L < 1536 + 56 + 16) { const int idx = (int)L - 1592; u.pm = 66 + idx / 2; u.pn = 28 + idx % 2; return true; }
        return false;
    }
    __device__ __forceinline__ void a_ready(const Unit&) const {}
    __device__ __forceinline__ void done(const Unit&) const {}
};
struct EpiP1 {
    static constexpr bool PERM = true, AFTER_DRAIN = false, HAS_MID = false;
    bf16_t* Zp; int ldz; float* mk; float* mv; bf16_t* srg; bf16_t* sg; int c_rg, c_g;
    __device__ __forceinline__ void operator()(const f32x4 (&acc)[2][2][4][2], const Unit& u, int wr, int wc, int fr, int fq) const {
        if (u.pm >= 66) {
            float* base = (u.pn == 28) ? mk : mv; const int row0 = (u.pm - 66) * BM + wr * 64 + fr, col0 = wc * 32 + 8 * fq;
#pragma unroll
            for (int ai = 0; ai < 2; ++ai)
#pragma unroll
                for (int m = 0; m < 4; ++m) { float* rowp = base + (size_t)(row0 + ai * HALF + m * 16) * 256 + col0;
#pragma unroll
                    for (int bj = 0; bj < 2; ++bj) { *(f32x4*)(rowp + bj * HALF) = acc[ai][bj][m][0]; *(f32x4*)(rowp + bj * HALF + 4) = acc[ai][bj][m][1]; } }
            return;
        }
        const int row0 = u.pm * BM + wr * 64 + fr, col0 = u.pn * BM + wc * 32 + 8 * fq;
#pragma unroll
        for (int bj = 0; bj < 2; ++bj) { const int c = col0 + bj * HALF;
            if (c >= c_g + 3072) continue;
            const int kind = c >= c_g ? 2 : (c >= c_rg && c < c_rg + 1024) ? 1 : 0;
            bf16_t* dst = kind == 2 ? sg + (c - c_g) : kind == 1 ? srg + (c - c_rg) : Zp + c; const int ld = kind == 2 ? 3072 : kind == 1 ? 1024 : ldz;
#pragma unroll
            for (int ai = 0; ai < 2; ++ai)
#pragma unroll
                for (int m = 0; m < 4; ++m) { f32x4 v0 = acc[ai][bj][m][0], v1 = acc[ai][bj][m][1];
                    if (kind) {
#pragma unroll
                        for (int e = 0; e < 4; ++e) { const float s0 = __builtin_amdgcn_rcpf(1.f + __expf(-v0[e])), s1 = __builtin_amdgcn_rcpf(1.f + __expf(-v1[e]));        v0[e] = kind == 2 ? s0 : v0[e] * s0; v1[e] = kind == 2 ? s1 : v1[e] * s1; } }
                    u32x4 w; w.x = cvt_pk_bf16(v0[0], v0[1]); w.y = cvt_pk_bf16(v0[2], v0[3]); w.z = cvt_pk_bf16(v1[0], v1[1]); w.w = cvt_pk_bf16(v1[2], v1[3]);
                    *(u32x4*)(dst + (size_t)(row0 + ai * HALF + m * 16) * ld) = w; } }
    }
};
struct EpiF32S {
    static constexpr bool PERM = false, AFTER_DRAIN = false, HAS_MID = false;
    float* C; int ldc; int split_tiles; size_t split_stride;
    __device__ __forceinline__ void operator()(const f32x4 (&acc)[2][2][4][2], const Unit& u, int wr, int wc, int fr, int fq) const {
        int pn = u.pn; float* base = C; if (split_tiles) { const int t = pn / split_tiles; base += (size_t)t * split_stride; pn -= t * split_tiles; }
        const int row0 = u.pm * BM + wr * 64 + fr, col0 = pn * BM + wc * 32 + 4 * fq;
#pragma unroll
        for (int ai = 0; ai < 2; ++ai)
#pragma unroll
            for (int m = 0; m < 4; ++m) { float* rowp = base + (size_t)(row0 + ai * HALF + m * 16) * ldc + col0;
#pragma unroll
                for (int bj = 0; bj < 2; ++bj)
#pragma unroll
                    for (int n = 0; n < 2; ++n) *(f32x4*)(rowp + bj * HALF + n * 16) = acc[ai][bj][m][n]; }
    }
};
struct EpiBf16S {
    static constexpr bool PERM = true, AFTER_DRAIN = false, HAS_MID = false;
    bf16_t* O; int ldc;
    __device__ __forceinline__ void operator()(const f32x4 (&acc)[2][2][4][2], const Unit& u, int wr, int wc, int fr, int fq) const {
        const int row0 = u.pm * BM + wr * 64 + fr, col0 = u.pn * BM + wc * 32 + 8 * fq;
#pragma unroll
        for (int ai = 0; ai < 2; ++ai)
#pragma unroll
            for (int m = 0; m < 4; ++m) { bf16_t* rowp = O + (size_t)(row0 + ai * HALF + m * 16) * ldc + col0;
#pragma unroll
                for (int bj = 0; bj < 2; ++bj) { const f32x4 v0 = acc[ai][bj][m][0], v1 = acc[ai][bj][m][1];
                    u32x4 w; w.x = cvt_pk_bf16(v0[0], v0[1]); w.y = cvt_pk_bf16(v0[2], v0[3]); w.z = cvt_pk_bf16(v1[0], v1[1]); w.w = cvt_pk_bf16(v1[2], v1[3]);
                    *(u32x4*)(rowp + bj * HALF) = w; } }
    }
};
struct EpiSwiGLU {
    static constexpr bool PERM = true, AFTER_DRAIN = false, HAS_MID = false;
    bf16_t* O; int ldc;
    __device__ __forceinline__ void operator()(const f32x4 (&acc)[2][2][4][2], const Unit& u, int wr, int wc, int fr, int fq) const {
        const int row0 = u.pm * BM + wr * 64 + fr, col0 = u.pn * (BM / 2) + wc * 16 + 4 * fq;
#pragma unroll
        for (int ai = 0; ai < 2; ++ai)
#pragma unroll
            for (int m = 0; m < 4; ++m) { bf16_t* rowp = O + (size_t)(row0 + ai * HALF + m * 16) * ldc + col0;
#pragma unroll
                for (int bj = 0; bj < 2; ++bj) { const f32x4 v0 = acc[ai][bj][m][0], v1 = acc[ai][bj][m][1];
                    const float a0 = v0[0] * __builtin_amdgcn_rcpf(1.f + __expf(-v0[0])) * v0[1], a1 = v0[2] * __builtin_amdgcn_rcpf(1.f + __expf(-v0[2])) * v0[3];
                    const float a2 = v1[0] * __builtin_amdgcn_rcpf(1.f + __expf(-v1[0])) * v1[1], a3 = v1[2] * __builtin_amdgcn_rcpf(1.f + __expf(-v1[2])) * v1[3];
                    u32x2 w; w.x = cvt_pk_bf16(a0, a1); w.y = cvt_pk_bf16(a2, a3);
                    *(u32x2*)(rowp + bj * (HALF / 2)) = w; } }
    }
};
template <int MODE  > struct EpiGate {
    static constexpr bool PERM = true, AFTER_DRAIN = false, HAS_MID = false;
    const bf16_t* sg; const bf16_t* tin; bf16_t* tout; int ldc;
    __device__ __forceinline__ void operator()(const f32x4 (&acc)[2][2][4][2], const Unit& u, int wr, int wc, int fr, int fq) const {
        const int row0 = u.pm * BM + wr * 64 + fr, col0 = u.pn * BM + wc * 32 + 8 * fq;
#pragma unroll
        for (int ai = 0; ai < 2; ++ai)
#pragma unroll
            for (int m = 0; m < 4; ++m) { const size_t r = (size_t)(row0 + ai * HALF + m * 16);
#pragma unroll
                for (int bj = 0; bj < 2; ++bj) { const int c = col0 + bj * HALF;
                    const u32x4 gq = *(const u32x4*)(sg + r * 3072 + c); u32x4 tq = {0u, 0u, 0u, 0u}; if (MODE >= 1) tq = *(const u32x4*)(tin + r * ldc + c);
                    const f32x4 v0 = acc[ai][bj][m][0], v1 = acc[ai][bj][m][1]; u32x4 w;
#define EG_ONE(dst, x0, x1, gw_, tw_) { float a_ = (x0) * __builtin_bit_cast(float, (gw_) << 16), b_ = (x1) * __builtin_bit_cast(float, (gw_) & 0xffff0000u); \
                        if (MODE >= 1) { a_ += __builtin_bit_cast(float, (tw_) << 16); b_ += __builtin_bit_cast(float, (tw_) & 0xffff0000u); } dst = cvt_pk_bf16(a_, b_); }
                    EG_ONE(w.x, v0[0], v0[1], gq.x, tq.x) EG_ONE(w.y, v0[2], v0[3], gq.y, tq.y) EG_ONE(w.z, v1[0], v1[1], gq.z, tq.z) EG_ONE(w.w, v1[2], v1[3], gq.w, tq.w)
#undef EG_ONE
                    *(u32x4*)(tout + r * ldc + c) = w; } }
    }
};
struct EpiGate3 {
    static constexpr bool PERM = true, AFTER_DRAIN = false, HAS_MID = true;
    const bf16_t* sg; bf16_t* out; int ldc; int t1, t2;
    __device__ __forceinline__ void mid(f32x4 (&acc)[2][2][4][2], const Unit& u, int wr, int wc, int fr, int fq, int seam) const {
        int row0 = u.pm * BM + wr * 64 + fr, col0 = u.pn * BM + wc * 32 + 8 * fq;
        asm volatile("" : "+v"(row0), "+v"(col0));
#pragma unroll
        for (int ai = 0; ai < 2; ++ai)
#pragma unroll
            for (int m = 0; m < 4; ++m) { const bf16_t* gp = sg + (size_t)(row0 + ai * HALF + m * 16) * 3072 + seam * 1024 + col0;
#pragma unroll
                for (int bj = 0; bj < 2; ++bj) { const u32x4 ga = *(const u32x4*)(gp + bj * HALF), gb = *(const u32x4*)(gp + 1024 + bj * HALF);
#define EG3_R(a_, b_, hi_) (fmaxf(__builtin_bit_cast(float, (hi_) ? ((a_) & 0xffff0000u) : ((a_) << 16)), 1e-30f) * __builtin_amdgcn_rcpf(fmaxf(__builtin_bit_cast(float, (hi_) ? ((b_) & 0xffff0000u) : ((b_) << 16)), 1e-30f)))
                    acc[ai][bj][m][0][0] *= EG3_R(ga.x, gb.x, 0); acc[ai][bj][m][0][1] *= EG3_R(ga.x, gb.x, 1); acc[ai][bj][m][0][2] *= EG3_R(ga.y, gb.y, 0); acc[ai][bj][m][0][3] *= EG3_R(ga.y, gb.y, 1);
                    acc[ai][bj][m][1][0] *= EG3_R(ga.z, gb.z, 0); acc[ai][bj][m][1][1] *= EG3_R(ga.z, gb.z, 1); acc[ai][bj][m][1][2] *= EG3_R(ga.w, gb.w, 0); acc[ai][bj][m][1][3] *= EG3_R(ga.w, gb.w, 1);
#undef EG3_R
                } }
    }
    __device__ __forceinline__ void operator()(const f32x4 (&acc)[2][2][4][2], const Unit& u, int wr, int wc, int fr, int fq) const {
        const int row0 = u.pm * BM + wr * 64 + fr, col0 = u.pn * BM + wc * 32 + 8 * fq;
#pragma unroll
        for (int ai = 0; ai < 2; ++ai)
#pragma unroll
            for (int m = 0; m < 4; ++m) { const size_t r = (size_t)(row0 + ai * HALF + m * 16);
#pragma unroll
                for (int bj = 0; bj < 2; ++bj) { const int c = col0 + bj * HALF;
                    const u32x4 gq = *(const u32x4*)(sg + r * 3072 + 2048 + c); const f32x4 v0 = acc[ai][bj][m][0], v1 = acc[ai][bj][m][1]; u32x4 w;
#define EG3_G(g_, hi_) fmaxf(__builtin_bit_cast(float, (hi_) ? ((g_) & 0xffff0000u) : ((g_) << 16)), 1e-30f)
                    w.x = cvt_pk_bf16(v0[0] * EG3_G(gq.x, 0), v0[1] * EG3_G(gq.x, 1)); w.y = cvt_pk_bf16(v0[2] * EG3_G(gq.y, 0), v0[3] * EG3_G(gq.y, 1));
                    w.z = cvt_pk_bf16(v1[0] * EG3_G(gq.z, 0), v1[1] * EG3_G(gq.z, 1)); w.w = cvt_pk_bf16(v1[2] * EG3_G(gq.w, 0), v1[3] * EG3_G(gq.w, 1));
#undef EG3_G
                    *(u32x4*)(out + r * ldc + c) = w; } }
    }
};
template <class Epi, class Sched, bool ALIGN_EPI = false, bool SP2 = false>
__device__ __forceinline__ void gemm_phase(LAS unsigned char* lds, const Gemm g, const Sched& S, const Epi& E) {
    int tid_ = threadIdx.x; asm volatile("" : "+v"(tid_));
    const int tid = tid_, wid = __builtin_amdgcn_readfirstlane(tid >> 6), lane = tid & 63, wr = wid >> 2, wc = wid & 3, fr = lane & 15, fq = lane >> 4;
    const int K = g.K, nt = K / BK;
    unsigned voffA[2], voffB[2];
#pragma unroll
    for (int i = 0; i < 2; ++i) { int R, C; stage_rc(tid * 16 + i * 8192, R, C); const int Rb = Epi::PERM ? ((R & ~31) + perm32(R & 31)) : R;
        voffA[i] = (unsigned)(R * g.lda + C) * 2u; voffB[i] = (unsigned)(Rb * g.ldb + C) * 2u; }
    const size_t kstep = (size_t)(BK * 2);
    const size_t hstepA = (size_t)HALF * g.lda * 2, hstepB = (size_t)HALF * g.ldb * 2;
    const size_t tstepA = 2 * hstepA, tstepB = 2 * hstepB;
    const unsigned ldsw = (unsigned)wid * 1024u;
    const int aoff = lds_byte(wr * 64 + fr, fq * 8), boff = lds_byte(wc * 32 + fr, fq * 8);
#define PG8_SA(b, h) (((b) * 2 + (h)) * HTB)
#define PG8_SB(b, h) ((4 + (b) * 2 + (h)) * HTB)
#define PG8_STAGE(bufoff, gbase, voff) do { _Pragma("unroll") for (int _i = 0; _i < 2; ++_i) \
        __builtin_amdgcn_global_load_lds((const unsigned*)((const char*)(gbase) + (voff)[_i]), (LAS unsigned*)(lds + (bufoff) + ldsw + _i * 8192), 16, 0, 0); } while (0)
#define PG8_LDA(dst, b, h) do { _Pragma("unroll") for (int m = 0; m < 4; ++m) _Pragma("unroll") for (int k = 0; k < 2; ++k) dst[m][k] = *(const LAS bf16x8*)(lds + PG8_SA(b, h) + aoff + m * 2048 + k * 1024); } while (0)
#define PG8_LDB(dst, b, h) do { _Pragma("unroll") for (int n = 0; n < 2; ++n) _Pragma("unroll") for (int k = 0; k < 2; ++k) dst[n][k] = *(const LAS bf16x8*)(lds + PG8_SB(b, h) + boff + n * 2048 + k * 1024); } while (0)
#define PG8_MMA(ai, bj, At, Bt) do { __builtin_amdgcn_s_setprio(1); _Pragma("unroll") for (int m = 0; m < 4; ++m) _Pragma("unroll") for (int n = 0; n < 2; ++n) _Pragma("unroll") for (int k = 0; k < 2; ++k) \
        acc[ai][bj][m][n] = __builtin_amdgcn_mfma_f32_16x16x32_bf16(Bt[n][k], At[m][k], acc[ai][bj][m][n], 0, 0, 0); __builtin_amdgcn_s_setprio(0); } while (0)
#define PG8_WAIT_V(n) asm volatile("s_waitcnt vmcnt(" #n ")" ::: "memory")
#define PG8_WAIT_L(n) asm volatile("s_waitcnt lgkmcnt(" #n ")" ::: "memory")
#define PG8_BAR __builtin_amdgcn_s_barrier()
#define PG8_SCHED __builtin_amdgcn_sched_barrier(0)
    Unit cur, nxt; int ui = 0;
    if (!S.next(0, cur)) return;
    f32x4 acc[2][2][4][2];
#pragma unroll
    for (int a = 0; a < 2; ++a)
#pragma unroll
        for (int b = 0; b < 2; ++b)
#pragma unroll
            for (int m = 0; m < 4; ++m)
#pragma unroll
                for (int n = 0; n < 2; ++n) acc[a][b][m][n] = (f32x4){0.f, 0.f, 0.f, 0.f};
    bf16x8 At[4][2], B0[2][2], B1[2][2];
    const size_t kslb = (size_t)g.ksl * 2;
    const char* cA = (const char*)g.A + (size_t)cur.pm * tstepA + cur.ks * kslb; const char* cB = (const char*)g.Bt + (size_t)cur.pn * tstepB + cur.ks * kslb;
    S.a_ready(cur);
    if constexpr (SP2) {
        PG8_STAGE(PG8_SB(0, 0), cB, voffB); PG8_STAGE(PG8_SB(0, 1), cB + hstepB, voffB); PG8_STAGE(PG8_SA(0, 0), cA, voffA); PG8_STAGE(PG8_SA(0, 1), cA + hstepA, voffA);
        if (wr == 1) PG8_BAR;
        PG8_WAIT_V(2); PG8_BAR;
        PG8_STAGE(PG8_SB(1, 0), cB + kstep, voffB); PG8_STAGE(PG8_SA(1, 0), cA + kstep, voffA); PG8_STAGE(PG8_SB(1, 1), cB + hstepB + kstep, voffB);
        PG8_WAIT_V(6); PG8_BAR;
    } else {
        PG8_STAGE(PG8_SB(0, 0), cB, voffB); PG8_STAGE(PG8_SA(0, 0), cA, voffA); PG8_STAGE(PG8_SB(0, 1), cB + hstepB, voffB); PG8_STAGE(PG8_SA(0, 1), cA + hstepA, voffA);
        if (wr == 1) PG8_BAR;
        PG8_WAIT_V(4); PG8_BAR;
        PG8_STAGE(PG8_SB(1, 0), cB + kstep, voffB); PG8_STAGE(PG8_SA(1, 0), cA + kstep, voffA); PG8_STAGE(PG8_SB(1, 1), cB + hstepB + kstep, voffB);
        PG8_WAIT_V(6); PG8_BAR;
    }
    for (;;) {
        const bool has_next = S.next(ui + 1, nxt);
        const char* nA = has_next ? (const char*)g.A + (size_t)nxt.pm * tstepA + nxt.ks * kslb : cA; const char* nB = has_next ? (const char*)g.Bt + (size_t)nxt.pn * tstepB + nxt.ks * kslb : cB;
#pragma unroll 1
        for (int t = 0; t < nt; t += 2) {
            const bool last = (t == nt - 2);
            const char* a1 = cA + (size_t)(t + 1) * kstep;
            const char* a2 = last ? nA : cA + (size_t)(t + 2) * kstep; const char* b2 = last ? nB : cB + (size_t)(t + 2) * kstep;
            const char* a3 = a2 + kstep; const char* b3 = b2 + kstep;
            if (last && has_next) S.a_ready(nxt);
            if constexpr (Epi::HAS_MID) { if (t == E.t1 || t == E.t2) E.mid(acc, cur, wr, wc, fr, fq, t == E.t1 ? 0 : 1); }
            if constexpr (SP2) {
            PG8_LDB(B0, 0, 0); PG8_LDB(B1, 0, 1); PG8_SCHED; PG8_LDA(At, 0, 0); PG8_STAGE(PG8_SA(1, 1), a1 + hstepA, voffA);
            PG8_WAIT_V(8); PG8_WAIT_L(0); PG8_BAR; PG8_MMA(0, 0, At, B0); PG8_MMA(0, 1, At, B1); PG8_BAR; PG8_SCHED;
            PG8_LDA(At, 0, 1); PG8_STAGE(PG8_SB(0, 0), b2, voffB); PG8_STAGE(PG8_SB(0, 1), b2 + hstepB, voffB); PG8_STAGE(PG8_SA(0, 0), a2, voffA);
            PG8_WAIT_V(8); PG8_WAIT_L(0); PG8_BAR; PG8_MMA(1, 0, At, B0); PG8_MMA(1, 1, At, B1); PG8_BAR; PG8_SCHED;
            PG8_LDB(B0, 1, 0); PG8_LDB(B1, 1, 1); PG8_SCHED; PG8_LDA(At, 1, 0); PG8_STAGE(PG8_SA(0, 1), a2 + hstepA, voffA);
            PG8_WAIT_V(8); PG8_WAIT_L(0); PG8_BAR; PG8_MMA(0, 0, At, B0); PG8_MMA(0, 1, At, B1); PG8_BAR; PG8_SCHED;
            PG8_LDA(At, 1, 1); PG8_STAGE(PG8_SB(1, 0), b3, voffB); PG8_STAGE(PG8_SB(1, 1), b3 + hstepB, voffB); PG8_STAGE(PG8_SA(1, 0), a3, voffA);
            PG8_WAIT_V(8); PG8_WAIT_L(0); PG8_BAR; PG8_MMA(1, 0, At, B0); PG8_MMA(1, 1, At, B1); PG8_BAR; PG8_SCHED;
            } else {
            PG8_LDB(B0, 0, 0); PG8_SCHED; PG8_LDA(At, 0, 0); PG8_STAGE(PG8_SA(1, 1), a1 + hstepA, voffA);
            PG8_WAIT_L(8); PG8_BAR; PG8_WAIT_L(0); PG8_MMA(0, 0, At, B0); PG8_BAR; PG8_SCHED;
            PG8_LDB(B1, 0, 1); PG8_STAGE(PG8_SB(0, 0), b2, voffB);
            PG8_BAR; PG8_WAIT_L(0); PG8_MMA(0, 1, At, B1); PG8_BAR;
            PG8_LDA(At, 0, 1); PG8_STAGE(PG8_SA(0, 0), a2, voffA);
            PG8_BAR; PG8_WAIT_L(0); PG8_MMA(1, 0, At, B0); PG8_BAR; PG8_SCHED;
            PG8_STAGE(PG8_SB(0, 1), b2 + hstepB, voffB);
            PG8_WAIT_V(6); PG8_BAR; PG8_MMA(1, 1, At, B1); PG8_BAR;
            PG8_LDB(B0, 1, 0); PG8_SCHED; PG8_LDA(At, 1, 0); PG8_STAGE(PG8_SA(0, 1), a2 + hstepA, voffA);
            PG8_WAIT_L(8); PG8_BAR; PG8_WAIT_L(0); PG8_MMA(0, 0, At, B0); PG8_BAR; PG8_SCHED;
            PG8_LDB(B1, 1, 1); PG8_STAGE(PG8_SB(1, 0), b3, voffB);
            PG8_BAR; PG8_WAIT_L(0); PG8_MMA(0, 1, At, B1); PG8_BAR;
            PG8_LDA(At, 1, 1); PG8_STAGE(PG8_SA(1, 0), a3, voffA);
            PG8_BAR; PG8_WAIT_L(0); PG8_MMA(1, 0, At, B0); PG8_BAR; PG8_SCHED;
            PG8_STAGE(PG8_SB(1, 1), b3 + hstepB, voffB);
            PG8_WAIT_V(6); PG8_BAR; PG8_MMA(1, 1, At, B1); PG8_BAR;
            }
        }
        if constexpr (ALIGN_EPI) { if (wr == 0) PG8_BAR; }
        if constexpr (!Epi::AFTER_DRAIN) { E(acc, cur, wr, wc, fr, fq); S.done(cur); }
        if (!has_next) break;
#pragma unroll
        for (int a = 0; a < 2; ++a)
#pragma unroll
            for (int b = 0; b < 2; ++b)
#pragma unroll
                for (int m = 0; m < 4; ++m)
#pragma unroll
                    for (int n = 0; n < 2; ++n) acc[a][b][m][n] = (f32x4){0.f, 0.f, 0.f, 0.f};
        cur = nxt; cA = nA; cB = nB; ++ui;
        if constexpr (ALIGN_EPI) { if (wr == 1) PG8_BAR; }
    }
    PG8_WAIT_V(0);
    if constexpr (!ALIGN_EPI) { if (wr == 0) PG8_BAR; }
    PG8_BAR;
    if constexpr (Epi::AFTER_DRAIN) { E.fused(acc, cur, wr, wc, fr, fq, lds, wid, lane); S.done(cur); }
#undef PG8_SA
#undef PG8_SB
#undef PG8_STAGE
#undef PG8_LDA
#undef PG8_LDB
#undef PG8_MMA
#undef PG8_WAIT_V
#undef PG8_WAIT_L
#undef PG8_BAR
#undef PG8_SCHED
}
}
typedef unsigned short bf16_t;
DI unsigned pk2(float lo, float hi) { return pg8::cvt_pk_bf16(lo, hi); }
DI bf16_t f2bf(float f) { return (bf16_t)(pg8::cvt_pk_bf16(f, 0.f) & 0xffffu); }
DI void transpose_item(const float* W, int N, bf16_t* WT, int ldt, int row_off, int rmul, LAS float* scr, int item, int lane) {
    const int nblk = N / 32, kb = item / nblk, nb = item % nblk, k0 = 64 * kb, n0 = 32 * nb;
#pragma unroll 8
    for (int i = 0; i < 32; ++i) { const int kk = 2 * i + (lane >> 5); scr[kk * 33 + (lane & 31)] = W[(size_t)(k0 + kk) * N + n0 + (lane & 31)]; }
    asm volatile("s_waitcnt lgkmcnt(0)" ::: "memory");
    const int c = lane & 7;
#pragma unroll
    for (int j = 0; j < 4; ++j) { const int n = (lane >> 3) + 8 * j; const LAS float* sp = scr + (8 * c) * 33 + n;
        pg8::u32x4 o; o.x = pk2(sp[0 * 33], sp[1 * 33]); o.y = pk2(sp[2 * 33], sp[3 * 33]); o.z = pk2(sp[4 * 33], sp[5 * 33]); o.w = pk2(sp[6 * 33], sp[7 * 33]);
        *(pg8::u32x4*)(WT + (size_t)(row_off + rmul * (n0 + n)) * ldt + k0 + 8 * c) = o; }
    asm volatile("s_waitcnt lgkmcnt(0)" ::: "memory");
}
DI void transpose_w(const float* W, int K, int N, bf16_t* WT, int ldt, int row_off, LAS float* scr, int gw, int NGW, int lane, int& rot, int rmul = 1) {
    const int nitems = (K / 64) * (N / 32);
    int first = gw - (rot % NGW); if (first < 0) first += NGW;
    for (int it = first; it < nitems; it += NGW) transpose_item(W, N, WT, ldt, row_off, rmul, scr, it, lane);
    rot += nitems;
}

struct Args {
    const float* in[29]; float* out; unsigned char* ws; int ph_lo, ph_hi, sub, pad;
};

DI unsigned short f2bf_raw(float f) { unsigned u = __builtin_bit_cast(unsigned, f); return (unsigned short)((u + 0x7fffu + ((u >> 16) & 1u)) >> 16); }
DI void sgemm_naive(LAS float* lds, const float* __restrict__ A, int lda, const float* __restrict__ B, long sbk, long sbn,
                    float* __restrict__ C, int ldc, int M, int N, int K, int bid, int G, unsigned short* Cb = nullptr) {
    LAS float* As = lds;
    LAS float* Bs = lds + 16 * 132;
    const int tid = threadIdx.x, tx = tid & 15, ty = tid >> 4;
    const int ntn = N / 64, ntiles = (M / 128) * ntn;
    for (int t = bid; t < ntiles; t += G) {
        const int m0 = (t / ntn) * 128, n0 = (t % ntn) * 64;
        float acc[4][4];
#pragma unroll
        for (int i = 0; i < 4; ++i)
#pragma unroll
            for (int j = 0; j < 4; ++j) acc[i][j] = 0.f;
        for (int k0 = 0; k0 < K; k0 += 16) {
            {
                const int r = tid >> 2, kq = (tid & 3) * 4;
                const float4 v = *(const float4*)(A + (size_t)(m0 + r) * lda + k0 + kq);
                As[(kq + 0) * 132 + r] = v.x; As[(kq + 1) * 132 + r] = v.y; As[(kq + 2) * 132 + r] = v.z; As[(kq + 3) * 132 + r] = v.w;
            }
#pragma unroll
            for (int i = 0; i < 2; ++i) {
                const int idx = tid + i * 512, kk = idx >> 6, nn = idx & 63;
                Bs[kk * 64 + nn] = B[(size_t)(k0 + kk) * sbk + (size_t)(n0 + nn) * sbn];
            }
            __syncthreads();
#pragma unroll
            for (int kk = 0; kk < 16; ++kk) {
                const f32x4 a = *(const LAS f32x4*)(As + kk * 132 + ty * 4);
                const f32x4 b = *(const LAS f32x4*)(Bs + kk * 64 + tx * 4);
                const float av[4] = {a.x, a.y, a.z, a.w}, bv[4] = {b.x, b.y, b.z, b.w};
#pragma unroll
                for (int i = 0; i < 4; ++i)
#pragma unroll
                    for (int j = 0; j < 4; ++j) acc[i][j] += av[i] * bv[j];
            }
            __syncthreads();
        }
#pragma unroll
        for (int i = 0; i < 4; ++i) {
            float4 o; o.x = acc[i][0]; o.y = acc[i][1]; o.z = acc[i][2]; o.w = acc[i][3];
            if (Cb) { unsigned short* cb = Cb + (size_t)(m0 + ty * 4 + i) * ldc + n0 + tx * 4; cb[0] = f2bf_raw(o.x); cb[1] = f2bf_raw(o.y); cb[2] = f2bf_raw(o.z); cb[3] = f2bf_raw(o.w); }
            else *(float4*)(C + (size_t)(m0 + ty * 4 + i) * ldc + n0 + tx * 4) = o;
        }
    }
}

template <int DQK, int DV, bool V_IN_K, int MODE, class KV, class QF>
DI void attn_naive(LAS float* lds, const KV& kv, int nk_loop, const QF& qf, bool active, int limit, float scale, float lg, int tq, float* optr) {
    constexpr int KS = DQK + 1;
    constexpr int VS = V_IN_K ? KS : DV;
    LAS float* Ks = lds;
    LAS float* Vs = V_IN_K ? Ks : (lds + 64 * KS);
    LAS float* qs = lds + 64 * KS + (V_IN_K ? 0 : 64 * DV);
    LAS float* ps = qs + 8 * DQK;
    static_assert((64 * KS + (V_IN_K ? 0 : 64 * DV) + 8 * DQK + 8 * 64) * 4 <= MISC_OFF, "attn_naive LDS");
    const int tid = threadIdx.x, lane = tid & 63, w = tid >> 6;
    __syncthreads();
    for (int d = lane; d < DQK; d += 64) qs[w * DQK + d] = active ? qf(d) : 0.f;
    float m = -INFINITY, l = 0.f;
    float acc[DV / 64];
#pragma unroll
    for (int c = 0; c < DV / 64; ++c) acc[c] = 0.f;
    for (int base = 0; base < nk_loop; base += 64) {
        __syncthreads();
        for (int idx = tid; idx < 64 * DQK; idx += NTHREADS) { const int j = idx / DQK, d = idx - j * DQK, key = base + j; Ks[j * KS + d] = key < nk_loop ? kv.k(key, d) : 0.f; }
        if (!V_IN_K) for (int idx = tid; idx < 64 * DV; idx += NTHREADS) { const int j = idx / DV, e = idx - j * DV, key = base + j; Vs[j * DV + e] = key < nk_loop ? kv.v(key, e) : 0.f; }
        __syncthreads();
        const int key = base + lane; const bool valid = active && key <= limit && key < nk_loop;
        float s = 0.f;
        for (int d = 0; d < DQK; ++d) s += qs[w * DQK + d] * Ks[lane * KS + d];
        float p;
        if (MODE == 0) {
            s *= scale;
            const float cm = wave_max(valid ? s : -INFINITY);
            const float mn = fmaxf(m, cm);
            const float alpha = (mn == -INFINITY) ? 1.f : expf(m - mn);
            p = valid ? expf(s - mn) : 0.f;
            l = l * alpha + wave_sum(p);
#pragma unroll
            for (int c = 0; c < DV / 64; ++c) acc[c] *= alpha;
            m = mn;
        } else {
            p = valid ? s * expf((float)(tq - key) * lg) : 0.f;
        }
        ps[w * 64 + lane] = p;
        __syncthreads();
        for (int j = 0; j < 64; ++j) { const float pj = ps[w * 64 + j];
#pragma unroll
            for (int c = 0; c < DV / 64; ++c) acc[c] += pj * Vs[j * VS + lane + 64 * c]; }
    }
    if (active) {
#pragma unroll
        for (int c = 0; c < DV / 64; ++c) optr[lane + 64 * c] = (MODE == 0) ? acc[c] / l : acc[c];
    }
}

struct KvMlaPrompt { const float* ckvn; const float* kper; int b;
    DI float k(int key, int d) const { const size_t row = (size_t)b * SEQ + key; return d < KVL ? ckvn[row * KVL + d] : kper[row * DROPE + (d - KVL)]; }
    DI float v(int, int) const { return 0.f; } };
struct KvMlaSample { const float* ckvn; const float* kper; const float* cckv; const float* ckpe; const int* pt; int b;
    DI float k(int key, int d) const {
        if (key < PAST) { const size_t r = (size_t)pt[b * NPAGES + (key >> 7)] * PAGE + (key & (PAGE - 1)); return d < KVL ? cckv[r * KVL + d] : ckpe[r * DROPE + (d - KVL)]; }
        const size_t row = (size_t)NP + b * DS + (key - PAST); return d < KVL ? ckvn[row * KVL + d] : kper[row * DROPE + (d - KVL)]; }
    DI float v(int, int) const { return 0.f; } };
struct KvRet { const float* rk; const float* z; int b, h;
    DI float k(int key, int d) const { return rk[((size_t)b * SEQ + key) * 512 + h * RDK + d]; }
    DI float v(int key, int e) const { return z[((size_t)b * SEQ + key) * ZLD + C_RV + h * RDV + e]; } };
struct KvMem { const float* mk; const float* mv; int b, h;
    DI float k(int key, int d) const { return mk[(((size_t)b * NMEM + key) * XH + h) * XHD + d]; }
    DI float v(int key, int e) const { return mv[(((size_t)b * NMEM + key) * XH + h) * XHD + e]; } };


typedef float f32x16 __attribute__((ext_vector_type(16)));
typedef short bf16x8 __attribute__((ext_vector_type(8)));
typedef short s16x4 __attribute__((ext_vector_type(4)));
typedef unsigned u32x4_t __attribute__((ext_vector_type(4)));
typedef unsigned u32x2_t __attribute__((ext_vector_type(2)));
DI int crow(int i, int h) { return (i & 3) + 8 * (i >> 2) + 4 * h; }
#define MFMA32(a, b, c) __builtin_amdgcn_mfma_f32_32x32x16_bf16((a), (b), (c), 0, 0, 0)
template <int DQK, int DV, bool CAUSAL, class Src>
DI void flash_unit(LAS unsigned char* lds, const Src& src, int qpos0, int ntiles, bf16_t* O, int ldo, float c2) {
    constexpr int KP = DQK + 8, VP = 68, KS = DQK / 16, NBLK = DV / 32;
    constexpr int KBYTES = 64 * KP * 2, VBYTES = DV * VP * 2, BUF = KBYTES + VBYTES;
    constexpr int D8 = DQK / 8, NPK = (64 * D8) / NTHREADS, NPV = (DV * 8) / NTHREADS;
    static_assert((64 * D8) % NTHREADS == 0 && (DV * 8) % NTHREADS == 0 && 2 * BUF <= 131072, "flash_unit geometry");
    const int tid = threadIdx.x, lane = tid & 63, w = __builtin_amdgcn_readfirstlane(tid >> 6), l31 = lane & 31, h = lane >> 5;
    bf16x8 qf[KS];
#pragma unroll
    for (int s_ = 0; s_ < KS; ++s_) qf[s_] = src.qfrag(32 * w + l31, s_, h);
    f32x16 o[NBLK];
#pragma unroll
    for (int b = 0; b < NBLK; ++b)
#pragma unroll
        for (int i = 0; i < 16; ++i) o[b][i] = 0.f;
    float m = -INFINITY, lsum = 0.f;
    u32x4_t kreg[NPK], vreg[NPV];
#define FL_LOAD(t_) do { _Pragma("unroll") for (int i_ = 0; i_ < NPK; ++i_) { const int p_ = tid + i_ * NTHREADS; kreg[i_] = src.kpiece(64 * (t_) + p_ / D8, p_ % D8); } \
                         _Pragma("unroll") for (int i_ = 0; i_ < NPV; ++i_) { const int p_ = tid + i_ * NTHREADS; vreg[i_] = src.vpiece(p_ >> 3, 64 * (t_) + 8 * (p_ & 7)); } } while (0)
#define FL_STORE(buf_) do { _Pragma("unroll") for (int i_ = 0; i_ < NPK; ++i_) { const int p_ = tid + i_ * NTHREADS; *(LAS u32x4_t*)(lds + (buf_) * BUF + ((p_ / D8) * KP + (p_ % D8) * 8) * 2) = kreg[i_]; } \
                          _Pragma("unroll") for (int i_ = 0; i_ < NPV; ++i_) { const int p_ = tid + i_ * NTHREADS; LAS unsigned char* a_ = lds + (buf_) * BUF + KBYTES + ((p_ >> 3) * VP + (p_ & 7) * 8) * 2; \
                              *(LAS u32x2_t*)a_ = (u32x2_t){vreg[i_].x, vreg[i_].y}; *(LAS u32x2_t*)(a_ + 8) = (u32x2_t){vreg[i_].z, vreg[i_].w}; } } while (0)
    __syncthreads();
    FL_LOAD(0); FL_STORE(0);
    __syncthreads();
    const int qmine = qpos0 + 32 * w + l31, qlast = qpos0 + 32 * w + 31;
    for (int t = 0; t < ntiles; ++t) {
        const int buf = t & 1;
        if (t + 1 < ntiles) FL_LOAD(t + 1);
        if (!CAUSAL || 64 * t <= qlast) {
            const LAS unsigned char* kb_ = lds + buf * BUF; const LAS unsigned char* vb_ = kb_ + KBYTES;
            f32x16 st[2];
#pragma unroll
            for (int kb = 0; kb < 2; ++kb) {
#pragma unroll
                for (int i = 0; i < 16; ++i) st[kb][i] = 0.f;
#pragma unroll
                for (int g_ = 0; g_ < KS / 4; ++g_) { bf16x8 kf[4];
#pragma unroll
                    for (int j = 0; j < 4; ++j) kf[j] = *(const LAS bf16x8*)(kb_ + ((32 * kb + l31) * KP + 16 * (4 * g_ + j) + 8 * h) * 2);
#pragma unroll
                    for (int j = 0; j < 4; ++j) st[kb] = MFMA32(kf[j], qf[4 * g_ + j], st[kb]);
                    __builtin_amdgcn_sched_barrier(0); }
            }
            if (CAUSAL && 64 * t + 63 > qpos0 + 32 * w) {
#pragma unroll
                for (int kb = 0; kb < 2; ++kb)
#pragma unroll
                    for (int i = 0; i < 16; ++i) { const int key = 64 * t + 32 * kb + crow(i, h); st[kb][i] = key <= qmine ? st[kb][i] : -INFINITY; }
            }
            float mx = -INFINITY;
#pragma unroll
            for (int kb = 0; kb < 2; ++kb)
#pragma unroll
                for (int i = 0; i < 16; ++i) mx = fmaxf(mx, st[kb][i]);
            mx = fmaxf(mx, __shfl_xor(mx, 32));
            const float mn = fmaxf(m, mx);
            { const float alpha = __builtin_amdgcn_exp2f((m - mn) * c2);
                lsum *= alpha;
#pragma unroll
                for (int b = 0; b < NBLK; ++b)
#pragma unroll
                    for (int i = 0; i < 16; ++i) o[b][i] *= alpha;
                m = mn;
            }
            const float nmc = -mn * c2;
            float ps = 0.f;
#pragma unroll
            for (int kb = 0; kb < 2; ++kb)
#pragma unroll
                for (int i = 0; i < 16; ++i) { const float p = __builtin_amdgcn_exp2f(__builtin_fmaf(st[kb][i], c2, nmc)); st[kb][i] = p; ps += p; }
            lsum += ps;
            bf16x8 pf[4];
#pragma unroll
            for (int ks = 0; ks < 4; ++ks) { const int kb = ks >> 1, s2 = ks & 1; u32x4_t pk;
                pk.x = cvtpk(st[kb][8 * s2 + 0], st[kb][8 * s2 + 1]); pk.y = cvtpk(st[kb][8 * s2 + 2], st[kb][8 * s2 + 3]);
                pk.z = cvtpk(st[kb][8 * s2 + 4], st[kb][8 * s2 + 5]); pk.w = cvtpk(st[kb][8 * s2 + 6], st[kb][8 * s2 + 7]); pf[ks] = __builtin_bit_cast(bf16x8, pk); }
            __builtin_amdgcn_sched_barrier(0);
#pragma unroll
            for (int b = 0; b < NBLK; ++b) { bf16x8 vf[4];
#pragma unroll
                for (int ks = 0; ks < 4; ++ks) { const LAS unsigned char* a_ = vb_ + ((32 * b + l31) * VP + 16 * ks + 4 * h) * 2;
                    const s16x4 lo = *(const LAS s16x4*)a_, hi = *(const LAS s16x4*)(a_ + 16);
                    vf[ks] = __builtin_shufflevector(lo, hi, 0, 1, 2, 3, 4, 5, 6, 7); }
#pragma unroll
                for (int ks = 0; ks < 4; ++ks) o[b] = MFMA32(vf[ks], pf[ks], o[b]);
                __builtin_amdgcn_sched_barrier(0); }
        }
        if (t + 1 < ntiles) FL_STORE(buf ^ 1);
        __syncthreads();
    }
#undef FL_LOAD
#undef FL_STORE
    lsum += __shfl_xor(lsum, 32);
    const float inv = 1.f / lsum;
    bf16_t* orow = O + (size_t)(32 * w + l31) * ldo;
#pragma unroll
    for (int b = 0; b < NBLK; ++b)
#pragma unroll
        for (int g = 0; g < 4; ++g) { u32x2_t pk; pk.x = cvtpk(o[b][4 * g + 0] * inv, o[b][4 * g + 1] * inv); pk.y = cvtpk(o[b][4 * g + 2] * inv, o[b][4 * g + 3] * inv);
            *(u32x2_t*)(orow + 32 * b + 8 * g + 4 * h) = pk; }
}
struct SrcMlaP { const bf16_t* kn; const bf16_t* kpe; const bf16_t* vt; const bf16_t* qraw; const bf16_t* qpe; int b, hh; size_t row0;
    DI bf16x8 qfrag(int r, int s_, int h8) const { return s_ < 8 ? *(const bf16x8*)(qraw + (row0 + r) * 1536 + hh * DQH + 16 * s_ + 8 * h8) : *(const bf16x8*)(qpe + (row0 + r) * 512 + hh * DROPE + 16 * (s_ - 8) + 8 * h8); }
    DI u32x4_t kpiece(int key, int d8) const { const size_t row = (size_t)b * SEQ + key;
        return d8 < 16 ? *(const u32x4_t*)(kn + row * 1024 + hh * DNOPE + d8 * 8) : *(const u32x4_t*)(kpe + row * DROPE + (d8 - 16) * 8); }
    DI u32x4_t vpiece(int dv, int key0) const { return *(const u32x4_t*)(vt + (size_t)(hh * DVH + dv) * NP + (size_t)b * SEQ + key0); } };
struct SrcMemP { const bf16_t* mk; const bf16_t* mvt; const bf16_t* xq; int b, hh; size_t row0;
    DI bf16x8 qfrag(int r, int s_, int h8) const { return *(const bf16x8*)(xq + (row0 + r) * ZLD + hh * XHD + 16 * s_ + 8 * h8); }
    DI u32x4_t kpiece(int key, int d8) const { return *(const u32x4_t*)(mk + ((size_t)b * NMEM + key) * 256 + hh * XHD + d8 * 8); }
    DI u32x4_t vpiece(int dv, int key0) const { return *(const u32x4_t*)(mvt + (size_t)(hh * XHD + dv) * (NB * NMEM) + (size_t)b * NMEM + key0); } };


typedef short v4i16_t __attribute__((ext_vector_type(4)));
DI s16x4 vtr(const LAS unsigned char* p) { return __builtin_bit_cast(s16x4, __builtin_amdgcn_ds_read_tr16_b64_v4i16((LAS v4i16_t*)p)); }
constexpr int MS_NSPLIT = 2, MS_KEYS = PAST / MS_NSPLIT, MS_TILES = MS_KEYS / 64;
DI void mla_sample_unit(LAS unsigned char* lds, const float* __restrict__ cckv, const float* __restrict__ ckpe, const int* __restrict__ pt,
                        const bf16_t* __restrict__ QLATb, const bf16_t* __restrict__ QPEb, float* __restrict__ PO, float* __restrict__ PML, int b, int split, float c2) {
    constexpr int KP = 328, KBYTES = 64 * KP * 2, SP = 68;
    LAS float* Sc = (LAS float*)(lds + 2 * KBYTES);
    const int tid = threadIdx.x, lane = tid & 63, w = __builtin_amdgcn_readfirstlane(tid >> 6), l31 = lane & 31, hh = lane >> 5, l15 = lane & 15, g4 = lane >> 4;
    const int kg = w >> 1, qg = w & 1;
    bf16x8 qf[10];
    { const int qi = 16 * qg + l15, t = qi >> 3, head = qi & 7;
      const bf16_t* ql = QLATb + (size_t)(b * DS + t) * 2048 + head * KVL + 8 * g4;
      const bf16_t* qp = QPEb + (size_t)(NP + b * DS + t) * 512 + head * DROPE + 8 * g4;
#pragma unroll
      for (int s_ = 0; s_ < 8; ++s_) qf[s_] = *(const bf16x8*)(ql + 32 * s_);
#pragma unroll
      for (int s_ = 0; s_ < 2; ++s_) qf[8 + s_] = *(const bf16x8*)(qp + 32 * s_); }
    f32x16 o;
#pragma unroll
    for (int i = 0; i < 16; ++i) o[i] = 0.f;
    float m = -INFINITY, lsum = 0.f;
    f32x4 crA[8], prA[2], crB[8], prB[2];
    const unsigned voffc = (unsigned)(((tid >> 6) * KVL + 4 * (tid & 63)) * 4), voffp = (unsigned)(((tid >> 4) * DROPE + 4 * (tid & 15)) * 4);
#define MS_LOAD(t_, CR_, PR_) do { const int key0_ = split * MS_KEYS + 64 * (t_); const int pg_ = __builtin_amdgcn_readfirstlane(pt[b * NPAGES + (key0_ >> 7)]); \
        const size_t rowb_ = (size_t)pg_ * PAGE + (key0_ & (PAGE - 1)); const char* cb_ = (const char*)(cckv + rowb_ * KVL); const char* pb_ = (const char*)(ckpe + rowb_ * DROPE); \
        _Pragma("unroll") for (int i_ = 0; i_ < 8; ++i_) CR_[i_] = __builtin_nontemporal_load((const f32x4*)(cb_ + (size_t)i_ * (8 * KVL * 4) + voffc)); \
        _Pragma("unroll") for (int i_ = 0; i_ < 2; ++i_) PR_[i_] = __builtin_nontemporal_load((const f32x4*)(pb_ + (size_t)i_ * (32 * DROPE * 4) + voffp)); } while (0)
#define MS_STORE(buf_, CR_, PR_) do { \
        _Pragma("unroll") for (int i_ = 0; i_ < 8; ++i_) { const int pc_ = tid + i_ * NTHREADS; *(LAS u32x2_t*)(lds + (buf_) * KBYTES + ((pc_ >> 6) * KP + 4 * (pc_ & 63)) * 2) = (u32x2_t){cvtpk(CR_[i_][0], CR_[i_][1]), cvtpk(CR_[i_][2], CR_[i_][3])}; } \
        _Pragma("unroll") for (int i_ = 0; i_ < 2; ++i_) { const int pc_ = tid + i_ * NTHREADS; *(LAS u32x2_t*)(lds + (buf_) * KBYTES + ((pc_ >> 4) * KP + KVL + 4 * (pc_ & 15)) * 2) = (u32x2_t){cvtpk(PR_[i_][0], PR_[i_][1]), cvtpk(PR_[i_][2], PR_[i_][3])}; } } while (0)
    __syncthreads();
    MS_LOAD(0, crA, prA); MS_LOAD(1, crB, prB); MS_STORE(0, crA, prA); MS_LOAD(2, crA, prA);
    __syncthreads();
    const int q4 = (lane & 15) >> 2, p4 = lane & 3, blk = (lane >> 4) & 1;
    auto tile = [&](const int buf) __attribute__((always_inline)) {
        const LAS unsigned char* kb_ = lds + buf * KBYTES;
        {   f32x4 s4 = {0.f, 0.f, 0.f, 0.f};
            const LAS unsigned char* kr_ = kb_ + ((16 * kg + l15) * KP + 8 * g4) * 2;
#pragma unroll
            for (int g_ = 0; g_ < 2; ++g_) { bf16x8 kf[5];
#pragma unroll
                for (int j = 0; j < 5; ++j) kf[j] = *(const LAS bf16x8*)(kr_ + 64 * (5 * g_ + j));
#pragma unroll
                for (int j = 0; j < 5; ++j) s4 = __builtin_amdgcn_mfma_f32_16x16x32_bf16(kf[j], qf[5 * g_ + j], s4, 0, 0, 0); }
            *(LAS f32x4*)(Sc + (16 * qg + l15) * SP + 16 * kg + 4 * g4) = s4; }
        __syncthreads();
        f32x4 sv[8];
#pragma unroll
        for (int i = 0; i < 8; ++i) sv[i] = *(const LAS f32x4*)(Sc + l31 * SP + 8 * i + 4 * hh);
        float mx = -INFINITY;
#pragma unroll
        for (int i = 0; i < 8; ++i) mx = fmaxf(mx, fmaxf(fmaxf(sv[i][0], sv[i][1]), fmaxf(sv[i][2], sv[i][3])));
        mx = fmaxf(mx, __shfl_xor(mx, 32));
        const float mn = fmaxf(m, mx);
        if (__builtin_amdgcn_ballot_w64(mn > m) != 0ull) {
            const float alpha = __builtin_amdgcn_exp2f((m - mn) * c2);
            lsum *= alpha;
#pragma unroll
            for (int i = 0; i < 16; ++i) o[i] *= alpha;
            m = mn;
        }
        const float nmc = -mn * c2;
        float ps = 0.f;
#pragma unroll
        for (int i = 0; i < 8; ++i)
#pragma unroll
            for (int e = 0; e < 4; ++e) { const float p = __builtin_amdgcn_exp2f(__builtin_fmaf(sv[i][e], c2, nmc)); sv[i][e] = p; ps += p; }
        lsum += ps;
#pragma unroll
        for (int ks = 0; ks < 4; ++ks) { const LAS unsigned char* a_ = kb_ + ((16 * ks + 4 * hh + q4) * KP + 32 * w + 16 * blk + 4 * p4) * 2;
            const s16x4 lo = vtr(a_), hi = vtr(a_ + 8 * KP * 2);
            const bf16x8 vf = __builtin_shufflevector(lo, hi, 0, 1, 2, 3, 4, 5, 6, 7); u32x4_t pk;
            pk.x = cvtpk(sv[2 * ks][0], sv[2 * ks][1]); pk.y = cvtpk(sv[2 * ks][2], sv[2 * ks][3]);
            pk.z = cvtpk(sv[2 * ks + 1][0], sv[2 * ks + 1][1]); pk.w = cvtpk(sv[2 * ks + 1][2], sv[2 * ks + 1][3]);
            o = MFMA32(vf, __builtin_bit_cast(bf16x8, pk), o); }
    };
    static_assert(MS_TILES % 2 == 0 && MS_TILES >= 4 && 2 * KBYTES + 32 * SP * 4 <= MISC_OFF, "mla_sample_unit pipeline");
#pragma unroll 1
    for (int t = 0; t < MS_TILES; t += 2) {
        tile(0);
        MS_STORE(1, crB, prB);
        if (t + 3 < MS_TILES) MS_LOAD(t + 3, crB, prB);
        __syncthreads();
        tile(1);
        if (t + 2 < MS_TILES) { MS_STORE(0, crA, prA); }
        if (t + 4 < MS_TILES) MS_LOAD(t + 4, crA, prA);
        __syncthreads();
    }
#undef MS_LOAD
#undef MS_STORE
    lsum += __shfl_xor(lsum, 32);
    const int item = b * MS_NSPLIT + split;
    if (w == 0 && lane < 32) { PML[(item * 32 + lane) * 2] = m * c2; PML[(item * 32 + lane) * 2 + 1] = lsum; }
#pragma unroll
    for (int i = 0; i < 16; ++i) PO[((size_t)item * 32 + l31) * KVL + 32 * w + crow(i, hh)] = o[i];
}


DI void ret_fused_phase(LAS unsigned char* lds, const bf16_t* __restrict__ RQt, const bf16_t* __restrict__ RKt, const bf16_t* __restrict__ RVT, bf16_t* __restrict__ ORETb, float* __restrict__ state_out, int bid, int G) {
    constexpr int PITCH = 136, KT_B = 128 * PITCH * 2, VT_B = 32 * PITCH * 2, NCH = SEQ / 128;
    int tid_ = threadIdx.x; asm volatile("" : "+v"(tid_));
    const int tid = tid_, lane = tid & 63, w = __builtin_amdgcn_readfirstlane(tid >> 6), l31 = lane & 31, hh = lane >> 5;
    const int ib = w < 4 ? 3 - (w >> 1) : (w >> 1) - 2, kh = w & 1;
    const int q4 = (lane & 15) >> 2, p4 = lane & 3, blk = (lane >> 4) & 1;
    LAS unsigned char* Kt = lds; LAS unsigned char* Vt = lds + KT_B; LAS unsigned char* SPl = Vt + VT_B; LAS float* RED = (LAS float*)(SPl + VT_B);
    static_assert(KT_B + 2 * VT_B + 4 * 16 * 64 * 4 <= MISC_OFF, "ret_fused_phase LDS");
    for (int v = bid; v < NB * RH * 8; v += G) {
        const int it = ((v & 7) * 4 + (v >> 6)) * 8 + ((v >> 3) & 7);
        const int ds = it & 7, h = (it >> 3) & 3, b = it >> 5; const float g128 = __expf(128.f * lg_gamma(h));
        f32x16 S;
#pragma unroll
        for (int i = 0; i < 16; ++i) S[i] = 0.f;
        u32x4_t kregA[4], vregA, kregB[4], vregB;
        const unsigned voffk = (unsigned)(((tid >> 4) * 512 + 8 * (tid & 15)) * 2), voffv = (unsigned)(((tid >> 4) * NT + 8 * (tid & 15)) * 2), voffq = (unsigned)((l31 * 512 + 8 * hh) * 2), voffo = (unsigned)((l31 * 1024 + 4 * hh) * 2);
#define RF_LOAD(c_, kreg, vreg) do { const size_t tok0_ = (size_t)b * SEQ + (c_) * 128; const char* kb_ = (const char*)(RKt + tok0_ * 512 + h * RDK); \
            _Pragma("unroll") for (int i_ = 0; i_ < 4; ++i_) kreg[i_] = *(const u32x4_t*)(kb_ + (size_t)i_ * (32 * 512 * 2) + voffk); \
            vreg = *(const u32x4_t*)((const char*)(RVT + (size_t)(h * RDV + 32 * ds) * NT + tok0_) + voffv); } while (0)
#define RF_LOADQ(c_, Q_) do { const char* qb_ = (const char*)(RQt + ((size_t)b * SEQ + (c_) * 128 + 32 * ib) * 512 + h * RDK + 64 * kh); _Pragma("unroll") for (int s_ = 0; s_ < 4; ++s_) Q_[s_] = *(const bf16x8*)(qb_ + 32 * s_ + voffq); } while (0)
        bf16x8 qf[4], qfnA[4], qfnB[4];
        RF_LOAD(0, kregA, vregA); RF_LOADQ(0, qfnA); RF_LOAD(1, kregB, vregB); RF_LOADQ(1, qfnB);
        __syncthreads();
        for (int i = tid; i < VT_B / 16; i += NTHREADS) *(LAS u32x4_t*)(SPl + i * 16) = (u32x4_t){0u, 0u, 0u, 0u};
        u32x2_t opk[2] = {{0u, 0u}, {0u, 0u}};
#define RF_FLUSH(c_) do { char* ob_ = (char*)(ORETb + ((size_t)b * SEQ + (c_) * 128 + 32 * ib) * 1024 + h * RDV + 32 * ds + 16 * kh); \
            *(u32x2_t*)(ob_ + voffo) = opk[0]; *(u32x2_t*)(ob_ + 16 + voffo) = opk[1]; } while (0)
        auto chunk = [&](const int c, u32x4_t (&kreg)[4], u32x4_t& vreg, bf16x8 (&qfn)[4]) __attribute__((always_inline)) {
#pragma unroll
            for (int i = 0; i < 4; ++i) { const int p = tid + i * NTHREADS; *(LAS u32x4_t*)(Kt + ((p >> 4) * PITCH + 8 * (p & 15)) * 2) = kreg[i]; }
            *(LAS u32x4_t*)(Vt + ((tid >> 4) * PITCH + 8 * (tid & 15)) * 2) = vreg;
#pragma unroll
            for (int s_ = 0; s_ < 4; ++s_) qf[s_] = qfn[s_];
            __syncthreads();
            RF_FLUSH(c > 0 ? c - 1 : 0);
            { const int cn = c + 2 < NCH ? c + 2 : NCH - 1; RF_LOAD(cn, kreg, vreg); RF_LOADQ(cn, qfn); }
            f32x16 o;
#pragma unroll
            for (int i = 0; i < 16; ++i) o[i] = 0.f;
#pragma unroll 1
            for (int jb = 0; jb <= ib; ++jb) {
                f32x16 x;
#pragma unroll
                for (int i = 0; i < 16; ++i) x[i] = 0.f;
#pragma unroll
                for (int s_ = 0; s_ < 4; ++s_) { const bf16x8 kf = *(const LAS bf16x8*)(Kt + ((32 * jb + l31) * PITCH + 64 * kh + 16 * s_ + 8 * hh) * 2); x = MFMA32(kf, qf[s_], x); }
                if (jb == ib) {
#pragma unroll
                    for (int i = 0; i < 16; ++i) x[i] = (crow(i, hh) <= l31) ? x[i] : 0.f;
                }
#pragma unroll
                for (int s2 = 0; s2 < 2; ++s2) {
                    u32x4_t pk; pk.x = cvtpk(x[8 * s2 + 0], x[8 * s2 + 1]); pk.y = cvtpk(x[8 * s2 + 2], x[8 * s2 + 3]); pk.z = cvtpk(x[8 * s2 + 4], x[8 * s2 + 5]); pk.w = cvtpk(x[8 * s2 + 6], x[8 * s2 + 7]);
                    const LAS unsigned char* vp = Vt + (l31 * PITCH + 32 * jb + 16 * s2 + 4 * hh) * 2;
                    const s16x4 lo = *(const LAS s16x4*)vp, hi = *(const LAS s16x4*)(vp + 16);
                    o = MFMA32(__builtin_shufflevector(lo, hi, 0, 1, 2, 3, 4, 5, 6, 7), __builtin_bit_cast(bf16x8, pk), o); }
            }
#pragma unroll
            for (int s_ = 0; s_ < 4; ++s_) { const bf16x8 sf = *(const LAS bf16x8*)(SPl + (l31 * PITCH + 64 * kh + 16 * s_ + 8 * hh) * 2); o = MFMA32(sf, qf[s_], o); }
#pragma unroll
            for (int i = 0; i < 8; ++i) RED[((ib * 2 + kh) * 8 + i) * 64 + lane] = kh ? o[i] : o[8 + i];
            if (w < 4) {
                f32x16 u;
#pragma unroll
                for (int i = 0; i < 16; ++i) u[i] = 0.f;
#pragma unroll
                for (int s_ = 0; s_ < 8; ++s_) { const LAS unsigned char* a_ = Kt + ((16 * s_ + 4 * hh + q4) * PITCH + 32 * w + 16 * blk + 4 * p4) * 2;
                    const s16x4 alo = vtr(a_), ahi = vtr(a_ + 8 * PITCH * 2);
                    const LAS unsigned char* vp = Vt + (l31 * PITCH + 16 * s_ + 4 * hh) * 2;
                    const s16x4 blo = *(const LAS s16x4*)vp, bhi = *(const LAS s16x4*)(vp + 16);
                    u = MFMA32(__builtin_shufflevector(alo, ahi, 0, 1, 2, 3, 4, 5, 6, 7), __builtin_shufflevector(blo, bhi, 0, 1, 2, 3, 4, 5, 6, 7), u); }
#pragma unroll
                for (int i = 0; i < 16; ++i) S[i] = S[i] * g128 + u[i];
            }
            __syncthreads();
#pragma unroll
            for (int g = 0; g < 2; ++g) { const LAS float* rp = RED + ((ib * 2 + (kh ^ 1)) * 8 + 4 * g) * 64 + lane;
                const float o0 = (kh ? o[8 + 4 * g + 0] : o[4 * g + 0]) + rp[0], o1 = (kh ? o[8 + 4 * g + 1] : o[4 * g + 1]) + rp[64], o2 = (kh ? o[8 + 4 * g + 2] : o[4 * g + 2]) + rp[128], o3 = (kh ? o[8 + 4 * g + 3] : o[4 * g + 3]) + rp[192];
                opk[g] = (u32x2_t){cvtpk(o0, o1), cvtpk(o2, o3)}; }
            if (w < 4) {
#pragma unroll
                for (int g = 0; g < 4; ++g) *(LAS u32x2_t*)(SPl + (l31 * PITCH + 32 * w + 8 * g + 4 * hh) * 2) = (u32x2_t){cvtpk(S[4 * g + 0] * g128, S[4 * g + 1] * g128), cvtpk(S[4 * g + 2] * g128, S[4 * g + 3] * g128)};
            }
                };
        static_assert(NCH % 2 == 0, "chunk pairs");
#pragma unroll 1
        for (int c = 0; c < NCH; c += 2) { chunk(c, kregA, vregA, qfnA); chunk(c + 1, kregB, vregB, qfnB); }
        RF_FLUSH(NCH - 1);
#undef RF_LOAD
#undef RF_LOADQ
#undef RF_FLUSH
        if (w < 4) {
            float* so = state_out + ((size_t)(b * RH + h) * RDK + 32 * w) * RDV + 32 * ds + l31;
#pragma unroll
            for (int i = 0; i < 16; ++i) so[(size_t)crow(i, hh) * RDV] = S[i];
        }
    }
}

struct QPtr { const float* p; DI float operator()(int d) const { return p[d]; } };
struct QMla { const float* ql; const float* qp; DI float operator()(int d) const { return d < KVL ? ql[d] : qp[d - KVL]; } };
DI void rms_row(const float* x, const float* g, float* o, int n, int lane) {
    float s = 0.f;
    for (int i = lane; i < n; i += 64) { const float v = x[i]; s += v * v; }
    const float r = rsqrtf(wave_sum(s) / (float)n + EPS);
    for (int i = lane; i < n; i += 64) o[i] = x[i] * r * g[i];
}

DI void rms_row_bf16(const float* x, const float* g, bf16_t* o, int n, int lane) {
    float s = 0.f;
    for (int i = lane; i < n; i += 64) { const float v = x[i]; s += v * v; }
    const float r = rsqrtf(wave_sum(s) / (float)n + EPS);
    for (int i = lane; i < n; i += 64) o[i] = f2bf(x[i] * r * g[i]);
}
#define GEMM_PHASE(EPI, ...) pg8::gemm_phase<EPI, pg8::StaticOrder, true, true>(__VA_ARGS__)
#define GEMM_SPLIT(...) pg8::gemm_phase<pg8::EpiPart, pg8::SplitOrder, true, true>(__VA_ARGS__)
__global__ void __launch_bounds__(NTHREADS, 2) fwd_kernel(Args args) {
    extern __shared__ __attribute__((aligned(16))) unsigned char lds_raw[];
    LAS unsigned char* ldsb = (LAS unsigned char*)lds_raw;
    LAS float* lds = (LAS float*)ldsb;
    volatile LAS unsigned* MISC = (volatile LAS unsigned*)(ldsb + MISC_OFF);
    const int tid = threadIdx.x, lane = tid & 63, wave = tid >> 6;
    const int G = gridDim.x, bid = blockIdx.x;
    const int gw = bid * NWAVES + wave, NGW = G * NWAVES;
    unsigned char* ws = args.ws;
    float* out = args.out;
    const int lo = args.ph_lo, hi = args.ph_hi;

    if (tid < 64) MISC[tid] = 0u;
    __syncthreads();
    XcdBarrier bar; bar.bar = (unsigned*)(ws + WS_CTL) + CW_BAR; bar.x = 0; bar.st = MISC;
    if (hi - lo > 1) bar = xcd_barrier_post((unsigned*)(ws + WS_CTL) + CW_BAR, MISC);
#define IN(k) (lo <= (k) && (k) < hi)
#define PHASE_IDS int tid_l_ = threadIdx.x; asm volatile("" : "+v"(tid_l_)); const int tid = tid_l_, lane = tid & 63, wave = tid >> 6, gw = bid * NWAVES + wave; (void)tid; (void)lane; (void)wave; (void)gw;
#define SEAM(k) do { if (IN(k) && IN((k) + 1)) xcd_barrier(bar); } while (0)

#define x_prompt ((const float*)(args.in[0]))
#define x_sample ((const float*)(args.in[1]))
#define mem_prompt ((const float*)(args.in[2]))
#define cache_ckv ((const float*)(args.in[3]))
#define cache_kpe ((const float*)(args.in[4]))
#define page_table ((const int*)args.in[5])
#define state_ret ((const float*)(args.in[6]))
#define cache_mem_k ((const float*)(args.in[7]))
#define cache_mem_v ((const float*)(args.in[8]))
#define g_mix_pre ((const float*)(args.in[9]))
#define g_mix_post ((const float*)(args.in[10]))
#define g_ffn_pre ((const float*)(args.in[11]))
#define g_ffn_post ((const float*)(args.in[12]))
#define g_mem ((const float*)(args.in[13]))
#define g_qlat ((const float*)(args.in[14]))
#define g_kvlat ((const float*)(args.in[15]))
#define w_in ((const float*)(args.in[16]))
#define w_uq ((const float*)(args.in[17]))
#define w_uk ((const float*)(args.in[18]))
#define w_uv ((const float*)(args.in[19]))
#define w_mem_k ((const float*)(args.in[20]))
#define w_mem_v ((const float*)(args.in[21]))
#define w_ret_o ((const float*)(args.in[22]))
#define w_mla_o ((const float*)(args.in[23]))
#define w_x_o ((const float*)(args.in[24]))
#define w_out ((const float*)(args.in[25]))
#define w_gate ((const float*)(args.in[26]))
#define w_up ((const float*)(args.in[27]))
#define w_down ((const float*)(args.in[28]))
#define COSA ((float*)(ws + WS_COSA))
#define SINA ((float*)(ws + WS_SINA))
#define COSB ((float*)(ws + WS_COSB))
#define SINB ((float*)(ws + WS_SINB))
#define U ((float*)(ws + WS_U))
#define MN ((float*)(ws + WS_MN))
#define Zb ((bf16_t*)(ws + WS_Z))
#define RQ ((float*)(ws + WS_RQ))
#define RK ((float*)(ws + WS_RK))
#define CQN ((float*)(ws + WS_CQN))
#define CKVN ((float*)(ws + WS_CKVN))
#define KPER ((float*)(ws + WS_KPER))
#define Q ((float*)(ws + WS_Q))
#define QLAT ((float*)(ws + WS_QLAT))
#define QPE ((float*)(ws + WS_QPE))
#define ORETb ((bf16_t*)(ws + WS_ORET))
#define OLAT ((float*)(ws + WS_OLAT))
#define OX ((float*)(ws + WS_OX))
#define OMLA ((float*)(ws + WS_OMLA))
#define ORETN ((float*)(ws + WS_ORETN))
#define ARET ((float*)(ws + WS_ARET))
#define AMLA ((float*)(ws + WS_AMLA))
#define AX ((float*)(ws + WS_AX))
#define MIX ((float*)(ws + WS_MIX))
#define HPb ((bf16_t*)(ws + WS_HP))
#define Hb ((bf16_t*)(ws + WS_H))
#define F ((float*)(ws + WS_F))
#define GU ((float*)(ws + WS_GG))
#define FOb ((bf16_t*)(ws + WS_FO))
#define WinT ((bf16_t*)(ws + WS_WIN_T))
#define WmkvT ((bf16_t*)(ws + WS_WMKV_T))
#define WuqT ((bf16_t*)(ws + WS_WUQ_T))
#define WcatT ((bf16_t*)(ws + WS_WRO_T))
#define CATb ((bf16_t*)(ws + WS_ORETNB))
#define WroT ((bf16_t*)(ws + WS_WRO_T))
#define WmoT ((bf16_t*)(ws + WS_WMO_T))
#define WxoT ((bf16_t*)(ws + WS_WXO_T))
#define WoT ((bf16_t*)(ws + WS_WO_T))
#define WguT ((bf16_t*)(ws + WS_WGU_T))
#define WdT ((bf16_t*)(ws + WS_WD_T))
#define Ub ((bf16_t*)(ws + WS_UB))
#define MNb ((bf16_t*)(ws + WS_MNB))
#define CQNb ((bf16_t*)(ws + WS_CQNB))
#define ORETNb ((bf16_t*)(ws + WS_ORETNB))
#define OMLAb ((bf16_t*)(ws + WS_OMLAB))
#define OXb ((bf16_t*)(ws + WS_OXB))
#define MIXb ((bf16_t*)(ws + WS_MIXB))
#define Fb ((bf16_t*)(ws + WS_FB))
#define ACTb ((bf16_t*)(ws + WS_ACTB))
#define WukT ((bf16_t*)(ws + WS_WUK_T))
#define WuvT ((bf16_t*)(ws + WS_WUV_T))
#define CKVNb ((bf16_t*)(ws + WS_CKVNB))
#define KPERb ((bf16_t*)(ws + WS_KPERB))
#define XQb ((bf16_t*)(ws + WS_XQB))
#define MKb ((bf16_t*)(ws + WS_MKB))
#define MVT ((bf16_t*)(ws + WS_MVT))
#define KN ((bf16_t*)(ws + WS_KN))
#define VT ((bf16_t*)(ws + WS_VT))
#define Qb ((bf16_t*)(ws + WS_QB))
#define RQt ((bf16_t*)(ws + WS_RQT))
#define RKt ((bf16_t*)(ws + WS_RKT))
#define RKtT ((bf16_t*)(ws + WS_RKTT))
#define RVT ((bf16_t*)(ws + WS_RVT))
#define UT ((float*)(ws + WS_UT))
#define SPT ((bf16_t*)(ws + WS_SPT))
#define QPEb ((bf16_t*)(ws + WS_QPEB))
#define WukB ((bf16_t*)(ws + WS_WUKB))
#define PART ((float*)(ws + WS_PART))
#define SGb ((bf16_t*)(ws + WS_SGB))
#define SRGb ((bf16_t*)(ws + WS_SRGB))
#define T0b ((bf16_t*)(ws + WS_T0B))
#define T1b ((bf16_t*)(ws + WS_T1B))
#define QLATb ((bf16_t*)(ws + WS_QLATB))
#define PO ((float*)(ws + WS_PO))
#define PML ((float*)(ws + WS_PML))
    if (IN(0)) { PHASE_IDS
        for (int i = bid * NTHREADS + tid; i < NPOS * 64 + NPOS * 32; i += G * NTHREADS) {
            const bool a = i < NPOS * 64; const int j = a ? i : i - NPOS * 64; const int half = a ? 64 : 32;
            const int p = j / half, f = j % half; const int pos = p < SEQ ? p : PAST + (p - SEQ);
            const float inv = powf(10000.0f, -(float)f / (float)half);
            const float ang = (float)pos * inv;
            double rev = (double)ang * 0.15915494309189535; rev -= floor(rev);
            const float r = (float)rev;
            const float sn = __builtin_amdgcn_sinf(r), cs = __builtin_amdgcn_cosf(r);
            if (a) { COSA[j] = cs; SINA[j] = sn; } else { COSB[j] = cs; SINB[j] = sn; }
        }
#pragma unroll 1
        for (int pass = 0; pass < 2; ++pass) {
            const int nrows = pass ? NB * NMEM : NT; const float* gsrc = pass ? g_mem : g_mix_pre; bf16_t* dst = pass ? MNb : Ub;
#define P0_SRC(r_) (pass ? mem_prompt + (size_t)(r_) * DM : (r_) < NP ? x_prompt + (size_t)(r_) * DM : x_sample + (size_t)((r_) - NP) * DM)
#define P0_LOAD(r_, A_) do { const float* s_ = P0_SRC(r_); _Pragma("unroll") for (int j_ = 0; j_ < 4; ++j_) A_[j_] = *(const f32x4*)(s_ + 4 * lane + 256 * j_); } while (0)
            f32x4 gv[4];
#pragma unroll
            for (int j = 0; j < 4; ++j) gv[j] = *(const f32x4*)(gsrc + 4 * lane + 256 * j);
#pragma unroll 1
            for (int row0 = gw; row0 < nrows; row0 += 4 * NGW) {
                f32x4 a[4][4];
#pragma unroll
                for (int k = 0; k < 4; ++k) { const int r = row0 + k * NGW; if (r < nrows) P0_LOAD(r, a[k]); }
#pragma unroll
                for (int k = 0; k < 4; ++k) { const int r = row0 + k * NGW;
                    if (r < nrows) { float ss = 0.f;
#pragma unroll
                        for (int j = 0; j < 4; ++j) ss += a[k][j][0] * a[k][j][0] + a[k][j][1] * a[k][j][1] + a[k][j][2] * a[k][j][2] + a[k][j][3] * a[k][j][3];
                        const float rs = rsqrtf(wave_sum(ss) * (1.f / DM) + EPS);
#pragma unroll
                        for (int j = 0; j < 4; ++j) { const f32x4 v = a[k][j] * rs * gv[j]; *(u32x2_t*)(dst + (size_t)r * DM + 4 * lane + 256 * j) = (u32x2_t){cvtpk(v[0], v[1]), cvtpk(v[2], v[3])}; } } }
            }
#undef P0_LOAD
#undef P0_SRC
        }
        {
            LAS float* scr = lds + wave * (64 * 33);
            int rot = 0;
            transpose_w(w_in, 1024, DIN, WinT, 1024, 0, scr, gw, NGW, lane, rot);
            for (int i = bid * NTHREADS + tid; i < (ZLD - DIN) * 1024 / 2; i += G * NTHREADS) ((unsigned*)(WinT + (size_t)DIN * 1024))[i] = 0u;
            for (int i = bid * NTHREADS + tid; i < MH * KVL * DNOPE / 4; i += G * NTHREADS) { const f32x4 v = *(const f32x4*)(w_uk + 4 * (size_t)i); *(u32x2_t*)(WukB + 4 * (size_t)i) = (u32x2_t){cvtpk(v[0], v[1]), cvtpk(v[2], v[3])}; }
            transpose_w(w_mem_k, 1024, 256, WmkvT, 1024, 0, scr, gw, NGW, lane, rot);
            transpose_w(w_mem_v, 1024, 256, WmkvT, 1024, 256, scr, gw, NGW, lane, rot);
            transpose_w(w_uq, QL, 1536, WuqT, QL, 0, scr, gw, NGW, lane, rot);
            for (int hh = 0; hh < MH; ++hh) { transpose_w(w_uk + (size_t)hh * KVL * DNOPE, KVL, DNOPE, WukT, KVL, hh * DNOPE, scr, gw, NGW, lane, rot);
                                              transpose_w(w_uv + (size_t)hh * KVL * DVH, KVL, DVH, WuvT, KVL, hh * DVH, scr, gw, NGW, lane, rot); }
        }
    }
    SEAM(0);
    if (IN(1)) {
        static_assert(WS_MNB == WS_UB + (size_t)NT * 1024 * 2 && WS_WMKV_T == WS_WIN_T + (size_t)ZLD * 1024 * 2, "P1 stacks Ub|MNb and WinT|WmkvT");
        { pg8::Gemm g{Ub, WinT, NT + NB * NMEM, ZLD + 512, 1024, 1024, 1024}; pg8::P1Order S; S.init(G, bid); pg8::EpiP1 E{Zb, ZLD, out + O_MKP, out + O_MVP, SRGb, SGb, C_RG, C_G};
          pg8::gemm_phase<pg8::EpiP1, pg8::P1Order, true, true>(ldsb, g, S, E); }
        __syncthreads();
        if (bid >= 72 || G != 256) {
            const int fb = G == 256 ? bid - 72 : bid, FG = G == 256 ? G - 72 : G; const int lane = threadIdx.x & 63, wave = threadIdx.x >> 6, gw = fb * NWAVES + wave, NGW = FG * NWAVES;
            LAS float* scr = lds + wave * (64 * 33);
            int rot = 0;
            transpose_w(w_gate, 1024, DFF, WguT, 1024, 0, scr, gw, NGW, lane, rot, 2);
            transpose_w(w_up, 1024, DFF, WguT, 1024, 1, scr, gw, NGW, lane, rot, 2);
            transpose_w(w_down, DFF, 1024, WdT, DFF, 0, scr, gw, NGW, lane, rot);
            transpose_w(w_ret_o, 1024, 1024, WcatT, CATLD, 0, scr, gw, NGW, lane, rot);
            transpose_w(w_mla_o, 1024, 1024, WcatT + 1024, CATLD, 0, scr, gw, NGW, lane, rot);
            transpose_w(w_x_o, 256, 1024, WcatT + 2048, CATLD, 0, scr, gw, NGW, lane, rot);
            transpose_w(w_out, 1024, 1024, WoT, 1024, 0, scr, gw, NGW, lane, rot);
        }
        __syncthreads();
        { pg8::Gemm g{WinT + (size_t)C_RV * 1024, Ub, 1024, NP, 1024, 1024, 1024}; pg8::StaticOrder S; S.init(1024, NP, G, bid); pg8::EpiBf16S E{RVT, NT};
          GEMM_PHASE(pg8::EpiBf16S, ldsb, g, S, E); }
    }
    SEAM(1);
    if (IN(2)) { PHASE_IDS
        {   constexpr int row_base = 0;
            {
                const int hq = lane >> 4, f4 = (lane & 15) * 4;
#define P2_LOAD(r_, Q1_, Q2_, K1_, K2_, CQ_, CV_, P1_, P2_, CA_, SA_, CB_, SB_, P_) do { const bf16_t* z_ = Zb + (size_t)(row_base + (r_)) * ZLD; P_ = pos_index(row_base + (r_)); \
                Q1_ = *(const u32x2_t*)(z_ + C_RQ + hq * RDK + f4); Q2_ = *(const u32x2_t*)(z_ + C_RQ + hq * RDK + 64 + f4); K1_ = *(const u32x2_t*)(z_ + C_RK + hq * RDK + f4); K2_ = *(const u32x2_t*)(z_ + C_RK + hq * RDK + 64 + f4); \
                CQ_ = (u32x4_t){0u, 0u, 0u, 0u}; if (lane < 48) CQ_ = *(const u32x4_t*)(z_ + C_CQ + 8 * lane); CV_ = *(const u32x2_t*)(z_ + C_CKV + 4 * lane); \
                P1_ = (u32x2_t){0u, 0u}; P2_ = P1_; CB_ = (f32x4){0.f, 0.f, 0.f, 0.f}; SB_ = CB_; \
                if (lane < 8) { P1_ = *(const u32x2_t*)(z_ + C_KPE + 4 * lane); P2_ = *(const u32x2_t*)(z_ + C_KPE + 32 + 4 * lane); CB_ = *(const f32x4*)(COSB + P_ * 32 + 4 * lane); SB_ = *(const f32x4*)(SINB + P_ * 32 + 4 * lane); } \
                CA_ = *(const f32x4*)(COSA + P_ * 64 + f4); SA_ = *(const f32x4*)(SINA + P_ * 64 + f4); } while (0)
#define BLO(x_) __builtin_bit_cast(float, (x_) << 16)
#define BHI(x_) __builtin_bit_cast(float, (x_) & 0xffff0000u)
                struct P2Row { u32x2_t q1, q2, k1, k2, cv, p1, p2; u32x4_t cq8; f32x4 ca, sa, cb, sb; int p; };
#pragma unroll 1
                for (int row0 = gw; row0 < NT; row0 += 4 * NGW) {
                    P2Row R[4];
#pragma unroll
                    for (int k = 0; k < 4; ++k) { const int r = row0 + k * NGW; if (r < NT) P2_LOAD(r, R[k].q1, R[k].q2, R[k].k1, R[k].k2, R[k].cq8, R[k].cv, R[k].p1, R[k].p2, R[k].ca, R[k].sa, R[k].cb, R[k].sb, R[k].p); }
#pragma unroll
                    for (int k = 0; k < 4; ++k) { const int r = row0 + k * NGW;
                    if (r < NT) {
                    const u32x2_t q1 = R[k].q1, q2 = R[k].q2, k1 = R[k].k1, k2 = R[k].k2, cv = R[k].cv, p1 = R[k].p1, p2 = R[k].p2; const u32x4_t cq8 = R[k].cq8; const f32x4 ca = R[k].ca, sa = R[k].sa, cb = R[k].cb, sb = R[k].sb; const int p = R[k].p;
                    const int row = row_base + r; const int il = p & 127; const bool prompt = row < NP;
                    {
                        const float x1q[4] = {BLO(q1.x), BHI(q1.x), BLO(q1.y), BHI(q1.y)}, x2q[4] = {BLO(q2.x), BHI(q2.x), BLO(q2.y), BHI(q2.y)};
                        const float x1k[4] = {BLO(k1.x), BHI(k1.x), BLO(k1.y), BHI(k1.y)}, x2k[4] = {BLO(k2.x), BHI(k2.x), BLO(k2.y), BHI(k2.y)};
                        const float sc = 0.08838834764831845f;
                        float oq1[4], oq2[4], ok1[4], ok2[4];
#pragma unroll
                        for (int e = 0; e < 4; ++e) { oq1[e] = x1q[e] * ca[e] - x2q[e] * sa[e]; oq2[e] = x1q[e] * sa[e] + x2q[e] * ca[e];
                            ok1[e] = (x1k[e] * ca[e] - x2k[e] * sa[e]) * sc; ok2[e] = (x1k[e] * sa[e] + x2k[e] * ca[e]) * sc; }
                        if (prompt) {
                            const float fq = __expf((float)(il - 127) * lg_gamma(hq)), fk = 1.f / fq;
                            *(u32x2_t*)(RQt + (size_t)row * 512 + hq * RDK + f4) = (u32x2_t){cvtpk(oq1[0] * fq, oq1[1] * fq), cvtpk(oq1[2] * fq, oq1[3] * fq)};
                            *(u32x2_t*)(RQt + (size_t)row * 512 + hq * RDK + 64 + f4) = (u32x2_t){cvtpk(oq2[0] * fq, oq2[1] * fq), cvtpk(oq2[2] * fq, oq2[3] * fq)};
                            const u32x2_t kb1 = {cvtpk(ok1[0] * fk, ok1[1] * fk), cvtpk(ok1[2] * fk, ok1[3] * fk)}, kb2 = {cvtpk(ok2[0] * fk, ok2[1] * fk), cvtpk(ok2[2] * fk, ok2[3] * fk)};
                            *(u32x2_t*)(RKt + (size_t)row * 512 + hq * RDK + f4) = kb1; *(u32x2_t*)(RKt + (size_t)row * 512 + hq * RDK + 64 + f4) = kb2;
                        } else {
                            *(f32x4*)(RQ + (size_t)row * 512 + hq * RDK + f4) = (f32x4){oq1[0], oq1[1], oq1[2], oq1[3]}; *(f32x4*)(RQ + (size_t)row * 512 + hq * RDK + 64 + f4) = (f32x4){oq2[0], oq2[1], oq2[2], oq2[3]};
                            *(f32x4*)(RK + (size_t)row * 512 + hq * RDK + f4) = (f32x4){ok1[0], ok1[1], ok1[2], ok1[3]}; *(f32x4*)(RK + (size_t)row * 512 + hq * RDK + 64 + f4) = (f32x4){ok2[0], ok2[1], ok2[2], ok2[3]};
                        }
                    }
                    {
                        const float c_[8] = {BLO(cq8.x), BHI(cq8.x), BLO(cq8.y), BHI(cq8.y), BLO(cq8.z), BHI(cq8.z), BLO(cq8.w), BHI(cq8.w)};
                        float ss = 0.f;
#pragma unroll
                        for (int e = 0; e < 8; ++e) ss += c_[e] * c_[e];
                        const float rr = rsqrtf(wave_sum(ss) * (1.f / QL) + EPS);
                        if (lane < 48) { const f32x4 g0 = *(const f32x4*)(g_qlat + 8 * lane), g1 = *(const f32x4*)(g_qlat + 8 * lane + 4);
                            *(u32x4_t*)(CQNb + (size_t)row * QL + 8 * lane) = (u32x4_t){cvtpk(c_[0] * rr * g0[0], c_[1] * rr * g0[1]), cvtpk(c_[2] * rr * g0[2], c_[3] * rr * g0[3]),
                                                                                     cvtpk(c_[4] * rr * g1[0], c_[5] * rr * g1[1]), cvtpk(c_[6] * rr * g1[2], c_[7] * rr * g1[3])}; }
                    }
                    {
                        const float v_[4] = {BLO(cv.x), BHI(cv.x), BLO(cv.y), BHI(cv.y)};
                        const float rr = rsqrtf(wave_sum(v_[0] * v_[0] + v_[1] * v_[1] + v_[2] * v_[2] + v_[3] * v_[3]) * (1.f / KVL) + EPS);
                        const f32x4 g0 = *(const f32x4*)(g_kvlat + 4 * lane); const f32x4 o_ = {v_[0] * rr * g0[0], v_[1] * rr * g0[1], v_[2] * rr * g0[2], v_[3] * rr * g0[3]};
                        float* ockv = row < NP ? out + O_CKVP + (size_t)row * KVL : out + O_CKVS + (size_t)(row - NP) * KVL;
                        *(f32x4*)(ockv + 4 * lane) = o_; if (!prompt) *(f32x4*)(CKVN + (size_t)row * KVL + 4 * lane) = o_;
                        *(u32x2_t*)(CKVNb + (size_t)row * KVL + 4 * lane) = (u32x2_t){cvtpk(o_[0], o_[1]), cvtpk(o_[2], o_[3])};
                    }
                    if (lane < 8) {
                        const float x1[4] = {BLO(p1.x), BHI(p1.x), BLO(p1.y), BHI(p1.y)}, x2[4] = {BLO(p2.x), BHI(p2.x), BLO(p2.y), BHI(p2.y)};
                        f32x4 o1, o2;
#pragma unroll
                        for (int e = 0; e < 4; ++e) { o1[e] = x1[e] * cb[e] - x2[e] * sb[e]; o2[e] = x1[e] * sb[e] + x2[e] * cb[e]; }
                        if (!prompt) { *(f32x4*)(KPER + (size_t)row * DROPE + 4 * lane) = o1; *(f32x4*)(KPER + (size_t)row * DROPE + 32 + 4 * lane) = o2; }
                        float* okpe = row < NP ? out + O_KPEP + (size_t)row * DROPE : out + O_KPES + (size_t)(row - NP) * DROPE;
                        *(f32x4*)(okpe + 4 * lane) = o1; *(f32x4*)(okpe + 32 + 4 * lane) = o2;
                        *(u32x2_t*)(KPERb + (size_t)row * DROPE + 4 * lane) = (u32x2_t){cvtpk(o1[0], o1[1]), cvtpk(o1[2], o1[3])}; *(u32x2_t*)(KPERb + (size_t)row * DROPE + 32 + 4 * lane) = (u32x2_t){cvtpk(o2[0], o2[1]), cvtpk(o2[2], o2[3])};
                    }
                    } }
                }
#undef P2_LOAD
            }
        }
    }
    if (IN(2)) { PHASE_IDS
        for (int i = bid * NTHREADS + tid; i < NB * NMEM * 256; i += G * NTHREADS) { MKb[i] = f2bf(out[O_MKP + i]);
            const int f = i / (NB * NMEM), r = i - f * (NB * NMEM); MVT[i] = f2bf(out[O_MVP + (size_t)r * 256 + f]); }
    }
    SEAM(2);
    if (IN(3)) { pg8::Gemm g{CQNb, WuqT, NT, 1536, QL, QL, QL}; pg8::StaticOrder S; S.init(NT, 1536, G, bid); pg8::EpiBf16S E{Qb, 1536};
        GEMM_PHASE(pg8::EpiBf16S, ldsb, g, S, E);
        __syncthreads();
        { pg8::Gemm g2{CKVNb, WukT, NP, 1024, KVL, KVL, KVL}; pg8::StaticOrder S2; S2.init(NP, 1024, G, bid); pg8::EpiBf16S E2{KN, 1024}; GEMM_PHASE(pg8::EpiBf16S, ldsb, g2, S2, E2); }
        __syncthreads();
        { pg8::Gemm g3{WuvT, CKVNb, 1024, NP, KVL, KVL, KVL}; pg8::StaticOrder S3; S3.init(1024, NP, G, bid); pg8::EpiBf16S E3{VT, NP}; GEMM_PHASE(pg8::EpiBf16S, ldsb, g3, S3, E3); }
        }
    SEAM(3);
    if (IN(4)) { PHASE_IDS
        {
            const int hd = lane >> 3, f4 = (lane & 7) * 4;
#define P4_LOAD(r_, X1_, X2_, C_, S_) do { const bf16_t* q_ = Qb + (size_t)(r_) * 1536 + hd * DQH + DNOPE + f4; X1_ = *(const u32x2_t*)q_; X2_ = *(const u32x2_t*)(q_ + 32); \
            const int p_ = pos_index(r_); C_ = *(const f32x4*)(COSB + p_ * 32 + f4); S_ = *(const f32x4*)(SINB + p_ * 32 + f4); } while (0)
#pragma unroll 1
            for (int row0 = gw; row0 < NT; row0 += 4 * NGW) {
                u32x2_t x1[4], x2[4]; f32x4 cb[4], sb[4];
#pragma unroll
                for (int k = 0; k < 4; ++k) { const int r = row0 + k * NGW; if (r < NT) P4_LOAD(r, x1[k], x2[k], cb[k], sb[k]); }
#pragma unroll
                for (int k = 0; k < 4; ++k) { const int r = row0 + k * NGW;
                    if (r < NT) {
                        const float a0 = __builtin_bit_cast(float, x1[k].x << 16), a1 = __builtin_bit_cast(float, x1[k].x & 0xffff0000u), a2 = __builtin_bit_cast(float, x1[k].y << 16), a3 = __builtin_bit_cast(float, x1[k].y & 0xffff0000u);
                        const float b0 = __builtin_bit_cast(float, x2[k].x << 16), b1 = __builtin_bit_cast(float, x2[k].x & 0xffff0000u), b2 = __builtin_bit_cast(float, x2[k].y << 16), b3 = __builtin_bit_cast(float, x2[k].y & 0xffff0000u);
                        bf16_t* o_ = QPEb + (size_t)r * 512 + hd * DROPE + f4;
                        *(u32x2_t*)o_ = (u32x2_t){cvtpk(a0 * cb[k][0] - b0 * sb[k][0], a1 * cb[k][1] - b1 * sb[k][1]), cvtpk(a2 * cb[k][2] - b2 * sb[k][2], a3 * cb[k][3] - b3 * sb[k][3])};
                        *(u32x2_t*)(o_ + 32) = (u32x2_t){cvtpk(a0 * sb[k][0] + b0 * cb[k][0], a1 * sb[k][1] + b1 * cb[k][1]), cvtpk(a2 * sb[k][2] + b2 * cb[k][2], a3 * sb[k][3] + b3 * cb[k][3])}; } }
            }
#undef P4_LOAD
        }
        for (int wt = gw; wt < MH * 16 * 2; wt += NGW) {
            const int lh = wt & 1, rb = (wt >> 1) & 15, head = wt >> 5; const int l31 = lane & 31, h8 = lane >> 5;
            f32x16 acc[4];
#pragma unroll
            for (int k_ = 0; k_ < 4; ++k_)
#pragma unroll
                for (int i = 0; i < 16; ++i) acc[k_][i] = 0.f;
            const bf16_t* ap = Qb + ((size_t)NP + 32 * rb + l31) * 1536 + head * DQH + 8 * h8;
            const bf16_t* bp = WukB + ((size_t)head * KVL + 128 * lh + l31) * DNOPE + 8 * h8;
#pragma unroll
            for (int s_ = 0; s_ < 8; ++s_) { const bf16x8 a = *(const bf16x8*)(ap + 16 * s_);
#pragma unroll
                for (int k_ = 0; k_ < 4; ++k_) { const bf16x8 b_ = *(const bf16x8*)(bp + (size_t)(32 * k_) * DNOPE + 16 * s_); acc[k_] = MFMA32(a, b_, acc[k_]); } }
#pragma unroll
            for (int k_ = 0; k_ < 4; ++k_)
#pragma unroll
                for (int i = 0; i < 16; ++i) QLATb[(size_t)(32 * rb + crow(i, h8)) * 2048 + head * KVL + 128 * lh + 32 * k_ + l31] = f2bf(acc[k_][i]);
        }
    }
    SEAM(4);
    if (IN(5)) { PHASE_IDS
        auto compute_units = [&]() __attribute__((always_inline)) {
        if (args.sub & 2) for (int v = bid; v < NB * MH * 4; v += G) {
            const int it = ((v & 7) * 8 + (v >> 5)) * 4 + ((v >> 3) & 3);
            const int pr = __builtin_amdgcn_readfirstlane(it & 3), hh = __builtin_amdgcn_readfirstlane((it >> 2) & 7), b = __builtin_amdgcn_readfirstlane(it >> 5);
#pragma unroll 1
            for (int half = 0; half < 2; ++half) { const int qb = __builtin_amdgcn_readfirstlane(half ? pr : 7 - pr); const size_t row0 = (size_t)b * SEQ + qb * 256;
                SrcMlaP src{KN, KPERb, VT, Qb, QPEb, b, hh, row0};
                flash_unit<192, 128, true>(ldsb, src, qb * 256, 4 * (qb + 1), CATb + row0 * CATLD + 1024 + hh * DVH, CATLD, 0.07216878364870322f * 1.4426950408889634f); }
        }
        if (args.sub & 4) ret_fused_phase(ldsb, RQt, RKt, RVT, ORETb, out + O_RETP, bid, G);
        if (args.sub & 16) for (int it = bid; it < NB * XH * 8; it += G) {
            const int qb = __builtin_amdgcn_readfirstlane(it & 7), hh = __builtin_amdgcn_readfirstlane((it >> 3) & 3), b = __builtin_amdgcn_readfirstlane(it >> 5); const size_t row0 = (size_t)b * SEQ + qb * 256;
            SrcMemP src{MKb, MVT, Zb + C_XQ, b, hh, row0};
            flash_unit<64, 64, false>(ldsb, src, 0, 4, CATb + row0 * CATLD + 2048 + hh * XHD, CATLD, 0.125f * 1.4426950408889634f);
        }
        };
        const bool compute_first = ((bid >> 3) & 1) != 0;
        if (compute_first) compute_units();
        if (args.sub & 1) for (int it = bid; it < DB * MS_NSPLIT; it += G) { const int split = __builtin_amdgcn_readfirstlane(it % MS_NSPLIT), b = __builtin_amdgcn_readfirstlane(it / MS_NSPLIT);
            mla_sample_unit(ldsb, cache_ckv, cache_kpe, page_table, QLATb, QPEb, PO, PML, b, split, 0.07216878364870322f * 1.4426950408889634f); }
        if (args.sub & 8) for (int it = bid; it < DB * RH; it += G) {
            const int h = it & 3, b = it >> 2; const float lg = lg_gamma(h);
            const float* s0 = state_ret + (size_t)it * RDK * RDV;
            float* so = out + O_RETS + (size_t)it * RDK * RDV;
            LAS float* inner = lds;
            LAS float* qk = lds + 16;
            LAS float* vls = lds + 1040;
            LAS float* red = lds + 2064;
            f32x4 sv[16], vv[4];
#pragma unroll
            for (int r = 0; r < 16; ++r) sv[r] = __builtin_nontemporal_load((const f32x4*)(s0 + (size_t)(wave + 8 * r) * RDV + 4 * lane));
#pragma unroll
            for (int j = 0; j < DS; ++j) { const u32x2_t t_ = *(const u32x2_t*)(Zb + ((size_t)NP + b * DS + j) * ZLD + C_RV + h * RDV + 4 * lane); vv[j] = (f32x4){BLO(t_.x), BHI(t_.x), BLO(t_.y), BHI(t_.y)}; }
            __syncthreads();
            for (int i = tid; i < 1024; i += NTHREADS) { const int which = i >> 9, ti = (i >> 7) & 3, d = i & 127; const size_t row = (size_t)NP + b * DS + ti;
                qk[i] = which ? RK[row * 512 + h * RDK + d] : RQ[row * 512 + h * RDK + d]; }
            if (wave == 0) {
#pragma unroll
                for (int j = 0; j < DS; ++j) *(LAS f32x4*)(vls + j * 256 + 4 * lane) = vv[j]; }
            __syncthreads();
            for (int pr = wave; pr < 16; pr += NWAVES) { const int i = pr >> 2, j = pr & 3;
                float s_ = qk[i * 128 + lane] * qk[512 + j * 128 + lane] + qk[i * 128 + 64 + lane] * qk[512 + j * 128 + 64 + lane];
                s_ = wave_sum(s_);
                if (lane == 0) inner[pr] = (j <= i) ? s_ * __expf((float)(i - j) * lg) : 0.f; }
            const float g4 = __expf(4.f * lg), gk0 = __expf(3.f * lg), gk1 = __expf(2.f * lg), gk2 = __expf(lg);
            f32x4 po[4];
#pragma unroll
            for (int i = 0; i < 4; ++i) po[i] = (f32x4){0.f, 0.f, 0.f, 0.f};
#pragma unroll
            for (int r = 0; r < 16; ++r) { const int d = wave + 8 * r; const f32x4 sx = sv[r];
                f32x4 a = sx * g4 + (gk0 * qk[512 + d]) * vv[0] + (gk1 * qk[512 + 128 + d]) * vv[1] + (gk2 * qk[512 + 256 + d]) * vv[2] + qk[512 + 384 + d] * vv[3];
                __builtin_nontemporal_store(a, (f32x4*)(so + (size_t)d * RDV + 4 * lane));
#pragma unroll
                for (int i = 0; i < 4; ++i) po[i] += qk[i * 128 + d] * sx; }
#pragma unroll
            for (int i = 0; i < 4; ++i) *(LAS f32x4*)(red + (wave * 4 + i) * 256 + 4 * lane) = po[i];
            __syncthreads();
            {
                const int i = tid >> 7, e2 = (tid & 127) * 2;
                float o0 = 0.f, o1 = 0.f;
#pragma unroll
                for (int w_ = 0; w_ < NWAVES; ++w_) { o0 += red[(w_ * 4 + i) * 256 + e2]; o1 += red[(w_ * 4 + i) * 256 + e2 + 1]; }
                const float gi = __expf((float)(i + 1) * lg); o0 *= gi; o1 *= gi;
#pragma unroll
                for (int j = 0; j < DS; ++j) { const float w_ = inner[i * 4 + j]; o0 += w_ * vls[j * 256 + e2]; o1 += w_ * vls[j * 256 + e2 + 1]; }
                *(unsigned*)(ORETb + ((size_t)NP + b * DS + i) * 1024 + h * RDV + e2) = cvtpk(o0, o1);
            }
        }
        if (args.sub & 32) for (int it = bid; it < DB * 2; it += G) {
            const int hp = it & 1, b = it >> 1, kh = lane >> 5, hl = (lane >> 4) & 1;
            LAS float* sc = lds;
            LAS float* red = lds + 2048;
            const float* kb_ = cache_mem_k + (size_t)b * NMEM * 256 + hp * 128 + 4 * (lane & 31); const float* vb_ = cache_mem_v + (size_t)b * NMEM * 256 + hp * 128 + 4 * (lane & 31);
            f32x4 qr[4];
#pragma unroll
            for (int q = 0; q < DS; ++q) { const u32x2_t t_ = *(const u32x2_t*)(Zb + ((size_t)NP + b * DS + q) * ZLD + C_XQ + hp * 128 + 4 * (lane & 31)); qr[q] = (f32x4){BLO(t_.x), BHI(t_.x), BLO(t_.y), BHI(t_.y)}; }
            __syncthreads();
            f32x4 kv[16];
#pragma unroll
            for (int kk = 0; kk < 16; ++kk) kv[kk] = __builtin_nontemporal_load((const f32x4*)(kb_ + (size_t)(32 * wave + 2 * kk + kh) * 256));
#pragma unroll
            for (int kk = 0; kk < 16; ++kk) { const int key = 32 * wave + 2 * kk + kh;
                float pq[4];
#pragma unroll
                for (int q = 0; q < 4; ++q) { float a = kv[kk][0] * qr[q][0] + kv[kk][1] * qr[q][1] + kv[kk][2] * qr[q][2] + kv[kk][3] * qr[q][3];
                    a += __shfl_xor(a, 1); a += __shfl_xor(a, 2); a += __shfl_xor(a, 4); a += __shfl_xor(a, 8); pq[q] = a; }
                if ((lane & 15) == 0) {
#pragma unroll
                    for (int q = 0; q < 4; ++q) sc[(q * 2 + hl) * 256 + key] = pq[q] * (0.125f * 1.4426950408889634f); } }
#pragma unroll
            for (int kk = 0; kk < 16; ++kk) kv[kk] = __builtin_nontemporal_load((const f32x4*)(vb_ + (size_t)(32 * wave + 2 * kk + kh) * 256));
            __syncthreads();
            {
                f32x4 v = *(LAS f32x4*)(sc + wave * 256 + 4 * lane);
                const float mx = wave_max(fmaxf(fmaxf(v[0], v[1]), fmaxf(v[2], v[3])));
#pragma unroll
                for (int e = 0; e < 4; ++e) v[e] = __builtin_amdgcn_exp2f(v[e] - mx);
                const float inv = 1.f / wave_sum(v[0] + v[1] + v[2] + v[3]);
                *(LAS f32x4*)(sc + wave * 256 + 4 * lane) = v * inv; }
            __syncthreads();
            f32x4 acc[4];
#pragma unroll
            for (int q = 0; q < 4; ++q) acc[q] = (f32x4){0.f, 0.f, 0.f, 0.f};
#pragma unroll
            for (int kk = 0; kk < 16; ++kk) { const int key = 32 * wave + 2 * kk + kh;
#pragma unroll
                for (int q = 0; q < 4; ++q) acc[q] += sc[(q * 2 + hl) * 256 + key] * kv[kk]; }
#pragma unroll
            for (int q = 0; q < 4; ++q) *(LAS f32x4*)(red + ((wave * 2 + kh) * 4 + q) * 128 + 4 * (lane & 31)) = acc[q];
            __syncthreads();
            { const int q = tid >> 7, e = tid & 127; float o0 = 0.f;
#pragma unroll
              for (int w_ = 0; w_ < 2 * NWAVES; ++w_) o0 += red[(w_ * 4 + q) * 128 + e];
              const float o1 = __shfl_xor(o0, 1);
              if ((tid & 1) == 0) *(unsigned*)(CATb + ((size_t)NP + b * DS + q) * CATLD + 2048 + hp * 128 + e) = cvtpk(o0, o1); }
        }
        if (!compute_first) compute_units();
    }
    SEAM(5);
    if (IN(6)) { PHASE_IDS
        for (int task = bid; task < (NS / 32) * MH; task += G) {
            const int head = task & 7, rb = task >> 3, b = 8 * rb + wave; const float c2 = 0.07216878364870322f * 1.4426950408889634f;
            constexpr int OLP = 264;
            LAS bf16_t* ol = (LAS bf16_t*)ldsb;
            __syncthreads();
            float kn[DS][5];
#pragma unroll
            for (int j = 0; j < DS; ++j) { const size_t krow = (size_t)NP + b * DS + j;
#pragma unroll
                for (int c = 0; c < 5; ++c) { const int d = lane + 64 * c; kn[j][c] = d < KVL ? CKVN[krow * KVL + d] : KPER[krow * DROPE + (d - KVL)]; } }
#pragma unroll
            for (int t = 0; t < DS; ++t) {
                const int qi = t * 8 + head; const size_t qrow = (size_t)b * DS + t;
                float qv[5];
#pragma unroll
                for (int c = 0; c < 5; ++c) { const int d = lane + 64 * c; const bf16_t raw = d < KVL ? QLATb[qrow * 2048 + head * KVL + d] : QPEb[(NP + qrow) * 512 + head * DROPE + (d - KVL)];
                    qv[c] = __builtin_bit_cast(float, (unsigned)raw << 16); }
                float sc[DS]; float M = -INFINITY;
#pragma unroll
                for (int j = 0; j < DS; ++j) { float a_ = 0.f;
#pragma unroll
                    for (int c = 0; c < 5; ++c) a_ += qv[c] * kn[j][c];
                    a_ = wave_sum(a_) * c2; sc[j] = (j <= t) ? a_ : -INFINITY; M = fmaxf(M, sc[j]); }
                float ms[MS_NSPLIT], ls[MS_NSPLIT];
#pragma unroll
                for (int sp = 0; sp < MS_NSPLIT; ++sp) { const int item = b * MS_NSPLIT + sp; ms[sp] = PML[(item * 32 + qi) * 2]; ls[sp] = PML[(item * 32 + qi) * 2 + 1]; M = fmaxf(M, ms[sp]); }
                float L = 0.f; float acc[4] = {0.f, 0.f, 0.f, 0.f};
#pragma unroll
                for (int sp = 0; sp < MS_NSPLIT; ++sp) { const int item = b * MS_NSPLIT + sp; const float wgt = __builtin_amdgcn_exp2f(ms[sp] - M); L += ls[sp] * wgt;
#pragma unroll
                    for (int c = 0; c < 4; ++c) acc[c] += wgt * PO[((size_t)item * 32 + qi) * KVL + lane + 64 * c]; }
#pragma unroll
                for (int j = 0; j < DS; ++j) { const float wgt = __builtin_amdgcn_exp2f(sc[j] - M); L += wgt;
#pragma unroll
                    for (int c = 0; c < 4; ++c) acc[c] += wgt * kn[j][c]; }
                const float inv = 1.f / L;
#pragma unroll
                for (int c = 0; c < 4; ++c) ol[(4 * wave + t) * OLP + lane + 64 * c] = f2bf(acc[c] * inv);
            }
            __syncthreads();
            if (wave < 4) {
                const int l31 = lane & 31, h8 = lane >> 5;
                f32x16 acc;
#pragma unroll
                for (int i = 0; i < 16; ++i) acc[i] = 0.f;
                const bf16_t* bp = WuvT + (size_t)(head * DVH + 32 * wave + l31) * KVL + 8 * h8;
#pragma unroll
                for (int s_ = 0; s_ < 16; ++s_) { const bf16x8 a_ = *(const LAS bf16x8*)(ol + l31 * OLP + 16 * s_ + 8 * h8); const bf16x8 b_ = *(const bf16x8*)(bp + 16 * s_); acc = MFMA32(a_, b_, acc); }
#pragma unroll
                for (int i = 0; i < 16; ++i) CATb[((size_t)NP + 32 * rb + crow(i, h8)) * CATLD + 1024 + head * DVH + 32 * wave + l31] = f2bf(acc[i]);
            }
        }
        {
#pragma unroll 1
            for (int row0 = gw; row0 < NT; row0 += 4 * NGW) {
                u32x2_t oa[4][4], gz[4][4];
#pragma unroll
                for (int k = 0; k < 4; ++k) { const int r = row0 + k * NGW;
                    if (r < NT) {
#pragma unroll
                        for (int j = 0; j < 4; ++j) { oa[k][j] = *(const u32x2_t*)(ORETb + (size_t)r * 1024 + 4 * lane + 256 * j); gz[k][j] = *(const u32x2_t*)(SRGb + (size_t)r * 1024 + 4 * lane + 256 * j); } } }
#pragma unroll
                for (int k = 0; k < 4; ++k) { const int r = row0 + k * NGW;
                    if (r < NT) {
#pragma unroll
                        for (int j = 0; j < 4; ++j) { const f32x4 a = bf4_to_f32(oa[k][j].x, oa[k][j].y), g_ = bf4_to_f32(gz[k][j].x, gz[k][j].y);
                            const float ss = wave_sum(a[0] * a[0] + a[1] * a[1] + a[2] * a[2] + a[3] * a[3]);
                            const float rr = rsqrtf(ss * (1.f / RDV) + EPS);
                            *(u32x2_t*)(CATb + (size_t)r * CATLD + 4 * lane + 256 * j) = (u32x2_t){cvtpk(g_[0] * a[0] * rr, g_[1] * a[1] * rr), cvtpk(g_[2] * a[2] * rr, g_[3] * a[3] * rr)}; } } }
            }
        }
    }
    SEAM(6);
    if (IN(7)) {
        { pg8::StaticOrder S; S.init(NP, 1024, G, bid); pg8::Gemm g{CATb, WcatT, NP, 1024, CATLD, CATLD, CATLD}; pg8::EpiGate3 E{SGb, MIXb, 1024, 16, 32};
          pg8::gemm_phase<pg8::EpiGate3, pg8::StaticOrder, true, true>(ldsb, g, S, E); }
        __syncthreads();
        { pg8::Gemm g{CATb, WcatT, NT, 1024, 256, CATLD, CATLD, 256}; pg8::SplitOrder SS{9, bid}; pg8::EpiPart E{PART}; GEMM_SPLIT(ldsb, g, SS, E); }
    }
    SEAM(7);
    if (IN(8)) { PHASE_IDS
        for (int i = bid * NTHREADS + tid; i < NS * 256; i += G * NTHREADS) { const int r = i >> 8, c4 = (i & 255) * 4; const size_t o_ = (size_t)r * 1024 + c4;
            f32x4 mix = {0.f, 0.f, 0.f, 0.f};
#pragma unroll
            for (int br = 0; br < 3; ++br) { f32x4 a = *(const f32x4*)(PART + (size_t)(br == 2 ? 8 : 4 * br) * (512 * 1024) + o_);
                if (br < 2) {
#pragma unroll
                    for (int k_ = 1; k_ < 4; ++k_) a += *(const f32x4*)(PART + (size_t)(4 * br + k_) * (512 * 1024) + o_); }
                const u32x2_t gq = *(const u32x2_t*)(SGb + (size_t)(NP + r) * 3072 + br * 1024 + c4);
                mix[0] += a[0] * __builtin_bit_cast(float, gq.x << 16); mix[1] += a[1] * __builtin_bit_cast(float, gq.x & 0xffff0000u);
                mix[2] += a[2] * __builtin_bit_cast(float, gq.y << 16); mix[3] += a[3] * __builtin_bit_cast(float, gq.y & 0xffff0000u); }
            *(u32x2_t*)(MIXb + (size_t)(NP + r) * 1024 + c4) = (u32x2_t){cvtpk(mix[0], mix[1]), cvtpk(mix[2], mix[3])}; }
    }
    SEAM(8);
    if (IN(9)) { pg8::Gemm g{MIXb, WoT, NP, 1024, 1024, 1024, 1024}; pg8::StaticOrder S; S.init(NP, 1024, G, bid); pg8::EpiBf16S E{HPb, 1024};
        GEMM_PHASE(pg8::EpiBf16S, ldsb, g, S, E);
        __syncthreads();
        { pg8::Gemm g2{MIXb, WoT, NT, 1024, 256, 1024, 1024, 256}; pg8::SplitOrder SS{4, bid}; pg8::EpiPart E2{PART}; GEMM_SPLIT(ldsb, g2, SS, E2); } }
    SEAM(9);
    if (IN(10)) { PHASE_IDS
        f32x4 gp[4], gf[4];
#pragma unroll
        for (int j = 0; j < 4; ++j) { gp[j] = *(const f32x4*)(g_mix_post + 4 * lane + 256 * j); gf[j] = *(const f32x4*)(g_ffn_pre + 4 * lane + 256 * j); }
        auto finish_row = [&](const int row, f32x4 (&a)[4], const f32x4 (&b)[4]) __attribute__((always_inline)) {
            float ss = 0.f;
#pragma unroll
            for (int j = 0; j < 4; ++j) ss += a[j][0] * a[j][0] + a[j][1] * a[j][1] + a[j][2] * a[j][2] + a[j][3] * a[j][3];
            float r = rsqrtf(wave_sum(ss) * (1.f / DM) + EPS); ss = 0.f;
#pragma unroll
            for (int j = 0; j < 4; ++j) { a[j] = b[j] + a[j] * r * gp[j]; *(u32x2_t*)(Hb + (size_t)row * DM + 4 * lane + 256 * j) = (u32x2_t){cvtpk(a[j][0], a[j][1]), cvtpk(a[j][2], a[j][3])};
                ss += a[j][0] * a[j][0] + a[j][1] * a[j][1] + a[j][2] * a[j][2] + a[j][3] * a[j][3]; }
            r = rsqrtf(wave_sum(ss) * (1.f / DM) + EPS);
#pragma unroll
            for (int j = 0; j < 4; ++j) { const f32x4 f_ = a[j] * r * gf[j]; *(u32x2_t*)(Fb + (size_t)row * DM + 4 * lane + 256 * j) = (u32x2_t){cvtpk(f_[0], f_[1]), cvtpk(f_[2], f_[3])}; }
        };
#pragma unroll 1
        for (int row0 = gw; row0 < NP; row0 += 4 * NGW) {
            u32x2_t hp[4][4]; f32x4 xb[4][4];
#pragma unroll
            for (int k = 0; k < 4; ++k) { const int r = row0 + k * NGW;
                if (r < NP) {
#pragma unroll
                    for (int j = 0; j < 4; ++j) { hp[k][j] = *(const u32x2_t*)(HPb + (size_t)r * DM + 4 * lane + 256 * j); xb[k][j] = *(const f32x4*)(x_prompt + (size_t)r * DM + 4 * lane + 256 * j); } } }
#pragma unroll
            for (int k = 0; k < 4; ++k) { const int r = row0 + k * NGW;
                if (r < NP) { f32x4 a[4];
#pragma unroll
                    for (int j = 0; j < 4; ++j) a[j] = bf4_to_f32(hp[k][j].x, hp[k][j].y);
                    finish_row(r, a, xb[k]); } }
        }
        for (int r = NP + gw; r < NT; r += NGW) { f32x4 a[4], b[4];
#pragma unroll
            for (int j = 0; j < 4; ++j) { const float* p_ = PART + (size_t)(r - NP) * DM + 4 * lane + 256 * j;
                a[j] = (*(const f32x4*)p_ + *(const f32x4*)(p_ + 512 * 1024)) + (*(const f32x4*)(p_ + 2 * 512 * 1024) + *(const f32x4*)(p_ + 3 * 512 * 1024));
                b[j] = *(const f32x4*)(x_sample + (size_t)(r - NP) * DM + 4 * lane + 256 * j); }
            finish_row(r, a, b); }
    }
    SEAM(10);
    if (IN(11)) {
        pg8::Gemm g{Fb, WguT, NT, 2 * DFF, 1024, 1024, 1024}; pg8::StaticOrder S; S.init(NT, 2 * DFF, G, bid); pg8::EpiSwiGLU E{ACTb, DFF};
        GEMM_PHASE(pg8::EpiSwiGLU, ldsb, g, S, E);
    }
    SEAM(11);
    if (IN(13)) { pg8::Gemm g{ACTb, WdT, NP, 1024, DFF, DFF, DFF}; pg8::StaticOrder S; S.init(NP, 1024, G, bid); pg8::EpiBf16S E{FOb, 1024};
        GEMM_PHASE(pg8::EpiBf16S, ldsb, g, S, E);
        __syncthreads();
        { pg8::Gemm g2{ACTb, WdT, NT, 1024, 256, DFF, DFF, 256}; pg8::SplitOrder SS{11, bid}; pg8::EpiPart E2{PART}; GEMM_SPLIT(ldsb, g2, SS, E2); } }
    SEAM(13);
    if (IN(14)) { PHASE_IDS
        f32x4 gp[4];
#pragma unroll
        for (int j = 0; j < 4; ++j) gp[j] = *(const f32x4*)(g_ffn_post + 4 * lane + 256 * j);
#pragma unroll 1
        for (int row0 = gw; row0 < NP; row0 += 4 * NGW) {
            u32x2_t fa[4][4], hb[4][4];
#pragma unroll
            for (int k = 0; k < 4; ++k) { const int r = row0 + k * NGW;
                if (r < NP) {
#pragma unroll
                    for (int j = 0; j < 4; ++j) { fa[k][j] = *(const u32x2_t*)(FOb + (size_t)r * DM + 4 * lane + 256 * j); hb[k][j] = *(const u32x2_t*)(Hb + (size_t)r * DM + 4 * lane + 256 * j); } } }
#pragma unroll
            for (int k = 0; k < 4; ++k) { const int r = row0 + k * NGW;
                if (r < NP) { f32x4 a[4]; float ss = 0.f;
#pragma unroll
                    for (int j = 0; j < 4; ++j) { a[j] = bf4_to_f32(fa[k][j].x, fa[k][j].y); ss += a[j][0] * a[j][0] + a[j][1] * a[j][1] + a[j][2] * a[j][2] + a[j][3] * a[j][3]; }
                    const float rs = rsqrtf(wave_sum(ss) * (1.f / DM) + EPS);
                    float* y = out + O_YP + (size_t)r * DM;
#pragma unroll
                    for (int j = 0; j < 4; ++j) *(f32x4*)(y + 4 * lane + 256 * j) = bf4_to_f32(hb[k][j].x, hb[k][j].y) + a[j] * rs * gp[j]; } }
        }
        for (int r = NP + gw; r < NT; r += NGW) { f32x4 a[4]; float ss = 0.f;
#pragma unroll
            for (int j = 0; j < 4; ++j) { const float* p_ = PART + (size_t)(r - NP) * DM + 4 * lane + 256 * j; f32x4 a_ = *(const f32x4*)p_;
#pragma unroll
                for (int k_ = 1; k_ < 11; ++k_) a_ += *(const f32x4*)(p_ + (size_t)k_ * 512 * 1024);
                a[j] = a_; ss += a_[0] * a_[0] + a_[1] * a_[1] + a_[2] * a_[2] + a_[3] * a_[3]; }
            const float rs = rsqrtf(wave_sum(ss) * (1.f / DM) + EPS);
            float* y = out + O_YS + (size_t)(r - NP) * DM;
#pragma unroll
            for (int j = 0; j < 4; ++j) { const u32x2_t h_ = *(const u32x2_t*)(Hb + (size_t)r * DM + 4 * lane + 256 * j); *(f32x4*)(y + 4 * lane + 256 * j) = bf4_to_f32(h_.x, h_.y) + a[j] * rs * gp[j]; } }
    }
#undef IN
#undef SEAM
#undef PHASE_IDS
}
#undef x_prompt
#undef x_sample
#undef mem_prompt
#undef cache_ckv
#undef cache_kpe
#undef page_table
#undef state_ret
#undef cache_mem_k
#undef cache_mem_v
#undef g_mix_pre
#undef g_mix_post
#undef g_ffn_pre
#undef g_ffn_post
#undef g_mem
#undef g_qlat
#undef g_kvlat
#undef w_in
#undef w_uq
#undef w_uk
#undef w_uv
#undef w_mem_k
#undef w_mem_v
#undef w_ret_o
#undef w_mla_o
#undef w_x_o
#undef w_out
#undef w_gate
#undef w_up
#undef w_down
#undef COSA
#undef SINA
#undef COSB
#undef SINB
#undef U
#undef MN
#undef Zb
#undef RQ
#undef RK
#undef CQN
#undef CKVN
#undef KPER
#undef Q
#undef QLAT
#undef QPE
#undef ORETb
#undef OLAT
#undef OX
#undef OMLA
#undef ORETN
#undef ARET
#undef AMLA
#undef AX
#undef MIX
#undef HPb
#undef Hb
#undef F
#undef GU
#undef FOb
#undef WinT
#undef WmkvT
#undef WuqT
#undef WcatT
#undef CATb
#undef WroT
#undef WmoT
#undef WxoT
#undef WoT
#undef WguT
#undef WdT
#undef Ub
#undef MNb
#undef CQNb
#undef ORETNb
#undef OMLAb
#undef OXb
#undef MIXb
#undef Fb
#undef ACTb
#undef WukT
#undef WuvT
#undef CKVNb
#undef KPERb
#undef XQb
#undef MKb
#undef MVT
#undef KN
#undef VT
#undef Qb
#undef RQt
#undef RKt
#undef RKtT
#undef RVT
#undef UT
#undef SPT
#undef QPEb
#undef WukB
#undef PART
#undef SGb
#undef SRGb
#undef T0b
#undef T1b
#undef QLATb
#undef PO
#undef PML
constexpr int N_PHASES = 15;
}

extern "C" void kernel_launch(void* const* d_in, const int* in_sizes, int n_in, void* d_out, int out_size, void* d_ws, size_t ws_size, hipStream_t stream) {
    static int grid = 0;
    if (grid == 0) {
        if (n_in != 29 || (size_t)out_size != O_END || ws_size < WS_END) { fprintf(stderr, "kernel_launch: unexpected shapes: n_in %d out %d ws %zu (need %zu)\n", n_in, out_size, ws_size, (size_t)WS_END); grid = -1; return; }
        int dev = 0, cus = 0, per_cu = 0;
        if (hipGetDevice(&dev) != hipSuccess || hipDeviceGetAttribute(&cus, hipDeviceAttributeMultiprocessorCount, dev) != hipSuccess) { grid = -1; return; }
        if (hipFuncSetAttribute((const void*)fwd_kernel, hipFuncAttributeMaxDynamicSharedMemorySize, LDS_BYTES) != hipSuccess) { fprintf(stderr, "kernel_launch: hipFuncSetAttribute failed\n"); grid = -1; return; }
        if (hipOccupancyMaxActiveBlocksPerMultiprocessor(&per_cu, (const void*)fwd_kernel, NTHREADS, LDS_BYTES) != hipSuccess || per_cu < 1) { fprintf(stderr, "kernel_launch: occupancy query says %d\n", per_cu); per_cu = 1; }
        (void)hipGetLastError();
        grid = cus;
    }
    if (grid < 0) return;
    (void)hipMemsetAsync((char*)d_ws + WS_CTL, 0, CTL_BYTES, stream);
    Args a{};
    for (int i = 0; i < 29; ++i) a.in[i] = (const float*)d_in[i];
    a.out = (float*)d_out; a.ws = (unsigned char*)d_ws;
#if MK_ONE_LAUNCH
    a.ph_lo = 0; a.ph_hi = N_PHASES; a.sub = 0xff;
    hipLaunchKernelGGL(fwd_kernel, dim3(grid), dim3(NTHREADS), LDS_BYTES, stream, a);
#if PROBE_DUP >= 0
    a.ph_lo = PROBE_DUP; a.ph_hi = PROBE_DUP + 1; a.sub = PROBE_SUB;
    for (int r = 0; r < PROBE_REP; ++r) hipLaunchKernelGGL(fwd_kernel, dim3(grid), dim3(NTHREADS), LDS_BYTES, stream, a);
#endif
#else
    a.sub = 0xff; for (int p = 0; p < N_PHASES; ++p) { a.ph_lo = p; a.ph_hi = p + 1; hipLaunchKernelGGL(fwd_kernel, dim3(grid), dim3(NTHREADS), LDS_BYTES, stream, a); }
#endif
}
```

```cpp
#include <hip/hip_runtime.h>
#include <cstdio>
#include <cstdint>

#ifndef PROBE_DUP
#define PROBE_DUP -1
#endif
#ifndef PROBE_REP
#define PROBE_REP 4
#endif
#ifndef PROBE_SUB
#define PROBE_SUB 0xff
#endif
#ifndef MK_ONE_LAUNCH
#define MK_ONE_LAUNCH 1
#endif

#define LAS __attribute__((address_space(3)))
#define GAS __attribute__((address_space(1)))
#define DI __device__ __forceinline__
typedef float f32x4 __attribute__((ext_vector_type(4)));
typedef __bf16 bf16x2_t __attribute__((ext_vector_type(2)));
typedef float f32x2_t __attribute__((ext_vector_type(2)));
DI unsigned cvtpk(float lo, float hi) { f32x2_t v = {lo, hi}; bf16x2_t b = __builtin_convertvector(v, bf16x2_t); return __builtin_bit_cast(unsigned, b); }

namespace {
constexpr int DM = 1024, NB = 8, SEQ = 2048, NP = NB * SEQ, DB = 128, DS = 4, NS = DB * DS, NT = NP + NS;
constexpr int PAST = 8192, PAGE = 128, NPAGES = PAST / PAGE;
constexpr int RH = 4, RDK = 128, RDV = 256;
constexpr int MH = 8, QL = 384, KVL = 256, DNOPE = 128, DROPE = 64, DVH = 128, DQH = DNOPE + DROPE;
constexpr int NMEM = 256, XH = 4, XHD = 64;
constexpr int DFF = 2816, DIN = 7104, ZLD = 7168;
constexpr int C_RQ = 0, C_RK = 512, C_RV = 1024, C_RG = 2048, C_CQ = 3072, C_CKV = 3456, C_KPE = 3712, C_XQ = 3776, C_G = 4032;
constexpr float EPS = 1e-6f;
constexpr int NPOS = SEQ + DS;
constexpr int NTHREADS = 512, NWAVES = 8;
constexpr int LDS_BYTES = 147456;
constexpr int MISC_OFF = 147456 - 256;

constexpr size_t O_YP = 0, O_YS = O_YP + (size_t)NP * DM, O_CKVP = O_YS + (size_t)NS * DM, O_KPEP = O_CKVP + (size_t)NP * KVL,
                 O_CKVS = O_KPEP + (size_t)NP * DROPE, O_KPES = O_CKVS + (size_t)NS * KVL, O_RETP = O_KPES + (size_t)NS * DROPE,
                 O_RETS = O_RETP + (size_t)NB * RH * RDK * RDV, O_MKP = O_RETS + (size_t)DB * RH * RDK * RDV, O_MVP = O_MKP + (size_t)NB * NMEM * 256,
                 O_END = O_MVP + (size_t)NB * NMEM * 256;

constexpr size_t al256(size_t x) { return (x + 255) & ~(size_t)255; }
constexpr size_t WS_CTL = 0, CTL_BYTES = 1u << 20;
constexpr size_t WS_COSA = WS_CTL + CTL_BYTES;
constexpr size_t WS_SINA = WS_COSA + al256((size_t)NPOS * 64 * 4);
constexpr size_t WS_COSB = WS_SINA + al256((size_t)NPOS * 64 * 4);
constexpr size_t WS_SINB = WS_COSB + al256((size_t)NPOS * 32 * 4);
constexpr size_t WS_U = WS_SINB + al256((size_t)NPOS * 32 * 4);
constexpr size_t WS_MN = WS_U + (size_t)NT * DM * 4;
constexpr size_t WS_Z = WS_MN + (size_t)NB * NMEM * DM * 4;
constexpr size_t WS_RQ = WS_Z + (size_t)NT * ZLD * 4;
constexpr size_t WS_RK = WS_RQ + (size_t)NT * 512 * 4;
constexpr size_t WS_CQN = WS_RK + (size_t)NT * 512 * 4;
constexpr size_t WS_CKVN = WS_CQN + (size_t)NT * QL * 4;
constexpr size_t WS_KPER = WS_CKVN + (size_t)NT * KVL * 4;
constexpr size_t WS_Q = WS_KPER + (size_t)NT * DROPE * 4;
constexpr size_t WS_QLAT = WS_Q + (size_t)NT * 1536 * 4;
constexpr size_t WS_QPE = WS_QLAT + (size_t)NT * 2048 * 4;
constexpr size_t WS_ORET = WS_QPE + (size_t)NT * 512 * 4;
constexpr size_t WS_OLAT = WS_ORET + (size_t)NT * 1024 * 4;
constexpr size_t WS_OX = WS_OLAT + (size_t)NT * 2048 * 4;
constexpr size_t WS_OMLA = WS_OX + (size_t)NT * 256 * 4;
constexpr size_t WS_ORETN = WS_OMLA + (size_t)NT * 1024 * 4;
constexpr size_t WS_ARET = WS_ORETN + (size_t)NT * 1024 * 4;
constexpr size_t WS_AMLA = WS_ARET + (size_t)NT * 1024 * 4;
constexpr size_t WS_AX = WS_AMLA + (size_t)NT * 1024 * 4;
constexpr size_t WS_MIX = WS_AX + (size_t)NT * 1024 * 4;
constexpr size_t WS_HP = WS_MIX + (size_t)NT * 1024 * 4;
constexpr size_t WS_H = WS_HP + (size_t)NT * 1024 * 4;
constexpr size_t WS_F = WS_H + (size_t)NT * 1024 * 4;
constexpr size_t WS_GG = WS_F + (size_t)NT * 1024 * 4;
constexpr size_t WS_UP = WS_GG + (size_t)NT * DFF * 4;
constexpr size_t WS_ACT = WS_UP + (size_t)NT * DFF * 4;
constexpr size_t WS_FO = WS_ACT + (size_t)NT * DFF * 4;
constexpr size_t WS_F32_END = WS_FO + (size_t)NT * 1024 * 4;
constexpr size_t WS_WIN_T = al256(WS_F32_END);
constexpr size_t WS_WMKV_T = WS_WIN_T + (size_t)ZLD * 1024 * 2;
constexpr size_t WS_WUQ_T = WS_WMKV_T + (size_t)512 * 1024 * 2;
constexpr size_t WS_WRO_T = WS_WUQ_T + (size_t)1536 * 384 * 2;
constexpr size_t WS_WMO_T = WS_WRO_T + (size_t)1024 * 1024 * 2;
constexpr size_t WS_WXO_T = WS_WMO_T + (size_t)1024 * 1024 * 2;
constexpr size_t WS_WO_T = WS_WXO_T + (size_t)1024 * 256 * 2;
constexpr size_t WS_WGU_T = WS_WO_T + (size_t)1024 * 1024 * 2;
constexpr size_t WS_WD_T = WS_WGU_T + (size_t)5632 * 1024 * 2;
constexpr size_t WS_UB = WS_WD_T + (size_t)1024 * 2816 * 2;
constexpr size_t WS_MNB = WS_UB + (size_t)NT * 1024 * 2;
constexpr size_t WS_CQNB = WS_MNB + (size_t)2048 * 1024 * 2;
constexpr size_t WS_ORETNB = WS_CQNB + (size_t)NT * 384 * 2;
constexpr size_t WS_OMLAB = WS_ORETNB + (size_t)NT * 1024 * 2;
constexpr size_t WS_OXB = WS_OMLAB + (size_t)NT * 1024 * 2;
constexpr size_t WS_MIXB = WS_OXB + (size_t)NT * 256 * 2;
constexpr size_t WS_FB = WS_MIXB + (size_t)NT * 1024 * 2;
constexpr size_t WS_ACTB = WS_FB + (size_t)NT * 1024 * 2;
constexpr size_t WS_WUK_T = WS_ACTB + (size_t)NT * 2816 * 2;
constexpr size_t WS_WUV_T = WS_WUK_T + (size_t)1024 * 256 * 2;
constexpr size_t WS_CKVNB = WS_WUV_T + (size_t)1024 * 256 * 2;
constexpr size_t WS_KPERB = WS_CKVNB + (size_t)NT * 256 * 2;
constexpr size_t WS_XQB = WS_KPERB + (size_t)NT * 64 * 2;
constexpr size_t WS_MKB = WS_XQB + (size_t)NT * 256 * 2;
constexpr size_t WS_MVT = WS_MKB + (size_t)2048 * 256 * 2;
constexpr size_t WS_KN = WS_MVT + (size_t)2048 * 256 * 2;
constexpr size_t WS_VT = WS_KN + (size_t)NP * 1024 * 2;
constexpr size_t WS_QB = WS_VT + (size_t)NP * 1024 * 2;
constexpr size_t WS_RQT = WS_QB + (size_t)NT * 1536 * 2;
constexpr size_t WS_RKT = WS_RQT + (size_t)NP * 512 * 2;
constexpr size_t WS_RKTT = WS_RKT + (size_t)NP * 512 * 2;
constexpr size_t WS_RVT = WS_RKTT + (size_t)NP * 512 * 2;
constexpr size_t WS_UT = WS_RVT + (size_t)NT * 1024 * 2;
constexpr size_t WS_SPT = WS_UT + (size_t)512 * 32768 * 4;
constexpr size_t WS_QLATB = WS_SPT + (size_t)512 * 32768 * 2;
constexpr size_t WS_PO = WS_QLATB + (size_t)NS * 2048 * 2;
constexpr size_t WS_PML = WS_PO + (size_t)DB * 2 * 32 * 256 * 4;
constexpr size_t WS_PART = al256(WS_PML + (size_t)DB * 2 * 32 * 2 * 4);
constexpr size_t WS_QPEB_ = WS_PART + (size_t)11 * 512 * 1024 * 4;
constexpr size_t WS_QPEB = al256(WS_QPEB_ + 0 * WS_PML + (size_t)DB * 2 * 32 * 2 * 4);
constexpr size_t WS_SGB = WS_QPEB + (size_t)NT * 512 * 2;
constexpr size_t WS_SRGB = WS_SGB + (size_t)NT * 3072 * 2;
constexpr size_t WS_T0B = WS_SRGB + (size_t)NT * 1024 * 2;
constexpr size_t WS_T1B = WS_T0B + (size_t)NT * 1024 * 2;
constexpr size_t WS_WUKB = WS_T1B + (size_t)NT * 1024 * 2;
constexpr size_t WS_WUQABS = al256(WS_WUKB + (size_t)8 * 256 * 128 * 2);
constexpr size_t WS_END = WS_WUQABS + (size_t)(1536 + 2048) * 384 * 2;

static_assert(WS_OMLAB == WS_ORETNB + (size_t)NT * 1024 * 2 && WS_OXB == WS_OMLAB + (size_t)NT * 1024 * 2 && WS_MIXB == WS_OXB + (size_t)NT * 256 * 2, "CATb = [o_ret_n | o_mla | o_x] rows of 2304");
static_assert(WS_WMO_T == WS_WRO_T + (size_t)1024 * 1024 * 2 && WS_WXO_T == WS_WMO_T + (size_t)1024 * 1024 * 2 && WS_WO_T == WS_WXO_T + (size_t)1024 * 256 * 2, "WcatT = [w_ret_o | w_mla_o | w_x_o]^T rows of 2304");
constexpr int CATLD = 2304;
constexpr int CW_BAR = 4096;

#define XB_TMO      128
#define XB_XCNT(j)  (256  + 64 * (j))
#define XB_XSUB(j)  (1280 + 64 * (j))
#define XB_XGEN(j)  (2304 + 64 * (j))
#define XB_TOP      3328
#define XB_TOPGEN   3392
#define XCD_BAR_WORDS 3456
#define XB_SPIN_CAP (1u << 25)

DI unsigned xb_ld(unsigned* p)              { return __hip_atomic_load(p, __ATOMIC_RELAXED, __HIP_MEMORY_SCOPE_AGENT); }
DI unsigned xb_add(unsigned* p, unsigned v) { return __hip_atomic_fetch_add(p, v, __ATOMIC_RELAXED, __HIP_MEMORY_SCOPE_AGENT); }
DI unsigned xb_xcc_id() { return (unsigned)__builtin_amdgcn_s_getreg((3 << 11) | 20) & 0xFu; }
#define XB_SPIN(cond, bar) do { unsigned _sp = 0; while (cond) { __builtin_amdgcn_s_sleep(1); \
    if ((++_sp & 255u) == 0u) { if (xb_ld(&(bar)[XB_TMO])) break; if (_sp > XB_SPIN_CAP) { atomicAdd(&(bar)[XB_TMO], 1u); break; } } } } while (0)

struct XcdBarrier { unsigned* bar; unsigned x; volatile LAS unsigned* st; };

DI XcdBarrier xcd_barrier_post(unsigned* bar, volatile LAS unsigned* st) {
    XcdBarrier b; b.bar = bar; b.x = xb_xcc_id(); b.st = st;
    if (threadIdx.x == 0) (void)xb_add(&bar[XB_XCNT(b.x)], 1u);
    return b;
}
DI void xcd_barrier_complete(unsigned* bar, unsigned x, unsigned& nloc, unsigned& nx) {
    const unsigned G = gridDim.x * gridDim.y * gridDim.z;
    unsigned sum, cnt, mine, sp = 0u;
    for (;;) {
        sum = 0u; cnt = 0u; mine = 0u;
#pragma unroll
        for (unsigned j = 0; j < 16; ++j) { const unsigned c = xb_ld(&bar[XB_XCNT(j)]); sum += c; cnt += (c > 0u) ? 1u : 0u; mine = (j == x) ? c : mine; }
        if (sum == G) break;
        __builtin_amdgcn_s_sleep(1);
        if ((++sp & 255u) == 0u) { if (xb_ld(&bar[XB_TMO])) break; if (sp > XB_SPIN_CAP) { atomicAdd(&bar[XB_TMO], 1u); break; } }
    }
    nloc = mine > 0u ? mine : 1u; nx = cnt > 0u ? cnt : 1u;
}
DI void xcd_barrier(const XcdBarrier& b) {
    asm volatile("s_waitcnt vmcnt(0)" ::: "memory");
    __syncthreads();
    if (threadIdx.x == 0) {
        unsigned* bar = b.bar;
        __builtin_amdgcn_s_waitcnt(0);
        unsigned nloc = b.st[0], nx = b.st[1];
        if (nloc == 0u) { xcd_barrier_complete(bar, b.x, nloc, nx); b.st[0] = nloc; b.st[1] = nx; }
        const unsigned old = xb_add(&bar[XB_XSUB(b.x)], 1u);
        const unsigned gen = old / nloc;
        if (old + 1u == (gen + 1u) * nloc) {
            __builtin_amdgcn_fence(__ATOMIC_RELEASE, "agent");
            asm volatile("s_waitcnt vmcnt(0)" ::: "memory");
            const unsigned og = xb_add(&bar[XB_TOP], 1u);
            const unsigned tg = og / nx;
            if (og + 1u == (tg + 1u) * nx) xb_add(&bar[XB_TOPGEN], 1u);
            else XB_SPIN(xb_ld(&bar[XB_TOPGEN]) == tg, bar);
            __builtin_amdgcn_fence(__ATOMIC_ACQUIRE, "agent");
            xb_add(&bar[XB_XGEN(b.x)], 1u);
            asm volatile("s_waitcnt vmcnt(0)" ::: "memory");
        } else {
            XB_SPIN(xb_ld(&bar[XB_XGEN(b.x)]) == gen, bar);
            __builtin_amdgcn_fence(__ATOMIC_ACQUIRE, "agent");
            asm volatile("s_waitcnt vmcnt(0)" ::: "memory");
        }
    }
    __syncthreads();
}

DI float wave_sum(float v) {
#pragma unroll
    for (int o = 1; o < 64; o <<= 1) v += __shfl_xor(v, o);
    return v;
}
DI float wave_max(float v) {
#pragma unroll
    for (int o = 1; o < 64; o <<= 1) v = fmaxf(v, __shfl_xor(v, o));
    return v;
}
DI float sigmoidf_(float x) { return 1.f / (1.f + expf(-x)); }
DI float siluf_(float x) { return x / (1.f + expf(-x)); }
DI f32x4 bf4_to_f32(unsigned lo, unsigned hi) { return (f32x4){__builtin_bit_cast(float, lo << 16), __builtin_bit_cast(float, lo & 0xffff0000u), __builtin_bit_cast(float, hi << 16), __builtin_bit_cast(float, hi & 0xffff0000u)}; }
DI int pos_index(int row) { return row < NP ? (row & (SEQ - 1)) : SEQ + ((row - NP) & (DS - 1)); }
DI float lg_gamma(int h) { return h == 0 ? -0.03174869831458027f : h == 1 ? -0.015748356968139112f : h == 2 ? -0.007843177461025892f : -0.003913899321136329f; }


namespace pg8 {
typedef unsigned short bf16_t;
typedef short bf16x8 __attribute__((ext_vector_type(8)));
typedef unsigned u32x4 __attribute__((ext_vector_type(4)));
typedef unsigned u32x2 __attribute__((ext_vector_type(2)));
constexpr int BM = 256, BK = 64, HALF = 128, HTB = HALF * BK * 2, STAGE_BYTES = 8 * HTB, NXCD = 8, WGM = 8;
__host__ __device__ __forceinline__ int lds_byte(int r, int c) { const int st = (r >> 4) * 2 + (c >> 5), rr = r & 15, cc = c & 31, ob = rr * 64 + cc * 2; return st * 1024 + (ob ^ (((ob >> 9) & 1) << 5)); }
__host__ __device__ __forceinline__ void stage_rc(int b, int& R, int& C) { const int st = b / 1024, sb = b % 1024, swz = sb ^ (((sb >> 9) & 1) << 5); R = (st >> 1) * 16 + swz / 64; C = (st & 1) * 32 + (swz % 64) / 2; }
__host__ __device__ __forceinline__ int perm32(int rho) { const int n = rho >> 4, i = rho & 15; return 8 * (i >> 2) + 4 * n + (i & 3); }
struct Unit { int pm, pn, ks; };
struct Gemm { const bf16_t* A; const bf16_t* Bt; int M, N, K, lda, ldb, ksl; };
struct StaticOrder {
    int nM, nN, nwg, G, c;
    __host__ __device__ void init(int M, int N, int G_, int c_) { nM = M / BM; nN = N / BM; nwg = nM * nN; G = G_; c = c_; }
    __host__ __device__ bool next(int i, Unit& u) const {
        const long L = (long)i * G + c; if (L >= nwg) return false;
        int wgid = (int)L; { const int q = nwg / NXCD, r = nwg % NXCD, xcd = wgid % NXCD, off = wgid / NXCD; wgid = (xcd < r ? xcd * (q + 1) : r * (q + 1) + (xcd - r) * q) + off; }
        const int nig = WGM * nN, gid = wgid / nig, fm = gid * WGM, gsz = (nM - fm) < WGM ? (nM - fm) : WGM;
        u.pm = fm + ((wgid % nig) % gsz); u.pn = (wgid % nig) / gsz; u.ks = 0; return true;
    }
    __device__ __forceinline__ void a_ready(const Unit&) const {}
    __device__ __forceinline__ void done(const Unit&) const {}
};
__device__ __forceinline__ unsigned cvt_pk_bf16(float lo, float hi) { return cvtpk(lo, hi); }
struct SplitOrder {
    int KS, c;
    __host__ __device__ bool next(int i, Unit& u) const { if (i != 0 || c >= 8 * KS) return false; const int tile = c / KS; u.ks = c % KS; u.pm = 64 + (tile >> 2); u.pn = tile & 3; return true; }
    __device__ __forceinline__ void a_ready(const Unit&) const {}
    __device__ __forceinline__ void done(const Unit&) const {}
};
struct EpiPart {
    static constexpr bool PERM = false, AFTER_DRAIN = false, HAS_MID = false;
    float* C;
    __device__ __forceinline__ void operator()(const f32x4 (&acc)[2][2][4][2], const Unit& u, int wr, int wc, int fr, int fq) const {
        const int row0 = (u.pm - 64) * BM + wr * 64 + fr, col0 = u.pn * BM + wc * 32 + 4 * fq; float* base = C + (size_t)u.ks * (512 * 1024);
#pragma unroll
        for (int ai = 0; ai < 2; ++ai)
#pragma unroll
            for (int m = 0; m < 4; ++m) { float* rowp = base + (size_t)(row0 + ai * HALF + m * 16) * 1024 + col0;
#pragma unroll
                for (int bj = 0; bj < 2; ++bj)
#pragma unroll
                    for (int n = 0; n < 2; ++n) *(f32x4*)(rowp + bj * HALF + n * 16) = acc[ai][bj][m][n]; }
    }
};
struct P1Order {
    StaticOrder so;
    __host__ __device__ void init(int G_, int c_) { so.init(64 * 256, 24 * 256, G_, c_); }
    __host__ __device__ bool next(int i, Unit& u) const {
        const long L = (long)i * so.G + so.c;
        if (L < 1536) { so.next(i, u); if (u.pn >= 4) u.pn += 4; return true; }
        u.ks = 0;
        if (L < 1536 + 56) { const int idx = (int)L - 1536; u.pm = 64 + idx / 28; u.pn = idx % 28; return true; }
        if (L < 1536 + 56 + 16) { const int idx = (int)L - 1592; u.pm = 66 + idx / 2; u.pn = 28 + idx % 2; return true; }
        return false;
    }
    __device__ __forceinline__ void a_ready(const Unit&) const {}
    __device__ __forceinline__ void done(const Unit&) const {}
};
struct EpiP1 {
    static constexpr bool PERM = true, AFTER_DRAIN = false, HAS_MID = false;
    bf16_t* Zp; int ldz; float* mk; float* mv; bf16_t* srg; bf16_t* sg; int c_rg, c_g;
    __device__ __forceinline__ void operator()(const f32x4 (&acc)[2][2][4][2], const Unit& u, int wr, int wc, int fr, int fq) const {
        if (u.pm >= 66) {
            float* base = (u.pn == 28) ? mk : mv; const int row0 = (u.pm - 66) * BM + wr * 64 + fr, col0 = wc * 32 + 8 * fq;
#pragma unroll
            for (int ai = 0; ai < 2; ++ai)
#pragma unroll
                for (int m = 0; m < 4; ++m) { float* rowp = base + (size_t)(row0 + ai * HALF + m * 16) * 256 + col0;
#pragma unroll
                    for (int bj = 0; bj < 2; ++bj) { *(f32x4*)(rowp + bj * HALF) = acc[ai][bj][m][0]; *(f32x4*)(rowp + bj * HALF + 4) = acc[ai][bj][m][1]; } }
            return;
        }
        const int row0 = u.pm * BM + wr * 64 + fr, col0 = u.pn * BM + wc * 32 + 8 * fq;
#pragma unroll
        for (int bj = 0; bj < 2; ++bj) { const int c = col0 + bj * HALF;
            if (c >= c_g + 3072) continue;
            const int kind = c >= c_g ? 2 : (c >= c_rg && c < c_rg + 1024) ? 1 : 0;
            bf16_t* dst = kind == 2 ? sg + (c - c_g) : kind == 1 ? srg + (c - c_rg) : Zp + c; const int ld = kind == 2 ? 3072 : kind == 1 ? 1024 : ldz;
#pragma unroll
            for (int ai = 0; ai < 2; ++ai)
#pragma unroll
                for (int m = 0; m < 4; ++m) { f32x4 v0 = acc[ai][bj][m][0], v1 = acc[ai][bj][m][1];
                    if (kind) {
#pragma unroll
                        for (int e = 0; e < 4; ++e) { const float s0 = __builtin_amdgcn_rcpf(1.f + __expf(-v0[e])), s1 = __builtin_amdgcn_rcpf(1.f + __expf(-v1[e]));        v0[e] = kind == 2 ? s0 : v0[e] * s0; v1[e] = kind == 2 ? s1 : v1[e] * s1; } }
                    u32x4 w; w.x = cvt_pk_bf16(v0[0], v0[1]); w.y = cvt_pk_bf16(v0[2], v0[3]); w.z = cvt_pk_bf16(v1[0], v1[1]); w.w = cvt_pk_bf16(v1[2], v1[3]);
                    *(u32x4*)(dst + (size_t)(row0 + ai * HALF + m * 16) * ld) = w; } }
    }
};
struct EpiF32S {
    static constexpr bool PERM = false, AFTER_DRAIN = false, HAS_MID = false;
    float* C; int ldc; int split_tiles; size_t split_stride;
    __device__ __forceinline__ void operator()(const f32x4 (&acc)[2][2][4][2], const Unit& u, int wr, int wc, int fr, int fq) const {
        int pn = u.pn; float* base = C; if (split_tiles) { const int t = pn / split_tiles; base += (size_t)t * split_stride; pn -= t * split_tiles; }
        const int row0 = u.pm * BM + wr * 64 + fr, col0 = pn * BM + wc * 32 + 4 * fq;
#pragma unroll
        for (int ai = 0; ai < 2; ++ai)
#pragma unroll
            for (int m = 0; m < 4; ++m) { float* rowp = base + (size_t)(row0 + ai * HALF + m * 16) * ldc + col0;
#pragma unroll
                for (int bj = 0; bj < 2; ++bj)
#pragma unroll
                    for (int n = 0; n < 2; ++n) *(f32x4*)(rowp + bj * HALF + n * 16) = acc[ai][bj][m][n]; }
    }
};
struct EpiBf16S {
    static constexpr bool PERM = true, AFTER_DRAIN = false, HAS_MID = false;
    bf16_t* O; int ldc;
    __device__ __forceinline__ void operator()(const f32x4 (&acc)[2][2][4][2], const Unit& u, int wr, int wc, int fr, int fq) const {
        const int row0 = u.pm * BM + wr * 64 + fr, col0 = u.pn * BM + wc * 32 + 8 * fq;
#pragma unroll
        for (int ai = 0; ai < 2; ++ai)
#pragma unroll
            for (int m = 0; m < 4; ++m) { bf16_t* rowp = O + (size_t)(row0 + ai * HALF + m * 16) * ldc + col0;
#pragma unroll
                for (int bj = 0; bj < 2; ++bj) { const f32x4 v0 = acc[ai][bj][m][0], v1 = acc[ai][bj][m][1];
                    u32x4 w; w.x = cvt_pk_bf16(v0[0], v0[1]); w.y = cvt_pk_bf16(v0[2], v0[3]); w.z = cvt_pk_bf16(v1[0], v1[1]); w.w = cvt_pk_bf16(v1[2], v1[3]);
                    *(u32x4*)(rowp + bj * HALF) = w; } }
    }
};
struct EpiSwiGLU {
    static constexpr bool PERM = true, AFTER_DRAIN = false, HAS_MID = false;
    bf16_t* O; int ldc;
    __device__ __forceinline__ void operator()(const f32x4 (&acc)[2][2][4][2], const Unit& u, int wr, int wc, int fr, int fq) const {
        const int row0 = u.pm * BM + wr * 64 + fr, col0 = u.pn * (BM / 2) + wc * 16 + 4 * fq;
#pragma unroll
        for (int ai = 0; ai < 2; ++ai)
#pragma unroll
            for (int m = 0; m < 4; ++m) { bf16_t* rowp = O + (size_t)(row0 + ai * HALF + m * 16) * ldc + col0;
#pragma unroll
                for (int bj = 0; bj < 2; ++bj) { const f32x4 v0 = acc[ai][bj][m][0], v1 = acc[ai][bj][m][1];
                    const float a0 = v0[0] * __builtin_amdgcn_rcpf(1.f + __expf(-v0[0])) * v0[1], a1 = v0[2] * __builtin_amdgcn_rcpf(1.f + __expf(-v0[2])) * v0[3];
                    const float a2 = v1[0] * __builtin_amdgcn_rcpf(1.f + __expf(-v1[0])) * v1[1], a3 = v1[2] * __builtin_amdgcn_rcpf(1.f + __expf(-v1[2])) * v1[3];
                    u32x2 w; w.x = cvt_pk_bf16(a0, a1); w.y = cvt_pk_bf16(a2, a3);
                    *(u32x2*)(rowp + bj * (HALF / 2)) = w; } }
    }
};
template <int MODE  > struct EpiGate {
    static constexpr bool PERM = true, AFTER_DRAIN = false, HAS_MID = false;
    const bf16_t* sg; const bf16_t* tin; bf16_t* tout; int ldc;
    __device__ __forceinline__ void operator()(const f32x4 (&acc)[2][2][4][2], const Unit& u, int wr, int wc, int fr, int fq) const {
        const int row0 = u.pm * BM + wr * 64 + fr, col0 = u.pn * BM + wc * 32 + 8 * fq;
#pragma unroll
        for (int ai = 0; ai < 2; ++ai)
#pragma unroll
            for (int m = 0; m < 4; ++m) { const size_t r = (size_t)(row0 + ai * HALF + m * 16);
#pragma unroll
                for (int bj = 0; bj < 2; ++bj) { const int c = col0 + bj * HALF;
                    const u32x4 gq = *(const u32x4*)(sg + r * 3072 + c); u32x4 tq = {0u, 0u, 0u, 0u}; if (MODE >= 1) tq = *(const u32x4*)(tin + r * ldc + c);
                    const f32x4 v0 = acc[ai][bj][m][0], v1 = acc[ai][bj][m][1]; u32x4 w;
#define EG_ONE(dst, x0, x1, gw_, tw_) { float a_ = (x0) * __builtin_bit_cast(float, (gw_) << 16), b_ = (x1) * __builtin_bit_cast(float, (gw_) & 0xffff0000u); \
                        if (MODE >= 1) { a_ += __builtin_bit_cast(float, (tw_) << 16); b_ += __builtin_bit_cast(float, (tw_) & 0xffff0000u); } dst = cvt_pk_bf16(a_, b_); }
                    EG_ONE(w.x, v0[0], v0[1], gq.x, tq.x) EG_ONE(w.y, v0[2], v0[3], gq.y, tq.y) EG_ONE(w.z, v1[0], v1[1], gq.z, tq.z) EG_ONE(w.w, v1[2], v1[3], gq.w, tq.w)
#undef EG_ONE
                    *(u32x4*)(tout + r * ldc + c) = w; } }
    }
};
struct P3Order {
    StaticOrder so;
    __host__ __device__ void init(int G_, int c_) { so.init(66 * 256, 1536, G_, c_); }
    __host__ __device__ bool next(int i, Unit& u) const {
        const long L = (long)i * so.G + so.c;
        if (L < 396) return so.next(i, u);
        const int idx = (int)L - 396; if (idx >= 16) return false;
        u.pm = 64 + idx / 8; u.pn = 6 + idx % 8; u.ks = 0; return true;
    }
    __device__ __forceinline__ void a_ready(const Unit&) const {}
    __device__ __forceinline__ void done(const Unit&) const {}
};
struct EpiQ {
    static constexpr bool PERM = true, AFTER_DRAIN = false, HAS_MID = false;
    bf16_t* Q; bf16_t* QL_; int np;
    __device__ __forceinline__ void operator()(const f32x4 (&acc)[2][2][4][2], const Unit& u, int wr, int wc, int fr, int fq) const {
        const bool ab = u.pn >= 6; const int ldc = ab ? 2048 : 1536;
        const int row0 = u.pm * BM + wr * 64 + fr - (ab ? np : 0), col0 = (u.pn - (ab ? 6 : 0)) * BM + wc * 32 + 8 * fq; bf16_t* O = ab ? QL_ : Q;
#pragma unroll
        for (int ai = 0; ai < 2; ++ai)
#pragma unroll
            for (int m = 0; m < 4; ++m) { bf16_t* rowp = O + (size_t)(row0 + ai * HALF + m * 16) * ldc + col0;
#pragma unroll
                for (int bj = 0; bj < 2; ++bj) { const f32x4 v0 = acc[ai][bj][m][0], v1 = acc[ai][bj][m][1];
                    u32x4 w; w.x = cvt_pk_bf16(v0[0], v0[1]); w.y = cvt_pk_bf16(v0[2], v0[3]); w.z = cvt_pk_bf16(v1[0], v1[1]); w.w = cvt_pk_bf16(v1[2], v1[3]);
                    *(u32x4*)(rowp + bj * HALF) = w; } }
    }
};
struct EpiGate3 {
    static constexpr bool PERM = true, AFTER_DRAIN = false, HAS_MID = true;
    const bf16_t* sg; bf16_t* out; int ldc; int t1, t2;
    __device__ __forceinline__ void mid(f32x4 (&acc)[2][2][4][2], const Unit& u, int wr, int wc, int fr, int fq, int seam) const {
        int row0 = u.pm * BM + wr * 64 + fr, col0 = u.pn * BM + wc * 32 + 8 * fq;
        asm volatile("" : "+v"(row0), "+v"(col0));
#pragma unroll
        for (int ai = 0; ai < 2; ++ai)
#pragma unroll
            for (int m = 0; m < 4; ++m) { const bf16_t* gp = sg + (size_t)(row0 + ai * HALF + m * 16) * 3072 + seam * 1024 + col0;
#pragma unroll
                for (int bj = 0; bj < 2; ++bj) { const u32x4 ga = *(const u32x4*)(gp + bj * HALF), gb = *(const u32x4*)(gp + 1024 + bj * HALF);
#define EG3_R(a_, b_, hi_) (fmaxf(__builtin_bit_cast(float, (hi_) ? ((a_) & 0xffff0000u) : ((a_) << 16)), 1e-30f) * __builtin_amdgcn_rcpf(fmaxf(__builtin_bit_cast(float, (hi_) ? ((b_) & 0xffff0000u) : ((b_) << 16)), 1e-30f)))
                    acc[ai][bj][m][0][0] *= EG3_R(ga.x, gb.x, 0); acc[ai][bj][m][0][1] *= EG3_R(ga.x, gb.x, 1); acc[ai][bj][m][0][2] *= EG3_R(ga.y, gb.y, 0); acc[ai][bj][m][0][3] *= EG3_R(ga.y, gb.y, 1);
                    acc[ai][bj][m][1][0] *= EG3_R(ga.z, gb.z, 0); acc[ai][bj][m][1][1] *= EG3_R(ga.z, gb.z, 1); acc[ai][bj][m][1][2] *= EG3_R(ga.w, gb.w, 0); acc[ai][bj][m][1][3] *= EG3_R(ga.w, gb.w, 1);
#undef EG3_R
                } }
    }
    __device__ __forceinline__ void operator()(const f32x4 (&acc)[2][2][4][2], const Unit& u, int wr, int wc, int fr, int fq) const {
        const int row0 = u.pm * BM + wr * 64 + fr, col0 = u.pn * BM + wc * 32 + 8 * fq;
#pragma unroll
        for (int ai = 0; ai < 2; ++ai)
#pragma unroll
            for (int m = 0; m < 4; ++m) { const size_t r = (size_t)(row0 + ai * HALF + m * 16);
#pragma unroll
                for (int bj = 0; bj < 2; ++bj) { const int c = col0 + bj * HALF;
                    const u32x4 gq = *(const u32x4*)(sg + r * 3072 + 2048 + c); const f32x4 v0 = acc[ai][bj][m][0], v1 = acc[ai][bj][m][1]; u32x4 w;
#define EG3_G(g_, hi_) fmaxf(__builtin_bit_cast(float, (hi_) ? ((g_) & 0xffff0000u) : ((g_) << 16)), 1e-30f)
                    w.x = cvt_pk_bf16(v0[0] * EG3_G(gq.x, 0), v0[1] * EG3_G(gq.x, 1)); w.y = cvt_pk_bf16(v0[2] * EG3_G(gq.y, 0), v0[3] * EG3_G(gq.y, 1));
                    w.z = cvt_pk_bf16(v1[0] * EG3_G(gq.z, 0), v1[1] * EG3_G(gq.z, 1)); w.w = cvt_pk_bf16(v1[2] * EG3_G(gq.w, 0), v1[3] * EG3_G(gq.w, 1));
#undef EG3_G
                    *(u32x4*)(out + r * ldc + c) = w; } }
    }
};
template <class Epi, class Sched, bool ALIGN_EPI = false, bool SP2 = false>
__device__ __forceinline__ void gemm_phase(LAS unsigned char* lds, const Gemm g, const Sched& S, const Epi& E) {
    int tid_ = threadIdx.x; asm volatile("" : "+v"(tid_));
    const int tid = tid_, wid = __builtin_amdgcn_readfirstlane(tid >> 6), lane = tid & 63, wr = wid >> 2, wc = wid & 3, fr = lane & 15, fq = lane >> 4;
    const int K = g.K, nt = K / BK;
    unsigned voffA[2], voffB[2];
#pragma unroll
    for (int i = 0; i < 2; ++i) { int R, C; stage_rc(tid * 16 + i * 8192, R, C); const int Rb = Epi::PERM ? ((R & ~31) + perm32(R & 31)) : R;
        voffA[i] = (unsigned)(R * g.lda + C) * 2u; voffB[i] = (unsigned)(Rb * g.ldb + C) * 2u; }
    const size_t kstep = (size_t)(BK * 2);
    const size_t hstepA = (size_t)HALF * g.lda * 2, hstepB = (size_t)HALF * g.ldb * 2;
    const size_t tstepA = 2 * hstepA, tstepB = 2 * hstepB;
    const unsigned ldsw = (unsigned)wid * 1024u;
    const int aoff = lds_byte(wr * 64 + fr, fq * 8), boff = lds_byte(wc * 32 + fr, fq * 8);
#define PG8_SA(b, h) (((b) * 2 + (h)) * HTB)
#define PG8_SB(b, h) ((4 + (b) * 2 + (h)) * HTB)
#define PG8_STAGE(bufoff, gbase, voff) do { _Pragma("unroll") for (int _i = 0; _i < 2; ++_i) \
        __builtin_amdgcn_global_load_lds((const unsigned*)((const char*)(gbase) + (voff)[_i]), (LAS unsigned*)(lds + (bufoff) + ldsw + _i * 8192), 16, 0, 0); } while (0)
#define PG8_LDA(dst, b, h) do { _Pragma("unroll") for (int m = 0; m < 4; ++m) _Pragma("unroll") for (int k = 0; k < 2; ++k) dst[m][k] = *(const LAS bf16x8*)(lds + PG8_SA(b, h) + aoff + m * 2048 + k * 1024); } while (0)
#define PG8_LDB(dst, b, h) do { _Pragma("unroll") for (int n = 0; n < 2; ++n) _Pragma("unroll") for (int k = 0; k < 2; ++k) dst[n][k] = *(const LAS bf16x8*)(lds + PG8_SB(b, h) + boff + n * 2048 + k * 1024); } while (0)
#define PG8_MMA(ai, bj, At, Bt) do { __builtin_amdgcn_s_setprio(1); _Pragma("unroll") for (int m = 0; m < 4; ++m) _Pragma("unroll") for (int n = 0; n < 2; ++n) _Pragma("unroll") for (int k = 0; k < 2; ++k) \
        acc[ai][bj][m][n] = __builtin_amdgcn_mfma_f32_16x16x32_bf16(Bt[n][k], At[m][k], acc[ai][bj][m][n], 0, 0, 0); __builtin_amdgcn_s_setprio(0); } while (0)
#define PG8_WAIT_V(n) asm volatile("s_waitcnt vmcnt(" #n ")" ::: "memory")
#define PG8_WAIT_L(n) asm volatile("s_waitcnt lgkmcnt(" #n ")" ::: "memory")
#define PG8_BAR __builtin_amdgcn_s_barrier()
#define PG8_SCHED __builtin_amdgcn_sched_barrier(0)
    Unit cur, nxt; int ui = 0;
    if (!S.next(0, cur)) return;
    f32x4 acc[2][2][4][2];
#pragma unroll
    for (int a = 0; a < 2; ++a)
#pragma unroll
        for (int b = 0; b < 2; ++b)
#pragma unroll
            for (int m = 0; m < 4; ++m)
#pragma unroll
                for (int n = 0; n < 2; ++n) acc[a][b][m][n] = (f32x4){0.f, 0.f, 0.f, 0.f};
    bf16x8 At[4][2], B0[2][2], B1[2][2];
    const size_t kslb = (size_t)g.ksl * 2;
    const char* cA = (const char*)g.A + (size_t)cur.pm * tstepA + cur.ks * kslb; const char* cB = (const char*)g.Bt + (size_t)cur.pn * tstepB + cur.ks * kslb;
    S.a_ready(cur);
    if constexpr (SP2) {
        PG8_STAGE(PG8_SB(0, 0), cB, voffB); PG8_STAGE(PG8_SB(0, 1), cB + hstepB, voffB); PG8_STAGE(PG8_SA(0, 0), cA, voffA); PG8_STAGE(PG8_SA(0, 1), cA + hstepA, voffA);
        if (wr == 1) PG8_BAR;
        PG8_WAIT_V(2); PG8_BAR;
        PG8_STAGE(PG8_SB(1, 0), cB + kstep, voffB); PG8_STAGE(PG8_SA(1, 0), cA + kstep, voffA); PG8_STAGE(PG8_SB(1, 1), cB + hstepB + kstep, voffB);
        PG8_WAIT_V(6); PG8_BAR;
    } else {
        PG8_STAGE(PG8_SB(0, 0), cB, voffB); PG8_STAGE(PG8_SA(0, 0), cA, voffA); PG8_STAGE(PG8_SB(0, 1), cB + hstepB, voffB); PG8_STAGE(PG8_SA(0, 1), cA + hstepA, voffA);
        if (wr == 1) PG8_BAR;
        PG8_WAIT_V(4); PG8_BAR;
        PG8_STAGE(PG8_SB(1, 0), cB + kstep, voffB); PG8_STAGE(PG8_SA(1, 0), cA + kstep, voffA); PG8_STAGE(PG8_SB(1, 1), cB + hstepB + kstep, voffB);
        PG8_WAIT_V(6); PG8_BAR;
    }
    for (;;) {
        const bool has_next = S.next(ui + 1, nxt);
        const char* nA = has_next ? (const char*)g.A + (size_t)nxt.pm * tstepA + nxt.ks * kslb : cA; const char* nB = has_next ? (const char*)g.Bt + (size_t)nxt.pn * tstepB + nxt.ks * kslb : cB;
#pragma unroll 1
        for (int t = 0; t < nt; t += 2) {
            const bool last = (t == nt - 2);
            const char* a1 = cA + (size_t)(t + 1) * kstep;
            const char* a2 = last ? nA : cA + (size_t)(t + 2) * kstep; const char* b2 = last ? nB : cB + (size_t)(t + 2) * kstep;
            const char* a3 = a2 + kstep; const char* b3 = b2 + kstep;
            if (last && has_next) S.a_ready(nxt);
            if constexpr (Epi::HAS_MID) { if (t == E.t1 || t == E.t2) E.mid(acc, cur, wr, wc, fr, fq, t == E.t1 ? 0 : 1); }
            if constexpr (SP2) {
            PG8_LDB(B0, 0, 0); PG8_LDB(B1, 0, 1); PG8_SCHED; PG8_LDA(At, 0, 0); PG8_STAGE(PG8_SA(1, 1), a1 + hstepA, voffA);
            PG8_WAIT_V(8); PG8_WAIT_L(0); PG8_BAR; PG8_MMA(0, 0, At, B0); PG8_MMA(0, 1, At, B1); PG8_BAR; PG8_SCHED;
            PG8_LDA(At, 0, 1); PG8_STAGE(PG8_SB(0, 0), b2, voffB); PG8_STAGE(PG8_SB(0, 1), b2 + hstepB, voffB); PG8_STAGE(PG8_SA(0, 0), a2, voffA);
            PG8_WAIT_V(8); PG8_WAIT_L(0); PG8_BAR; PG8_MMA(1, 0, At, B0); PG8_MMA(1, 1, At, B1); PG8_BAR; PG8_SCHED;
            PG8_LDB(B0, 1, 0); PG8_LDB(B1, 1, 1); PG8_SCHED; PG8_LDA(At, 1, 0); PG8_STAGE(PG8_SA(0, 1), a2 + hstepA, voffA);
            PG8_WAIT_V(8); PG8_WAIT_L(0); PG8_BAR; PG8_MMA(0, 0, At, B0); PG8_MMA(0, 1, At, B1); PG8_BAR; PG8_SCHED;
            PG8_LDA(At, 1, 1); PG8_STAGE(PG8_SB(1, 0), b3, voffB); PG8_STAGE(PG8_SB(1, 1), b3 + hstepB, voffB); PG8_STAGE(PG8_SA(1, 0), a3, voffA);
            PG8_WAIT_V(8); PG8_WAIT_L(0); PG8_BAR; PG8_MMA(1, 0, At, B0); PG8_MMA(1, 1, At, B1); PG8_BAR; PG8_SCHED;
            } else {
            PG8_LDB(B0, 0, 0); PG8_SCHED; PG8_LDA(At, 0, 0); PG8_STAGE(PG8_SA(1, 1), a1 + hstepA, voffA);
            PG8_WAIT_L(8); PG8_BAR; PG8_WAIT_L(0); PG8_MMA(0, 0, At, B0); PG8_BAR; PG8_SCHED;
            PG8_LDB(B1, 0, 1); PG8_STAGE(PG8_SB(0, 0), b2, voffB);
            PG8_BAR; PG8_WAIT_L(0); PG8_MMA(0, 1, At, B1); PG8_BAR;
            PG8_LDA(At, 0, 1); PG8_STAGE(PG8_SA(0, 0), a2, voffA);
            PG8_BAR; PG8_WAIT_L(0); PG8_MMA(1, 0, At, B0); PG8_BAR; PG8_SCHED;
            PG8_STAGE(PG8_SB(0, 1), b2 + hstepB, voffB);
            PG8_WAIT_V(6); PG8_BAR; PG8_MMA(1, 1, At, B1); PG8_BAR;
            PG8_LDB(B0, 1, 0); PG8_SCHED; PG8_LDA(At, 1, 0); PG8_STAGE(PG8_SA(0, 1), a2 + hstepA, voffA);
            PG8_WAIT_L(8); PG8_BAR; PG8_WAIT_L(0); PG8_MMA(0, 0, At, B0); PG8_BAR; PG8_SCHED;
            PG8_LDB(B1, 1, 1); PG8_STAGE(PG8_SB(1, 0), b3, voffB);
            PG8_BAR; PG8_WAIT_L(0); PG8_MMA(0, 1, At, B1); PG8_BAR;
            PG8_LDA(At, 1, 1); PG8_STAGE(PG8_SA(1, 0), a3, voffA);
            PG8_BAR; PG8_WAIT_L(0); PG8_MMA(1, 0, At, B0); PG8_BAR; PG8_SCHED;
            PG8_STAGE(PG8_SB(1, 1), b3 + hstepB, voffB);
            PG8_WAIT_V(6); PG8_BAR; PG8_MMA(1, 1, At, B1); PG8_BAR;
            }
        }
        if constexpr (ALIGN_EPI) { if (wr == 0) PG8_BAR; }
        if constexpr (!Epi::AFTER_DRAIN) { E(acc, cur, wr, wc, fr, fq); S.done(cur); }
        if (!has_next) break;
#pragma unroll
        for (int a = 0; a < 2; ++a)
#pragma unroll
            for (int b = 0; b < 2; ++b)
#pragma unroll
                for (int m = 0; m < 4; ++m)
#pragma unroll
                    for (int n = 0; n < 2; ++n) acc[a][b][m][n] = (f32x4){0.f, 0.f, 0.f, 0.f};
        cur = nxt; cA = nA; cB = nB; ++ui;
        if constexpr (ALIGN_EPI) { if (wr == 1) PG8_BAR; }
    }
    PG8_WAIT_V(0);
    if constexpr (!ALIGN_EPI) { if (wr == 0) PG8_BAR; }
    PG8_BAR;
    if constexpr (Epi::AFTER_DRAIN) { E.fused(acc, cur, wr, wc, fr, fq, lds, wid, lane); S.done(cur); }
#undef PG8_SA
#undef PG8_SB
#undef PG8_STAGE
#undef PG8_LDA
#undef PG8_LDB
#undef PG8_MMA
#undef PG8_WAIT_V
#undef PG8_WAIT_L
#undef PG8_BAR
#undef PG8_SCHED
}
}
typedef unsigned short bf16_t;
DI unsigned pk2(float lo, float hi) { return pg8::cvt_pk_bf16(lo, hi); }
DI bf16_t f2bf(float f) { return (bf16_t)(pg8::cvt_pk_bf16(f, 0.f) & 0xffffu); }
DI void transpose_item(const float* W, int N, bf16_t* WT, int ldt, int row_off, int rmul, LAS float* scr, int item, int lane) {
    const int nblk = N / 32, kb = item / nblk, nb = item % nblk, k0 = 64 * kb, n0 = 32 * nb;
#pragma unroll 8
    for (int i = 0; i < 32; ++i) { const int kk = 2 * i + (lane >> 5); scr[kk * 33 + (lane & 31)] = W[(size_t)(k0 + kk) * N + n0 + (lane & 31)]; }
    asm volatile("s_waitcnt lgkmcnt(0)" ::: "memory");
    const int c = lane & 7;
#pragma unroll
    for (int j = 0; j < 4; ++j) { const int n = (lane >> 3) + 8 * j; const LAS float* sp = scr + (8 * c) * 33 + n;
        pg8::u32x4 o; o.x = pk2(sp[0 * 33], sp[1 * 33]); o.y = pk2(sp[2 * 33], sp[3 * 33]); o.z = pk2(sp[4 * 33], sp[5 * 33]); o.w = pk2(sp[6 * 33], sp[7 * 33]);
        *(pg8::u32x4*)(WT + (size_t)(row_off + rmul * (n0 + n)) * ldt + k0 + 8 * c) = o; }
    asm volatile("s_waitcnt lgkmcnt(0)" ::: "memory");
}
DI void transpose_w(const float* W, int K, int N, bf16_t* WT, int ldt, int row_off, LAS float* scr, int gw, int NGW, int lane, int& rot, int rmul = 1) {
    const int nitems = (K / 64) * (N / 32);
    int first = gw - (rot % NGW); if (first < 0) first += NGW;
    for (int it = first; it < nitems; it += NGW) transpose_item(W, N, WT, ldt, row_off, rmul, scr, it, lane);
    rot += nitems;
}

struct Args {
    const float* in[29]; float* out; unsigned char* ws; int ph_lo, ph_hi, sub, pad;
};

DI unsigned short f2bf_raw(float f) { unsigned u = __builtin_bit_cast(unsigned, f); return (unsigned short)((u + 0x7fffu + ((u >> 16) & 1u)) >> 16); }
DI void sgemm_naive(LAS float* lds, const float* __restrict__ A, int lda, const float* __restrict__ B, long sbk, long sbn,
                    float* __restrict__ C, int ldc, int M, int N, int K, int bid, int G, unsigned short* Cb = nullptr) {
    LAS float* As = lds;
    LAS float* Bs = lds + 16 * 132;
    const int tid = threadIdx.x, tx = tid & 15, ty = tid >> 4;
    const int ntn = N / 64, ntiles = (M / 128) * ntn;
    for (int t = bid; t < ntiles; t += G) {
        const int m0 = (t / ntn) * 128, n0 = (t % ntn) * 64;
        float acc[4][4];
#pragma unroll
        for (int i = 0; i < 4; ++i)
#pragma unroll
            for (int j = 0; j < 4; ++j) acc[i][j] = 0.f;
        for (int k0 = 0; k0 < K; k0 += 16) {
            {
                const int r = tid >> 2, kq = (tid & 3) * 4;
                const float4 v = *(const float4*)(A + (size_t)(m0 + r) * lda + k0 + kq);
                As[(kq + 0) * 132 + r] = v.x; As[(kq + 1) * 132 + r] = v.y; As[(kq + 2) * 132 + r] = v.z; As[(kq + 3) * 132 + r] = v.w;
            }
#pragma unroll
            for (int i = 0; i < 2; ++i) {
                const int idx = tid + i * 512, kk = idx >> 6, nn = idx & 63;
                Bs[kk * 64 + nn] = B[(size_t)(k0 + kk) * sbk + (size_t)(n0 + nn) * sbn];
            }
            __syncthreads();
#pragma unroll
            for (int kk = 0; kk < 16; ++kk) {
                const f32x4 a = *(const LAS f32x4*)(As + kk * 132 + ty * 4);
                const f32x4 b = *(const LAS f32x4*)(Bs + kk * 64 + tx * 4);
                const float av[4] = {a.x, a.y, a.z, a.w}, bv[4] = {b.x, b.y, b.z, b.w};
#pragma unroll
                for (int i = 0; i < 4; ++i)
#pragma unroll
                    for (int j = 0; j < 4; ++j) acc[i][j] += av[i] * bv[j];
            }
            __syncthreads();
        }
#pragma unroll
        for (int i = 0; i < 4; ++i) {
            float4 o; o.x = acc[i][0]; o.y = acc[i][1]; o.z = acc[i][2]; o.w = acc[i][3];
            if (Cb) { unsigned short* cb = Cb + (size_t)(m0 + ty * 4 + i) * ldc + n0 + tx * 4; cb[0] = f2bf_raw(o.x); cb[1] = f2bf_raw(o.y); cb[2] = f2bf_raw(o.z); cb[3] = f2bf_raw(o.w); }
            else *(float4*)(C + (size_t)(m0 + ty * 4 + i) * ldc + n0 + tx * 4) = o;
        }
    }
}

template <int DQK, int DV, bool V_IN_K, int MODE, class KV, class QF>
DI void attn_naive(LAS float* lds, const KV& kv, int nk_loop, const QF& qf, bool active, int limit, float scale, float lg, int tq, float* optr) {
    constexpr int KS = DQK + 1;
    constexpr int VS = V_IN_K ? KS : DV;
    LAS float* Ks = lds;
    LAS float* Vs = V_IN_K ? Ks : (lds + 64 * KS);
    LAS float* qs = lds + 64 * KS + (V_IN_K ? 0 : 64 * DV);
    LAS float* ps = qs + 8 * DQK;
    static_assert((64 * KS + (V_IN_K ? 0 : 64 * DV) + 8 * DQK + 8 * 64) * 4 <= MISC_OFF, "attn_naive LDS");
    const int tid = threadIdx.x, lane = tid & 63, w = tid >> 6;
    __syncthreads();
    for (int d = lane; d < DQK; d += 64) qs[w * DQK + d] = active ? qf(d) : 0.f;
    float m = -INFINITY, l = 0.f;
    float acc[DV / 64];
#pragma unroll
    for (int c = 0; c < DV / 64; ++c) acc[c] = 0.f;
    for (int base = 0; base < nk_loop; base += 64) {
        __syncthreads();
        for (int idx = tid; idx < 64 * DQK; idx += NTHREADS) { const int j = idx / DQK, d = idx - j * DQK, key = base + j; Ks[j * KS + d] = key < nk_loop ? kv.k(key, d) : 0.f; }
        if (!V_IN_K) for (int idx = tid; idx < 64 * DV; idx += NTHREADS) { const int j = idx / DV, e = idx - j * DV, key = base + j; Vs[j * DV + e] = key < nk_loop ? kv.v(key, e) : 0.f; }
        __syncthreads();
        const int key = base + lane; const bool valid = active && key <= limit && key < nk_loop;
        float s = 0.f;
        for (int d = 0; d < DQK; ++d) s += qs[w * DQK + d] * Ks[lane * KS + d];
        float p;
        if (MODE == 0) {
            s *= scale;
            const float cm = wave_max(valid ? s : -INFINITY);
            const float mn = fmaxf(m, cm);
            const float alpha = (mn == -INFINITY) ? 1.f : expf(m - mn);
            p = valid ? expf(s - mn) : 0.f;
            l = l * alpha + wave_sum(p);
#pragma unroll
            for (int c = 0; c < DV / 64; ++c) acc[c] *= alpha;
            m = mn;
        } else {
            p = valid ? s * expf((float)(tq - key) * lg) : 0.f;
        }
        ps[w * 64 + lane] = p;
        __syncthreads();
        for (int j = 0; j < 64; ++j) { const float pj = ps[w * 64 + j];
#pragma unroll
            for (int c = 0; c < DV / 64; ++c) acc[c] += pj * Vs[j * VS + lane + 64 * c]; }
    }
    if (active) {
#pragma unroll
        for (int c = 0; c < DV / 64; ++c) optr[lane + 64 * c] = (MODE == 0) ? acc[c] / l : acc[c];
    }
}

struct KvMlaPrompt { const float* ckvn; const float* kper; int b;
    DI float k(int key, int d) const { const size_t row = (size_t)b * SEQ + key; return d < KVL ? ckvn[row * KVL + d] : kper[row * DROPE + (d - KVL)]; }
    DI float v(int, int) const { return 0.f; } };
struct KvMlaSample { const float* ckvn; const float* kper; const float* cckv; const float* ckpe; const int* pt; int b;
    DI float k(int key, int d) const {
        if (key < PAST) { const size_t r = (size_t)pt[b * NPAGES + (key >> 7)] * PAGE + (key & (PAGE - 1)); return d < KVL ? cckv[r * KVL + d] : ckpe[r * DROPE + (d - KVL)]; }
        const size_t row = (size_t)NP + b * DS + (key - PAST); return d < KVL ? ckvn[row * KVL + d] : kper[row * DROPE + (d - KVL)]; }
    DI float v(int, int) const { return 0.f; } };
struct KvRet { const float* rk; const float* z; int b, h;
    DI float k(int key, int d) const { return rk[((size_t)b * SEQ + key) * 512 + h * RDK + d]; }
    DI float v(int key, int e) const { return z[((size_t)b * SEQ + key) * ZLD + C_RV + h * RDV + e]; } };
struct KvMem { const float* mk; const float* mv; int b, h;
    DI float k(int key, int d) const { return mk[(((size_t)b * NMEM + key) * XH + h) * XHD + d]; }
    DI float v(int key, int e) const { return mv[(((size_t)b * NMEM + key) * XH + h) * XHD + e]; } };


typedef float f32x16 __attribute__((ext_vector_type(16)));
typedef short bf16x8 __attribute__((ext_vector_type(8)));
typedef short s16x4 __attribute__((ext_vector_type(4)));
typedef unsigned u32x4_t __attribute__((ext_vector_type(4)));
typedef unsigned u32x2_t __attribute__((ext_vector_type(2)));
DI int crow(int i, int h) { return (i & 3) + 8 * (i >> 2) + 4 * h; }
#define MFMA32(a, b, c) __builtin_amdgcn_mfma_f32_32x32x16_bf16((a), (b), (c), 0, 0, 0)
template <int DQK, int DV, bool CAUSAL, class Src>
DI void flash_unit(LAS unsigned char* lds, const Src& src, int qpos0, int ntiles, bf16_t* O, int ldo, float c2) {
    constexpr int KP = DQK + 8, VP = 68, KS = DQK / 16, NBLK = DV / 32;
    constexpr int KBYTES = 64 * KP * 2, VBYTES = DV * VP * 2, BUF = KBYTES + VBYTES;
    constexpr int D8 = DQK / 8, NPK = (64 * D8) / NTHREADS, NPV = (DV * 8) / NTHREADS;
    static_assert((64 * D8) % NTHREADS == 0 && (DV * 8) % NTHREADS == 0 && 2 * BUF <= 131072, "flash_unit geometry");
    const int tid = threadIdx.x, lane = tid & 63, w = __builtin_amdgcn_readfirstlane(tid >> 6), l31 = lane & 31, h = lane >> 5;
    bf16x8 qf[KS];
#pragma unroll
    for (int s_ = 0; s_ < KS; ++s_) qf[s_] = src.qfrag(32 * w + l31, s_, h);
    src.post_q(qf, 32 * w + l31, h);
    f32x16 o[NBLK];
#pragma unroll
    for (int b = 0; b < NBLK; ++b)
#pragma unroll
        for (int i = 0; i < 16; ++i) o[b][i] = 0.f;
    float m = -INFINITY, lsum = 0.f;
    u32x4_t kreg[NPK], vreg[NPV];
#define FL_LOAD(t_) do { _Pragma("unroll") for (int i_ = 0; i_ < NPK; ++i_) { const int p_ = tid + i_ * NTHREADS; kreg[i_] = src.kpiece(64 * (t_) + p_ / D8, p_ % D8); } \
                         _Pragma("unroll") for (int i_ = 0; i_ < NPV; ++i_) { const int p_ = tid + i_ * NTHREADS; vreg[i_] = src.vpiece(p_ >> 3, 64 * (t_) + 8 * (p_ & 7)); } } while (0)
#define FL_STORE(buf_) do { _Pragma("unroll") for (int i_ = 0; i_ < NPK; ++i_) { const int p_ = tid + i_ * NTHREADS; *(LAS u32x4_t*)(lds + (buf_) * BUF + ((p_ / D8) * KP + (p_ % D8) * 8) * 2) = kreg[i_]; } \
                          _Pragma("unroll") for (int i_ = 0; i_ < NPV; ++i_) { const int p_ = tid + i_ * NTHREADS; LAS unsigned char* a_ = lds + (buf_) * BUF + KBYTES + ((p_ >> 3) * VP + (p_ & 7) * 8) * 2; \
                              *(LAS u32x2_t*)a_ = (u32x2_t){vreg[i_].x, vreg[i_].y}; *(LAS u32x2_t*)(a_ + 8) = (u32x2_t){vreg[i_].z, vreg[i_].w}; } } while (0)
    __syncthreads();
    FL_LOAD(0); FL_STORE(0);
    __syncthreads();
    const int qmine = qpos0 + 32 * w + l31, qlast = qpos0 + 32 * w + 31;
    for (int t = 0; t < ntiles; ++t) {
        const int buf = t & 1;
        if (t + 1 < ntiles) FL_LOAD(t + 1);
        if (!CAUSAL || 64 * t <= qlast) {
            const LAS unsigned char* kb_ = lds + buf * BUF; const LAS unsigned char* vb_ = kb_ + KBYTES;
            f32x16 st[2];
#pragma unroll
            for (int kb = 0; kb < 2; ++kb) {
#pragma unroll
                for (int i = 0; i < 16; ++i) st[kb][i] = 0.f;
#pragma unroll
                for (int g_ = 0; g_ < KS / 4; ++g_) { bf16x8 kf[4];
#pragma unroll
                    for (int j = 0; j < 4; ++j) kf[j] = *(const LAS bf16x8*)(kb_ + ((32 * kb + l31) * KP + 16 * (4 * g_ + j) + 8 * h) * 2);
#pragma unroll
                    for (int j = 0; j < 4; ++j) st[kb] = MFMA32(kf[j], qf[4 * g_ + j], st[kb]);
                    __builtin_amdgcn_sched_barrier(0); }
            }
            if (CAUSAL && 64 * t + 63 > qpos0 + 32 * w) {
#pragma unroll
                for (int kb = 0; kb < 2; ++kb)
#pragma unroll
                    for (int i = 0; i < 16; ++i) { const int key = 64 * t + 32 * kb + crow(i, h); st[kb][i] = key <= qmine ? st[kb][i] : -INFINITY; }
            }
            float mx = -INFINITY;
#pragma unroll
            for (int kb = 0; kb < 2; ++kb)
#pragma unroll
                for (int i = 0; i < 16; ++i) mx = fmaxf(mx, st[kb][i]);
            mx = fmaxf(mx, __shfl_xor(mx, 32));
            const float mn = fmaxf(m, mx);
            { const float alpha = __builtin_amdgcn_exp2f((m - mn) * c2);
                lsum *= alpha;
#pragma unroll
                for (int b = 0; b < NBLK; ++b)
#pragma unroll
                    for (int i = 0; i < 16; ++i) o[b][i] *= alpha;
                m = mn;
            }
            const float nmc = -mn * c2;
            float ps = 0.f;
#pragma unroll
            for (int kb = 0; kb < 2; ++kb)
#pragma unroll
                for (int i = 0; i < 16; ++i) { const float p = __builtin_amdgcn_exp2f(__builtin_fmaf(st[kb][i], c2, nmc)); st[kb][i] = p; ps += p; }
            lsum += ps;
            bf16x8 pf[4];
#pragma unroll
            for (int ks = 0; ks < 4; ++ks) { const int kb = ks >> 1, s2 = ks & 1; u32x4_t pk;
                pk.x = cvtpk(st[kb][8 * s2 + 0], st[kb][8 * s2 + 1]); pk.y = cvtpk(st[kb][8 * s2 + 2], st[kb][8 * s2 + 3]);
                pk.z = cvtpk(st[kb][8 * s2 + 4], st[kb][8 * s2 + 5]); pk.w = cvtpk(st[kb][8 * s2 + 6], st[kb][8 * s2 + 7]); pf[ks] = __builtin_bit_cast(bf16x8, pk); }
            __builtin_amdgcn_sched_barrier(0);
#pragma unroll
            for (int b = 0; b < NBLK; ++b) { bf16x8 vf[4];
#pragma unroll
                for (int ks = 0; ks < 4; ++ks) { const LAS unsigned char* a_ = vb_ + ((32 * b + l31) * VP + 16 * ks + 4 * h) * 2;
                    const s16x4 lo = *(const LAS s16x4*)a_, hi = *(const LAS s16x4*)(a_ + 16);
                    vf[ks] = __builtin_shufflevector(lo, hi, 0, 1, 2, 3, 4, 5, 6, 7); }
#pragma unroll
                for (int ks = 0; ks < 4; ++ks) o[b] = MFMA32(vf[ks], pf[ks], o[b]);
                __builtin_amdgcn_sched_barrier(0); }
        }
        if (t + 1 < ntiles) FL_STORE(buf ^ 1);
        __syncthreads();
    }
#undef FL_LOAD
#undef FL_STORE
    lsum += __shfl_xor(lsum, 32);
    const float inv = 1.f / lsum;
    bf16_t* orow = O + (size_t)(32 * w + l31) * ldo;
#pragma unroll
    for (int b = 0; b < NBLK; ++b)
#pragma unroll
        for (int g = 0; g < 4; ++g) { u32x2_t pk; pk.x = cvtpk(o[b][4 * g + 0] * inv, o[b][4 * g + 1] * inv); pk.y = cvtpk(o[b][4 * g + 2] * inv, o[b][4 * g + 3] * inv);
            *(u32x2_t*)(orow + 32 * b + 8 * g + 4 * h) = pk; }
}
DI void rope_frag_pair(bf16x8& x1, bf16x8& x2, const float* __restrict__ cosr, const float* __restrict__ sinr, int f0) {
    const f32x4 c0 = *(const f32x4*)(cosr + f0), c1 = *(const f32x4*)(cosr + f0 + 4), s0 = *(const f32x4*)(sinr + f0), s1 = *(const f32x4*)(sinr + f0 + 4);
    const u32x4_t a = __builtin_bit_cast(u32x4_t, x1), b = __builtin_bit_cast(u32x4_t, x2); u32x4_t oa, ob;
#define RFP_ONE(i_, cl_, ch_, sl_, sh_) { const float al = __builtin_bit_cast(float, a[i_] << 16), ah = __builtin_bit_cast(float, a[i_] & 0xffff0000u), bl = __builtin_bit_cast(float, b[i_] << 16), bh = __builtin_bit_cast(float, b[i_] & 0xffff0000u); \
        oa[i_] = cvtpk(al * (cl_) - bl * (sl_), ah * (ch_) - bh * (sh_)); ob[i_] = cvtpk(al * (sl_) + bl * (cl_), ah * (sh_) + bh * (ch_)); }
    RFP_ONE(0, c0[0], c0[1], s0[0], s0[1]) RFP_ONE(1, c0[2], c0[3], s0[2], s0[3]) RFP_ONE(2, c1[0], c1[1], s1[0], s1[1]) RFP_ONE(3, c1[2], c1[3], s1[2], s1[3])
#undef RFP_ONE
    x1 = __builtin_bit_cast(bf16x8, oa); x2 = __builtin_bit_cast(bf16x8, ob);
}
struct SrcMlaP { const bf16_t* kn; const bf16_t* kpe; const bf16_t* vt; const bf16_t* qraw; const float* cosb; const float* sinb; int b, hh; size_t row0;
    DI bf16x8 qfrag(int r, int s_, int h8) const { return *(const bf16x8*)(qraw + (row0 + r) * 1536 + hh * DQH + 16 * s_ + 8 * h8); }
    template <int KS_> DI void post_q(bf16x8 (&qf)[KS_], int r, int h8) const {
        const int p = (int)((row0 + r) & (SEQ - 1));
#pragma unroll
        for (int j = 0; j < 2; ++j) rope_frag_pair(qf[8 + j], qf[10 + j], cosb + p * 32, sinb + p * 32, 16 * j + 8 * h8);
    }
    DI u32x4_t kpiece(int key, int d8) const { const size_t row = (size_t)b * SEQ + key;
        return d8 < 16 ? *(const u32x4_t*)(kn + row * 1024 + hh * DNOPE + d8 * 8) : *(const u32x4_t*)(kpe + row * DROPE + (d8 - 16) * 8); }
    DI u32x4_t vpiece(int dv, int key0) const { return *(const u32x4_t*)(vt + (size_t)(hh * DVH + dv) * NP + (size_t)b * SEQ + key0); } };
struct SrcMemP { const bf16_t* mk; const bf16_t* mvt; const bf16_t* xq; int b, hh; size_t row0;
    DI bf16x8 qfrag(int r, int s_, int h8) const { return *(const bf16x8*)(xq + (row0 + r) * ZLD + hh * XHD + 16 * s_ + 8 * h8); }
    template <int KS_> DI void post_q(bf16x8 (&)[KS_], int, int) const {}
    DI u32x4_t kpiece(int key, int d8) const { return *(const u32x4_t*)(mk + ((size_t)b * NMEM + key) * 256 + hh * XHD + d8 * 8); }
    DI u32x4_t vpiece(int dv, int key0) const { return *(const u32x4_t*)(mvt + (size_t)(hh * XHD + dv) * (NB * NMEM) + (size_t)b * NMEM + key0); } };


typedef short v4i16_t __attribute__((ext_vector_type(4)));
DI s16x4 vtr(const LAS unsigned char* p) { return __builtin_bit_cast(s16x4, __builtin_amdgcn_ds_read_tr16_b64_v4i16((LAS v4i16_t*)p)); }
constexpr int MS_NSPLIT = 2, MS_KEYS = PAST / MS_NSPLIT, MS_TILES = MS_KEYS / 64;
DI void mla_sample_unit(LAS unsigned char* lds, const float* __restrict__ cckv, const float* __restrict__ ckpe, const int* __restrict__ pt,
                        const bf16_t* __restrict__ QLATb, const bf16_t* __restrict__ Qraw, const float* __restrict__ cosb, const float* __restrict__ sinb, float* __restrict__ PO, float* __restrict__ PML, int b, int split, float c2) {
    constexpr int KP = 328, KBYTES = 64 * KP * 2, SP = 68;
    LAS float* Sc = (LAS float*)(lds + 2 * KBYTES);
    const int tid = threadIdx.x, lane = tid & 63, w = __builtin_amdgcn_readfirstlane(tid >> 6), l31 = lane & 31, hh = lane >> 5, l15 = lane & 15, g4 = lane >> 4;
    const int kg = w >> 1, qg = w & 1;
    bf16x8 qf[10];
    { const int qi = 16 * qg + l15, t = qi >> 3, head = qi & 7;
      const bf16_t* ql = QLATb + (size_t)(b * DS + t) * 2048 + head * KVL + 8 * g4;
      const bf16_t* qp = Qraw + (size_t)(NP + b * DS + t) * 1536 + head * DQH + DNOPE + 8 * g4;
#pragma unroll
      for (int s_ = 0; s_ < 8; ++s_) qf[s_] = *(const bf16x8*)(ql + 32 * s_);
#pragma unroll
      for (int s_ = 0; s_ < 2; ++s_) qf[8 + s_] = *(const bf16x8*)(qp + 32 * s_);
      rope_frag_pair(qf[8], qf[9], cosb + (SEQ + t) * 32, sinb + (SEQ + t) * 32, 8 * g4); }
    f32x16 o;
#pragma unroll
    for (int i = 0; i < 16; ++i) o[i] = 0.f;
    float m = -INFINITY, lsum = 0.f;
    f32x4 crA[8], prA[2], crB[8], prB[2];
    const unsigned voffc = (unsigned)(((tid >> 6) * KVL + 4 * (tid & 63)) * 4), voffp = (unsigned)(((tid >> 4) * DROPE + 4 * (tid & 15)) * 4);
#define MS_LOAD(t_, CR_, PR_) do { const int key0_ = split * MS_KEYS + 64 * (t_); const int pg_ = __builtin_amdgcn_readfirstlane(pt[b * NPAGES + (key0_ >> 7)]); \
        const size_t rowb_ = (size_t)pg_ * PAGE + (key0_ & (PAGE - 1)); const char* cb_ = (const char*)(cckv + rowb_ * KVL); const char* pb_ = (const char*)(ckpe + rowb_ * DROPE); \
        _Pragma("unroll") for (int i_ = 0; i_ < 8; ++i_) CR_[i_] = __builtin_nontemporal_load((const f32x4*)(cb_ + (size_t)i_ * (8 * KVL * 4) + voffc)); \
        _Pragma("unroll") for (int i_ = 0; i_ < 2; ++i_) PR_[i_] = __builtin_nontemporal_load((const f32x4*)(pb_ + (size_t)i_ * (32 * DROPE * 4) + voffp)); } while (0)
#define MS_STORE(buf_, CR_, PR_) do { \
        _Pragma("unroll") for (int i_ = 0; i_ < 8; ++i_) { const int pc_ = tid + i_ * NTHREADS; *(LAS u32x2_t*)(lds + (buf_) * KBYTES + ((pc_ >> 6) * KP + 4 * (pc_ & 63)) * 2) = (u32x2_t){cvtpk(CR_[i_][0], CR_[i_][1]), cvtpk(CR_[i_][2], CR_[i_][3])}; } \
        _Pragma("unroll") for (int i_ = 0; i_ < 2; ++i_) { const int pc_ = tid + i_ * NTHREADS; *(LAS u32x2_t*)(lds + (buf_) * KBYTES + ((pc_ >> 4) * KP + KVL + 4 * (pc_ & 15)) * 2) = (u32x2_t){cvtpk(PR_[i_][0], PR_[i_][1]), cvtpk(PR_[i_][2], PR_[i_][3])}; } } while (0)
    __syncthreads();
    MS_LOAD(0, crA, prA); MS_LOAD(1, crB, prB); MS_STORE(0, crA, prA); MS_LOAD(2, crA, prA);
    __syncthreads();
    const int q4 = (lane & 15) >> 2, p4 = lane & 3, blk = (lane >> 4) & 1;
    auto tile = [&](const int buf) __attribute__((always_inline)) {
        const LAS unsigned char* kb_ = lds + buf * KBYTES;
        {   f32x4 s4 = {0.f, 0.f, 0.f, 0.f};
            const LAS unsigned char* kr_ = kb_ + ((16 * kg + l15) * KP + 8 * g4) * 2;
#pragma unroll
            for (int g_ = 0; g_ < 2; ++g_) { bf16x8 kf[5];
#pragma unroll
                for (int j = 0; j < 5; ++j) kf[j] = *(const LAS bf16x8*)(kr_ + 64 * (5 * g_ + j));
#pragma unroll
                for (int j = 0; j < 5; ++j) s4 = __builtin_amdgcn_mfma_f32_16x16x32_bf16(kf[j], qf[5 * g_ + j], s4, 0, 0, 0); }
            *(LAS f32x4*)(Sc + (16 * qg + l15) * SP + 16 * kg + 4 * g4) = s4; }
        __syncthreads();
        f32x4 sv[8];
#pragma unroll
        for (int i = 0; i < 8; ++i) sv[i] = *(const LAS f32x4*)(Sc + l31 * SP + 8 * i + 4 * hh);
        float mx = -INFINITY;
#pragma unroll
        for (int i = 0; i < 8; ++i) mx = fmaxf(mx, fmaxf(fmaxf(sv[i][0], sv[i][1]), fmaxf(sv[i][2], sv[i][3])));
        mx = fmaxf(mx, __shfl_xor(mx, 32));
        const float mn = fmaxf(m, mx);
        if (__builtin_amdgcn_ballot_w64(mn > m) != 0ull) {
            const float alpha = __builtin_amdgcn_exp2f((m - mn) * c2);
            lsum *= alpha;
#pragma unroll
            for (int i = 0; i < 16; ++i) o[i] *= alpha;
            m = mn;
        }
        const float nmc = -mn * c2;
        float ps = 0.f;
#pragma unroll
        for (int i = 0; i < 8; ++i)
#pragma unroll
            for (int e = 0; e < 4; ++e) { const float p = __builtin_amdgcn_exp2f(__builtin_fmaf(sv[i][e], c2, nmc)); sv[i][e] = p; ps += p; }
        lsum += ps;
#pragma unroll
        for (int ks = 0; ks < 4; ++ks) { const LAS unsigned char* a_ = kb_ + ((16 * ks + 4 * hh + q4) * KP + 32 * w + 16 * blk + 4 * p4) * 2;
            const s16x4 lo = vtr(a_), hi = vtr(a_ + 8 * KP * 2);
            const bf16x8 vf = __builtin_shufflevector(lo, hi, 0, 1, 2, 3, 4, 5, 6, 7); u32x4_t pk;
            pk.x = cvtpk(sv[2 * ks][0], sv[2 * ks][1]); pk.y = cvtpk(sv[2 * ks][2], sv[2 * ks][3]);
            pk.z = cvtpk(sv[2 * ks + 1][0], sv[2 * ks + 1][1]); pk.w = cvtpk(sv[2 * ks + 1][2], sv[2 * ks + 1][3]);
            o = MFMA32(vf, __builtin_bit_cast(bf16x8, pk), o); }
    };
    static_assert(MS_TILES % 2 == 0 && MS_TILES >= 4 && 2 * KBYTES + 32 * SP * 4 <= MISC_OFF, "mla_sample_unit pipeline");
#pragma unroll 1
    for (int t = 0; t < MS_TILES; t += 2) {
        tile(0);
        MS_STORE(1, crB, prB);
        if (t + 3 < MS_TILES) MS_LOAD(t + 3, crB, prB);
        __syncthreads();
        tile(1);
        if (t + 2 < MS_TILES) { MS_STORE(0, crA, prA); }
        if (t + 4 < MS_TILES) MS_LOAD(t + 4, crA, prA);
        __syncthreads();
    }
#undef MS_LOAD
#undef MS_STORE
    lsum += __shfl_xor(lsum, 32);
    const int item = b * MS_NSPLIT + split;
    if (w == 0 && lane < 32) { PML[(item * 32 + lane) * 2] = m * c2; PML[(item * 32 + lane) * 2 + 1] = lsum; }
#pragma unroll
    for (int i = 0; i < 16; ++i) PO[((size_t)item * 32 + l31) * KVL + 32 * w + crow(i, hh)] = o[i];
}


DI void ret_fused_phase(LAS unsigned char* lds, const bf16_t* __restrict__ RQt, const bf16_t* __restrict__ RKt, const bf16_t* __restrict__ RVT, bf16_t* __restrict__ ORETb, float* __restrict__ state_out, int bid, int G) {
    constexpr int PITCH = 136, KT_B = 128 * PITCH * 2, VT_B = 32 * PITCH * 2, NCH = SEQ / 128;
    int tid_ = threadIdx.x; asm volatile("" : "+v"(tid_));
    const int tid = tid_, lane = tid & 63, w = __builtin_amdgcn_readfirstlane(tid >> 6), l31 = lane & 31, hh = lane >> 5;
    const int ib = w < 4 ? 3 - (w >> 1) : (w >> 1) - 2, kh = w & 1;
    const int q4 = (lane & 15) >> 2, p4 = lane & 3, blk = (lane >> 4) & 1;
    LAS unsigned char* Kt = lds; LAS unsigned char* Vt = lds + KT_B; LAS unsigned char* SPl = Vt + VT_B; LAS float* RED = (LAS float*)(SPl + VT_B);
    static_assert(KT_B + 2 * VT_B + 4 * 16 * 64 * 4 <= MISC_OFF, "ret_fused_phase LDS");
    for (int v = bid; v < NB * RH * 8; v += G) {
        const int it = ((v & 7) * 4 + (v >> 6)) * 8 + ((v >> 3) & 7);
        const int ds = it & 7, h = (it >> 3) & 3, b = it >> 5; const float g128 = __expf(128.f * lg_gamma(h));
        f32x16 S;
#pragma unroll
        for (int i = 0; i < 16; ++i) S[i] = 0.f;
        u32x4_t kregA[4], vregA, kregB[4], vregB;
        const unsigned voffk = (unsigned)(((tid >> 4) * 512 + 8 * (tid & 15)) * 2), voffv = (unsigned)(((tid >> 4) * NT + 8 * (tid & 15)) * 2), voffq = (unsigned)((l31 * 512 + 8 * hh) * 2), voffo = (unsigned)((l31 * 1024 + 4 * hh) * 2);
#define RF_LOAD(c_, kreg, vreg) do { const size_t tok0_ = (size_t)b * SEQ + (c_) * 128; const char* kb_ = (const char*)(RKt + tok0_ * 512 + h * RDK); \
            _Pragma("unroll") for (int i_ = 0; i_ < 4; ++i_) kreg[i_] = *(const u32x4_t*)(kb_ + (size_t)i_ * (32 * 512 * 2) + voffk); \
            vreg = *(const u32x4_t*)((const char*)(RVT + (size_t)(h * RDV + 32 * ds) * NT + tok0_) + voffv); } while (0)
#define RF_LOADQ(c_, Q_) do { const char* qb_ = (const char*)(RQt + ((size_t)b * SEQ + (c_) * 128 + 32 * ib) * 512 + h * RDK + 64 * kh); _Pragma("unroll") for (int s_ = 0; s_ < 4; ++s_) Q_[s_] = *(const bf16x8*)(qb_ + 32 * s_ + voffq); } while (0)
        bf16x8 qf[4], qfnA[4], qfnB[4];
        RF_LOAD(0, kregA, vregA); RF_LOADQ(0, qfnA); RF_LOAD(1, kregB, vregB); RF_LOADQ(1, qfnB);
        __syncthreads();
        for (int i = tid; i < VT_B / 16; i += NTHREADS) *(LAS u32x4_t*)(SPl + i * 16) = (u32x4_t){0u, 0u, 0u, 0u};
        u32x2_t opk[2] = {{0u, 0u}, {0u, 0u}};
#define RF_FLUSH(c_) do { char* ob_ = (char*)(ORETb + ((size_t)b * SEQ + (c_) * 128 + 32 * ib) * 1024 + h * RDV + 32 * ds + 16 * kh); \
            *(u32x2_t*)(ob_ + voffo) = opk[0]; *(u32x2_t*)(ob_ + 16 + voffo) = opk[1]; } while (0)
        auto chunk = [&](const int c, u32x4_t (&kreg)[4], u32x4_t& vreg, bf16x8 (&qfn)[4]) __attribute__((always_inline)) {
#pragma unroll
            for (int i = 0; i < 4; ++i) { const int p = tid + i * NTHREADS; *(LAS u32x4_t*)(Kt + ((p >> 4) * PITCH + 8 * (p & 15)) * 2) = kreg[i]; }
            *(LAS u32x4_t*)(Vt + ((tid >> 4) * PITCH + 8 * (tid & 15)) * 2) = vreg;
#pragma unroll
            for (int s_ = 0; s_ < 4; ++s_) qf[s_] = qfn[s_];
            __syncthreads();
            RF_FLUSH(c > 0 ? c - 1 : 0);
            { const int cn = c + 2 < NCH ? c + 2 : NCH - 1; RF_LOAD(cn, kreg, vreg); RF_LOADQ(cn, qfn); }
            f32x16 o;
#pragma unroll
            for (int i = 0; i < 16; ++i) o[i] = 0.f;
#pragma unroll 1
            for (int jb = 0; jb <= ib; ++jb) {
                f32x16 x;
#pragma unroll
                for (int i = 0; i < 16; ++i) x[i] = 0.f;
#pragma unroll
                for (int s_ = 0; s_ < 4; ++s_) { const bf16x8 kf = *(const LAS bf16x8*)(Kt + ((32 * jb + l31) * PITCH + 64 * kh + 16 * s_ + 8 * hh) * 2); x = MFMA32(kf, qf[s_], x); }
                if (jb == ib) {
#pragma unroll
                    for (int i = 0; i < 16; ++i) x[i] = (crow(i, hh) <= l31) ? x[i] : 0.f;
                }
#pragma unroll
                for (int s2 = 0; s2 < 2; ++s2) {
                    u32x4_t pk; pk.x = cvtpk(x[8 * s2 + 0], x[8 * s2 + 1]); pk.y = cvtpk(x[8 * s2 + 2], x[8 * s2 + 3]); pk.z = cvtpk(x[8 * s2 + 4], x[8 * s2 + 5]); pk.w = cvtpk(x[8 * s2 + 6], x[8 * s2 + 7]);
                    const LAS unsigned char* vp = Vt + (l31 * PITCH + 32 * jb + 16 * s2 + 4 * hh) * 2;
                    const s16x4 lo = *(const LAS s16x4*)vp, hi = *(const LAS s16x4*)(vp + 16);
                    o = MFMA32(__builtin_shufflevector(lo, hi, 0, 1, 2, 3, 4, 5, 6, 7), __builtin_bit_cast(bf16x8, pk), o); }
            }
#pragma unroll
            for (int s_ = 0; s_ < 4; ++s_) { const bf16x8 sf = *(const LAS bf16x8*)(SPl + (l31 * PITCH + 64 * kh + 16 * s_ + 8 * hh) * 2); o = MFMA32(sf, qf[s_], o); }
#pragma unroll
            for (int i = 0; i < 8; ++i) RED[((ib * 2 + kh) * 8 + i) * 64 + lane] = kh ? o[i] : o[8 + i];
            if (w < 4) {
                f32x16 u;
#pragma unroll
                for (int i = 0; i < 16; ++i) u[i] = 0.f;
#pragma unroll
                for (int s_ = 0; s_ < 8; ++s_) { const LAS unsigned char* a_ = Kt + ((16 * s_ + 4 * hh + q4) * PITCH + 32 * w + 16 * blk + 4 * p4) * 2;
                    const s16x4 alo = vtr(a_), ahi = vtr(a_ + 8 * PITCH * 2);
                    const LAS unsigned char* vp = Vt + (l31 * PITCH + 16 * s_ + 4 * hh) * 2;
                    const s16x4 blo = *(const LAS s16x4*)vp, bhi = *(const LAS s16x4*)(vp + 16);
                    u = MFMA32(__builtin_shufflevector(alo, ahi, 0, 1, 2, 3, 4, 5, 6, 7), __builtin_shufflevector(blo, bhi, 0, 1, 2, 3, 4, 5, 6, 7), u); }
#pragma unroll
                for (int i = 0; i < 16; ++i) S[i] = S[i] * g128 + u[i];
            }
            __syncthreads();
#pragma unroll
            for (int g = 0; g < 2; ++g) { const LAS float* rp = RED + ((ib * 2 + (kh ^ 1)) * 8 + 4 * g) * 64 + lane;
                const float o0 = (kh ? o[8 + 4 * g + 0] : o[4 * g + 0]) + rp[0], o1 = (kh ? o[8 + 4 * g + 1] : o[4 * g + 1]) + rp[64], o2 = (kh ? o[8 + 4 * g + 2] : o[4 * g + 2]) + rp[128], o3 = (kh ? o[8 + 4 * g + 3] : o[4 * g + 3]) + rp[192];
                opk[g] = (u32x2_t){cvtpk(o0, o1), cvtpk(o2, o3)}; }
            if (w < 4) {
#pragma unroll
                for (int g = 0; g < 4; ++g) *(LAS u32x2_t*)(SPl + (l31 * PITCH + 32 * w + 8 * g + 4 * hh) * 2) = (u32x2_t){cvtpk(S[4 * g + 0] * g128, S[4 * g + 1] * g128), cvtpk(S[4 * g + 2] * g128, S[4 * g + 3] * g128)};
            }
                };
        static_assert(NCH % 2 == 0, "chunk pairs");
#pragma unroll 1
        for (int c = 0; c < NCH; c += 2) { chunk(c, kregA, vregA, qfnA); chunk(c + 1, kregB, vregB, qfnB); }
        RF_FLUSH(NCH - 1);
#undef RF_LOAD
#undef RF_LOADQ
#undef RF_FLUSH
        if (w < 4) {
            float* so = state_out + ((size_t)(b * RH + h) * RDK + 32 * w) * RDV + 32 * ds + l31;
#pragma unroll
            for (int i = 0; i < 16; ++i) so[(size_t)crow(i, hh) * RDV] = S[i];
        }
    }
}

struct QPtr { const float* p; DI float operator()(int d) const { return p[d]; } };
struct QMla { const float* ql; const float* qp; DI float operator()(int d) const { return d < KVL ? ql[d] : qp[d - KVL]; } };
DI void rms_row(const float* x, const float* g, float* o, int n, int lane) {
    float s = 0.f;
    for (int i = lane; i < n; i += 64) { const float v = x[i]; s += v * v; }
    const float r = rsqrtf(wave_sum(s) / (float)n + EPS);
    for (int i = lane; i < n; i += 64) o[i] = x[i] * r * g[i];
}

DI void rms_row_bf16(const float* x, const float* g, bf16_t* o, int n, int lane) {
    float s = 0.f;
    for (int i = lane; i < n; i += 64) { const float v = x[i]; s += v * v; }
    const float r = rsqrtf(wave_sum(s) / (float)n + EPS);
    for (int i = lane; i < n; i += 64) o[i] = f2bf(x[i] * r * g[i]);
}
#define GEMM_PHASE(EPI, ...) pg8::gemm_phase<EPI, pg8::StaticOrder, true, true>(__VA_ARGS__)
#define GEMM_SPLIT(...) pg8::gemm_phase<pg8::EpiPart, pg8::SplitOrder, true, true>(__VA_ARGS__)
__global__ void __launch_bounds__(NTHREADS, 2) fwd_kernel(Args args) {
    extern __shared__ __attribute__((aligned(16))) unsigned char lds_raw[];
    LAS unsigned char* ldsb = (LAS unsigned char*)lds_raw;
    LAS float* lds = (LAS float*)ldsb;
    volatile LAS unsigned* MISC = (volatile LAS unsigned*)(ldsb + MISC_OFF);
    const int tid = threadIdx.x, lane = tid & 63, wave = tid >> 6;
    const int G = gridDim.x, bid = blockIdx.x;
    const int gw = bid * NWAVES + wave, NGW = G * NWAVES;
    unsigned char* ws = args.ws;
    float* out = args.out;
    const int lo = args.ph_lo, hi = args.ph_hi;

    if (tid < 64) MISC[tid] = 0u;
    __syncthreads();
    XcdBarrier bar; bar.bar = (unsigned*)(ws + WS_CTL) + CW_BAR; bar.x = 0; bar.st = MISC;
    if (hi - lo > 1) bar = xcd_barrier_post((unsigned*)(ws + WS_CTL) + CW_BAR, MISC);
#define IN(k) (lo <= (k) && (k) < hi)
#define PHASE_IDS int tid_l_ = threadIdx.x; asm volatile("" : "+v"(tid_l_)); const int tid = tid_l_, lane = tid & 63, wave = tid >> 6, gw = bid * NWAVES + wave; (void)tid; (void)lane; (void)wave; (void)gw;
#define SEAM(k) do { if (IN(k) && IN((k) + 1)) xcd_barrier(bar); } while (0)

#define x_prompt ((const float*)(args.in[0]))
#define x_sample ((const float*)(args.in[1]))
#define mem_prompt ((const float*)(args.in[2]))
#define cache_ckv ((const float*)(args.in[3]))
#define cache_kpe ((const float*)(args.in[4]))
#define page_table ((const int*)args.in[5])
#define state_ret ((const float*)(args.in[6]))
#define cache_mem_k ((const float*)(args.in[7]))
#define cache_mem_v ((const float*)(args.in[8]))
#define g_mix_pre ((const float*)(args.in[9]))
#define g_mix_post ((const float*)(args.in[10]))
#define g_ffn_pre ((const float*)(args.in[11]))
#define g_ffn_post ((const float*)(args.in[12]))
#define g_mem ((const float*)(args.in[13]))
#define g_qlat ((const float*)(args.in[14]))
#define g_kvlat ((const float*)(args.in[15]))
#define w_in ((const float*)(args.in[16]))
#define w_uq ((const float*)(args.in[17]))
#define w_uk ((const float*)(args.in[18]))
#define w_uv ((const float*)(args.in[19]))
#define w_mem_k ((const float*)(args.in[20]))
#define w_mem_v ((const float*)(args.in[21]))
#define w_ret_o ((const float*)(args.in[22]))
#define w_mla_o ((const float*)(args.in[23]))
#define w_x_o ((const float*)(args.in[24]))
#define w_out ((const float*)(args.in[25]))
#define w_gate ((const float*)(args.in[26]))
#define w_up ((const float*)(args.in[27]))
#define w_down ((const float*)(args.in[28]))
#define COSA ((float*)(ws + WS_COSA))
#define SINA ((float*)(ws + WS_SINA))
#define COSB ((float*)(ws + WS_COSB))
#define SINB ((float*)(ws + WS_SINB))
#define U ((float*)(ws + WS_U))
#define MN ((float*)(ws + WS_MN))
#define Zb ((bf16_t*)(ws + WS_Z))
#define RQ ((float*)(ws + WS_RQ))
#define RK ((float*)(ws + WS_RK))
#define CQN ((float*)(ws + WS_CQN))
#define CKVN ((float*)(ws + WS_CKVN))
#define KPER ((float*)(ws + WS_KPER))
#define Q ((float*)(ws + WS_Q))
#define QLAT ((float*)(ws + WS_QLAT))
#define QPE ((float*)(ws + WS_QPE))
#define ORETb ((bf16_t*)(ws + WS_ORET))
#define OLAT ((float*)(ws + WS_OLAT))
#define OX ((float*)(ws + WS_OX))
#define OMLA ((float*)(ws + WS_OMLA))
#define ORETN ((float*)(ws + WS_ORETN))
#define ARET ((float*)(ws + WS_ARET))
#define AMLA ((float*)(ws + WS_AMLA))
#define AX ((float*)(ws + WS_AX))
#define MIX ((float*)(ws + WS_MIX))
#define HPb ((bf16_t*)(ws + WS_HP))
#define Hb ((bf16_t*)(ws + WS_H))
#define F ((float*)(ws + WS_F))
#define GU ((float*)(ws + WS_GG))
#define FOb ((bf16_t*)(ws + WS_FO))
#define WinT ((bf16_t*)(ws + WS_WIN_T))
#define WmkvT ((bf16_t*)(ws + WS_WMKV_T))
#define WuqT ((bf16_t*)(ws + WS_WUQABS))
#define WabsT ((bf16_t*)(ws + WS_WUQABS) + (size_t)1536 * 384)
#define WcatT ((bf16_t*)(ws + WS_WRO_T))
#define CATb ((bf16_t*)(ws + WS_ORETNB))
#define WroT ((bf16_t*)(ws + WS_WRO_T))
#define WmoT ((bf16_t*)(ws + WS_WMO_T))
#define WxoT ((bf16_t*)(ws + WS_WXO_T))
#define WoT ((bf16_t*)(ws + WS_WO_T))
#define WguT ((bf16_t*)(ws + WS_WGU_T))
#define WdT ((bf16_t*)(ws + WS_WD_T))
#define Ub ((bf16_t*)(ws + WS_UB))
#define MNb ((bf16_t*)(ws + WS_MNB))
#define CQNb ((bf16_t*)(ws + WS_CQNB))
#define ORETNb ((bf16_t*)(ws + WS_ORETNB))
#define OMLAb ((bf16_t*)(ws + WS_OMLAB))
#define OXb ((bf16_t*)(ws + WS_OXB))
#define MIXb ((bf16_t*)(ws + WS_MIXB))
#define Fb ((bf16_t*)(ws + WS_FB))
#define ACTb ((bf16_t*)(ws + WS_ACTB))
#define WukT ((bf16_t*)(ws + WS_WUK_T))
#define WuvT ((bf16_t*)(ws + WS_WUV_T))
#define CKVNb ((bf16_t*)(ws + WS_CKVNB))
#define KPERb ((bf16_t*)(ws + WS_KPERB))
#define XQb ((bf16_t*)(ws + WS_XQB))
#define MKb ((bf16_t*)(ws + WS_MKB))
#define MVT ((bf16_t*)(ws + WS_MVT))
#define KN ((bf16_t*)(ws + WS_KN))
#define VT ((bf16_t*)(ws + WS_VT))
#define Qb ((bf16_t*)(ws + WS_QB))
#define RQt ((bf16_t*)(ws + WS_RQT))
#define RKt ((bf16_t*)(ws + WS_RKT))
#define RKtT ((bf16_t*)(ws + WS_RKTT))
#define RVT ((bf16_t*)(ws + WS_RVT))
#define UT ((float*)(ws + WS_UT))
#define SPT ((bf16_t*)(ws + WS_SPT))
#define QPEb ((bf16_t*)(ws + WS_QPEB))
#define WukB ((bf16_t*)(ws + WS_WUKB))
#define PART ((float*)(ws + WS_PART))
#define SGb ((bf16_t*)(ws + WS_SGB))
#define SRGb ((bf16_t*)(ws + WS_SRGB))
#define T0b ((bf16_t*)(ws + WS_T0B))
#define T1b ((bf16_t*)(ws + WS_T1B))
#define QLATb ((bf16_t*)(ws + WS_QLATB))
#define PO ((float*)(ws + WS_PO))
#define PML ((float*)(ws + WS_PML))
    if (IN(0)) { PHASE_IDS
        for (int i = bid * NTHREADS + tid; i < NPOS * 64 + NPOS * 32; i += G * NTHREADS) {
            const bool a = i < NPOS * 64; const int j = a ? i : i - NPOS * 64; const int half = a ? 64 : 32;
            const int p = j / half, f = j % half; const int pos = p < SEQ ? p : PAST + (p - SEQ);
            const float inv = powf(10000.0f, -(float)f / (float)half);
            const float ang = (float)pos * inv;
            double rev = (double)ang * 0.15915494309189535; rev -= floor(rev);
            const float r = (float)rev;
            const float sn = __builtin_amdgcn_sinf(r), cs = __builtin_amdgcn_cosf(r);
            if (a) { COSA[j] = cs; SINA[j] = sn; } else { COSB[j] = cs; SINB[j] = sn; }
        }
#pragma unroll 1
        for (int pass = 0; pass < 2; ++pass) {
            const int nrows = pass ? NB * NMEM : NT; const float* gsrc = pass ? g_mem : g_mix_pre; bf16_t* dst = pass ? MNb : Ub;
#define P0_SRC(r_) (pass ? mem_prompt + (size_t)(r_) * DM : (r_) < NP ? x_prompt + (size_t)(r_) * DM : x_sample + (size_t)((r_) - NP) * DM)
#define P0_LOAD(r_, A_) do { const float* s_ = P0_SRC(r_); _Pragma("unroll") for (int j_ = 0; j_ < 4; ++j_) A_[j_] = *(const f32x4*)(s_ + 4 * lane + 256 * j_); } while (0)
            f32x4 gv[4];
#pragma unroll
            for (int j = 0; j < 4; ++j) gv[j] = *(const f32x4*)(gsrc + 4 * lane + 256 * j);
#pragma unroll 1
            for (int row0 = gw; row0 < nrows; row0 += 4 * NGW) {
                f32x4 a[4][4];
#pragma unroll
                for (int k = 0; k < 4; ++k) { const int r = row0 + k * NGW; if (r < nrows) P0_LOAD(r, a[k]); }
#pragma unroll
                for (int k = 0; k < 4; ++k) { const int r = row0 + k * NGW;
                    if (r < nrows) { float ss = 0.f;
#pragma unroll
                        for (int j = 0; j < 4; ++j) ss += a[k][j][0] * a[k][j][0] + a[k][j][1] * a[k][j][1] + a[k][j][2] * a[k][j][2] + a[k][j][3] * a[k][j][3];
                        const float rs = rsqrtf(wave_sum(ss) * (1.f / DM) + EPS);
#pragma unroll
                        for (int j = 0; j < 4; ++j) { const f32x4 v = a[k][j] * rs * gv[j]; *(u32x2_t*)(dst + (size_t)r * DM + 4 * lane + 256 * j) = (u32x2_t){cvtpk(v[0], v[1]), cvtpk(v[2], v[3])}; } } }
            }
#undef P0_LOAD
#undef P0_SRC
        }
        {
            LAS float* scr = lds + wave * (64 * 33);
            int rot = 0;
            transpose_w(w_in, 1024, DIN, WinT, 1024, 0, scr, gw, NGW, lane, rot);
            for (int i = bid * NTHREADS + tid; i < (ZLD - DIN) * 1024 / 2; i += G * NTHREADS) ((unsigned*)(WinT + (size_t)DIN * 1024))[i] = 0u;
            transpose_w(w_mem_k, 1024, 256, WmkvT, 1024, 0, scr, gw, NGW, lane, rot);
            transpose_w(w_mem_v, 1024, 256, WmkvT, 1024, 256, scr, gw, NGW, lane, rot);
            transpose_w(w_uq, QL, 1536, WuqT, QL, 0, scr, gw, NGW, lane, rot);
            for (int hh = 0; hh < MH; ++hh) { transpose_w(w_uk + (size_t)hh * KVL * DNOPE, KVL, DNOPE, WukT, KVL, hh * DNOPE, scr, gw, NGW, lane, rot);
                                              transpose_w(w_uv + (size_t)hh * KVL * DVH, KVL, DVH, WuvT, KVL, hh * DVH, scr, gw, NGW, lane, rot); }
        }
    }
    SEAM(0);
    if (IN(1)) {
        static_assert(WS_MNB == WS_UB + (size_t)NT * 1024 * 2 && WS_WMKV_T == WS_WIN_T + (size_t)ZLD * 1024 * 2, "P1 stacks Ub|MNb and WinT|WmkvT");
        { pg8::Gemm g{Ub, WinT, NT + NB * NMEM, ZLD + 512, 1024, 1024, 1024}; pg8::P1Order S; S.init(G, bid); pg8::EpiP1 E{Zb, ZLD, out + O_MKP, out + O_MVP, SRGb, SGb, C_RG, C_G};
          pg8::gemm_phase<pg8::EpiP1, pg8::P1Order, true, true>(ldsb, g, S, E); }
        __syncthreads();
        if (bid >= 72 || G != 256) {
            const int fb = G == 256 ? bid - 72 : bid, FG = G == 256 ? G - 72 : G; const int lane = threadIdx.x & 63, wave = threadIdx.x >> 6, gw = fb * NWAVES + wave, NGW = FG * NWAVES;
            LAS float* scr = lds + wave * (64 * 33);
            int rot = 0;
            transpose_w(w_gate, 1024, DFF, WguT, 1024, 0, scr, gw, NGW, lane, rot, 2);
            transpose_w(w_up, 1024, DFF, WguT, 1024, 1, scr, gw, NGW, lane, rot, 2);
            transpose_w(w_down, DFF, 1024, WdT, DFF, 0, scr, gw, NGW, lane, rot);
            transpose_w(w_ret_o, 1024, 1024, WcatT, CATLD, 0, scr, gw, NGW, lane, rot);
            transpose_w(w_mla_o, 1024, 1024, WcatT + 1024, CATLD, 0, scr, gw, NGW, lane, rot);
            transpose_w(w_x_o, 256, 1024, WcatT + 2048, CATLD, 0, scr, gw, NGW, lane, rot);
            transpose_w(w_out, 1024, 1024, WoT, 1024, 0, scr, gw, NGW, lane, rot);
            for (int wt = gw; wt < MH * 8 * 12; wt += NGW) {
                const int cb_ = wt % 12, lb_ = (wt / 12) & 7, head = wt / 96, l31 = lane & 31, h8 = lane >> 5;
                f32x16 acc;
#pragma unroll
                for (int i = 0; i < 16; ++i) acc[i] = 0.f;
                const float* ap = w_uk + ((size_t)head * KVL + 32 * lb_ + l31) * DNOPE + 8 * h8;
                const float* bp = w_uq + (size_t)(32 * cb_ + l31) * 1536 + head * DQH + 8 * h8;
#pragma unroll
                for (int s_ = 0; s_ < 8; ++s_) { const f32x4 a0 = *(const f32x4*)(ap + 16 * s_), a1 = *(const f32x4*)(ap + 16 * s_ + 4), b0 = *(const f32x4*)(bp + 16 * s_), b1 = *(const f32x4*)(bp + 16 * s_ + 4);
                    const u32x4_t ua = {cvtpk(a0[0], a0[1]), cvtpk(a0[2], a0[3]), cvtpk(a1[0], a1[1]), cvtpk(a1[2], a1[3])}, ub = {cvtpk(b0[0], b0[1]), cvtpk(b0[2], b0[3]), cvtpk(b1[0], b1[1]), cvtpk(b1[2], b1[3])};
                    acc = MFMA32(__builtin_bit_cast(bf16x8, ua), __builtin_bit_cast(bf16x8, ub), acc); }
#pragma unroll
                for (int i = 0; i < 16; ++i) WabsT[((size_t)head * KVL + 32 * lb_ + crow(i, h8)) * QL + 32 * cb_ + l31] = f2bf(acc[i]);
            }
        }
        __syncthreads();
        { pg8::Gemm g{WinT + (size_t)C_RV * 1024, Ub, 1024, NP, 1024, 1024, 1024}; pg8::StaticOrder S; S.init(1024, NP, G, bid); pg8::EpiBf16S E{RVT, NT};
          GEMM_PHASE(pg8::EpiBf16S, ldsb, g, S, E); }
    }
    SEAM(1);
    if (IN(2)) { PHASE_IDS
        {   constexpr int row_base = 0;
            {
                const int hq = lane >> 4, f4 = (lane & 15) * 4;
                u32x2_t q1, q2, k1, k2, cv, p1, p2; u32x4_t cq8; f32x4 ca, sa, cb, sb; int p;
#define P2_LOAD(r_, Q1_, Q2_, K1_, K2_, CQ_, CV_, P1_, P2_, CA_, SA_, CB_, SB_, P_) do { const bf16_t* z_ = Zb + (size_t)(row_base + (r_)) * ZLD; P_ = pos_index(row_base + (r_)); \
                Q1_ = *(const u32x2_t*)(z_ + C_RQ + hq * RDK + f4); Q2_ = *(const u32x2_t*)(z_ + C_RQ + hq * RDK + 64 + f4); K1_ = *(const u32x2_t*)(z_ + C_RK + hq * RDK + f4); K2_ = *(const u32x2_t*)(z_ + C_RK + hq * RDK + 64 + f4); \
                CQ_ = (u32x4_t){0u, 0u, 0u, 0u}; if (lane < 48) CQ_ = *(const u32x4_t*)(z_ + C_CQ + 8 * lane); CV_ = *(const u32x2_t*)(z_ + C_CKV + 4 * lane); \
                P1_ = (u32x2_t){0u, 0u}; P2_ = P1_; CB_ = (f32x4){0.f, 0.f, 0.f, 0.f}; SB_ = CB_; \
                if (lane < 8) { P1_ = *(const u32x2_t*)(z_ + C_KPE + 4 * lane); P2_ = *(const u32x2_t*)(z_ + C_KPE + 32 + 4 * lane); CB_ = *(const f32x4*)(COSB + P_ * 32 + 4 * lane); SB_ = *(const f32x4*)(SINB + P_ * 32 + 4 * lane); } \
                CA_ = *(const f32x4*)(COSA + P_ * 64 + f4); SA_ = *(const f32x4*)(SINA + P_ * 64 + f4); } while (0)
#define BLO(x_) __builtin_bit_cast(float, (x_) << 16)
#define BHI(x_) __builtin_bit_cast(float, (x_) & 0xffff0000u)
                int r = gw;
                if (r < NT) P2_LOAD(r, q1, q2, k1, k2, cq8, cv, p1, p2, ca, sa, cb, sb, p);
                for (; r < NT; r += NGW) {
                    u32x2_t q1n, q2n, k1n, k2n, cvn, p1n, p2n; u32x4_t cq8n; f32x4 can, san, cbn, sbn; int pn;
                    if (r + NGW < NT) P2_LOAD(r + NGW, q1n, q2n, k1n, k2n, cq8n, cvn, p1n, p2n, can, san, cbn, sbn, pn);
                    const int row = row_base + r; const int il = p & 127; const bool prompt = row < NP;
                    {
                        const float x1q[4] = {BLO(q1.x), BHI(q1.x), BLO(q1.y), BHI(q1.y)}, x2q[4] = {BLO(q2.x), BHI(q2.x), BLO(q2.y), BHI(q2.y)};
                        const float x1k[4] = {BLO(k1.x), BHI(k1.x), BLO(k1.y), BHI(k1.y)}, x2k[4] = {BLO(k2.x), BHI(k2.x), BLO(k2.y), BHI(k2.y)};
                        const float sc = 0.08838834764831845f;
                        float oq1[4], oq2[4], ok1[4], ok2[4];
#pragma unroll
                        for (int e = 0; e < 4; ++e) { oq1[e] = x1q[e] * ca[e] - x2q[e] * sa[e]; oq2[e] = x1q[e] * sa[e] + x2q[e] * ca[e];
                            ok1[e] = (x1k[e] * ca[e] - x2k[e] * sa[e]) * sc; ok2[e] = (x1k[e] * sa[e] + x2k[e] * ca[e]) * sc; }
                        if (prompt) {
                            const float fq = __expf((float)(il - 127) * lg_gamma(hq)), fk = 1.f / fq;
                            *(u32x2_t*)(RQt + (size_t)row * 512 + hq * RDK + f4) = (u32x2_t){cvtpk(oq1[0] * fq, oq1[1] * fq), cvtpk(oq1[2] * fq, oq1[3] * fq)};
                            *(u32x2_t*)(RQt + (size_t)row * 512 + hq * RDK + 64 + f4) = (u32x2_t){cvtpk(oq2[0] * fq, oq2[1] * fq), cvtpk(oq2[2] * fq, oq2[3] * fq)};
                            const u32x2_t kb1 = {cvtpk(ok1[0] * fk, ok1[1] * fk), cvtpk(ok1[2] * fk, ok1[3] * fk)}, kb2 = {cvtpk(ok2[0] * fk, ok2[1] * fk), cvtpk(ok2[2] * fk, ok2[3] * fk)};
                            *(u32x2_t*)(RKt + (size_t)row * 512 + hq * RDK + f4) = kb1; *(u32x2_t*)(RKt + (size_t)row * 512 + hq * RDK + 64 + f4) = kb2;
                        } else {
                            *(f32x4*)(RQ + (size_t)row * 512 + hq * RDK + f4) = (f32x4){oq1[0], oq1[1], oq1[2], oq1[3]}; *(f32x4*)(RQ + (size_t)row * 512 + hq * RDK + 64 + f4) = (f32x4){oq2[0], oq2[1], oq2[2], oq2[3]};
                            *(f32x4*)(RK + (size_t)row * 512 + hq * RDK + f4) = (f32x4){ok1[0], ok1[1], ok1[2], ok1[3]}; *(f32x4*)(RK + (size_t)row * 512 + hq * RDK + 64 + f4) = (f32x4){ok2[0], ok2[1], ok2[2], ok2[3]};
                        }
                    }
                    {
                        const float c_[8] = {BLO(cq8.x), BHI(cq8.x), BLO(cq8.y), BHI(cq8.y), BLO(cq8.z), BHI(cq8.z), BLO(cq8.w), BHI(cq8.w)};
                        float ss = 0.f;
#pragma unroll
                        for (int e = 0; e < 8; ++e) ss += c_[e] * c_[e];
                        const float rr = rsqrtf(wave_sum(ss) * (1.f / QL) + EPS);
                        if (lane < 48) { const f32x4 g0 = *(const f32x4*)(g_qlat + 8 * lane), g1 = *(const f32x4*)(g_qlat + 8 * lane + 4);
                            *(u32x4_t*)(CQNb + (size_t)row * QL + 8 * lane) = (u32x4_t){cvtpk(c_[0] * rr * g0[0], c_[1] * rr * g0[1]), cvtpk(c_[2] * rr * g0[2], c_[3] * rr * g0[3]),
                                                                                     cvtpk(c_[4] * rr * g1[0], c_[5] * rr * g1[1]), cvtpk(c_[6] * rr * g1[2], c_[7] * rr * g1[3])}; }
                    }
                    {
                        const float v_[4] = {BLO(cv.x), BHI(cv.x), BLO(cv.y), BHI(cv.y)};
                        const float rr = rsqrtf(wave_sum(v_[0] * v_[0] + v_[1] * v_[1] + v_[2] * v_[2] + v_[3] * v_[3]) * (1.f / KVL) + EPS);
                        const f32x4 g0 = *(const f32x4*)(g_kvlat + 4 * lane); const f32x4 o_ = {v_[0] * rr * g0[0], v_[1] * rr * g0[1], v_[2] * rr * g0[2], v_[3] * rr * g0[3]};
                        float* ockv = row < NP ? out + O_CKVP + (size_t)row * KVL : out + O_CKVS + (size_t)(row - NP) * KVL;
                        *(f32x4*)(ockv + 4 * lane) = o_; if (!prompt) *(f32x4*)(CKVN + (size_t)row * KVL + 4 * lane) = o_;
                        *(u32x2_t*)(CKVNb + (size_t)row * KVL + 4 * lane) = (u32x2_t){cvtpk(o_[0], o_[1]), cvtpk(o_[2], o_[3])};
                    }
                    if (lane < 8) {
                        const float x1[4] = {BLO(p1.x), BHI(p1.x), BLO(p1.y), BHI(p1.y)}, x2[4] = {BLO(p2.x), BHI(p2.x), BLO(p2.y), BHI(p2.y)};
                        f32x4 o1, o2;
#pragma unroll
                        for (int e = 0; e < 4; ++e) { o1[e] = x1[e] * cb[e] - x2[e] * sb[e]; o2[e] = x1[e] * sb[e] + x2[e] * cb[e]; }
                        if (!prompt) { *(f32x4*)(KPER + (size_t)row * DROPE + 4 * lane) = o1; *(f32x4*)(KPER + (size_t)row * DROPE + 32 + 4 * lane) = o2; }
                        float* okpe = row < NP ? out + O_KPEP + (size_t)row * DROPE : out + O_KPES + (size_t)(row - NP) * DROPE;
                        *(f32x4*)(okpe + 4 * lane) = o1; *(f32x4*)(okpe + 32 + 4 * lane) = o2;
                        *(u32x2_t*)(KPERb + (size_t)row * DROPE + 4 * lane) = (u32x2_t){cvtpk(o1[0], o1[1]), cvtpk(o1[2], o1[3])}; *(u32x2_t*)(KPERb + (size_t)row * DROPE + 32 + 4 * lane) = (u32x2_t){cvtpk(o2[0], o2[1]), cvtpk(o2[2], o2[3])};
                    }
                    q1 = q1n; q2 = q2n; k1 = k1n; k2 = k2n; cq8 = cq8n; cv = cvn; p1 = p1n; p2 = p2n; ca = can; sa = san; cb = cbn; sb = sbn; p = pn;
                }
#undef P2_LOAD
            }
        }
    }
    if (IN(2)) { PHASE_IDS
        for (int i = bid * NTHREADS + tid; i < NB * NMEM * 256; i += G * NTHREADS) { MKb[i] = f2bf(out[O_MKP + i]);
            const int f = i / (NB * NMEM), r = i - f * (NB * NMEM); MVT[i] = f2bf(out[O_MVP + (size_t)r * 256 + f]); }
    }
    SEAM(2);
    if (IN(3)) { pg8::Gemm g{CQNb, WuqT, NT, 1536 + 2048, QL, QL, QL}; pg8::P3Order S; S.init(G, bid); pg8::EpiQ E{Qb, QLATb, NP};
        pg8::gemm_phase<pg8::EpiQ, pg8::P3Order, true, true>(ldsb, g, S, E);
        __syncthreads();
        { pg8::Gemm g2{CKVNb, WukT, NP, 1024, KVL, KVL, KVL}; pg8::StaticOrder S2; S2.init(NP, 1024, G, bid); pg8::EpiBf16S E2{KN, 1024}; GEMM_PHASE(pg8::EpiBf16S, ldsb, g2, S2, E2); }
        __syncthreads();
        { pg8::Gemm g3{WuvT, CKVNb, 1024, NP, KVL, KVL, KVL}; pg8::StaticOrder S3; S3.init(1024, NP, G, bid); pg8::EpiBf16S E3{VT, NP}; GEMM_PHASE(pg8::EpiBf16S, ldsb, g3, S3, E3); }
        }
    SEAM(3);
    if (IN(5)) { PHASE_IDS
        auto compute_units = [&]() __attribute__((always_inline)) {
        if (args.sub & 2) for (int v = bid; v < NB * MH * 4; v += G) {
            const int it = ((v & 7) * 8 + (v >> 5)) * 4 + ((v >> 3) & 3);
            const int pr = __builtin_amdgcn_readfirstlane(it & 3), hh = __builtin_amdgcn_readfirstlane((it >> 2) & 7), b = __builtin_amdgcn_readfirstlane(it >> 5);
#pragma unroll 1
            for (int half = 0; half < 2; ++half) { const int qb = __builtin_amdgcn_readfirstlane(half ? pr : 7 - pr); const size_t row0 = (size_t)b * SEQ + qb * 256;
                SrcMlaP src{KN, KPERb, VT, Qb, COSB, SINB, b, hh, row0};
                flash_unit<192, 128, true>(ldsb, src, qb * 256, 4 * (qb + 1), CATb + row0 * CATLD + 1024 + hh * DVH, CATLD, 0.07216878364870322f * 1.4426950408889634f); }
        }
        if (args.sub & 4) ret_fused_phase(ldsb, RQt, RKt, RVT, ORETb, out + O_RETP, bid, G);
        if (args.sub & 16) for (int it = bid; it < NB * XH * 8; it += G) {
            const int qb = __builtin_amdgcn_readfirstlane(it & 7), hh = __builtin_amdgcn_readfirstlane((it >> 3) & 3), b = __builtin_amdgcn_readfirstlane(it >> 5); const size_t row0 = (size_t)b * SEQ + qb * 256;
            SrcMemP src{MKb, MVT, Zb + C_XQ, b, hh, row0};
            flash_unit<64, 64, false>(ldsb, src, 0, 4, CATb + row0 * CATLD + 2048 + hh * XHD, CATLD, 0.125f * 1.4426950408889634f);
        }
        };
        const bool compute_first = ((bid >> 3) & 1) != 0;
        if (compute_first) compute_units();
        if (args.sub & 1) for (int it = bid; it < DB * MS_NSPLIT; it += G) { const int split = __builtin_amdgcn_readfirstlane(it % MS_NSPLIT), b = __builtin_amdgcn_readfirstlane(it / MS_NSPLIT);
            mla_sample_unit(ldsb, cache_ckv, cache_kpe, page_table, QLATb, Qb, COSB, SINB, PO, PML, b, split, 0.07216878364870322f * 1.4426950408889634f); }
        if (args.sub & 8) for (int it = bid; it < DB * RH; it += G) {
            const int h = it & 3, b = it >> 2; const float lg = lg_gamma(h);
            const float* s0 = state_ret + (size_t)it * RDK * RDV;
            float* so = out + O_RETS + (size_t)it * RDK * RDV;
            LAS float* inner = lds;
            LAS float* qk = lds + 16;
            LAS float* vls = lds + 1040;
            LAS float* red = lds + 2064;
            f32x4 sv[16], vv[4];
#pragma unroll
            for (int r = 0; r < 16; ++r) sv[r] = __builtin_nontemporal_load((const f32x4*)(s0 + (size_t)(wave + 8 * r) * RDV + 4 * lane));
#pragma unroll
            for (int j = 0; j < DS; ++j) { const u32x2_t t_ = *(const u32x2_t*)(Zb + ((size_t)NP + b * DS + j) * ZLD + C_RV + h * RDV + 4 * lane); vv[j] = (f32x4){BLO(t_.x), BHI(t_.x), BLO(t_.y), BHI(t_.y)}; }
            __syncthreads();
            for (int i = tid; i < 1024; i += NTHREADS) { const int which = i >> 9, ti = (i >> 7) & 3, d = i & 127; const size_t row = (size_t)NP + b * DS + ti;
                qk[i] = which ? RK[row * 512 + h * RDK + d] : RQ[row * 512 + h * RDK + d]; }
            if (wave == 0) {
#pragma unroll
                for (int j = 0; j < DS; ++j) *(LAS f32x4*)(vls + j * 256 + 4 * lane) = vv[j]; }
            __syncthreads();
            for (int pr = wave; pr < 16; pr += NWAVES) { const int i = pr >> 2, j = pr & 3;
                float s_ = qk[i * 128 + lane] * qk[512 + j * 128 + lane] + qk[i * 128 + 64 + lane] * qk[512 + j * 128 + 64 + lane];
                s_ = wave_sum(s_);
                if (lane == 0) inner[pr] = (j <= i) ? s_ * __expf((float)(i - j) * lg) : 0.f; }
            const float g4 = __expf(4.f * lg), gk0 = __expf(3.f * lg), gk1 = __expf(2.f * lg), gk2 = __expf(lg);
            f32x4 po[4];
#pragma unroll
            for (int i = 0; i < 4; ++i) po[i] = (f32x4){0.f, 0.f, 0.f, 0.f};
#pragma unroll
            for (int r = 0; r < 16; ++r) { const int d = wave + 8 * r; const f32x4 sx = sv[r];
                f32x4 a = sx * g4 + (gk0 * qk[512 + d]) * vv[0] + (gk1 * qk[512 + 128 + d]) * vv[1] + (gk2 * qk[512 + 256 + d]) * vv[2] + qk[512 + 384 + d] * vv[3];
                __builtin_nontemporal_store(a, (f32x4*)(so + (size_t)d * RDV + 4 * lane));
#pragma unroll
                for (int i = 0; i < 4; ++i) po[i] += qk[i * 128 + d] * sx; }
#pragma unroll
            for (int i = 0; i < 4; ++i) *(LAS f32x4*)(red + (wave * 4 + i) * 256 + 4 * lane) = po[i];
            __syncthreads();
            {
                const int i = tid >> 7, e2 = (tid & 127) * 2;
                float o0 = 0.f, o1 = 0.f;
#pragma unroll
                for (int w_ = 0; w_ < NWAVES; ++w_) { o0 += red[(w_ * 4 + i) * 256 + e2]; o1 += red[(w_ * 4 + i) * 256 + e2 + 1]; }
                const float gi = __expf((float)(i + 1) * lg); o0 *= gi; o1 *= gi;
#pragma unroll
                for (int j = 0; j < DS; ++j) { const float w_ = inner[i * 4 + j]; o0 += w_ * vls[j * 256 + e2]; o1 += w_ * vls[j * 256 + e2 + 1]; }
                *(unsigned*)(ORETb + ((size_t)NP + b * DS + i) * 1024 + h * RDV + e2) = cvtpk(o0, o1);
            }
        }
        if (args.sub & 32) for (int it = bid; it < DB * 2; it += G) {
            const int hp = it & 1, b = it >> 1, kh = lane >> 5, hl = (lane >> 4) & 1;
            LAS float* sc = lds;
            LAS float* red = lds + 2048;
            const float* kb_ = cache_mem_k + (size_t)b * NMEM * 256 + hp * 128 + 4 * (lane & 31); const float* vb_ = cache_mem_v + (size_t)b * NMEM * 256 + hp * 128 + 4 * (lane & 31);
            f32x4 qr[4];
#pragma unroll
            for (int q = 0; q < DS; ++q) { const u32x2_t t_ = *(const u32x2_t*)(Zb + ((size_t)NP + b * DS + q) * ZLD + C_XQ + hp * 128 + 4 * (lane & 31)); qr[q] = (f32x4){BLO(t_.x), BHI(t_.x), BLO(t_.y), BHI(t_.y)}; }
            __syncthreads();
            f32x4 kv[16];
#pragma unroll
            for (int kk = 0; kk < 16; ++kk) kv[kk] = __builtin_nontemporal_load((const f32x4*)(kb_ + (size_t)(32 * wave + 2 * kk + kh) * 256));
#pragma unroll
            for (int kk = 0; kk < 16; ++kk) { const int key = 32 * wave + 2 * kk + kh;
                float pq[4];
#pragma unroll
                for (int q = 0; q < 4; ++q) { float a = kv[kk][0] * qr[q][0] + kv[kk][1] * qr[q][1] + kv[kk][2] * qr[q][2] + kv[kk][3] * qr[q][3];
                    a += __shfl_xor(a, 1); a += __shfl_xor(a, 2); a += __shfl_xor(a, 4); a += __shfl_xor(a, 8); pq[q] = a; }
                if ((lane & 15) == 0) {
#pragma unroll
                    for (int q = 0; q < 4; ++q) sc[(q * 2 + hl) * 256 + key] = pq[q] * (0.125f * 1.4426950408889634f); } }
#pragma unroll
            for (int kk = 0; kk < 16; ++kk) kv[kk] = __builtin_nontemporal_load((const f32x4*)(vb_ + (size_t)(32 * wave + 2 * kk + kh) * 256));
            __syncthreads();
            {
                f32x4 v = *(LAS f32x4*)(sc + wave * 256 + 4 * lane);
                const float mx = wave_max(fmaxf(fmaxf(v[0], v[1]), fmaxf(v[2], v[3])));
#pragma unroll
                for (int e = 0; e < 4; ++e) v[e] = __builtin_amdgcn_exp2f(v[e] - mx);
                const float inv = 1.f / wave_sum(v[0] + v[1] + v[2] + v[3]);
                *(LAS f32x4*)(sc + wave * 256 + 4 * lane) = v * inv; }
            __syncthreads();
            f32x4 acc[4];
#pragma unroll
            for (int q = 0; q < 4; ++q) acc[q] = (f32x4){0.f, 0.f, 0.f, 0.f};
#pragma unroll
            for (int kk = 0; kk < 16; ++kk) { const int key = 32 * wave + 2 * kk + kh;
#pragma unroll
                for (int q = 0; q < 4; ++q) acc[q] += sc[(q * 2 + hl) * 256 + key] * kv[kk]; }
#pragma unroll
            for (int q = 0; q < 4; ++q) *(LAS f32x4*)(red + ((wave * 2 + kh) * 4 + q) * 128 + 4 * (lane & 31)) = acc[q];
            __syncthreads();
            { const int q = tid >> 7, e = tid & 127; float o0 = 0.f;
#pragma unroll
              for (int w_ = 0; w_ < 2 * NWAVES; ++w_) o0 += red[(w_ * 4 + q) * 128 + e];
              const float o1 = __shfl_xor(o0, 1);
              if ((tid & 1) == 0) *(unsigned*)(CATb + ((size_t)NP + b * DS + q) * CATLD + 2048 + hp * 128 + e) = cvtpk(o0, o1); }
        }
        if (!compute_first) compute_units();
    }
    SEAM(5);
    if (IN(6)) { PHASE_IDS
        for (int task = bid; task < (NS / 32) * MH; task += G) {
            const int head = task & 7, rb = task >> 3, b = 8 * rb + wave; const float c2 = 0.07216878364870322f * 1.4426950408889634f;
            constexpr int OLP = 264;
            LAS bf16_t* ol = (LAS bf16_t*)ldsb;
            __syncthreads();
            float kn[DS][5];
#pragma unroll
            for (int j = 0; j < DS; ++j) { const size_t krow = (size_t)NP + b * DS + j;
#pragma unroll
                for (int c = 0; c < 5; ++c) { const int d = lane + 64 * c; kn[j][c] = d < KVL ? CKVN[krow * KVL + d] : KPER[krow * DROPE + (d - KVL)]; } }
#pragma unroll
            for (int t = 0; t < DS; ++t) {
                const int qi = t * 8 + head; const size_t qrow = (size_t)b * DS + t;
                float qv[5];
#pragma unroll
                for (int c = 0; c < 5; ++c) { const int d = lane + 64 * c; const bf16_t raw = d < KVL ? QLATb[qrow * 2048 + head * KVL + d] : Qb[(NP + qrow) * 1536 + head * DQH + DNOPE + (d - KVL)];
                    qv[c] = __builtin_bit_cast(float, (unsigned)raw << 16); }
                {
                    const float xp = __shfl_xor(qv[4], 32), cs = COSB[(SEQ + t) * 32 + (lane & 31)], sn = SINB[(SEQ + t) * 32 + (lane & 31)];
                    qv[4] = lane < 32 ? qv[4] * cs - xp * sn : xp * sn + qv[4] * cs; }
                float sc[DS]; float M = -INFINITY;
#pragma unroll
                for (int j = 0; j < DS; ++j) { float a_ = 0.f;
#pragma unroll
                    for (int c = 0; c < 5; ++c) a_ += qv[c] * kn[j][c];
                    a_ = wave_sum(a_) * c2; sc[j] = (j <= t) ? a_ : -INFINITY; M = fmaxf(M, sc[j]); }
                float ms[MS_NSPLIT], ls[MS_NSPLIT];
#pragma unroll
                for (int sp = 0; sp < MS_NSPLIT; ++sp) { const int item = b * MS_NSPLIT + sp; ms[sp] = PML[(item * 32 + qi) * 2]; ls[sp] = PML[(item * 32 + qi) * 2 + 1]; M = fmaxf(M, ms[sp]); }
                float L = 0.f; float acc[4] = {0.f, 0.f, 0.f, 0.f};
#pragma unroll
                for (int sp = 0; sp < MS_NSPLIT; ++sp) { const int item = b * MS_NSPLIT + sp; const float wgt = __builtin_amdgcn_exp2f(ms[sp] - M); L += ls[sp] * wgt;
#pragma unroll
                    for (int c = 0; c < 4; ++c) acc[c] += wgt * PO[((size_t)item * 32 + qi) * KVL + lane + 64 * c]; }
#pragma unroll
                for (int j = 0; j < DS; ++j) { const float wgt = __builtin_amdgcn_exp2f(sc[j] - M); L += wgt;
#pragma unroll
                    for (int c = 0; c < 4; ++c) acc[c] += wgt * kn[j][c]; }
                const float inv = 1.f / L;
#pragma unroll
                for (int c = 0; c < 4; ++c) ol[(4 * wave + t) * OLP + lane + 64 * c] = f2bf(acc[c] * inv);
            }
            __syncthreads();
            if (wave < 4) {
                const int l31 = lane & 31, h8 = lane >> 5;
                f32x16 acc;
#pragma unroll
                for (int i = 0; i < 16; ++i) acc[i] = 0.f;
                const bf16_t* bp = WuvT + (size_t)(head * DVH + 32 * wave + l31) * KVL + 8 * h8;
#pragma unroll
                for (int s_ = 0; s_ < 16; ++s_) { const bf16x8 a_ = *(const LAS bf16x8*)(ol + l31 * OLP + 16 * s_ + 8 * h8); const bf16x8 b_ = *(const bf16x8*)(bp + 16 * s_); acc = MFMA32(a_, b_, acc); }
#pragma unroll
                for (int i = 0; i < 16; ++i) CATb[((size_t)NP + 32 * rb + crow(i, h8)) * CATLD + 1024 + head * DVH + 32 * wave + l31] = f2bf(acc[i]);
            }
        }
        {
#pragma unroll 1
            for (int row0 = gw; row0 < NT; row0 += 4 * NGW) {
                u32x2_t oa[4][4], gz[4][4];
#pragma unroll
                for (int k = 0; k < 4; ++k) { const int r = row0 + k * NGW;
                    if (r < NT) {
#pragma unroll
                        for (int j = 0; j < 4; ++j) { oa[k][j] = *(const u32x2_t*)(ORETb + (size_t)r * 1024 + 4 * lane + 256 * j); gz[k][j] = *(const u32x2_t*)(SRGb + (size_t)r * 1024 + 4 * lane + 256 * j); } } }
#pragma unroll
                for (int k = 0; k < 4; ++k) { const int r = row0 + k * NGW;
                    if (r < NT) {
#pragma unroll
                        for (int j = 0; j < 4; ++j) { const f32x4 a = bf4_to_f32(oa[k][j].x, oa[k][j].y), g_ = bf4_to_f32(gz[k][j].x, gz[k][j].y);
                            const float ss = wave_sum(a[0] * a[0] + a[1] * a[1] + a[2] * a[2] + a[3] * a[3]);
                            const float rr = rsqrtf(ss * (1.f / RDV) + EPS);
                            *(u32x2_t*)(CATb + (size_t)r * CATLD + 4 * lane + 256 * j) = (u32x2_t){cvtpk(g_[0] * a[0] * rr, g_[1] * a[1] * rr), cvtpk(g_[2] * a[2] * rr, g_[3] * a[3] * rr)}; } } }
            }
        }
    }
    SEAM(6);
    if (IN(7)) {
        { pg8::StaticOrder S; S.init(NP, 1024, G, bid); pg8::Gemm g{CATb, WcatT, NP, 1024, CATLD, CATLD, CATLD}; pg8::EpiGate3 E{SGb, MIXb, 1024, 16, 32};
          pg8::gemm_phase<pg8::EpiGate3, pg8::StaticOrder, true, true>(ldsb, g, S, E); }
        __syncthreads();
        { pg8::Gemm g{CATb, WcatT, NT, 1024, 256, CATLD, CATLD, 256}; pg8::SplitOrder SS{9, bid}; pg8::EpiPart E{PART}; GEMM_SPLIT(ldsb, g, SS, E); }
    }
    SEAM(7);
    if (IN(8)) { PHASE_IDS
        for (int i = bid * NTHREADS + tid; i < NS * 256; i += G * NTHREADS) { const int r = i >> 8, c4 = (i & 255) * 4; const size_t o_ = (size_t)r * 1024 + c4;
            f32x4 mix = {0.f, 0.f, 0.f, 0.f};
#pragma unroll
            for (int br = 0; br < 3; ++br) { f32x4 a = *(const f32x4*)(PART + (size_t)(br == 2 ? 8 : 4 * br) * (512 * 1024) + o_);
                if (br < 2) {
#pragma unroll
                    for (int k_ = 1; k_ < 4; ++k_) a += *(const f32x4*)(PART + (size_t)(4 * br + k_) * (512 * 1024) + o_); }
                const u32x2_t gq = *(const u32x2_t*)(SGb + (size_t)(NP + r) * 3072 + br * 1024 + c4);
                mix[0] += a[0] * __builtin_bit_cast(float, gq.x << 16); mix[1] += a[1] * __builtin_bit_cast(float, gq.x & 0xffff0000u);
                mix[2] += a[2] * __builtin_bit_cast(float, gq.y << 16); mix[3] += a[3] * __builtin_bit_cast(float, gq.y & 0xffff0000u); }
            *(u32x2_t*)(MIXb + (size_t)(NP + r) * 1024 + c4) = (u32x2_t){cvtpk(mix[0], mix[1]), cvtpk(mix[2], mix[3])}; }
    }
    SEAM(8);
    if (IN(9)) { pg8::Gemm g{MIXb, WoT, NP, 1024, 1024, 1024, 1024}; pg8::StaticOrder S; S.init(NP, 1024, G, bid); pg8::EpiBf16S E{HPb, 1024};
        GEMM_PHASE(pg8::EpiBf16S, ldsb, g, S, E);
        __syncthreads();
        { pg8::Gemm g2{MIXb, WoT, NT, 1024, 256, 1024, 1024, 256}; pg8::SplitOrder SS{4, bid}; pg8::EpiPart E2{PART}; GEMM_SPLIT(ldsb, g2, SS, E2); } }
    SEAM(9);
    if (IN(10)) { PHASE_IDS
        f32x4 gp[4], gf[4];
#pragma unroll
        for (int j = 0; j < 4; ++j) { gp[j] = *(const f32x4*)(g_mix_post + 4 * lane + 256 * j); gf[j] = *(const f32x4*)(g_ffn_pre + 4 * lane + 256 * j); }
        auto finish_row = [&](const int row, f32x4 (&a)[4], const f32x4 (&b)[4]) __attribute__((always_inline)) {
            float ss = 0.f;
#pragma unroll
            for (int j = 0; j < 4; ++j) ss += a[j][0] * a[j][0] + a[j][1] * a[j][1] + a[j][2] * a[j][2] + a[j][3] * a[j][3];
            float r = rsqrtf(wave_sum(ss) * (1.f / DM) + EPS); ss = 0.f;
#pragma unroll
            for (int j = 0; j < 4; ++j) { a[j] = b[j] + a[j] * r * gp[j]; *(u32x2_t*)(Hb + (size_t)row * DM + 4 * lane + 256 * j) = (u32x2_t){cvtpk(a[j][0], a[j][1]), cvtpk(a[j][2], a[j][3])};
                ss += a[j][0] * a[j][0] + a[j][1] * a[j][1] + a[j][2] * a[j][2] + a[j][3] * a[j][3]; }
            r = rsqrtf(wave_sum(ss) * (1.f / DM) + EPS);
#pragma unroll
            for (int j = 0; j < 4; ++j) { const f32x4 f_ = a[j] * r * gf[j]; *(u32x2_t*)(Fb + (size_t)row * DM + 4 * lane + 256 * j) = (u32x2_t){cvtpk(f_[0], f_[1]), cvtpk(f_[2], f_[3])}; }
        };
#pragma unroll 1
        for (int row0 = gw; row0 < NP; row0 += 4 * NGW) {
            u32x2_t hp[4][4]; f32x4 xb[4][4];
#pragma unroll
            for (int k = 0; k < 4; ++k) { const int r = row0 + k * NGW;
                if (r < NP) {
#pragma unroll
                    for (int j = 0; j < 4; ++j) { hp[k][j] = *(const u32x2_t*)(HPb + (size_t)r * DM + 4 * lane + 256 * j); xb[k][j] = *(const f32x4*)(x_prompt + (size_t)r * DM + 4 * lane + 256 * j); } } }
#pragma unroll
            for (int k = 0; k < 4; ++k) { const int r = row0 + k * NGW;
                if (r < NP) { f32x4 a[4];
#pragma unroll
                    for (int j = 0; j < 4; ++j) a[j] = bf4_to_f32(hp[k][j].x, hp[k][j].y);
                    finish_row(r, a, xb[k]); } }
        }
        for (int r = NP + gw; r < NT; r += NGW) { f32x4 a[4], b[4];
#pragma unroll
            for (int j = 0; j < 4; ++j) { const float* p_ = PART + (size_t)(r - NP) * DM + 4 * lane + 256 * j;
                a[j] = (*(const f32x4*)p_ + *(const f32x4*)(p_ + 512 * 1024)) + (*(const f32x4*)(p_ + 2 * 512 * 1024) + *(const f32x4*)(p_ + 3 * 512 * 1024));
                b[j] = *(const f32x4*)(x_sample + (size_t)(r - NP) * DM + 4 * lane + 256 * j); }
            finish_row(r, a, b); }
    }
    SEAM(10);
    if (IN(11)) {
        pg8::Gemm g{Fb, WguT, NT, 2 * DFF, 1024, 1024, 1024}; pg8::StaticOrder S; S.init(NT, 2 * DFF, G, bid); pg8::EpiSwiGLU E{ACTb, DFF};
        GEMM_PHASE(pg8::EpiSwiGLU, ldsb, g, S, E);
    }
    SEAM(11);
    if (IN(13)) { pg8::Gemm g{ACTb, WdT, NP, 1024, DFF, DFF, DFF}; pg8::StaticOrder S; S.init(NP, 1024, G, bid); pg8::EpiBf16S E{FOb, 1024};
        GEMM_PHASE(pg8::EpiBf16S, ldsb, g, S, E);
        __syncthreads();
        { pg8::Gemm g2{ACTb, WdT, NT, 1024, 256, DFF, DFF, 256}; pg8::SplitOrder SS{11, bid}; pg8::EpiPart E2{PART}; GEMM_SPLIT(ldsb, g2, SS, E2); } }
    SEAM(13);
    if (IN(14)) { PHASE_IDS
        f32x4 gp[4];
#pragma unroll
        for (int j = 0; j < 4; ++j) gp[j] = *(const f32x4*)(g_ffn_post + 4 * lane + 256 * j);
#pragma unroll 1
        for (int row0 = gw; row0 < NP; row0 += 4 * NGW) {
            u32x2_t fa[4][4], hb[4][4];
#pragma unroll
            for (int k = 0; k < 4; ++k) { const int r = row0 + k * NGW;
                if (r < NP) {
#pragma unroll
                    for (int j = 0; j < 4; ++j) { fa[k][j] = *(const u32x2_t*)(FOb + (size_t)r * DM + 4 * lane + 256 * j); hb[k][j] = *(const u32x2_t*)(Hb + (size_t)r * DM + 4 * lane + 256 * j); } } }
#pragma unroll
            for (int k = 0; k < 4; ++k) { const int r = row0 + k * NGW;
                if (r < NP) { f32x4 a[4]; float ss = 0.f;
#pragma unroll
                    for (int j = 0; j < 4; ++j) { a[j] = bf4_to_f32(fa[k][j].x, fa[k][j].y); ss += a[j][0] * a[j][0] + a[j][1] * a[j][1] + a[j][2] * a[j][2] + a[j][3] * a[j][3]; }
                    const float rs = rsqrtf(wave_sum(ss) * (1.f / DM) + EPS);
                    float* y = out + O_YP + (size_t)r * DM;
#pragma unroll
                    for (int j = 0; j < 4; ++j) *(f32x4*)(y + 4 * lane + 256 * j) = bf4_to_f32(hb[k][j].x, hb[k][j].y) + a[j] * rs * gp[j]; } }
        }
        for (int r = NP + gw; r < NT; r += NGW) { f32x4 a[4]; float ss = 0.f;
#pragma unroll
            for (int j = 0; j < 4; ++j) { const float* p_ = PART + (size_t)(r - NP) * DM + 4 * lane + 256 * j; f32x4 a_ = *(const f32x4*)p_;
#pragma unroll
                for (int k_ = 1; k_ < 11; ++k_) a_ += *(const f32x4*)(p_ + (size_t)k_ * 512 * 1024);
                a[j] = a_; ss += a_[0] * a_[0] + a_[1] * a_[1] + a_[2] * a_[2] + a_[3] * a_[3]; }
            const float rs = rsqrtf(wave_sum(ss) * (1.f / DM) + EPS);
            float* y = out + O_YS + (size_t)(r - NP) * DM;
#pragma unroll
            for (int j = 0; j < 4; ++j) { const u32x2_t h_ = *(const u32x2_t*)(Hb + (size_t)r * DM + 4 * lane + 256 * j); *(f32x4*)(y + 4 * lane + 256 * j) = bf4_to_f32(h_.x, h_.y) + a[j] * rs * gp[j]; } }
    }
#undef IN
#undef SEAM
#undef PHASE_IDS
}
#undef x_prompt
#undef x_sample
#undef mem_prompt
#undef cache_ckv
#undef cache_kpe
#undef page_table
#undef state_ret
#undef cache_mem_k
#undef cache_mem_v
#undef g_mix_pre
#undef g_mix_post
#undef g_ffn_pre
#undef g_ffn_post
#undef g_mem
#undef g_qlat
#undef g_kvlat
#undef w_in
#undef w_uq
#undef w_uk
#undef w_uv
#undef w_mem_k
#undef w_mem_v
#undef w_ret_o
#undef w_mla_o
#undef w_x_o
#undef w_out
#undef w_gate
#undef w_up
#undef w_down
#undef COSA
#undef SINA
#undef COSB
#undef SINB
#undef U
#undef MN
#undef Zb
#undef RQ
#undef RK
#undef CQN
#undef CKVN
#undef KPER
#undef Q
#undef QLAT
#undef QPE
#undef ORETb
#undef OLAT
#undef OX
#undef OMLA
#undef ORETN
#undef ARET
#undef AMLA
#undef AX
#undef MIX
#undef HPb
#undef Hb
#undef F
#undef GU
#undef FOb
#undef WinT
#undef WmkvT
#undef WuqT
#undef WabsT
#undef WcatT
#undef CATb
#undef WroT
#undef WmoT
#undef WxoT
#undef WoT
#undef WguT
#undef WdT
#undef Ub
#undef MNb
#undef CQNb
#undef ORETNb
#undef OMLAb
#undef OXb
#undef MIXb
#undef Fb
#undef ACTb
#undef WukT
#undef WuvT
#undef CKVNb
#undef KPERb
#undef XQb
#undef MKb
#undef MVT
#undef KN
#undef VT
#undef Qb
#undef RQt
#undef RKt
#undef RKtT
#undef RVT
#undef UT
#undef SPT
#undef QPEb
#undef WukB
#undef PART
#undef SGb
#undef SRGb
#undef T0b
#undef T1b
#undef QLATb
#undef PO
#undef PML
constexpr int N_PHASES = 15;
}

extern "C" void kernel_launch(void* const* d_in, const int* in_sizes, int n_in, void* d_out, int out_size, void* d_ws, size_t ws_size, hipStream_t stream) {
    static int grid = 0;
    if (grid == 0) {
        if (n_in != 29 || (size_t)out_size != O_END || ws_size < WS_END) { fprintf(stderr, "kernel_launch: unexpected shapes: n_in %d out %d ws %zu (need %zu)\n", n_in, out_size, ws_size, (size_t)WS_END); grid = -1; return; }
        int dev = 0, cus = 0, per_cu = 0;
        if (hipGetDevice(&dev) != hipSuccess || hipDeviceGetAttribute(&cus, hipDeviceAttributeMultiprocessorCount, dev) != hipSuccess) { grid = -1; return; }
        if (hipFuncSetAttribute((const void*)fwd_kernel, hipFuncAttributeMaxDynamicSharedMemorySize, LDS_BYTES) != hipSuccess) { fprintf(stderr, "kernel_launch: hipFuncSetAttribute failed\n"); grid = -1; return; }
        if (hipOccupancyMaxActiveBlocksPerMultiprocessor(&per_cu, (const void*)fwd_kernel, NTHREADS, LDS_BYTES) != hipSuccess || per_cu < 1) { fprintf(stderr, "kernel_launch: occupancy query says %d\n", per_cu); per_cu = 1; }
        (void)hipGetLastError();
        grid = cus;
    }
    if (grid < 0) return;
    (void)hipMemsetAsync((char*)d_ws + WS_CTL, 0, CTL_BYTES, stream);
    Args a{};
    for (int i = 0; i < 29; ++i) a.in[i] = (const float*)d_in[i];
    a.out = (float*)d_out; a.ws = (unsigned char*)d_ws;
#if MK_ONE_LAUNCH
    a.ph_lo = 0; a.ph_hi = N_PHASES; a.sub = 0xff;
    hipLaunchKernelGGL(fwd_kernel, dim3(grid), dim3(NTHREADS), LDS_BYTES, stream, a);
#if PROBE_DUP >= 0
    a.ph_lo = PROBE_DUP; a.ph_hi = PROBE_DUP + 1; a.sub = PROBE_SUB;
    for (int r = 0; r < PROBE_REP; ++r) hipLaunchKernelGGL(fwd_kernel, dim3(grid), dim3(NTHREADS), LDS_BYTES, stream, a);
#endif
#else
    a.sub = 0xff; for (int p = 0; p < N_PHASES; ++p) { a.ph_lo = p; a.ph_hi = p + 1; hipLaunchKernelGGL(fwd_kernel, dim3(grid), dim3(NTHREADS), LDS_BYTES, stream, a); }
#endif
}
```

```cpp
#include <hip/hip_runtime.h>
#include <cstdio>
#include <cstdint>

#ifndef PROBE_DUP
#define PROBE_DUP -1
#endif
#ifndef PROBE_REP
#define PROBE_REP 4
#endif
#ifndef PROBE_SUB
#define PROBE_SUB 0xff
#endif
#ifndef MK_ONE_LAUNCH
#define MK_ONE_LAUNCH 1
#endif

#define LAS __attribute__((address_space(3)))
#define GAS __attribute__((address_space(1)))
#define DI __device__ __forceinline__
typedef float f32x4 __attribute__((ext_vector_type(4)));
typedef __bf16 bf16x2_t __attribute__((ext_vector_type(2)));
typedef float f32x2_t __attribute__((ext_vector_type(2)));
DI unsigned cvtpk(float lo, float hi) { f32x2_t v = {lo, hi}; bf16x2_t b = __builtin_convertvector(v, bf16x2_t); return __builtin_bit_cast(unsigned, b); }

namespace {
constexpr int DM = 1024, NB = 8, SEQ = 2048, NP = NB * SEQ, DB = 128, DS = 4, NS = DB * DS, NT = NP + NS;
constexpr int PAST = 8192, PAGE = 128, NPAGES = PAST / PAGE;
constexpr int RH = 4, RDK = 128, RDV = 256;
constexpr int MH = 8, QL = 384, KVL = 256, DNOPE = 128, DROPE = 64, DVH = 128, DQH = DNOPE + DROPE;
constexpr int NMEM = 256, XH = 4, XHD = 64;
constexpr int DFF = 2816, DIN = 7104, ZLD = 7168;
constexpr int C_RQ = 0, C_RK = 512, C_RV = 1024, C_RG = 2048, C_CQ = 3072, C_CKV = 3456, C_KPE = 3712, C_XQ = 3776, C_G = 4096;
constexpr float EPS = 1e-6f;
constexpr int NPOS = SEQ + DS;
constexpr int NTHREADS = 512, NWAVES = 8;
constexpr int LDS_BYTES = 147456;
constexpr int MISC_OFF = 147456 - 256;

constexpr size_t O_YP = 0, O_YS = O_YP + (size_t)NP * DM, O_CKVP = O_YS + (size_t)NS * DM, O_KPEP = O_CKVP + (size_t)NP * KVL,
                 O_CKVS = O_KPEP + (size_t)NP * DROPE, O_KPES = O_CKVS + (size_t)NS * KVL, O_RETP = O_KPES + (size_t)NS * DROPE,
                 O_RETS = O_RETP + (size_t)NB * RH * RDK * RDV, O_MKP = O_RETS + (size_t)DB * RH * RDK * RDV, O_MVP = O_MKP + (size_t)NB * NMEM * 256,
                 O_END = O_MVP + (size_t)NB * NMEM * 256;

constexpr size_t al256(size_t x) { return (x + 255) & ~(size_t)255; }
constexpr size_t WS_CTL = 0, CTL_BYTES = 1u << 20;
constexpr size_t WS_COSA = WS_CTL + CTL_BYTES;
constexpr size_t WS_SINA = WS_COSA + al256((size_t)NPOS * 64 * 4);
constexpr size_t WS_COSB = WS_SINA + al256((size_t)NPOS * 64 * 4);
constexpr size_t WS_SINB = WS_COSB + al256((size_t)NPOS * 32 * 4);
constexpr size_t WS_U = WS_SINB + al256((size_t)NPOS * 32 * 4);
constexpr size_t WS_MN = WS_U + (size_t)NT * DM * 4;
constexpr size_t WS_Z = WS_MN + (size_t)NB * NMEM * DM * 4;
constexpr size_t WS_RQ = WS_Z + (size_t)NT * ZLD * 4;
constexpr size_t WS_RK = WS_RQ + (size_t)NT * 512 * 4;
constexpr size_t WS_CQN = WS_RK + (size_t)NT * 512 * 4;
constexpr size_t WS_CKVN = WS_CQN + (size_t)NT * QL * 4;
constexpr size_t WS_KPER = WS_CKVN + (size_t)NT * KVL * 4;
constexpr size_t WS_Q = WS_KPER + (size_t)NT * DROPE * 4;
constexpr size_t WS_QLAT = WS_Q + (size_t)NT * 1536 * 4;
constexpr size_t WS_QPE = WS_QLAT + (size_t)NT * 2048 * 4;
constexpr size_t WS_ORET = WS_QPE + (size_t)NT * 512 * 4;
constexpr size_t WS_OLAT = WS_ORET + (size_t)NT * 1024 * 4;
constexpr size_t WS_OX = WS_OLAT + (size_t)NT * 2048 * 4;
constexpr size_t WS_OMLA = WS_OX + (size_t)NT * 256 * 4;
constexpr size_t WS_ORETN = WS_OMLA + (size_t)NT * 1024 * 4;
constexpr size_t WS_ARET = WS_ORETN + (size_t)NT * 1024 * 4;
constexpr size_t WS_AMLA = WS_ARET + (size_t)NT * 1024 * 4;
constexpr size_t WS_AX = WS_AMLA + (size_t)NT * 1024 * 4;
constexpr size_t WS_MIX = WS_AX + (size_t)NT * 1024 * 4;
constexpr size_t WS_HP = WS_MIX + (size_t)NT * 1024 * 4;
constexpr size_t WS_H = WS_HP + (size_t)NT * 1024 * 4;
constexpr size_t WS_F = WS_H + (size_t)NT * 1024 * 4;
constexpr size_t WS_GG = WS_F + (size_t)NT * 1024 * 4;
constexpr size_t WS_UP = WS_GG + (size_t)NT * DFF * 4;
constexpr size_t WS_ACT = WS_UP + (size_t)NT * DFF * 4;
constexpr size_t WS_FO = WS_ACT + (size_t)NT * DFF * 4;
constexpr size_t WS_F32_END = WS_FO + (size_t)NT * 1024 * 4;
constexpr size_t WS_WIN_T = al256(WS_F32_END);
constexpr size_t WS_WMKV_T = WS_WIN_T + (size_t)ZLD * 1024 * 2;
constexpr size_t WS_WUQ_T = WS_WMKV_T + (size_t)512 * 1024 * 2;
constexpr size_t WS_WRO_T = WS_WUQ_T + (size_t)1536 * 384 * 2;
constexpr size_t WS_WMO_T = WS_WRO_T + (size_t)1024 * 1024 * 2;
constexpr size_t WS_WXO_T = WS_WMO_T + (size_t)1024 * 1024 * 2;
constexpr size_t WS_WO_T = WS_WXO_T + (size_t)1024 * 256 * 2;
constexpr size_t WS_WGU_T = WS_WO_T + (size_t)1024 * 1024 * 2;
constexpr size_t WS_WD_T = WS_WGU_T + (size_t)5632 * 1024 * 2;
constexpr size_t WS_UB = WS_WD_T + (size_t)1024 * 2816 * 2;
constexpr size_t WS_MNB = WS_UB + (size_t)NT * 1024 * 2;
constexpr size_t WS_CQNB = WS_MNB + (size_t)2048 * 1024 * 2;
constexpr size_t WS_ORETNB = WS_CQNB + (size_t)NT * 384 * 2;
constexpr size_t WS_OMLAB = WS_ORETNB + (size_t)NT * 1024 * 2;
constexpr size_t WS_OXB = WS_OMLAB + (size_t)NT * 1024 * 2;
constexpr size_t WS_MIXB = WS_OXB + (size_t)NT * 256 * 2;
constexpr size_t WS_FB = WS_MIXB + (size_t)NT * 1024 * 2;
constexpr size_t WS_ACTB = WS_FB + (size_t)NT * 1024 * 2;
constexpr size_t WS_WUK_T = WS_ACTB + (size_t)NT * 2816 * 2;
constexpr size_t WS_WUV_T = WS_WUK_T + (size_t)1024 * 256 * 2;
constexpr size_t WS_CKVNB = WS_WUV_T + (size_t)1024 * 256 * 2;
constexpr size_t WS_KPERB = WS_CKVNB + (size_t)NT * 256 * 2;
constexpr size_t WS_XQB = WS_KPERB + (size_t)NT * 64 * 2;
constexpr size_t WS_MKB = WS_XQB + (size_t)NT * 256 * 2;
constexpr size_t WS_MVT = WS_MKB + (size_t)2048 * 256 * 2;
constexpr size_t WS_KN = WS_MVT + (size_t)2048 * 256 * 2;
constexpr size_t WS_VT = WS_KN + (size_t)NP * 1024 * 2;
constexpr size_t WS_QB = WS_VT + (size_t)NP * 1024 * 2;
constexpr size_t WS_RQT = WS_QB + (size_t)NT * 1536 * 2;
constexpr size_t WS_RKT = WS_RQT + (size_t)NP * 512 * 2;
constexpr size_t WS_RKTT = WS_RKT + (size_t)NP * 512 * 2;
constexpr size_t WS_RVT = WS_RKTT + (size_t)NP * 512 * 2;
constexpr size_t WS_UT = WS_RVT + (size_t)NT * 1024 * 2;
constexpr size_t WS_SPT = WS_UT + (size_t)512 * 32768 * 4;
constexpr size_t WS_QLATB = WS_SPT + (size_t)512 * 32768 * 2;
constexpr size_t WS_PO = WS_QLATB + (size_t)NS * 2048 * 2;
constexpr size_t WS_PML = WS_PO + (size_t)DB * 2 * 32 * 256 * 4;
constexpr size_t WS_PART = al256(WS_PML + (size_t)DB * 2 * 32 * 2 * 4);
constexpr size_t WS_QPEB_ = WS_PART + (size_t)11 * 512 * 1024 * 4;
constexpr size_t WS_QPEB = al256(WS_QPEB_ + 0 * WS_PML + (size_t)DB * 2 * 32 * 2 * 4);
constexpr size_t WS_SGB = WS_QPEB + (size_t)NT * 512 * 2;
constexpr size_t WS_SRGB = WS_SGB + (size_t)NT * 3072 * 2;
constexpr size_t WS_T0B = WS_SRGB + (size_t)NT * 1024 * 2;
constexpr size_t WS_T1B = WS_T0B + (size_t)NT * 1024 * 2;
constexpr size_t WS_WUKB = WS_T1B + (size_t)NT * 1024 * 2;
constexpr size_t WS_WUQABS = al256(WS_WUKB + (size_t)8 * 256 * 128 * 2);
constexpr int LP = 384;
constexpr size_t WS_WUK2 = WS_WUQABS + (size_t)(1536 + 2048) * 384 * 2;
constexpr size_t WS_WUV2 = WS_WUK2 + (size_t)1024 * LP * 2;
constexpr size_t WS_CKVNB2 = WS_WUV2 + (size_t)1024 * LP * 2;
constexpr size_t WS_END = WS_CKVNB2 + (size_t)NT * LP * 2;

static_assert(WS_OMLAB == WS_ORETNB + (size_t)NT * 1024 * 2 && WS_OXB == WS_OMLAB + (size_t)NT * 1024 * 2 && WS_MIXB == WS_OXB + (size_t)NT * 256 * 2, "CATb = [o_ret_n | o_mla | o_x] rows of 2304");
static_assert(WS_WMO_T == WS_WRO_T + (size_t)1024 * 1024 * 2 && WS_WXO_T == WS_WMO_T + (size_t)1024 * 1024 * 2 && WS_WO_T == WS_WXO_T + (size_t)1024 * 256 * 2, "WcatT = [w_ret_o | w_mla_o | w_x_o]^T rows of 2304");
constexpr int CATLD = 2304;
constexpr int CW_BAR = 4096;

#define XB_TMO      128
#define XB_XCNT(j)  (256  + 64 * (j))
#define XB_XSUB(j)  (1280 + 64 * (j))
#define XB_XGEN(j)  (2304 + 64 * (j))
#define XB_TOP      3328
#define XB_TOPGEN   3392
#define XCD_BAR_WORDS 3456
#define XB_SPIN_CAP (1u << 25)

DI unsigned xb_ld(unsigned* p)              { return __hip_atomic_load(p, __ATOMIC_RELAXED, __HIP_MEMORY_SCOPE_AGENT); }
DI unsigned xb_add(unsigned* p, unsigned v) { return __hip_atomic_fetch_add(p, v, __ATOMIC_RELAXED, __HIP_MEMORY_SCOPE_AGENT); }
DI unsigned xb_xcc_id() { return (unsigned)__builtin_amdgcn_s_getreg((3 << 11) | 20) & 0xFu; }
#define XB_SPIN(cond, bar) do { unsigned _sp = 0; while (cond) { __builtin_amdgcn_s_sleep(1); \
    if ((++_sp & 255u) == 0u) { if (xb_ld(&(bar)[XB_TMO])) break; if (_sp > XB_SPIN_CAP) { atomicAdd(&(bar)[XB_TMO], 1u); break; } } } } while (0)

struct XcdBarrier { unsigned* bar; unsigned x; volatile LAS unsigned* st; };

DI XcdBarrier xcd_barrier_post(unsigned* bar, volatile LAS unsigned* st) {
    XcdBarrier b; b.bar = bar; b.x = xb_xcc_id(); b.st = st;
    if (threadIdx.x == 0) (void)xb_add(&bar[XB_XCNT(b.x)], 1u);
    return b;
}
DI void xcd_barrier_complete(unsigned* bar, unsigned x, unsigned& nloc, unsigned& nx) {
    const unsigned G = gridDim.x * gridDim.y * gridDim.z;
    unsigned sum, cnt, mine, sp = 0u;
    for (;;) {
        sum = 0u; cnt = 0u; mine = 0u;
#pragma unroll
        for (unsigned j = 0; j < 16; ++j) { const unsigned c = xb_ld(&bar[XB_XCNT(j)]); sum += c; cnt += (c > 0u) ? 1u : 0u; mine = (j == x) ? c : mine; }
        if (sum == G) break;
        __builtin_amdgcn_s_sleep(1);
        if ((++sp & 255u) == 0u) { if (xb_ld(&bar[XB_TMO])) break; if (sp > XB_SPIN_CAP) { atomicAdd(&bar[XB_TMO], 1u); break; } }
    }
    nloc = mine > 0u ? mine : 1u; nx = cnt > 0u ? cnt : 1u;
}
DI void xcd_barrier(const XcdBarrier& b) {
    asm volatile("s_waitcnt vmcnt(0)" ::: "memory");
    __syncthreads();
    if (threadIdx.x == 0) {
        unsigned* bar = b.bar;
        __builtin_amdgcn_s_waitcnt(0);
        unsigned nloc = b.st[0], nx = b.st[1];
        if (nloc == 0u) { xcd_barrier_complete(bar, b.x, nloc, nx); b.st[0] = nloc; b.st[1] = nx; }
        const unsigned old = xb_add(&bar[XB_XSUB(b.x)], 1u);
        const unsigned gen = old / nloc;
        if (old + 1u == (gen + 1u) * nloc) {
            __builtin_amdgcn_fence(__ATOMIC_RELEASE, "agent");
            asm volatile("s_waitcnt vmcnt(0)" ::: "memory");
            const unsigned og = xb_add(&bar[XB_TOP], 1u);
            const unsigned tg = og / nx;
            if (og + 1u == (tg + 1u) * nx) xb_add(&bar[XB_TOPGEN], 1u);
            else XB_SPIN(xb_ld(&bar[XB_TOPGEN]) == tg, bar);
            __builtin_amdgcn_fence(__ATOMIC_ACQUIRE, "agent");
            xb_add(&bar[XB_XGEN(b.x)], 1u);
            asm volatile("s_waitcnt vmcnt(0)" ::: "memory");
        } else {
            XB_SPIN(xb_ld(&bar[XB_XGEN(b.x)]) == gen, bar);
            __builtin_amdgcn_fence(__ATOMIC_ACQUIRE, "agent");
            asm volatile("s_waitcnt vmcnt(0)" ::: "memory");
        }
    }
    __syncthreads();
}

DI float wave_sum(float v) {
#pragma unroll
    for (int o = 1; o < 64; o <<= 1) v += __shfl_xor(v, o);
    return v;
}
DI float wave_max(float v) {
#pragma unroll
    for (int o = 1; o < 64; o <<= 1) v = fmaxf(v, __shfl_xor(v, o));
    return v;
}
DI float sigmoidf_(float x) { return 1.f / (1.f + expf(-x)); }
DI float siluf_(float x) { return x / (1.f + expf(-x)); }
DI f32x4 bf4_to_f32(unsigned lo, unsigned hi) { return (f32x4){__builtin_bit_cast(float, lo << 16), __builtin_bit_cast(float, lo & 0xffff0000u), __builtin_bit_cast(float, hi << 16), __builtin_bit_cast(float, hi & 0xffff0000u)}; }
DI int pos_index(int row) { return row < NP ? (row & (SEQ - 1)) : SEQ + ((row - NP) & (DS - 1)); }
DI float lg_gamma(int h) { return h == 0 ? -0.03174869831458027f : h == 1 ? -0.015748356968139112f : h == 2 ? -0.007843177461025892f : -0.003913899321136329f; }


namespace pg8 {
typedef unsigned short bf16_t;
typedef short bf16x8 __attribute__((ext_vector_type(8)));
typedef unsigned u32x4 __attribute__((ext_vector_type(4)));
typedef unsigned u32x2 __attribute__((ext_vector_type(2)));
constexpr int BM = 256, BK = 64, HALF = 128, HTB = HALF * BK * 2, STAGE_BYTES = 8 * HTB, NXCD = 8, WGM = 8;
__host__ __device__ __forceinline__ int lds_byte(int r, int c) { const int st = (r >> 4) * 2 + (c >> 5), rr = r & 15, cc = c & 31, ob = rr * 64 + cc * 2; return st * 1024 + (ob ^ (((ob >> 9) & 1) << 5)); }
__host__ __device__ __forceinline__ void stage_rc(int b, int& R, int& C) { const int st = b / 1024, sb = b % 1024, swz = sb ^ (((sb >> 9) & 1) << 5); R = (st >> 1) * 16 + swz / 64; C = (st & 1) * 32 + (swz % 64) / 2; }
__host__ __device__ __forceinline__ int perm32(int rho) { const int n = rho >> 4, i = rho & 15; return 8 * (i >> 2) + 4 * n + (i & 3); }
struct Unit { int pm, pn, ks, g; };
struct Gemm { const bf16_t* A; const bf16_t* Bt; int M, N, K, lda, ldb, ksl; };
struct StaticOrder {
    int nM, nN, nwg, G, c;
    __host__ __device__ void init(int M, int N, int G_, int c_) { nM = M / BM; nN = N / BM; nwg = nM * nN; G = G_; c = c_; }
    static constexpr bool MULTI = false;
    __host__ __device__ bool next(int i, Unit& u) const { return at((long)i * G + c, u); }
    __host__ __device__ bool at(const long L, Unit& u) const {
        if (L >= nwg) return false;
        int wgid = (int)L; { const int q = nwg / NXCD, r = nwg % NXCD, xcd = wgid % NXCD, off = wgid / NXCD; wgid = (xcd < r ? xcd * (q + 1) : r * (q + 1) + (xcd - r) * q) + off; }
        const int nig = WGM * nN, gid = wgid / nig, fm = gid * WGM, gsz = (nM - fm) < WGM ? (nM - fm) : WGM;
        u.pm = fm + ((wgid % nig) % gsz); u.pn = (wgid % nig) / gsz; u.ks = 0; return true;
    }
    __device__ __forceinline__ void a_ready(const Unit&) const {}
    __device__ __forceinline__ void done(const Unit&) const {}
};
__device__ __forceinline__ unsigned cvt_pk_bf16(float lo, float hi) { return cvtpk(lo, hi); }
struct SplitOrder {
    static constexpr bool MULTI = false;
    int KS, c;
    __host__ __device__ bool next(int i, Unit& u) const { if (i != 0 || c >= 8 * KS) return false; const int tile = c / KS; u.ks = c % KS; u.pm = 64 + (tile >> 2); u.pn = tile & 3; return true; }
    __device__ __forceinline__ void a_ready(const Unit&) const {}
    __device__ __forceinline__ void done(const Unit&) const {}
};
struct EpiPart {
    static constexpr bool PERM = false, AFTER_DRAIN = false, HAS_MID = false;
    float* C;
    __device__ __forceinline__ void operator()(const f32x4 (&acc)[2][2][4][2], const Unit& u, int wr, int wc, int fr, int fq) const {
        const int row0 = (u.pm - 64) * BM + wr * 64 + fr, col0 = u.pn * BM + wc * 32 + 4 * fq; float* base = C + (size_t)u.ks * (512 * 1024);
#pragma unroll
        for (int ai = 0; ai < 2; ++ai)
#pragma unroll
            for (int m = 0; m < 4; ++m) { float* rowp = base + (size_t)(row0 + ai * HALF + m * 16) * 1024 + col0;
#pragma unroll
                for (int bj = 0; bj < 2; ++bj)
#pragma unroll
                    for (int n = 0; n < 2; ++n) *(f32x4*)(rowp + bj * HALF + n * 16) = acc[ai][bj][m][n]; }
    }
};
struct P1Order {
    static constexpr bool MULTI = false;
    StaticOrder so;
    __host__ __device__ void init(int G_, int c_) { so.init(64 * 256, 24 * 256, G_, c_); }
    __host__ __device__ bool next(int i, Unit& u) const {
        const long L = (long)i * so.G + so.c;
        if (L < 1536) { so.next(i, u); if (u.pn >= 4) u.pn += 4; return true; }
        u.ks = 0;
        if (L < 1536 + 56) { const int idx = (int)L - 1536; u.pm = 64 + idx / 28; u.pn = idx % 28; return true; }
        if (L < 1536 + 56 + 16) { const int idx = (int)L - 1592; u.pm = 66 + idx / 2; u.pn = 28 + idx % 2; return true; }
        return false;
    }
    __device__ __forceinline__ void a_ready(const Unit&) const {}
    __device__ __forceinline__ void done(const Unit&) const {}
};
struct EpiP1 {
    static constexpr bool PERM = true, AFTER_DRAIN = false, HAS_MID = false;
    bf16_t* Zp; int ldz; float* mk; float* mv; bf16_t* srg; unsigned char* sg; int c_rg, c_g;
    __device__ __forceinline__ void operator()(const f32x4 (&acc)[2][2][4][2], const Unit& u, int wr, int wc, int fr, int fq) const {
        if (u.pm >= 66) {
            float* base = (u.pn == 28) ? mk : mv; const int row0 = (u.pm - 66) * BM + wr * 64 + fr, col0 = wc * 32 + 8 * fq;
#pragma unroll
            for (int ai = 0; ai < 2; ++ai)
#pragma unroll
                for (int m = 0; m < 4; ++m) { float* rowp = base + (size_t)(row0 + ai * HALF + m * 16) * 256 + col0;
#pragma unroll
                    for (int bj = 0; bj < 2; ++bj) { *(f32x4*)(rowp + bj * HALF) = acc[ai][bj][m][0]; *(f32x4*)(rowp + bj * HALF + 4) = acc[ai][bj][m][1]; } }
            return;
        }
        const int row0 = u.pm * BM + wr * 64 + fr, col0 = u.pn * BM + wc * 32 + 8 * fq;
        if (u.pn * BM >= c_g) {
            unsigned char* gbase = sg + (u.pn * BM - c_g) + 16 * (4 * wc + fq);
#pragma unroll
            for (int ai = 0; ai < 2; ++ai)
#pragma unroll
                for (int m = 0; m < 4; ++m) { u32x4 q;
#define EP1_Q(x_) ((unsigned)__builtin_fmaxf(__builtin_fmaf(__builtin_amdgcn_rcpf(1.f + __expf(-(x_))), 255.f, 0.5f), 1.f))
#define EP1_Q4(v_) (EP1_Q((v_)[0]) | (EP1_Q((v_)[1]) << 8) | (EP1_Q((v_)[2]) << 16) | (EP1_Q((v_)[3]) << 24))
                    q.x = EP1_Q4(acc[ai][0][m][0]); q.y = EP1_Q4(acc[ai][0][m][1]); q.z = EP1_Q4(acc[ai][1][m][0]); q.w = EP1_Q4(acc[ai][1][m][1]);
#undef EP1_Q4
#undef EP1_Q
                    *(u32x4*)(gbase + (size_t)(row0 + ai * HALF + m * 16) * 3072) = q; }
            return;
        }
#pragma unroll
        for (int bj = 0; bj < 2; ++bj) { const int c = col0 + bj * HALF;
            if (c >= c_g + 3072) continue;
            const int kind = c >= c_g ? 2 : (c >= c_rg && c < c_rg + 1024) ? 1 : 0;
            bf16_t* dst = kind == 1 ? srg + (c - c_rg) : Zp + c; const int ld = kind == 1 ? 1024 : ldz;
#pragma unroll
            for (int ai = 0; ai < 2; ++ai)
#pragma unroll
                for (int m = 0; m < 4; ++m) { f32x4 v0 = acc[ai][bj][m][0], v1 = acc[ai][bj][m][1];
                    if (kind) {
#pragma unroll
                        for (int e = 0; e < 4; ++e) { const float s0 = __builtin_amdgcn_rcpf(1.f + __expf(-v0[e])), s1 = __builtin_amdgcn_rcpf(1.f + __expf(-v1[e]));        v0[e] = kind == 2 ? s0 : v0[e] * s0; v1[e] = kind == 2 ? s1 : v1[e] * s1; } }
                    if (kind == 2) {
#define EP1_Q(x_) ((unsigned)__builtin_fmaxf(__builtin_fmaf((x_), 255.f, 0.5f), 1.f))
                        u32x2 q; q.x = EP1_Q(v0[0]) | (EP1_Q(v0[1]) << 8) | (EP1_Q(v0[2]) << 16) | (EP1_Q(v0[3]) << 24); q.y = EP1_Q(v1[0]) | (EP1_Q(v1[1]) << 8) | (EP1_Q(v1[2]) << 16) | (EP1_Q(v1[3]) << 24);
#undef EP1_Q
                        *(u32x2*)(sg + (size_t)(row0 + ai * HALF + m * 16) * 3072 + (c - c_g)) = q; continue; }
                    u32x4 w; w.x = cvt_pk_bf16(v0[0], v0[1]); w.y = cvt_pk_bf16(v0[2], v0[3]); w.z = cvt_pk_bf16(v1[0], v1[1]); w.w = cvt_pk_bf16(v1[2], v1[3]);
                    *(u32x4*)(dst + (size_t)(row0 + ai * HALF + m * 16) * ld) = w; } }
    }
};
struct EpiF32S {
    static constexpr bool PERM = false, AFTER_DRAIN = false, HAS_MID = false;
    float* C; int ldc; int split_tiles; size_t split_stride;
    __device__ __forceinline__ void operator()(const f32x4 (&acc)[2][2][4][2], const Unit& u, int wr, int wc, int fr, int fq) const {
        int pn = u.pn; float* base = C; if (split_tiles) { const int t = pn / split_tiles; base += (size_t)t * split_stride; pn -= t * split_tiles; }
        const int row0 = u.pm * BM + wr * 64 + fr, col0 = pn * BM + wc * 32 + 4 * fq;
#pragma unroll
        for (int ai = 0; ai < 2; ++ai)
#pragma unroll
            for (int m = 0; m < 4; ++m) { float* rowp = base + (size_t)(row0 + ai * HALF + m * 16) * ldc + col0;
#pragma unroll
                for (int bj = 0; bj < 2; ++bj)
#pragma unroll
                    for (int n = 0; n < 2; ++n) *(f32x4*)(rowp + bj * HALF + n * 16) = acc[ai][bj][m][n]; }
    }
};
struct EpiBf16S {
    static constexpr bool PERM = true, AFTER_DRAIN = false, HAS_MID = false;
    bf16_t* O; int ldc;
    __device__ __forceinline__ void operator()(const f32x4 (&acc)[2][2][4][2], const Unit& u, int wr, int wc, int fr, int fq) const {
        const int row0 = u.pm * BM + wr * 64 + fr, col0 = u.pn * BM + wc * 32 + 8 * fq;
#pragma unroll
        for (int ai = 0; ai < 2; ++ai)
#pragma unroll
            for (int m = 0; m < 4; ++m) { bf16_t* rowp = O + (size_t)(row0 + ai * HALF + m * 16) * ldc + col0;
#pragma unroll
                for (int bj = 0; bj < 2; ++bj) { const f32x4 v0 = acc[ai][bj][m][0], v1 = acc[ai][bj][m][1];
                    u32x4 w; w.x = cvt_pk_bf16(v0[0], v0[1]); w.y = cvt_pk_bf16(v0[2], v0[3]); w.z = cvt_pk_bf16(v1[0], v1[1]); w.w = cvt_pk_bf16(v1[2], v1[3]);
                    *(u32x4*)(rowp + bj * HALF) = w; } }
    }
};
struct EpiSwiGLU {
    static constexpr bool PERM = true, AFTER_DRAIN = false, HAS_MID = false;
    bf16_t* O; int ldc;
    __device__ __forceinline__ void operator()(const f32x4 (&acc)[2][2][4][2], const Unit& u, int wr, int wc, int fr, int fq) const {
        const int row0 = u.pm * BM + wr * 64 + fr, col0 = u.pn * (BM / 2) + 8 * (4 * wc + fq);
#pragma unroll
        for (int ai = 0; ai < 2; ++ai)
#pragma unroll
            for (int m = 0; m < 4; ++m) { bf16_t* rowp = O + (size_t)(row0 + ai * HALF + m * 16) * ldc + col0; u32x4 w;
#pragma unroll
                for (int bj = 0; bj < 2; ++bj) { const f32x4 v0 = acc[ai][bj][m][0], v1 = acc[ai][bj][m][1];
                    const float a0 = v0[0] * __builtin_amdgcn_rcpf(1.f + __expf(-v0[0])) * v0[1], a1 = v0[2] * __builtin_amdgcn_rcpf(1.f + __expf(-v0[2])) * v0[3];
                    const float a2 = v1[0] * __builtin_amdgcn_rcpf(1.f + __expf(-v1[0])) * v1[1], a3 = v1[2] * __builtin_amdgcn_rcpf(1.f + __expf(-v1[2])) * v1[3];
                    if (bj == 0) { w.x = cvt_pk_bf16(a0, a1); w.y = cvt_pk_bf16(a2, a3); } else { w.z = cvt_pk_bf16(a0, a1); w.w = cvt_pk_bf16(a2, a3); } }
                *(u32x4*)rowp = w; }
    }
};
template <int MODE  > struct EpiGate {
    static constexpr bool PERM = true, AFTER_DRAIN = false, HAS_MID = false;
    const bf16_t* sg; const bf16_t* tin; bf16_t* tout; int ldc;
    __device__ __forceinline__ void operator()(const f32x4 (&acc)[2][2][4][2], const Unit& u, int wr, int wc, int fr, int fq) const {
        const int row0 = u.pm * BM + wr * 64 + fr, col0 = u.pn * BM + wc * 32 + 8 * fq;
#pragma unroll
        for (int ai = 0; ai < 2; ++ai)
#pragma unroll
            for (int m = 0; m < 4; ++m) { const size_t r = (size_t)(row0 + ai * HALF + m * 16);
#pragma unroll
                for (int bj = 0; bj < 2; ++bj) { const int c = col0 + bj * HALF;
                    const u32x4 gq = *(const u32x4*)(sg + r * 3072 + c); u32x4 tq = {0u, 0u, 0u, 0u}; if (MODE >= 1) tq = *(const u32x4*)(tin + r * ldc + c);
                    const f32x4 v0 = acc[ai][bj][m][0], v1 = acc[ai][bj][m][1]; u32x4 w;
#define EG_ONE(dst, x0, x1, gw_, tw_) { float a_ = (x0) * __builtin_bit_cast(float, (gw_) << 16), b_ = (x1) * __builtin_bit_cast(float, (gw_) & 0xffff0000u); \
                        if (MODE >= 1) { a_ += __builtin_bit_cast(float, (tw_) << 16); b_ += __builtin_bit_cast(float, (tw_) & 0xffff0000u); } dst = cvt_pk_bf16(a_, b_); }
                    EG_ONE(w.x, v0[0], v0[1], gq.x, tq.x) EG_ONE(w.y, v0[2], v0[3], gq.y, tq.y) EG_ONE(w.z, v1[0], v1[1], gq.z, tq.z) EG_ONE(w.w, v1[2], v1[3], gq.w, tq.w)
#undef EG_ONE
                    *(u32x4*)(tout + r * ldc + c) = w; } }
    }
};
struct P3Multi {
    static constexpr bool MULTI = true;
    const char* wsb; int G, c;
    __host__ __device__ void init(int G_, int c_) { G = G_; c = c_; }
    static __host__ __device__ __forceinline__ bool at_(long L, int nM, int nN, Unit& u) { StaticOrder so; so.nM = nM; so.nN = nN; so.nwg = nM * nN; so.G = 1; so.c = 0; return so.at(L, u); }
    __host__ __device__ bool next(int i, Unit& u) const {
        const long L = (long)i * G + c; u.ks = 0;
        if (L < 396) { u.g = 0; return at_(L, 66, 6, u); }
        if (L < 412) { const int idx = (int)L - 396; u.g = 0; u.pm = 64 + idx / 8; u.pn = 6 + idx % 8; return true; }
        if (L < 668) { u.g = 1; return at_(L - 412, 64, 4, u); }
        if (L < 924) { u.g = 2; return at_(L - 668, 4, 64, u); }
        return false;
    }
    __device__ __forceinline__ void operands(const Unit& u, const char*& A, const char*& B, int& nt) const {
        const size_t tstep = (size_t)BM * 384 * 2;
        size_t ao = WS_CQNB, bo = WS_WUQABS; nt = 6;
        if (u.g == 1) { ao = WS_CKVNB2; bo = WS_WUK2; nt = 4; }
        if (u.g == 2) { ao = WS_WUV2; bo = WS_CKVNB2; nt = 4; }
        A = wsb + ao + (size_t)u.pm * tstep; B = wsb + bo + (size_t)u.pn * tstep;
    }
    __device__ __forceinline__ void a_ready(const Unit&) const {}
    __device__ __forceinline__ void done(const Unit&) const {}
};
struct EpiP3 {
    static constexpr bool PERM = true, AFTER_DRAIN = false, HAS_MID = false;
    char* wsb; int np;
    __device__ __forceinline__ void operator()(const f32x4 (&acc)[2][2][4][2], const Unit& u, int wr, int wc, int fr, int fq) const {
        const bool ab = u.g == 0 && u.pn >= 6; const int ldc = u.g == 0 ? (ab ? 2048 : 1536) : u.g == 1 ? 1024 : np;
        const int row0 = u.pm * BM + wr * 64 + fr - (ab ? np : 0), col0 = (u.pn - (ab ? 6 : 0)) * BM + wc * 32 + 8 * fq; size_t oo = WS_QB; if (ab) oo = WS_QLATB; if (u.g == 1) oo = WS_KN; if (u.g == 2) oo = WS_VT; bf16_t* O = (bf16_t*)(wsb + oo);
#pragma unroll
        for (int ai = 0; ai < 2; ++ai)
#pragma unroll
            for (int m = 0; m < 4; ++m) { bf16_t* rowp = O + (size_t)(row0 + ai * HALF + m * 16) * ldc + col0;
#pragma unroll
                for (int bj = 0; bj < 2; ++bj) { const f32x4 v0 = acc[ai][bj][m][0], v1 = acc[ai][bj][m][1];
                    u32x4 w; w.x = cvt_pk_bf16(v0[0], v0[1]); w.y = cvt_pk_bf16(v0[2], v0[3]); w.z = cvt_pk_bf16(v1[0], v1[1]); w.w = cvt_pk_bf16(v1[2], v1[3]);
                    *(u32x4*)(rowp + bj * HALF) = w; } }
    }
};
struct TailOrder {
    static constexpr bool MULTI = true;
    const char* wsb; size_t ao, bo; int ld, ntm, KS, G, c;
    __host__ __device__ bool next(int i, Unit& u) const {
        const long L = (long)i * G + c; u.ks = 0;
        if (L < 256) { u.g = 0; return P3Multi::at_(L, 64, 4, u); }
        const int idx = (int)L - 256; if (idx >= 8 * KS) return false;
        const int tile = idx / KS; u.g = 1; u.ks = idx % KS; u.pm = 64 + (tile >> 2); u.pn = tile & 3; return true;
    }
    __device__ __forceinline__ void operands(const Unit& u, const char*& A, const char*& B, int& nt) const {
        const size_t tstep = (size_t)BM * ld * 2, ko = u.g ? (size_t)u.ks * 512 : 0;
        A = wsb + ao + (size_t)u.pm * tstep + ko; B = wsb + bo + (size_t)u.pn * tstep + ko; nt = u.g ? 4 : ntm;
    }
    __device__ __forceinline__ void a_ready(const Unit&) const {}
    __device__ __forceinline__ void done(const Unit&) const {}
};
struct EpiTail {
    static constexpr bool PERM = true, AFTER_DRAIN = false, HAS_MID = false;
    char* wsb; size_t oo, po;
    __device__ __forceinline__ void operator()(const f32x4 (&acc)[2][2][4][2], const Unit& u, int wr, int wc, int fr, int fq) const {
        const int col0 = u.pn * BM + wc * 32 + 8 * fq;
        if (u.g) {
            const int row0 = (u.pm - 64) * BM + wr * 64 + fr; float* base = (float*)(wsb + po) + (size_t)u.ks * (512 * 1024);
#pragma unroll
            for (int ai = 0; ai < 2; ++ai)
#pragma unroll
                for (int m = 0; m < 4; ++m) { float* rowp = base + (size_t)(row0 + ai * HALF + m * 16) * 1024 + col0;
#pragma unroll
                    for (int bj = 0; bj < 2; ++bj) { *(f32x4*)(rowp + bj * HALF) = acc[ai][bj][m][0]; *(f32x4*)(rowp + bj * HALF + 4) = acc[ai][bj][m][1]; } }
            return;
        }
        const int row0 = u.pm * BM + wr * 64 + fr; bf16_t* O = (bf16_t*)(wsb + oo);
#pragma unroll
        for (int ai = 0; ai < 2; ++ai)
#pragma unroll
            for (int m = 0; m < 4; ++m) { bf16_t* rowp = O + (size_t)(row0 + ai * HALF + m * 16) * 1024 + col0;
#pragma unroll
                for (int bj = 0; bj < 2; ++bj) { const f32x4 v0 = acc[ai][bj][m][0], v1 = acc[ai][bj][m][1];
                    u32x4 w; w.x = cvt_pk_bf16(v0[0], v0[1]); w.y = cvt_pk_bf16(v0[2], v0[3]); w.z = cvt_pk_bf16(v1[0], v1[1]); w.w = cvt_pk_bf16(v1[2], v1[3]);
                    *(u32x4*)(rowp + bj * HALF) = w; } }
    }
};
struct EpiGate3 {
    static constexpr bool PERM = true, AFTER_DRAIN = false, HAS_MID = true;
    const unsigned char* sg; bf16_t* out; int ldc; int t1, t2, rot, gn0, gd0, gn1, gd1, gf;
    __device__ __forceinline__ void mid(f32x4 (&acc)[2][2][4][2], const Unit& u, int wr, int wc, int fr, int fq, int seam) const {
        int row0 = u.pm * BM + wr * 64 + fr, gcol = u.pn * BM + 16 * (4 * wc + fq);
        asm volatile("" : "+v"(row0), "+v"(gcol));
        const int gna = (seam ? gn1 : gn0) * 1024, gda = (seam ? gd1 : gd0) * 1024;
#pragma unroll
        for (int ai = 0; ai < 2; ++ai)
#pragma unroll
            for (int m = 0; m < 4; ++m) { const unsigned char* gp = sg + (size_t)(row0 + ai * HALF + m * 16) * 3072 + gcol;
                const u32x4 ga = *(const u32x4*)(gp + gna), gb = *(const u32x4*)(gp + gda);
#define EG3_R(a_, b_, e_) ((float)(((a_) >> (8 * (e_))) & 0xffu) * __builtin_amdgcn_rcpf((float)(((b_) >> (8 * (e_))) & 0xffu)))
                acc[ai][0][m][0][0] *= EG3_R(ga.x, gb.x, 0); acc[ai][0][m][0][1] *= EG3_R(ga.x, gb.x, 1); acc[ai][0][m][0][2] *= EG3_R(ga.x, gb.x, 2); acc[ai][0][m][0][3] *= EG3_R(ga.x, gb.x, 3);
                acc[ai][0][m][1][0] *= EG3_R(ga.y, gb.y, 0); acc[ai][0][m][1][1] *= EG3_R(ga.y, gb.y, 1); acc[ai][0][m][1][2] *= EG3_R(ga.y, gb.y, 2); acc[ai][0][m][1][3] *= EG3_R(ga.y, gb.y, 3);
                acc[ai][1][m][0][0] *= EG3_R(ga.z, gb.z, 0); acc[ai][1][m][0][1] *= EG3_R(ga.z, gb.z, 1); acc[ai][1][m][0][2] *= EG3_R(ga.z, gb.z, 2); acc[ai][1][m][0][3] *= EG3_R(ga.z, gb.z, 3);
                acc[ai][1][m][1][0] *= EG3_R(ga.w, gb.w, 0); acc[ai][1][m][1][1] *= EG3_R(ga.w, gb.w, 1); acc[ai][1][m][1][2] *= EG3_R(ga.w, gb.w, 2); acc[ai][1][m][1][3] *= EG3_R(ga.w, gb.w, 3);
#undef EG3_R
            }
    }
    __device__ __forceinline__ void operator()(const f32x4 (&acc)[2][2][4][2], const Unit& u, int wr, int wc, int fr, int fq) const {
        const int row0 = u.pm * BM + wr * 64 + fr, col0 = u.pn * BM + wc * 32 + 8 * fq, gcol = u.pn * BM + 16 * (4 * wc + fq);
#pragma unroll
        for (int ai = 0; ai < 2; ++ai)
#pragma unroll
            for (int m = 0; m < 4; ++m) { const size_t r = (size_t)(row0 + ai * HALF + m * 16);
                const u32x4 gq4 = *(const u32x4*)(sg + r * 3072 + gf * 1024 + gcol);
#pragma unroll
                for (int bj = 0; bj < 2; ++bj) { const int c = col0 + bj * HALF; const unsigned g0_ = bj ? gq4.z : gq4.x, g1_ = bj ? gq4.w : gq4.y;
                    const f32x4 v0 = acc[ai][bj][m][0], v1 = acc[ai][bj][m][1]; u32x4 w;
#define EG3_G(g_, e_) ((float)(((g_) >> (8 * (e_))) & 0xffu) * (1.f / 255.f))
                    w.x = cvt_pk_bf16(v0[0] * EG3_G(g0_, 0), v0[1] * EG3_G(g0_, 1)); w.y = cvt_pk_bf16(v0[2] * EG3_G(g0_, 2), v0[3] * EG3_G(g0_, 3));
                    w.z = cvt_pk_bf16(v1[0] * EG3_G(g1_, 0), v1[1] * EG3_G(g1_, 1)); w.w = cvt_pk_bf16(v1[2] * EG3_G(g1_, 2), v1[3] * EG3_G(g1_, 3));
#undef EG3_G
                    *(u32x4*)(out + r * ldc + c) = w; } }
    }
};
template <class Epi, class Sched, bool ALIGN_EPI = false, bool SP2 = false>
__device__ __forceinline__ void gemm_phase(LAS unsigned char* lds, const Gemm g, const Sched& S, const Epi& E) {
    int tid_ = threadIdx.x; asm volatile("" : "+v"(tid_));
    const int tid = tid_, wid = __builtin_amdgcn_readfirstlane(tid >> 6), lane = tid & 63, wr = wid >> 2, wc = wid & 3, fr = lane & 15, fq = lane >> 4;
    const int K = g.K; int nt = K / BK;
    unsigned voffA[2], voffB[2];
#pragma unroll
    for (int i = 0; i < 2; ++i) { int R, C; stage_rc(tid * 16 + i * 8192, R, C); const int Rb = Epi::PERM ? ((R & ~31) + perm32(R & 31)) : R;
        voffA[i] = (unsigned)(R * g.lda + C) * 2u; voffB[i] = (unsigned)(Rb * g.ldb + C) * 2u; }
    const size_t kstep = (size_t)(BK * 2);
    const size_t hstepA = (size_t)HALF * g.lda * 2, hstepB = (size_t)HALF * g.ldb * 2;
    const size_t tstepA = 2 * hstepA, tstepB = 2 * hstepB;
    const unsigned ldsw = (unsigned)wid * 1024u;
    const int aoff = lds_byte(wr * 64 + fr, fq * 8), boff = lds_byte(wc * 32 + fr, fq * 8);
#define PG8_SA(b, h) (((b) * 2 + (h)) * HTB)
#define PG8_SB(b, h) ((4 + (b) * 2 + (h)) * HTB)
#define PG8_STAGE(bufoff, gbase, voff) do { _Pragma("unroll") for (int _i = 0; _i < 2; ++_i) \
        __builtin_amdgcn_global_load_lds((const unsigned*)((const char*)(gbase) + (voff)[_i]), (LAS unsigned*)(lds + (bufoff) + ldsw + _i * 8192), 16, 0, 0); } while (0)
#define PG8_LDA(dst, b, h) do { _Pragma("unroll") for (int m = 0; m < 4; ++m) _Pragma("unroll") for (int k = 0; k < 2; ++k) dst[m][k] = *(const LAS bf16x8*)(lds + PG8_SA(b, h) + aoff + m * 2048 + k * 1024); } while (0)
#define PG8_LDB(dst, b, h) do { _Pragma("unroll") for (int n = 0; n < 2; ++n) _Pragma("unroll") for (int k = 0; k < 2; ++k) dst[n][k] = *(const LAS bf16x8*)(lds + PG8_SB(b, h) + boff + n * 2048 + k * 1024); } while (0)
#define PG8_MMA(ai, bj, At, Bt) do { __builtin_amdgcn_s_setprio(1); _Pragma("unroll") for (int m = 0; m < 4; ++m) _Pragma("unroll") for (int n = 0; n < 2; ++n) _Pragma("unroll") for (int k = 0; k < 2; ++k) \
        acc[ai][bj][m][n] = __builtin_amdgcn_mfma_f32_16x16x32_bf16(Bt[n][k], At[m][k], acc[ai][bj][m][n], 0, 0, 0); __builtin_amdgcn_s_setprio(0); } while (0)
#define PG8_WAIT_V(n) asm volatile("s_waitcnt vmcnt(" #n ")" ::: "memory")
#define PG8_WAIT_L(n) asm volatile("s_waitcnt lgkmcnt(" #n ")" ::: "memory")
#define PG8_BAR __builtin_amdgcn_s_barrier()
#define PG8_SCHED __builtin_amdgcn_sched_barrier(0)
    Unit cur, nxt; int ui = 0;
    if (!S.next(0, cur)) return;
    f32x4 acc[2][2][4][2];
#pragma unroll
    for (int a = 0; a < 2; ++a)
#pragma unroll
        for (int b = 0; b < 2; ++b)
#pragma unroll
            for (int m = 0; m < 4; ++m)
#pragma unroll
                for (int n = 0; n < 2; ++n) acc[a][b][m][n] = (f32x4){0.f, 0.f, 0.f, 0.f};
    bf16x8 At[4][2], B0[2][2], B1[2][2];
    const size_t kslb = (size_t)g.ksl * 2;
    const char* cA = (const char*)g.A + (size_t)cur.pm * tstepA + cur.ks * kslb; const char* cB = (const char*)g.Bt + (size_t)cur.pn * tstepB + cur.ks * kslb;
    if constexpr (Sched::MULTI) S.operands(cur, cA, cB, nt);
    int R = 0; if constexpr (Epi::HAS_MID) R = E.rot;
    const size_t rotb = (size_t)R * kstep;
#define PG8_PH(x_) ((size_t)((x_) + R >= nt ? (x_) + R - nt : (x_) + R) * kstep)
    S.a_ready(cur);
    if constexpr (SP2) {
        PG8_STAGE(PG8_SB(0, 0), cB + rotb, voffB); PG8_STAGE(PG8_SB(0, 1), cB + rotb + hstepB, voffB); PG8_STAGE(PG8_SA(0, 0), cA + rotb, voffA); PG8_STAGE(PG8_SA(0, 1), cA + rotb + hstepA, voffA);
        if (wr == 1) PG8_BAR;
        PG8_WAIT_V(2); PG8_BAR;
        PG8_STAGE(PG8_SB(1, 0), cB + rotb + kstep, voffB); PG8_STAGE(PG8_SA(1, 0), cA + rotb + kstep, voffA); PG8_STAGE(PG8_SB(1, 1), cB + rotb + hstepB + kstep, voffB);
        PG8_WAIT_V(6); PG8_BAR;
    } else {
        PG8_STAGE(PG8_SB(0, 0), cB + rotb, voffB); PG8_STAGE(PG8_SA(0, 0), cA + rotb, voffA); PG8_STAGE(PG8_SB(0, 1), cB + rotb + hstepB, voffB); PG8_STAGE(PG8_SA(0, 1), cA + rotb + hstepA, voffA);
        if (wr == 1) PG8_BAR;
        PG8_WAIT_V(4); PG8_BAR;
        PG8_STAGE(PG8_SB(1, 0), cB + rotb + kstep, voffB); PG8_STAGE(PG8_SA(1, 0), cA + rotb + kstep, voffA); PG8_STAGE(PG8_SB(1, 1), cB + rotb + hstepB + kstep, voffB);
        PG8_WAIT_V(6); PG8_BAR;
    }
    for (;;) {
        const bool has_next = S.next(ui + 1, nxt);
        const char* nA = has_next ? (const char*)g.A + (size_t)nxt.pm * tstepA + nxt.ks * kslb : cA; const char* nB = has_next ? (const char*)g.Bt + (size_t)nxt.pn * tstepB + nxt.ks * kslb : cB;
        int ntn = nt; if constexpr (Sched::MULTI) { if (has_next) S.operands(nxt, nA, nB, ntn); }
#pragma unroll 1
        for (int t = 0; t < nt; t += 2) {
            const bool last = (t == nt - 2);
            const char* a1 = cA + PG8_PH(t + 1);
            const char* a2 = last ? nA + rotb : cA + PG8_PH(t + 2); const char* b2 = last ? nB + rotb : cB + PG8_PH(t + 2);
            const char* a3 = a2 + kstep; const char* b3 = b2 + kstep;
            if (last && has_next) S.a_ready(nxt);
            if constexpr (Epi::HAS_MID) { if (t == E.t1 || t == E.t2) E.mid(acc, cur, wr, wc, fr, fq, t == E.t1 ? 0 : 1); }
            if constexpr (SP2) {
            PG8_LDB(B0, 0, 0); PG8_LDB(B1, 0, 1); PG8_SCHED; PG8_LDA(At, 0, 0); PG8_STAGE(PG8_SA(1, 1), a1 + hstepA, voffA);
            PG8_WAIT_V(8); PG8_WAIT_L(0); PG8_BAR; PG8_MMA(0, 0, At, B0); PG8_MMA(0, 1, At, B1); PG8_BAR; PG8_SCHED;
            PG8_LDA(At, 0, 1); PG8_STAGE(PG8_SB(0, 0), b2, voffB); PG8_STAGE(PG8_SB(0, 1), b2 + hstepB, voffB); PG8_STAGE(PG8_SA(0, 0), a2, voffA);
            PG8_WAIT_V(8); PG8_WAIT_L(0); PG8_BAR; PG8_MMA(1, 0, At, B0); PG8_MMA(1, 1, At, B1); PG8_BAR; PG8_SCHED;
            PG8_LDB(B0, 1, 0); PG8_LDB(B1, 1, 1); PG8_SCHED; PG8_LDA(At, 1, 0); PG8_STAGE(PG8_SA(0, 1), a2 + hstepA, voffA);
            PG8_WAIT_V(8); PG8_WAIT_L(0); PG8_BAR; PG8_MMA(0, 0, At, B0); PG8_MMA(0, 1, At, B1); PG8_BAR; PG8_SCHED;
            PG8_LDA(At, 1, 1); PG8_STAGE(PG8_SB(1, 0), b3, voffB); PG8_STAGE(PG8_SB(1, 1), b3 + hstepB, voffB); PG8_STAGE(PG8_SA(1, 0), a3, voffA);
            PG8_WAIT_V(8); PG8_WAIT_L(0); PG8_BAR; PG8_MMA(1, 0, At, B0); PG8_MMA(1, 1, At, B1); PG8_BAR; PG8_SCHED;
            } else {
            PG8_LDB(B0, 0, 0); PG8_SCHED; PG8_LDA(At, 0, 0); PG8_STAGE(PG8_SA(1, 1), a1 + hstepA, voffA);
            PG8_WAIT_L(8); PG8_BAR; PG8_WAIT_L(0); PG8_MMA(0, 0, At, B0); PG8_BAR; PG8_SCHED;
            PG8_LDB(B1, 0, 1); PG8_STAGE(PG8_SB(0, 0), b2, voffB);
            PG8_BAR; PG8_WAIT_L(0); PG8_MMA(0, 1, At, B1); PG8_BAR;
            PG8_LDA(At, 0, 1); PG8_STAGE(PG8_SA(0, 0), a2, voffA);
            PG8_BAR; PG8_WAIT_L(0); PG8_MMA(1, 0, At, B0); PG8_BAR; PG8_SCHED;
            PG8_STAGE(PG8_SB(0, 1), b2 + hstepB, voffB);
            PG8_WAIT_V(6); PG8_BAR; PG8_MMA(1, 1, At, B1); PG8_BAR;
            PG8_LDB(B0, 1, 0); PG8_SCHED; PG8_LDA(At, 1, 0); PG8_STAGE(PG8_SA(0, 1), a2 + hstepA, voffA);
            PG8_WAIT_L(8); PG8_BAR; PG8_WAIT_L(0); PG8_MMA(0, 0, At, B0); PG8_BAR; PG8_SCHED;
            PG8_LDB(B1, 1, 1); PG8_STAGE(PG8_SB(1, 0), b3, voffB);
            PG8_BAR; PG8_WAIT_L(0); PG8_MMA(0, 1, At, B1); PG8_BAR;
            PG8_LDA(At, 1, 1); PG8_STAGE(PG8_SA(1, 0), a3, voffA);
            PG8_BAR; PG8_WAIT_L(0); PG8_MMA(1, 0, At, B0); PG8_BAR; PG8_SCHED;
            PG8_STAGE(PG8_SB(1, 1), b3 + hstepB, voffB);
            PG8_WAIT_V(6); PG8_BAR; PG8_MMA(1, 1, At, B1); PG8_BAR;
            }
        }
        if constexpr (ALIGN_EPI) { if (wr == 0) PG8_BAR; }
        if constexpr (!Epi::AFTER_DRAIN) { E(acc, cur, wr, wc, fr, fq); S.done(cur); }
        if (!has_next) break;
#pragma unroll
        for (int a = 0; a < 2; ++a)
#pragma unroll
            for (int b = 0; b < 2; ++b)
#pragma unroll
                for (int m = 0; m < 4; ++m)
#pragma unroll
                    for (int n = 0; n < 2; ++n) acc[a][b][m][n] = (f32x4){0.f, 0.f, 0.f, 0.f};
        cur = nxt; cA = nA; cB = nB; nt = ntn; ++ui;
        if constexpr (ALIGN_EPI) { if (wr == 1) PG8_BAR; }
    }
    PG8_WAIT_V(0);
    if constexpr (!ALIGN_EPI) { if (wr == 0) PG8_BAR; }
    PG8_BAR;
    if constexpr (Epi::AFTER_DRAIN) { E.fused(acc, cur, wr, wc, fr, fq, lds, wid, lane); S.done(cur); }
#undef PG8_PH
#undef PG8_SA
#undef PG8_SB
#undef PG8_STAGE
#undef PG8_LDA
#undef PG8_LDB
#undef PG8_MMA
#undef PG8_WAIT_V
#undef PG8_WAIT_L
#undef PG8_BAR
#undef PG8_SCHED
}
}
typedef unsigned short bf16_t;
DI unsigned pk2(float lo, float hi) { return pg8::cvt_pk_bf16(lo, hi); }
DI bf16_t f2bf(float f) { return (bf16_t)(pg8::cvt_pk_bf16(f, 0.f) & 0xffffu); }
DI void transpose_item(const float* W, int N, bf16_t* WT, int ldt, int row_off, int rmul, LAS float* scr, int item, int lane, int pitch) {
    const int nblk = N / 32, kb = item / nblk, nb = item % nblk, k0 = 64 * kb, n0 = 32 * nb;
    float v[32];
#pragma unroll
    for (int i = 0; i < 32; ++i) v[i] = W[(size_t)(k0 + 2 * i + (lane >> 5)) * pitch + n0 + (lane & 31)];
#pragma unroll
    for (int i = 0; i < 32; ++i) scr[(2 * i + (lane >> 5)) * 33 + (lane & 31)] = v[i];
    asm volatile("s_waitcnt lgkmcnt(0)" ::: "memory");
    const int c = lane & 7;
#pragma unroll
    for (int j = 0; j < 4; ++j) { const int n = (lane >> 3) + 8 * j; const LAS float* sp = scr + (8 * c) * 33 + n;
        pg8::u32x4 o; o.x = pk2(sp[0 * 33], sp[1 * 33]); o.y = pk2(sp[2 * 33], sp[3 * 33]); o.z = pk2(sp[4 * 33], sp[5 * 33]); o.w = pk2(sp[6 * 33], sp[7 * 33]);
        const int j_ = n0 + n, jl_ = j_ & 127, r_ = jl_ & 7; const int row_ = rmul == 2 ? 256 * (j_ >> 7) + (r_ < 4 ? 0 : 128) + 8 * (jl_ >> 3) + 2 * (r_ & 3) + row_off : row_off + rmul * j_;
        *(pg8::u32x4*)(WT + (size_t)row_ * ldt + k0 + 8 * c) = o; }
    asm volatile("s_waitcnt lgkmcnt(0)" ::: "memory");
}
DI void transpose_w(const float* W, int K, int N, bf16_t* WT, int ldt, int row_off, LAS float* scr, int gw, int NGW, int lane, int& rot, int rmul = 1, int pitch = 0) {
    const int nitems = (K / 64) * (N / 32);
    int first = gw - (rot % NGW); if (first < 0) first += NGW;
    for (int it = first; it < nitems; it += NGW) transpose_item(W, N, WT, ldt, row_off, rmul, scr, it, lane, pitch ? pitch : N);
    rot += nitems;
}

struct Args {
    const float* in[29]; float* out; unsigned char* ws; int ph_lo, ph_hi, sub, pad;
};

DI unsigned short f2bf_raw(float f) { unsigned u = __builtin_bit_cast(unsigned, f); return (unsigned short)((u + 0x7fffu + ((u >> 16) & 1u)) >> 16); }
DI void sgemm_naive(LAS float* lds, const float* __restrict__ A, int lda, const float* __restrict__ B, long sbk, long sbn,
                    float* __restrict__ C, int ldc, int M, int N, int K, int bid, int G, unsigned short* Cb = nullptr) {
    LAS float* As = lds;
    LAS float* Bs = lds + 16 * 132;
    const int tid = threadIdx.x, tx = tid & 15, ty = tid >> 4;
    const int ntn = N / 64, ntiles = (M / 128) * ntn;
    for (int t = bid; t < ntiles; t += G) {
        const int m0 = (t / ntn) * 128, n0 = (t % ntn) * 64;
        float acc[4][4];
#pragma unroll
        for (int i = 0; i < 4; ++i)
#pragma unroll
            for (int j = 0; j < 4; ++j) acc[i][j] = 0.f;
        for (int k0 = 0; k0 < K; k0 += 16) {
            {
                const int r = tid >> 2, kq = (tid & 3) * 4;
                const float4 v = *(const float4*)(A + (size_t)(m0 + r) * lda + k0 + kq);
                As[(kq + 0) * 132 + r] = v.x; As[(kq + 1) * 132 + r] = v.y; As[(kq + 2) * 132 + r] = v.z; As[(kq + 3) * 132 + r] = v.w;
            }
#pragma unroll
            for (int i = 0; i < 2; ++i) {
                const int idx = tid + i * 512, kk = idx >> 6, nn = idx & 63;
                Bs[kk * 64 + nn] = B[(size_t)(k0 + kk) * sbk + (size_t)(n0 + nn) * sbn];
            }
            __syncthreads();
#pragma unroll
            for (int kk = 0; kk < 16; ++kk) {
                const f32x4 a = *(const LAS f32x4*)(As + kk * 132 + ty * 4);
                const f32x4 b = *(const LAS f32x4*)(Bs + kk * 64 + tx * 4);
                const float av[4] = {a.x, a.y, a.z, a.w}, bv[4] = {b.x, b.y, b.z, b.w};
#pragma unroll
                for (int i = 0; i < 4; ++i)
#pragma unroll
                    for (int j = 0; j < 4; ++j) acc[i][j] += av[i] * bv[j];
            }
            __syncthreads();
        }
#pragma unroll
        for (int i = 0; i < 4; ++i) {
            float4 o; o.x = acc[i][0]; o.y = acc[i][1]; o.z = acc[i][2]; o.w = acc[i][3];
            if (Cb) { unsigned short* cb = Cb + (size_t)(m0 + ty * 4 + i) * ldc + n0 + tx * 4; cb[0] = f2bf_raw(o.x); cb[1] = f2bf_raw(o.y); cb[2] = f2bf_raw(o.z); cb[3] = f2bf_raw(o.w); }
            else *(float4*)(C + (size_t)(m0 + ty * 4 + i) * ldc + n0 + tx * 4) = o;
        }
    }
}

template <int DQK, int DV, bool V_IN_K, int MODE, class KV, class QF>
DI void attn_naive(LAS float* lds, const KV& kv, int nk_loop, const QF& qf, bool active, int limit, float scale, float lg, int tq, float* optr) {
    constexpr int KS = DQK + 1;
    constexpr int VS = V_IN_K ? KS : DV;
    LAS float* Ks = lds;
    LAS float* Vs = V_IN_K ? Ks : (lds + 64 * KS);
    LAS float* qs = lds + 64 * KS + (V_IN_K ? 0 : 64 * DV);
    LAS float* ps = qs + 8 * DQK;
    static_assert((64 * KS + (V_IN_K ? 0 : 64 * DV) + 8 * DQK + 8 * 64) * 4 <= MISC_OFF, "attn_naive LDS");
    const int tid = threadIdx.x, lane = tid & 63, w = tid >> 6;
    __syncthreads();
    for (int d = lane; d < DQK; d += 64) qs[w * DQK + d] = active ? qf(d) : 0.f;
    float m = -INFINITY, l = 0.f;
    float acc[DV / 64];
#pragma unroll
    for (int c = 0; c < DV / 64; ++c) acc[c] = 0.f;
    for (int base = 0; base < nk_loop; base += 64) {
        __syncthreads();
        for (int idx = tid; idx < 64 * DQK; idx += NTHREADS) { const int j = idx / DQK, d = idx - j * DQK, key = base + j; Ks[j * KS + d] = key < nk_loop ? kv.k(key, d) : 0.f; }
        if (!V_IN_K) for (int idx = tid; idx < 64 * DV; idx += NTHREADS) { const int j = idx / DV, e = idx - j * DV, key = base + j; Vs[j * DV + e] = key < nk_loop ? kv.v(key, e) : 0.f; }
        __syncthreads();
        const int key = base + lane; const bool valid = active && key <= limit && key < nk_loop;
        float s = 0.f;
        for (int d = 0; d < DQK; ++d) s += qs[w * DQK + d] * Ks[lane * KS + d];
        float p;
        if (MODE == 0) {
            s *= scale;
            const float cm = wave_max(valid ? s : -INFINITY);
            const float mn = fmaxf(m, cm);
            const float alpha = (mn == -INFINITY) ? 1.f : expf(m - mn);
            p = valid ? expf(s - mn) : 0.f;
            l = l * alpha + wave_sum(p);
#pragma unroll
            for (int c = 0; c < DV / 64; ++c) acc[c] *= alpha;
            m = mn;
        } else {
            p = valid ? s * expf((float)(tq - key) * lg) : 0.f;
        }
        ps[w * 64 + lane] = p;
        __syncthreads();
        for (int j = 0; j < 64; ++j) { const float pj = ps[w * 64 + j];
#pragma unroll
            for (int c = 0; c < DV / 64; ++c) acc[c] += pj * Vs[j * VS + lane + 64 * c]; }
    }
    if (active) {
#pragma unroll
        for (int c = 0; c < DV / 64; ++c) optr[lane + 64 * c] = (MODE == 0) ? acc[c] / l : acc[c];
    }
}

struct KvMlaPrompt { const float* ckvn; const float* kper; int b;
    DI float k(int key, int d) const { const size_t row = (size_t)b * SEQ + key; return d < KVL ? ckvn[row * KVL + d] : kper[row * DROPE + (d - KVL)]; }
    DI float v(int, int) const { return 0.f; } };
struct KvMlaSample { const float* ckvn; const float* kper; const float* cckv; const float* ckpe; const int* pt; int b;
    DI float k(int key, int d) const {
        if (key < PAST) { const size_t r = (size_t)pt[b * NPAGES + (key >> 7)] * PAGE + (key & (PAGE - 1)); return d < KVL ? cckv[r * KVL + d] : ckpe[r * DROPE + (d - KVL)]; }
        const size_t row = (size_t)NP + b * DS + (key - PAST); return d < KVL ? ckvn[row * KVL + d] : kper[row * DROPE + (d - KVL)]; }
    DI float v(int, int) const { return 0.f; } };
struct KvRet { const float* rk; const float* z; int b, h;
    DI float k(int key, int d) const { return rk[((size_t)b * SEQ + key) * 512 + h * RDK + d]; }
    DI float v(int key, int e) const { return z[((size_t)b * SEQ + key) * ZLD + C_RV + h * RDV + e]; } };
struct KvMem { const float* mk; const float* mv; int b, h;
    DI float k(int key, int d) const { return mk[(((size_t)b * NMEM + key) * XH + h) * XHD + d]; }
    DI float v(int key, int e) const { return mv[(((size_t)b * NMEM + key) * XH + h) * XHD + e]; } };


typedef float f32x16 __attribute__((ext_vector_type(16)));
typedef short bf16x8 __attribute__((ext_vector_type(8)));
typedef short s16x4 __attribute__((ext_vector_type(4)));
typedef unsigned u32x4_t __attribute__((ext_vector_type(4)));
typedef unsigned u32x2_t __attribute__((ext_vector_type(2)));
DI int crow(int i, int h) { return (i & 3) + 8 * (i >> 2) + 4 * h; }
#define MFMA32(a, b, c) __builtin_amdgcn_mfma_f32_32x32x16_bf16((a), (b), (c), 0, 0, 0)
template <int DQK, int DV, bool CAUSAL, class Src, int PRELOAD = 0  >
DI void flash_unit(LAS unsigned char* lds, const Src& src, int qpos0, int ntiles, bf16_t* O, int ldo, float c2) {
    constexpr int KP = DQK + 8, VP = 68, KS = DQK / 16, NBLK = DV / 32;
    constexpr int KBYTES = 64 * KP * 2, VBYTES = DV * VP * 2, BUF = KBYTES + VBYTES;
    constexpr int D8 = DQK / 8, NPK = (64 * D8) / NTHREADS, NPV = (DV * 8) / NTHREADS;
    static_assert((64 * D8) % NTHREADS == 0 && (DV * 8) % NTHREADS == 0 && 2 * BUF <= 131072 && PRELOAD * BUF <= 131072, "flash_unit geometry");
    const int tid = threadIdx.x, lane = tid & 63, w = __builtin_amdgcn_readfirstlane(tid >> 6), l31 = lane & 31, h = lane >> 5;
    bf16x8 qf[KS];
    {
        constexpr int QP = DQK + 8, QD8 = DQK / 8, NPQ = (256 * QD8) / NTHREADS;
        static_assert((256 * QD8) % NTHREADS == 0 && 256 * QP * 2 <= 131072, "flash_unit Q staging");
        int tq = threadIdx.x; asm volatile("" : "+v"(tq));
        u32x4_t qr[NPQ];
#pragma unroll
        for (int i = 0; i < NPQ; ++i) { const int p = tq + i * NTHREADS; qr[i] = src.qpiece(p / QD8, p % QD8); }
        __syncthreads();
#pragma unroll
        for (int i = 0; i < NPQ; ++i) { const int p = tq + i * NTHREADS; *(LAS u32x4_t*)(lds + ((p / QD8) * QP + (p % QD8) * 8) * 2) = qr[i]; }
        __syncthreads();
        { const int qrow = (tq >> 6) * 32 + (tq & 31), qh = (tq >> 5) & 1;
#pragma unroll
          for (int s_ = 0; s_ < KS; ++s_) qf[s_] = *(const LAS bf16x8*)(lds + (qrow * QP + 16 * s_ + 8 * qh) * 2); }
    }
    src.post_q(qf, 32 * w + l31, h);
    f32x16 o[NBLK];
#pragma unroll
    for (int b = 0; b < NBLK; ++b)
#pragma unroll
        for (int i = 0; i < 16; ++i) o[b][i] = 0.f;
    float m = -INFINITY, lsum = 0.f;
    u32x4_t kreg[NPK], vreg[NPV];
#define FL_LOAD(t_) do { _Pragma("unroll") for (int i_ = 0; i_ < NPK; ++i_) { const int p_ = tid + i_ * NTHREADS; kreg[i_] = src.kpiece(64 * (t_) + p_ / D8, p_ % D8); } \
                         _Pragma("unroll") for (int i_ = 0; i_ < NPV; ++i_) { const int p_ = tid + i_ * NTHREADS; vreg[i_] = src.vpiece(p_ >> 3, 64 * (t_) + 8 * (p_ & 7)); } } while (0)
#define FL_STORE(buf_) do { _Pragma("unroll") for (int i_ = 0; i_ < NPK; ++i_) { const int p_ = tid + i_ * NTHREADS; *(LAS u32x4_t*)(lds + (buf_) * BUF + ((p_ / D8) * KP + (p_ % D8) * 8) * 2) = kreg[i_]; } \
                          _Pragma("unroll") for (int i_ = 0; i_ < NPV; ++i_) { const int p_ = tid + i_ * NTHREADS; LAS unsigned char* a_ = lds + (buf_) * BUF + KBYTES + ((p_ >> 3) * VP + (p_ & 7) * 8) * 2; \
                              *(LAS u32x2_t*)a_ = (u32x2_t){vreg[i_].x, vreg[i_].y}; *(LAS u32x2_t*)(a_ + 8) = (u32x2_t){vreg[i_].z, vreg[i_].w}; } } while (0)
    __syncthreads();
    if constexpr (PRELOAD > 0) {
        u32x4_t kr[PRELOAD][NPK], vr[PRELOAD][NPV];
#pragma unroll
        for (int t_ = 0; t_ < PRELOAD; ++t_) {
#pragma unroll
            for (int i_ = 0; i_ < NPK; ++i_) { const int p_ = tid + i_ * NTHREADS; kr[t_][i_] = src.kpiece(64 * t_ + p_ / D8, p_ % D8); }
#pragma unroll
            for (int i_ = 0; i_ < NPV; ++i_) { const int p_ = tid + i_ * NTHREADS; vr[t_][i_] = src.vpiece(p_ >> 3, 64 * t_ + 8 * (p_ & 7)); } }
#pragma unroll
        for (int t_ = 0; t_ < PRELOAD; ++t_) {
#pragma unroll
            for (int i_ = 0; i_ < NPK; ++i_) kreg[i_] = kr[t_][i_];
#pragma unroll
            for (int i_ = 0; i_ < NPV; ++i_) vreg[i_] = vr[t_][i_];
            FL_STORE(t_); }
    } else { FL_LOAD(0); FL_STORE(0); }
    __syncthreads();
    const int qmine = qpos0 + 32 * w + l31, qlast = qpos0 + 32 * w + 31;
    for (int t = 0; t < ntiles; ++t) {
        const int buf = PRELOAD > 0 ? t : (t & 1);
        if (PRELOAD == 0 && t + 1 < ntiles) FL_LOAD(t + 1);
        if (!CAUSAL || 64 * t <= qlast) {
            const LAS unsigned char* kb_ = lds + buf * BUF; const LAS unsigned char* vb_ = kb_ + KBYTES;
            f32x16 st[2];
#pragma unroll
            for (int kb = 0; kb < 2; ++kb) {
#pragma unroll
                for (int i = 0; i < 16; ++i) st[kb][i] = 0.f;
#pragma unroll
                for (int g_ = 0; g_ < KS / 4; ++g_) { bf16x8 kf[4];
#pragma unroll
                    for (int j = 0; j < 4; ++j) kf[j] = *(const LAS bf16x8*)(kb_ + ((32 * kb + l31) * KP + 16 * (4 * g_ + j) + 8 * h) * 2);
#pragma unroll
                    for (int j = 0; j < 4; ++j) st[kb] = MFMA32(kf[j], qf[4 * g_ + j], st[kb]);
                    }
            }
            if (CAUSAL && 64 * t + 63 > qpos0 + 32 * w) {
#pragma unroll
                for (int kb = 0; kb < 2; ++kb)
#pragma unroll
                    for (int i = 0; i < 16; ++i) { const int key = 64 * t + 32 * kb + crow(i, h); st[kb][i] = key <= qmine ? st[kb][i] : -INFINITY; }
            }
            float mx = -INFINITY;
#pragma unroll
            for (int kb = 0; kb < 2; ++kb)
#pragma unroll
                for (int i = 0; i < 16; ++i) mx = fmaxf(mx, st[kb][i]);
            mx = fmaxf(mx, __shfl_xor(mx, 32));
            const float mn = fmaxf(m, mx);
            { const float alpha = __builtin_amdgcn_exp2f((m - mn) * c2);
                lsum *= alpha;
#pragma unroll
                for (int b = 0; b < NBLK; ++b)
#pragma unroll
                    for (int i = 0; i < 16; ++i) o[b][i] *= alpha;
                m = mn;
            }
            const float nmc = -mn * c2;
            float ps = 0.f;
#pragma unroll
            for (int kb = 0; kb < 2; ++kb)
#pragma unroll
                for (int i = 0; i < 16; ++i) { const float p = __builtin_amdgcn_exp2f(__builtin_fmaf(st[kb][i], c2, nmc)); st[kb][i] = p; ps += p; }
            lsum += ps;
            bf16x8 pf[4];
#pragma unroll
            for (int ks = 0; ks < 4; ++ks) { const int kb = ks >> 1, s2 = ks & 1; u32x4_t pk;
                pk.x = cvtpk(st[kb][8 * s2 + 0], st[kb][8 * s2 + 1]); pk.y = cvtpk(st[kb][8 * s2 + 2], st[kb][8 * s2 + 3]);
                pk.z = cvtpk(st[kb][8 * s2 + 4], st[kb][8 * s2 + 5]); pk.w = cvtpk(st[kb][8 * s2 + 6], st[kb][8 * s2 + 7]); pf[ks] = __builtin_bit_cast(bf16x8, pk); }
#pragma unroll
            for (int b = 0; b < NBLK; ++b) { bf16x8 vf[4];
#pragma unroll
                for (int ks = 0; ks < 4; ++ks) { const LAS unsigned char* a_ = vb_ + ((32 * b + l31) * VP + 16 * ks + 4 * h) * 2;
                    const s16x4 lo = *(const LAS s16x4*)a_, hi = *(const LAS s16x4*)(a_ + 16);
                    vf[ks] = __builtin_shufflevector(lo, hi, 0, 1, 2, 3, 4, 5, 6, 7); }
#pragma unroll
                for (int ks = 0; ks < 4; ++ks) o[b] = MFMA32(vf[ks], pf[ks], o[b]);
                }
        }
        if constexpr (PRELOAD == 0) { if (t + 1 < ntiles) FL_STORE(buf ^ 1);
            __syncthreads(); }
    }
#undef FL_LOAD
#undef FL_STORE
    lsum += __shfl_xor(lsum, 32);
    const float inv = 1.f / lsum;
    constexpr int OPT = DV + 8;
    static_assert(256 * OPT * 2 <= 131072 && (256 * (DV / 8)) % NTHREADS == 0, "flash_unit output tile");
    __syncthreads();
    int t2 = threadIdx.x; asm volatile("" : "+v"(t2));
    { const int orow_ = (t2 >> 6) * 32 + (t2 & 31), oh_ = (t2 >> 5) & 1;
#pragma unroll
    for (int b = 0; b < NBLK; ++b)
#pragma unroll
        for (int g = 0; g < 4; ++g) { u32x2_t pk; pk.x = cvtpk(o[b][4 * g + 0] * inv, o[b][4 * g + 1] * inv); pk.y = cvtpk(o[b][4 * g + 2] * inv, o[b][4 * g + 3] * inv);
            *(LAS u32x2_t*)(lds + (orow_ * OPT + 32 * b + 8 * g + 4 * oh_) * 2) = pk; } }
    __syncthreads();
#pragma unroll
    for (int i = 0; i < (256 * (DV / 8)) / NTHREADS; ++i) { const int p = t2 + i * NTHREADS, row = p / (DV / 8), pc = p % (DV / 8);
        *(u32x4_t*)(O + (size_t)row * ldo + 8 * pc) = *(const LAS u32x4_t*)(lds + (row * OPT + 8 * pc) * 2); }
}
DI void rope_frag_pair(bf16x8& x1, bf16x8& x2, const float* __restrict__ cosr, const float* __restrict__ sinr, int f0) {
    const f32x4 c0 = *(const f32x4*)(cosr + f0), c1 = *(const f32x4*)(cosr + f0 + 4), s0 = *(const f32x4*)(sinr + f0), s1 = *(const f32x4*)(sinr + f0 + 4);
    const u32x4_t a = __builtin_bit_cast(u32x4_t, x1), b = __builtin_bit_cast(u32x4_t, x2); u32x4_t oa, ob;
#define RFP_ONE(i_, cl_, ch_, sl_, sh_) { const float al = __builtin_bit_cast(float, a[i_] << 16), ah = __builtin_bit_cast(float, a[i_] & 0xffff0000u), bl = __builtin_bit_cast(float, b[i_] << 16), bh = __builtin_bit_cast(float, b[i_] & 0xffff0000u); \
        oa[i_] = cvtpk(al * (cl_) - bl * (sl_), ah * (ch_) - bh * (sh_)); ob[i_] = cvtpk(al * (sl_) + bl * (cl_), ah * (sh_) + bh * (ch_)); }
    RFP_ONE(0, c0[0], c0[1], s0[0], s0[1]) RFP_ONE(1, c0[2], c0[3], s0[2], s0[3]) RFP_ONE(2, c1[0], c1[1], s1[0], s1[1]) RFP_ONE(3, c1[2], c1[3], s1[2], s1[3])
#undef RFP_ONE
    x1 = __builtin_bit_cast(bf16x8, oa); x2 = __builtin_bit_cast(bf16x8, ob);
}
struct SrcMlaP { const bf16_t* kn; const bf16_t* kpe; const bf16_t* vt; const bf16_t* qraw; const float* cosb; const float* sinb; int b, hh; size_t row0;
    DI bf16x8 qfrag(int r, int s_, int h8) const { return *(const bf16x8*)(qraw + (row0 + r) * 1536 + hh * DQH + 16 * s_ + 8 * h8); }
    DI u32x4_t qpiece(int r, int pc) const { return *(const u32x4_t*)(qraw + (row0 + r) * 1536 + hh * DQH + 8 * pc); }
    template <int KS_> DI void post_q(bf16x8 (&qf)[KS_], int r, int h8) const {
        const int p = (int)((row0 + r) & (SEQ - 1));
#pragma unroll
        for (int j = 0; j < 2; ++j) rope_frag_pair(qf[8 + j], qf[10 + j], cosb + p * 32, sinb + p * 32, 16 * j + 8 * h8);
    }
    DI u32x4_t kpiece(int key, int d8) const { const size_t row = (size_t)b * SEQ + key;
        return d8 < 16 ? *(const u32x4_t*)(kn + row * 1024 + hh * DNOPE + d8 * 8) : *(const u32x4_t*)(kpe + row * DROPE + (d8 - 16) * 8); }
    DI u32x4_t vpiece(int dv, int key0) const { return *(const u32x4_t*)(vt + (size_t)(hh * DVH + dv) * NP + (size_t)b * SEQ + key0); } };
struct SrcMemP { const bf16_t* mk; const bf16_t* mvt; const bf16_t* xq; int b, hh; size_t row0;
    DI bf16x8 qfrag(int r, int s_, int h8) const { return *(const bf16x8*)(xq + (row0 + r) * ZLD + hh * XHD + 16 * s_ + 8 * h8); }
    DI u32x4_t qpiece(int r, int pc) const { return *(const u32x4_t*)(xq + (row0 + r) * ZLD + hh * XHD + 8 * pc); }
    template <int KS_> DI void post_q(bf16x8 (&)[KS_], int, int) const {}
    DI u32x4_t kpiece(int key, int d8) const { return *(const u32x4_t*)(mk + ((size_t)b * NMEM + key) * 256 + hh * XHD + d8 * 8); }
    DI u32x4_t vpiece(int dv, int key0) const { return *(const u32x4_t*)(mvt + (size_t)(hh * XHD + dv) * (NB * NMEM) + (size_t)b * NMEM + key0); } };


typedef short v4i16_t __attribute__((ext_vector_type(4)));
DI s16x4 vtr(const LAS unsigned char* p) { return __builtin_bit_cast(s16x4, __builtin_amdgcn_ds_read_tr16_b64_v4i16((LAS v4i16_t*)p)); }
constexpr int MS_NSPLIT = 2, MS_KEYS = PAST / MS_NSPLIT, MS_TILES = MS_KEYS / 64;
DI void mla_sample_unit(LAS unsigned char* lds, const float* __restrict__ cckv, const float* __restrict__ ckpe, const int* __restrict__ pt,
                        const bf16_t* __restrict__ QLATb, const bf16_t* __restrict__ Qraw, const float* __restrict__ cosb, const float* __restrict__ sinb, float* __restrict__ PO, float* __restrict__ PML, int b, int split, float c2, int key_begin, int ntiles) {
    constexpr int KP = 328, KBYTES = 64 * KP * 2, SP = 68;
    LAS float* Sc = (LAS float*)(lds + 2 * KBYTES);
    int tid_ = threadIdx.x; asm volatile("" : "+v"(tid_));
    const int tid = tid_, lane = tid & 63, w = __builtin_amdgcn_readfirstlane(tid >> 6), l31 = lane & 31, hh = lane >> 5, l15 = lane & 15, g4 = lane >> 4;
    const int kg = w >> 1, qg = w & 1;
    bf16x8 qf[10];
    { const int qi = 16 * qg + l15, t = qi >> 3, head = qi & 7;
      const bf16_t* ql = QLATb + (size_t)(b * DS + t) * 2048 + head * KVL + 8 * g4;
      const bf16_t* qp = Qraw + (size_t)(NP + b * DS + t) * 1536 + head * DQH + DNOPE + 8 * g4;
#pragma unroll
      for (int s_ = 0; s_ < 8; ++s_) qf[s_] = *(const bf16x8*)(ql + 32 * s_);
#pragma unroll
      for (int s_ = 0; s_ < 2; ++s_) qf[8 + s_] = *(const bf16x8*)(qp + 32 * s_);
      rope_frag_pair(qf[8], qf[9], cosb + (SEQ + t) * 32, sinb + (SEQ + t) * 32, 8 * g4); }
    f32x16 o;
#pragma unroll
    for (int i = 0; i < 16; ++i) o[i] = 0.f;
    float m = -INFINITY, lsum = 0.f;
    f32x4 crA[8], prA[2], crB[8], prB[2];
    const unsigned voffc = (unsigned)(((tid >> 6) * KVL + 4 * (tid & 63)) * 4), voffp = (unsigned)(((tid >> 4) * DROPE + 4 * (tid & 15)) * 4);
#define MS_LOAD(t_, CR_, PR_) do { const int key0_ = key_begin + 64 * (t_); const int pg_ = __builtin_amdgcn_readfirstlane(pt[b * NPAGES + (key0_ >> 7)]); \
        const size_t rowb_ = (size_t)pg_ * PAGE + (key0_ & (PAGE - 1)); const char* cb_ = (const char*)(cckv + rowb_ * KVL); const char* pb_ = (const char*)(ckpe + rowb_ * DROPE); \
        _Pragma("unroll") for (int i_ = 0; i_ < 8; ++i_) CR_[i_] = __builtin_nontemporal_load((const f32x4*)(cb_ + (size_t)i_ * (8 * KVL * 4) + voffc)); \
        _Pragma("unroll") for (int i_ = 0; i_ < 2; ++i_) PR_[i_] = __builtin_nontemporal_load((const f32x4*)(pb_ + (size_t)i_ * (32 * DROPE * 4) + voffp)); } while (0)
#define MS_STORE(buf_, CR_, PR_) do { \
        _Pragma("unroll") for (int i_ = 0; i_ < 8; ++i_) { const int pc_ = tid + i_ * NTHREADS; *(LAS u32x2_t*)(lds + (buf_) * KBYTES + ((pc_ >> 6) * KP + 4 * (pc_ & 63)) * 2) = (u32x2_t){cvtpk(CR_[i_][0], CR_[i_][1]), cvtpk(CR_[i_][2], CR_[i_][3])}; } \
        _Pragma("unroll") for (int i_ = 0; i_ < 2; ++i_) { const int pc_ = tid + i_ * NTHREADS; *(LAS u32x2_t*)(lds + (buf_) * KBYTES + ((pc_ >> 4) * KP + KVL + 4 * (pc_ & 15)) * 2) = (u32x2_t){cvtpk(PR_[i_][0], PR_[i_][1]), cvtpk(PR_[i_][2], PR_[i_][3])}; } } while (0)
    __syncthreads();
    MS_LOAD(0, crA, prA); MS_LOAD(1, crB, prB); MS_STORE(0, crA, prA); MS_LOAD(2, crA, prA);
    __syncthreads();
    const int q4 = (lane & 15) >> 2, p4 = lane & 3, blk = (lane >> 4) & 1;
    auto tile = [&](const int buf) __attribute__((always_inline)) {
        const LAS unsigned char* kb_ = lds + buf * KBYTES;
        {   f32x4 s4 = {0.f, 0.f, 0.f, 0.f};
            const LAS unsigned char* kr_ = kb_ + ((16 * kg + l15) * KP + 8 * g4) * 2;
#pragma unroll
            for (int g_ = 0; g_ < 2; ++g_) { bf16x8 kf[5];
#pragma unroll
                for (int j = 0; j < 5; ++j) kf[j] = *(const LAS bf16x8*)(kr_ + 64 * (5 * g_ + j));
#pragma unroll
                for (int j = 0; j < 5; ++j) s4 = __builtin_amdgcn_mfma_f32_16x16x32_bf16(kf[j], qf[5 * g_ + j], s4, 0, 0, 0); }
            *(LAS f32x4*)(Sc + (16 * qg + l15) * SP + 16 * kg + 4 * g4) = s4; }
        __syncthreads();
        f32x4 sv[8];
#pragma unroll
        for (int i = 0; i < 8; ++i) sv[i] = *(const LAS f32x4*)(Sc + l31 * SP + 8 * i + 4 * hh);
        float mx = -INFINITY;
#pragma unroll
        for (int i = 0; i < 8; ++i) mx = fmaxf(mx, fmaxf(fmaxf(sv[i][0], sv[i][1]), fmaxf(sv[i][2], sv[i][3])));
        mx = fmaxf(mx, __shfl_xor(mx, 32));
        const float mn = fmaxf(m, mx);
        if (__builtin_amdgcn_ballot_w64(mn > m) != 0ull) {
            const float alpha = __builtin_amdgcn_exp2f((m - mn) * c2);
            lsum *= alpha;
#pragma unroll
            for (int i = 0; i < 16; ++i) o[i] *= alpha;
            m = mn;
        }
        const float nmc = -mn * c2;
        float ps = 0.f;
#pragma unroll
        for (int i = 0; i < 8; ++i)
#pragma unroll
            for (int e = 0; e < 4; ++e) { const float p = __builtin_amdgcn_exp2f(__builtin_fmaf(sv[i][e], c2, nmc)); sv[i][e] = p; ps += p; }
        lsum += ps;
#pragma unroll
        for (int ks = 0; ks < 4; ++ks) { const LAS unsigned char* a_ = kb_ + ((16 * ks + 4 * hh + q4) * KP + 32 * w + 16 * blk + 4 * p4) * 2;
            const s16x4 lo = vtr(a_), hi = vtr(a_ + 8 * KP * 2);
            const bf16x8 vf = __builtin_shufflevector(lo, hi, 0, 1, 2, 3, 4, 5, 6, 7); u32x4_t pk;
            pk.x = cvtpk(sv[2 * ks][0], sv[2 * ks][1]); pk.y = cvtpk(sv[2 * ks][2], sv[2 * ks][3]);
            pk.z = cvtpk(sv[2 * ks + 1][0], sv[2 * ks + 1][1]); pk.w = cvtpk(sv[2 * ks + 1][2], sv[2 * ks + 1][3]);
            o = MFMA32(vf, __builtin_bit_cast(bf16x8, pk), o); }
    };
    static_assert(MS_TILES % 2 == 0 && MS_TILES >= 4 && 2 * KBYTES + 32 * SP * 4 <= MISC_OFF, "mla_sample_unit pipeline");
#pragma unroll 1
    for (int t = 0; t < ntiles; t += 2) {
        tile(0);
        MS_STORE(1, crB, prB);
        if (t + 3 < ntiles) MS_LOAD(t + 3, crB, prB);
        __syncthreads();
        tile(1);
        if (t + 2 < ntiles) { MS_STORE(0, crA, prA); }
        if (t + 4 < ntiles) MS_LOAD(t + 4, crA, prA);
        __syncthreads();
    }
#undef MS_LOAD
#undef MS_STORE
    lsum += __shfl_xor(lsum, 32);
    const int item = b * MS_NSPLIT + split;
    if (w == 0 && lane < 32) { PML[(item * 32 + lane) * 2] = m * c2; PML[(item * 32 + lane) * 2 + 1] = lsum; }
#pragma unroll
    for (int g = 0; g < 4; ++g) *(f32x4*)(PO + ((size_t)item * 32 + l31) * KVL + 32 * w + 8 * g + 4 * hh) = (f32x4){o[4 * g + 0], o[4 * g + 1], o[4 * g + 2], o[4 * g + 3]};
}


DI void ret_fused_phase(LAS unsigned char* lds, const bf16_t* __restrict__ RQt, const bf16_t* __restrict__ RKt, const bf16_t* __restrict__ RVT, bf16_t* __restrict__ ORETb, float* __restrict__ state_out, int bid, int G) {
    constexpr int PITCH = 136, KT_B = 128 * PITCH * 2, VT_B = 32 * PITCH * 2, NCH = SEQ / 128;
    int tid_ = threadIdx.x; asm volatile("" : "+v"(tid_));
    const int tid = tid_, lane = tid & 63, w = __builtin_amdgcn_readfirstlane(tid >> 6), l31 = lane & 31, hh = lane >> 5;
    const int ib = w < 4 ? 3 - (w >> 1) : (w >> 1) - 2, kh = w & 1;
    const int q4 = (lane & 15) >> 2, p4 = lane & 3, blk = (lane >> 4) & 1;
    LAS unsigned char* Kt = lds; LAS unsigned char* Vt = lds + KT_B; LAS unsigned char* SPl = Vt + VT_B; LAS float* RED = (LAS float*)(SPl + VT_B);
    LAS unsigned char* Qt = (LAS unsigned char*)RED + 4 * 16 * 64 * 4;
    constexpr int OP = 40; LAS unsigned char* OUTs = Qt + KT_B;
    static_assert(2 * KT_B + 2 * VT_B + 4 * 16 * 64 * 4 + 128 * OP * 2 <= MISC_OFF, "ret_fused_phase LDS");
    for (int v = bid; v < NB * RH * 8; v += G) {
        const int it = ((v & 7) * 4 + (v >> 6)) * 8 + ((v >> 3) & 7);
        const int ds = it & 7, h = (it >> 3) & 3, b = it >> 5; const float g128 = __expf(128.f * lg_gamma(h));
        f32x16 S;
#pragma unroll
        for (int i = 0; i < 16; ++i) S[i] = 0.f;
        u32x4_t kregA[4], vregA, kregB[4], vregB;
        const unsigned voffk = (unsigned)(((tid >> 4) * 512 + 8 * (tid & 15)) * 2), voffv = (unsigned)(((tid >> 4) * NT + 8 * (tid & 15)) * 2), voffo = (unsigned)(((tid >> 2) * 1024 + 8 * (tid & 3)) * 2);
#define RF_LOAD(c_, kreg, vreg) do { const size_t tok0_ = (size_t)b * SEQ + (c_) * 128; const char* kb_ = (const char*)(RKt + tok0_ * 512 + h * RDK); \
            _Pragma("unroll") for (int i_ = 0; i_ < 4; ++i_) kreg[i_] = *(const u32x4_t*)(kb_ + (size_t)i_ * (32 * 512 * 2) + voffk); \
            vreg = *(const u32x4_t*)((const char*)(RVT + (size_t)(h * RDV + 32 * ds) * NT + tok0_) + voffv); } while (0)
#define RF_LOADQ(c_, Q_) do { const char* qb_ = (const char*)(RQt + ((size_t)b * SEQ + (c_) * 128) * 512 + h * RDK); _Pragma("unroll") for (int i_ = 0; i_ < 4; ++i_) Q_[i_] = *(const u32x4_t*)(qb_ + (size_t)i_ * (32 * 512 * 2) + voffk); } while (0)
        bf16x8 qf[4]; u32x4_t qfnA[4], qfnB[4];
        RF_LOAD(0, kregA, vregA); RF_LOADQ(0, qfnA); RF_LOAD(1, kregB, vregB); RF_LOADQ(1, qfnB);
        __syncthreads();
        for (int i = tid; i < VT_B / 16; i += NTHREADS) *(LAS u32x4_t*)(SPl + i * 16) = (u32x4_t){0u, 0u, 0u, 0u};
#define RF_FLUSH(c_) do { char* ob_ = (char*)(ORETb + ((size_t)b * SEQ + (c_) * 128) * 1024 + h * RDV + 32 * ds); \
            *(u32x4_t*)(ob_ + voffo) = *(const LAS u32x4_t*)(OUTs + ((tid >> 2) * OP + 8 * (tid & 3)) * 2); } while (0)
        auto chunk = [&](const int c, u32x4_t (&kreg)[4], u32x4_t& vreg, u32x4_t (&qfn)[4]) __attribute__((always_inline)) {
#pragma unroll
            for (int i = 0; i < 4; ++i) { const int p = tid + i * NTHREADS; *(LAS u32x4_t*)(Kt + ((p >> 4) * PITCH + 8 * (p & 15)) * 2) = kreg[i]; }
            *(LAS u32x4_t*)(Vt + ((tid >> 4) * PITCH + 8 * (tid & 15)) * 2) = vreg;
#pragma unroll
            for (int i = 0; i < 4; ++i) { const int p = tid + i * NTHREADS; *(LAS u32x4_t*)(Qt + ((p >> 4) * PITCH + 8 * (p & 15)) * 2) = qfn[i]; }
            __syncthreads();
#pragma unroll
            for (int s_ = 0; s_ < 4; ++s_) qf[s_] = *(const LAS bf16x8*)(Qt + ((32 * ib + l31) * PITCH + 64 * kh + 16 * s_ + 8 * hh) * 2);
            RF_FLUSH(c > 0 ? c - 1 : 0);
            { const int cn = c + 2 < NCH ? c + 2 : NCH - 1; RF_LOAD(cn, kreg, vreg); RF_LOADQ(cn, qfn); }
            f32x16 o;
#pragma unroll
            for (int i = 0; i < 16; ++i) o[i] = 0.f;
#pragma unroll 1
            for (int jb = 0; jb <= ib; ++jb) {
                f32x16 x;
#pragma unroll
                for (int i = 0; i < 16; ++i) x[i] = 0.f;
#pragma unroll
                for (int s_ = 0; s_ < 4; ++s_) { const bf16x8 kf = *(const LAS bf16x8*)(Kt + ((32 * jb + l31) * PITCH + 64 * kh + 16 * s_ + 8 * hh) * 2); x = MFMA32(kf, qf[s_], x); }
                if (jb == ib) {
#pragma unroll
                    for (int i = 0; i < 16; ++i) x[i] = (crow(i, hh) <= l31) ? x[i] : 0.f;
                }
#pragma unroll
                for (int s2 = 0; s2 < 2; ++s2) {
                    u32x4_t pk; pk.x = cvtpk(x[8 * s2 + 0], x[8 * s2 + 1]); pk.y = cvtpk(x[8 * s2 + 2], x[8 * s2 + 3]); pk.z = cvtpk(x[8 * s2 + 4], x[8 * s2 + 5]); pk.w = cvtpk(x[8 * s2 + 6], x[8 * s2 + 7]);
                    const LAS unsigned char* vp = Vt + (l31 * PITCH + 32 * jb + 16 * s2 + 4 * hh) * 2;
                    const s16x4 lo = *(const LAS s16x4*)vp, hi = *(const LAS s16x4*)(vp + 16);
                    o = MFMA32(__builtin_shufflevector(lo, hi, 0, 1, 2, 3, 4, 5, 6, 7), __builtin_bit_cast(bf16x8, pk), o); }
            }
#pragma unroll
            for (int s_ = 0; s_ < 4; ++s_) { const bf16x8 sf = *(const LAS bf16x8*)(SPl + (l31 * PITCH + 64 * kh + 16 * s_ + 8 * hh) * 2); o = MFMA32(sf, qf[s_], o); }
#pragma unroll
            for (int i = 0; i < 8; ++i) RED[((ib * 2 + kh) * 8 + i) * 64 + lane] = kh ? o[i] : o[8 + i];
            if (w < 4) {
                f32x16 u;
#pragma unroll
                for (int i = 0; i < 16; ++i) u[i] = 0.f;
#pragma unroll
                for (int s_ = 0; s_ < 8; ++s_) { const LAS unsigned char* a_ = Kt + ((16 * s_ + 4 * hh + q4) * PITCH + 32 * w + 16 * blk + 4 * p4) * 2;
                    const s16x4 alo = vtr(a_), ahi = vtr(a_ + 8 * PITCH * 2);
                    const LAS unsigned char* vp = Vt + (l31 * PITCH + 16 * s_ + 4 * hh) * 2;
                    const s16x4 blo = *(const LAS s16x4*)vp, bhi = *(const LAS s16x4*)(vp + 16);
                    u = MFMA32(__builtin_shufflevector(alo, ahi, 0, 1, 2, 3, 4, 5, 6, 7), __builtin_shufflevector(blo, bhi, 0, 1, 2, 3, 4, 5, 6, 7), u); }
#pragma unroll
                for (int i = 0; i < 16; ++i) S[i] = S[i] * g128 + u[i];
            }
            __syncthreads();
#pragma unroll
            for (int g = 0; g < 2; ++g) { const LAS float* rp = RED + ((ib * 2 + (kh ^ 1)) * 8 + 4 * g) * 64 + lane;
                const float o0 = (kh ? o[8 + 4 * g + 0] : o[4 * g + 0]) + rp[0], o1 = (kh ? o[8 + 4 * g + 1] : o[4 * g + 1]) + rp[64], o2 = (kh ? o[8 + 4 * g + 2] : o[4 * g + 2]) + rp[128], o3 = (kh ? o[8 + 4 * g + 3] : o[4 * g + 3]) + rp[192];
                *(LAS u32x2_t*)(OUTs + ((32 * ib + l31) * OP + 16 * kh + 8 * g + 4 * hh) * 2) = (u32x2_t){cvtpk(o0, o1), cvtpk(o2, o3)}; }
            if (w < 4) {
#pragma unroll
                for (int g = 0; g < 4; ++g) *(LAS u32x2_t*)(SPl + (l31 * PITCH + 32 * w + 8 * g + 4 * hh) * 2) = (u32x2_t){cvtpk(S[4 * g + 0] * g128, S[4 * g + 1] * g128), cvtpk(S[4 * g + 2] * g128, S[4 * g + 3] * g128)};
            }
                };
        static_assert(NCH % 2 == 0, "chunk pairs");
#pragma unroll 1
        for (int c = 0; c < NCH; c += 2) { chunk(c, kregA, vregA, qfnA); chunk(c + 1, kregB, vregB, qfnB); }
        __syncthreads();
        RF_FLUSH(NCH - 1);
#undef RF_LOAD
#undef RF_LOADQ
#undef RF_FLUSH
        if (w < 4) {
            float* so = state_out + ((size_t)(b * RH + h) * RDK + 32 * w) * RDV + 32 * ds + l31;
#pragma unroll
            for (int i = 0; i < 16; ++i) so[(size_t)crow(i, hh) * RDV] = S[i];
        }
    }
}

DI void ret_fused64_phase(LAS unsigned char* lds, const bf16_t* __restrict__ RQt, const bf16_t* __restrict__ RKt, const bf16_t* __restrict__ RVT, bf16_t* __restrict__ ORETb, float* __restrict__ state_out, int item) {
    constexpr int PITCH = 136, KT_B = 128 * PITCH * 2, VT_B = 64 * PITCH * 2, NCH = SEQ / 128, OP = 72;
    int tid_ = threadIdx.x; asm volatile("" : "+v"(tid_));
    const int tid = tid_, lane = tid & 63, w = __builtin_amdgcn_readfirstlane(tid >> 6), l31 = lane & 31, hh = lane >> 5;
    const int ib = w < 4 ? 3 - (w >> 1) : (w >> 1) - 2, kh = w & 1;
    const int sd = w & 3, sv = w >> 2;
    const int q4 = (lane & 15) >> 2, p4 = lane & 3, blk = (lane >> 4) & 1;
    LAS unsigned char* Kt = lds; LAS unsigned char* Vt = lds + KT_B; LAS unsigned char* SPl = Vt + VT_B; LAS unsigned* REDb = (LAS unsigned*)(SPl + VT_B);
    LAS unsigned char* Qt = (LAS unsigned char*)REDb + 8 * 8 * 64 * 4; LAS unsigned char* OUTs = Qt + KT_B;
    static_assert(2 * KT_B + 2 * VT_B + 8 * 8 * 64 * 4 + 128 * OP * 2 <= MISC_OFF, "ret_fused64_phase LDS");
    {
        const int ds = item & 3, h = (item >> 2) & 3, b = item >> 4; const float g128 = __expf(128.f * lg_gamma(h));
        f32x16 S;
#pragma unroll
        for (int i = 0; i < 16; ++i) S[i] = 0.f;
        u32x4_t kregA[4], vregA[2], qregA[4], kregB[4], vregB[2], qregB[4];
        const unsigned voffk = (unsigned)(((tid >> 4) * 512 + 8 * (tid & 15)) * 2), voffv = (unsigned)(((tid >> 4) * NT + 8 * (tid & 15)) * 2), voffo = (unsigned)(((tid >> 3) * 1024 + 8 * (tid & 7)) * 2);
#define R6_LOAD(c_, kreg, vreg, qreg) do { const size_t tok0_ = (size_t)b * SEQ + (c_) * 128; const char* kb_ = (const char*)(RKt + tok0_ * 512 + h * RDK); const char* qb_ = (const char*)(RQt + tok0_ * 512 + h * RDK); \
            const char* vb_ = (const char*)(RVT + (size_t)(h * RDV + 64 * ds) * NT + tok0_); \
            _Pragma("unroll") for (int i_ = 0; i_ < 4; ++i_) { kreg[i_] = *(const u32x4_t*)(kb_ + (size_t)i_ * (32 * 512 * 2) + voffk); qreg[i_] = *(const u32x4_t*)(qb_ + (size_t)i_ * (32 * 512 * 2) + voffk); } \
            _Pragma("unroll") for (int i_ = 0; i_ < 2; ++i_) vreg[i_] = *(const u32x4_t*)(vb_ + (size_t)i_ * ((size_t)32 * NT * 2) + voffv); } while (0)
#define R6_FLUSH(c_) do { char* ob_ = (char*)(ORETb + ((size_t)b * SEQ + (c_) * 128) * 1024 + h * RDV + 64 * ds); \
            _Pragma("unroll") for (int i_ = 0; i_ < 2; ++i_) *(u32x4_t*)(ob_ + (size_t)i_ * (64 * 1024 * 2) + voffo) = *(const LAS u32x4_t*)(OUTs + (((tid >> 3) + 64 * i_) * OP + 8 * (tid & 7)) * 2); } while (0)
        bf16x8 qf[4];
        R6_LOAD(0, kregA, vregA, qregA); R6_LOAD(1, kregB, vregB, qregB);
        __syncthreads();
        for (int i = tid; i < VT_B / 16; i += NTHREADS) *(LAS u32x4_t*)(SPl + i * 16) = (u32x4_t){0u, 0u, 0u, 0u};
        auto chunk = [&](const int c, u32x4_t (&kreg)[4], u32x4_t (&vreg)[2], u32x4_t (&qreg)[4]) __attribute__((always_inline)) {
#pragma unroll
            for (int i = 0; i < 4; ++i) { const int p = tid + i * NTHREADS; *(LAS u32x4_t*)(Kt + ((p >> 4) * PITCH + 8 * (p & 15)) * 2) = kreg[i]; *(LAS u32x4_t*)(Qt + ((p >> 4) * PITCH + 8 * (p & 15)) * 2) = qreg[i]; }
#pragma unroll
            for (int i = 0; i < 2; ++i) { const int p = tid + i * NTHREADS; *(LAS u32x4_t*)(Vt + ((p >> 4) * PITCH + 8 * (p & 15)) * 2) = vreg[i]; }
            __syncthreads();
#pragma unroll
            for (int s_ = 0; s_ < 4; ++s_) qf[s_] = *(const LAS bf16x8*)(Qt + ((32 * ib + l31) * PITCH + 64 * kh + 16 * s_ + 8 * hh) * 2);
            R6_FLUSH(c > 0 ? c - 1 : 0);
            { const int cn = c + 2 < NCH ? c + 2 : NCH - 1; R6_LOAD(cn, kreg, vreg, qreg); }
            f32x16 o[2];
#pragma unroll
            for (int nb = 0; nb < 2; ++nb)
#pragma unroll
                for (int i = 0; i < 16; ++i) o[nb][i] = 0.f;
#pragma unroll 1
            for (int jb = 0; jb <= ib; ++jb) {
                f32x16 x;
#pragma unroll
                for (int i = 0; i < 16; ++i) x[i] = 0.f;
#pragma unroll
                for (int s_ = 0; s_ < 4; ++s_) { const bf16x8 kf = *(const LAS bf16x8*)(Kt + ((32 * jb + l31) * PITCH + 64 * kh + 16 * s_ + 8 * hh) * 2); x = MFMA32(kf, qf[s_], x); }
                if (jb == ib) {
#pragma unroll
                    for (int i = 0; i < 16; ++i) x[i] = (crow(i, hh) <= l31) ? x[i] : 0.f;
                }
#pragma unroll
                for (int s2 = 0; s2 < 2; ++s2) {
                    u32x4_t pk; pk.x = cvtpk(x[8 * s2 + 0], x[8 * s2 + 1]); pk.y = cvtpk(x[8 * s2 + 2], x[8 * s2 + 3]); pk.z = cvtpk(x[8 * s2 + 4], x[8 * s2 + 5]); pk.w = cvtpk(x[8 * s2 + 6], x[8 * s2 + 7]);
#pragma unroll
                    for (int nb = 0; nb < 2; ++nb) { const LAS unsigned char* vp = Vt + ((32 * nb + l31) * PITCH + 32 * jb + 16 * s2 + 4 * hh) * 2;
                        const s16x4 lo = *(const LAS s16x4*)vp, hi = *(const LAS s16x4*)(vp + 16);
                        o[nb] = MFMA32(__builtin_shufflevector(lo, hi, 0, 1, 2, 3, 4, 5, 6, 7), __builtin_bit_cast(bf16x8, pk), o[nb]); } }
            }
#pragma unroll
            for (int s_ = 0; s_ < 4; ++s_)
#pragma unroll
                for (int nb = 0; nb < 2; ++nb) { const bf16x8 sf = *(const LAS bf16x8*)(SPl + ((32 * nb + l31) * PITCH + 64 * kh + 16 * s_ + 8 * hh) * 2); o[nb] = MFMA32(sf, qf[s_], o[nb]); }
#pragma unroll
            for (int i = 0; i < 8; ++i) REDb[(w * 8 + i) * 64 + lane] = kh ? cvtpk(o[0][2 * i], o[0][2 * i + 1]) : cvtpk(o[1][2 * i], o[1][2 * i + 1]);
            {
                f32x16 u;
#pragma unroll
                for (int i = 0; i < 16; ++i) u[i] = 0.f;
#pragma unroll
                for (int s_ = 0; s_ < 8; ++s_) { const LAS unsigned char* a_ = Kt + ((16 * s_ + 4 * hh + q4) * PITCH + 32 * sd + 16 * blk + 4 * p4) * 2;
                    const s16x4 alo = vtr(a_), ahi = vtr(a_ + 8 * PITCH * 2);
                    const LAS unsigned char* vp = Vt + ((32 * sv + l31) * PITCH + 16 * s_ + 4 * hh) * 2;
                    const s16x4 blo = *(const LAS s16x4*)vp, bhi = *(const LAS s16x4*)(vp + 16);
                    u = MFMA32(__builtin_shufflevector(alo, ahi, 0, 1, 2, 3, 4, 5, 6, 7), __builtin_shufflevector(blo, bhi, 0, 1, 2, 3, 4, 5, 6, 7), u); }
#pragma unroll
                for (int i = 0; i < 16; ++i) S[i] = S[i] * g128 + u[i];
            }
            __syncthreads();
            {
                const LAS unsigned* rp = REDb + ((w ^ 1) * 8) * 64 + lane;
#pragma unroll
                for (int g = 0; g < 4; ++g) { const unsigned r0 = rp[(2 * g) * 64], r1 = rp[(2 * g + 1) * 64];
                    const float o0 = (kh ? o[1][4 * g + 0] : o[0][4 * g + 0]) + __builtin_bit_cast(float, r0 << 16), o1 = (kh ? o[1][4 * g + 1] : o[0][4 * g + 1]) + __builtin_bit_cast(float, r0 & 0xffff0000u),
                                o2 = (kh ? o[1][4 * g + 2] : o[0][4 * g + 2]) + __builtin_bit_cast(float, r1 << 16), o3 = (kh ? o[1][4 * g + 3] : o[0][4 * g + 3]) + __builtin_bit_cast(float, r1 & 0xffff0000u);
                    *(LAS u32x2_t*)(OUTs + ((32 * ib + l31) * OP + 32 * kh + 8 * g + 4 * hh) * 2) = (u32x2_t){cvtpk(o0, o1), cvtpk(o2, o3)}; }
            }
#pragma unroll
            for (int g = 0; g < 4; ++g) *(LAS u32x2_t*)(SPl + ((32 * sv + l31) * PITCH + 32 * sd + 8 * g + 4 * hh) * 2) = (u32x2_t){cvtpk(S[4 * g + 0] * g128, S[4 * g + 1] * g128), cvtpk(S[4 * g + 2] * g128, S[4 * g + 3] * g128)};
        };
        static_assert(NCH % 2 == 0, "chunk pairs");
#pragma unroll 1
        for (int c = 0; c < NCH; c += 2) { chunk(c, kregA, vregA, qregA); chunk(c + 1, kregB, vregB, qregB); }
        __syncthreads();
        R6_FLUSH(NCH - 1);
#undef R6_LOAD
#undef R6_FLUSH
        {
            float* so = state_out + ((size_t)(b * RH + h) * RDK + 32 * sd) * RDV + 64 * ds + 32 * sv + l31;
#pragma unroll
            for (int i = 0; i < 16; ++i) so[(size_t)crow(i, hh) * RDV] = S[i];
        }
    }
}

struct QPtr { const float* p; DI float operator()(int d) const { return p[d]; } };
struct QMla { const float* ql; const float* qp; DI float operator()(int d) const { return d < KVL ? ql[d] : qp[d - KVL]; } };
DI void rms_row(const float* x, const float* g, float* o, int n, int lane) {
    float s = 0.f;
    for (int i = lane; i < n; i += 64) { const float v = x[i]; s += v * v; }
    const float r = rsqrtf(wave_sum(s) / (float)n + EPS);
    for (int i = lane; i < n; i += 64) o[i] = x[i] * r * g[i];
}

DI void rms_row_bf16(const float* x, const float* g, bf16_t* o, int n, int lane) {
    float s = 0.f;
    for (int i = lane; i < n; i += 64) { const float v = x[i]; s += v * v; }
    const float r = rsqrtf(wave_sum(s) / (float)n + EPS);
    for (int i = lane; i < n; i += 64) o[i] = f2bf(x[i] * r * g[i]);
}
#define GEMM_PHASE(EPI, ...) pg8::gemm_phase<EPI, pg8::StaticOrder, true, true>(__VA_ARGS__)
#define GEMM_SPLIT(...) pg8::gemm_phase<pg8::EpiPart, pg8::SplitOrder, true, true>(__VA_ARGS__)
__global__ void __launch_bounds__(NTHREADS, 2) fwd_kernel(Args args) {
    extern __shared__ __attribute__((aligned(16))) unsigned char lds_raw[];
    LAS unsigned char* ldsb = (LAS unsigned char*)lds_raw;
    LAS float* lds = (LAS float*)ldsb;
    volatile LAS unsigned* MISC = (volatile LAS unsigned*)(ldsb + MISC_OFF);
    const int tid = threadIdx.x, lane = tid & 63, wave = tid >> 6;
    const int G = gridDim.x, bid = blockIdx.x;
    const int gw = bid * NWAVES + wave, NGW = G * NWAVES;
    unsigned char* ws = args.ws;
    float* out = args.out;
    const int lo = args.ph_lo, hi = args.ph_hi;

    if (tid < 64) MISC[tid] = 0u;
    __syncthreads();
    XcdBarrier bar; bar.bar = (unsigned*)(ws + WS_CTL) + CW_BAR; bar.x = 0; bar.st = MISC;
    if (hi - lo > 1) bar = xcd_barrier_post((unsigned*)(ws + WS_CTL) + CW_BAR, MISC);
#define IN(k) (lo <= (k) && (k) < hi)
#define PHASE_IDS int tid_l_ = threadIdx.x; asm volatile("" : "+v"(tid_l_)); const int tid = tid_l_, lane = tid & 63, wave = tid >> 6, gw = bid * NWAVES + wave; (void)tid; (void)lane; (void)wave; (void)gw;
#define SEAM(k) do { if (IN(k) && IN((k) + 1)) xcd_barrier(bar); } while (0)

#define x_prompt ((const float*)(args.in[0]))
#define x_sample ((const float*)(args.in[1]))
#define mem_prompt ((const float*)(args.in[2]))
#define cache_ckv ((const float*)(args.in[3]))
#define cache_kpe ((const float*)(args.in[4]))
#define page_table ((const int*)args.in[5])
#define state_ret ((const float*)(args.in[6]))
#define cache_mem_k ((const float*)(args.in[7]))
#define cache_mem_v ((const float*)(args.in[8]))
#define g_mix_pre ((const float*)(args.in[9]))
#define g_mix_post ((const float*)(args.in[10]))
#define g_ffn_pre ((const float*)(args.in[11]))
#define g_ffn_post ((const float*)(args.in[12]))
#define g_mem ((const float*)(args.in[13]))
#define g_qlat ((const float*)(args.in[14]))
#define g_kvlat ((const float*)(args.in[15]))
#define w_in ((const float*)(args.in[16]))
#define w_uq ((const float*)(args.in[17]))
#define w_uk ((const float*)(args.in[18]))
#define w_uv ((const float*)(args.in[19]))
#define w_mem_k ((const float*)(args.in[20]))
#define w_mem_v ((const float*)(args.in[21]))
#define w_ret_o ((const float*)(args.in[22]))
#define w_mla_o ((const float*)(args.in[23]))
#define w_x_o ((const float*)(args.in[24]))
#define w_out ((const float*)(args.in[25]))
#define w_gate ((const float*)(args.in[26]))
#define w_up ((const float*)(args.in[27]))
#define w_down ((const float*)(args.in[28]))
#define COSA ((float*)(ws + WS_COSA))
#define SINA ((float*)(ws + WS_SINA))
#define COSB ((float*)(ws + WS_COSB))
#define SINB ((float*)(ws + WS_SINB))
#define U ((float*)(ws + WS_U))
#define MN ((float*)(ws + WS_MN))
#define Zb ((bf16_t*)(ws + WS_Z))
#define RQ ((float*)(ws + WS_RQ))
#define RK ((float*)(ws + WS_RK))
#define CQN ((float*)(ws + WS_CQN))
#define CKVN ((float*)(ws + WS_CKVN))
#define KPER ((float*)(ws + WS_KPER))
#define Q ((float*)(ws + WS_Q))
#define QLAT ((float*)(ws + WS_QLAT))
#define QPE ((float*)(ws + WS_QPE))
#define ORETb ((bf16_t*)(ws + WS_ORET))
#define OLAT ((float*)(ws + WS_OLAT))
#define OX ((float*)(ws + WS_OX))
#define OMLA ((float*)(ws + WS_OMLA))
#define ORETN ((float*)(ws + WS_ORETN))
#define ARET ((float*)(ws + WS_ARET))
#define AMLA ((float*)(ws + WS_AMLA))
#define AX ((float*)(ws + WS_AX))
#define MIX ((float*)(ws + WS_MIX))
#define HPb ((bf16_t*)(ws + WS_HP))
#define Hb ((bf16_t*)(ws + WS_H))
#define F ((float*)(ws + WS_F))
#define GU ((float*)(ws + WS_GG))
#define FOb ((bf16_t*)(ws + WS_FO))
#define WinT ((bf16_t*)(ws + WS_WIN_T))
#define WmkvT ((bf16_t*)(ws + WS_WMKV_T))
#define WuqT ((bf16_t*)(ws + WS_WUQABS))
#define WabsT ((bf16_t*)(ws + WS_WUQABS) + (size_t)1536 * 384)
#define WcatT ((bf16_t*)(ws + WS_WRO_T))
#define CATb ((bf16_t*)(ws + WS_ORETNB))
#define WroT ((bf16_t*)(ws + WS_WRO_T))
#define WmoT ((bf16_t*)(ws + WS_WMO_T))
#define WxoT ((bf16_t*)(ws + WS_WXO_T))
#define WoT ((bf16_t*)(ws + WS_WO_T))
#define WguT ((bf16_t*)(ws + WS_WGU_T))
#define WdT ((bf16_t*)(ws + WS_WD_T))
#define Ub ((bf16_t*)(ws + WS_UB))
#define MNb ((bf16_t*)(ws + WS_MNB))
#define CQNb ((bf16_t*)(ws + WS_CQNB))
#define ORETNb ((bf16_t*)(ws + WS_ORETNB))
#define OMLAb ((bf16_t*)(ws + WS_OMLAB))
#define OXb ((bf16_t*)(ws + WS_OXB))
#define MIXb ((bf16_t*)(ws + WS_MIXB))
#define Fb ((bf16_t*)(ws + WS_FB))
#define ACTb ((bf16_t*)(ws + WS_ACTB))
#define WukT ((bf16_t*)(ws + WS_WUK2))
#define WuvT ((bf16_t*)(ws + WS_WUV2))
#define CKVNb ((bf16_t*)(ws + WS_CKVNB2))
#define KPERb ((bf16_t*)(ws + WS_KPERB))
#define XQb ((bf16_t*)(ws + WS_XQB))
#define MKb ((bf16_t*)(ws + WS_MKB))
#define MVT ((bf16_t*)(ws + WS_MVT))
#define KN ((bf16_t*)(ws + WS_KN))
#define VT ((bf16_t*)(ws + WS_VT))
#define Qb ((bf16_t*)(ws + WS_QB))
#define RQt ((bf16_t*)(ws + WS_RQT))
#define RKt ((bf16_t*)(ws + WS_RKT))
#define RKtT ((bf16_t*)(ws + WS_RKTT))
#define RVT ((bf16_t*)(ws + WS_RVT))
#define UT ((float*)(ws + WS_UT))
#define SPT ((bf16_t*)(ws + WS_SPT))
#define QPEb ((bf16_t*)(ws + WS_QPEB))
#define WukB ((bf16_t*)(ws + WS_WUKB))
#define PART ((float*)(ws + WS_PART))
#define SGb ((unsigned char*)(ws + WS_SGB))
#define SRGb ((bf16_t*)(ws + WS_SRGB))
#define T0b ((bf16_t*)(ws + WS_T0B))
#define T1b ((bf16_t*)(ws + WS_T1B))
#define QLATb ((bf16_t*)(ws + WS_QLATB))
#define PO ((float*)(ws + WS_PO))
#define PML ((float*)(ws + WS_PML))
    if (IN(0)) { PHASE_IDS
        for (int i = bid * NTHREADS + tid; i < NPOS * 64 + NPOS * 32; i += G * NTHREADS) {
            const bool a = i < NPOS * 64; const int j = a ? i : i - NPOS * 64; const int half = a ? 64 : 32;
            const int p = j / half, f = j % half; const int pos = p < SEQ ? p : PAST + (p - SEQ);
            const float inv = powf(10000.0f, -(float)f / (float)half);
            const float ang = (float)pos * inv;
            double rev = (double)ang * 0.15915494309189535; rev -= floor(rev);
            const float r = (float)rev;
            const float sn = __builtin_amdgcn_sinf(r), cs = __builtin_amdgcn_cosf(r);
            if (a) { COSA[j] = cs; SINA[j] = sn; } else { COSB[j] = cs; SINB[j] = sn; }
        }
#pragma unroll 1
        for (int pass = 0; pass < 2; ++pass) {
            const int nrows = pass ? NB * NMEM : NT; const float* gsrc = pass ? g_mem : g_mix_pre; bf16_t* dst = pass ? MNb : Ub;
#define P0_SRC(r_) (pass ? mem_prompt + (size_t)(r_) * DM : (r_) < NP ? x_prompt + (size_t)(r_) * DM : x_sample + (size_t)((r_) - NP) * DM)
#define P0_LOAD(r_, A_) do { const float* s_ = P0_SRC(r_); _Pragma("unroll") for (int j_ = 0; j_ < 4; ++j_) A_[j_] = *(const f32x4*)(s_ + 4 * lane + 256 * j_); } while (0)
            f32x4 gv[4];
#pragma unroll
            for (int j = 0; j < 4; ++j) gv[j] = *(const f32x4*)(gsrc + 4 * lane + 256 * j);
#pragma unroll 1
            for (int row0 = gw; row0 < nrows; row0 += 4 * NGW) {
                f32x4 a[4][4];
#pragma unroll
                for (int k = 0; k < 4; ++k) { const int r = row0 + k * NGW; if (r < nrows) P0_LOAD(r, a[k]); }
#pragma unroll
                for (int k = 0; k < 4; ++k) { const int r = row0 + k * NGW;
                    if (r < nrows) { float ss = 0.f;
#pragma unroll
                        for (int j = 0; j < 4; ++j) ss += a[k][j][0] * a[k][j][0] + a[k][j][1] * a[k][j][1] + a[k][j][2] * a[k][j][2] + a[k][j][3] * a[k][j][3];
                        const float rs = rsqrtf(wave_sum(ss) * (1.f / DM) + EPS);
#pragma unroll
                        for (int j = 0; j < 4; ++j) { const f32x4 v = a[k][j] * rs * gv[j]; *(u32x2_t*)(dst + (size_t)r * DM + 4 * lane + 256 * j) = (u32x2_t){cvtpk(v[0], v[1]), cvtpk(v[2], v[3])}; } } }
            }
#undef P0_LOAD
#undef P0_SRC
        }
        {
            LAS float* scr = lds + wave * (64 * 33);
            int rot = 0;
            transpose_w(w_in, 1024, 4032, WinT, 1024, 0, scr, gw, NGW, lane, rot, 1, DIN);
            transpose_w(w_in + 4032, 1024, 3072, WinT, 1024, C_G, scr, gw, NGW, lane, rot, 1, DIN);
            for (int i = bid * NTHREADS + tid; i < (C_G - 4032) * 1024 / 2; i += G * NTHREADS) ((unsigned*)(WinT + (size_t)4032 * 1024))[i] = 0u;
            transpose_w(w_mem_k, 1024, 256, WmkvT, 1024, 0, scr, gw, NGW, lane, rot);
            transpose_w(w_mem_v, 1024, 256, WmkvT, 1024, 256, scr, gw, NGW, lane, rot);
            transpose_w(w_uq, QL, 1536, WuqT, QL, 0, scr, gw, NGW, lane, rot);
            for (int hh = 0; hh < MH; ++hh) { transpose_w(w_uk + (size_t)hh * KVL * DNOPE, KVL, DNOPE, WukT, LP, hh * DNOPE, scr, gw, NGW, lane, rot);
                                              transpose_w(w_uv + (size_t)hh * KVL * DVH, KVL, DVH, WuvT, LP, hh * DVH, scr, gw, NGW, lane, rot); }
        }
    }
    SEAM(0);
    if (IN(1)) {
        static_assert(WS_MNB == WS_UB + (size_t)NT * 1024 * 2 && WS_WMKV_T == WS_WIN_T + (size_t)ZLD * 1024 * 2, "P1 stacks Ub|MNb and WinT|WmkvT");
        { pg8::Gemm g{Ub, WinT, NT + NB * NMEM, ZLD + 512, 1024, 1024, 1024}; pg8::P1Order S; S.init(G, bid); pg8::EpiP1 E{Zb, ZLD, out + O_MKP, out + O_MVP, SRGb, SGb, C_RG, C_G};
          pg8::gemm_phase<pg8::EpiP1, pg8::P1Order, true, true>(ldsb, g, S, E); }
        __syncthreads();
        if (bid >= 72 || G != 256) {
            const int fb = G == 256 ? bid - 72 : bid, FG = G == 256 ? G - 72 : G; const int lane = threadIdx.x & 63, wave = threadIdx.x >> 6, gw = fb * NWAVES + wave, NGW = FG * NWAVES;
            LAS float* scr = lds + wave * (64 * 33);
            int rot = 0;
            transpose_w(w_gate, 1024, DFF, WguT, 1024, 0, scr, gw, NGW, lane, rot, 2);
            transpose_w(w_up, 1024, DFF, WguT, 1024, 1, scr, gw, NGW, lane, rot, 2);
            transpose_w(w_down, DFF, 1024, WdT, DFF, 0, scr, gw, NGW, lane, rot);
            transpose_w(w_ret_o, 1024, 1024, WcatT, CATLD, 0, scr, gw, NGW, lane, rot);
            transpose_w(w_mla_o, 1024, 1024, WcatT + 1024, CATLD, 0, scr, gw, NGW, lane, rot);
            transpose_w(w_x_o, 256, 1024, WcatT + 2048, CATLD, 0, scr, gw, NGW, lane, rot);
            transpose_w(w_out, 1024, 1024, WoT, 1024, 0, scr, gw, NGW, lane, rot);
            for (int wt = gw; wt < MH * 8 * 12; wt += NGW) {
                const int cb_ = wt % 12, lb_ = (wt / 12) & 7, head = wt / 96, l31 = lane & 31, h8 = lane >> 5;
                f32x16 acc;
#pragma unroll
                for (int i = 0; i < 16; ++i) acc[i] = 0.f;
                const float* ap = w_uk + ((size_t)head * KVL + 32 * lb_ + l31) * DNOPE + 8 * h8;
                const float* bp = w_uq + (size_t)(32 * cb_ + l31) * 1536 + head * DQH + 8 * h8;
#pragma unroll
                for (int s_ = 0; s_ < 8; ++s_) { const f32x4 a0 = *(const f32x4*)(ap + 16 * s_), a1 = *(const f32x4*)(ap + 16 * s_ + 4), b0 = *(const f32x4*)(bp + 16 * s_), b1 = *(const f32x4*)(bp + 16 * s_ + 4);
                    const u32x4_t ua = {cvtpk(a0[0], a0[1]), cvtpk(a0[2], a0[3]), cvtpk(a1[0], a1[1]), cvtpk(a1[2], a1[3])}, ub = {cvtpk(b0[0], b0[1]), cvtpk(b0[2], b0[3]), cvtpk(b1[0], b1[1]), cvtpk(b1[2], b1[3])};
                    acc = MFMA32(__builtin_bit_cast(bf16x8, ua), __builtin_bit_cast(bf16x8, ub), acc); }
#pragma unroll
                for (int i = 0; i < 16; ++i) WabsT[((size_t)head * KVL + 32 * lb_ + crow(i, h8)) * QL + 32 * cb_ + l31] = f2bf(acc[i]);
            }
        }
        __syncthreads();
        { pg8::Gemm g{WinT + (size_t)C_RV * 1024, Ub, 1024, NP, 1024, 1024, 1024}; pg8::StaticOrder S; S.init(1024, NP, G, bid); pg8::EpiBf16S E{RVT, NT};
          GEMM_PHASE(pg8::EpiBf16S, ldsb, g, S, E); }
    }
    SEAM(1);
    if (IN(2)) { PHASE_IDS
        {   constexpr int row_base = 0;
            {
                const int hq = lane >> 4, f4 = (lane & 15) * 4;
                u32x2_t q1, q2, k1, k2, cv, p1, p2; u32x4_t cq8; f32x4 ca, sa, cb, sb; int p;
#define P2_LOAD(r_, Q1_, Q2_, K1_, K2_, CQ_, CV_, P1_, P2_, CA_, SA_, CB_, SB_, P_) do { const bf16_t* z_ = Zb + (size_t)(row_base + (r_)) * ZLD; P_ = pos_index(row_base + (r_)); \
                Q1_ = *(const u32x2_t*)(z_ + C_RQ + hq * RDK + f4); Q2_ = *(const u32x2_t*)(z_ + C_RQ + hq * RDK + 64 + f4); K1_ = *(const u32x2_t*)(z_ + C_RK + hq * RDK + f4); K2_ = *(const u32x2_t*)(z_ + C_RK + hq * RDK + 64 + f4); \
                CQ_ = (u32x4_t){0u, 0u, 0u, 0u}; if (lane < 48) CQ_ = *(const u32x4_t*)(z_ + C_CQ + 8 * lane); CV_ = *(const u32x2_t*)(z_ + C_CKV + 4 * lane); \
                P1_ = (u32x2_t){0u, 0u}; P2_ = P1_; CB_ = (f32x4){0.f, 0.f, 0.f, 0.f}; SB_ = CB_; \
                if (lane < 8) { P1_ = *(const u32x2_t*)(z_ + C_KPE + 4 * lane); P2_ = *(const u32x2_t*)(z_ + C_KPE + 32 + 4 * lane); CB_ = *(const f32x4*)(COSB + P_ * 32 + 4 * lane); SB_ = *(const f32x4*)(SINB + P_ * 32 + 4 * lane); } \
                CA_ = *(const f32x4*)(COSA + P_ * 64 + f4); SA_ = *(const f32x4*)(SINA + P_ * 64 + f4); } while (0)
#define BLO(x_) __builtin_bit_cast(float, (x_) << 16)
#define BHI(x_) __builtin_bit_cast(float, (x_) & 0xffff0000u)
                int r = gw;
                if (r < NT) P2_LOAD(r, q1, q2, k1, k2, cq8, cv, p1, p2, ca, sa, cb, sb, p);
                for (; r < NT; r += NGW) {
                    u32x2_t q1n, q2n, k1n, k2n, cvn, p1n, p2n; u32x4_t cq8n; f32x4 can, san, cbn, sbn; int pn;
                    if (r + NGW < NT) P2_LOAD(r + NGW, q1n, q2n, k1n, k2n, cq8n, cvn, p1n, p2n, can, san, cbn, sbn, pn);
                    const int row = row_base + r; const int il = p & 127; const bool prompt = row < NP;
                    {
                        const float x1q[4] = {BLO(q1.x), BHI(q1.x), BLO(q1.y), BHI(q1.y)}, x2q[4] = {BLO(q2.x), BHI(q2.x), BLO(q2.y), BHI(q2.y)};
                        const float x1k[4] = {BLO(k1.x), BHI(k1.x), BLO(k1.y), BHI(k1.y)}, x2k[4] = {BLO(k2.x), BHI(k2.x), BLO(k2.y), BHI(k2.y)};
                        const float sc = 0.08838834764831845f;
                        float oq1[4], oq2[4], ok1[4], ok2[4];
#pragma unroll
                        for (int e = 0; e < 4; ++e) { oq1[e] = x1q[e] * ca[e] - x2q[e] * sa[e]; oq2[e] = x1q[e] * sa[e] + x2q[e] * ca[e];
                            ok1[e] = (x1k[e] * ca[e] - x2k[e] * sa[e]) * sc; ok2[e] = (x1k[e] * sa[e] + x2k[e] * ca[e]) * sc; }
                        if (prompt) {
                            const float fq = __expf((float)(il - 127) * lg_gamma(hq)), fk = 1.f / fq;
                            *(u32x2_t*)(RQt + (size_t)row * 512 + hq * RDK + f4) = (u32x2_t){cvtpk(oq1[0] * fq, oq1[1] * fq), cvtpk(oq1[2] * fq, oq1[3] * fq)};
                            *(u32x2_t*)(RQt + (size_t)row * 512 + hq * RDK + 64 + f4) = (u32x2_t){cvtpk(oq2[0] * fq, oq2[1] * fq), cvtpk(oq2[2] * fq, oq2[3] * fq)};
                            const u32x2_t kb1 = {cvtpk(ok1[0] * fk, ok1[1] * fk), cvtpk(ok1[2] * fk, ok1[3] * fk)}, kb2 = {cvtpk(ok2[0] * fk, ok2[1] * fk), cvtpk(ok2[2] * fk, ok2[3] * fk)};
                            *(u32x2_t*)(RKt + (size_t)row * 512 + hq * RDK + f4) = kb1; *(u32x2_t*)(RKt + (size_t)row * 512 + hq * RDK + 64 + f4) = kb2;
                        } else {
                            *(f32x4*)(RQ + (size_t)row * 512 + hq * RDK + f4) = (f32x4){oq1[0], oq1[1], oq1[2], oq1[3]}; *(f32x4*)(RQ + (size_t)row * 512 + hq * RDK + 64 + f4) = (f32x4){oq2[0], oq2[1], oq2[2], oq2[3]};
                            *(f32x4*)(RK + (size_t)row * 512 + hq * RDK + f4) = (f32x4){ok1[0], ok1[1], ok1[2], ok1[3]}; *(f32x4*)(RK + (size_t)row * 512 + hq * RDK + 64 + f4) = (f32x4){ok2[0], ok2[1], ok2[2], ok2[3]};
                        }
                    }
                    {
                        const float c_[8] = {BLO(cq8.x), BHI(cq8.x), BLO(cq8.y), BHI(cq8.y), BLO(cq8.z), BHI(cq8.z), BLO(cq8.w), BHI(cq8.w)};
                        float ss = 0.f;
#pragma unroll
                        for (int e = 0; e < 8; ++e) ss += c_[e] * c_[e];
                        const float rr = rsqrtf(wave_sum(ss) * (1.f / QL) + EPS);
                        if (lane < 48) { const f32x4 g0 = *(const f32x4*)(g_qlat + 8 * lane), g1 = *(const f32x4*)(g_qlat + 8 * lane + 4);
                            *(u32x4_t*)(CQNb + (size_t)row * QL + 8 * lane) = (u32x4_t){cvtpk(c_[0] * rr * g0[0], c_[1] * rr * g0[1]), cvtpk(c_[2] * rr * g0[2], c_[3] * rr * g0[3]),
                                                                                     cvtpk(c_[4] * rr * g1[0], c_[5] * rr * g1[1]), cvtpk(c_[6] * rr * g1[2], c_[7] * rr * g1[3])}; }
                    }
                    {
                        const float v_[4] = {BLO(cv.x), BHI(cv.x), BLO(cv.y), BHI(cv.y)};
                        const float rr = rsqrtf(wave_sum(v_[0] * v_[0] + v_[1] * v_[1] + v_[2] * v_[2] + v_[3] * v_[3]) * (1.f / KVL) + EPS);
                        const f32x4 g0 = *(const f32x4*)(g_kvlat + 4 * lane); const f32x4 o_ = {v_[0] * rr * g0[0], v_[1] * rr * g0[1], v_[2] * rr * g0[2], v_[3] * rr * g0[3]};
                        float* ockv = row < NP ? out + O_CKVP + (size_t)row * KVL : out + O_CKVS + (size_t)(row - NP) * KVL;
                        __builtin_nontemporal_store(o_, (f32x4*)(ockv + 4 * lane)); if (!prompt) *(f32x4*)(CKVN + (size_t)row * KVL + 4 * lane) = o_;
                        *(u32x2_t*)(CKVNb + (size_t)row * LP + 4 * lane) = (u32x2_t){cvtpk(o_[0], o_[1]), cvtpk(o_[2], o_[3])};
                    }
                    if (lane < 8) {
                        const float x1[4] = {BLO(p1.x), BHI(p1.x), BLO(p1.y), BHI(p1.y)}, x2[4] = {BLO(p2.x), BHI(p2.x), BLO(p2.y), BHI(p2.y)};
                        f32x4 o1, o2;
#pragma unroll
                        for (int e = 0; e < 4; ++e) { o1[e] = x1[e] * cb[e] - x2[e] * sb[e]; o2[e] = x1[e] * sb[e] + x2[e] * cb[e]; }
                        if (!prompt) { *(f32x4*)(KPER + (size_t)row * DROPE + 4 * lane) = o1; *(f32x4*)(KPER + (size_t)row * DROPE + 32 + 4 * lane) = o2; }
                        float* okpe = row < NP ? out + O_KPEP + (size_t)row * DROPE : out + O_KPES + (size_t)(row - NP) * DROPE;
                        *(f32x4*)(okpe + 4 * lane) = o1; *(f32x4*)(okpe + 32 + 4 * lane) = o2;
                        *(u32x2_t*)(KPERb + (size_t)row * DROPE + 4 * lane) = (u32x2_t){cvtpk(o1[0], o1[1]), cvtpk(o1[2], o1[3])}; *(u32x2_t*)(KPERb + (size_t)row * DROPE + 32 + 4 * lane) = (u32x2_t){cvtpk(o2[0], o2[1]), cvtpk(o2[2], o2[3])};
                    }
                    q1 = q1n; q2 = q2n; k1 = k1n; k2 = k2n; cq8 = cq8n; cv = cvn; p1 = p1n; p2 = p2n; ca = can; sa = san; cb = cbn; sb = sbn; p = pn;
                }
#undef P2_LOAD
            }
        }
    }
    if (IN(2)) { PHASE_IDS
        for (int i = bid * NTHREADS + tid; i < NB * NMEM * 256; i += G * NTHREADS) { MKb[i] = f2bf(out[O_MKP + i]);
            const int f = i / (NB * NMEM), r = i - f * (NB * NMEM); MVT[i] = f2bf(out[O_MVP + (size_t)r * 256 + f]); }
    }
    SEAM(2);
    if (IN(3)) {
        pg8::Gemm g{CQNb, WuqT, NT, 1536 + 2048, QL, LP, LP}; pg8::P3Multi S; S.wsb = (const char*)ws; S.init(G, bid);
        pg8::EpiP3 E{(char*)ws, NP};
        pg8::gemm_phase<pg8::EpiP3, pg8::P3Multi, true, true>(ldsb, g, S, E);
    }
    SEAM(3);
    if (IN(5)) { PHASE_IDS
        const int yq = bid >> 3; const bool std256 = G == 256; const bool isA = !std256 || ((yq >> 1) & 1) == 0; const int yh = (yq >> 2) * 2 + (yq & 1);
        const int nidx = yh * 8 + (bid & 7);
        const int cfirst = std256 ? (isA ? DB * RH : nidx) : bid, cstride = std256 ? 128 : G;
        auto compute_units = [&]() __attribute__((always_inline)) {
        if (args.sub & 2) for (int v = bid; v < NB * MH * 4; v += G) {
            const int it = ((v & 7) * 8 + (v >> 5)) * 4 + ((v >> 3) & 3);
            const int pr = __builtin_amdgcn_readfirstlane(it & 3), hh = __builtin_amdgcn_readfirstlane((it >> 2) & 7), b = __builtin_amdgcn_readfirstlane(it >> 5);
#pragma unroll 1
            for (int half = 0; half < 2; ++half) { const int qb = __builtin_amdgcn_readfirstlane(half ? pr : 7 - pr); const size_t row0 = (size_t)b * SEQ + qb * 256;
                SrcMlaP src{KN, KPERb, VT, Qb, COSB, SINB, b, hh, row0};
                flash_unit<192, 128, true>(ldsb, src, qb * 256, 4 * (qb + 1), CATb + row0 * CATLD + 1024 + hh * DVH, CATLD, 0.07216878364870322f * 1.4426950408889634f); }
        }
        if (args.sub & 4) { if (std256) { if (isA) ret_fused64_phase(ldsb, RQt, RKt, RVT, ORETb, out + O_RETP, ((bid & 7) * 4 + (yh >> 2)) * 4 + (yh & 3)); }
                             else for (int v = bid; v < NB * RH * 4; v += G) ret_fused64_phase(ldsb, RQt, RKt, RVT, ORETb, out + O_RETP, v); }
        if (args.sub & 16) for (int it = (std256 ? (isA ? NB * XH * 8 : nidx) : bid); it < NB * XH * 8; it += cstride) {
            const int qb = __builtin_amdgcn_readfirstlane(it & 7), hh = __builtin_amdgcn_readfirstlane((it >> 3) & 3), b = __builtin_amdgcn_readfirstlane(it >> 5); const size_t row0 = (size_t)b * SEQ + qb * 256;
            SrcMemP src{MKb, MVT, Zb + C_XQ, b, hh, row0};
            flash_unit<64, 64, false, SrcMemP, 4>(ldsb, src, 0, 4, CATb + row0 * CATLD + 2048 + hh * XHD, CATLD, 0.125f * 1.4426950408889634f);
        }
        };
        const bool compute_first = ((bid >> 3) & 1) != 0;
        if (compute_first) compute_units();
        if (args.sub & 1) for (int it = bid; it < DB * MS_NSPLIT; it += G) {
            const int split = __builtin_amdgcn_readfirstlane(std256 ? (it >> 4) & 1 : it % MS_NSPLIT), b = __builtin_amdgcn_readfirstlane(std256 ? ((it >> 5) << 4) | (it & 15) : it / MS_NSPLIT);
            const int t0 = std256 ? 60 : MS_TILES, kb0 = split ? 64 * t0 : 0, nt_ = split ? 2 * MS_TILES - t0 : t0;
            mla_sample_unit(ldsb, cache_ckv, cache_kpe, page_table, QLATb, Qb, COSB, SINB, PO, PML, b, split, 0.07216878364870322f * 1.4426950408889634f, kb0, nt_); }
        if (args.sub & 8) for (int it = cfirst; it < DB * RH; it += cstride) {
            int tid_f_ = threadIdx.x; asm volatile("" : "+v"(tid_f_)); const int tid = tid_f_, lane = tid & 63, wave = tid >> 6; (void)tid; (void)lane; (void)wave;
            const int h = it & 3, b = it >> 2; const float lg = lg_gamma(h);
            const float* s0 = state_ret + (size_t)it * RDK * RDV;
            float* so = out + O_RETS + (size_t)it * RDK * RDV;
            LAS float* inner = lds;
            LAS float* qk = lds + 16;
            LAS float* vls = lds + 1040;
            LAS float* red = lds + 2064;
            f32x4 sv[16], vv[4];
#pragma unroll
            for (int r = 0; r < 16; ++r) sv[r] = __builtin_nontemporal_load((const f32x4*)(s0 + (size_t)(wave + 8 * r) * RDV + 4 * lane));
#pragma unroll
            for (int j = 0; j < DS; ++j) { const u32x2_t t_ = *(const u32x2_t*)(Zb + ((size_t)NP + b * DS + j) * ZLD + C_RV + h * RDV + 4 * lane); vv[j] = (f32x4){BLO(t_.x), BHI(t_.x), BLO(t_.y), BHI(t_.y)}; }
            __syncthreads();
            for (int i = tid; i < 1024; i += NTHREADS) { const int which = i >> 9, ti = (i >> 7) & 3, d = i & 127; const size_t row = (size_t)NP + b * DS + ti;
                qk[i] = which ? RK[row * 512 + h * RDK + d] : RQ[row * 512 + h * RDK + d]; }
            if (wave == 0) {
#pragma unroll
                for (int j = 0; j < DS; ++j) *(LAS f32x4*)(vls + j * 256 + 4 * lane) = vv[j]; }
            __syncthreads();
            for (int pr = wave; pr < 16; pr += NWAVES) { const int i = pr >> 2, j = pr & 3;
                float s_ = qk[i * 128 + lane] * qk[512 + j * 128 + lane] + qk[i * 128 + 64 + lane] * qk[512 + j * 128 + 64 + lane];
                s_ = wave_sum(s_);
                if (lane == 0) inner[pr] = (j <= i) ? s_ * __expf((float)(i - j) * lg) : 0.f; }
            const float g4 = __expf(4.f * lg), gk0 = __expf(3.f * lg), gk1 = __expf(2.f * lg), gk2 = __expf(lg);
            f32x4 po[4];
#pragma unroll
            for (int i = 0; i < 4; ++i) po[i] = (f32x4){0.f, 0.f, 0.f, 0.f};
#pragma unroll
            for (int r = 0; r < 16; ++r) { const int d = wave + 8 * r; const f32x4 sx = sv[r];
                f32x4 a = sx * g4 + (gk0 * qk[512 + d]) * vv[0] + (gk1 * qk[512 + 128 + d]) * vv[1] + (gk2 * qk[512 + 256 + d]) * vv[2] + qk[512 + 384 + d] * vv[3];
                __builtin_nontemporal_store(a, (f32x4*)(so + (size_t)d * RDV + 4 * lane));
#pragma unroll
                for (int i = 0; i < 4; ++i) po[i] += qk[i * 128 + d] * sx; }
#pragma unroll
            for (int i = 0; i < 4; ++i) *(LAS f32x4*)(red + (wave * 4 + i) * 256 + 4 * lane) = po[i];
            __syncthreads();
            {
                const int i = tid >> 7, e2 = (tid & 127) * 2;
                float o0 = 0.f, o1 = 0.f;
#pragma unroll
                for (int w_ = 0; w_ < NWAVES; ++w_) { o0 += red[(w_ * 4 + i) * 256 + e2]; o1 += red[(w_ * 4 + i) * 256 + e2 + 1]; }
                const float gi = __expf((float)(i + 1) * lg); o0 *= gi; o1 *= gi;
#pragma unroll
                for (int j = 0; j < DS; ++j) { const float w_ = inner[i * 4 + j]; o0 += w_ * vls[j * 256 + e2]; o1 += w_ * vls[j * 256 + e2 + 1]; }
                *(unsigned*)(ORETb + ((size_t)NP + b * DS + i) * 1024 + h * RDV + e2) = cvtpk(o0, o1);
            }
        }
        if (args.sub & 32) for (int it = bid; it < DB * 2; it += G) {
            int tid_f_ = threadIdx.x; asm volatile("" : "+v"(tid_f_)); const int tid = tid_f_, lane = tid & 63, wave = tid >> 6; (void)tid; (void)lane; (void)wave;
            const int hp = it & 1, b = it >> 1, kh = lane >> 5, hl = (lane >> 4) & 1;
            LAS float* sc = lds;
            LAS float* red = lds + 2048;
            const float* kb_ = cache_mem_k + (size_t)b * NMEM * 256 + hp * 128 + 4 * (lane & 31); const float* vb_ = cache_mem_v + (size_t)b * NMEM * 256 + hp * 128 + 4 * (lane & 31);
            f32x4 qr[4];
#pragma unroll
            for (int q = 0; q < DS; ++q) { const u32x2_t t_ = *(const u32x2_t*)(Zb + ((size_t)NP + b * DS + q) * ZLD + C_XQ + hp * 128 + 4 * (lane & 31)); qr[q] = (f32x4){BLO(t_.x), BHI(t_.x), BLO(t_.y), BHI(t_.y)}; }
            __syncthreads();
            f32x4 kv[16], vv[16];
#pragma unroll
            for (int kk = 0; kk < 16; ++kk) kv[kk] = __builtin_nontemporal_load((const f32x4*)(kb_ + (size_t)(32 * wave + 2 * kk + kh) * 256));
#pragma unroll
            for (int kk = 0; kk < 16; ++kk) vv[kk] = __builtin_nontemporal_load((const f32x4*)(vb_ + (size_t)(32 * wave + 2 * kk + kh) * 256));
#pragma unroll
            for (int kk = 0; kk < 16; ++kk) { const int key = 32 * wave + 2 * kk + kh;
                float pq[4];
#pragma unroll
                for (int q = 0; q < 4; ++q) { float a = kv[kk][0] * qr[q][0] + kv[kk][1] * qr[q][1] + kv[kk][2] * qr[q][2] + kv[kk][3] * qr[q][3];
                    a += __shfl_xor(a, 1); a += __shfl_xor(a, 2); a += __shfl_xor(a, 4); a += __shfl_xor(a, 8); pq[q] = a; }
                if ((lane & 15) == 0) {
#pragma unroll
                    for (int q = 0; q < 4; ++q) sc[(q * 2 + hl) * 256 + key] = pq[q] * (0.125f * 1.4426950408889634f); } }
            __syncthreads();
            {
                f32x4 v = *(LAS f32x4*)(sc + wave * 256 + 4 * lane);
                const float mx = wave_max(fmaxf(fmaxf(v[0], v[1]), fmaxf(v[2], v[3])));
#pragma unroll
                for (int e = 0; e < 4; ++e) v[e] = __builtin_amdgcn_exp2f(v[e] - mx);
                const float inv = 1.f / wave_sum(v[0] + v[1] + v[2] + v[3]);
                *(LAS f32x4*)(sc + wave * 256 + 4 * lane) = v * inv; }
            __syncthreads();
            f32x4 acc[4];
#pragma unroll
            for (int q = 0; q < 4; ++q) acc[q] = (f32x4){0.f, 0.f, 0.f, 0.f};
#pragma unroll
            for (int kk = 0; kk < 16; ++kk) { const int key = 32 * wave + 2 * kk + kh;
#pragma unroll
                for (int q = 0; q < 4; ++q) acc[q] += sc[(q * 2 + hl) * 256 + key] * vv[kk]; }
#pragma unroll
            for (int q = 0; q < 4; ++q) *(LAS f32x4*)(red + ((wave * 2 + kh) * 4 + q) * 128 + 4 * (lane & 31)) = acc[q];
            __syncthreads();
            { const int q = tid >> 7, e = tid & 127; float o0 = 0.f;
#pragma unroll
              for (int w_ = 0; w_ < 2 * NWAVES; ++w_) o0 += red[(w_ * 4 + q) * 128 + e];
              const float o1 = __shfl_xor(o0, 1);
              if ((tid & 1) == 0) *(unsigned*)(CATb + ((size_t)NP + b * DS + q) * CATLD + 2048 + hp * 128 + e) = cvtpk(o0, o1); }
        }
        if (!compute_first) compute_units();
    }
    SEAM(5);
    if (IN(6)) { PHASE_IDS
        for (int task = bid; task < (NS / 32) * MH; task += G) {
            const int head = task & 7, rb = task >> 3, b = 8 * rb + wave; const float c2 = 0.07216878364870322f * 1.4426950408889634f;
            constexpr int OLP = 264;
            LAS bf16_t* ol = (LAS bf16_t*)ldsb;
            __syncthreads();
            float kn[DS][5];
#pragma unroll
            for (int j = 0; j < DS; ++j) { const size_t krow = (size_t)NP + b * DS + j;
#pragma unroll
                for (int c = 0; c < 5; ++c) { const int d = lane + 64 * c; kn[j][c] = d < KVL ? CKVN[krow * KVL + d] : KPER[krow * DROPE + (d - KVL)]; } }
#pragma unroll
            for (int t = 0; t < DS; ++t) {
                const int qi = t * 8 + head; const size_t qrow = (size_t)b * DS + t;
                float qv[5];
#pragma unroll
                for (int c = 0; c < 5; ++c) { const int d = lane + 64 * c; const bf16_t raw = d < KVL ? QLATb[qrow * 2048 + head * KVL + d] : Qb[(NP + qrow) * 1536 + head * DQH + DNOPE + (d - KVL)];
                    qv[c] = __builtin_bit_cast(float, (unsigned)raw << 16); }
                {
                    const float xp = __shfl_xor(qv[4], 32), cs = COSB[(SEQ + t) * 32 + (lane & 31)], sn = SINB[(SEQ + t) * 32 + (lane & 31)];
                    qv[4] = lane < 32 ? qv[4] * cs - xp * sn : xp * sn + qv[4] * cs; }
                float sc[DS]; float M = -INFINITY;
#pragma unroll
                for (int j = 0; j < DS; ++j) { float a_ = 0.f;
#pragma unroll
                    for (int c = 0; c < 5; ++c) a_ += qv[c] * kn[j][c];
                    a_ = wave_sum(a_) * c2; sc[j] = (j <= t) ? a_ : -INFINITY; M = fmaxf(M, sc[j]); }
                float ms[MS_NSPLIT], ls[MS_NSPLIT];
#pragma unroll
                for (int sp = 0; sp < MS_NSPLIT; ++sp) { const int item = b * MS_NSPLIT + sp; ms[sp] = PML[(item * 32 + qi) * 2]; ls[sp] = PML[(item * 32 + qi) * 2 + 1]; M = fmaxf(M, ms[sp]); }
                float L = 0.f; float acc[4] = {0.f, 0.f, 0.f, 0.f};
#pragma unroll
                for (int sp = 0; sp < MS_NSPLIT; ++sp) { const int item = b * MS_NSPLIT + sp; const float wgt = __builtin_amdgcn_exp2f(ms[sp] - M); L += ls[sp] * wgt;
#pragma unroll
                    for (int c = 0; c < 4; ++c) acc[c] += wgt * PO[((size_t)item * 32 + qi) * KVL + lane + 64 * c]; }
#pragma unroll
                for (int j = 0; j < DS; ++j) { const float wgt = __builtin_amdgcn_exp2f(sc[j] - M); L += wgt;
#pragma unroll
                    for (int c = 0; c < 4; ++c) acc[c] += wgt * kn[j][c]; }
                const float inv = 1.f / L;
#pragma unroll
                for (int c = 0; c < 4; ++c) ol[(4 * wave + t) * OLP + lane + 64 * c] = f2bf(acc[c] * inv);
            }
            __syncthreads();
            if (wave < 4) {
                const int l31 = lane & 31, h8 = lane >> 5;
                f32x16 acc;
#pragma unroll
                for (int i = 0; i < 16; ++i) acc[i] = 0.f;
                const bf16_t* bp = WuvT + (size_t)(head * DVH + 32 * wave + l31) * LP + 8 * h8;
#pragma unroll
                for (int s_ = 0; s_ < 16; ++s_) { const bf16x8 a_ = *(const LAS bf16x8*)(ol + l31 * OLP + 16 * s_ + 8 * h8); const bf16x8 b_ = *(const bf16x8*)(bp + 16 * s_); acc = MFMA32(a_, b_, acc); }
#pragma unroll
                for (int i = 0; i < 16; ++i) CATb[((size_t)NP + 32 * rb + crow(i, h8)) * CATLD + 1024 + head * DVH + 32 * wave + l31] = f2bf(acc[i]);
            }
        }
        {
#pragma unroll 1
            for (int row0 = gw; row0 < NT; row0 += 4 * NGW) {
                u32x2_t oa[4][4], gz[4][4];
#pragma unroll
                for (int k = 0; k < 4; ++k) { const int r = row0 + k * NGW;
                    if (r < NT) {
#pragma unroll
                        for (int j = 0; j < 4; ++j) { oa[k][j] = *(const u32x2_t*)(ORETb + (size_t)r * 1024 + 4 * lane + 256 * j); gz[k][j] = *(const u32x2_t*)(SRGb + (size_t)r * 1024 + 4 * lane + 256 * j); } } }
#pragma unroll
                for (int k = 0; k < 4; ++k) { const int r = row0 + k * NGW;
                    if (r < NT) {
#pragma unroll
                        for (int j = 0; j < 4; ++j) { const f32x4 a = bf4_to_f32(oa[k][j].x, oa[k][j].y), g_ = bf4_to_f32(gz[k][j].x, gz[k][j].y);
                            const float ss = wave_sum(a[0] * a[0] + a[1] * a[1] + a[2] * a[2] + a[3] * a[3]);
                            const float rr = rsqrtf(ss * (1.f / RDV) + EPS);
                            *(u32x2_t*)(CATb + (size_t)r * CATLD + 4 * lane + 256 * j) = (u32x2_t){cvtpk(g_[0] * a[0] * rr, g_[1] * a[1] * rr), cvtpk(g_[2] * a[2] * rr, g_[3] * a[3] * rr)}; } } }
            }
        }
    }
    SEAM(6);
    if (IN(7)) {
        { pg8::StaticOrder S; S.init(NP, 1024, G, bid); pg8::Gemm g{CATb, WcatT, NP, 1024, CATLD, CATLD, CATLD}; const bool rotd = ((bid >> 3) & 1) != 0;
          pg8::EpiGate3 E{SGb, MIXb, 1024, rotd ? 4 : 16, rotd ? 20 : 32, rotd ? 32 : 0, rotd ? 2 : 0, rotd ? 0 : 1, rotd ? 0 : 1, rotd ? 1 : 2, rotd ? 1 : 2};
          pg8::gemm_phase<pg8::EpiGate3, pg8::StaticOrder, true, true>(ldsb, g, S, E); }
        __syncthreads();
        { pg8::Gemm g{CATb, WcatT, NT, 1024, 256, CATLD, CATLD, 256}; pg8::SplitOrder SS{9, bid}; pg8::EpiPart E{PART}; GEMM_SPLIT(ldsb, g, SS, E); }
    }
    SEAM(7);
    if (IN(8)) { PHASE_IDS
        for (int i = bid * NTHREADS + tid; i < NS * 256; i += G * NTHREADS) { const int r = i >> 8, c4 = (i & 255) * 4; const size_t o_ = (size_t)r * 1024 + c4;
            f32x4 mix = {0.f, 0.f, 0.f, 0.f};
#pragma unroll
            for (int br = 0; br < 3; ++br) { f32x4 a = *(const f32x4*)(PART + (size_t)(br == 2 ? 8 : 4 * br) * (512 * 1024) + o_);
                if (br < 2) {
#pragma unroll
                    for (int k_ = 1; k_ < 4; ++k_) a += *(const f32x4*)(PART + (size_t)(4 * br + k_) * (512 * 1024) + o_); }
                const unsigned gq = *(const unsigned*)(SGb + (size_t)(NP + r) * 3072 + br * 1024 + (c4 & ~255) + 16 * ((c4 & 127) >> 3) + 8 * ((c4 >> 7) & 1) + (c4 & 7));
                mix[0] += a[0] * ((float)(gq & 0xffu) * (1.f / 255.f)); mix[1] += a[1] * ((float)((gq >> 8) & 0xffu) * (1.f / 255.f));
                mix[2] += a[2] * ((float)((gq >> 16) & 0xffu) * (1.f / 255.f)); mix[3] += a[3] * ((float)(gq >> 24) * (1.f / 255.f)); }
            *(u32x2_t*)(MIXb + (size_t)(NP + r) * 1024 + c4) = (u32x2_t){cvtpk(mix[0], mix[1]), cvtpk(mix[2], mix[3])}; }
    }
    SEAM(8);
    if (IN(9)) {
        pg8::Gemm g{MIXb, WoT, NT, 1024, 1024, 1024, 1024}; pg8::TailOrder S{(const char*)ws, WS_MIXB, WS_WO_T, 1024, 16, 4, G, bid}; pg8::EpiTail E{(char*)ws, WS_HP, WS_PART};
        pg8::gemm_phase<pg8::EpiTail, pg8::TailOrder, true, true>(ldsb, g, S, E); }
    SEAM(9);
    if (IN(10)) { PHASE_IDS
        f32x4 gp[4], gf[4];
#pragma unroll
        for (int j = 0; j < 4; ++j) { gp[j] = *(const f32x4*)(g_mix_post + 4 * lane + 256 * j); gf[j] = *(const f32x4*)(g_ffn_pre + 4 * lane + 256 * j); }
        auto finish_row = [&](const int row, f32x4 (&a)[4], const f32x4 (&b)[4]) __attribute__((always_inline)) {
            float ss = 0.f;
#pragma unroll
            for (int j = 0; j < 4; ++j) ss += a[j][0] * a[j][0] + a[j][1] * a[j][1] + a[j][2] * a[j][2] + a[j][3] * a[j][3];
            float r = rsqrtf(wave_sum(ss) * (1.f / DM) + EPS); ss = 0.f;
#pragma unroll
            for (int j = 0; j < 4; ++j) { a[j] = b[j] + a[j] * r * gp[j]; *(u32x2_t*)(Hb + (size_t)row * DM + 4 * lane + 256 * j) = (u32x2_t){cvtpk(a[j][0], a[j][1]), cvtpk(a[j][2], a[j][3])};
                ss += a[j][0] * a[j][0] + a[j][1] * a[j][1] + a[j][2] * a[j][2] + a[j][3] * a[j][3]; }
            r = rsqrtf(wave_sum(ss) * (1.f / DM) + EPS);
#pragma unroll
            for (int j = 0; j < 4; ++j) { const f32x4 f_ = a[j] * r * gf[j]; *(u32x2_t*)(Fb + (size_t)row * DM + 4 * lane + 256 * j) = (u32x2_t){cvtpk(f_[0], f_[1]), cvtpk(f_[2], f_[3])}; }
        };
#pragma unroll 1
        for (int row0 = gw; row0 < NP; row0 += 4 * NGW) {
            u32x2_t hp[4][4]; f32x4 xb[4][4];
#pragma unroll
            for (int k = 0; k < 4; ++k) { const int r = row0 + k * NGW;
                if (r < NP) {
#pragma unroll
                    for (int j = 0; j < 4; ++j) { hp[k][j] = *(const u32x2_t*)(HPb + (size_t)r * DM + 4 * lane + 256 * j); xb[k][j] = *(const f32x4*)(x_prompt + (size_t)r * DM + 4 * lane + 256 * j); } } }
#pragma unroll
            for (int k = 0; k < 4; ++k) { const int r = row0 + k * NGW;
                if (r < NP) { f32x4 a[4];
#pragma unroll
                    for (int j = 0; j < 4; ++j) a[j] = bf4_to_f32(hp[k][j].x, hp[k][j].y);
                    finish_row(r, a, xb[k]); } }
        }
        for (int r = NP + gw; r < NT; r += NGW) { f32x4 a[4], b[4];
#pragma unroll
            for (int j = 0; j < 4; ++j) { const float* p_ = PART + (size_t)(r - NP) * DM + 4 * lane + 256 * j;
                a[j] = (*(const f32x4*)p_ + *(const f32x4*)(p_ + 512 * 1024)) + (*(const f32x4*)(p_ + 2 * 512 * 1024) + *(const f32x4*)(p_ + 3 * 512 * 1024));
                b[j] = *(const f32x4*)(x_sample + (size_t)(r - NP) * DM + 4 * lane + 256 * j); }
            finish_row(r, a, b); }
    }
    SEAM(10);
    if (IN(11)) {
        pg8::Gemm g{Fb, WguT, NT, 2 * DFF, 1024, 1024, 1024}; pg8::StaticOrder S; S.init(NT, 2 * DFF, G, bid); pg8::EpiSwiGLU E{ACTb, DFF};
        GEMM_PHASE(pg8::EpiSwiGLU, ldsb, g, S, E);
    }
    SEAM(11);
    if (IN(13)) {
        pg8::Gemm g{ACTb, WdT, NT, 1024, DFF, DFF, DFF}; pg8::TailOrder S{(const char*)ws, WS_ACTB, WS_WD_T, DFF, DFF / 64, 11, G, bid}; pg8::EpiTail E{(char*)ws, WS_FO, WS_PART};
        pg8::gemm_phase<pg8::EpiTail, pg8::TailOrder, true, true>(ldsb, g, S, E); }
    SEAM(13);
    if (IN(14)) { PHASE_IDS
        f32x4 gp[4];
#pragma unroll
        for (int j = 0; j < 4; ++j) gp[j] = *(const f32x4*)(g_ffn_post + 4 * lane + 256 * j);
#pragma unroll 1
        for (int row0 = gw; row0 < NP; row0 += 4 * NGW) {
            u32x2_t fa[4][4], hb[4][4];
#pragma unroll
            for (int k = 0; k < 4; ++k) { const int r = row0 + k * NGW;
                if (r < NP) {
#pragma unroll
                    for (int j = 0; j < 4; ++j) { fa[k][j] = *(const u32x2_t*)(FOb + (size_t)r * DM + 4 * lane + 256 * j); hb[k][j] = *(const u32x2_t*)(Hb + (size_t)r * DM + 4 * lane + 256 * j); } } }
#pragma unroll
            for (int k = 0; k < 4; ++k) { const int r = row0 + k * NGW;
                if (r < NP) { f32x4 a[4]; float ss = 0.f;
#pragma unroll
                    for (int j = 0; j < 4; ++j) { a[j] = bf4_to_f32(fa[k][j].x, fa[k][j].y); ss += a[j][0] * a[j][0] + a[j][1] * a[j][1] + a[j][2] * a[j][2] + a[j][3] * a[j][3]; }
                    const float rs = rsqrtf(wave_sum(ss) * (1.f / DM) + EPS);
                    float* y = out + O_YP + (size_t)r * DM;
#pragma unroll
                    for (int j = 0; j < 4; ++j) __builtin_nontemporal_store(bf4_to_f32(hb[k][j].x, hb[k][j].y) + a[j] * rs * gp[j], (f32x4*)(y + 4 * lane + 256 * j)); } }
        }
        for (int r = NP + gw; r < NT; r += NGW) { f32x4 a[4]; float ss = 0.f;
#pragma unroll
            for (int j = 0; j < 4; ++j) { const float* p_ = PART + (size_t)(r - NP) * DM + 4 * lane + 256 * j; f32x4 a_ = *(const f32x4*)p_;
#pragma unroll
                for (int k_ = 1; k_ < 11; ++k_) a_ += *(const f32x4*)(p_ + (size_t)k_ * 512 * 1024);
                a[j] = a_; ss += a_[0] * a_[0] + a_[1] * a_[1] + a_[2] * a_[2] + a_[3] * a_[3]; }
            const float rs = rsqrtf(wave_sum(ss) * (1.f / DM) + EPS);
            float* y = out + O_YS + (size_t)(r - NP) * DM;
#pragma unroll
            for (int j = 0; j < 4; ++j) { const u32x2_t h_ = *(const u32x2_t*)(Hb + (size_t)r * DM + 4 * lane + 256 * j); *(f32x4*)(y + 4 * lane + 256 * j) = bf4_to_f32(h_.x, h_.y) + a[j] * rs * gp[j]; } }
    }
#undef IN
#undef SEAM
#undef PHASE_IDS
}
#undef x_prompt
#undef x_sample
#undef mem_prompt
#undef cache_ckv
#undef cache_kpe
#undef page_table
#undef state_ret
#undef cache_mem_k
#undef cache_mem_v
#undef g_mix_pre
#undef g_mix_post
#undef g_ffn_pre
#undef g_ffn_post
#undef g_mem
#undef g_qlat
#undef g_kvlat
#undef w_in
#undef w_uq
#undef w_uk
#undef w_uv
#undef w_mem_k
#undef w_mem_v
#undef w_ret_o
#undef w_mla_o
#undef w_x_o
#undef w_out
#undef w_gate
#undef w_up
#undef w_down
#undef COSA
#undef SINA
#undef COSB
#undef SINB
#undef U
#undef MN
#undef Zb
#undef RQ
#undef RK
#undef CQN
#undef CKVN
#undef KPER
#undef Q
#undef QLAT
#undef QPE
#undef ORETb
#undef OLAT
#undef OX
#undef OMLA
#undef ORETN
#undef ARET
#undef AMLA
#undef AX
#undef MIX
#undef HPb
#undef Hb
#undef F
#undef GU
#undef FOb
#undef WinT
#undef WmkvT
#undef WuqT
#undef WabsT
#undef WcatT
#undef CATb
#undef WroT
#undef WmoT
#undef WxoT
#undef WoT
#undef WguT
#undef WdT
#undef Ub
#undef MNb
#undef CQNb
#undef ORETNb
#undef OMLAb
#undef OXb
#undef MIXb
#undef Fb
#undef ACTb
#undef WukT
#undef WuvT
#undef CKVNb
#undef KPERb
#undef XQb
#undef MKb
#undef MVT
#undef KN
#undef VT
#undef Qb
#undef RQt
#undef RKt
#undef RKtT
#undef RVT
#undef UT
#undef SPT
#undef QPEb
#undef WukB
#undef PART
#undef SGb
#undef SRGb
#undef T0b
#undef T1b
#undef QLATb
#undef PO
#undef PML
constexpr int N_PHASES = 15;
}

extern "C" void kernel_launch(void* const* d_in, const int* in_sizes, int n_in, void* d_out, int out_size, void* d_ws, size_t ws_size, hipStream_t stream) {
    static int grid = 0;
    if (grid == 0) {
        if (n_in != 29 || (size_t)out_size != O_END || ws_size < WS_END) { fprintf(stderr, "kernel_launch: unexpected shapes: n_in %d out %d ws %zu (need %zu)\n", n_in, out_size, ws_size, (size_t)WS_END); grid = -1; return; }
        int dev = 0, cus = 0, per_cu = 0;
        if (hipGetDevice(&dev) != hipSuccess || hipDeviceGetAttribute(&cus, hipDeviceAttributeMultiprocessorCount, dev) != hipSuccess) { grid = -1; return; }
        if (hipFuncSetAttribute((const void*)fwd_kernel, hipFuncAttributeMaxDynamicSharedMemorySize, LDS_BYTES) != hipSuccess) { fprintf(stderr, "kernel_launch: hipFuncSetAttribute failed\n"); grid = -1; return; }
        if (hipOccupancyMaxActiveBlocksPerMultiprocessor(&per_cu, (const void*)fwd_kernel, NTHREADS, LDS_BYTES) != hipSuccess || per_cu < 1) { fprintf(stderr, "kernel_launch: occupancy query says %d\n", per_cu); per_cu = 1; }
        (void)hipGetLastError();
        grid = cus;
    }
    if (grid < 0) return;
    (void)hipMemsetAsync((char*)d_ws + WS_CTL + (size_t)CW_BAR * 4, 0, (size_t)XCD_BAR_WORDS * 4, stream);
    Args a{};
    for (int i = 0; i < 29; ++i) a.in[i] = (const float*)d_in[i];
    a.out = (float*)d_out; a.ws = (unsigned char*)d_ws;
#if MK_ONE_LAUNCH
    a.ph_lo = 0; a.ph_hi = N_PHASES; a.sub = 0xff;
    hipLaunchKernelGGL(fwd_kernel, dim3(grid), dim3(NTHREADS), LDS_BYTES, stream, a);
#if PROBE_DUP >= 0
    a.ph_lo = PROBE_DUP; a.ph_hi = PROBE_DUP + 1; a.sub = PROBE_SUB;
    for (int r = 0; r < PROBE_REP; ++r) hipLaunchKernelGGL(fwd_kernel, dim3(grid), dim3(NTHREADS), LDS_BYTES, stream, a);
#endif
#else
    a.sub = 0xff; for (int p = 0; p < N_PHASES; ++p) { a.ph_lo = p; a.ph_hi = p + 1; hipLaunchKernelGGL(fwd_kernel, dim3(grid), dim3(NTHREADS), LDS_BYTES, stream, a); }
#endif
}
```
